# Optimizing an MI355X kernel written in HIP

```python
import jax
import jax.numpy as jnp
from jax import lax
import numpy as np

D_MODEL = 1024
BATCH = 4
SEQ = 4096
DEPTH = 4

CTX_LEN = 256
GRID_W = 64
N_MOD = 6
ADA_SCALE = 0.5
LN_EPS = 1e-5
DN_ALPHA = (2 * DEPTH) ** 0.25
DN_BETA = (8 * DEPTH) ** -0.25

SSD_HEADS = 8
SSD_HEAD_DIM = 64
SSD_INNER = SSD_HEADS * SSD_HEAD_DIM
SSD_GROUPS = 2
SSD_STATE = 128
SSD_CONV = 3
SSD_CHUNK = 128
SSD_XBC = SSD_INNER + 2 * SSD_GROUPS * SSD_STATE

RWKV_HEADS = 4
RWKV_HEAD_DIM = 64
RWKV_WIDTH = RWKV_HEADS * RWKV_HEAD_DIM
RWKV_DECAY_LORA = 64
RWKV_ICLR_LORA = 64
RWKV_GATE_LORA = 128
RWKV_COLS = 3 * RWKV_WIDTH + 2 * RWKV_DECAY_LORA + 2 * RWKV_ICLR_LORA + RWKV_GATE_LORA
RWKV_LNX_EPS = 64e-5

GLA_HEADS = 4
GLA_KEY_DIM = 32
GLA_VAL_DIM = 64
GLA_K_WIDTH = GLA_HEADS * GLA_KEY_DIM
GLA_V_WIDTH = GLA_HEADS * GLA_VAL_DIM
GLA_GATE_LORA = 16
GLA_GATE_NORMALIZER = 16.0
GLA_CHUNK = 16

MIX_WIDTH = SSD_INNER + RWKV_WIDTH + GLA_V_WIDTH
IN_WIDTHS = (SSD_INNER, SSD_XBC, 2 * SSD_HEADS, RWKV_COLS, GLA_K_WIDTH, GLA_K_WIDTH, GLA_V_WIDTH, 2 * GLA_GATE_LORA, GLA_V_WIDTH)
N_IN = SSD_INNER + SSD_XBC + 2 * SSD_HEADS + RWKV_COLS + 2 * GLA_K_WIDTH + 2 * GLA_V_WIDTH + 2 * GLA_GATE_LORA

N_EXPERTS = 64
TOP_K = 8
N_GROUPS = 8
TOPK_GROUPS = 4
EXPERT_DIM = 256
SHARED_DIM = 256
ROUTED_SCALE = 2.5
MOE_BLOCK = 128

kernel_name = 'hybrid_ssd_rwkv7_gla_moe_diffusion'


def _split(z, widths):
    return jnp.split(z, [int(i) for i in np.cumsum(widths)[:-1]], axis=-1)


def _layernorm(x, w=None, b=None, eps=LN_EPS):
    xf = x.astype(jnp.float32)
    mu = jnp.mean(xf, -1, keepdims=True)
    var = jnp.mean(jnp.square(xf - mu), -1, keepdims=True)
    y = (xf - mu) * lax.rsqrt(var + eps)
    if w is not None:
        y = y * w.astype(jnp.float32) + b.astype(jnp.float32)
    return y.astype(x.dtype)


def _rmsnorm_groups(x, w, group, eps=1e-5):
    xf = x.astype(jnp.float32)
    shp = xf.shape
    g = xf.reshape(shp[:-1] + (shp[-1] // group, group))
    g = g * lax.rsqrt(jnp.mean(g * g, -1, keepdims=True) + eps)
    return (g.reshape(shp) * w.astype(jnp.float32)).astype(x.dtype)


def _seg_flip(z, n_ctx):
    return jnp.concatenate([jnp.flip(z[:, :n_ctx], 1), jnp.flip(z[:, n_ctx:], 1)], axis=1)


def _dwconv_centred(z, w, b):
    ch = z.shape[-1]
    pad = (SSD_CONV - 1) // 2
    y = lax.conv_general_dilated(z, w[:, None, :].astype(z.dtype), window_strides=(1,), padding=[(pad, pad)],
                                 dimension_numbers=('NWC', 'WIO', 'NWC'), feature_group_count=ch)
    return y + b


def _seq_shift_mix(z, mu_prev, mu_next):
    prev = jnp.pad(z, ((0, 0), (1, 0), (0, 0)))[:, :-1]
    nxt = jnp.pad(z, ((0, 0), (0, 1), (0, 0)))[:, 1:]
    return z + mu_prev * (prev - z) + mu_next * (nxt - z)


def _grid_shift_mix(z, mu):
    b, s, ch = z.shape
    rows = s // GRID_W
    g = z.reshape(b, rows, GRID_W, ch)
    left = jnp.pad(g, ((0, 0), (0, 0), (1, 0), (0, 0)))[:, :, :-1]
    right = jnp.pad(g, ((0, 0), (0, 0), (0, 1), (0, 0)))[:, :, 1:]
    up = jnp.pad(g, ((0, 0), (1, 0), (0, 0), (0, 0)))[:, :-1]
    down = jnp.pad(g, ((0, 0), (0, 1), (0, 0), (0, 0)))[:, 1:]
    out = g + mu[0] * (left - g) + mu[1] * (right - g) + mu[2] * (up - g) + mu[3] * (down - g)
    return out.reshape(b, s, ch)


def _ssd_chunked(x, dt, log_a, bm, cm):
    n, t, h, p = x.shape
    g, ds = bm.shape[2], bm.shape[3]
    q = SSD_CHUNK
    nc = t // q
    rep = h // g
    b_h = jnp.repeat(bm, rep, axis=2).reshape(n, nc, q, h, ds)
    c_h = jnp.repeat(cm, rep, axis=2).reshape(n, nc, q, h, ds)
    xdt = (x * dt[..., None]).reshape(n, nc, q, h, p)
    acs = jnp.cumsum(log_a.reshape(n, nc, q, h), axis=2)
    acs_h = jnp.moveaxis(acs, 3, 1)
    tril = jnp.tril(jnp.ones((q, q), dtype=bool))
    seg = acs_h[..., :, None] - acs_h[..., None, :]
    lmat = jnp.exp(jnp.where(tril, seg, -jnp.inf))
    scores = jnp.einsum('nclhd,ncshd->nhcls', c_h, b_h) * lmat
    y_diag = jnp.einsum('nhcls,ncshp->nclhp', scores, xdt)
    decay_end = jnp.exp(acs[:, :, -1:, :] - acs)
    states = jnp.einsum('nclhd,nclh,nclhp->nchpd', b_h, decay_end, xdt)
    chunk_decay = jnp.exp(acs[:, :, -1, :])

    def step(hprev, inp):
        st, dec = inp
        return hprev * dec[..., None, None] + st, hprev

    h0 = jnp.zeros((n, h, p, ds), x.dtype)
    _, h_in = lax.scan(step, h0, (jnp.moveaxis(states, 1, 0), jnp.moveaxis(chunk_decay, 1, 0)))
    h_in = jnp.moveaxis(h_in, 0, 1)
    y_off = jnp.einsum('nclhd,nchpd,nclh->nclhp', c_h, h_in, jnp.exp(acs))
    return (y_diag + y_off).reshape(n, t, h, p)


def _rwkv7_scan(r, w, k, v, kk, a):
    n, t, h, dk = r.shape

    def step(S, inp):
        r_t, w_t, k_t, v_t, kk_t, a_t = inp
        sa = -jnp.einsum('nhvk,nhk->nhv', S, kk_t)
        S = S * w_t[:, :, None, :] + sa[..., None] * (kk_t * a_t)[:, :, None, :] + v_t[..., None] * k_t[:, :, None, :]
        return S, jnp.einsum('nhvk,nhk->nhv', S, r_t)

    S0 = jnp.zeros((n, h, dk, dk), r.dtype)
    xs = (jnp.moveaxis(r, 1, 0), jnp.moveaxis(w, 1, 0), jnp.moveaxis(k, 1, 0),
          jnp.moveaxis(v, 1, 0), jnp.moveaxis(kk, 1, 0), jnp.moveaxis(a, 1, 0))
    _, y = lax.scan(step, S0, xs)
    return jnp.moveaxis(y, 0, 1)


def _gla_chunked(q, k, v, log_a):
    n, t, h, dk = q.shape
    dv = v.shape[-1]
    c = GLA_CHUNK
    nc = t // c
    q = q.reshape(n, nc, c, h, dk)
    k = k.reshape(n, nc, c, h, dk)
    v = v.reshape(n, nc, c, h, dv)
    acs = jnp.cumsum(log_a.reshape(n, nc, c, h, dk), axis=2)
    tril = jnp.tril(jnp.ones((c, c), dtype=bool))[:, :, None, None]
    seg = acs[:, :, :, None] - acs[:, :, None, :]
    decay = jnp.exp(jnp.where(tril, seg, -jnp.inf))
    scores = jnp.einsum('ncihd,ncjhd,ncijhd->nchij', q, k, decay)
    o_intra = jnp.einsum('nchij,ncjhv->ncihv', scores, v)
    q_dec = q * jnp.exp(acs)
    k_dec = k * jnp.exp(acs[:, :, -1:] - acs)
    states = jnp.einsum('ncjhd,ncjhv->nchdv', k_dec, v)
    chunk_decay = jnp.exp(acs[:, :, -1])

    def step(S, inp):
        st, dec = inp
        return S * dec[..., None] + st, S

    S0 = jnp.zeros((n, h, dk, dv), q.dtype)
    _, s_in = lax.scan(step, S0, (jnp.moveaxis(states, 1, 0), jnp.moveaxis(chunk_decay, 1, 0)))
    s_in = jnp.moveaxis(s_in, 0, 1)
    o_inter = jnp.einsum('ncihd,nchdv->ncihv', q_dec, s_in)
    return (o_intra + o_inter).reshape(n, t, h, dv)


def _token_mixer(u, n_ctx, w_in, ssd_conv_w, ssd_conv_b, ssd_dt_bias, ssd_a_log, ssd_d, ssd_norm_w,
                 rwkv_mu, rwkv_w0, rwkv_w2, rwkv_a0, rwkv_a2, rwkv_g2, rwkv_kk, rwkv_ka, rwkv_rk,
                 rwkv_lnx_w, rwkv_lnx_b, gla_gu, gla_gb, gla_norm_w, w_out):
    f32 = jnp.float32
    bsz, t, _ = u.shape
    flip = lambda zz: _seg_flip(zz, n_ctx)

    def both(fwd, bwd):
        s = jnp.stack([fwd, flip(bwd)])
        return s.reshape((2 * bsz,) + s.shape[2:])

    def unboth(y):
        y = y.reshape((2, bsz) + y.shape[1:])
        return y[0] + flip(y[1])

    z, xbc, dt, rw, gq, gk, gv, gd, og = _split(u @ w_in, IN_WIDTHS)

    xbc = jax.nn.silu(jnp.concatenate([_dwconv_centred(xbc[:, :n_ctx], ssd_conv_w, ssd_conv_b),
                                       _dwconv_centred(xbc[:, n_ctx:], ssd_conv_w, ssd_conv_b)], axis=1))
    xs, bm, cm = _split(xbc.astype(f32), (SSD_INNER, SSD_GROUPS * SSD_STATE, SSD_GROUPS * SSD_STATE))
    xs = xs.reshape(bsz, t, SSD_HEADS, SSD_HEAD_DIM)
    bm = bm.reshape(bsz, t, SSD_GROUPS, SSD_STATE)
    cm = cm.reshape(bsz, t, SSD_GROUPS, SSD_STATE)
    dt = jax.nn.softplus(dt.astype(f32).reshape(bsz, t, 2, SSD_HEADS) + ssd_dt_bias.astype(f32))
    neg_a = -jnp.exp(ssd_a_log.astype(f32))
    dt_f, dt_b = dt[:, :, 0], dt[:, :, 1]
    y = unboth(_ssd_chunked(both(xs, xs), both(dt_f, dt_b), both(dt_f * neg_a[0], dt_b * neg_a[1]),
                            both(bm, bm), both(cm, cm)))
    y = y + ssd_d.astype(f32)[:, None] * xs
    y_ssd = _rmsnorm_groups(y.reshape(bsz, t, SSD_INNER) * jax.nn.silu(z.astype(f32)), ssd_norm_w,
                            SSD_INNER // SSD_GROUPS)

    rw = jnp.concatenate([_seq_shift_mix(rw[:, :n_ctx], rwkv_mu[0], rwkv_mu[1]),
                          _grid_shift_mix(rw[:, n_ctx:], rwkv_mu)], axis=1)
    r, k, v, wd_f, wd_b, ad_f, ad_b, gd_r = _split(
        rw.astype(f32), (RWKV_WIDTH,) * 3 + (RWKV_DECAY_LORA,) * 2 + (RWKV_ICLR_LORA,) * 2 + (RWKV_GATE_LORA,))
    hd = lambda zz: zz.reshape(bsz, t, RWKV_HEADS, RWKV_HEAD_DIM)
    decay = lambda wd, i: jnp.exp(-jnp.exp(-jax.nn.softplus(-(rwkv_w0[i] + jnp.tanh(wd) @ rwkv_w2[i])) - 0.5))
    iclr = lambda ad, i: jax.nn.sigmoid(rwkv_a0[i] + ad @ rwkv_a2[i])
    w_f, w_b = hd(decay(wd_f, 0)), hd(decay(wd_b, 1))
    a_f, a_b = hd(iclr(ad_f, 0)), hd(iclr(ad_b, 1))
    r, k, v = hd(r), hd(k), hd(v)
    kk = k * rwkv_kk.reshape(RWKV_HEADS, RWKV_HEAD_DIM)
    kk = kk / jnp.maximum(jnp.sqrt(jnp.sum(kk * kk, -1, keepdims=True)), 1e-12)
    ka = rwkv_ka.reshape(RWKV_HEADS, RWKV_HEAD_DIM)
    k_f = k * (1.0 + (a_f - 1.0) * ka)
    k_b = k * (1.0 + (a_b - 1.0) * ka)
    y = unboth(_rwkv7_scan(both(r, r), both(w_f, w_b), both(k_f, k_b), both(v, v), both(kk, kk), both(a_f, a_b)))
    mu = jnp.mean(y, -1, keepdims=True)
    var = jnp.mean(jnp.square(y - mu), -1, keepdims=True)
    y = ((y - mu) * lax.rsqrt(var + RWKV_LNX_EPS)).reshape(bsz, t, RWKV_WIDTH) * rwkv_lnx_w + rwkv_lnx_b
    bonus = (jnp.sum(r * (k_f + k_b) * rwkv_rk, -1, keepdims=True) * v).reshape(bsz, t, RWKV_WIDTH)
    y_rwkv = (y + bonus) * (jax.nn.sigmoid(gd_r) @ rwkv_g2)

    gh = lambda zz, d: zz.reshape(bsz, t, GLA_HEADS, d)
    q = gh(gq.astype(f32), GLA_KEY_DIM) * GLA_KEY_DIM ** -0.5
    kg = gh(gk.astype(f32), GLA_KEY_DIM)
    vg = gh(gv.astype(f32), GLA_VAL_DIM)
    gd_f, gd_b = _split(gd.astype(f32), (GLA_GATE_LORA, GLA_GATE_LORA))
    la = lambda gg, i: gh(jax.nn.log_sigmoid(gg @ gla_gu[i] + gla_gb[i]) / GLA_GATE_NORMALIZER, GLA_KEY_DIM)
    o = unboth(_gla_chunked(both(q, q), both(kg, kg), both(vg, vg), both(la(gd_f, 0), la(gd_b, 1))))
    y_gla = _rmsnorm_groups(o.reshape(bsz, t, GLA_V_WIDTH), gla_norm_w, GLA_VAL_DIM) * jax.nn.silu(og.astype(f32))

    y_mix = jnp.concatenate([y_ssd, y_rwkv, y_gla], axis=-1).astype(u.dtype)
    return y_mix @ w_out


def _moe_ffn(h, router_w, router_b, w1, w3, w2, sw1, sw3, sw2):
    f32 = jnp.float32
    t = h.shape[0]
    per_group = N_EXPERTS // N_GROUPS
    scores = jax.nn.sigmoid((h @ router_w).astype(f32))
    sel = scores + router_b.astype(f32)
    grp_score = lax.top_k(sel.reshape(t, N_GROUPS, per_group), 2)[0].sum(-1)
    _, top_g = lax.top_k(grp_score, TOPK_GROUPS)
    gmask = jax.nn.one_hot(top_g, N_GROUPS, dtype=f32).sum(1) > 0
    sel = jnp.where(jnp.repeat(gmask, per_group, axis=1), sel, -jnp.inf)
    _, idx = lax.top_k(sel, TOP_K)
    wts = jnp.take_along_axis(scores, idx, axis=1)
    wts = wts / jnp.sum(wts, -1, keepdims=True) * ROUTED_SCALE

    n_assign = t * TOP_K
    flat_e = idx.reshape(-1)
    order = jnp.argsort(flat_e)
    sorted_e = flat_e[order]
    counts = jnp.bincount(flat_e, length=N_EXPERTS)
    padded = (counts + MOE_BLOCK - 1) // MOE_BLOCK * MOE_BLOCK
    pend = jnp.cumsum(padded)
    pstart = pend - padded
    sstart = jnp.cumsum(counts) - counts
    dest = pstart[sorted_e] + jnp.arange(n_assign, dtype=jnp.int32) - sstart[sorted_e]
    n_rows = -(-n_assign // MOE_BLOCK) * MOE_BLOCK + N_EXPERTS * MOE_BLOCK
    n_blocks = n_rows // MOE_BLOCK
    row_tok = jnp.zeros((n_rows,), jnp.int32).at[dest].set((order // TOP_K).astype(jnp.int32))
    row_w = jnp.zeros((n_rows,), f32).at[dest].set(wts.reshape(-1)[order])
    block_e = jnp.minimum(jnp.searchsorted(pend, jnp.arange(n_blocks, dtype=jnp.int32) * MOE_BLOCK, side='right'),
                          N_EXPERTS - 1)

    def body(acc, blk):
        tok, wt, e = blk
        xb = h[tok]
        hid = jax.nn.silu(xb @ w1[e]) * (xb @ w3[e])
        return acc.at[tok].add(wt[:, None] * (hid @ w2[e]).astype(f32)), None

    routed, _ = lax.scan(body, jnp.zeros(h.shape, f32),
                         (row_tok.reshape(n_blocks, MOE_BLOCK), row_w.reshape(n_blocks, MOE_BLOCK), block_e))
    shared = (jax.nn.silu(h @ sw1) * (h @ sw3)) @ sw2
    return routed.astype(h.dtype) + shared


def setup_inputs(seed: int = 0) -> dict:
    key = jax.random.key(seed)
    ks = jax.random.split(key, 40)
    L, D, E, F, Fs = DEPTH, D_MODEL, N_EXPERTS, EXPERT_DIM, SHARED_DIM
    nrm = lambda k, shape, s: jax.random.normal(k, shape, jnp.float32) * s
    one = lambda k, shape: 1.0 + 0.1 * jax.random.normal(k, shape, jnp.float32)
    dt0 = jnp.exp(jax.random.uniform(ks[9], (L, 2, SSD_HEADS), jnp.float32, np.log(1e-3), np.log(1e-1)))
    return {
        'x': nrm(ks[0], (BATCH, SEQ, D), 1.0),
        'c': nrm(ks[1], (BATCH, D), 1.0),
        'ctx': nrm(ks[2], (BATCH, CTX_LEN, D), 1.0),
        'c_ctx': nrm(ks[3], (D,), 1.0),
        'ada_w': nrm(ks[4], (L, D, N_MOD * D), D ** -0.5 * ADA_SCALE),
        'ada_b': nrm(ks[5], (L, N_MOD * D), 0.02),
        'w_in': nrm(ks[6], (L, D, N_IN), D ** -0.5),
        'ssd_conv_w': nrm(ks[7], (L, SSD_CONV, SSD_XBC), SSD_CONV ** -0.5),
        'ssd_conv_b': nrm(ks[8], (L, SSD_XBC), 0.02),
        'ssd_dt_bias': dt0 + jnp.log(-jnp.expm1(-dt0)),
        'ssd_a_log': jnp.log(jax.random.uniform(ks[10], (L, 2, SSD_HEADS), jnp.float32, 1.0, 16.0)),
        'ssd_d': one(ks[11], (L, SSD_HEADS)),
        'ssd_norm_w': one(ks[12], (L, SSD_INNER)),
        'rwkv_mu': jax.random.uniform(ks[13], (L, 4, RWKV_COLS), jnp.float32, 0.0, 0.5),
        'rwkv_w0': jax.random.uniform(ks[14], (L, 2, RWKV_WIDTH), jnp.float32, -6.0, 1.0),
        'rwkv_w2': nrm(ks[15], (L, 2, RWKV_DECAY_LORA, RWKV_WIDTH), 0.1),
        'rwkv_a0': nrm(ks[16], (L, 2, RWKV_WIDTH), 0.1),
        'rwkv_a2': nrm(ks[17], (L, 2, RWKV_ICLR_LORA, RWKV_WIDTH), 0.1),
        'rwkv_g2': nrm(ks[18], (L, RWKV_GATE_LORA, RWKV_WIDTH), RWKV_GATE_LORA ** -0.5),
        'rwkv_kk': one(ks[19], (L, RWKV_WIDTH)),
        'rwkv_ka': one(ks[20], (L, RWKV_WIDTH)),
        'rwkv_rk': nrm(ks[21], (L, RWKV_HEADS, RWKV_HEAD_DIM), 0.1),
        'rwkv_lnx_w': one(ks[22], (L, RWKV_WIDTH)),
        'rwkv_lnx_b': nrm(ks[23], (L, RWKV_WIDTH), 0.02),
        'gla_gu': nrm(ks[24], (L, 2, GLA_GATE_LORA, GLA_K_WIDTH), GLA_GATE_LORA ** -0.5),
        'gla_gb': nrm(ks[25], (L, 2, GLA_K_WIDTH), 0.5),
        'gla_norm_w': one(ks[26], (L, GLA_V_WIDTH)),
        'w_out': nrm(ks[27], (L, MIX_WIDTH, D), MIX_WIDTH ** -0.5 * DN_BETA),
        'ln1_w': one(ks[28], (L, D)),
        'ln1_b': nrm(ks[29], (L, D), 0.02),
        'ln2_w': one(ks[30], (L, D)),
        'ln2_b': nrm(ks[31], (L, D), 0.02),
        'router_w': nrm(ks[32], (L, D, E), D ** -0.5),
        'router_b': nrm(ks[33], (L, E), 0.01),
        'exp_w1': nrm(ks[34], (L, E, D, F), D ** -0.5),
        'exp_w3': nrm(ks[35], (L, E, D, F), D ** -0.5),
        'exp_w2': nrm(ks[36], (L, E, F, D), F ** -0.5 * DN_BETA),
        'sh_w1': nrm(ks[37], (L, D, Fs), D ** -0.5),
        'sh_w3': nrm(ks[38], (L, D, Fs), D ** -0.5),
        'sh_w2': nrm(ks[39], (L, Fs, D), Fs ** -0.5 * DN_BETA),
    }


def reference(x, c, ctx, c_ctx, ada_w, ada_b, w_in, ssd_conv_w, ssd_conv_b, ssd_dt_bias, ssd_a_log, ssd_d,
              ssd_norm_w, rwkv_mu, rwkv_w0, rwkv_w2, rwkv_a0, rwkv_a2, rwkv_g2, rwkv_kk, rwkv_ka, rwkv_rk,
              rwkv_lnx_w, rwkv_lnx_b, gla_gu, gla_gb, gla_norm_w, w_out, ln1_w, ln1_b, ln2_w, ln2_b,
              router_w, router_b, exp_w1, exp_w3, exp_w2, sh_w1, sh_w3, sh_w2):
    n_ctx = ctx.shape[1]
    xc = ctx
    for l in range(DEPTH):
        mod = jnp.split(jax.nn.silu(c) @ ada_w[l] + ada_b[l], N_MOD, axis=-1)
        modc = jnp.split(jax.nn.silu(c_ctx) @ ada_w[l] + ada_b[l], N_MOD, axis=-1)
        sh1, sc1, g1, sh2, sc2, g2 = [m[:, None, :] for m in mod]
        sh1c, sc1c, g1c, sh2c, sc2c, g2c = modc

        u = jnp.concatenate([_layernorm(xc) * (1.0 + sc1c) + sh1c,
                             _layernorm(x) * (1.0 + sc1) + sh1], axis=1)
        mix = _token_mixer(u, n_ctx, w_in[l], ssd_conv_w[l], ssd_conv_b[l], ssd_dt_bias[l], ssd_a_log[l], ssd_d[l],
                           ssd_norm_w[l], rwkv_mu[l], rwkv_w0[l], rwkv_w2[l], rwkv_a0[l], rwkv_a2[l], rwkv_g2[l],
                           rwkv_kk[l], rwkv_ka[l], rwkv_rk[l], rwkv_lnx_w[l], rwkv_lnx_b[l], gla_gu[l], gla_gb[l],
                           gla_norm_w[l], w_out[l])
        x = _layernorm(DN_ALPHA * x + g1 * mix[:, n_ctx:], ln1_w[l], ln1_b[l])
        xc = _layernorm(DN_ALPHA * xc + g1c * mix[:, :n_ctx], ln1_w[l], ln1_b[l])

        h = _layernorm(x) * (1.0 + sc2) + sh2
        moe_w = (router_w[l], router_b[l], exp_w1[l], exp_w3[l], exp_w2[l], sh_w1[l], sh_w3[l], sh_w2[l])
        if l < DEPTH - 1:
            hc = _layernorm(xc) * (1.0 + sc2c) + sh2c
            tok = jnp.concatenate([hc, h], axis=1)
            f = _moe_ffn(tok.reshape(-1, D_MODEL), *moe_w).reshape(tok.shape)
            xc = _layernorm(DN_ALPHA * xc + g2c * f[:, :n_ctx], ln2_w[l], ln2_b[l])
            f = f[:, n_ctx:]
        else:
            f = _moe_ffn(h.reshape(-1, D_MODEL), *moe_w).reshape(h.shape)
        x = _layernorm(DN_ALPHA * x + g2 * f, ln2_w[l], ln2_b[l])
    return x
```

```cpp
#ifndef HIPEMU
#include <hip/hip_runtime.h>
#endif
#include <stdint.h>
#include <stdio.h>

#ifndef B_
#define B_ 4
#endif
#ifndef SEQ_
#define SEQ_ 4096
#endif
#ifndef CTX_
#define CTX_ 256
#endif
#ifndef DEPTH_
#define DEPTH_ 4
#endif
#ifndef N_LAUNCH_MODE
#define N_LAUNCH_MODE 0
#endif
#define T_ (SEQ_ + CTX_)
#define NT_ (B_ * T_)
#define D_ 1024
#define NIN_ 3504
#define NMOD_ 6144
#define NR_ (B_ + 1)
#define OZ 0
#define OXBC 512
#define ODT 1536
#define ORW 1552
#define OGQ 2704
#define OGK 2832
#define OGV 2960
#define OGD 3216
#define OOG 3248
#define ALPHA_ 1.681792830507429f
#define NEXP 64
#define NSLOT 9

#define DEVFN __device__ __forceinline__
#define LDT 72
#define GEMM_SMEM (2 * 128 * LDT * 2)
typedef unsigned short bf16_t;
typedef unsigned u32x4 __attribute__((ext_vector_type(4)));

#ifdef HIPEMU
typedef emu_bf16x8 bf16x8;
typedef emu_f32x4 f32x4;
#define MFMA16(a, b, c) emu_mfma_16x16x32_bf16(a, b, c)
#define GRID_SYNC() hipemu::grid_sync()
#else
typedef short bf16x8 __attribute__((ext_vector_type(8)));
typedef float f32x4 __attribute__((ext_vector_type(4)));
#define MFMA16(a, b, c) __builtin_amdgcn_mfma_f32_16x16x32_bf16(a, b, c, 0, 0, 0)
#endif

DEVFN float bf2f(bf16_t h) { return __builtin_bit_cast(float, (unsigned)h << 16); }
DEVFN bf16_t f2bf(float f) { unsigned u = __builtin_bit_cast(unsigned, f); u += 0x7FFFu + ((u >> 16) & 1u); return (bf16_t)(u >> 16); }
DEVFN float sigmoidf_(float x) { return 1.f / (1.f + expf(-x)); }
DEVFN float siluf_(float x) { return x / (1.f + expf(-x)); }
DEVFN float softplusf_(float x) { return x > 20.f ? x : log1pf(expf(x)); }
DEVFN float logsigmoidf_(float x) { return fminf(x, 0.f) - log1pf(expf(-fabsf(x))); }
DEVFN float wave_sum(float v) { for (int m = 32; m >= 1; m >>= 1) v += __shfl_xor(v, m); return v; }

constexpr size_t al(size_t x) { return (x + 255) & ~(size_t)255; }
struct Ws {
  static constexpr size_t BAR = 0;
  static constexpr size_t CNT = 16384;
  static constexpr size_t MOD = CNT + 4096;
  static constexpr size_t ZROW = al(MOD + (size_t)DEPTH_ * NR_ * NMOD_ * 4);
  static constexpr size_t ZERO_END = al(ZROW + 2048);
  static constexpr size_t MODP = ZERO_END;
  static constexpr size_t RWT = al(MODP + (size_t)16 * DEPTH_ * NR_ * NMOD_ * 4);
  static constexpr size_t X = al(RWT + (size_t)DEPTH_ * 64 * 1024 * 4);
  static constexpr size_t U = al(X + (size_t)NT_ * 1024 * 4);
  static constexpr size_t YMIX = al(U + (size_t)NT_ * 1024 * 2);
  static constexpr size_t ZX = al(YMIX + (size_t)NT_ * 1024 * 2);
  static constexpr size_t MIX = ZX;
  static constexpr size_t LTOK = al(ZX + (size_t)NT_ * NIN_ * 2);
  static constexpr size_t LWT = al(LTOK + (size_t)64 * NT_ * 4);
  static constexpr size_t WIN = al(LWT + (size_t)64 * NT_ * 4);
  static constexpr size_t WOUT = al(WIN + (size_t)DEPTH_ * NIN_ * 1024 * 2);
  static constexpr size_t W13 = al(WOUT + (size_t)DEPTH_ * 1024 * 1024 * 2);
  static constexpr size_t W2T = al(W13 + (size_t)65 * 512 * 1024 * 2);
  static constexpr size_t UNI = al(W2T + (size_t)65 * 1024 * 256 * 2);
  static constexpr size_t XBC = UNI;
  static constexpr size_t DTB = al(XBC + (size_t)NT_ * 1024 * 4);
  static constexpr size_t RR = al(DTB + (size_t)NT_ * 16 * 4);
  static constexpr size_t VV = RR + (size_t)NT_ * 256 * 4;
  static constexpr size_t KK = VV + (size_t)NT_ * 256 * 4;
  static constexpr size_t WD = KK + (size_t)NT_ * 256 * 4;
  static constexpr size_t KD = WD + (size_t)2 * NT_ * 256 * 4;
  static constexpr size_t BD = KD + (size_t)2 * NT_ * 256 * 4;
  static constexpr size_t GATE = BD + (size_t)2 * NT_ * 256 * 4;
  static constexpr size_t LA = GATE + (size_t)NT_ * 256 * 4;
  static constexpr size_t YS = LA + (size_t)2 * NT_ * 128 * 4;
  static constexpr size_t YR = YS + (size_t)2 * NT_ * 512 * 4;
  static constexpr size_t YG = YR + (size_t)2 * NT_ * 256 * 4;
  static constexpr size_t MIXER_END = YG + (size_t)2 * NT_ * 256 * 4;
  static constexpr size_t HID = UNI;
  static constexpr size_t YBUF = al(HID + ((size_t)NT_ * 9 + 65 * 128) * 256 * 2);
  static constexpr size_t MOE_END = YBUF + (size_t)NT_ * 9 * 1024 * 2;
  static constexpr size_t END = al(MIXER_END > MOE_END ? MIXER_END : MOE_END);
};

struct Params {
  const float* in[40];
  float* out;
  unsigned char* ws;
};
enum { I_X = 0, I_C, I_CTX, I_CCTX, I_ADAW, I_ADAB, I_WIN, I_CONVW, I_CONVB, I_DTBIAS, I_ALOG, I_SSDD, I_SSDNW, I_MU, I_W0, I_W2, I_A0, I_A2,
       I_G2, I_KKW, I_KAW, I_RK, I_LNXW, I_LNXB, I_GU, I_GB, I_GNW, I_WOUT, I_LN1W, I_LN1B, I_LN2W, I_LN2B, I_RW, I_RB, I_EW1, I_EW3, I_EW2,
       I_SW1, I_SW3, I_SW2 };

#define SM_PRE (GEMM_SMEM)
#define SM_TAB (GEMM_SMEM + 1024)
#define SM_BAR (GEMM_SMEM + 2032)
#ifdef HIPEMU
#define INP(i) (p.in[i])
#define LAUNDER(x)
#define TIDX ((int)threadIdx.x)
#define BIDX ((int)blockIdx.x)
#else
extern __shared__ __align__(16) unsigned char smem_dyn[];
DEVFN const float* inp_lds(int i) {
  const volatile unsigned* t = (const volatile unsigned*)(smem_dyn + SM_TAB) + 2 * i;
  unsigned lo = __builtin_amdgcn_readfirstlane(t[0]), hi = __builtin_amdgcn_readfirstlane(t[1]);
  return (const float*)(((unsigned long long)hi << 32) | lo);
}
#define INP(i) inp_lds(i)
#define LAUNDER(x) asm volatile("" : "+s"(x))
DEVFN int tidx_() { int t = threadIdx.x; asm volatile("" : "+v"(t)); return t; }
DEVFN int bidx_() { int b = blockIdx.x; asm volatile("" : "+s"(b)); return b; }
#define TIDX tidx_()
#define BIDX bidx_()
#endif
#ifndef HIPEMU
#define XB_TMO      128
#define XB_XCNT(j)  (256  + 64 * (j))
#define XB_XSUB(j)  (1280 + 64 * (j))
#define XB_XGEN(j)  (2304 + 64 * (j))
#define XB_TOP      3328
#define XB_TOPGEN   3392
#define XCD_BAR_WORDS 3456
#define XB_SPIN_CAP (1u << 22)
#define LAS __attribute__((address_space(3)))
__device__ __forceinline__ unsigned xb_ld(unsigned* p)              { return __hip_atomic_load(p, __ATOMIC_RELAXED, __HIP_MEMORY_SCOPE_AGENT); }
__device__ __forceinline__ unsigned xb_add(unsigned* p, unsigned v) { return __hip_atomic_fetch_add(p, v, __ATOMIC_RELAXED, __HIP_MEMORY_SCOPE_AGENT); }
__device__ __forceinline__ unsigned xb_xcc_id() { return (unsigned)__builtin_amdgcn_s_getreg((3 << 11) | 20) & 0xFu; }
#define XB_SPIN(cond, bar) do { unsigned _sp = 0; while (cond) { __builtin_amdgcn_s_sleep(1); \
    if ((++_sp & 255u) == 0u) { if (xb_ld(&(bar)[XB_TMO])) break; if (_sp > XB_SPIN_CAP) { atomicAdd(&(bar)[XB_TMO], 1u); break; } } } } while (0)
struct XcdBarrier { unsigned* bar; unsigned x; volatile LAS unsigned* st; };
__device__ __forceinline__ XcdBarrier xcd_barrier_post(unsigned* bar, volatile LAS unsigned* st) {
    XcdBarrier b; b.bar = bar; b.x = xb_xcc_id(); b.st = st;
    if (threadIdx.x == 0) (void)xb_add(&bar[XB_XCNT(b.x)], 1u);
    return b;
}
__device__ __forceinline__ void xcd_barrier_complete(unsigned* bar, unsigned x, unsigned& nloc, unsigned& nx) {
    const unsigned G = gridDim.x * gridDim.y * gridDim.z;
    unsigned sum, cnt, mine, sp = 0u;
    for (;;) {
        sum = 0u; cnt = 0u; mine = 0u;
#pragma unroll
        for (unsigned j = 0; j < 16; ++j) { const unsigned c = xb_ld(&bar[XB_XCNT(j)]); sum += c; cnt += (c > 0u) ? 1u : 0u; mine = (j == x) ? c : mine; }
        if (sum == G) break;
        __builtin_amdgcn_s_sleep(1);
        if ((++sp & 255u) == 0u) { if (xb_ld(&bar[XB_TMO])) break; if (sp > XB_SPIN_CAP) { atomicAdd(&bar[XB_TMO], 1u); break; } }
    }
    nloc = mine > 0u ? mine : 1u; nx = cnt > 0u ? cnt : 1u;
}
__device__ __forceinline__ void xcd_barrier(const XcdBarrier& b) {
    asm volatile("s_waitcnt vmcnt(0)" ::: "memory");
    __syncthreads();
    if (threadIdx.x == 0) {
        unsigned* bar = b.bar;
        __builtin_amdgcn_s_waitcnt(0);
        unsigned nloc = b.st[0], nx = b.st[1];
        if (nloc == 0u) { xcd_barrier_complete(bar, b.x, nloc, nx); b.st[0] = nloc; b.st[1] = nx; }
        const unsigned old = xb_add(&bar[XB_XSUB(b.x)], 1u);
        const unsigned gen = old / nloc;
        if (old + 1u == (gen + 1u) * nloc) {
            __builtin_amdgcn_fence(__ATOMIC_RELEASE, "agent");
            asm volatile("s_waitcnt vmcnt(0)" ::: "memory");
            const unsigned og = xb_add(&bar[XB_TOP], 1u);
            const unsigned tg = og / nx;
            if (og + 1u == (tg + 1u) * nx) xb_add(&bar[XB_TOPGEN], 1u);
            else XB_SPIN(xb_ld(&bar[XB_TOPGEN]) == tg, bar);
            __builtin_amdgcn_fence(__ATOMIC_ACQUIRE, "agent");
            xb_add(&bar[XB_XGEN(b.x)], 1u);
            asm volatile("s_waitcnt vmcnt(0)" ::: "memory");
        } else {
            XB_SPIN(xb_ld(&bar[XB_XGEN(b.x)]) == gen, bar);
            __builtin_amdgcn_fence(__ATOMIC_ACQUIRE, "agent");
            asm volatile("s_waitcnt vmcnt(0)" ::: "memory");
        }
    }
    __syncthreads();
}
#endif

DEVFN int tokmap(int dir, int p) { return dir == 0 ? p : (p < CTX_ ? CTX_ - 1 - p : 2 * CTX_ + SEQ_ - 1 - p); }
DEVFN const float* tok_input_row(const Params& p, int tok) {
  int b = tok / T_, t = tok % T_;
  return t < CTX_ ? INP(I_CTX) + ((size_t)b * CTX_ + t) * D_ : INP(I_X) + ((size_t)b * SEQ_ + (t - CTX_)) * D_;
}
DEVFN int tok_modrow(int tok) { return (tok % T_) < CTX_ ? B_ : tok / T_; }

template <class ARow, class BRow, class Epi>
DEVFN void gemm_tile(unsigned char* smem, int K, ARow arow, BRow brow, Epi epi) {
  bf16_t* As = (bf16_t*)smem;
  bf16_t* Bs = As + 128 * LDT;
  const int tid = TIDX, lane = tid & 63, wave = tid >> 6, wr = wave >> 1, wc = wave & 1;
  const int g = lane >> 4, l15 = lane & 15;
  const int lr = tid >> 3, lc = (tid & 7) * 8;
  const bf16_t* ap[4];
  const bf16_t* bp[4];
#pragma unroll
  for (int i = 0; i < 4; ++i) { ap[i] = arow(lr + 32 * i); bp[i] = brow(lr + 32 * i); }
  f32x4 acc[4][4];
#pragma unroll
  for (int mi = 0; mi < 4; ++mi)
#pragma unroll
    for (int ni = 0; ni < 4; ++ni) acc[mi][ni] = f32x4{0.f, 0.f, 0.f, 0.f};
  u32x4 ra[4], rb[4];
#pragma unroll
  for (int i = 0; i < 4; ++i) { ra[i] = *(const u32x4*)(ap[i] + lc); rb[i] = *(const u32x4*)(bp[i] + lc); }
  for (int k0 = 0; k0 < K; k0 += 64) {
    __syncthreads();
#pragma unroll
    for (int i = 0; i < 4; ++i) { *(u32x4*)(As + (lr + 32 * i) * LDT + lc) = ra[i]; *(u32x4*)(Bs + (lr + 32 * i) * LDT + lc) = rb[i]; }
    __syncthreads();
    if (k0 + 64 < K) {
#pragma unroll
      for (int i = 0; i < 4; ++i) { ra[i] = *(const u32x4*)(ap[i] + k0 + 64 + lc); rb[i] = *(const u32x4*)(bp[i] + k0 + 64 + lc); }
    }
#pragma unroll
    for (int kk = 0; kk < 2; ++kk) {
      bf16x8 af[4], bfr[4];
#pragma unroll
      for (int mi = 0; mi < 4; ++mi) af[mi] = *(const bf16x8*)(As + (wr * 64 + mi * 16 + l15) * LDT + kk * 32 + g * 8);
#pragma unroll
      for (int ni = 0; ni < 4; ++ni) bfr[ni] = *(const bf16x8*)(Bs + (wc * 64 + ni * 16 + l15) * LDT + kk * 32 + g * 8);
#pragma unroll
      for (int mi = 0; mi < 4; ++mi)
#pragma unroll
        for (int ni = 0; ni < 4; ++ni) acc[mi][ni] = MFMA16(af[mi], bfr[ni], acc[mi][ni]);
    }
  }
  epi(acc, wr, wc, g, l15);
}

DEVFN void cvt_tile(unsigned char* smem, const float* src, int K, int N, int k0, int n0, bf16_t* dst, int ldd, int mode) {
  float* s = (float*)smem;
  const int tid = TIDX;
  __syncthreads();
  for (int e = tid; e < 64 * 64; e += 256) { int kk = e >> 6, nn = e & 63; s[kk * 65 + nn] = (n0 + nn < N) ? src[(size_t)(k0 + kk) * N + n0 + nn] : 0.f; }
  __syncthreads();
  for (int e = tid; e < 64 * 64; e += 256) { int nn = e >> 6, kk = e & 63; int n = n0 + nn;
    if (n < N) { int row = mode == 0 ? n : ((n >> 4) * 32 + (n & 15) + (mode == 2 ? 16 : 0)); dst[(size_t)row * ldd + k0 + kk] = f2bf(s[kk * 65 + nn]); } }
}
DEVFN void convert_moe_weights(const Params& p, int l, unsigned char* smem) {
  bf16_t* w13 = (bf16_t*)(p.ws + Ws::W13);
  bf16_t* w2t = (bf16_t*)(p.ws + Ws::W2T);
  const int per_e = 192;
  for (int u = BIDX; u < 65 * per_e; u += gridDim.x) {
    int e = u / per_e, r = u % per_e, which = r / 64, t = r % 64;
    if (which < 2) {
      const float* src = e < 64 ? (which == 0 ? INP(I_EW1) : INP(I_EW3)) + ((size_t)l * 64 + e) * 1024 * 256 : (which == 0 ? INP(I_SW1) : INP(I_SW3)) + (size_t)l * 1024 * 256;
      cvt_tile(smem, src, 1024, 256, (t >> 2) * 64, (t & 3) * 64, w13 + (size_t)e * 512 * 1024, 1024, which == 0 ? 1 : 2);
    } else {
      const float* src = e < 64 ? INP(I_EW2) + ((size_t)l * 64 + e) * 256 * 1024 : INP(I_SW2) + (size_t)l * 256 * 1024;
      cvt_tile(smem, src, 256, 1024, (t >> 4) * 64, (t & 15) * 64, w2t + (size_t)e * 1024 * 256, 256, 0);
    }
  }
}
DEVFN void phase0(const Params& p, unsigned char* smem) {
  const int tid = TIDX;
  float* modp = (float*)(p.ws + Ws::MODP);
  for (int u = BIDX; u < DEPTH_ * 24 * 16; u += gridDim.x) {
    int l = u / (24 * 16), jb = (u / 16) % 24, ks = u % 16;
    float* sc = (float*)smem;
    __syncthreads();
    for (int e = tid; e < NR_ * 64; e += 256) { int r = e / 64, i = ks * 64 + (e % 64); float cv = r < B_ ? INP(I_C)[(size_t)r * D_ + i] : INP(I_CCTX)[i]; sc[e] = siluf_(cv); }
    __syncthreads();
    int j = jb * 256 + tid;
    float acc[NR_];
#pragma unroll
    for (int r = 0; r < NR_; ++r) acc[r] = 0.f;
    const float* w = INP(I_ADAW) + ((size_t)l * D_ + ks * 64) * NMOD_ + j;
#pragma unroll 4
    for (int i = 0; i < 64; ++i) { float wv = w[(size_t)i * NMOD_];
#pragma unroll
      for (int r = 0; r < NR_; ++r) acc[r] += sc[r * 64 + i] * wv; }
#pragma unroll
    for (int r = 0; r < NR_; ++r) modp[(((size_t)ks * DEPTH_ + l) * NR_ + r) * NMOD_ + j] = acc[r];
  }
  bf16_t* win = (bf16_t*)(p.ws + Ws::WIN);
  bf16_t* wout = (bf16_t*)(p.ws + Ws::WOUT);
  for (int u = BIDX; u < DEPTH_ * 16 * 55; u += gridDim.x) {
    int l = u / (16 * 55), r = u % (16 * 55);
    cvt_tile(smem, INP(I_WIN) + (size_t)l * 1024 * NIN_, 1024, NIN_, (r / 55) * 64, (r % 55) * 64, win + (size_t)l * NIN_ * 1024, 1024, 0);
  }
  for (int u = BIDX; u < DEPTH_ * 256; u += gridDim.x) {
    int l = u / 256, r = u % 256;
    cvt_tile(smem, INP(I_WOUT) + (size_t)l * 1024 * 1024, 1024, 1024, (r / 16) * 64, (r % 16) * 64, wout + (size_t)l * 1024 * 1024, 1024, 0);
  }
  float* rwt = (float*)(p.ws + Ws::RWT);
  for (int u = BIDX * 256 + tid; u < DEPTH_ * 64 * 1024; u += gridDim.x * 256) {
    int l = u / (64 * 1024), e = (u / 1024) % 64, i = u % 1024;
    rwt[u] = INP(I_RW)[((size_t)l * 1024 + i) * 64 + e];
  }
}

DEVFN void phase0b(const Params& p) {
  float* mod = (float*)(p.ws + Ws::MOD); const float* modp = (const float*)(p.ws + Ws::MODP);
  for (int u = BIDX * 256 + TIDX; u < DEPTH_ * NR_ * NMOD_; u += gridDim.x * 256) {
    int l = u / (NR_ * NMOD_), j = u % NMOD_;
    float s = INP(I_ADAB)[(size_t)l * NMOD_ + j];
    for (int ks = 0; ks < 16; ++ks) s += modp[(size_t)ks * DEPTH_ * NR_ * NMOD_ + u];
    mod[u] = s;
  }
}

DEVFN void row_stats(const float (&v)[16], float& mean, float& rstd) {
  float s = 0.f;
#pragma unroll
  for (int i = 0; i < 16; ++i) s += v[i];
  mean = wave_sum(s) * (1.f / 1024.f);
  float q = 0.f;
#pragma unroll
  for (int i = 0; i < 16; ++i) { float d = v[i] - mean; q += d * d; }
  rstd = rsqrtf(wave_sum(q) * (1.f / 1024.f) + 1e-5f);
}
DEVFN void load_row16(const float* row, int lane, float (&v)[16]) {
#pragma unroll
  for (int j = 0; j < 4; ++j) { float4 t = *(const float4*)(row + lane * 4 + 256 * j); v[4 * j] = t.x; v[4 * j + 1] = t.y; v[4 * j + 2] = t.z; v[4 * j + 3] = t.w; }
}
DEVFN void moe_residual_row(const Params& p, int lp, int tok, int lane, float (&xv)[16]) {
  const float* mod = (const float*)(p.ws + Ws::MOD) + ((size_t)lp * NR_ + tok_modrow(tok)) * NMOD_;
  const bf16_t* yb = (const bf16_t*)(p.ws + Ws::YBUF) + (size_t)tok * NSLOT * 1024;
  float f[16];
#pragma unroll
  for (int i = 0; i < 16; ++i) f[i] = 0.f;
  for (int s = 0; s < NSLOT; ++s) {
#pragma unroll
    for (int j = 0; j < 4; ++j) { uint2 t = *(const uint2*)(yb + (size_t)s * 1024 + lane * 4 + 256 * j);
      f[4 * j] += bf2f((bf16_t)(t.x & 0xFFFF)); f[4 * j + 1] += bf2f((bf16_t)(t.x >> 16)); f[4 * j + 2] += bf2f((bf16_t)(t.y & 0xFFFF)); f[4 * j + 3] += bf2f((bf16_t)(t.y >> 16)); }
  }
  float g2[16], w[16], b[16];
  load_row16(mod + 5 * 1024, lane, g2);
  load_row16(INP(I_LN2W) + (size_t)lp * 1024, lane, w);
  load_row16(INP(I_LN2B) + (size_t)lp * 1024, lane, b);
#pragma unroll
  for (int i = 0; i < 16; ++i) xv[i] = ALPHA_ * xv[i] + g2[i] * f[i];
  float mean, rstd;
  row_stats(xv, mean, rstd);
#pragma unroll
  for (int i = 0; i < 16; ++i) xv[i] = (xv[i] - mean) * rstd * w[i] + b[i];
}
DEVFN void phase1(const Params& p, int l) {
  const int lane = TIDX & 63, wave = TIDX >> 6;
  float* X = (float*)(p.ws + Ws::X);
  bf16_t* U = (bf16_t*)(p.ws + Ws::U);
  for (int tok = BIDX * 4 + wave; tok < NT_; tok += gridDim.x * 4) {
    float xv[16];
    if (l == 0) load_row16(tok_input_row(p, tok), lane, xv);
    else { load_row16(X + (size_t)tok * 1024, lane, xv); moe_residual_row(p, l - 1, tok, lane, xv); }
#pragma unroll
    for (int j = 0; j < 4; ++j) *(float4*)(X + (size_t)tok * 1024 + lane * 4 + 256 * j) = make_float4(xv[4 * j], xv[4 * j + 1], xv[4 * j + 2], xv[4 * j + 3]);
    const float* mod = (const float*)(p.ws + Ws::MOD) + ((size_t)l * NR_ + tok_modrow(tok)) * NMOD_;
    float sh[16], sc[16], mean, rstd;
    load_row16(mod, lane, sh);
    load_row16(mod + 1024, lane, sc);
    row_stats(xv, mean, rstd);
#pragma unroll
    for (int j = 0; j < 4; ++j) {
      float u0 = (xv[4 * j] - mean) * rstd * (1.f + sc[4 * j]) + sh[4 * j], u1 = (xv[4 * j + 1] - mean) * rstd * (1.f + sc[4 * j + 1]) + sh[4 * j + 1];
      float u2 = (xv[4 * j + 2] - mean) * rstd * (1.f + sc[4 * j + 2]) + sh[4 * j + 2], u3 = (xv[4 * j + 3] - mean) * rstd * (1.f + sc[4 * j + 3]) + sh[4 * j + 3];
      *(uint2*)(U + (size_t)tok * 1024 + lane * 4 + 256 * j) = make_uint2((unsigned)f2bf(u0) | ((unsigned)f2bf(u1) << 16), (unsigned)f2bf(u2) | ((unsigned)f2bf(u3) << 16));
    }
  }
}
DEVFN void phase_final(const Params& p) {
  const int lane = TIDX & 63, wave = TIDX >> 6;
  const float* X = (const float*)(p.ws + Ws::X);
  for (int r = BIDX * 4 + wave; r < B_ * SEQ_; r += gridDim.x * 4) {
    int b = r / SEQ_, s = r % SEQ_, tok = b * T_ + CTX_ + s;
    float xv[16];
    load_row16(X + (size_t)tok * 1024, lane, xv);
    moe_residual_row(p, DEPTH_ - 1, tok, lane, xv);
#pragma unroll
    for (int j = 0; j < 4; ++j) *(float4*)(p.out + (size_t)r * 1024 + lane * 4 + 256 * j) = make_float4(xv[4 * j], xv[4 * j + 1], xv[4 * j + 2], xv[4 * j + 3]);
  }
}

DEVFN void phase2(const Params& p, int l, unsigned char* smem) {
  const bf16_t* U = (const bf16_t*)(p.ws + Ws::U);
  const bf16_t* W = (const bf16_t*)(p.ws + Ws::WIN) + (size_t)l * NIN_ * 1024;
  bf16_t* ZX = (bf16_t*)(p.ws + Ws::ZX);
  const int nct = (NIN_ + 127) / 128;
  for (int u = BIDX; u < (NT_ / 128) * nct; u += gridDim.x) {
    int rt = u / nct, ct = u % nct;
    gemm_tile(smem, 1024,
      [&](int r) { return U + (size_t)(rt * 128 + r) * 1024; },
      [&](int r) { int n = ct * 128 + r; return n < NIN_ ? W + (size_t)n * 1024 : (const bf16_t*)(p.ws + Ws::ZROW); },
      [&](f32x4 (&acc)[4][4], int wr, int wc, int g, int l15) {
#pragma unroll
        for (int mi = 0; mi < 4; ++mi)
#pragma unroll
          for (int ni = 0; ni < 4; ++ni) { int col = ct * 128 + wc * 64 + ni * 16 + l15;
            if (col < NIN_) {
#pragma unroll
              for (int i = 0; i < 4; ++i) { int row = rt * 128 + wr * 64 + mi * 16 + 4 * g + i; ZX[(size_t)row * NIN_ + col] = f2bf(acc[mi][ni][i]); } } }
      });
  }
}

DEVFN float zxv(const bf16_t* ZX, int tok, int col) { return bf2f(ZX[(size_t)tok * NIN_ + col]); }
struct Nbr { int n; int tok[4]; };
DEVFN Nbr shift_nbrs(int tok) {
  Nbr nb; int b = tok / T_, t = tok % T_;
  if (t < CTX_) { nb.n = 2; nb.tok[0] = t > 0 ? tok - 1 : -1; nb.tok[1] = t < CTX_ - 1 ? tok + 1 : -1; nb.tok[2] = -1; nb.tok[3] = -1; }
  else { int s = t - CTX_, row = s / 64, col = s % 64; nb.n = 4; nb.tok[0] = col > 0 ? tok - 1 : -1; nb.tok[1] = col < 63 ? tok + 1 : -1;
    nb.tok[2] = row > 0 ? tok - 64 : -1; nb.tok[3] = row < SEQ_ / 64 - 1 ? tok + 64 : -1; }
  (void)b; return nb;
}
DEVFN float shiftmix(const bf16_t* ZX, const float* mu, int tok, const Nbr& nb, int ch) {
  float z = zxv(ZX, tok, ORW + ch), o = z;
#pragma unroll
  for (int j = 0; j < 4; ++j) if (j < nb.n) { float v = nb.tok[j] >= 0 ? zxv(ZX, nb.tok[j], ORW + ch) : 0.f; o += mu[j * 1152 + ch] * (v - z); }
  return o;
}
#define P3_TT 4
DEVFN void phase3(const Params& p, int l, unsigned char* smem) {
  const int tid = TIDX;
  const bf16_t* ZX = (const bf16_t*)(p.ws + Ws::ZX);
  float* XBC = (float*)(p.ws + Ws::XBC); float* DTB = (float*)(p.ws + Ws::DTB);
  float* RR = (float*)(p.ws + Ws::RR); float* VV = (float*)(p.ws + Ws::VV); float* KKb = (float*)(p.ws + Ws::KK);
  float* WD = (float*)(p.ws + Ws::WD); float* KD = (float*)(p.ws + Ws::KD); float* BD = (float*)(p.ws + Ws::BD);
  float* GATE = (float*)(p.ws + Ws::GATE); float* LA = (float*)(p.ws + Ws::LA);
  const float* convw = INP(I_CONVW) + (size_t)l * 3 * 1024; const float* convb = INP(I_CONVB) + (size_t)l * 1024;
  const float* mu = INP(I_MU) + (size_t)l * 4 * 1152;
  float* li = (float*)smem;
  const float kkw = INP(I_KKW)[(size_t)l * 256 + tid], kaw = INP(I_KAW)[(size_t)l * 256 + tid];
  for (int tile = BIDX; tile < NT_ / P3_TT; tile += gridDim.x) {
    float* kls = li + P3_TT * 416;
    float* knls = kls + P3_TT * 256;
    __syncthreads();
#pragma unroll 1
    for (int tt = 0; tt < P3_TT; ++tt) {
      const int tok = tile * P3_TT + tt, t = tok % T_;
      const bool hasp = (t != 0 && t != CTX_), hasn = (t != CTX_ - 1 && t != T_ - 1);
#pragma unroll
      for (int j = 0; j < 4; ++j) { int c = tid + 256 * j;
        float a = convb[c] + convw[1024 + c] * zxv(ZX, tok, OXBC + c);
        if (hasp) a += convw[c] * zxv(ZX, tok - 1, OXBC + c);
        if (hasn) a += convw[2048 + c] * zxv(ZX, tok + 1, OXBC + c);
        XBC[(size_t)tok * 1024 + c] = siluf_(a); }
      if (tid < 16) DTB[(size_t)tok * 16 + tid] = softplusf_(zxv(ZX, tok, ODT + tid) + INP(I_DTBIAS)[(size_t)l * 16 + tid]);
      const Nbr nb = shift_nbrs(tok);
      float r = shiftmix(ZX, mu, tok, nb, tid), k = shiftmix(ZX, mu, tok, nb, 256 + tid), v = shiftmix(ZX, mu, tok, nb, 512 + tid);
      RR[(size_t)tok * 256 + tid] = r; VV[(size_t)tok * 256 + tid] = v;
      float kq = k * kkw, nrm = sqrtf(wave_sum(kq * kq));
      const float kn = kq / fmaxf(nrm, 1e-12f);
      kls[tt * 256 + tid] = k; knls[tt * 256 + tid] = kn;
      KKb[(size_t)tok * 256 + tid] = kn;
      { float x = shiftmix(ZX, mu, tok, nb, 768 + tid); li[tt * 416 + tid] = tid < 128 ? tanhf(x) : x; }
      if (tid < 128) li[tt * 416 + 256 + tid] = sigmoidf_(shiftmix(ZX, mu, tok, nb, 1024 + tid));
      if (tid >= 128 && tid < 160) li[tt * 416 + 384 + (tid - 128)] = zxv(ZX, tok, OGD + (tid - 128));
    }
    __syncthreads();
    float xf[P3_TT], xb[P3_TT], af[P3_TT], ab[P3_TT], gt[P3_TT];
    { const float w0f = INP(I_W0)[(size_t)l * 512 + tid], w0b = INP(I_W0)[(size_t)l * 512 + 256 + tid];
      const float a0f = INP(I_A0)[(size_t)l * 512 + tid], a0b = INP(I_A0)[(size_t)l * 512 + 256 + tid];
#pragma unroll
      for (int tt = 0; tt < P3_TT; ++tt) { xf[tt] = w0f; xb[tt] = w0b; af[tt] = a0f; ab[tt] = a0b; gt[tt] = 0.f; } }
    const float* w2 = INP(I_W2) + (size_t)l * 2 * 64 * 256; const float* a2 = INP(I_A2) + (size_t)l * 2 * 64 * 256; const float* g2 = INP(I_G2) + (size_t)l * 128 * 256;
#pragma unroll 2
    for (int i = 0; i < 64; ++i) {
      float wf = w2[i * 256 + tid], wb = w2[(64 + i) * 256 + tid], af2 = a2[i * 256 + tid], ab2 = a2[(64 + i) * 256 + tid];
#pragma unroll
      for (int tt = 0; tt < P3_TT; ++tt) { xf[tt] += li[tt * 416 + i] * wf; xb[tt] += li[tt * 416 + 64 + i] * wb; af[tt] += li[tt * 416 + 128 + i] * af2; ab[tt] += li[tt * 416 + 192 + i] * ab2; }
    }
#pragma unroll 2
    for (int i = 0; i < 128; ++i) { float gw = g2[i * 256 + tid];
#pragma unroll
      for (int tt = 0; tt < P3_TT; ++tt) gt[tt] += li[tt * 416 + 256 + i] * gw; }
#pragma unroll
    for (int tt = 0; tt < P3_TT; ++tt) {
      const size_t o = (size_t)(tile * P3_TT + tt) * 256 + tid, o1 = (size_t)NT_ * 256 + o;
      float wf = expf(-0.6065306597126334f * sigmoidf_(xf[tt])), wb = expf(-0.6065306597126334f * sigmoidf_(xb[tt]));
      float aF = sigmoidf_(af[tt]), aB = sigmoidf_(ab[tt]);
      WD[o] = wf; WD[o1] = wb;
      const float kr_ = kls[tt * 256 + tid], kn_ = knls[tt * 256 + tid];
      KD[o] = kr_ * (1.f + (aF - 1.f) * kaw); KD[o1] = kr_ * (1.f + (aB - 1.f) * kaw);
      BD[o] = kn_ * aF; BD[o1] = kn_ * aB;
      GATE[o] = gt[tt];
    }
    { const int d = tid >> 7, c = tid & 127; const float* gu = INP(I_GU) + ((size_t)l * 2 + d) * 16 * 128; const float gb = INP(I_GB)[((size_t)l * 2 + d) * 128 + c];
      float guw[16];
#pragma unroll
      for (int i = 0; i < 16; ++i) guw[i] = gu[i * 128 + c];
#pragma unroll
      for (int tt = 0; tt < P3_TT; ++tt) { float s = gb;
#pragma unroll
        for (int i = 0; i < 16; ++i) s += li[tt * 416 + 384 + d * 16 + i] * guw[i];
        LA[((size_t)d * NT_ + tile * P3_TT + tt) * 128 + c] = logsigmoidf_(s) * (1.f / 16.f); } }
  }
}

DEVFN void scan_rwkv(const Params& p, int unit) {
  const int tid = TIDX, lane = tid & 63, wave = tid >> 6;
  const int rowblk = unit & 3, h = (unit >> 2) & 3, dir = (unit >> 4) & 1, b = unit >> 5;
  const int row = rowblk * 16 + wave * 4 + (lane >> 4), kq = lane & 15;
  const float* RR = (const float*)(p.ws + Ws::RR); const float* VV = (const float*)(p.ws + Ws::VV); const float* KKb = (const float*)(p.ws + Ws::KK);
  const float* WD = (const float*)(p.ws + Ws::WD) + (size_t)dir * NT_ * 256; const float* KD = (const float*)(p.ws + Ws::KD) + (size_t)dir * NT_ * 256;
  const float* BD = (const float*)(p.ws + Ws::BD) + (size_t)dir * NT_ * 256;
  float* YR = (float*)(p.ws + Ws::YR) + (size_t)dir * NT_ * 256;
  float s0 = 0.f, s1 = 0.f, s2 = 0.f, s3 = 0.f;
  for (int pos = 0; pos < T_; ++pos) {
    const int tok = b * T_ + tokmap(dir, pos);
    const size_t o = (size_t)tok * 256 + h * 64 + kq * 4;
    const float4 kk = *(const float4*)(KKb + o), w = *(const float4*)(WD + o), bd = *(const float4*)(BD + o), kd = *(const float4*)(KD + o), r = *(const float4*)(RR + o);
    const float v = VV[(size_t)tok * 256 + h * 64 + row];
    float d1 = s0 * kk.x + s1 * kk.y + s2 * kk.z + s3 * kk.w;
    float d2 = s0 * w.x * r.x + s1 * w.y * r.y + s2 * w.z * r.z + s3 * w.w * r.w;
    float br = bd.x * r.x + bd.y * r.y + bd.z * r.z + bd.w * r.w;
    float kr = kd.x * r.x + kd.y * r.y + kd.z * r.z + kd.w * r.w;
#pragma unroll
    for (int m = 8; m >= 1; m >>= 1) { d1 += __shfl_xor(d1, m); d2 += __shfl_xor(d2, m); br += __shfl_xor(br, m); kr += __shfl_xor(kr, m); }
    s0 = s0 * w.x - d1 * bd.x + v * kd.x; s1 = s1 * w.y - d1 * bd.y + v * kd.y; s2 = s2 * w.z - d1 * bd.z + v * kd.z; s3 = s3 * w.w - d1 * bd.w + v * kd.w;
    if (kq == 0) YR[(size_t)tok * 256 + h * 64 + row] = d2 - d1 * br + v * kr;
  }
}
DEVFN void scan_ssd(const Params& p, int l, int unit) {
  const int tid = TIDX, lane = tid & 63, wave = tid >> 6;
  const int rowblk = unit & 3, h = (unit >> 2) & 7, dir = (unit >> 5) & 1, b = unit >> 6;
  const int row = rowblk * 16 + wave * 4 + (lane >> 4), dq = lane & 15, grp = h >> 2;
  const float* XBC = (const float*)(p.ws + Ws::XBC); const float* DTB = (const float*)(p.ws + Ws::DTB);
  float* YS = (float*)(p.ws + Ws::YS) + (size_t)dir * NT_ * 512;
  const float nega = -expf(INP(I_ALOG)[(size_t)l * 16 + dir * 8 + h]);
  float s[8];
#pragma unroll
  for (int i = 0; i < 8; ++i) s[i] = 0.f;
  for (int pos = 0; pos < T_; ++pos) {
    const int tok = b * T_ + tokmap(dir, pos);
    const float dt = DTB[(size_t)tok * 16 + dir * 8 + h], dA = expf(dt * nega);
    const float xdt = XBC[(size_t)tok * 1024 + h * 64 + row] * dt;
    const float* bp = XBC + (size_t)tok * 1024 + 512 + grp * 128 + dq * 8; const float* cp = bp + 256;
    const float4 b0 = *(const float4*)bp, b1 = *(const float4*)(bp + 4), c0 = *(const float4*)cp, c1 = *(const float4*)(cp + 4);
    s[0] = s[0] * dA + xdt * b0.x; s[1] = s[1] * dA + xdt * b0.y; s[2] = s[2] * dA + xdt * b0.z; s[3] = s[3] * dA + xdt * b0.w;
    s[4] = s[4] * dA + xdt * b1.x; s[5] = s[5] * dA + xdt * b1.y; s[6] = s[6] * dA + xdt * b1.z; s[7] = s[7] * dA + xdt * b1.w;
    float y = s[0] * c0.x + s[1] * c0.y + s[2] * c0.z + s[3] * c0.w + s[4] * c1.x + s[5] * c1.y + s[6] * c1.z + s[7] * c1.w;
#pragma unroll
    for (int m = 8; m >= 1; m >>= 1) y += __shfl_xor(y, m);
    if (dq == 0) YS[(size_t)tok * 512 + h * 64 + row] = y;
  }
}
DEVFN void scan_gla(const Params& p, int unit) {
  const int tid = TIDX, lane = tid & 63, wave = tid >> 6;
  const int colblk = unit & 1, h = (unit >> 1) & 3, dir = (unit >> 3) & 1, b = unit >> 4;
  const int col = colblk * 32 + wave * 8 + (lane >> 3), kq = lane & 7;
  const bf16_t* ZX = (const bf16_t*)(p.ws + Ws::ZX);
  const float* LA = (const float*)(p.ws + Ws::LA) + (size_t)dir * NT_ * 128;
  float* YG = (float*)(p.ws + Ws::YG) + (size_t)dir * NT_ * 256;
  float s[4] = {0.f, 0.f, 0.f, 0.f};
  const float qs = 0.17677669529663687f;
  for (int pos = 0; pos < T_; ++pos) {
    const int tok = b * T_ + tokmap(dir, pos);
    const float4 la = *(const float4*)(LA + (size_t)tok * 128 + h * 32 + kq * 4);
    const float v = zxv(ZX, tok, OGV + h * 64 + col);
    float o = 0.f;
#pragma unroll
    for (int i = 0; i < 4; ++i) { float al = expf(i == 0 ? la.x : i == 1 ? la.y : i == 2 ? la.z : la.w);
      float k = zxv(ZX, tok, OGK + h * 32 + kq * 4 + i), q = zxv(ZX, tok, OGQ + h * 32 + kq * 4 + i) * qs;
      s[i] = s[i] * al + k * v; o += q * s[i]; }
#pragma unroll
    for (int m = 4; m >= 1; m >>= 1) o += __shfl_xor(o, m);
    if (kq == 0) YG[(size_t)tok * 256 + h * 64 + col] = o;
  }
}
DEVFN void phase4(const Params& p, int l) {
  const int n_r = B_ * 32, n_s = B_ * 64, n_g = B_ * 16;
  for (int u = BIDX; u < n_r + n_s + n_g; u += gridDim.x) {
    if (u < n_s) scan_ssd(p, l, u);
    else if (u < n_s + n_r) scan_rwkv(p, u - n_s);
    else scan_gla(p, u - n_s - n_r);
  }
}

DEVFN void phase5(const Params& p, int l, unsigned char* smem) {
  const int tid = TIDX, lane = tid & 63, wave = tid >> 6;
  const bf16_t* ZX = (const bf16_t*)(p.ws + Ws::ZX);
  const float* XBC = (const float*)(p.ws + Ws::XBC);
  const float* YS = (const float*)(p.ws + Ws::YS); const float* YR = (const float*)(p.ws + Ws::YR); const float* YG = (const float*)(p.ws + Ws::YG);
  const float* RR = (const float*)(p.ws + Ws::RR); const float* VV = (const float*)(p.ws + Ws::VV); const float* KD = (const float*)(p.ws + Ws::KD);
  const float* GATE = (const float*)(p.ws + Ws::GATE);
  bf16_t* YM = (bf16_t*)(p.ws + Ws::YMIX);
  float* red = (float*)smem;
  const float dA = INP(I_SSDD)[(size_t)l * 8 + (tid >> 6)], dB = INP(I_SSDD)[(size_t)l * 8 + 4 + (tid >> 6)];
  const float nwA = INP(I_SSDNW)[(size_t)l * 512 + tid], nwB = INP(I_SSDNW)[(size_t)l * 512 + 256 + tid];
  const float lnw = INP(I_LNXW)[(size_t)l * 256 + tid], lnb = INP(I_LNXB)[(size_t)l * 256 + tid], rk = INP(I_RK)[(size_t)l * 256 + tid];
  const float gnw = INP(I_GNW)[(size_t)l * 256 + tid];
  for (int tok = BIDX; tok < NT_; tok += gridDim.x) {
    float ya = YS[(size_t)tok * 512 + tid] + YS[((size_t)NT_ + tok) * 512 + tid] + dA * XBC[(size_t)tok * 1024 + tid];
    float yb = YS[(size_t)tok * 512 + 256 + tid] + YS[((size_t)NT_ + tok) * 512 + 256 + tid] + dB * XBC[(size_t)tok * 1024 + 256 + tid];
    ya *= siluf_(zxv(ZX, tok, OZ + tid)); yb *= siluf_(zxv(ZX, tok, OZ + 256 + tid));
    float qa = wave_sum(ya * ya), qb = wave_sum(yb * yb);
    __syncthreads();
    if (lane == 0) { red[wave] = qa; red[4 + wave] = qb; }
    __syncthreads();
    float ma = (red[0] + red[1] + red[2] + red[3]) * (1.f / 256.f), mb = (red[4] + red[5] + red[6] + red[7]) * (1.f / 256.f);
    YM[(size_t)tok * 1024 + tid] = f2bf(ya * rsqrtf(ma + 1e-5f) * nwA);
    YM[(size_t)tok * 1024 + 256 + tid] = f2bf(yb * rsqrtf(mb + 1e-5f) * nwB);
    { float y = YR[(size_t)tok * 256 + tid] + YR[((size_t)NT_ + tok) * 256 + tid];
      float mu = wave_sum(y) * (1.f / 64.f), d = y - mu, var = wave_sum(d * d) * (1.f / 64.f);
      float yn = d * rsqrtf(var + 64e-5f) * lnw + lnb;
      float r = RR[(size_t)tok * 256 + tid], kf = KD[(size_t)tok * 256 + tid], kb = KD[((size_t)NT_ + tok) * 256 + tid];
      float bonus = wave_sum(r * (kf + kb) * rk) * VV[(size_t)tok * 256 + tid];
      YM[(size_t)tok * 1024 + 512 + tid] = f2bf((yn + bonus) * GATE[(size_t)tok * 256 + tid]); }
    { float o = YG[(size_t)tok * 256 + tid] + YG[((size_t)NT_ + tok) * 256 + tid];
      float ms = wave_sum(o * o) * (1.f / 64.f);
      YM[(size_t)tok * 1024 + 768 + tid] = f2bf(o * rsqrtf(ms + 1e-5f) * gnw * siluf_(zxv(ZX, tok, OOG + tid))); }
  }
}

DEVFN void phase6(const Params& p, int l, unsigned char* smem) {
  const bf16_t* A = (const bf16_t*)(p.ws + Ws::YMIX);
  const bf16_t* W = (const bf16_t*)(p.ws + Ws::WOUT) + (size_t)l * 1024 * 1024;
  float* MIX = (float*)(p.ws + Ws::MIX);
  for (int u = BIDX; u < (NT_ / 128) * 8; u += gridDim.x) {
    int rt = u / 8, ct = u % 8;
    gemm_tile(smem, 1024,
      [&](int r) { return A + (size_t)(rt * 128 + r) * 1024; },
      [&](int r) { return W + (size_t)(ct * 128 + r) * 1024; },
      [&](f32x4 (&acc)[4][4], int wr, int wc, int g, int l15) {
#pragma unroll
        for (int mi = 0; mi < 4; ++mi)
#pragma unroll
          for (int ni = 0; ni < 4; ++ni)
#pragma unroll
            for (int i = 0; i < 4; ++i) MIX[(size_t)(rt * 128 + wr * 64 + mi * 16 + 4 * g + i) * 1024 + ct * 128 + wc * 64 + ni * 16 + l15] = acc[mi][ni][i];
      });
  }
}

DEVFN void phase7(const Params& p, int l) {
  const int lane = TIDX & 63, wave = TIDX >> 6;
  float* X = (float*)(p.ws + Ws::X);
  const float* MIX = (const float*)(p.ws + Ws::MIX);
  bf16_t* H = (bf16_t*)(p.ws + Ws::U);
  const float* rwt = (const float*)(p.ws + Ws::RWT) + (size_t)l * 64 * 1024;
  int* cnt = (int*)(p.ws + Ws::CNT) + l * 64;
  int* ltok = (int*)(p.ws + Ws::LTOK); float* lwt = (float*)(p.ws + Ws::LWT);
  const float rbias = INP(I_RB)[(size_t)l * 64 + lane];
  for (int tok = BIDX * 4 + wave; tok < NT_; tok += gridDim.x * 4) {
    const float* mod = (const float*)(p.ws + Ws::MOD) + ((size_t)l * NR_ + tok_modrow(tok)) * NMOD_;
    float xv[16], t0[16], t1[16], mean, rstd;
    load_row16(X + (size_t)tok * 1024, lane, xv);
    load_row16(MIX + (size_t)tok * 1024, lane, t0);
    load_row16(mod + 2 * 1024, lane, t1);
#pragma unroll
    for (int i = 0; i < 16; ++i) xv[i] = ALPHA_ * xv[i] + t1[i] * t0[i];
    row_stats(xv, mean, rstd);
    load_row16(INP(I_LN1W) + (size_t)l * 1024, lane, t0);
    load_row16(INP(I_LN1B) + (size_t)l * 1024, lane, t1);
#pragma unroll
    for (int i = 0; i < 16; ++i) xv[i] = (xv[i] - mean) * rstd * t0[i] + t1[i];
#pragma unroll
    for (int j = 0; j < 4; ++j) *(float4*)(X + (size_t)tok * 1024 + lane * 4 + 256 * j) = make_float4(xv[4 * j], xv[4 * j + 1], xv[4 * j + 2], xv[4 * j + 3]);
    const bool is_ctx = (tok % T_) < CTX_;
    if (l == DEPTH_ - 1 && is_ctx) continue;
    row_stats(xv, mean, rstd);
    load_row16(mod + 3 * 1024, lane, t0);
    load_row16(mod + 4 * 1024, lane, t1);
#pragma unroll
    for (int i = 0; i < 16; ++i) xv[i] = (xv[i] - mean) * rstd * (1.f + t1[i]) + t0[i];
#pragma unroll
    for (int j = 0; j < 4; ++j)
      *(uint2*)(H + (size_t)tok * 1024 + lane * 4 + 256 * j) = make_uint2((unsigned)f2bf(xv[4 * j]) | ((unsigned)f2bf(xv[4 * j + 1]) << 16), (unsigned)f2bf(xv[4 * j + 2]) | ((unsigned)f2bf(xv[4 * j + 3]) << 16));
    float logit = 0.f;
    for (int e = 0; e < 64; ++e) {
      float s = 0.f;
#pragma unroll
      for (int j = 0; j < 4; ++j) { float4 w = *(const float4*)(rwt + (size_t)e * 1024 + lane * 4 + 256 * j); s += xv[4 * j] * w.x + xv[4 * j + 1] * w.y + xv[4 * j + 2] * w.z + xv[4 * j + 3] * w.w; }
      s = wave_sum(s);
      if (lane == e) logit = s;
    }
    const float score = sigmoidf_(logit), sel = score + rbias;
    float m1 = sel; int a1 = lane;
#pragma unroll
    for (int m = 1; m <= 4; m <<= 1) { float ov = __shfl_xor(m1, m); int oa = __shfl_xor(a1, m); if (ov > m1 || (ov == m1 && oa < a1)) { m1 = ov; a1 = oa; } }
    float m2 = (lane == a1) ? -3.0e38f : sel;
#pragma unroll
    for (int m = 1; m <= 4; m <<= 1) m2 = fmaxf(m2, __shfl_xor(m2, m));
    const float gs = m1 + m2; const int grp = lane >> 3;
    int grank = 0;
#pragma unroll
    for (int g2 = 0; g2 < 8; ++g2) { float og = __shfl(gs, g2 * 8); grank += (og > gs || (og == gs && g2 < grp)) ? 1 : 0; }
    const bool gsel = grank < 4;
    const float msel = gsel ? sel : -3.0e38f;
    int rank = 0;
    for (int e = 0; e < 64; ++e) { float ov = __shfl(msel, e); rank += (ov > msel || (ov == msel && e < lane)) ? 1 : 0; }
    const bool chosen = gsel && rank < 8;
    const float wsum = wave_sum(chosen ? score : 0.f);
    if (chosen) { int pos = atomicAdd(&cnt[lane], 1); ltok[(size_t)lane * NT_ + pos] = tok * 8 + rank; lwt[(size_t)lane * NT_ + pos] = score / wsum * 2.5f; }
  }
}

struct MoeMap { int nblk_total; int e; int rb; int cnt; int hoff; };
DEVFN int moe_ntok(int l) { return l == DEPTH_ - 1 ? B_ * SEQ_ : NT_; }
DEVFN int moe_shared_tok(int l, int i) { return l == DEPTH_ - 1 ? (i / SEQ_) * T_ + CTX_ + (i % SEQ_) : i; }
DEVFN void moe_prefix(const Params& p, int l, int* pre) {
  const int* cnt = (const int*)(p.ws + Ws::CNT) + l * 64;
  __syncthreads();
  if (TIDX == 0) { int s = 0; for (int e = 0; e < 65; ++e) { pre[e] = s; int c = e < 64 ? cnt[e] : moe_ntok(l); pre[66 + e] = c; s += (c + 127) / 128; } pre[65] = s; }
  __syncthreads();
}
DEVFN void phase8(const Params& p, int l, unsigned char* smem) {
  int* pre = (int*)(smem + SM_PRE);
  moe_prefix(p, l, pre);
  const bf16_t* H = (const bf16_t*)(p.ws + Ws::U);
  const bf16_t* W13 = (const bf16_t*)(p.ws + Ws::W13);
  bf16_t* HID = (bf16_t*)(p.ws + Ws::HID);
  const int* ltok = (const int*)(p.ws + Ws::LTOK); const float* lwt = (const float*)(p.ws + Ws::LWT);
  const int total = pre[65];
  for (int u = BIDX; u < total * 4; u += gridDim.x) {
    const int gb = u >> 2, nt = u & 3;
    int e = 0; while (pre[e + 1] <= gb) ++e;
    const int rb = gb - pre[e], cnt = pre[66 + e];
    gemm_tile(smem, 1024,
      [&](int r) { int pos = rb * 128 + r; if (pos >= cnt) return (const bf16_t*)(p.ws + Ws::ZROW); int tok = e < 64 ? (ltok[(size_t)e * NT_ + pos] >> 3) : moe_shared_tok(l, pos); return H + (size_t)tok * 1024; },
      [&](int r) { return W13 + ((size_t)e * 512 + nt * 128 + r) * 1024; },
      [&](f32x4 (&acc)[4][4], int wr, int wc, int g, int l15) {
#pragma unroll
        for (int mi = 0; mi < 4; ++mi)
#pragma unroll
          for (int i = 0; i < 4; ++i) { int r = wr * 64 + mi * 16 + 4 * g + i, pos = rb * 128 + r;
            if (pos < cnt) { float gw = e < 64 ? lwt[(size_t)e * NT_ + pos] : 1.f;
#pragma unroll
              for (int j = 0; j < 2; ++j) { float a1 = acc[mi][2 * j][i], a3 = acc[mi][2 * j + 1][i];
                HID[((size_t)gb * 128 + r) * 256 + nt * 64 + wc * 32 + j * 16 + l15] = f2bf(siluf_(a1) * a3 * gw); } } }
      });
  }
}
DEVFN void phase9(const Params& p, int l, unsigned char* smem) {
  int* pre = (int*)(smem + SM_PRE);
  moe_prefix(p, l, pre);
  const bf16_t* HID = (const bf16_t*)(p.ws + Ws::HID);
  const bf16_t* W2T = (const bf16_t*)(p.ws + Ws::W2T);
  bf16_t* YB = (bf16_t*)(p.ws + Ws::YBUF);
  const int* ltok = (const int*)(p.ws + Ws::LTOK);
  const int total = pre[65];
  for (int u = BIDX; u < total * 8; u += gridDim.x) {
    const int gb = u >> 3, nt = u & 7;
    int e = 0; while (pre[e + 1] <= gb) ++e;
    const int rb = gb - pre[e], cnt = pre[66 + e];
    gemm_tile(smem, 256,
      [&](int r) { int pos = rb * 128 + r; return pos < cnt ? HID + ((size_t)gb * 128 + r) * 256 : (const bf16_t*)(p.ws + Ws::ZROW); },
      [&](int r) { return W2T + ((size_t)e * 1024 + nt * 128 + r) * 256; },
      [&](f32x4 (&acc)[4][4], int wr, int wc, int g, int l15) {
#pragma unroll
        for (int mi = 0; mi < 4; ++mi)
#pragma unroll
          for (int i = 0; i < 4; ++i) { int r = wr * 64 + mi * 16 + 4 * g + i, pos = rb * 128 + r;
            if (pos < cnt) { int ts = e < 64 ? ltok[(size_t)e * NT_ + pos] : moe_shared_tok(l, pos) * 8; int tok = ts >> 3, slot = e < 64 ? (ts & 7) : 8;
              bf16_t* dst = YB + ((size_t)tok * NSLOT + slot) * 1024 + nt * 128 + wc * 64 + l15;
#pragma unroll
              for (int ni = 0; ni < 4; ++ni) dst[ni * 16] = f2bf(acc[mi][ni][i]); } }
      });
  }
}

#define SMEM_BYTES (GEMM_SMEM + 2048)
#define N_PHASES (3 + 9 * DEPTH_)
__global__ void __launch_bounds__(256, 2) mega(Params p, int ph_lo, int ph_hi) {
#ifdef HIPEMU
  unsigned char* smem = hipemu::cur_smem();
#else
  unsigned char* smem = smem_dyn;
  volatile LAS unsigned* st = (volatile LAS unsigned*)(smem_dyn + SM_BAR);
  if (threadIdx.x == 0) {
    st[0] = 0u; st[1] = 0u;
    unsigned long long* tab = (unsigned long long*)(smem_dyn + SM_TAB);
#pragma unroll
    for (int i = 0; i < 40; ++i) tab[i] = (unsigned long long)p.in[i];
  }
  __syncthreads();
  XcdBarrier bar = xcd_barrier_post((unsigned*)(p.ws + Ws::BAR), st);
#define GRID_SYNC() xcd_barrier(bar)
#endif
  int ph = 0;
#ifdef ONLY_KIND
#define KIND_ON(k) ((k) == ONLY_KIND)
#else
#define KIND_ON(k) 1
#endif
#define RUN_PHASE(kind, code) { if (KIND_ON(kind) && ph >= ph_lo && ph < ph_hi) { LAUNDER(p.ws); LAUNDER(p.out); code; if (ph + 1 < ph_hi) { GRID_SYNC(); } } ++ph; }
  RUN_PHASE(0, phase0(p, smem));
  RUN_PHASE(11, phase0b(p));
  for (int l = 0; l < DEPTH_; ++l) {
    RUN_PHASE(1, phase1(p, l));
    RUN_PHASE(2, phase2(p, l, smem));
    RUN_PHASE(3, { phase3(p, l, smem); convert_moe_weights(p, l, smem); });
    RUN_PHASE(4, phase4(p, l));
    RUN_PHASE(5, phase5(p, l, smem));
    RUN_PHASE(6, phase6(p, l, smem));
    RUN_PHASE(7, phase7(p, l));
    RUN_PHASE(8, phase8(p, l, smem));
    RUN_PHASE(9, phase9(p, l, smem));
  }
  RUN_PHASE(10, phase_final(p));
}

extern "C" void kernel_launch(void* const* d_in, const int* in_sizes, int n_in, void* d_out, int out_size, void* d_ws, size_t ws_size, hipStream_t stream) {
  Params p{};
  for (int i = 0; i < 40; ++i) p.in[i] = (const float*)d_in[i];
  p.out = (float*)d_out;
  p.ws = (unsigned char*)d_ws;
  if (ws_size < Ws::END) { fprintf(stderr, "workspace too small: %zu < %zu\n", ws_size, (size_t)Ws::END); return; }
  hipMemsetAsync(d_ws, 0, Ws::ZERO_END, stream);
#ifdef HIPEMU
  int grid = 16; if (const char* e = getenv("EMU_GRID")) grid = atoi(e);
  int stop = N_PHASES; if (const char* e = getenv("EMU_STOP")) stop = atoi(e);
  if (getenv("EMU_ONE")) hipemu::launch(grid, 256, SMEM_BYTES, true, [=] { mega(p, 0, stop); });
  else for (int ph = 0; ph < stop; ++ph) hipemu::launch(grid, 256, SMEM_BYTES, false, [=] { mega(p, ph, ph + 1); });
#else
  static int grid = 0;
  if (!grid) {
    int dev = 0, cus = 0, per_cu = 0;
    hipGetDevice(&dev);
    hipDeviceGetAttribute(&cus, hipDeviceAttributeMultiprocessorCount, dev);
    hipOccupancyMaxActiveBlocksPerMultiprocessor(&per_cu, mega, 256, SMEM_BYTES);
    if (per_cu > 2) per_cu = 2;
    if (per_cu < 1) per_cu = 1;
    grid = cus * per_cu;
  }
#if N_LAUNCH_MODE == 1
  mega<<<grid, 256, SMEM_BYTES, stream>>>(p, 0, N_PHASES);
#else
  for (int ph = 0; ph < N_PHASES; ++ph) mega<<<grid, 256, SMEM_BYTES, stream>>>(p, ph, ph + 1);
#endif
#endif
}
```

```cpp
#ifndef HIPEMU
#include <hip/hip_runtime.h>
#endif
#include <stdint.h>
#include <stdio.h>

#ifndef B_
#define B_ 4
#endif
#ifndef SEQ_
#define SEQ_ 4096
#endif
#ifndef CTX_
#define CTX_ 256
#endif
#ifndef DEPTH_
#define DEPTH_ 4
#endif
#ifndef N_LAUNCH_MODE
#define N_LAUNCH_MODE 1
#endif
#define T_ (SEQ_ + CTX_)
#define NT_ (B_ * T_)
#define D_ 1024
#define NIN_ 3504
#define NMOD_ 6144
#define NR_ (B_ + 1)
#define OZ 0
#define OXBC 512
#define ODT 1536
#define ORW 1552
#define OGQ 2704
#define OGK 2832
#define OGV 2960
#define OGD 3216
#define OOG 3248
#define ALPHA_ 1.681792830507429f
#define NEXP 64
#define NSLOT 9

#define DEVFN __device__ __forceinline__
#define LDT 72
#define GEMM_SMEM (2 * 128 * LDT * 2)
typedef unsigned short bf16_t;
typedef unsigned u32x4 __attribute__((ext_vector_type(4)));

#ifdef HIPEMU
typedef emu_bf16x8 bf16x8;
typedef emu_f32x4 f32x4;
#define MFMA16(a, b, c) emu_mfma_16x16x32_bf16(a, b, c)
#define GRID_SYNC() hipemu::grid_sync()
#else
typedef short bf16x8 __attribute__((ext_vector_type(8)));
typedef float f32x4 __attribute__((ext_vector_type(4)));
#define MFMA16(a, b, c) __builtin_amdgcn_mfma_f32_16x16x32_bf16(a, b, c, 0, 0, 0)
#endif

DEVFN float bf2f(bf16_t h) { return __builtin_bit_cast(float, (unsigned)h << 16); }
DEVFN bf16_t f2bf(float f) { unsigned u = __builtin_bit_cast(unsigned, f); u += 0x7FFFu + ((u >> 16) & 1u); return (bf16_t)(u >> 16); }
DEVFN float sigmoidf_(float x) { return 1.f / (1.f + expf(-x)); }
DEVFN float siluf_(float x) { return x / (1.f + expf(-x)); }
DEVFN float softplusf_(float x) { return x > 20.f ? x : log1pf(expf(x)); }
DEVFN float logsigmoidf_(float x) { return fminf(x, 0.f) - log1pf(expf(-fabsf(x))); }
DEVFN float wave_sum(float v) { for (int m = 32; m >= 1; m >>= 1) v += __shfl_xor(v, m); return v; }

constexpr size_t al(size_t x) { return (x + 255) & ~(size_t)255; }
struct Ws {
  static constexpr size_t BAR = 0;
  static constexpr size_t CNT = 16384;
  static constexpr size_t MOD = CNT + 4096;
  static constexpr size_t ZROW = al(MOD + (size_t)DEPTH_ * NR_ * NMOD_ * 4);
  static constexpr size_t ZERO_END = al(ZROW + 2048);
  static constexpr size_t MODP = ZERO_END;
  static constexpr size_t RWT = al(MODP + (size_t)16 * DEPTH_ * NR_ * NMOD_ * 4);
  static constexpr size_t X = al(RWT + (size_t)DEPTH_ * 64 * 1024 * 4);
  static constexpr size_t U = al(X + (size_t)NT_ * 1024 * 4);
  static constexpr size_t YMIX = al(U + (size_t)NT_ * 1024 * 2);
  static constexpr size_t ZX = al(YMIX + (size_t)NT_ * 1024 * 2);
  static constexpr size_t MIX = ZX;
  static constexpr size_t LTOK = al(ZX + (size_t)NT_ * NIN_ * 2);
  static constexpr size_t LWT = al(LTOK + (size_t)64 * NT_ * 4);
  static constexpr size_t WIN = al(LWT + (size_t)64 * NT_ * 4);
  static constexpr size_t WOUT = al(WIN + (size_t)DEPTH_ * NIN_ * 1024 * 2);
  static constexpr size_t W13 = al(WOUT + (size_t)DEPTH_ * 1024 * 1024 * 2);
  static constexpr size_t W2T = al(W13 + (size_t)65 * 512 * 1024 * 2);
  static constexpr size_t UNI = al(W2T + (size_t)65 * 1024 * 256 * 2);
  static constexpr size_t XBC = UNI;
  static constexpr size_t DTB = al(XBC + (size_t)NT_ * 1024 * 4);
  static constexpr size_t RR = al(DTB + (size_t)NT_ * 16 * 4);
  static constexpr size_t VV = RR + (size_t)NT_ * 256 * 4;
  static constexpr size_t KK = VV + (size_t)NT_ * 256 * 4;
  static constexpr size_t WD = KK + (size_t)NT_ * 256 * 4;
  static constexpr size_t KD = WD + (size_t)2 * NT_ * 256 * 4;
  static constexpr size_t BD = KD + (size_t)2 * NT_ * 256 * 4;
  static constexpr size_t GATE = BD + (size_t)2 * NT_ * 256 * 4;
  static constexpr size_t LA = GATE + (size_t)NT_ * 256 * 4;
  static constexpr size_t YS = LA + (size_t)2 * NT_ * 128 * 4;
  static constexpr size_t YR = YS + (size_t)2 * NT_ * 512 * 4;
  static constexpr size_t YG = YR + (size_t)2 * NT_ * 256 * 4;
  static constexpr size_t MIXER_END = YG + (size_t)2 * NT_ * 256 * 4;
  static constexpr size_t HID = UNI;
  static constexpr size_t YBUF = al(HID + ((size_t)NT_ * 9 + 65 * 128) * 256 * 2);
  static constexpr size_t MOE_END = YBUF + (size_t)NT_ * 9 * 1024 * 2;
  static constexpr size_t END = al(MIXER_END > MOE_END ? MIXER_END : MOE_END);
};

struct Params {
  const float* in[40];
  float* out;
  unsigned char* ws;
};
enum { I_X = 0, I_C, I_CTX, I_CCTX, I_ADAW, I_ADAB, I_WIN, I_CONVW, I_CONVB, I_DTBIAS, I_ALOG, I_SSDD, I_SSDNW, I_MU, I_W0, I_W2, I_A0, I_A2,
       I_G2, I_KKW, I_KAW, I_RK, I_LNXW, I_LNXB, I_GU, I_GB, I_GNW, I_WOUT, I_LN1W, I_LN1B, I_LN2W, I_LN2B, I_RW, I_RB, I_EW1, I_EW3, I_EW2,
       I_SW1, I_SW3, I_SW2 };

#define SM_PRE (GEMM_SMEM)
#define SM_TAB (GEMM_SMEM + 1024)
#define SM_BAR (GEMM_SMEM + 2032)
#ifdef HIPEMU
#define INP(i) (p.in[i])
#define LAUNDER(x)
#define TIDX ((int)threadIdx.x)
#define BIDX ((int)blockIdx.x)
#else
extern __shared__ __align__(16) unsigned char smem_dyn[];
DEVFN const float* inp_lds(int i) {
  const volatile unsigned* t = (const volatile unsigned*)(smem_dyn + SM_TAB) + 2 * i;
  unsigned lo = __builtin_amdgcn_readfirstlane(t[0]), hi = __builtin_amdgcn_readfirstlane(t[1]);
  return (const float*)(((unsigned long long)hi << 32) | lo);
}
#define INP(i) inp_lds(i)
#define LAUNDER(x) asm volatile("" : "+s"(x))
DEVFN int tidx_() { int t = threadIdx.x; asm volatile("" : "+v"(t)); return t; }
DEVFN int bidx_() { int b = blockIdx.x; asm volatile("" : "+s"(b)); return b; }
#define TIDX tidx_()
#define BIDX bidx_()
#endif
#ifndef HIPEMU
#define XB_TMO      128
#define XB_XCNT(j)  (256  + 64 * (j))
#define XB_XSUB(j)  (1280 + 64 * (j))
#define XB_XGEN(j)  (2304 + 64 * (j))
#define XB_TOP      3328
#define XB_TOPGEN   3392
#define XCD_BAR_WORDS 3456
#define XB_SPIN_CAP (1u << 22)
#define LAS __attribute__((address_space(3)))
__device__ __forceinline__ unsigned xb_ld(unsigned* p)              { return __hip_atomic_load(p, __ATOMIC_RELAXED, __HIP_MEMORY_SCOPE_AGENT); }
__device__ __forceinline__ unsigned xb_add(unsigned* p, unsigned v) { return __hip_atomic_fetch_add(p, v, __ATOMIC_RELAXED, __HIP_MEMORY_SCOPE_AGENT); }
__device__ __forceinline__ unsigned xb_xcc_id() { return (unsigned)__builtin_amdgcn_s_getreg((3 << 11) | 20) & 0xFu; }
#define XB_SPIN(cond, bar) do { unsigned _sp = 0; while (cond) { __builtin_amdgcn_s_sleep(1); \
    if ((++_sp & 255u) == 0u) { if (xb_ld(&(bar)[XB_TMO])) break; if (_sp > XB_SPIN_CAP) { atomicAdd(&(bar)[XB_TMO], 1u); break; } } } } while (0)
struct XcdBarrier { unsigned* bar; unsigned x; volatile LAS unsigned* st; };
__device__ __forceinline__ XcdBarrier xcd_barrier_post(unsigned* bar, volatile LAS unsigned* st) {
    XcdBarrier b; b.bar = bar; b.x = xb_xcc_id(); b.st = st;
    if (threadIdx.x == 0) (void)xb_add(&bar[XB_XCNT(b.x)], 1u);
    return b;
}
__device__ __forceinline__ void xcd_barrier_complete(unsigned* bar, unsigned x, unsigned& nloc, unsigned& nx) {
    const unsigned G = gridDim.x * gridDim.y * gridDim.z;
    unsigned sum, cnt, mine, sp = 0u;
    for (;;) {
        sum = 0u; cnt = 0u; mine = 0u;
#pragma unroll
        for (unsigned j = 0; j < 16; ++j) { const unsigned c = xb_ld(&bar[XB_XCNT(j)]); sum += c; cnt += (c > 0u) ? 1u : 0u; mine = (j == x) ? c : mine; }
        if (sum == G) break;
        __builtin_amdgcn_s_sleep(1);
        if ((++sp & 255u) == 0u) { if (xb_ld(&bar[XB_TMO])) break; if (sp > XB_SPIN_CAP) { atomicAdd(&bar[XB_TMO], 1u); break; } }
    }
    nloc = mine > 0u ? mine : 1u; nx = cnt > 0u ? cnt : 1u;
}
__device__ __forceinline__ void xcd_barrier(const XcdBarrier& b) {
    asm volatile("s_waitcnt vmcnt(0)" ::: "memory");
    __syncthreads();
    if (threadIdx.x == 0) {
        unsigned* bar = b.bar;
        __builtin_amdgcn_s_waitcnt(0);
        unsigned nloc = b.st[0], nx = b.st[1];
        if (nloc == 0u) { xcd_barrier_complete(bar, b.x, nloc, nx); b.st[0] = nloc; b.st[1] = nx; }
        const unsigned old = xb_add(&bar[XB_XSUB(b.x)], 1u);
        const unsigned gen = old / nloc;
        if (old + 1u == (gen + 1u) * nloc) {
            __builtin_amdgcn_fence(__ATOMIC_RELEASE, "agent");
            asm volatile("s_waitcnt vmcnt(0)" ::: "memory");
            const unsigned og = xb_add(&bar[XB_TOP], 1u);
            const unsigned tg = og / nx;
            if (og + 1u == (tg + 1u) * nx) xb_add(&bar[XB_TOPGEN], 1u);
            else XB_SPIN(xb_ld(&bar[XB_TOPGEN]) == tg, bar);
            __builtin_amdgcn_fence(__ATOMIC_ACQUIRE, "agent");
            xb_add(&bar[XB_XGEN(b.x)], 1u);
            asm volatile("s_waitcnt vmcnt(0)" ::: "memory");
        } else {
            XB_SPIN(xb_ld(&bar[XB_XGEN(b.x)]) == gen, bar);
            __builtin_amdgcn_fence(__ATOMIC_ACQUIRE, "agent");
            asm volatile("s_waitcnt vmcnt(0)" ::: "memory");
        }
    }
    __syncthreads();
}
#endif

DEVFN int tokmap(int dir, int p) { return dir == 0 ? p : (p < CTX_ ? CTX_ - 1 - p : 2 * CTX_ + SEQ_ - 1 - p); }
DEVFN const float* tok_input_row(const Params& p, int tok) {
  int b = tok / T_, t = tok % T_;
  return t < CTX_ ? INP(I_CTX) + ((size_t)b * CTX_ + t) * D_ : INP(I_X) + ((size_t)b * SEQ_ + (t - CTX_)) * D_;
}
DEVFN int tok_modrow(int tok) { return (tok % T_) < CTX_ ? B_ : tok / T_; }

template <class ARow, class BRow, class Epi>
DEVFN void gemm_tile(unsigned char* smem, int K, ARow arow, BRow brow, Epi epi) {
  bf16_t* As = (bf16_t*)smem;
  bf16_t* Bs = As + 128 * LDT;
  const int tid = TIDX, lane = tid & 63, wave = tid >> 6, wr = wave >> 1, wc = wave & 1;
  const int g = lane >> 4, l15 = lane & 15;
  const int lr = tid >> 3, lc = (tid & 7) * 8;
  const bf16_t* ap[4];
  const bf16_t* bp[4];
#pragma unroll
  for (int i = 0; i < 4; ++i) { ap[i] = arow(lr + 32 * i); bp[i] = brow(lr + 32 * i); }
  f32x4 acc[4][4];
#pragma unroll
  for (int mi = 0; mi < 4; ++mi)
#pragma unroll
    for (int ni = 0; ni < 4; ++ni) acc[mi][ni] = f32x4{0.f, 0.f, 0.f, 0.f};
  u32x4 ra[4], rb[4];
#pragma unroll
  for (int i = 0; i < 4; ++i) { ra[i] = *(const u32x4*)(ap[i] + lc); rb[i] = *(const u32x4*)(bp[i] + lc); }
  for (int k0 = 0; k0 < K; k0 += 64) {
    __syncthreads();
#pragma unroll
    for (int i = 0; i < 4; ++i) { *(u32x4*)(As + (lr + 32 * i) * LDT + lc) = ra[i]; *(u32x4*)(Bs + (lr + 32 * i) * LDT + lc) = rb[i]; }
    __syncthreads();
    if (k0 + 64 < K) {
#pragma unroll
      for (int i = 0; i < 4; ++i) { ra[i] = *(const u32x4*)(ap[i] + k0 + 64 + lc); rb[i] = *(const u32x4*)(bp[i] + k0 + 64 + lc); }
    }
#pragma unroll
    for (int kk = 0; kk < 2; ++kk) {
      bf16x8 af[4], bfr[4];
#pragma unroll
      for (int mi = 0; mi < 4; ++mi) af[mi] = *(const bf16x8*)(As + (wr * 64 + mi * 16 + l15) * LDT + kk * 32 + g * 8);
#pragma unroll
      for (int ni = 0; ni < 4; ++ni) bfr[ni] = *(const bf16x8*)(Bs + (wc * 64 + ni * 16 + l15) * LDT + kk * 32 + g * 8);
#pragma unroll
      for (int mi = 0; mi < 4; ++mi)
#pragma unroll
        for (int ni = 0; ni < 4; ++ni) acc[mi][ni] = MFMA16(af[mi], bfr[ni], acc[mi][ni]);
    }
  }
  epi(acc, wr, wc, g, l15);
}

DEVFN void cvt_tile(unsigned char* smem, const float* src, int K, int N, int k0, int n0, bf16_t* dst, int ldd, int mode) {
  float* s = (float*)smem;
  const int tid = TIDX;
  __syncthreads();
  for (int e = tid; e < 64 * 64; e += 256) { int kk = e >> 6, nn = e & 63; s[kk * 65 + nn] = (n0 + nn < N) ? src[(size_t)(k0 + kk) * N + n0 + nn] : 0.f; }
  __syncthreads();
  for (int e = tid; e < 64 * 64; e += 256) { int nn = e >> 6, kk = e & 63; int n = n0 + nn;
    if (n < N) { int row = mode == 0 ? n : ((n >> 4) * 32 + (n & 15) + (mode == 2 ? 16 : 0)); dst[(size_t)row * ldd + k0 + kk] = f2bf(s[kk * 65 + nn]); } }
}
DEVFN void convert_moe_weights(const Params& p, int l, unsigned char* smem) {
  bf16_t* w13 = (bf16_t*)(p.ws + Ws::W13);
  bf16_t* w2t = (bf16_t*)(p.ws + Ws::W2T);
  const int per_e = 192;
  for (int u = BIDX; u < 65 * per_e; u += gridDim.x) {
    int e = u / per_e, r = u % per_e, which = r / 64, t = r % 64;
    if (which < 2) {
      const float* src = e < 64 ? (which == 0 ? INP(I_EW1) : INP(I_EW3)) + ((size_t)l * 64 + e) * 1024 * 256 : (which == 0 ? INP(I_SW1) : INP(I_SW3)) + (size_t)l * 1024 * 256;
      cvt_tile(smem, src, 1024, 256, (t >> 2) * 64, (t & 3) * 64, w13 + (size_t)e * 512 * 1024, 1024, which == 0 ? 1 : 2);
    } else {
      const float* src = e < 64 ? INP(I_EW2) + ((size_t)l * 64 + e) * 256 * 1024 : INP(I_SW2) + (size_t)l * 256 * 1024;
      cvt_tile(smem, src, 256, 1024, (t >> 4) * 64, (t & 15) * 64, w2t + (size_t)e * 1024 * 256, 256, 0);
    }
  }
}
DEVFN void phase0(const Params& p, unsigned char* smem) {
  const int tid = TIDX;
  float* modp = (float*)(p.ws + Ws::MODP);
  for (int u = BIDX; u < DEPTH_ * 24 * 16; u += gridDim.x) {
    int l = u / (24 * 16), jb = (u / 16) % 24, ks = u % 16;
    float* sc = (float*)smem;
    __syncthreads();
    for (int e = tid; e < NR_ * 64; e += 256) { int r = e / 64, i = ks * 64 + (e % 64); float cv = r < B_ ? INP(I_C)[(size_t)r * D_ + i] : INP(I_CCTX)[i]; sc[e] = siluf_(cv); }
    __syncthreads();
    int j = jb * 256 + tid;
    float acc[NR_];
#pragma unroll
    for (int r = 0; r < NR_; ++r) acc[r] = 0.f;
    const float* w = INP(I_ADAW) + ((size_t)l * D_ + ks * 64) * NMOD_ + j;
#pragma unroll 4
    for (int i = 0; i < 64; ++i) { float wv = w[(size_t)i * NMOD_];
#pragma unroll
      for (int r = 0; r < NR_; ++r) acc[r] += sc[r * 64 + i] * wv; }
#pragma unroll
    for (int r = 0; r < NR_; ++r) modp[(((size_t)ks * DEPTH_ + l) * NR_ + r) * NMOD_ + j] = acc[r];
  }
  bf16_t* win = (bf16_t*)(p.ws + Ws::WIN);
  bf16_t* wout = (bf16_t*)(p.ws + Ws::WOUT);
  for (int u = BIDX; u < DEPTH_ * 16 * 55; u += gridDim.x) {
    int l = u / (16 * 55), r = u % (16 * 55);
    cvt_tile(smem, INP(I_WIN) + (size_t)l * 1024 * NIN_, 1024, NIN_, (r / 55) * 64, (r % 55) * 64, win + (size_t)l * NIN_ * 1024, 1024, 0);
  }
  for (int u = BIDX; u < DEPTH_ * 256; u += gridDim.x) {
    int l = u / 256, r = u % 256;
    cvt_tile(smem, INP(I_WOUT) + (size_t)l * 1024 * 1024, 1024, 1024, (r / 16) * 64, (r % 16) * 64, wout + (size_t)l * 1024 * 1024, 1024, 0);
  }
  float* rwt = (float*)(p.ws + Ws::RWT);
  for (int u = BIDX * 256 + tid; u < DEPTH_ * 64 * 1024; u += gridDim.x * 256) {
    int l = u / (64 * 1024), e = (u / 1024) % 64, i = u % 1024;
    rwt[u] = INP(I_RW)[((size_t)l * 1024 + i) * 64 + e];
  }
}

DEVFN void phase0b(const Params& p) {
  float* mod = (float*)(p.ws + Ws::MOD); const float* modp = (const float*)(p.ws + Ws::MODP);
  for (int u = BIDX * 256 + TIDX; u < DEPTH_ * NR_ * NMOD_; u += gridDim.x * 256) {
    int l = u / (NR_ * NMOD_), j = u % NMOD_;
    float s = INP(I_ADAB)[(size_t)l * NMOD_ + j];
    for (int ks = 0; ks < 16; ++ks) s += modp[(size_t)ks * DEPTH_ * NR_ * NMOD_ + u];
    mod[u] = s;
  }
}

DEVFN void row_stats(const float (&v)[16], float& mean, float& rstd) {
  float s = 0.f;
#pragma unroll
  for (int i = 0; i < 16; ++i) s += v[i];
  mean = wave_sum(s) * (1.f / 1024.f);
  float q = 0.f;
#pragma unroll
  for (int i = 0; i < 16; ++i) { float d = v[i] - mean; q += d * d; }
  rstd = rsqrtf(wave_sum(q) * (1.f / 1024.f) + 1e-5f);
}
DEVFN void load_row16(const float* row, int lane, float (&v)[16]) {
#pragma unroll
  for (int j = 0; j < 4; ++j) { float4 t = *(const float4*)(row + lane * 4 + 256 * j); v[4 * j] = t.x; v[4 * j + 1] = t.y; v[4 * j + 2] = t.z; v[4 * j + 3] = t.w; }
}
DEVFN void moe_residual_row(const Params& p, int lp, int tok, int lane, float (&xv)[16]) {
  const float* mod = (const float*)(p.ws + Ws::MOD) + ((size_t)lp * NR_ + tok_modrow(tok)) * NMOD_;
  const bf16_t* yb = (const bf16_t*)(p.ws + Ws::YBUF) + (size_t)tok * NSLOT * 1024;
  float f[16];
#pragma unroll
  for (int i = 0; i < 16; ++i) f[i] = 0.f;
  for (int s = 0; s < NSLOT; ++s) {
#pragma unroll
    for (int j = 0; j < 4; ++j) { uint2 t = *(const uint2*)(yb + (size_t)s * 1024 + lane * 4 + 256 * j);
      f[4 * j] += bf2f((bf16_t)(t.x & 0xFFFF)); f[4 * j + 1] += bf2f((bf16_t)(t.x >> 16)); f[4 * j + 2] += bf2f((bf16_t)(t.y & 0xFFFF)); f[4 * j + 3] += bf2f((bf16_t)(t.y >> 16)); }
  }
  float g2[16], w[16], b[16];
  load_row16(mod + 5 * 1024, lane, g2);
  load_row16(INP(I_LN2W) + (size_t)lp * 1024, lane, w);
  load_row16(INP(I_LN2B) + (size_t)lp * 1024, lane, b);
#pragma unroll
  for (int i = 0; i < 16; ++i) xv[i] = ALPHA_ * xv[i] + g2[i] * f[i];
  float mean, rstd;
  row_stats(xv, mean, rstd);
#pragma unroll
  for (int i = 0; i < 16; ++i) xv[i] = (xv[i] - mean) * rstd * w[i] + b[i];
}
DEVFN void phase1(const Params& p, int l) {
  const int lane = TIDX & 63, wave = TIDX >> 6;
  float* X = (float*)(p.ws + Ws::X);
  bf16_t* U = (bf16_t*)(p.ws + Ws::U);
  for (int tok = BIDX * 4 + wave; tok < NT_; tok += gridDim.x * 4) {
    float xv[16];
    if (l == 0) load_row16(tok_input_row(p, tok), lane, xv);
    else { load_row16(X + (size_t)tok * 1024, lane, xv); moe_residual_row(p, l - 1, tok, lane, xv); }
#pragma unroll
    for (int j = 0; j < 4; ++j) *(float4*)(X + (size_t)tok * 1024 + lane * 4 + 256 * j) = make_float4(xv[4 * j], xv[4 * j + 1], xv[4 * j + 2], xv[4 * j + 3]);
    const float* mod = (const float*)(p.ws + Ws::MOD) + ((size_t)l * NR_ + tok_modrow(tok)) * NMOD_;
    float sh[16], sc[16], mean, rstd;
    load_row16(mod, lane, sh);
    load_row16(mod + 1024, lane, sc);
    row_stats(xv, mean, rstd);
#pragma unroll
    for (int j = 0; j < 4; ++j) {
      float u0 = (xv[4 * j] - mean) * rstd * (1.f + sc[4 * j]) + sh[4 * j], u1 = (xv[4 * j + 1] - mean) * rstd * (1.f + sc[4 * j + 1]) + sh[4 * j + 1];
      float u2 = (xv[4 * j + 2] - mean) * rstd * (1.f + sc[4 * j + 2]) + sh[4 * j + 2], u3 = (xv[4 * j + 3] - mean) * rstd * (1.f + sc[4 * j + 3]) + sh[4 * j + 3];
      *(uint2*)(U + (size_t)tok * 1024 + lane * 4 + 256 * j) = make_uint2((unsigned)f2bf(u0) | ((unsigned)f2bf(u1) << 16), (unsigned)f2bf(u2) | ((unsigned)f2bf(u3) << 16));
    }
  }
}
DEVFN void phase_final(const Params& p) {
  const int lane = TIDX & 63, wave = TIDX >> 6;
  const float* X = (const float*)(p.ws + Ws::X);
  for (int r = BIDX * 4 + wave; r < B_ * SEQ_; r += gridDim.x * 4) {
    int b = r / SEQ_, s = r % SEQ_, tok = b * T_ + CTX_ + s;
    float xv[16];
    load_row16(X + (size_t)tok * 1024, lane, xv);
    moe_residual_row(p, DEPTH_ - 1, tok, lane, xv);
#pragma unroll
    for (int j = 0; j < 4; ++j) *(float4*)(p.out + (size_t)r * 1024 + lane * 4 + 256 * j) = make_float4(xv[4 * j], xv[4 * j + 1], xv[4 * j + 2], xv[4 * j + 3]);
  }
}

DEVFN void phase2(const Params& p, int l, unsigned char* smem) {
  const bf16_t* U = (const bf16_t*)(p.ws + Ws::U);
  const bf16_t* W = (const bf16_t*)(p.ws + Ws::WIN) + (size_t)l * NIN_ * 1024;
  bf16_t* ZX = (bf16_t*)(p.ws + Ws::ZX);
  const int nct = (NIN_ + 127) / 128;
  for (int u = BIDX; u < (NT_ / 128) * nct; u += gridDim.x) {
    int rt = u / nct, ct = u % nct;
    gemm_tile(smem, 1024,
      [&](int r) { return U + (size_t)(rt * 128 + r) * 1024; },
      [&](int r) { int n = ct * 128 + r; return n < NIN_ ? W + (size_t)n * 1024 : (const bf16_t*)(p.ws + Ws::ZROW); },
      [&](f32x4 (&acc)[4][4], int wr, int wc, int g, int l15) {
#pragma unroll
        for (int mi = 0; mi < 4; ++mi)
#pragma unroll
          for (int ni = 0; ni < 4; ++ni) { int col = ct * 128 + wc * 64 + ni * 16 + l15;
            if (col < NIN_) {
#pragma unroll
              for (int i = 0; i < 4; ++i) { int row = rt * 128 + wr * 64 + mi * 16 + 4 * g + i; ZX[(size_t)row * NIN_ + col] = f2bf(acc[mi][ni][i]); } } }
      });
  }
}

DEVFN float zxv(const bf16_t* ZX, int tok, int col) { return bf2f(ZX[(size_t)tok * NIN_ + col]); }
struct Nbr { int n; int tok[4]; };
DEVFN Nbr shift_nbrs(int tok) {
  Nbr nb; int b = tok / T_, t = tok % T_;
  if (t < CTX_) { nb.n = 2; nb.tok[0] = t > 0 ? tok - 1 : -1; nb.tok[1] = t < CTX_ - 1 ? tok + 1 : -1; nb.tok[2] = -1; nb.tok[3] = -1; }
  else { int s = t - CTX_, row = s / 64, col = s % 64; nb.n = 4; nb.tok[0] = col > 0 ? tok - 1 : -1; nb.tok[1] = col < 63 ? tok + 1 : -1;
    nb.tok[2] = row > 0 ? tok - 64 : -1; nb.tok[3] = row < SEQ_ / 64 - 1 ? tok + 64 : -1; }
  (void)b; return nb;
}
DEVFN float shiftmix(const bf16_t* ZX, const float* mu, int tok, const Nbr& nb, int ch) {
  float z = zxv(ZX, tok, ORW + ch), o = z;
#pragma unroll
  for (int j = 0; j < 4; ++j) if (j < nb.n) { float v = nb.tok[j] >= 0 ? zxv(ZX, nb.tok[j], ORW + ch) : 0.f; o += mu[j * 1152 + ch] * (v - z); }
  return o;
}
#define P3_TT 4
DEVFN void phase3(const Params& p, int l, unsigned char* smem) {
  const int tid = TIDX;
  const bf16_t* ZX = (const bf16_t*)(p.ws + Ws::ZX);
  float* XBC = (float*)(p.ws + Ws::XBC); float* DTB = (float*)(p.ws + Ws::DTB);
  float* RR = (float*)(p.ws + Ws::RR); float* VV = (float*)(p.ws + Ws::VV); float* KKb = (float*)(p.ws + Ws::KK);
  float* WD = (float*)(p.ws + Ws::WD); float* KD = (float*)(p.ws + Ws::KD); float* BD = (float*)(p.ws + Ws::BD);
  float* GATE = (float*)(p.ws + Ws::GATE); float* LA = (float*)(p.ws + Ws::LA);
  const float* convw = INP(I_CONVW) + (size_t)l * 3 * 1024; const float* convb = INP(I_CONVB) + (size_t)l * 1024;
  const float* mu = INP(I_MU) + (size_t)l * 4 * 1152;
  float* li = (float*)smem;
  const float kkw = INP(I_KKW)[(size_t)l * 256 + tid], kaw = INP(I_KAW)[(size_t)l * 256 + tid];
  for (int tile = BIDX; tile < NT_ / P3_TT; tile += gridDim.x) {
    float* kls = li + P3_TT * 416;
    float* knls = kls + P3_TT * 256;
    __syncthreads();
#pragma unroll 1
    for (int tt = 0; tt < P3_TT; ++tt) {
      const int tok = tile * P3_TT + tt, t = tok % T_;
      const bool hasp = (t != 0 && t != CTX_), hasn = (t != CTX_ - 1 && t != T_ - 1);
#pragma unroll
      for (int j = 0; j < 4; ++j) { int c = tid + 256 * j;
        float a = convb[c] + convw[1024 + c] * zxv(ZX, tok, OXBC + c);
        if (hasp) a += convw[c] * zxv(ZX, tok - 1, OXBC + c);
        if (hasn) a += convw[2048 + c] * zxv(ZX, tok + 1, OXBC + c);
        XBC[(size_t)tok * 1024 + c] = siluf_(a); }
      if (tid < 16) DTB[(size_t)tok * 16 + tid] = softplusf_(zxv(ZX, tok, ODT + tid) + INP(I_DTBIAS)[(size_t)l * 16 + tid]);
      const Nbr nb = shift_nbrs(tok);
      float r = shiftmix(ZX, mu, tok, nb, tid), k = shiftmix(ZX, mu, tok, nb, 256 + tid), v = shiftmix(ZX, mu, tok, nb, 512 + tid);
      RR[(size_t)tok * 256 + tid] = r; VV[(size_t)tok * 256 + tid] = v;
      float kq = k * kkw, nrm = sqrtf(wave_sum(kq * kq));
      const float kn = kq / fmaxf(nrm, 1e-12f);
      kls[tt * 256 + tid] = k; knls[tt * 256 + tid] = kn;
      KKb[(size_t)tok * 256 + tid] = kn;
      { float x = shiftmix(ZX, mu, tok, nb, 768 + tid); li[tt * 416 + tid] = tid < 128 ? tanhf(x) : x; }
      if (tid < 128) li[tt * 416 + 256 + tid] = sigmoidf_(shiftmix(ZX, mu, tok, nb, 1024 + tid));
      if (tid >= 128 && tid < 160) li[tt * 416 + 384 + (tid - 128)] = zxv(ZX, tok, OGD + (tid - 128));
    }
    __syncthreads();
    float xf[P3_TT], xb[P3_TT], af[P3_TT], ab[P3_TT], gt[P3_TT];
    { const float w0f = INP(I_W0)[(size_t)l * 512 + tid], w0b = INP(I_W0)[(size_t)l * 512 + 256 + tid];
      const float a0f = INP(I_A0)[(size_t)l * 512 + tid], a0b = INP(I_A0)[(size_t)l * 512 + 256 + tid];
#pragma unroll
      for (int tt = 0; tt < P3_TT; ++tt) { xf[tt] = w0f; xb[tt] = w0b; af[tt] = a0f; ab[tt] = a0b; gt[tt] = 0.f; } }
    const float* w2 = INP(I_W2) + (size_t)l * 2 * 64 * 256; const float* a2 = INP(I_A2) + (size_t)l * 2 * 64 * 256; const float* g2 = INP(I_G2) + (size_t)l * 128 * 256;
#pragma unroll 2
    for (int i = 0; i < 64; ++i) {
      float wf = w2[i * 256 + tid], wb = w2[(64 + i) * 256 + tid], af2 = a2[i * 256 + tid], ab2 = a2[(64 + i) * 256 + tid];
#pragma unroll
      for (int tt = 0; tt < P3_TT; ++tt) { xf[tt] += li[tt * 416 + i] * wf; xb[tt] += li[tt * 416 + 64 + i] * wb; af[tt] += li[tt * 416 + 128 + i] * af2; ab[tt] += li[tt * 416 + 192 + i] * ab2; }
    }
#pragma unroll 2
    for (int i = 0; i < 128; ++i) { float gw = g2[i * 256 + tid];
#pragma unroll
      for (int tt = 0; tt < P3_TT; ++tt) gt[tt] += li[tt * 416 + 256 + i] * gw; }
#pragma unroll
    for (int tt = 0; tt < P3_TT; ++tt) {
      const size_t o = (size_t)(tile * P3_TT + tt) * 256 + tid, o1 = (size_t)NT_ * 256 + o;
      float wf = expf(-0.6065306597126334f * sigmoidf_(xf[tt])), wb = expf(-0.6065306597126334f * sigmoidf_(xb[tt]));
      float aF = sigmoidf_(af[tt]), aB = sigmoidf_(ab[tt]);
      WD[o] = wf; WD[o1] = wb;
      const float kr_ = kls[tt * 256 + tid], kn_ = knls[tt * 256 + tid];
      KD[o] = kr_ * (1.f + (aF - 1.f) * kaw); KD[o1] = kr_ * (1.f + (aB - 1.f) * kaw);
      BD[o] = kn_ * aF; BD[o1] = kn_ * aB;
      GATE[o] = gt[tt];
    }
    { const int d = tid >> 7, c = tid & 127; const float* gu = INP(I_GU) + ((size_t)l * 2 + d) * 16 * 128; const float gb = INP(I_GB)[((size_t)l * 2 + d) * 128 + c];
      float guw[16];
#pragma unroll
      for (int i = 0; i < 16; ++i) guw[i] = gu[i * 128 + c];
#pragma unroll
      for (int tt = 0; tt < P3_TT; ++tt) { float s = gb;
#pragma unroll
        for (int i = 0; i < 16; ++i) s += li[tt * 416 + 384 + d * 16 + i] * guw[i];
        LA[((size_t)d * NT_ + tile * P3_TT + tt) * 128 + c] = logsigmoidf_(s) * (1.f / 16.f); } }
  }
}

DEVFN void scan_rwkv(const Params& p, int unit) {
  const int tid = TIDX, lane = tid & 63, wave = tid >> 6;
  const int rowblk = unit & 3, h = (unit >> 2) & 3, dir = (unit >> 4) & 1, b = unit >> 5;
  const int row = rowblk * 16 + wave * 4 + (lane >> 4), kq = lane & 15;
  const float* RR = (const float*)(p.ws + Ws::RR); const float* VV = (const float*)(p.ws + Ws::VV); const float* KKb = (const float*)(p.ws + Ws::KK);
  const float* WD = (const float*)(p.ws + Ws::WD) + (size_t)dir * NT_ * 256; const float* KD = (const float*)(p.ws + Ws::KD) + (size_t)dir * NT_ * 256;
  const float* BD = (const float*)(p.ws + Ws::BD) + (size_t)dir * NT_ * 256;
  float* YR = (float*)(p.ws + Ws::YR) + (size_t)dir * NT_ * 256;
  float s0 = 0.f, s1 = 0.f, s2 = 0.f, s3 = 0.f;
  for (int pos = 0; pos < T_; ++pos) {
    const int tok = b * T_ + tokmap(dir, pos);
    const size_t o = (size_t)tok * 256 + h * 64 + kq * 4;
    const float4 kk = *(const float4*)(KKb + o), w = *(const float4*)(WD + o), bd = *(const float4*)(BD + o), kd = *(const float4*)(KD + o), r = *(const float4*)(RR + o);
    const float v = VV[(size_t)tok * 256 + h * 64 + row];
    float d1 = s0 * kk.x + s1 * kk.y + s2 * kk.z + s3 * kk.w;
    float d2 = s0 * w.x * r.x + s1 * w.y * r.y + s2 * w.z * r.z + s3 * w.w * r.w;
    float br = bd.x * r.x + bd.y * r.y + bd.z * r.z + bd.w * r.w;
    float kr = kd.x * r.x + kd.y * r.y + kd.z * r.z + kd.w * r.w;
#pragma unroll
    for (int m = 8; m >= 1; m >>= 1) { d1 += __shfl_xor(d1, m); d2 += __shfl_xor(d2, m); br += __shfl_xor(br, m); kr += __shfl_xor(kr, m); }
    s0 = s0 * w.x - d1 * bd.x + v * kd.x; s1 = s1 * w.y - d1 * bd.y + v * kd.y; s2 = s2 * w.z - d1 * bd.z + v * kd.z; s3 = s3 * w.w - d1 * bd.w + v * kd.w;
    if (kq == 0) YR[(size_t)tok * 256 + h * 64 + row] = d2 - d1 * br + v * kr;
  }
}
DEVFN void scan_ssd(const Params& p, int l, int unit) {
  const int tid = TIDX, lane = tid & 63, wave = tid >> 6;
  const int rowblk = unit & 3, h = (unit >> 2) & 7, dir = (unit >> 5) & 1, b = unit >> 6;
  const int row = rowblk * 16 + wave * 4 + (lane >> 4), dq = lane & 15, grp = h >> 2;
  const float* XBC = (const float*)(p.ws + Ws::XBC); const float* DTB = (const float*)(p.ws + Ws::DTB);
  float* YS = (float*)(p.ws + Ws::YS) + (size_t)dir * NT_ * 512;
  const float nega = -expf(INP(I_ALOG)[(size_t)l * 16 + dir * 8 + h]);
  float s[8];
#pragma unroll
  for (int i = 0; i < 8; ++i) s[i] = 0.f;
  for (int pos = 0; pos < T_; ++pos) {
    const int tok = b * T_ + tokmap(dir, pos);
    const float dt = DTB[(size_t)tok * 16 + dir * 8 + h], dA = expf(dt * nega);
    const float xdt = XBC[(size_t)tok * 1024 + h * 64 + row] * dt;
    const float* bp = XBC + (size_t)tok * 1024 + 512 + grp * 128 + dq * 8; const float* cp = bp + 256;
    const float4 b0 = *(const float4*)bp, b1 = *(const float4*)(bp + 4), c0 = *(const float4*)cp, c1 = *(const float4*)(cp + 4);
    s[0] = s[0] * dA + xdt * b0.x; s[1] = s[1] * dA + xdt * b0.y; s[2] = s[2] * dA + xdt * b0.z; s[3] = s[3] * dA + xdt * b0.w;
    s[4] = s[4] * dA + xdt * b1.x; s[5] = s[5] * dA + xdt * b1.y; s[6] = s[6] * dA + xdt * b1.z; s[7] = s[7] * dA + xdt * b1.w;
    float y = s[0] * c0.x + s[1] * c0.y + s[2] * c0.z + s[3] * c0.w + s[4] * c1.x + s[5] * c1.y + s[6] * c1.z + s[7] * c1.w;
#pragma unroll
    for (int m = 8; m >= 1; m >>= 1) y += __shfl_xor(y, m);
    if (dq == 0) YS[(size_t)tok * 512 + h * 64 + row] = y;
  }
}
DEVFN void scan_gla(const Params& p, int unit) {
  const int tid = TIDX, lane = tid & 63, wave = tid >> 6;
  const int colblk = unit & 1, h = (unit >> 1) & 3, dir = (unit >> 3) & 1, b = unit >> 4;
  const int col = colblk * 32 + wave * 8 + (lane >> 3), kq = lane & 7;
  const bf16_t* ZX = (const bf16_t*)(p.ws + Ws::ZX);
  const float* LA = (const float*)(p.ws + Ws::LA) + (size_t)dir * NT_ * 128;
  float* YG = (float*)(p.ws + Ws::YG) + (size_t)dir * NT_ * 256;
  float s[4] = {0.f, 0.f, 0.f, 0.f};
  const float qs = 0.17677669529663687f;
  for (int pos = 0; pos < T_; ++pos) {
    const int tok = b * T_ + tokmap(dir, pos);
    const float4 la = *(const float4*)(LA + (size_t)tok * 128 + h * 32 + kq * 4);
    const float v = zxv(ZX, tok, OGV + h * 64 + col);
    float o = 0.f;
#pragma unroll
    for (int i = 0; i < 4; ++i) { float al = expf(i == 0 ? la.x : i == 1 ? la.y : i == 2 ? la.z : la.w);
      float k = zxv(ZX, tok, OGK + h * 32 + kq * 4 + i), q = zxv(ZX, tok, OGQ + h * 32 + kq * 4 + i) * qs;
      s[i] = s[i] * al + k * v; o += q * s[i]; }
#pragma unroll
    for (int m = 4; m >= 1; m >>= 1) o += __shfl_xor(o, m);
    if (kq == 0) YG[(size_t)tok * 256 + h * 64 + col] = o;
  }
}
DEVFN void phase4(const Params& p, int l) {
  const int n_r = B_ * 32, n_s = B_ * 64, n_g = B_ * 16;
  for (int u = BIDX; u < n_r + n_s + n_g; u += gridDim.x) {
    if (u < n_s) scan_ssd(p, l, u);
    else if (u < n_s + n_r) scan_rwkv(p, u - n_s);
    else scan_gla(p, u - n_s - n_r);
  }
}

DEVFN void phase5(const Params& p, int l, unsigned char* smem) {
  const int tid = TIDX, lane = tid & 63, wave = tid >> 6;
  const bf16_t* ZX = (const bf16_t*)(p.ws + Ws::ZX);
  const float* XBC = (const float*)(p.ws + Ws::XBC);
  const float* YS = (const float*)(p.ws + Ws::YS); const float* YR = (const float*)(p.ws + Ws::YR); const float* YG = (const float*)(p.ws + Ws::YG);
  const float* RR = (const float*)(p.ws + Ws::RR); const float* VV = (const float*)(p.ws + Ws::VV); const float* KD = (const float*)(p.ws + Ws::KD);
  const float* GATE = (const float*)(p.ws + Ws::GATE);
  bf16_t* YM = (bf16_t*)(p.ws + Ws::YMIX);
  float* red = (float*)smem;
  const float dA = INP(I_SSDD)[(size_t)l * 8 + (tid >> 6)], dB = INP(I_SSDD)[(size_t)l * 8 + 4 + (tid >> 6)];
  const float nwA = INP(I_SSDNW)[(size_t)l * 512 + tid], nwB = INP(I_SSDNW)[(size_t)l * 512 + 256 + tid];
  const float lnw = INP(I_LNXW)[(size_t)l * 256 + tid], lnb = INP(I_LNXB)[(size_t)l * 256 + tid], rk = INP(I_RK)[(size_t)l * 256 + tid];
  const float gnw = INP(I_GNW)[(size_t)l * 256 + tid];
  for (int tok = BIDX; tok < NT_; tok += gridDim.x) {
    float ya = YS[(size_t)tok * 512 + tid] + YS[((size_t)NT_ + tok) * 512 + tid] + dA * XBC[(size_t)tok * 1024 + tid];
    float yb = YS[(size_t)tok * 512 + 256 + tid] + YS[((size_t)NT_ + tok) * 512 + 256 + tid] + dB * XBC[(size_t)tok * 1024 + 256 + tid];
    ya *= siluf_(zxv(ZX, tok, OZ + tid)); yb *= siluf_(zxv(ZX, tok, OZ + 256 + tid));
    float qa = wave_sum(ya * ya), qb = wave_sum(yb * yb);
    __syncthreads();
    if (lane == 0) { red[wave] = qa; red[4 + wave] = qb; }
    __syncthreads();
    float ma = (red[0] + red[1] + red[2] + red[3]) * (1.f / 256.f), mb = (red[4] + red[5] + red[6] + red[7]) * (1.f / 256.f);
    YM[(size_t)tok * 1024 + tid] = f2bf(ya * rsqrtf(ma + 1e-5f) * nwA);
    YM[(size_t)tok * 1024 + 256 + tid] = f2bf(yb * rsqrtf(mb + 1e-5f) * nwB);
    { float y = YR[(size_t)tok * 256 + tid] + YR[((size_t)NT_ + tok) * 256 + tid];
      float mu = wave_sum(y) * (1.f / 64.f), d = y - mu, var = wave_sum(d * d) * (1.f / 64.f);
      float yn = d * rsqrtf(var + 64e-5f) * lnw + lnb;
      float r = RR[(size_t)tok * 256 + tid], kf = KD[(size_t)tok * 256 + tid], kb = KD[((size_t)NT_ + tok) * 256 + tid];
      float bonus = wave_sum(r * (kf + kb) * rk) * VV[(size_t)tok * 256 + tid];
      YM[(size_t)tok * 1024 + 512 + tid] = f2bf((yn + bonus) * GATE[(size_t)tok * 256 + tid]); }
    { float o = YG[(size_t)tok * 256 + tid] + YG[((size_t)NT_ + tok) * 256 + tid];
      float ms = wave_sum(o * o) * (1.f / 64.f);
      YM[(size_t)tok * 1024 + 768 + tid] = f2bf(o * rsqrtf(ms + 1e-5f) * gnw * siluf_(zxv(ZX, tok, OOG + tid))); }
  }
}

DEVFN void phase6(const Params& p, int l, unsigned char* smem) {
  const bf16_t* A = (const bf16_t*)(p.ws + Ws::YMIX);
  const bf16_t* W = (const bf16_t*)(p.ws + Ws::WOUT) + (size_t)l * 1024 * 1024;
  float* MIX = (float*)(p.ws + Ws::MIX);
  for (int u = BIDX; u < (NT_ / 128) * 8; u += gridDim.x) {
    int rt = u / 8, ct = u % 8;
    gemm_tile(smem, 1024,
      [&](int r) { return A + (size_t)(rt * 128 + r) * 1024; },
      [&](int r) { return W + (size_t)(ct * 128 + r) * 1024; },
      [&](f32x4 (&acc)[4][4], int wr, int wc, int g, int l15) {
#pragma unroll
        for (int mi = 0; mi < 4; ++mi)
#pragma unroll
          for (int ni = 0; ni < 4; ++ni)
#pragma unroll
            for (int i = 0; i < 4; ++i) MIX[(size_t)(rt * 128 + wr * 64 + mi * 16 + 4 * g + i) * 1024 + ct * 128 + wc * 64 + ni * 16 + l15] = acc[mi][ni][i];
      });
  }
}

DEVFN void phase7(const Params& p, int l) {
  const int lane = TIDX & 63, wave = TIDX >> 6;
  float* X = (float*)(p.ws + Ws::X);
  const float* MIX = (const float*)(p.ws + Ws::MIX);
  bf16_t* H = (bf16_t*)(p.ws + Ws::U);
  const float* rwt = (const float*)(p.ws + Ws::RWT) + (size_t)l * 64 * 1024;
  int* cnt = (int*)(p.ws + Ws::CNT) + l * 64;
  int* ltok = (int*)(p.ws + Ws::LTOK); float* lwt = (float*)(p.ws + Ws::LWT);
  const float rbias = INP(I_RB)[(size_t)l * 64 + lane];
  for (int tok = BIDX * 4 + wave; tok < NT_; tok += gridDim.x * 4) {
    const float* mod = (const float*)(p.ws + Ws::MOD) + ((size_t)l * NR_ + tok_modrow(tok)) * NMOD_;
    float xv[16], t0[16], t1[16], mean, rstd;
    load_row16(X + (size_t)tok * 1024, lane, xv);
    load_row16(MIX + (size_t)tok * 1024, lane, t0);
    load_row16(mod + 2 * 1024, lane, t1);
#pragma unroll
    for (int i = 0; i < 16; ++i) xv[i] = ALPHA_ * xv[i] + t1[i] * t0[i];
    row_stats(xv, mean, rstd);
    load_row16(INP(I_LN1W) + (size_t)l * 1024, lane, t0);
    load_row16(INP(I_LN1B) + (size_t)l * 1024, lane, t1);
#pragma unroll
    for (int i = 0; i < 16; ++i) xv[i] = (xv[i] - mean) * rstd * t0[i] + t1[i];
#pragma unroll
    for (int j = 0; j < 4; ++j) *(float4*)(X + (size_t)tok * 1024 + lane * 4 + 256 * j) = make_float4(xv[4 * j], xv[4 * j + 1], xv[4 * j + 2], xv[4 * j + 3]);
    const bool is_ctx = (tok % T_) < CTX_;
    if (l == DEPTH_ - 1 && is_ctx) continue;
    row_stats(xv, mean, rstd);
    load_row16(mod + 3 * 1024, lane, t0);
    load_row16(mod + 4 * 1024, lane, t1);
#pragma unroll
    for (int i = 0; i < 16; ++i) xv[i] = (xv[i] - mean) * rstd * (1.f + t1[i]) + t0[i];
#pragma unroll
    for (int j = 0; j < 4; ++j)
      *(uint2*)(H + (size_t)tok * 1024 + lane * 4 + 256 * j) = make_uint2((unsigned)f2bf(xv[4 * j]) | ((unsigned)f2bf(xv[4 * j + 1]) << 16), (unsigned)f2bf(xv[4 * j + 2]) | ((unsigned)f2bf(xv[4 * j + 3]) << 16));
    float logit = 0.f;
    for (int e = 0; e < 64; ++e) {
      float s = 0.f;
#pragma unroll
      for (int j = 0; j < 4; ++j) { float4 w = *(const float4*)(rwt + (size_t)e * 1024 + lane * 4 + 256 * j); s += xv[4 * j] * w.x + xv[4 * j + 1] * w.y + xv[4 * j + 2] * w.z + xv[4 * j + 3] * w.w; }
      s = wave_sum(s);
      if (lane == e) logit = s;
    }
    const float score = sigmoidf_(logit), sel = score + rbias;
    float m1 = sel; int a1 = lane;
#pragma unroll
    for (int m = 1; m <= 4; m <<= 1) { float ov = __shfl_xor(m1, m); int oa = __shfl_xor(a1, m); if (ov > m1 || (ov == m1 && oa < a1)) { m1 = ov; a1 = oa; } }
    float m2 = (lane == a1) ? -3.0e38f : sel;
#pragma unroll
    for (int m = 1; m <= 4; m <<= 1) m2 = fmaxf(m2, __shfl_xor(m2, m));
    const float gs = m1 + m2; const int grp = lane >> 3;
    int grank = 0;
#pragma unroll
    for (int g2 = 0; g2 < 8; ++g2) { float og = __shfl(gs, g2 * 8); grank += (og > gs || (og == gs && g2 < grp)) ? 1 : 0; }
    const bool gsel = grank < 4;
    const float msel = gsel ? sel : -3.0e38f;
    int rank = 0;
    for (int e = 0; e < 64; ++e) { float ov = __shfl(msel, e); rank += (ov > msel || (ov == msel && e < lane)) ? 1 : 0; }
    const bool chosen = gsel && rank < 8;
    const float wsum = wave_sum(chosen ? score : 0.f);
    if (chosen) { int pos = atomicAdd(&cnt[lane], 1); ltok[(size_t)lane * NT_ + pos] = tok * 8 + rank; lwt[(size_t)lane * NT_ + pos] = score / wsum * 2.5f; }
  }
}

struct MoeMap { int nblk_total; int e; int rb; int cnt; int hoff; };
DEVFN int moe_ntok(int l) { return l == DEPTH_ - 1 ? B_ * SEQ_ : NT_; }
DEVFN int moe_shared_tok(int l, int i) { return l == DEPTH_ - 1 ? (i / SEQ_) * T_ + CTX_ + (i % SEQ_) : i; }
DEVFN void moe_prefix(const Params& p, int l, int* pre) {
  const int* cnt = (const int*)(p.ws + Ws::CNT) + l * 64;
  __syncthreads();
  if (TIDX == 0) { int s = 0; for (int e = 0; e < 65; ++e) { pre[e] = s; int c = e < 64 ? cnt[e] : moe_ntok(l); pre[66 + e] = c; s += (c + 127) / 128; } pre[65] = s; }
  __syncthreads();
}
DEVFN void phase8(const Params& p, int l, unsigned char* smem) {
  int* pre = (int*)(smem + SM_PRE);
  moe_prefix(p, l, pre);
  const bf16_t* H = (const bf16_t*)(p.ws + Ws::U);
  const bf16_t* W13 = (const bf16_t*)(p.ws + Ws::W13);
  bf16_t* HID = (bf16_t*)(p.ws + Ws::HID);
  const int* ltok = (const int*)(p.ws + Ws::LTOK); const float* lwt = (const float*)(p.ws + Ws::LWT);
  const int total = pre[65];
  for (int u = BIDX; u < total * 4; u += gridDim.x) {
    const int gb = u >> 2, nt = u & 3;
    int e = 0; while (pre[e + 1] <= gb) ++e;
    const int rb = gb - pre[e], cnt = pre[66 + e];
    gemm_tile(smem, 1024,
      [&](int r) { int pos = rb * 128 + r; if (pos >= cnt) return (const bf16_t*)(p.ws + Ws::ZROW); int tok = e < 64 ? (ltok[(size_t)e * NT_ + pos] >> 3) : moe_shared_tok(l, pos); return H + (size_t)tok * 1024; },
      [&](int r) { return W13 + ((size_t)e * 512 + nt * 128 + r) * 1024; },
      [&](f32x4 (&acc)[4][4], int wr, int wc, int g, int l15) {
#pragma unroll
        for (int mi = 0; mi < 4; ++mi)
#pragma unroll
          for (int i = 0; i < 4; ++i) { int r = wr * 64 + mi * 16 + 4 * g + i, pos = rb * 128 + r;
            if (pos < cnt) { float gw = e < 64 ? lwt[(size_t)e * NT_ + pos] : 1.f;
#pragma unroll
              for (int j = 0; j < 2; ++j) { float a1 = acc[mi][2 * j][i], a3 = acc[mi][2 * j + 1][i];
                HID[((size_t)gb * 128 + r) * 256 + nt * 64 + wc * 32 + j * 16 + l15] = f2bf(siluf_(a1) * a3 * gw); } } }
      });
  }
}
DEVFN void phase9(const Params& p, int l, unsigned char* smem) {
  int* pre = (int*)(smem + SM_PRE);
  moe_prefix(p, l, pre);
  const bf16_t* HID = (const bf16_t*)(p.ws + Ws::HID);
  const bf16_t* W2T = (const bf16_t*)(p.ws + Ws::W2T);
  bf16_t* YB = (bf16_t*)(p.ws + Ws::YBUF);
  const int* ltok = (const int*)(p.ws + Ws::LTOK);
  const int total = pre[65];
  for (int u = BIDX; u < total * 8; u += gridDim.x) {
    const int gb = u >> 3, nt = u & 7;
    int e = 0; while (pre[e + 1] <= gb) ++e;
    const int rb = gb - pre[e], cnt = pre[66 + e];
    gemm_tile(smem, 256,
      [&](int r) { int pos = rb * 128 + r; return pos < cnt ? HID + ((size_t)gb * 128 + r) * 256 : (const bf16_t*)(p.ws + Ws::ZROW); },
      [&](int r) { return W2T + ((size_t)e * 1024 + nt * 128 + r) * 256; },
      [&](f32x4 (&acc)[4][4], int wr, int wc, int g, int l15) {
#pragma unroll
        for (int mi = 0; mi < 4; ++mi)
#pragma unroll
          for (int i = 0; i < 4; ++i) { int r = wr * 64 + mi * 16 + 4 * g + i, pos = rb * 128 + r;
            if (pos < cnt) { int ts = e < 64 ? ltok[(size_t)e * NT_ + pos] : moe_shared_tok(l, pos) * 8; int tok = ts >> 3, slot = e < 64 ? (ts & 7) : 8;
              bf16_t* dst = YB + ((size_t)tok * NSLOT + slot) * 1024 + nt * 128 + wc * 64 + l15;
#pragma unroll
              for (int ni = 0; ni < 4; ++ni) dst[ni * 16] = f2bf(acc[mi][ni][i]); } }
      });
  }
}

#define SMEM_BYTES (GEMM_SMEM + 2048)
#define N_PHASES (3 + 9 * DEPTH_)
__global__ void __launch_bounds__(256, 2) mega(Params p, int ph_lo, int ph_hi) {
#ifdef HIPEMU
  unsigned char* smem = hipemu::cur_smem();
#else
  unsigned char* smem = smem_dyn;
  volatile LAS unsigned* st = (volatile LAS unsigned*)(smem_dyn + SM_BAR);
  if (threadIdx.x == 0) {
    st[0] = 0u; st[1] = 0u;
    unsigned long long* tab = (unsigned long long*)(smem_dyn + SM_TAB);
#pragma unroll
    for (int i = 0; i < 40; ++i) tab[i] = (unsigned long long)p.in[i];
  }
  __syncthreads();
  XcdBarrier bar = xcd_barrier_post((unsigned*)(p.ws + Ws::BAR), st);
#define GRID_SYNC() xcd_barrier(bar)
#endif
  int ph = 0;
#ifdef ONLY_KIND
#define KIND_ON(k) ((k) == ONLY_KIND)
#else
#define KIND_ON(k) 1
#endif
#define RUN_PHASE(kind, code) { if (KIND_ON(kind) && ph >= ph_lo && ph < ph_hi) { LAUNDER(p.ws); LAUNDER(p.out); code; if (ph + 1 < ph_hi) { GRID_SYNC(); } } ++ph; }
  RUN_PHASE(0, phase0(p, smem));
  RUN_PHASE(11, phase0b(p));
  for (int l = 0; l < DEPTH_; ++l) {
    RUN_PHASE(1, phase1(p, l));
    RUN_PHASE(2, phase2(p, l, smem));
    RUN_PHASE(3, { phase3(p, l, smem); convert_moe_weights(p, l, smem); });
    RUN_PHASE(4, phase4(p, l));
    RUN_PHASE(5, phase5(p, l, smem));
    RUN_PHASE(6, phase6(p, l, smem));
    RUN_PHASE(7, phase7(p, l));
    RUN_PHASE(8, phase8(p, l, smem));
    RUN_PHASE(9, phase9(p, l, smem));
  }
  RUN_PHASE(10, phase_final(p));
}

extern "C" void kernel_launch(void* const* d_in, const int* in_sizes, int n_in, void* d_out, int out_size, void* d_ws, size_t ws_size, hipStream_t stream) {
  Params p{};
  for (int i = 0; i < 40; ++i) p.in[i] = (const float*)d_in[i];
  p.out = (float*)d_out;
  p.ws = (unsigned char*)d_ws;
  if (ws_size < Ws::END) { fprintf(stderr, "workspace too small: %zu < %zu\n", ws_size, (size_t)Ws::END); return; }
  hipMemsetAsync(d_ws, 0, Ws::ZERO_END, stream);
#ifdef HIPEMU
  int grid = 16; if (const char* e = getenv("EMU_GRID")) grid = atoi(e);
  int stop = N_PHASES; if (const char* e = getenv("EMU_STOP")) stop = atoi(e);
  if (getenv("EMU_ONE")) hipemu::launch(grid, 256, SMEM_BYTES, true, [=] { mega(p, 0, stop); });
  else for (int ph = 0; ph < stop; ++ph) hipemu::launch(grid, 256, SMEM_BYTES, false, [=] { mega(p, ph, ph + 1); });
#else
  static int grid = 0;
  if (!grid) {
    int dev = 0, cus = 0, per_cu = 0;
    hipGetDevice(&dev);
    hipDeviceGetAttribute(&cus, hipDeviceAttributeMultiprocessorCount, dev);
    hipOccupancyMaxActiveBlocksPerMultiprocessor(&per_cu, mega, 256, SMEM_BYTES);
    if (per_cu > 2) per_cu = 2;
    if (per_cu < 1) per_cu = 1;
    grid = cus * per_cu;
  }
#if N_LAUNCH_MODE == 1
  mega<<<grid, 256, SMEM_BYTES, stream>>>(p, 0, N_PHASES);
#else
  for (int ph = 0; ph < N_PHASES; ++ph) mega<<<grid, 256, SMEM_BYTES, stream>>>(p, ph, ph + 1);
#endif
#endif
}
```

```cpp
#ifndef HIPEMU
#include <hip/hip_runtime.h>
#endif
#include <stdint.h>
#include <stdio.h>

#ifndef B_
#define B_ 4
#endif
#ifndef SEQ_
#define SEQ_ 4096
#endif
#ifndef CTX_
#define CTX_ 256
#endif
#ifndef DEPTH_
#define DEPTH_ 4
#endif
#ifndef N_LAUNCH_MODE
#define N_LAUNCH_MODE 1
#endif
#define T_ (SEQ_ + CTX_)
#define NT_ (B_ * T_)
#define D_ 1024
#define NIN_ 3504
#define NMOD_ 6144
#define NR_ (B_ + 1)
#define OZ 0
#define OXBC 512
#define ODT 1536
#define ORW 1552
#define OGQ 2704
#define OGK 2832
#define OGV 2960
#define OGD 3216
#define OOG 3248
#define ALPHA_ 1.681792830507429f
#define NEXP 64
#define NSLOT 9
#define NC128 (T_ / 128)
#define NC64 (T_ / 64)
#define NC16 (T_ / 16)

#define DEVFN __device__ __forceinline__
#define LDT 72
#define GEMM_SMEM (2 * 128 * LDT * 2)
typedef unsigned short bf16_t;
typedef unsigned u32x4 __attribute__((ext_vector_type(4)));

#ifdef HIPEMU
typedef emu_bf16x8 bf16x8;
typedef emu_f32x4 f32x4;
#define MFMA16(a, b, c) emu_mfma_16x16x32_bf16(a, b, c)
#define MFMA16K16(a, b, c) emu_mfma_16x16x16_bf16(a, b, c)
#define GRID_SYNC() hipemu::grid_sync()
#else
typedef short bf16x8 __attribute__((ext_vector_type(8)));
typedef float f32x4 __attribute__((ext_vector_type(4)));
#define MFMA16(a, b, c) __builtin_amdgcn_mfma_f32_16x16x32_bf16(a, b, c, 0, 0, 0)
#define MFMA16K16(a, b, c) __builtin_amdgcn_mfma_f32_16x16x16bf16_1k(a, b, c, 0, 0, 0)
#endif

DEVFN float bf2f(bf16_t h) { return __builtin_bit_cast(float, (unsigned)h << 16); }
DEVFN bf16_t f2bf(float f) { unsigned u = __builtin_bit_cast(unsigned, f); u += 0x7FFFu + ((u >> 16) & 1u); return (bf16_t)(u >> 16); }
DEVFN float sigmoidf_(float x) { return 1.f / (1.f + expf(-x)); }
DEVFN float siluf_(float x) { return x / (1.f + expf(-x)); }
DEVFN float softplusf_(float x) { return x > 20.f ? x : log1pf(expf(x)); }
DEVFN float logsigmoidf_(float x) { return fminf(x, 0.f) - log1pf(expf(-fabsf(x))); }
DEVFN float wave_sum(float v) { for (int m = 32; m >= 1; m >>= 1) v += __shfl_xor(v, m); return v; }

constexpr size_t al(size_t x) { return (x + 255) & ~(size_t)255; }
struct Ws {
  static constexpr size_t BAR = 0;
  static constexpr size_t CNT = 16384;
  static constexpr size_t MOD = CNT + 4096;
  static constexpr size_t ZROW = al(MOD + (size_t)DEPTH_ * NR_ * NMOD_ * 4);
  static constexpr size_t ZERO_END = al(ZROW + 2048);
  static constexpr size_t MODP = ZERO_END;
  static constexpr size_t RWT = al(MODP + (size_t)16 * DEPTH_ * NR_ * NMOD_ * 4);
  static constexpr size_t X = al(RWT + (size_t)DEPTH_ * 64 * 1024 * 4);
  static constexpr size_t U = al(X + (size_t)NT_ * 1024 * 4);
  static constexpr size_t YMIX = al(U + (size_t)NT_ * 1024 * 2);
  static constexpr size_t ZX = al(YMIX + (size_t)NT_ * 1024 * 2);
  static constexpr size_t MIX = ZX;
  static constexpr size_t LTOK = al(ZX + (size_t)NT_ * NIN_ * 2);
  static constexpr size_t LWT = al(LTOK + (size_t)64 * NT_ * 4);
  static constexpr size_t WIN = al(LWT + (size_t)64 * NT_ * 4);
  static constexpr size_t WOUT = al(WIN + (size_t)DEPTH_ * NIN_ * 1024 * 2);
  static constexpr size_t W13 = al(WOUT + (size_t)DEPTH_ * 1024 * 1024 * 2);
  static constexpr size_t W2T = al(W13 + (size_t)65 * 512 * 1024 * 2);
  static constexpr size_t UNI = al(W2T + (size_t)65 * 1024 * 256 * 2);
  static constexpr size_t XBC = UNI;
  static constexpr size_t XBCT = al(XBC + (size_t)NT_ * 1024 * 2);
  static constexpr size_t DTB = al(XBCT + (size_t)NT_ * 768 * 2);
  static constexpr size_t SST = al(DTB + (size_t)NT_ * 16 * 4);
  static constexpr size_t SCD = al(SST + (size_t)2 * NT_ / 128 * 8 * 8192 * 4);
  static constexpr size_t HIN = al(SCD + (size_t)2 * NT_ / 128 * 8 * 4);
  static constexpr size_t YS = SST;
  static constexpr size_t LA = al(HIN + (size_t)2 * NT_ / 128 * 8 * 8192 * 2);
  static constexpr size_t VT = al(LA + (size_t)2 * NT_ * 128 * 4);
  static constexpr size_t QT = al(VT + (size_t)NT_ * 256 * 2);
  static constexpr size_t OI = al(QT + (size_t)2 * NT_ * 128 * 2);
  static constexpr size_t GST = al(OI + (size_t)NT_ * 256 * 4);
  static constexpr size_t GCD = al(GST + (size_t)2 * NT_ / 64 * 4 * 2048 * 4);
  static constexpr size_t GSIN = al(GCD + (size_t)2 * NT_ / 64 * 4 * 32 * 4);
  static constexpr size_t RR = al(GSIN + (size_t)2 * NT_ / 64 * 4 * 2048 * 2);
  static constexpr size_t VV = RR + (size_t)NT_ * 256 * 2;
  static constexpr size_t KK = VV + (size_t)NT_ * 256 * 2;
  static constexpr size_t KD = KK + (size_t)NT_ * 256 * 2;
  static constexpr size_t BD = KD + (size_t)2 * NT_ * 256 * 2;
  static constexpr size_t LW = BD + (size_t)2 * NT_ * 256 * 2;
  static constexpr size_t GATE = LW + (size_t)2 * NT_ * 256 * 4;
  static constexpr size_t YR = GATE + (size_t)NT_ * 256 * 4;
  static constexpr size_t RML = al(YR + (size_t)2 * NT_ * 256 * 4);
  static constexpr size_t RNS = RML + (size_t)(NT_ / 16) * 8 * 4096 * 2;
  static constexpr size_t RWC = RNS + (size_t)(NT_ / 16) * 8 * 4096 * 2;
  static constexpr size_t RG = RWC + (size_t)(NT_ / 16) * 8 * 64 * 4;
  static constexpr size_t RY0 = RG + (size_t)(NT_ / 16) * 8 * 1024 * 2;
  static constexpr size_t MIXER_END = RY0 + (size_t)(NT_ / 16) * 8 * 1024 * 4;
  static constexpr size_t HID = UNI;
  static constexpr size_t YBUF = al(HID + ((size_t)NT_ * 9 + 65 * 128) * 256 * 2);
  static constexpr size_t MOE_END = YBUF + (size_t)NT_ * 9 * 1024 * 2;
  static constexpr size_t END = al(MIXER_END > MOE_END ? MIXER_END : MOE_END);
};

struct Params {
  const float* in[40];
  float* out;
  unsigned char* ws;
};
enum { I_X = 0, I_C, I_CTX, I_CCTX, I_ADAW, I_ADAB, I_WIN, I_CONVW, I_CONVB, I_DTBIAS, I_ALOG, I_SSDD, I_SSDNW, I_MU, I_W0, I_W2, I_A0, I_A2,
       I_G2, I_KKW, I_KAW, I_RK, I_LNXW, I_LNXB, I_GU, I_GB, I_GNW, I_WOUT, I_LN1W, I_LN1B, I_LN2W, I_LN2B, I_RW, I_RB, I_EW1, I_EW3, I_EW2,
       I_SW1, I_SW3, I_SW2 };

#define PH_SMEM 47104
#define SM_PRE (PH_SMEM)
#define SM_TAB (PH_SMEM + 1024)
#define SM_BAR (PH_SMEM + 2032)
#ifdef HIPEMU
#define INP(i) (p.in[i])
#define LAUNDER(x)
#define TIDX ((int)threadIdx.x)
#define BIDX ((int)blockIdx.x)
#else
extern __shared__ __align__(16) unsigned char smem_dyn[];
DEVFN const float* inp_lds(int i) {
  const volatile unsigned* t = (const volatile unsigned*)(smem_dyn + SM_TAB) + 2 * i;
  unsigned lo = __builtin_amdgcn_readfirstlane(t[0]), hi = __builtin_amdgcn_readfirstlane(t[1]);
  return (const float*)(((unsigned long long)hi << 32) | lo);
}
#define INP(i) inp_lds(i)
#define LAUNDER(x) asm volatile("" : "+s"(x))
DEVFN int tidx_() { int t = threadIdx.x; asm volatile("" : "+v"(t)); return t; }
DEVFN int bidx_() { int b = blockIdx.x; asm volatile("" : "+s"(b)); return b; }
#define TIDX tidx_()
#define BIDX bidx_()
#endif
#ifndef HIPEMU
#define XB_TMO      128
#define XB_XCNT(j)  (256  + 64 * (j))
#define XB_XSUB(j)  (1280 + 64 * (j))
#define XB_XGEN(j)  (2304 + 64 * (j))
#define XB_TOP      3328
#define XB_TOPGEN   3392
#define XCD_BAR_WORDS 3456
#define XB_SPIN_CAP (1u << 22)
#define LAS __attribute__((address_space(3)))
__device__ __forceinline__ unsigned xb_ld(unsigned* p)              { return __hip_atomic_load(p, __ATOMIC_RELAXED, __HIP_MEMORY_SCOPE_AGENT); }
__device__ __forceinline__ unsigned xb_add(unsigned* p, unsigned v) { return __hip_atomic_fetch_add(p, v, __ATOMIC_RELAXED, __HIP_MEMORY_SCOPE_AGENT); }
__device__ __forceinline__ unsigned xb_xcc_id() { return (unsigned)__builtin_amdgcn_s_getreg((3 << 11) | 20) & 0xFu; }
#define XB_SPIN(cond, bar) do { unsigned _sp = 0; while (cond) { __builtin_amdgcn_s_sleep(1); \
    if ((++_sp & 255u) == 0u) { if (xb_ld(&(bar)[XB_TMO])) break; if (_sp > XB_SPIN_CAP) { atomicAdd(&(bar)[XB_TMO], 1u); break; } } } } while (0)
struct XcdBarrier { unsigned* bar; unsigned x; volatile LAS unsigned* st; };
__device__ __forceinline__ XcdBarrier xcd_barrier_post(unsigned* bar, volatile LAS unsigned* st) {
    XcdBarrier b; b.bar = bar; b.x = xb_xcc_id(); b.st = st;
    if (threadIdx.x == 0) (void)xb_add(&bar[XB_XCNT(b.x)], 1u);
    return b;
}
__device__ __forceinline__ void xcd_barrier_complete(unsigned* bar, unsigned x, unsigned& nloc, unsigned& nx) {
    const unsigned G = gridDim.x * gridDim.y * gridDim.z;
    unsigned sum, cnt, mine, sp = 0u;
    for (;;) {
        sum = 0u; cnt = 0u; mine = 0u;
#pragma unroll
        for (unsigned j = 0; j < 16; ++j) { const unsigned c = xb_ld(&bar[XB_XCNT(j)]); sum += c; cnt += (c > 0u) ? 1u : 0u; mine = (j == x) ? c : mine; }
        if (sum == G) break;
        __builtin_amdgcn_s_sleep(1);
        if ((++sp & 255u) == 0u) { if (xb_ld(&bar[XB_TMO])) break; if (sp > XB_SPIN_CAP) { atomicAdd(&bar[XB_TMO], 1u); break; } }
    }
    nloc = mine > 0u ? mine : 1u; nx = cnt > 0u ? cnt : 1u;
}
__device__ __forceinline__ void xcd_barrier(const XcdBarrier& b) {
    asm volatile("s_waitcnt vmcnt(0)" ::: "memory");
    __syncthreads();
    if (threadIdx.x == 0) {
        unsigned* bar = b.bar;
        __builtin_amdgcn_s_waitcnt(0);
        unsigned nloc = b.st[0], nx = b.st[1];
        if (nloc == 0u) { xcd_barrier_complete(bar, b.x, nloc, nx); b.st[0] = nloc; b.st[1] = nx; }
        const unsigned old = xb_add(&bar[XB_XSUB(b.x)], 1u);
        const unsigned gen = old / nloc;
        if (old + 1u == (gen + 1u) * nloc) {
            __builtin_amdgcn_fence(__ATOMIC_RELEASE, "agent");
            asm volatile("s_waitcnt vmcnt(0)" ::: "memory");
            const unsigned og = xb_add(&bar[XB_TOP], 1u);
            const unsigned tg = og / nx;
            if (og + 1u == (tg + 1u) * nx) xb_add(&bar[XB_TOPGEN], 1u);
            else XB_SPIN(xb_ld(&bar[XB_TOPGEN]) == tg, bar);
            __builtin_amdgcn_fence(__ATOMIC_ACQUIRE, "agent");
            xb_add(&bar[XB_XGEN(b.x)], 1u);
            asm volatile("s_waitcnt vmcnt(0)" ::: "memory");
        } else {
            XB_SPIN(xb_ld(&bar[XB_XGEN(b.x)]) == gen, bar);
            __builtin_amdgcn_fence(__ATOMIC_ACQUIRE, "agent");
            asm volatile("s_waitcnt vmcnt(0)" ::: "memory");
        }
    }
    __syncthreads();
}
#endif

DEVFN int tokmap(int dir, int p) { return dir == 0 ? p : (p < CTX_ ? CTX_ - 1 - p : 2 * CTX_ + SEQ_ - 1 - p); }
DEVFN const float* tok_input_row(const Params& p, int tok) {
  int b = tok / T_, t = tok % T_;
  return t < CTX_ ? INP(I_CTX) + ((size_t)b * CTX_ + t) * D_ : INP(I_X) + ((size_t)b * SEQ_ + (t - CTX_)) * D_;
}
DEVFN int tok_modrow(int tok) { return (tok % T_) < CTX_ ? B_ : tok / T_; }

template <class ARow, class BRow, class Epi>
DEVFN void gemm_tile(unsigned char* smem, int K, ARow arow, BRow brow, Epi epi) {
  bf16_t* As = (bf16_t*)smem;
  bf16_t* Bs = As + 128 * LDT;
  const int tid = TIDX, lane = tid & 63, wave = tid >> 6, wr = wave >> 1, wc = wave & 1;
  const int g = lane >> 4, l15 = lane & 15;
  const int lr = tid >> 3, lc = (tid & 7) * 8;
  const bf16_t* ap[4];
  const bf16_t* bp[4];
#pragma unroll
  for (int i = 0; i < 4; ++i) { ap[i] = arow(lr + 32 * i); bp[i] = brow(lr + 32 * i); }
  f32x4 acc[4][4];
#pragma unroll
  for (int mi = 0; mi < 4; ++mi)
#pragma unroll
    for (int ni = 0; ni < 4; ++ni) acc[mi][ni] = f32x4{0.f, 0.f, 0.f, 0.f};
  u32x4 ra[4], rb[4];
#pragma unroll
  for (int i = 0; i < 4; ++i) { ra[i] = *(const u32x4*)(ap[i] + lc); rb[i] = *(const u32x4*)(bp[i] + lc); }
  for (int k0 = 0; k0 < K; k0 += 64) {
    __syncthreads();
#pragma unroll
    for (int i = 0; i < 4; ++i) { *(u32x4*)(As + (lr + 32 * i) * LDT + lc) = ra[i]; *(u32x4*)(Bs + (lr + 32 * i) * LDT + lc) = rb[i]; }
    __syncthreads();
    if (k0 + 64 < K) {
#pragma unroll
      for (int i = 0; i < 4; ++i) { ra[i] = *(const u32x4*)(ap[i] + k0 + 64 + lc); rb[i] = *(const u32x4*)(bp[i] + k0 + 64 + lc); }
    }
#pragma unroll
    for (int kk = 0; kk < 2; ++kk) {
      bf16x8 af[4], bfr[4];
#pragma unroll
      for (int mi = 0; mi < 4; ++mi) af[mi] = *(const bf16x8*)(As + (wr * 64 + mi * 16 + l15) * LDT + kk * 32 + g * 8);
#pragma unroll
      for (int ni = 0; ni < 4; ++ni) bfr[ni] = *(const bf16x8*)(Bs + (wc * 64 + ni * 16 + l15) * LDT + kk * 32 + g * 8);
#pragma unroll
      for (int mi = 0; mi < 4; ++mi)
#pragma unroll
        for (int ni = 0; ni < 4; ++ni) acc[mi][ni] = MFMA16(af[mi], bfr[ni], acc[mi][ni]);
    }
  }
  epi(acc, wr, wc, g, l15);
}

DEVFN void cvt_tile(unsigned char* smem, const float* src, int K, int N, int k0, int n0, bf16_t* dst, int ldd, int mode) {
  float* s = (float*)smem;
  const int tid = TIDX;
  __syncthreads();
  for (int e = tid; e < 64 * 64; e += 256) { int kk = e >> 6, nn = e & 63; s[kk * 65 + nn] = (n0 + nn < N) ? src[(size_t)(k0 + kk) * N + n0 + nn] : 0.f; }
  __syncthreads();
  for (int e = tid; e < 64 * 64; e += 256) { int nn = e >> 6, kk = e & 63; int n = n0 + nn;
    if (n < N) { int row = mode == 0 ? n : ((n >> 4) * 32 + (n & 15) + (mode == 2 ? 16 : 0)); dst[(size_t)row * ldd + k0 + kk] = f2bf(s[kk * 65 + nn]); } }
}
DEVFN void convert_moe_weights(const Params& p, int l, unsigned char* smem, int bid, int nb) {
  bf16_t* w13 = (bf16_t*)(p.ws + Ws::W13);
  bf16_t* w2t = (bf16_t*)(p.ws + Ws::W2T);
  const int per_e = 192;
  for (int u = bid; u < 65 * per_e; u += nb) {
    int e = u / per_e, r = u % per_e, which = r / 64, t = r % 64;
    if (which < 2) {
      const float* src = e < 64 ? (which == 0 ? INP(I_EW1) : INP(I_EW3)) + ((size_t)l * 64 + e) * 1024 * 256 : (which == 0 ? INP(I_SW1) : INP(I_SW3)) + (size_t)l * 1024 * 256;
      cvt_tile(smem, src, 1024, 256, (t >> 2) * 64, (t & 3) * 64, w13 + (size_t)e * 512 * 1024, 1024, which == 0 ? 1 : 2);
    } else {
      const float* src = e < 64 ? INP(I_EW2) + ((size_t)l * 64 + e) * 256 * 1024 : INP(I_SW2) + (size_t)l * 256 * 1024;
      cvt_tile(smem, src, 256, 1024, (t >> 4) * 64, (t & 15) * 64, w2t + (size_t)e * 1024 * 256, 256, 0);
    }
  }
}
DEVFN void phase0(const Params& p, unsigned char* smem) {
  const int tid = TIDX;
  float* modp = (float*)(p.ws + Ws::MODP);
  for (int u = BIDX; u < DEPTH_ * 24 * 16; u += gridDim.x) {
    int l = u / (24 * 16), jb = (u / 16) % 24, ks = u % 16;
    float* sc = (float*)smem;
    __syncthreads();
    for (int e = tid; e < NR_ * 64; e += 256) { int r = e / 64, i = ks * 64 + (e % 64); float cv = r < B_ ? INP(I_C)[(size_t)r * D_ + i] : INP(I_CCTX)[i]; sc[e] = siluf_(cv); }
    __syncthreads();
    int j = jb * 256 + tid;
    float acc[NR_];
#pragma unroll
    for (int r = 0; r < NR_; ++r) acc[r] = 0.f;
    const float* w = INP(I_ADAW) + ((size_t)l * D_ + ks * 64) * NMOD_ + j;
#pragma unroll 4
    for (int i = 0; i < 64; ++i) { float wv = w[(size_t)i * NMOD_];
#pragma unroll
      for (int r = 0; r < NR_; ++r) acc[r] += sc[r * 64 + i] * wv; }
#pragma unroll
    for (int r = 0; r < NR_; ++r) modp[(((size_t)ks * DEPTH_ + l) * NR_ + r) * NMOD_ + j] = acc[r];
  }
  bf16_t* win = (bf16_t*)(p.ws + Ws::WIN);
  bf16_t* wout = (bf16_t*)(p.ws + Ws::WOUT);
  for (int u = BIDX; u < DEPTH_ * 16 * 55; u += gridDim.x) {
    int l = u / (16 * 55), r = u % (16 * 55);
    cvt_tile(smem, INP(I_WIN) + (size_t)l * 1024 * NIN_, 1024, NIN_, (r / 55) * 64, (r % 55) * 64, win + (size_t)l * NIN_ * 1024, 1024, 0);
  }
  for (int u = BIDX; u < DEPTH_ * 256; u += gridDim.x) {
    int l = u / 256, r = u % 256;
    cvt_tile(smem, INP(I_WOUT) + (size_t)l * 1024 * 1024, 1024, 1024, (r / 16) * 64, (r % 16) * 64, wout + (size_t)l * 1024 * 1024, 1024, 0);
  }
  float* rwt = (float*)(p.ws + Ws::RWT);
  for (int u = BIDX * 256 + tid; u < DEPTH_ * 64 * 1024; u += gridDim.x * 256) {
    int l = u / (64 * 1024), e = (u / 1024) % 64, i = u % 1024;
    rwt[u] = INP(I_RW)[((size_t)l * 1024 + i) * 64 + e];
  }
}

DEVFN void phase0b(const Params& p) {
  float* mod = (float*)(p.ws + Ws::MOD); const float* modp = (const float*)(p.ws + Ws::MODP);
  for (int u = BIDX * 256 + TIDX; u < DEPTH_ * NR_ * NMOD_; u += gridDim.x * 256) {
    int l = u / (NR_ * NMOD_), j = u % NMOD_;
    float s = INP(I_ADAB)[(size_t)l * NMOD_ + j];
    for (int ks = 0; ks < 16; ++ks) s += modp[(size_t)ks * DEPTH_ * NR_ * NMOD_ + u];
    mod[u] = s;
  }
}

DEVFN void row_stats(const float (&v)[16], float& mean, float& rstd) {
  float s = 0.f;
#pragma unroll
  for (int i = 0; i < 16; ++i) s += v[i];
  mean = wave_sum(s) * (1.f / 1024.f);
  float q = 0.f;
#pragma unroll
  for (int i = 0; i < 16; ++i) { float d = v[i] - mean; q += d * d; }
  rstd = rsqrtf(wave_sum(q) * (1.f / 1024.f) + 1e-5f);
}
DEVFN void load_row16(const float* row, int lane, float (&v)[16]) {
#pragma unroll
  for (int j = 0; j < 4; ++j) { float4 t = *(const float4*)(row + lane * 4 + 256 * j); v[4 * j] = t.x; v[4 * j + 1] = t.y; v[4 * j + 2] = t.z; v[4 * j + 3] = t.w; }
}
DEVFN void moe_residual_row(const Params& p, int lp, int tok, int lane, float (&xv)[16]) {
  const float* mod = (const float*)(p.ws + Ws::MOD) + ((size_t)lp * NR_ + tok_modrow(tok)) * NMOD_;
  const bf16_t* yb = (const bf16_t*)(p.ws + Ws::YBUF) + (size_t)tok * NSLOT * 1024;
  float f[16];
#pragma unroll
  for (int i = 0; i < 16; ++i) f[i] = 0.f;
  for (int s = 0; s < NSLOT; ++s) {
#pragma unroll
    for (int j = 0; j < 4; ++j) { uint2 t = *(const uint2*)(yb + (size_t)s * 1024 + lane * 4 + 256 * j);
      f[4 * j] += bf2f((bf16_t)(t.x & 0xFFFF)); f[4 * j + 1] += bf2f((bf16_t)(t.x >> 16)); f[4 * j + 2] += bf2f((bf16_t)(t.y & 0xFFFF)); f[4 * j + 3] += bf2f((bf16_t)(t.y >> 16)); }
  }
  float g2[16], w[16], b[16];
  load_row16(mod + 5 * 1024, lane, g2);
  load_row16(INP(I_LN2W) + (size_t)lp * 1024, lane, w);
  load_row16(INP(I_LN2B) + (size_t)lp * 1024, lane, b);
#pragma unroll
  for (int i = 0; i < 16; ++i) xv[i] = ALPHA_ * xv[i] + g2[i] * f[i];
  float mean, rstd;
  row_stats(xv, mean, rstd);
#pragma unroll
  for (int i = 0; i < 16; ++i) xv[i] = (xv[i] - mean) * rstd * w[i] + b[i];
}
DEVFN void phase1(const Params& p, int l) {
  const int lane = TIDX & 63, wave = TIDX >> 6;
  float* X = (float*)(p.ws + Ws::X);
  bf16_t* U = (bf16_t*)(p.ws + Ws::U);
  for (int tok = BIDX * 4 + wave; tok < NT_; tok += gridDim.x * 4) {
    float xv[16];
    if (l == 0) load_row16(tok_input_row(p, tok), lane, xv);
    else { load_row16(X + (size_t)tok * 1024, lane, xv); moe_residual_row(p, l - 1, tok, lane, xv); }
#pragma unroll
    for (int j = 0; j < 4; ++j) *(float4*)(X + (size_t)tok * 1024 + lane * 4 + 256 * j) = make_float4(xv[4 * j], xv[4 * j + 1], xv[4 * j + 2], xv[4 * j + 3]);
    const float* mod = (const float*)(p.ws + Ws::MOD) + ((size_t)l * NR_ + tok_modrow(tok)) * NMOD_;
    float sh[16], sc[16], mean, rstd;
    load_row16(mod, lane, sh);
    load_row16(mod + 1024, lane, sc);
    row_stats(xv, mean, rstd);
#pragma unroll
    for (int j = 0; j < 4; ++j) {
      float u0 = (xv[4 * j] - mean) * rstd * (1.f + sc[4 * j]) + sh[4 * j], u1 = (xv[4 * j + 1] - mean) * rstd * (1.f + sc[4 * j + 1]) + sh[4 * j + 1];
      float u2 = (xv[4 * j + 2] - mean) * rstd * (1.f + sc[4 * j + 2]) + sh[4 * j + 2], u3 = (xv[4 * j + 3] - mean) * rstd * (1.f + sc[4 * j + 3]) + sh[4 * j + 3];
      *(uint2*)(U + (size_t)tok * 1024 + lane * 4 + 256 * j) = make_uint2((unsigned)f2bf(u0) | ((unsigned)f2bf(u1) << 16), (unsigned)f2bf(u2) | ((unsigned)f2bf(u3) << 16));
    }
  }
}
DEVFN void phase_final(const Params& p) {
  const int lane = TIDX & 63, wave = TIDX >> 6;
  const float* X = (const float*)(p.ws + Ws::X);
  for (int r = BIDX * 4 + wave; r < B_ * SEQ_; r += gridDim.x * 4) {
    int b = r / SEQ_, s = r % SEQ_, tok = b * T_ + CTX_ + s;
    float xv[16];
    load_row16(X + (size_t)tok * 1024, lane, xv);
    moe_residual_row(p, DEPTH_ - 1, tok, lane, xv);
#pragma unroll
    for (int j = 0; j < 4; ++j) *(float4*)(p.out + (size_t)r * 1024 + lane * 4 + 256 * j) = make_float4(xv[4 * j], xv[4 * j + 1], xv[4 * j + 2], xv[4 * j + 3]);
  }
}

DEVFN void phase2(const Params& p, int l, unsigned char* smem) {
  const bf16_t* U = (const bf16_t*)(p.ws + Ws::U);
  const bf16_t* W = (const bf16_t*)(p.ws + Ws::WIN) + (size_t)l * NIN_ * 1024;
  bf16_t* ZX = (bf16_t*)(p.ws + Ws::ZX);
  const int nct = (NIN_ + 127) / 128;
  for (int u = BIDX; u < (NT_ / 128) * nct; u += gridDim.x) {
    int rt = u / nct, ct = u % nct;
    gemm_tile(smem, 1024,
      [&](int r) { return U + (size_t)(rt * 128 + r) * 1024; },
      [&](int r) { int n = ct * 128 + r; return n < NIN_ ? W + (size_t)n * 1024 : (const bf16_t*)(p.ws + Ws::ZROW); },
      [&](f32x4 (&acc)[4][4], int wr, int wc, int g, int l15) {
#pragma unroll
        for (int mi = 0; mi < 4; ++mi)
#pragma unroll
          for (int ni = 0; ni < 4; ++ni) { int col = ct * 128 + wc * 64 + ni * 16 + l15;
            if (col < NIN_) {
#pragma unroll
              for (int i = 0; i < 4; ++i) { int row = rt * 128 + wr * 64 + mi * 16 + 4 * g + i; ZX[(size_t)row * NIN_ + col] = f2bf(acc[mi][ni][i]); } } }
      });
  }
}

DEVFN float zxv(const bf16_t* ZX, int tok, int col) { return bf2f(ZX[(size_t)tok * NIN_ + col]); }
struct Nbr { int n; int tok[4]; };
DEVFN Nbr shift_nbrs(int tok) {
  Nbr nb; int b = tok / T_, t = tok % T_;
  if (t < CTX_) { nb.n = 2; nb.tok[0] = t > 0 ? tok - 1 : -1; nb.tok[1] = t < CTX_ - 1 ? tok + 1 : -1; nb.tok[2] = -1; nb.tok[3] = -1; }
  else { int s = t - CTX_, row = s / 64, col = s % 64; nb.n = 4; nb.tok[0] = col > 0 ? tok - 1 : -1; nb.tok[1] = col < 63 ? tok + 1 : -1;
    nb.tok[2] = row > 0 ? tok - 64 : -1; nb.tok[3] = row < SEQ_ / 64 - 1 ? tok + 64 : -1; }
  (void)b; return nb;
}
DEVFN float shiftmix(const bf16_t* ZX, const float* mu, int tok, const Nbr& nb, int ch) {
  float z = zxv(ZX, tok, ORW + ch), o = z;
#pragma unroll
  for (int j = 0; j < 4; ++j) if (j < nb.n) { float v = nb.tok[j] >= 0 ? zxv(ZX, nb.tok[j], ORW + ch) : 0.f; o += mu[j * 1152 + ch] * (v - z); }
  return o;
}
#define P3_TT 4
DEVFN void phase3(const Params& p, int l, unsigned char* smem) {
  const int tid = TIDX;
  const bf16_t* ZX = (const bf16_t*)(p.ws + Ws::ZX);
  bf16_t* XBC = (bf16_t*)(p.ws + Ws::XBC); float* DTB = (float*)(p.ws + Ws::DTB);
  bf16_t* RR = (bf16_t*)(p.ws + Ws::RR); bf16_t* VV = (bf16_t*)(p.ws + Ws::VV); bf16_t* KKb = (bf16_t*)(p.ws + Ws::KK);
  float* LWp = (float*)(p.ws + Ws::LW); bf16_t* KD = (bf16_t*)(p.ws + Ws::KD); bf16_t* BD = (bf16_t*)(p.ws + Ws::BD);
  float* GATE = (float*)(p.ws + Ws::GATE); float* LA = (float*)(p.ws + Ws::LA);
  const float* convw = INP(I_CONVW) + (size_t)l * 3 * 1024; const float* convb = INP(I_CONVB) + (size_t)l * 1024;
  const float* mu = INP(I_MU) + (size_t)l * 4 * 1152;
  float* li = (float*)smem;
  const float kkw = INP(I_KKW)[(size_t)l * 256 + tid], kaw = INP(I_KAW)[(size_t)l * 256 + tid];
  for (int tile = BIDX; tile < NT_ / P3_TT; tile += gridDim.x) {
    float* kls = li + P3_TT * 416;
    float* knls = kls + P3_TT * 256;
    __syncthreads();
    {
      const int tok0 = tile * P3_TT, t0 = tok0 % T_, bb = tok0 / T_;
      const bool segstart = (t0 == 0 || t0 == CTX_), segend = (t0 + 3 == CTX_ - 1 || t0 + 3 == T_ - 1);
      bf16_t* XBCT = (bf16_t*)(p.ws + Ws::XBCT) + ((size_t)(bb * NC128 + t0 / 128) * 768) * 128 + (t0 % 128);
#pragma unroll
      for (int j = 0; j < 4; ++j) { const int c = tid + 256 * j;
        float z[6];
#pragma unroll
        for (int q = 0; q < 6; ++q) z[q] = ((q == 0 && segstart) || (q == 5 && segend)) ? 0.f : zxv(ZX, tok0 + q - 1, OXBC + c);
        const float w0 = convw[c], w1 = convw[1024 + c], w2 = convw[2048 + c], cb = convb[c];
        bf16_t y[4];
#pragma unroll
        for (int tt = 0; tt < 4; ++tt) { y[tt] = f2bf(siluf_(cb + w0 * z[tt] + w1 * z[tt + 1] + w2 * z[tt + 2])); XBC[(size_t)(tok0 + tt) * 1024 + c] = y[tt]; }
        if (c < 768) *(uint2*)(XBCT + (size_t)c * 128) = make_uint2((unsigned)y[0] | ((unsigned)y[1] << 16), (unsigned)y[2] | ((unsigned)y[3] << 16)); }
      bf16_t* VTp = (bf16_t*)(p.ws + Ws::VT) + ((size_t)(bb * NC64 + t0 / 64) * 256 + tid) * 64 + (t0 % 64);
      const bf16_t v0 = ZX[(size_t)tok0 * NIN_ + OGV + tid], v1 = ZX[(size_t)(tok0 + 1) * NIN_ + OGV + tid], v2 = ZX[(size_t)(tok0 + 2) * NIN_ + OGV + tid], v3 = ZX[(size_t)(tok0 + 3) * NIN_ + OGV + tid];
      *(uint2*)VTp = make_uint2((unsigned)v0 | ((unsigned)v1 << 16), (unsigned)v2 | ((unsigned)v3 << 16));
    }
#pragma unroll 1
    for (int tt = 0; tt < P3_TT; ++tt) {
      const int tok = tile * P3_TT + tt;
      if (tid < 16) DTB[(size_t)tok * 16 + tid] = softplusf_(zxv(ZX, tok, ODT + tid) + INP(I_DTBIAS)[(size_t)l * 16 + tid]);
      const Nbr nb = shift_nbrs(tok);
      float r = shiftmix(ZX, mu, tok, nb, tid), k = shiftmix(ZX, mu, tok, nb, 256 + tid), v = shiftmix(ZX, mu, tok, nb, 512 + tid);
      RR[(size_t)tok * 256 + tid] = f2bf(r); VV[(size_t)tok * 256 + tid] = f2bf(v);
      float kq = k * kkw, nrm = sqrtf(wave_sum(kq * kq));
      const float kn = kq / fmaxf(nrm, 1e-12f);
      kls[tt * 256 + tid] = k; knls[tt * 256 + tid] = kn;
      KKb[(size_t)tok * 256 + tid] = f2bf(kn);
      { float x = shiftmix(ZX, mu, tok, nb, 768 + tid); li[tt * 416 + tid] = tid < 128 ? tanhf(x) : x; }
      if (tid < 128) li[tt * 416 + 256 + tid] = sigmoidf_(shiftmix(ZX, mu, tok, nb, 1024 + tid));
      if (tid >= 128 && tid < 160) li[tt * 416 + 384 + (tid - 128)] = zxv(ZX, tok, OGD + (tid - 128));
    }
    __syncthreads();
    float xf[P3_TT], xb[P3_TT], af[P3_TT], ab[P3_TT], gt[P3_TT];
    { const float w0f = INP(I_W0)[(size_t)l * 512 + tid], w0b = INP(I_W0)[(size_t)l * 512 + 256 + tid];
      const float a0f = INP(I_A0)[(size_t)l * 512 + tid], a0b = INP(I_A0)[(size_t)l * 512 + 256 + tid];
#pragma unroll
      for (int tt = 0; tt < P3_TT; ++tt) { xf[tt] = w0f; xb[tt] = w0b; af[tt] = a0f; ab[tt] = a0b; gt[tt] = 0.f; } }
    const float* w2 = INP(I_W2) + (size_t)l * 2 * 64 * 256; const float* a2 = INP(I_A2) + (size_t)l * 2 * 64 * 256; const float* g2 = INP(I_G2) + (size_t)l * 128 * 256;
#pragma unroll 2
    for (int i = 0; i < 64; ++i) {
      float wf = w2[i * 256 + tid], wb = w2[(64 + i) * 256 + tid], af2 = a2[i * 256 + tid], ab2 = a2[(64 + i) * 256 + tid];
#pragma unroll
      for (int tt = 0; tt < P3_TT; ++tt) { xf[tt] += li[tt * 416 + i] * wf; xb[tt] += li[tt * 416 + 64 + i] * wb; af[tt] += li[tt * 416 + 128 + i] * af2; ab[tt] += li[tt * 416 + 192 + i] * ab2; }
    }
#pragma unroll 2
    for (int i = 0; i < 128; ++i) { float gw = g2[i * 256 + tid];
#pragma unroll
      for (int tt = 0; tt < P3_TT; ++tt) gt[tt] += li[tt * 416 + 256 + i] * gw; }
#pragma unroll
    for (int tt = 0; tt < P3_TT; ++tt) {
      const size_t o = (size_t)(tile * P3_TT + tt) * 256 + tid, o1 = (size_t)NT_ * 256 + o;
      float aF = sigmoidf_(af[tt]), aB = sigmoidf_(ab[tt]);
      LWp[o] = -0.6065306597126334f * sigmoidf_(xf[tt]); LWp[o1] = -0.6065306597126334f * sigmoidf_(xb[tt]);
      const float kr_ = kls[tt * 256 + tid], kn_ = knls[tt * 256 + tid];
      KD[o] = f2bf(kr_ * (1.f + (aF - 1.f) * kaw)); KD[o1] = f2bf(kr_ * (1.f + (aB - 1.f) * kaw));
      BD[o] = f2bf(kn_ * aF); BD[o1] = f2bf(kn_ * aB);
      GATE[o] = gt[tt];
    }
    { const int d = tid >> 7, c = tid & 127; const float* gu = INP(I_GU) + ((size_t)l * 2 + d) * 16 * 128; const float gb = INP(I_GB)[((size_t)l * 2 + d) * 128 + c];
      float guw[16];
#pragma unroll
      for (int i = 0; i < 16; ++i) guw[i] = gu[i * 128 + c];
#pragma unroll
      for (int tt = 0; tt < P3_TT; ++tt) { float s = gb;
#pragma unroll
        for (int i = 0; i < 16; ++i) s += li[tt * 416 + 384 + d * 16 + i] * guw[i];
        LA[((size_t)d * NT_ + tile * P3_TT + tt) * 128 + c] = logsigmoidf_(s) * (1.f / 16.f); } }
  }
}

DEVFN bf16x8 ld8(const bf16_t* p) { return *(const bf16x8*)p; }
typedef short bf16x4v __attribute__((ext_vector_type(4)));
DEVFN bf16x4v cvt4(f32x4 v) { return bf16x4v{(short)f2bf(v[0]), (short)f2bf(v[1]), (short)f2bf(v[2]), (short)f2bf(v[3])}; }
DEVFN bf16x8 cat44(bf16x4v a, bf16x4v b) { return bf16x8{a[0], a[1], a[2], a[3], b[0], b[1], b[2], b[3]}; }
DEVFN bf16x4v ld4(const bf16_t* p) { return *(const bf16x4v*)p; }
DEVFN int rm_off(int i, int k) { return i * 64 + ((((k >> 3) ^ (i & 7)) << 3) | (k & 7)); }
#define RW_WAVE_LDS 11264
DEVFN void rwkv_chunk(const Params& p, int unit_base, unsigned char* smem) {
  const int tid = TIDX, lane = tid & 63, wave = tid >> 6, q = lane >> 4, l15 = lane & 15;
  const int unit = unit_base + wave;
  const int c = unit % NC16, h = (unit / NC16) & 3, dir = (unit / (NC16 * 4)) & 1, b = unit / (NC16 * 8);
  bf16_t* big = (bf16_t*)(smem + wave * RW_WAVE_LDS);
  unsigned char* small = smem + wave * RW_WAVE_LDS + 8192;
  float* AbF = (float*)small;
  bf16_t* TN = (bf16_t*)(small + 1024);
  bf16_t* AK = TN + 256; bf16_t* RB = AK + 256; bf16_t* RK = RB + 256;
  const bf16_t* RRg = (const bf16_t*)(p.ws + Ws::RR); const bf16_t* VVg = (const bf16_t*)(p.ws + Ws::VV); const bf16_t* KKg = (const bf16_t*)(p.ws + Ws::KK);
  const bf16_t* KDg = (const bf16_t*)(p.ws + Ws::KD) + (size_t)dir * NT_ * 256; const bf16_t* BDg = (const bf16_t*)(p.ws + Ws::BD) + (size_t)dir * NT_ * 256;
  const float* LWg = (const float*)(p.ws + Ws::LW) + (size_t)dir * NT_ * 256;
  float kkm[16], vv[16], bneg[16], kneg[16];
  float run = 0.f;
  __syncthreads();
#pragma unroll
  for (int i = 0; i < 16; ++i) {
    const size_t o = (size_t)(b * T_ + tokmap(dir, c * 16 + i)) * 256 + h * 64 + lane;
    const float lw = LWg[o], r = bf2f(RRg[o]), k = bf2f(KDg[o]), v = bf2f(VVg[o]), kk = bf2f(KKg[o]), bb = bf2f(BDg[o]);
    const float e_ex = expf(run); run += lw; const float e_in = expf(run), e_neg = expf(-run);
    kkm[i] = kk * e_ex; vv[i] = v; bneg[i] = bb * e_neg; kneg[i] = k * e_neg;
    big[rm_off(i, lane)] = f2bf(kkm[i]); big[1024 + rm_off(i, lane)] = f2bf(r * e_in);
    big[2048 + rm_off(i, lane)] = f2bf(bneg[i]); big[3072 + rm_off(i, lane)] = f2bf(kneg[i]);
  }
  const float WC = expf(run);
  __syncthreads();
  f32x4 ab = f32x4{0.f, 0.f, 0.f, 0.f}, ak = ab, rb = ab, rk = ab;
#pragma unroll
  for (int s2 = 0; s2 < 2; ++s2) { const int ch = ((4 * s2 + q) ^ (l15 & 7)) << 3;
    const bf16x8 a_kk = ld8(big + l15 * 64 + ch), a_r = ld8(big + 1024 + l15 * 64 + ch), b_b = ld8(big + 2048 + l15 * 64 + ch), b_k = ld8(big + 3072 + l15 * 64 + ch);
    ab = MFMA16(a_kk, b_b, ab); ak = MFMA16(a_kk, b_k, ak); rb = MFMA16(a_r, b_b, rb); rk = MFMA16(a_r, b_k, rk); }
  f32x4 gacc[4];
#pragma unroll
  for (int nk = 0; nk < 4; ++nk)
#pragma unroll
    for (int r = 0; r < 4; ++r) gacc[nk][r] = bf2f(big[1024 + rm_off(4 * q + r, 16 * nk + l15)]);
  __syncthreads();
#pragma unroll
  for (int r = 0; r < 4; ++r) { const int i = 4 * q + r, j = l15;
    AbF[i * 16 + j] = j < i ? ab[r] : 0.f; AK[i * 16 + j] = f2bf(j < i ? ak[r] : 0.f);
    RB[i * 16 + j] = f2bf(j <= i ? rb[r] : 0.f); RK[i * 16 + j] = f2bf(j <= i ? rk[r] : 0.f); }
  { bf16_t* KKMT = big; bf16_t* VTT = big + 1024; bf16_t* BHT = big + 2048; bf16_t* KHT = big + 3072;
#pragma unroll
    for (int i = 0; i < 16; ++i) { KKMT[lane * 16 + i] = f2bf(kkm[i]); VTT[lane * 16 + i] = f2bf(vv[i]); BHT[lane * 16 + i] = f2bf(bneg[i] * WC); KHT[lane * 16 + i] = f2bf(kneg[i] * WC); } }
  __syncthreads();
  { float t[16];
#pragma unroll
    for (int i = 0; i < 16; ++i) { float acc = (i == l15) ? 1.f : 0.f;
#pragma unroll
      for (int j = 0; j < i; ++j) acc -= AbF[i * 16 + j] * t[j];
      t[i] = acc; }
    if (q == 0) {
#pragma unroll
      for (int i = 0; i < 16; ++i) TN[i * 16 + l15] = f2bf(-t[i]); } }
  __syncthreads();
  const size_t ci = (size_t)((b * 2 + dir) * 4 + h) * NC16 + c;
  bf16_t* MLg = (bf16_t*)(p.ws + Ws::RML) + ci * 4096; bf16_t* Ng = (bf16_t*)(p.ws + Ws::RNS) + ci * 4096;
  bf16_t* Gg = (bf16_t*)(p.ws + Ws::RG) + ci * 1024; float* Y0g = (float*)(p.ws + Ws::RY0) + ci * 1024;
  const bf16x4v a_T = ld4(TN + l15 * 16 + 4 * q), a_Ak = ld4(AK + l15 * 16 + 4 * q), a_Rb = ld4(RB + l15 * 16 + 4 * q), a_Rk = ld4(RK + l15 * 16 + 4 * q);
  const f32x4 z4 = f32x4{0.f, 0.f, 0.f, 0.f};
  bf16x4v vfr[4], qfr[4], pfr[4];
#pragma unroll
  for (int n = 0; n < 4; ++n) {
    vfr[n] = ld4(big + 1024 + (16 * n + l15) * 16 + 4 * q);
    const f32x4 akv = MFMA16K16(a_Ak, vfr[n], z4);
    qfr[n] = cvt4(MFMA16K16(a_T, cvt4(akv), z4));
    pfr[n] = cvt4(MFMA16K16(a_T, ld4(big + (16 * n + l15) * 16 + 4 * q), z4)); }
  const bf16x8 a_RbRk = cat44(a_Rb, a_Rk);
#pragma unroll
  for (int n = 0; n < 4; ++n) {
    const f32x4 g = MFMA16K16(a_Rb, pfr[n], gacc[n]);
    const f32x4 y0 = MFMA16(a_RbRk, cat44(qfr[n], vfr[n]), z4);
#pragma unroll
    for (int r = 0; r < 4; ++r) { Gg[(4 * q + r) * 64 + 16 * n + l15] = f2bf(g[r]); Y0g[(4 * q + r) * 64 + 16 * n + l15] = y0[r]; } }
#pragma unroll
  for (int mk = 0; mk < 4; ++mk) {
    const bf16x4v a_B = ld4(big + 2048 + (16 * mk + l15) * 16 + 4 * q), a_K = ld4(big + 3072 + (16 * mk + l15) * 16 + 4 * q);
    const bf16x8 a_BK = cat44(a_B, a_K);
#pragma unroll
    for (int n = 0; n < 4; ++n) {
      const f32x4 m = MFMA16K16(a_B, pfr[n], z4);
      const f32x4 nn = MFMA16(a_BK, cat44(qfr[n], vfr[n]), z4);
#pragma unroll
      for (int r = 0; r < 4; ++r) MLg[((mk * 2 + (n >> 1)) * 64 + (l15 >> 2) * 16 + 4 * q + r) * 8 + (n & 1) * 4 + (l15 & 3)] = f2bf(m[r]);
      *(bf16x4v*)(Ng + (n * 64 + lane) * 16 + mk * 4) = cvt4(nn); } }
  ((float*)(p.ws + Ws::RWC))[ci * 64 + ((lane >> 2) & 3) * 16 + (lane >> 4) * 4 + (lane & 3)] = WC;
}
struct RwStep { bf16x8 ml[4][2]; bf16x8 n[2]; float4 wc[4]; };
DEVFN void rw_load(RwStep& t, const bf16_t* MLg, const bf16_t* NSg, const float* WCg, int c, int lane, int q) {
#pragma unroll
  for (int mk = 0; mk < 4; ++mk) { t.ml[mk][0] = ld8(MLg + (size_t)c * 4096 + ((mk * 2 + 0) * 64 + lane) * 8); t.ml[mk][1] = ld8(MLg + (size_t)c * 4096 + ((mk * 2 + 1) * 64 + lane) * 8);
    t.wc[mk] = *(const float4*)(WCg + (size_t)c * 64 + q * 16 + mk * 4); }
  t.n[0] = ld8(NSg + (size_t)c * 4096 + lane * 16); t.n[1] = ld8(NSg + (size_t)c * 4096 + lane * 16 + 8);
}
DEVFN void rw_step(const RwStep& t, f32x4 (&S)[4], bf16_t* NSg, int c, int q, int l15) {
  bf16x4v sb[4];
#pragma unroll
  for (int mk = 0; mk < 4; ++mk) sb[mk] = cvt4(S[mk]);
  const bf16x8 bf0 = cat44(sb[0], sb[1]), bf1 = cat44(sb[2], sb[3]);
#pragma unroll
  for (int mk = 0; mk < 4; ++mk) {
    f32x4 acc;
    const float w4[4] = {t.wc[mk].x, t.wc[mk].y, t.wc[mk].z, t.wc[mk].w};
#pragma unroll
    for (int r = 0; r < 4; ++r) acc[r] = bf2f((bf16_t)t.n[mk >> 1][(mk & 1) * 4 + r]) + w4[r] * S[mk][r];
    acc = MFMA16(t.ml[mk][0], bf0, acc);
    acc = MFMA16(t.ml[mk][1], bf1, acc);
    S[mk] = acc; }
#pragma unroll
  for (int mk = 0; mk < 4; ++mk) *(bf16x4v*)(NSg + (size_t)c * 4096 + l15 * 64 + 16 * mk + 4 * q) = sb[mk];
}
DEVFN void rwkv_scan(const Params& p, int chain) {
  const int tid = TIDX, lane = tid & 63, wave = tid >> 6, q = lane >> 4, l15 = lane & 15;
  const bf16_t* MLg = (const bf16_t*)(p.ws + Ws::RML) + (size_t)chain * NC16 * 4096;
  bf16_t* NSg = (bf16_t*)(p.ws + Ws::RNS) + (size_t)chain * NC16 * 4096 + wave * 1024;
  const float* WCg = (const float*)(p.ws + Ws::RWC) + (size_t)chain * NC16 * 64;
  f32x4 S[4];
#pragma unroll
  for (int mk = 0; mk < 4; ++mk) S[mk] = f32x4{0.f, 0.f, 0.f, 0.f};
  RwStep t0, t1, t2;
  rw_load(t0, MLg, NSg, WCg, 0, lane, q);
  if (1 < NC16) rw_load(t1, MLg, NSg, WCg, 1, lane, q);
  for (int c = 0; c < NC16; c += 3) {
    if (c + 2 < NC16) rw_load(t2, MLg, NSg, WCg, c + 2, lane, q);
    rw_step(t0, S, NSg, c, q, l15);
    if (c + 1 < NC16) { if (c + 3 < NC16) rw_load(t0, MLg, NSg, WCg, c + 3, lane, q); rw_step(t1, S, NSg, c + 1, q, l15); }
    if (c + 2 < NC16) { if (c + 4 < NC16) rw_load(t1, MLg, NSg, WCg, c + 4, lane, q); rw_step(t2, S, NSg, c + 2, q, l15); }
  }
}
DEVFN void rwkv_out(const Params& p, int unit_base) {
  const int tid = TIDX, lane = tid & 63, wave = tid >> 6, q = lane >> 4, l15 = lane & 15;
  const int unit = unit_base + wave;
  const int c = unit % NC16, h = (unit / NC16) & 3, dir = (unit / (NC16 * 4)) & 1, b = unit / (NC16 * 8);
  const size_t ci = (size_t)((b * 2 + dir) * 4 + h) * NC16 + c;
  const bf16_t* Sg = (const bf16_t*)(p.ws + Ws::RNS) + ci * 4096; const bf16_t* Gg = (const bf16_t*)(p.ws + Ws::RG) + ci * 1024;
  const float* Y0g = (const float*)(p.ws + Ws::RY0) + ci * 1024;
  float* YR = (float*)(p.ws + Ws::YR) + (size_t)dir * NT_ * 256;
  const bf16x8 a0 = ld8(Gg + l15 * 64 + 8 * q), a1 = ld8(Gg + l15 * 64 + 32 + 8 * q);
#pragma unroll
  for (int n = 0; n < 4; ++n) {
    f32x4 acc;
#pragma unroll
    for (int r = 0; r < 4; ++r) acc[r] = Y0g[(4 * q + r) * 64 + 16 * n + l15];
    acc = MFMA16(a0, ld8(Sg + n * 1024 + l15 * 64 + 8 * q), acc);
    acc = MFMA16(a1, ld8(Sg + n * 1024 + l15 * 64 + 32 + 8 * q), acc);
#pragma unroll
    for (int r = 0; r < 4; ++r) YR[(size_t)(b * T_ + tokmap(dir, c * 16 + 4 * q + r)) * 256 + h * 64 + 16 * n + l15] = acc[r]; }
}
DEVFN int cscan(int dir, int co, int nctx, int nc) { return dir == 0 ? co : (co < nctx ? nctx - 1 - co : 2 * nctx + nc - 1 - co); }
DEVFN bf16x8 ld4x2(const bf16_t* p0, const bf16_t* p1) { bf16x4v a = *(const bf16x4v*)p0, b = *(const bf16x4v*)p1; return bf16x8{a[0], a[1], a[2], a[3], b[0], b[1], b[2], b[3]}; }

DEVFN void ssd_chunk_scalars(const Params& p, int l, int b, int co, int h, float* f) {
  const int tid = TIDX, d = tid >> 7, j = tid & 127;
  const float* DTB = (const float*)(p.ws + Ws::DTB);
  const float nega = -expf(INP(I_ALOG)[(size_t)l * 16 + d * 8 + h]);
  const float dt = DTB[(size_t)(b * T_ + co * 128 + j) * 16 + d * 8 + h];
  __syncthreads();
  f[256 + d * 128 + j] = dt;
  float* cur = f + d * 128; float* tmp = f + 512 + d * 128;
  cur[j] = dt * nega;
  __syncthreads();
  for (int off = 1; off < 128; off <<= 1) {
    float v = cur[j] + (j >= off ? cur[j - off] : 0.f);
    tmp[j] = v;
    __syncthreads();
    cur[j] = tmp[j];
    __syncthreads();
  }
}
DEVFN void ssd_states(const Params& p, int l, int unit, unsigned char* smem) {
  const int tid = TIDX, lane = tid & 63, wave = tid >> 6, q = lane >> 4, l15 = lane & 15;
  const int h = unit & 7, co = (unit >> 3) % NC128, b = unit / (8 * NC128), grp = h >> 2;
  float* f = (float*)smem;
  ssd_chunk_scalars(p, l, b, co, h, f);
  { const int d = tid >> 7, j = tid & 127; const float* cum = f + d * 128; const float dt = f[256 + d * 128 + j];
    float w = d == 0 ? expf(cum[127] - cum[j]) * dt : expf(j > 0 ? cum[j - 1] : 0.f) * dt;
    f[512 + d * 128 + j] = w; }
  __syncthreads();
  const bf16_t* XT = (const bf16_t*)(p.ws + Ws::XBCT) + (size_t)(b * NC128 + co) * 768 * 128;
  f32x4 acc[2][8];
#pragma unroll
  for (int d = 0; d < 2; ++d)
#pragma unroll
    for (int n = 0; n < 8; ++n) acc[d][n] = f32x4{0.f, 0.f, 0.f, 0.f};
#pragma unroll 1
  for (int s4 = 0; s4 < 4; ++s4) {
    const int j0 = s4 * 32 + q * 8;
    bf16x8 xa = ld8(XT + (size_t)(h * 64 + wave * 16 + l15) * 128 + j0), a0, a1;
#pragma unroll
    for (int jj = 0; jj < 8; ++jj) { float x = bf2f((bf16_t)xa[jj]); a0[jj] = (short)f2bf(x * f[512 + j0 + jj]); a1[jj] = (short)f2bf(x * f[640 + j0 + jj]); }
#pragma unroll
    for (int n = 0; n < 8; ++n) { bf16x8 bb = ld8(XT + (size_t)(512 + grp * 128 + n * 16 + l15) * 128 + j0);
      acc[0][n] = MFMA16(a0, bb, acc[0][n]); acc[1][n] = MFMA16(a1, bb, acc[1][n]); }
  }
#pragma unroll
  for (int d = 0; d < 2; ++d) {
    const int cs = cscan(d, co, CTX_ / 128, SEQ_ / 128);
    float* ST = (float*)(p.ws + Ws::SST) + ((size_t)((d * B_ + b) * NC128 + cs) * 8 + h) * 8192;
#pragma unroll
    for (int n = 0; n < 8; ++n)
#pragma unroll
      for (int r = 0; r < 4; ++r) ST[(wave * 16 + q * 4 + r) * 128 + n * 16 + l15] = acc[d][n][r];
    if (tid == 0) ((float*)(p.ws + Ws::SCD))[((size_t)(d * B_ + b) * NC128 + cs) * 8 + h] = expf(f[d * 128 + 127]);
  }
}
#define SSD_SB ((NC128 % 17) == 0 ? 17 : NC128)
DEVFN void ssd_scan(const Params& p, int gtid, int gthreads) {
  const float* __restrict__ ST = (const float*)(p.ws + Ws::SST); const float* __restrict__ CD = (const float*)(p.ws + Ws::SCD); bf16_t* __restrict__ HIN = (bf16_t*)(p.ws + Ws::HIN);
  for (int e = gtid; e < 2 * B_ * 8 * 8192; e += gthreads) {
    const int pd = e & 8191, h = (e >> 13) & 7, db = e >> 16;
    float hv = 0.f;
#pragma unroll 1
    for (int c0 = 0; c0 < NC128; c0 += SSD_SB) {
      float st[SSD_SB], cd[SSD_SB];
#pragma unroll
      for (int i = 0; i < SSD_SB; ++i) { st[i] = ST[((size_t)(db * NC128 + c0 + i) * 8 + h) * 8192 + pd]; cd[i] = CD[(size_t)(db * NC128 + c0 + i) * 8 + h]; }
#pragma unroll
      for (int i = 0; i < SSD_SB; ++i) { HIN[((size_t)(db * NC128 + c0 + i) * 8 + h) * 8192 + pd] = f2bf(hv); hv = hv * cd[i] + st[i]; }
    }
  }
}
DEVFN void ssd_out(const Params& p, int l, int unit, unsigned char* smem) {
  const int tid = TIDX, lane = tid & 63, wave = tid >> 6, q = lane >> 4, l15 = lane & 15;
  const int h = unit & 7, co = (unit >> 3) % NC128, b = unit / (8 * NC128), grp = h >> 2;
  float* f = (float*)smem;
  ssd_chunk_scalars(p, l, b, co, h, f);
  if (tid < 128) f[640 + tid] = f[128 + 127] - (tid > 0 ? f[128 + tid - 1] : 0.f);
  __syncthreads();
  const float* cum0 = f; const float* suf1 = f + 640; const float* dt0 = f + 256; const float* dt1 = f + 384;
  const bf16_t* XBC = (const bf16_t*)(p.ws + Ws::XBC) + (size_t)(b * T_ + co * 128) * 1024;
  const bf16_t* XT = (const bf16_t*)(p.ws + Ws::XBCT) + (size_t)(b * NC128 + co) * 768 * 128;
  const bf16_t* Cb = XBC + (size_t)(wave * 32 + l15) * 1024 + 768 + grp * 128 + q * 8;
  f32x4 y[4][2];
  { f32x4 o0[4][2], o1[4][2];
#pragma unroll
    for (int mp = 0; mp < 4; ++mp)
#pragma unroll
      for (int ni = 0; ni < 2; ++ni) { o0[mp][ni] = f32x4{0.f, 0.f, 0.f, 0.f}; o1[mp][ni] = f32x4{0.f, 0.f, 0.f, 0.f}; }
    const int cs0 = cscan(0, co, CTX_ / 128, SEQ_ / 128), cs1 = cscan(1, co, CTX_ / 128, SEQ_ / 128);
    const bf16_t* H0 = (const bf16_t*)(p.ws + Ws::HIN) + ((size_t)((0 * B_ + b) * NC128 + cs0) * 8 + h) * 8192;
    const bf16_t* H1 = (const bf16_t*)(p.ws + Ws::HIN) + ((size_t)((1 * B_ + b) * NC128 + cs1) * 8 + h) * 8192;
#pragma unroll 1
    for (int s4 = 0; s4 < 4; ++s4) { const bf16x8 c0 = ld8(Cb + s4 * 32), c1 = ld8(Cb + 16 * 1024 + s4 * 32);
#pragma unroll
      for (int mp = 0; mp < 4; ++mp) { bf16x8 h0 = ld8(H0 + (size_t)(mp * 16 + l15) * 128 + s4 * 32 + q * 8), h1 = ld8(H1 + (size_t)(mp * 16 + l15) * 128 + s4 * 32 + q * 8);
        o0[mp][0] = MFMA16(h0, c0, o0[mp][0]); o0[mp][1] = MFMA16(h0, c1, o0[mp][1]);
        o1[mp][0] = MFMA16(h1, c0, o1[mp][0]); o1[mp][1] = MFMA16(h1, c1, o1[mp][1]); } }
#pragma unroll
    for (int ni = 0; ni < 2; ++ni) { const int i = wave * 32 + ni * 16 + l15; const float e0 = expf(cum0[i]), e1 = expf(suf1[i]);
#pragma unroll
      for (int mp = 0; mp < 4; ++mp)
#pragma unroll
        for (int r = 0; r < 4; ++r) y[mp][ni][r] = e0 * o0[mp][ni][r] + e1 * o1[mp][ni][r]; } }
  bf16x8 mfr[4][2];
  { f32x4 g[8][2];
#pragma unroll
    for (int mj = 0; mj < 8; ++mj) { g[mj][0] = f32x4{0.f, 0.f, 0.f, 0.f}; g[mj][1] = f32x4{0.f, 0.f, 0.f, 0.f}; }
#pragma unroll 1
    for (int s4 = 0; s4 < 4; ++s4) { const bf16x8 c0 = ld8(Cb + s4 * 32), c1 = ld8(Cb + 16 * 1024 + s4 * 32);
#pragma unroll
      for (int mj = 0; mj < 8; ++mj) { bf16x8 bb = ld8(XBC + (size_t)(mj * 16 + l15) * 1024 + 512 + grp * 128 + s4 * 32 + q * 8);
        g[mj][0] = MFMA16(bb, c0, g[mj][0]); g[mj][1] = MFMA16(bb, c1, g[mj][1]); } }
    const int i0 = wave * 32 + l15, i1 = i0 + 16;
    const float c0i0 = cum0[i0], s1i0 = suf1[i0], c0i1 = cum0[i1], s1i1 = suf1[i1];
#pragma unroll
    for (int mj = 0; mj < 8; ++mj)
#pragma unroll
      for (int r = 0; r < 4; ++r) { const int j = mj * 16 + q * 4 + r;
        const float cj = cum0[j], sj = suf1[j], d0 = dt0[j], d1 = dt1[j];
        const float lw0 = (j <= i0 ? expf(c0i0 - cj) * d0 : 0.f) + (j >= i0 ? expf(s1i0 - sj) * d1 : 0.f);
        const float lw1 = (j <= i1 ? expf(c0i1 - cj) * d0 : 0.f) + (j >= i1 ? expf(s1i1 - sj) * d1 : 0.f);
        mfr[mj >> 1][0][(mj & 1) * 4 + r] = (short)f2bf(g[mj][0][r] * lw0);
        mfr[mj >> 1][1][(mj & 1) * 4 + r] = (short)f2bf(g[mj][1][r] * lw1); } }
#pragma unroll
  for (int s4 = 0; s4 < 4; ++s4)
#pragma unroll
    for (int mp = 0; mp < 4; ++mp) { const bf16_t* xr = XT + (size_t)(h * 64 + mp * 16 + l15) * 128 + s4 * 32 + q * 4;
      bf16x8 xa = ld4x2(xr, xr + 16);
      y[mp][0] = MFMA16(xa, mfr[s4][0], y[mp][0]); y[mp][1] = MFMA16(xa, mfr[s4][1], y[mp][1]); }
  __syncthreads();
  float* yl = f + 1024;
#pragma unroll
  for (int mp = 0; mp < 4; ++mp)
#pragma unroll
    for (int ni = 0; ni < 2; ++ni)
#pragma unroll
      for (int r = 0; r < 4; ++r) yl[(wave * 32 + ni * 16 + l15) * 65 + mp * 16 + q * 4 + r] = y[mp][ni][r];
  __syncthreads();
  float* YS = (float*)(p.ws + Ws::YS) + (size_t)(b * T_ + co * 128) * 512 + h * 64;
  for (int e = tid; e < 128 * 64; e += 256) YS[(size_t)(e >> 6) * 512 + (e & 63)] = yl[(e >> 6) * 65 + (e & 63)];
}

#define GQ_LD 40
#define GK_LD 72
DEVFN void gla_chunk(const Params& p, int unit, unsigned char* smem) {
  const int tid = TIDX, lane = tid & 63, wave = tid >> 6, q = lane >> 4, l15 = lane & 15;
  const int h = unit & 3, co = (unit >> 2) % NC64, b = unit / (4 * NC64);
  const bf16_t* ZX = (const bf16_t*)(p.ws + Ws::ZX) + (size_t)(b * T_ + co * 64) * NIN_;
  const float* LA = (const float*)(p.ws + Ws::LA);
  float* cum = (float*)smem;
  bf16_t* qs = (bf16_t*)(smem + 16384);
  bf16_t* ks = qs + 2 * 64 * GQ_LD;
  bf16_t* kt = ks + 2 * 64 * GQ_LD;
  __syncthreads();
  for (int e = tid; e < 2 * 64 * 32; e += 256) { const int d = e >> 11, i = (e >> 5) & 63, dd = e & 31;
    cum[e] = LA[((size_t)d * NT_ + b * T_ + co * 64 + i) * 128 + h * 32 + dd]; }
  __syncthreads();
  if (tid < 64) { const int d = tid >> 5, dd = tid & 31; float* c = cum + d * 2048 + dd; float sacc = 0.f;
    if (d == 0) for (int i = 0; i < 64; ++i) { sacc += c[i * 32]; c[i * 32] = sacc; }
    else for (int i = 63; i >= 0; --i) { sacc += c[i * 32]; c[i * 32] = sacc; } }
  __syncthreads();
  bf16_t* QT = (bf16_t*)(p.ws + Ws::QT);
  for (int e = tid; e < 64 * 32; e += 256) { const int i = e >> 5, dd = e & 31;
    const float qv = bf2f(ZX[(size_t)i * NIN_ + OGQ + h * 32 + dd]) * 0.17677669529663687f, kv = bf2f(ZX[(size_t)i * NIN_ + OGK + h * 32 + dd]);
    const float c0 = cum[i * 32 + dd], c1 = cum[2048 + i * 32 + dd], t0 = cum[63 * 32 + dd], t1 = cum[2048 + dd];
    const bf16_t q0 = f2bf(qv * expf(c0)), q1 = f2bf(qv * expf(c1));
    qs[i * GQ_LD + dd] = q0; qs[64 * GQ_LD + i * GQ_LD + dd] = q1;
    ks[i * GQ_LD + dd] = f2bf(kv * expf(-c0)); ks[64 * GQ_LD + i * GQ_LD + dd] = f2bf(kv * expf(-c1));
    kt[dd * GK_LD + i] = f2bf(kv * expf(t0 - c0)); kt[32 * GK_LD + dd * GK_LD + i] = f2bf(kv * expf(t1 - c1));
    const size_t tok = (size_t)b * T_ + co * 64 + i;
    QT[tok * 128 + h * 32 + dd] = q0; QT[((size_t)NT_ + tok) * 128 + h * 32 + dd] = q1; }
  if (tid < 64) { const int d = tid >> 5, dd = tid & 31; const int cs = cscan(d, co, CTX_ / 64, SEQ_ / 64);
    ((float*)(p.ws + Ws::GCD))[(((size_t)(d * B_ + b) * NC64 + cs) * 4 + h) * 32 + dd] = expf(d == 0 ? cum[63 * 32 + dd] : cum[2048 + dd]); }
  __syncthreads();
  bf16x8 pfr[2];
  { f32x4 p0[4], p1[4];
    const bf16x8 qb0 = ld8(qs + (wave * 16 + l15) * GQ_LD + q * 8), qb1 = ld8(qs + 64 * GQ_LD + (wave * 16 + l15) * GQ_LD + q * 8);
#pragma unroll
    for (int mj = 0; mj < 4; ++mj) { p0[mj] = MFMA16(ld8(ks + (mj * 16 + l15) * GQ_LD + q * 8), qb0, (f32x4{0.f, 0.f, 0.f, 0.f}));
      p1[mj] = MFMA16(ld8(ks + 64 * GQ_LD + (mj * 16 + l15) * GQ_LD + q * 8), qb1, (f32x4{0.f, 0.f, 0.f, 0.f})); }
    const int i = wave * 16 + l15;
#pragma unroll
    for (int mj = 0; mj < 4; ++mj)
#pragma unroll
      for (int r = 0; r < 4; ++r) { const int j = mj * 16 + q * 4 + r; pfr[mj >> 1][(mj & 1) * 4 + r] = (short)f2bf((j <= i ? p0[mj][r] : 0.f) + (j >= i ? p1[mj][r] : 0.f)); } }
  const bf16_t* VT = (const bf16_t*)(p.ws + Ws::VT) + ((size_t)(b * NC64 + co) * 256 + h * 64) * 64;
  f32x4 o[4];
#pragma unroll
  for (int md = 0; md < 4; ++md) { o[md] = f32x4{0.f, 0.f, 0.f, 0.f};
#pragma unroll
    for (int s2 = 0; s2 < 2; ++s2) { const bf16_t* vr = VT + (size_t)(md * 16 + l15) * 64 + s2 * 32 + q * 4; o[md] = MFMA16(ld4x2(vr, vr + 16), pfr[s2], o[md]); } }
#pragma unroll
  for (int d = 0; d < 2; ++d) { const int cs = cscan(d, co, CTX_ / 64, SEQ_ / 64);
    float* GST = (float*)(p.ws + Ws::GST) + (((size_t)(d * B_ + b) * NC64 + cs) * 4 + h) * 2048;
#pragma unroll
    for (int nd = 0; nd < 2; ++nd) { f32x4 st = f32x4{0.f, 0.f, 0.f, 0.f};
#pragma unroll
      for (int s2 = 0; s2 < 2; ++s2) st = MFMA16(ld8(VT + (size_t)(wave * 16 + l15) * 64 + s2 * 32 + q * 8), ld8(kt + d * 32 * GK_LD + (nd * 16 + l15) * GK_LD + s2 * 32 + q * 8), st);
#pragma unroll
      for (int r = 0; r < 4; ++r) GST[(wave * 16 + q * 4 + r) * 32 + nd * 16 + l15] = st[r]; } }
  __syncthreads();
  float* ol = (float*)smem;
#pragma unroll
  for (int md = 0; md < 4; ++md)
#pragma unroll
    for (int r = 0; r < 4; ++r) ol[(wave * 16 + l15) * 65 + md * 16 + q * 4 + r] = o[md][r];
  __syncthreads();
  float* OI = (float*)(p.ws + Ws::OI) + (size_t)(b * T_ + co * 64) * 256 + h * 64;
  for (int e = tid; e < 64 * 64; e += 256) OI[(size_t)(e >> 6) * 256 + (e & 63)] = ol[(e >> 6) * 65 + (e & 63)];
}
#define GLA_SB ((NC64 % 17) == 0 ? 17 : NC64)
DEVFN void gla_scan(const Params& p, int gtid, int gthreads) {
  const float* __restrict__ ST = (const float*)(p.ws + Ws::GST); const float* __restrict__ CD = (const float*)(p.ws + Ws::GCD); bf16_t* __restrict__ SIN = (bf16_t*)(p.ws + Ws::GSIN);
  for (int e = gtid; e < 2 * B_ * 4 * 2048; e += gthreads) {
    const int vd = e & 2047, h = (e >> 11) & 3, db = e >> 13;
    float sv = 0.f;
#pragma unroll 1
    for (int c0 = 0; c0 < NC64; c0 += GLA_SB) {
      float st[GLA_SB], cd[GLA_SB];
#pragma unroll
      for (int i = 0; i < GLA_SB; ++i) { st[i] = ST[(((size_t)db * NC64 + c0 + i) * 4 + h) * 2048 + vd]; cd[i] = CD[(((size_t)db * NC64 + c0 + i) * 4 + h) * 32 + (vd & 31)]; }
#pragma unroll
      for (int i = 0; i < GLA_SB; ++i) { SIN[(((size_t)db * NC64 + c0 + i) * 4 + h) * 2048 + vd] = f2bf(sv); sv = sv * cd[i] + st[i]; }
    }
  }
}
DEVFN void phase4a(const Params& p, int l, unsigned char* smem) {
  const int n_s = B_ * NC128 * 8, n_g = B_ * NC64 * 4;
  const int n_r = B_ * 8 * NC16 / 4;
  for (int u = BIDX; u < n_s + n_g + n_r; u += gridDim.x) { if (u < n_s) ssd_states(p, l, u, smem); else if (u < n_s + n_g) gla_chunk(p, u - n_s, smem); else rwkv_chunk(p, (u - n_s - n_g) * 4, smem); }
}
DEVFN void convert_moe_weights(const Params& p, int l, unsigned char* smem, int bid, int nb);
DEVFN void phase4b(const Params& p, int l, unsigned char* smem) {
  const int bid = BIDX, nrw = B_ * 8, G = (int)gridDim.x;
  if (G >= 2 * nrw) {
    if (bid < nrw) rwkv_scan(p, bid);
    else { const int ob = bid - nrw, on = G - nrw; ssd_scan(p, ob * 256 + TIDX, on * 256); gla_scan(p, ob * 256 + TIDX, on * 256); convert_moe_weights(p, l, smem, ob, on); }
  } else {
    for (int u = bid; u < nrw; u += G) rwkv_scan(p, u);
    ssd_scan(p, bid * 256 + TIDX, G * 256); gla_scan(p, bid * 256 + TIDX, G * 256); convert_moe_weights(p, l, smem, bid, G);
  }
}
DEVFN void phase4c(const Params& p, int l, unsigned char* smem) {
  const int n_s = B_ * NC128 * 8, n_r = B_ * 8 * NC16 / 4;
  for (int u = BIDX; u < n_s + n_r; u += gridDim.x) { if (u < n_s) ssd_out(p, l, u, smem); else rwkv_out(p, (u - n_s) * 4); }
}

DEVFN void phase5(const Params& p, int l, unsigned char* smem) {
  const int tid = TIDX, lane = tid & 63, wave = tid >> 6;
  const bf16_t* ZX = (const bf16_t*)(p.ws + Ws::ZX);
  const bf16_t* XBC = (const bf16_t*)(p.ws + Ws::XBC);
  const float* YS = (const float*)(p.ws + Ws::YS); const float* YR = (const float*)(p.ws + Ws::YR); const float* OI = (const float*)(p.ws + Ws::OI);
  const bf16_t* QT = (const bf16_t*)(p.ws + Ws::QT); const bf16_t* GSIN = (const bf16_t*)(p.ws + Ws::GSIN);
  const bf16_t* RR = (const bf16_t*)(p.ws + Ws::RR); const bf16_t* VV = (const bf16_t*)(p.ws + Ws::VV); const bf16_t* KD = (const bf16_t*)(p.ws + Ws::KD);
  const float* GATE = (const float*)(p.ws + Ws::GATE);
  bf16_t* YM = (bf16_t*)(p.ws + Ws::YMIX);
  float* red = (float*)smem;
  float* qt = red + 16;
  const float dA = INP(I_SSDD)[(size_t)l * 8 + (tid >> 6)], dB = INP(I_SSDD)[(size_t)l * 8 + 4 + (tid >> 6)];
  const float nwA = INP(I_SSDNW)[(size_t)l * 512 + tid], nwB = INP(I_SSDNW)[(size_t)l * 512 + 256 + tid];
  const float lnw = INP(I_LNXW)[(size_t)l * 256 + tid], lnb = INP(I_LNXB)[(size_t)l * 256 + tid], rk = INP(I_RK)[(size_t)l * 256 + tid];
  const float gnw = INP(I_GNW)[(size_t)l * 256 + tid];
  for (int tok = BIDX; tok < NT_; tok += gridDim.x) {
    float ya = YS[(size_t)tok * 512 + tid] + dA * bf2f(XBC[(size_t)tok * 1024 + tid]);
    float yb = YS[(size_t)tok * 512 + 256 + tid] + dB * bf2f(XBC[(size_t)tok * 1024 + 256 + tid]);
    ya *= siluf_(zxv(ZX, tok, OZ + tid)); yb *= siluf_(zxv(ZX, tok, OZ + 256 + tid));
    float qa = wave_sum(ya * ya), qb = wave_sum(yb * yb);
    __syncthreads();
    if (lane == 0) { red[wave] = qa; red[4 + wave] = qb; }
    qt[tid] = bf2f(QT[((size_t)(tid >> 7) * NT_ + tok) * 128 + (tid & 127)]);
    __syncthreads();
    float ma = (red[0] + red[1] + red[2] + red[3]) * (1.f / 256.f), mb = (red[4] + red[5] + red[6] + red[7]) * (1.f / 256.f);
    YM[(size_t)tok * 1024 + tid] = f2bf(ya * rsqrtf(ma + 1e-5f) * nwA);
    YM[(size_t)tok * 1024 + 256 + tid] = f2bf(yb * rsqrtf(mb + 1e-5f) * nwB);
    { float y = YR[(size_t)tok * 256 + tid] + YR[((size_t)NT_ + tok) * 256 + tid];
      float mu = wave_sum(y) * (1.f / 64.f), d = y - mu, var = wave_sum(d * d) * (1.f / 64.f);
      float yn = d * rsqrtf(var + 64e-5f) * lnw + lnb;
      float r = bf2f(RR[(size_t)tok * 256 + tid]), kf = bf2f(KD[(size_t)tok * 256 + tid]), kb = bf2f(KD[((size_t)NT_ + tok) * 256 + tid]);
      float bonus = wave_sum(r * (kf + kb) * rk) * bf2f(VV[(size_t)tok * 256 + tid]);
      YM[(size_t)tok * 1024 + 512 + tid] = f2bf((yn + bonus) * GATE[(size_t)tok * 256 + tid]); }
    { float o = OI[(size_t)tok * 256 + tid];
      const int b = tok / T_, co = (tok % T_) / 64;
#pragma unroll
      for (int d = 0; d < 2; ++d) { const int cs = cscan(d, co, CTX_ / 64, SEQ_ / 64);
        const bf16_t* sr = GSIN + ((((size_t)(d * B_ + b) * NC64 + cs) * 4 + wave) * 64 + lane) * 32;
#pragma unroll
        for (int c8 = 0; c8 < 4; ++c8) { bf16x8 sv = ld8(sr + c8 * 8);
#pragma unroll
          for (int jj = 0; jj < 8; ++jj) o += qt[d * 128 + wave * 32 + c8 * 8 + jj] * bf2f((bf16_t)sv[jj]); } }
      float ms = wave_sum(o * o) * (1.f / 64.f);
      YM[(size_t)tok * 1024 + 768 + tid] = f2bf(o * rsqrtf(ms + 1e-5f) * gnw * siluf_(zxv(ZX, tok, OOG + tid))); }
  }
}

DEVFN void phase6(const Params& p, int l, unsigned char* smem) {
  const bf16_t* A = (const bf16_t*)(p.ws + Ws::YMIX);
  const bf16_t* W = (const bf16_t*)(p.ws + Ws::WOUT) + (size_t)l * 1024 * 1024;
  float* MIX = (float*)(p.ws + Ws::MIX);
  for (int u = BIDX; u < (NT_ / 128) * 8; u += gridDim.x) {
    int rt = u / 8, ct = u % 8;
    gemm_tile(smem, 1024,
      [&](int r) { return A + (size_t)(rt * 128 + r) * 1024; },
      [&](int r) { return W + (size_t)(ct * 128 + r) * 1024; },
      [&](f32x4 (&acc)[4][4], int wr, int wc, int g, int l15) {
#pragma unroll
        for (int mi = 0; mi < 4; ++mi)
#pragma unroll
          for (int ni = 0; ni < 4; ++ni)
#pragma unroll
            for (int i = 0; i < 4; ++i) MIX[(size_t)(rt * 128 + wr * 64 + mi * 16 + 4 * g + i) * 1024 + ct * 128 + wc * 64 + ni * 16 + l15] = acc[mi][ni][i];
      });
  }
}

DEVFN void phase7(const Params& p, int l) {
  const int lane = TIDX & 63, wave = TIDX >> 6;
  float* X = (float*)(p.ws + Ws::X);
  const float* MIX = (const float*)(p.ws + Ws::MIX);
  bf16_t* H = (bf16_t*)(p.ws + Ws::U);
  const float* rwt = (const float*)(p.ws + Ws::RWT) + (size_t)l * 64 * 1024;
  int* cnt = (int*)(p.ws + Ws::CNT) + l * 64;
  int* ltok = (int*)(p.ws + Ws::LTOK); float* lwt = (float*)(p.ws + Ws::LWT);
  const float rbias = INP(I_RB)[(size_t)l * 64 + lane];
  for (int tok = BIDX * 4 + wave; tok < NT_; tok += gridDim.x * 4) {
    const float* mod = (const float*)(p.ws + Ws::MOD) + ((size_t)l * NR_ + tok_modrow(tok)) * NMOD_;
    float xv[16], t0[16], t1[16], mean, rstd;
    load_row16(X + (size_t)tok * 1024, lane, xv);
    load_row16(MIX + (size_t)tok * 1024, lane, t0);
    load_row16(mod + 2 * 1024, lane, t1);
#pragma unroll
    for (int i = 0; i < 16; ++i) xv[i] = ALPHA_ * xv[i] + t1[i] * t0[i];
    row_stats(xv, mean, rstd);
    load_row16(INP(I_LN1W) + (size_t)l * 1024, lane, t0);
    load_row16(INP(I_LN1B) + (size_t)l * 1024, lane, t1);
#pragma unroll
    for (int i = 0; i < 16; ++i) xv[i] = (xv[i] - mean) * rstd * t0[i] + t1[i];
#pragma unroll
    for (int j = 0; j < 4; ++j) *(float4*)(X + (size_t)tok * 1024 + lane * 4 + 256 * j) = make_float4(xv[4 * j], xv[4 * j + 1], xv[4 * j + 2], xv[4 * j + 3]);
    const bool is_ctx = (tok % T_) < CTX_;
    if (l == DEPTH_ - 1 && is_ctx) continue;
    row_stats(xv, mean, rstd);
    load_row16(mod + 3 * 1024, lane, t0);
    load_row16(mod + 4 * 1024, lane, t1);
#pragma unroll
    for (int i = 0; i < 16; ++i) xv[i] = (xv[i] - mean) * rstd * (1.f + t1[i]) + t0[i];
#pragma unroll
    for (int j = 0; j < 4; ++j)
      *(uint2*)(H + (size_t)tok * 1024 + lane * 4 + 256 * j) = make_uint2((unsigned)f2bf(xv[4 * j]) | ((unsigned)f2bf(xv[4 * j + 1]) << 16), (unsigned)f2bf(xv[4 * j + 2]) | ((unsigned)f2bf(xv[4 * j + 3]) << 16));
    float logit = 0.f;
    for (int e = 0; e < 64; ++e) {
      float s = 0.f;
#pragma unroll
      for (int j = 0; j < 4; ++j) { float4 w = *(const float4*)(rwt + (size_t)e * 1024 + lane * 4 + 256 * j); s += xv[4 * j] * w.x + xv[4 * j + 1] * w.y + xv[4 * j + 2] * w.z + xv[4 * j + 3] * w.w; }
      s = wave_sum(s);
      if (lane == e) logit = s;
    }
    const float score = sigmoidf_(logit), sel = score + rbias;
    float m1 = sel; int a1 = lane;
#pragma unroll
    for (int m = 1; m <= 4; m <<= 1) { float ov = __shfl_xor(m1, m); int oa = __shfl_xor(a1, m); if (ov > m1 || (ov == m1 && oa < a1)) { m1 = ov; a1 = oa; } }
    float m2 = (lane == a1) ? -3.0e38f : sel;
#pragma unroll
    for (int m = 1; m <= 4; m <<= 1) m2 = fmaxf(m2, __shfl_xor(m2, m));
    const float gs = m1 + m2; const int grp = lane >> 3;
    int grank = 0;
#pragma unroll
    for (int g2 = 0; g2 < 8; ++g2) { float og = __shfl(gs, g2 * 8); grank += (og > gs || (og == gs && g2 < grp)) ? 1 : 0; }
    const bool gsel = grank < 4;
    const float msel = gsel ? sel : -3.0e38f;
    int rank = 0;
    for (int e = 0; e < 64; ++e) { float ov = __shfl(msel, e); rank += (ov > msel || (ov == msel && e < lane)) ? 1 : 0; }
    const bool chosen = gsel && rank < 8;
    const float wsum = wave_sum(chosen ? score : 0.f);
    if (chosen) { int pos = atomicAdd(&cnt[lane], 1); ltok[(size_t)lane * NT_ + pos] = tok * 8 + rank; lwt[(size_t)lane * NT_ + pos] = score / wsum * 2.5f; }
  }
}

struct MoeMap { int nblk_total; int e; int rb; int cnt; int hoff; };
DEVFN int moe_ntok(int l) { return l == DEPTH_ - 1 ? B_ * SEQ_ : NT_; }
DEVFN int moe_shared_tok(int l, int i) { return l == DEPTH_ - 1 ? (i / SEQ_) * T_ + CTX_ + (i % SEQ_) : i; }
DEVFN void moe_prefix(const Params& p, int l, int* pre) {
  const int* cnt = (const int*)(p.ws + Ws::CNT) + l * 64;
  __syncthreads();
  if (TIDX == 0) { int s = 0; for (int e = 0; e < 65; ++e) { pre[e] = s; int c = e < 64 ? cnt[e] : moe_ntok(l); pre[66 + e] = c; s += (c + 127) / 128; } pre[65] = s; }
  __syncthreads();
}
DEVFN void phase8(const Params& p, int l, unsigned char* smem) {
  int* pre = (int*)(smem + SM_PRE);
  moe_prefix(p, l, pre);
  const bf16_t* H = (const bf16_t*)(p.ws + Ws::U);
  const bf16_t* W13 = (const bf16_t*)(p.ws + Ws::W13);
  bf16_t* HID = (bf16_t*)(p.ws + Ws::HID);
  const int* ltok = (const int*)(p.ws + Ws::LTOK); const float* lwt = (const float*)(p.ws + Ws::LWT);
  const int total = pre[65];
  for (int u = BIDX; u < total * 4; u += gridDim.x) {
    const int gb = u >> 2, nt = u & 3;
    int e = 0; while (pre[e + 1] <= gb) ++e;
    const int rb = gb - pre[e], cnt = pre[66 + e];
    gemm_tile(smem, 1024,
      [&](int r) { int pos = rb * 128 + r; if (pos >= cnt) return (const bf16_t*)(p.ws + Ws::ZROW); int tok = e < 64 ? (ltok[(size_t)e * NT_ + pos] >> 3) : moe_shared_tok(l, pos); return H + (size_t)tok * 1024; },
      [&](int r) { return W13 + ((size_t)e * 512 + nt * 128 + r) * 1024; },
      [&](f32x4 (&acc)[4][4], int wr, int wc, int g, int l15) {
#pragma unroll
        for (int mi = 0; mi < 4; ++mi)
#pragma unroll
          for (int i = 0; i < 4; ++i) { int r = wr * 64 + mi * 16 + 4 * g + i, pos = rb * 128 + r;
            if (pos < cnt) { float gw = e < 64 ? lwt[(size_t)e * NT_ + pos] : 1.f;
#pragma unroll
              for (int j = 0; j < 2; ++j) { float a1 = acc[mi][2 * j][i], a3 = acc[mi][2 * j + 1][i];
                HID[((size_t)gb * 128 + r) * 256 + nt * 64 + wc * 32 + j * 16 + l15] = f2bf(siluf_(a1) * a3 * gw); } } }
      });
  }
}
DEVFN void phase9(const Params& p, int l, unsigned char* smem) {
  int* pre = (int*)(smem + SM_PRE);
  moe_prefix(p, l, pre);
  const bf16_t* HID = (const bf16_t*)(p.ws + Ws::HID);
  const bf16_t* W2T = (const bf16_t*)(p.ws + Ws::W2T);
  bf16_t* YB = (bf16_t*)(p.ws + Ws::YBUF);
  const int* ltok = (const int*)(p.ws + Ws::LTOK);
  const int total = pre[65];
  for (int u = BIDX; u < total * 8; u += gridDim.x) {
    const int gb = u >> 3, nt = u & 7;
    int e = 0; while (pre[e + 1] <= gb) ++e;
    const int rb = gb - pre[e], cnt = pre[66 + e];
    gemm_tile(smem, 256,
      [&](int r) { int pos = rb * 128 + r; return pos < cnt ? HID + ((size_t)gb * 128 + r) * 256 : (const bf16_t*)(p.ws + Ws::ZROW); },
      [&](int r) { return W2T + ((size_t)e * 1024 + nt * 128 + r) * 256; },
      [&](f32x4 (&acc)[4][4], int wr, int wc, int g, int l15) {
#pragma unroll
        for (int mi = 0; mi < 4; ++mi)
#pragma unroll
          for (int i = 0; i < 4; ++i) { int r = wr * 64 + mi * 16 + 4 * g + i, pos = rb * 128 + r;
            if (pos < cnt) { int ts = e < 64 ? ltok[(size_t)e * NT_ + pos] : moe_shared_tok(l, pos) * 8; int tok = ts >> 3, slot = e < 64 ? (ts & 7) : 8;
              bf16_t* dst = YB + ((size_t)tok * NSLOT + slot) * 1024 + nt * 128 + wc * 64 + l15;
#pragma unroll
              for (int ni = 0; ni < 4; ++ni) dst[ni * 16] = f2bf(acc[mi][ni][i]); } }
      });
  }
}

#define SMEM_BYTES (PH_SMEM + 2048)
#define N_PHASES (3 + 11 * DEPTH_)
__global__ void __launch_bounds__(256, 2) mega(Params p, int ph_lo, int ph_hi) {
#ifdef HIPEMU
  unsigned char* smem = hipemu::cur_smem();
#else
  unsigned char* smem = smem_dyn;
  volatile LAS unsigned* st = (volatile LAS unsigned*)(smem_dyn + SM_BAR);
  if (threadIdx.x == 0) {
    st[0] = 0u; st[1] = 0u;
    unsigned long long* tab = (unsigned long long*)(smem_dyn + SM_TAB);
#pragma unroll
    for (int i = 0; i < 40; ++i) tab[i] = (unsigned long long)p.in[i];
  }
  __syncthreads();
  XcdBarrier bar = xcd_barrier_post((unsigned*)(p.ws + Ws::BAR), st);
#define GRID_SYNC() xcd_barrier(bar)
#endif
  int ph = 0;
#ifdef ONLY_KIND
#define KIND_ON(k) ((k) == ONLY_KIND)
#else
#define KIND_ON(k) 1
#endif
#ifndef REPEAT_MASK
#define REPEAT_MASK 0u
#endif
#define RUN_PHASE(kind, code) { if (KIND_ON(kind) && ph >= ph_lo && ph < ph_hi) { \
    int nrep_ = ((REPEAT_MASK >> (kind)) & 1u) ? 2 : 1; LAUNDER(nrep_); \
    _Pragma("unroll 1") for (int rep_ = 0; rep_ < nrep_; ++rep_) { LAUNDER(p.ws); LAUNDER(p.out); code; if (rep_ + 1 < nrep_ || ph + 1 < ph_hi) { GRID_SYNC(); } } } ++ph; }
  RUN_PHASE(0, phase0(p, smem));
  RUN_PHASE(11, phase0b(p));
  for (int l = 0; l < DEPTH_; ++l) {
    RUN_PHASE(1, phase1(p, l));
    RUN_PHASE(2, phase2(p, l, smem));
    RUN_PHASE(3, phase3(p, l, smem));
    RUN_PHASE(4, phase4a(p, l, smem));
    RUN_PHASE(12, phase4b(p, l, smem));
    RUN_PHASE(13, phase4c(p, l, smem));
    RUN_PHASE(5, phase5(p, l, smem));
    RUN_PHASE(6, phase6(p, l, smem));
    RUN_PHASE(7, phase7(p, l));
    RUN_PHASE(8, phase8(p, l, smem));
    RUN_PHASE(9, phase9(p, l, smem));
  }
  RUN_PHASE(10, phase_final(p));
}

extern "C" void kernel_launch(void* const* d_in, const int* in_sizes, int n_in, void* d_out, int out_size, void* d_ws, size_t ws_size, hipStream_t stream) {
  Params p{};
  for (int i = 0; i < 40; ++i) p.in[i] = (const float*)d_in[i];
  p.out = (float*)d_out;
  p.ws = (unsigned char*)d_ws;
  if (ws_size < Ws::END) { fprintf(stderr, "workspace too small: %zu < %zu\n", ws_size, (size_t)Ws::END); return; }
  hipMemsetAsync(d_ws, 0, Ws::ZERO_END, stream);
#ifdef HIPEMU
  int grid = 16; if (const char* e = getenv("EMU_GRID")) grid = atoi(e);
  int stop = N_PHASES; if (const char* e = getenv("EMU_STOP")) stop = atoi(e);
  if (getenv("EMU_ONE")) hipemu::launch(grid, 256, SMEM_BYTES, true, [=] { mega(p, 0, stop); });
  else for (int ph = 0; ph < stop; ++ph) hipemu::launch(grid, 256, SMEM_BYTES, false, [=] { mega(p, ph, ph + 1); });
#else
  static int grid = 0;
  if (!grid) {
    int dev = 0, cus = 0, per_cu = 0;
    hipGetDevice(&dev);
    hipDeviceGetAttribute(&cus, hipDeviceAttributeMultiprocessorCount, dev);
    hipOccupancyMaxActiveBlocksPerMultiprocessor(&per_cu, mega, 256, SMEM_BYTES);
    if (per_cu > 2) per_cu = 2;
    if (per_cu < 1) per_cu = 1;
    grid = cus * per_cu;
  }
#if N_LAUNCH_MODE == 1
  mega<<<grid, 256, SMEM_BYTES, stream>>>(p, 0, N_PHASES);
#else
  for (int ph = 0; ph < N_PHASES; ++ph) mega<<<grid, 256, SMEM_BYTES, stream>>>(p, ph, ph + 1);
#endif
#endif
}
```

```cpp
#ifndef HIPEMU
#include <hip/hip_runtime.h>
#endif
#include <stdint.h>
#include <stdio.h>

#ifndef B_
#define B_ 4
#endif
#ifndef SEQ_
#define SEQ_ 4096
#endif
#ifndef CTX_
#define CTX_ 256
#endif
#ifndef DEPTH_
#define DEPTH_ 4
#endif
#ifndef N_LAUNCH_MODE
#define N_LAUNCH_MODE 1
#endif
#define T_ (SEQ_ + CTX_)
#define NT_ (B_ * T_)
#define D_ 1024
#define NIN_ 3504
#define NMOD_ 6144
#define NR_ (B_ + 1)
#define OZ 0
#define OXBC 512
#define ODT 1536
#define ORW 1552
#define OGQ 2704
#define OGK 2832
#define OGV 2960
#define OGD 3216
#define OOG 3248
#define ALPHA_ 1.681792830507429f
#define NEXP 64
#define NSLOT 9
#define NC128 (T_ / 128)
#define NC64 (T_ / 64)
#define NC16 (T_ / 16)

#define DEVFN __device__ __forceinline__
#define LDT 72
#define GEMM_SMEM (2 * 128 * LDT * 2)
typedef unsigned short bf16_t;
#ifdef HIPEMU
#define AS1
#else
#define AS1 __attribute__((address_space(1)))
#endif
typedef unsigned u32x4 __attribute__((ext_vector_type(4)));

#ifdef HIPEMU
typedef emu_bf16x8 bf16x8;
typedef emu_f32x4 f32x4;
#define MFMA16(a, b, c) emu_mfma_16x16x32_bf16(a, b, c)
#define MFMA16K16(a, b, c) emu_mfma_16x16x16_bf16(a, b, c)
#define GRID_SYNC() hipemu::grid_sync()
#else
typedef short bf16x8 __attribute__((ext_vector_type(8)));
typedef float f32x4 __attribute__((ext_vector_type(4)));
#define MFMA16(a, b, c) __builtin_amdgcn_mfma_f32_16x16x32_bf16(a, b, c, 0, 0, 0)
#define MFMA16K16(a, b, c) __builtin_amdgcn_mfma_f32_16x16x16bf16_1k(a, b, c, 0, 0, 0)
#endif

DEVFN float bf2f(bf16_t h) { return __builtin_bit_cast(float, (unsigned)h << 16); }
DEVFN bf16_t f2bf(float f) { unsigned u = __builtin_bit_cast(unsigned, f); u += 0x7FFFu + ((u >> 16) & 1u); return (bf16_t)(u >> 16); }
template <class T> DEVFN AS1 T* gptr(T* q) { return (AS1 T*)q; }
DEVFN bf16x8 ld8g(const bf16_t* q) { return *(const AS1 bf16x8*)gptr(q); }
DEVFN float sigmoidf_(float x) { return 1.f / (1.f + expf(-x)); }
DEVFN float siluf_(float x) { return x / (1.f + expf(-x)); }
DEVFN float softplusf_(float x) { return x > 20.f ? x : log1pf(expf(x)); }
DEVFN float logsigmoidf_(float x) { return fminf(x, 0.f) - log1pf(expf(-fabsf(x))); }
DEVFN float wave_sum(float v) { for (int m = 32; m >= 1; m >>= 1) v += __shfl_xor(v, m); return v; }

constexpr size_t al(size_t x) { return (x + 255) & ~(size_t)255; }
struct Ws {
  static constexpr size_t BAR = 0;
  static constexpr size_t CNT = 16384;
  static constexpr size_t MOD = CNT + 4096;
  static constexpr size_t ZROW = al(MOD + (size_t)DEPTH_ * NR_ * NMOD_ * 4);
  static constexpr size_t ZERO_END = al(ZROW + 2048);
  static constexpr size_t MODP = ZERO_END;
  static constexpr size_t RWT = al(MODP + (size_t)16 * DEPTH_ * NR_ * NMOD_ * 4);
  static constexpr size_t LORA = al(RWT + (size_t)DEPTH_ * 64 * 1024 * 4);
  static constexpr size_t X = al(LORA + (size_t)DEPTH_ * 98304 * 2);
  static constexpr size_t U = al(X + (size_t)NT_ * 1024 * 4);
  static constexpr size_t YMIX = al(U + (size_t)NT_ * 1024 * 2);
  static constexpr size_t ZX = al(YMIX + (size_t)NT_ * 1024 * 2);
  static constexpr size_t MIX = ZX;
  static constexpr size_t LTOK = al(ZX + (size_t)NT_ * NIN_ * 2);
  static constexpr size_t LWT = al(LTOK + (size_t)64 * NT_ * 4);
  static constexpr size_t WIN = al(LWT + (size_t)64 * NT_ * 4);
  static constexpr size_t WOUT = al(WIN + (size_t)DEPTH_ * NIN_ * 1024 * 2);
  static constexpr size_t W13 = al(WOUT + (size_t)DEPTH_ * 1024 * 1024 * 2);
  static constexpr size_t W2T = al(W13 + (size_t)65 * 512 * 1024 * 2);
  static constexpr size_t UNI = al(W2T + (size_t)65 * 1024 * 256 * 2);
  static constexpr size_t XBC = UNI;
  static constexpr size_t XBCT = al(XBC + (size_t)NT_ * 1024 * 2);
  static constexpr size_t DTB = al(XBCT + (size_t)NT_ * 768 * 2);
  static constexpr size_t SST = al(DTB + (size_t)NT_ * 16 * 4);
  static constexpr size_t SCD = al(SST + (size_t)2 * NT_ / 128 * 8 * 8192 * 4);
  static constexpr size_t HIN = al(SCD + (size_t)2 * NT_ / 128 * 8 * 4);
  static constexpr size_t YS = SST;
  static constexpr size_t LA = al(HIN + (size_t)2 * NT_ / 128 * 8 * 8192 * 2);
  static constexpr size_t VT = al(LA + (size_t)2 * NT_ * 128 * 4);
  static constexpr size_t QT = al(VT + (size_t)NT_ * 256 * 2);
  static constexpr size_t OI = al(QT + (size_t)2 * NT_ * 128 * 2);
  static constexpr size_t GST = al(OI + (size_t)NT_ * 256 * 4);
  static constexpr size_t GCD = al(GST + (size_t)2 * NT_ / 64 * 4 * 2048 * 4);
  static constexpr size_t GSIN = al(GCD + (size_t)2 * NT_ / 64 * 4 * 32 * 4);
  static constexpr size_t RR = al(GSIN + (size_t)2 * NT_ / 64 * 4 * 2048 * 2);
  static constexpr size_t VV = RR + (size_t)NT_ * 256 * 2;
  static constexpr size_t KK = VV + (size_t)NT_ * 256 * 2;
  static constexpr size_t KD = KK + (size_t)NT_ * 256 * 2;
  static constexpr size_t BD = KD + (size_t)2 * NT_ * 256 * 2;
  static constexpr size_t LW = BD + (size_t)2 * NT_ * 256 * 2;
  static constexpr size_t GATE = LW + (size_t)2 * NT_ * 256 * 4;
  static constexpr size_t YR = GATE + (size_t)NT_ * 256 * 4;
  static constexpr size_t RML = al(YR + (size_t)2 * NT_ * 256 * 4);
  static constexpr size_t RNS = RML + (size_t)(NT_ / 16) * 8 * 4096 * 2;
  static constexpr size_t RWC = RNS + (size_t)(NT_ / 16) * 8 * 4096 * 2;
  static constexpr size_t RG = RWC + (size_t)(NT_ / 16) * 8 * 64 * 4;
  static constexpr size_t RY0 = RG + (size_t)(NT_ / 16) * 8 * 1024 * 2;
  static constexpr size_t LI = RY0 + (size_t)(NT_ / 16) * 8 * 1024 * 4;
  static constexpr size_t KRW = LI + (size_t)NT_ * 384 * 2;
  static constexpr size_t MIXER_END = KRW + (size_t)NT_ * 256 * 2;
  static constexpr size_t HID = UNI;
  static constexpr size_t YBUF = al(HID + ((size_t)NT_ * 9 + 65 * 128) * 256 * 2);
  static constexpr size_t MOE_END = YBUF + (size_t)NT_ * 9 * 1024 * 2;
  static constexpr size_t END = al(MIXER_END > MOE_END ? MIXER_END : MOE_END);
};

struct Params {
  const float* in[40];
  float* out;
  unsigned char* ws;
};
enum { I_X = 0, I_C, I_CTX, I_CCTX, I_ADAW, I_ADAB, I_WIN, I_CONVW, I_CONVB, I_DTBIAS, I_ALOG, I_SSDD, I_SSDNW, I_MU, I_W0, I_W2, I_A0, I_A2,
       I_G2, I_KKW, I_KAW, I_RK, I_LNXW, I_LNXB, I_GU, I_GB, I_GNW, I_WOUT, I_LN1W, I_LN1B, I_LN2W, I_LN2B, I_RW, I_RB, I_EW1, I_EW3, I_EW2,
       I_SW1, I_SW3, I_SW2 };

#define PH_SMEM 47104
#define SM_PRE (PH_SMEM)
#define SM_TAB (PH_SMEM + 1024)
#define SM_BAR (PH_SMEM + 2032)
#ifdef HIPEMU
#define INP(i) (p.in[i])
#define LAUNDER(x)
#define TIDX ((int)threadIdx.x)
#define BIDX ((int)blockIdx.x)
#else
extern __shared__ __align__(16) unsigned char smem_dyn[];
DEVFN const float* inp_lds(int i) {
  const volatile unsigned* t = (const volatile unsigned*)(smem_dyn + SM_TAB) + 2 * i;
  unsigned lo = __builtin_amdgcn_readfirstlane(t[0]), hi = __builtin_amdgcn_readfirstlane(t[1]);
  return (const float*)(((unsigned long long)hi << 32) | lo);
}
#define INP(i) inp_lds(i)
#define LAUNDER(x) asm volatile("" : "+s"(x))
DEVFN int tidx_() { int t = threadIdx.x; asm volatile("" : "+v"(t)); return t; }
DEVFN int bidx_() { int b = blockIdx.x; asm volatile("" : "+s"(b)); return b; }
#define TIDX tidx_()
#define BIDX bidx_()
#endif
#ifndef HIPEMU
#define XB_TMO      128
#define XB_XCNT(j)  (256  + 64 * (j))
#define XB_XSUB(j)  (1280 + 64 * (j))
#define XB_XGEN(j)  (2304 + 64 * (j))
#define XB_TOP      3328
#define XB_TOPGEN   3392
#define XCD_BAR_WORDS 3456
#define XB_SPIN_CAP (1u << 22)
#define LAS __attribute__((address_space(3)))
__device__ __forceinline__ unsigned xb_ld(unsigned* p)              { return __hip_atomic_load(p, __ATOMIC_RELAXED, __HIP_MEMORY_SCOPE_AGENT); }
__device__ __forceinline__ unsigned xb_add(unsigned* p, unsigned v) { return __hip_atomic_fetch_add(p, v, __ATOMIC_RELAXED, __HIP_MEMORY_SCOPE_AGENT); }
__device__ __forceinline__ unsigned xb_xcc_id() { return (unsigned)__builtin_amdgcn_s_getreg((3 << 11) | 20) & 0xFu; }
#define XB_SPIN(cond, bar) do { unsigned _sp = 0; while (cond) { __builtin_amdgcn_s_sleep(1); \
    if ((++_sp & 255u) == 0u) { if (xb_ld(&(bar)[XB_TMO])) break; if (_sp > XB_SPIN_CAP) { atomicAdd(&(bar)[XB_TMO], 1u); break; } } } } while (0)
struct XcdBarrier { unsigned* bar; unsigned x; volatile LAS unsigned* st; };
__device__ __forceinline__ XcdBarrier xcd_barrier_post(unsigned* bar, volatile LAS unsigned* st) {
    XcdBarrier b; b.bar = bar; b.x = xb_xcc_id(); b.st = st;
    if (threadIdx.x == 0) (void)xb_add(&bar[XB_XCNT(b.x)], 1u);
    return b;
}
__device__ __forceinline__ void xcd_barrier_complete(unsigned* bar, unsigned x, unsigned& nloc, unsigned& nx) {
    const unsigned G = gridDim.x * gridDim.y * gridDim.z;
    unsigned sum, cnt, mine, sp = 0u;
    for (;;) {
        sum = 0u; cnt = 0u; mine = 0u;
#pragma unroll
        for (unsigned j = 0; j < 16; ++j) { const unsigned c = xb_ld(&bar[XB_XCNT(j)]); sum += c; cnt += (c > 0u) ? 1u : 0u; mine = (j == x) ? c : mine; }
        if (sum == G) break;
        __builtin_amdgcn_s_sleep(1);
        if ((++sp & 255u) == 0u) { if (xb_ld(&bar[XB_TMO])) break; if (sp > XB_SPIN_CAP) { atomicAdd(&bar[XB_TMO], 1u); break; } }
    }
    nloc = mine > 0u ? mine : 1u; nx = cnt > 0u ? cnt : 1u;
}
__device__ __forceinline__ void xcd_barrier(const XcdBarrier& b) {
    asm volatile("s_waitcnt vmcnt(0)" ::: "memory");
    __syncthreads();
    if (threadIdx.x == 0) {
        unsigned* bar = b.bar;
        __builtin_amdgcn_s_waitcnt(0);
        unsigned nloc = b.st[0], nx = b.st[1];
        if (nloc == 0u) { xcd_barrier_complete(bar, b.x, nloc, nx); b.st[0] = nloc; b.st[1] = nx; }
        const unsigned old = xb_add(&bar[XB_XSUB(b.x)], 1u);
        const unsigned gen = old / nloc;
        if (old + 1u == (gen + 1u) * nloc) {
            __builtin_amdgcn_fence(__ATOMIC_RELEASE, "agent");
            asm volatile("s_waitcnt vmcnt(0)" ::: "memory");
            const unsigned og = xb_add(&bar[XB_TOP], 1u);
            const unsigned tg = og / nx;
            if (og + 1u == (tg + 1u) * nx) xb_add(&bar[XB_TOPGEN], 1u);
            else XB_SPIN(xb_ld(&bar[XB_TOPGEN]) == tg, bar);
            __builtin_amdgcn_fence(__ATOMIC_ACQUIRE, "agent");
            xb_add(&bar[XB_XGEN(b.x)], 1u);
            asm volatile("s_waitcnt vmcnt(0)" ::: "memory");
        } else {
            XB_SPIN(xb_ld(&bar[XB_XGEN(b.x)]) == gen, bar);
            __builtin_amdgcn_fence(__ATOMIC_ACQUIRE, "agent");
            asm volatile("s_waitcnt vmcnt(0)" ::: "memory");
        }
    }
    __syncthreads();
}
#endif

DEVFN int tokmap(int dir, int p) { return dir == 0 ? p : (p < CTX_ ? CTX_ - 1 - p : 2 * CTX_ + SEQ_ - 1 - p); }
DEVFN const float* tok_input_row(const Params& p, int tok) {
  int b = tok / T_, t = tok % T_;
  return t < CTX_ ? INP(I_CTX) + ((size_t)b * CTX_ + t) * D_ : INP(I_X) + ((size_t)b * SEQ_ + (t - CTX_)) * D_;
}
DEVFN int tok_modrow(int tok) { return (tok % T_) < CTX_ ? B_ : tok / T_; }

template <class ARow, class BRow, class Epi>
DEVFN void gemm_tile(unsigned char* smem, int K, ARow arow, BRow brow, Epi epi) {
  bf16_t* As = (bf16_t*)smem;
  bf16_t* Bs = As + 128 * LDT;
  const int tid = TIDX, lane = tid & 63, wave = tid >> 6, wr = wave >> 1, wc = wave & 1;
  const int g = lane >> 4, l15 = lane & 15;
  const int lr = tid >> 3, lc = (tid & 7) * 8;
  const AS1 bf16_t* ap[4];
  const AS1 bf16_t* bp[4];
#pragma unroll
  for (int i = 0; i < 4; ++i) { ap[i] = gptr(arow(lr + 32 * i)); bp[i] = gptr(brow(lr + 32 * i)); }
  f32x4 acc[4][4];
#pragma unroll
  for (int mi = 0; mi < 4; ++mi)
#pragma unroll
    for (int ni = 0; ni < 4; ++ni) acc[mi][ni] = f32x4{0.f, 0.f, 0.f, 0.f};
  u32x4 ra0[4], rb0[4], ra1[4], rb1[4];
#pragma unroll
  for (int i = 0; i < 4; ++i) { ra0[i] = *(const AS1 u32x4*)(ap[i] + lc); rb0[i] = *(const AS1 u32x4*)(bp[i] + lc); }
  if (K > 64) {
#pragma unroll
    for (int i = 0; i < 4; ++i) { ra1[i] = *(const AS1 u32x4*)(ap[i] + 64 + lc); rb1[i] = *(const AS1 u32x4*)(bp[i] + 64 + lc); } }
  auto compute = [&]() {
#pragma unroll
    for (int kk = 0; kk < 2; ++kk) {
      bf16x8 af[4], bfr[4];
#pragma unroll
      for (int mi = 0; mi < 4; ++mi) af[mi] = *(const bf16x8*)(As + (wr * 64 + mi * 16 + l15) * LDT + kk * 32 + g * 8);
#pragma unroll
      for (int ni = 0; ni < 4; ++ni) bfr[ni] = *(const bf16x8*)(Bs + (wc * 64 + ni * 16 + l15) * LDT + kk * 32 + g * 8);
#pragma unroll
      for (int mi = 0; mi < 4; ++mi)
#pragma unroll
        for (int ni = 0; ni < 4; ++ni) acc[mi][ni] = MFMA16(af[mi], bfr[ni], acc[mi][ni]);
    } };
  for (int k0 = 0; k0 < K; k0 += 128) {
    __syncthreads();
#pragma unroll
    for (int i = 0; i < 4; ++i) { *(u32x4*)(As + (lr + 32 * i) * LDT + lc) = ra0[i]; *(u32x4*)(Bs + (lr + 32 * i) * LDT + lc) = rb0[i]; }
    __syncthreads();
    if (k0 + 128 < K) {
#pragma unroll
      for (int i = 0; i < 4; ++i) { ra0[i] = *(const AS1 u32x4*)(ap[i] + k0 + 128 + lc); rb0[i] = *(const AS1 u32x4*)(bp[i] + k0 + 128 + lc); } }
    compute();
    if (k0 + 64 < K) {
      __syncthreads();
#pragma unroll
      for (int i = 0; i < 4; ++i) { *(u32x4*)(As + (lr + 32 * i) * LDT + lc) = ra1[i]; *(u32x4*)(Bs + (lr + 32 * i) * LDT + lc) = rb1[i]; }
      __syncthreads();
      if (k0 + 192 < K) {
#pragma unroll
        for (int i = 0; i < 4; ++i) { ra1[i] = *(const AS1 u32x4*)(ap[i] + k0 + 192 + lc); rb1[i] = *(const AS1 u32x4*)(bp[i] + k0 + 192 + lc); } }
      compute();
    }
  }
  epi(acc, wr, wc, g, l15);
}

template <int NCH, class Val, class RowP>
DEVFN void tile_store_bf16(unsigned char* smem, int wr, int g, int l15, Val val, RowP rowp) {
  constexpr int LDC = NCH * 8 + 8;
  bf16_t* T = (bf16_t*)smem;
  const int tid = TIDX;
  __syncthreads();
  val(T, LDC);
  __syncthreads();
#pragma unroll
  for (int pass = 0; pass < NCH / 2; ++pass) { const int id = tid + 256 * pass, row = id / NCH, c = id % NCH;
    bf16_t* dst = rowp(row, c * 8);
    if (dst) *(AS1 u32x4*)gptr(dst) = *(const u32x4*)(T + row * LDC + c * 8); }
  (void)wr; (void)g; (void)l15;
}
DEVFN void cvt_tile(unsigned char* smem, const float* src, int K, int N, int k0, int n0, bf16_t* dst, int ldd, int mode) {
  float* s = (float*)smem;
  const int tid = TIDX;
  __syncthreads();
  for (int e = tid; e < 64 * 64; e += 256) { int kk = e >> 6, nn = e & 63; s[kk * 65 + nn] = (n0 + nn < N) ? src[(size_t)(k0 + kk) * N + n0 + nn] : 0.f; }
  __syncthreads();
  for (int e = tid; e < 64 * 64; e += 256) { int nn = e >> 6, kk = e & 63; int n = n0 + nn;
    if (n < N) { int row = mode == 0 ? n : ((n >> 4) * 32 + (n & 15) + (mode == 2 ? 16 : 0)); dst[(size_t)row * ldd + k0 + kk] = f2bf(s[kk * 65 + nn]); } }
}
DEVFN void convert_moe_weights(const Params& p, int l, unsigned char* smem, int bid, int nb) {
  bf16_t* w13 = (bf16_t*)(p.ws + Ws::W13);
  bf16_t* w2t = (bf16_t*)(p.ws + Ws::W2T);
  const int per_e = 192;
  for (int u = bid; u < 65 * per_e; u += nb) {
    int e = u / per_e, r = u % per_e, which = r / 64, t = r % 64;
    if (which < 2) {
      const float* src = e < 64 ? (which == 0 ? INP(I_EW1) : INP(I_EW3)) + ((size_t)l * 64 + e) * 1024 * 256 : (which == 0 ? INP(I_SW1) : INP(I_SW3)) + (size_t)l * 1024 * 256;
      cvt_tile(smem, src, 1024, 256, (t >> 2) * 64, (t & 3) * 64, w13 + (size_t)e * 512 * 1024, 1024, which == 0 ? 1 : 2);
    } else {
      const float* src = e < 64 ? INP(I_EW2) + ((size_t)l * 64 + e) * 256 * 1024 : INP(I_SW2) + (size_t)l * 256 * 1024;
      cvt_tile(smem, src, 256, 1024, (t >> 4) * 64, (t & 15) * 64, w2t + (size_t)e * 1024 * 256, 256, 0);
    }
  }
}
DEVFN void phase0(const Params& p, unsigned char* smem) {
  const int tid = TIDX;
  float* modp = (float*)(p.ws + Ws::MODP);
  for (int u = BIDX; u < DEPTH_ * 24 * 16; u += gridDim.x) {
    int l = u / (24 * 16), jb = (u / 16) % 24, ks = u % 16;
    float* sc = (float*)smem;
    __syncthreads();
    for (int e = tid; e < NR_ * 64; e += 256) { int r = e / 64, i = ks * 64 + (e % 64); float cv = r < B_ ? INP(I_C)[(size_t)r * D_ + i] : INP(I_CCTX)[i]; sc[e] = siluf_(cv); }
    __syncthreads();
    int j = jb * 256 + tid;
    float acc[NR_];
#pragma unroll
    for (int r = 0; r < NR_; ++r) acc[r] = 0.f;
    const float* w = INP(I_ADAW) + ((size_t)l * D_ + ks * 64) * NMOD_ + j;
#pragma unroll 4
    for (int i = 0; i < 64; ++i) { float wv = w[(size_t)i * NMOD_];
#pragma unroll
      for (int r = 0; r < NR_; ++r) acc[r] += sc[r * 64 + i] * wv; }
#pragma unroll
    for (int r = 0; r < NR_; ++r) modp[(((size_t)ks * DEPTH_ + l) * NR_ + r) * NMOD_ + j] = acc[r];
  }
  bf16_t* win = (bf16_t*)(p.ws + Ws::WIN);
  bf16_t* wout = (bf16_t*)(p.ws + Ws::WOUT);
  for (int u = BIDX; u < DEPTH_ * 16 * 55; u += gridDim.x) {
    int l = u / (16 * 55), r = u % (16 * 55);
    cvt_tile(smem, INP(I_WIN) + (size_t)l * 1024 * NIN_, 1024, NIN_, (r / 55) * 64, (r % 55) * 64, win + (size_t)l * NIN_ * 1024, 1024, 0);
  }
  for (int u = BIDX; u < DEPTH_ * 256; u += gridDim.x) {
    int l = u / 256, r = u % 256;
    cvt_tile(smem, INP(I_WOUT) + (size_t)l * 1024 * 1024, 1024, 1024, (r / 16) * 64, (r % 16) * 64, wout + (size_t)l * 1024 * 1024, 1024, 0);
  }
  { bf16_t* lo = (bf16_t*)(p.ws + Ws::LORA);
    for (int u = BIDX * 256 + tid; u < DEPTH_ * 98304; u += gridDim.x * 256) {
      const int l = u / 98304, r = u % 98304; float v;
      if (r < 32768) { const int d = r >> 14, n = (r >> 6) & 255, k = r & 63; v = INP(I_W2)[(((size_t)l * 2 + d) * 64 + k) * 256 + n]; }
      else if (r < 65536) { const int r2 = r - 32768, d = r2 >> 14, n = (r2 >> 6) & 255, k = r2 & 63; v = INP(I_A2)[(((size_t)l * 2 + d) * 64 + k) * 256 + n]; }
      else { const int r2 = r - 65536, n = r2 >> 7, k = r2 & 127; v = INP(I_G2)[((size_t)l * 128 + k) * 256 + n]; }
      lo[u] = f2bf(v); } }
  float* rwt = (float*)(p.ws + Ws::RWT);
  for (int u = BIDX * 256 + tid; u < DEPTH_ * 64 * 1024; u += gridDim.x * 256) {
    int l = u / (64 * 1024), e = (u / 1024) % 64, i = u % 1024;
    rwt[u] = INP(I_RW)[((size_t)l * 1024 + i) * 64 + e];
  }
}

DEVFN void phase0b(const Params& p) {
  float* mod = (float*)(p.ws + Ws::MOD); const float* modp = (const float*)(p.ws + Ws::MODP);
  for (int u = BIDX * 256 + TIDX; u < DEPTH_ * NR_ * NMOD_; u += gridDim.x * 256) {
    int l = u / (NR_ * NMOD_), j = u % NMOD_;
    float s = INP(I_ADAB)[(size_t)l * NMOD_ + j];
    for (int ks = 0; ks < 16; ++ks) s += modp[(size_t)ks * DEPTH_ * NR_ * NMOD_ + u];
    mod[u] = s;
  }
}

DEVFN void row_stats(const float (&v)[16], float& mean, float& rstd) {
  float s = 0.f;
#pragma unroll
  for (int i = 0; i < 16; ++i) s += v[i];
  mean = wave_sum(s) * (1.f / 1024.f);
  float q = 0.f;
#pragma unroll
  for (int i = 0; i < 16; ++i) { float d = v[i] - mean; q += d * d; }
  rstd = rsqrtf(wave_sum(q) * (1.f / 1024.f) + 1e-5f);
}
DEVFN void load_row16(const float* row, int lane, float (&v)[16]) {
#pragma unroll
  for (int j = 0; j < 4; ++j) { float4 t = *(const float4*)(row + lane * 4 + 256 * j); v[4 * j] = t.x; v[4 * j + 1] = t.y; v[4 * j + 2] = t.z; v[4 * j + 3] = t.w; }
}
DEVFN void moe_residual_row(const Params& p, int lp, int tok, int lane, float (&xv)[16]) {
  const float* mod = (const float*)(p.ws + Ws::MOD) + ((size_t)lp * NR_ + tok_modrow(tok)) * NMOD_;
  const bf16_t* yb = (const bf16_t*)(p.ws + Ws::YBUF) + (size_t)tok * NSLOT * 1024;
  float f[16];
#pragma unroll
  for (int i = 0; i < 16; ++i) f[i] = 0.f;
  for (int s = 0; s < NSLOT; ++s) {
#pragma unroll
    for (int j = 0; j < 4; ++j) { uint2 t = *(const uint2*)(yb + (size_t)s * 1024 + lane * 4 + 256 * j);
      f[4 * j] += bf2f((bf16_t)(t.x & 0xFFFF)); f[4 * j + 1] += bf2f((bf16_t)(t.x >> 16)); f[4 * j + 2] += bf2f((bf16_t)(t.y & 0xFFFF)); f[4 * j + 3] += bf2f((bf16_t)(t.y >> 16)); }
  }
  float g2[16], w[16], b[16];
  load_row16(mod + 5 * 1024, lane, g2);
  load_row16(INP(I_LN2W) + (size_t)lp * 1024, lane, w);
  load_row16(INP(I_LN2B) + (size_t)lp * 1024, lane, b);
#pragma unroll
  for (int i = 0; i < 16; ++i) xv[i] = ALPHA_ * xv[i] + g2[i] * f[i];
  float mean, rstd;
  row_stats(xv, mean, rstd);
#pragma unroll
  for (int i = 0; i < 16; ++i) xv[i] = (xv[i] - mean) * rstd * w[i] + b[i];
}
DEVFN void phase1(const Params& p, int l) {
  const int lane = TIDX & 63, wave = TIDX >> 6;
  float* X = (float*)(p.ws + Ws::X);
  bf16_t* U = (bf16_t*)(p.ws + Ws::U);
  for (int tok = BIDX * 4 + wave; tok < NT_; tok += gridDim.x * 4) {
    float xv[16];
    if (l == 0) load_row16(tok_input_row(p, tok), lane, xv);
    else { load_row16(X + (size_t)tok * 1024, lane, xv); moe_residual_row(p, l - 1, tok, lane, xv); }
#pragma unroll
    for (int j = 0; j < 4; ++j) *(float4*)(X + (size_t)tok * 1024 + lane * 4 + 256 * j) = make_float4(xv[4 * j], xv[4 * j + 1], xv[4 * j + 2], xv[4 * j + 3]);
    const float* mod = (const float*)(p.ws + Ws::MOD) + ((size_t)l * NR_ + tok_modrow(tok)) * NMOD_;
    float sh[16], sc[16], mean, rstd;
    load_row16(mod, lane, sh);
    load_row16(mod + 1024, lane, sc);
    row_stats(xv, mean, rstd);
#pragma unroll
    for (int j = 0; j < 4; ++j) {
      float u0 = (xv[4 * j] - mean) * rstd * (1.f + sc[4 * j]) + sh[4 * j], u1 = (xv[4 * j + 1] - mean) * rstd * (1.f + sc[4 * j + 1]) + sh[4 * j + 1];
      float u2 = (xv[4 * j + 2] - mean) * rstd * (1.f + sc[4 * j + 2]) + sh[4 * j + 2], u3 = (xv[4 * j + 3] - mean) * rstd * (1.f + sc[4 * j + 3]) + sh[4 * j + 3];
      *(uint2*)(U + (size_t)tok * 1024 + lane * 4 + 256 * j) = make_uint2((unsigned)f2bf(u0) | ((unsigned)f2bf(u1) << 16), (unsigned)f2bf(u2) | ((unsigned)f2bf(u3) << 16));
    }
  }
}
DEVFN void phase_final(const Params& p) {
  const int lane = TIDX & 63, wave = TIDX >> 6;
  const float* X = (const float*)(p.ws + Ws::X);
  for (int r = BIDX * 4 + wave; r < B_ * SEQ_; r += gridDim.x * 4) {
    int b = r / SEQ_, s = r % SEQ_, tok = b * T_ + CTX_ + s;
    float xv[16];
    load_row16(X + (size_t)tok * 1024, lane, xv);
    moe_residual_row(p, DEPTH_ - 1, tok, lane, xv);
#pragma unroll
    for (int j = 0; j < 4; ++j) *(float4*)(p.out + (size_t)r * 1024 + lane * 4 + 256 * j) = make_float4(xv[4 * j], xv[4 * j + 1], xv[4 * j + 2], xv[4 * j + 3]);
  }
}

DEVFN void phase2(const Params& p, int l, unsigned char* smem) {
  const bf16_t* U = (const bf16_t*)(p.ws + Ws::U);
  const bf16_t* W = (const bf16_t*)(p.ws + Ws::WIN) + (size_t)l * NIN_ * 1024;
  bf16_t* ZX = (bf16_t*)(p.ws + Ws::ZX);
  const int nct = (NIN_ + 127) / 128;
  for (int u = BIDX; u < (NT_ / 128) * nct; u += gridDim.x) {
    int rt = u / nct, ct = u % nct;
    gemm_tile(smem, 1024,
      [&](int r) { return U + (size_t)(rt * 128 + r) * 1024; },
      [&](int r) { int n = ct * 128 + r; return n < NIN_ ? W + (size_t)n * 1024 : (const bf16_t*)(p.ws + Ws::ZROW); },
      [&](f32x4 (&acc)[4][4], int wr, int wc, int g, int l15) {
        tile_store_bf16<16>(smem, wr, g, l15,
          [&](bf16_t* T, int ldc) {
#pragma unroll
            for (int mi = 0; mi < 4; ++mi)
#pragma unroll
              for (int ni = 0; ni < 4; ++ni)
#pragma unroll
                for (int i = 0; i < 4; ++i) T[(wr * 64 + mi * 16 + 4 * g + i) * ldc + wc * 64 + ni * 16 + l15] = f2bf(acc[mi][ni][i]); },
          [&](int row, int c0) { return ct * 128 + c0 < NIN_ ? ZX + (size_t)(rt * 128 + row) * NIN_ + ct * 128 + c0 : (bf16_t*)nullptr; });
      });
  }
}

DEVFN float zxv(const bf16_t* ZX, int tok, int col) { return bf2f(ZX[(size_t)tok * NIN_ + col]); }
struct Nbr { int n; int tok[4]; };
DEVFN Nbr shift_nbrs(int tok) {
  Nbr nb; int b = tok / T_, t = tok % T_;
  if (t < CTX_) { nb.n = 2; nb.tok[0] = t > 0 ? tok - 1 : -1; nb.tok[1] = t < CTX_ - 1 ? tok + 1 : -1; nb.tok[2] = -1; nb.tok[3] = -1; }
  else { int s = t - CTX_, row = s / 64, col = s % 64; nb.n = 4; nb.tok[0] = col > 0 ? tok - 1 : -1; nb.tok[1] = col < 63 ? tok + 1 : -1;
    nb.tok[2] = row > 0 ? tok - 64 : -1; nb.tok[3] = row < SEQ_ / 64 - 1 ? tok + 64 : -1; }
  (void)b; return nb;
}
DEVFN float shiftmix(const bf16_t* ZX, const float* mu, int tok, const Nbr& nb, int ch) {
  float z = zxv(ZX, tok, ORW + ch), o = z;
#pragma unroll
  for (int j = 0; j < 4; ++j) if (j < nb.n) { float v = nb.tok[j] >= 0 ? zxv(ZX, nb.tok[j], ORW + ch) : 0.f; o += mu[j * 1152 + ch] * (v - z); }
  return o;
}
#define P3_TT 4
DEVFN void phase3(const Params& p, int l, unsigned char* smem) {
  const int tid = TIDX;
  const bf16_t* ZX = (const bf16_t*)(p.ws + Ws::ZX);
  bf16_t* XBC = (bf16_t*)(p.ws + Ws::XBC); float* DTB = (float*)(p.ws + Ws::DTB);
  bf16_t* RR = (bf16_t*)(p.ws + Ws::RR); bf16_t* VV = (bf16_t*)(p.ws + Ws::VV); bf16_t* KKb = (bf16_t*)(p.ws + Ws::KK);
  float* LWp = (float*)(p.ws + Ws::LW); bf16_t* KD = (bf16_t*)(p.ws + Ws::KD); bf16_t* BD = (bf16_t*)(p.ws + Ws::BD);
  float* GATE = (float*)(p.ws + Ws::GATE); float* LA = (float*)(p.ws + Ws::LA);
  const float* convw = INP(I_CONVW) + (size_t)l * 3 * 1024; const float* convb = INP(I_CONVB) + (size_t)l * 1024;
  const float* mu = INP(I_MU) + (size_t)l * 4 * 1152;
  bf16_t* LIg = (bf16_t*)(p.ws + Ws::LI);
  float* li = (float*)smem;
  const float kkw = INP(I_KKW)[(size_t)l * 256 + tid], kaw = INP(I_KAW)[(size_t)l * 256 + tid];
  for (int tile = BIDX; tile < NT_ / P3_TT; tile += gridDim.x) {
    __syncthreads();
    {
      const int tok0 = tile * P3_TT, t0 = tok0 % T_, bb = tok0 / T_;
      const bool segstart = (t0 == 0 || t0 == CTX_), segend = (t0 + 3 == CTX_ - 1 || t0 + 3 == T_ - 1);
      bf16_t* XBCT = (bf16_t*)(p.ws + Ws::XBCT) + ((size_t)(bb * NC128 + t0 / 128) * 768) * 128 + (t0 % 128);
#pragma unroll
      for (int j = 0; j < 4; ++j) { const int c = tid + 256 * j;
        float z[6];
#pragma unroll
        for (int q = 0; q < 6; ++q) z[q] = ((q == 0 && segstart) || (q == 5 && segend)) ? 0.f : zxv(ZX, tok0 + q - 1, OXBC + c);
        const float w0 = convw[c], w1 = convw[1024 + c], w2 = convw[2048 + c], cb = convb[c];
        bf16_t y[4];
#pragma unroll
        for (int tt = 0; tt < 4; ++tt) { y[tt] = f2bf(siluf_(cb + w0 * z[tt] + w1 * z[tt + 1] + w2 * z[tt + 2])); XBC[(size_t)(tok0 + tt) * 1024 + c] = y[tt]; }
        if (c < 768) *(uint2*)(XBCT + (size_t)c * 128) = make_uint2((unsigned)y[0] | ((unsigned)y[1] << 16), (unsigned)y[2] | ((unsigned)y[3] << 16)); }
      bf16_t* VTp = (bf16_t*)(p.ws + Ws::VT) + ((size_t)(bb * NC64 + t0 / 64) * 256 + tid) * 64 + (t0 % 64);
      const bf16_t v0 = ZX[(size_t)tok0 * NIN_ + OGV + tid], v1 = ZX[(size_t)(tok0 + 1) * NIN_ + OGV + tid], v2 = ZX[(size_t)(tok0 + 2) * NIN_ + OGV + tid], v3 = ZX[(size_t)(tok0 + 3) * NIN_ + OGV + tid];
      *(uint2*)VTp = make_uint2((unsigned)v0 | ((unsigned)v1 << 16), (unsigned)v2 | ((unsigned)v3 << 16));
    }
#pragma unroll 1
    for (int tt = 0; tt < P3_TT; ++tt) {
      const int tok = tile * P3_TT + tt;
      if (tid < 16) DTB[(size_t)tok * 16 + tid] = softplusf_(zxv(ZX, tok, ODT + tid) + INP(I_DTBIAS)[(size_t)l * 16 + tid]);
      const Nbr nb = shift_nbrs(tok);
      float r = shiftmix(ZX, mu, tok, nb, tid), k = shiftmix(ZX, mu, tok, nb, 256 + tid), v = shiftmix(ZX, mu, tok, nb, 512 + tid);
      RR[(size_t)tok * 256 + tid] = f2bf(r); VV[(size_t)tok * 256 + tid] = f2bf(v);
      float kq = k * kkw, nrm = sqrtf(wave_sum(kq * kq));
      const float kn = kq / fmaxf(nrm, 1e-12f);
      ((bf16_t*)(p.ws + Ws::KRW))[(size_t)tok * 256 + tid] = f2bf(k);
      KKb[(size_t)tok * 256 + tid] = f2bf(kn);
      { float x = shiftmix(ZX, mu, tok, nb, 768 + tid); LIg[(size_t)tok * 384 + tid] = f2bf(tid < 128 ? tanhf(x) : x); }
      if (tid < 128) LIg[(size_t)tok * 384 + 256 + tid] = f2bf(sigmoidf_(shiftmix(ZX, mu, tok, nb, 1024 + tid)));
      if (tid >= 128 && tid < 160) li[tt * 416 + 384 + (tid - 128)] = zxv(ZX, tok, OGD + (tid - 128));
    }
    __syncthreads();
    { const int d = tid >> 7, c = tid & 127; const float* gu = INP(I_GU) + ((size_t)l * 2 + d) * 16 * 128; const float gb = INP(I_GB)[((size_t)l * 2 + d) * 128 + c];
      float guw[16];
#pragma unroll
      for (int i = 0; i < 16; ++i) guw[i] = gu[i * 128 + c];
#pragma unroll
      for (int tt = 0; tt < P3_TT; ++tt) { float s = gb;
#pragma unroll
        for (int i = 0; i < 16; ++i) s += li[tt * 416 + 384 + d * 16 + i] * guw[i];
        LA[((size_t)d * NT_ + tile * P3_TT + tt) * 128 + c] = logsigmoidf_(s) * (1.f / 16.f); } }
  }
}

DEVFN void phase3b(const Params& p, int l, unsigned char* smem) {
  const bf16_t* LIg = (const bf16_t*)(p.ws + Ws::LI);
  const bf16_t* lora = (const bf16_t*)(p.ws + Ws::LORA) + (size_t)l * 98304;
  const bf16_t* KRg = (const bf16_t*)(p.ws + Ws::KRW); const bf16_t* KKg = (const bf16_t*)(p.ws + Ws::KK);
  float* LWp = (float*)(p.ws + Ws::LW); bf16_t* KD = (bf16_t*)(p.ws + Ws::KD); bf16_t* BD = (bf16_t*)(p.ws + Ws::BD); float* GATE = (float*)(p.ws + Ws::GATE);
  for (int u = BIDX; u < (NT_ / 128) * 10; u += gridDim.x) {
    const int rt = u / 10, which = (u % 10) >> 1, ct = u & 1;
    const int K = which < 4 ? 64 : 128, acol = which < 4 ? which * 64 : 256;
    const bf16_t* wb = which < 2 ? lora + (size_t)which * 16384 : which < 4 ? lora + 32768 + (size_t)(which - 2) * 16384 : lora + 65536;
    const float* bias = which < 2 ? INP(I_W0) + (size_t)l * 512 + which * 256 : INP(I_A0) + (size_t)l * 512 + (which & 1) * 256;
    const float* kav = INP(I_KAW) + (size_t)l * 256;
    gemm_tile(smem, K,
      [&](int r) { return LIg + (size_t)(rt * 128 + r) * 384 + acol; },
      [&](int r) { return wb + (size_t)(ct * 128 + r) * K; },
      [&](f32x4 (&acc)[4][4], int wr, int wc, int g, int l15) {
#pragma unroll
        for (int ni = 0; ni < 4; ++ni) { const int col = ct * 128 + wc * 64 + ni * 16 + l15;
          const float bv = which < 4 ? bias[col] : 0.f, ka = kav[col];
#pragma unroll
          for (int mi = 0; mi < 4; ++mi)
#pragma unroll
            for (int i = 0; i < 4; ++i) { const int row = rt * 128 + wr * 64 + mi * 16 + 4 * g + i; const size_t o = (size_t)row * 256 + col;
              const float v = acc[mi][ni][i];
              if (which < 2) LWp[(size_t)which * NT_ * 256 + o] = -0.6065306597126334f * sigmoidf_(v + bv);
              else if (which < 4) { const float a = sigmoidf_(v + bv); const size_t od = (size_t)(which - 2) * NT_ * 256 + o;
                KD[od] = f2bf(bf2f(KRg[o]) * (1.f + (a - 1.f) * ka)); BD[od] = f2bf(bf2f(KKg[o]) * a); }
              else GATE[o] = v; } }
      });
  }
}

DEVFN bf16x8 ld8(const bf16_t* p) { return *(const bf16x8*)p; }
typedef short bf16x4v __attribute__((ext_vector_type(4)));
DEVFN bf16x4v cvt4(f32x4 v) { return bf16x4v{(short)f2bf(v[0]), (short)f2bf(v[1]), (short)f2bf(v[2]), (short)f2bf(v[3])}; }
DEVFN bf16x8 cat44(bf16x4v a, bf16x4v b) { return bf16x8{a[0], a[1], a[2], a[3], b[0], b[1], b[2], b[3]}; }
DEVFN bf16x4v ld4(const bf16_t* p) { return *(const bf16x4v*)p; }
DEVFN int rm_off(int i, int k) { return i * 64 + ((((k >> 3) ^ (i & 7)) << 3) | (k & 7)); }
#define RW_WAVE_LDS 11264
DEVFN void rwkv_chunk(const Params& p, int unit_base, unsigned char* smem) {
  const int tid = TIDX, lane = tid & 63, wave = tid >> 6, q = lane >> 4, l15 = lane & 15;
  const int unit = unit_base + wave;
  const int c = unit % NC16, h = (unit / NC16) & 3, dir = (unit / (NC16 * 4)) & 1, b = unit / (NC16 * 8);
  bf16_t* big = (bf16_t*)(smem + wave * RW_WAVE_LDS);
  unsigned char* small = smem + wave * RW_WAVE_LDS + 8192;
  float* AbF = (float*)small;
  bf16_t* TN = (bf16_t*)(small + 1024);
  bf16_t* AK = TN + 256; bf16_t* RB = AK + 256; bf16_t* RK = RB + 256;
  const bf16_t* RRg = (const bf16_t*)(p.ws + Ws::RR); const bf16_t* VVg = (const bf16_t*)(p.ws + Ws::VV); const bf16_t* KKg = (const bf16_t*)(p.ws + Ws::KK);
  const bf16_t* KDg = (const bf16_t*)(p.ws + Ws::KD) + (size_t)dir * NT_ * 256; const bf16_t* BDg = (const bf16_t*)(p.ws + Ws::BD) + (size_t)dir * NT_ * 256;
  const float* LWg = (const float*)(p.ws + Ws::LW) + (size_t)dir * NT_ * 256;
  float kkm[16], vv[16], bneg[16], kneg[16];
  float run = 0.f;
  __syncthreads();
#pragma unroll
  for (int i = 0; i < 16; ++i) {
    const size_t o = (size_t)(b * T_ + tokmap(dir, c * 16 + i)) * 256 + h * 64 + lane;
    const float lw = LWg[o], r = bf2f(RRg[o]), k = bf2f(KDg[o]), v = bf2f(VVg[o]), kk = bf2f(KKg[o]), bb = bf2f(BDg[o]);
    const float e_ex = expf(run); run += lw; const float e_in = expf(run), e_neg = expf(-run);
    kkm[i] = kk * e_ex; vv[i] = v; bneg[i] = bb * e_neg; kneg[i] = k * e_neg;
    big[rm_off(i, lane)] = f2bf(kkm[i]); big[1024 + rm_off(i, lane)] = f2bf(r * e_in);
    big[2048 + rm_off(i, lane)] = f2bf(bneg[i]); big[3072 + rm_off(i, lane)] = f2bf(kneg[i]);
  }
  const float WC = expf(run);
  __syncthreads();
  f32x4 ab = f32x4{0.f, 0.f, 0.f, 0.f}, ak = ab, rb = ab, rk = ab;
#pragma unroll
  for (int s2 = 0; s2 < 2; ++s2) { const int ch = ((4 * s2 + q) ^ (l15 & 7)) << 3;
    const bf16x8 a_kk = ld8(big + l15 * 64 + ch), a_r = ld8(big + 1024 + l15 * 64 + ch), b_b = ld8(big + 2048 + l15 * 64 + ch), b_k = ld8(big + 3072 + l15 * 64 + ch);
    ab = MFMA16(a_kk, b_b, ab); ak = MFMA16(a_kk, b_k, ak); rb = MFMA16(a_r, b_b, rb); rk = MFMA16(a_r, b_k, rk); }
  f32x4 gacc[4];
#pragma unroll
  for (int nk = 0; nk < 4; ++nk)
#pragma unroll
    for (int r = 0; r < 4; ++r) gacc[nk][r] = bf2f(big[1024 + rm_off(4 * q + r, 16 * nk + l15)]);
  __syncthreads();
#pragma unroll
  for (int r = 0; r < 4; ++r) { const int i = 4 * q + r, j = l15;
    AbF[i * 16 + j] = j < i ? ab[r] : 0.f; AK[i * 16 + j] = f2bf(j < i ? ak[r] : 0.f);
    RB[i * 16 + j] = f2bf(j <= i ? rb[r] : 0.f); RK[i * 16 + j] = f2bf(j <= i ? rk[r] : 0.f); }
  { bf16_t* KKMT = big; bf16_t* VTT = big + 1024; bf16_t* BHT = big + 2048; bf16_t* KHT = big + 3072;
#pragma unroll
    for (int i = 0; i < 16; ++i) { KKMT[lane * 16 + i] = f2bf(kkm[i]); VTT[lane * 16 + i] = f2bf(vv[i]); BHT[lane * 16 + i] = f2bf(bneg[i] * WC); KHT[lane * 16 + i] = f2bf(kneg[i] * WC); } }
  __syncthreads();
  { float t[16];
#pragma unroll
    for (int i = 0; i < 16; ++i) { float acc = (i == l15) ? 1.f : 0.f;
#pragma unroll
      for (int j = 0; j < i; ++j) acc -= AbF[i * 16 + j] * t[j];
      t[i] = acc; }
    if (q == 0) {
#pragma unroll
      for (int i = 0; i < 16; ++i) TN[i * 16 + l15] = f2bf(-t[i]); } }
  __syncthreads();
  const size_t ci = (size_t)((b * 2 + dir) * 4 + h) * NC16 + c;
  bf16_t* MLg = (bf16_t*)(p.ws + Ws::RML) + ci * 4096; bf16_t* Ng = (bf16_t*)(p.ws + Ws::RNS) + ci * 4096;
  bf16_t* Gg = (bf16_t*)(p.ws + Ws::RG) + ci * 1024; float* Y0g = (float*)(p.ws + Ws::RY0) + ci * 1024;
  const bf16x4v a_T = ld4(TN + l15 * 16 + 4 * q), a_Ak = ld4(AK + l15 * 16 + 4 * q), a_Rb = ld4(RB + l15 * 16 + 4 * q), a_Rk = ld4(RK + l15 * 16 + 4 * q);
  const f32x4 z4 = f32x4{0.f, 0.f, 0.f, 0.f};
  bf16x4v vfr[4], qfr[4], pfr[4];
#pragma unroll
  for (int n = 0; n < 4; ++n) {
    vfr[n] = ld4(big + 1024 + (16 * n + l15) * 16 + 4 * q);
    const f32x4 akv = MFMA16K16(a_Ak, vfr[n], z4);
    qfr[n] = cvt4(MFMA16K16(a_T, cvt4(akv), z4));
    pfr[n] = cvt4(MFMA16K16(a_T, ld4(big + (16 * n + l15) * 16 + 4 * q), z4)); }
  const bf16x8 a_RbRk = cat44(a_Rb, a_Rk);
#pragma unroll
  for (int n = 0; n < 4; ++n) {
    const f32x4 g = MFMA16K16(a_Rb, pfr[n], gacc[n]);
    const f32x4 y0 = MFMA16(a_RbRk, cat44(qfr[n], vfr[n]), z4);
#pragma unroll
    for (int r = 0; r < 4; ++r) { Gg[(4 * q + r) * 64 + 16 * n + l15] = f2bf(g[r]); Y0g[(4 * q + r) * 64 + 16 * n + l15] = y0[r]; } }
#pragma unroll
  for (int mk = 0; mk < 4; ++mk) {
    const bf16x4v a_B = ld4(big + 2048 + (16 * mk + l15) * 16 + 4 * q), a_K = ld4(big + 3072 + (16 * mk + l15) * 16 + 4 * q);
    const bf16x8 a_BK = cat44(a_B, a_K);
#pragma unroll
    for (int n = 0; n < 4; ++n) {
      const f32x4 m = MFMA16K16(a_B, pfr[n], z4);
      const f32x4 nn = MFMA16(a_BK, cat44(qfr[n], vfr[n]), z4);
#pragma unroll
      for (int r = 0; r < 4; ++r) MLg[((mk * 2 + (n >> 1)) * 64 + (l15 >> 2) * 16 + 4 * q + r) * 8 + (n & 1) * 4 + (l15 & 3)] = f2bf(m[r]);
      *(bf16x4v*)(Ng + (n * 64 + lane) * 16 + mk * 4) = cvt4(nn); } }
  ((float*)(p.ws + Ws::RWC))[ci * 64 + ((lane >> 2) & 3) * 16 + (lane >> 4) * 4 + (lane & 3)] = WC;
}
struct RwStep { bf16x8 ml[4][2]; bf16x8 n[2]; f32x4 wc[4]; };
DEVFN void rw_load(RwStep& t, const bf16_t* MLg, const bf16_t* NSg, const float* WCg, int c, int lane, int q) {
#pragma unroll
  for (int mk = 0; mk < 4; ++mk) { t.ml[mk][0] = ld8g(MLg + (size_t)c * 4096 + ((mk * 2 + 0) * 64 + lane) * 8); t.ml[mk][1] = ld8g(MLg + (size_t)c * 4096 + ((mk * 2 + 1) * 64 + lane) * 8);
    t.wc[mk] = *(const AS1 f32x4*)gptr(WCg + (size_t)c * 64 + q * 16 + mk * 4); }
  t.n[0] = ld8g(NSg + (size_t)c * 4096 + lane * 16); t.n[1] = ld8g(NSg + (size_t)c * 4096 + lane * 16 + 8);
}
DEVFN void rw_step(const RwStep& t, f32x4 (&S)[4], bf16_t* NSg, int c, int q, int l15) {
  bf16x4v sb[4];
#pragma unroll
  for (int mk = 0; mk < 4; ++mk) sb[mk] = cvt4(S[mk]);
  const bf16x8 bf0 = cat44(sb[0], sb[1]), bf1 = cat44(sb[2], sb[3]);
#pragma unroll
  for (int mk = 0; mk < 4; ++mk) {
    f32x4 acc;
#pragma unroll
    for (int r = 0; r < 4; ++r) acc[r] = bf2f((bf16_t)t.n[mk >> 1][(mk & 1) * 4 + r]) + t.wc[mk][r] * S[mk][r];
    acc = MFMA16(t.ml[mk][0], bf0, acc);
    acc = MFMA16(t.ml[mk][1], bf1, acc);
    S[mk] = acc; }
#pragma unroll
  for (int mk = 0; mk < 4; ++mk) *(AS1 bf16x4v*)gptr(NSg + (size_t)c * 4096 + l15 * 64 + 16 * mk + 4 * q) = sb[mk];
}
DEVFN void rwkv_scan(const Params& p, int chain) {
  const int tid = TIDX, lane = tid & 63, wave = tid >> 6, q = lane >> 4, l15 = lane & 15;
  const bf16_t* MLg = (const bf16_t*)(p.ws + Ws::RML) + (size_t)chain * NC16 * 4096;
  bf16_t* NSg = (bf16_t*)(p.ws + Ws::RNS) + (size_t)chain * NC16 * 4096 + wave * 1024;
  const float* WCg = (const float*)(p.ws + Ws::RWC) + (size_t)chain * NC16 * 64;
  f32x4 S[4];
#pragma unroll
  for (int mk = 0; mk < 4; ++mk) S[mk] = f32x4{0.f, 0.f, 0.f, 0.f};
  RwStep t0, t1, t2;
#define RWC_(x) ((x) < NC16 ? (x) : NC16 - 1)
  rw_load(t0, MLg, NSg, WCg, 0, lane, q);
  rw_load(t1, MLg, NSg, WCg, RWC_(1), lane, q);
  int c = 0;
  for (; c + 2 < NC16; c += 3) {
    rw_load(t2, MLg, NSg, WCg, c + 2, lane, q);
    rw_step(t0, S, NSg, c, q, l15);
    rw_load(t0, MLg, NSg, WCg, RWC_(c + 3), lane, q);
    rw_step(t1, S, NSg, c + 1, q, l15);
    rw_load(t1, MLg, NSg, WCg, RWC_(c + 4), lane, q);
    rw_step(t2, S, NSg, c + 2, q, l15);
  }
  if (c < NC16) { rw_step(t0, S, NSg, c, q, l15); if (c + 1 < NC16) rw_step(t1, S, NSg, c + 1, q, l15); }
#undef RWC_
}
DEVFN void rwkv_out(const Params& p, int unit_base) {
  const int tid = TIDX, lane = tid & 63, wave = tid >> 6, q = lane >> 4, l15 = lane & 15;
  const int unit = unit_base + wave;
  const int c = unit % NC16, h = (unit / NC16) & 3, dir = (unit / (NC16 * 4)) & 1, b = unit / (NC16 * 8);
  const size_t ci = (size_t)((b * 2 + dir) * 4 + h) * NC16 + c;
  const bf16_t* Sg = (const bf16_t*)(p.ws + Ws::RNS) + ci * 4096; const bf16_t* Gg = (const bf16_t*)(p.ws + Ws::RG) + ci * 1024;
  const float* Y0g = (const float*)(p.ws + Ws::RY0) + ci * 1024;
  float* YR = (float*)(p.ws + Ws::YR) + (size_t)dir * NT_ * 256;
  const bf16x8 a0 = ld8(Gg + l15 * 64 + 8 * q), a1 = ld8(Gg + l15 * 64 + 32 + 8 * q);
#pragma unroll
  for (int n = 0; n < 4; ++n) {
    f32x4 acc;
#pragma unroll
    for (int r = 0; r < 4; ++r) acc[r] = Y0g[(4 * q + r) * 64 + 16 * n + l15];
    acc = MFMA16(a0, ld8(Sg + n * 1024 + l15 * 64 + 8 * q), acc);
    acc = MFMA16(a1, ld8(Sg + n * 1024 + l15 * 64 + 32 + 8 * q), acc);
#pragma unroll
    for (int r = 0; r < 4; ++r) YR[(size_t)(b * T_ + tokmap(dir, c * 16 + 4 * q + r)) * 256 + h * 64 + 16 * n + l15] = acc[r]; }
}
DEVFN int cscan(int dir, int co, int nctx, int nc) { return dir == 0 ? co : (co < nctx ? nctx - 1 - co : 2 * nctx + nc - 1 - co); }
DEVFN bf16x8 ld4x2(const bf16_t* p0, const bf16_t* p1) { bf16x4v a = *(const bf16x4v*)p0, b = *(const bf16x4v*)p1; return bf16x8{a[0], a[1], a[2], a[3], b[0], b[1], b[2], b[3]}; }

DEVFN void ssd_chunk_scalars(const Params& p, int l, int b, int co, int h, float* f) {
  const int tid = TIDX, d = tid >> 7, j = tid & 127;
  const float* DTB = (const float*)(p.ws + Ws::DTB);
  const float nega = -expf(INP(I_ALOG)[(size_t)l * 16 + d * 8 + h]);
  const float dt = DTB[(size_t)(b * T_ + co * 128 + j) * 16 + d * 8 + h];
  __syncthreads();
  f[256 + d * 128 + j] = dt;
  float* cur = f + d * 128; float* tmp = f + 512 + d * 128;
  cur[j] = dt * nega;
  __syncthreads();
  for (int off = 1; off < 128; off <<= 1) {
    float v = cur[j] + (j >= off ? cur[j - off] : 0.f);
    tmp[j] = v;
    __syncthreads();
    cur[j] = tmp[j];
    __syncthreads();
  }
}
DEVFN void ssd_states(const Params& p, int l, int unit, unsigned char* smem) {
  const int tid = TIDX, lane = tid & 63, wave = tid >> 6, q = lane >> 4, l15 = lane & 15;
  const int h = unit & 7, co = (unit >> 3) % NC128, b = unit / (8 * NC128), grp = h >> 2;
  float* f = (float*)smem;
  ssd_chunk_scalars(p, l, b, co, h, f);
  { const int d = tid >> 7, j = tid & 127; const float* cum = f + d * 128; const float dt = f[256 + d * 128 + j];
    float w = d == 0 ? expf(cum[127] - cum[j]) * dt : expf(j > 0 ? cum[j - 1] : 0.f) * dt;
    f[512 + d * 128 + j] = w; }
  __syncthreads();
  const bf16_t* XT = (const bf16_t*)(p.ws + Ws::XBCT) + (size_t)(b * NC128 + co) * 768 * 128;
  f32x4 acc[2][8];
#pragma unroll
  for (int d = 0; d < 2; ++d)
#pragma unroll
    for (int n = 0; n < 8; ++n) acc[d][n] = f32x4{0.f, 0.f, 0.f, 0.f};
#pragma unroll 1
  for (int s4 = 0; s4 < 4; ++s4) {
    const int j0 = s4 * 32 + q * 8;
    bf16x8 xa = ld8(XT + (size_t)(h * 64 + wave * 16 + l15) * 128 + j0), a0, a1;
#pragma unroll
    for (int jj = 0; jj < 8; ++jj) { float x = bf2f((bf16_t)xa[jj]); a0[jj] = (short)f2bf(x * f[512 + j0 + jj]); a1[jj] = (short)f2bf(x * f[640 + j0 + jj]); }
#pragma unroll
    for (int n = 0; n < 8; ++n) { bf16x8 bb = ld8(XT + (size_t)(512 + grp * 128 + n * 16 + l15) * 128 + j0);
      acc[0][n] = MFMA16(a0, bb, acc[0][n]); acc[1][n] = MFMA16(a1, bb, acc[1][n]); }
  }
#pragma unroll
  for (int d = 0; d < 2; ++d) {
    const int cs = cscan(d, co, CTX_ / 128, SEQ_ / 128);
    float* ST = (float*)(p.ws + Ws::SST) + ((size_t)((d * B_ + b) * NC128 + cs) * 8 + h) * 8192;
#pragma unroll
    for (int n = 0; n < 8; ++n)
#pragma unroll
      for (int r = 0; r < 4; ++r) ST[(wave * 16 + q * 4 + r) * 128 + n * 16 + l15] = acc[d][n][r];
    if (tid == 0) ((float*)(p.ws + Ws::SCD))[((size_t)(d * B_ + b) * NC128 + cs) * 8 + h] = expf(f[d * 128 + 127]);
  }
}
#define SSD_SB ((NC128 % 17) == 0 ? 17 : NC128)
DEVFN void ssd_scan(const Params& p, int gtid, int gthreads) {
  const float* __restrict__ ST = (const float*)(p.ws + Ws::SST); const float* __restrict__ CD = (const float*)(p.ws + Ws::SCD); bf16_t* __restrict__ HIN = (bf16_t*)(p.ws + Ws::HIN);
  for (int e = gtid; e < 2 * B_ * 8 * 8192; e += gthreads) {
    const int pd = e & 8191, h = (e >> 13) & 7, db = e >> 16;
    float hv = 0.f;
#pragma unroll 1
    for (int c0 = 0; c0 < NC128; c0 += SSD_SB) {
      float st[SSD_SB], cd[SSD_SB];
#pragma unroll
      for (int i = 0; i < SSD_SB; ++i) { st[i] = ST[((size_t)(db * NC128 + c0 + i) * 8 + h) * 8192 + pd]; cd[i] = CD[(size_t)(db * NC128 + c0 + i) * 8 + h]; }
#pragma unroll
      for (int i = 0; i < SSD_SB; ++i) { HIN[((size_t)(db * NC128 + c0 + i) * 8 + h) * 8192 + pd] = f2bf(hv); hv = hv * cd[i] + st[i]; }
    }
  }
}
DEVFN void ssd_out(const Params& p, int l, int unit, unsigned char* smem) {
  const int tid = TIDX, lane = tid & 63, wave = tid >> 6, q = lane >> 4, l15 = lane & 15;
  const int h = unit & 7, co = (unit >> 3) % NC128, b = unit / (8 * NC128), grp = h >> 2;
  float* f = (float*)smem;
  ssd_chunk_scalars(p, l, b, co, h, f);
  if (tid < 128) f[640 + tid] = f[128 + 127] - (tid > 0 ? f[128 + tid - 1] : 0.f);
  __syncthreads();
  const float* cum0 = f; const float* suf1 = f + 640; const float* dt0 = f + 256; const float* dt1 = f + 384;
  const bf16_t* XBC = (const bf16_t*)(p.ws + Ws::XBC) + (size_t)(b * T_ + co * 128) * 1024;
  const bf16_t* XT = (const bf16_t*)(p.ws + Ws::XBCT) + (size_t)(b * NC128 + co) * 768 * 128;
  const bf16_t* Cb = XBC + (size_t)(wave * 32 + l15) * 1024 + 768 + grp * 128 + q * 8;
  f32x4 y[4][2];
  { f32x4 o0[4][2], o1[4][2];
#pragma unroll
    for (int mp = 0; mp < 4; ++mp)
#pragma unroll
      for (int ni = 0; ni < 2; ++ni) { o0[mp][ni] = f32x4{0.f, 0.f, 0.f, 0.f}; o1[mp][ni] = f32x4{0.f, 0.f, 0.f, 0.f}; }
    const int cs0 = cscan(0, co, CTX_ / 128, SEQ_ / 128), cs1 = cscan(1, co, CTX_ / 128, SEQ_ / 128);
    const bf16_t* H0 = (const bf16_t*)(p.ws + Ws::HIN) + ((size_t)((0 * B_ + b) * NC128 + cs0) * 8 + h) * 8192;
    const bf16_t* H1 = (const bf16_t*)(p.ws + Ws::HIN) + ((size_t)((1 * B_ + b) * NC128 + cs1) * 8 + h) * 8192;
#pragma unroll 1
    for (int s4 = 0; s4 < 4; ++s4) { const bf16x8 c0 = ld8(Cb + s4 * 32), c1 = ld8(Cb + 16 * 1024 + s4 * 32);
#pragma unroll
      for (int mp = 0; mp < 4; ++mp) { bf16x8 h0 = ld8(H0 + (size_t)(mp * 16 + l15) * 128 + s4 * 32 + q * 8), h1 = ld8(H1 + (size_t)(mp * 16 + l15) * 128 + s4 * 32 + q * 8);
        o0[mp][0] = MFMA16(h0, c0, o0[mp][0]); o0[mp][1] = MFMA16(h0, c1, o0[mp][1]);
        o1[mp][0] = MFMA16(h1, c0, o1[mp][0]); o1[mp][1] = MFMA16(h1, c1, o1[mp][1]); } }
#pragma unroll
    for (int ni = 0; ni < 2; ++ni) { const int i = wave * 32 + ni * 16 + l15; const float e0 = expf(cum0[i]), e1 = expf(suf1[i]);
#pragma unroll
      for (int mp = 0; mp < 4; ++mp)
#pragma unroll
        for (int r = 0; r < 4; ++r) y[mp][ni][r] = e0 * o0[mp][ni][r] + e1 * o1[mp][ni][r]; } }
  bf16x8 mfr[4][2];
  { f32x4 g[8][2];
#pragma unroll
    for (int mj = 0; mj < 8; ++mj) { g[mj][0] = f32x4{0.f, 0.f, 0.f, 0.f}; g[mj][1] = f32x4{0.f, 0.f, 0.f, 0.f}; }
#pragma unroll 1
    for (int s4 = 0; s4 < 4; ++s4) { const bf16x8 c0 = ld8(Cb + s4 * 32), c1 = ld8(Cb + 16 * 1024 + s4 * 32);
#pragma unroll
      for (int mj = 0; mj < 8; ++mj) { bf16x8 bb = ld8(XBC + (size_t)(mj * 16 + l15) * 1024 + 512 + grp * 128 + s4 * 32 + q * 8);
        g[mj][0] = MFMA16(bb, c0, g[mj][0]); g[mj][1] = MFMA16(bb, c1, g[mj][1]); } }
    const int i0 = wave * 32 + l15, i1 = i0 + 16;
    const float c0i0 = cum0[i0], s1i0 = suf1[i0], c0i1 = cum0[i1], s1i1 = suf1[i1];
#pragma unroll
    for (int mj = 0; mj < 8; ++mj)
#pragma unroll
      for (int r = 0; r < 4; ++r) { const int j = mj * 16 + q * 4 + r;
        const float cj = cum0[j], sj = suf1[j], d0 = dt0[j], d1 = dt1[j];
        const float lw0 = (j <= i0 ? expf(c0i0 - cj) * d0 : 0.f) + (j >= i0 ? expf(s1i0 - sj) * d1 : 0.f);
        const float lw1 = (j <= i1 ? expf(c0i1 - cj) * d0 : 0.f) + (j >= i1 ? expf(s1i1 - sj) * d1 : 0.f);
        mfr[mj >> 1][0][(mj & 1) * 4 + r] = (short)f2bf(g[mj][0][r] * lw0);
        mfr[mj >> 1][1][(mj & 1) * 4 + r] = (short)f2bf(g[mj][1][r] * lw1); } }
#pragma unroll
  for (int s4 = 0; s4 < 4; ++s4)
#pragma unroll
    for (int mp = 0; mp < 4; ++mp) { const bf16_t* xr = XT + (size_t)(h * 64 + mp * 16 + l15) * 128 + s4 * 32 + q * 4;
      bf16x8 xa = ld4x2(xr, xr + 16);
      y[mp][0] = MFMA16(xa, mfr[s4][0], y[mp][0]); y[mp][1] = MFMA16(xa, mfr[s4][1], y[mp][1]); }
  __syncthreads();
  float* yl = f + 1024;
#pragma unroll
  for (int mp = 0; mp < 4; ++mp)
#pragma unroll
    for (int ni = 0; ni < 2; ++ni)
#pragma unroll
      for (int r = 0; r < 4; ++r) yl[(wave * 32 + ni * 16 + l15) * 65 + mp * 16 + q * 4 + r] = y[mp][ni][r];
  __syncthreads();
  float* YS = (float*)(p.ws + Ws::YS) + (size_t)(b * T_ + co * 128) * 512 + h * 64;
  for (int e = tid; e < 128 * 64; e += 256) YS[(size_t)(e >> 6) * 512 + (e & 63)] = yl[(e >> 6) * 65 + (e & 63)];
}

#define GQ_LD 40
#define GK_LD 72
DEVFN void gla_chunk(const Params& p, int unit, unsigned char* smem) {
  const int tid = TIDX, lane = tid & 63, wave = tid >> 6, q = lane >> 4, l15 = lane & 15;
  const int h = unit & 3, co = (unit >> 2) % NC64, b = unit / (4 * NC64);
  const bf16_t* ZX = (const bf16_t*)(p.ws + Ws::ZX) + (size_t)(b * T_ + co * 64) * NIN_;
  const float* LA = (const float*)(p.ws + Ws::LA);
  float* cum = (float*)smem;
  bf16_t* qs = (bf16_t*)(smem + 16384);
  bf16_t* ks = qs + 2 * 64 * GQ_LD;
  bf16_t* kt = ks + 2 * 64 * GQ_LD;
  __syncthreads();
  for (int e = tid; e < 2 * 64 * 32; e += 256) { const int d = e >> 11, i = (e >> 5) & 63, dd = e & 31;
    cum[e] = LA[((size_t)d * NT_ + b * T_ + co * 64 + i) * 128 + h * 32 + dd]; }
  __syncthreads();
  if (tid < 64) { const int d = tid >> 5, dd = tid & 31; float* c = cum + d * 2048 + dd; float sacc = 0.f;
    if (d == 0) for (int i = 0; i < 64; ++i) { sacc += c[i * 32]; c[i * 32] = sacc; }
    else for (int i = 63; i >= 0; --i) { sacc += c[i * 32]; c[i * 32] = sacc; } }
  __syncthreads();
  bf16_t* QT = (bf16_t*)(p.ws + Ws::QT);
  for (int e = tid; e < 64 * 32; e += 256) { const int i = e >> 5, dd = e & 31;
    const float qv = bf2f(ZX[(size_t)i * NIN_ + OGQ + h * 32 + dd]) * 0.17677669529663687f, kv = bf2f(ZX[(size_t)i * NIN_ + OGK + h * 32 + dd]);
    const float c0 = cum[i * 32 + dd], c1 = cum[2048 + i * 32 + dd], t0 = cum[63 * 32 + dd], t1 = cum[2048 + dd];
    const bf16_t q0 = f2bf(qv * expf(c0)), q1 = f2bf(qv * expf(c1));
    qs[i * GQ_LD + dd] = q0; qs[64 * GQ_LD + i * GQ_LD + dd] = q1;
    ks[i * GQ_LD + dd] = f2bf(kv * expf(-c0)); ks[64 * GQ_LD + i * GQ_LD + dd] = f2bf(kv * expf(-c1));
    kt[dd * GK_LD + i] = f2bf(kv * expf(t0 - c0)); kt[32 * GK_LD + dd * GK_LD + i] = f2bf(kv * expf(t1 - c1));
    const size_t tok = (size_t)b * T_ + co * 64 + i;
    QT[tok * 128 + h * 32 + dd] = q0; QT[((size_t)NT_ + tok) * 128 + h * 32 + dd] = q1; }
  if (tid < 64) { const int d = tid >> 5, dd = tid & 31; const int cs = cscan(d, co, CTX_ / 64, SEQ_ / 64);
    ((float*)(p.ws + Ws::GCD))[(((size_t)(d * B_ + b) * NC64 + cs) * 4 + h) * 32 + dd] = expf(d == 0 ? cum[63 * 32 + dd] : cum[2048 + dd]); }
  __syncthreads();
  bf16x8 pfr[2];
  { f32x4 p0[4], p1[4];
    const bf16x8 qb0 = ld8(qs + (wave * 16 + l15) * GQ_LD + q * 8), qb1 = ld8(qs + 64 * GQ_LD + (wave * 16 + l15) * GQ_LD + q * 8);
#pragma unroll
    for (int mj = 0; mj < 4; ++mj) { p0[mj] = MFMA16(ld8(ks + (mj * 16 + l15) * GQ_LD + q * 8), qb0, (f32x4{0.f, 0.f, 0.f, 0.f}));
      p1[mj] = MFMA16(ld8(ks + 64 * GQ_LD + (mj * 16 + l15) * GQ_LD + q * 8), qb1, (f32x4{0.f, 0.f, 0.f, 0.f})); }
    const int i = wave * 16 + l15;
#pragma unroll
    for (int mj = 0; mj < 4; ++mj)
#pragma unroll
      for (int r = 0; r < 4; ++r) { const int j = mj * 16 + q * 4 + r; pfr[mj >> 1][(mj & 1) * 4 + r] = (short)f2bf((j <= i ? p0[mj][r] : 0.f) + (j >= i ? p1[mj][r] : 0.f)); } }
  const bf16_t* VT = (const bf16_t*)(p.ws + Ws::VT) + ((size_t)(b * NC64 + co) * 256 + h * 64) * 64;
  f32x4 o[4];
#pragma unroll
  for (int md = 0; md < 4; ++md) { o[md] = f32x4{0.f, 0.f, 0.f, 0.f};
#pragma unroll
    for (int s2 = 0; s2 < 2; ++s2) { const bf16_t* vr = VT + (size_t)(md * 16 + l15) * 64 + s2 * 32 + q * 4; o[md] = MFMA16(ld4x2(vr, vr + 16), pfr[s2], o[md]); } }
#pragma unroll
  for (int d = 0; d < 2; ++d) { const int cs = cscan(d, co, CTX_ / 64, SEQ_ / 64);
    float* GST = (float*)(p.ws + Ws::GST) + (((size_t)(d * B_ + b) * NC64 + cs) * 4 + h) * 2048;
#pragma unroll
    for (int nd = 0; nd < 2; ++nd) { f32x4 st = f32x4{0.f, 0.f, 0.f, 0.f};
#pragma unroll
      for (int s2 = 0; s2 < 2; ++s2) st = MFMA16(ld8(VT + (size_t)(wave * 16 + l15) * 64 + s2 * 32 + q * 8), ld8(kt + d * 32 * GK_LD + (nd * 16 + l15) * GK_LD + s2 * 32 + q * 8), st);
#pragma unroll
      for (int r = 0; r < 4; ++r) GST[(wave * 16 + q * 4 + r) * 32 + nd * 16 + l15] = st[r]; } }
  __syncthreads();
  float* ol = (float*)smem;
#pragma unroll
  for (int md = 0; md < 4; ++md)
#pragma unroll
    for (int r = 0; r < 4; ++r) ol[(wave * 16 + l15) * 65 + md * 16 + q * 4 + r] = o[md][r];
  __syncthreads();
  float* OI = (float*)(p.ws + Ws::OI) + (size_t)(b * T_ + co * 64) * 256 + h * 64;
  for (int e = tid; e < 64 * 64; e += 256) OI[(size_t)(e >> 6) * 256 + (e & 63)] = ol[(e >> 6) * 65 + (e & 63)];
}
#define GLA_SB ((NC64 % 17) == 0 ? 17 : NC64)
DEVFN void gla_scan(const Params& p, int gtid, int gthreads) {
  const float* __restrict__ ST = (const float*)(p.ws + Ws::GST); const float* __restrict__ CD = (const float*)(p.ws + Ws::GCD); bf16_t* __restrict__ SIN = (bf16_t*)(p.ws + Ws::GSIN);
  for (int e = gtid; e < 2 * B_ * 4 * 2048; e += gthreads) {
    const int vd = e & 2047, h = (e >> 11) & 3, db = e >> 13;
    float sv = 0.f;
#pragma unroll 1
    for (int c0 = 0; c0 < NC64; c0 += GLA_SB) {
      float st[GLA_SB], cd[GLA_SB];
#pragma unroll
      for (int i = 0; i < GLA_SB; ++i) { st[i] = ST[(((size_t)db * NC64 + c0 + i) * 4 + h) * 2048 + vd]; cd[i] = CD[(((size_t)db * NC64 + c0 + i) * 4 + h) * 32 + (vd & 31)]; }
#pragma unroll
      for (int i = 0; i < GLA_SB; ++i) { SIN[(((size_t)db * NC64 + c0 + i) * 4 + h) * 2048 + vd] = f2bf(sv); sv = sv * cd[i] + st[i]; }
    }
  }
}
DEVFN void convert_moe_weights(const Params& p, int l, unsigned char* smem, int bid, int nb);
DEVFN void phase4a(const Params& p, int l, unsigned char* smem) {
  const int n_r = B_ * 8 * NC16 / 4;
  for (int u = BIDX; u < n_r; u += gridDim.x) rwkv_chunk(p, (u) * 4, smem);
  (void)l;
}
DEVFN void phase4b(const Params& p, int l, unsigned char* smem) {
  const int bid = BIDX, nrw = B_ * 8, G = (int)gridDim.x;
  const int n_s = B_ * NC128 * 8, n_g = B_ * NC64 * 4;
  int ob = bid, on = G;
  if (G >= 2 * nrw) { if (bid < nrw) { rwkv_scan(p, bid); return; } ob = bid - nrw; on = G - nrw; }
  else { for (int u = bid; u < nrw; u += G) rwkv_scan(p, u); }
  for (int u = ob; u < n_s + n_g; u += on) { if (u < n_s) ssd_states(p, l, u, smem); else gla_chunk(p, u - n_s, smem); }
  convert_moe_weights(p, l, smem, ob, on);
}
DEVFN void phase4b2(const Params& p) {
  const int bid = BIDX, G = (int)gridDim.x;
  ssd_scan(p, bid * 256 + TIDX, G * 256); gla_scan(p, bid * 256 + TIDX, G * 256);
}
DEVFN void phase4c(const Params& p, int l, unsigned char* smem) {
  const int n_s = B_ * NC128 * 8, n_r = B_ * 8 * NC16 / 4;
  for (int u = BIDX; u < n_s + n_r; u += gridDim.x) { if (u < n_s) ssd_out(p, l, u, smem); else rwkv_out(p, (u - n_s) * 4); }
}

DEVFN void phase5(const Params& p, int l, unsigned char* smem) {
  const int tid = TIDX, lane = tid & 63, wave = tid >> 6;
  const bf16_t* ZX = (const bf16_t*)(p.ws + Ws::ZX);
  const bf16_t* XBC = (const bf16_t*)(p.ws + Ws::XBC);
  const float* YS = (const float*)(p.ws + Ws::YS); const float* YR = (const float*)(p.ws + Ws::YR); const float* OI = (const float*)(p.ws + Ws::OI);
  const bf16_t* QT = (const bf16_t*)(p.ws + Ws::QT); const bf16_t* GSIN = (const bf16_t*)(p.ws + Ws::GSIN);
  const bf16_t* RR = (const bf16_t*)(p.ws + Ws::RR); const bf16_t* VV = (const bf16_t*)(p.ws + Ws::VV); const bf16_t* KD = (const bf16_t*)(p.ws + Ws::KD);
  const float* GATE = (const float*)(p.ws + Ws::GATE);
  bf16_t* YM = (bf16_t*)(p.ws + Ws::YMIX);
  float* red = (float*)smem;
  float* qt = red + 16;
  const float dA = INP(I_SSDD)[(size_t)l * 8 + (tid >> 6)], dB = INP(I_SSDD)[(size_t)l * 8 + 4 + (tid >> 6)];
  const float nwA = INP(I_SSDNW)[(size_t)l * 512 + tid], nwB = INP(I_SSDNW)[(size_t)l * 512 + 256 + tid];
  const float lnw = INP(I_LNXW)[(size_t)l * 256 + tid], lnb = INP(I_LNXB)[(size_t)l * 256 + tid], rk = INP(I_RK)[(size_t)l * 256 + tid];
  const float gnw = INP(I_GNW)[(size_t)l * 256 + tid];
  for (int tok = BIDX; tok < NT_; tok += gridDim.x) {
    float ya = YS[(size_t)tok * 512 + tid] + dA * bf2f(XBC[(size_t)tok * 1024 + tid]);
    float yb = YS[(size_t)tok * 512 + 256 + tid] + dB * bf2f(XBC[(size_t)tok * 1024 + 256 + tid]);
    ya *= siluf_(zxv(ZX, tok, OZ + tid)); yb *= siluf_(zxv(ZX, tok, OZ + 256 + tid));
    float qa = wave_sum(ya * ya), qb = wave_sum(yb * yb);
    __syncthreads();
    if (lane == 0) { red[wave] = qa; red[4 + wave] = qb; }
    qt[tid] = bf2f(QT[((size_t)(tid >> 7) * NT_ + tok) * 128 + (tid & 127)]);
    __syncthreads();
    float ma = (red[0] + red[1] + red[2] + red[3]) * (1.f / 256.f), mb = (red[4] + red[5] + red[6] + red[7]) * (1.f / 256.f);
    YM[(size_t)tok * 1024 + tid] = f2bf(ya * rsqrtf(ma + 1e-5f) * nwA);
    YM[(size_t)tok * 1024 + 256 + tid] = f2bf(yb * rsqrtf(mb + 1e-5f) * nwB);
    { float y = YR[(size_t)tok * 256 + tid] + YR[((size_t)NT_ + tok) * 256 + tid];
      float mu = wave_sum(y) * (1.f / 64.f), d = y - mu, var = wave_sum(d * d) * (1.f / 64.f);
      float yn = d * rsqrtf(var + 64e-5f) * lnw + lnb;
      float r = bf2f(RR[(size_t)tok * 256 + tid]), kf = bf2f(KD[(size_t)tok * 256 + tid]), kb = bf2f(KD[((size_t)NT_ + tok) * 256 + tid]);
      float bonus = wave_sum(r * (kf + kb) * rk) * bf2f(VV[(size_t)tok * 256 + tid]);
      YM[(size_t)tok * 1024 + 512 + tid] = f2bf((yn + bonus) * GATE[(size_t)tok * 256 + tid]); }
    { float o = OI[(size_t)tok * 256 + tid];
      const int b = tok / T_, co = (tok % T_) / 64;
#pragma unroll
      for (int d = 0; d < 2; ++d) { const int cs = cscan(d, co, CTX_ / 64, SEQ_ / 64);
        const bf16_t* sr = GSIN + ((((size_t)(d * B_ + b) * NC64 + cs) * 4 + wave) * 64 + lane) * 32;
#pragma unroll
        for (int c8 = 0; c8 < 4; ++c8) { bf16x8 sv = ld8(sr + c8 * 8);
#pragma unroll
          for (int jj = 0; jj < 8; ++jj) o += qt[d * 128 + wave * 32 + c8 * 8 + jj] * bf2f((bf16_t)sv[jj]); } }
      float ms = wave_sum(o * o) * (1.f / 64.f);
      YM[(size_t)tok * 1024 + 768 + tid] = f2bf(o * rsqrtf(ms + 1e-5f) * gnw * siluf_(zxv(ZX, tok, OOG + tid))); }
  }
}

DEVFN void phase6(const Params& p, int l, unsigned char* smem) {
  const bf16_t* A = (const bf16_t*)(p.ws + Ws::YMIX);
  const bf16_t* W = (const bf16_t*)(p.ws + Ws::WOUT) + (size_t)l * 1024 * 1024;
  float* MIX = (float*)(p.ws + Ws::MIX);
  for (int u = BIDX; u < (NT_ / 128) * 8; u += gridDim.x) {
    int rt = u / 8, ct = u % 8;
    gemm_tile(smem, 1024,
      [&](int r) { return A + (size_t)(rt * 128 + r) * 1024; },
      [&](int r) { return W + (size_t)(ct * 128 + r) * 1024; },
      [&](f32x4 (&acc)[4][4], int wr, int wc, int g, int l15) {
#pragma unroll
        for (int mi = 0; mi < 4; ++mi)
#pragma unroll
          for (int ni = 0; ni < 4; ++ni)
#pragma unroll
            for (int i = 0; i < 4; ++i) MIX[(size_t)(rt * 128 + wr * 64 + mi * 16 + 4 * g + i) * 1024 + ct * 128 + wc * 64 + ni * 16 + l15] = acc[mi][ni][i];
      });
  }
}

DEVFN void phase7(const Params& p, int l, unsigned char* smem) {
  const int lane = TIDX & 63, wave = TIDX >> 6;
  float* X = (float*)(p.ws + Ws::X);
  const float* MIX = (const float*)(p.ws + Ws::MIX);
  bf16_t* H = (bf16_t*)(p.ws + Ws::U);
  const float* rwt = (const float*)(p.ws + Ws::RWT) + (size_t)l * 64 * 1024;
  int* cnt = (int*)(p.ws + Ws::CNT) + l * 64;
  int* ltok = (int*)(p.ws + Ws::LTOK); float* lwt = (float*)(p.ws + Ws::LWT);
  const float rbias = INP(I_RB)[(size_t)l * 64 + lane];
  float* hs = (float*)smem;
  float* lg = hs + 4096;
  for (int tok0 = BIDX * 4; tok0 < NT_; tok0 += gridDim.x * 4) {
    const int tok = tok0 + wave;
    const float* mod = (const float*)(p.ws + Ws::MOD) + ((size_t)l * NR_ + tok_modrow(tok)) * NMOD_;
    float xv[16], t0[16], t1[16], mean, rstd;
    load_row16(X + (size_t)tok * 1024, lane, xv);
    load_row16(MIX + (size_t)tok * 1024, lane, t0);
    load_row16(mod + 2 * 1024, lane, t1);
#pragma unroll
    for (int i = 0; i < 16; ++i) xv[i] = ALPHA_ * xv[i] + t1[i] * t0[i];
    row_stats(xv, mean, rstd);
    load_row16(INP(I_LN1W) + (size_t)l * 1024, lane, t0);
    load_row16(INP(I_LN1B) + (size_t)l * 1024, lane, t1);
#pragma unroll
    for (int i = 0; i < 16; ++i) xv[i] = (xv[i] - mean) * rstd * t0[i] + t1[i];
#pragma unroll
    for (int j = 0; j < 4; ++j) *(float4*)(X + (size_t)tok * 1024 + lane * 4 + 256 * j) = make_float4(xv[4 * j], xv[4 * j + 1], xv[4 * j + 2], xv[4 * j + 3]);
    const bool routed = !(l == DEPTH_ - 1 && (tok % T_) < CTX_);
    row_stats(xv, mean, rstd);
    load_row16(mod + 3 * 1024, lane, t0);
    load_row16(mod + 4 * 1024, lane, t1);
#pragma unroll
    for (int i = 0; i < 16; ++i) xv[i] = (xv[i] - mean) * rstd * (1.f + t1[i]) + t0[i];
    __syncthreads();
#pragma unroll
    for (int j = 0; j < 4; ++j) {
      if (routed) *(uint2*)(H + (size_t)tok * 1024 + lane * 4 + 256 * j) = make_uint2((unsigned)f2bf(xv[4 * j]) | ((unsigned)f2bf(xv[4 * j + 1]) << 16), (unsigned)f2bf(xv[4 * j + 2]) | ((unsigned)f2bf(xv[4 * j + 3]) << 16));
      *(float4*)(hs + wave * 1024 + lane * 4 + 256 * j) = make_float4(xv[4 * j], xv[4 * j + 1], xv[4 * j + 2], xv[4 * j + 3]); }
    __syncthreads();
    { float hv[4][16];
#pragma unroll
      for (int t = 0; t < 4; ++t)
#pragma unroll
        for (int j = 0; j < 4; ++j) { const float4 v = *(const float4*)(hs + t * 1024 + lane * 4 + 256 * j); hv[t][4 * j] = v.x; hv[t][4 * j + 1] = v.y; hv[t][4 * j + 2] = v.z; hv[t][4 * j + 3] = v.w; }
      float pe[64];
#pragma unroll
      for (int e = 0; e < 16; ++e) {
        float4 w[4];
#pragma unroll
        for (int j = 0; j < 4; ++j) w[j] = *(const float4*)(rwt + (size_t)(16 * wave + e) * 1024 + lane * 4 + 256 * j);
#pragma unroll
        for (int t = 0; t < 4; ++t) { float sacc = 0.f;
#pragma unroll
          for (int j = 0; j < 4; ++j) sacc += hv[t][4 * j] * w[j].x + hv[t][4 * j + 1] * w[j].y + hv[t][4 * j + 2] * w[j].z + hv[t][4 * j + 3] * w[j].w;
          pe[e * 4 + t] = sacc; } }
#pragma unroll
      for (int half = 32; half >= 1; half >>= 1) { const bool up = (lane & half) != 0;
#pragma unroll
        for (int e = 0; e < half; ++e) { const float send = up ? pe[e] : pe[e + half]; const float recv = __shfl_xor(send, half); pe[e] = (up ? pe[e + half] : pe[e]) + recv; } }
      lg[(lane & 3) * 64 + 16 * wave + (lane >> 2)] = pe[0]; }
    __syncthreads();
    if (!routed) continue;
    const float logit = lg[wave * 64 + lane];
    const float score = sigmoidf_(logit), sel = score + rbias;
    float m1 = sel; int a1 = lane;
#pragma unroll
    for (int m = 1; m <= 4; m <<= 1) { float ov = __shfl_xor(m1, m); int oa = __shfl_xor(a1, m); if (ov > m1 || (ov == m1 && oa < a1)) { m1 = ov; a1 = oa; } }
    float m2 = (lane == a1) ? -3.0e38f : sel;
#pragma unroll
    for (int m = 1; m <= 4; m <<= 1) m2 = fmaxf(m2, __shfl_xor(m2, m));
    const float gs = m1 + m2; const int grp = lane >> 3;
    int grank = 0;
#pragma unroll
    for (int g2 = 0; g2 < 8; ++g2) { float og = __shfl(gs, g2 * 8); grank += (og > gs || (og == gs && g2 < grp)) ? 1 : 0; }
    const bool gsel = grank < 4;
    const float msel = gsel ? sel : -3.0e38f;
    int rank = 0;
    for (int e = 0; e < 64; ++e) { float ov = __shfl(msel, e); rank += (ov > msel || (ov == msel && e < lane)) ? 1 : 0; }
    const bool chosen = gsel && rank < 8;
    const float wsum = wave_sum(chosen ? score : 0.f);
    if (chosen) { int pos = atomicAdd(&cnt[lane], 1); ltok[(size_t)lane * NT_ + pos] = tok * 8 + rank; lwt[(size_t)lane * NT_ + pos] = score / wsum * 2.5f; }
  }
}

struct MoeMap { int nblk_total; int e; int rb; int cnt; int hoff; };
DEVFN int moe_ntok(int l) { return l == DEPTH_ - 1 ? B_ * SEQ_ : NT_; }
DEVFN int moe_shared_tok(int l, int i) { return l == DEPTH_ - 1 ? (i / SEQ_) * T_ + CTX_ + (i % SEQ_) : i; }
DEVFN void moe_prefix(const Params& p, int l, int* pre) {
  const int* cnt = (const int*)(p.ws + Ws::CNT) + l * 64;
  __syncthreads();
  if (TIDX == 0) { int s = 0; for (int e = 0; e < 65; ++e) { pre[e] = s; int c = e < 64 ? cnt[e] : moe_ntok(l); pre[66 + e] = c; s += (c + 127) / 128; } pre[65] = s; }
  __syncthreads();
}
DEVFN void phase8(const Params& p, int l, unsigned char* smem) {
  int* pre = (int*)(smem + SM_PRE);
  moe_prefix(p, l, pre);
  const bf16_t* H = (const bf16_t*)(p.ws + Ws::U);
  const bf16_t* W13 = (const bf16_t*)(p.ws + Ws::W13);
  bf16_t* HID = (bf16_t*)(p.ws + Ws::HID);
  const int* ltok = (const int*)(p.ws + Ws::LTOK); const float* lwt = (const float*)(p.ws + Ws::LWT);
  const int total = pre[65];
  for (int u = BIDX; u < total * 4; u += gridDim.x) {
    const int gb = u >> 2, nt = u & 3;
    int e = 0; while (pre[e + 1] <= gb) ++e;
    const int rb = gb - pre[e], cnt = pre[66 + e];
    gemm_tile(smem, 1024,
      [&](int r) { int pos = rb * 128 + r; if (pos >= cnt) return (const bf16_t*)(p.ws + Ws::ZROW); int tok = e < 64 ? (ltok[(size_t)e * NT_ + pos] >> 3) : moe_shared_tok(l, pos); return H + (size_t)tok * 1024; },
      [&](int r) { return W13 + ((size_t)e * 512 + nt * 128 + r) * 1024; },
      [&](f32x4 (&acc)[4][4], int wr, int wc, int g, int l15) {
        tile_store_bf16<8>(smem, wr, g, l15,
          [&](bf16_t* T, int ldc) {
#pragma unroll
            for (int mi = 0; mi < 4; ++mi)
#pragma unroll
              for (int i = 0; i < 4; ++i) { const int r = wr * 64 + mi * 16 + 4 * g + i, pos = rb * 128 + r;
                const float gw = pos < cnt ? (e < 64 ? lwt[(size_t)e * NT_ + pos] : 1.f) : 0.f;
#pragma unroll
                for (int j = 0; j < 2; ++j) T[r * ldc + wc * 32 + j * 16 + l15] = f2bf(siluf_(acc[mi][2 * j][i]) * acc[mi][2 * j + 1][i] * gw); } },
          [&](int row, int c0) { const int pos = rb * 128 + row; return pos < cnt ? HID + ((size_t)gb * 128 + row) * 256 + nt * 64 + c0 : (bf16_t*)nullptr; });
      });
  }
}
DEVFN void phase9(const Params& p, int l, unsigned char* smem) {
  int* pre = (int*)(smem + SM_PRE);
  moe_prefix(p, l, pre);
  const bf16_t* HID = (const bf16_t*)(p.ws + Ws::HID);
  const bf16_t* W2T = (const bf16_t*)(p.ws + Ws::W2T);
  bf16_t* YB = (bf16_t*)(p.ws + Ws::YBUF);
  const int* ltok = (const int*)(p.ws + Ws::LTOK);
  const int total = pre[65];
  for (int u = BIDX; u < total * 8; u += gridDim.x) {
    const int gb = u >> 3, nt = u & 7;
    int e = 0; while (pre[e + 1] <= gb) ++e;
    const int rb = gb - pre[e], cnt = pre[66 + e];
    gemm_tile(smem, 256,
      [&](int r) { int pos = rb * 128 + r; return pos < cnt ? HID + ((size_t)gb * 128 + r) * 256 : (const bf16_t*)(p.ws + Ws::ZROW); },
      [&](int r) { return W2T + ((size_t)e * 1024 + nt * 128 + r) * 256; },
      [&](f32x4 (&acc)[4][4], int wr, int wc, int g, int l15) {
        tile_store_bf16<16>(smem, wr, g, l15,
          [&](bf16_t* T, int ldc) {
#pragma unroll
            for (int mi = 0; mi < 4; ++mi)
#pragma unroll
              for (int ni = 0; ni < 4; ++ni)
#pragma unroll
                for (int i = 0; i < 4; ++i) T[(wr * 64 + mi * 16 + 4 * g + i) * ldc + wc * 64 + ni * 16 + l15] = f2bf(acc[mi][ni][i]); },
          [&](int row, int c0) { const int pos = rb * 128 + row; if (pos >= cnt) return (bf16_t*)nullptr;
            const int ts = e < 64 ? ltok[(size_t)e * NT_ + pos] : moe_shared_tok(l, pos) * 8; const int tok = ts >> 3, slot = e < 64 ? (ts & 7) : 8;
            return YB + ((size_t)tok * NSLOT + slot) * 1024 + nt * 128 + c0; });
      });
  }
}

#define SMEM_BYTES (PH_SMEM + 2048)
#define N_PHASES (3 + 13 * DEPTH_)
__global__ void __launch_bounds__(256, 2) mega(Params p, int ph_lo, int ph_hi) {
#ifdef HIPEMU
  unsigned char* smem = hipemu::cur_smem();
#else
  unsigned char* smem = smem_dyn;
  volatile LAS unsigned* st = (volatile LAS unsigned*)(smem_dyn + SM_BAR);
  if (threadIdx.x == 0) {
    st[0] = 0u; st[1] = 0u;
    unsigned long long* tab = (unsigned long long*)(smem_dyn + SM_TAB);
#pragma unroll
    for (int i = 0; i < 40; ++i) tab[i] = (unsigned long long)p.in[i];
  }
  __syncthreads();
  XcdBarrier bar = xcd_barrier_post((unsigned*)(p.ws + Ws::BAR), st);
#define GRID_SYNC() xcd_barrier(bar)
#endif
  int ph = 0;
#ifdef ONLY_KIND
#define KIND_ON(k) ((k) == ONLY_KIND)
#else
#define KIND_ON(k) 1
#endif
#ifndef REPEAT_MASK
#define REPEAT_MASK 0u
#endif
#define RUN_PHASE(kind, code) { if (KIND_ON(kind) && ph >= ph_lo && ph < ph_hi) { \
    int nrep_ = ((REPEAT_MASK >> (kind)) & 1u) ? 2 : 1; LAUNDER(nrep_); \
    _Pragma("unroll 1") for (int rep_ = 0; rep_ < nrep_; ++rep_) { LAUNDER(p.ws); LAUNDER(p.out); code; if (rep_ + 1 < nrep_ || ph + 1 < ph_hi) { GRID_SYNC(); } } } ++ph; }
  RUN_PHASE(0, phase0(p, smem));
  RUN_PHASE(11, phase0b(p));
  for (int l = 0; l < DEPTH_; ++l) {
    RUN_PHASE(1, phase1(p, l));
    RUN_PHASE(2, phase2(p, l, smem));
    RUN_PHASE(3, phase3(p, l, smem));
    RUN_PHASE(14, phase3b(p, l, smem));
    RUN_PHASE(4, phase4a(p, l, smem));
    RUN_PHASE(12, phase4b(p, l, smem));
    RUN_PHASE(16, phase4b2(p));
    RUN_PHASE(13, phase4c(p, l, smem));
    RUN_PHASE(5, phase5(p, l, smem));
    RUN_PHASE(6, phase6(p, l, smem));
    RUN_PHASE(7, phase7(p, l, smem));
    RUN_PHASE(8, phase8(p, l, smem));
    RUN_PHASE(9, phase9(p, l, smem));
  }
  RUN_PHASE(10, phase_final(p));
}

extern "C" void kernel_launch(void* const* d_in, const int* in_sizes, int n_in, void* d_out, int out_size, void* d_ws, size_t ws_size, hipStream_t stream) {
  Params p{};
  for (int i = 0; i < 40; ++i) p.in[i] = (const float*)d_in[i];
  p.out = (float*)d_out;
  p.ws = (unsigned char*)d_ws;
  if (ws_size < Ws::END) { fprintf(stderr, "workspace too small: %zu < %zu\n", ws_size, (size_t)Ws::END); return; }
  hipMemsetAsync(d_ws, 0, Ws::ZERO_END, stream);
#ifdef HIPEMU
  int grid = 16; if (const char* e = getenv("EMU_GRID")) grid = atoi(e);
  int stop = N_PHASES; if (const char* e = getenv("EMU_STOP")) stop = atoi(e);
  if (getenv("EMU_ONE")) hipemu::launch(grid, 256, SMEM_BYTES, true, [=] { mega(p, 0, stop); });
  else for (int ph = 0; ph < stop; ++ph) hipemu::launch(grid, 256, SMEM_BYTES, false, [=] { mega(p, ph, ph + 1); });
#else
  static int grid = 0;
  if (!grid) {
    int dev = 0, cus = 0, per_cu = 0;
    hipGetDevice(&dev);
    hipDeviceGetAttribute(&cus, hipDeviceAttributeMultiprocessorCount, dev);
    hipOccupancyMaxActiveBlocksPerMultiprocessor(&per_cu, mega, 256, SMEM_BYTES);
    if (per_cu > 2) per_cu = 2;
    if (per_cu < 1) per_cu = 1;
    grid = cus * per_cu;
  }
#if N_LAUNCH_MODE == 1
  mega<<<grid, 256, SMEM_BYTES, stream>>>(p, 0, N_PHASES);
#else
  for (int ph = 0; ph < N_PHASES; ++ph) mega<<<grid, 256, SMEM_BYTES, stream>>>(p, ph, ph + 1);
#endif
#endif
}
```

```cpp
#ifndef HIPEMU
#include <hip/hip_runtime.h>
#endif
#include <stdint.h>
#include <stdio.h>

#ifndef B_
#define B_ 4
#endif
#ifndef SEQ_
#define SEQ_ 4096
#endif
#ifndef CTX_
#define CTX_ 256
#endif
#ifndef DEPTH_
#define DEPTH_ 4
#endif
#ifndef N_LAUNCH_MODE
#define N_LAUNCH_MODE 1
#endif
#define T_ (SEQ_ + CTX_)
#define NT_ (B_ * T_)
#define D_ 1024
#define NIN_ 3504
#define NMOD_ 6144
#define NR_ (B_ + 1)
#define OZ 0
#define OXBC 512
#define ODT 1536
#define ORW 1552
#define OGQ 2704
#define OGK 2832
#define OGV 2960
#define OGD 3216
#define OOG 3248
#define ALPHA_ 1.681792830507429f
#define NEXP 64
#define NSLOT 9
#define NC128 (T_ / 128)
#define NC64 (T_ / 64)
#define NC16 (T_ / 16)

#define DEVFN __device__ __forceinline__
#define LDT 72
#define GEMM_SMEM (2 * 128 * LDT * 2)
typedef unsigned short bf16_t;
#ifdef HIPEMU
#define AS1
#else
#define AS1 __attribute__((address_space(1)))
#endif
typedef unsigned u32x4 __attribute__((ext_vector_type(4)));

#ifdef HIPEMU
typedef emu_bf16x8 bf16x8;
typedef emu_f32x4 f32x4;
#define MFMA16(a, b, c) emu_mfma_16x16x32_bf16(a, b, c)
#define MFMA16K16(a, b, c) emu_mfma_16x16x16_bf16(a, b, c)
#define GRID_SYNC() hipemu::grid_sync()
#else
typedef short bf16x8 __attribute__((ext_vector_type(8)));
typedef float f32x4 __attribute__((ext_vector_type(4)));
#define MFMA16(a, b, c) __builtin_amdgcn_mfma_f32_16x16x32_bf16(a, b, c, 0, 0, 0)
#define MFMA16K16(a, b, c) __builtin_amdgcn_mfma_f32_16x16x16bf16_1k(a, b, c, 0, 0, 0)
#endif

DEVFN float bf2f(bf16_t h) { return __builtin_bit_cast(float, (unsigned)h << 16); }
DEVFN bf16_t f2bf(float f) { unsigned u = __builtin_bit_cast(unsigned, f); u += 0x7FFFu + ((u >> 16) & 1u); return (bf16_t)(u >> 16); }
template <class T> DEVFN AS1 T* gptr(T* q) { return (AS1 T*)q; }
DEVFN bf16x8 ld8g(const bf16_t* q) { return *(const AS1 bf16x8*)gptr(q); }
DEVFN float sigmoidf_(float x) { return 1.f / (1.f + expf(-x)); }
DEVFN float siluf_(float x) { return x / (1.f + expf(-x)); }
DEVFN float softplusf_(float x) { return x > 20.f ? x : log1pf(expf(x)); }
DEVFN float logsigmoidf_(float x) { return fminf(x, 0.f) - log1pf(expf(-fabsf(x))); }
DEVFN float wave_sum(float v) { for (int m = 32; m >= 1; m >>= 1) v += __shfl_xor(v, m); return v; }

constexpr size_t al(size_t x) { return (x + 255) & ~(size_t)255; }
struct Ws {
  static constexpr size_t BAR = 0;
  static constexpr size_t CNT = 16384;
  static constexpr size_t MOD = CNT + 4096;
  static constexpr size_t ZROW = al(MOD + (size_t)DEPTH_ * NR_ * NMOD_ * 4);
  static constexpr size_t ZERO_END = al(ZROW + 2048);
  static constexpr size_t MODP = ZERO_END;
  static constexpr size_t RWT = al(MODP + (size_t)16 * DEPTH_ * NR_ * NMOD_ * 4);
  static constexpr size_t LORA = al(RWT + (size_t)DEPTH_ * 64 * 1024 * 4);
  static constexpr size_t X = al(LORA + (size_t)DEPTH_ * 98304 * 2);
  static constexpr size_t U = al(X + (size_t)NT_ * 1024 * 4);
  static constexpr size_t YMIX = al(U + (size_t)NT_ * 1024 * 2);
  static constexpr size_t ZX = al(YMIX + (size_t)NT_ * 1024 * 2);
  static constexpr size_t MIX = ZX;
  static constexpr size_t LTOK = al(ZX + (size_t)NT_ * NIN_ * 2);
  static constexpr size_t LWT = al(LTOK + (size_t)64 * NT_ * 4);
  static constexpr size_t WIN = al(LWT + (size_t)64 * NT_ * 4);
  static constexpr size_t WOUT = al(WIN + (size_t)DEPTH_ * NIN_ * 1024 * 2);
  static constexpr size_t W13 = al(WOUT + (size_t)DEPTH_ * 1024 * 1024 * 2);
  static constexpr size_t W2T = al(W13 + (size_t)65 * 512 * 1024 * 2);
  static constexpr size_t UNI = al(W2T + (size_t)65 * 1024 * 256 * 2);
  static constexpr size_t XBC = UNI;
  static constexpr size_t XBCT = al(XBC + (size_t)NT_ * 1024 * 2);
  static constexpr size_t DTB = al(XBCT + (size_t)NT_ * 768 * 2);
  static constexpr size_t SST = al(DTB + (size_t)NT_ * 16 * 4);
  static constexpr size_t SCD = al(SST + (size_t)2 * NT_ / 128 * 8 * 8192 * 4);
  static constexpr size_t HIN = al(SCD + (size_t)2 * NT_ / 128 * 8 * 4);
  static constexpr size_t YS = SST;
  static constexpr size_t LA = al(HIN + (size_t)2 * NT_ / 128 * 8 * 8192 * 2);
  static constexpr size_t VT = al(LA + (size_t)2 * NT_ * 128 * 4);
  static constexpr size_t QT = al(VT + (size_t)NT_ * 256 * 2);
  static constexpr size_t OI = al(QT + (size_t)2 * NT_ * 128 * 2);
  static constexpr size_t GST = al(OI + (size_t)NT_ * 256 * 4);
  static constexpr size_t GCD = al(GST + (size_t)2 * NT_ / 64 * 4 * 2048 * 4);
  static constexpr size_t GSIN = al(GCD + (size_t)2 * NT_ / 64 * 4 * 32 * 4);
  static constexpr size_t RR = al(GSIN + (size_t)2 * NT_ / 64 * 4 * 2048 * 2);
  static constexpr size_t VV = RR + (size_t)NT_ * 256 * 2;
  static constexpr size_t KK = VV + (size_t)NT_ * 256 * 2;
  static constexpr size_t KD = KK + (size_t)NT_ * 256 * 2;
  static constexpr size_t BD = KD + (size_t)2 * NT_ * 256 * 2;
  static constexpr size_t LW = BD + (size_t)2 * NT_ * 256 * 2;
  static constexpr size_t GATE = LW + (size_t)2 * NT_ * 256 * 4;
  static constexpr size_t YR = GATE + (size_t)NT_ * 256 * 4;
  static constexpr size_t RML = al(YR + (size_t)2 * NT_ * 256 * 4);
  static constexpr size_t RNS = RML + (size_t)(NT_ / 16) * 8 * 4096 * 2;
  static constexpr size_t RWC = RNS + (size_t)(NT_ / 16) * 8 * 4096 * 2;
  static constexpr size_t RG = RWC + (size_t)(NT_ / 16) * 8 * 64 * 4;
  static constexpr size_t RY0 = RG + (size_t)(NT_ / 16) * 8 * 1024 * 2;
  static constexpr size_t LI = RY0 + (size_t)(NT_ / 16) * 8 * 1024 * 4;
  static constexpr size_t KRW = LI + (size_t)NT_ * 384 * 2;
  static constexpr size_t MIXER_END = KRW + (size_t)NT_ * 256 * 2;
  static constexpr size_t HID = UNI;
  static constexpr size_t YBUF = al(HID + ((size_t)NT_ * 9 + 65 * 128) * 256 * 2);
  static constexpr size_t MOE_END = YBUF + (size_t)NT_ * 9 * 1024 * 2;
  static constexpr size_t END = al(MIXER_END > MOE_END ? MIXER_END : MOE_END);
};

struct Params {
  const float* in[40];
  float* out;
  unsigned char* ws;
};
enum { I_X = 0, I_C, I_CTX, I_CCTX, I_ADAW, I_ADAB, I_WIN, I_CONVW, I_CONVB, I_DTBIAS, I_ALOG, I_SSDD, I_SSDNW, I_MU, I_W0, I_W2, I_A0, I_A2,
       I_G2, I_KKW, I_KAW, I_RK, I_LNXW, I_LNXB, I_GU, I_GB, I_GNW, I_WOUT, I_LN1W, I_LN1B, I_LN2W, I_LN2B, I_RW, I_RB, I_EW1, I_EW3, I_EW2,
       I_SW1, I_SW3, I_SW2 };

#define PH_SMEM 47104
#define SM_PRE (PH_SMEM)
#define SM_TAB (PH_SMEM + 1024)
#define SM_BAR (PH_SMEM + 2032)
#ifdef HIPEMU
#define INP(i) (p.in[i])
#define LAUNDER(x)
#define TIDX ((int)threadIdx.x)
#define BIDX ((int)blockIdx.x)
#define LAUNDER_V(x)
#else
extern __shared__ __align__(16) unsigned char smem_dyn[];
DEVFN const float* inp_lds(int i) {
  const volatile unsigned* t = (const volatile unsigned*)(smem_dyn + SM_TAB) + 2 * i;
  unsigned lo = __builtin_amdgcn_readfirstlane(t[0]), hi = __builtin_amdgcn_readfirstlane(t[1]);
  return (const float*)(((unsigned long long)hi << 32) | lo);
}
#define INP(i) inp_lds(i)
#define LAUNDER(x) asm volatile("" : "+s"(x))
DEVFN int tidx_() { int t = threadIdx.x; asm volatile("" : "+v"(t)); return t; }
DEVFN int bidx_() { int b = blockIdx.x; asm volatile("" : "+s"(b)); return b; }
#define TIDX tidx_()
#define LAUNDER_V(x) asm volatile("" : "+v"(x))
#define BIDX bidx_()
#endif
#ifndef HIPEMU
#define XB_TMO      128
#define XB_XCNT(j)  (256  + 64 * (j))
#define XB_XSUB(j)  (1280 + 64 * (j))
#define XB_XGEN(j)  (2304 + 64 * (j))
#define XB_TOP      3328
#define XB_TOPGEN   3392
#define XCD_BAR_WORDS 3456
#define XB_SPIN_CAP (1u << 22)
#define LAS __attribute__((address_space(3)))
__device__ __forceinline__ unsigned xb_ld(unsigned* p)              { return __hip_atomic_load(p, __ATOMIC_RELAXED, __HIP_MEMORY_SCOPE_AGENT); }
__device__ __forceinline__ unsigned xb_add(unsigned* p, unsigned v) { return __hip_atomic_fetch_add(p, v, __ATOMIC_RELAXED, __HIP_MEMORY_SCOPE_AGENT); }
__device__ __forceinline__ unsigned xb_xcc_id() { return (unsigned)__builtin_amdgcn_s_getreg((3 << 11) | 20) & 0xFu; }
#define XB_SPIN(cond, bar) do { unsigned _sp = 0; while (cond) { __builtin_amdgcn_s_sleep(1); \
    if ((++_sp & 255u) == 0u) { if (xb_ld(&(bar)[XB_TMO])) break; if (_sp > XB_SPIN_CAP) { atomicAdd(&(bar)[XB_TMO], 1u); break; } } } } while (0)
struct XcdBarrier { unsigned* bar; unsigned x; volatile LAS unsigned* st; };
__device__ __forceinline__ XcdBarrier xcd_barrier_post(unsigned* bar, volatile LAS unsigned* st) {
    XcdBarrier b; b.bar = bar; b.x = xb_xcc_id(); b.st = st;
    if (threadIdx.x == 0) (void)xb_add(&bar[XB_XCNT(b.x)], 1u);
    return b;
}
__device__ __forceinline__ void xcd_barrier_complete(unsigned* bar, unsigned x, unsigned& nloc, unsigned& nx) {
    const unsigned G = gridDim.x * gridDim.y * gridDim.z;
    unsigned sum, cnt, mine, sp = 0u;
    for (;;) {
        sum = 0u; cnt = 0u; mine = 0u;
#pragma unroll
        for (unsigned j = 0; j < 16; ++j) { const unsigned c = xb_ld(&bar[XB_XCNT(j)]); sum += c; cnt += (c > 0u) ? 1u : 0u; mine = (j == x) ? c : mine; }
        if (sum == G) break;
        __builtin_amdgcn_s_sleep(1);
        if ((++sp & 255u) == 0u) { if (xb_ld(&bar[XB_TMO])) break; if (sp > XB_SPIN_CAP) { atomicAdd(&bar[XB_TMO], 1u); break; } }
    }
    nloc = mine > 0u ? mine : 1u; nx = cnt > 0u ? cnt : 1u;
}
__device__ __forceinline__ void xcd_barrier(const XcdBarrier& b) {
    asm volatile("s_waitcnt vmcnt(0)" ::: "memory");
    __syncthreads();
    if (threadIdx.x == 0) {
        unsigned* bar = b.bar;
        __builtin_amdgcn_s_waitcnt(0);
        unsigned nloc = b.st[0], nx = b.st[1];
        if (nloc == 0u) { xcd_barrier_complete(bar, b.x, nloc, nx); b.st[0] = nloc; b.st[1] = nx; }
        const unsigned old = xb_add(&bar[XB_XSUB(b.x)], 1u);
        const unsigned gen = old / nloc;
        if (old + 1u == (gen + 1u) * nloc) {
            __builtin_amdgcn_fence(__ATOMIC_RELEASE, "agent");
            asm volatile("s_waitcnt vmcnt(0)" ::: "memory");
            const unsigned og = xb_add(&bar[XB_TOP], 1u);
            const unsigned tg = og / nx;
            if (og + 1u == (tg + 1u) * nx) xb_add(&bar[XB_TOPGEN], 1u);
            else XB_SPIN(xb_ld(&bar[XB_TOPGEN]) == tg, bar);
            __builtin_amdgcn_fence(__ATOMIC_ACQUIRE, "agent");
            xb_add(&bar[XB_XGEN(b.x)], 1u);
            asm volatile("s_waitcnt vmcnt(0)" ::: "memory");
        } else {
            XB_SPIN(xb_ld(&bar[XB_XGEN(b.x)]) == gen, bar);
            __builtin_amdgcn_fence(__ATOMIC_ACQUIRE, "agent");
            asm volatile("s_waitcnt vmcnt(0)" ::: "memory");
        }
    }
    __syncthreads();
}
#endif

DEVFN int tokmap(int dir, int p) { return dir == 0 ? p : (p < CTX_ ? CTX_ - 1 - p : 2 * CTX_ + SEQ_ - 1 - p); }
DEVFN const float* tok_input_row(const Params& p, int tok) {
  int b = tok / T_, t = tok % T_;
  return t < CTX_ ? INP(I_CTX) + ((size_t)b * CTX_ + t) * D_ : INP(I_X) + ((size_t)b * SEQ_ + (t - CTX_)) * D_;
}
DEVFN int tok_modrow(int tok) { return (tok % T_) < CTX_ ? B_ : tok / T_; }

template <class ARow, class BRow, class Epi>
DEVFN void gemm_tile(unsigned char* smem, int K, ARow arow, BRow brow, Epi epi) {
  bf16_t* As = (bf16_t*)smem;
  bf16_t* Bs = As + 128 * LDT;
  const int tid = TIDX, lane = tid & 63, wave = tid >> 6, wr = wave >> 1, wc = wave & 1;
  const int g = lane >> 4, l15 = lane & 15;
  const int lr = tid >> 3, lc = (tid & 7) * 8;
  const AS1 bf16_t* ap[4];
  const AS1 bf16_t* bp[4];
#pragma unroll
  for (int i = 0; i < 4; ++i) { ap[i] = gptr(arow(lr + 32 * i)); bp[i] = gptr(brow(lr + 32 * i)); }
  f32x4 acc[4][4];
#pragma unroll
  for (int mi = 0; mi < 4; ++mi)
#pragma unroll
    for (int ni = 0; ni < 4; ++ni) acc[mi][ni] = f32x4{0.f, 0.f, 0.f, 0.f};
  u32x4 ra0[4], rb0[4], ra1[4], rb1[4];
#pragma unroll
  for (int i = 0; i < 4; ++i) { ra0[i] = *(const AS1 u32x4*)(ap[i] + lc); rb0[i] = *(const AS1 u32x4*)(bp[i] + lc); }
  if (K > 64) {
#pragma unroll
    for (int i = 0; i < 4; ++i) { ra1[i] = *(const AS1 u32x4*)(ap[i] + 64 + lc); rb1[i] = *(const AS1 u32x4*)(bp[i] + 64 + lc); } }
  auto compute = [&]() {
#pragma unroll
    for (int kk = 0; kk < 2; ++kk) {
      bf16x8 af[4], bfr[4];
#pragma unroll
      for (int mi = 0; mi < 4; ++mi) af[mi] = *(const bf16x8*)(As + (wr * 64 + mi * 16 + l15) * LDT + kk * 32 + g * 8);
#pragma unroll
      for (int ni = 0; ni < 4; ++ni) bfr[ni] = *(const bf16x8*)(Bs + (wc * 64 + ni * 16 + l15) * LDT + kk * 32 + g * 8);
#pragma unroll
      for (int mi = 0; mi < 4; ++mi)
#pragma unroll
        for (int ni = 0; ni < 4; ++ni) acc[mi][ni] = MFMA16(af[mi], bfr[ni], acc[mi][ni]);
    } };
  for (int k0 = 0; k0 < K; k0 += 128) {
    __syncthreads();
#pragma unroll
    for (int i = 0; i < 4; ++i) { *(u32x4*)(As + (lr + 32 * i) * LDT + lc) = ra0[i]; *(u32x4*)(Bs + (lr + 32 * i) * LDT + lc) = rb0[i]; }
    __syncthreads();
    if (k0 + 128 < K) {
#pragma unroll
      for (int i = 0; i < 4; ++i) { ra0[i] = *(const AS1 u32x4*)(ap[i] + k0 + 128 + lc); rb0[i] = *(const AS1 u32x4*)(bp[i] + k0 + 128 + lc); } }
    compute();
    if (k0 + 64 < K) {
      __syncthreads();
#pragma unroll
      for (int i = 0; i < 4; ++i) { *(u32x4*)(As + (lr + 32 * i) * LDT + lc) = ra1[i]; *(u32x4*)(Bs + (lr + 32 * i) * LDT + lc) = rb1[i]; }
      __syncthreads();
      if (k0 + 192 < K) {
#pragma unroll
        for (int i = 0; i < 4; ++i) { ra1[i] = *(const AS1 u32x4*)(ap[i] + k0 + 192 + lc); rb1[i] = *(const AS1 u32x4*)(bp[i] + k0 + 192 + lc); } }
      compute();
    }
  }
  epi(acc, wr, wc, g, l15);
}

template <int NCH, class Val, class RowP>
DEVFN void tile_store_bf16(unsigned char* smem, int wr, int g, int l15, Val val, RowP rowp) {
  constexpr int LDC = NCH * 8 + 8;
  bf16_t* T = (bf16_t*)smem;
  const int tid = TIDX;
  __syncthreads();
  val(T, LDC);
  __syncthreads();
#pragma unroll
  for (int pass = 0; pass < NCH / 2; ++pass) { const int id = tid + 256 * pass, row = id / NCH, c = id % NCH;
    bf16_t* dst = rowp(row, c * 8);
    if (dst) *(AS1 u32x4*)gptr(dst) = *(const u32x4*)(T + row * LDC + c * 8); }
  (void)wr; (void)g; (void)l15;
}
DEVFN void cvt_tile(unsigned char* smem, const float* src, int K, int N, int k0, int n0, bf16_t* dst, int ldd, int mode) {
  float* s = (float*)smem;
  const int tid = TIDX;
  const AS1 float* gsrc = gptr(src);
  __syncthreads();
  { const int kk = tid >> 4, n4 = (tid & 15) * 4;
#pragma unroll
    for (int pass = 0; pass < 4; ++pass) { const int k = kk + 16 * pass;
      f32x4 v = f32x4{0.f, 0.f, 0.f, 0.f};
      if (n0 + n4 < N) v = *(const AS1 f32x4*)(gsrc + (size_t)(k0 + k) * N + n0 + n4);
      s[k * 65 + n4] = v[0]; s[k * 65 + n4 + 1] = v[1]; s[k * 65 + n4 + 2] = v[2]; s[k * 65 + n4 + 3] = v[3]; } }
  __syncthreads();
  { const int nn = tid >> 2, k16 = (tid & 3) * 16, n = n0 + nn;
    if (n < N) { const int row = mode == 0 ? n : ((n >> 4) * 32 + (n & 15) + (mode == 2 ? 16 : 0));
      u32x4 o0, o1;
#pragma unroll
      for (int j = 0; j < 4; ++j) { o0[j] = (unsigned)f2bf(s[(k16 + 2 * j) * 65 + nn]) | ((unsigned)f2bf(s[(k16 + 2 * j + 1) * 65 + nn]) << 16);
        o1[j] = (unsigned)f2bf(s[(k16 + 8 + 2 * j) * 65 + nn]) | ((unsigned)f2bf(s[(k16 + 9 + 2 * j) * 65 + nn]) << 16); }
      AS1 bf16_t* d = gptr(dst) + (size_t)row * ldd + k0 + k16;
      *(AS1 u32x4*)d = o0; *(AS1 u32x4*)(d + 8) = o1; } }
  (void)K;
}
DEVFN void convert_moe_weights(const Params& p, int l, unsigned char* smem, int bid, int nb) {
  bf16_t* w13 = (bf16_t*)(p.ws + Ws::W13);
  bf16_t* w2t = (bf16_t*)(p.ws + Ws::W2T);
  const int per_e = 192;
  for (int u = bid; u < 65 * per_e; u += nb) {
    int e = u / per_e, r = u % per_e, which = r / 64, t = r % 64;
    if (which < 2) {
      const float* src = e < 64 ? (which == 0 ? INP(I_EW1) : INP(I_EW3)) + ((size_t)l * 64 + e) * 1024 * 256 : (which == 0 ? INP(I_SW1) : INP(I_SW3)) + (size_t)l * 1024 * 256;
      cvt_tile(smem, src, 1024, 256, (t >> 2) * 64, (t & 3) * 64, w13 + (size_t)e * 512 * 1024, 1024, which == 0 ? 1 : 2);
    } else {
      const float* src = e < 64 ? INP(I_EW2) + ((size_t)l * 64 + e) * 256 * 1024 : INP(I_SW2) + (size_t)l * 256 * 1024;
      cvt_tile(smem, src, 256, 1024, (t >> 4) * 64, (t & 15) * 64, w2t + (size_t)e * 1024 * 256, 256, 0);
    }
  }
}
DEVFN void phase0(const Params& p, unsigned char* smem) {
  const int tid = TIDX;
  float* modp = (float*)(p.ws + Ws::MODP);
  for (int u = BIDX; u < DEPTH_ * 24 * 16; u += gridDim.x) {
    int l = u / (24 * 16), jb = (u / 16) % 24, ks = u % 16;
    float* sc = (float*)smem;
    __syncthreads();
    for (int e = tid; e < NR_ * 64; e += 256) { int r = e / 64, i = ks * 64 + (e % 64); float cv = r < B_ ? INP(I_C)[(size_t)r * D_ + i] : INP(I_CCTX)[i]; sc[e] = siluf_(cv); }
    __syncthreads();
    int j = jb * 256 + tid;
    float acc[NR_];
#pragma unroll
    for (int r = 0; r < NR_; ++r) acc[r] = 0.f;
    const float* w = INP(I_ADAW) + ((size_t)l * D_ + ks * 64) * NMOD_ + j;
#pragma unroll 4
    for (int i = 0; i < 64; ++i) { float wv = w[(size_t)i * NMOD_];
#pragma unroll
      for (int r = 0; r < NR_; ++r) acc[r] += sc[r * 64 + i] * wv; }
#pragma unroll
    for (int r = 0; r < NR_; ++r) modp[(((size_t)ks * DEPTH_ + l) * NR_ + r) * NMOD_ + j] = acc[r];
  }
  bf16_t* win = (bf16_t*)(p.ws + Ws::WIN);
  bf16_t* wout = (bf16_t*)(p.ws + Ws::WOUT);
  for (int u = BIDX; u < DEPTH_ * 16 * 55; u += gridDim.x) {
    int l = u / (16 * 55), r = u % (16 * 55);
    cvt_tile(smem, INP(I_WIN) + (size_t)l * 1024 * NIN_, 1024, NIN_, (r / 55) * 64, (r % 55) * 64, win + (size_t)l * NIN_ * 1024, 1024, 0);
  }
  for (int u = BIDX; u < DEPTH_ * 256; u += gridDim.x) {
    int l = u / 256, r = u % 256;
    cvt_tile(smem, INP(I_WOUT) + (size_t)l * 1024 * 1024, 1024, 1024, (r / 16) * 64, (r % 16) * 64, wout + (size_t)l * 1024 * 1024, 1024, 0);
  }
  { bf16_t* lo = (bf16_t*)(p.ws + Ws::LORA);
    for (int u = BIDX * 256 + tid; u < DEPTH_ * 98304; u += gridDim.x * 256) {
      const int l = u / 98304, r = u % 98304; float v;
      if (r < 32768) { const int d = r >> 14, n = (r >> 6) & 255, k = r & 63; v = INP(I_W2)[(((size_t)l * 2 + d) * 64 + k) * 256 + n]; }
      else if (r < 65536) { const int r2 = r - 32768, d = r2 >> 14, n = (r2 >> 6) & 255, k = r2 & 63; v = INP(I_A2)[(((size_t)l * 2 + d) * 64 + k) * 256 + n]; }
      else { const int r2 = r - 65536, n = r2 >> 7, k = r2 & 127; v = INP(I_G2)[((size_t)l * 128 + k) * 256 + n]; }
      lo[u] = f2bf(v); } }
  float* rwt = (float*)(p.ws + Ws::RWT);
  for (int u = BIDX * 256 + tid; u < DEPTH_ * 64 * 1024; u += gridDim.x * 256) {
    int l = u / (64 * 1024), e = (u / 1024) % 64, i = u % 1024;
    rwt[u] = INP(I_RW)[((size_t)l * 1024 + i) * 64 + e];
  }
}

DEVFN void phase0b(const Params& p) {
  float* mod = (float*)(p.ws + Ws::MOD); const float* modp = (const float*)(p.ws + Ws::MODP);
  for (int u = BIDX * 256 + TIDX; u < DEPTH_ * NR_ * NMOD_; u += gridDim.x * 256) {
    int l = u / (NR_ * NMOD_), j = u % NMOD_;
    float s = INP(I_ADAB)[(size_t)l * NMOD_ + j];
    for (int ks = 0; ks < 16; ++ks) s += modp[(size_t)ks * DEPTH_ * NR_ * NMOD_ + u];
    mod[u] = s;
  }
}

DEVFN void row_stats(const float (&v)[16], float& mean, float& rstd) {
  float s = 0.f;
#pragma unroll
  for (int i = 0; i < 16; ++i) s += v[i];
  mean = wave_sum(s) * (1.f / 1024.f);
  float q = 0.f;
#pragma unroll
  for (int i = 0; i < 16; ++i) { float d = v[i] - mean; q += d * d; }
  rstd = rsqrtf(wave_sum(q) * (1.f / 1024.f) + 1e-5f);
}
DEVFN void load_row16(const float* row, int lane, float (&v)[16]) {
#pragma unroll
  for (int j = 0; j < 4; ++j) { float4 t = *(const float4*)(row + lane * 4 + 256 * j); v[4 * j] = t.x; v[4 * j + 1] = t.y; v[4 * j + 2] = t.z; v[4 * j + 3] = t.w; }
}
DEVFN void moe_residual_row(const Params& p, int lp, int tok, int lane, float (&xv)[16]) {
  const float* mod = (const float*)(p.ws + Ws::MOD) + ((size_t)lp * NR_ + tok_modrow(tok)) * NMOD_;
  const bf16_t* yb = (const bf16_t*)(p.ws + Ws::YBUF) + (size_t)tok * NSLOT * 1024;
  float f[16];
#pragma unroll
  for (int i = 0; i < 16; ++i) f[i] = 0.f;
  for (int s = 0; s < NSLOT; ++s) {
#pragma unroll
    for (int j = 0; j < 4; ++j) { uint2 t = *(const uint2*)(yb + (size_t)s * 1024 + lane * 4 + 256 * j);
      f[4 * j] += bf2f((bf16_t)(t.x & 0xFFFF)); f[4 * j + 1] += bf2f((bf16_t)(t.x >> 16)); f[4 * j + 2] += bf2f((bf16_t)(t.y & 0xFFFF)); f[4 * j + 3] += bf2f((bf16_t)(t.y >> 16)); }
  }
  float g2[16], w[16], b[16];
  load_row16(mod + 5 * 1024, lane, g2);
  load_row16(INP(I_LN2W) + (size_t)lp * 1024, lane, w);
  load_row16(INP(I_LN2B) + (size_t)lp * 1024, lane, b);
#pragma unroll
  for (int i = 0; i < 16; ++i) xv[i] = ALPHA_ * xv[i] + g2[i] * f[i];
  float mean, rstd;
  row_stats(xv, mean, rstd);
#pragma unroll
  for (int i = 0; i < 16; ++i) xv[i] = (xv[i] - mean) * rstd * w[i] + b[i];
}
DEVFN void phase1(const Params& p, int l) {
  const int lane = TIDX & 63, wave = TIDX >> 6;
  float* X = (float*)(p.ws + Ws::X);
  bf16_t* U = (bf16_t*)(p.ws + Ws::U);
  for (int tok = BIDX * 4 + wave; tok < NT_; tok += gridDim.x * 4) {
    float xv[16];
    if (l == 0) load_row16(tok_input_row(p, tok), lane, xv);
    else { load_row16(X + (size_t)tok * 1024, lane, xv); moe_residual_row(p, l - 1, tok, lane, xv); }
#pragma unroll
    for (int j = 0; j < 4; ++j) *(float4*)(X + (size_t)tok * 1024 + lane * 4 + 256 * j) = make_float4(xv[4 * j], xv[4 * j + 1], xv[4 * j + 2], xv[4 * j + 3]);
    const float* mod = (const float*)(p.ws + Ws::MOD) + ((size_t)l * NR_ + tok_modrow(tok)) * NMOD_;
    float sh[16], sc[16], mean, rstd;
    load_row16(mod, lane, sh);
    load_row16(mod + 1024, lane, sc);
    row_stats(xv, mean, rstd);
#pragma unroll
    for (int j = 0; j < 4; ++j) {
      float u0 = (xv[4 * j] - mean) * rstd * (1.f + sc[4 * j]) + sh[4 * j], u1 = (xv[4 * j + 1] - mean) * rstd * (1.f + sc[4 * j + 1]) + sh[4 * j + 1];
      float u2 = (xv[4 * j + 2] - mean) * rstd * (1.f + sc[4 * j + 2]) + sh[4 * j + 2], u3 = (xv[4 * j + 3] - mean) * rstd * (1.f + sc[4 * j + 3]) + sh[4 * j + 3];
      *(uint2*)(U + (size_t)tok * 1024 + lane * 4 + 256 * j) = make_uint2((unsigned)f2bf(u0) | ((unsigned)f2bf(u1) << 16), (unsigned)f2bf(u2) | ((unsigned)f2bf(u3) << 16));
    }
  }
}
DEVFN void phase_final(const Params& p) {
  const int lane = TIDX & 63, wave = TIDX >> 6;
  const float* X = (const float*)(p.ws + Ws::X);
  for (int r = BIDX * 4 + wave; r < B_ * SEQ_; r += gridDim.x * 4) {
    int b = r / SEQ_, s = r % SEQ_, tok = b * T_ + CTX_ + s;
    float xv[16];
    load_row16(X + (size_t)tok * 1024, lane, xv);
    moe_residual_row(p, DEPTH_ - 1, tok, lane, xv);
#pragma unroll
    for (int j = 0; j < 4; ++j) *(float4*)(p.out + (size_t)r * 1024 + lane * 4 + 256 * j) = make_float4(xv[4 * j], xv[4 * j + 1], xv[4 * j + 2], xv[4 * j + 3]);
  }
}

DEVFN void phase2(const Params& p, int l, unsigned char* smem) {
  const bf16_t* U = (const bf16_t*)(p.ws + Ws::U);
  const bf16_t* W = (const bf16_t*)(p.ws + Ws::WIN) + (size_t)l * NIN_ * 1024;
  bf16_t* ZX = (bf16_t*)(p.ws + Ws::ZX);
  const int nct = (NIN_ + 127) / 128;
  for (int u = BIDX; u < (NT_ / 128) * nct; u += gridDim.x) {
    int rt = u / nct, ct = u % nct;
    gemm_tile(smem, 1024,
      [&](int r) { return U + (size_t)(rt * 128 + r) * 1024; },
      [&](int r) { int n = ct * 128 + r; return n < NIN_ ? W + (size_t)n * 1024 : (const bf16_t*)(p.ws + Ws::ZROW); },
      [&](f32x4 (&acc)[4][4], int wr, int wc, int g, int l15) {
        tile_store_bf16<16>(smem, wr, g, l15,
          [&](bf16_t* T, int ldc) {
#pragma unroll
            for (int mi = 0; mi < 4; ++mi)
#pragma unroll
              for (int ni = 0; ni < 4; ++ni)
#pragma unroll
                for (int i = 0; i < 4; ++i) T[(wr * 64 + mi * 16 + 4 * g + i) * ldc + wc * 64 + ni * 16 + l15] = f2bf(acc[mi][ni][i]); },
          [&](int row, int c0) { return ct * 128 + c0 < NIN_ ? ZX + (size_t)(rt * 128 + row) * NIN_ + ct * 128 + c0 : (bf16_t*)nullptr; });
      });
  }
}

DEVFN float zxv(const bf16_t* ZX, int tok, int col) { return bf2f(ZX[(size_t)tok * NIN_ + col]); }
struct Nbr { int n; int tok[4]; };
DEVFN Nbr shift_nbrs(int tok) {
  Nbr nb; int b = tok / T_, t = tok % T_;
  if (t < CTX_) { nb.n = 2; nb.tok[0] = t > 0 ? tok - 1 : -1; nb.tok[1] = t < CTX_ - 1 ? tok + 1 : -1; nb.tok[2] = -1; nb.tok[3] = -1; }
  else { int s = t - CTX_, row = s / 64, col = s % 64; nb.n = 4; nb.tok[0] = col > 0 ? tok - 1 : -1; nb.tok[1] = col < 63 ? tok + 1 : -1;
    nb.tok[2] = row > 0 ? tok - 64 : -1; nb.tok[3] = row < SEQ_ / 64 - 1 ? tok + 64 : -1; }
  (void)b; return nb;
}
DEVFN float shiftmix(const bf16_t* ZX, const float* mu, int tok, const Nbr& nb, int ch) {
  float z = zxv(ZX, tok, ORW + ch), o = z;
#pragma unroll
  for (int j = 0; j < 4; ++j) if (j < nb.n) { float v = nb.tok[j] >= 0 ? zxv(ZX, nb.tok[j], ORW + ch) : 0.f; o += mu[j * 1152 + ch] * (v - z); }
  return o;
}
#define LI_LD 392
#define KL_LD 264
DEVFN void phase3(const Params& p, int l, unsigned char* smem) {
  const int tid = TIDX, lane = tid & 63, wave = tid >> 6, q = lane >> 4, l15 = lane & 15;
  const bf16_t* ZX = (const bf16_t*)(p.ws + Ws::ZX);
  bf16_t* XBC = (bf16_t*)(p.ws + Ws::XBC); float* DTB = (float*)(p.ws + Ws::DTB);
  bf16_t* RR = (bf16_t*)(p.ws + Ws::RR); bf16_t* VV = (bf16_t*)(p.ws + Ws::VV); bf16_t* KKb = (bf16_t*)(p.ws + Ws::KK);
  bf16_t* KRW = (bf16_t*)(p.ws + Ws::KRW); bf16_t* LIg = (bf16_t*)(p.ws + Ws::LI);
  float* LA = (float*)(p.ws + Ws::LA);
  const float* convw = INP(I_CONVW) + (size_t)l * 3 * 1024; const float* convb = INP(I_CONVB) + (size_t)l * 1024;
  const float* mu = INP(I_MU) + (size_t)l * 4 * 1152;
  float* gdl = (float*)smem;
  const float kkw = INP(I_KKW)[(size_t)l * 256 + tid];
  for (int tile = BIDX; tile < NT_ / 16; tile += gridDim.x) {
    const int tok0 = tile * 16, t0 = tok0 % T_, bb = tok0 / T_;
    const bool isctx = t0 < CTX_;
    const int s0 = t0 - CTX_;
    const bool lval = isctx ? (t0 > 0) : ((s0 & 63) != 0), rval = isctx ? (t0 + 16 < CTX_) : ((s0 & 63) != 48);
    const bool uval = !isctx && (s0 >= 64), dval = !isctx && (s0 + 64 < SEQ_);
    __syncthreads();
    {
      const bool segstart = (t0 == 0 || t0 == CTX_), segend = (t0 + 16 == CTX_ || t0 + 16 == T_);
      bf16_t* XBCT = (bf16_t*)(p.ws + Ws::XBCT) + ((size_t)(bb * NC128 + t0 / 128) * 768) * 128 + (t0 % 128);
#pragma unroll 1
      for (int j = 0; j < 4; ++j) { const int c = tid + 256 * j;
        const bf16_t* zp = ZX + (size_t)tok0 * NIN_ + OXBC + c - NIN_; bf16_t* xp = XBC + (size_t)tok0 * 1024 + c;
        float z[18];
#pragma unroll
        for (int i = 0; i < 18; ++i) { z[i] = ((i == 0 && segstart) || (i == 17 && segend)) ? 0.f : bf2f(*zp); zp += NIN_; LAUNDER_V(zp); }
        const float w0 = convw[c], w1 = convw[1024 + c], w2 = convw[2048 + c], cb = convb[c];
        bf16_t y[16];
#pragma unroll
        for (int i = 0; i < 16; ++i) { y[i] = f2bf(siluf_(cb + w0 * z[i] + w1 * z[i + 1] + w2 * z[i + 2])); *xp = y[i]; xp += 1024; LAUNDER_V(xp); }
        if (c < 768) {
          u32x4 o0, o1;
#pragma unroll
          for (int i = 0; i < 4; ++i) { o0[i] = (unsigned)y[2 * i] | ((unsigned)y[2 * i + 1] << 16); o1[i] = (unsigned)y[8 + 2 * i] | ((unsigned)y[9 + 2 * i] << 16); }
          *(u32x4*)(XBCT + (size_t)c * 128) = o0; *(u32x4*)(XBCT + (size_t)c * 128 + 8) = o1; } }
      { bf16_t* VTp = (bf16_t*)(p.ws + Ws::VT) + ((size_t)(bb * NC64 + t0 / 64) * 256 + tid) * 64 + (t0 % 64);
        const bf16_t* vp = ZX + (size_t)tok0 * NIN_ + OGV + tid;
        u32x4 o0, o1;
        bf16_t vv16[16];
#pragma unroll
        for (int i = 0; i < 16; ++i) { vv16[i] = *vp; vp += NIN_; LAUNDER_V(vp); }
#pragma unroll
        for (int i = 0; i < 4; ++i) { o0[i] = (unsigned)vv16[2 * i] | ((unsigned)vv16[2 * i + 1] << 16); o1[i] = (unsigned)vv16[8 + 2 * i] | ((unsigned)vv16[9 + 2 * i] << 16); }
        *(u32x4*)VTp = o0; *(u32x4*)(VTp + 8) = o1; }
      DTB[(size_t)tok0 * 16 + tid] = softplusf_(zxv(ZX, tok0 + (tid >> 4), ODT + (tid & 15)) + INP(I_DTBIAS)[(size_t)l * 16 + (tid & 15)]);
      gdl[tid] = zxv(ZX, tok0 + (tid >> 5), OGD + (tid & 31)); gdl[256 + tid] = zxv(ZX, tok0 + 8 + (tid >> 5), OGD + (tid & 31));
    }
#pragma unroll 1
    for (int g = 0; g < 5; ++g) {
      const bool act = !(g == 4 && tid >= 128);
      const int ch = act ? g * 256 + tid : 0;
      const bf16_t* zp0 = ZX + (size_t)tok0 * NIN_ + ORW + ch;
      const bf16_t* zp = zp0 - NIN_;
      const float m0 = mu[ch], m1 = mu[1152 + ch], m2 = mu[2304 + ch], m3 = mu[3456 + ch];
      float z[18], o[16];
#pragma unroll
      for (int i = 0; i < 18; ++i) { z[i] = ((i == 0 && !lval) || (i == 17 && !rval)) ? 0.f : bf2f(*zp); zp += NIN_; LAUNDER_V(zp); }
#pragma unroll
      for (int i = 0; i < 16; ++i) o[i] = z[i + 1] + m0 * (z[i] - z[i + 1]) + m1 * (z[i + 2] - z[i + 1]);
      if (!isctx) {
        const bf16_t* up = zp0 - (size_t)64 * NIN_; const bf16_t* dn = zp0 + (size_t)64 * NIN_;
#pragma unroll
        for (int i = 0; i < 16; ++i) { const float zu = uval ? bf2f(*up) : 0.f, zd = dval ? bf2f(*dn) : 0.f; up += NIN_; dn += NIN_; LAUNDER_V(up); LAUNDER_V(dn);
          o[i] += m2 * (zu - z[i + 1]) + m3 * (zd - z[i + 1]); } }
      if (g == 0) { bf16_t* rp = RR + (size_t)tok0 * 256 + tid;
#pragma unroll
        for (int i = 0; i < 16; ++i) { *rp = f2bf(o[i]); rp += 256; LAUNDER_V(rp); }
      } else if (g == 1) { bf16_t* kp = KKb + (size_t)tok0 * 256 + tid; bf16_t* krp = KRW + (size_t)tok0 * 256 + tid;
#pragma unroll
        for (int i = 0; i < 16; ++i) { const float kq = o[i] * kkw, nrm = sqrtf(wave_sum(kq * kq));
          *kp = f2bf(kq / fmaxf(nrm, 1e-12f)); *krp = f2bf(o[i]); kp += 256; krp += 256; LAUNDER_V(kp); LAUNDER_V(krp); }
      } else if (g == 2) { bf16_t* vp2 = VV + (size_t)tok0 * 256 + tid;
#pragma unroll
        for (int i = 0; i < 16; ++i) { *vp2 = f2bf(o[i]); vp2 += 256; LAUNDER_V(vp2); }
      } else if (g == 3) { bf16_t* lp = LIg + (size_t)tok0 * 384 + tid;
#pragma unroll
        for (int i = 0; i < 16; ++i) { *lp = f2bf(tid < 128 ? tanhf(o[i]) : o[i]); lp += 384; LAUNDER_V(lp); }
      } else if (act) { bf16_t* lp = LIg + (size_t)tok0 * 384 + 256 + tid;
#pragma unroll
        for (int i = 0; i < 16; ++i) { *lp = f2bf(sigmoidf_(o[i])); lp += 384; LAUNDER_V(lp); }
      }
    }
    __syncthreads();
    { const int d = tid >> 7, c = tid & 127; const float* gu = INP(I_GU) + ((size_t)l * 2 + d) * 16 * 128; const float gb = INP(I_GB)[((size_t)l * 2 + d) * 128 + c];
      float guw[16];
#pragma unroll
      for (int i = 0; i < 16; ++i) guw[i] = gu[i * 128 + c];
#pragma unroll 4
      for (int tt = 0; tt < 16; ++tt) { float sacc = gb;
#pragma unroll
        for (int i = 0; i < 16; ++i) sacc += gdl[tt * 32 + d * 16 + i] * guw[i];
        LA[((size_t)d * NT_ + tok0 + tt) * 128 + c] = logsigmoidf_(sacc) * (1.f / 16.f); } }
  }
}

DEVFN void phase3b(const Params& p, int l, unsigned char* smem) {
  const bf16_t* LIg = (const bf16_t*)(p.ws + Ws::LI);
  const bf16_t* lora = (const bf16_t*)(p.ws + Ws::LORA) + (size_t)l * 98304;
  const bf16_t* KRg = (const bf16_t*)(p.ws + Ws::KRW); const bf16_t* KKg = (const bf16_t*)(p.ws + Ws::KK);
  float* LWp = (float*)(p.ws + Ws::LW); bf16_t* KD = (bf16_t*)(p.ws + Ws::KD); bf16_t* BD = (bf16_t*)(p.ws + Ws::BD); float* GATE = (float*)(p.ws + Ws::GATE);
  for (int u = BIDX; u < (NT_ / 128) * 10; u += gridDim.x) {
    const int rt = u / 10, which = (u % 10) >> 1, ct = u & 1;
    const int K = which < 4 ? 64 : 128, acol = which < 4 ? which * 64 : 256;
    const bf16_t* wb = which < 2 ? lora + (size_t)which * 16384 : which < 4 ? lora + 32768 + (size_t)(which - 2) * 16384 : lora + 65536;
    const float* bias = which < 2 ? INP(I_W0) + (size_t)l * 512 + which * 256 : INP(I_A0) + (size_t)l * 512 + (which & 1) * 256;
    const float* kav = INP(I_KAW) + (size_t)l * 256;
    gemm_tile(smem, K,
      [&](int r) { return LIg + (size_t)(rt * 128 + r) * 384 + acol; },
      [&](int r) { return wb + (size_t)(ct * 128 + r) * K; },
      [&](f32x4 (&acc)[4][4], int wr, int wc, int g, int l15) {
#pragma unroll
        for (int ni = 0; ni < 4; ++ni) { const int col = ct * 128 + wc * 64 + ni * 16 + l15;
          const float bv = which < 4 ? bias[col] : 0.f, ka = kav[col];
#pragma unroll
          for (int mi = 0; mi < 4; ++mi)
#pragma unroll
            for (int i = 0; i < 4; ++i) { const int row = rt * 128 + wr * 64 + mi * 16 + 4 * g + i; const size_t o = (size_t)row * 256 + col;
              const float v = acc[mi][ni][i];
              if (which < 2) LWp[(size_t)which * NT_ * 256 + o] = -0.6065306597126334f * sigmoidf_(v + bv);
              else if (which < 4) { const float a = sigmoidf_(v + bv); const size_t od = (size_t)(which - 2) * NT_ * 256 + o;
                KD[od] = f2bf(bf2f(KRg[o]) * (1.f + (a - 1.f) * ka)); BD[od] = f2bf(bf2f(KKg[o]) * a); }
              else GATE[o] = v; } }
      });
  }
}

DEVFN bf16x8 ld8(const bf16_t* p) { return *(const bf16x8*)p; }
typedef short bf16x4v __attribute__((ext_vector_type(4)));
DEVFN bf16x4v cvt4(f32x4 v) { return bf16x4v{(short)f2bf(v[0]), (short)f2bf(v[1]), (short)f2bf(v[2]), (short)f2bf(v[3])}; }
DEVFN bf16x8 cat44(bf16x4v a, bf16x4v b) { return bf16x8{a[0], a[1], a[2], a[3], b[0], b[1], b[2], b[3]}; }
DEVFN bf16x4v ld4(const bf16_t* p) { return *(const bf16x4v*)p; }
DEVFN int rm_off(int i, int k) { return i * 64 + ((((k >> 3) ^ (i & 7)) << 3) | (k & 7)); }
#define RW_WAVE_LDS 11264
DEVFN void rwkv_chunk(const Params& p, int unit_base, unsigned char* smem) {
  const int tid = TIDX, lane = tid & 63, wave = tid >> 6, q = lane >> 4, l15 = lane & 15;
  const int unit = unit_base + wave;
  const int c = unit % NC16, h = (unit / NC16) & 3, dir = (unit / (NC16 * 4)) & 1, b = unit / (NC16 * 8);
  bf16_t* big = (bf16_t*)(smem + wave * RW_WAVE_LDS);
  unsigned char* small = smem + wave * RW_WAVE_LDS + 8192;
  float* AbF = (float*)small;
  bf16_t* TN = (bf16_t*)(small + 1024);
  bf16_t* AK = TN + 256; bf16_t* RB = AK + 256; bf16_t* RK = RB + 256;
  const bf16_t* RRg = (const bf16_t*)(p.ws + Ws::RR); const bf16_t* VVg = (const bf16_t*)(p.ws + Ws::VV); const bf16_t* KKg = (const bf16_t*)(p.ws + Ws::KK);
  const bf16_t* KDg = (const bf16_t*)(p.ws + Ws::KD) + (size_t)dir * NT_ * 256; const bf16_t* BDg = (const bf16_t*)(p.ws + Ws::BD) + (size_t)dir * NT_ * 256;
  const float* LWg = (const float*)(p.ws + Ws::LW) + (size_t)dir * NT_ * 256;
  float kkm[16], vv[16], bneg[16], kneg[16];
  float run = 0.f;
  __syncthreads();
#pragma unroll
  for (int i = 0; i < 16; ++i) {
    const size_t o = (size_t)(b * T_ + tokmap(dir, c * 16 + i)) * 256 + h * 64 + lane;
    const float lw = LWg[o], r = bf2f(RRg[o]), k = bf2f(KDg[o]), v = bf2f(VVg[o]), kk = bf2f(KKg[o]), bb = bf2f(BDg[o]);
    const float e_ex = expf(run); run += lw; const float e_in = expf(run), e_neg = expf(-run);
    kkm[i] = kk * e_ex; vv[i] = v; bneg[i] = bb * e_neg; kneg[i] = k * e_neg;
    big[rm_off(i, lane)] = f2bf(kkm[i]); big[1024 + rm_off(i, lane)] = f2bf(r * e_in);
    big[2048 + rm_off(i, lane)] = f2bf(bneg[i]); big[3072 + rm_off(i, lane)] = f2bf(kneg[i]);
  }
  const float WC = expf(run);
  __syncthreads();
  f32x4 ab = f32x4{0.f, 0.f, 0.f, 0.f}, ak = ab, rb = ab, rk = ab;
#pragma unroll
  for (int s2 = 0; s2 < 2; ++s2) { const int ch = ((4 * s2 + q) ^ (l15 & 7)) << 3;
    const bf16x8 a_kk = ld8(big + l15 * 64 + ch), a_r = ld8(big + 1024 + l15 * 64 + ch), b_b = ld8(big + 2048 + l15 * 64 + ch), b_k = ld8(big + 3072 + l15 * 64 + ch);
    ab = MFMA16(a_kk, b_b, ab); ak = MFMA16(a_kk, b_k, ak); rb = MFMA16(a_r, b_b, rb); rk = MFMA16(a_r, b_k, rk); }
  f32x4 gacc[4];
#pragma unroll
  for (int nk = 0; nk < 4; ++nk)
#pragma unroll
    for (int r = 0; r < 4; ++r) gacc[nk][r] = bf2f(big[1024 + rm_off(4 * q + r, 16 * nk + l15)]);
  __syncthreads();
#pragma unroll
  for (int r = 0; r < 4; ++r) { const int i = 4 * q + r, j = l15;
    AbF[i * 16 + j] = j < i ? ab[r] : 0.f; AK[i * 16 + j] = f2bf(j < i ? ak[r] : 0.f);
    RB[i * 16 + j] = f2bf(j <= i ? rb[r] : 0.f); RK[i * 16 + j] = f2bf(j <= i ? rk[r] : 0.f); }
  { bf16_t* KKMT = big; bf16_t* VTT = big + 1024; bf16_t* BHT = big + 2048; bf16_t* KHT = big + 3072;
#pragma unroll
    for (int i = 0; i < 16; ++i) { KKMT[lane * 16 + i] = f2bf(kkm[i]); VTT[lane * 16 + i] = f2bf(vv[i]); BHT[lane * 16 + i] = f2bf(bneg[i] * WC); KHT[lane * 16 + i] = f2bf(kneg[i] * WC); } }
  __syncthreads();
  { float t[16];
#pragma unroll
    for (int i = 0; i < 16; ++i) { float acc = (i == l15) ? 1.f : 0.f;
#pragma unroll
      for (int j = 0; j < i; ++j) acc -= AbF[i * 16 + j] * t[j];
      t[i] = acc; }
    if (q == 0) {
#pragma unroll
      for (int i = 0; i < 16; ++i) TN[i * 16 + l15] = f2bf(-t[i]); } }
  __syncthreads();
  const size_t ci = (size_t)((b * 2 + dir) * 4 + h) * NC16 + c;
  bf16_t* MLg = (bf16_t*)(p.ws + Ws::RML) + ci * 4096; bf16_t* Ng = (bf16_t*)(p.ws + Ws::RNS) + ci * 4096;
  bf16_t* Gg = (bf16_t*)(p.ws + Ws::RG) + ci * 1024; float* Y0g = (float*)(p.ws + Ws::RY0) + ci * 1024;
  const bf16x4v a_T = ld4(TN + l15 * 16 + 4 * q), a_Ak = ld4(AK + l15 * 16 + 4 * q), a_Rb = ld4(RB + l15 * 16 + 4 * q), a_Rk = ld4(RK + l15 * 16 + 4 * q);
  const f32x4 z4 = f32x4{0.f, 0.f, 0.f, 0.f};
  bf16x4v vfr[4], qfr[4], pfr[4];
#pragma unroll
  for (int n = 0; n < 4; ++n) {
    vfr[n] = ld4(big + 1024 + (16 * n + l15) * 16 + 4 * q);
    const f32x4 akv = MFMA16K16(a_Ak, vfr[n], z4);
    qfr[n] = cvt4(MFMA16K16(a_T, cvt4(akv), z4));
    pfr[n] = cvt4(MFMA16K16(a_T, ld4(big + (16 * n + l15) * 16 + 4 * q), z4)); }
  const bf16x8 a_RbRk = cat44(a_Rb, a_Rk);
#pragma unroll
  for (int n = 0; n < 4; ++n) {
    const f32x4 g = MFMA16K16(a_Rb, pfr[n], gacc[n]);
    const f32x4 y0 = MFMA16(a_RbRk, cat44(qfr[n], vfr[n]), z4);
#pragma unroll
    for (int r = 0; r < 4; ++r) { Gg[(4 * q + r) * 64 + 16 * n + l15] = f2bf(g[r]); Y0g[(4 * q + r) * 64 + 16 * n + l15] = y0[r]; } }
#pragma unroll
  for (int mk = 0; mk < 4; ++mk) {
    const bf16x4v a_B = ld4(big + 2048 + (16 * mk + l15) * 16 + 4 * q), a_K = ld4(big + 3072 + (16 * mk + l15) * 16 + 4 * q);
    const bf16x8 a_BK = cat44(a_B, a_K);
#pragma unroll
    for (int n = 0; n < 4; ++n) {
      const f32x4 m = MFMA16K16(a_B, pfr[n], z4);
      const f32x4 nn = MFMA16(a_BK, cat44(qfr[n], vfr[n]), z4);
#pragma unroll
      for (int r = 0; r < 4; ++r) MLg[((mk * 2 + (n >> 1)) * 64 + (l15 >> 2) * 16 + 4 * q + r) * 8 + (n & 1) * 4 + (l15 & 3)] = f2bf(m[r]);
      *(bf16x4v*)(Ng + (n * 64 + lane) * 16 + mk * 4) = cvt4(nn); } }
  ((float*)(p.ws + Ws::RWC))[ci * 64 + ((lane >> 2) & 3) * 16 + (lane >> 4) * 4 + (lane & 3)] = WC;
}
struct RwStep { bf16x8 ml[4][2]; bf16x8 n[2]; f32x4 wc[4]; };
DEVFN void rw_load(RwStep& t, const bf16_t* MLg, const bf16_t* NSg, const float* WCg, int c, int lane, int q) {
#pragma unroll
  for (int mk = 0; mk < 4; ++mk) { t.ml[mk][0] = ld8g(MLg + (size_t)c * 4096 + ((mk * 2 + 0) * 64 + lane) * 8); t.ml[mk][1] = ld8g(MLg + (size_t)c * 4096 + ((mk * 2 + 1) * 64 + lane) * 8);
    t.wc[mk] = *(const AS1 f32x4*)gptr(WCg + (size_t)c * 64 + q * 16 + mk * 4); }
  t.n[0] = ld8g(NSg + (size_t)c * 4096 + lane * 16); t.n[1] = ld8g(NSg + (size_t)c * 4096 + lane * 16 + 8);
}
DEVFN void rw_step(const RwStep& t, f32x4 (&S)[4], bf16_t* NSg, int c, int q, int l15) {
  bf16x4v sb[4];
#pragma unroll
  for (int mk = 0; mk < 4; ++mk) sb[mk] = cvt4(S[mk]);
  const bf16x8 bf0 = cat44(sb[0], sb[1]), bf1 = cat44(sb[2], sb[3]);
#pragma unroll
  for (int mk = 0; mk < 4; ++mk) {
    f32x4 acc;
#pragma unroll
    for (int r = 0; r < 4; ++r) acc[r] = bf2f((bf16_t)t.n[mk >> 1][(mk & 1) * 4 + r]) + t.wc[mk][r] * S[mk][r];
    acc = MFMA16(t.ml[mk][0], bf0, acc);
    acc = MFMA16(t.ml[mk][1], bf1, acc);
    S[mk] = acc; }
#pragma unroll
  for (int mk = 0; mk < 4; ++mk) *(AS1 bf16x4v*)gptr(NSg + (size_t)c * 4096 + l15 * 64 + 16 * mk + 4 * q) = sb[mk];
}
DEVFN void rwkv_scan(const Params& p, int chain, int wave) {
  const int tid = TIDX, lane = tid & 63, q = lane >> 4, l15 = lane & 15;
  const bf16_t* MLg = (const bf16_t*)(p.ws + Ws::RML) + (size_t)chain * NC16 * 4096;
  bf16_t* NSg = (bf16_t*)(p.ws + Ws::RNS) + (size_t)chain * NC16 * 4096 + wave * 1024;
  const float* WCg = (const float*)(p.ws + Ws::RWC) + (size_t)chain * NC16 * 64;
  f32x4 S[4];
#pragma unroll
  for (int mk = 0; mk < 4; ++mk) S[mk] = f32x4{0.f, 0.f, 0.f, 0.f};
  RwStep t0, t1, t2;
#define RWC_(x) ((x) < NC16 ? (x) : NC16 - 1)
  rw_load(t0, MLg, NSg, WCg, 0, lane, q);
  rw_load(t1, MLg, NSg, WCg, RWC_(1), lane, q);
  int c = 0;
  for (; c + 2 < NC16; c += 3) {
    rw_load(t2, MLg, NSg, WCg, c + 2, lane, q);
    rw_step(t0, S, NSg, c, q, l15);
    rw_load(t0, MLg, NSg, WCg, RWC_(c + 3), lane, q);
    rw_step(t1, S, NSg, c + 1, q, l15);
    rw_load(t1, MLg, NSg, WCg, RWC_(c + 4), lane, q);
    rw_step(t2, S, NSg, c + 2, q, l15);
  }
  if (c < NC16) { rw_step(t0, S, NSg, c, q, l15); if (c + 1 < NC16) rw_step(t1, S, NSg, c + 1, q, l15); }
#undef RWC_
}
DEVFN void rwkv_out(const Params& p, int unit_base) {
  const int tid = TIDX, lane = tid & 63, wave = tid >> 6, q = lane >> 4, l15 = lane & 15;
  const int unit = unit_base + wave;
  const int c = unit % NC16, h = (unit / NC16) & 3, dir = (unit / (NC16 * 4)) & 1, b = unit / (NC16 * 8);
  const size_t ci = (size_t)((b * 2 + dir) * 4 + h) * NC16 + c;
  const bf16_t* Sg = (const bf16_t*)(p.ws + Ws::RNS) + ci * 4096; const bf16_t* Gg = (const bf16_t*)(p.ws + Ws::RG) + ci * 1024;
  const float* Y0g = (const float*)(p.ws + Ws::RY0) + ci * 1024;
  float* YR = (float*)(p.ws + Ws::YR) + (size_t)dir * NT_ * 256;
  const bf16x8 a0 = ld8(Gg + l15 * 64 + 8 * q), a1 = ld8(Gg + l15 * 64 + 32 + 8 * q);
#pragma unroll
  for (int n = 0; n < 4; ++n) {
    f32x4 acc;
#pragma unroll
    for (int r = 0; r < 4; ++r) acc[r] = Y0g[(4 * q + r) * 64 + 16 * n + l15];
    acc = MFMA16(a0, ld8(Sg + n * 1024 + l15 * 64 + 8 * q), acc);
    acc = MFMA16(a1, ld8(Sg + n * 1024 + l15 * 64 + 32 + 8 * q), acc);
#pragma unroll
    for (int r = 0; r < 4; ++r) YR[(size_t)(b * T_ + tokmap(dir, c * 16 + 4 * q + r)) * 256 + h * 64 + 16 * n + l15] = acc[r]; }
}
DEVFN int cscan(int dir, int co, int nctx, int nc) { return dir == 0 ? co : (co < nctx ? nctx - 1 - co : 2 * nctx + nc - 1 - co); }
DEVFN bf16x8 ld4x2(const bf16_t* p0, const bf16_t* p1) { bf16x4v a = *(const bf16x4v*)p0, b = *(const bf16x4v*)p1; return bf16x8{a[0], a[1], a[2], a[3], b[0], b[1], b[2], b[3]}; }

DEVFN void ssd_chunk_scalars(const Params& p, int l, int b, int co, int h, float* f) {
  const int tid = TIDX, d = tid >> 7, j = tid & 127;
  const float* DTB = (const float*)(p.ws + Ws::DTB);
  const float nega = -expf(INP(I_ALOG)[(size_t)l * 16 + d * 8 + h]);
  const float dt = DTB[(size_t)(b * T_ + co * 128 + j) * 16 + d * 8 + h];
  __syncthreads();
  f[256 + d * 128 + j] = dt;
  float* cur = f + d * 128; float* tmp = f + 512 + d * 128;
  cur[j] = dt * nega;
  __syncthreads();
  for (int off = 1; off < 128; off <<= 1) {
    float v = cur[j] + (j >= off ? cur[j - off] : 0.f);
    tmp[j] = v;
    __syncthreads();
    cur[j] = tmp[j];
    __syncthreads();
  }
}
DEVFN void ssd_states(const Params& p, int l, int unit, unsigned char* smem) {
  const int tid = TIDX, lane = tid & 63, wave = tid >> 6, q = lane >> 4, l15 = lane & 15;
  const int h = unit & 7, co = (unit >> 3) % NC128, b = unit / (8 * NC128), grp = h >> 2;
  float* f = (float*)smem;
  ssd_chunk_scalars(p, l, b, co, h, f);
  { const int d = tid >> 7, j = tid & 127; const float* cum = f + d * 128; const float dt = f[256 + d * 128 + j];
    float w = d == 0 ? expf(cum[127] - cum[j]) * dt : expf(j > 0 ? cum[j - 1] : 0.f) * dt;
    f[512 + d * 128 + j] = w; }
  __syncthreads();
  const bf16_t* XT = (const bf16_t*)(p.ws + Ws::XBCT) + (size_t)(b * NC128 + co) * 768 * 128;
  f32x4 acc[2][8];
#pragma unroll
  for (int d = 0; d < 2; ++d)
#pragma unroll
    for (int n = 0; n < 8; ++n) acc[d][n] = f32x4{0.f, 0.f, 0.f, 0.f};
#pragma unroll 1
  for (int s4 = 0; s4 < 4; ++s4) {
    const int j0 = s4 * 32 + q * 8;
    bf16x8 xa = ld8(XT + (size_t)(h * 64 + wave * 16 + l15) * 128 + j0), a0, a1;
#pragma unroll
    for (int jj = 0; jj < 8; ++jj) { float x = bf2f((bf16_t)xa[jj]); a0[jj] = (short)f2bf(x * f[512 + j0 + jj]); a1[jj] = (short)f2bf(x * f[640 + j0 + jj]); }
#pragma unroll
    for (int n = 0; n < 8; ++n) { bf16x8 bb = ld8(XT + (size_t)(512 + grp * 128 + n * 16 + l15) * 128 + j0);
      acc[0][n] = MFMA16(a0, bb, acc[0][n]); acc[1][n] = MFMA16(a1, bb, acc[1][n]); }
  }
#pragma unroll
  for (int d = 0; d < 2; ++d) {
    const int cs = cscan(d, co, CTX_ / 128, SEQ_ / 128);
    float* ST = (float*)(p.ws + Ws::SST) + ((size_t)((d * B_ + b) * NC128 + cs) * 8 + h) * 8192;
#pragma unroll
    for (int n = 0; n < 8; ++n)
#pragma unroll
      for (int r = 0; r < 4; ++r) ST[(wave * 16 + q * 4 + r) * 128 + n * 16 + l15] = acc[d][n][r];
    if (tid == 0) ((float*)(p.ws + Ws::SCD))[((size_t)(d * B_ + b) * NC128 + cs) * 8 + h] = expf(f[d * 128 + 127]);
  }
}
#define SSD_SB ((NC128 % 17) == 0 ? 17 : NC128)
DEVFN void ssd_scan(const Params& p, int gtid, int gthreads) {
  const float* __restrict__ ST = (const float*)(p.ws + Ws::SST); const float* __restrict__ CD = (const float*)(p.ws + Ws::SCD); bf16_t* __restrict__ HIN = (bf16_t*)(p.ws + Ws::HIN);
  for (int e = gtid; e < 2 * B_ * 8 * 8192; e += gthreads) {
    const int pd = e & 8191, h = (e >> 13) & 7, db = e >> 16;
    float hv = 0.f;
#pragma unroll 1
    for (int c0 = 0; c0 < NC128; c0 += SSD_SB) {
      float st[SSD_SB], cd[SSD_SB];
#pragma unroll
      for (int i = 0; i < SSD_SB; ++i) { st[i] = ST[((size_t)(db * NC128 + c0 + i) * 8 + h) * 8192 + pd]; cd[i] = CD[(size_t)(db * NC128 + c0 + i) * 8 + h]; }
#pragma unroll
      for (int i = 0; i < SSD_SB; ++i) { HIN[((size_t)(db * NC128 + c0 + i) * 8 + h) * 8192 + pd] = f2bf(hv); hv = hv * cd[i] + st[i]; }
    }
  }
}
DEVFN void ssd_out(const Params& p, int l, int unit, unsigned char* smem) {
  const int tid = TIDX, lane = tid & 63, wave = tid >> 6, q = lane >> 4, l15 = lane & 15;
  const int h = unit & 7, co = (unit >> 3) % NC128, b = unit / (8 * NC128), grp = h >> 2;
  float* f = (float*)smem;
  ssd_chunk_scalars(p, l, b, co, h, f);
  if (tid < 128) f[640 + tid] = f[128 + 127] - (tid > 0 ? f[128 + tid - 1] : 0.f);
  __syncthreads();
  const float* cum0 = f; const float* suf1 = f + 640; const float* dt0 = f + 256; const float* dt1 = f + 384;
  const bf16_t* XBC = (const bf16_t*)(p.ws + Ws::XBC) + (size_t)(b * T_ + co * 128) * 1024;
  const bf16_t* XT = (const bf16_t*)(p.ws + Ws::XBCT) + (size_t)(b * NC128 + co) * 768 * 128;
  const bf16_t* Cb = XBC + (size_t)(wave * 32 + l15) * 1024 + 768 + grp * 128 + q * 8;
  f32x4 y[4][2];
  { f32x4 o0[4][2], o1[4][2];
#pragma unroll
    for (int mp = 0; mp < 4; ++mp)
#pragma unroll
      for (int ni = 0; ni < 2; ++ni) { o0[mp][ni] = f32x4{0.f, 0.f, 0.f, 0.f}; o1[mp][ni] = f32x4{0.f, 0.f, 0.f, 0.f}; }
    const int cs0 = cscan(0, co, CTX_ / 128, SEQ_ / 128), cs1 = cscan(1, co, CTX_ / 128, SEQ_ / 128);
    const bf16_t* H0 = (const bf16_t*)(p.ws + Ws::HIN) + ((size_t)((0 * B_ + b) * NC128 + cs0) * 8 + h) * 8192;
    const bf16_t* H1 = (const bf16_t*)(p.ws + Ws::HIN) + ((size_t)((1 * B_ + b) * NC128 + cs1) * 8 + h) * 8192;
#pragma unroll 1
    for (int s4 = 0; s4 < 4; ++s4) { const bf16x8 c0 = ld8(Cb + s4 * 32), c1 = ld8(Cb + 16 * 1024 + s4 * 32);
#pragma unroll
      for (int mp = 0; mp < 4; ++mp) { bf16x8 h0 = ld8(H0 + (size_t)(mp * 16 + l15) * 128 + s4 * 32 + q * 8), h1 = ld8(H1 + (size_t)(mp * 16 + l15) * 128 + s4 * 32 + q * 8);
        o0[mp][0] = MFMA16(h0, c0, o0[mp][0]); o0[mp][1] = MFMA16(h0, c1, o0[mp][1]);
        o1[mp][0] = MFMA16(h1, c0, o1[mp][0]); o1[mp][1] = MFMA16(h1, c1, o1[mp][1]); } }
#pragma unroll
    for (int ni = 0; ni < 2; ++ni) { const int i = wave * 32 + ni * 16 + l15; const float e0 = expf(cum0[i]), e1 = expf(suf1[i]);
#pragma unroll
      for (int mp = 0; mp < 4; ++mp)
#pragma unroll
        for (int r = 0; r < 4; ++r) y[mp][ni][r] = e0 * o0[mp][ni][r] + e1 * o1[mp][ni][r]; } }
  bf16x8 mfr[4][2];
  { f32x4 g[8][2];
#pragma unroll
    for (int mj = 0; mj < 8; ++mj) { g[mj][0] = f32x4{0.f, 0.f, 0.f, 0.f}; g[mj][1] = f32x4{0.f, 0.f, 0.f, 0.f}; }
#pragma unroll 1
    for (int s4 = 0; s4 < 4; ++s4) { const bf16x8 c0 = ld8(Cb + s4 * 32), c1 = ld8(Cb + 16 * 1024 + s4 * 32);
#pragma unroll
      for (int mj = 0; mj < 8; ++mj) { bf16x8 bb = ld8(XBC + (size_t)(mj * 16 + l15) * 1024 + 512 + grp * 128 + s4 * 32 + q * 8);
        g[mj][0] = MFMA16(bb, c0, g[mj][0]); g[mj][1] = MFMA16(bb, c1, g[mj][1]); } }
    const int i0 = wave * 32 + l15, i1 = i0 + 16;
    const float c0i0 = cum0[i0], s1i0 = suf1[i0], c0i1 = cum0[i1], s1i1 = suf1[i1];
#pragma unroll
    for (int mj = 0; mj < 8; ++mj)
#pragma unroll
      for (int r = 0; r < 4; ++r) { const int j = mj * 16 + q * 4 + r;
        const float cj = cum0[j], sj = suf1[j], d0 = dt0[j], d1 = dt1[j];
        const float lw0 = (j <= i0 ? expf(c0i0 - cj) * d0 : 0.f) + (j >= i0 ? expf(s1i0 - sj) * d1 : 0.f);
        const float lw1 = (j <= i1 ? expf(c0i1 - cj) * d0 : 0.f) + (j >= i1 ? expf(s1i1 - sj) * d1 : 0.f);
        mfr[mj >> 1][0][(mj & 1) * 4 + r] = (short)f2bf(g[mj][0][r] * lw0);
        mfr[mj >> 1][1][(mj & 1) * 4 + r] = (short)f2bf(g[mj][1][r] * lw1); } }
#pragma unroll
  for (int s4 = 0; s4 < 4; ++s4)
#pragma unroll
    for (int mp = 0; mp < 4; ++mp) { const bf16_t* xr = XT + (size_t)(h * 64 + mp * 16 + l15) * 128 + s4 * 32 + q * 4;
      bf16x8 xa = ld4x2(xr, xr + 16);
      y[mp][0] = MFMA16(xa, mfr[s4][0], y[mp][0]); y[mp][1] = MFMA16(xa, mfr[s4][1], y[mp][1]); }
  __syncthreads();
  float* yl = f + 1024;
#pragma unroll
  for (int mp = 0; mp < 4; ++mp)
#pragma unroll
    for (int ni = 0; ni < 2; ++ni)
#pragma unroll
      for (int r = 0; r < 4; ++r) yl[(wave * 32 + ni * 16 + l15) * 65 + mp * 16 + q * 4 + r] = y[mp][ni][r];
  __syncthreads();
  float* YS = (float*)(p.ws + Ws::YS) + (size_t)(b * T_ + co * 128) * 512 + h * 64;
  for (int e = tid; e < 128 * 64; e += 256) YS[(size_t)(e >> 6) * 512 + (e & 63)] = yl[(e >> 6) * 65 + (e & 63)];
}

#define GQ_LD 40
#define GK_LD 72
DEVFN void gla_chunk(const Params& p, int unit, unsigned char* smem) {
  const int tid = TIDX, lane = tid & 63, wave = tid >> 6, q = lane >> 4, l15 = lane & 15;
  const int h = unit & 3, co = (unit >> 2) % NC64, b = unit / (4 * NC64);
  const bf16_t* ZX = (const bf16_t*)(p.ws + Ws::ZX) + (size_t)(b * T_ + co * 64) * NIN_;
  const float* LA = (const float*)(p.ws + Ws::LA);
  float* cum = (float*)smem;
  bf16_t* qs = (bf16_t*)(smem + 16384);
  bf16_t* ks = qs + 2 * 64 * GQ_LD;
  bf16_t* kt = ks + 2 * 64 * GQ_LD;
  __syncthreads();
  for (int e = tid; e < 2 * 64 * 32; e += 256) { const int d = e >> 11, i = (e >> 5) & 63, dd = e & 31;
    cum[e] = LA[((size_t)d * NT_ + b * T_ + co * 64 + i) * 128 + h * 32 + dd]; }
  __syncthreads();
  if (tid < 64) { const int d = tid >> 5, dd = tid & 31; float* c = cum + d * 2048 + dd; float sacc = 0.f;
    if (d == 0) for (int i = 0; i < 64; ++i) { sacc += c[i * 32]; c[i * 32] = sacc; }
    else for (int i = 63; i >= 0; --i) { sacc += c[i * 32]; c[i * 32] = sacc; } }
  __syncthreads();
  bf16_t* QT = (bf16_t*)(p.ws + Ws::QT);
  for (int e = tid; e < 64 * 32; e += 256) { const int i = e >> 5, dd = e & 31;
    const float qv = bf2f(ZX[(size_t)i * NIN_ + OGQ + h * 32 + dd]) * 0.17677669529663687f, kv = bf2f(ZX[(size_t)i * NIN_ + OGK + h * 32 + dd]);
    const float c0 = cum[i * 32 + dd], c1 = cum[2048 + i * 32 + dd], t0 = cum[63 * 32 + dd], t1 = cum[2048 + dd];
    const bf16_t q0 = f2bf(qv * expf(c0)), q1 = f2bf(qv * expf(c1));
    qs[i * GQ_LD + dd] = q0; qs[64 * GQ_LD + i * GQ_LD + dd] = q1;
    ks[i * GQ_LD + dd] = f2bf(kv * expf(-c0)); ks[64 * GQ_LD + i * GQ_LD + dd] = f2bf(kv * expf(-c1));
    kt[dd * GK_LD + i] = f2bf(kv * expf(t0 - c0)); kt[32 * GK_LD + dd * GK_LD + i] = f2bf(kv * expf(t1 - c1));
    const size_t tok = (size_t)b * T_ + co * 64 + i;
    QT[tok * 128 + h * 32 + dd] = q0; QT[((size_t)NT_ + tok) * 128 + h * 32 + dd] = q1; }
  if (tid < 64) { const int d = tid >> 5, dd = tid & 31; const int cs = cscan(d, co, CTX_ / 64, SEQ_ / 64);
    ((float*)(p.ws + Ws::GCD))[(((size_t)(d * B_ + b) * NC64 + cs) * 4 + h) * 32 + dd] = expf(d == 0 ? cum[63 * 32 + dd] : cum[2048 + dd]); }
  __syncthreads();
  bf16x8 pfr[2];
  { f32x4 p0[4], p1[4];
    const bf16x8 qb0 = ld8(qs + (wave * 16 + l15) * GQ_LD + q * 8), qb1 = ld8(qs + 64 * GQ_LD + (wave * 16 + l15) * GQ_LD + q * 8);
#pragma unroll
    for (int mj = 0; mj < 4; ++mj) { p0[mj] = MFMA16(ld8(ks + (mj * 16 + l15) * GQ_LD + q * 8), qb0, (f32x4{0.f, 0.f, 0.f, 0.f}));
      p1[mj] = MFMA16(ld8(ks + 64 * GQ_LD + (mj * 16 + l15) * GQ_LD + q * 8), qb1, (f32x4{0.f, 0.f, 0.f, 0.f})); }
    const int i = wave * 16 + l15;
#pragma unroll
    for (int mj = 0; mj < 4; ++mj)
#pragma unroll
      for (int r = 0; r < 4; ++r) { const int j = mj * 16 + q * 4 + r; pfr[mj >> 1][(mj & 1) * 4 + r] = (short)f2bf((j <= i ? p0[mj][r] : 0.f) + (j >= i ? p1[mj][r] : 0.f)); } }
  const bf16_t* VT = (const bf16_t*)(p.ws + Ws::VT) + ((size_t)(b * NC64 + co) * 256 + h * 64) * 64;
  f32x4 o[4];
#pragma unroll
  for (int md = 0; md < 4; ++md) { o[md] = f32x4{0.f, 0.f, 0.f, 0.f};
#pragma unroll
    for (int s2 = 0; s2 < 2; ++s2) { const bf16_t* vr = VT + (size_t)(md * 16 + l15) * 64 + s2 * 32 + q * 4; o[md] = MFMA16(ld4x2(vr, vr + 16), pfr[s2], o[md]); } }
#pragma unroll
  for (int d = 0; d < 2; ++d) { const int cs = cscan(d, co, CTX_ / 64, SEQ_ / 64);
    float* GST = (float*)(p.ws + Ws::GST) + (((size_t)(d * B_ + b) * NC64 + cs) * 4 + h) * 2048;
#pragma unroll
    for (int nd = 0; nd < 2; ++nd) { f32x4 st = f32x4{0.f, 0.f, 0.f, 0.f};
#pragma unroll
      for (int s2 = 0; s2 < 2; ++s2) st = MFMA16(ld8(VT + (size_t)(wave * 16 + l15) * 64 + s2 * 32 + q * 8), ld8(kt + d * 32 * GK_LD + (nd * 16 + l15) * GK_LD + s2 * 32 + q * 8), st);
#pragma unroll
      for (int r = 0; r < 4; ++r) GST[(wave * 16 + q * 4 + r) * 32 + nd * 16 + l15] = st[r]; } }
  __syncthreads();
  float* ol = (float*)smem;
#pragma unroll
  for (int md = 0; md < 4; ++md)
#pragma unroll
    for (int r = 0; r < 4; ++r) ol[(wave * 16 + l15) * 65 + md * 16 + q * 4 + r] = o[md][r];
  __syncthreads();
  float* OI = (float*)(p.ws + Ws::OI) + (size_t)(b * T_ + co * 64) * 256 + h * 64;
  for (int e = tid; e < 64 * 64; e += 256) OI[(size_t)(e >> 6) * 256 + (e & 63)] = ol[(e >> 6) * 65 + (e & 63)];
}
#define GLA_SB ((NC64 % 17) == 0 ? 17 : NC64)
DEVFN void gla_scan(const Params& p, int gtid, int gthreads) {
  const float* __restrict__ ST = (const float*)(p.ws + Ws::GST); const float* __restrict__ CD = (const float*)(p.ws + Ws::GCD); bf16_t* __restrict__ SIN = (bf16_t*)(p.ws + Ws::GSIN);
  for (int e = gtid; e < 2 * B_ * 4 * 2048; e += gthreads) {
    const int vd = e & 2047, h = (e >> 11) & 3, db = e >> 13;
    float sv = 0.f;
#pragma unroll 1
    for (int c0 = 0; c0 < NC64; c0 += GLA_SB) {
      float st[GLA_SB], cd[GLA_SB];
#pragma unroll
      for (int i = 0; i < GLA_SB; ++i) { st[i] = ST[(((size_t)db * NC64 + c0 + i) * 4 + h) * 2048 + vd]; cd[i] = CD[(((size_t)db * NC64 + c0 + i) * 4 + h) * 32 + (vd & 31)]; }
#pragma unroll
      for (int i = 0; i < GLA_SB; ++i) { SIN[(((size_t)db * NC64 + c0 + i) * 4 + h) * 2048 + vd] = f2bf(sv); sv = sv * cd[i] + st[i]; }
    }
  }
}
DEVFN void convert_moe_weights(const Params& p, int l, unsigned char* smem, int bid, int nb);
DEVFN void phase4a(const Params& p, int l, unsigned char* smem) {
  const int n_r = B_ * 8 * NC16 / 4;
  for (int u = BIDX; u < n_r; u += gridDim.x) rwkv_chunk(p, (u) * 4, smem);
  (void)l;
}
DEVFN void phase4b(const Params& p, int l, unsigned char* smem) {
  const int bid = BIDX, nrw = B_ * 8, G = (int)gridDim.x;
  const int n_s = B_ * NC128 * 8, n_g = B_ * NC64 * 4;
  int ob = bid, on = G;
  if (G >= 8 * nrw) {
    if (bid < 4 * nrw) { if ((TIDX >> 6) == 0) rwkv_scan(p, bid >> 2, bid & 3); return; }
    ob = bid - 4 * nrw; on = G - 4 * nrw; }
  else { for (int u = bid; u < nrw; u += G) rwkv_scan(p, u, TIDX >> 6); }
  for (int u = ob; u < n_s + n_g; u += on) { if (u < n_s) ssd_states(p, l, u, smem); else gla_chunk(p, u - n_s, smem); }
  convert_moe_weights(p, l, smem, ob, on);
}
DEVFN void phase4b2(const Params& p) {
  const int bid = BIDX, G = (int)gridDim.x;
  ssd_scan(p, bid * 256 + TIDX, G * 256); gla_scan(p, bid * 256 + TIDX, G * 256);
}
DEVFN void phase4c(const Params& p, int l, unsigned char* smem) {
  const int n_s = B_ * NC128 * 8, n_r = B_ * 8 * NC16 / 4;
  for (int u = BIDX; u < n_s + n_r; u += gridDim.x) { if (u < n_s) ssd_out(p, l, u, smem); else rwkv_out(p, (u - n_s) * 4); }
}

DEVFN void phase5(const Params& p, int l, unsigned char* smem) {
  const int tid = TIDX, lane = tid & 63, wave = tid >> 6;
  const bf16_t* ZX = (const bf16_t*)(p.ws + Ws::ZX);
  const bf16_t* XBC = (const bf16_t*)(p.ws + Ws::XBC);
  const float* YS = (const float*)(p.ws + Ws::YS); const float* YR = (const float*)(p.ws + Ws::YR); const float* OI = (const float*)(p.ws + Ws::OI);
  const bf16_t* QT = (const bf16_t*)(p.ws + Ws::QT); const bf16_t* GSIN = (const bf16_t*)(p.ws + Ws::GSIN);
  const bf16_t* RR = (const bf16_t*)(p.ws + Ws::RR); const bf16_t* VV = (const bf16_t*)(p.ws + Ws::VV); const bf16_t* KD = (const bf16_t*)(p.ws + Ws::KD);
  const float* GATE = (const float*)(p.ws + Ws::GATE);
  bf16_t* YM = (bf16_t*)(p.ws + Ws::YMIX);
  float* red = (float*)smem;
  float* qt = red + 16;
  const float dA = INP(I_SSDD)[(size_t)l * 8 + (tid >> 6)], dB = INP(I_SSDD)[(size_t)l * 8 + 4 + (tid >> 6)];
  const float nwA = INP(I_SSDNW)[(size_t)l * 512 + tid], nwB = INP(I_SSDNW)[(size_t)l * 512 + 256 + tid];
  const float lnw = INP(I_LNXW)[(size_t)l * 256 + tid], lnb = INP(I_LNXB)[(size_t)l * 256 + tid], rk = INP(I_RK)[(size_t)l * 256 + tid];
  const float gnw = INP(I_GNW)[(size_t)l * 256 + tid];
  for (int tp = BIDX; tp < NT_ / 2; tp += gridDim.x) {
    float ya[2], yb[2], qa[2], qb[2];
#pragma unroll
    for (int t = 0; t < 2; ++t) { const int tok = tp * 2 + t;
      ya[t] = YS[(size_t)tok * 512 + tid] + dA * bf2f(XBC[(size_t)tok * 1024 + tid]);
      yb[t] = YS[(size_t)tok * 512 + 256 + tid] + dB * bf2f(XBC[(size_t)tok * 1024 + 256 + tid]);
      ya[t] *= siluf_(zxv(ZX, tok, OZ + tid)); yb[t] *= siluf_(zxv(ZX, tok, OZ + 256 + tid));
      qa[t] = wave_sum(ya[t] * ya[t]); qb[t] = wave_sum(yb[t] * yb[t]); }
    __syncthreads();
#pragma unroll
    for (int t = 0; t < 2; ++t) { const int tok = tp * 2 + t;
      if (lane == 0) { red[t * 8 + wave] = qa[t]; red[t * 8 + 4 + wave] = qb[t]; }
      qt[t * 256 + tid] = bf2f(QT[((size_t)(tid >> 7) * NT_ + tok) * 128 + (tid & 127)]); }
    __syncthreads();
#pragma unroll
    for (int t = 0; t < 2; ++t) { const int tok = tp * 2 + t;
      const float* rd = red + t * 8; const float* qtt = qt + t * 256;
      float ma = (rd[0] + rd[1] + rd[2] + rd[3]) * (1.f / 256.f), mb = (rd[4] + rd[5] + rd[6] + rd[7]) * (1.f / 256.f);
      YM[(size_t)tok * 1024 + tid] = f2bf(ya[t] * rsqrtf(ma + 1e-5f) * nwA);
      YM[(size_t)tok * 1024 + 256 + tid] = f2bf(yb[t] * rsqrtf(mb + 1e-5f) * nwB);
      { float y = YR[(size_t)tok * 256 + tid] + YR[((size_t)NT_ + tok) * 256 + tid];
        float mu = wave_sum(y) * (1.f / 64.f), d = y - mu, var = wave_sum(d * d) * (1.f / 64.f);
        float yn = d * rsqrtf(var + 64e-5f) * lnw + lnb;
        float r = bf2f(RR[(size_t)tok * 256 + tid]), kf = bf2f(KD[(size_t)tok * 256 + tid]), kb = bf2f(KD[((size_t)NT_ + tok) * 256 + tid]);
        float bonus = wave_sum(r * (kf + kb) * rk) * bf2f(VV[(size_t)tok * 256 + tid]);
        YM[(size_t)tok * 1024 + 512 + tid] = f2bf((yn + bonus) * GATE[(size_t)tok * 256 + tid]); }
      { float o = OI[(size_t)tok * 256 + tid];
        const int b = tok / T_, co = (tok % T_) / 64;
#pragma unroll
        for (int d = 0; d < 2; ++d) { const int cs = cscan(d, co, CTX_ / 64, SEQ_ / 64);
          const bf16_t* sr = GSIN + ((((size_t)(d * B_ + b) * NC64 + cs) * 4 + wave) * 64 + lane) * 32;
#pragma unroll
          for (int c8 = 0; c8 < 4; ++c8) { bf16x8 sv = ld8(sr + c8 * 8);
#pragma unroll
            for (int jj = 0; jj < 8; ++jj) o += qtt[d * 128 + wave * 32 + c8 * 8 + jj] * bf2f((bf16_t)sv[jj]); } }
        float ms = wave_sum(o * o) * (1.f / 64.f);
        YM[(size_t)tok * 1024 + 768 + tid] = f2bf(o * rsqrtf(ms + 1e-5f) * gnw * siluf_(zxv(ZX, tok, OOG + tid))); } }
  }
}

DEVFN void phase6(const Params& p, int l, unsigned char* smem) {
  const bf16_t* A = (const bf16_t*)(p.ws + Ws::YMIX);
  const bf16_t* W = (const bf16_t*)(p.ws + Ws::WOUT) + (size_t)l * 1024 * 1024;
  float* MIX = (float*)(p.ws + Ws::MIX);
  for (int u = BIDX; u < (NT_ / 128) * 8; u += gridDim.x) {
    int rt = u / 8, ct = u % 8;
    gemm_tile(smem, 1024,
      [&](int r) { return A + (size_t)(rt * 128 + r) * 1024; },
      [&](int r) { return W + (size_t)(ct * 128 + r) * 1024; },
      [&](f32x4 (&acc)[4][4], int wr, int wc, int g, int l15) {
#pragma unroll
        for (int mi = 0; mi < 4; ++mi)
#pragma unroll
          for (int ni = 0; ni < 4; ++ni)
#pragma unroll
            for (int i = 0; i < 4; ++i) MIX[(size_t)(rt * 128 + wr * 64 + mi * 16 + 4 * g + i) * 1024 + ct * 128 + wc * 64 + ni * 16 + l15] = acc[mi][ni][i];
      });
  }
}

DEVFN void phase7(const Params& p, int l, unsigned char* smem) {
  const int lane = TIDX & 63, wave = TIDX >> 6;
  float* X = (float*)(p.ws + Ws::X);
  const float* MIX = (const float*)(p.ws + Ws::MIX);
  bf16_t* H = (bf16_t*)(p.ws + Ws::U);
  const float* rwt = (const float*)(p.ws + Ws::RWT) + (size_t)l * 64 * 1024;
  int* cnt = (int*)(p.ws + Ws::CNT) + l * 64;
  int* ltok = (int*)(p.ws + Ws::LTOK); float* lwt = (float*)(p.ws + Ws::LWT);
  const float rbias = INP(I_RB)[(size_t)l * 64 + lane];
  float* hs = (float*)smem;
  float* lg = hs + 4096;
  for (int tok0 = BIDX * 4; tok0 < NT_; tok0 += gridDim.x * 4) {
    const int tok = tok0 + wave;
    const float* mod = (const float*)(p.ws + Ws::MOD) + ((size_t)l * NR_ + tok_modrow(tok)) * NMOD_;
    float xv[16], t0[16], t1[16], mean, rstd;
    load_row16(X + (size_t)tok * 1024, lane, xv);
    load_row16(MIX + (size_t)tok * 1024, lane, t0);
    load_row16(mod + 2 * 1024, lane, t1);
#pragma unroll
    for (int i = 0; i < 16; ++i) xv[i] = ALPHA_ * xv[i] + t1[i] * t0[i];
    row_stats(xv, mean, rstd);
    load_row16(INP(I_LN1W) + (size_t)l * 1024, lane, t0);
    load_row16(INP(I_LN1B) + (size_t)l * 1024, lane, t1);
#pragma unroll
    for (int i = 0; i < 16; ++i) xv[i] = (xv[i] - mean) * rstd * t0[i] + t1[i];
#pragma unroll
    for (int j = 0; j < 4; ++j) *(float4*)(X + (size_t)tok * 1024 + lane * 4 + 256 * j) = make_float4(xv[4 * j], xv[4 * j + 1], xv[4 * j + 2], xv[4 * j + 3]);
    const bool routed = !(l == DEPTH_ - 1 && (tok % T_) < CTX_);
    row_stats(xv, mean, rstd);
    load_row16(mod + 3 * 1024, lane, t0);
    load_row16(mod + 4 * 1024, lane, t1);
#pragma unroll
    for (int i = 0; i < 16; ++i) xv[i] = (xv[i] - mean) * rstd * (1.f + t1[i]) + t0[i];
    __syncthreads();
#pragma unroll
    for (int j = 0; j < 4; ++j) {
      if (routed) *(uint2*)(H + (size_t)tok * 1024 + lane * 4 + 256 * j) = make_uint2((unsigned)f2bf(xv[4 * j]) | ((unsigned)f2bf(xv[4 * j + 1]) << 16), (unsigned)f2bf(xv[4 * j + 2]) | ((unsigned)f2bf(xv[4 * j + 3]) << 16));
      *(float4*)(hs + wave * 1024 + lane * 4 + 256 * j) = make_float4(xv[4 * j], xv[4 * j + 1], xv[4 * j + 2], xv[4 * j + 3]); }
    __syncthreads();
    { float hv[4][16];
#pragma unroll
      for (int t = 0; t < 4; ++t)
#pragma unroll
        for (int j = 0; j < 4; ++j) { const float4 v = *(const float4*)(hs + t * 1024 + lane * 4 + 256 * j); hv[t][4 * j] = v.x; hv[t][4 * j + 1] = v.y; hv[t][4 * j + 2] = v.z; hv[t][4 * j + 3] = v.w; }
      float pe[64];
#pragma unroll
      for (int e = 0; e < 16; ++e) {
        float4 w[4];
#pragma unroll
        for (int j = 0; j < 4; ++j) w[j] = *(const float4*)(rwt + (size_t)(16 * wave + e) * 1024 + lane * 4 + 256 * j);
#pragma unroll
        for (int t = 0; t < 4; ++t) { float sacc = 0.f;
#pragma unroll
          for (int j = 0; j < 4; ++j) sacc += hv[t][4 * j] * w[j].x + hv[t][4 * j + 1] * w[j].y + hv[t][4 * j + 2] * w[j].z + hv[t][4 * j + 3] * w[j].w;
          pe[e * 4 + t] = sacc; } }
#pragma unroll
      for (int half = 32; half >= 1; half >>= 1) { const bool up = (lane & half) != 0;
#pragma unroll
        for (int e = 0; e < half; ++e) { const float send = up ? pe[e] : pe[e + half]; const float recv = __shfl_xor(send, half); pe[e] = (up ? pe[e + half] : pe[e]) + recv; } }
      lg[(lane & 3) * 64 + 16 * wave + (lane >> 2)] = pe[0]; }
    __syncthreads();
    if (!routed) continue;
    const float logit = lg[wave * 64 + lane];
    const float score = sigmoidf_(logit), sel = score + rbias;
    float m1 = sel; int a1 = lane;
#pragma unroll
    for (int m = 1; m <= 4; m <<= 1) { float ov = __shfl_xor(m1, m); int oa = __shfl_xor(a1, m); if (ov > m1 || (ov == m1 && oa < a1)) { m1 = ov; a1 = oa; } }
    float m2 = (lane == a1) ? -3.0e38f : sel;
#pragma unroll
    for (int m = 1; m <= 4; m <<= 1) m2 = fmaxf(m2, __shfl_xor(m2, m));
    const float gs = m1 + m2; const int grp = lane >> 3;
    int grank = 0;
#pragma unroll
    for (int g2 = 0; g2 < 8; ++g2) { float og = __shfl(gs, g2 * 8); grank += (og > gs || (og == gs && g2 < grp)) ? 1 : 0; }
    const bool gsel = grank < 4;
    const float msel = gsel ? sel : -3.0e38f;
    int rank = 0;
    for (int e = 0; e < 64; ++e) { float ov = __shfl(msel, e); rank += (ov > msel || (ov == msel && e < lane)) ? 1 : 0; }
    const bool chosen = gsel && rank < 8;
    const float wsum = wave_sum(chosen ? score : 0.f);
    if (chosen) { int pos = atomicAdd(&cnt[lane], 1); ltok[(size_t)lane * NT_ + pos] = tok * 8 + rank; lwt[(size_t)lane * NT_ + pos] = score / wsum * 2.5f; }
  }
}

struct MoeMap { int nblk_total; int e; int rb; int cnt; int hoff; };
DEVFN int moe_ntok(int l) { return l == DEPTH_ - 1 ? B_ * SEQ_ : NT_; }
DEVFN int moe_shared_tok(int l, int i) { return l == DEPTH_ - 1 ? (i / SEQ_) * T_ + CTX_ + (i % SEQ_) : i; }
DEVFN void moe_prefix(const Params& p, int l, int* pre) {
  const int* cnt = (const int*)(p.ws + Ws::CNT) + l * 64;
  __syncthreads();
  if (TIDX == 0) { int s = 0; for (int e = 0; e < 65; ++e) { pre[e] = s; int c = e < 64 ? cnt[e] : moe_ntok(l); pre[66 + e] = c; s += (c + 127) / 128; } pre[65] = s; }
  __syncthreads();
}
DEVFN void phase8(const Params& p, int l, unsigned char* smem) {
  int* pre = (int*)(smem + SM_PRE);
  moe_prefix(p, l, pre);
  const bf16_t* H = (const bf16_t*)(p.ws + Ws::U);
  const bf16_t* W13 = (const bf16_t*)(p.ws + Ws::W13);
  bf16_t* HID = (bf16_t*)(p.ws + Ws::HID);
  const int* ltok = (const int*)(p.ws + Ws::LTOK); const float* lwt = (const float*)(p.ws + Ws::LWT);
  const int total = pre[65];
  for (int u = BIDX; u < total * 4; u += gridDim.x) {
    const int gb = u >> 2, nt = u & 3;
    int e = 0; while (pre[e + 1] <= gb) ++e;
    const int rb = gb - pre[e], cnt = pre[66 + e];
    gemm_tile(smem, 1024,
      [&](int r) { int pos = rb * 128 + r; if (pos >= cnt) return (const bf16_t*)(p.ws + Ws::ZROW); int tok = e < 64 ? (ltok[(size_t)e * NT_ + pos] >> 3) : moe_shared_tok(l, pos); return H + (size_t)tok * 1024; },
      [&](int r) { return W13 + ((size_t)e * 512 + nt * 128 + r) * 1024; },
      [&](f32x4 (&acc)[4][4], int wr, int wc, int g, int l15) {
        tile_store_bf16<8>(smem, wr, g, l15,
          [&](bf16_t* T, int ldc) {
#pragma unroll
            for (int mi = 0; mi < 4; ++mi)
#pragma unroll
              for (int i = 0; i < 4; ++i) { const int r = wr * 64 + mi * 16 + 4 * g + i, pos = rb * 128 + r;
                const float gw = pos < cnt ? (e < 64 ? lwt[(size_t)e * NT_ + pos] : 1.f) : 0.f;
#pragma unroll
                for (int j = 0; j < 2; ++j) T[r * ldc + wc * 32 + j * 16 + l15] = f2bf(siluf_(acc[mi][2 * j][i]) * acc[mi][2 * j + 1][i] * gw); } },
          [&](int row, int c0) { const int pos = rb * 128 + row; return pos < cnt ? HID + ((size_t)gb * 128 + row) * 256 + nt * 64 + c0 : (bf16_t*)nullptr; });
      });
  }
}
DEVFN void phase9(const Params& p, int l, unsigned char* smem) {
  int* pre = (int*)(smem + SM_PRE);
  moe_prefix(p, l, pre);
  const bf16_t* HID = (const bf16_t*)(p.ws + Ws::HID);
  const bf16_t* W2T = (const bf16_t*)(p.ws + Ws::W2T);
  bf16_t* YB = (bf16_t*)(p.ws + Ws::YBUF);
  const int* ltok = (const int*)(p.ws + Ws::LTOK);
  const int total = pre[65];
  for (int u = BIDX; u < total * 8; u += gridDim.x) {
    const int gb = u >> 3, nt = u & 7;
    int e = 0; while (pre[e + 1] <= gb) ++e;
    const int rb = gb - pre[e], cnt = pre[66 + e];
    gemm_tile(smem, 256,
      [&](int r) { int pos = rb * 128 + r; return pos < cnt ? HID + ((size_t)gb * 128 + r) * 256 : (const bf16_t*)(p.ws + Ws::ZROW); },
      [&](int r) { return W2T + ((size_t)e * 1024 + nt * 128 + r) * 256; },
      [&](f32x4 (&acc)[4][4], int wr, int wc, int g, int l15) {
        tile_store_bf16<16>(smem, wr, g, l15,
          [&](bf16_t* T, int ldc) {
#pragma unroll
            for (int mi = 0; mi < 4; ++mi)
#pragma unroll
              for (int ni = 0; ni < 4; ++ni)
#pragma unroll
                for (int i = 0; i < 4; ++i) T[(wr * 64 + mi * 16 + 4 * g + i) * ldc + wc * 64 + ni * 16 + l15] = f2bf(acc[mi][ni][i]); },
          [&](int row, int c0) { const int pos = rb * 128 + row; if (pos >= cnt) return (bf16_t*)nullptr;
            const int ts = e < 64 ? ltok[(size_t)e * NT_ + pos] : moe_shared_tok(l, pos) * 8; const int tok = ts >> 3, slot = e < 64 ? (ts & 7) : 8;
            return YB + ((size_t)tok * NSLOT + slot) * 1024 + nt * 128 + c0; });
      });
  }
}

#define SMEM_BYTES (PH_SMEM + 2048)
#define N_PHASES (3 + 13 * DEPTH_)
__global__ void __launch_bounds__(256, 2) mega(Params p, int ph_lo, int ph_hi) {
#ifdef HIPEMU
  unsigned char* smem = hipemu::cur_smem();
#else
  unsigned char* smem = smem_dyn;
  volatile LAS unsigned* st = (volatile LAS unsigned*)(smem_dyn + SM_BAR);
  if (threadIdx.x == 0) {
    st[0] = 0u; st[1] = 0u;
    unsigned long long* tab = (unsigned long long*)(smem_dyn + SM_TAB);
#pragma unroll
    for (int i = 0; i < 40; ++i) tab[i] = (unsigned long long)p.in[i];
  }
  __syncthreads();
  XcdBarrier bar = xcd_barrier_post((unsigned*)(p.ws + Ws::BAR), st);
#define GRID_SYNC() xcd_barrier(bar)
#endif
  int ph = 0;
#ifdef ONLY_KIND
#define KIND_ON(k) ((k) == ONLY_KIND)
#else
#define KIND_ON(k) 1
#endif
#ifndef REPEAT_MASK
#define REPEAT_MASK 0u
#endif
#define RUN_PHASE(kind, code) { if (KIND_ON(kind) && ph >= ph_lo && ph < ph_hi) { \
    int nrep_ = ((REPEAT_MASK >> (kind)) & 1u) ? 2 : 1; LAUNDER(nrep_); \
    _Pragma("unroll 1") for (int rep_ = 0; rep_ < nrep_; ++rep_) { LAUNDER(p.ws); LAUNDER(p.out); code; if (rep_ + 1 < nrep_ || ph + 1 < ph_hi) { GRID_SYNC(); } } } ++ph; }
  RUN_PHASE(0, phase0(p, smem));
  RUN_PHASE(11, phase0b(p));
  for (int l = 0; l < DEPTH_; ++l) {
    RUN_PHASE(1, phase1(p, l));
    RUN_PHASE(2, phase2(p, l, smem));
    RUN_PHASE(3, phase3(p, l, smem));
    RUN_PHASE(14, phase3b(p, l, smem));
    RUN_PHASE(4, phase4a(p, l, smem));
    RUN_PHASE(12, phase4b(p, l, smem));
    RUN_PHASE(16, phase4b2(p));
    RUN_PHASE(13, phase4c(p, l, smem));
    RUN_PHASE(5, phase5(p, l, smem));
    RUN_PHASE(6, phase6(p, l, smem));
    RUN_PHASE(7, phase7(p, l, smem));
    RUN_PHASE(8, phase8(p, l, smem));
    RUN_PHASE(9, phase9(p, l, smem));
  }
  RUN_PHASE(10, phase_final(p));
}

extern "C" void kernel_launch(void* const* d_in, const int* in_sizes, int n_in, void* d_out, int out_size, void* d_ws, size_t ws_size, hipStream_t stream) {
  Params p{};
  for (int i = 0; i < 40; ++i) p.in[i] = (const float*)d_in[i];
  p.out = (float*)d_out;
  p.ws = (unsigned char*)d_ws;
  if (ws_size < Ws::END) { fprintf(stderr, "workspace too small: %zu < %zu\n", ws_size, (size_t)Ws::END); return; }
  hipMemsetAsync(d_ws, 0, Ws::ZERO_END, stream);
#ifdef HIPEMU
  int grid = 16; if (const char* e = getenv("EMU_GRID")) grid = atoi(e);
  int stop = N_PHASES; if (const char* e = getenv("EMU_STOP")) stop = atoi(e);
  if (getenv("EMU_ONE")) hipemu::launch(grid, 256, SMEM_BYTES, true, [=] { mega(p, 0, stop); });
  else for (int ph = 0; ph < stop; ++ph) hipemu::launch(grid, 256, SMEM_BYTES, false, [=] { mega(p, ph, ph + 1); });
#else
  static int grid = 0;
  if (!grid) {
    int dev = 0, cus = 0, per_cu = 0;
    hipGetDevice(&dev);
    hipDeviceGetAttribute(&cus, hipDeviceAttributeMultiprocessorCount, dev);
    hipOccupancyMaxActiveBlocksPerMultiprocessor(&per_cu, mega, 256, SMEM_BYTES);
    if (per_cu > 2) per_cu = 2;
    if (per_cu < 1) per_cu = 1;
    grid = cus * per_cu;
  }
#if N_LAUNCH_MODE == 1
  mega<<<grid, 256, SMEM_BYTES, stream>>>(p, 0, N_PHASES);
#else
  for (int ph = 0; ph < N_PHASES; ++ph) mega<<<grid, 256, SMEM_BYTES, stream>>>(p, ph, ph + 1);
#endif
#endif
}
```

```cpp
#ifndef HIPEMU
#include <hip/hip_runtime.h>
#endif
#include <stdint.h>
#include <stdio.h>

#ifndef B_
#define B_ 4
#endif
#ifndef SEQ_
#define SEQ_ 4096
#endif
#ifndef CTX_
#define CTX_ 256
#endif
#ifndef DEPTH_
#define DEPTH_ 4
#endif
#ifndef N_LAUNCH_MODE
#define N_LAUNCH_MODE 1
#endif
#define T_ (SEQ_ + CTX_)
#define NT_ (B_ * T_)
#define D_ 1024
#define NIN_ 3504
#define NMOD_ 6144
#define NR_ (B_ + 1)
#define OZ 0
#define OXBC 512
#define ODT 1536
#define ORW 1552
#define OGQ 2704
#define OGK 2832
#define OGV 2960
#define OGD 3216
#define OOG 3248
#define ALPHA_ 1.681792830507429f
#define NEXP 64
#define NSLOT 9
#define NC128 (T_ / 128)
#define NC64 (T_ / 64)
#define NC16 (T_ / 16)

#define DEVFN __device__ __forceinline__
#define LDT 72
#define GEMM_SMEM (2 * 128 * LDT * 2)
typedef unsigned short bf16_t;
#ifdef HIPEMU
#define AS1
#else
#define AS1 __attribute__((address_space(1)))
#endif
typedef unsigned u32x4 __attribute__((ext_vector_type(4)));
typedef unsigned u32x2 __attribute__((ext_vector_type(2)));

#ifdef HIPEMU
typedef emu_bf16x8 bf16x8;
typedef emu_f32x4 f32x4;
#define MFMA16(a, b, c) emu_mfma_16x16x32_bf16(a, b, c)
#define MFMA16K16(a, b, c) emu_mfma_16x16x16_bf16(a, b, c)
#define GRID_SYNC() hipemu::grid_sync()
#else
typedef short bf16x8 __attribute__((ext_vector_type(8)));
typedef float f32x4 __attribute__((ext_vector_type(4)));
#define MFMA16(a, b, c) __builtin_amdgcn_mfma_f32_16x16x32_bf16(a, b, c, 0, 0, 0)
#define MFMA16K16(a, b, c) __builtin_amdgcn_mfma_f32_16x16x16bf16_1k(a, b, c, 0, 0, 0)
#endif

DEVFN float bf2f(bf16_t h) { return __builtin_bit_cast(float, (unsigned)h << 16); }
DEVFN bf16_t f2bf(float f) { unsigned u = __builtin_bit_cast(unsigned, f); u += 0x7FFFu + ((u >> 16) & 1u); return (bf16_t)(u >> 16); }
template <class T> DEVFN AS1 T* gptr(T* q) { return (AS1 T*)q; }
DEVFN bf16x8 ld8g(const bf16_t* q) { return *(const AS1 bf16x8*)gptr(q); }
DEVFN float sigmoidf_(float x) { return 1.f / (1.f + expf(-x)); }
DEVFN float siluf_(float x) { return x / (1.f + expf(-x)); }
DEVFN float softplusf_(float x) { return x > 20.f ? x : log1pf(expf(x)); }
DEVFN float logsigmoidf_(float x) { return fminf(x, 0.f) - log1pf(expf(-fabsf(x))); }
DEVFN float wave_sum(float v) { for (int m = 32; m >= 1; m >>= 1) v += __shfl_xor(v, m); return v; }

constexpr size_t al(size_t x) { return (x + 255) & ~(size_t)255; }
struct Ws {
  static constexpr size_t BAR = 0;
  static constexpr size_t CNT = 16384;
  static constexpr size_t MOD = CNT + 4096;
  static constexpr size_t ZROW = al(MOD + (size_t)DEPTH_ * NR_ * NMOD_ * 4);
  static constexpr size_t ZERO_END = al(ZROW + 2048);
  static constexpr size_t MODP = ZERO_END;
  static constexpr size_t RWT = al(MODP + (size_t)16 * DEPTH_ * NR_ * NMOD_ * 4);
  static constexpr size_t LORA = al(RWT + (size_t)DEPTH_ * 64 * 1024 * 4);
  static constexpr size_t X = al(LORA + (size_t)DEPTH_ * 98304 * 2);
  static constexpr size_t U = al(X + (size_t)NT_ * 1024 * 4);
  static constexpr size_t YMIX = al(U + (size_t)NT_ * 1024 * 2);
  static constexpr size_t ZX = al(YMIX + (size_t)NT_ * 1024 * 2);
  static constexpr size_t MIX = ZX;
  static constexpr size_t LTOK = al(ZX + (size_t)NT_ * NIN_ * 2);
  static constexpr size_t LWT = al(LTOK + (size_t)64 * NT_ * 4);
  static constexpr size_t WIN = al(LWT + (size_t)64 * NT_ * 4);
  static constexpr size_t WOUT = al(WIN + (size_t)DEPTH_ * NIN_ * 1024 * 2);
  static constexpr size_t W13 = al(WOUT + (size_t)DEPTH_ * 1024 * 1024 * 2);
  static constexpr size_t W2T = al(W13 + (size_t)65 * 512 * 1024 * 2);
  static constexpr size_t UNI = al(W2T + (size_t)65 * 1024 * 256 * 2);
  static constexpr size_t XBC = UNI;
  static constexpr size_t XBCT = al(XBC + (size_t)NT_ * 1024 * 2);
  static constexpr size_t DTB = al(XBCT + (size_t)NT_ * 768 * 2);
  static constexpr size_t SST = al(DTB + (size_t)NT_ * 16 * 4);
  static constexpr size_t SCD = al(SST + (size_t)2 * NT_ / 128 * 8 * 8192 * 4);
  static constexpr size_t HIN = al(SCD + (size_t)2 * NT_ / 128 * 8 * 4);
  static constexpr size_t YS = SST;
  static constexpr size_t LA = al(HIN + (size_t)2 * NT_ / 128 * 8 * 8192 * 2);
  static constexpr size_t VT = al(LA + (size_t)2 * NT_ * 128 * 4);
  static constexpr size_t QT = al(VT + (size_t)NT_ * 256 * 2);
  static constexpr size_t OI = al(QT + (size_t)2 * NT_ * 128 * 2);
  static constexpr size_t GST = al(OI + (size_t)NT_ * 256 * 4);
  static constexpr size_t GCD = al(GST + (size_t)2 * NT_ / 64 * 4 * 2048 * 4);
  static constexpr size_t GSIN = al(GCD + (size_t)2 * NT_ / 64 * 4 * 32 * 4);
  static constexpr size_t RR = al(GSIN + (size_t)2 * NT_ / 64 * 4 * 2048 * 2);
  static constexpr size_t VV = RR + (size_t)NT_ * 256 * 2;
  static constexpr size_t KK = VV + (size_t)NT_ * 256 * 2;
  static constexpr size_t KD = KK + (size_t)NT_ * 256 * 2;
  static constexpr size_t BD = KD + (size_t)2 * NT_ * 256 * 2;
  static constexpr size_t LW = BD + (size_t)2 * NT_ * 256 * 2;
  static constexpr size_t GATE = LW + (size_t)2 * NT_ * 256 * 4;
  static constexpr size_t YR = GATE + (size_t)NT_ * 256 * 4;
  static constexpr size_t RML = al(YR + (size_t)2 * NT_ * 256 * 4);
  static constexpr size_t RNS = RML + (size_t)(NT_ / 16) * 8 * 4096 * 2;
  static constexpr size_t RWC = RNS + (size_t)(NT_ / 16) * 8 * 4096 * 2;
  static constexpr size_t RG = RWC + (size_t)(NT_ / 16) * 8 * 64 * 4;
  static constexpr size_t RY0 = RG + (size_t)(NT_ / 16) * 8 * 1024 * 2;
  static constexpr size_t LI = RY0 + (size_t)(NT_ / 16) * 8 * 1024 * 4;
  static constexpr size_t KRW = LI + (size_t)NT_ * 384 * 2;
  static constexpr size_t MIXER_END = KRW + (size_t)NT_ * 256 * 2;
  static constexpr size_t HID = UNI;
  static constexpr size_t YBUF = al(HID + ((size_t)NT_ * 9 + 65 * 128) * 256 * 2);
  static constexpr size_t MOE_END = YBUF + (size_t)NT_ * 9 * 1024 * 2;
  static constexpr size_t END = al(MIXER_END > MOE_END ? MIXER_END : MOE_END);
};

struct Params {
  const float* in[40];
  float* out;
  unsigned char* ws;
};
enum { I_X = 0, I_C, I_CTX, I_CCTX, I_ADAW, I_ADAB, I_WIN, I_CONVW, I_CONVB, I_DTBIAS, I_ALOG, I_SSDD, I_SSDNW, I_MU, I_W0, I_W2, I_A0, I_A2,
       I_G2, I_KKW, I_KAW, I_RK, I_LNXW, I_LNXB, I_GU, I_GB, I_GNW, I_WOUT, I_LN1W, I_LN1B, I_LN2W, I_LN2B, I_RW, I_RB, I_EW1, I_EW3, I_EW2,
       I_SW1, I_SW3, I_SW2 };

#define PH_SMEM 47104
#define SM_PRE (PH_SMEM)
#define SM_TAB (PH_SMEM + 1024)
#define SM_BAR (PH_SMEM + 2032)
#ifdef HIPEMU
#define INP(i) (p.in[i])
#define LAUNDER(x)
#define TIDX ((int)threadIdx.x)
#define BIDX ((int)blockIdx.x)
#define LAUNDER_V(x)
#else
extern __shared__ __align__(16) unsigned char smem_dyn[];
DEVFN const float* inp_lds(int i) {
  const volatile unsigned* t = (const volatile unsigned*)(smem_dyn + SM_TAB) + 2 * i;
  unsigned lo = __builtin_amdgcn_readfirstlane(t[0]), hi = __builtin_amdgcn_readfirstlane(t[1]);
  return (const float*)(((unsigned long long)hi << 32) | lo);
}
#define INP(i) inp_lds(i)
#define LAUNDER(x) asm volatile("" : "+s"(x))
DEVFN int tidx_() { int t = threadIdx.x; asm volatile("" : "+v"(t)); return t; }
DEVFN int bidx_() { int b = blockIdx.x; asm volatile("" : "+s"(b)); return b; }
#define TIDX tidx_()
#define LAUNDER_V(x) asm volatile("" : "+v"(x))
#define BIDX bidx_()
#endif
#ifndef HIPEMU
#define XB_TMO      128
#define XB_XCNT(j)  (256  + 64 * (j))
#define XB_XSUB(j)  (1280 + 64 * (j))
#define XB_XGEN(j)  (2304 + 64 * (j))
#define XB_TOP      3328
#define XB_TOPGEN   3392
#define XCD_BAR_WORDS 3456
#define XB_SPIN_CAP (1u << 22)
#define LAS __attribute__((address_space(3)))
__device__ __forceinline__ unsigned xb_ld(unsigned* p)              { return __hip_atomic_load(p, __ATOMIC_RELAXED, __HIP_MEMORY_SCOPE_AGENT); }
__device__ __forceinline__ unsigned xb_add(unsigned* p, unsigned v) { return __hip_atomic_fetch_add(p, v, __ATOMIC_RELAXED, __HIP_MEMORY_SCOPE_AGENT); }
__device__ __forceinline__ unsigned xb_xcc_id() { return (unsigned)__builtin_amdgcn_s_getreg((3 << 11) | 20) & 0xFu; }
#define XB_SPIN(cond, bar) do { unsigned _sp = 0; while (cond) { __builtin_amdgcn_s_sleep(1); \
    if ((++_sp & 255u) == 0u) { if (xb_ld(&(bar)[XB_TMO])) break; if (_sp > XB_SPIN_CAP) { atomicAdd(&(bar)[XB_TMO], 1u); break; } } } } while (0)
struct XcdBarrier { unsigned* bar; unsigned x; volatile LAS unsigned* st; };
__device__ __forceinline__ XcdBarrier xcd_barrier_post(unsigned* bar, volatile LAS unsigned* st) {
    XcdBarrier b; b.bar = bar; b.x = xb_xcc_id(); b.st = st;
    if (threadIdx.x == 0) (void)xb_add(&bar[XB_XCNT(b.x)], 1u);
    return b;
}
__device__ __forceinline__ void xcd_barrier_complete(unsigned* bar, unsigned x, unsigned& nloc, unsigned& nx) {
    const unsigned G = gridDim.x * gridDim.y * gridDim.z;
    unsigned sum, cnt, mine, sp = 0u;
    for (;;) {
        sum = 0u; cnt = 0u; mine = 0u;
#pragma unroll
        for (unsigned j = 0; j < 16; ++j) { const unsigned c = xb_ld(&bar[XB_XCNT(j)]); sum += c; cnt += (c > 0u) ? 1u : 0u; mine = (j == x) ? c : mine; }
        if (sum == G) break;
        __builtin_amdgcn_s_sleep(1);
        if ((++sp & 255u) == 0u) { if (xb_ld(&bar[XB_TMO])) break; if (sp > XB_SPIN_CAP) { atomicAdd(&bar[XB_TMO], 1u); break; } }
    }
    nloc = mine > 0u ? mine : 1u; nx = cnt > 0u ? cnt : 1u;
}
__device__ __forceinline__ void xcd_barrier(const XcdBarrier& b) {
    asm volatile("s_waitcnt vmcnt(0)" ::: "memory");
    __syncthreads();
    if (threadIdx.x == 0) {
        unsigned* bar = b.bar;
        __builtin_amdgcn_s_waitcnt(0);
        unsigned nloc = b.st[0], nx = b.st[1];
        if (nloc == 0u) { xcd_barrier_complete(bar, b.x, nloc, nx); b.st[0] = nloc; b.st[1] = nx; }
        const unsigned old = xb_add(&bar[XB_XSUB(b.x)], 1u);
        const unsigned gen = old / nloc;
        if (old + 1u == (gen + 1u) * nloc) {
            __builtin_amdgcn_fence(__ATOMIC_RELEASE, "agent");
            asm volatile("s_waitcnt vmcnt(0)" ::: "memory");
            const unsigned og = xb_add(&bar[XB_TOP], 1u);
            const unsigned tg = og / nx;
            if (og + 1u == (tg + 1u) * nx) xb_add(&bar[XB_TOPGEN], 1u);
            else XB_SPIN(xb_ld(&bar[XB_TOPGEN]) == tg, bar);
            __builtin_amdgcn_fence(__ATOMIC_ACQUIRE, "agent");
            xb_add(&bar[XB_XGEN(b.x)], 1u);
            asm volatile("s_waitcnt vmcnt(0)" ::: "memory");
        } else {
            XB_SPIN(xb_ld(&bar[XB_XGEN(b.x)]) == gen, bar);
            __builtin_amdgcn_fence(__ATOMIC_ACQUIRE, "agent");
            asm volatile("s_waitcnt vmcnt(0)" ::: "memory");
        }
    }
    __syncthreads();
}
#endif

DEVFN int tokmap(int dir, int p) { return dir == 0 ? p : (p < CTX_ ? CTX_ - 1 - p : 2 * CTX_ + SEQ_ - 1 - p); }
DEVFN const float* tok_input_row(const Params& p, int tok) {
  int b = tok / T_, t = tok % T_;
  return t < CTX_ ? INP(I_CTX) + ((size_t)b * CTX_ + t) * D_ : INP(I_X) + ((size_t)b * SEQ_ + (t - CTX_)) * D_;
}
DEVFN int tok_modrow(int tok) { return (tok % T_) < CTX_ ? B_ : tok / T_; }

template <class ARow, class BRow, class Epi>
DEVFN void gemm_tile(unsigned char* smem, int K, ARow arow, BRow brow, Epi epi) {
  bf16_t* As = (bf16_t*)smem;
  bf16_t* Bs = As + 128 * LDT;
  const int tid = TIDX, lane = tid & 63, wave = tid >> 6, wr = wave >> 1, wc = wave & 1;
  const int g = lane >> 4, l15 = lane & 15;
  const int lr = tid >> 3, lc = (tid & 7) * 8;
  const AS1 bf16_t* ap[4];
  const AS1 bf16_t* bp[4];
#pragma unroll
  for (int i = 0; i < 4; ++i) { ap[i] = gptr(arow(lr + 32 * i)); bp[i] = gptr(brow(lr + 32 * i)); }
  f32x4 acc[4][4];
#pragma unroll
  for (int mi = 0; mi < 4; ++mi)
#pragma unroll
    for (int ni = 0; ni < 4; ++ni) acc[mi][ni] = f32x4{0.f, 0.f, 0.f, 0.f};
  u32x4 ra0[4], rb0[4], ra1[4], rb1[4];
#pragma unroll
  for (int i = 0; i < 4; ++i) { ra0[i] = *(const AS1 u32x4*)(ap[i] + lc); rb0[i] = *(const AS1 u32x4*)(bp[i] + lc); }
  if (K > 64) {
#pragma unroll
    for (int i = 0; i < 4; ++i) { ra1[i] = *(const AS1 u32x4*)(ap[i] + 64 + lc); rb1[i] = *(const AS1 u32x4*)(bp[i] + 64 + lc); } }
  auto compute = [&]() {
#pragma unroll
    for (int kk = 0; kk < 2; ++kk) {
      bf16x8 af[4], bfr[4];
#pragma unroll
      for (int mi = 0; mi < 4; ++mi) af[mi] = *(const bf16x8*)(As + (wr * 64 + mi * 16 + l15) * LDT + kk * 32 + g * 8);
#pragma unroll
      for (int ni = 0; ni < 4; ++ni) bfr[ni] = *(const bf16x8*)(Bs + (wc * 64 + ni * 16 + l15) * LDT + kk * 32 + g * 8);
#pragma unroll
      for (int mi = 0; mi < 4; ++mi)
#pragma unroll
        for (int ni = 0; ni < 4; ++ni) acc[mi][ni] = MFMA16(af[mi], bfr[ni], acc[mi][ni]);
    } };
  for (int k0 = 0; k0 < K; k0 += 128) {
    __syncthreads();
#pragma unroll
    for (int i = 0; i < 4; ++i) { *(u32x4*)(As + (lr + 32 * i) * LDT + lc) = ra0[i]; *(u32x4*)(Bs + (lr + 32 * i) * LDT + lc) = rb0[i]; }
    __syncthreads();
    if (k0 + 128 < K) {
#pragma unroll
      for (int i = 0; i < 4; ++i) { ra0[i] = *(const AS1 u32x4*)(ap[i] + k0 + 128 + lc); rb0[i] = *(const AS1 u32x4*)(bp[i] + k0 + 128 + lc); } }
    compute();
    if (k0 + 64 < K) {
      __syncthreads();
#pragma unroll
      for (int i = 0; i < 4; ++i) { *(u32x4*)(As + (lr + 32 * i) * LDT + lc) = ra1[i]; *(u32x4*)(Bs + (lr + 32 * i) * LDT + lc) = rb1[i]; }
      __syncthreads();
      if (k0 + 192 < K) {
#pragma unroll
        for (int i = 0; i < 4; ++i) { ra1[i] = *(const AS1 u32x4*)(ap[i] + k0 + 192 + lc); rb1[i] = *(const AS1 u32x4*)(bp[i] + k0 + 192 + lc); } }
      compute();
    }
  }
  epi(acc, wr, wc, g, l15);
}

template <int NCH, class Val, class RowP>
DEVFN void tile_store_bf16(unsigned char* smem, int wr, int g, int l15, Val val, RowP rowp) {
  constexpr int LDC = NCH * 8 + 8;
  bf16_t* T = (bf16_t*)smem;
  const int tid = TIDX;
  __syncthreads();
  val(T, LDC);
  __syncthreads();
#pragma unroll
  for (int pass = 0; pass < NCH / 2; ++pass) { const int id = tid + 256 * pass, row = id / NCH, c = id % NCH;
    bf16_t* dst = rowp(row, c * 8);
    if (dst) *(AS1 u32x4*)gptr(dst) = *(const u32x4*)(T + row * LDC + c * 8); }
  (void)wr; (void)g; (void)l15;
}
DEVFN void cvt_tile(unsigned char* smem, const float* src, int K, int N, int k0, int n0, bf16_t* dst, int ldd, int mode) {
  float* s = (float*)smem;
  const int tid = TIDX;
  const AS1 float* gsrc = gptr(src);
  __syncthreads();
  { const int kk = tid >> 4, n4 = (tid & 15) * 4;
#pragma unroll
    for (int pass = 0; pass < 4; ++pass) { const int k = kk + 16 * pass;
      f32x4 v = f32x4{0.f, 0.f, 0.f, 0.f};
      if (n0 + n4 < N) v = *(const AS1 f32x4*)(gsrc + (size_t)(k0 + k) * N + n0 + n4);
      s[k * 65 + n4] = v[0]; s[k * 65 + n4 + 1] = v[1]; s[k * 65 + n4 + 2] = v[2]; s[k * 65 + n4 + 3] = v[3]; } }
  __syncthreads();
  { const int nn = tid >> 2, k16 = (tid & 3) * 16, n = n0 + nn;
    if (n < N) { const int row = mode == 0 ? n : ((n >> 4) * 32 + (n & 15) + (mode == 2 ? 16 : 0));
      u32x4 o0, o1;
#pragma unroll
      for (int j = 0; j < 4; ++j) { o0[j] = (unsigned)f2bf(s[(k16 + 2 * j) * 65 + nn]) | ((unsigned)f2bf(s[(k16 + 2 * j + 1) * 65 + nn]) << 16);
        o1[j] = (unsigned)f2bf(s[(k16 + 8 + 2 * j) * 65 + nn]) | ((unsigned)f2bf(s[(k16 + 9 + 2 * j) * 65 + nn]) << 16); }
      AS1 bf16_t* d = gptr(dst) + (size_t)row * ldd + k0 + k16;
      *(AS1 u32x4*)d = o0; *(AS1 u32x4*)(d + 8) = o1; } }
  (void)K;
}
DEVFN void convert_moe_weights(const Params& p, int l, unsigned char* smem, int bid, int nb) {
  bf16_t* w13 = (bf16_t*)(p.ws + Ws::W13);
  bf16_t* w2t = (bf16_t*)(p.ws + Ws::W2T);
  const int per_e = 192;
  for (int u = bid; u < 65 * per_e; u += nb) {
    int e = u / per_e, r = u % per_e, which = r / 64, t = r % 64;
    if (which < 2) {
      const float* src = e < 64 ? (which == 0 ? INP(I_EW1) : INP(I_EW3)) + ((size_t)l * 64 + e) * 1024 * 256 : (which == 0 ? INP(I_SW1) : INP(I_SW3)) + (size_t)l * 1024 * 256;
      cvt_tile(smem, src, 1024, 256, (t >> 2) * 64, (t & 3) * 64, w13 + (size_t)e * 512 * 1024, 1024, which == 0 ? 1 : 2);
    } else {
      const float* src = e < 64 ? INP(I_EW2) + ((size_t)l * 64 + e) * 256 * 1024 : INP(I_SW2) + (size_t)l * 256 * 1024;
      cvt_tile(smem, src, 256, 1024, (t >> 4) * 64, (t & 15) * 64, w2t + (size_t)e * 1024 * 256, 256, 0);
    }
  }
}
DEVFN void phase0(const Params& p, unsigned char* smem) {
  const int tid = TIDX;
  float* modp = (float*)(p.ws + Ws::MODP);
  for (int u = BIDX; u < DEPTH_ * 24 * 16; u += gridDim.x) {
    int l = u / (24 * 16), jb = (u / 16) % 24, ks = u % 16;
    float* sc = (float*)smem;
    __syncthreads();
    for (int e = tid; e < NR_ * 64; e += 256) { int r = e / 64, i = ks * 64 + (e % 64); float cv = r < B_ ? INP(I_C)[(size_t)r * D_ + i] : INP(I_CCTX)[i]; sc[e] = siluf_(cv); }
    __syncthreads();
    int j = jb * 256 + tid;
    float acc[NR_];
#pragma unroll
    for (int r = 0; r < NR_; ++r) acc[r] = 0.f;
    const float* w = INP(I_ADAW) + ((size_t)l * D_ + ks * 64) * NMOD_ + j;
#pragma unroll 4
    for (int i = 0; i < 64; ++i) { float wv = w[(size_t)i * NMOD_];
#pragma unroll
      for (int r = 0; r < NR_; ++r) acc[r] += sc[r * 64 + i] * wv; }
#pragma unroll
    for (int r = 0; r < NR_; ++r) modp[(((size_t)ks * DEPTH_ + l) * NR_ + r) * NMOD_ + j] = acc[r];
  }
  bf16_t* win = (bf16_t*)(p.ws + Ws::WIN);
  bf16_t* wout = (bf16_t*)(p.ws + Ws::WOUT);
  for (int u = BIDX; u < DEPTH_ * 16 * 55; u += gridDim.x) {
    int l = u / (16 * 55), r = u % (16 * 55);
    cvt_tile(smem, INP(I_WIN) + (size_t)l * 1024 * NIN_, 1024, NIN_, (r / 55) * 64, (r % 55) * 64, win + (size_t)l * NIN_ * 1024, 1024, 0);
  }
  for (int u = BIDX; u < DEPTH_ * 256; u += gridDim.x) {
    int l = u / 256, r = u % 256;
    cvt_tile(smem, INP(I_WOUT) + (size_t)l * 1024 * 1024, 1024, 1024, (r / 16) * 64, (r % 16) * 64, wout + (size_t)l * 1024 * 1024, 1024, 0);
  }
  { bf16_t* lo = (bf16_t*)(p.ws + Ws::LORA);
    for (int u = BIDX * 256 + tid; u < DEPTH_ * 98304; u += gridDim.x * 256) {
      const int l = u / 98304, r = u % 98304; float v;
      if (r < 32768) { const int d = r >> 14, n = (r >> 6) & 255, k = r & 63; v = INP(I_W2)[(((size_t)l * 2 + d) * 64 + k) * 256 + n]; }
      else if (r < 65536) { const int r2 = r - 32768, d = r2 >> 14, n = (r2 >> 6) & 255, k = r2 & 63; v = INP(I_A2)[(((size_t)l * 2 + d) * 64 + k) * 256 + n]; }
      else { const int r2 = r - 65536, n = r2 >> 7, k = r2 & 127; v = INP(I_G2)[((size_t)l * 128 + k) * 256 + n]; }
      lo[u] = f2bf(v); } }
  float* rwt = (float*)(p.ws + Ws::RWT);
  for (int u = BIDX * 256 + tid; u < DEPTH_ * 64 * 1024; u += gridDim.x * 256) {
    int l = u / (64 * 1024), e = (u / 1024) % 64, i = u % 1024;
    rwt[u] = INP(I_RW)[((size_t)l * 1024 + i) * 64 + e];
  }
}

DEVFN void phase0b(const Params& p) {
  float* mod = (float*)(p.ws + Ws::MOD); const float* modp = (const float*)(p.ws + Ws::MODP);
  for (int u = BIDX * 256 + TIDX; u < DEPTH_ * NR_ * NMOD_; u += gridDim.x * 256) {
    int l = u / (NR_ * NMOD_), j = u % NMOD_;
    float s = INP(I_ADAB)[(size_t)l * NMOD_ + j];
    for (int ks = 0; ks < 16; ++ks) s += modp[(size_t)ks * DEPTH_ * NR_ * NMOD_ + u];
    mod[u] = s;
  }
}

DEVFN void row_stats(const float (&v)[16], float& mean, float& rstd) {
  float s = 0.f;
#pragma unroll
  for (int i = 0; i < 16; ++i) s += v[i];
  mean = wave_sum(s) * (1.f / 1024.f);
  float q = 0.f;
#pragma unroll
  for (int i = 0; i < 16; ++i) { float d = v[i] - mean; q += d * d; }
  rstd = rsqrtf(wave_sum(q) * (1.f / 1024.f) + 1e-5f);
}
DEVFN void load_row16(const float* row, int lane, float (&v)[16]) {
  const AS1 float* r = gptr(row);
#pragma unroll
  for (int j = 0; j < 4; ++j) { const f32x4 t = *(const AS1 f32x4*)(r + lane * 4 + 256 * j); v[4 * j] = t[0]; v[4 * j + 1] = t[1]; v[4 * j + 2] = t[2]; v[4 * j + 3] = t[3]; }
}
DEVFN void moe_residual_row(const Params& p, int lp, int tok, int lane, float (&xv)[16]) {
  const float* mod = (const float*)(p.ws + Ws::MOD) + ((size_t)lp * NR_ + tok_modrow(tok)) * NMOD_;
  const bf16_t* yb = (const bf16_t*)(p.ws + Ws::YBUF) + (size_t)tok * NSLOT * 1024;
  float f[16];
#pragma unroll
  for (int i = 0; i < 16; ++i) f[i] = 0.f;
#pragma unroll
  for (int s = 0; s < NSLOT; ++s) {
#pragma unroll
    for (int j = 0; j < 4; ++j) { const u32x2 t = *(const AS1 u32x2*)gptr(yb + (size_t)s * 1024 + lane * 4 + 256 * j);
      f[4 * j] += bf2f((bf16_t)(t[0] & 0xFFFF)); f[4 * j + 1] += bf2f((bf16_t)(t[0] >> 16)); f[4 * j + 2] += bf2f((bf16_t)(t[1] & 0xFFFF)); f[4 * j + 3] += bf2f((bf16_t)(t[1] >> 16)); }
  }
  float g2[16], w[16], b[16];
  load_row16(mod + 5 * 1024, lane, g2);
  load_row16(INP(I_LN2W) + (size_t)lp * 1024, lane, w);
  load_row16(INP(I_LN2B) + (size_t)lp * 1024, lane, b);
#pragma unroll
  for (int i = 0; i < 16; ++i) xv[i] = ALPHA_ * xv[i] + g2[i] * f[i];
  float mean, rstd;
  row_stats(xv, mean, rstd);
#pragma unroll
  for (int i = 0; i < 16; ++i) xv[i] = (xv[i] - mean) * rstd * w[i] + b[i];
}
DEVFN void phase1(const Params& p, int l) {
  const int lane = TIDX & 63, wave = TIDX >> 6;
  float* X = (float*)(p.ws + Ws::X);
  bf16_t* U = (bf16_t*)(p.ws + Ws::U);
  for (int tok = BIDX * 4 + wave; tok < NT_; tok += gridDim.x * 4) {
    float xv[16];
    if (l == 0) load_row16(tok_input_row(p, tok), lane, xv);
    else { load_row16(X + (size_t)tok * 1024, lane, xv); moe_residual_row(p, l - 1, tok, lane, xv); }
#pragma unroll
    for (int j = 0; j < 4; ++j) *(float4*)(X + (size_t)tok * 1024 + lane * 4 + 256 * j) = make_float4(xv[4 * j], xv[4 * j + 1], xv[4 * j + 2], xv[4 * j + 3]);
    const float* mod = (const float*)(p.ws + Ws::MOD) + ((size_t)l * NR_ + tok_modrow(tok)) * NMOD_;
    float sh[16], sc[16], mean, rstd;
    load_row16(mod, lane, sh);
    load_row16(mod + 1024, lane, sc);
    row_stats(xv, mean, rstd);
#pragma unroll
    for (int j = 0; j < 4; ++j) {
      float u0 = (xv[4 * j] - mean) * rstd * (1.f + sc[4 * j]) + sh[4 * j], u1 = (xv[4 * j + 1] - mean) * rstd * (1.f + sc[4 * j + 1]) + sh[4 * j + 1];
      float u2 = (xv[4 * j + 2] - mean) * rstd * (1.f + sc[4 * j + 2]) + sh[4 * j + 2], u3 = (xv[4 * j + 3] - mean) * rstd * (1.f + sc[4 * j + 3]) + sh[4 * j + 3];
      *(uint2*)(U + (size_t)tok * 1024 + lane * 4 + 256 * j) = make_uint2((unsigned)f2bf(u0) | ((unsigned)f2bf(u1) << 16), (unsigned)f2bf(u2) | ((unsigned)f2bf(u3) << 16));
    }
  }
}
DEVFN void phase_final(const Params& p) {
  const int lane = TIDX & 63, wave = TIDX >> 6;
  const float* X = (const float*)(p.ws + Ws::X);
  for (int r = BIDX * 4 + wave; r < B_ * SEQ_; r += gridDim.x * 4) {
    int b = r / SEQ_, s = r % SEQ_, tok = b * T_ + CTX_ + s;
    float xv[16];
    load_row16(X + (size_t)tok * 1024, lane, xv);
    moe_residual_row(p, DEPTH_ - 1, tok, lane, xv);
#pragma unroll
    for (int j = 0; j < 4; ++j) *(float4*)(p.out + (size_t)r * 1024 + lane * 4 + 256 * j) = make_float4(xv[4 * j], xv[4 * j + 1], xv[4 * j + 2], xv[4 * j + 3]);
  }
}

DEVFN void phase2(const Params& p, int l, unsigned char* smem) {
  const bf16_t* U = (const bf16_t*)(p.ws + Ws::U);
  const bf16_t* W = (const bf16_t*)(p.ws + Ws::WIN) + (size_t)l * NIN_ * 1024;
  bf16_t* ZX = (bf16_t*)(p.ws + Ws::ZX);
  const int nct = (NIN_ + 127) / 128;
  for (int u = BIDX; u < (NT_ / 128) * nct; u += gridDim.x) {
    int rt = u / nct, ct = u % nct;
    gemm_tile(smem, 1024,
      [&](int r) { return U + (size_t)(rt * 128 + r) * 1024; },
      [&](int r) { int n = ct * 128 + r; return n < NIN_ ? W + (size_t)n * 1024 : (const bf16_t*)(p.ws + Ws::ZROW); },
      [&](f32x4 (&acc)[4][4], int wr, int wc, int g, int l15) {
        tile_store_bf16<16>(smem, wr, g, l15,
          [&](bf16_t* T, int ldc) {
#pragma unroll
            for (int mi = 0; mi < 4; ++mi)
#pragma unroll
              for (int ni = 0; ni < 4; ++ni)
#pragma unroll
                for (int i = 0; i < 4; ++i) T[(wr * 64 + mi * 16 + 4 * g + i) * ldc + wc * 64 + ni * 16 + l15] = f2bf(acc[mi][ni][i]); },
          [&](int row, int c0) { return ct * 128 + c0 < NIN_ ? ZX + (size_t)(rt * 128 + row) * NIN_ + ct * 128 + c0 : (bf16_t*)nullptr; });
      });
  }
}

DEVFN float zxv(const bf16_t* ZX, int tok, int col) { return bf2f(gptr(ZX)[(size_t)tok * NIN_ + col]); }
struct Nbr { int n; int tok[4]; };
DEVFN Nbr shift_nbrs(int tok) {
  Nbr nb; int b = tok / T_, t = tok % T_;
  if (t < CTX_) { nb.n = 2; nb.tok[0] = t > 0 ? tok - 1 : -1; nb.tok[1] = t < CTX_ - 1 ? tok + 1 : -1; nb.tok[2] = -1; nb.tok[3] = -1; }
  else { int s = t - CTX_, row = s / 64, col = s % 64; nb.n = 4; nb.tok[0] = col > 0 ? tok - 1 : -1; nb.tok[1] = col < 63 ? tok + 1 : -1;
    nb.tok[2] = row > 0 ? tok - 64 : -1; nb.tok[3] = row < SEQ_ / 64 - 1 ? tok + 64 : -1; }
  (void)b; return nb;
}
DEVFN float shiftmix(const bf16_t* ZX, const float* mu, int tok, const Nbr& nb, int ch) {
  float z = zxv(ZX, tok, ORW + ch), o = z;
#pragma unroll
  for (int j = 0; j < 4; ++j) if (j < nb.n) { float v = nb.tok[j] >= 0 ? zxv(ZX, nb.tok[j], ORW + ch) : 0.f; o += mu[j * 1152 + ch] * (v - z); }
  return o;
}
#define LI_LD 392
#define KL_LD 264
DEVFN void phase3(const Params& p, int l, unsigned char* smem) {
  const int tid = TIDX, lane = tid & 63, wave = tid >> 6, q = lane >> 4, l15 = lane & 15;
  const bf16_t* ZX = (const bf16_t*)(p.ws + Ws::ZX);
  bf16_t* XBC = (bf16_t*)(p.ws + Ws::XBC); float* DTB = (float*)(p.ws + Ws::DTB);
  bf16_t* RR = (bf16_t*)(p.ws + Ws::RR); bf16_t* VV = (bf16_t*)(p.ws + Ws::VV); bf16_t* KKb = (bf16_t*)(p.ws + Ws::KK);
  bf16_t* KRW = (bf16_t*)(p.ws + Ws::KRW); bf16_t* LIg = (bf16_t*)(p.ws + Ws::LI);
  float* LA = (float*)(p.ws + Ws::LA);
  const float* convw = INP(I_CONVW) + (size_t)l * 3 * 1024; const float* convb = INP(I_CONVB) + (size_t)l * 1024;
  const float* mu = INP(I_MU) + (size_t)l * 4 * 1152;
  float* gdl = (float*)smem;
  const float kkw = INP(I_KKW)[(size_t)l * 256 + tid];
  for (int tile = BIDX; tile < NT_ / 16; tile += gridDim.x) {
    const int tok0 = tile * 16, t0 = tok0 % T_, bb = tok0 / T_;
    const bool isctx = t0 < CTX_;
    const int s0 = t0 - CTX_;
    const bool lval = isctx ? (t0 > 0) : ((s0 & 63) != 0), rval = isctx ? (t0 + 16 < CTX_) : ((s0 & 63) != 48);
    const bool uval = !isctx && (s0 >= 64), dval = !isctx && (s0 + 64 < SEQ_);
    __syncthreads();
    {
      const bool segstart = (t0 == 0 || t0 == CTX_), segend = (t0 + 16 == CTX_ || t0 + 16 == T_);
      bf16_t* XBCT = (bf16_t*)(p.ws + Ws::XBCT) + ((size_t)(bb * NC128 + t0 / 128) * 768) * 128 + (t0 % 128);
#pragma unroll 1
      for (int j = 0; j < 4; ++j) { const int c = tid + 256 * j;
        const bf16_t* zp = ZX + (size_t)tok0 * NIN_ + OXBC + c - NIN_; bf16_t* xp = XBC + (size_t)tok0 * 1024 + c;
        float z[18];
#pragma unroll
        for (int i = 0; i < 18; ++i) { z[i] = ((i == 0 && segstart) || (i == 17 && segend)) ? 0.f : bf2f(*zp); zp += NIN_; LAUNDER_V(zp); }
        const float w0 = convw[c], w1 = convw[1024 + c], w2 = convw[2048 + c], cb = convb[c];
        bf16_t y[16];
#pragma unroll
        for (int i = 0; i < 16; ++i) { y[i] = f2bf(siluf_(cb + w0 * z[i] + w1 * z[i + 1] + w2 * z[i + 2])); *xp = y[i]; xp += 1024; LAUNDER_V(xp); }
        if (c < 768) {
          u32x4 o0, o1;
#pragma unroll
          for (int i = 0; i < 4; ++i) { o0[i] = (unsigned)y[2 * i] | ((unsigned)y[2 * i + 1] << 16); o1[i] = (unsigned)y[8 + 2 * i] | ((unsigned)y[9 + 2 * i] << 16); }
          *(u32x4*)(XBCT + (size_t)c * 128) = o0; *(u32x4*)(XBCT + (size_t)c * 128 + 8) = o1; } }
      { bf16_t* VTp = (bf16_t*)(p.ws + Ws::VT) + ((size_t)(bb * NC64 + t0 / 64) * 256 + tid) * 64 + (t0 % 64);
        const bf16_t* vp = ZX + (size_t)tok0 * NIN_ + OGV + tid;
        u32x4 o0, o1;
        bf16_t vv16[16];
#pragma unroll
        for (int i = 0; i < 16; ++i) { vv16[i] = *vp; vp += NIN_; LAUNDER_V(vp); }
#pragma unroll
        for (int i = 0; i < 4; ++i) { o0[i] = (unsigned)vv16[2 * i] | ((unsigned)vv16[2 * i + 1] << 16); o1[i] = (unsigned)vv16[8 + 2 * i] | ((unsigned)vv16[9 + 2 * i] << 16); }
        *(u32x4*)VTp = o0; *(u32x4*)(VTp + 8) = o1; }
      DTB[(size_t)tok0 * 16 + tid] = softplusf_(zxv(ZX, tok0 + (tid >> 4), ODT + (tid & 15)) + INP(I_DTBIAS)[(size_t)l * 16 + (tid & 15)]);
      gdl[tid] = zxv(ZX, tok0 + (tid >> 5), OGD + (tid & 31)); gdl[256 + tid] = zxv(ZX, tok0 + 8 + (tid >> 5), OGD + (tid & 31));
    }
#pragma unroll 1
    for (int g = 0; g < 5; ++g) {
      const bool act = !(g == 4 && tid >= 128);
      const int ch = act ? g * 256 + tid : 0;
      const bf16_t* zp0 = ZX + (size_t)tok0 * NIN_ + ORW + ch;
      const bf16_t* zp = zp0 - NIN_;
      const float m0 = mu[ch], m1 = mu[1152 + ch], m2 = mu[2304 + ch], m3 = mu[3456 + ch];
      float z[18], o[16];
#pragma unroll
      for (int i = 0; i < 18; ++i) { z[i] = ((i == 0 && !lval) || (i == 17 && !rval)) ? 0.f : bf2f(*zp); zp += NIN_; LAUNDER_V(zp); }
#pragma unroll
      for (int i = 0; i < 16; ++i) o[i] = z[i + 1] + m0 * (z[i] - z[i + 1]) + m1 * (z[i + 2] - z[i + 1]);
      if (!isctx) {
        const bf16_t* up = zp0 - (size_t)64 * NIN_; const bf16_t* dn = zp0 + (size_t)64 * NIN_;
#pragma unroll
        for (int i = 0; i < 16; ++i) { const float zu = uval ? bf2f(*up) : 0.f, zd = dval ? bf2f(*dn) : 0.f; up += NIN_; dn += NIN_; LAUNDER_V(up); LAUNDER_V(dn);
          o[i] += m2 * (zu - z[i + 1]) + m3 * (zd - z[i + 1]); } }
      if (g == 0) { bf16_t* rp = RR + (size_t)tok0 * 256 + tid;
#pragma unroll
        for (int i = 0; i < 16; ++i) { *rp = f2bf(o[i]); rp += 256; LAUNDER_V(rp); }
      } else if (g == 1) { bf16_t* kp = KKb + (size_t)tok0 * 256 + tid; bf16_t* krp = KRW + (size_t)tok0 * 256 + tid;
#pragma unroll
        for (int i = 0; i < 16; ++i) { const float kq = o[i] * kkw, nrm = sqrtf(wave_sum(kq * kq));
          *kp = f2bf(kq / fmaxf(nrm, 1e-12f)); *krp = f2bf(o[i]); kp += 256; krp += 256; LAUNDER_V(kp); LAUNDER_V(krp); }
      } else if (g == 2) { bf16_t* vp2 = VV + (size_t)tok0 * 256 + tid;
#pragma unroll
        for (int i = 0; i < 16; ++i) { *vp2 = f2bf(o[i]); vp2 += 256; LAUNDER_V(vp2); }
      } else if (g == 3) { bf16_t* lp = LIg + (size_t)tok0 * 384 + tid;
#pragma unroll
        for (int i = 0; i < 16; ++i) { *lp = f2bf(tid < 128 ? tanhf(o[i]) : o[i]); lp += 384; LAUNDER_V(lp); }
      } else if (act) { bf16_t* lp = LIg + (size_t)tok0 * 384 + 256 + tid;
#pragma unroll
        for (int i = 0; i < 16; ++i) { *lp = f2bf(sigmoidf_(o[i])); lp += 384; LAUNDER_V(lp); }
      }
    }
    __syncthreads();
    { const int d = tid >> 7, c = tid & 127; const float* gu = INP(I_GU) + ((size_t)l * 2 + d) * 16 * 128; const float gb = INP(I_GB)[((size_t)l * 2 + d) * 128 + c];
      float guw[16];
#pragma unroll
      for (int i = 0; i < 16; ++i) guw[i] = gu[i * 128 + c];
#pragma unroll 4
      for (int tt = 0; tt < 16; ++tt) { float sacc = gb;
#pragma unroll
        for (int i = 0; i < 16; ++i) sacc += gdl[tt * 32 + d * 16 + i] * guw[i];
        LA[((size_t)d * NT_ + tok0 + tt) * 128 + c] = logsigmoidf_(sacc) * (1.f / 16.f); } }
  }
}

DEVFN void phase3b(const Params& p, int l, unsigned char* smem) {
  const bf16_t* LIg = (const bf16_t*)(p.ws + Ws::LI);
  const bf16_t* lora = (const bf16_t*)(p.ws + Ws::LORA) + (size_t)l * 98304;
  const bf16_t* KRg = (const bf16_t*)(p.ws + Ws::KRW); const bf16_t* KKg = (const bf16_t*)(p.ws + Ws::KK);
  float* LWp = (float*)(p.ws + Ws::LW); bf16_t* KD = (bf16_t*)(p.ws + Ws::KD); bf16_t* BD = (bf16_t*)(p.ws + Ws::BD); float* GATE = (float*)(p.ws + Ws::GATE);
  for (int u = BIDX; u < (NT_ / 128) * 10; u += gridDim.x) {
    const int rt = u / 10, which = (u % 10) >> 1, ct = u & 1;
    const int K = which < 4 ? 64 : 128, acol = which < 4 ? which * 64 : 256;
    const bf16_t* wb = which < 2 ? lora + (size_t)which * 16384 : which < 4 ? lora + 32768 + (size_t)(which - 2) * 16384 : lora + 65536;
    const float* bias = which < 2 ? INP(I_W0) + (size_t)l * 512 + which * 256 : INP(I_A0) + (size_t)l * 512 + (which & 1) * 256;
    const float* kav = INP(I_KAW) + (size_t)l * 256;
    gemm_tile(smem, K,
      [&](int r) { return LIg + (size_t)(rt * 128 + r) * 384 + acol; },
      [&](int r) { return wb + (size_t)(ct * 128 + r) * K; },
      [&](f32x4 (&acc)[4][4], int wr, int wc, int g, int l15) {
#pragma unroll
        for (int ni = 0; ni < 4; ++ni) { const int col = ct * 128 + wc * 64 + ni * 16 + l15;
          const float bv = which < 4 ? bias[col] : 0.f, ka = kav[col];
#pragma unroll
          for (int mi = 0; mi < 4; ++mi)
#pragma unroll
            for (int i = 0; i < 4; ++i) { const int row = rt * 128 + wr * 64 + mi * 16 + 4 * g + i; const size_t o = (size_t)row * 256 + col;
              const float v = acc[mi][ni][i];
              if (which < 2) LWp[(size_t)which * NT_ * 256 + o] = -0.6065306597126334f * sigmoidf_(v + bv);
              else if (which < 4) { const float a = sigmoidf_(v + bv); const size_t od = (size_t)(which - 2) * NT_ * 256 + o;
                KD[od] = f2bf(bf2f(KRg[o]) * (1.f + (a - 1.f) * ka)); BD[od] = f2bf(bf2f(KKg[o]) * a); }
              else GATE[o] = v; } }
      });
  }
}

DEVFN bf16x8 ld8(const bf16_t* p) { return *(const bf16x8*)p; }
typedef short bf16x4v __attribute__((ext_vector_type(4)));
DEVFN bf16x4v cvt4(f32x4 v) { return bf16x4v{(short)f2bf(v[0]), (short)f2bf(v[1]), (short)f2bf(v[2]), (short)f2bf(v[3])}; }
DEVFN bf16x8 cat44(bf16x4v a, bf16x4v b) { return bf16x8{a[0], a[1], a[2], a[3], b[0], b[1], b[2], b[3]}; }
DEVFN bf16x4v ld4(const bf16_t* p) { return *(const bf16x4v*)p; }
DEVFN int rm_off(int i, int k) { return i * 64 + ((((k >> 3) ^ (i & 7)) << 3) | (k & 7)); }
#define RW_WAVE_LDS 11264
DEVFN void rwkv_chunk(const Params& p, int unit_base, unsigned char* smem) {
  const int tid = TIDX, lane = tid & 63, wave = tid >> 6, q = lane >> 4, l15 = lane & 15;
  const int unit = unit_base + wave;
  const int c = unit % NC16, h = (unit / NC16) & 3, dir = (unit / (NC16 * 4)) & 1, b = unit / (NC16 * 8);
  bf16_t* big = (bf16_t*)(smem + wave * RW_WAVE_LDS);
  unsigned char* small = smem + wave * RW_WAVE_LDS + 8192;
  float* AbF = (float*)small;
  bf16_t* TN = (bf16_t*)(small + 1024);
  bf16_t* AK = TN + 256; bf16_t* RB = AK + 256; bf16_t* RK = RB + 256;
  const bf16_t* RRg = (const bf16_t*)(p.ws + Ws::RR); const bf16_t* VVg = (const bf16_t*)(p.ws + Ws::VV); const bf16_t* KKg = (const bf16_t*)(p.ws + Ws::KK);
  const bf16_t* KDg = (const bf16_t*)(p.ws + Ws::KD) + (size_t)dir * NT_ * 256; const bf16_t* BDg = (const bf16_t*)(p.ws + Ws::BD) + (size_t)dir * NT_ * 256;
  const float* LWg = (const float*)(p.ws + Ws::LW) + (size_t)dir * NT_ * 256;
  float kkm[16], vv[16], bneg[16], kneg[16];
  float run = 0.f;
  __syncthreads();
#pragma unroll
  for (int i = 0; i < 16; ++i) {
    const size_t o = (size_t)(b * T_ + tokmap(dir, c * 16 + i)) * 256 + h * 64 + lane;
    const float lw = LWg[o], r = bf2f(RRg[o]), k = bf2f(KDg[o]), v = bf2f(VVg[o]), kk = bf2f(KKg[o]), bb = bf2f(BDg[o]);
    const float e_ex = expf(run); run += lw; const float e_in = expf(run), e_neg = expf(-run);
    kkm[i] = kk * e_ex; vv[i] = v; bneg[i] = bb * e_neg; kneg[i] = k * e_neg;
    big[rm_off(i, lane)] = f2bf(kkm[i]); big[1024 + rm_off(i, lane)] = f2bf(r * e_in);
    big[2048 + rm_off(i, lane)] = f2bf(bneg[i]); big[3072 + rm_off(i, lane)] = f2bf(kneg[i]);
  }
  const float WC = expf(run);
  __syncthreads();
  f32x4 ab = f32x4{0.f, 0.f, 0.f, 0.f}, ak = ab, rb = ab, rk = ab;
#pragma unroll
  for (int s2 = 0; s2 < 2; ++s2) { const int ch = ((4 * s2 + q) ^ (l15 & 7)) << 3;
    const bf16x8 a_kk = ld8(big + l15 * 64 + ch), a_r = ld8(big + 1024 + l15 * 64 + ch), b_b = ld8(big + 2048 + l15 * 64 + ch), b_k = ld8(big + 3072 + l15 * 64 + ch);
    ab = MFMA16(a_kk, b_b, ab); ak = MFMA16(a_kk, b_k, ak); rb = MFMA16(a_r, b_b, rb); rk = MFMA16(a_r, b_k, rk); }
  f32x4 gacc[4];
#pragma unroll
  for (int nk = 0; nk < 4; ++nk)
#pragma unroll
    for (int r = 0; r < 4; ++r) gacc[nk][r] = bf2f(big[1024 + rm_off(4 * q + r, 16 * nk + l15)]);
  __syncthreads();
#pragma unroll
  for (int r = 0; r < 4; ++r) { const int i = 4 * q + r, j = l15;
    AbF[i * 16 + j] = j < i ? ab[r] : 0.f; AK[i * 16 + j] = f2bf(j < i ? ak[r] : 0.f);
    RB[i * 16 + j] = f2bf(j <= i ? rb[r] : 0.f); RK[i * 16 + j] = f2bf(j <= i ? rk[r] : 0.f); }
  { bf16_t* KKMT = big; bf16_t* VTT = big + 1024; bf16_t* BHT = big + 2048; bf16_t* KHT = big + 3072;
#pragma unroll
    for (int i = 0; i < 16; ++i) { KKMT[lane * 16 + i] = f2bf(kkm[i]); VTT[lane * 16 + i] = f2bf(vv[i]); BHT[lane * 16 + i] = f2bf(bneg[i] * WC); KHT[lane * 16 + i] = f2bf(kneg[i] * WC); } }
  __syncthreads();
  { float t[16];
#pragma unroll
    for (int i = 0; i < 16; ++i) { float acc = (i == l15) ? 1.f : 0.f;
#pragma unroll
      for (int j = 0; j < i; ++j) acc -= AbF[i * 16 + j] * t[j];
      t[i] = acc; }
    if (q == 0) {
#pragma unroll
      for (int i = 0; i < 16; ++i) TN[i * 16 + l15] = f2bf(-t[i]); } }
  __syncthreads();
  const size_t ci = (size_t)((b * 2 + dir) * 4 + h) * NC16 + c;
  bf16_t* MLg = (bf16_t*)(p.ws + Ws::RML) + ci * 4096; bf16_t* Ng = (bf16_t*)(p.ws + Ws::RNS) + ci * 4096;
  bf16_t* Gg = (bf16_t*)(p.ws + Ws::RG) + ci * 1024; float* Y0g = (float*)(p.ws + Ws::RY0) + ci * 1024;
  const bf16x4v a_T = ld4(TN + l15 * 16 + 4 * q), a_Ak = ld4(AK + l15 * 16 + 4 * q), a_Rb = ld4(RB + l15 * 16 + 4 * q), a_Rk = ld4(RK + l15 * 16 + 4 * q);
  const f32x4 z4 = f32x4{0.f, 0.f, 0.f, 0.f};
  bf16x4v vfr[4], qfr[4], pfr[4];
#pragma unroll
  for (int n = 0; n < 4; ++n) {
    vfr[n] = ld4(big + 1024 + (16 * n + l15) * 16 + 4 * q);
    const f32x4 akv = MFMA16K16(a_Ak, vfr[n], z4);
    qfr[n] = cvt4(MFMA16K16(a_T, cvt4(akv), z4));
    pfr[n] = cvt4(MFMA16K16(a_T, ld4(big + (16 * n + l15) * 16 + 4 * q), z4)); }
  const bf16x8 a_RbRk = cat44(a_Rb, a_Rk);
#pragma unroll
  for (int n = 0; n < 4; ++n) {
    const f32x4 g = MFMA16K16(a_Rb, pfr[n], gacc[n]);
    const f32x4 y0 = MFMA16(a_RbRk, cat44(qfr[n], vfr[n]), z4);
#pragma unroll
    for (int r = 0; r < 4; ++r) { Gg[(4 * q + r) * 64 + 16 * n + l15] = f2bf(g[r]); Y0g[(4 * q + r) * 64 + 16 * n + l15] = y0[r]; } }
#pragma unroll
  for (int mk = 0; mk < 4; ++mk) {
    const bf16x4v a_B = ld4(big + 2048 + (16 * mk + l15) * 16 + 4 * q), a_K = ld4(big + 3072 + (16 * mk + l15) * 16 + 4 * q);
    const bf16x8 a_BK = cat44(a_B, a_K);
#pragma unroll
    for (int n = 0; n < 4; ++n) {
      const f32x4 m = MFMA16K16(a_B, pfr[n], z4);
      const f32x4 nn = MFMA16(a_BK, cat44(qfr[n], vfr[n]), z4);
#pragma unroll
      for (int r = 0; r < 4; ++r) MLg[((mk * 2 + (n >> 1)) * 64 + (l15 >> 2) * 16 + 4 * q + r) * 8 + (n & 1) * 4 + (l15 & 3)] = f2bf(m[r]);
      *(bf16x4v*)(Ng + (n * 64 + lane) * 16 + mk * 4) = cvt4(nn); } }
  ((float*)(p.ws + Ws::RWC))[ci * 64 + ((lane >> 2) & 3) * 16 + (lane >> 4) * 4 + (lane & 3)] = WC;
}
struct RwStep { bf16x8 ml[4][2]; bf16x8 n[2]; f32x4 wc[4]; };
DEVFN void rw_load(RwStep& t, const bf16_t* MLg, const bf16_t* NSg, const float* WCg, int c, int lane, int q) {
#pragma unroll
  for (int mk = 0; mk < 4; ++mk) { t.ml[mk][0] = ld8g(MLg + (size_t)c * 4096 + ((mk * 2 + 0) * 64 + lane) * 8); t.ml[mk][1] = ld8g(MLg + (size_t)c * 4096 + ((mk * 2 + 1) * 64 + lane) * 8);
    t.wc[mk] = *(const AS1 f32x4*)gptr(WCg + (size_t)c * 64 + q * 16 + mk * 4); }
  t.n[0] = ld8g(NSg + (size_t)c * 4096 + lane * 16); t.n[1] = ld8g(NSg + (size_t)c * 4096 + lane * 16 + 8);
}
DEVFN void rw_step(const RwStep& t, f32x4 (&S)[4], bf16_t* NSg, int c, int q, int l15) {
  bf16x4v sb[4];
#pragma unroll
  for (int mk = 0; mk < 4; ++mk) sb[mk] = cvt4(S[mk]);
  const bf16x8 bf0 = cat44(sb[0], sb[1]), bf1 = cat44(sb[2], sb[3]);
#pragma unroll
  for (int mk = 0; mk < 4; ++mk) {
    f32x4 acc;
#pragma unroll
    for (int r = 0; r < 4; ++r) acc[r] = bf2f((bf16_t)t.n[mk >> 1][(mk & 1) * 4 + r]) + t.wc[mk][r] * S[mk][r];
    acc = MFMA16(t.ml[mk][0], bf0, acc);
    acc = MFMA16(t.ml[mk][1], bf1, acc);
    S[mk] = acc; }
#pragma unroll
  for (int mk = 0; mk < 4; ++mk) *(AS1 bf16x4v*)gptr(NSg + (size_t)c * 4096 + l15 * 64 + 16 * mk + 4 * q) = sb[mk];
}
DEVFN void rwkv_scan(const Params& p, int chain, int wave) {
  const int tid = TIDX, lane = tid & 63, q = lane >> 4, l15 = lane & 15;
  const bf16_t* MLg = (const bf16_t*)(p.ws + Ws::RML) + (size_t)chain * NC16 * 4096;
  bf16_t* NSg = (bf16_t*)(p.ws + Ws::RNS) + (size_t)chain * NC16 * 4096 + wave * 1024;
  const float* WCg = (const float*)(p.ws + Ws::RWC) + (size_t)chain * NC16 * 64;
  f32x4 S[4];
#pragma unroll
  for (int mk = 0; mk < 4; ++mk) S[mk] = f32x4{0.f, 0.f, 0.f, 0.f};
  RwStep t0, t1, t2;
#define RWC_(x) ((x) < NC16 ? (x) : NC16 - 1)
  rw_load(t0, MLg, NSg, WCg, 0, lane, q);
  rw_load(t1, MLg, NSg, WCg, RWC_(1), lane, q);
  int c = 0;
  for (; c + 2 < NC16; c += 3) {
    rw_load(t2, MLg, NSg, WCg, c + 2, lane, q);
    rw_step(t0, S, NSg, c, q, l15);
    rw_load(t0, MLg, NSg, WCg, RWC_(c + 3), lane, q);
    rw_step(t1, S, NSg, c + 1, q, l15);
    rw_load(t1, MLg, NSg, WCg, RWC_(c + 4), lane, q);
    rw_step(t2, S, NSg, c + 2, q, l15);
  }
  if (c < NC16) { rw_step(t0, S, NSg, c, q, l15); if (c + 1 < NC16) rw_step(t1, S, NSg, c + 1, q, l15); }
#undef RWC_
}
DEVFN void rwkv_out(const Params& p, int unit_base) {
  const int tid = TIDX, lane = tid & 63, wave = tid >> 6, q = lane >> 4, l15 = lane & 15;
  const int unit = unit_base + wave;
  const int c = unit % NC16, h = (unit / NC16) & 3, dir = (unit / (NC16 * 4)) & 1, b = unit / (NC16 * 8);
  const size_t ci = (size_t)((b * 2 + dir) * 4 + h) * NC16 + c;
  const bf16_t* Sg = (const bf16_t*)(p.ws + Ws::RNS) + ci * 4096; const bf16_t* Gg = (const bf16_t*)(p.ws + Ws::RG) + ci * 1024;
  const float* Y0g = (const float*)(p.ws + Ws::RY0) + ci * 1024;
  float* YR = (float*)(p.ws + Ws::YR) + (size_t)dir * NT_ * 256;
  const bf16x8 a0 = ld8(Gg + l15 * 64 + 8 * q), a1 = ld8(Gg + l15 * 64 + 32 + 8 * q);
#pragma unroll
  for (int n = 0; n < 4; ++n) {
    f32x4 acc;
#pragma unroll
    for (int r = 0; r < 4; ++r) acc[r] = Y0g[(4 * q + r) * 64 + 16 * n + l15];
    acc = MFMA16(a0, ld8(Sg + n * 1024 + l15 * 64 + 8 * q), acc);
    acc = MFMA16(a1, ld8(Sg + n * 1024 + l15 * 64 + 32 + 8 * q), acc);
#pragma unroll
    for (int r = 0; r < 4; ++r) YR[(size_t)(b * T_ + tokmap(dir, c * 16 + 4 * q + r)) * 256 + h * 64 + 16 * n + l15] = acc[r]; }
}
DEVFN int cscan(int dir, int co, int nctx, int nc) { return dir == 0 ? co : (co < nctx ? nctx - 1 - co : 2 * nctx + nc - 1 - co); }
DEVFN bf16x8 ld4x2(const bf16_t* p0, const bf16_t* p1) { bf16x4v a = *(const bf16x4v*)p0, b = *(const bf16x4v*)p1; return bf16x8{a[0], a[1], a[2], a[3], b[0], b[1], b[2], b[3]}; }

DEVFN void ssd_chunk_scalars(const Params& p, int l, int b, int co, int h, float* f) {
  const int tid = TIDX, d = tid >> 7, j = tid & 127;
  const float* DTB = (const float*)(p.ws + Ws::DTB);
  const float nega = -expf(INP(I_ALOG)[(size_t)l * 16 + d * 8 + h]);
  const float dt = DTB[(size_t)(b * T_ + co * 128 + j) * 16 + d * 8 + h];
  __syncthreads();
  f[256 + d * 128 + j] = dt;
  float* cur = f + d * 128; float* tmp = f + 512 + d * 128;
  cur[j] = dt * nega;
  __syncthreads();
  for (int off = 1; off < 128; off <<= 1) {
    float v = cur[j] + (j >= off ? cur[j - off] : 0.f);
    tmp[j] = v;
    __syncthreads();
    cur[j] = tmp[j];
    __syncthreads();
  }
}
DEVFN void ssd_states(const Params& p, int l, int unit, unsigned char* smem) {
  const int tid = TIDX, lane = tid & 63, wave = tid >> 6, q = lane >> 4, l15 = lane & 15;
  const int h = unit & 7, co = (unit >> 3) % NC128, b = unit / (8 * NC128), grp = h >> 2;
  float* f = (float*)smem;
  ssd_chunk_scalars(p, l, b, co, h, f);
  { const int d = tid >> 7, j = tid & 127; const float* cum = f + d * 128; const float dt = f[256 + d * 128 + j];
    float w = d == 0 ? expf(cum[127] - cum[j]) * dt : expf(j > 0 ? cum[j - 1] : 0.f) * dt;
    f[512 + d * 128 + j] = w; }
  __syncthreads();
  const bf16_t* XT = (const bf16_t*)(p.ws + Ws::XBCT) + (size_t)(b * NC128 + co) * 768 * 128;
  f32x4 acc[2][8];
#pragma unroll
  for (int d = 0; d < 2; ++d)
#pragma unroll
    for (int n = 0; n < 8; ++n) acc[d][n] = f32x4{0.f, 0.f, 0.f, 0.f};
#pragma unroll 1
  for (int s4 = 0; s4 < 4; ++s4) {
    const int j0 = s4 * 32 + q * 8;
    bf16x8 xa = ld8(XT + (size_t)(h * 64 + wave * 16 + l15) * 128 + j0), a0, a1;
#pragma unroll
    for (int jj = 0; jj < 8; ++jj) { float x = bf2f((bf16_t)xa[jj]); a0[jj] = (short)f2bf(x * f[512 + j0 + jj]); a1[jj] = (short)f2bf(x * f[640 + j0 + jj]); }
#pragma unroll
    for (int n = 0; n < 8; ++n) { bf16x8 bb = ld8(XT + (size_t)(512 + grp * 128 + n * 16 + l15) * 128 + j0);
      acc[0][n] = MFMA16(a0, bb, acc[0][n]); acc[1][n] = MFMA16(a1, bb, acc[1][n]); }
  }
#pragma unroll
  for (int d = 0; d < 2; ++d) {
    const int cs = cscan(d, co, CTX_ / 128, SEQ_ / 128);
    float* ST = (float*)(p.ws + Ws::SST) + ((size_t)((d * B_ + b) * NC128 + cs) * 8 + h) * 8192;
#pragma unroll
    for (int n = 0; n < 8; ++n)
#pragma unroll
      for (int r = 0; r < 4; ++r) ST[(wave * 16 + q * 4 + r) * 128 + n * 16 + l15] = acc[d][n][r];
    if (tid == 0) ((float*)(p.ws + Ws::SCD))[((size_t)(d * B_ + b) * NC128 + cs) * 8 + h] = expf(f[d * 128 + 127]);
  }
}
#define SSD_SB ((NC128 % 17) == 0 ? 17 : NC128)
DEVFN void ssd_scan(const Params& p, int gtid, int gthreads) {
  const float* __restrict__ ST = (const float*)(p.ws + Ws::SST); const float* __restrict__ CD = (const float*)(p.ws + Ws::SCD); bf16_t* __restrict__ HIN = (bf16_t*)(p.ws + Ws::HIN);
  for (int e = gtid; e < 2 * B_ * 8 * 8192; e += gthreads) {
    const int pd = e & 8191, h = (e >> 13) & 7, db = e >> 16;
    float hv = 0.f;
#pragma unroll 1
    for (int c0 = 0; c0 < NC128; c0 += SSD_SB) {
      float st[SSD_SB], cd[SSD_SB];
#pragma unroll
      for (int i = 0; i < SSD_SB; ++i) { st[i] = ST[((size_t)(db * NC128 + c0 + i) * 8 + h) * 8192 + pd]; cd[i] = CD[(size_t)(db * NC128 + c0 + i) * 8 + h]; }
#pragma unroll
      for (int i = 0; i < SSD_SB; ++i) { HIN[((size_t)(db * NC128 + c0 + i) * 8 + h) * 8192 + pd] = f2bf(hv); hv = hv * cd[i] + st[i]; }
    }
  }
}
DEVFN void ssd_out(const Params& p, int l, int unit, unsigned char* smem) {
  const int tid = TIDX, lane = tid & 63, wave = tid >> 6, q = lane >> 4, l15 = lane & 15;
  const int h = unit & 7, co = (unit >> 3) % NC128, b = unit / (8 * NC128), grp = h >> 2;
  float* f = (float*)smem;
  ssd_chunk_scalars(p, l, b, co, h, f);
  if (tid < 128) f[640 + tid] = f[128 + 127] - (tid > 0 ? f[128 + tid - 1] : 0.f);
  __syncthreads();
  const float* cum0 = f; const float* suf1 = f + 640; const float* dt0 = f + 256; const float* dt1 = f + 384;
  const bf16_t* XBC = (const bf16_t*)(p.ws + Ws::XBC) + (size_t)(b * T_ + co * 128) * 1024;
  const bf16_t* XT = (const bf16_t*)(p.ws + Ws::XBCT) + (size_t)(b * NC128 + co) * 768 * 128;
  const bf16_t* Cb = XBC + (size_t)(wave * 32 + l15) * 1024 + 768 + grp * 128 + q * 8;
  f32x4 y[4][2];
  { f32x4 o0[4][2], o1[4][2];
#pragma unroll
    for (int mp = 0; mp < 4; ++mp)
#pragma unroll
      for (int ni = 0; ni < 2; ++ni) { o0[mp][ni] = f32x4{0.f, 0.f, 0.f, 0.f}; o1[mp][ni] = f32x4{0.f, 0.f, 0.f, 0.f}; }
    const int cs0 = cscan(0, co, CTX_ / 128, SEQ_ / 128), cs1 = cscan(1, co, CTX_ / 128, SEQ_ / 128);
    const bf16_t* H0 = (const bf16_t*)(p.ws + Ws::HIN) + ((size_t)((0 * B_ + b) * NC128 + cs0) * 8 + h) * 8192;
    const bf16_t* H1 = (const bf16_t*)(p.ws + Ws::HIN) + ((size_t)((1 * B_ + b) * NC128 + cs1) * 8 + h) * 8192;
#pragma unroll 1
    for (int s4 = 0; s4 < 4; ++s4) { const bf16x8 c0 = ld8(Cb + s4 * 32), c1 = ld8(Cb + 16 * 1024 + s4 * 32);
#pragma unroll
      for (int mp = 0; mp < 4; ++mp) { bf16x8 h0 = ld8(H0 + (size_t)(mp * 16 + l15) * 128 + s4 * 32 + q * 8), h1 = ld8(H1 + (size_t)(mp * 16 + l15) * 128 + s4 * 32 + q * 8);
        o0[mp][0] = MFMA16(h0, c0, o0[mp][0]); o0[mp][1] = MFMA16(h0, c1, o0[mp][1]);
        o1[mp][0] = MFMA16(h1, c0, o1[mp][0]); o1[mp][1] = MFMA16(h1, c1, o1[mp][1]); } }
#pragma unroll
    for (int ni = 0; ni < 2; ++ni) { const int i = wave * 32 + ni * 16 + l15; const float e0 = expf(cum0[i]), e1 = expf(suf1[i]);
#pragma unroll
      for (int mp = 0; mp < 4; ++mp)
#pragma unroll
        for (int r = 0; r < 4; ++r) y[mp][ni][r] = e0 * o0[mp][ni][r] + e1 * o1[mp][ni][r]; } }
  bf16x8 mfr[4][2];
  { f32x4 g[8][2];
#pragma unroll
    for (int mj = 0; mj < 8; ++mj) { g[mj][0] = f32x4{0.f, 0.f, 0.f, 0.f}; g[mj][1] = f32x4{0.f, 0.f, 0.f, 0.f}; }
#pragma unroll 1
    for (int s4 = 0; s4 < 4; ++s4) { const bf16x8 c0 = ld8(Cb + s4 * 32), c1 = ld8(Cb + 16 * 1024 + s4 * 32);
#pragma unroll
      for (int mj = 0; mj < 8; ++mj) { bf16x8 bb = ld8(XBC + (size_t)(mj * 16 + l15) * 1024 + 512 + grp * 128 + s4 * 32 + q * 8);
        g[mj][0] = MFMA16(bb, c0, g[mj][0]); g[mj][1] = MFMA16(bb, c1, g[mj][1]); } }
    const int i0 = wave * 32 + l15, i1 = i0 + 16;
    const float c0i0 = cum0[i0], s1i0 = suf1[i0], c0i1 = cum0[i1], s1i1 = suf1[i1];
#pragma unroll
    for (int mj = 0; mj < 8; ++mj)
#pragma unroll
      for (int r = 0; r < 4; ++r) { const int j = mj * 16 + q * 4 + r;
        const float cj = cum0[j], sj = suf1[j], d0 = dt0[j], d1 = dt1[j];
        const float lw0 = (j <= i0 ? expf(c0i0 - cj) * d0 : 0.f) + (j >= i0 ? expf(s1i0 - sj) * d1 : 0.f);
        const float lw1 = (j <= i1 ? expf(c0i1 - cj) * d0 : 0.f) + (j >= i1 ? expf(s1i1 - sj) * d1 : 0.f);
        mfr[mj >> 1][0][(mj & 1) * 4 + r] = (short)f2bf(g[mj][0][r] * lw0);
        mfr[mj >> 1][1][(mj & 1) * 4 + r] = (short)f2bf(g[mj][1][r] * lw1); } }
#pragma unroll
  for (int s4 = 0; s4 < 4; ++s4)
#pragma unroll
    for (int mp = 0; mp < 4; ++mp) { const bf16_t* xr = XT + (size_t)(h * 64 + mp * 16 + l15) * 128 + s4 * 32 + q * 4;
      bf16x8 xa = ld4x2(xr, xr + 16);
      y[mp][0] = MFMA16(xa, mfr[s4][0], y[mp][0]); y[mp][1] = MFMA16(xa, mfr[s4][1], y[mp][1]); }
  __syncthreads();
  float* yl = f + 1024;
#pragma unroll
  for (int mp = 0; mp < 4; ++mp)
#pragma unroll
    for (int ni = 0; ni < 2; ++ni)
#pragma unroll
      for (int r = 0; r < 4; ++r) yl[(wave * 32 + ni * 16 + l15) * 65 + mp * 16 + q * 4 + r] = y[mp][ni][r];
  __syncthreads();
  float* YS = (float*)(p.ws + Ws::YS) + (size_t)(b * T_ + co * 128) * 512 + h * 64;
  for (int e = tid; e < 128 * 64; e += 256) YS[(size_t)(e >> 6) * 512 + (e & 63)] = yl[(e >> 6) * 65 + (e & 63)];
}

#define GQ_LD 40
#define GK_LD 72
DEVFN void gla_chunk(const Params& p, int unit, unsigned char* smem) {
  const int tid = TIDX, lane = tid & 63, wave = tid >> 6, q = lane >> 4, l15 = lane & 15;
  const int h = unit & 3, co = (unit >> 2) % NC64, b = unit / (4 * NC64);
  const bf16_t* ZX = (const bf16_t*)(p.ws + Ws::ZX) + (size_t)(b * T_ + co * 64) * NIN_;
  const float* LA = (const float*)(p.ws + Ws::LA);
  float* cum = (float*)smem;
  bf16_t* qs = (bf16_t*)(smem + 16384);
  bf16_t* ks = qs + 2 * 64 * GQ_LD;
  bf16_t* kt = ks + 2 * 64 * GQ_LD;
  __syncthreads();
  for (int e = tid; e < 2 * 64 * 32; e += 256) { const int d = e >> 11, i = (e >> 5) & 63, dd = e & 31;
    cum[e] = LA[((size_t)d * NT_ + b * T_ + co * 64 + i) * 128 + h * 32 + dd]; }
  __syncthreads();
  if (tid < 64) { const int d = tid >> 5, dd = tid & 31; float* c = cum + d * 2048 + dd; float sacc = 0.f;
    if (d == 0) for (int i = 0; i < 64; ++i) { sacc += c[i * 32]; c[i * 32] = sacc; }
    else for (int i = 63; i >= 0; --i) { sacc += c[i * 32]; c[i * 32] = sacc; } }
  __syncthreads();
  bf16_t* QT = (bf16_t*)(p.ws + Ws::QT);
  for (int e = tid; e < 64 * 32; e += 256) { const int i = e >> 5, dd = e & 31;
    const float qv = bf2f(ZX[(size_t)i * NIN_ + OGQ + h * 32 + dd]) * 0.17677669529663687f, kv = bf2f(ZX[(size_t)i * NIN_ + OGK + h * 32 + dd]);
    const float c0 = cum[i * 32 + dd], c1 = cum[2048 + i * 32 + dd], t0 = cum[63 * 32 + dd], t1 = cum[2048 + dd];
    const bf16_t q0 = f2bf(qv * expf(c0)), q1 = f2bf(qv * expf(c1));
    qs[i * GQ_LD + dd] = q0; qs[64 * GQ_LD + i * GQ_LD + dd] = q1;
    ks[i * GQ_LD + dd] = f2bf(kv * expf(-c0)); ks[64 * GQ_LD + i * GQ_LD + dd] = f2bf(kv * expf(-c1));
    kt[dd * GK_LD + i] = f2bf(kv * expf(t0 - c0)); kt[32 * GK_LD + dd * GK_LD + i] = f2bf(kv * expf(t1 - c1));
    const size_t tok = (size_t)b * T_ + co * 64 + i;
    QT[tok * 128 + h * 32 + dd] = q0; QT[((size_t)NT_ + tok) * 128 + h * 32 + dd] = q1; }
  if (tid < 64) { const int d = tid >> 5, dd = tid & 31; const int cs = cscan(d, co, CTX_ / 64, SEQ_ / 64);
    ((float*)(p.ws + Ws::GCD))[(((size_t)(d * B_ + b) * NC64 + cs) * 4 + h) * 32 + dd] = expf(d == 0 ? cum[63 * 32 + dd] : cum[2048 + dd]); }
  __syncthreads();
  bf16x8 pfr[2];
  { f32x4 p0[4], p1[4];
    const bf16x8 qb0 = ld8(qs + (wave * 16 + l15) * GQ_LD + q * 8), qb1 = ld8(qs + 64 * GQ_LD + (wave * 16 + l15) * GQ_LD + q * 8);
#pragma unroll
    for (int mj = 0; mj < 4; ++mj) { p0[mj] = MFMA16(ld8(ks + (mj * 16 + l15) * GQ_LD + q * 8), qb0, (f32x4{0.f, 0.f, 0.f, 0.f}));
      p1[mj] = MFMA16(ld8(ks + 64 * GQ_LD + (mj * 16 + l15) * GQ_LD + q * 8), qb1, (f32x4{0.f, 0.f, 0.f, 0.f})); }
    const int i = wave * 16 + l15;
#pragma unroll
    for (int mj = 0; mj < 4; ++mj)
#pragma unroll
      for (int r = 0; r < 4; ++r) { const int j = mj * 16 + q * 4 + r; pfr[mj >> 1][(mj & 1) * 4 + r] = (short)f2bf((j <= i ? p0[mj][r] : 0.f) + (j >= i ? p1[mj][r] : 0.f)); } }
  const bf16_t* VT = (const bf16_t*)(p.ws + Ws::VT) + ((size_t)(b * NC64 + co) * 256 + h * 64) * 64;
  f32x4 o[4];
#pragma unroll
  for (int md = 0; md < 4; ++md) { o[md] = f32x4{0.f, 0.f, 0.f, 0.f};
#pragma unroll
    for (int s2 = 0; s2 < 2; ++s2) { const bf16_t* vr = VT + (size_t)(md * 16 + l15) * 64 + s2 * 32 + q * 4; o[md] = MFMA16(ld4x2(vr, vr + 16), pfr[s2], o[md]); } }
#pragma unroll
  for (int d = 0; d < 2; ++d) { const int cs = cscan(d, co, CTX_ / 64, SEQ_ / 64);
    float* GST = (float*)(p.ws + Ws::GST) + (((size_t)(d * B_ + b) * NC64 + cs) * 4 + h) * 2048;
#pragma unroll
    for (int nd = 0; nd < 2; ++nd) { f32x4 st = f32x4{0.f, 0.f, 0.f, 0.f};
#pragma unroll
      for (int s2 = 0; s2 < 2; ++s2) st = MFMA16(ld8(VT + (size_t)(wave * 16 + l15) * 64 + s2 * 32 + q * 8), ld8(kt + d * 32 * GK_LD + (nd * 16 + l15) * GK_LD + s2 * 32 + q * 8), st);
#pragma unroll
      for (int r = 0; r < 4; ++r) GST[(wave * 16 + q * 4 + r) * 32 + nd * 16 + l15] = st[r]; } }
  __syncthreads();
  float* ol = (float*)smem;
#pragma unroll
  for (int md = 0; md < 4; ++md)
#pragma unroll
    for (int r = 0; r < 4; ++r) ol[(wave * 16 + l15) * 65 + md * 16 + q * 4 + r] = o[md][r];
  __syncthreads();
  float* OI = (float*)(p.ws + Ws::OI) + (size_t)(b * T_ + co * 64) * 256 + h * 64;
  for (int e = tid; e < 64 * 64; e += 256) OI[(size_t)(e >> 6) * 256 + (e & 63)] = ol[(e >> 6) * 65 + (e & 63)];
}
#define GLA_SB ((NC64 % 17) == 0 ? 17 : NC64)
DEVFN void gla_scan(const Params& p, int gtid, int gthreads) {
  const float* __restrict__ ST = (const float*)(p.ws + Ws::GST); const float* __restrict__ CD = (const float*)(p.ws + Ws::GCD); bf16_t* __restrict__ SIN = (bf16_t*)(p.ws + Ws::GSIN);
  for (int e = gtid; e < 2 * B_ * 4 * 2048; e += gthreads) {
    const int vd = e & 2047, h = (e >> 11) & 3, db = e >> 13;
    float sv = 0.f;
#pragma unroll 1
    for (int c0 = 0; c0 < NC64; c0 += GLA_SB) {
      float st[GLA_SB], cd[GLA_SB];
#pragma unroll
      for (int i = 0; i < GLA_SB; ++i) { st[i] = ST[(((size_t)db * NC64 + c0 + i) * 4 + h) * 2048 + vd]; cd[i] = CD[(((size_t)db * NC64 + c0 + i) * 4 + h) * 32 + (vd & 31)]; }
#pragma unroll
      for (int i = 0; i < GLA_SB; ++i) { SIN[(((size_t)db * NC64 + c0 + i) * 4 + h) * 2048 + vd] = f2bf(sv); sv = sv * cd[i] + st[i]; }
    }
  }
}
DEVFN void convert_moe_weights(const Params& p, int l, unsigned char* smem, int bid, int nb);
DEVFN void phase4a(const Params& p, int l, unsigned char* smem) {
  const int n_r = B_ * 8 * NC16 / 4;
  for (int u = BIDX; u < n_r; u += gridDim.x) rwkv_chunk(p, (u) * 4, smem);
  (void)l;
}
DEVFN void phase4b(const Params& p, int l, unsigned char* smem) {
  const int bid = BIDX, nrw = B_ * 8, G = (int)gridDim.x;
  const int n_s = B_ * NC128 * 8, n_g = B_ * NC64 * 4;
  int ob = bid, on = G;
  if (G >= 8 * nrw) {
    if (bid < 4 * nrw) { if ((TIDX >> 6) == 0) rwkv_scan(p, bid >> 2, bid & 3); return; }
    ob = bid - 4 * nrw; on = G - 4 * nrw; }
  else { for (int u = bid; u < nrw; u += G) rwkv_scan(p, u, TIDX >> 6); }
  for (int u = ob; u < n_s + n_g; u += on) { if (u < n_s) ssd_states(p, l, u, smem); else gla_chunk(p, u - n_s, smem); }
  convert_moe_weights(p, l, smem, ob, on);
}
DEVFN void phase4b2(const Params& p) {
  const int bid = BIDX, G = (int)gridDim.x;
  ssd_scan(p, bid * 256 + TIDX, G * 256); gla_scan(p, bid * 256 + TIDX, G * 256);
}
DEVFN void phase4c(const Params& p, int l, unsigned char* smem) {
  const int n_s = B_ * NC128 * 8, n_r = B_ * 8 * NC16 / 4;
  for (int u = BIDX; u < n_s + n_r; u += gridDim.x) { if (u < n_s) ssd_out(p, l, u, smem); else rwkv_out(p, (u - n_s) * 4); }
}

DEVFN void phase5(const Params& p, int l, unsigned char* smem) {
  const int tid = TIDX, lane = tid & 63, wave = tid >> 6;
  const bf16_t* ZX = (const bf16_t*)(p.ws + Ws::ZX);
  const bf16_t* XBC = (const bf16_t*)(p.ws + Ws::XBC);
  const float* YS = (const float*)(p.ws + Ws::YS); const float* YR = (const float*)(p.ws + Ws::YR); const float* OI = (const float*)(p.ws + Ws::OI);
  const bf16_t* QT = (const bf16_t*)(p.ws + Ws::QT); const bf16_t* GSIN = (const bf16_t*)(p.ws + Ws::GSIN);
  const bf16_t* RR = (const bf16_t*)(p.ws + Ws::RR); const bf16_t* VV = (const bf16_t*)(p.ws + Ws::VV); const bf16_t* KD = (const bf16_t*)(p.ws + Ws::KD);
  const float* GATE = (const float*)(p.ws + Ws::GATE);
  bf16_t* YM = (bf16_t*)(p.ws + Ws::YMIX);
  float* red = (float*)smem;
  float* qt = red + 16;
  const float dA = INP(I_SSDD)[(size_t)l * 8 + (tid >> 6)], dB = INP(I_SSDD)[(size_t)l * 8 + 4 + (tid >> 6)];
  const float nwA = INP(I_SSDNW)[(size_t)l * 512 + tid], nwB = INP(I_SSDNW)[(size_t)l * 512 + 256 + tid];
  const float lnw = INP(I_LNXW)[(size_t)l * 256 + tid], lnb = INP(I_LNXB)[(size_t)l * 256 + tid], rk = INP(I_RK)[(size_t)l * 256 + tid];
  const float gnw = INP(I_GNW)[(size_t)l * 256 + tid];
  const int per_ = (NT_ / 2 + (int)gridDim.x - 1) / (int)gridDim.x, tp_lo = BIDX * per_, tp_hi = (tp_lo + per_ < NT_ / 2) ? tp_lo + per_ : NT_ / 2;
  for (int tp = tp_lo; tp < tp_hi; ++tp) {
    float ya[2], yb[2], qa[2], qb[2];
#pragma unroll
    for (int t = 0; t < 2; ++t) { const int tok = tp * 2 + t;
      ya[t] = YS[(size_t)tok * 512 + tid] + dA * bf2f(XBC[(size_t)tok * 1024 + tid]);
      yb[t] = YS[(size_t)tok * 512 + 256 + tid] + dB * bf2f(XBC[(size_t)tok * 1024 + 256 + tid]);
      ya[t] *= siluf_(zxv(ZX, tok, OZ + tid)); yb[t] *= siluf_(zxv(ZX, tok, OZ + 256 + tid));
      qa[t] = wave_sum(ya[t] * ya[t]); qb[t] = wave_sum(yb[t] * yb[t]); }
    __syncthreads();
#pragma unroll
    for (int t = 0; t < 2; ++t) { const int tok = tp * 2 + t;
      if (lane == 0) { red[t * 8 + wave] = qa[t]; red[t * 8 + 4 + wave] = qb[t]; }
      qt[t * 256 + tid] = bf2f(QT[((size_t)(tid >> 7) * NT_ + tok) * 128 + (tid & 127)]); }
    __syncthreads();
#pragma unroll
    for (int t = 0; t < 2; ++t) { const int tok = tp * 2 + t;
      const float* rd = red + t * 8; const float* qtt = qt + t * 256;
      float ma = (rd[0] + rd[1] + rd[2] + rd[3]) * (1.f / 256.f), mb = (rd[4] + rd[5] + rd[6] + rd[7]) * (1.f / 256.f);
      YM[(size_t)tok * 1024 + tid] = f2bf(ya[t] * rsqrtf(ma + 1e-5f) * nwA);
      YM[(size_t)tok * 1024 + 256 + tid] = f2bf(yb[t] * rsqrtf(mb + 1e-5f) * nwB);
      { float y = YR[(size_t)tok * 256 + tid] + YR[((size_t)NT_ + tok) * 256 + tid];
        float mu = wave_sum(y) * (1.f / 64.f), d = y - mu, var = wave_sum(d * d) * (1.f / 64.f);
        float yn = d * rsqrtf(var + 64e-5f) * lnw + lnb;
        float r = bf2f(RR[(size_t)tok * 256 + tid]), kf = bf2f(KD[(size_t)tok * 256 + tid]), kb = bf2f(KD[((size_t)NT_ + tok) * 256 + tid]);
        float bonus = wave_sum(r * (kf + kb) * rk) * bf2f(VV[(size_t)tok * 256 + tid]);
        YM[(size_t)tok * 1024 + 512 + tid] = f2bf((yn + bonus) * GATE[(size_t)tok * 256 + tid]); }
      { float o = OI[(size_t)tok * 256 + tid];
        const int b = tok / T_, co = (tok % T_) / 64;
#pragma unroll
        for (int d = 0; d < 2; ++d) { const int cs = cscan(d, co, CTX_ / 64, SEQ_ / 64);
          const bf16_t* sr = GSIN + ((((size_t)(d * B_ + b) * NC64 + cs) * 4 + wave) * 64 + lane) * 32;
#pragma unroll
          for (int c8 = 0; c8 < 4; ++c8) { bf16x8 sv = ld8(sr + c8 * 8);
#pragma unroll
            for (int jj = 0; jj < 8; ++jj) o += qtt[d * 128 + wave * 32 + c8 * 8 + jj] * bf2f((bf16_t)sv[jj]); } }
        float ms = wave_sum(o * o) * (1.f / 64.f);
        YM[(size_t)tok * 1024 + 768 + tid] = f2bf(o * rsqrtf(ms + 1e-5f) * gnw * siluf_(zxv(ZX, tok, OOG + tid))); } }
  }
}

DEVFN void phase6(const Params& p, int l, unsigned char* smem) {
  const bf16_t* A = (const bf16_t*)(p.ws + Ws::YMIX);
  const bf16_t* W = (const bf16_t*)(p.ws + Ws::WOUT) + (size_t)l * 1024 * 1024;
  float* MIX = (float*)(p.ws + Ws::MIX);
  for (int u = BIDX; u < (NT_ / 128) * 8; u += gridDim.x) {
    int rt = u / 8, ct = u % 8;
    gemm_tile(smem, 1024,
      [&](int r) { return A + (size_t)(rt * 128 + r) * 1024; },
      [&](int r) { return W + (size_t)(ct * 128 + r) * 1024; },
      [&](f32x4 (&acc)[4][4], int wr, int wc, int g, int l15) {
#pragma unroll
        for (int mi = 0; mi < 4; ++mi)
#pragma unroll
          for (int ni = 0; ni < 4; ++ni)
#pragma unroll
            for (int i = 0; i < 4; ++i) MIX[(size_t)(rt * 128 + wr * 64 + mi * 16 + 4 * g + i) * 1024 + ct * 128 + wc * 64 + ni * 16 + l15] = acc[mi][ni][i];
      });
  }
}

DEVFN void phase7(const Params& p, int l, unsigned char* smem) {
  const int lane = TIDX & 63, wave = TIDX >> 6;
  float* X = (float*)(p.ws + Ws::X);
  const float* MIX = (const float*)(p.ws + Ws::MIX);
  bf16_t* H = (bf16_t*)(p.ws + Ws::U);
  const float* rwt = (const float*)(p.ws + Ws::RWT) + (size_t)l * 64 * 1024;
  int* cnt = (int*)(p.ws + Ws::CNT) + l * 64;
  int* ltok = (int*)(p.ws + Ws::LTOK); float* lwt = (float*)(p.ws + Ws::LWT);
  const float rbias = INP(I_RB)[(size_t)l * 64 + lane];
  float* hs = (float*)smem;
  float* lg = hs + 4096;
  for (int tok0 = BIDX * 4; tok0 < NT_; tok0 += gridDim.x * 4) {
    const int tok = tok0 + wave;
    const float* mod = (const float*)(p.ws + Ws::MOD) + ((size_t)l * NR_ + tok_modrow(tok)) * NMOD_;
    float xv[16], t0[16], t1[16], mean, rstd;
    load_row16(X + (size_t)tok * 1024, lane, xv);
    load_row16(MIX + (size_t)tok * 1024, lane, t0);
    load_row16(mod + 2 * 1024, lane, t1);
#pragma unroll
    for (int i = 0; i < 16; ++i) xv[i] = ALPHA_ * xv[i] + t1[i] * t0[i];
    row_stats(xv, mean, rstd);
    load_row16(INP(I_LN1W) + (size_t)l * 1024, lane, t0);
    load_row16(INP(I_LN1B) + (size_t)l * 1024, lane, t1);
#pragma unroll
    for (int i = 0; i < 16; ++i) xv[i] = (xv[i] - mean) * rstd * t0[i] + t1[i];
#pragma unroll
    for (int j = 0; j < 4; ++j) *(float4*)(X + (size_t)tok * 1024 + lane * 4 + 256 * j) = make_float4(xv[4 * j], xv[4 * j + 1], xv[4 * j + 2], xv[4 * j + 3]);
    const bool routed = !(l == DEPTH_ - 1 && (tok % T_) < CTX_);
    row_stats(xv, mean, rstd);
    load_row16(mod + 3 * 1024, lane, t0);
    load_row16(mod + 4 * 1024, lane, t1);
#pragma unroll
    for (int i = 0; i < 16; ++i) xv[i] = (xv[i] - mean) * rstd * (1.f + t1[i]) + t0[i];
    __syncthreads();
#pragma unroll
    for (int j = 0; j < 4; ++j) {
      if (routed) *(uint2*)(H + (size_t)tok * 1024 + lane * 4 + 256 * j) = make_uint2((unsigned)f2bf(xv[4 * j]) | ((unsigned)f2bf(xv[4 * j + 1]) << 16), (unsigned)f2bf(xv[4 * j + 2]) | ((unsigned)f2bf(xv[4 * j + 3]) << 16));
      *(float4*)(hs + wave * 1024 + lane * 4 + 256 * j) = make_float4(xv[4 * j], xv[4 * j + 1], xv[4 * j + 2], xv[4 * j + 3]); }
    __syncthreads();
    { float hv[4][16];
#pragma unroll
      for (int t = 0; t < 4; ++t)
#pragma unroll
        for (int j = 0; j < 4; ++j) { const float4 v = *(const float4*)(hs + t * 1024 + lane * 4 + 256 * j); hv[t][4 * j] = v.x; hv[t][4 * j + 1] = v.y; hv[t][4 * j + 2] = v.z; hv[t][4 * j + 3] = v.w; }
      float pe[64];
#pragma unroll
      for (int e = 0; e < 16; ++e) {
        float4 w[4];
#pragma unroll
        for (int j = 0; j < 4; ++j) w[j] = *(const float4*)(rwt + (size_t)(16 * wave + e) * 1024 + lane * 4 + 256 * j);
#pragma unroll
        for (int t = 0; t < 4; ++t) { float sacc = 0.f;
#pragma unroll
          for (int j = 0; j < 4; ++j) sacc += hv[t][4 * j] * w[j].x + hv[t][4 * j + 1] * w[j].y + hv[t][4 * j + 2] * w[j].z + hv[t][4 * j + 3] * w[j].w;
          pe[e * 4 + t] = sacc; } }
#pragma unroll
      for (int half = 32; half >= 1; half >>= 1) { const bool up = (lane & half) != 0;
#pragma unroll
        for (int e = 0; e < half; ++e) { const float send = up ? pe[e] : pe[e + half]; const float recv = __shfl_xor(send, half); pe[e] = (up ? pe[e + half] : pe[e]) + recv; } }
      lg[(lane & 3) * 64 + 16 * wave + (lane >> 2)] = pe[0]; }
    __syncthreads();
    if (!routed) continue;
    const float logit = lg[wave * 64 + lane];
    const float score = sigmoidf_(logit), sel = score + rbias;
    float m1 = sel; int a1 = lane;
#pragma unroll
    for (int m = 1; m <= 4; m <<= 1) { float ov = __shfl_xor(m1, m); int oa = __shfl_xor(a1, m); if (ov > m1 || (ov == m1 && oa < a1)) { m1 = ov; a1 = oa; } }
    float m2 = (lane == a1) ? -3.0e38f : sel;
#pragma unroll
    for (int m = 1; m <= 4; m <<= 1) m2 = fmaxf(m2, __shfl_xor(m2, m));
    const float gs = m1 + m2; const int grp = lane >> 3;
    int grank = 0;
#pragma unroll
    for (int g2 = 0; g2 < 8; ++g2) { float og = __shfl(gs, g2 * 8); grank += (og > gs || (og == gs && g2 < grp)) ? 1 : 0; }
    const bool gsel = grank < 4;
    const float msel = gsel ? sel : -3.0e38f;
    int rank = 0;
    for (int e = 0; e < 64; ++e) { float ov = __shfl(msel, e); rank += (ov > msel || (ov == msel && e < lane)) ? 1 : 0; }
    const bool chosen = gsel && rank < 8;
    const float wsum = wave_sum(chosen ? score : 0.f);
    if (chosen) { int pos = atomicAdd(&cnt[lane], 1); ltok[(size_t)lane * NT_ + pos] = tok * 8 + rank; lwt[(size_t)lane * NT_ + pos] = score / wsum * 2.5f; }
  }
}

struct MoeMap { int nblk_total; int e; int rb; int cnt; int hoff; };
DEVFN int moe_ntok(int l) { return l == DEPTH_ - 1 ? B_ * SEQ_ : NT_; }
DEVFN int moe_shared_tok(int l, int i) { return l == DEPTH_ - 1 ? (i / SEQ_) * T_ + CTX_ + (i % SEQ_) : i; }
DEVFN void moe_prefix(const Params& p, int l, int* pre) {
  const int* cnt = (const int*)(p.ws + Ws::CNT) + l * 64;
  __syncthreads();
  if (TIDX == 0) { int s = 0; for (int e = 0; e < 65; ++e) { pre[e] = s; int c = e < 64 ? cnt[e] : moe_ntok(l); pre[66 + e] = c; s += (c + 127) / 128; } pre[65] = s; }
  __syncthreads();
}
DEVFN void phase8(const Params& p, int l, unsigned char* smem) {
  int* pre = (int*)(smem + SM_PRE);
  moe_prefix(p, l, pre);
  const bf16_t* H = (const bf16_t*)(p.ws + Ws::U);
  const bf16_t* W13 = (const bf16_t*)(p.ws + Ws::W13);
  bf16_t* HID = (bf16_t*)(p.ws + Ws::HID);
  const int* ltok = (const int*)(p.ws + Ws::LTOK); const float* lwt = (const float*)(p.ws + Ws::LWT);
  const int total = pre[65];
  for (int u = BIDX; u < total * 4; u += gridDim.x) {
    const int gb = u >> 2, nt = u & 3;
    int e = 0; while (pre[e + 1] <= gb) ++e;
    const int rb = gb - pre[e], cnt = pre[66 + e];
    gemm_tile(smem, 1024,
      [&](int r) { int pos = rb * 128 + r; if (pos >= cnt) return (const bf16_t*)(p.ws + Ws::ZROW); int tok = e < 64 ? (ltok[(size_t)e * NT_ + pos] >> 3) : moe_shared_tok(l, pos); return H + (size_t)tok * 1024; },
      [&](int r) { return W13 + ((size_t)e * 512 + nt * 128 + r) * 1024; },
      [&](f32x4 (&acc)[4][4], int wr, int wc, int g, int l15) {
        tile_store_bf16<8>(smem, wr, g, l15,
          [&](bf16_t* T, int ldc) {
#pragma unroll
            for (int mi = 0; mi < 4; ++mi)
#pragma unroll
              for (int i = 0; i < 4; ++i) { const int r = wr * 64 + mi * 16 + 4 * g + i, pos = rb * 128 + r;
                const float gw = pos < cnt ? (e < 64 ? lwt[(size_t)e * NT_ + pos] : 1.f) : 0.f;
#pragma unroll
                for (int j = 0; j < 2; ++j) T[r * ldc + wc * 32 + j * 16 + l15] = f2bf(siluf_(acc[mi][2 * j][i]) * acc[mi][2 * j + 1][i] * gw); } },
          [&](int row, int c0) { const int pos = rb * 128 + row; return pos < cnt ? HID + ((size_t)gb * 128 + row) * 256 + nt * 64 + c0 : (bf16_t*)nullptr; });
      });
  }
}
DEVFN void phase9(const Params& p, int l, unsigned char* smem) {
  int* pre = (int*)(smem + SM_PRE);
  moe_prefix(p, l, pre);
  const bf16_t* HID = (const bf16_t*)(p.ws + Ws::HID);
  const bf16_t* W2T = (const bf16_t*)(p.ws + Ws::W2T);
  bf16_t* YB = (bf16_t*)(p.ws + Ws::YBUF);
  const int* ltok = (const int*)(p.ws + Ws::LTOK);
  const int total = pre[65];
  for (int u = BIDX; u < total * 8; u += gridDim.x) {
    const int gb = u >> 3, nt = u & 7;
    int e = 0; while (pre[e + 1] <= gb) ++e;
    const int rb = gb - pre[e], cnt = pre[66 + e];
    gemm_tile(smem, 256,
      [&](int r) { int pos = rb * 128 + r; return pos < cnt ? HID + ((size_t)gb * 128 + r) * 256 : (const bf16_t*)(p.ws + Ws::ZROW); },
      [&](int r) { return W2T + ((size_t)e * 1024 + nt * 128 + r) * 256; },
      [&](f32x4 (&acc)[4][4], int wr, int wc, int g, int l15) {
        tile_store_bf16<16>(smem, wr, g, l15,
          [&](bf16_t* T, int ldc) {
#pragma unroll
            for (int mi = 0; mi < 4; ++mi)
#pragma unroll
              for (int ni = 0; ni < 4; ++ni)
#pragma unroll
                for (int i = 0; i < 4; ++i) T[(wr * 64 + mi * 16 + 4 * g + i) * ldc + wc * 64 + ni * 16 + l15] = f2bf(acc[mi][ni][i]); },
          [&](int row, int c0) { const int pos = rb * 128 + row; if (pos >= cnt) return (bf16_t*)nullptr;
            const int ts = e < 64 ? ltok[(size_t)e * NT_ + pos] : moe_shared_tok(l, pos) * 8; const int tok = ts >> 3, slot = e < 64 ? (ts & 7) : 8;
            return YB + ((size_t)tok * NSLOT + slot) * 1024 + nt * 128 + c0; });
      });
  }
}

#define SMEM_BYTES (PH_SMEM + 2048)
#define N_PHASES (3 + 13 * DEPTH_)
__global__ void __launch_bounds__(256, 2) mega(Params p, int ph_lo, int ph_hi) {
#ifdef HIPEMU
  unsigned char* smem = hipemu::cur_smem();
#else
  unsigned char* smem = smem_dyn;
  volatile LAS unsigned* st = (volatile LAS unsigned*)(smem_dyn + SM_BAR);
  if (threadIdx.x == 0) {
    st[0] = 0u; st[1] = 0u;
    unsigned long long* tab = (unsigned long long*)(smem_dyn + SM_TAB);
#pragma unroll
    for (int i = 0; i < 40; ++i) tab[i] = (unsigned long long)p.in[i];
  }
  __syncthreads();
  XcdBarrier bar = xcd_barrier_post((unsigned*)(p.ws + Ws::BAR), st);
#define GRID_SYNC() xcd_barrier(bar)
#endif
  int ph = 0;
#ifdef ONLY_KIND
#define KIND_ON(k) ((k) == ONLY_KIND)
#else
#define KIND_ON(k) 1
#endif
#ifndef REPEAT_MASK
#define REPEAT_MASK 0u
#endif
#define RUN_PHASE(kind, code) { if (KIND_ON(kind) && ph >= ph_lo && ph < ph_hi) { \
    int nrep_ = ((REPEAT_MASK >> (kind)) & 1u) ? 2 : 1; LAUNDER(nrep_); \
    _Pragma("unroll 1") for (int rep_ = 0; rep_ < nrep_; ++rep_) { LAUNDER(p.ws); LAUNDER(p.out); code; if (rep_ + 1 < nrep_ || ph + 1 < ph_hi) { GRID_SYNC(); } } } ++ph; }
  RUN_PHASE(0, phase0(p, smem));
  RUN_PHASE(11, phase0b(p));
  for (int l = 0; l < DEPTH_; ++l) {
    RUN_PHASE(1, phase1(p, l));
    RUN_PHASE(2, phase2(p, l, smem));
    RUN_PHASE(3, phase3(p, l, smem));
    RUN_PHASE(14, phase3b(p, l, smem));
    RUN_PHASE(4, phase4a(p, l, smem));
    RUN_PHASE(12, phase4b(p, l, smem));
    RUN_PHASE(16, phase4b2(p));
    RUN_PHASE(13, phase4c(p, l, smem));
    RUN_PHASE(5, phase5(p, l, smem));
    RUN_PHASE(6, phase6(p, l, smem));
    RUN_PHASE(7, phase7(p, l, smem));
    RUN_PHASE(8, phase8(p, l, smem));
    RUN_PHASE(9, phase9(p, l, smem));
  }
  RUN_PHASE(10, phase_final(p));
}

extern "C" void kernel_launch(void* const* d_in, const int* in_sizes, int n_in, void* d_out, int out_size, void* d_ws, size_t ws_size, hipStream_t stream) {
  Params p{};
  for (int i = 0; i < 40; ++i) p.in[i] = (const float*)d_in[i];
  p.out = (float*)d_out;
  p.ws = (unsigned char*)d_ws;
  if (ws_size < Ws::END) { fprintf(stderr, "workspace too small: %zu < %zu\n", ws_size, (size_t)Ws::END); return; }
  hipMemsetAsync(d_ws, 0, Ws::ZERO_END, stream);
#ifdef HIPEMU
  int grid = 16; if (const char* e = getenv("EMU_GRID")) grid = atoi(e);
  int stop = N_PHASES; if (const char* e = getenv("EMU_STOP")) stop = atoi(e);
  if (getenv("EMU_ONE")) hipemu::launch(grid, 256, SMEM_BYTES, true, [=] { mega(p, 0, stop); });
  else for (int ph = 0; ph < stop; ++ph) hipemu::launch(grid, 256, SMEM_BYTES, false, [=] { mega(p, ph, ph + 1); });
#else
  static int grid = 0;
  if (!grid) {
    int dev = 0, cus = 0, per_cu = 0;
    hipGetDevice(&dev);
    hipDeviceGetAttribute(&cus, hipDeviceAttributeMultiprocessorCount, dev);
    hipOccupancyMaxActiveBlocksPerMultiprocessor(&per_cu, mega, 256, SMEM_BYTES);
    if (per_cu > 2) per_cu = 2;
    if (per_cu < 1) per_cu = 1;
    grid = cus * per_cu;
  }
#if N_LAUNCH_MODE == 1
  mega<<<grid, 256, SMEM_BYTES, stream>>>(p, 0, N_PHASES);
#else
  for (int ph = 0; ph < N_PHASES; ++ph) mega<<<grid, 256, SMEM_BYTES, stream>>>(p, ph, ph + 1);
#endif
#endif
}
```

```cpp
#ifndef HIPEMU
#include <hip/hip_runtime.h>
#endif
#include <stdint.h>
#include <stdio.h>

#ifndef B_
#define B_ 4
#endif
#ifndef SEQ_
#define SEQ_ 4096
#endif
#ifndef CTX_
#define CTX_ 256
#endif
#ifndef DEPTH_
#define DEPTH_ 4
#endif
#ifndef N_LAUNCH_MODE
#define N_LAUNCH_MODE 1
#endif
#define T_ (SEQ_ + CTX_)
#define NT_ (B_ * T_)
#define D_ 1024
#define NIN_ 3504
#define NMOD_ 6144
#define NR_ (B_ + 1)
#define OZ 0
#define OXBC 512
#define ODT 1536
#define ORW 1552
#define OGQ 2704
#define OGK 2832
#define OGV 2960
#define OGD 3216
#define OOG 3248
#define ALPHA_ 1.681792830507429f
#define NEXP 64
#define NSLOT 9
#define NC128 (T_ / 128)
#define NC64 (T_ / 64)
#define NC16 (T_ / 16)

#define DEVFN __device__ __forceinline__
#define LDT 72
#define GEMM_SMEM (2 * 128 * LDT * 2)
typedef unsigned short bf16_t;
#ifdef HIPEMU
#define AS1
#else
#define AS1 __attribute__((address_space(1)))
#endif
typedef unsigned u32x4 __attribute__((ext_vector_type(4)));
typedef unsigned u32x2 __attribute__((ext_vector_type(2)));

#ifdef HIPEMU
typedef emu_bf16x8 bf16x8;
typedef emu_f32x4 f32x4;
#define MFMA16(a, b, c) emu_mfma_16x16x32_bf16(a, b, c)
#define MFMA16K16(a, b, c) emu_mfma_16x16x16_bf16(a, b, c)
#define GRID_SYNC() hipemu::grid_sync()
#else
typedef short bf16x8 __attribute__((ext_vector_type(8)));
typedef float f32x4 __attribute__((ext_vector_type(4)));
#define MFMA16(a, b, c) __builtin_amdgcn_mfma_f32_16x16x32_bf16(a, b, c, 0, 0, 0)
#define MFMA16K16(a, b, c) __builtin_amdgcn_mfma_f32_16x16x16bf16_1k(a, b, c, 0, 0, 0)
#endif

DEVFN float bf2f(bf16_t h) { return __builtin_bit_cast(float, (unsigned)h << 16); }
DEVFN bf16_t f2bf(float f) { unsigned u = __builtin_bit_cast(unsigned, f); u += 0x7FFFu + ((u >> 16) & 1u); return (bf16_t)(u >> 16); }
template <class T> DEVFN AS1 T* gptr(T* q) { return (AS1 T*)q; }
DEVFN bf16x8 ld8g(const bf16_t* q) { return *(const AS1 bf16x8*)gptr(q); }
DEVFN float sigmoidf_(float x) { return 1.f / (1.f + expf(-x)); }
DEVFN float siluf_(float x) { return x / (1.f + expf(-x)); }
DEVFN float softplusf_(float x) { return x > 20.f ? x : log1pf(expf(x)); }
DEVFN float logsigmoidf_(float x) { return fminf(x, 0.f) - log1pf(expf(-fabsf(x))); }
DEVFN float wave_sum(float v) { for (int m = 32; m >= 1; m >>= 1) v += __shfl_xor(v, m); return v; }

constexpr size_t al(size_t x) { return (x + 255) & ~(size_t)255; }
struct Ws {
  static constexpr size_t BAR = 0;
  static constexpr size_t CNT = 16384;
  static constexpr size_t MOD = CNT + 4096;
  static constexpr size_t ZROW = al(MOD + (size_t)DEPTH_ * NR_ * NMOD_ * 4);
  static constexpr size_t ZERO_END = al(ZROW + 2048);
  static constexpr size_t MODP = ZERO_END;
  static constexpr size_t RWT = al(MODP + (size_t)16 * DEPTH_ * NR_ * NMOD_ * 4);
  static constexpr size_t LORA = al(RWT + (size_t)DEPTH_ * 64 * 1024 * 4);
  static constexpr size_t X = al(LORA + (size_t)DEPTH_ * 98304 * 2);
  static constexpr size_t U = al(X + (size_t)NT_ * 1024 * 4);
  static constexpr size_t YMIX = al(U + (size_t)NT_ * 1024 * 2);
  static constexpr size_t ZX = al(YMIX + (size_t)NT_ * 1024 * 2);
  static constexpr size_t MIX = ZX;
  static constexpr size_t LTOK = al(ZX + (size_t)NT_ * NIN_ * 2);
  static constexpr size_t LWT = al(LTOK + (size_t)64 * NT_ * 4);
  static constexpr size_t WIN = al(LWT + (size_t)64 * NT_ * 4);
  static constexpr size_t WOUT = al(WIN + (size_t)DEPTH_ * NIN_ * 1024 * 2);
  static constexpr size_t W13 = al(WOUT + (size_t)DEPTH_ * 1024 * 1024 * 2);
  static constexpr size_t W2T = al(W13 + (size_t)65 * 512 * 1024 * 2);
  static constexpr size_t UNI = al(W2T + (size_t)65 * 1024 * 256 * 2);
  static constexpr size_t XBC = UNI;
  static constexpr size_t XBCT = al(XBC + (size_t)NT_ * 1024 * 2);
  static constexpr size_t DTB = al(XBCT + (size_t)NT_ * 768 * 2);
  static constexpr size_t SST = al(DTB + (size_t)NT_ * 16 * 4);
  static constexpr size_t SCD = al(SST + (size_t)2 * NT_ / 128 * 8 * 8192 * 4);
  static constexpr size_t HIN = al(SCD + (size_t)2 * NT_ / 128 * 8 * 4);
  static constexpr size_t YS = SST;
  static constexpr size_t LA = al(HIN + (size_t)2 * NT_ / 128 * 8 * 8192 * 2);
  static constexpr size_t VT = al(LA + (size_t)2 * NT_ * 128 * 4);
  static constexpr size_t QT = al(VT + (size_t)NT_ * 256 * 2);
  static constexpr size_t OI = al(QT + (size_t)2 * NT_ * 128 * 2);
  static constexpr size_t GST = al(OI + (size_t)NT_ * 256 * 4);
  static constexpr size_t GCD = al(GST + (size_t)2 * NT_ / 64 * 4 * 2048 * 4);
  static constexpr size_t GSIN = al(GCD + (size_t)2 * NT_ / 64 * 4 * 32 * 4);
  static constexpr size_t RR = al(GSIN + (size_t)2 * NT_ / 64 * 4 * 2048 * 2);
  static constexpr size_t VV = RR + (size_t)NT_ * 256 * 2;
  static constexpr size_t KK = VV + (size_t)NT_ * 256 * 2;
  static constexpr size_t KD = KK + (size_t)NT_ * 256 * 2;
  static constexpr size_t BD = KD + (size_t)2 * NT_ * 256 * 2;
  static constexpr size_t LW = BD + (size_t)2 * NT_ * 256 * 2;
  static constexpr size_t GATE = LW + (size_t)2 * NT_ * 256 * 4;
  static constexpr size_t YR = GATE + (size_t)NT_ * 256 * 4;
  static constexpr size_t RML = al(YR + (size_t)2 * NT_ * 256 * 4);
  static constexpr size_t RNS = RML + (size_t)(NT_ / 16) * 8 * 4096 * 2;
  static constexpr size_t RWC = RNS + (size_t)(NT_ / 16) * 8 * 4096 * 2;
  static constexpr size_t RG = RWC + (size_t)(NT_ / 16) * 8 * 64 * 4;
  static constexpr size_t RY0 = RG + (size_t)(NT_ / 16) * 8 * 1024 * 2;
  static constexpr size_t LI = RY0 + (size_t)(NT_ / 16) * 8 * 1024 * 4;
  static constexpr size_t KRW = LI + (size_t)NT_ * 384 * 2;
  static constexpr size_t MIXER_END = KRW + (size_t)NT_ * 256 * 2;
  static constexpr size_t HID = UNI;
  static constexpr size_t YBUF = al(HID + ((size_t)NT_ * 9 + 65 * 128) * 256 * 2);
  static constexpr size_t MOE_END = YBUF + (size_t)NT_ * 9 * 1024 * 2;
  static constexpr size_t END = al(MIXER_END > MOE_END ? MIXER_END : MOE_END);
};

struct Params {
  const float* in[40];
  float* out;
  unsigned char* ws;
};
enum { I_X = 0, I_C, I_CTX, I_CCTX, I_ADAW, I_ADAB, I_WIN, I_CONVW, I_CONVB, I_DTBIAS, I_ALOG, I_SSDD, I_SSDNW, I_MU, I_W0, I_W2, I_A0, I_A2,
       I_G2, I_KKW, I_KAW, I_RK, I_LNXW, I_LNXB, I_GU, I_GB, I_GNW, I_WOUT, I_LN1W, I_LN1B, I_LN2W, I_LN2B, I_RW, I_RB, I_EW1, I_EW3, I_EW2,
       I_SW1, I_SW3, I_SW2 };

#define PH_SMEM 47104
#define SM_PRE (PH_SMEM)
#define SM_TAB (PH_SMEM + 1024)
#define SM_BAR (PH_SMEM + 2032)
#ifdef HIPEMU
#define INP(i) (p.in[i])
#define LAUNDER(x)
#define TIDX ((int)threadIdx.x)
#define BIDX ((int)blockIdx.x)
#define LAUNDER_V(x)
#else
extern __shared__ __align__(16) unsigned char smem_dyn[];
DEVFN const float* inp_lds(int i) {
  const volatile unsigned* t = (const volatile unsigned*)(smem_dyn + SM_TAB) + 2 * i;
  unsigned lo = __builtin_amdgcn_readfirstlane(t[0]), hi = __builtin_amdgcn_readfirstlane(t[1]);
  return (const float*)(((unsigned long long)hi << 32) | lo);
}
#define INP(i) inp_lds(i)
#define LAUNDER(x) asm volatile("" : "+s"(x))
DEVFN int tidx_() { int t = threadIdx.x; asm volatile("" : "+v"(t)); return t; }
DEVFN int bidx_() { int b = blockIdx.x; asm volatile("" : "+s"(b)); return b; }
#define TIDX tidx_()
#define LAUNDER_V(x) asm volatile("" : "+v"(x))
#define BIDX bidx_()
#endif
#ifndef HIPEMU
#define XB_TMO      128
#define XB_XCNT(j)  (256  + 64 * (j))
#define XB_XSUB(j)  (1280 + 64 * (j))
#define XB_XGEN(j)  (2304 + 64 * (j))
#define XB_TOP      3328
#define XB_TOPGEN   3392
#define XCD_BAR_WORDS 3456
#define XB_SPIN_CAP (1u << 22)
#define LAS __attribute__((address_space(3)))
__device__ __forceinline__ unsigned xb_ld(unsigned* p)              { return __hip_atomic_load(p, __ATOMIC_RELAXED, __HIP_MEMORY_SCOPE_AGENT); }
__device__ __forceinline__ unsigned xb_add(unsigned* p, unsigned v) { return __hip_atomic_fetch_add(p, v, __ATOMIC_RELAXED, __HIP_MEMORY_SCOPE_AGENT); }
__device__ __forceinline__ unsigned xb_xcc_id() { return (unsigned)__builtin_amdgcn_s_getreg((3 << 11) | 20) & 0xFu; }
#define XB_SPIN(cond, bar) do { unsigned _sp = 0; while (cond) { __builtin_amdgcn_s_sleep(1); \
    if ((++_sp & 255u) == 0u) { if (xb_ld(&(bar)[XB_TMO])) break; if (_sp > XB_SPIN_CAP) { atomicAdd(&(bar)[XB_TMO], 1u); break; } } } } while (0)
struct XcdBarrier { unsigned* bar; unsigned x; volatile LAS unsigned* st; };
__device__ __forceinline__ XcdBarrier xcd_barrier_post(unsigned* bar, volatile LAS unsigned* st) {
    XcdBarrier b; b.bar = bar; b.x = xb_xcc_id(); b.st = st;
    if (threadIdx.x == 0) (void)xb_add(&bar[XB_XCNT(b.x)], 1u);
    return b;
}
__device__ __forceinline__ void xcd_barrier_complete(unsigned* bar, unsigned x, unsigned& nloc, unsigned& nx) {
    const unsigned G = gridDim.x * gridDim.y * gridDim.z;
    unsigned sum, cnt, mine, sp = 0u;
    for (;;) {
        sum = 0u; cnt = 0u; mine = 0u;
#pragma unroll
        for (unsigned j = 0; j < 16; ++j) { const unsigned c = xb_ld(&bar[XB_XCNT(j)]); sum += c; cnt += (c > 0u) ? 1u : 0u; mine = (j == x) ? c : mine; }
        if (sum == G) break;
        __builtin_amdgcn_s_sleep(1);
        if ((++sp & 255u) == 0u) { if (xb_ld(&bar[XB_TMO])) break; if (sp > XB_SPIN_CAP) { atomicAdd(&bar[XB_TMO], 1u); break; } }
    }
    nloc = mine > 0u ? mine : 1u; nx = cnt > 0u ? cnt : 1u;
}
__device__ __forceinline__ void xcd_barrier(const XcdBarrier& b) {
    asm volatile("s_waitcnt vmcnt(0)" ::: "memory");
    __syncthreads();
    if (threadIdx.x == 0) {
        unsigned* bar = b.bar;
        __builtin_amdgcn_s_waitcnt(0);
        unsigned nloc = b.st[0], nx = b.st[1];
        if (nloc == 0u) { xcd_barrier_complete(bar, b.x, nloc, nx); b.st[0] = nloc; b.st[1] = nx; }
        const unsigned old = xb_add(&bar[XB_XSUB(b.x)], 1u);
        const unsigned gen = old / nloc;
        if (old + 1u == (gen + 1u) * nloc) {
            __builtin_amdgcn_fence(__ATOMIC_RELEASE, "agent");
            asm volatile("s_waitcnt vmcnt(0)" ::: "memory");
            const unsigned og = xb_add(&bar[XB_TOP], 1u);
            const unsigned tg = og / nx;
            if (og + 1u == (tg + 1u) * nx) xb_add(&bar[XB_TOPGEN], 1u);
            else XB_SPIN(xb_ld(&bar[XB_TOPGEN]) == tg, bar);
            __builtin_amdgcn_fence(__ATOMIC_ACQUIRE, "agent");
            xb_add(&bar[XB_XGEN(b.x)], 1u);
            asm volatile("s_waitcnt vmcnt(0)" ::: "memory");
        } else {
            XB_SPIN(xb_ld(&bar[XB_XGEN(b.x)]) == gen, bar);
            __builtin_amdgcn_fence(__ATOMIC_ACQUIRE, "agent");
            asm volatile("s_waitcnt vmcnt(0)" ::: "memory");
        }
    }
    __syncthreads();
}
#endif

DEVFN int tokmap(int dir, int p) { return dir == 0 ? p : (p < CTX_ ? CTX_ - 1 - p : 2 * CTX_ + SEQ_ - 1 - p); }
DEVFN const float* tok_input_row(const Params& p, int tok) {
  int b = tok / T_, t = tok % T_;
  return t < CTX_ ? INP(I_CTX) + ((size_t)b * CTX_ + t) * D_ : INP(I_X) + ((size_t)b * SEQ_ + (t - CTX_)) * D_;
}
DEVFN int tok_modrow(int tok) { return (tok % T_) < CTX_ ? B_ : tok / T_; }

template <class ARow, class BRow, class Epi>
DEVFN void gemm_tile(unsigned char* smem, int K, ARow arow, BRow brow, Epi epi) {
  bf16_t* As = (bf16_t*)smem;
  bf16_t* Bs = As + 128 * LDT;
  const int tid = TIDX, lane = tid & 63, wave = tid >> 6, wr = wave >> 1, wc = wave & 1;
  const int g = lane >> 4, l15 = lane & 15;
  const int lr = tid >> 3, lc = (tid & 7) * 8;
  const AS1 bf16_t* ap[4];
  const AS1 bf16_t* bp[4];
#pragma unroll
  for (int i = 0; i < 4; ++i) { ap[i] = gptr(arow(lr + 32 * i)); bp[i] = gptr(brow(lr + 32 * i)); }
  f32x4 acc[4][4];
#pragma unroll
  for (int mi = 0; mi < 4; ++mi)
#pragma unroll
    for (int ni = 0; ni < 4; ++ni) acc[mi][ni] = f32x4{0.f, 0.f, 0.f, 0.f};
  u32x4 ra0[4], rb0[4], ra1[4], rb1[4];
#pragma unroll
  for (int i = 0; i < 4; ++i) { ra0[i] = *(const AS1 u32x4*)(ap[i] + lc); rb0[i] = *(const AS1 u32x4*)(bp[i] + lc); }
  if (K > 64) {
#pragma unroll
    for (int i = 0; i < 4; ++i) { ra1[i] = *(const AS1 u32x4*)(ap[i] + 64 + lc); rb1[i] = *(const AS1 u32x4*)(bp[i] + 64 + lc); } }
  auto compute = [&]() {
#pragma unroll
    for (int kk = 0; kk < 2; ++kk) {
      bf16x8 af[4], bfr[4];
#pragma unroll
      for (int mi = 0; mi < 4; ++mi) af[mi] = *(const bf16x8*)(As + (wr * 64 + mi * 16 + l15) * LDT + kk * 32 + g * 8);
#pragma unroll
      for (int ni = 0; ni < 4; ++ni) bfr[ni] = *(const bf16x8*)(Bs + (wc * 64 + ni * 16 + l15) * LDT + kk * 32 + g * 8);
#pragma unroll
      for (int mi = 0; mi < 4; ++mi)
#pragma unroll
        for (int ni = 0; ni < 4; ++ni) acc[mi][ni] = MFMA16(af[mi], bfr[ni], acc[mi][ni]);
    } };
  for (int k0 = 0; k0 < K; k0 += 128) {
    __syncthreads();
#pragma unroll
    for (int i = 0; i < 4; ++i) { *(u32x4*)(As + (lr + 32 * i) * LDT + lc) = ra0[i]; *(u32x4*)(Bs + (lr + 32 * i) * LDT + lc) = rb0[i]; }
    __syncthreads();
    if (k0 + 128 < K) {
#pragma unroll
      for (int i = 0; i < 4; ++i) { ra0[i] = *(const AS1 u32x4*)(ap[i] + k0 + 128 + lc); rb0[i] = *(const AS1 u32x4*)(bp[i] + k0 + 128 + lc); } }
    compute();
    if (k0 + 64 < K) {
      __syncthreads();
#pragma unroll
      for (int i = 0; i < 4; ++i) { *(u32x4*)(As + (lr + 32 * i) * LDT + lc) = ra1[i]; *(u32x4*)(Bs + (lr + 32 * i) * LDT + lc) = rb1[i]; }
      __syncthreads();
      if (k0 + 192 < K) {
#pragma unroll
        for (int i = 0; i < 4; ++i) { ra1[i] = *(const AS1 u32x4*)(ap[i] + k0 + 192 + lc); rb1[i] = *(const AS1 u32x4*)(bp[i] + k0 + 192 + lc); } }
      compute();
    }
  }
  epi(acc, wr, wc, g, l15);
}

template <int NCH, class Val, class RowP>
DEVFN void tile_store_bf16(unsigned char* smem, int wr, int g, int l15, Val val, RowP rowp) {
  constexpr int LDC = NCH * 8 + 8;
  bf16_t* T = (bf16_t*)smem;
  const int tid = TIDX;
  __syncthreads();
  val(T, LDC);
  __syncthreads();
#pragma unroll
  for (int pass = 0; pass < NCH / 2; ++pass) { const int id = tid + 256 * pass, row = id / NCH, c = id % NCH;
    bf16_t* dst = rowp(row, c * 8);
    if (dst) *(AS1 u32x4*)gptr(dst) = *(const u32x4*)(T + row * LDC + c * 8); }
  (void)wr; (void)g; (void)l15;
}
DEVFN void cvt_tile(unsigned char* smem, const float* src, int K, int N, int k0, int n0, bf16_t* dst, int ldd, int mode) {
  float* s = (float*)smem;
  const int tid = TIDX;
  const AS1 float* gsrc = gptr(src);
  __syncthreads();
  { const int kk = tid >> 4, n4 = (tid & 15) * 4;
#pragma unroll
    for (int pass = 0; pass < 4; ++pass) { const int k = kk + 16 * pass;
      f32x4 v = f32x4{0.f, 0.f, 0.f, 0.f};
      if (n0 + n4 < N) v = *(const AS1 f32x4*)(gsrc + (size_t)(k0 + k) * N + n0 + n4);
      s[k * 65 + n4] = v[0]; s[k * 65 + n4 + 1] = v[1]; s[k * 65 + n4 + 2] = v[2]; s[k * 65 + n4 + 3] = v[3]; } }
  __syncthreads();
  { const int nn = tid >> 2, k16 = (tid & 3) * 16, n = n0 + nn;
    if (n < N) { const int row = mode == 0 ? n : ((n >> 4) * 32 + (n & 15) + (mode == 2 ? 16 : 0));
      u32x4 o0, o1;
#pragma unroll
      for (int j = 0; j < 4; ++j) { o0[j] = (unsigned)f2bf(s[(k16 + 2 * j) * 65 + nn]) | ((unsigned)f2bf(s[(k16 + 2 * j + 1) * 65 + nn]) << 16);
        o1[j] = (unsigned)f2bf(s[(k16 + 8 + 2 * j) * 65 + nn]) | ((unsigned)f2bf(s[(k16 + 9 + 2 * j) * 65 + nn]) << 16); }
      AS1 bf16_t* d = gptr(dst) + (size_t)row * ldd + k0 + k16;
      *(AS1 u32x4*)d = o0; *(AS1 u32x4*)(d + 8) = o1; } }
  (void)K;
}
DEVFN void convert_moe_weights(const Params& p, int l, unsigned char* smem, int bid, int nb) {
  bf16_t* w13 = (bf16_t*)(p.ws + Ws::W13);
  bf16_t* w2t = (bf16_t*)(p.ws + Ws::W2T);
  const int per_e = 192;
  for (int u = bid; u < 65 * per_e; u += nb) {
    int e = u / per_e, r = u % per_e, which = r / 64, t = r % 64;
    if (which < 2) {
      const float* src = e < 64 ? (which == 0 ? INP(I_EW1) : INP(I_EW3)) + ((size_t)l * 64 + e) * 1024 * 256 : (which == 0 ? INP(I_SW1) : INP(I_SW3)) + (size_t)l * 1024 * 256;
      cvt_tile(smem, src, 1024, 256, (t >> 2) * 64, (t & 3) * 64, w13 + (size_t)e * 512 * 1024, 1024, which == 0 ? 1 : 2);
    } else {
      const float* src = e < 64 ? INP(I_EW2) + ((size_t)l * 64 + e) * 256 * 1024 : INP(I_SW2) + (size_t)l * 256 * 1024;
      cvt_tile(smem, src, 256, 1024, (t >> 4) * 64, (t & 15) * 64, w2t + (size_t)e * 1024 * 256, 256, 0);
    }
  }
}
DEVFN void phase0(const Params& p, unsigned char* smem) {
  const int tid = TIDX;
  float* modp = (float*)(p.ws + Ws::MODP);
  for (int u = BIDX; u < DEPTH_ * 24 * 16; u += gridDim.x) {
    int l = u / (24 * 16), jb = (u / 16) % 24, ks = u % 16;
    float* sc = (float*)smem;
    __syncthreads();
    for (int e = tid; e < NR_ * 64; e += 256) { int r = e / 64, i = ks * 64 + (e % 64); float cv = r < B_ ? INP(I_C)[(size_t)r * D_ + i] : INP(I_CCTX)[i]; sc[e] = siluf_(cv); }
    __syncthreads();
    int j = jb * 256 + tid;
    float acc[NR_];
#pragma unroll
    for (int r = 0; r < NR_; ++r) acc[r] = 0.f;
    const float* w = INP(I_ADAW) + ((size_t)l * D_ + ks * 64) * NMOD_ + j;
#pragma unroll 4
    for (int i = 0; i < 64; ++i) { float wv = w[(size_t)i * NMOD_];
#pragma unroll
      for (int r = 0; r < NR_; ++r) acc[r] += sc[r * 64 + i] * wv; }
#pragma unroll
    for (int r = 0; r < NR_; ++r) modp[(((size_t)ks * DEPTH_ + l) * NR_ + r) * NMOD_ + j] = acc[r];
  }
  bf16_t* win = (bf16_t*)(p.ws + Ws::WIN);
  bf16_t* wout = (bf16_t*)(p.ws + Ws::WOUT);
  for (int u = BIDX; u < DEPTH_ * 16 * 55; u += gridDim.x) {
    int l = u / (16 * 55), r = u % (16 * 55);
    cvt_tile(smem, INP(I_WIN) + (size_t)l * 1024 * NIN_, 1024, NIN_, (r / 55) * 64, (r % 55) * 64, win + (size_t)l * NIN_ * 1024, 1024, 0);
  }
  for (int u = BIDX; u < DEPTH_ * 256; u += gridDim.x) {
    int l = u / 256, r = u % 256;
    cvt_tile(smem, INP(I_WOUT) + (size_t)l * 1024 * 1024, 1024, 1024, (r / 16) * 64, (r % 16) * 64, wout + (size_t)l * 1024 * 1024, 1024, 0);
  }
  { bf16_t* lo = (bf16_t*)(p.ws + Ws::LORA);
    for (int u = BIDX * 256 + tid; u < DEPTH_ * 98304; u += gridDim.x * 256) {
      const int l = u / 98304, r = u % 98304; float v;
      if (r < 32768) { const int d = r >> 14, n = (r >> 6) & 255, k = r & 63; v = INP(I_W2)[(((size_t)l * 2 + d) * 64 + k) * 256 + n]; }
      else if (r < 65536) { const int r2 = r - 32768, d = r2 >> 14, n = (r2 >> 6) & 255, k = r2 & 63; v = INP(I_A2)[(((size_t)l * 2 + d) * 64 + k) * 256 + n]; }
      else { const int r2 = r - 65536, n = r2 >> 7, k = r2 & 127; v = INP(I_G2)[((size_t)l * 128 + k) * 256 + n]; }
      lo[u] = f2bf(v); } }
  float* rwt = (float*)(p.ws + Ws::RWT);
  for (int u = BIDX * 256 + tid; u < DEPTH_ * 64 * 1024; u += gridDim.x * 256) {
    int l = u / (64 * 1024), e = (u / 1024) % 64, i = u % 1024;
    rwt[u] = INP(I_RW)[((size_t)l * 1024 + i) * 64 + e];
  }
}

DEVFN void phase0b(const Params& p) {
  float* mod = (float*)(p.ws + Ws::MOD); const float* modp = (const float*)(p.ws + Ws::MODP);
  for (int u = BIDX * 256 + TIDX; u < DEPTH_ * NR_ * NMOD_; u += gridDim.x * 256) {
    int l = u / (NR_ * NMOD_), j = u % NMOD_;
    float s = INP(I_ADAB)[(size_t)l * NMOD_ + j];
    for (int ks = 0; ks < 16; ++ks) s += modp[(size_t)ks * DEPTH_ * NR_ * NMOD_ + u];
    mod[u] = s;
  }
}

DEVFN void row_stats(const float (&v)[16], float& mean, float& rstd) {
  float s = 0.f;
#pragma unroll
  for (int i = 0; i < 16; ++i) s += v[i];
  mean = wave_sum(s) * (1.f / 1024.f);
  float q = 0.f;
#pragma unroll
  for (int i = 0; i < 16; ++i) { float d = v[i] - mean; q += d * d; }
  rstd = rsqrtf(wave_sum(q) * (1.f / 1024.f) + 1e-5f);
}
DEVFN void load_row16(const float* row, int lane, float (&v)[16]) {
  const AS1 float* r = gptr(row);
#pragma unroll
  for (int j = 0; j < 4; ++j) { const f32x4 t = *(const AS1 f32x4*)(r + lane * 4 + 256 * j); v[4 * j] = t[0]; v[4 * j + 1] = t[1]; v[4 * j + 2] = t[2]; v[4 * j + 3] = t[3]; }
}
DEVFN void moe_residual_row(const Params& p, int lp, int tok, int lane, float (&xv)[16]) {
  const float* mod = (const float*)(p.ws + Ws::MOD) + ((size_t)lp * NR_ + tok_modrow(tok)) * NMOD_;
  const bf16_t* yb = (const bf16_t*)(p.ws + Ws::YBUF) + (size_t)tok * NSLOT * 1024;
  float f[16];
#pragma unroll
  for (int i = 0; i < 16; ++i) f[i] = 0.f;
#pragma unroll
  for (int s = 0; s < NSLOT; ++s) {
#pragma unroll
    for (int j = 0; j < 4; ++j) { const u32x2 t = *(const AS1 u32x2*)gptr(yb + (size_t)s * 1024 + lane * 4 + 256 * j);
      f[4 * j] += bf2f((bf16_t)(t[0] & 0xFFFF)); f[4 * j + 1] += bf2f((bf16_t)(t[0] >> 16)); f[4 * j + 2] += bf2f((bf16_t)(t[1] & 0xFFFF)); f[4 * j + 3] += bf2f((bf16_t)(t[1] >> 16)); }
  }
  float g2[16], w[16], b[16];
  load_row16(mod + 5 * 1024, lane, g2);
  load_row16(INP(I_LN2W) + (size_t)lp * 1024, lane, w);
  load_row16(INP(I_LN2B) + (size_t)lp * 1024, lane, b);
#pragma unroll
  for (int i = 0; i < 16; ++i) xv[i] = ALPHA_ * xv[i] + g2[i] * f[i];
  float mean, rstd;
  row_stats(xv, mean, rstd);
#pragma unroll
  for (int i = 0; i < 16; ++i) xv[i] = (xv[i] - mean) * rstd * w[i] + b[i];
}
DEVFN void phase1(const Params& p, int l) {
  const int lane = TIDX & 63, wave = TIDX >> 6;
  float* X = (float*)(p.ws + Ws::X);
  bf16_t* U = (bf16_t*)(p.ws + Ws::U);
  for (int tok = BIDX * 4 + wave; tok < NT_; tok += gridDim.x * 4) {
    float xv[16];
    if (l == 0) load_row16(tok_input_row(p, tok), lane, xv);
    else { load_row16(X + (size_t)tok * 1024, lane, xv); moe_residual_row(p, l - 1, tok, lane, xv); }
#pragma unroll
    for (int j = 0; j < 4; ++j) *(float4*)(X + (size_t)tok * 1024 + lane * 4 + 256 * j) = make_float4(xv[4 * j], xv[4 * j + 1], xv[4 * j + 2], xv[4 * j + 3]);
    const float* mod = (const float*)(p.ws + Ws::MOD) + ((size_t)l * NR_ + tok_modrow(tok)) * NMOD_;
    float sh[16], sc[16], mean, rstd;
    load_row16(mod, lane, sh);
    load_row16(mod + 1024, lane, sc);
    row_stats(xv, mean, rstd);
#pragma unroll
    for (int j = 0; j < 4; ++j) {
      float u0 = (xv[4 * j] - mean) * rstd * (1.f + sc[4 * j]) + sh[4 * j], u1 = (xv[4 * j + 1] - mean) * rstd * (1.f + sc[4 * j + 1]) + sh[4 * j + 1];
      float u2 = (xv[4 * j + 2] - mean) * rstd * (1.f + sc[4 * j + 2]) + sh[4 * j + 2], u3 = (xv[4 * j + 3] - mean) * rstd * (1.f + sc[4 * j + 3]) + sh[4 * j + 3];
      *(uint2*)(U + (size_t)tok * 1024 + lane * 4 + 256 * j) = make_uint2((unsigned)f2bf(u0) | ((unsigned)f2bf(u1) << 16), (unsigned)f2bf(u2) | ((unsigned)f2bf(u3) << 16));
    }
  }
}
DEVFN void phase_final(const Params& p) {
  const int lane = TIDX & 63, wave = TIDX >> 6;
  const float* X = (const float*)(p.ws + Ws::X);
  for (int r = BIDX * 4 + wave; r < B_ * SEQ_; r += gridDim.x * 4) {
    int b = r / SEQ_, s = r % SEQ_, tok = b * T_ + CTX_ + s;
    float xv[16];
    load_row16(X + (size_t)tok * 1024, lane, xv);
    moe_residual_row(p, DEPTH_ - 1, tok, lane, xv);
#pragma unroll
    for (int j = 0; j < 4; ++j) *(float4*)(p.out + (size_t)r * 1024 + lane * 4 + 256 * j) = make_float4(xv[4 * j], xv[4 * j + 1], xv[4 * j + 2], xv[4 * j + 3]);
  }
}

DEVFN void phase2(const Params& p, int l, unsigned char* smem) {
  const bf16_t* U = (const bf16_t*)(p.ws + Ws::U);
  const bf16_t* W = (const bf16_t*)(p.ws + Ws::WIN) + (size_t)l * NIN_ * 1024;
  bf16_t* ZX = (bf16_t*)(p.ws + Ws::ZX);
  const int nct = (NIN_ + 127) / 128;
  for (int u = BIDX; u < (NT_ / 128) * nct; u += gridDim.x) {
    int rt = u / nct, ct = u % nct;
    gemm_tile(smem, 1024,
      [&](int r) { return U + (size_t)(rt * 128 + r) * 1024; },
      [&](int r) { int n = ct * 128 + r; return n < NIN_ ? W + (size_t)n * 1024 : (const bf16_t*)(p.ws + Ws::ZROW); },
      [&](f32x4 (&acc)[4][4], int wr, int wc, int g, int l15) {
        tile_store_bf16<16>(smem, wr, g, l15,
          [&](bf16_t* T, int ldc) {
#pragma unroll
            for (int mi = 0; mi < 4; ++mi)
#pragma unroll
              for (int ni = 0; ni < 4; ++ni)
#pragma unroll
                for (int i = 0; i < 4; ++i) T[(wr * 64 + mi * 16 + 4 * g + i) * ldc + wc * 64 + ni * 16 + l15] = f2bf(acc[mi][ni][i]); },
          [&](int row, int c0) { return ct * 128 + c0 < NIN_ ? ZX + (size_t)(rt * 128 + row) * NIN_ + ct * 128 + c0 : (bf16_t*)nullptr; });
      });
  }
}

DEVFN float zxv(const bf16_t* ZX, int tok, int col) { return bf2f(gptr(ZX)[(size_t)tok * NIN_ + col]); }
struct Nbr { int n; int tok[4]; };
DEVFN Nbr shift_nbrs(int tok) {
  Nbr nb; int b = tok / T_, t = tok % T_;
  if (t < CTX_) { nb.n = 2; nb.tok[0] = t > 0 ? tok - 1 : -1; nb.tok[1] = t < CTX_ - 1 ? tok + 1 : -1; nb.tok[2] = -1; nb.tok[3] = -1; }
  else { int s = t - CTX_, row = s / 64, col = s % 64; nb.n = 4; nb.tok[0] = col > 0 ? tok - 1 : -1; nb.tok[1] = col < 63 ? tok + 1 : -1;
    nb.tok[2] = row > 0 ? tok - 64 : -1; nb.tok[3] = row < SEQ_ / 64 - 1 ? tok + 64 : -1; }
  (void)b; return nb;
}
DEVFN float shiftmix(const bf16_t* ZX, const float* mu, int tok, const Nbr& nb, int ch) {
  float z = zxv(ZX, tok, ORW + ch), o = z;
#pragma unroll
  for (int j = 0; j < 4; ++j) if (j < nb.n) { float v = nb.tok[j] >= 0 ? zxv(ZX, nb.tok[j], ORW + ch) : 0.f; o += mu[j * 1152 + ch] * (v - z); }
  return o;
}
#define LI_LD 392
#define KL_LD 264
DEVFN void phase3(const Params& p, int l, unsigned char* smem) {
  const int tid = TIDX, lane = tid & 63, wave = tid >> 6, q = lane >> 4, l15 = lane & 15;
  const bf16_t* ZX = (const bf16_t*)(p.ws + Ws::ZX);
  bf16_t* XBC = (bf16_t*)(p.ws + Ws::XBC); float* DTB = (float*)(p.ws + Ws::DTB);
  bf16_t* RR = (bf16_t*)(p.ws + Ws::RR); bf16_t* VV = (bf16_t*)(p.ws + Ws::VV); bf16_t* KKb = (bf16_t*)(p.ws + Ws::KK);
  bf16_t* KRW = (bf16_t*)(p.ws + Ws::KRW); bf16_t* LIg = (bf16_t*)(p.ws + Ws::LI);
  float* LA = (float*)(p.ws + Ws::LA);
  const float* convw = INP(I_CONVW) + (size_t)l * 3 * 1024; const float* convb = INP(I_CONVB) + (size_t)l * 1024;
  const float* mu = INP(I_MU) + (size_t)l * 4 * 1152;
  float* gdl = (float*)smem;
  const float kkw = INP(I_KKW)[(size_t)l * 256 + tid];
  for (int tile = BIDX; tile < NT_ / 16; tile += gridDim.x) {
    const int tok0 = tile * 16, t0 = tok0 % T_, bb = tok0 / T_;
    const bool isctx = t0 < CTX_;
    const int s0 = t0 - CTX_;
    const bool lval = isctx ? (t0 > 0) : ((s0 & 63) != 0), rval = isctx ? (t0 + 16 < CTX_) : ((s0 & 63) != 48);
    const bool uval = !isctx && (s0 >= 64), dval = !isctx && (s0 + 64 < SEQ_);
    __syncthreads();
    {
      const bool segstart = (t0 == 0 || t0 == CTX_), segend = (t0 + 16 == CTX_ || t0 + 16 == T_);
      bf16_t* XBCT = (bf16_t*)(p.ws + Ws::XBCT) + ((size_t)(bb * NC128 + t0 / 128) * 768) * 128 + (t0 % 128);
#pragma unroll 1
      for (int j = 0; j < 4; ++j) { const int c = tid + 256 * j;
        const bf16_t* zp = ZX + (size_t)tok0 * NIN_ + OXBC + c - NIN_; bf16_t* xp = XBC + (size_t)tok0 * 1024 + c;
        float z[18];
#pragma unroll
        for (int i = 0; i < 18; ++i) { z[i] = ((i == 0 && segstart) || (i == 17 && segend)) ? 0.f : bf2f(*zp); zp += NIN_; LAUNDER_V(zp); }
        const float w0 = convw[c], w1 = convw[1024 + c], w2 = convw[2048 + c], cb = convb[c];
        bf16_t y[16];
#pragma unroll
        for (int i = 0; i < 16; ++i) { y[i] = f2bf(siluf_(cb + w0 * z[i] + w1 * z[i + 1] + w2 * z[i + 2])); *xp = y[i]; xp += 1024; LAUNDER_V(xp); }
        if (c < 768) {
          u32x4 o0, o1;
#pragma unroll
          for (int i = 0; i < 4; ++i) { o0[i] = (unsigned)y[2 * i] | ((unsigned)y[2 * i + 1] << 16); o1[i] = (unsigned)y[8 + 2 * i] | ((unsigned)y[9 + 2 * i] << 16); }
          *(u32x4*)(XBCT + (size_t)c * 128) = o0; *(u32x4*)(XBCT + (size_t)c * 128 + 8) = o1; } }
      { bf16_t* VTp = (bf16_t*)(p.ws + Ws::VT) + ((size_t)(bb * NC64 + t0 / 64) * 256 + tid) * 64 + (t0 % 64);
        const bf16_t* vp = ZX + (size_t)tok0 * NIN_ + OGV + tid;
        u32x4 o0, o1;
        bf16_t vv16[16];
#pragma unroll
        for (int i = 0; i < 16; ++i) { vv16[i] = *vp; vp += NIN_; LAUNDER_V(vp); }
#pragma unroll
        for (int i = 0; i < 4; ++i) { o0[i] = (unsigned)vv16[2 * i] | ((unsigned)vv16[2 * i + 1] << 16); o1[i] = (unsigned)vv16[8 + 2 * i] | ((unsigned)vv16[9 + 2 * i] << 16); }
        *(u32x4*)VTp = o0; *(u32x4*)(VTp + 8) = o1; }
      DTB[(size_t)tok0 * 16 + tid] = softplusf_(zxv(ZX, tok0 + (tid >> 4), ODT + (tid & 15)) + INP(I_DTBIAS)[(size_t)l * 16 + (tid & 15)]);
      gdl[tid] = zxv(ZX, tok0 + (tid >> 5), OGD + (tid & 31)); gdl[256 + tid] = zxv(ZX, tok0 + 8 + (tid >> 5), OGD + (tid & 31));
    }
#pragma unroll 1
    for (int g = 0; g < 5; ++g) {
      const bool act = !(g == 4 && tid >= 128);
      const int ch = act ? g * 256 + tid : 0;
      const bf16_t* zp0 = ZX + (size_t)tok0 * NIN_ + ORW + ch;
      const bf16_t* zp = zp0 - NIN_;
      const float m0 = mu[ch], m1 = mu[1152 + ch], m2 = mu[2304 + ch], m3 = mu[3456 + ch];
      float z[18], o[16];
#pragma unroll
      for (int i = 0; i < 18; ++i) { z[i] = ((i == 0 && !lval) || (i == 17 && !rval)) ? 0.f : bf2f(*zp); zp += NIN_; LAUNDER_V(zp); }
#pragma unroll
      for (int i = 0; i < 16; ++i) o[i] = z[i + 1] + m0 * (z[i] - z[i + 1]) + m1 * (z[i + 2] - z[i + 1]);
      if (!isctx) {
        const bf16_t* up = zp0 - (size_t)64 * NIN_; const bf16_t* dn = zp0 + (size_t)64 * NIN_;
#pragma unroll
        for (int i = 0; i < 16; ++i) { const float zu = uval ? bf2f(*up) : 0.f, zd = dval ? bf2f(*dn) : 0.f; up += NIN_; dn += NIN_; LAUNDER_V(up); LAUNDER_V(dn);
          o[i] += m2 * (zu - z[i + 1]) + m3 * (zd - z[i + 1]); } }
      if (g == 0) { bf16_t* rp = RR + (size_t)tok0 * 256 + tid;
#pragma unroll
        for (int i = 0; i < 16; ++i) { *rp = f2bf(o[i]); rp += 256; LAUNDER_V(rp); }
      } else if (g == 1) { bf16_t* kp = KKb + (size_t)tok0 * 256 + tid; bf16_t* krp = KRW + (size_t)tok0 * 256 + tid;
#pragma unroll
        for (int i = 0; i < 16; ++i) { const float kq = o[i] * kkw, nrm = sqrtf(wave_sum(kq * kq));
          *kp = f2bf(kq / fmaxf(nrm, 1e-12f)); *krp = f2bf(o[i]); kp += 256; krp += 256; LAUNDER_V(kp); LAUNDER_V(krp); }
      } else if (g == 2) { bf16_t* vp2 = VV + (size_t)tok0 * 256 + tid;
#pragma unroll
        for (int i = 0; i < 16; ++i) { *vp2 = f2bf(o[i]); vp2 += 256; LAUNDER_V(vp2); }
      } else if (g == 3) { bf16_t* lp = LIg + (size_t)tok0 * 384 + tid;
#pragma unroll
        for (int i = 0; i < 16; ++i) { *lp = f2bf(tid < 128 ? tanhf(o[i]) : o[i]); lp += 384; LAUNDER_V(lp); }
      } else if (act) { bf16_t* lp = LIg + (size_t)tok0 * 384 + 256 + tid;
#pragma unroll
        for (int i = 0; i < 16; ++i) { *lp = f2bf(sigmoidf_(o[i])); lp += 384; LAUNDER_V(lp); }
      }
    }
    __syncthreads();
    { const int d = tid >> 7, c = tid & 127; const float* gu = INP(I_GU) + ((size_t)l * 2 + d) * 16 * 128; const float gb = INP(I_GB)[((size_t)l * 2 + d) * 128 + c];
      float guw[16];
#pragma unroll
      for (int i = 0; i < 16; ++i) guw[i] = gu[i * 128 + c];
#pragma unroll 4
      for (int tt = 0; tt < 16; ++tt) { float sacc = gb;
#pragma unroll
        for (int i = 0; i < 16; ++i) sacc += gdl[tt * 32 + d * 16 + i] * guw[i];
        LA[((size_t)d * NT_ + tok0 + tt) * 128 + c] = logsigmoidf_(sacc) * (1.f / 16.f); } }
  }
}

DEVFN void phase3b(const Params& p, int l, unsigned char* smem) {
  const bf16_t* LIg = (const bf16_t*)(p.ws + Ws::LI);
  const bf16_t* lora = (const bf16_t*)(p.ws + Ws::LORA) + (size_t)l * 98304;
  const bf16_t* KRg = (const bf16_t*)(p.ws + Ws::KRW); const bf16_t* KKg = (const bf16_t*)(p.ws + Ws::KK);
  float* LWp = (float*)(p.ws + Ws::LW); bf16_t* KD = (bf16_t*)(p.ws + Ws::KD); bf16_t* BD = (bf16_t*)(p.ws + Ws::BD); float* GATE = (float*)(p.ws + Ws::GATE);
  for (int u = BIDX; u < (NT_ / 128) * 10; u += gridDim.x) {
    const int rt = u / 10, which = (u % 10) >> 1, ct = u & 1;
    const int K = which < 4 ? 64 : 128, acol = which < 4 ? which * 64 : 256;
    const bf16_t* wb = which < 2 ? lora + (size_t)which * 16384 : which < 4 ? lora + 32768 + (size_t)(which - 2) * 16384 : lora + 65536;
    const float* bias = which < 2 ? INP(I_W0) + (size_t)l * 512 + which * 256 : INP(I_A0) + (size_t)l * 512 + (which & 1) * 256;
    const float* kav = INP(I_KAW) + (size_t)l * 256;
    gemm_tile(smem, K,
      [&](int r) { return LIg + (size_t)(rt * 128 + r) * 384 + acol; },
      [&](int r) { return wb + (size_t)(ct * 128 + r) * K; },
      [&](f32x4 (&acc)[4][4], int wr, int wc, int g, int l15) {
#pragma unroll
        for (int ni = 0; ni < 4; ++ni) { const int col = ct * 128 + wc * 64 + ni * 16 + l15;
          const float bv = which < 4 ? bias[col] : 0.f, ka = kav[col];
#pragma unroll
          for (int mi = 0; mi < 4; ++mi)
#pragma unroll
            for (int i = 0; i < 4; ++i) { const int row = rt * 128 + wr * 64 + mi * 16 + 4 * g + i; const size_t o = (size_t)row * 256 + col;
              const float v = acc[mi][ni][i];
              if (which < 2) LWp[(size_t)which * NT_ * 256 + o] = -0.6065306597126334f * sigmoidf_(v + bv);
              else if (which < 4) { const float a = sigmoidf_(v + bv); const size_t od = (size_t)(which - 2) * NT_ * 256 + o;
                KD[od] = f2bf(bf2f(KRg[o]) * (1.f + (a - 1.f) * ka)); BD[od] = f2bf(bf2f(KKg[o]) * a); }
              else GATE[o] = v; } }
      });
  }
}

DEVFN bf16x8 ld8(const bf16_t* p) { return *(const bf16x8*)p; }
typedef short bf16x4v __attribute__((ext_vector_type(4)));
DEVFN bf16x4v cvt4(f32x4 v) { return bf16x4v{(short)f2bf(v[0]), (short)f2bf(v[1]), (short)f2bf(v[2]), (short)f2bf(v[3])}; }
DEVFN bf16x8 cat44(bf16x4v a, bf16x4v b) { return bf16x8{a[0], a[1], a[2], a[3], b[0], b[1], b[2], b[3]}; }
DEVFN bf16x4v ld4(const bf16_t* p) { return *(const bf16x4v*)p; }
DEVFN int rm_off(int i, int k) { return i * 64 + ((((k >> 3) ^ (i & 7)) << 3) | (k & 7)); }
#define RW_WAVE_LDS 11264
DEVFN void rwkv_chunk(const Params& p, int unit_base, unsigned char* smem) {
  const int tid = TIDX, lane = tid & 63, wave = tid >> 6, q = lane >> 4, l15 = lane & 15;
  const int unit = unit_base + wave;
  const int c = unit % NC16, h = (unit / NC16) & 3, dir = (unit / (NC16 * 4)) & 1, b = unit / (NC16 * 8);
  bf16_t* big = (bf16_t*)(smem + wave * RW_WAVE_LDS);
  unsigned char* small = smem + wave * RW_WAVE_LDS + 8192;
  float* AbF = (float*)small;
  bf16_t* TN = (bf16_t*)(small + 1024);
  bf16_t* AK = TN + 256; bf16_t* RB = AK + 256; bf16_t* RK = RB + 256;
  const bf16_t* RRg = (const bf16_t*)(p.ws + Ws::RR); const bf16_t* VVg = (const bf16_t*)(p.ws + Ws::VV); const bf16_t* KKg = (const bf16_t*)(p.ws + Ws::KK);
  const bf16_t* KDg = (const bf16_t*)(p.ws + Ws::KD) + (size_t)dir * NT_ * 256; const bf16_t* BDg = (const bf16_t*)(p.ws + Ws::BD) + (size_t)dir * NT_ * 256;
  const float* LWg = (const float*)(p.ws + Ws::LW) + (size_t)dir * NT_ * 256;
  float kkm[16], vv[16], bneg[16], kneg[16];
  float run = 0.f;
  __syncthreads();
#pragma unroll
  for (int i = 0; i < 16; ++i) {
    const size_t o = (size_t)(b * T_ + tokmap(dir, c * 16 + i)) * 256 + h * 64 + lane;
    const float lw = LWg[o], r = bf2f(RRg[o]), k = bf2f(KDg[o]), v = bf2f(VVg[o]), kk = bf2f(KKg[o]), bb = bf2f(BDg[o]);
    const float e_ex = expf(run); run += lw; const float e_in = expf(run), e_neg = expf(-run);
    kkm[i] = kk * e_ex; vv[i] = v; bneg[i] = bb * e_neg; kneg[i] = k * e_neg;
    big[rm_off(i, lane)] = f2bf(kkm[i]); big[1024 + rm_off(i, lane)] = f2bf(r * e_in);
    big[2048 + rm_off(i, lane)] = f2bf(bneg[i]); big[3072 + rm_off(i, lane)] = f2bf(kneg[i]);
  }
  const float WC = expf(run);
  __syncthreads();
  f32x4 ab = f32x4{0.f, 0.f, 0.f, 0.f}, ak = ab, rb = ab, rk = ab;
#pragma unroll
  for (int s2 = 0; s2 < 2; ++s2) { const int ch = ((4 * s2 + q) ^ (l15 & 7)) << 3;
    const bf16x8 a_kk = ld8(big + l15 * 64 + ch), a_r = ld8(big + 1024 + l15 * 64 + ch), b_b = ld8(big + 2048 + l15 * 64 + ch), b_k = ld8(big + 3072 + l15 * 64 + ch);
    ab = MFMA16(a_kk, b_b, ab); ak = MFMA16(a_kk, b_k, ak); rb = MFMA16(a_r, b_b, rb); rk = MFMA16(a_r, b_k, rk); }
  f32x4 gacc[4];
#pragma unroll
  for (int nk = 0; nk < 4; ++nk)
#pragma unroll
    for (int r = 0; r < 4; ++r) gacc[nk][r] = bf2f(big[1024 + rm_off(4 * q + r, 16 * nk + l15)]);
  __syncthreads();
#pragma unroll
  for (int r = 0; r < 4; ++r) { const int i = 4 * q + r, j = l15;
    AbF[i * 16 + j] = j < i ? ab[r] : 0.f; AK[i * 16 + j] = f2bf(j < i ? ak[r] : 0.f);
    RB[i * 16 + j] = f2bf(j <= i ? rb[r] : 0.f); RK[i * 16 + j] = f2bf(j <= i ? rk[r] : 0.f); }
  { bf16_t* KKMT = big; bf16_t* VTT = big + 1024; bf16_t* BHT = big + 2048; bf16_t* KHT = big + 3072;
#pragma unroll
    for (int i = 0; i < 16; ++i) { KKMT[lane * 16 + i] = f2bf(kkm[i]); VTT[lane * 16 + i] = f2bf(vv[i]); BHT[lane * 16 + i] = f2bf(bneg[i] * WC); KHT[lane * 16 + i] = f2bf(kneg[i] * WC); } }
  __syncthreads();
  { float t[16];
#pragma unroll
    for (int i = 0; i < 16; ++i) { float acc = (i == l15) ? 1.f : 0.f;
#pragma unroll
      for (int j = 0; j < i; ++j) acc -= AbF[i * 16 + j] * t[j];
      t[i] = acc; }
    if (q == 0) {
#pragma unroll
      for (int i = 0; i < 16; ++i) TN[i * 16 + l15] = f2bf(-t[i]); } }
  __syncthreads();
  const size_t ci = (size_t)((b * 2 + dir) * 4 + h) * NC16 + c;
  bf16_t* MLg = (bf16_t*)(p.ws + Ws::RML) + ci * 4096; bf16_t* Ng = (bf16_t*)(p.ws + Ws::RNS) + ci * 4096;
  bf16_t* Gg = (bf16_t*)(p.ws + Ws::RG) + ci * 1024; float* Y0g = (float*)(p.ws + Ws::RY0) + ci * 1024;
  const bf16x4v a_T = ld4(TN + l15 * 16 + 4 * q), a_Ak = ld4(AK + l15 * 16 + 4 * q), a_Rb = ld4(RB + l15 * 16 + 4 * q), a_Rk = ld4(RK + l15 * 16 + 4 * q);
  const f32x4 z4 = f32x4{0.f, 0.f, 0.f, 0.f};
  bf16x4v vfr[4], qfr[4], pfr[4];
#pragma unroll
  for (int n = 0; n < 4; ++n) {
    vfr[n] = ld4(big + 1024 + (16 * n + l15) * 16 + 4 * q);
    const f32x4 akv = MFMA16K16(a_Ak, vfr[n], z4);
    qfr[n] = cvt4(MFMA16K16(a_T, cvt4(akv), z4));
    pfr[n] = cvt4(MFMA16K16(a_T, ld4(big + (16 * n + l15) * 16 + 4 * q), z4)); }
  const bf16x8 a_RbRk = cat44(a_Rb, a_Rk);
#pragma unroll
  for (int n = 0; n < 4; ++n) {
    const f32x4 g = MFMA16K16(a_Rb, pfr[n], gacc[n]);
    const f32x4 y0 = MFMA16(a_RbRk, cat44(qfr[n], vfr[n]), z4);
#pragma unroll
    for (int r = 0; r < 4; ++r) { Gg[(4 * q + r) * 64 + 16 * n + l15] = f2bf(g[r]); Y0g[(4 * q + r) * 64 + 16 * n + l15] = y0[r]; } }
#pragma unroll
  for (int mk = 0; mk < 4; ++mk) {
    const bf16x4v a_B = ld4(big + 2048 + (16 * mk + l15) * 16 + 4 * q), a_K = ld4(big + 3072 + (16 * mk + l15) * 16 + 4 * q);
    const bf16x8 a_BK = cat44(a_B, a_K);
#pragma unroll
    for (int n = 0; n < 4; ++n) {
      const f32x4 m = MFMA16K16(a_B, pfr[n], z4);
      const f32x4 nn = MFMA16(a_BK, cat44(qfr[n], vfr[n]), z4);
#pragma unroll
      for (int r = 0; r < 4; ++r) MLg[((mk * 2 + (n >> 1)) * 64 + (l15 >> 2) * 16 + 4 * q + r) * 8 + (n & 1) * 4 + (l15 & 3)] = f2bf(m[r]);
      *(bf16x4v*)(Ng + (n * 64 + lane) * 16 + mk * 4) = cvt4(nn); } }
  ((float*)(p.ws + Ws::RWC))[ci * 64 + ((lane >> 2) & 3) * 16 + (lane >> 4) * 4 + (lane & 3)] = WC;
}
struct RwStep { bf16x8 ml[4][2]; bf16x8 n[2]; f32x4 wc[4]; };
DEVFN void rw_load(RwStep& t, const bf16_t* MLg, const bf16_t* NSg, const float* WCg, int c, int lane, int q) {
#pragma unroll
  for (int mk = 0; mk < 4; ++mk) { t.ml[mk][0] = ld8g(MLg + (size_t)c * 4096 + ((mk * 2 + 0) * 64 + lane) * 8); t.ml[mk][1] = ld8g(MLg + (size_t)c * 4096 + ((mk * 2 + 1) * 64 + lane) * 8);
    t.wc[mk] = *(const AS1 f32x4*)gptr(WCg + (size_t)c * 64 + q * 16 + mk * 4); }
  t.n[0] = ld8g(NSg + (size_t)c * 4096 + lane * 16); t.n[1] = ld8g(NSg + (size_t)c * 4096 + lane * 16 + 8);
}
DEVFN void rw_step(const RwStep& t, f32x4 (&S)[4], bf16_t* NSg, int c, int q, int l15) {
  bf16x4v sb[4];
#pragma unroll
  for (int mk = 0; mk < 4; ++mk) sb[mk] = cvt4(S[mk]);
  const bf16x8 bf0 = cat44(sb[0], sb[1]), bf1 = cat44(sb[2], sb[3]);
#pragma unroll
  for (int mk = 0; mk < 4; ++mk) {
    f32x4 acc;
#pragma unroll
    for (int r = 0; r < 4; ++r) acc[r] = bf2f((bf16_t)t.n[mk >> 1][(mk & 1) * 4 + r]) + t.wc[mk][r] * S[mk][r];
    acc = MFMA16(t.ml[mk][0], bf0, acc);
    acc = MFMA16(t.ml[mk][1], bf1, acc);
    S[mk] = acc; }
#pragma unroll
  for (int mk = 0; mk < 4; ++mk) *(AS1 bf16x4v*)gptr(NSg + (size_t)c * 4096 + l15 * 64 + 16 * mk + 4 * q) = sb[mk];
}
DEVFN void rwkv_scan(const Params& p, int chain, int wave) {
  const int tid = TIDX, lane = tid & 63, q = lane >> 4, l15 = lane & 15;
  const bf16_t* MLg = (const bf16_t*)(p.ws + Ws::RML) + (size_t)chain * NC16 * 4096;
  bf16_t* NSg = (bf16_t*)(p.ws + Ws::RNS) + (size_t)chain * NC16 * 4096 + wave * 1024;
  const float* WCg = (const float*)(p.ws + Ws::RWC) + (size_t)chain * NC16 * 64;
  f32x4 S[4];
#pragma unroll
  for (int mk = 0; mk < 4; ++mk) S[mk] = f32x4{0.f, 0.f, 0.f, 0.f};
  RwStep t0, t1, t2;
#define RWC_(x) ((x) < NC16 ? (x) : NC16 - 1)
  rw_load(t0, MLg, NSg, WCg, 0, lane, q);
  rw_load(t1, MLg, NSg, WCg, RWC_(1), lane, q);
  int c = 0;
  for (; c + 2 < NC16; c += 3) {
    rw_load(t2, MLg, NSg, WCg, c + 2, lane, q);
    rw_step(t0, S, NSg, c, q, l15);
    rw_load(t0, MLg, NSg, WCg, RWC_(c + 3), lane, q);
    rw_step(t1, S, NSg, c + 1, q, l15);
    rw_load(t1, MLg, NSg, WCg, RWC_(c + 4), lane, q);
    rw_step(t2, S, NSg, c + 2, q, l15);
  }
  if (c < NC16) { rw_step(t0, S, NSg, c, q, l15); if (c + 1 < NC16) rw_step(t1, S, NSg, c + 1, q, l15); }
#undef RWC_
}
DEVFN void rwkv_out(const Params& p, int unit_base) {
  const int tid = TIDX, lane = tid & 63, wave = tid >> 6, q = lane >> 4, l15 = lane & 15;
  const int unit = unit_base + wave;
  const int c = unit % NC16, h = (unit / NC16) & 3, dir = (unit / (NC16 * 4)) & 1, b = unit / (NC16 * 8);
  const size_t ci = (size_t)((b * 2 + dir) * 4 + h) * NC16 + c;
  const bf16_t* Sg = (const bf16_t*)(p.ws + Ws::RNS) + ci * 4096; const bf16_t* Gg = (const bf16_t*)(p.ws + Ws::RG) + ci * 1024;
  const float* Y0g = (const float*)(p.ws + Ws::RY0) + ci * 1024;
  float* YR = (float*)(p.ws + Ws::YR) + (size_t)dir * NT_ * 256;
  const bf16x8 a0 = ld8(Gg + l15 * 64 + 8 * q), a1 = ld8(Gg + l15 * 64 + 32 + 8 * q);
#pragma unroll
  for (int n = 0; n < 4; ++n) {
    f32x4 acc;
#pragma unroll
    for (int r = 0; r < 4; ++r) acc[r] = Y0g[(4 * q + r) * 64 + 16 * n + l15];
    acc = MFMA16(a0, ld8(Sg + n * 1024 + l15 * 64 + 8 * q), acc);
    acc = MFMA16(a1, ld8(Sg + n * 1024 + l15 * 64 + 32 + 8 * q), acc);
#pragma unroll
    for (int r = 0; r < 4; ++r) YR[(size_t)(b * T_ + tokmap(dir, c * 16 + 4 * q + r)) * 256 + h * 64 + 16 * n + l15] = acc[r]; }
}
DEVFN int cscan(int dir, int co, int nctx, int nc) { return dir == 0 ? co : (co < nctx ? nctx - 1 - co : 2 * nctx + nc - 1 - co); }
DEVFN bf16x8 ld4x2(const bf16_t* p0, const bf16_t* p1) { bf16x4v a = *(const bf16x4v*)p0, b = *(const bf16x4v*)p1; return bf16x8{a[0], a[1], a[2], a[3], b[0], b[1], b[2], b[3]}; }

DEVFN void ssd_chunk_scalars(const Params& p, int l, int b, int co, int h, float* f) {
  const int tid = TIDX, d = tid >> 7, j = tid & 127;
  const float* DTB = (const float*)(p.ws + Ws::DTB);
  const float nega = -expf(INP(I_ALOG)[(size_t)l * 16 + d * 8 + h]);
  const float dt = DTB[(size_t)(b * T_ + co * 128 + j) * 16 + d * 8 + h];
  __syncthreads();
  f[256 + d * 128 + j] = dt;
  float* cur = f + d * 128; float* tmp = f + 512 + d * 128;
  cur[j] = dt * nega;
  __syncthreads();
  for (int off = 1; off < 128; off <<= 1) {
    float v = cur[j] + (j >= off ? cur[j - off] : 0.f);
    tmp[j] = v;
    __syncthreads();
    cur[j] = tmp[j];
    __syncthreads();
  }
}
DEVFN void ssd_states(const Params& p, int l, int unit, unsigned char* smem) {
  const int tid = TIDX, lane = tid & 63, wave = tid >> 6, q = lane >> 4, l15 = lane & 15;
  const int h = unit & 7, co = (unit >> 3) % NC128, b = unit / (8 * NC128), grp = h >> 2;
  float* f = (float*)smem;
  ssd_chunk_scalars(p, l, b, co, h, f);
  { const int d = tid >> 7, j = tid & 127; const float* cum = f + d * 128; const float dt = f[256 + d * 128 + j];
    float w = d == 0 ? expf(cum[127] - cum[j]) * dt : expf(j > 0 ? cum[j - 1] : 0.f) * dt;
    f[512 + d * 128 + j] = w; }
  __syncthreads();
  const bf16_t* XT = (const bf16_t*)(p.ws + Ws::XBCT) + (size_t)(b * NC128 + co) * 768 * 128;
  f32x4 acc[2][8];
#pragma unroll
  for (int d = 0; d < 2; ++d)
#pragma unroll
    for (int n = 0; n < 8; ++n) acc[d][n] = f32x4{0.f, 0.f, 0.f, 0.f};
#pragma unroll 1
  for (int s4 = 0; s4 < 4; ++s4) {
    const int j0 = s4 * 32 + q * 8;
    bf16x8 xa = ld8(XT + (size_t)(h * 64 + wave * 16 + l15) * 128 + j0), a0, a1;
#pragma unroll
    for (int jj = 0; jj < 8; ++jj) { float x = bf2f((bf16_t)xa[jj]); a0[jj] = (short)f2bf(x * f[512 + j0 + jj]); a1[jj] = (short)f2bf(x * f[640 + j0 + jj]); }
#pragma unroll
    for (int n = 0; n < 8; ++n) { bf16x8 bb = ld8(XT + (size_t)(512 + grp * 128 + n * 16 + l15) * 128 + j0);
      acc[0][n] = MFMA16(a0, bb, acc[0][n]); acc[1][n] = MFMA16(a1, bb, acc[1][n]); }
  }
#pragma unroll
  for (int d = 0; d < 2; ++d) {
    const int cs = cscan(d, co, CTX_ / 128, SEQ_ / 128);
    float* ST = (float*)(p.ws + Ws::SST) + ((size_t)((d * B_ + b) * NC128 + cs) * 8 + h) * 8192;
#pragma unroll
    for (int n = 0; n < 8; ++n)
#pragma unroll
      for (int r = 0; r < 4; ++r) ST[(wave * 16 + q * 4 + r) * 128 + n * 16 + l15] = acc[d][n][r];
    if (tid == 0) ((float*)(p.ws + Ws::SCD))[((size_t)(d * B_ + b) * NC128 + cs) * 8 + h] = expf(f[d * 128 + 127]);
  }
}
#define SSD_SB ((NC128 % 17) == 0 ? 17 : NC128)
DEVFN void ssd_scan(const Params& p, int gtid, int gthreads) {
  const float* __restrict__ ST = (const float*)(p.ws + Ws::SST); const float* __restrict__ CD = (const float*)(p.ws + Ws::SCD); bf16_t* __restrict__ HIN = (bf16_t*)(p.ws + Ws::HIN);
  for (int e = gtid; e < 2 * B_ * 8 * 8192; e += gthreads) {
    const int pd = e & 8191, h = (e >> 13) & 7, db = e >> 16;
    float hv = 0.f;
#pragma unroll 1
    for (int c0 = 0; c0 < NC128; c0 += SSD_SB) {
      float st[SSD_SB], cd[SSD_SB];
#pragma unroll
      for (int i = 0; i < SSD_SB; ++i) { st[i] = ST[((size_t)(db * NC128 + c0 + i) * 8 + h) * 8192 + pd]; cd[i] = CD[(size_t)(db * NC128 + c0 + i) * 8 + h]; }
#pragma unroll
      for (int i = 0; i < SSD_SB; ++i) { HIN[((size_t)(db * NC128 + c0 + i) * 8 + h) * 8192 + pd] = f2bf(hv); hv = hv * cd[i] + st[i]; }
    }
  }
}
DEVFN void ssd_out(const Params& p, int l, int unit, unsigned char* smem) {
  const int tid = TIDX, lane = tid & 63, wave = tid >> 6, q = lane >> 4, l15 = lane & 15;
  const int h = unit & 7, co = (unit >> 3) % NC128, b = unit / (8 * NC128), grp = h >> 2;
  float* f = (float*)smem;
  ssd_chunk_scalars(p, l, b, co, h, f);
  if (tid < 128) f[640 + tid] = f[128 + 127] - (tid > 0 ? f[128 + tid - 1] : 0.f);
  __syncthreads();
  const float* cum0 = f; const float* suf1 = f + 640; const float* dt0 = f + 256; const float* dt1 = f + 384;
  const bf16_t* XBC = (const bf16_t*)(p.ws + Ws::XBC) + (size_t)(b * T_ + co * 128) * 1024;
  const bf16_t* XT = (const bf16_t*)(p.ws + Ws::XBCT) + (size_t)(b * NC128 + co) * 768 * 128;
  const bf16_t* Cb = XBC + (size_t)(wave * 32 + l15) * 1024 + 768 + grp * 128 + q * 8;
  f32x4 y[4][2];
  { f32x4 o0[4][2], o1[4][2];
#pragma unroll
    for (int mp = 0; mp < 4; ++mp)
#pragma unroll
      for (int ni = 0; ni < 2; ++ni) { o0[mp][ni] = f32x4{0.f, 0.f, 0.f, 0.f}; o1[mp][ni] = f32x4{0.f, 0.f, 0.f, 0.f}; }
    const int cs0 = cscan(0, co, CTX_ / 128, SEQ_ / 128), cs1 = cscan(1, co, CTX_ / 128, SEQ_ / 128);
    const bf16_t* H0 = (const bf16_t*)(p.ws + Ws::HIN) + ((size_t)((0 * B_ + b) * NC128 + cs0) * 8 + h) * 8192;
    const bf16_t* H1 = (const bf16_t*)(p.ws + Ws::HIN) + ((size_t)((1 * B_ + b) * NC128 + cs1) * 8 + h) * 8192;
#pragma unroll 1
    for (int s4 = 0; s4 < 4; ++s4) { const bf16x8 c0 = ld8(Cb + s4 * 32), c1 = ld8(Cb + 16 * 1024 + s4 * 32);
#pragma unroll
      for (int mp = 0; mp < 4; ++mp) { bf16x8 h0 = ld8(H0 + (size_t)(mp * 16 + l15) * 128 + s4 * 32 + q * 8), h1 = ld8(H1 + (size_t)(mp * 16 + l15) * 128 + s4 * 32 + q * 8);
        o0[mp][0] = MFMA16(h0, c0, o0[mp][0]); o0[mp][1] = MFMA16(h0, c1, o0[mp][1]);
        o1[mp][0] = MFMA16(h1, c0, o1[mp][0]); o1[mp][1] = MFMA16(h1, c1, o1[mp][1]); } }
#pragma unroll
    for (int ni = 0; ni < 2; ++ni) { const int i = wave * 32 + ni * 16 + l15; const float e0 = expf(cum0[i]), e1 = expf(suf1[i]);
#pragma unroll
      for (int mp = 0; mp < 4; ++mp)
#pragma unroll
        for (int r = 0; r < 4; ++r) y[mp][ni][r] = e0 * o0[mp][ni][r] + e1 * o1[mp][ni][r]; } }
  bf16x8 mfr[4][2];
  { f32x4 g[8][2];
#pragma unroll
    for (int mj = 0; mj < 8; ++mj) { g[mj][0] = f32x4{0.f, 0.f, 0.f, 0.f}; g[mj][1] = f32x4{0.f, 0.f, 0.f, 0.f}; }
#pragma unroll 1
    for (int s4 = 0; s4 < 4; ++s4) { const bf16x8 c0 = ld8(Cb + s4 * 32), c1 = ld8(Cb + 16 * 1024 + s4 * 32);
#pragma unroll
      for (int mj = 0; mj < 8; ++mj) { bf16x8 bb = ld8(XBC + (size_t)(mj * 16 + l15) * 1024 + 512 + grp * 128 + s4 * 32 + q * 8);
        g[mj][0] = MFMA16(bb, c0, g[mj][0]); g[mj][1] = MFMA16(bb, c1, g[mj][1]); } }
    const int i0 = wave * 32 + l15, i1 = i0 + 16;
    const float c0i0 = cum0[i0], s1i0 = suf1[i0], c0i1 = cum0[i1], s1i1 = suf1[i1];
#pragma unroll
    for (int mj = 0; mj < 8; ++mj)
#pragma unroll
      for (int r = 0; r < 4; ++r) { const int j = mj * 16 + q * 4 + r;
        const float cj = cum0[j], sj = suf1[j], d0 = dt0[j], d1 = dt1[j];
        const float lw0 = (j <= i0 ? expf(c0i0 - cj) * d0 : 0.f) + (j >= i0 ? expf(s1i0 - sj) * d1 : 0.f);
        const float lw1 = (j <= i1 ? expf(c0i1 - cj) * d0 : 0.f) + (j >= i1 ? expf(s1i1 - sj) * d1 : 0.f);
        mfr[mj >> 1][0][(mj & 1) * 4 + r] = (short)f2bf(g[mj][0][r] * lw0);
        mfr[mj >> 1][1][(mj & 1) * 4 + r] = (short)f2bf(g[mj][1][r] * lw1); } }
#pragma unroll
  for (int s4 = 0; s4 < 4; ++s4)
#pragma unroll
    for (int mp = 0; mp < 4; ++mp) { const bf16_t* xr = XT + (size_t)(h * 64 + mp * 16 + l15) * 128 + s4 * 32 + q * 4;
      bf16x8 xa = ld4x2(xr, xr + 16);
      y[mp][0] = MFMA16(xa, mfr[s4][0], y[mp][0]); y[mp][1] = MFMA16(xa, mfr[s4][1], y[mp][1]); }
  __syncthreads();
  float* yl = f + 1024;
#pragma unroll
  for (int mp = 0; mp < 4; ++mp)
#pragma unroll
    for (int ni = 0; ni < 2; ++ni)
#pragma unroll
      for (int r = 0; r < 4; ++r) yl[(wave * 32 + ni * 16 + l15) * 65 + mp * 16 + q * 4 + r] = y[mp][ni][r];
  __syncthreads();
  float* YS = (float*)(p.ws + Ws::YS) + (size_t)(b * T_ + co * 128) * 512 + h * 64;
  for (int e = tid; e < 128 * 64; e += 256) YS[(size_t)(e >> 6) * 512 + (e & 63)] = yl[(e >> 6) * 65 + (e & 63)];
}

#define GQ_LD 40
#define GK_LD 72
DEVFN void gla_chunk(const Params& p, int unit, unsigned char* smem) {
  const int tid = TIDX, lane = tid & 63, wave = tid >> 6, q = lane >> 4, l15 = lane & 15;
  const int h = unit & 3, co = (unit >> 2) % NC64, b = unit / (4 * NC64);
  const bf16_t* ZX = (const bf16_t*)(p.ws + Ws::ZX) + (size_t)(b * T_ + co * 64) * NIN_;
  const float* LA = (const float*)(p.ws + Ws::LA);
  float* cum = (float*)smem;
  bf16_t* qs = (bf16_t*)(smem + 16384);
  bf16_t* ks = qs + 2 * 64 * GQ_LD;
  bf16_t* kt = ks + 2 * 64 * GQ_LD;
  __syncthreads();
  for (int e = tid; e < 2 * 64 * 32; e += 256) { const int d = e >> 11, i = (e >> 5) & 63, dd = e & 31;
    cum[e] = LA[((size_t)d * NT_ + b * T_ + co * 64 + i) * 128 + h * 32 + dd]; }
  __syncthreads();
  if (tid < 64) { const int d = tid >> 5, dd = tid & 31; float* c = cum + d * 2048 + dd; float sacc = 0.f;
    if (d == 0) for (int i = 0; i < 64; ++i) { sacc += c[i * 32]; c[i * 32] = sacc; }
    else for (int i = 63; i >= 0; --i) { sacc += c[i * 32]; c[i * 32] = sacc; } }
  __syncthreads();
  bf16_t* QT = (bf16_t*)(p.ws + Ws::QT);
  for (int e = tid; e < 64 * 32; e += 256) { const int i = e >> 5, dd = e & 31;
    const float qv = bf2f(ZX[(size_t)i * NIN_ + OGQ + h * 32 + dd]) * 0.17677669529663687f, kv = bf2f(ZX[(size_t)i * NIN_ + OGK + h * 32 + dd]);
    const float c0 = cum[i * 32 + dd], c1 = cum[2048 + i * 32 + dd], t0 = cum[63 * 32 + dd], t1 = cum[2048 + dd];
    const bf16_t q0 = f2bf(qv * expf(c0)), q1 = f2bf(qv * expf(c1));
    qs[i * GQ_LD + dd] = q0; qs[64 * GQ_LD + i * GQ_LD + dd] = q1;
    ks[i * GQ_LD + dd] = f2bf(kv * expf(-c0)); ks[64 * GQ_LD + i * GQ_LD + dd] = f2bf(kv * expf(-c1));
    kt[dd * GK_LD + i] = f2bf(kv * expf(t0 - c0)); kt[32 * GK_LD + dd * GK_LD + i] = f2bf(kv * expf(t1 - c1));
    const size_t tok = (size_t)b * T_ + co * 64 + i;
    QT[tok * 128 + h * 32 + dd] = q0; QT[((size_t)NT_ + tok) * 128 + h * 32 + dd] = q1; }
  if (tid < 64) { const int d = tid >> 5, dd = tid & 31; const int cs = cscan(d, co, CTX_ / 64, SEQ_ / 64);
    ((float*)(p.ws + Ws::GCD))[(((size_t)(d * B_ + b) * NC64 + cs) * 4 + h) * 32 + dd] = expf(d == 0 ? cum[63 * 32 + dd] : cum[2048 + dd]); }
  __syncthreads();
  bf16x8 pfr[2];
  { f32x4 p0[4], p1[4];
    const bf16x8 qb0 = ld8(qs + (wave * 16 + l15) * GQ_LD + q * 8), qb1 = ld8(qs + 64 * GQ_LD + (wave * 16 + l15) * GQ_LD + q * 8);
#pragma unroll
    for (int mj = 0; mj < 4; ++mj) { p0[mj] = MFMA16(ld8(ks + (mj * 16 + l15) * GQ_LD + q * 8), qb0, (f32x4{0.f, 0.f, 0.f, 0.f}));
      p1[mj] = MFMA16(ld8(ks + 64 * GQ_LD + (mj * 16 + l15) * GQ_LD + q * 8), qb1, (f32x4{0.f, 0.f, 0.f, 0.f})); }
    const int i = wave * 16 + l15;
#pragma unroll
    for (int mj = 0; mj < 4; ++mj)
#pragma unroll
      for (int r = 0; r < 4; ++r) { const int j = mj * 16 + q * 4 + r; pfr[mj >> 1][(mj & 1) * 4 + r] = (short)f2bf((j <= i ? p0[mj][r] : 0.f) + (j >= i ? p1[mj][r] : 0.f)); } }
  const bf16_t* VT = (const bf16_t*)(p.ws + Ws::VT) + ((size_t)(b * NC64 + co) * 256 + h * 64) * 64;
  f32x4 o[4];
#pragma unroll
  for (int md = 0; md < 4; ++md) { o[md] = f32x4{0.f, 0.f, 0.f, 0.f};
#pragma unroll
    for (int s2 = 0; s2 < 2; ++s2) { const bf16_t* vr = VT + (size_t)(md * 16 + l15) * 64 + s2 * 32 + q * 4; o[md] = MFMA16(ld4x2(vr, vr + 16), pfr[s2], o[md]); } }
#pragma unroll
  for (int d = 0; d < 2; ++d) { const int cs = cscan(d, co, CTX_ / 64, SEQ_ / 64);
    float* GST = (float*)(p.ws + Ws::GST) + (((size_t)(d * B_ + b) * NC64 + cs) * 4 + h) * 2048;
#pragma unroll
    for (int nd = 0; nd < 2; ++nd) { f32x4 st = f32x4{0.f, 0.f, 0.f, 0.f};
#pragma unroll
      for (int s2 = 0; s2 < 2; ++s2) st = MFMA16(ld8(VT + (size_t)(wave * 16 + l15) * 64 + s2 * 32 + q * 8), ld8(kt + d * 32 * GK_LD + (nd * 16 + l15) * GK_LD + s2 * 32 + q * 8), st);
#pragma unroll
      for (int r = 0; r < 4; ++r) GST[(wave * 16 + q * 4 + r) * 32 + nd * 16 + l15] = st[r]; } }
  __syncthreads();
  float* ol = (float*)smem;
#pragma unroll
  for (int md = 0; md < 4; ++md)
#pragma unroll
    for (int r = 0; r < 4; ++r) ol[(wave * 16 + l15) * 65 + md * 16 + q * 4 + r] = o[md][r];
  __syncthreads();
  float* OI = (float*)(p.ws + Ws::OI) + (size_t)(b * T_ + co * 64) * 256 + h * 64;
  for (int e = tid; e < 64 * 64; e += 256) OI[(size_t)(e >> 6) * 256 + (e & 63)] = ol[(e >> 6) * 65 + (e & 63)];
}
#define GLA_SB ((NC64 % 17) == 0 ? 17 : NC64)
DEVFN void gla_scan(const Params& p, int gtid, int gthreads) {
  const float* __restrict__ ST = (const float*)(p.ws + Ws::GST); const float* __restrict__ CD = (const float*)(p.ws + Ws::GCD); bf16_t* __restrict__ SIN = (bf16_t*)(p.ws + Ws::GSIN);
  for (int e = gtid; e < 2 * B_ * 4 * 2048; e += gthreads) {
    const int vd = e & 2047, h = (e >> 11) & 3, db = e >> 13;
    float sv = 0.f;
#pragma unroll 1
    for (int c0 = 0; c0 < NC64; c0 += GLA_SB) {
      float st[GLA_SB], cd[GLA_SB];
#pragma unroll
      for (int i = 0; i < GLA_SB; ++i) { st[i] = ST[(((size_t)db * NC64 + c0 + i) * 4 + h) * 2048 + vd]; cd[i] = CD[(((size_t)db * NC64 + c0 + i) * 4 + h) * 32 + (vd & 31)]; }
#pragma unroll
      for (int i = 0; i < GLA_SB; ++i) { SIN[(((size_t)db * NC64 + c0 + i) * 4 + h) * 2048 + vd] = f2bf(sv); sv = sv * cd[i] + st[i]; }
    }
  }
}
DEVFN void convert_moe_weights(const Params& p, int l, unsigned char* smem, int bid, int nb);
DEVFN void phase4a(const Params& p, int l, unsigned char* smem) {
  const int n_r = B_ * 8 * NC16 / 4;
  for (int u = BIDX; u < n_r; u += gridDim.x) rwkv_chunk(p, (u) * 4, smem);
  (void)l;
}
DEVFN void phase4b(const Params& p, int l, unsigned char* smem) {
  const int bid = BIDX, nrw = B_ * 8, G = (int)gridDim.x;
  const int n_s = B_ * NC128 * 8, n_g = B_ * NC64 * 4;
  int ob = bid, on = G;
  if (G >= 8 * nrw) {
    if (bid < 4 * nrw) { if ((TIDX >> 6) == 0) rwkv_scan(p, bid >> 2, bid & 3); return; }
    ob = bid - 4 * nrw; on = G - 4 * nrw; }
  else { for (int u = bid; u < nrw; u += G) rwkv_scan(p, u, TIDX >> 6); }
  for (int u = ob; u < n_s + n_g; u += on) { if (u < n_s) ssd_states(p, l, u, smem); else gla_chunk(p, u - n_s, smem); }
  convert_moe_weights(p, l, smem, ob, on);
}
DEVFN void phase4b2(const Params& p) {
  const int bid = BIDX, G = (int)gridDim.x;
  ssd_scan(p, bid * 256 + TIDX, G * 256); gla_scan(p, bid * 256 + TIDX, G * 256);
}
DEVFN void phase4c(const Params& p, int l, unsigned char* smem) {
  const int n_s = B_ * NC128 * 8, n_r = B_ * 8 * NC16 / 4;
  for (int u = BIDX; u < n_s + n_r; u += gridDim.x) { if (u < n_s) ssd_out(p, l, u, smem); else rwkv_out(p, (u - n_s) * 4); }
}

DEVFN void phase5(const Params& p, int l, unsigned char* smem) {
  const int tid = TIDX, lane = tid & 63, wave = tid >> 6;
  const bf16_t* ZX = (const bf16_t*)(p.ws + Ws::ZX);
  const bf16_t* XBC = (const bf16_t*)(p.ws + Ws::XBC);
  const float* YS = (const float*)(p.ws + Ws::YS); const float* YR = (const float*)(p.ws + Ws::YR); const float* OI = (const float*)(p.ws + Ws::OI);
  const bf16_t* QT = (const bf16_t*)(p.ws + Ws::QT); const bf16_t* GSIN = (const bf16_t*)(p.ws + Ws::GSIN);
  const bf16_t* RR = (const bf16_t*)(p.ws + Ws::RR); const bf16_t* VV = (const bf16_t*)(p.ws + Ws::VV); const bf16_t* KD = (const bf16_t*)(p.ws + Ws::KD);
  const float* GATE = (const float*)(p.ws + Ws::GATE);
  bf16_t* YM = (bf16_t*)(p.ws + Ws::YMIX);
  float* red = (float*)smem;
  float* qt = red + 16;
  const float dA = INP(I_SSDD)[(size_t)l * 8 + (tid >> 6)], dB = INP(I_SSDD)[(size_t)l * 8 + 4 + (tid >> 6)];
  const float nwA = INP(I_SSDNW)[(size_t)l * 512 + tid], nwB = INP(I_SSDNW)[(size_t)l * 512 + 256 + tid];
  const float lnw = INP(I_LNXW)[(size_t)l * 256 + tid], lnb = INP(I_LNXB)[(size_t)l * 256 + tid], rk = INP(I_RK)[(size_t)l * 256 + tid];
  const float gnw = INP(I_GNW)[(size_t)l * 256 + tid];
  const int per_ = (NT_ / 2 + (int)gridDim.x - 1) / (int)gridDim.x, tp_lo = BIDX * per_, tp_hi = (tp_lo + per_ < NT_ / 2) ? tp_lo + per_ : NT_ / 2;
  for (int tp = tp_lo; tp < tp_hi; ++tp) {
    float ya[2], yb[2], qa[2], qb[2];
#pragma unroll
    for (int t = 0; t < 2; ++t) { const int tok = tp * 2 + t;
      ya[t] = YS[(size_t)tok * 512 + tid] + dA * bf2f(XBC[(size_t)tok * 1024 + tid]);
      yb[t] = YS[(size_t)tok * 512 + 256 + tid] + dB * bf2f(XBC[(size_t)tok * 1024 + 256 + tid]);
      ya[t] *= siluf_(zxv(ZX, tok, OZ + tid)); yb[t] *= siluf_(zxv(ZX, tok, OZ + 256 + tid));
      qa[t] = wave_sum(ya[t] * ya[t]); qb[t] = wave_sum(yb[t] * yb[t]); }
    __syncthreads();
#pragma unroll
    for (int t = 0; t < 2; ++t) { const int tok = tp * 2 + t;
      if (lane == 0) { red[t * 8 + wave] = qa[t]; red[t * 8 + 4 + wave] = qb[t]; }
      qt[t * 256 + tid] = bf2f(QT[((size_t)(tid >> 7) * NT_ + tok) * 128 + (tid & 127)]); }
    __syncthreads();
#pragma unroll
    for (int t = 0; t < 2; ++t) { const int tok = tp * 2 + t;
      const float* rd = red + t * 8; const float* qtt = qt + t * 256;
      float ma = (rd[0] + rd[1] + rd[2] + rd[3]) * (1.f / 256.f), mb = (rd[4] + rd[5] + rd[6] + rd[7]) * (1.f / 256.f);
      YM[(size_t)tok * 1024 + tid] = f2bf(ya[t] * rsqrtf(ma + 1e-5f) * nwA);
      YM[(size_t)tok * 1024 + 256 + tid] = f2bf(yb[t] * rsqrtf(mb + 1e-5f) * nwB);
      { float y = YR[(size_t)tok * 256 + tid] + YR[((size_t)NT_ + tok) * 256 + tid];
        float mu = wave_sum(y) * (1.f / 64.f), d = y - mu, var = wave_sum(d * d) * (1.f / 64.f);
        float yn = d * rsqrtf(var + 64e-5f) * lnw + lnb;
        float r = bf2f(RR[(size_t)tok * 256 + tid]), kf = bf2f(KD[(size_t)tok * 256 + tid]), kb = bf2f(KD[((size_t)NT_ + tok) * 256 + tid]);
        float bonus = wave_sum(r * (kf + kb) * rk) * bf2f(VV[(size_t)tok * 256 + tid]);
        YM[(size_t)tok * 1024 + 512 + tid] = f2bf((yn + bonus) * GATE[(size_t)tok * 256 + tid]); }
      { float o = OI[(size_t)tok * 256 + tid];
        const int b = tok / T_, co = (tok % T_) / 64;
#pragma unroll
        for (int d = 0; d < 2; ++d) { const int cs = cscan(d, co, CTX_ / 64, SEQ_ / 64);
          const bf16_t* sr = GSIN + ((((size_t)(d * B_ + b) * NC64 + cs) * 4 + wave) * 64 + lane) * 32;
#pragma unroll
          for (int c8 = 0; c8 < 4; ++c8) { bf16x8 sv = ld8(sr + c8 * 8);
#pragma unroll
            for (int jj = 0; jj < 8; ++jj) o += qtt[d * 128 + wave * 32 + c8 * 8 + jj] * bf2f((bf16_t)sv[jj]); } }
        float ms = wave_sum(o * o) * (1.f / 64.f);
        YM[(size_t)tok * 1024 + 768 + tid] = f2bf(o * rsqrtf(ms + 1e-5f) * gnw * siluf_(zxv(ZX, tok, OOG + tid))); } }
  }
}

DEVFN void phase6(const Params& p, int l, unsigned char* smem) {
  const bf16_t* A = (const bf16_t*)(p.ws + Ws::YMIX);
  const bf16_t* W = (const bf16_t*)(p.ws + Ws::WOUT) + (size_t)l * 1024 * 1024;
  float* MIX = (float*)(p.ws + Ws::MIX);
  for (int u = BIDX; u < (NT_ / 128) * 8; u += gridDim.x) {
    int rt = u / 8, ct = u % 8;
    gemm_tile(smem, 1024,
      [&](int r) { return A + (size_t)(rt * 128 + r) * 1024; },
      [&](int r) { return W + (size_t)(ct * 128 + r) * 1024; },
      [&](f32x4 (&acc)[4][4], int wr, int wc, int g, int l15) {
#pragma unroll
        for (int mi = 0; mi < 4; ++mi)
#pragma unroll
          for (int ni = 0; ni < 4; ++ni)
#pragma unroll
            for (int i = 0; i < 4; ++i) MIX[(size_t)(rt * 128 + wr * 64 + mi * 16 + 4 * g + i) * 1024 + ct * 128 + wc * 64 + ni * 16 + l15] = acc[mi][ni][i];
      });
  }
}

DEVFN void phase7(const Params& p, int l, unsigned char* smem) {
  const int lane = TIDX & 63, wave = TIDX >> 6;
  float* X = (float*)(p.ws + Ws::X);
  const float* MIX = (const float*)(p.ws + Ws::MIX);
  bf16_t* H = (bf16_t*)(p.ws + Ws::U);
  const float* rwt = (const float*)(p.ws + Ws::RWT) + (size_t)l * 64 * 1024;
  int* cnt = (int*)(p.ws + Ws::CNT) + l * 64;
  int* ltok = (int*)(p.ws + Ws::LTOK); float* lwt = (float*)(p.ws + Ws::LWT);
  const float rbias = INP(I_RB)[(size_t)l * 64 + lane];
  float* hs = (float*)smem;
  float* lg = hs + 4096;
  for (int tok0 = BIDX * 4; tok0 < NT_; tok0 += gridDim.x * 4) {
    const int tok = tok0 + wave;
    const float* mod = (const float*)(p.ws + Ws::MOD) + ((size_t)l * NR_ + tok_modrow(tok)) * NMOD_;
    float xv[16], t0[16], t1[16], mean, rstd;
    load_row16(X + (size_t)tok * 1024, lane, xv);
    load_row16(MIX + (size_t)tok * 1024, lane, t0);
    load_row16(mod + 2 * 1024, lane, t1);
#pragma unroll
    for (int i = 0; i < 16; ++i) xv[i] = ALPHA_ * xv[i] + t1[i] * t0[i];
    row_stats(xv, mean, rstd);
    load_row16(INP(I_LN1W) + (size_t)l * 1024, lane, t0);
    load_row16(INP(I_LN1B) + (size_t)l * 1024, lane, t1);
#pragma unroll
    for (int i = 0; i < 16; ++i) xv[i] = (xv[i] - mean) * rstd * t0[i] + t1[i];
#pragma unroll
    for (int j = 0; j < 4; ++j) *(float4*)(X + (size_t)tok * 1024 + lane * 4 + 256 * j) = make_float4(xv[4 * j], xv[4 * j + 1], xv[4 * j + 2], xv[4 * j + 3]);
    const bool routed = !(l == DEPTH_ - 1 && (tok % T_) < CTX_);
    row_stats(xv, mean, rstd);
    load_row16(mod + 3 * 1024, lane, t0);
    load_row16(mod + 4 * 1024, lane, t1);
#pragma unroll
    for (int i = 0; i < 16; ++i) xv[i] = (xv[i] - mean) * rstd * (1.f + t1[i]) + t0[i];
    __syncthreads();
#pragma unroll
    for (int j = 0; j < 4; ++j) {
      if (routed) *(uint2*)(H + (size_t)tok * 1024 + lane * 4 + 256 * j) = make_uint2((unsigned)f2bf(xv[4 * j]) | ((unsigned)f2bf(xv[4 * j + 1]) << 16), (unsigned)f2bf(xv[4 * j + 2]) | ((unsigned)f2bf(xv[4 * j + 3]) << 16));
      *(float4*)(hs + wave * 1024 + lane * 4 + 256 * j) = make_float4(xv[4 * j], xv[4 * j + 1], xv[4 * j + 2], xv[4 * j + 3]); }
    __syncthreads();
    { float hv[4][16];
      const int rot = BIDX & 15;
#pragma unroll
      for (int t = 0; t < 4; ++t)
#pragma unroll
        for (int j = 0; j < 4; ++j) { const float4 v = *(const float4*)(hs + t * 1024 + lane * 4 + 256 * j); hv[t][4 * j] = v.x; hv[t][4 * j + 1] = v.y; hv[t][4 * j + 2] = v.z; hv[t][4 * j + 3] = v.w; }
      float pe[64];
#pragma unroll
      for (int e = 0; e < 16; ++e) {
        float4 w[4];
#pragma unroll
        for (int j = 0; j < 4; ++j) w[j] = *(const float4*)(rwt + (size_t)(16 * wave + ((e + rot) & 15)) * 1024 + lane * 4 + 256 * j);
#pragma unroll
        for (int t = 0; t < 4; ++t) { float sacc = 0.f;
#pragma unroll
          for (int j = 0; j < 4; ++j) sacc += hv[t][4 * j] * w[j].x + hv[t][4 * j + 1] * w[j].y + hv[t][4 * j + 2] * w[j].z + hv[t][4 * j + 3] * w[j].w;
          pe[e * 4 + t] = sacc; } }
#pragma unroll
      for (int half = 32; half >= 1; half >>= 1) { const bool up = (lane & half) != 0;
#pragma unroll
        for (int e = 0; e < half; ++e) { const float send = up ? pe[e] : pe[e + half]; const float recv = __shfl_xor(send, half); pe[e] = (up ? pe[e + half] : pe[e]) + recv; } }
      lg[(lane & 3) * 64 + 16 * wave + (((lane >> 2) + rot) & 15)] = pe[0]; }
    __syncthreads();
    if (!routed) continue;
    const float logit = lg[wave * 64 + lane];
    const float score = sigmoidf_(logit), sel = score + rbias;
    float m1 = sel; int a1 = lane;
#pragma unroll
    for (int m = 1; m <= 4; m <<= 1) { float ov = __shfl_xor(m1, m); int oa = __shfl_xor(a1, m); if (ov > m1 || (ov == m1 && oa < a1)) { m1 = ov; a1 = oa; } }
    float m2 = (lane == a1) ? -3.0e38f : sel;
#pragma unroll
    for (int m = 1; m <= 4; m <<= 1) m2 = fmaxf(m2, __shfl_xor(m2, m));
    const float gs = m1 + m2; const int grp = lane >> 3;
    int grank = 0;
#pragma unroll
    for (int g2 = 0; g2 < 8; ++g2) { float og = __shfl(gs, g2 * 8); grank += (og > gs || (og == gs && g2 < grp)) ? 1 : 0; }
    const bool gsel = grank < 4;
    const float msel = gsel ? sel : -3.0e38f;
    int rank = 0;
    for (int e = 0; e < 64; ++e) { float ov = __shfl(msel, e); rank += (ov > msel || (ov == msel && e < lane)) ? 1 : 0; }
    const bool chosen = gsel && rank < 8;
    const float wsum = wave_sum(chosen ? score : 0.f);
    if (chosen) { int pos = atomicAdd(&cnt[lane], 1); ltok[(size_t)lane * NT_ + pos] = tok * 8 + rank; lwt[(size_t)lane * NT_ + pos] = score / wsum * 2.5f; }
  }
}

struct MoeMap { int nblk_total; int e; int rb; int cnt; int hoff; };
DEVFN int moe_ntok(int l) { return l == DEPTH_ - 1 ? B_ * SEQ_ : NT_; }
DEVFN int moe_shared_tok(int l, int i) { return l == DEPTH_ - 1 ? (i / SEQ_) * T_ + CTX_ + (i % SEQ_) : i; }
DEVFN void moe_prefix(const Params& p, int l, int* pre) {
  const int* cnt = (const int*)(p.ws + Ws::CNT) + l * 64;
  __syncthreads();
  if (TIDX == 0) { int s = 0; for (int e = 0; e < 65; ++e) { pre[e] = s; int c = e < 64 ? cnt[e] : moe_ntok(l); pre[66 + e] = c; s += (c + 127) / 128; } pre[65] = s; }
  __syncthreads();
}
DEVFN void phase8(const Params& p, int l, unsigned char* smem) {
  int* pre = (int*)(smem + SM_PRE);
  moe_prefix(p, l, pre);
  const bf16_t* H = (const bf16_t*)(p.ws + Ws::U);
  const bf16_t* W13 = (const bf16_t*)(p.ws + Ws::W13);
  bf16_t* HID = (bf16_t*)(p.ws + Ws::HID);
  const int* ltok = (const int*)(p.ws + Ws::LTOK); const float* lwt = (const float*)(p.ws + Ws::LWT);
  const int total = pre[65];
  for (int u = BIDX; u < total * 4; u += gridDim.x) {
    const int gb = u >> 2, nt = u & 3;
    int e = 0; while (pre[e + 1] <= gb) ++e;
    const int rb = gb - pre[e], cnt = pre[66 + e];
    gemm_tile(smem, 1024,
      [&](int r) { int pos = rb * 128 + r; if (pos >= cnt) return (const bf16_t*)(p.ws + Ws::ZROW); int tok = e < 64 ? (ltok[(size_t)e * NT_ + pos] >> 3) : moe_shared_tok(l, pos); return H + (size_t)tok * 1024; },
      [&](int r) { return W13 + ((size_t)e * 512 + nt * 128 + r) * 1024; },
      [&](f32x4 (&acc)[4][4], int wr, int wc, int g, int l15) {
        tile_store_bf16<8>(smem, wr, g, l15,
          [&](bf16_t* T, int ldc) {
#pragma unroll
            for (int mi = 0; mi < 4; ++mi)
#pragma unroll
              for (int i = 0; i < 4; ++i) { const int r = wr * 64 + mi * 16 + 4 * g + i, pos = rb * 128 + r;
                const float gw = pos < cnt ? (e < 64 ? lwt[(size_t)e * NT_ + pos] : 1.f) : 0.f;
#pragma unroll
                for (int j = 0; j < 2; ++j) T[r * ldc + wc * 32 + j * 16 + l15] = f2bf(siluf_(acc[mi][2 * j][i]) * acc[mi][2 * j + 1][i] * gw); } },
          [&](int row, int c0) { const int pos = rb * 128 + row; return pos < cnt ? HID + ((size_t)gb * 128 + row) * 256 + nt * 64 + c0 : (bf16_t*)nullptr; });
      });
  }
}
DEVFN void phase9(const Params& p, int l, unsigned char* smem) {
  int* pre = (int*)(smem + SM_PRE);
  moe_prefix(p, l, pre);
  const bf16_t* HID = (const bf16_t*)(p.ws + Ws::HID);
  const bf16_t* W2T = (const bf16_t*)(p.ws + Ws::W2T);
  bf16_t* YB = (bf16_t*)(p.ws + Ws::YBUF);
  const int* ltok = (const int*)(p.ws + Ws::LTOK);
  const int total = pre[65];
  for (int u = BIDX; u < total * 8; u += gridDim.x) {
    const int gb = u >> 3, nt = u & 7;
    int e = 0; while (pre[e + 1] <= gb) ++e;
    const int rb = gb - pre[e], cnt = pre[66 + e];
    gemm_tile(smem, 256,
      [&](int r) { int pos = rb * 128 + r; return pos < cnt ? HID + ((size_t)gb * 128 + r) * 256 : (const bf16_t*)(p.ws + Ws::ZROW); },
      [&](int r) { return W2T + ((size_t)e * 1024 + nt * 128 + r) * 256; },
      [&](f32x4 (&acc)[4][4], int wr, int wc, int g, int l15) {
        tile_store_bf16<16>(smem, wr, g, l15,
          [&](bf16_t* T, int ldc) {
#pragma unroll
            for (int mi = 0; mi < 4; ++mi)
#pragma unroll
              for (int ni = 0; ni < 4; ++ni)
#pragma unroll
                for (int i = 0; i < 4; ++i) T[(wr * 64 + mi * 16 + 4 * g + i) * ldc + wc * 64 + ni * 16 + l15] = f2bf(acc[mi][ni][i]); },
          [&](int row, int c0) { const int pos = rb * 128 + row; if (pos >= cnt) return (bf16_t*)nullptr;
            const int ts = e < 64 ? ltok[(size_t)e * NT_ + pos] : moe_shared_tok(l, pos) * 8; const int tok = ts >> 3, slot = e < 64 ? (ts & 7) : 8;
            return YB + ((size_t)tok * NSLOT + slot) * 1024 + nt * 128 + c0; });
      });
  }
}

#define SMEM_BYTES (PH_SMEM + 2048)
#define N_PHASES (3 + 13 * DEPTH_)
__global__ void __launch_bounds__(256, 2) mega(Params p, int ph_lo, int ph_hi) {
#ifdef HIPEMU
  unsigned char* smem = hipemu::cur_smem();
#else
  unsigned char* smem = smem_dyn;
  volatile LAS unsigned* st = (volatile LAS unsigned*)(smem_dyn + SM_BAR);
  if (threadIdx.x == 0) {
    st[0] = 0u; st[1] = 0u;
    unsigned long long* tab = (unsigned long long*)(smem_dyn + SM_TAB);
#pragma unroll
    for (int i = 0; i < 40; ++i) tab[i] = (unsigned long long)p.in[i];
  }
  __syncthreads();
  XcdBarrier bar = xcd_barrier_post((unsigned*)(p.ws + Ws::BAR), st);
#define GRID_SYNC() xcd_barrier(bar)
#endif
  int ph = 0;
#ifdef ONLY_KIND
#define KIND_ON(k) ((k) == ONLY_KIND)
#else
#define KIND_ON(k) 1
#endif
#ifndef REPEAT_MASK
#define REPEAT_MASK 0u
#endif
#define RUN_PHASE(kind, code) { if (KIND_ON(kind) && ph >= ph_lo && ph < ph_hi) { \
    int nrep_ = ((REPEAT_MASK >> (kind)) & 1u) ? 2 : 1; LAUNDER(nrep_); \
    _Pragma("unroll 1") for (int rep_ = 0; rep_ < nrep_; ++rep_) { LAUNDER(p.ws); LAUNDER(p.out); code; if (rep_ + 1 < nrep_ || ph + 1 < ph_hi) { GRID_SYNC(); } } } ++ph; }
  RUN_PHASE(0, phase0(p, smem));
  RUN_PHASE(11, phase0b(p));
  for (int l = 0; l < DEPTH_; ++l) {
    RUN_PHASE(1, phase1(p, l));
    RUN_PHASE(2, phase2(p, l, smem));
    RUN_PHASE(3, phase3(p, l, smem));
    RUN_PHASE(14, phase3b(p, l, smem));
    RUN_PHASE(4, phase4a(p, l, smem));
    RUN_PHASE(12, phase4b(p, l, smem));
    RUN_PHASE(16, phase4b2(p));
    RUN_PHASE(13, phase4c(p, l, smem));
    RUN_PHASE(5, phase5(p, l, smem));
    RUN_PHASE(6, phase6(p, l, smem));
    RUN_PHASE(7, phase7(p, l, smem));
    RUN_PHASE(8, phase8(p, l, smem));
    RUN_PHASE(9, phase9(p, l, smem));
  }
  RUN_PHASE(10, phase_final(p));
}

extern "C" void kernel_launch(void* const* d_in, const int* in_sizes, int n_in, void* d_out, int out_size, void* d_ws, size_t ws_size, hipStream_t stream) {
  Params p{};
  for (int i = 0; i < 40; ++i) p.in[i] = (const float*)d_in[i];
  p.out = (float*)d_out;
  p.ws = (unsigned char*)d_ws;
  if (ws_size < Ws::END) { fprintf(stderr, "workspace too small: %zu < %zu\n", ws_size, (size_t)Ws::END); return; }
  hipMemsetAsync(d_ws, 0, Ws::ZERO_END, stream);
#ifdef HIPEMU
  int grid = 16; if (const char* e = getenv("EMU_GRID")) grid = atoi(e);
  int stop = N_PHASES; if (const char* e = getenv("EMU_STOP")) stop = atoi(e);
  if (getenv("EMU_ONE")) hipemu::launch(grid, 256, SMEM_BYTES, true, [=] { mega(p, 0, stop); });
  else for (int ph = 0; ph < stop; ++ph) hipemu::launch(grid, 256, SMEM_BYTES, false, [=] { mega(p, ph, ph + 1); });
#else
  static int grid = 0;
  if (!grid) {
    int dev = 0, cus = 0, per_cu = 0;
    hipGetDevice(&dev);
    hipDeviceGetAttribute(&cus, hipDeviceAttributeMultiprocessorCount, dev);
    hipOccupancyMaxActiveBlocksPerMultiprocessor(&per_cu, mega, 256, SMEM_BYTES);
    if (per_cu > 2) per_cu = 2;
    if (per_cu < 1) per_cu = 1;
    grid = cus * per_cu;
  }
#if N_LAUNCH_MODE == 1
  mega<<<grid, 256, SMEM_BYTES, stream>>>(p, 0, N_PHASES);
#else
  for (int ph = 0; ph < N_PHASES; ++ph) mega<<<grid, 256, SMEM_BYTES, stream>>>(p, ph, ph + 1);
#endif
#endif
}
```

```cpp
#ifndef HIPEMU
#include <hip/hip_runtime.h>
#endif
#include <stdint.h>
#include <stdio.h>

#ifndef B_
#define B_ 4
#endif
#ifndef SEQ_
#define SEQ_ 4096
#endif
#ifndef CTX_
#define CTX_ 256
#endif
#ifndef DEPTH_
#define DEPTH_ 4
#endif
#ifndef N_LAUNCH_MODE
#define N_LAUNCH_MODE 1
#endif
#define T_ (SEQ_ + CTX_)
#define NT_ (B_ * T_)
#define D_ 1024
#define NIN_ 3504
#define NMOD_ 6144
#define NR_ (B_ + 1)
#define OZ 0
#define OXBC 512
#define ODT 1536
#define ORW 1552
#define OGQ 2704
#define OGK 2832
#define OGV 2960
#define OGD 3216
#define OOG 3248
#define ALPHA_ 1.681792830507429f
#define NEXP 64
#define NSLOT 9
#define NC128 (T_ / 128)
#define NC64 (T_ / 64)
#define NC16 (T_ / 16)

#define DEVFN __device__ __forceinline__
#define LDT 72
#define GEMM_SMEM (2 * 128 * LDT * 2)
typedef unsigned short bf16_t;
#ifdef HIPEMU
#define AS1
#else
#define AS1 __attribute__((address_space(1)))
#endif
typedef unsigned u32x4 __attribute__((ext_vector_type(4)));
typedef unsigned u32x2 __attribute__((ext_vector_type(2)));

#ifdef HIPEMU
typedef emu_bf16x8 bf16x8;
typedef emu_f32x4 f32x4;
#define MFMA16(a, b, c) emu_mfma_16x16x32_bf16(a, b, c)
#define MFMA16K16(a, b, c) emu_mfma_16x16x16_bf16(a, b, c)
#define GRID_SYNC() hipemu::grid_sync()
#else
typedef short bf16x8 __attribute__((ext_vector_type(8)));
typedef float f32x4 __attribute__((ext_vector_type(4)));
#define MFMA16(a, b, c) __builtin_amdgcn_mfma_f32_16x16x32_bf16(a, b, c, 0, 0, 0)
#define MFMA16K16(a, b, c) __builtin_amdgcn_mfma_f32_16x16x16bf16_1k(a, b, c, 0, 0, 0)
#endif

DEVFN float bf2f(bf16_t h) { return __builtin_bit_cast(float, (unsigned)h << 16); }
DEVFN bf16_t f2bf(float f) { unsigned u = __builtin_bit_cast(unsigned, f); u += 0x7FFFu + ((u >> 16) & 1u); return (bf16_t)(u >> 16); }
template <class T> DEVFN AS1 T* gptr(T* q) { return (AS1 T*)q; }
DEVFN bf16x8 ld8g(const bf16_t* q) { return *(const AS1 bf16x8*)gptr(q); }
DEVFN float sigmoidf_(float x) { return 1.f / (1.f + expf(-x)); }
DEVFN float siluf_(float x) { return x / (1.f + expf(-x)); }
DEVFN float softplusf_(float x) { return x > 20.f ? x : log1pf(expf(x)); }
DEVFN float logsigmoidf_(float x) { return fminf(x, 0.f) - log1pf(expf(-fabsf(x))); }
#ifdef HIPEMU
DEVFN float wave_sum(float v) { for (int m = 32; m >= 1; m >>= 1) v += __shfl_xor(v, m); return v; }
#define SHFL_CONST(x, ln) __shfl(x, ln)
#define XOR8(x, m) __shfl_xor(x, m)
#else
template <int CTRL> DEVFN float dpp_f(float v) { return __builtin_bit_cast(float, __builtin_amdgcn_update_dpp(0, __builtin_bit_cast(int, v), CTRL, 0xF, 0xF, false)); }
template <int CTRL> DEVFN int dpp_i(int v) { return __builtin_amdgcn_update_dpp(0, v, CTRL, 0xF, 0xF, false); }
DEVFN float rdl_f(float v, int ln) { return __builtin_bit_cast(float, __builtin_amdgcn_readlane(__builtin_bit_cast(int, v), ln)); }
DEVFN float wave_sum(float v) {
  v += dpp_f<0xB1>(v);
  v += dpp_f<0x4E>(v);
  v += dpp_f<0x141>(v);
  v += dpp_f<0x140>(v);
  return (rdl_f(v, 0) + rdl_f(v, 16)) + (rdl_f(v, 32) + rdl_f(v, 48));
}
DEVFN float shfl_const_(float x, int ln) { return rdl_f(x, ln); }
DEVFN int shfl_const_(int x, int ln) { return __builtin_amdgcn_readlane(x, ln); }
#define SHFL_CONST(x, ln) shfl_const_(x, ln)
DEVFN float xor8_(float x, int m) { return m == 1 ? dpp_f<0xB1>(x) : m == 2 ? dpp_f<0x4E>(x) : dpp_f<0x141>(x); }
DEVFN int xor8_(int x, int m) { return m == 1 ? dpp_i<0xB1>(x) : m == 2 ? dpp_i<0x4E>(x) : dpp_i<0x141>(x); }
#define XOR8(x, m) xor8_(x, m)
#endif

constexpr size_t al(size_t x) { return (x + 255) & ~(size_t)255; }
struct Ws {
  static constexpr size_t BAR = 0;
  static constexpr size_t CNT = 16384;
  static constexpr size_t MOD = CNT + 4096;
  static constexpr size_t ZROW = al(MOD + (size_t)DEPTH_ * NR_ * NMOD_ * 4);
  static constexpr size_t ZERO_END = al(ZROW + 2048);
  static constexpr size_t MODP = ZERO_END;
  static constexpr size_t RWT = al(MODP + (size_t)16 * DEPTH_ * NR_ * NMOD_ * 4);
  static constexpr size_t LORA = al(RWT + (size_t)DEPTH_ * 64 * 1024 * 4);
  static constexpr size_t X = al(LORA + (size_t)DEPTH_ * 98304 * 2);
  static constexpr size_t U = al(X + (size_t)NT_ * 1024 * 4);
  static constexpr size_t YMIX = al(U + (size_t)NT_ * 1024 * 2);
  static constexpr size_t ZX = al(YMIX + (size_t)NT_ * 1024 * 2);
  static constexpr size_t MIX = ZX;
  static constexpr size_t LTOK = al(ZX + (size_t)NT_ * NIN_ * 2);
  static constexpr size_t LWT = al(LTOK + (size_t)64 * NT_ * 4);
  static constexpr size_t WIN = al(LWT + (size_t)64 * NT_ * 4);
  static constexpr size_t WOUT = al(WIN + (size_t)DEPTH_ * NIN_ * 1024 * 2);
  static constexpr size_t W13 = al(WOUT + (size_t)DEPTH_ * 1024 * 1024 * 2);
  static constexpr size_t W2T = al(W13 + (size_t)65 * 512 * 1024 * 2);
  static constexpr size_t UNI = al(W2T + (size_t)65 * 1024 * 256 * 2);
  static constexpr size_t XBC = UNI;
  static constexpr size_t XBCT = al(XBC + (size_t)NT_ * 1024 * 2);
  static constexpr size_t DTB = al(XBCT + (size_t)NT_ * 768 * 2);
  static constexpr size_t SST = al(DTB + (size_t)NT_ * 16 * 4);
  static constexpr size_t SCD = al(SST + (size_t)2 * NT_ / 128 * 8 * 8192 * 4);
  static constexpr size_t HIN = al(SCD + (size_t)2 * NT_ / 128 * 8 * 4);
  static constexpr size_t YS = SST;
  static constexpr size_t LA = al(HIN + (size_t)2 * NT_ / 128 * 8 * 8192 * 2);
  static constexpr size_t VT = al(LA + (size_t)2 * NT_ * 128 * 4);
  static constexpr size_t QT = al(VT + (size_t)NT_ * 256 * 2);
  static constexpr size_t OI = al(QT + (size_t)2 * NT_ * 128 * 2);
  static constexpr size_t GST = al(OI + (size_t)NT_ * 256 * 4);
  static constexpr size_t GCD = al(GST + (size_t)2 * NT_ / 64 * 4 * 2048 * 4);
  static constexpr size_t GSIN = al(GCD + (size_t)2 * NT_ / 64 * 4 * 32 * 4);
  static constexpr size_t RR = al(GSIN + (size_t)2 * NT_ / 64 * 4 * 2048 * 2);
  static constexpr size_t VV = RR + (size_t)NT_ * 256 * 2;
  static constexpr size_t KK = VV + (size_t)NT_ * 256 * 2;
  static constexpr size_t KD = KK + (size_t)NT_ * 256 * 2;
  static constexpr size_t BD = KD + (size_t)2 * NT_ * 256 * 2;
  static constexpr size_t LW = BD + (size_t)2 * NT_ * 256 * 2;
  static constexpr size_t GATE = LW + (size_t)2 * NT_ * 256 * 4;
  static constexpr size_t YR = GATE + (size_t)NT_ * 256 * 4;
  static constexpr size_t RML = al(YR + (size_t)2 * NT_ * 256 * 4);
  static constexpr size_t RNS = RML + (size_t)(NT_ / 16) * 8 * 4096 * 2;
  static constexpr size_t RWC = RNS + (size_t)(NT_ / 16) * 8 * 4096 * 2;
  static constexpr size_t RG = RWC + (size_t)(NT_ / 16) * 8 * 64 * 4;
  static constexpr size_t RY0 = RG + (size_t)(NT_ / 16) * 8 * 1024 * 2;
  static constexpr size_t LI = RY0 + (size_t)(NT_ / 16) * 8 * 1024 * 4;
  static constexpr size_t KRW = LI + (size_t)NT_ * 384 * 2;
  static constexpr size_t MIXER_END = KRW + (size_t)NT_ * 256 * 2;
  static constexpr size_t HID = UNI;
  static constexpr size_t YBUF = al(HID + ((size_t)NT_ * 9 + 65 * 128) * 256 * 2);
  static constexpr size_t MOE_END = YBUF + (size_t)NT_ * 9 * 1024 * 2;
  static constexpr size_t END = al(MIXER_END > MOE_END ? MIXER_END : MOE_END);
};

struct Params {
  const float* in[40];
  float* out;
  unsigned char* ws;
};
enum { I_X = 0, I_C, I_CTX, I_CCTX, I_ADAW, I_ADAB, I_WIN, I_CONVW, I_CONVB, I_DTBIAS, I_ALOG, I_SSDD, I_SSDNW, I_MU, I_W0, I_W2, I_A0, I_A2,
       I_G2, I_KKW, I_KAW, I_RK, I_LNXW, I_LNXB, I_GU, I_GB, I_GNW, I_WOUT, I_LN1W, I_LN1B, I_LN2W, I_LN2B, I_RW, I_RB, I_EW1, I_EW3, I_EW2,
       I_SW1, I_SW3, I_SW2 };

#define PH_SMEM 47104
#define SM_PRE (PH_SMEM)
#define SM_TAB (PH_SMEM + 1024)
#define SM_BAR (PH_SMEM + 2032)
#ifdef HIPEMU
#define INP(i) (p.in[i])
#define LAUNDER(x)
#define TIDX ((int)threadIdx.x)
#define BIDX ((int)blockIdx.x)
#define LAUNDER_V(x)
#else
extern __shared__ __align__(16) unsigned char smem_dyn[];
DEVFN const float* inp_lds(int i) {
  const volatile unsigned* t = (const volatile unsigned*)(smem_dyn + SM_TAB) + 2 * i;
  unsigned lo = __builtin_amdgcn_readfirstlane(t[0]), hi = __builtin_amdgcn_readfirstlane(t[1]);
  return (const float*)(((unsigned long long)hi << 32) | lo);
}
#define INP(i) inp_lds(i)
#define LAUNDER(x) asm volatile("" : "+s"(x))
DEVFN int tidx_() { int t = threadIdx.x; asm volatile("" : "+v"(t)); return t; }
DEVFN int bidx_() { int b = blockIdx.x; asm volatile("" : "+s"(b)); return b; }
#define TIDX tidx_()
#define LAUNDER_V(x) asm volatile("" : "+v"(x))
#define BIDX bidx_()
#endif
#ifndef HIPEMU
#define XB_TMO      128
#define XB_XCNT(j)  (256  + 64 * (j))
#define XB_XSUB(j)  (1280 + 64 * (j))
#define XB_XGEN(j)  (2304 + 64 * (j))
#define XB_TOP      3328
#define XB_TOPGEN   3392
#define XCD_BAR_WORDS 3456
#define XB_SPIN_CAP (1u << 22)
#define LAS __attribute__((address_space(3)))
__device__ __forceinline__ unsigned xb_ld(unsigned* p)              { return __hip_atomic_load(p, __ATOMIC_RELAXED, __HIP_MEMORY_SCOPE_AGENT); }
__device__ __forceinline__ unsigned xb_add(unsigned* p, unsigned v) { return __hip_atomic_fetch_add(p, v, __ATOMIC_RELAXED, __HIP_MEMORY_SCOPE_AGENT); }
__device__ __forceinline__ unsigned xb_xcc_id() { return (unsigned)__builtin_amdgcn_s_getreg((3 << 11) | 20) & 0xFu; }
#define XB_SPIN(cond, bar) do { unsigned _sp = 0; while (cond) { __builtin_amdgcn_s_sleep(1); \
    if ((++_sp & 255u) == 0u) { if (xb_ld(&(bar)[XB_TMO])) break; if (_sp > XB_SPIN_CAP) { atomicAdd(&(bar)[XB_TMO], 1u); break; } } } } while (0)
struct XcdBarrier { unsigned* bar; unsigned x; volatile LAS unsigned* st; };
__device__ __forceinline__ XcdBarrier xcd_barrier_post(unsigned* bar, volatile LAS unsigned* st) {
    XcdBarrier b; b.bar = bar; b.x = xb_xcc_id(); b.st = st;
    if (threadIdx.x == 0) (void)xb_add(&bar[XB_XCNT(b.x)], 1u);
    return b;
}
__device__ __forceinline__ void xcd_barrier_complete(unsigned* bar, unsigned x, unsigned& nloc, unsigned& nx) {
    const unsigned G = gridDim.x * gridDim.y * gridDim.z;
    unsigned sum, cnt, mine, sp = 0u;
    for (;;) {
        sum = 0u; cnt = 0u; mine = 0u;
#pragma unroll
        for (unsigned j = 0; j < 16; ++j) { const unsigned c = xb_ld(&bar[XB_XCNT(j)]); sum += c; cnt += (c > 0u) ? 1u : 0u; mine = (j == x) ? c : mine; }
        if (sum == G) break;
        __builtin_amdgcn_s_sleep(1);
        if ((++sp & 255u) == 0u) { if (xb_ld(&bar[XB_TMO])) break; if (sp > XB_SPIN_CAP) { atomicAdd(&bar[XB_TMO], 1u); break; } }
    }
    nloc = mine > 0u ? mine : 1u; nx = cnt > 0u ? cnt : 1u;
}
__device__ __forceinline__ void xcd_barrier(const XcdBarrier& b) {
    asm volatile("s_waitcnt vmcnt(0)" ::: "memory");
    __syncthreads();
    if (threadIdx.x == 0) {
        unsigned* bar = b.bar;
        __builtin_amdgcn_s_waitcnt(0);
        unsigned nloc = b.st[0], nx = b.st[1];
        if (nloc == 0u) { xcd_barrier_complete(bar, b.x, nloc, nx); b.st[0] = nloc; b.st[1] = nx; }
        const unsigned old = xb_add(&bar[XB_XSUB(b.x)], 1u);
        const unsigned gen = old / nloc;
        if (old + 1u == (gen + 1u) * nloc) {
            __builtin_amdgcn_fence(__ATOMIC_RELEASE, "agent");
            asm volatile("s_waitcnt vmcnt(0)" ::: "memory");
            const unsigned og = xb_add(&bar[XB_TOP], 1u);
            const unsigned tg = og / nx;
            if (og + 1u == (tg + 1u) * nx) xb_add(&bar[XB_TOPGEN], 1u);
            else XB_SPIN(xb_ld(&bar[XB_TOPGEN]) == tg, bar);
            __builtin_amdgcn_fence(__ATOMIC_ACQUIRE, "agent");
            xb_add(&bar[XB_XGEN(b.x)], 1u);
            asm volatile("s_waitcnt vmcnt(0)" ::: "memory");
        } else {
            XB_SPIN(xb_ld(&bar[XB_XGEN(b.x)]) == gen, bar);
            __builtin_amdgcn_fence(__ATOMIC_ACQUIRE, "agent");
            asm volatile("s_waitcnt vmcnt(0)" ::: "memory");
        }
    }
    __syncthreads();
}
#endif

DEVFN int tokmap(int dir, int p) { return dir == 0 ? p : (p < CTX_ ? CTX_ - 1 - p : 2 * CTX_ + SEQ_ - 1 - p); }
DEVFN const float* tok_input_row(const Params& p, int tok) {
  int b = tok / T_, t = tok % T_;
  return t < CTX_ ? INP(I_CTX) + ((size_t)b * CTX_ + t) * D_ : INP(I_X) + ((size_t)b * SEQ_ + (t - CTX_)) * D_;
}
DEVFN int tok_modrow(int tok) { return (tok % T_) < CTX_ ? B_ : tok / T_; }

template <class ARow, class BRow, class Epi>
DEVFN void gemm_tile(unsigned char* smem, int K, ARow arow, BRow brow, Epi epi) {
  bf16_t* As = (bf16_t*)smem;
  bf16_t* Bs = As + 128 * LDT;
  const int tid = TIDX, lane = tid & 63, wave = tid >> 6, wr = wave >> 1, wc = wave & 1;
  const int g = lane >> 4, l15 = lane & 15;
  const int lr = tid >> 3, lc = (tid & 7) * 8;
  const AS1 bf16_t* ap[4];
  const AS1 bf16_t* bp[4];
#pragma unroll
  for (int i = 0; i < 4; ++i) { ap[i] = gptr(arow(lr + 32 * i)); bp[i] = gptr(brow(lr + 32 * i)); }
  f32x4 acc[4][4];
#pragma unroll
  for (int mi = 0; mi < 4; ++mi)
#pragma unroll
    for (int ni = 0; ni < 4; ++ni) acc[mi][ni] = f32x4{0.f, 0.f, 0.f, 0.f};
  u32x4 ra0[4], rb0[4], ra1[4], rb1[4];
#pragma unroll
  for (int i = 0; i < 4; ++i) { ra0[i] = *(const AS1 u32x4*)(ap[i] + lc); rb0[i] = *(const AS1 u32x4*)(bp[i] + lc); }
  if (K > 64) {
#pragma unroll
    for (int i = 0; i < 4; ++i) { ra1[i] = *(const AS1 u32x4*)(ap[i] + 64 + lc); rb1[i] = *(const AS1 u32x4*)(bp[i] + 64 + lc); } }
  auto compute = [&]() {
#pragma unroll
    for (int kk = 0; kk < 2; ++kk) {
      bf16x8 af[4], bfr[4];
#pragma unroll
      for (int mi = 0; mi < 4; ++mi) af[mi] = *(const bf16x8*)(As + (wr * 64 + mi * 16 + l15) * LDT + kk * 32 + g * 8);
#pragma unroll
      for (int ni = 0; ni < 4; ++ni) bfr[ni] = *(const bf16x8*)(Bs + (wc * 64 + ni * 16 + l15) * LDT + kk * 32 + g * 8);
#pragma unroll
      for (int mi = 0; mi < 4; ++mi)
#pragma unroll
        for (int ni = 0; ni < 4; ++ni) acc[mi][ni] = MFMA16(af[mi], bfr[ni], acc[mi][ni]);
    } };
  for (int k0 = 0; k0 < K; k0 += 128) {
    __syncthreads();
#pragma unroll
    for (int i = 0; i < 4; ++i) { *(u32x4*)(As + (lr + 32 * i) * LDT + lc) = ra0[i]; *(u32x4*)(Bs + (lr + 32 * i) * LDT + lc) = rb0[i]; }
    __syncthreads();
    if (k0 + 128 < K) {
#pragma unroll
      for (int i = 0; i < 4; ++i) { ra0[i] = *(const AS1 u32x4*)(ap[i] + k0 + 128 + lc); rb0[i] = *(const AS1 u32x4*)(bp[i] + k0 + 128 + lc); } }
    compute();
    if (k0 + 64 < K) {
      __syncthreads();
#pragma unroll
      for (int i = 0; i < 4; ++i) { *(u32x4*)(As + (lr + 32 * i) * LDT + lc) = ra1[i]; *(u32x4*)(Bs + (lr + 32 * i) * LDT + lc) = rb1[i]; }
      __syncthreads();
      if (k0 + 192 < K) {
#pragma unroll
        for (int i = 0; i < 4; ++i) { ra1[i] = *(const AS1 u32x4*)(ap[i] + k0 + 192 + lc); rb1[i] = *(const AS1 u32x4*)(bp[i] + k0 + 192 + lc); } }
      compute();
    }
  }
  epi(acc, wr, wc, g, l15);
}

template <int NCH, class Val, class RowP>
DEVFN void tile_store_bf16(unsigned char* smem, int wr, int g, int l15, Val val, RowP rowp) {
  constexpr int LDC = NCH * 8 + 8;
  bf16_t* T = (bf16_t*)smem;
  const int tid = TIDX;
  __syncthreads();
  val(T, LDC);
  __syncthreads();
#pragma unroll
  for (int pass = 0; pass < NCH / 2; ++pass) { const int id = tid + 256 * pass, row = id / NCH, c = id % NCH;
    bf16_t* dst = rowp(row, c * 8);
    if (dst) *(AS1 u32x4*)gptr(dst) = *(const u32x4*)(T + row * LDC + c * 8); }
  (void)wr; (void)g; (void)l15;
}
DEVFN void cvt_tile(unsigned char* smem, const float* src, int K, int N, int k0, int n0, bf16_t* dst, int ldd, int mode) {
  float* s = (float*)smem;
  const int tid = TIDX;
  const AS1 float* gsrc = gptr(src);
  __syncthreads();
  { const int kk = tid >> 4, n4 = (tid & 15) * 4;
#pragma unroll
    for (int pass = 0; pass < 4; ++pass) { const int k = kk + 16 * pass;
      f32x4 v = f32x4{0.f, 0.f, 0.f, 0.f};
      if (n0 + n4 < N) v = *(const AS1 f32x4*)(gsrc + (size_t)(k0 + k) * N + n0 + n4);
      s[k * 65 + n4] = v[0]; s[k * 65 + n4 + 1] = v[1]; s[k * 65 + n4 + 2] = v[2]; s[k * 65 + n4 + 3] = v[3]; } }
  __syncthreads();
  { const int nn = tid >> 2, k16 = (tid & 3) * 16, n = n0 + nn;
    if (n < N) { const int row = mode == 0 ? n : ((n >> 4) * 32 + (n & 15) + (mode == 2 ? 16 : 0));
      u32x4 o0, o1;
#pragma unroll
      for (int j = 0; j < 4; ++j) { o0[j] = (unsigned)f2bf(s[(k16 + 2 * j) * 65 + nn]) | ((unsigned)f2bf(s[(k16 + 2 * j + 1) * 65 + nn]) << 16);
        o1[j] = (unsigned)f2bf(s[(k16 + 8 + 2 * j) * 65 + nn]) | ((unsigned)f2bf(s[(k16 + 9 + 2 * j) * 65 + nn]) << 16); }
      AS1 bf16_t* d = gptr(dst) + (size_t)row * ldd + k0 + k16;
      *(AS1 u32x4*)d = o0; *(AS1 u32x4*)(d + 8) = o1; } }
  (void)K;
}
DEVFN void convert_moe_weights(const Params& p, int l, unsigned char* smem, int bid, int nb) {
  bf16_t* w13 = (bf16_t*)(p.ws + Ws::W13);
  bf16_t* w2t = (bf16_t*)(p.ws + Ws::W2T);
  const int per_e = 192;
  for (int u = bid; u < 65 * per_e; u += nb) {
    int e = u / per_e, r = u % per_e, which = r / 64, t = r % 64;
    if (which < 2) {
      const float* src = e < 64 ? (which == 0 ? INP(I_EW1) : INP(I_EW3)) + ((size_t)l * 64 + e) * 1024 * 256 : (which == 0 ? INP(I_SW1) : INP(I_SW3)) + (size_t)l * 1024 * 256;
      cvt_tile(smem, src, 1024, 256, (t >> 2) * 64, (t & 3) * 64, w13 + (size_t)e * 512 * 1024, 1024, which == 0 ? 1 : 2);
    } else {
      const float* src = e < 64 ? INP(I_EW2) + ((size_t)l * 64 + e) * 256 * 1024 : INP(I_SW2) + (size_t)l * 256 * 1024;
      cvt_tile(smem, src, 256, 1024, (t >> 4) * 64, (t & 15) * 64, w2t + (size_t)e * 1024 * 256, 256, 0);
    }
  }
}
DEVFN void phase0(const Params& p, unsigned char* smem) {
  const int tid = TIDX;
  float* modp = (float*)(p.ws + Ws::MODP);
  for (int u = BIDX; u < DEPTH_ * 24 * 16; u += gridDim.x) {
    int l = u / (24 * 16), jb = (u / 16) % 24, ks = u % 16;
    float* sc = (float*)smem;
    __syncthreads();
    for (int e = tid; e < NR_ * 64; e += 256) { int r = e / 64, i = ks * 64 + (e % 64); float cv = r < B_ ? INP(I_C)[(size_t)r * D_ + i] : INP(I_CCTX)[i]; sc[e] = siluf_(cv); }
    __syncthreads();
    int j = jb * 256 + tid;
    float acc[NR_];
#pragma unroll
    for (int r = 0; r < NR_; ++r) acc[r] = 0.f;
    const float* w = INP(I_ADAW) + ((size_t)l * D_ + ks * 64) * NMOD_ + j;
#pragma unroll 4
    for (int i = 0; i < 64; ++i) { float wv = w[(size_t)i * NMOD_];
#pragma unroll
      for (int r = 0; r < NR_; ++r) acc[r] += sc[r * 64 + i] * wv; }
#pragma unroll
    for (int r = 0; r < NR_; ++r) modp[(((size_t)ks * DEPTH_ + l) * NR_ + r) * NMOD_ + j] = acc[r];
  }
  bf16_t* win = (bf16_t*)(p.ws + Ws::WIN);
  bf16_t* wout = (bf16_t*)(p.ws + Ws::WOUT);
  for (int u = BIDX; u < DEPTH_ * 16 * 55; u += gridDim.x) {
    int l = u / (16 * 55), r = u % (16 * 55);
    cvt_tile(smem, INP(I_WIN) + (size_t)l * 1024 * NIN_, 1024, NIN_, (r / 55) * 64, (r % 55) * 64, win + (size_t)l * NIN_ * 1024, 1024, 0);
  }
  for (int u = BIDX; u < DEPTH_ * 256; u += gridDim.x) {
    int l = u / 256, r = u % 256;
    cvt_tile(smem, INP(I_WOUT) + (size_t)l * 1024 * 1024, 1024, 1024, (r / 16) * 64, (r % 16) * 64, wout + (size_t)l * 1024 * 1024, 1024, 0);
  }
  { bf16_t* lo = (bf16_t*)(p.ws + Ws::LORA);
    for (int u = BIDX * 256 + tid; u < DEPTH_ * 98304; u += gridDim.x * 256) {
      const int l = u / 98304, r = u % 98304; float v;
      if (r < 32768) { const int d = r >> 14, n = (r >> 6) & 255, k = r & 63; v = INP(I_W2)[(((size_t)l * 2 + d) * 64 + k) * 256 + n]; }
      else if (r < 65536) { const int r2 = r - 32768, d = r2 >> 14, n = (r2 >> 6) & 255, k = r2 & 63; v = INP(I_A2)[(((size_t)l * 2 + d) * 64 + k) * 256 + n]; }
      else { const int r2 = r - 65536, n = r2 >> 7, k = r2 & 127; v = INP(I_G2)[((size_t)l * 128 + k) * 256 + n]; }
      lo[u] = f2bf(v); } }
  float* rwt = (float*)(p.ws + Ws::RWT);
  for (int u = BIDX * 256 + tid; u < DEPTH_ * 64 * 1024; u += gridDim.x * 256) {
    int l = u / (64 * 1024), e = (u / 1024) % 64, i = u % 1024;
    rwt[u] = INP(I_RW)[((size_t)l * 1024 + i) * 64 + e];
  }
}

DEVFN void phase0b(const Params& p) {
  float* mod = (float*)(p.ws + Ws::MOD); const float* modp = (const float*)(p.ws + Ws::MODP);
  for (int u = BIDX * 256 + TIDX; u < DEPTH_ * NR_ * NMOD_; u += gridDim.x * 256) {
    int l = u / (NR_ * NMOD_), j = u % NMOD_;
    float s = INP(I_ADAB)[(size_t)l * NMOD_ + j];
    for (int ks = 0; ks < 16; ++ks) s += modp[(size_t)ks * DEPTH_ * NR_ * NMOD_ + u];
    mod[u] = s;
  }
}

DEVFN void row_stats(const float (&v)[16], float& mean, float& rstd) {
  float s = 0.f;
#pragma unroll
  for (int i = 0; i < 16; ++i) s += v[i];
  mean = wave_sum(s) * (1.f / 1024.f);
  float q = 0.f;
#pragma unroll
  for (int i = 0; i < 16; ++i) { float d = v[i] - mean; q += d * d; }
  rstd = rsqrtf(wave_sum(q) * (1.f / 1024.f) + 1e-5f);
}
DEVFN void load_row16(const float* row, int lane, float (&v)[16]) {
  const AS1 float* r = gptr(row);
#pragma unroll
  for (int j = 0; j < 4; ++j) { const f32x4 t = *(const AS1 f32x4*)(r + lane * 4 + 256 * j); v[4 * j] = t[0]; v[4 * j + 1] = t[1]; v[4 * j + 2] = t[2]; v[4 * j + 3] = t[3]; }
}
DEVFN void moe_residual_row(const Params& p, int lp, int tok, int lane, float (&xv)[16]) {
  const float* mod = (const float*)(p.ws + Ws::MOD) + ((size_t)lp * NR_ + tok_modrow(tok)) * NMOD_;
  const bf16_t* yb = (const bf16_t*)(p.ws + Ws::YBUF) + (size_t)tok * NSLOT * 1024;
  float g2[16], w[16], b[16];
  load_row16(mod + 5 * 1024, lane, g2);
  load_row16(INP(I_LN2W) + (size_t)lp * 1024, lane, w);
  load_row16(INP(I_LN2B) + (size_t)lp * 1024, lane, b);
  u32x2 sl[NSLOT][4];
#pragma unroll
  for (int s = 0; s < NSLOT; ++s)
#pragma unroll
    for (int j = 0; j < 4; ++j) sl[s][j] = *(const AS1 u32x2*)gptr(yb + (size_t)s * 1024 + lane * 4 + 256 * j);
  float f[16];
#pragma unroll
  for (int i = 0; i < 16; ++i) f[i] = 0.f;
#pragma unroll
  for (int s = 0; s < NSLOT; ++s)
#pragma unroll
    for (int j = 0; j < 4; ++j) { const u32x2 t = sl[s][j];
      f[4 * j] += bf2f((bf16_t)(t[0] & 0xFFFF)); f[4 * j + 1] += bf2f((bf16_t)(t[0] >> 16)); f[4 * j + 2] += bf2f((bf16_t)(t[1] & 0xFFFF)); f[4 * j + 3] += bf2f((bf16_t)(t[1] >> 16)); }
#pragma unroll
  for (int i = 0; i < 16; ++i) xv[i] = ALPHA_ * xv[i] + g2[i] * f[i];
  float mean, rstd;
  row_stats(xv, mean, rstd);
#pragma unroll
  for (int i = 0; i < 16; ++i) xv[i] = (xv[i] - mean) * rstd * w[i] + b[i];
}
DEVFN void phase1(const Params& p, int l) {
  const int lane = TIDX & 63, wave = TIDX >> 6;
  float* X = (float*)(p.ws + Ws::X);
  bf16_t* U = (bf16_t*)(p.ws + Ws::U);
  for (int tok = BIDX * 4 + wave; tok < NT_; tok += gridDim.x * 4) {
    float xv[16], sh[16], sc[16], mean, rstd;
    const float* mod = (const float*)(p.ws + Ws::MOD) + ((size_t)l * NR_ + tok_modrow(tok)) * NMOD_;
    load_row16(mod, lane, sh);
    load_row16(mod + 1024, lane, sc);
    if (l == 0) load_row16(tok_input_row(p, tok), lane, xv);
    else { load_row16(X + (size_t)tok * 1024, lane, xv); moe_residual_row(p, l - 1, tok, lane, xv); }
#pragma unroll
    for (int j = 0; j < 4; ++j) *(float4*)(X + (size_t)tok * 1024 + lane * 4 + 256 * j) = make_float4(xv[4 * j], xv[4 * j + 1], xv[4 * j + 2], xv[4 * j + 3]);
    row_stats(xv, mean, rstd);
#pragma unroll
    for (int j = 0; j < 4; ++j) {
      float u0 = (xv[4 * j] - mean) * rstd * (1.f + sc[4 * j]) + sh[4 * j], u1 = (xv[4 * j + 1] - mean) * rstd * (1.f + sc[4 * j + 1]) + sh[4 * j + 1];
      float u2 = (xv[4 * j + 2] - mean) * rstd * (1.f + sc[4 * j + 2]) + sh[4 * j + 2], u3 = (xv[4 * j + 3] - mean) * rstd * (1.f + sc[4 * j + 3]) + sh[4 * j + 3];
      *(uint2*)(U + (size_t)tok * 1024 + lane * 4 + 256 * j) = make_uint2((unsigned)f2bf(u0) | ((unsigned)f2bf(u1) << 16), (unsigned)f2bf(u2) | ((unsigned)f2bf(u3) << 16));
    }
  }
}
DEVFN void phase_final(const Params& p) {
  const int lane = TIDX & 63, wave = TIDX >> 6;
  const float* X = (const float*)(p.ws + Ws::X);
  for (int r = BIDX * 4 + wave; r < B_ * SEQ_; r += gridDim.x * 4) {
    int b = r / SEQ_, s = r % SEQ_, tok = b * T_ + CTX_ + s;
    float xv[16];
    load_row16(X + (size_t)tok * 1024, lane, xv);
    moe_residual_row(p, DEPTH_ - 1, tok, lane, xv);
#pragma unroll
    for (int j = 0; j < 4; ++j) *(float4*)(p.out + (size_t)r * 1024 + lane * 4 + 256 * j) = make_float4(xv[4 * j], xv[4 * j + 1], xv[4 * j + 2], xv[4 * j + 3]);
  }
}

DEVFN void phase2(const Params& p, int l, unsigned char* smem) {
  const bf16_t* U = (const bf16_t*)(p.ws + Ws::U);
  const bf16_t* W = (const bf16_t*)(p.ws + Ws::WIN) + (size_t)l * NIN_ * 1024;
  bf16_t* ZX = (bf16_t*)(p.ws + Ws::ZX);
  const int nct = (NIN_ + 127) / 128;
  for (int u = BIDX; u < (NT_ / 128) * nct; u += gridDim.x) {
    int rt = u / nct, ct = u % nct;
    gemm_tile(smem, 1024,
      [&](int r) { return U + (size_t)(rt * 128 + r) * 1024; },
      [&](int r) { int n = ct * 128 + r; return n < NIN_ ? W + (size_t)n * 1024 : (const bf16_t*)(p.ws + Ws::ZROW); },
      [&](f32x4 (&acc)[4][4], int wr, int wc, int g, int l15) {
        tile_store_bf16<16>(smem, wr, g, l15,
          [&](bf16_t* T, int ldc) {
#pragma unroll
            for (int mi = 0; mi < 4; ++mi)
#pragma unroll
              for (int ni = 0; ni < 4; ++ni)
#pragma unroll
                for (int i = 0; i < 4; ++i) T[(wr * 64 + mi * 16 + 4 * g + i) * ldc + wc * 64 + ni * 16 + l15] = f2bf(acc[mi][ni][i]); },
          [&](int row, int c0) { return ct * 128 + c0 < NIN_ ? ZX + (size_t)(rt * 128 + row) * NIN_ + ct * 128 + c0 : (bf16_t*)nullptr; });
      });
  }
}

DEVFN float zxv(const bf16_t* ZX, int tok, int col) { return bf2f(gptr(ZX)[(size_t)tok * NIN_ + col]); }
struct Nbr { int n; int tok[4]; };
DEVFN Nbr shift_nbrs(int tok) {
  Nbr nb; int b = tok / T_, t = tok % T_;
  if (t < CTX_) { nb.n = 2; nb.tok[0] = t > 0 ? tok - 1 : -1; nb.tok[1] = t < CTX_ - 1 ? tok + 1 : -1; nb.tok[2] = -1; nb.tok[3] = -1; }
  else { int s = t - CTX_, row = s / 64, col = s % 64; nb.n = 4; nb.tok[0] = col > 0 ? tok - 1 : -1; nb.tok[1] = col < 63 ? tok + 1 : -1;
    nb.tok[2] = row > 0 ? tok - 64 : -1; nb.tok[3] = row < SEQ_ / 64 - 1 ? tok + 64 : -1; }
  (void)b; return nb;
}
DEVFN float shiftmix(const bf16_t* ZX, const float* mu, int tok, const Nbr& nb, int ch) {
  float z = zxv(ZX, tok, ORW + ch), o = z;
#pragma unroll
  for (int j = 0; j < 4; ++j) if (j < nb.n) { float v = nb.tok[j] >= 0 ? zxv(ZX, nb.tok[j], ORW + ch) : 0.f; o += mu[j * 1152 + ch] * (v - z); }
  return o;
}
#define LI_LD 392
#define KL_LD 264
DEVFN void phase3(const Params& p, int l, unsigned char* smem) {
  const int tid = TIDX, lane = tid & 63, wave = tid >> 6, q = lane >> 4, l15 = lane & 15;
  const bf16_t* ZX = (const bf16_t*)(p.ws + Ws::ZX);
  bf16_t* XBC = (bf16_t*)(p.ws + Ws::XBC); float* DTB = (float*)(p.ws + Ws::DTB);
  bf16_t* RR = (bf16_t*)(p.ws + Ws::RR); bf16_t* VV = (bf16_t*)(p.ws + Ws::VV); bf16_t* KKb = (bf16_t*)(p.ws + Ws::KK);
  bf16_t* KRW = (bf16_t*)(p.ws + Ws::KRW); bf16_t* LIg = (bf16_t*)(p.ws + Ws::LI);
  float* LA = (float*)(p.ws + Ws::LA);
  const float* convw = INP(I_CONVW) + (size_t)l * 3 * 1024; const float* convb = INP(I_CONVB) + (size_t)l * 1024;
  const float* mu = INP(I_MU) + (size_t)l * 4 * 1152;
  float* gdl = (float*)smem;
  const float kkw = INP(I_KKW)[(size_t)l * 256 + tid];
  for (int tile = BIDX; tile < NT_ / 16; tile += gridDim.x) {
    const int tok0 = tile * 16, t0 = tok0 % T_, bb = tok0 / T_;
    const bool isctx = t0 < CTX_;
    const int s0 = t0 - CTX_;
    const bool lval = isctx ? (t0 > 0) : ((s0 & 63) != 0), rval = isctx ? (t0 + 16 < CTX_) : ((s0 & 63) != 48);
    const bool uval = !isctx && (s0 >= 64), dval = !isctx && (s0 + 64 < SEQ_);
    __syncthreads();
    {
      const bool segstart = (t0 == 0 || t0 == CTX_), segend = (t0 + 16 == CTX_ || t0 + 16 == T_);
      bf16_t* XBCT = (bf16_t*)(p.ws + Ws::XBCT) + ((size_t)(bb * NC128 + t0 / 128) * 768) * 128 + (t0 % 128);
#pragma unroll 1
      for (int j = 0; j < 4; ++j) { const int c = tid + 256 * j;
        const AS1 bf16_t* zp = gptr(ZX) + (size_t)tok0 * NIN_ + OXBC + c - NIN_; AS1 bf16_t* xp = gptr(XBC) + (size_t)tok0 * 1024 + c;
        float z[18];
#pragma unroll
        for (int i = 0; i < 18; ++i) { z[i] = ((i == 0 && segstart) || (i == 17 && segend)) ? 0.f : bf2f(*zp); zp += NIN_; LAUNDER_V(zp); }
        const float w0 = convw[c], w1 = convw[1024 + c], w2 = convw[2048 + c], cb = convb[c];
        bf16_t y[16];
#pragma unroll
        for (int i = 0; i < 16; ++i) { y[i] = f2bf(siluf_(cb + w0 * z[i] + w1 * z[i + 1] + w2 * z[i + 2])); *xp = y[i]; xp += 1024; LAUNDER_V(xp); }
        if (c < 768) {
          u32x4 o0, o1;
#pragma unroll
          for (int i = 0; i < 4; ++i) { o0[i] = (unsigned)y[2 * i] | ((unsigned)y[2 * i + 1] << 16); o1[i] = (unsigned)y[8 + 2 * i] | ((unsigned)y[9 + 2 * i] << 16); }
          *(u32x4*)(XBCT + (size_t)c * 128) = o0; *(u32x4*)(XBCT + (size_t)c * 128 + 8) = o1; } }
      { bf16_t* VTp = (bf16_t*)(p.ws + Ws::VT) + ((size_t)(bb * NC64 + t0 / 64) * 256 + tid) * 64 + (t0 % 64);
        const AS1 bf16_t* vp = gptr(ZX) + (size_t)tok0 * NIN_ + OGV + tid;
        u32x4 o0, o1;
        bf16_t vv16[16];
#pragma unroll
        for (int i = 0; i < 16; ++i) { vv16[i] = *vp; vp += NIN_; LAUNDER_V(vp); }
#pragma unroll
        for (int i = 0; i < 4; ++i) { o0[i] = (unsigned)vv16[2 * i] | ((unsigned)vv16[2 * i + 1] << 16); o1[i] = (unsigned)vv16[8 + 2 * i] | ((unsigned)vv16[9 + 2 * i] << 16); }
        *(u32x4*)VTp = o0; *(u32x4*)(VTp + 8) = o1; }
      DTB[(size_t)tok0 * 16 + tid] = softplusf_(zxv(ZX, tok0 + (tid >> 4), ODT + (tid & 15)) + INP(I_DTBIAS)[(size_t)l * 16 + (tid & 15)]);
      gdl[tid] = zxv(ZX, tok0 + (tid >> 5), OGD + (tid & 31)); gdl[256 + tid] = zxv(ZX, tok0 + 8 + (tid >> 5), OGD + (tid & 31));
    }
#pragma unroll 1
    for (int g = 0; g < 5; ++g) {
      const bool act = !(g == 4 && tid >= 128);
      const int ch = act ? g * 256 + tid : 0;
      const AS1 bf16_t* zp0 = gptr(ZX) + (size_t)tok0 * NIN_ + ORW + ch;
      const AS1 bf16_t* zp = zp0 - NIN_;
      const float m0 = mu[ch], m1 = mu[1152 + ch], m2 = mu[2304 + ch], m3 = mu[3456 + ch];
      float z[18], o[16];
#pragma unroll
      for (int i = 0; i < 18; ++i) { z[i] = ((i == 0 && !lval) || (i == 17 && !rval)) ? 0.f : bf2f(*zp); zp += NIN_; LAUNDER_V(zp); }
#pragma unroll
      for (int i = 0; i < 16; ++i) o[i] = z[i + 1] + m0 * (z[i] - z[i + 1]) + m1 * (z[i + 2] - z[i + 1]);
      if (!isctx) {
        const AS1 bf16_t* up = zp0 - (size_t)64 * NIN_; const AS1 bf16_t* dn = zp0 + (size_t)64 * NIN_;
#pragma unroll
        for (int i = 0; i < 16; ++i) { const float zu = uval ? bf2f(*up) : 0.f, zd = dval ? bf2f(*dn) : 0.f; up += NIN_; dn += NIN_; LAUNDER_V(up); LAUNDER_V(dn);
          o[i] += m2 * (zu - z[i + 1]) + m3 * (zd - z[i + 1]); } }
      if (g == 0) { AS1 bf16_t* rp = gptr(RR) + (size_t)tok0 * 256 + tid;
#pragma unroll
        for (int i = 0; i < 16; ++i) { *rp = f2bf(o[i]); rp += 256; LAUNDER_V(rp); }
      } else if (g == 1) { AS1 bf16_t* kp = gptr(KKb) + (size_t)tok0 * 256 + tid; AS1 bf16_t* krp = gptr(KRW) + (size_t)tok0 * 256 + tid;
#pragma unroll
        for (int i = 0; i < 16; ++i) { const float kq = o[i] * kkw, nrm = sqrtf(wave_sum(kq * kq));
          *kp = f2bf(kq / fmaxf(nrm, 1e-12f)); *krp = f2bf(o[i]); kp += 256; krp += 256; LAUNDER_V(kp); LAUNDER_V(krp); }
      } else if (g == 2) { AS1 bf16_t* vp2 = gptr(VV) + (size_t)tok0 * 256 + tid;
#pragma unroll
        for (int i = 0; i < 16; ++i) { *vp2 = f2bf(o[i]); vp2 += 256; LAUNDER_V(vp2); }
      } else if (g == 3) { AS1 bf16_t* lp = gptr(LIg) + (size_t)tok0 * 384 + tid;
#pragma unroll
        for (int i = 0; i < 16; ++i) { *lp = f2bf(tid < 128 ? tanhf(o[i]) : o[i]); lp += 384; LAUNDER_V(lp); }
      } else if (act) { AS1 bf16_t* lp = gptr(LIg) + (size_t)tok0 * 384 + 256 + tid;
#pragma unroll
        for (int i = 0; i < 16; ++i) { *lp = f2bf(sigmoidf_(o[i])); lp += 384; LAUNDER_V(lp); }
      }
    }
    __syncthreads();
    { const int d = tid >> 7, c = tid & 127; const float* gu = INP(I_GU) + ((size_t)l * 2 + d) * 16 * 128; const float gb = INP(I_GB)[((size_t)l * 2 + d) * 128 + c];
      float guw[16];
#pragma unroll
      for (int i = 0; i < 16; ++i) guw[i] = gu[i * 128 + c];
#pragma unroll 4
      for (int tt = 0; tt < 16; ++tt) { float sacc = gb;
#pragma unroll
        for (int i = 0; i < 16; ++i) sacc += gdl[tt * 32 + d * 16 + i] * guw[i];
        LA[((size_t)d * NT_ + tok0 + tt) * 128 + c] = logsigmoidf_(sacc) * (1.f / 16.f); } }
  }
}

DEVFN void phase3b(const Params& p, int l, unsigned char* smem) {
  const bf16_t* LIg = (const bf16_t*)(p.ws + Ws::LI);
  const bf16_t* lora = (const bf16_t*)(p.ws + Ws::LORA) + (size_t)l * 98304;
  const bf16_t* KRg = (const bf16_t*)(p.ws + Ws::KRW); const bf16_t* KKg = (const bf16_t*)(p.ws + Ws::KK);
  float* LWp = (float*)(p.ws + Ws::LW); bf16_t* KD = (bf16_t*)(p.ws + Ws::KD); bf16_t* BD = (bf16_t*)(p.ws + Ws::BD); float* GATE = (float*)(p.ws + Ws::GATE);
  for (int u = BIDX; u < (NT_ / 128) * 10; u += gridDim.x) {
    const int rt = u / 10, which = (u % 10) >> 1, ct = u & 1;
    const int K = which < 4 ? 64 : 128, acol = which < 4 ? which * 64 : 256;
    const bf16_t* wb = which < 2 ? lora + (size_t)which * 16384 : which < 4 ? lora + 32768 + (size_t)(which - 2) * 16384 : lora + 65536;
    const float* bias = which < 2 ? INP(I_W0) + (size_t)l * 512 + which * 256 : INP(I_A0) + (size_t)l * 512 + (which & 1) * 256;
    const float* kav = INP(I_KAW) + (size_t)l * 256;
    gemm_tile(smem, K,
      [&](int r) { return LIg + (size_t)(rt * 128 + r) * 384 + acol; },
      [&](int r) { return wb + (size_t)(ct * 128 + r) * K; },
      [&](f32x4 (&acc)[4][4], int wr, int wc, int g, int l15) {
#pragma unroll
        for (int ni = 0; ni < 4; ++ni) { const int col = ct * 128 + wc * 64 + ni * 16 + l15;
          const float bv = which < 4 ? bias[col] : 0.f, ka = kav[col];
#pragma unroll
          for (int mi = 0; mi < 4; ++mi)
#pragma unroll
            for (int i = 0; i < 4; ++i) { const int row = rt * 128 + wr * 64 + mi * 16 + 4 * g + i; const size_t o = (size_t)row * 256 + col;
              const float v = acc[mi][ni][i];
              if (which < 2) LWp[(size_t)which * NT_ * 256 + o] = -0.6065306597126334f * sigmoidf_(v + bv);
              else if (which < 4) { const float a = sigmoidf_(v + bv); const size_t od = (size_t)(which - 2) * NT_ * 256 + o;
                KD[od] = f2bf(bf2f(KRg[o]) * (1.f + (a - 1.f) * ka)); BD[od] = f2bf(bf2f(KKg[o]) * a); }
              else GATE[o] = v; } }
      });
  }
}

DEVFN bf16x8 ld8(const bf16_t* p) { return *(const bf16x8*)p; }
typedef short bf16x4v __attribute__((ext_vector_type(4)));
DEVFN bf16x4v cvt4(f32x4 v) { return bf16x4v{(short)f2bf(v[0]), (short)f2bf(v[1]), (short)f2bf(v[2]), (short)f2bf(v[3])}; }
DEVFN bf16x8 cat44(bf16x4v a, bf16x4v b) { return bf16x8{a[0], a[1], a[2], a[3], b[0], b[1], b[2], b[3]}; }
DEVFN bf16x4v ld4(const bf16_t* p) { return *(const bf16x4v*)p; }
DEVFN int rm_off(int i, int k) { return i * 64 + ((((k >> 3) ^ (i & 7)) << 3) | (k & 7)); }
#define RW_WAVE_LDS 11264
DEVFN void rwkv_chunk(const Params& p, int unit_base, unsigned char* smem) {
  const int tid = TIDX, lane = tid & 63, wave = tid >> 6, q = lane >> 4, l15 = lane & 15;
  const int unit = unit_base + wave;
  const int c = unit % NC16, h = (unit / NC16) & 3, dir = (unit / (NC16 * 4)) & 1, b = unit / (NC16 * 8);
  bf16_t* big = (bf16_t*)(smem + wave * RW_WAVE_LDS);
  unsigned char* small = smem + wave * RW_WAVE_LDS + 8192;
  float* AbF = (float*)small;
  bf16_t* TN = (bf16_t*)(small + 1024);
  bf16_t* AK = TN + 256; bf16_t* RB = AK + 256; bf16_t* RK = RB + 256;
  const bf16_t* RRg = (const bf16_t*)(p.ws + Ws::RR); const bf16_t* VVg = (const bf16_t*)(p.ws + Ws::VV); const bf16_t* KKg = (const bf16_t*)(p.ws + Ws::KK);
  const bf16_t* KDg = (const bf16_t*)(p.ws + Ws::KD) + (size_t)dir * NT_ * 256; const bf16_t* BDg = (const bf16_t*)(p.ws + Ws::BD) + (size_t)dir * NT_ * 256;
  const float* LWg = (const float*)(p.ws + Ws::LW) + (size_t)dir * NT_ * 256;
  float kkm[16], vv[16], bneg[16], kneg[16];
  float run = 0.f;
  __syncthreads();
#pragma unroll
  for (int i = 0; i < 16; ++i) {
    const size_t o = (size_t)(b * T_ + tokmap(dir, c * 16 + i)) * 256 + h * 64 + lane;
    const float lw = gptr(LWg)[o], r = bf2f(gptr(RRg)[o]), k = bf2f(gptr(KDg)[o]), v = bf2f(gptr(VVg)[o]), kk = bf2f(gptr(KKg)[o]), bb = bf2f(gptr(BDg)[o]);
    const float e_ex = expf(run); run += lw; const float e_in = expf(run), e_neg = expf(-run);
    kkm[i] = kk * e_ex; vv[i] = v; bneg[i] = bb * e_neg; kneg[i] = k * e_neg;
    big[rm_off(i, lane)] = f2bf(kkm[i]); big[1024 + rm_off(i, lane)] = f2bf(r * e_in);
    big[2048 + rm_off(i, lane)] = f2bf(bneg[i]); big[3072 + rm_off(i, lane)] = f2bf(kneg[i]);
  }
  const float WC = expf(run);
  __syncthreads();
  f32x4 ab = f32x4{0.f, 0.f, 0.f, 0.f}, ak = ab, rb = ab, rk = ab;
#pragma unroll
  for (int s2 = 0; s2 < 2; ++s2) { const int ch = ((4 * s2 + q) ^ (l15 & 7)) << 3;
    const bf16x8 a_kk = ld8(big + l15 * 64 + ch), a_r = ld8(big + 1024 + l15 * 64 + ch), b_b = ld8(big + 2048 + l15 * 64 + ch), b_k = ld8(big + 3072 + l15 * 64 + ch);
    ab = MFMA16(a_kk, b_b, ab); ak = MFMA16(a_kk, b_k, ak); rb = MFMA16(a_r, b_b, rb); rk = MFMA16(a_r, b_k, rk); }
  f32x4 gacc[4];
#pragma unroll
  for (int nk = 0; nk < 4; ++nk)
#pragma unroll
    for (int r = 0; r < 4; ++r) gacc[nk][r] = bf2f(big[1024 + rm_off(4 * q + r, 16 * nk + l15)]);
  __syncthreads();
#pragma unroll
  for (int r = 0; r < 4; ++r) { const int i = 4 * q + r, j = l15;
    AbF[i * 16 + j] = j < i ? ab[r] : 0.f; AK[i * 16 + j] = f2bf(j < i ? ak[r] : 0.f);
    RB[i * 16 + j] = f2bf(j <= i ? rb[r] : 0.f); RK[i * 16 + j] = f2bf(j <= i ? rk[r] : 0.f); }
  { bf16_t* KKMT = big; bf16_t* VTT = big + 1024; bf16_t* BHT = big + 2048; bf16_t* KHT = big + 3072;
#pragma unroll
    for (int i = 0; i < 16; ++i) { KKMT[lane * 16 + i] = f2bf(kkm[i]); VTT[lane * 16 + i] = f2bf(vv[i]); BHT[lane * 16 + i] = f2bf(bneg[i] * WC); KHT[lane * 16 + i] = f2bf(kneg[i] * WC); } }
  __syncthreads();
  { float t[16];
#pragma unroll
    for (int i = 0; i < 16; ++i) { float acc = (i == l15) ? 1.f : 0.f;
#pragma unroll
      for (int j = 0; j < i; ++j) acc -= AbF[i * 16 + j] * t[j];
      t[i] = acc; }
    if (q == 0) {
#pragma unroll
      for (int i = 0; i < 16; ++i) TN[i * 16 + l15] = f2bf(-t[i]); } }
  __syncthreads();
  const size_t ci = (size_t)((b * 2 + dir) * 4 + h) * NC16 + c;
  bf16_t* MLg = (bf16_t*)(p.ws + Ws::RML) + ci * 4096; bf16_t* Ng = (bf16_t*)(p.ws + Ws::RNS) + ci * 4096;
  bf16_t* Gg = (bf16_t*)(p.ws + Ws::RG) + ci * 1024; float* Y0g = (float*)(p.ws + Ws::RY0) + ci * 1024;
  const bf16x4v a_T = ld4(TN + l15 * 16 + 4 * q), a_Ak = ld4(AK + l15 * 16 + 4 * q), a_Rb = ld4(RB + l15 * 16 + 4 * q), a_Rk = ld4(RK + l15 * 16 + 4 * q);
  const f32x4 z4 = f32x4{0.f, 0.f, 0.f, 0.f};
  bf16x4v vfr[4], qfr[4], pfr[4];
#pragma unroll
  for (int n = 0; n < 4; ++n) {
    vfr[n] = ld4(big + 1024 + (16 * n + l15) * 16 + 4 * q);
    const f32x4 akv = MFMA16K16(a_Ak, vfr[n], z4);
    qfr[n] = cvt4(MFMA16K16(a_T, cvt4(akv), z4));
    pfr[n] = cvt4(MFMA16K16(a_T, ld4(big + (16 * n + l15) * 16 + 4 * q), z4)); }
  const bf16x8 a_RbRk = cat44(a_Rb, a_Rk);
#pragma unroll
  for (int n = 0; n < 4; ++n) {
    const f32x4 g = MFMA16K16(a_Rb, pfr[n], gacc[n]);
    const f32x4 y0 = MFMA16(a_RbRk, cat44(qfr[n], vfr[n]), z4);
#pragma unroll
    for (int r = 0; r < 4; ++r) { Gg[(4 * q + r) * 64 + 16 * n + l15] = f2bf(g[r]); Y0g[(4 * q + r) * 64 + 16 * n + l15] = y0[r]; } }
#pragma unroll
  for (int mk = 0; mk < 4; ++mk) {
    const bf16x4v a_B = ld4(big + 2048 + (16 * mk + l15) * 16 + 4 * q), a_K = ld4(big + 3072 + (16 * mk + l15) * 16 + 4 * q);
    const bf16x8 a_BK = cat44(a_B, a_K);
#pragma unroll
    for (int n = 0; n < 4; ++n) {
      const f32x4 m = MFMA16K16(a_B, pfr[n], z4);
      const f32x4 nn = MFMA16(a_BK, cat44(qfr[n], vfr[n]), z4);
#pragma unroll
      for (int r = 0; r < 4; ++r) MLg[((mk * 2 + (n >> 1)) * 64 + (l15 >> 2) * 16 + 4 * q + r) * 8 + (n & 1) * 4 + (l15 & 3)] = f2bf(m[r]);
      *(bf16x4v*)(Ng + (n * 64 + lane) * 16 + mk * 4) = cvt4(nn); } }
  ((float*)(p.ws + Ws::RWC))[ci * 64 + ((lane >> 2) & 3) * 16 + (lane >> 4) * 4 + (lane & 3)] = WC;
}
struct RwStep { bf16x8 ml[4][2]; bf16x8 n[2]; f32x4 wc[4]; };
DEVFN void rw_load(RwStep& t, const bf16_t* MLg, const bf16_t* NSg, const float* WCg, int c, int lane, int q) {
#pragma unroll
  for (int mk = 0; mk < 4; ++mk) { t.ml[mk][0] = ld8g(MLg + (size_t)c * 4096 + ((mk * 2 + 0) * 64 + lane) * 8); t.ml[mk][1] = ld8g(MLg + (size_t)c * 4096 + ((mk * 2 + 1) * 64 + lane) * 8);
    t.wc[mk] = *(const AS1 f32x4*)gptr(WCg + (size_t)c * 64 + q * 16 + mk * 4); }
  t.n[0] = ld8g(NSg + (size_t)c * 4096 + lane * 16); t.n[1] = ld8g(NSg + (size_t)c * 4096 + lane * 16 + 8);
}
DEVFN void rw_step(const RwStep& t, f32x4 (&S)[4], bf16_t* NSg, int c, int q, int l15) {
  bf16x4v sb[4];
#pragma unroll
  for (int mk = 0; mk < 4; ++mk) sb[mk] = cvt4(S[mk]);
  const bf16x8 bf0 = cat44(sb[0], sb[1]), bf1 = cat44(sb[2], sb[3]);
#pragma unroll
  for (int mk = 0; mk < 4; ++mk) {
    f32x4 acc;
#pragma unroll
    for (int r = 0; r < 4; ++r) acc[r] = bf2f((bf16_t)t.n[mk >> 1][(mk & 1) * 4 + r]) + t.wc[mk][r] * S[mk][r];
    acc = MFMA16(t.ml[mk][0], bf0, acc);
    acc = MFMA16(t.ml[mk][1], bf1, acc);
    S[mk] = acc; }
#pragma unroll
  for (int mk = 0; mk < 4; ++mk) *(AS1 bf16x4v*)gptr(NSg + (size_t)c * 4096 + l15 * 64 + 16 * mk + 4 * q) = sb[mk];
}
DEVFN void rwkv_scan(const Params& p, int chain, int wave) {
  const int tid = TIDX, lane = tid & 63, q = lane >> 4, l15 = lane & 15;
  const bf16_t* MLg = (const bf16_t*)(p.ws + Ws::RML) + (size_t)chain * NC16 * 4096;
  bf16_t* NSg = (bf16_t*)(p.ws + Ws::RNS) + (size_t)chain * NC16 * 4096 + wave * 1024;
  const float* WCg = (const float*)(p.ws + Ws::RWC) + (size_t)chain * NC16 * 64;
  f32x4 S[4];
#pragma unroll
  for (int mk = 0; mk < 4; ++mk) S[mk] = f32x4{0.f, 0.f, 0.f, 0.f};
  RwStep t0, t1, t2;
#define RWC_(x) ((x) < NC16 ? (x) : NC16 - 1)
  rw_load(t0, MLg, NSg, WCg, 0, lane, q);
  rw_load(t1, MLg, NSg, WCg, RWC_(1), lane, q);
  int c = 0;
  for (; c + 2 < NC16; c += 3) {
    rw_load(t2, MLg, NSg, WCg, c + 2, lane, q);
    rw_step(t0, S, NSg, c, q, l15);
    rw_load(t0, MLg, NSg, WCg, RWC_(c + 3), lane, q);
    rw_step(t1, S, NSg, c + 1, q, l15);
    rw_load(t1, MLg, NSg, WCg, RWC_(c + 4), lane, q);
    rw_step(t2, S, NSg, c + 2, q, l15);
  }
  if (c < NC16) { rw_step(t0, S, NSg, c, q, l15); if (c + 1 < NC16) rw_step(t1, S, NSg, c + 1, q, l15); }
#undef RWC_
}
DEVFN void rwkv_out(const Params& p, int unit_base) {
  const int tid = TIDX, lane = tid & 63, wave = tid >> 6, q = lane >> 4, l15 = lane & 15;
  const int unit = unit_base + wave;
  const int c = unit % NC16, h = (unit / NC16) & 3, dir = (unit / (NC16 * 4)) & 1, b = unit / (NC16 * 8);
  const size_t ci = (size_t)((b * 2 + dir) * 4 + h) * NC16 + c;
  const bf16_t* Sg = (const bf16_t*)(p.ws + Ws::RNS) + ci * 4096; const bf16_t* Gg = (const bf16_t*)(p.ws + Ws::RG) + ci * 1024;
  const float* Y0g = (const float*)(p.ws + Ws::RY0) + ci * 1024;
  float* YR = (float*)(p.ws + Ws::YR) + (size_t)dir * NT_ * 256;
  const bf16x8 a0 = ld8g(Gg + l15 * 64 + 8 * q), a1 = ld8g(Gg + l15 * 64 + 32 + 8 * q);
#pragma unroll
  for (int n = 0; n < 4; ++n) {
    f32x4 acc;
#pragma unroll
    for (int r = 0; r < 4; ++r) acc[r] = gptr(Y0g)[(4 * q + r) * 64 + 16 * n + l15];
    acc = MFMA16(a0, ld8g(Sg + n * 1024 + l15 * 64 + 8 * q), acc);
    acc = MFMA16(a1, ld8g(Sg + n * 1024 + l15 * 64 + 32 + 8 * q), acc);
#pragma unroll
    for (int r = 0; r < 4; ++r) YR[(size_t)(b * T_ + tokmap(dir, c * 16 + 4 * q + r)) * 256 + h * 64 + 16 * n + l15] = acc[r]; }
}
DEVFN int cscan(int dir, int co, int nctx, int nc) { return dir == 0 ? co : (co < nctx ? nctx - 1 - co : 2 * nctx + nc - 1 - co); }
DEVFN bf16x8 ld4x2g(const bf16_t* p0, const bf16_t* p1) { bf16x4v a = *(const AS1 bf16x4v*)gptr(p0), b = *(const AS1 bf16x4v*)gptr(p1); return bf16x8{a[0], a[1], a[2], a[3], b[0], b[1], b[2], b[3]}; }
DEVFN bf16x8 ld4x2(const bf16_t* p0, const bf16_t* p1) { bf16x4v a = *(const bf16x4v*)p0, b = *(const bf16x4v*)p1; return bf16x8{a[0], a[1], a[2], a[3], b[0], b[1], b[2], b[3]}; }

DEVFN void ssd_chunk_scalars(const Params& p, int l, int b, int co, int h, float* f) {
  const int tid = TIDX, d = tid >> 7, j = tid & 127;
  const float* DTB = (const float*)(p.ws + Ws::DTB);
  const float nega = -expf(INP(I_ALOG)[(size_t)l * 16 + d * 8 + h]);
  const float dt = DTB[(size_t)(b * T_ + co * 128 + j) * 16 + d * 8 + h];
  __syncthreads();
  f[256 + d * 128 + j] = dt;
  float* cur = f + d * 128; float* tmp = f + 512 + d * 128;
  cur[j] = dt * nega;
  __syncthreads();
  for (int off = 1; off < 128; off <<= 1) {
    float v = cur[j] + (j >= off ? cur[j - off] : 0.f);
    tmp[j] = v;
    __syncthreads();
    cur[j] = tmp[j];
    __syncthreads();
  }
}
DEVFN void ssd_states(const Params& p, int l, int unit, unsigned char* smem) {
  const int tid = TIDX, lane = tid & 63, wave = tid >> 6, q = lane >> 4, l15 = lane & 15;
  const int h = unit & 7, co = (unit >> 3) % NC128, b = unit / (8 * NC128), grp = h >> 2;
  float* f = (float*)smem;
  ssd_chunk_scalars(p, l, b, co, h, f);
  { const int d = tid >> 7, j = tid & 127; const float* cum = f + d * 128; const float dt = f[256 + d * 128 + j];
    float w = d == 0 ? expf(cum[127] - cum[j]) * dt : expf(j > 0 ? cum[j - 1] : 0.f) * dt;
    f[512 + d * 128 + j] = w; }
  __syncthreads();
  const bf16_t* XT = (const bf16_t*)(p.ws + Ws::XBCT) + (size_t)(b * NC128 + co) * 768 * 128;
  f32x4 acc[2][8];
#pragma unroll
  for (int d = 0; d < 2; ++d)
#pragma unroll
    for (int n = 0; n < 8; ++n) acc[d][n] = f32x4{0.f, 0.f, 0.f, 0.f};
#pragma unroll 1
  for (int s4 = 0; s4 < 4; ++s4) {
    const int j0 = s4 * 32 + q * 8;
    bf16x8 xa = ld8g(XT + (size_t)(h * 64 + wave * 16 + l15) * 128 + j0), a0, a1;
#pragma unroll
    for (int jj = 0; jj < 8; ++jj) { float x = bf2f((bf16_t)xa[jj]); a0[jj] = (short)f2bf(x * f[512 + j0 + jj]); a1[jj] = (short)f2bf(x * f[640 + j0 + jj]); }
#pragma unroll
    for (int n = 0; n < 8; ++n) { bf16x8 bb = ld8g(XT + (size_t)(512 + grp * 128 + n * 16 + l15) * 128 + j0);
      acc[0][n] = MFMA16(a0, bb, acc[0][n]); acc[1][n] = MFMA16(a1, bb, acc[1][n]); }
  }
#pragma unroll
  for (int d = 0; d < 2; ++d) {
    const int cs = cscan(d, co, CTX_ / 128, SEQ_ / 128);
    float* ST = (float*)(p.ws + Ws::SST) + ((size_t)((d * B_ + b) * NC128 + cs) * 8 + h) * 8192;
#pragma unroll
    for (int n = 0; n < 8; ++n)
#pragma unroll
      for (int r = 0; r < 4; ++r) ST[(wave * 16 + q * 4 + r) * 128 + n * 16 + l15] = acc[d][n][r];
    if (tid == 0) ((float*)(p.ws + Ws::SCD))[((size_t)(d * B_ + b) * NC128 + cs) * 8 + h] = expf(f[d * 128 + 127]);
  }
}
#define SSD_SB ((NC128 % 17) == 0 ? 17 : NC128)
DEVFN void ssd_scan(const Params& p, int gtid, int gthreads) {
  const float* __restrict__ ST = (const float*)(p.ws + Ws::SST); const float* __restrict__ CD = (const float*)(p.ws + Ws::SCD); bf16_t* __restrict__ HIN = (bf16_t*)(p.ws + Ws::HIN);
  for (int e = gtid; e < 2 * B_ * 8 * 8192; e += gthreads) {
    const int pd = e & 8191, h = (e >> 13) & 7, db = e >> 16;
    float hv = 0.f;
#pragma unroll 1
    for (int c0 = 0; c0 < NC128; c0 += SSD_SB) {
      float st[SSD_SB], cd[SSD_SB];
#pragma unroll
      for (int i = 0; i < SSD_SB; ++i) { st[i] = ST[((size_t)(db * NC128 + c0 + i) * 8 + h) * 8192 + pd]; cd[i] = CD[(size_t)(db * NC128 + c0 + i) * 8 + h]; }
#pragma unroll
      for (int i = 0; i < SSD_SB; ++i) { HIN[((size_t)(db * NC128 + c0 + i) * 8 + h) * 8192 + pd] = f2bf(hv); hv = hv * cd[i] + st[i]; }
    }
  }
}
DEVFN void ssd_out(const Params& p, int l, int unit, unsigned char* smem) {
  const int tid = TIDX, lane = tid & 63, wave = tid >> 6, q = lane >> 4, l15 = lane & 15;
  const int h = unit & 7, co = (unit >> 3) % NC128, b = unit / (8 * NC128), grp = h >> 2;
  float* f = (float*)smem;
  ssd_chunk_scalars(p, l, b, co, h, f);
  if (tid < 128) f[640 + tid] = f[128 + 127] - (tid > 0 ? f[128 + tid - 1] : 0.f);
  __syncthreads();
  const float* cum0 = f; const float* suf1 = f + 640; const float* dt0 = f + 256; const float* dt1 = f + 384;
  const bf16_t* XBC = (const bf16_t*)(p.ws + Ws::XBC) + (size_t)(b * T_ + co * 128) * 1024;
  const bf16_t* XT = (const bf16_t*)(p.ws + Ws::XBCT) + (size_t)(b * NC128 + co) * 768 * 128;
  const bf16_t* Cb = XBC + (size_t)(wave * 32 + l15) * 1024 + 768 + grp * 128 + q * 8;
  f32x4 y[4][2];
  { f32x4 o0[4][2], o1[4][2];
#pragma unroll
    for (int mp = 0; mp < 4; ++mp)
#pragma unroll
      for (int ni = 0; ni < 2; ++ni) { o0[mp][ni] = f32x4{0.f, 0.f, 0.f, 0.f}; o1[mp][ni] = f32x4{0.f, 0.f, 0.f, 0.f}; }
    const int cs0 = cscan(0, co, CTX_ / 128, SEQ_ / 128), cs1 = cscan(1, co, CTX_ / 128, SEQ_ / 128);
    const bf16_t* H0 = (const bf16_t*)(p.ws + Ws::HIN) + ((size_t)((0 * B_ + b) * NC128 + cs0) * 8 + h) * 8192;
    const bf16_t* H1 = (const bf16_t*)(p.ws + Ws::HIN) + ((size_t)((1 * B_ + b) * NC128 + cs1) * 8 + h) * 8192;
#pragma unroll 1
    for (int s4 = 0; s4 < 4; ++s4) { const bf16x8 c0 = ld8g(Cb + s4 * 32), c1 = ld8g(Cb + 16 * 1024 + s4 * 32);
#pragma unroll
      for (int mp = 0; mp < 4; ++mp) { bf16x8 h0 = ld8g(H0 + (size_t)(mp * 16 + l15) * 128 + s4 * 32 + q * 8), h1 = ld8g(H1 + (size_t)(mp * 16 + l15) * 128 + s4 * 32 + q * 8);
        o0[mp][0] = MFMA16(h0, c0, o0[mp][0]); o0[mp][1] = MFMA16(h0, c1, o0[mp][1]);
        o1[mp][0] = MFMA16(h1, c0, o1[mp][0]); o1[mp][1] = MFMA16(h1, c1, o1[mp][1]); } }
#pragma unroll
    for (int ni = 0; ni < 2; ++ni) { const int i = wave * 32 + ni * 16 + l15; const float e0 = expf(cum0[i]), e1 = expf(suf1[i]);
#pragma unroll
      for (int mp = 0; mp < 4; ++mp)
#pragma unroll
        for (int r = 0; r < 4; ++r) y[mp][ni][r] = e0 * o0[mp][ni][r] + e1 * o1[mp][ni][r]; } }
  bf16x8 mfr[4][2];
  { f32x4 g[8][2];
#pragma unroll
    for (int mj = 0; mj < 8; ++mj) { g[mj][0] = f32x4{0.f, 0.f, 0.f, 0.f}; g[mj][1] = f32x4{0.f, 0.f, 0.f, 0.f}; }
#pragma unroll 1
    for (int s4 = 0; s4 < 4; ++s4) { const bf16x8 c0 = ld8g(Cb + s4 * 32), c1 = ld8g(Cb + 16 * 1024 + s4 * 32);
#pragma unroll
      for (int mj = 0; mj < 8; ++mj) { bf16x8 bb = ld8g(XBC + (size_t)(mj * 16 + l15) * 1024 + 512 + grp * 128 + s4 * 32 + q * 8);
        g[mj][0] = MFMA16(bb, c0, g[mj][0]); g[mj][1] = MFMA16(bb, c1, g[mj][1]); } }
    const int i0 = wave * 32 + l15, i1 = i0 + 16;
    const float c0i0 = cum0[i0], s1i0 = suf1[i0], c0i1 = cum0[i1], s1i1 = suf1[i1];
#pragma unroll
    for (int mj = 0; mj < 8; ++mj)
#pragma unroll
      for (int r = 0; r < 4; ++r) { const int j = mj * 16 + q * 4 + r;
        const float cj = cum0[j], sj = suf1[j], d0 = dt0[j], d1 = dt1[j];
        const float lw0 = (j <= i0 ? expf(c0i0 - cj) * d0 : 0.f) + (j >= i0 ? expf(s1i0 - sj) * d1 : 0.f);
        const float lw1 = (j <= i1 ? expf(c0i1 - cj) * d0 : 0.f) + (j >= i1 ? expf(s1i1 - sj) * d1 : 0.f);
        mfr[mj >> 1][0][(mj & 1) * 4 + r] = (short)f2bf(g[mj][0][r] * lw0);
        mfr[mj >> 1][1][(mj & 1) * 4 + r] = (short)f2bf(g[mj][1][r] * lw1); } }
#pragma unroll
  for (int s4 = 0; s4 < 4; ++s4)
#pragma unroll
    for (int mp = 0; mp < 4; ++mp) { const bf16_t* xr = XT + (size_t)(h * 64 + mp * 16 + l15) * 128 + s4 * 32 + q * 4;
      bf16x8 xa = ld4x2g(xr, xr + 16);
      y[mp][0] = MFMA16(xa, mfr[s4][0], y[mp][0]); y[mp][1] = MFMA16(xa, mfr[s4][1], y[mp][1]); }
  __syncthreads();
  float* yl = f + 1024;
#pragma unroll
  for (int mp = 0; mp < 4; ++mp)
#pragma unroll
    for (int ni = 0; ni < 2; ++ni)
#pragma unroll
      for (int r = 0; r < 4; ++r) yl[(wave * 32 + ni * 16 + l15) * 65 + mp * 16 + q * 4 + r] = y[mp][ni][r];
  __syncthreads();
  float* YS = (float*)(p.ws + Ws::YS) + (size_t)(b * T_ + co * 128) * 512 + h * 64;
  for (int e = tid; e < 128 * 64; e += 256) YS[(size_t)(e >> 6) * 512 + (e & 63)] = yl[(e >> 6) * 65 + (e & 63)];
}

#define GQ_LD 40
#define GK_LD 72
DEVFN void gla_chunk(const Params& p, int unit, unsigned char* smem) {
  const int tid = TIDX, lane = tid & 63, wave = tid >> 6, q = lane >> 4, l15 = lane & 15;
  const int h = unit & 3, co = (unit >> 2) % NC64, b = unit / (4 * NC64);
  const bf16_t* ZX = (const bf16_t*)(p.ws + Ws::ZX) + (size_t)(b * T_ + co * 64) * NIN_;
  const float* LA = (const float*)(p.ws + Ws::LA);
  float* cum = (float*)smem;
  bf16_t* qs = (bf16_t*)(smem + 16384);
  bf16_t* ks = qs + 2 * 64 * GQ_LD;
  bf16_t* kt = ks + 2 * 64 * GQ_LD;
  __syncthreads();
  for (int e = tid; e < 2 * 64 * 32; e += 256) { const int d = e >> 11, i = (e >> 5) & 63, dd = e & 31;
    cum[e] = LA[((size_t)d * NT_ + b * T_ + co * 64 + i) * 128 + h * 32 + dd]; }
  __syncthreads();
  if (tid < 64) { const int d = tid >> 5, dd = tid & 31; float* c = cum + d * 2048 + dd; float sacc = 0.f;
    if (d == 0) for (int i = 0; i < 64; ++i) { sacc += c[i * 32]; c[i * 32] = sacc; }
    else for (int i = 63; i >= 0; --i) { sacc += c[i * 32]; c[i * 32] = sacc; } }
  __syncthreads();
  bf16_t* QT = (bf16_t*)(p.ws + Ws::QT);
  for (int e = tid; e < 64 * 32; e += 256) { const int i = e >> 5, dd = e & 31;
    const float qv = bf2f(ZX[(size_t)i * NIN_ + OGQ + h * 32 + dd]) * 0.17677669529663687f, kv = bf2f(ZX[(size_t)i * NIN_ + OGK + h * 32 + dd]);
    const float c0 = cum[i * 32 + dd], c1 = cum[2048 + i * 32 + dd], t0 = cum[63 * 32 + dd], t1 = cum[2048 + dd];
    const bf16_t q0 = f2bf(qv * expf(c0)), q1 = f2bf(qv * expf(c1));
    qs[i * GQ_LD + dd] = q0; qs[64 * GQ_LD + i * GQ_LD + dd] = q1;
    ks[i * GQ_LD + dd] = f2bf(kv * expf(-c0)); ks[64 * GQ_LD + i * GQ_LD + dd] = f2bf(kv * expf(-c1));
    kt[dd * GK_LD + i] = f2bf(kv * expf(t0 - c0)); kt[32 * GK_LD + dd * GK_LD + i] = f2bf(kv * expf(t1 - c1));
    const size_t tok = (size_t)b * T_ + co * 64 + i;
    QT[tok * 128 + h * 32 + dd] = q0; QT[((size_t)NT_ + tok) * 128 + h * 32 + dd] = q1; }
  if (tid < 64) { const int d = tid >> 5, dd = tid & 31; const int cs = cscan(d, co, CTX_ / 64, SEQ_ / 64);
    ((float*)(p.ws + Ws::GCD))[(((size_t)(d * B_ + b) * NC64 + cs) * 4 + h) * 32 + dd] = expf(d == 0 ? cum[63 * 32 + dd] : cum[2048 + dd]); }
  __syncthreads();
  bf16x8 pfr[2];
  { f32x4 p0[4], p1[4];
    const bf16x8 qb0 = ld8(qs + (wave * 16 + l15) * GQ_LD + q * 8), qb1 = ld8(qs + 64 * GQ_LD + (wave * 16 + l15) * GQ_LD + q * 8);
#pragma unroll
    for (int mj = 0; mj < 4; ++mj) { p0[mj] = MFMA16(ld8(ks + (mj * 16 + l15) * GQ_LD + q * 8), qb0, (f32x4{0.f, 0.f, 0.f, 0.f}));
      p1[mj] = MFMA16(ld8(ks + 64 * GQ_LD + (mj * 16 + l15) * GQ_LD + q * 8), qb1, (f32x4{0.f, 0.f, 0.f, 0.f})); }
    const int i = wave * 16 + l15;
#pragma unroll
    for (int mj = 0; mj < 4; ++mj)
#pragma unroll
      for (int r = 0; r < 4; ++r) { const int j = mj * 16 + q * 4 + r; pfr[mj >> 1][(mj & 1) * 4 + r] = (short)f2bf((j <= i ? p0[mj][r] : 0.f) + (j >= i ? p1[mj][r] : 0.f)); } }
  const bf16_t* VT = (const bf16_t*)(p.ws + Ws::VT) + ((size_t)(b * NC64 + co) * 256 + h * 64) * 64;
  f32x4 o[4];
#pragma unroll
  for (int md = 0; md < 4; ++md) { o[md] = f32x4{0.f, 0.f, 0.f, 0.f};
#pragma unroll
    for (int s2 = 0; s2 < 2; ++s2) { const bf16_t* vr = VT + (size_t)(md * 16 + l15) * 64 + s2 * 32 + q * 4; o[md] = MFMA16(ld4x2g(vr, vr + 16), pfr[s2], o[md]); } }
#pragma unroll
  for (int d = 0; d < 2; ++d) { const int cs = cscan(d, co, CTX_ / 64, SEQ_ / 64);
    float* GST = (float*)(p.ws + Ws::GST) + (((size_t)(d * B_ + b) * NC64 + cs) * 4 + h) * 2048;
#pragma unroll
    for (int nd = 0; nd < 2; ++nd) { f32x4 st = f32x4{0.f, 0.f, 0.f, 0.f};
#pragma unroll
      for (int s2 = 0; s2 < 2; ++s2) st = MFMA16(ld8g(VT + (size_t)(wave * 16 + l15) * 64 + s2 * 32 + q * 8), ld8(kt + d * 32 * GK_LD + (nd * 16 + l15) * GK_LD + s2 * 32 + q * 8), st);
#pragma unroll
      for (int r = 0; r < 4; ++r) GST[(wave * 16 + q * 4 + r) * 32 + nd * 16 + l15] = st[r]; } }
  __syncthreads();
  float* ol = (float*)smem;
#pragma unroll
  for (int md = 0; md < 4; ++md)
#pragma unroll
    for (int r = 0; r < 4; ++r) ol[(wave * 16 + l15) * 65 + md * 16 + q * 4 + r] = o[md][r];
  __syncthreads();
  float* OI = (float*)(p.ws + Ws::OI) + (size_t)(b * T_ + co * 64) * 256 + h * 64;
  for (int e = tid; e < 64 * 64; e += 256) OI[(size_t)(e >> 6) * 256 + (e & 63)] = ol[(e >> 6) * 65 + (e & 63)];
}
#define GLA_SB ((NC64 % 17) == 0 ? 17 : NC64)
DEVFN void gla_scan(const Params& p, int gtid, int gthreads) {
  const float* __restrict__ ST = (const float*)(p.ws + Ws::GST); const float* __restrict__ CD = (const float*)(p.ws + Ws::GCD); bf16_t* __restrict__ SIN = (bf16_t*)(p.ws + Ws::GSIN);
  for (int e = gtid; e < 2 * B_ * 4 * 2048; e += gthreads) {
    const int vd = e & 2047, h = (e >> 11) & 3, db = e >> 13;
    float sv = 0.f;
#pragma unroll 1
    for (int c0 = 0; c0 < NC64; c0 += GLA_SB) {
      float st[GLA_SB], cd[GLA_SB];
#pragma unroll
      for (int i = 0; i < GLA_SB; ++i) { st[i] = ST[(((size_t)db * NC64 + c0 + i) * 4 + h) * 2048 + vd]; cd[i] = CD[(((size_t)db * NC64 + c0 + i) * 4 + h) * 32 + (vd & 31)]; }
#pragma unroll
      for (int i = 0; i < GLA_SB; ++i) { SIN[(((size_t)db * NC64 + c0 + i) * 4 + h) * 2048 + vd] = f2bf(sv); sv = sv * cd[i] + st[i]; }
    }
  }
}
DEVFN void convert_moe_weights(const Params& p, int l, unsigned char* smem, int bid, int nb);
DEVFN void phase4a(const Params& p, int l, unsigned char* smem) {
  const int n_r = B_ * 8 * NC16 / 4;
  for (int u = BIDX; u < n_r; u += gridDim.x) rwkv_chunk(p, (u) * 4, smem);
  (void)l;
}
DEVFN void phase4b(const Params& p, int l, unsigned char* smem) {
  const int bid = BIDX, nrw = B_ * 8, G = (int)gridDim.x;
  const int n_s = B_ * NC128 * 8, n_g = B_ * NC64 * 4;
  int ob = bid, on = G;
  if (G >= 8 * nrw) {
    if (bid < 4 * nrw) { if ((TIDX >> 6) == 0) rwkv_scan(p, bid >> 2, bid & 3); return; }
    ob = bid - 4 * nrw; on = G - 4 * nrw; }
  else { for (int u = bid; u < nrw; u += G) rwkv_scan(p, u, TIDX >> 6); }
  for (int u = ob; u < n_s + n_g; u += on) { if (u < n_s) ssd_states(p, l, u, smem); else gla_chunk(p, u - n_s, smem); }
  convert_moe_weights(p, l, smem, ob, on);
}
DEVFN void phase4b2(const Params& p) {
  const int bid = BIDX, G = (int)gridDim.x;
  ssd_scan(p, bid * 256 + TIDX, G * 256); gla_scan(p, bid * 256 + TIDX, G * 256);
}
DEVFN void phase4c(const Params& p, int l, unsigned char* smem) {
  const int n_s = B_ * NC128 * 8, n_r = B_ * 8 * NC16 / 4;
  for (int u = BIDX; u < n_s + n_r; u += gridDim.x) { if (u < n_s) ssd_out(p, l, u, smem); else rwkv_out(p, (u - n_s) * 4); }
}

DEVFN void phase5(const Params& p, int l, unsigned char* smem) {
  const int tid = TIDX, lane = tid & 63, wave = tid >> 6;
  const bf16_t* ZX = (const bf16_t*)(p.ws + Ws::ZX);
  const bf16_t* XBC = (const bf16_t*)(p.ws + Ws::XBC);
  const float* YS = (const float*)(p.ws + Ws::YS); const float* YR = (const float*)(p.ws + Ws::YR); const float* OI = (const float*)(p.ws + Ws::OI);
  const bf16_t* QT = (const bf16_t*)(p.ws + Ws::QT); const bf16_t* GSIN = (const bf16_t*)(p.ws + Ws::GSIN);
  const bf16_t* RR = (const bf16_t*)(p.ws + Ws::RR); const bf16_t* VV = (const bf16_t*)(p.ws + Ws::VV); const bf16_t* KD = (const bf16_t*)(p.ws + Ws::KD);
  const float* GATE = (const float*)(p.ws + Ws::GATE);
  bf16_t* YM = (bf16_t*)(p.ws + Ws::YMIX);
  float* red = (float*)smem;
  float* qt = red + 16;
  const float dA = INP(I_SSDD)[(size_t)l * 8 + (tid >> 6)], dB = INP(I_SSDD)[(size_t)l * 8 + 4 + (tid >> 6)];
  const float nwA = INP(I_SSDNW)[(size_t)l * 512 + tid], nwB = INP(I_SSDNW)[(size_t)l * 512 + 256 + tid];
  const float lnw = INP(I_LNXW)[(size_t)l * 256 + tid], lnb = INP(I_LNXB)[(size_t)l * 256 + tid], rk = INP(I_RK)[(size_t)l * 256 + tid];
  const float gnw = INP(I_GNW)[(size_t)l * 256 + tid];
  const int per_ = (NT_ / 2 + (int)gridDim.x - 1) / (int)gridDim.x, tp_lo = BIDX * per_, tp_hi = (tp_lo + per_ < NT_ / 2) ? tp_lo + per_ : NT_ / 2;
  for (int tp = tp_lo; tp < tp_hi; ++tp) {
    float ys0[2], ys1[2], x0[2], x1[2], z0[2], z1[2], og[2], yr[2], rr[2], kf[2], kb[2], vv[2], gt[2], oi[2], qv[2];
    bf16x8 gs[2][2][4];
#pragma unroll
    for (int t = 0; t < 2; ++t) { const int tok = tp * 2 + t; const int b = tok / T_, co = (tok % T_) / 64;
      ys0[t] = gptr(YS)[(size_t)tok * 512 + tid]; ys1[t] = gptr(YS)[(size_t)tok * 512 + 256 + tid];
      x0[t] = bf2f(gptr(XBC)[(size_t)tok * 1024 + tid]); x1[t] = bf2f(gptr(XBC)[(size_t)tok * 1024 + 256 + tid]);
      z0[t] = zxv(ZX, tok, OZ + tid); z1[t] = zxv(ZX, tok, OZ + 256 + tid); og[t] = zxv(ZX, tok, OOG + tid);
      yr[t] = gptr(YR)[(size_t)tok * 256 + tid] + gptr(YR)[((size_t)NT_ + tok) * 256 + tid];
      rr[t] = bf2f(gptr(RR)[(size_t)tok * 256 + tid]); kf[t] = bf2f(gptr(KD)[(size_t)tok * 256 + tid]); kb[t] = bf2f(gptr(KD)[((size_t)NT_ + tok) * 256 + tid]);
      vv[t] = bf2f(gptr(VV)[(size_t)tok * 256 + tid]); gt[t] = gptr(GATE)[(size_t)tok * 256 + tid]; oi[t] = gptr(OI)[(size_t)tok * 256 + tid];
      qv[t] = bf2f(gptr(QT)[((size_t)(tid >> 7) * NT_ + tok) * 128 + (tid & 127)]);
#pragma unroll
      for (int d = 0; d < 2; ++d) { const int cs = cscan(d, co, CTX_ / 64, SEQ_ / 64);
        const bf16_t* sr = GSIN + ((((size_t)(d * B_ + b) * NC64 + cs) * 4 + wave) * 64 + lane) * 32;
#pragma unroll
        for (int c8 = 0; c8 < 4; ++c8) gs[t][d][c8] = ld8g(sr + c8 * 8); } }
    float ya[2], yb[2], qa[2], qb[2];
#pragma unroll
    for (int t = 0; t < 2; ++t) {
      ya[t] = (ys0[t] + dA * x0[t]) * siluf_(z0[t]); yb[t] = (ys1[t] + dB * x1[t]) * siluf_(z1[t]);
      qa[t] = wave_sum(ya[t] * ya[t]); qb[t] = wave_sum(yb[t] * yb[t]); }
    __syncthreads();
#pragma unroll
    for (int t = 0; t < 2; ++t) {
      if (lane == 0) { red[t * 8 + wave] = qa[t]; red[t * 8 + 4 + wave] = qb[t]; }
      qt[t * 256 + tid] = qv[t]; }
    __syncthreads();
#pragma unroll
    for (int t = 0; t < 2; ++t) { const int tok = tp * 2 + t;
      const float* rd = red + t * 8; const float* qtt = qt + t * 256;
      float ma = (rd[0] + rd[1] + rd[2] + rd[3]) * (1.f / 256.f), mb = (rd[4] + rd[5] + rd[6] + rd[7]) * (1.f / 256.f);
      YM[(size_t)tok * 1024 + tid] = f2bf(ya[t] * rsqrtf(ma + 1e-5f) * nwA);
      YM[(size_t)tok * 1024 + 256 + tid] = f2bf(yb[t] * rsqrtf(mb + 1e-5f) * nwB);
      { const float y = yr[t];
        float mu = wave_sum(y) * (1.f / 64.f), d = y - mu, var = wave_sum(d * d) * (1.f / 64.f);
        float yn = d * rsqrtf(var + 64e-5f) * lnw + lnb;
        float bonus = wave_sum(rr[t] * (kf[t] + kb[t]) * rk) * vv[t];
        YM[(size_t)tok * 1024 + 512 + tid] = f2bf((yn + bonus) * gt[t]); }
      { float o = oi[t];
#pragma unroll
        for (int d = 0; d < 2; ++d)
#pragma unroll
          for (int c8 = 0; c8 < 4; ++c8)
#pragma unroll
            for (int jj = 0; jj < 8; ++jj) o += qtt[d * 128 + wave * 32 + c8 * 8 + jj] * bf2f((bf16_t)gs[t][d][c8][jj]);
        float ms = wave_sum(o * o) * (1.f / 64.f);
        YM[(size_t)tok * 1024 + 768 + tid] = f2bf(o * rsqrtf(ms + 1e-5f) * gnw * siluf_(og[t])); } }
  }
}

DEVFN void phase6(const Params& p, int l, unsigned char* smem) {
  const bf16_t* A = (const bf16_t*)(p.ws + Ws::YMIX);
  const bf16_t* W = (const bf16_t*)(p.ws + Ws::WOUT) + (size_t)l * 1024 * 1024;
  float* MIX = (float*)(p.ws + Ws::MIX);
  for (int u = BIDX; u < (NT_ / 128) * 8; u += gridDim.x) {
    int rt = u / 8, ct = u % 8;
    gemm_tile(smem, 1024,
      [&](int r) { return A + (size_t)(rt * 128 + r) * 1024; },
      [&](int r) { return W + (size_t)(ct * 128 + r) * 1024; },
      [&](f32x4 (&acc)[4][4], int wr, int wc, int g, int l15) {
#pragma unroll
        for (int mi = 0; mi < 4; ++mi)
#pragma unroll
          for (int ni = 0; ni < 4; ++ni)
#pragma unroll
            for (int i = 0; i < 4; ++i) MIX[(size_t)(rt * 128 + wr * 64 + mi * 16 + 4 * g + i) * 1024 + ct * 128 + wc * 64 + ni * 16 + l15] = acc[mi][ni][i];
      });
  }
}

DEVFN void phase7(const Params& p, int l, unsigned char* smem) {
  const int lane = TIDX & 63, wave = TIDX >> 6;
  float* X = (float*)(p.ws + Ws::X);
  const float* MIX = (const float*)(p.ws + Ws::MIX);
  bf16_t* H = (bf16_t*)(p.ws + Ws::U);
  const float* rwt = (const float*)(p.ws + Ws::RWT) + (size_t)l * 64 * 1024;
  int* cnt = (int*)(p.ws + Ws::CNT) + l * 64;
  int* ltok = (int*)(p.ws + Ws::LTOK); float* lwt = (float*)(p.ws + Ws::LWT);
  const float rbias = INP(I_RB)[(size_t)l * 64 + lane];
  float* hs = (float*)smem;
  float* lg = hs + 4096;
  for (int tok0 = BIDX * 4; tok0 < NT_; tok0 += gridDim.x * 4) {
    const int tok = tok0 + wave;
    const float* mod = (const float*)(p.ws + Ws::MOD) + ((size_t)l * NR_ + tok_modrow(tok)) * NMOD_;
    float xv[16], mx[16], g1[16], lw[16], lb[16], sh2[16], sc2[16], mean, rstd;
    load_row16(X + (size_t)tok * 1024, lane, xv);
    load_row16(MIX + (size_t)tok * 1024, lane, mx);
    load_row16(mod + 2 * 1024, lane, g1);
    load_row16(INP(I_LN1W) + (size_t)l * 1024, lane, lw);
    load_row16(INP(I_LN1B) + (size_t)l * 1024, lane, lb);
    load_row16(mod + 3 * 1024, lane, sh2);
    load_row16(mod + 4 * 1024, lane, sc2);
#pragma unroll
    for (int i = 0; i < 16; ++i) xv[i] = ALPHA_ * xv[i] + g1[i] * mx[i];
    row_stats(xv, mean, rstd);
#pragma unroll
    for (int i = 0; i < 16; ++i) xv[i] = (xv[i] - mean) * rstd * lw[i] + lb[i];
#pragma unroll
    for (int j = 0; j < 4; ++j) *(float4*)(X + (size_t)tok * 1024 + lane * 4 + 256 * j) = make_float4(xv[4 * j], xv[4 * j + 1], xv[4 * j + 2], xv[4 * j + 3]);
    const bool routed = !(l == DEPTH_ - 1 && (tok % T_) < CTX_);
    row_stats(xv, mean, rstd);
#pragma unroll
    for (int i = 0; i < 16; ++i) xv[i] = (xv[i] - mean) * rstd * (1.f + sc2[i]) + sh2[i];
    __syncthreads();
#pragma unroll
    for (int j = 0; j < 4; ++j) {
      if (routed) *(uint2*)(H + (size_t)tok * 1024 + lane * 4 + 256 * j) = make_uint2((unsigned)f2bf(xv[4 * j]) | ((unsigned)f2bf(xv[4 * j + 1]) << 16), (unsigned)f2bf(xv[4 * j + 2]) | ((unsigned)f2bf(xv[4 * j + 3]) << 16));
      *(float4*)(hs + wave * 1024 + lane * 4 + 256 * j) = make_float4(xv[4 * j], xv[4 * j + 1], xv[4 * j + 2], xv[4 * j + 3]); }
    __syncthreads();
    { float hv[4][16];
      const int rot = BIDX & 15;
#pragma unroll
      for (int t = 0; t < 4; ++t)
#pragma unroll
        for (int j = 0; j < 4; ++j) { const float4 v = *(const float4*)(hs + t * 1024 + lane * 4 + 256 * j); hv[t][4 * j] = v.x; hv[t][4 * j + 1] = v.y; hv[t][4 * j + 2] = v.z; hv[t][4 * j + 3] = v.w; }
      float pe[64];
      const AS1 float* rw = gptr(rwt) + lane * 4;
      f32x4 w[4], wn[4];
#pragma unroll
      for (int j = 0; j < 4; ++j) w[j] = *(const AS1 f32x4*)(rw + (size_t)(16 * wave + (rot & 15)) * 1024 + 256 * j);
#pragma unroll
      for (int e = 0; e < 16; ++e) {
        if (e + 1 < 16) {
#pragma unroll
          for (int j = 0; j < 4; ++j) wn[j] = *(const AS1 f32x4*)(rw + (size_t)(16 * wave + ((e + 1 + rot) & 15)) * 1024 + 256 * j); }
#pragma unroll
        for (int t = 0; t < 4; ++t) { float s0 = 0.f, s1 = 0.f;
#pragma unroll
          for (int j = 0; j < 4; ++j) { s0 += hv[t][4 * j] * w[j][0] + hv[t][4 * j + 2] * w[j][2]; s1 += hv[t][4 * j + 1] * w[j][1] + hv[t][4 * j + 3] * w[j][3]; }
          pe[e * 4 + t] = s0 + s1; }
#pragma unroll
        for (int j = 0; j < 4; ++j) w[j] = wn[j]; }
#pragma unroll
      for (int half = 32; half >= 1; half >>= 1) { const bool up = (lane & half) != 0;
#pragma unroll
        for (int e = 0; e < half; ++e) { const float send = up ? pe[e] : pe[e + half]; const float recv = __shfl_xor(send, half); pe[e] = (up ? pe[e + half] : pe[e]) + recv; } }
      lg[(lane & 3) * 64 + 16 * wave + (((lane >> 2) + rot) & 15)] = pe[0]; }
    __syncthreads();
    if (!routed) continue;
    const float logit = lg[wave * 64 + lane];
    const float score = sigmoidf_(logit), sel = score + rbias;
    float m1 = sel; int a1 = lane;
#pragma unroll
    for (int m = 1; m <= 4; m <<= 1) { float ov = XOR8(m1, m); int oa = XOR8(a1, m); if (ov > m1 || (ov == m1 && oa < a1)) { m1 = ov; a1 = oa; } }
    float m2 = (lane == a1) ? -3.0e38f : sel;
#pragma unroll
    for (int m = 1; m <= 4; m <<= 1) m2 = fmaxf(m2, XOR8(m2, m));
    const float gs = m1 + m2; const int grp = lane >> 3;
    int grank = 0;
#pragma unroll
    for (int g2 = 0; g2 < 8; ++g2) { float og = SHFL_CONST(gs, g2 * 8); grank += (og > gs || (og == gs && g2 < grp)) ? 1 : 0; }
    const bool gsel = grank < 4;
    const float msel = gsel ? sel : -3.0e38f;
    int rank = 0;
#pragma unroll
    for (int e = 0; e < 64; ++e) { float ov = SHFL_CONST(msel, e); rank += (ov > msel || (ov == msel && e < lane)) ? 1 : 0; }
    const bool chosen = gsel && rank < 8;
    const float wsum = wave_sum(chosen ? score : 0.f);
    if (chosen) { int pos = atomicAdd(&cnt[lane], 1); ltok[(size_t)lane * NT_ + pos] = tok * 8 + rank; lwt[(size_t)lane * NT_ + pos] = score / wsum * 2.5f; }
  }
}

struct MoeMap { int nblk_total; int e; int rb; int cnt; int hoff; };
DEVFN int moe_ntok(int l) { return l == DEPTH_ - 1 ? B_ * SEQ_ : NT_; }
DEVFN int moe_shared_tok(int l, int i) { return l == DEPTH_ - 1 ? (i / SEQ_) * T_ + CTX_ + (i % SEQ_) : i; }
DEVFN void moe_prefix(const Params& p, int l, int* pre) {
  const int* cnt = (const int*)(p.ws + Ws::CNT) + l * 64;
  __syncthreads();
  if (TIDX == 0) { int s = 0; for (int e = 0; e < 65; ++e) { pre[e] = s; int c = e < 64 ? cnt[e] : moe_ntok(l); pre[66 + e] = c; s += (c + 127) / 128; } pre[65] = s; }
  __syncthreads();
}
DEVFN void phase8(const Params& p, int l, unsigned char* smem) {
  int* pre = (int*)(smem + SM_PRE);
  moe_prefix(p, l, pre);
  const bf16_t* H = (const bf16_t*)(p.ws + Ws::U);
  const bf16_t* W13 = (const bf16_t*)(p.ws + Ws::W13);
  bf16_t* HID = (bf16_t*)(p.ws + Ws::HID);
  const int* ltok = (const int*)(p.ws + Ws::LTOK); const float* lwt = (const float*)(p.ws + Ws::LWT);
  const int total = pre[65];
  for (int u = BIDX; u < total * 4; u += gridDim.x) {
    const int gb = u >> 2, nt = u & 3;
    int e = 0; while (pre[e + 1] <= gb) ++e;
    const int rb = gb - pre[e], cnt = pre[66 + e];
    gemm_tile(smem, 1024,
      [&](int r) { int pos = rb * 128 + r; if (pos >= cnt) return (const bf16_t*)(p.ws + Ws::ZROW); int tok = e < 64 ? (ltok[(size_t)e * NT_ + pos] >> 3) : moe_shared_tok(l, pos); return H + (size_t)tok * 1024; },
      [&](int r) { return W13 + ((size_t)e * 512 + nt * 128 + r) * 1024; },
      [&](f32x4 (&acc)[4][4], int wr, int wc, int g, int l15) {
        tile_store_bf16<8>(smem, wr, g, l15,
          [&](bf16_t* T, int ldc) {
#pragma unroll
            for (int mi = 0; mi < 4; ++mi)
#pragma unroll
              for (int i = 0; i < 4; ++i) { const int r = wr * 64 + mi * 16 + 4 * g + i, pos = rb * 128 + r;
                const float gw = pos < cnt ? (e < 64 ? lwt[(size_t)e * NT_ + pos] : 1.f) : 0.f;
#pragma unroll
                for (int j = 0; j < 2; ++j) T[r * ldc + wc * 32 + j * 16 + l15] = f2bf(siluf_(acc[mi][2 * j][i]) * acc[mi][2 * j + 1][i] * gw); } },
          [&](int row, int c0) { const int pos = rb * 128 + row; return pos < cnt ? HID + ((size_t)gb * 128 + row) * 256 + nt * 64 + c0 : (bf16_t*)nullptr; });
      });
  }
}
DEVFN void phase9(const Params& p, int l, unsigned char* smem) {
  int* pre = (int*)(smem + SM_PRE);
  moe_prefix(p, l, pre);
  const bf16_t* HID = (const bf16_t*)(p.ws + Ws::HID);
  const bf16_t* W2T = (const bf16_t*)(p.ws + Ws::W2T);
  bf16_t* YB = (bf16_t*)(p.ws + Ws::YBUF);
  const int* ltok = (const int*)(p.ws + Ws::LTOK);
  const int total = pre[65];
  for (int u = BIDX; u < total * 8; u += gridDim.x) {
    const int gb = u >> 3, nt = u & 7;
    int e = 0; while (pre[e + 1] <= gb) ++e;
    const int rb = gb - pre[e], cnt = pre[66 + e];
    gemm_tile(smem, 256,
      [&](int r) { int pos = rb * 128 + r; return pos < cnt ? HID + ((size_t)gb * 128 + r) * 256 : (const bf16_t*)(p.ws + Ws::ZROW); },
      [&](int r) { return W2T + ((size_t)e * 1024 + nt * 128 + r) * 256; },
      [&](f32x4 (&acc)[4][4], int wr, int wc, int g, int l15) {
        tile_store_bf16<16>(smem, wr, g, l15,
          [&](bf16_t* T, int ldc) {
#pragma unroll
            for (int mi = 0; mi < 4; ++mi)
#pragma unroll
              for (int ni = 0; ni < 4; ++ni)
#pragma unroll
                for (int i = 0; i < 4; ++i) T[(wr * 64 + mi * 16 + 4 * g + i) * ldc + wc * 64 + ni * 16 + l15] = f2bf(acc[mi][ni][i]); },
          [&](int row, int c0) { const int pos = rb * 128 + row; if (pos >= cnt) return (bf16_t*)nullptr;
            const int ts = e < 64 ? ltok[(size_t)e * NT_ + pos] : moe_shared_tok(l, pos) * 8; const int tok = ts >> 3, slot = e < 64 ? (ts & 7) : 8;
            return YB + ((size_t)tok * NSLOT + slot) * 1024 + nt * 128 + c0; });
      });
  }
}

#define SMEM_BYTES (PH_SMEM + 2048)
#define N_PHASES (3 + 13 * DEPTH_)
__global__ void __launch_bounds__(256, 2) mega(Params p, int ph_lo, int ph_hi) {
#ifdef HIPEMU
  unsigned char* smem = hipemu::cur_smem();
#else
  unsigned char* smem = smem_dyn;
  volatile LAS unsigned* st = (volatile LAS unsigned*)(smem_dyn + SM_BAR);
  if (threadIdx.x == 0) {
    st[0] = 0u; st[1] = 0u;
    unsigned long long* tab = (unsigned long long*)(smem_dyn + SM_TAB);
#pragma unroll
    for (int i = 0; i < 40; ++i) tab[i] = (unsigned long long)p.in[i];
  }
  __syncthreads();
  XcdBarrier bar = xcd_barrier_post((unsigned*)(p.ws + Ws::BAR), st);
#define GRID_SYNC() xcd_barrier(bar)
#endif
  int ph = 0;
#ifdef ONLY_KIND
#define KIND_ON(k) ((k) == ONLY_KIND)
#else
#define KIND_ON(k) 1
#endif
#ifndef REPEAT_MASK
#define REPEAT_MASK 0u
#endif
#define RUN_PHASE(kind, code) { if (KIND_ON(kind) && ph >= ph_lo && ph < ph_hi) { \
    int nrep_ = ((REPEAT_MASK >> (kind)) & 1u) ? 2 : 1; LAUNDER(nrep_); \
    _Pragma("unroll 1") for (int rep_ = 0; rep_ < nrep_; ++rep_) { LAUNDER(p.ws); LAUNDER(p.out); code; if (rep_ + 1 < nrep_ || ph + 1 < ph_hi) { GRID_SYNC(); } } } ++ph; }
  RUN_PHASE(0, phase0(p, smem));
  RUN_PHASE(11, phase0b(p));
  for (int l = 0; l < DEPTH_; ++l) {
    RUN_PHASE(1, phase1(p, l));
    RUN_PHASE(2, phase2(p, l, smem));
    RUN_PHASE(3, phase3(p, l, smem));
    RUN_PHASE(14, phase3b(p, l, smem));
    RUN_PHASE(4, phase4a(p, l, smem));
    RUN_PHASE(12, phase4b(p, l, smem));
    RUN_PHASE(16, phase4b2(p));
    RUN_PHASE(13, phase4c(p, l, smem));
    RUN_PHASE(5, phase5(p, l, smem));
    RUN_PHASE(6, phase6(p, l, smem));
    RUN_PHASE(7, phase7(p, l, smem));
    RUN_PHASE(8, phase8(p, l, smem));
    RUN_PHASE(9, phase9(p, l, smem));
  }
  RUN_PHASE(10, phase_final(p));
}

extern "C" void kernel_launch(void* const* d_in, const int* in_sizes, int n_in, void* d_out, int out_size, void* d_ws, size_t ws_size, hipStream_t stream) {
  Params p{};
  for (int i = 0; i < 40; ++i) p.in[i] = (const float*)d_in[i];
  p.out = (float*)d_out;
  p.ws = (unsigned char*)d_ws;
  if (ws_size < Ws::END) { fprintf(stderr, "workspace too small: %zu < %zu\n", ws_size, (size_t)Ws::END); return; }
  hipMemsetAsync(d_ws, 0, Ws::ZERO_END, stream);
#ifdef HIPEMU
  int grid = 16; if (const char* e = getenv("EMU_GRID")) grid = atoi(e);
  int stop = N_PHASES; if (const char* e = getenv("EMU_STOP")) stop = atoi(e);
  if (getenv("EMU_ONE")) hipemu::launch(grid, 256, SMEM_BYTES, true, [=] { mega(p, 0, stop); });
  else for (int ph = 0; ph < stop; ++ph) hipemu::launch(grid, 256, SMEM_BYTES, false, [=] { mega(p, ph, ph + 1); });
#else
  static int grid = 0;
  if (!grid) {
    int dev = 0, cus = 0, per_cu = 0;
    hipGetDevice(&dev);
    hipDeviceGetAttribute(&cus, hipDeviceAttributeMultiprocessorCount, dev);
    hipOccupancyMaxActiveBlocksPerMultiprocessor(&per_cu, mega, 256, SMEM_BYTES);
    if (per_cu > 2) per_cu = 2;
    if (per_cu < 1) per_cu = 1;
    grid = cus * per_cu;
  }
#if N_LAUNCH_MODE == 1
  mega<<<grid, 256, SMEM_BYTES, stream>>>(p, 0, N_PHASES);
#else
  for (int ph = 0; ph < N_PHASES; ++ph) mega<<<grid, 256, SMEM_BYTES, stream>>>(p, ph, ph + 1);
#endif
#endif
}
```

```cpp
#ifndef HIPEMU
#include <hip/hip_runtime.h>
#endif
#include <stdint.h>
#include <stdio.h>

#ifndef B_
#define B_ 4
#endif
#ifndef SEQ_
#define SEQ_ 4096
#endif
#ifndef CTX_
#define CTX_ 256
#endif
#ifndef DEPTH_
#define DEPTH_ 4
#endif
#ifndef N_LAUNCH_MODE
#define N_LAUNCH_MODE 1
#endif
#define T_ (SEQ_ + CTX_)
#define NT_ (B_ * T_)
#define D_ 1024
#define NIN_ 3504
#define NMOD_ 6144
#define NR_ (B_ + 1)
#define OZ 0
#define OXBC 512
#define ODT 1536
#define ORW 1552
#define OGQ 2704
#define OGK 2832
#define OGV 2960
#define OGD 3216
#define OOG 3248
#define ALPHA_ 1.681792830507429f
#define NEXP 64
#define NSLOT 9
#define NC128 (T_ / 128)
#define NC64 (T_ / 64)
#define NC16 (T_ / 16)

#define DEVFN __device__ __forceinline__
#define LDT 72
#define GEMM_SMEM (2 * 128 * LDT * 2)
typedef unsigned short bf16_t;
#ifdef HIPEMU
#define AS1
#else
#define AS1 __attribute__((address_space(1)))
#endif
typedef unsigned u32x4 __attribute__((ext_vector_type(4)));
typedef unsigned u32x2 __attribute__((ext_vector_type(2)));

#ifdef HIPEMU
typedef emu_bf16x8 bf16x8;
typedef emu_f32x4 f32x4;
#define MFMA16(a, b, c) emu_mfma_16x16x32_bf16(a, b, c)
#define MFMA16K16(a, b, c) emu_mfma_16x16x16_bf16(a, b, c)
#define GRID_SYNC() hipemu::grid_sync()
#else
typedef short bf16x8 __attribute__((ext_vector_type(8)));
typedef float f32x4 __attribute__((ext_vector_type(4)));
#define MFMA16(a, b, c) __builtin_amdgcn_mfma_f32_16x16x32_bf16(a, b, c, 0, 0, 0)
#define MFMA16K16(a, b, c) __builtin_amdgcn_mfma_f32_16x16x16bf16_1k(a, b, c, 0, 0, 0)
#endif

DEVFN float bf2f(bf16_t h) { return __builtin_bit_cast(float, (unsigned)h << 16); }
DEVFN bf16_t f2bf(float f) { unsigned u = __builtin_bit_cast(unsigned, f); u += 0x7FFFu + ((u >> 16) & 1u); return (bf16_t)(u >> 16); }
template <class T> DEVFN AS1 T* gptr(T* q) { return (AS1 T*)q; }
DEVFN bf16x8 ld8g(const bf16_t* q) { return *(const AS1 bf16x8*)gptr(q); }
DEVFN float sigmoidf_(float x) { return 1.f / (1.f + expf(-x)); }
DEVFN float siluf_(float x) { return x / (1.f + expf(-x)); }
DEVFN float softplusf_(float x) { return x > 20.f ? x : log1pf(expf(x)); }
DEVFN float logsigmoidf_(float x) { return fminf(x, 0.f) - log1pf(expf(-fabsf(x))); }
#ifdef HIPEMU
DEVFN float wave_sum(float v) { for (int m = 32; m >= 1; m >>= 1) v += __shfl_xor(v, m); return v; }
#define SHFL_CONST(x, ln) __shfl(x, ln)
#define XOR8(x, m) __shfl_xor(x, m)
#else
template <int CTRL> DEVFN float dpp_f(float v) { return __builtin_bit_cast(float, __builtin_amdgcn_update_dpp(0, __builtin_bit_cast(int, v), CTRL, 0xF, 0xF, false)); }
template <int CTRL> DEVFN int dpp_i(int v) { return __builtin_amdgcn_update_dpp(0, v, CTRL, 0xF, 0xF, false); }
DEVFN float rdl_f(float v, int ln) { return __builtin_bit_cast(float, __builtin_amdgcn_readlane(__builtin_bit_cast(int, v), ln)); }
DEVFN float wave_sum(float v) {
  v += dpp_f<0xB1>(v);
  v += dpp_f<0x4E>(v);
  v += dpp_f<0x141>(v);
  v += dpp_f<0x140>(v);
  return (rdl_f(v, 0) + rdl_f(v, 16)) + (rdl_f(v, 32) + rdl_f(v, 48));
}
DEVFN float shfl_const_(float x, int ln) { return rdl_f(x, ln); }
DEVFN int shfl_const_(int x, int ln) { return __builtin_amdgcn_readlane(x, ln); }
#define SHFL_CONST(x, ln) shfl_const_(x, ln)
DEVFN float xor8_(float x, int m) { return m == 1 ? dpp_f<0xB1>(x) : m == 2 ? dpp_f<0x4E>(x) : dpp_f<0x141>(x); }
DEVFN int xor8_(int x, int m) { return m == 1 ? dpp_i<0xB1>(x) : m == 2 ? dpp_i<0x4E>(x) : dpp_i<0x141>(x); }
#define XOR8(x, m) xor8_(x, m)
#endif

constexpr size_t al(size_t x) { return (x + 255) & ~(size_t)255; }
struct Ws {
  static constexpr size_t BAR = 0;
  static constexpr size_t CNT = 16384;
  static constexpr size_t MOD = CNT + (size_t)DEPTH_ * 64 * 256;
  static constexpr size_t ZROW = al(MOD + (size_t)DEPTH_ * NR_ * NMOD_ * 4);
  static constexpr size_t ZERO_END = al(ZROW + 2048);
  static constexpr size_t MODP = ZERO_END;
  static constexpr size_t RWT = al(MODP + (size_t)16 * DEPTH_ * NR_ * NMOD_ * 4);
  static constexpr size_t LORA = al(RWT + (size_t)DEPTH_ * 64 * 1024 * 4);
  static constexpr size_t X = al(LORA + (size_t)DEPTH_ * 98304 * 2);
  static constexpr size_t U = al(X + (size_t)NT_ * 1024 * 4);
  static constexpr size_t YMIX = al(U + (size_t)NT_ * 1024 * 2);
  static constexpr size_t ZX = al(YMIX + (size_t)NT_ * 1024 * 2);
  static constexpr size_t MIX = ZX;
  static constexpr size_t LTOK = al(ZX + (size_t)NT_ * NIN_ * 2);
  static constexpr size_t LWT = al(LTOK + (size_t)64 * NT_ * 4);
  static constexpr size_t WIN = al(LWT + (size_t)64 * NT_ * 4);
  static constexpr size_t WOUT = al(WIN + (size_t)DEPTH_ * NIN_ * 1024 * 2);
  static constexpr size_t W13 = al(WOUT + (size_t)DEPTH_ * 1024 * 1024 * 2);
  static constexpr size_t W2T = al(W13 + (size_t)65 * 512 * 1024 * 2);
  static constexpr size_t UNI = al(W2T + (size_t)65 * 1024 * 256 * 2);
  static constexpr size_t XBC = UNI;
  static constexpr size_t XBCT = al(XBC + (size_t)NT_ * 1024 * 2);
  static constexpr size_t DTB = al(XBCT + (size_t)NT_ * 768 * 2);
  static constexpr size_t SST = al(DTB + (size_t)NT_ * 16 * 4);
  static constexpr size_t SCD = al(SST + (size_t)2 * NT_ / 128 * 8 * 8192 * 4);
  static constexpr size_t HIN = al(SCD + (size_t)2 * NT_ / 128 * 8 * 4);
  static constexpr size_t YS = SST;
  static constexpr size_t LA = al(HIN + (size_t)2 * NT_ / 128 * 8 * 8192 * 2);
  static constexpr size_t VT = al(LA + (size_t)2 * NT_ * 128 * 4);
  static constexpr size_t QT = al(VT + (size_t)NT_ * 256 * 2);
  static constexpr size_t OI = al(QT + (size_t)2 * NT_ * 128 * 2);
  static constexpr size_t GST = al(OI + (size_t)NT_ * 256 * 4);
  static constexpr size_t GCD = al(GST + (size_t)2 * NT_ / 64 * 4 * 2048 * 4);
  static constexpr size_t GSIN = al(GCD + (size_t)2 * NT_ / 64 * 4 * 32 * 4);
  static constexpr size_t RR = al(GSIN + (size_t)2 * NT_ / 64 * 4 * 2048 * 2);
  static constexpr size_t VV = RR + (size_t)NT_ * 256 * 2;
  static constexpr size_t KK = VV + (size_t)NT_ * 256 * 2;
  static constexpr size_t KD = KK + (size_t)NT_ * 256 * 2;
  static constexpr size_t BD = KD + (size_t)2 * NT_ * 256 * 2;
  static constexpr size_t LW = BD + (size_t)2 * NT_ * 256 * 2;
  static constexpr size_t GATE = LW + (size_t)2 * NT_ * 256 * 4;
  static constexpr size_t YR = GATE + (size_t)NT_ * 256 * 4;
  static constexpr size_t RML = al(YR + (size_t)2 * NT_ * 256 * 4);
  static constexpr size_t RNS = RML + (size_t)(NT_ / 16) * 8 * 4096 * 2;
  static constexpr size_t RWC = RNS + (size_t)(NT_ / 16) * 8 * 4096 * 2;
  static constexpr size_t RG = RWC + (size_t)(NT_ / 16) * 8 * 64 * 4;
  static constexpr size_t RY0 = RG + (size_t)(NT_ / 16) * 8 * 1024 * 2;
  static constexpr size_t LI = RY0 + (size_t)(NT_ / 16) * 8 * 1024 * 4;
  static constexpr size_t KRW = LI + (size_t)NT_ * 384 * 2;
  static constexpr size_t MIXER_END = KRW + (size_t)NT_ * 256 * 2;
  static constexpr size_t HID = UNI;
  static constexpr size_t YBUF = al(HID + ((size_t)NT_ * 9 + 65 * 128) * 256 * 2);
  static constexpr size_t MOE_END = YBUF + (size_t)NT_ * 9 * 1024 * 2;
  static constexpr size_t END = al(MIXER_END > MOE_END ? MIXER_END : MOE_END);
};

struct Params {
  const float* in[40];
  float* out;
  unsigned char* ws;
};
enum { I_X = 0, I_C, I_CTX, I_CCTX, I_ADAW, I_ADAB, I_WIN, I_CONVW, I_CONVB, I_DTBIAS, I_ALOG, I_SSDD, I_SSDNW, I_MU, I_W0, I_W2, I_A0, I_A2,
       I_G2, I_KKW, I_KAW, I_RK, I_LNXW, I_LNXB, I_GU, I_GB, I_GNW, I_WOUT, I_LN1W, I_LN1B, I_LN2W, I_LN2B, I_RW, I_RB, I_EW1, I_EW3, I_EW2,
       I_SW1, I_SW3, I_SW2 };

#define PH_SMEM 47104
#define SM_PRE (PH_SMEM)
#define SM_TAB (PH_SMEM + 1024)
#define SM_BAR (PH_SMEM + 2032)
#ifdef HIPEMU
#define INP(i) (p.in[i])
#define LAUNDER(x)
#define TIDX ((int)threadIdx.x)
#define BIDX ((int)blockIdx.x)
#define LAUNDER_V(x)
#else
extern __shared__ __align__(16) unsigned char smem_dyn[];
DEVFN const float* inp_lds(int i) {
  const volatile unsigned* t = (const volatile unsigned*)(smem_dyn + SM_TAB) + 2 * i;
  unsigned lo = __builtin_amdgcn_readfirstlane(t[0]), hi = __builtin_amdgcn_readfirstlane(t[1]);
  return (const float*)(((unsigned long long)hi << 32) | lo);
}
#define INP(i) inp_lds(i)
#define LAUNDER(x) asm volatile("" : "+s"(x))
DEVFN int tidx_() { int t = threadIdx.x; asm volatile("" : "+v"(t)); return t; }
DEVFN int bidx_() { int b = blockIdx.x; asm volatile("" : "+s"(b)); return b; }
#define TIDX tidx_()
#define LAUNDER_V(x) asm volatile("" : "+v"(x))
#define BIDX bidx_()
#endif
#ifndef HIPEMU
#define XB_TMO      128
#define XB_XCNT(j)  (256  + 64 * (j))
#define XB_XSUB(j)  (1280 + 64 * (j))
#define XB_XGEN(j)  (2304 + 64 * (j))
#define XB_TOP      3328
#define XB_TOPGEN   3392
#define XCD_BAR_WORDS 3456
#define XB_SPIN_CAP (1u << 22)
#define LAS __attribute__((address_space(3)))
__device__ __forceinline__ unsigned xb_ld(unsigned* p)              { return __hip_atomic_load(p, __ATOMIC_RELAXED, __HIP_MEMORY_SCOPE_AGENT); }
__device__ __forceinline__ unsigned xb_add(unsigned* p, unsigned v) { return __hip_atomic_fetch_add(p, v, __ATOMIC_RELAXED, __HIP_MEMORY_SCOPE_AGENT); }
__device__ __forceinline__ unsigned xb_xcc_id() { return (unsigned)__builtin_amdgcn_s_getreg((3 << 11) | 20) & 0xFu; }
#define XB_SPIN(cond, bar) do { unsigned _sp = 0; while (cond) { __builtin_amdgcn_s_sleep(1); \
    if ((++_sp & 255u) == 0u) { if (xb_ld(&(bar)[XB_TMO])) break; if (_sp > XB_SPIN_CAP) { atomicAdd(&(bar)[XB_TMO], 1u); break; } } } } while (0)
struct XcdBarrier { unsigned* bar; unsigned x; volatile LAS unsigned* st; };
__device__ __forceinline__ XcdBarrier xcd_barrier_post(unsigned* bar, volatile LAS unsigned* st) {
    XcdBarrier b; b.bar = bar; b.x = xb_xcc_id(); b.st = st;
    if (threadIdx.x == 0) (void)xb_add(&bar[XB_XCNT(b.x)], 1u);
    return b;
}
__device__ __forceinline__ void xcd_barrier_complete(unsigned* bar, unsigned x, unsigned& nloc, unsigned& nx) {
    const unsigned G = gridDim.x * gridDim.y * gridDim.z;
    unsigned sum, cnt, mine, sp = 0u;
    for (;;) {
        sum = 0u; cnt = 0u; mine = 0u;
#pragma unroll
        for (unsigned j = 0; j < 16; ++j) { const unsigned c = xb_ld(&bar[XB_XCNT(j)]); sum += c; cnt += (c > 0u) ? 1u : 0u; mine = (j == x) ? c : mine; }
        if (sum == G) break;
        __builtin_amdgcn_s_sleep(1);
        if ((++sp & 255u) == 0u) { if (xb_ld(&bar[XB_TMO])) break; if (sp > XB_SPIN_CAP) { atomicAdd(&bar[XB_TMO], 1u); break; } }
    }
    nloc = mine > 0u ? mine : 1u; nx = cnt > 0u ? cnt : 1u;
}
__device__ __forceinline__ void xcd_barrier(const XcdBarrier& b) {
    asm volatile("s_waitcnt vmcnt(0)" ::: "memory");
    __syncthreads();
    if (threadIdx.x == 0) {
        unsigned* bar = b.bar;
        __builtin_amdgcn_s_waitcnt(0);
        unsigned nloc = b.st[0], nx = b.st[1];
        if (nloc == 0u) { xcd_barrier_complete(bar, b.x, nloc, nx); b.st[0] = nloc; b.st[1] = nx; }
        const unsigned old = xb_add(&bar[XB_XSUB(b.x)], 1u);
        const unsigned gen = old / nloc;
        if (old + 1u == (gen + 1u) * nloc) {
            __builtin_amdgcn_fence(__ATOMIC_RELEASE, "agent");
            asm volatile("s_waitcnt vmcnt(0)" ::: "memory");
            const unsigned og = xb_add(&bar[XB_TOP], 1u);
            const unsigned tg = og / nx;
            if (og + 1u == (tg + 1u) * nx) xb_add(&bar[XB_TOPGEN], 1u);
            else XB_SPIN(xb_ld(&bar[XB_TOPGEN]) == tg, bar);
            __builtin_amdgcn_fence(__ATOMIC_ACQUIRE, "agent");
            xb_add(&bar[XB_XGEN(b.x)], 1u);
            asm volatile("s_waitcnt vmcnt(0)" ::: "memory");
        } else {
            XB_SPIN(xb_ld(&bar[XB_XGEN(b.x)]) == gen, bar);
            __builtin_amdgcn_fence(__ATOMIC_ACQUIRE, "agent");
            asm volatile("s_waitcnt vmcnt(0)" ::: "memory");
        }
    }
    __syncthreads();
}
#endif

DEVFN int tokmap(int dir, int p) { return dir == 0 ? p : (p < CTX_ ? CTX_ - 1 - p : 2 * CTX_ + SEQ_ - 1 - p); }
DEVFN const float* tok_input_row(const Params& p, int tok) {
  int b = tok / T_, t = tok % T_;
  return t < CTX_ ? INP(I_CTX) + ((size_t)b * CTX_ + t) * D_ : INP(I_X) + ((size_t)b * SEQ_ + (t - CTX_)) * D_;
}
DEVFN int tok_modrow(int tok) { return (tok % T_) < CTX_ ? B_ : tok / T_; }

template <class ARow, class BRow, class Epi>
DEVFN void gemm_tile(unsigned char* smem, int K, ARow arow, BRow brow, Epi epi) {
  bf16_t* As = (bf16_t*)smem;
  bf16_t* Bs = As + 128 * LDT;
  const int tid = TIDX, lane = tid & 63, wave = tid >> 6, wr = wave >> 1, wc = wave & 1;
  const int g = lane >> 4, l15 = lane & 15;
  const int lr = tid >> 3, lc = (tid & 7) * 8;
  const AS1 bf16_t* ap[4];
  const AS1 bf16_t* bp[4];
#pragma unroll
  for (int i = 0; i < 4; ++i) { ap[i] = gptr(arow(lr + 32 * i)); bp[i] = gptr(brow(lr + 32 * i)); }
  f32x4 acc[4][4];
#pragma unroll
  for (int mi = 0; mi < 4; ++mi)
#pragma unroll
    for (int ni = 0; ni < 4; ++ni) acc[mi][ni] = f32x4{0.f, 0.f, 0.f, 0.f};
  u32x4 ra0[4], rb0[4], ra1[4], rb1[4];
#pragma unroll
  for (int i = 0; i < 4; ++i) { ra0[i] = *(const AS1 u32x4*)(ap[i] + lc); rb0[i] = *(const AS1 u32x4*)(bp[i] + lc); }
  if (K > 64) {
#pragma unroll
    for (int i = 0; i < 4; ++i) { ra1[i] = *(const AS1 u32x4*)(ap[i] + 64 + lc); rb1[i] = *(const AS1 u32x4*)(bp[i] + 64 + lc); } }
  auto compute = [&]() {
#pragma unroll
    for (int kk = 0; kk < 2; ++kk) {
      bf16x8 af[4], bfr[4];
#pragma unroll
      for (int mi = 0; mi < 4; ++mi) af[mi] = *(const bf16x8*)(As + (wr * 64 + mi * 16 + l15) * LDT + kk * 32 + g * 8);
#pragma unroll
      for (int ni = 0; ni < 4; ++ni) bfr[ni] = *(const bf16x8*)(Bs + (wc * 64 + ni * 16 + l15) * LDT + kk * 32 + g * 8);
#pragma unroll
      for (int mi = 0; mi < 4; ++mi)
#pragma unroll
        for (int ni = 0; ni < 4; ++ni) acc[mi][ni] = MFMA16(af[mi], bfr[ni], acc[mi][ni]);
    } };
  for (int k0 = 0; k0 < K; k0 += 128) {
    __syncthreads();
#pragma unroll
    for (int i = 0; i < 4; ++i) { *(u32x4*)(As + (lr + 32 * i) * LDT + lc) = ra0[i]; *(u32x4*)(Bs + (lr + 32 * i) * LDT + lc) = rb0[i]; }
    __syncthreads();
    if (k0 + 128 < K) {
#pragma unroll
      for (int i = 0; i < 4; ++i) { ra0[i] = *(const AS1 u32x4*)(ap[i] + k0 + 128 + lc); rb0[i] = *(const AS1 u32x4*)(bp[i] + k0 + 128 + lc); } }
    compute();
    if (k0 + 64 < K) {
      __syncthreads();
#pragma unroll
      for (int i = 0; i < 4; ++i) { *(u32x4*)(As + (lr + 32 * i) * LDT + lc) = ra1[i]; *(u32x4*)(Bs + (lr + 32 * i) * LDT + lc) = rb1[i]; }
      __syncthreads();
      if (k0 + 192 < K) {
#pragma unroll
        for (int i = 0; i < 4; ++i) { ra1[i] = *(const AS1 u32x4*)(ap[i] + k0 + 192 + lc); rb1[i] = *(const AS1 u32x4*)(bp[i] + k0 + 192 + lc); } }
      compute();
    }
  }
  epi(acc, wr, wc, g, l15);
}

template <int NCH, class Val, class RowP>
DEVFN void tile_store_bf16(unsigned char* smem, int wr, int g, int l15, Val val, RowP rowp) {
  constexpr int LDC = NCH * 8 + 8;
  bf16_t* T = (bf16_t*)smem;
  const int tid = TIDX;
  __syncthreads();
  val(T, LDC);
  __syncthreads();
#pragma unroll
  for (int pass = 0; pass < NCH / 2; ++pass) { const int id = tid + 256 * pass, row = id / NCH, c = id % NCH;
    bf16_t* dst = rowp(row, c * 8);
    if (dst) *(AS1 u32x4*)gptr(dst) = *(const u32x4*)(T + row * LDC + c * 8); }
  (void)wr; (void)g; (void)l15;
}
DEVFN void cvt_tile(unsigned char* smem, const float* src, int K, int N, int k0, int n0, bf16_t* dst, int ldd, int mode) {
  float* s = (float*)smem;
  const int tid = TIDX;
  const AS1 float* gsrc = gptr(src);
  __syncthreads();
  { const int kk = tid >> 4, n4 = (tid & 15) * 4;
#pragma unroll
    for (int pass = 0; pass < 4; ++pass) { const int k = kk + 16 * pass;
      f32x4 v = f32x4{0.f, 0.f, 0.f, 0.f};
      if (n0 + n4 < N) v = *(const AS1 f32x4*)(gsrc + (size_t)(k0 + k) * N + n0 + n4);
      s[k * 65 + n4] = v[0]; s[k * 65 + n4 + 1] = v[1]; s[k * 65 + n4 + 2] = v[2]; s[k * 65 + n4 + 3] = v[3]; } }
  __syncthreads();
  { const int nn = tid >> 2, k16 = (tid & 3) * 16, n = n0 + nn;
    if (n < N) { const int row = mode == 0 ? n : ((n >> 4) * 32 + (n & 15) + (mode == 2 ? 16 : 0));
      u32x4 o0, o1;
#pragma unroll
      for (int j = 0; j < 4; ++j) { o0[j] = (unsigned)f2bf(s[(k16 + 2 * j) * 65 + nn]) | ((unsigned)f2bf(s[(k16 + 2 * j + 1) * 65 + nn]) << 16);
        o1[j] = (unsigned)f2bf(s[(k16 + 8 + 2 * j) * 65 + nn]) | ((unsigned)f2bf(s[(k16 + 9 + 2 * j) * 65 + nn]) << 16); }
      AS1 bf16_t* d = gptr(dst) + (size_t)row * ldd + k0 + k16;
      *(AS1 u32x4*)d = o0; *(AS1 u32x4*)(d + 8) = o1; } }
  (void)K;
}
DEVFN void convert_moe_weights(const Params& p, int l, unsigned char* smem, int bid, int nb) {
  bf16_t* w13 = (bf16_t*)(p.ws + Ws::W13);
  bf16_t* w2t = (bf16_t*)(p.ws + Ws::W2T);
  const int per_e = 192;
  for (int u = bid; u < 65 * per_e; u += nb) {
    int e = u / per_e, r = u % per_e, which = r / 64, t = r % 64;
    if (which < 2) {
      const float* src = e < 64 ? (which == 0 ? INP(I_EW1) : INP(I_EW3)) + ((size_t)l * 64 + e) * 1024 * 256 : (which == 0 ? INP(I_SW1) : INP(I_SW3)) + (size_t)l * 1024 * 256;
      cvt_tile(smem, src, 1024, 256, (t >> 2) * 64, (t & 3) * 64, w13 + (size_t)e * 512 * 1024, 1024, which == 0 ? 1 : 2);
    } else {
      const float* src = e < 64 ? INP(I_EW2) + ((size_t)l * 64 + e) * 256 * 1024 : INP(I_SW2) + (size_t)l * 256 * 1024;
      cvt_tile(smem, src, 256, 1024, (t >> 4) * 64, (t & 15) * 64, w2t + (size_t)e * 1024 * 256, 256, 0);
    }
  }
}
DEVFN void phase0(const Params& p, unsigned char* smem) {
  const int tid = TIDX;
  float* modp = (float*)(p.ws + Ws::MODP);
  for (int u = BIDX; u < DEPTH_ * 24 * 16; u += gridDim.x) {
    int l = u / (24 * 16), jb = (u / 16) % 24, ks = u % 16;
    float* sc = (float*)smem;
    __syncthreads();
    for (int e = tid; e < NR_ * 64; e += 256) { int r = e / 64, i = ks * 64 + (e % 64); float cv = r < B_ ? INP(I_C)[(size_t)r * D_ + i] : INP(I_CCTX)[i]; sc[e] = siluf_(cv); }
    __syncthreads();
    int j = jb * 256 + tid;
    float acc[NR_];
#pragma unroll
    for (int r = 0; r < NR_; ++r) acc[r] = 0.f;
    const float* w = INP(I_ADAW) + ((size_t)l * D_ + ks * 64) * NMOD_ + j;
#pragma unroll 4
    for (int i = 0; i < 64; ++i) { float wv = w[(size_t)i * NMOD_];
#pragma unroll
      for (int r = 0; r < NR_; ++r) acc[r] += sc[r * 64 + i] * wv; }
#pragma unroll
    for (int r = 0; r < NR_; ++r) modp[(((size_t)ks * DEPTH_ + l) * NR_ + r) * NMOD_ + j] = acc[r];
  }
  bf16_t* win = (bf16_t*)(p.ws + Ws::WIN);
  bf16_t* wout = (bf16_t*)(p.ws + Ws::WOUT);
  for (int u = BIDX; u < DEPTH_ * 16 * 55; u += gridDim.x) {
    int l = u / (16 * 55), r = u % (16 * 55);
    cvt_tile(smem, INP(I_WIN) + (size_t)l * 1024 * NIN_, 1024, NIN_, (r / 55) * 64, (r % 55) * 64, win + (size_t)l * NIN_ * 1024, 1024, 0);
  }
  for (int u = BIDX; u < DEPTH_ * 256; u += gridDim.x) {
    int l = u / 256, r = u % 256;
    cvt_tile(smem, INP(I_WOUT) + (size_t)l * 1024 * 1024, 1024, 1024, (r / 16) * 64, (r % 16) * 64, wout + (size_t)l * 1024 * 1024, 1024, 0);
  }
  { bf16_t* lo = (bf16_t*)(p.ws + Ws::LORA);
    for (int u = BIDX * 256 + tid; u < DEPTH_ * 98304; u += gridDim.x * 256) {
      const int l = u / 98304, r = u % 98304; float v;
      if (r < 32768) { const int d = r >> 14, n = (r >> 6) & 255, k = r & 63; v = INP(I_W2)[(((size_t)l * 2 + d) * 64 + k) * 256 + n]; }
      else if (r < 65536) { const int r2 = r - 32768, d = r2 >> 14, n = (r2 >> 6) & 255, k = r2 & 63; v = INP(I_A2)[(((size_t)l * 2 + d) * 64 + k) * 256 + n]; }
      else { const int r2 = r - 65536, n = r2 >> 7, k = r2 & 127; v = INP(I_G2)[((size_t)l * 128 + k) * 256 + n]; }
      lo[u] = f2bf(v); } }
  float* rwt = (float*)(p.ws + Ws::RWT);
  for (int u = BIDX * 256 + tid; u < DEPTH_ * 64 * 1024; u += gridDim.x * 256) {
    int l = u / (64 * 1024), e = (u / 1024) % 64, i = u % 1024;
    rwt[u] = INP(I_RW)[((size_t)l * 1024 + i) * 64 + e];
  }
}

DEVFN void phase0b(const Params& p) {
  float* mod = (float*)(p.ws + Ws::MOD); const float* modp = (const float*)(p.ws + Ws::MODP);
  for (int u = BIDX * 256 + TIDX; u < DEPTH_ * NR_ * NMOD_; u += gridDim.x * 256) {
    int l = u / (NR_ * NMOD_), j = u % NMOD_;
    float s = INP(I_ADAB)[(size_t)l * NMOD_ + j];
    for (int ks = 0; ks < 16; ++ks) s += modp[(size_t)ks * DEPTH_ * NR_ * NMOD_ + u];
    mod[u] = s;
  }
}

DEVFN void row_stats(const float (&v)[16], float& mean, float& rstd) {
  float s = 0.f;
#pragma unroll
  for (int i = 0; i < 16; ++i) s += v[i];
  mean = wave_sum(s) * (1.f / 1024.f);
  float q = 0.f;
#pragma unroll
  for (int i = 0; i < 16; ++i) { float d = v[i] - mean; q += d * d; }
  rstd = rsqrtf(wave_sum(q) * (1.f / 1024.f) + 1e-5f);
}
DEVFN void load_row16(const float* row, int lane, float (&v)[16]) {
  const AS1 float* r = gptr(row);
#pragma unroll
  for (int j = 0; j < 4; ++j) { const f32x4 t = *(const AS1 f32x4*)(r + lane * 4 + 256 * j); v[4 * j] = t[0]; v[4 * j + 1] = t[1]; v[4 * j + 2] = t[2]; v[4 * j + 3] = t[3]; }
}
DEVFN void moe_residual_row(const Params& p, int lp, int tok, int lane, float (&xv)[16]) {
  const float* mod = (const float*)(p.ws + Ws::MOD) + ((size_t)lp * NR_ + tok_modrow(tok)) * NMOD_;
  const bf16_t* yb = (const bf16_t*)(p.ws + Ws::YBUF) + (size_t)tok * NSLOT * 1024;
  float g2[16], w[16], b[16];
  load_row16(mod + 5 * 1024, lane, g2);
  load_row16(INP(I_LN2W) + (size_t)lp * 1024, lane, w);
  load_row16(INP(I_LN2B) + (size_t)lp * 1024, lane, b);
  u32x2 sl[NSLOT][4];
#pragma unroll
  for (int s = 0; s < NSLOT; ++s)
#pragma unroll
    for (int j = 0; j < 4; ++j) sl[s][j] = *(const AS1 u32x2*)gptr(yb + (size_t)s * 1024 + lane * 4 + 256 * j);
  float f[16];
#pragma unroll
  for (int i = 0; i < 16; ++i) f[i] = 0.f;
#pragma unroll
  for (int s = 0; s < NSLOT; ++s)
#pragma unroll
    for (int j = 0; j < 4; ++j) { const u32x2 t = sl[s][j];
      f[4 * j] += bf2f((bf16_t)(t[0] & 0xFFFF)); f[4 * j + 1] += bf2f((bf16_t)(t[0] >> 16)); f[4 * j + 2] += bf2f((bf16_t)(t[1] & 0xFFFF)); f[4 * j + 3] += bf2f((bf16_t)(t[1] >> 16)); }
#pragma unroll
  for (int i = 0; i < 16; ++i) xv[i] = ALPHA_ * xv[i] + g2[i] * f[i];
  float mean, rstd;
  row_stats(xv, mean, rstd);
#pragma unroll
  for (int i = 0; i < 16; ++i) xv[i] = (xv[i] - mean) * rstd * w[i] + b[i];
}
DEVFN void phase1(const Params& p, int l) {
  const int lane = TIDX & 63, wave = TIDX >> 6;
  float* X = (float*)(p.ws + Ws::X);
  bf16_t* U = (bf16_t*)(p.ws + Ws::U);
  for (int tok = BIDX * 4 + wave; tok < NT_; tok += gridDim.x * 4) {
    float xv[16], sh[16], sc[16], mean, rstd;
    const float* mod = (const float*)(p.ws + Ws::MOD) + ((size_t)l * NR_ + tok_modrow(tok)) * NMOD_;
    load_row16(mod, lane, sh);
    load_row16(mod + 1024, lane, sc);
    if (l == 0) load_row16(tok_input_row(p, tok), lane, xv);
    else { load_row16(X + (size_t)tok * 1024, lane, xv); moe_residual_row(p, l - 1, tok, lane, xv); }
#pragma unroll
    for (int j = 0; j < 4; ++j) *(float4*)(X + (size_t)tok * 1024 + lane * 4 + 256 * j) = make_float4(xv[4 * j], xv[4 * j + 1], xv[4 * j + 2], xv[4 * j + 3]);
    row_stats(xv, mean, rstd);
#pragma unroll
    for (int j = 0; j < 4; ++j) {
      float u0 = (xv[4 * j] - mean) * rstd * (1.f + sc[4 * j]) + sh[4 * j], u1 = (xv[4 * j + 1] - mean) * rstd * (1.f + sc[4 * j + 1]) + sh[4 * j + 1];
      float u2 = (xv[4 * j + 2] - mean) * rstd * (1.f + sc[4 * j + 2]) + sh[4 * j + 2], u3 = (xv[4 * j + 3] - mean) * rstd * (1.f + sc[4 * j + 3]) + sh[4 * j + 3];
      *(uint2*)(U + (size_t)tok * 1024 + lane * 4 + 256 * j) = make_uint2((unsigned)f2bf(u0) | ((unsigned)f2bf(u1) << 16), (unsigned)f2bf(u2) | ((unsigned)f2bf(u3) << 16));
    }
  }
}
DEVFN void phase_final(const Params& p) {
  const int lane = TIDX & 63, wave = TIDX >> 6;
  const float* X = (const float*)(p.ws + Ws::X);
  for (int r = BIDX * 4 + wave; r < B_ * SEQ_; r += gridDim.x * 4) {
    int b = r / SEQ_, s = r % SEQ_, tok = b * T_ + CTX_ + s;
    float xv[16];
    load_row16(X + (size_t)tok * 1024, lane, xv);
    moe_residual_row(p, DEPTH_ - 1, tok, lane, xv);
#pragma unroll
    for (int j = 0; j < 4; ++j) *(float4*)(p.out + (size_t)r * 1024 + lane * 4 + 256 * j) = make_float4(xv[4 * j], xv[4 * j + 1], xv[4 * j + 2], xv[4 * j + 3]);
  }
}

DEVFN void phase2(const Params& p, int l, unsigned char* smem) {
  const bf16_t* U = (const bf16_t*)(p.ws + Ws::U);
  const bf16_t* W = (const bf16_t*)(p.ws + Ws::WIN) + (size_t)l * NIN_ * 1024;
  bf16_t* ZX = (bf16_t*)(p.ws + Ws::ZX);
  const int nct = (NIN_ + 127) / 128;
  for (int u = BIDX; u < (NT_ / 128) * nct; u += gridDim.x) {
    int rt = u / nct, ct = u % nct;
    gemm_tile(smem, 1024,
      [&](int r) { return U + (size_t)(rt * 128 + r) * 1024; },
      [&](int r) { int n = ct * 128 + r; return n < NIN_ ? W + (size_t)n * 1024 : (const bf16_t*)(p.ws + Ws::ZROW); },
      [&](f32x4 (&acc)[4][4], int wr, int wc, int g, int l15) {
        tile_store_bf16<16>(smem, wr, g, l15,
          [&](bf16_t* T, int ldc) {
#pragma unroll
            for (int mi = 0; mi < 4; ++mi)
#pragma unroll
              for (int ni = 0; ni < 4; ++ni)
#pragma unroll
                for (int i = 0; i < 4; ++i) T[(wr * 64 + mi * 16 + 4 * g + i) * ldc + wc * 64 + ni * 16 + l15] = f2bf(acc[mi][ni][i]); },
          [&](int row, int c0) { return ct * 128 + c0 < NIN_ ? ZX + (size_t)(rt * 128 + row) * NIN_ + ct * 128 + c0 : (bf16_t*)nullptr; });
      });
  }
}

DEVFN float zxv(const bf16_t* ZX, int tok, int col) { return bf2f(gptr(ZX)[(size_t)tok * NIN_ + col]); }
struct Nbr { int n; int tok[4]; };
DEVFN Nbr shift_nbrs(int tok) {
  Nbr nb; int b = tok / T_, t = tok % T_;
  if (t < CTX_) { nb.n = 2; nb.tok[0] = t > 0 ? tok - 1 : -1; nb.tok[1] = t < CTX_ - 1 ? tok + 1 : -1; nb.tok[2] = -1; nb.tok[3] = -1; }
  else { int s = t - CTX_, row = s / 64, col = s % 64; nb.n = 4; nb.tok[0] = col > 0 ? tok - 1 : -1; nb.tok[1] = col < 63 ? tok + 1 : -1;
    nb.tok[2] = row > 0 ? tok - 64 : -1; nb.tok[3] = row < SEQ_ / 64 - 1 ? tok + 64 : -1; }
  (void)b; return nb;
}
DEVFN float shiftmix(const bf16_t* ZX, const float* mu, int tok, const Nbr& nb, int ch) {
  float z = zxv(ZX, tok, ORW + ch), o = z;
#pragma unroll
  for (int j = 0; j < 4; ++j) if (j < nb.n) { float v = nb.tok[j] >= 0 ? zxv(ZX, nb.tok[j], ORW + ch) : 0.f; o += mu[j * 1152 + ch] * (v - z); }
  return o;
}
#define LI_LD 392
#define KL_LD 264
DEVFN void phase3(const Params& p, int l, unsigned char* smem) {
  const int tid = TIDX, lane = tid & 63, wave = tid >> 6, q = lane >> 4, l15 = lane & 15;
  const bf16_t* ZX = (const bf16_t*)(p.ws + Ws::ZX);
  bf16_t* XBC = (bf16_t*)(p.ws + Ws::XBC); float* DTB = (float*)(p.ws + Ws::DTB);
  bf16_t* RR = (bf16_t*)(p.ws + Ws::RR); bf16_t* VV = (bf16_t*)(p.ws + Ws::VV); bf16_t* KKb = (bf16_t*)(p.ws + Ws::KK);
  bf16_t* KRW = (bf16_t*)(p.ws + Ws::KRW); bf16_t* LIg = (bf16_t*)(p.ws + Ws::LI);
  float* LA = (float*)(p.ws + Ws::LA);
  const float* convw = INP(I_CONVW) + (size_t)l * 3 * 1024; const float* convb = INP(I_CONVB) + (size_t)l * 1024;
  const float* mu = INP(I_MU) + (size_t)l * 4 * 1152;
  float* gdl = (float*)smem;
  const float kkw = INP(I_KKW)[(size_t)l * 256 + tid];
  for (int tile = BIDX; tile < NT_ / 16; tile += gridDim.x) {
    const int tok0 = tile * 16, t0 = tok0 % T_, bb = tok0 / T_;
    const bool isctx = t0 < CTX_;
    const int s0 = t0 - CTX_;
    const bool lval = isctx ? (t0 > 0) : ((s0 & 63) != 0), rval = isctx ? (t0 + 16 < CTX_) : ((s0 & 63) != 48);
    const bool uval = !isctx && (s0 >= 64), dval = !isctx && (s0 + 64 < SEQ_);
    __syncthreads();
    {
      const bool segstart = (t0 == 0 || t0 == CTX_), segend = (t0 + 16 == CTX_ || t0 + 16 == T_);
      bf16_t* XBCT = (bf16_t*)(p.ws + Ws::XBCT) + ((size_t)(bb * NC128 + t0 / 128) * 768) * 128 + (t0 % 128);
#pragma unroll 1
      for (int j = 0; j < 4; ++j) { const int c = tid + 256 * j;
        const AS1 bf16_t* zp = gptr(ZX) + (size_t)tok0 * NIN_ + OXBC + c - NIN_; AS1 bf16_t* xp = gptr(XBC) + (size_t)tok0 * 1024 + c;
        float z[18];
#pragma unroll
        for (int i = 0; i < 18; ++i) { z[i] = ((i == 0 && segstart) || (i == 17 && segend)) ? 0.f : bf2f(*zp); zp += NIN_; LAUNDER_V(zp); }
        const float w0 = convw[c], w1 = convw[1024 + c], w2 = convw[2048 + c], cb = convb[c];
        bf16_t y[16];
#pragma unroll
        for (int i = 0; i < 16; ++i) { y[i] = f2bf(siluf_(cb + w0 * z[i] + w1 * z[i + 1] + w2 * z[i + 2])); *xp = y[i]; xp += 1024; LAUNDER_V(xp); }
        if (c < 768) {
          u32x4 o0, o1;
#pragma unroll
          for (int i = 0; i < 4; ++i) { o0[i] = (unsigned)y[2 * i] | ((unsigned)y[2 * i + 1] << 16); o1[i] = (unsigned)y[8 + 2 * i] | ((unsigned)y[9 + 2 * i] << 16); }
          *(u32x4*)(XBCT + (size_t)c * 128) = o0; *(u32x4*)(XBCT + (size_t)c * 128 + 8) = o1; } }
      { bf16_t* VTp = (bf16_t*)(p.ws + Ws::VT) + ((size_t)(bb * NC64 + t0 / 64) * 256 + tid) * 64 + (t0 % 64);
        const AS1 bf16_t* vp = gptr(ZX) + (size_t)tok0 * NIN_ + OGV + tid;
        u32x4 o0, o1;
        bf16_t vv16[16];
#pragma unroll
        for (int i = 0; i < 16; ++i) { vv16[i] = *vp; vp += NIN_; LAUNDER_V(vp); }
#pragma unroll
        for (int i = 0; i < 4; ++i) { o0[i] = (unsigned)vv16[2 * i] | ((unsigned)vv16[2 * i + 1] << 16); o1[i] = (unsigned)vv16[8 + 2 * i] | ((unsigned)vv16[9 + 2 * i] << 16); }
        *(u32x4*)VTp = o0; *(u32x4*)(VTp + 8) = o1; }
      DTB[(size_t)tok0 * 16 + tid] = softplusf_(zxv(ZX, tok0 + (tid >> 4), ODT + (tid & 15)) + INP(I_DTBIAS)[(size_t)l * 16 + (tid & 15)]);
      gdl[tid] = zxv(ZX, tok0 + (tid >> 5), OGD + (tid & 31)); gdl[256 + tid] = zxv(ZX, tok0 + 8 + (tid >> 5), OGD + (tid & 31));
    }
#pragma unroll 1
    for (int g = 0; g < 5; ++g) {
      const bool act = !(g == 4 && tid >= 128);
      const int ch = act ? g * 256 + tid : 0;
      const AS1 bf16_t* zp0 = gptr(ZX) + (size_t)tok0 * NIN_ + ORW + ch;
      const AS1 bf16_t* zp = zp0 - NIN_;
      const float m0 = mu[ch], m1 = mu[1152 + ch], m2 = mu[2304 + ch], m3 = mu[3456 + ch];
      float z[18], o[16];
#pragma unroll
      for (int i = 0; i < 18; ++i) { z[i] = ((i == 0 && !lval) || (i == 17 && !rval)) ? 0.f : bf2f(*zp); zp += NIN_; LAUNDER_V(zp); }
#pragma unroll
      for (int i = 0; i < 16; ++i) o[i] = z[i + 1] + m0 * (z[i] - z[i + 1]) + m1 * (z[i + 2] - z[i + 1]);
      if (!isctx) {
        const AS1 bf16_t* up = zp0 - (size_t)64 * NIN_; const AS1 bf16_t* dn = zp0 + (size_t)64 * NIN_;
#pragma unroll
        for (int i = 0; i < 16; ++i) { const float zu = uval ? bf2f(*up) : 0.f, zd = dval ? bf2f(*dn) : 0.f; up += NIN_; dn += NIN_; LAUNDER_V(up); LAUNDER_V(dn);
          o[i] += m2 * (zu - z[i + 1]) + m3 * (zd - z[i + 1]); } }
      if (g == 0) { AS1 bf16_t* rp = gptr(RR) + (size_t)tok0 * 256 + tid;
#pragma unroll
        for (int i = 0; i < 16; ++i) { *rp = f2bf(o[i]); rp += 256; LAUNDER_V(rp); }
      } else if (g == 1) { AS1 bf16_t* kp = gptr(KKb) + (size_t)tok0 * 256 + tid; AS1 bf16_t* krp = gptr(KRW) + (size_t)tok0 * 256 + tid;
#pragma unroll
        for (int i = 0; i < 16; ++i) { const float kq = o[i] * kkw, nrm = sqrtf(wave_sum(kq * kq));
          *kp = f2bf(kq / fmaxf(nrm, 1e-12f)); *krp = f2bf(o[i]); kp += 256; krp += 256; LAUNDER_V(kp); LAUNDER_V(krp); }
      } else if (g == 2) { AS1 bf16_t* vp2 = gptr(VV) + (size_t)tok0 * 256 + tid;
#pragma unroll
        for (int i = 0; i < 16; ++i) { *vp2 = f2bf(o[i]); vp2 += 256; LAUNDER_V(vp2); }
      } else if (g == 3) { AS1 bf16_t* lp = gptr(LIg) + (size_t)tok0 * 384 + tid;
#pragma unroll
        for (int i = 0; i < 16; ++i) { *lp = f2bf(tid < 128 ? tanhf(o[i]) : o[i]); lp += 384; LAUNDER_V(lp); }
      } else if (act) { AS1 bf16_t* lp = gptr(LIg) + (size_t)tok0 * 384 + 256 + tid;
#pragma unroll
        for (int i = 0; i < 16; ++i) { *lp = f2bf(sigmoidf_(o[i])); lp += 384; LAUNDER_V(lp); }
      }
    }
    __syncthreads();
    { const int d = tid >> 7, c = tid & 127; const float* gu = INP(I_GU) + ((size_t)l * 2 + d) * 16 * 128; const float gb = INP(I_GB)[((size_t)l * 2 + d) * 128 + c];
      float guw[16];
#pragma unroll
      for (int i = 0; i < 16; ++i) guw[i] = gu[i * 128 + c];
#pragma unroll 4
      for (int tt = 0; tt < 16; ++tt) { float sacc = gb;
#pragma unroll
        for (int i = 0; i < 16; ++i) sacc += gdl[tt * 32 + d * 16 + i] * guw[i];
        LA[((size_t)d * NT_ + tok0 + tt) * 128 + c] = logsigmoidf_(sacc) * (1.f / 16.f); } }
  }
}

DEVFN void phase3b(const Params& p, int l, unsigned char* smem) {
  const bf16_t* LIg = (const bf16_t*)(p.ws + Ws::LI);
  const bf16_t* lora = (const bf16_t*)(p.ws + Ws::LORA) + (size_t)l * 98304;
  const bf16_t* KRg = (const bf16_t*)(p.ws + Ws::KRW); const bf16_t* KKg = (const bf16_t*)(p.ws + Ws::KK);
  float* LWp = (float*)(p.ws + Ws::LW); bf16_t* KD = (bf16_t*)(p.ws + Ws::KD); bf16_t* BD = (bf16_t*)(p.ws + Ws::BD); float* GATE = (float*)(p.ws + Ws::GATE);
  for (int u = BIDX; u < (NT_ / 128) * 10; u += gridDim.x) {
    const int rt = u / 10, which = (u % 10) >> 1, ct = u & 1;
    const int K = which < 4 ? 64 : 128, acol = which < 4 ? which * 64 : 256;
    const bf16_t* wb = which < 2 ? lora + (size_t)which * 16384 : which < 4 ? lora + 32768 + (size_t)(which - 2) * 16384 : lora + 65536;
    const float* bias = which < 2 ? INP(I_W0) + (size_t)l * 512 + which * 256 : INP(I_A0) + (size_t)l * 512 + (which & 1) * 256;
    const float* kav = INP(I_KAW) + (size_t)l * 256;
    gemm_tile(smem, K,
      [&](int r) { return LIg + (size_t)(rt * 128 + r) * 384 + acol; },
      [&](int r) { return wb + (size_t)(ct * 128 + r) * K; },
      [&](f32x4 (&acc)[4][4], int wr, int wc, int g, int l15) {
#pragma unroll
        for (int ni = 0; ni < 4; ++ni) { const int col = ct * 128 + wc * 64 + ni * 16 + l15;
          const float bv = which < 4 ? bias[col] : 0.f, ka = kav[col];
#pragma unroll
          for (int mi = 0; mi < 4; ++mi)
#pragma unroll
            for (int i = 0; i < 4; ++i) { const int row = rt * 128 + wr * 64 + mi * 16 + 4 * g + i; const size_t o = (size_t)row * 256 + col;
              const float v = acc[mi][ni][i];
              if (which < 2) LWp[(size_t)which * NT_ * 256 + o] = -0.6065306597126334f * sigmoidf_(v + bv);
              else if (which < 4) { const float a = sigmoidf_(v + bv); const size_t od = (size_t)(which - 2) * NT_ * 256 + o;
                KD[od] = f2bf(bf2f(KRg[o]) * (1.f + (a - 1.f) * ka)); BD[od] = f2bf(bf2f(KKg[o]) * a); }
              else GATE[o] = v; } }
      });
  }
}

DEVFN bf16x8 ld8(const bf16_t* p) { return *(const bf16x8*)p; }
typedef short bf16x4v __attribute__((ext_vector_type(4)));
DEVFN bf16x4v cvt4(f32x4 v) { return bf16x4v{(short)f2bf(v[0]), (short)f2bf(v[1]), (short)f2bf(v[2]), (short)f2bf(v[3])}; }
DEVFN bf16x8 cat44(bf16x4v a, bf16x4v b) { return bf16x8{a[0], a[1], a[2], a[3], b[0], b[1], b[2], b[3]}; }
DEVFN bf16x4v ld4(const bf16_t* p) { return *(const bf16x4v*)p; }
DEVFN int rm_off(int i, int k) { return i * 64 + ((((k >> 3) ^ (i & 7)) << 3) | (k & 7)); }
#define RW_WAVE_LDS 11264
DEVFN void rwkv_chunk(const Params& p, int unit_base, unsigned char* smem) {
  const int tid = TIDX, lane = tid & 63, wave = tid >> 6, q = lane >> 4, l15 = lane & 15;
  const int unit = unit_base + wave;
  const int c = unit % NC16, h = (unit / NC16) & 3, dir = (unit / (NC16 * 4)) & 1, b = unit / (NC16 * 8);
  bf16_t* big = (bf16_t*)(smem + wave * RW_WAVE_LDS);
  unsigned char* small = smem + wave * RW_WAVE_LDS + 8192;
  float* AbF = (float*)small;
  bf16_t* TN = (bf16_t*)(small + 1024);
  bf16_t* AK = TN + 256; bf16_t* RB = AK + 256; bf16_t* RK = RB + 256;
  const bf16_t* RRg = (const bf16_t*)(p.ws + Ws::RR); const bf16_t* VVg = (const bf16_t*)(p.ws + Ws::VV); const bf16_t* KKg = (const bf16_t*)(p.ws + Ws::KK);
  const bf16_t* KDg = (const bf16_t*)(p.ws + Ws::KD) + (size_t)dir * NT_ * 256; const bf16_t* BDg = (const bf16_t*)(p.ws + Ws::BD) + (size_t)dir * NT_ * 256;
  const float* LWg = (const float*)(p.ws + Ws::LW) + (size_t)dir * NT_ * 256;
  float kkm[16], vv[16], bneg[16], kneg[16];
  float run = 0.f;
  __syncthreads();
#pragma unroll
  for (int i = 0; i < 16; ++i) {
    const size_t o = (size_t)(b * T_ + tokmap(dir, c * 16 + i)) * 256 + h * 64 + lane;
    const float lw = gptr(LWg)[o], r = bf2f(gptr(RRg)[o]), k = bf2f(gptr(KDg)[o]), v = bf2f(gptr(VVg)[o]), kk = bf2f(gptr(KKg)[o]), bb = bf2f(gptr(BDg)[o]);
    const float e_ex = expf(run); run += lw; const float e_in = expf(run), e_neg = expf(-run);
    kkm[i] = kk * e_ex; vv[i] = v; bneg[i] = bb * e_neg; kneg[i] = k * e_neg;
    big[rm_off(i, lane)] = f2bf(kkm[i]); big[1024 + rm_off(i, lane)] = f2bf(r * e_in);
    big[2048 + rm_off(i, lane)] = f2bf(bneg[i]); big[3072 + rm_off(i, lane)] = f2bf(kneg[i]);
  }
  const float WC = expf(run);
  __syncthreads();
  f32x4 ab = f32x4{0.f, 0.f, 0.f, 0.f}, ak = ab, rb = ab, rk = ab;
#pragma unroll
  for (int s2 = 0; s2 < 2; ++s2) { const int ch = ((4 * s2 + q) ^ (l15 & 7)) << 3;
    const bf16x8 a_kk = ld8(big + l15 * 64 + ch), a_r = ld8(big + 1024 + l15 * 64 + ch), b_b = ld8(big + 2048 + l15 * 64 + ch), b_k = ld8(big + 3072 + l15 * 64 + ch);
    ab = MFMA16(a_kk, b_b, ab); ak = MFMA16(a_kk, b_k, ak); rb = MFMA16(a_r, b_b, rb); rk = MFMA16(a_r, b_k, rk); }
  f32x4 gacc[4];
#pragma unroll
  for (int nk = 0; nk < 4; ++nk)
#pragma unroll
    for (int r = 0; r < 4; ++r) gacc[nk][r] = bf2f(big[1024 + rm_off(4 * q + r, 16 * nk + l15)]);
  __syncthreads();
#pragma unroll
  for (int r = 0; r < 4; ++r) { const int i = 4 * q + r, j = l15;
    AbF[i * 16 + j] = j < i ? ab[r] : 0.f; AK[i * 16 + j] = f2bf(j < i ? ak[r] : 0.f);
    RB[i * 16 + j] = f2bf(j <= i ? rb[r] : 0.f); RK[i * 16 + j] = f2bf(j <= i ? rk[r] : 0.f); }
  { bf16_t* KKMT = big; bf16_t* VTT = big + 1024; bf16_t* BHT = big + 2048; bf16_t* KHT = big + 3072;
#pragma unroll
    for (int i = 0; i < 16; ++i) { KKMT[lane * 16 + i] = f2bf(kkm[i]); VTT[lane * 16 + i] = f2bf(vv[i]); BHT[lane * 16 + i] = f2bf(bneg[i] * WC); KHT[lane * 16 + i] = f2bf(kneg[i] * WC); } }
  __syncthreads();
  { float t[16];
#pragma unroll
    for (int i = 0; i < 16; ++i) { float acc = (i == l15) ? 1.f : 0.f;
#pragma unroll
      for (int j = 0; j < i; ++j) acc -= AbF[i * 16 + j] * t[j];
      t[i] = acc; }
    if (q == 0) {
#pragma unroll
      for (int i = 0; i < 16; ++i) TN[i * 16 + l15] = f2bf(-t[i]); } }
  __syncthreads();
  const size_t ci = (size_t)((b * 2 + dir) * 4 + h) * NC16 + c;
  bf16_t* MLg = (bf16_t*)(p.ws + Ws::RML) + ci * 4096; bf16_t* Ng = (bf16_t*)(p.ws + Ws::RNS) + ci * 4096;
  bf16_t* Gg = (bf16_t*)(p.ws + Ws::RG) + ci * 1024; float* Y0g = (float*)(p.ws + Ws::RY0) + ci * 1024;
  const bf16x4v a_T = ld4(TN + l15 * 16 + 4 * q), a_Ak = ld4(AK + l15 * 16 + 4 * q), a_Rb = ld4(RB + l15 * 16 + 4 * q), a_Rk = ld4(RK + l15 * 16 + 4 * q);
  const f32x4 z4 = f32x4{0.f, 0.f, 0.f, 0.f};
  bf16x4v vfr[4], qfr[4], pfr[4];
#pragma unroll
  for (int n = 0; n < 4; ++n) {
    vfr[n] = ld4(big + 1024 + (16 * n + l15) * 16 + 4 * q);
    const f32x4 akv = MFMA16K16(a_Ak, vfr[n], z4);
    qfr[n] = cvt4(MFMA16K16(a_T, cvt4(akv), z4));
    pfr[n] = cvt4(MFMA16K16(a_T, ld4(big + (16 * n + l15) * 16 + 4 * q), z4)); }
  const bf16x8 a_RbRk = cat44(a_Rb, a_Rk);
#pragma unroll
  for (int n = 0; n < 4; ++n) {
    const f32x4 g = MFMA16K16(a_Rb, pfr[n], gacc[n]);
    const f32x4 y0 = MFMA16(a_RbRk, cat44(qfr[n], vfr[n]), z4);
#pragma unroll
    for (int r = 0; r < 4; ++r) { Gg[(4 * q + r) * 64 + 16 * n + l15] = f2bf(g[r]); Y0g[(4 * q + r) * 64 + 16 * n + l15] = y0[r]; } }
#pragma unroll
  for (int mk = 0; mk < 4; ++mk) {
    const bf16x4v a_B = ld4(big + 2048 + (16 * mk + l15) * 16 + 4 * q), a_K = ld4(big + 3072 + (16 * mk + l15) * 16 + 4 * q);
    const bf16x8 a_BK = cat44(a_B, a_K);
#pragma unroll
    for (int n = 0; n < 4; ++n) {
      const f32x4 m = MFMA16K16(a_B, pfr[n], z4);
      const f32x4 nn = MFMA16(a_BK, cat44(qfr[n], vfr[n]), z4);
#pragma unroll
      for (int r = 0; r < 4; ++r) MLg[((mk * 2 + (n >> 1)) * 64 + (l15 >> 2) * 16 + 4 * q + r) * 8 + (n & 1) * 4 + (l15 & 3)] = f2bf(m[r]);
      *(bf16x4v*)(Ng + (n * 64 + lane) * 16 + mk * 4) = cvt4(nn); } }
  ((float*)(p.ws + Ws::RWC))[ci * 64 + ((lane >> 2) & 3) * 16 + (lane >> 4) * 4 + (lane & 3)] = WC;
}
struct RwStep { bf16x8 ml[4][2]; bf16x8 n[2]; f32x4 wc[4]; };
DEVFN void rw_load(RwStep& t, const bf16_t* MLg, const bf16_t* NSg, const float* WCg, int c, int lane, int q) {
#pragma unroll
  for (int mk = 0; mk < 4; ++mk) { t.ml[mk][0] = ld8g(MLg + (size_t)c * 4096 + ((mk * 2 + 0) * 64 + lane) * 8); t.ml[mk][1] = ld8g(MLg + (size_t)c * 4096 + ((mk * 2 + 1) * 64 + lane) * 8);
    t.wc[mk] = *(const AS1 f32x4*)gptr(WCg + (size_t)c * 64 + q * 16 + mk * 4); }
  t.n[0] = ld8g(NSg + (size_t)c * 4096 + lane * 16); t.n[1] = ld8g(NSg + (size_t)c * 4096 + lane * 16 + 8);
}
DEVFN void rw_step(const RwStep& t, f32x4 (&S)[4], bf16_t* NSg, int c, int q, int l15) {
  bf16x4v sb[4];
#pragma unroll
  for (int mk = 0; mk < 4; ++mk) sb[mk] = cvt4(S[mk]);
  const bf16x8 bf0 = cat44(sb[0], sb[1]), bf1 = cat44(sb[2], sb[3]);
#pragma unroll
  for (int mk = 0; mk < 4; ++mk) {
    f32x4 acc;
#pragma unroll
    for (int r = 0; r < 4; ++r) acc[r] = bf2f((bf16_t)t.n[mk >> 1][(mk & 1) * 4 + r]) + t.wc[mk][r] * S[mk][r];
    acc = MFMA16(t.ml[mk][0], bf0, acc);
    acc = MFMA16(t.ml[mk][1], bf1, acc);
    S[mk] = acc; }
#pragma unroll
  for (int mk = 0; mk < 4; ++mk) *(AS1 bf16x4v*)gptr(NSg + (size_t)c * 4096 + l15 * 64 + 16 * mk + 4 * q) = sb[mk];
}
DEVFN void rwkv_scan(const Params& p, int chain, int wave) {
  const int tid = TIDX, lane = tid & 63, q = lane >> 4, l15 = lane & 15;
  const bf16_t* MLg = (const bf16_t*)(p.ws + Ws::RML) + (size_t)chain * NC16 * 4096;
  bf16_t* NSg = (bf16_t*)(p.ws + Ws::RNS) + (size_t)chain * NC16 * 4096 + wave * 1024;
  const float* WCg = (const float*)(p.ws + Ws::RWC) + (size_t)chain * NC16 * 64;
  f32x4 S[4];
#pragma unroll
  for (int mk = 0; mk < 4; ++mk) S[mk] = f32x4{0.f, 0.f, 0.f, 0.f};
  RwStep t0, t1, t2;
#define RWC_(x) ((x) < NC16 ? (x) : NC16 - 1)
  rw_load(t0, MLg, NSg, WCg, 0, lane, q);
  rw_load(t1, MLg, NSg, WCg, RWC_(1), lane, q);
  int c = 0;
  for (; c + 2 < NC16; c += 3) {
    rw_load(t2, MLg, NSg, WCg, c + 2, lane, q);
    rw_step(t0, S, NSg, c, q, l15);
    rw_load(t0, MLg, NSg, WCg, RWC_(c + 3), lane, q);
    rw_step(t1, S, NSg, c + 1, q, l15);
    rw_load(t1, MLg, NSg, WCg, RWC_(c + 4), lane, q);
    rw_step(t2, S, NSg, c + 2, q, l15);
  }
  if (c < NC16) { rw_step(t0, S, NSg, c, q, l15); if (c + 1 < NC16) rw_step(t1, S, NSg, c + 1, q, l15); }
#undef RWC_
}
DEVFN void rwkv_out(const Params& p, int unit_base) {
  const int tid = TIDX, lane = tid & 63, wave = tid >> 6, q = lane >> 4, l15 = lane & 15;
  const int unit = unit_base + wave;
  const int c = unit % NC16, h = (unit / NC16) & 3, dir = (unit / (NC16 * 4)) & 1, b = unit / (NC16 * 8);
  const size_t ci = (size_t)((b * 2 + dir) * 4 + h) * NC16 + c;
  const bf16_t* Sg = (const bf16_t*)(p.ws + Ws::RNS) + ci * 4096; const bf16_t* Gg = (const bf16_t*)(p.ws + Ws::RG) + ci * 1024;
  const float* Y0g = (const float*)(p.ws + Ws::RY0) + ci * 1024;
  float* YR = (float*)(p.ws + Ws::YR) + (size_t)dir * NT_ * 256;
  const bf16x8 a0 = ld8g(Gg + l15 * 64 + 8 * q), a1 = ld8g(Gg + l15 * 64 + 32 + 8 * q);
#pragma unroll
  for (int n = 0; n < 4; ++n) {
    f32x4 acc;
#pragma unroll
    for (int r = 0; r < 4; ++r) acc[r] = gptr(Y0g)[(4 * q + r) * 64 + 16 * n + l15];
    acc = MFMA16(a0, ld8g(Sg + n * 1024 + l15 * 64 + 8 * q), acc);
    acc = MFMA16(a1, ld8g(Sg + n * 1024 + l15 * 64 + 32 + 8 * q), acc);
#pragma unroll
    for (int r = 0; r < 4; ++r) YR[(size_t)(b * T_ + tokmap(dir, c * 16 + 4 * q + r)) * 256 + h * 64 + 16 * n + l15] = acc[r]; }
}
DEVFN int cscan(int dir, int co, int nctx, int nc) { return dir == 0 ? co : (co < nctx ? nctx - 1 - co : 2 * nctx + nc - 1 - co); }
DEVFN bf16x8 ld4x2g(const bf16_t* p0, const bf16_t* p1) { bf16x4v a = *(const AS1 bf16x4v*)gptr(p0), b = *(const AS1 bf16x4v*)gptr(p1); return bf16x8{a[0], a[1], a[2], a[3], b[0], b[1], b[2], b[3]}; }
DEVFN bf16x8 ld4x2(const bf16_t* p0, const bf16_t* p1) { bf16x4v a = *(const bf16x4v*)p0, b = *(const bf16x4v*)p1; return bf16x8{a[0], a[1], a[2], a[3], b[0], b[1], b[2], b[3]}; }

DEVFN void ssd_chunk_scalars(const Params& p, int l, int b, int co, int h, float* f) {
  const int tid = TIDX, d = tid >> 7, j = tid & 127;
  const float* DTB = (const float*)(p.ws + Ws::DTB);
  const float nega = -expf(INP(I_ALOG)[(size_t)l * 16 + d * 8 + h]);
  const float dt = DTB[(size_t)(b * T_ + co * 128 + j) * 16 + d * 8 + h];
  __syncthreads();
  f[256 + d * 128 + j] = dt;
  float* cur = f + d * 128; float* tmp = f + 512 + d * 128;
  cur[j] = dt * nega;
  __syncthreads();
  for (int off = 1; off < 128; off <<= 1) {
    float v = cur[j] + (j >= off ? cur[j - off] : 0.f);
    tmp[j] = v;
    __syncthreads();
    cur[j] = tmp[j];
    __syncthreads();
  }
}
DEVFN void ssd_states(const Params& p, int l, int unit, unsigned char* smem) {
  const int tid = TIDX, lane = tid & 63, wave = tid >> 6, q = lane >> 4, l15 = lane & 15;
  const int h = unit & 7, co = (unit >> 3) % NC128, b = unit / (8 * NC128), grp = h >> 2;
  float* f = (float*)smem;
  ssd_chunk_scalars(p, l, b, co, h, f);
  { const int d = tid >> 7, j = tid & 127; const float* cum = f + d * 128; const float dt = f[256 + d * 128 + j];
    float w = d == 0 ? expf(cum[127] - cum[j]) * dt : expf(j > 0 ? cum[j - 1] : 0.f) * dt;
    f[512 + d * 128 + j] = w; }
  __syncthreads();
  const bf16_t* XT = (const bf16_t*)(p.ws + Ws::XBCT) + (size_t)(b * NC128 + co) * 768 * 128;
  f32x4 acc[2][8];
#pragma unroll
  for (int d = 0; d < 2; ++d)
#pragma unroll
    for (int n = 0; n < 8; ++n) acc[d][n] = f32x4{0.f, 0.f, 0.f, 0.f};
#pragma unroll 1
  for (int s4 = 0; s4 < 4; ++s4) {
    const int j0 = s4 * 32 + q * 8;
    bf16x8 xa = ld8g(XT + (size_t)(h * 64 + wave * 16 + l15) * 128 + j0), a0, a1;
#pragma unroll
    for (int jj = 0; jj < 8; ++jj) { float x = bf2f((bf16_t)xa[jj]); a0[jj] = (short)f2bf(x * f[512 + j0 + jj]); a1[jj] = (short)f2bf(x * f[640 + j0 + jj]); }
#pragma unroll
    for (int n = 0; n < 8; ++n) { bf16x8 bb = ld8g(XT + (size_t)(512 + grp * 128 + n * 16 + l15) * 128 + j0);
      acc[0][n] = MFMA16(a0, bb, acc[0][n]); acc[1][n] = MFMA16(a1, bb, acc[1][n]); }
  }
#pragma unroll
  for (int d = 0; d < 2; ++d) {
    const int cs = cscan(d, co, CTX_ / 128, SEQ_ / 128);
    float* ST = (float*)(p.ws + Ws::SST) + ((size_t)((d * B_ + b) * NC128 + cs) * 8 + h) * 8192;
#pragma unroll
    for (int n = 0; n < 8; ++n)
#pragma unroll
      for (int r = 0; r < 4; ++r) ST[(wave * 16 + q * 4 + r) * 128 + n * 16 + l15] = acc[d][n][r];
    if (tid == 0) ((float*)(p.ws + Ws::SCD))[((size_t)(d * B_ + b) * NC128 + cs) * 8 + h] = expf(f[d * 128 + 127]);
  }
}
#define SSD_SB ((NC128 % 17) == 0 ? 17 : NC128)
DEVFN void ssd_scan(const Params& p, int gtid, int gthreads) {
  const float* __restrict__ ST = (const float*)(p.ws + Ws::SST); const float* __restrict__ CD = (const float*)(p.ws + Ws::SCD); bf16_t* __restrict__ HIN = (bf16_t*)(p.ws + Ws::HIN);
  for (int e = gtid; e < 2 * B_ * 8 * 8192; e += gthreads) {
    const int pd = e & 8191, h = (e >> 13) & 7, db = e >> 16;
    float hv = 0.f;
#pragma unroll 1
    for (int c0 = 0; c0 < NC128; c0 += SSD_SB) {
      float st[SSD_SB], cd[SSD_SB];
#pragma unroll
      for (int i = 0; i < SSD_SB; ++i) { st[i] = ST[((size_t)(db * NC128 + c0 + i) * 8 + h) * 8192 + pd]; cd[i] = CD[(size_t)(db * NC128 + c0 + i) * 8 + h]; }
#pragma unroll
      for (int i = 0; i < SSD_SB; ++i) { HIN[((size_t)(db * NC128 + c0 + i) * 8 + h) * 8192 + pd] = f2bf(hv); hv = hv * cd[i] + st[i]; }
    }
  }
}
DEVFN void ssd_out(const Params& p, int l, int unit, unsigned char* smem) {
  const int tid = TIDX, lane = tid & 63, wave = tid >> 6, q = lane >> 4, l15 = lane & 15;
  const int h = unit & 7, co = (unit >> 3) % NC128, b = unit / (8 * NC128), grp = h >> 2;
  float* f = (float*)smem;
  ssd_chunk_scalars(p, l, b, co, h, f);
  if (tid < 128) f[640 + tid] = f[128 + 127] - (tid > 0 ? f[128 + tid - 1] : 0.f);
  __syncthreads();
  const float* cum0 = f; const float* suf1 = f + 640; const float* dt0 = f + 256; const float* dt1 = f + 384;
  const bf16_t* XBC = (const bf16_t*)(p.ws + Ws::XBC) + (size_t)(b * T_ + co * 128) * 1024;
  const bf16_t* XT = (const bf16_t*)(p.ws + Ws::XBCT) + (size_t)(b * NC128 + co) * 768 * 128;
  const bf16_t* Cb = XBC + (size_t)(wave * 32 + l15) * 1024 + 768 + grp * 128 + q * 8;
  f32x4 y[4][2];
  { f32x4 o0[4][2], o1[4][2];
#pragma unroll
    for (int mp = 0; mp < 4; ++mp)
#pragma unroll
      for (int ni = 0; ni < 2; ++ni) { o0[mp][ni] = f32x4{0.f, 0.f, 0.f, 0.f}; o1[mp][ni] = f32x4{0.f, 0.f, 0.f, 0.f}; }
    const int cs0 = cscan(0, co, CTX_ / 128, SEQ_ / 128), cs1 = cscan(1, co, CTX_ / 128, SEQ_ / 128);
    const bf16_t* H0 = (const bf16_t*)(p.ws + Ws::HIN) + ((size_t)((0 * B_ + b) * NC128 + cs0) * 8 + h) * 8192;
    const bf16_t* H1 = (const bf16_t*)(p.ws + Ws::HIN) + ((size_t)((1 * B_ + b) * NC128 + cs1) * 8 + h) * 8192;
#pragma unroll 1
    for (int s4 = 0; s4 < 4; ++s4) { const bf16x8 c0 = ld8g(Cb + s4 * 32), c1 = ld8g(Cb + 16 * 1024 + s4 * 32);
#pragma unroll
      for (int mp = 0; mp < 4; ++mp) { bf16x8 h0 = ld8g(H0 + (size_t)(mp * 16 + l15) * 128 + s4 * 32 + q * 8), h1 = ld8g(H1 + (size_t)(mp * 16 + l15) * 128 + s4 * 32 + q * 8);
        o0[mp][0] = MFMA16(h0, c0, o0[mp][0]); o0[mp][1] = MFMA16(h0, c1, o0[mp][1]);
        o1[mp][0] = MFMA16(h1, c0, o1[mp][0]); o1[mp][1] = MFMA16(h1, c1, o1[mp][1]); } }
#pragma unroll
    for (int ni = 0; ni < 2; ++ni) { const int i = wave * 32 + ni * 16 + l15; const float e0 = expf(cum0[i]), e1 = expf(suf1[i]);
#pragma unroll
      for (int mp = 0; mp < 4; ++mp)
#pragma unroll
        for (int r = 0; r < 4; ++r) y[mp][ni][r] = e0 * o0[mp][ni][r] + e1 * o1[mp][ni][r]; } }
  bf16x8 mfr[4][2];
  { f32x4 g[8][2];
#pragma unroll
    for (int mj = 0; mj < 8; ++mj) { g[mj][0] = f32x4{0.f, 0.f, 0.f, 0.f}; g[mj][1] = f32x4{0.f, 0.f, 0.f, 0.f}; }
#pragma unroll 1
    for (int s4 = 0; s4 < 4; ++s4) { const bf16x8 c0 = ld8g(Cb + s4 * 32), c1 = ld8g(Cb + 16 * 1024 + s4 * 32);
#pragma unroll
      for (int mj = 0; mj < 8; ++mj) { bf16x8 bb = ld8g(XBC + (size_t)(mj * 16 + l15) * 1024 + 512 + grp * 128 + s4 * 32 + q * 8);
        g[mj][0] = MFMA16(bb, c0, g[mj][0]); g[mj][1] = MFMA16(bb, c1, g[mj][1]); } }
    const int i0 = wave * 32 + l15, i1 = i0 + 16;
    const float c0i0 = cum0[i0], s1i0 = suf1[i0], c0i1 = cum0[i1], s1i1 = suf1[i1];
#pragma unroll
    for (int mj = 0; mj < 8; ++mj)
#pragma unroll
      for (int r = 0; r < 4; ++r) { const int j = mj * 16 + q * 4 + r;
        const float cj = cum0[j], sj = suf1[j], d0 = dt0[j], d1 = dt1[j];
        const float lw0 = (j <= i0 ? expf(c0i0 - cj) * d0 : 0.f) + (j >= i0 ? expf(s1i0 - sj) * d1 : 0.f);
        const float lw1 = (j <= i1 ? expf(c0i1 - cj) * d0 : 0.f) + (j >= i1 ? expf(s1i1 - sj) * d1 : 0.f);
        mfr[mj >> 1][0][(mj & 1) * 4 + r] = (short)f2bf(g[mj][0][r] * lw0);
        mfr[mj >> 1][1][(mj & 1) * 4 + r] = (short)f2bf(g[mj][1][r] * lw1); } }
#pragma unroll
  for (int s4 = 0; s4 < 4; ++s4)
#pragma unroll
    for (int mp = 0; mp < 4; ++mp) { const bf16_t* xr = XT + (size_t)(h * 64 + mp * 16 + l15) * 128 + s4 * 32 + q * 4;
      bf16x8 xa = ld4x2g(xr, xr + 16);
      y[mp][0] = MFMA16(xa, mfr[s4][0], y[mp][0]); y[mp][1] = MFMA16(xa, mfr[s4][1], y[mp][1]); }
  __syncthreads();
  float* yl = f + 1024;
#pragma unroll
  for (int mp = 0; mp < 4; ++mp)
#pragma unroll
    for (int ni = 0; ni < 2; ++ni)
#pragma unroll
      for (int r = 0; r < 4; ++r) yl[(wave * 32 + ni * 16 + l15) * 65 + mp * 16 + q * 4 + r] = y[mp][ni][r];
  __syncthreads();
  float* YS = (float*)(p.ws + Ws::YS) + (size_t)(b * T_ + co * 128) * 512 + h * 64;
  for (int e = tid; e < 128 * 64; e += 256) YS[(size_t)(e >> 6) * 512 + (e & 63)] = yl[(e >> 6) * 65 + (e & 63)];
}

#define GQ_LD 40
#define GK_LD 72
DEVFN void gla_chunk(const Params& p, int unit, unsigned char* smem) {
  const int tid = TIDX, lane = tid & 63, wave = tid >> 6, q = lane >> 4, l15 = lane & 15;
  const int h = unit & 3, co = (unit >> 2) % NC64, b = unit / (4 * NC64);
  const bf16_t* ZX = (const bf16_t*)(p.ws + Ws::ZX) + (size_t)(b * T_ + co * 64) * NIN_;
  const float* LA = (const float*)(p.ws + Ws::LA);
  float* cum = (float*)smem;
  bf16_t* qs = (bf16_t*)(smem + 16384);
  bf16_t* ks = qs + 2 * 64 * GQ_LD;
  bf16_t* kt = ks + 2 * 64 * GQ_LD;
  __syncthreads();
  for (int e = tid; e < 2 * 64 * 32; e += 256) { const int d = e >> 11, i = (e >> 5) & 63, dd = e & 31;
    cum[e] = LA[((size_t)d * NT_ + b * T_ + co * 64 + i) * 128 + h * 32 + dd]; }
  __syncthreads();
  if (tid < 64) { const int d = tid >> 5, dd = tid & 31; float* c = cum + d * 2048 + dd; float sacc = 0.f;
    if (d == 0) for (int i = 0; i < 64; ++i) { sacc += c[i * 32]; c[i * 32] = sacc; }
    else for (int i = 63; i >= 0; --i) { sacc += c[i * 32]; c[i * 32] = sacc; } }
  __syncthreads();
  bf16_t* QT = (bf16_t*)(p.ws + Ws::QT);
  for (int e = tid; e < 64 * 32; e += 256) { const int i = e >> 5, dd = e & 31;
    const float qv = bf2f(ZX[(size_t)i * NIN_ + OGQ + h * 32 + dd]) * 0.17677669529663687f, kv = bf2f(ZX[(size_t)i * NIN_ + OGK + h * 32 + dd]);
    const float c0 = cum[i * 32 + dd], c1 = cum[2048 + i * 32 + dd], t0 = cum[63 * 32 + dd], t1 = cum[2048 + dd];
    const bf16_t q0 = f2bf(qv * expf(c0)), q1 = f2bf(qv * expf(c1));
    qs[i * GQ_LD + dd] = q0; qs[64 * GQ_LD + i * GQ_LD + dd] = q1;
    ks[i * GQ_LD + dd] = f2bf(kv * expf(-c0)); ks[64 * GQ_LD + i * GQ_LD + dd] = f2bf(kv * expf(-c1));
    kt[dd * GK_LD + i] = f2bf(kv * expf(t0 - c0)); kt[32 * GK_LD + dd * GK_LD + i] = f2bf(kv * expf(t1 - c1));
    const size_t tok = (size_t)b * T_ + co * 64 + i;
    QT[tok * 128 + h * 32 + dd] = q0; QT[((size_t)NT_ + tok) * 128 + h * 32 + dd] = q1; }
  if (tid < 64) { const int d = tid >> 5, dd = tid & 31; const int cs = cscan(d, co, CTX_ / 64, SEQ_ / 64);
    ((float*)(p.ws + Ws::GCD))[(((size_t)(d * B_ + b) * NC64 + cs) * 4 + h) * 32 + dd] = expf(d == 0 ? cum[63 * 32 + dd] : cum[2048 + dd]); }
  __syncthreads();
  bf16x8 pfr[2];
  { f32x4 p0[4], p1[4];
    const bf16x8 qb0 = ld8(qs + (wave * 16 + l15) * GQ_LD + q * 8), qb1 = ld8(qs + 64 * GQ_LD + (wave * 16 + l15) * GQ_LD + q * 8);
#pragma unroll
    for (int mj = 0; mj < 4; ++mj) { p0[mj] = MFMA16(ld8(ks + (mj * 16 + l15) * GQ_LD + q * 8), qb0, (f32x4{0.f, 0.f, 0.f, 0.f}));
      p1[mj] = MFMA16(ld8(ks + 64 * GQ_LD + (mj * 16 + l15) * GQ_LD + q * 8), qb1, (f32x4{0.f, 0.f, 0.f, 0.f})); }
    const int i = wave * 16 + l15;
#pragma unroll
    for (int mj = 0; mj < 4; ++mj)
#pragma unroll
      for (int r = 0; r < 4; ++r) { const int j = mj * 16 + q * 4 + r; pfr[mj >> 1][(mj & 1) * 4 + r] = (short)f2bf((j <= i ? p0[mj][r] : 0.f) + (j >= i ? p1[mj][r] : 0.f)); } }
  const bf16_t* VT = (const bf16_t*)(p.ws + Ws::VT) + ((size_t)(b * NC64 + co) * 256 + h * 64) * 64;
  f32x4 o[4];
#pragma unroll
  for (int md = 0; md < 4; ++md) { o[md] = f32x4{0.f, 0.f, 0.f, 0.f};
#pragma unroll
    for (int s2 = 0; s2 < 2; ++s2) { const bf16_t* vr = VT + (size_t)(md * 16 + l15) * 64 + s2 * 32 + q * 4; o[md] = MFMA16(ld4x2g(vr, vr + 16), pfr[s2], o[md]); } }
#pragma unroll
  for (int d = 0; d < 2; ++d) { const int cs = cscan(d, co, CTX_ / 64, SEQ_ / 64);
    float* GST = (float*)(p.ws + Ws::GST) + (((size_t)(d * B_ + b) * NC64 + cs) * 4 + h) * 2048;
#pragma unroll
    for (int nd = 0; nd < 2; ++nd) { f32x4 st = f32x4{0.f, 0.f, 0.f, 0.f};
#pragma unroll
      for (int s2 = 0; s2 < 2; ++s2) st = MFMA16(ld8g(VT + (size_t)(wave * 16 + l15) * 64 + s2 * 32 + q * 8), ld8(kt + d * 32 * GK_LD + (nd * 16 + l15) * GK_LD + s2 * 32 + q * 8), st);
#pragma unroll
      for (int r = 0; r < 4; ++r) GST[(wave * 16 + q * 4 + r) * 32 + nd * 16 + l15] = st[r]; } }
  __syncthreads();
  float* ol = (float*)smem;
#pragma unroll
  for (int md = 0; md < 4; ++md)
#pragma unroll
    for (int r = 0; r < 4; ++r) ol[(wave * 16 + l15) * 65 + md * 16 + q * 4 + r] = o[md][r];
  __syncthreads();
  float* OI = (float*)(p.ws + Ws::OI) + (size_t)(b * T_ + co * 64) * 256 + h * 64;
  for (int e = tid; e < 64 * 64; e += 256) OI[(size_t)(e >> 6) * 256 + (e & 63)] = ol[(e >> 6) * 65 + (e & 63)];
}
#define GLA_SB ((NC64 % 17) == 0 ? 17 : NC64)
DEVFN void gla_scan(const Params& p, int gtid, int gthreads) {
  const float* __restrict__ ST = (const float*)(p.ws + Ws::GST); const float* __restrict__ CD = (const float*)(p.ws + Ws::GCD); bf16_t* __restrict__ SIN = (bf16_t*)(p.ws + Ws::GSIN);
  for (int e = gtid; e < 2 * B_ * 4 * 2048; e += gthreads) {
    const int vd = e & 2047, h = (e >> 11) & 3, db = e >> 13;
    float sv = 0.f;
#pragma unroll 1
    for (int c0 = 0; c0 < NC64; c0 += GLA_SB) {
      float st[GLA_SB], cd[GLA_SB];
#pragma unroll
      for (int i = 0; i < GLA_SB; ++i) { st[i] = ST[(((size_t)db * NC64 + c0 + i) * 4 + h) * 2048 + vd]; cd[i] = CD[(((size_t)db * NC64 + c0 + i) * 4 + h) * 32 + (vd & 31)]; }
#pragma unroll
      for (int i = 0; i < GLA_SB; ++i) { SIN[(((size_t)db * NC64 + c0 + i) * 4 + h) * 2048 + vd] = f2bf(sv); sv = sv * cd[i] + st[i]; }
    }
  }
}
DEVFN void convert_moe_weights(const Params& p, int l, unsigned char* smem, int bid, int nb);
DEVFN void phase4a(const Params& p, int l, unsigned char* smem) {
  const int n_r = B_ * 8 * NC16 / 4;
  for (int u = BIDX; u < n_r; u += gridDim.x) rwkv_chunk(p, (u) * 4, smem);
  (void)l;
}
DEVFN void phase4b(const Params& p, int l, unsigned char* smem) {
  const int bid = BIDX, nrw = B_ * 8, G = (int)gridDim.x;
  const int n_s = B_ * NC128 * 8, n_g = B_ * NC64 * 4;
  int ob = bid, on = G;
  if (G >= 8 * nrw) {
    if (bid < 4 * nrw) { if ((TIDX >> 6) == 0) rwkv_scan(p, bid >> 2, bid & 3); return; }
    ob = bid - 4 * nrw; on = G - 4 * nrw; }
  else { for (int u = bid; u < nrw; u += G) rwkv_scan(p, u, TIDX >> 6); }
  for (int u = ob; u < n_s + n_g; u += on) { if (u < n_s) ssd_states(p, l, u, smem); else gla_chunk(p, u - n_s, smem); }
  convert_moe_weights(p, l, smem, ob, on);
}
DEVFN void phase4b2(const Params& p) {
  const int bid = BIDX, G = (int)gridDim.x;
  ssd_scan(p, bid * 256 + TIDX, G * 256); gla_scan(p, bid * 256 + TIDX, G * 256);
}
DEVFN void phase4c(const Params& p, int l, unsigned char* smem) {
  const int n_s = B_ * NC128 * 8, n_r = B_ * 8 * NC16 / 4;
  for (int u = BIDX; u < n_s + n_r; u += gridDim.x) { if (u < n_s) ssd_out(p, l, u, smem); else rwkv_out(p, (u - n_s) * 4); }
}

DEVFN void phase5(const Params& p, int l, unsigned char* smem) {
  const int tid = TIDX, lane = tid & 63, wave = tid >> 6;
  const bf16_t* ZX = (const bf16_t*)(p.ws + Ws::ZX);
  const bf16_t* XBC = (const bf16_t*)(p.ws + Ws::XBC);
  const float* YS = (const float*)(p.ws + Ws::YS); const float* YR = (const float*)(p.ws + Ws::YR); const float* OI = (const float*)(p.ws + Ws::OI);
  const bf16_t* QT = (const bf16_t*)(p.ws + Ws::QT); const bf16_t* GSIN = (const bf16_t*)(p.ws + Ws::GSIN);
  const bf16_t* RR = (const bf16_t*)(p.ws + Ws::RR); const bf16_t* VV = (const bf16_t*)(p.ws + Ws::VV); const bf16_t* KD = (const bf16_t*)(p.ws + Ws::KD);
  const float* GATE = (const float*)(p.ws + Ws::GATE);
  bf16_t* YM = (bf16_t*)(p.ws + Ws::YMIX);
  float* red = (float*)smem;
  float* qt = red + 16;
  const float dA = INP(I_SSDD)[(size_t)l * 8 + (tid >> 6)], dB = INP(I_SSDD)[(size_t)l * 8 + 4 + (tid >> 6)];
  const float nwA = INP(I_SSDNW)[(size_t)l * 512 + tid], nwB = INP(I_SSDNW)[(size_t)l * 512 + 256 + tid];
  const float lnw = INP(I_LNXW)[(size_t)l * 256 + tid], lnb = INP(I_LNXB)[(size_t)l * 256 + tid], rk = INP(I_RK)[(size_t)l * 256 + tid];
  const float gnw = INP(I_GNW)[(size_t)l * 256 + tid];
  const int per_ = (NT_ / 2 + (int)gridDim.x - 1) / (int)gridDim.x, tp_lo = BIDX * per_, tp_hi = (tp_lo + per_ < NT_ / 2) ? tp_lo + per_ : NT_ / 2;
  for (int tp = tp_lo; tp < tp_hi; ++tp) {
    float ys0[2], ys1[2], x0[2], x1[2], z0[2], z1[2], og[2], yr[2], rr[2], kf[2], kb[2], vv[2], gt[2], oi[2], qv[2];
    bf16x8 gs[2][2][4];
#pragma unroll
    for (int t = 0; t < 2; ++t) { const int tok = tp * 2 + t; const int b = tok / T_, co = (tok % T_) / 64;
      ys0[t] = gptr(YS)[(size_t)tok * 512 + tid]; ys1[t] = gptr(YS)[(size_t)tok * 512 + 256 + tid];
      x0[t] = bf2f(gptr(XBC)[(size_t)tok * 1024 + tid]); x1[t] = bf2f(gptr(XBC)[(size_t)tok * 1024 + 256 + tid]);
      z0[t] = zxv(ZX, tok, OZ + tid); z1[t] = zxv(ZX, tok, OZ + 256 + tid); og[t] = zxv(ZX, tok, OOG + tid);
      yr[t] = gptr(YR)[(size_t)tok * 256 + tid] + gptr(YR)[((size_t)NT_ + tok) * 256 + tid];
      rr[t] = bf2f(gptr(RR)[(size_t)tok * 256 + tid]); kf[t] = bf2f(gptr(KD)[(size_t)tok * 256 + tid]); kb[t] = bf2f(gptr(KD)[((size_t)NT_ + tok) * 256 + tid]);
      vv[t] = bf2f(gptr(VV)[(size_t)tok * 256 + tid]); gt[t] = gptr(GATE)[(size_t)tok * 256 + tid]; oi[t] = gptr(OI)[(size_t)tok * 256 + tid];
      qv[t] = bf2f(gptr(QT)[((size_t)(tid >> 7) * NT_ + tok) * 128 + (tid & 127)]);
#pragma unroll
      for (int d = 0; d < 2; ++d) { const int cs = cscan(d, co, CTX_ / 64, SEQ_ / 64);
        const bf16_t* sr = GSIN + ((((size_t)(d * B_ + b) * NC64 + cs) * 4 + wave) * 64 + lane) * 32;
#pragma unroll
        for (int c8 = 0; c8 < 4; ++c8) gs[t][d][c8] = ld8g(sr + c8 * 8); } }
    float ya[2], yb[2], qa[2], qb[2];
#pragma unroll
    for (int t = 0; t < 2; ++t) {
      ya[t] = (ys0[t] + dA * x0[t]) * siluf_(z0[t]); yb[t] = (ys1[t] + dB * x1[t]) * siluf_(z1[t]);
      qa[t] = wave_sum(ya[t] * ya[t]); qb[t] = wave_sum(yb[t] * yb[t]); }
    __syncthreads();
#pragma unroll
    for (int t = 0; t < 2; ++t) {
      if (lane == 0) { red[t * 8 + wave] = qa[t]; red[t * 8 + 4 + wave] = qb[t]; }
      qt[t * 256 + tid] = qv[t]; }
    __syncthreads();
#pragma unroll
    for (int t = 0; t < 2; ++t) { const int tok = tp * 2 + t;
      const float* rd = red + t * 8; const float* qtt = qt + t * 256;
      float ma = (rd[0] + rd[1] + rd[2] + rd[3]) * (1.f / 256.f), mb = (rd[4] + rd[5] + rd[6] + rd[7]) * (1.f / 256.f);
      YM[(size_t)tok * 1024 + tid] = f2bf(ya[t] * rsqrtf(ma + 1e-5f) * nwA);
      YM[(size_t)tok * 1024 + 256 + tid] = f2bf(yb[t] * rsqrtf(mb + 1e-5f) * nwB);
      { const float y = yr[t];
        float mu = wave_sum(y) * (1.f / 64.f), d = y - mu, var = wave_sum(d * d) * (1.f / 64.f);
        float yn = d * rsqrtf(var + 64e-5f) * lnw + lnb;
        float bonus = wave_sum(rr[t] * (kf[t] + kb[t]) * rk) * vv[t];
        YM[(size_t)tok * 1024 + 512 + tid] = f2bf((yn + bonus) * gt[t]); }
      { float o = oi[t];
#pragma unroll
        for (int d = 0; d < 2; ++d)
#pragma unroll
          for (int c8 = 0; c8 < 4; ++c8)
#pragma unroll
            for (int jj = 0; jj < 8; ++jj) o += qtt[d * 128 + wave * 32 + c8 * 8 + jj] * bf2f((bf16_t)gs[t][d][c8][jj]);
        float ms = wave_sum(o * o) * (1.f / 64.f);
        YM[(size_t)tok * 1024 + 768 + tid] = f2bf(o * rsqrtf(ms + 1e-5f) * gnw * siluf_(og[t])); } }
  }
}

DEVFN void phase6(const Params& p, int l, unsigned char* smem) {
  const bf16_t* A = (const bf16_t*)(p.ws + Ws::YMIX);
  const bf16_t* W = (const bf16_t*)(p.ws + Ws::WOUT) + (size_t)l * 1024 * 1024;
  float* MIX = (float*)(p.ws + Ws::MIX);
  for (int u = BIDX; u < (NT_ / 128) * 8; u += gridDim.x) {
    int rt = u / 8, ct = u % 8;
    gemm_tile(smem, 1024,
      [&](int r) { return A + (size_t)(rt * 128 + r) * 1024; },
      [&](int r) { return W + (size_t)(ct * 128 + r) * 1024; },
      [&](f32x4 (&acc)[4][4], int wr, int wc, int g, int l15) {
#pragma unroll
        for (int mi = 0; mi < 4; ++mi)
#pragma unroll
          for (int ni = 0; ni < 4; ++ni)
#pragma unroll
            for (int i = 0; i < 4; ++i) MIX[(size_t)(rt * 128 + wr * 64 + mi * 16 + 4 * g + i) * 1024 + ct * 128 + wc * 64 + ni * 16 + l15] = acc[mi][ni][i];
      });
  }
}

DEVFN void phase7(const Params& p, int l, unsigned char* smem) {
  const int lane = TIDX & 63, wave = TIDX >> 6;
  float* X = (float*)(p.ws + Ws::X);
  const float* MIX = (const float*)(p.ws + Ws::MIX);
  bf16_t* H = (bf16_t*)(p.ws + Ws::U);
  const float* rwt = (const float*)(p.ws + Ws::RWT) + (size_t)l * 64 * 1024;
  int* cnt = (int*)(p.ws + Ws::CNT) + l * 64 * 64;
  int* ltok = (int*)(p.ws + Ws::LTOK); float* lwt = (float*)(p.ws + Ws::LWT);
  const float rbias = INP(I_RB)[(size_t)l * 64 + lane];
  float* hs = (float*)smem;
  float* lg = hs + 4096;
  for (int tok0 = BIDX * 4; tok0 < NT_; tok0 += gridDim.x * 4) {
    const int tok = tok0 + wave;
    const float* mod = (const float*)(p.ws + Ws::MOD) + ((size_t)l * NR_ + tok_modrow(tok)) * NMOD_;
    float xv[16], mx[16], g1[16], lw[16], lb[16], sh2[16], sc2[16], mean, rstd;
    load_row16(X + (size_t)tok * 1024, lane, xv);
    load_row16(MIX + (size_t)tok * 1024, lane, mx);
    load_row16(mod + 2 * 1024, lane, g1);
    load_row16(INP(I_LN1W) + (size_t)l * 1024, lane, lw);
    load_row16(INP(I_LN1B) + (size_t)l * 1024, lane, lb);
    load_row16(mod + 3 * 1024, lane, sh2);
    load_row16(mod + 4 * 1024, lane, sc2);
#pragma unroll
    for (int i = 0; i < 16; ++i) xv[i] = ALPHA_ * xv[i] + g1[i] * mx[i];
    row_stats(xv, mean, rstd);
#pragma unroll
    for (int i = 0; i < 16; ++i) xv[i] = (xv[i] - mean) * rstd * lw[i] + lb[i];
#pragma unroll
    for (int j = 0; j < 4; ++j) *(float4*)(X + (size_t)tok * 1024 + lane * 4 + 256 * j) = make_float4(xv[4 * j], xv[4 * j + 1], xv[4 * j + 2], xv[4 * j + 3]);
    const bool routed = !(l == DEPTH_ - 1 && (tok % T_) < CTX_);
    row_stats(xv, mean, rstd);
#pragma unroll
    for (int i = 0; i < 16; ++i) xv[i] = (xv[i] - mean) * rstd * (1.f + sc2[i]) + sh2[i];
    __syncthreads();
#pragma unroll
    for (int j = 0; j < 4; ++j) {
      if (routed) *(uint2*)(H + (size_t)tok * 1024 + lane * 4 + 256 * j) = make_uint2((unsigned)f2bf(xv[4 * j]) | ((unsigned)f2bf(xv[4 * j + 1]) << 16), (unsigned)f2bf(xv[4 * j + 2]) | ((unsigned)f2bf(xv[4 * j + 3]) << 16));
      *(float4*)(hs + wave * 1024 + lane * 4 + 256 * j) = make_float4(xv[4 * j], xv[4 * j + 1], xv[4 * j + 2], xv[4 * j + 3]); }
    __syncthreads();
    { float hv[4][16];
      const int rot = BIDX & 15;
#pragma unroll
      for (int t = 0; t < 4; ++t)
#pragma unroll
        for (int j = 0; j < 4; ++j) { const float4 v = *(const float4*)(hs + t * 1024 + lane * 4 + 256 * j); hv[t][4 * j] = v.x; hv[t][4 * j + 1] = v.y; hv[t][4 * j + 2] = v.z; hv[t][4 * j + 3] = v.w; }
      float pe[64];
      const AS1 float* rw = gptr(rwt) + lane * 4;
      f32x4 w[4], wn[4];
#pragma unroll
      for (int j = 0; j < 4; ++j) w[j] = *(const AS1 f32x4*)(rw + (size_t)(16 * wave + (rot & 15)) * 1024 + 256 * j);
#pragma unroll
      for (int e = 0; e < 16; ++e) {
        if (e + 1 < 16) {
#pragma unroll
          for (int j = 0; j < 4; ++j) wn[j] = *(const AS1 f32x4*)(rw + (size_t)(16 * wave + ((e + 1 + rot) & 15)) * 1024 + 256 * j); }
#pragma unroll
        for (int t = 0; t < 4; ++t) { float s0 = 0.f, s1 = 0.f;
#pragma unroll
          for (int j = 0; j < 4; ++j) { s0 += hv[t][4 * j] * w[j][0] + hv[t][4 * j + 2] * w[j][2]; s1 += hv[t][4 * j + 1] * w[j][1] + hv[t][4 * j + 3] * w[j][3]; }
          pe[e * 4 + t] = s0 + s1; }
#pragma unroll
        for (int j = 0; j < 4; ++j) w[j] = wn[j]; }
#pragma unroll
      for (int half = 32; half >= 1; half >>= 1) { const bool up = (lane & half) != 0;
#pragma unroll
        for (int e = 0; e < half; ++e) { const float send = up ? pe[e] : pe[e + half]; const float recv = __shfl_xor(send, half); pe[e] = (up ? pe[e + half] : pe[e]) + recv; } }
      lg[(lane & 3) * 64 + 16 * wave + (((lane >> 2) + rot) & 15)] = pe[0]; }
    __syncthreads();
    if (!routed) continue;
    const float logit = lg[wave * 64 + lane];
    const float score = sigmoidf_(logit), sel = score + rbias;
    float m1 = sel; int a1 = lane;
#pragma unroll
    for (int m = 1; m <= 4; m <<= 1) { float ov = XOR8(m1, m); int oa = XOR8(a1, m); if (ov > m1 || (ov == m1 && oa < a1)) { m1 = ov; a1 = oa; } }
    float m2 = (lane == a1) ? -3.0e38f : sel;
#pragma unroll
    for (int m = 1; m <= 4; m <<= 1) m2 = fmaxf(m2, XOR8(m2, m));
    const float gs = m1 + m2; const int grp = lane >> 3;
    int grank = 0;
#pragma unroll
    for (int g2 = 0; g2 < 8; ++g2) { float og = SHFL_CONST(gs, g2 * 8); grank += (og > gs || (og == gs && g2 < grp)) ? 1 : 0; }
    const bool gsel = grank < 4;
    const float msel = gsel ? sel : -3.0e38f;
    int rank = 0;
#pragma unroll
    for (int e = 0; e < 64; ++e) { float ov = SHFL_CONST(msel, e); rank += (ov > msel || (ov == msel && e < lane)) ? 1 : 0; }
    const bool chosen = gsel && rank < 8;
    const float wsum = wave_sum(chosen ? score : 0.f);
    if (chosen) { int pos = atomicAdd(&cnt[lane * 64], 1); ltok[(size_t)lane * NT_ + pos] = tok * 8 + rank; lwt[(size_t)lane * NT_ + pos] = score / wsum * 2.5f; }
  }
}

struct MoeMap { int nblk_total; int e; int rb; int cnt; int hoff; };
DEVFN int moe_ntok(int l) { return l == DEPTH_ - 1 ? B_ * SEQ_ : NT_; }
DEVFN int moe_shared_tok(int l, int i) { return l == DEPTH_ - 1 ? (i / SEQ_) * T_ + CTX_ + (i % SEQ_) : i; }
DEVFN void moe_prefix(const Params& p, int l, int* pre) {
  const int* cnt = (const int*)(p.ws + Ws::CNT) + l * 64 * 64;
  __syncthreads();
  if (TIDX < 64) pre[66 + TIDX] = gptr(cnt)[TIDX * 64];
  if (TIDX == 64) pre[66 + 64] = moe_ntok(l);
  __syncthreads();
  if (TIDX == 0) { int s = 0; for (int e = 0; e < 65; ++e) { pre[e] = s; s += (pre[66 + e] + 127) / 128; } pre[65] = s; }
  __syncthreads();
}
DEVFN void phase8(const Params& p, int l, unsigned char* smem) {
  int* pre = (int*)(smem + SM_PRE);
  moe_prefix(p, l, pre);
  const bf16_t* H = (const bf16_t*)(p.ws + Ws::U);
  const bf16_t* W13 = (const bf16_t*)(p.ws + Ws::W13);
  bf16_t* HID = (bf16_t*)(p.ws + Ws::HID);
  const int* ltok = (const int*)(p.ws + Ws::LTOK); const float* lwt = (const float*)(p.ws + Ws::LWT);
  const int total = pre[65];
  for (int u = BIDX; u < total * 4; u += gridDim.x) {
    const int gb = u >> 2, nt = u & 3;
    int e = 0; while (pre[e + 1] <= gb) ++e;
    const int rb = gb - pre[e], cnt = pre[66 + e];
    gemm_tile(smem, 1024,
      [&](int r) { int pos = rb * 128 + r; if (pos >= cnt) return (const bf16_t*)(p.ws + Ws::ZROW); int tok = e < 64 ? (ltok[(size_t)e * NT_ + pos] >> 3) : moe_shared_tok(l, pos); return H + (size_t)tok * 1024; },
      [&](int r) { return W13 + ((size_t)e * 512 + nt * 128 + r) * 1024; },
      [&](f32x4 (&acc)[4][4], int wr, int wc, int g, int l15) {
        tile_store_bf16<8>(smem, wr, g, l15,
          [&](bf16_t* T, int ldc) {
#pragma unroll
            for (int mi = 0; mi < 4; ++mi)
#pragma unroll
              for (int i = 0; i < 4; ++i) { const int r = wr * 64 + mi * 16 + 4 * g + i, pos = rb * 128 + r;
                const float gw = pos < cnt ? (e < 64 ? lwt[(size_t)e * NT_ + pos] : 1.f) : 0.f;
#pragma unroll
                for (int j = 0; j < 2; ++j) T[r * ldc + wc * 32 + j * 16 + l15] = f2bf(siluf_(acc[mi][2 * j][i]) * acc[mi][2 * j + 1][i] * gw); } },
          [&](int row, int c0) { const int pos = rb * 128 + row; return pos < cnt ? HID + ((size_t)gb * 128 + row) * 256 + nt * 64 + c0 : (bf16_t*)nullptr; });
      });
  }
}
DEVFN void phase9(const Params& p, int l, unsigned char* smem) {
  int* pre = (int*)(smem + SM_PRE);
  moe_prefix(p, l, pre);
  const bf16_t* HID = (const bf16_t*)(p.ws + Ws::HID);
  const bf16_t* W2T = (const bf16_t*)(p.ws + Ws::W2T);
  bf16_t* YB = (bf16_t*)(p.ws + Ws::YBUF);
  const int* ltok = (const int*)(p.ws + Ws::LTOK);
  const int total = pre[65];
  for (int u = BIDX; u < total * 8; u += gridDim.x) {
    const int gb = u >> 3, nt = u & 7;
    int e = 0; while (pre[e + 1] <= gb) ++e;
    const int rb = gb - pre[e], cnt = pre[66 + e];
    gemm_tile(smem, 256,
      [&](int r) { int pos = rb * 128 + r; return pos < cnt ? HID + ((size_t)gb * 128 + r) * 256 : (const bf16_t*)(p.ws + Ws::ZROW); },
      [&](int r) { return W2T + ((size_t)e * 1024 + nt * 128 + r) * 256; },
      [&](f32x4 (&acc)[4][4], int wr, int wc, int g, int l15) {
        tile_store_bf16<16>(smem, wr, g, l15,
          [&](bf16_t* T, int ldc) {
#pragma unroll
            for (int mi = 0; mi < 4; ++mi)
#pragma unroll
              for (int ni = 0; ni < 4; ++ni)
#pragma unroll
                for (int i = 0; i < 4; ++i) T[(wr * 64 + mi * 16 + 4 * g + i) * ldc + wc * 64 + ni * 16 + l15] = f2bf(acc[mi][ni][i]); },
          [&](int row, int c0) { const int pos = rb * 128 + row; if (pos >= cnt) return (bf16_t*)nullptr;
            const int ts = e < 64 ? ltok[(size_t)e * NT_ + pos] : moe_shared_tok(l, pos) * 8; const int tok = ts >> 3, slot = e < 64 ? (ts & 7) : 8;
            return YB + ((size_t)tok * NSLOT + slot) * 1024 + nt * 128 + c0; });
      });
  }
}

#define SMEM_BYTES (PH_SMEM + 2048)
#define N_PHASES (3 + 13 * DEPTH_)
__global__ void __launch_bounds__(256, 2) mega(Params p, int ph_lo, int ph_hi) {
#ifdef HIPEMU
  unsigned char* smem = hipemu::cur_smem();
#else
  unsigned char* smem = smem_dyn;
  volatile LAS unsigned* st = (volatile LAS unsigned*)(smem_dyn + SM_BAR);
  if (threadIdx.x == 0) {
    st[0] = 0u; st[1] = 0u;
    unsigned long long* tab = (unsigned long long*)(smem_dyn + SM_TAB);
#pragma unroll
    for (int i = 0; i < 40; ++i) tab[i] = (unsigned long long)p.in[i];
  }
  __syncthreads();
  XcdBarrier bar = xcd_barrier_post((unsigned*)(p.ws + Ws::BAR), st);
#define GRID_SYNC() xcd_barrier(bar)
#endif
  int ph = 0;
#ifdef ONLY_KIND
#define KIND_ON(k) ((k) == ONLY_KIND)
#else
#define KIND_ON(k) 1
#endif
#ifndef REPEAT_MASK
#define REPEAT_MASK 0u
#endif
#define RUN_PHASE(kind, code) { if (KIND_ON(kind) && ph >= ph_lo && ph < ph_hi) { \
    int nrep_ = ((REPEAT_MASK >> (kind)) & 1u) ? 2 : 1; LAUNDER(nrep_); \
    _Pragma("unroll 1") for (int rep_ = 0; rep_ < nrep_; ++rep_) { LAUNDER(p.ws); LAUNDER(p.out); code; if (rep_ + 1 < nrep_ || ph + 1 < ph_hi) { GRID_SYNC(); } } } ++ph; }
  RUN_PHASE(0, phase0(p, smem));
  RUN_PHASE(11, phase0b(p));
  for (int l = 0; l < DEPTH_; ++l) {
    RUN_PHASE(1, phase1(p, l));
    RUN_PHASE(2, phase2(p, l, smem));
    RUN_PHASE(3, phase3(p, l, smem));
    RUN_PHASE(14, phase3b(p, l, smem));
    RUN_PHASE(4, phase4a(p, l, smem));
    RUN_PHASE(12, phase4b(p, l, smem));
    RUN_PHASE(16, phase4b2(p));
    RUN_PHASE(13, phase4c(p, l, smem));
    RUN_PHASE(5, phase5(p, l, smem));
    RUN_PHASE(6, phase6(p, l, smem));
    RUN_PHASE(7, phase7(p, l, smem));
    RUN_PHASE(8, phase8(p, l, smem));
    RUN_PHASE(9, phase9(p, l, smem));
  }
  RUN_PHASE(10, phase_final(p));
}

extern "C" void kernel_launch(void* const* d_in, const int* in_sizes, int n_in, void* d_out, int out_size, void* d_ws, size_t ws_size, hipStream_t stream) {
  Params p{};
  for (int i = 0; i < 40; ++i) p.in[i] = (const float*)d_in[i];
  p.out = (float*)d_out;
  p.ws = (unsigned char*)d_ws;
  if (ws_size < Ws::END) { fprintf(stderr, "workspace too small: %zu < %zu\n", ws_size, (size_t)Ws::END); return; }
  hipMemsetAsync(d_ws, 0, Ws::ZERO_END, stream);
#ifdef HIPEMU
  int grid = 16; if (const char* e = getenv("EMU_GRID")) grid = atoi(e);
  int stop = N_PHASES; if (const char* e = getenv("EMU_STOP")) stop = atoi(e);
  if (getenv("EMU_ONE")) hipemu::launch(grid, 256, SMEM_BYTES, true, [=] { mega(p, 0, stop); });
  else for (int ph = 0; ph < stop; ++ph) hipemu::launch(grid, 256, SMEM_BYTES, false, [=] { mega(p, ph, ph + 1); });
#else
  static int grid = 0;
  if (!grid) {
    int dev = 0, cus = 0, per_cu = 0;
    hipGetDevice(&dev);
    hipDeviceGetAttribute(&cus, hipDeviceAttributeMultiprocessorCount, dev);
    hipOccupancyMaxActiveBlocksPerMultiprocessor(&per_cu, mega, 256, SMEM_BYTES);
    if (per_cu > 2) per_cu = 2;
    if (per_cu < 1) per_cu = 1;
    grid = cus * per_cu;
  }
#if N_LAUNCH_MODE == 1
  mega<<<grid, 256, SMEM_BYTES, stream>>>(p, 0, N_PHASES);
#else
  for (int ph = 0; ph < N_PHASES; ++ph) mega<<<grid, 256, SMEM_BYTES, stream>>>(p, ph, ph + 1);
#endif
#endif
}
```

```cpp
#ifndef HIPEMU
#include <hip/hip_runtime.h>
#endif
#include <stdint.h>
#include <stdio.h>

#ifndef B_
#define B_ 4
#endif
#ifndef SEQ_
#define SEQ_ 4096
#endif
#ifndef CTX_
#define CTX_ 256
#endif
#ifndef DEPTH_
#define DEPTH_ 4
#endif
#ifndef N_LAUNCH_MODE
#define N_LAUNCH_MODE 1
#endif
#define T_ (SEQ_ + CTX_)
#define NT_ (B_ * T_)
#define D_ 1024
#define NIN_ 3504
#define NMOD_ 6144
#define NR_ (B_ + 1)
#define OZ 0
#define OXBC 512
#define ODT 1536
#define ORW 1552
#define OGQ 2704
#define OGK 2832
#define OGV 2960
#define OGD 3216
#define OOG 3248
#define ALPHA_ 1.681792830507429f
#define NEXP 64
#define NSLOT 9
#define NC128 (T_ / 128)
#define NC64 (T_ / 64)
#define NC16 (T_ / 16)

#define DEVFN __device__ __forceinline__
#define LDT 72
#define GEMM_SMEM (2 * 128 * LDT * 2)
typedef unsigned short bf16_t;
#ifdef HIPEMU
#define AS1
#else
#define AS1 __attribute__((address_space(1)))
#endif
typedef unsigned u32x4 __attribute__((ext_vector_type(4)));
typedef unsigned u32x2 __attribute__((ext_vector_type(2)));

#ifdef HIPEMU
typedef emu_bf16x8 bf16x8;
typedef emu_f32x4 f32x4;
#define MFMA16(a, b, c) emu_mfma_16x16x32_bf16(a, b, c)
#define MFMA16K16(a, b, c) emu_mfma_16x16x16_bf16(a, b, c)
#define GRID_SYNC() hipemu::grid_sync()
#else
typedef short bf16x8 __attribute__((ext_vector_type(8)));
typedef float f32x4 __attribute__((ext_vector_type(4)));
#define MFMA16(a, b, c) __builtin_amdgcn_mfma_f32_16x16x32_bf16(a, b, c, 0, 0, 0)
#define MFMA16K16(a, b, c) __builtin_amdgcn_mfma_f32_16x16x16bf16_1k(a, b, c, 0, 0, 0)
#endif

DEVFN float bf2f(bf16_t h) { return __builtin_bit_cast(float, (unsigned)h << 16); }
DEVFN bf16_t f2bf(float f) { unsigned u = __builtin_bit_cast(unsigned, f); u += 0x7FFFu + ((u >> 16) & 1u); return (bf16_t)(u >> 16); }
template <class T> DEVFN AS1 T* gptr(T* q) { return (AS1 T*)q; }
DEVFN bf16x8 ld8g(const bf16_t* q) { return *(const AS1 bf16x8*)gptr(q); }
DEVFN float sigmoidf_(float x) { return 1.f / (1.f + expf(-x)); }
DEVFN float siluf_(float x) { return x / (1.f + expf(-x)); }
DEVFN float softplusf_(float x) { return x > 20.f ? x : log1pf(expf(x)); }
DEVFN float logsigmoidf_(float x) { return fminf(x, 0.f) - log1pf(expf(-fabsf(x))); }
#ifdef HIPEMU
DEVFN float wave_sum(float v) { for (int m = 32; m >= 1; m >>= 1) v += __shfl_xor(v, m); return v; }
#define SHFL_CONST(x, ln) __shfl(x, ln)
#define XOR8(x, m) __shfl_xor(x, m)
#else
template <int CTRL> DEVFN float dpp_f(float v) { return __builtin_bit_cast(float, __builtin_amdgcn_update_dpp(0, __builtin_bit_cast(int, v), CTRL, 0xF, 0xF, false)); }
template <int CTRL> DEVFN int dpp_i(int v) { return __builtin_amdgcn_update_dpp(0, v, CTRL, 0xF, 0xF, false); }
DEVFN float rdl_f(float v, int ln) { return __builtin_bit_cast(float, __builtin_amdgcn_readlane(__builtin_bit_cast(int, v), ln)); }
DEVFN float wave_sum(float v) {
  v += dpp_f<0xB1>(v);
  v += dpp_f<0x4E>(v);
  v += dpp_f<0x141>(v);
  v += dpp_f<0x140>(v);
  return (rdl_f(v, 0) + rdl_f(v, 16)) + (rdl_f(v, 32) + rdl_f(v, 48));
}
DEVFN float shfl_const_(float x, int ln) { return rdl_f(x, ln); }
DEVFN int shfl_const_(int x, int ln) { return __builtin_amdgcn_readlane(x, ln); }
#define SHFL_CONST(x, ln) shfl_const_(x, ln)
DEVFN float xor8_(float x, int m) { return m == 1 ? dpp_f<0xB1>(x) : m == 2 ? dpp_f<0x4E>(x) : dpp_f<0x141>(x); }
DEVFN int xor8_(int x, int m) { return m == 1 ? dpp_i<0xB1>(x) : m == 2 ? dpp_i<0x4E>(x) : dpp_i<0x141>(x); }
#define XOR8(x, m) xor8_(x, m)
#endif

constexpr size_t al(size_t x) { return (x + 255) & ~(size_t)255; }
struct Ws {
  static constexpr size_t BAR = 0;
  static constexpr size_t CNT = 16384;
  static constexpr size_t MOD = CNT + (size_t)DEPTH_ * 64 * 256;
  static constexpr size_t ZROW = al(MOD + (size_t)DEPTH_ * NR_ * NMOD_ * 4);
  static constexpr size_t ZERO_END = al(ZROW + 2048);
  static constexpr size_t MODP = ZERO_END;
  static constexpr size_t RWT = al(MODP + (size_t)16 * DEPTH_ * NR_ * NMOD_ * 4);
  static constexpr size_t LORA = al(RWT + (size_t)DEPTH_ * 64 * 1024 * 4);
  static constexpr size_t X = al(LORA + (size_t)DEPTH_ * 98304 * 2);
  static constexpr size_t U = al(X + (size_t)NT_ * 1024 * 4);
  static constexpr size_t YMIX = al(U + (size_t)NT_ * 1024 * 2);
  static constexpr size_t ZX = al(YMIX + (size_t)NT_ * 1024 * 2);
  static constexpr size_t MIX = ZX;
  static constexpr size_t LTOK = al(ZX + (size_t)NT_ * NIN_ * 2);
  static constexpr size_t LWT = al(LTOK + (size_t)64 * NT_ * 4);
  static constexpr size_t WIN = al(LWT + (size_t)64 * NT_ * 4);
  static constexpr size_t WOUT = al(WIN + (size_t)DEPTH_ * NIN_ * 1024 * 2);
  static constexpr size_t W13 = al(WOUT + (size_t)DEPTH_ * 1024 * 1024 * 2);
  static constexpr size_t W2T = al(W13 + (size_t)65 * 512 * 1024 * 2);
  static constexpr size_t UNI = al(W2T + (size_t)65 * 1024 * 256 * 2);
  static constexpr size_t XBC = UNI;
  static constexpr size_t XBCT = al(XBC + (size_t)NT_ * 1024 * 2);
  static constexpr size_t DTB = al(XBCT + (size_t)NT_ * 768 * 2);
  static constexpr size_t SST = al(DTB + (size_t)NT_ * 16 * 4);
  static constexpr size_t SCD = al(SST + (size_t)2 * NT_ / 128 * 8 * 8192 * 4);
  static constexpr size_t HIN = al(SCD + (size_t)2 * NT_ / 128 * 8 * 4);
  static constexpr size_t YS = SST;
  static constexpr size_t LA = al(HIN + (size_t)2 * NT_ / 128 * 8 * 8192 * 2);
  static constexpr size_t VT = al(LA + (size_t)2 * NT_ * 128 * 4);
  static constexpr size_t QT = al(VT + (size_t)NT_ * 256 * 2);
  static constexpr size_t OI = al(QT + (size_t)2 * NT_ * 128 * 2);
  static constexpr size_t GST = al(OI + (size_t)NT_ * 256 * 4);
  static constexpr size_t GCD = al(GST + (size_t)2 * NT_ / 64 * 4 * 2048 * 4);
  static constexpr size_t GSIN = al(GCD + (size_t)2 * NT_ / 64 * 4 * 32 * 4);
  static constexpr size_t RR = al(GSIN + (size_t)2 * NT_ / 64 * 4 * 2048 * 2);
  static constexpr size_t VV = RR + (size_t)NT_ * 256 * 2;
  static constexpr size_t KK = VV + (size_t)NT_ * 256 * 2;
  static constexpr size_t KD = KK + (size_t)NT_ * 256 * 2;
  static constexpr size_t BD = KD + (size_t)2 * NT_ * 256 * 2;
  static constexpr size_t LW = BD + (size_t)2 * NT_ * 256 * 2;
  static constexpr size_t GATE = LW + (size_t)2 * NT_ * 256 * 4;
  static constexpr size_t YR = GATE + (size_t)NT_ * 256 * 4;
  static constexpr size_t RML = al(YR + (size_t)2 * NT_ * 256 * 4);
  static constexpr size_t RNS = RML + (size_t)(NT_ / 16) * 8 * 4096 * 2;
  static constexpr size_t RWC = RNS + (size_t)(NT_ / 16) * 8 * 4096 * 2;
  static constexpr size_t RG = RWC + (size_t)(NT_ / 16) * 8 * 64 * 4;
  static constexpr size_t RY0 = RG + (size_t)(NT_ / 16) * 8 * 1024 * 2;
  static constexpr size_t LI = RY0 + (size_t)(NT_ / 16) * 8 * 1024 * 4;
  static constexpr size_t KRW = LI + (size_t)NT_ * 384 * 2;
  static constexpr size_t MIXER_END = KRW + (size_t)NT_ * 256 * 2;
  static constexpr size_t HID = UNI;
  static constexpr size_t YBUF = al(HID + ((size_t)NT_ * 9 + 65 * 128) * 256 * 2);
  static constexpr size_t MOE_END = YBUF + (size_t)NT_ * 9 * 1024 * 2;
  static constexpr size_t END = al(MIXER_END > MOE_END ? MIXER_END : MOE_END);
};

struct Params {
  const float* in[40];
  float* out;
  unsigned char* ws;
};
enum { I_X = 0, I_C, I_CTX, I_CCTX, I_ADAW, I_ADAB, I_WIN, I_CONVW, I_CONVB, I_DTBIAS, I_ALOG, I_SSDD, I_SSDNW, I_MU, I_W0, I_W2, I_A0, I_A2,
       I_G2, I_KKW, I_KAW, I_RK, I_LNXW, I_LNXB, I_GU, I_GB, I_GNW, I_WOUT, I_LN1W, I_LN1B, I_LN2W, I_LN2B, I_RW, I_RB, I_EW1, I_EW3, I_EW2,
       I_SW1, I_SW3, I_SW2 };

#define PH_SMEM 47104
#define SM_PRE (PH_SMEM)
#define SM_TAB (PH_SMEM + 1024)
#define SM_BAR (PH_SMEM + 2032)
#ifdef HIPEMU
#define INP(i) (p.in[i])
#define LAUNDER(x)
#define TIDX ((int)threadIdx.x)
#define BIDX ((int)blockIdx.x)
#define LAUNDER_V(x)
#else
extern __shared__ __align__(16) unsigned char smem_dyn[];
DEVFN const float* inp_lds(int i) {
  const volatile unsigned* t = (const volatile unsigned*)(smem_dyn + SM_TAB) + 2 * i;
  unsigned lo = __builtin_amdgcn_readfirstlane(t[0]), hi = __builtin_amdgcn_readfirstlane(t[1]);
  return (const float*)(((unsigned long long)hi << 32) | lo);
}
#define INP(i) inp_lds(i)
#define LAUNDER(x) asm volatile("" : "+s"(x))
DEVFN int tidx_() { int t = threadIdx.x; asm volatile("" : "+v"(t)); return t; }
DEVFN int bidx_() { int b = blockIdx.x; asm volatile("" : "+s"(b)); return b; }
#define TIDX tidx_()
#define LAUNDER_V(x) asm volatile("" : "+v"(x))
#define BIDX bidx_()
#endif
#ifndef HIPEMU
#define XB_TMO      128
#define XB_XCNT(j)  (256  + 64 * (j))
#define XB_XSUB(j)  (1280 + 64 * (j))
#define XB_XGEN(j)  (2304 + 64 * (j))
#define XB_TOP      3328
#define XB_TOPGEN   3392
#define XCD_BAR_WORDS 3456
#define XB_SPIN_CAP (1u << 22)
#define LAS __attribute__((address_space(3)))
__device__ __forceinline__ unsigned xb_ld(unsigned* p)              { return __hip_atomic_load(p, __ATOMIC_RELAXED, __HIP_MEMORY_SCOPE_AGENT); }
__device__ __forceinline__ unsigned xb_add(unsigned* p, unsigned v) { return __hip_atomic_fetch_add(p, v, __ATOMIC_RELAXED, __HIP_MEMORY_SCOPE_AGENT); }
__device__ __forceinline__ unsigned xb_xcc_id() { return (unsigned)__builtin_amdgcn_s_getreg((3 << 11) | 20) & 0xFu; }
#define XB_SPIN(cond, bar) do { unsigned _sp = 0; while (cond) { __builtin_amdgcn_s_sleep(1); \
    if ((++_sp & 255u) == 0u) { if (xb_ld(&(bar)[XB_TMO])) break; if (_sp > XB_SPIN_CAP) { atomicAdd(&(bar)[XB_TMO], 1u); break; } } } } while (0)
struct XcdBarrier { unsigned* bar; unsigned x; volatile LAS unsigned* st; };
__device__ __forceinline__ XcdBarrier xcd_barrier_post(unsigned* bar, volatile LAS unsigned* st) {
    XcdBarrier b; b.bar = bar; b.x = xb_xcc_id(); b.st = st;
    if (threadIdx.x == 0) (void)xb_add(&bar[XB_XCNT(b.x)], 1u);
    return b;
}
__device__ __forceinline__ void xcd_barrier_complete(unsigned* bar, unsigned x, unsigned& nloc, unsigned& nx) {
    const unsigned G = gridDim.x * gridDim.y * gridDim.z;
    unsigned sum, cnt, mine, sp = 0u;
    for (;;) {
        sum = 0u; cnt = 0u; mine = 0u;
#pragma unroll
        for (unsigned j = 0; j < 16; ++j) { const unsigned c = xb_ld(&bar[XB_XCNT(j)]); sum += c; cnt += (c > 0u) ? 1u : 0u; mine = (j == x) ? c : mine; }
        if (sum == G) break;
        __builtin_amdgcn_s_sleep(1);
        if ((++sp & 255u) == 0u) { if (xb_ld(&bar[XB_TMO])) break; if (sp > XB_SPIN_CAP) { atomicAdd(&bar[XB_TMO], 1u); break; } }
    }
    nloc = mine > 0u ? mine : 1u; nx = cnt > 0u ? cnt : 1u;
}
__device__ __forceinline__ void xcd_barrier(const XcdBarrier& b) {
    asm volatile("s_waitcnt vmcnt(0)" ::: "memory");
    __syncthreads();
    if (threadIdx.x == 0) {
        unsigned* bar = b.bar;
        __builtin_amdgcn_s_waitcnt(0);
        unsigned nloc = b.st[0], nx = b.st[1];
        if (nloc == 0u) { xcd_barrier_complete(bar, b.x, nloc, nx); b.st[0] = nloc; b.st[1] = nx; }
        const unsigned old = xb_add(&bar[XB_XSUB(b.x)], 1u);
        const unsigned gen = old / nloc;
        if (old + 1u == (gen + 1u) * nloc) {
            __builtin_amdgcn_fence(__ATOMIC_RELEASE, "agent");
            asm volatile("s_waitcnt vmcnt(0)" ::: "memory");
            const unsigned og = xb_add(&bar[XB_TOP], 1u);
            const unsigned tg = og / nx;
            if (og + 1u == (tg + 1u) * nx) xb_add(&bar[XB_TOPGEN], 1u);
            else XB_SPIN(xb_ld(&bar[XB_TOPGEN]) == tg, bar);
            __builtin_amdgcn_fence(__ATOMIC_ACQUIRE, "agent");
            xb_add(&bar[XB_XGEN(b.x)], 1u);
            asm volatile("s_waitcnt vmcnt(0)" ::: "memory");
        } else {
            XB_SPIN(xb_ld(&bar[XB_XGEN(b.x)]) == gen, bar);
            __builtin_amdgcn_fence(__ATOMIC_ACQUIRE, "agent");
            asm volatile("s_waitcnt vmcnt(0)" ::: "memory");
        }
    }
    __syncthreads();
}
#endif

DEVFN int tokmap(int dir, int p) { return dir == 0 ? p : (p < CTX_ ? CTX_ - 1 - p : 2 * CTX_ + SEQ_ - 1 - p); }
DEVFN const float* tok_input_row(const Params& p, int tok) {
  int b = tok / T_, t = tok % T_;
  return t < CTX_ ? INP(I_CTX) + ((size_t)b * CTX_ + t) * D_ : INP(I_X) + ((size_t)b * SEQ_ + (t - CTX_)) * D_;
}
DEVFN int tok_modrow(int tok) { return (tok % T_) < CTX_ ? B_ : tok / T_; }

template <class ARow, class BRow, class Epi>
DEVFN void gemm_tile(unsigned char* smem, int K, ARow arow, BRow brow, Epi epi) {
  bf16_t* As = (bf16_t*)smem;
  bf16_t* Bs = As + 128 * LDT;
  const int tid = TIDX, lane = tid & 63, wave = tid >> 6, wr = wave >> 1, wc = wave & 1;
  const int g = lane >> 4, l15 = lane & 15;
  const int lr = tid >> 3, lc = (tid & 7) * 8;
  const AS1 bf16_t* ap[4];
  const AS1 bf16_t* bp[4];
#pragma unroll
  for (int i = 0; i < 4; ++i) { ap[i] = gptr(arow(lr + 32 * i)); bp[i] = gptr(brow(lr + 32 * i)); }
  f32x4 acc[4][4];
#pragma unroll
  for (int mi = 0; mi < 4; ++mi)
#pragma unroll
    for (int ni = 0; ni < 4; ++ni) acc[mi][ni] = f32x4{0.f, 0.f, 0.f, 0.f};
  u32x4 ra0[4], rb0[4], ra1[4], rb1[4];
#pragma unroll
  for (int i = 0; i < 4; ++i) { ra0[i] = *(const AS1 u32x4*)(ap[i] + lc); rb0[i] = *(const AS1 u32x4*)(bp[i] + lc); }
  if (K > 64) {
#pragma unroll
    for (int i = 0; i < 4; ++i) { ra1[i] = *(const AS1 u32x4*)(ap[i] + 64 + lc); rb1[i] = *(const AS1 u32x4*)(bp[i] + 64 + lc); } }
  auto compute = [&]() {
#pragma unroll
    for (int kk = 0; kk < 2; ++kk) {
      bf16x8 af[4], bfr[4];
#pragma unroll
      for (int mi = 0; mi < 4; ++mi) af[mi] = *(const bf16x8*)(As + (wr * 64 + mi * 16 + l15) * LDT + kk * 32 + g * 8);
#pragma unroll
      for (int ni = 0; ni < 4; ++ni) bfr[ni] = *(const bf16x8*)(Bs + (wc * 64 + ni * 16 + l15) * LDT + kk * 32 + g * 8);
#pragma unroll
      for (int mi = 0; mi < 4; ++mi)
#pragma unroll
        for (int ni = 0; ni < 4; ++ni) acc[mi][ni] = MFMA16(af[mi], bfr[ni], acc[mi][ni]);
    } };
  for (int k0 = 0; k0 < K; k0 += 128) {
    __syncthreads();
#pragma unroll
    for (int i = 0; i < 4; ++i) { *(u32x4*)(As + (lr + 32 * i) * LDT + lc) = ra0[i]; *(u32x4*)(Bs + (lr + 32 * i) * LDT + lc) = rb0[i]; }
    __syncthreads();
    if (k0 + 128 < K) {
#pragma unroll
      for (int i = 0; i < 4; ++i) { ra0[i] = *(const AS1 u32x4*)(ap[i] + k0 + 128 + lc); rb0[i] = *(const AS1 u32x4*)(bp[i] + k0 + 128 + lc); } }
    compute();
    if (k0 + 64 < K) {
      __syncthreads();
#pragma unroll
      for (int i = 0; i < 4; ++i) { *(u32x4*)(As + (lr + 32 * i) * LDT + lc) = ra1[i]; *(u32x4*)(Bs + (lr + 32 * i) * LDT + lc) = rb1[i]; }
      __syncthreads();
      if (k0 + 192 < K) {
#pragma unroll
        for (int i = 0; i < 4; ++i) { ra1[i] = *(const AS1 u32x4*)(ap[i] + k0 + 192 + lc); rb1[i] = *(const AS1 u32x4*)(bp[i] + k0 + 192 + lc); } }
      compute();
    }
  }
  epi(acc, wr, wc, g, l15);
}

template <int NCH, class Val, class RowP>
DEVFN void tile_store_bf16(unsigned char* smem, int wr, int g, int l15, Val val, RowP rowp) {
  constexpr int LDC = NCH * 8 + 8;
  bf16_t* T = (bf16_t*)smem;
  const int tid = TIDX;
  __syncthreads();
  val(T, LDC);
  __syncthreads();
#pragma unroll
  for (int pass = 0; pass < NCH / 2; ++pass) { const int id = tid + 256 * pass, row = id / NCH, c = id % NCH;
    bf16_t* dst = rowp(row, c * 8);
    if (dst) *(AS1 u32x4*)gptr(dst) = *(const u32x4*)(T + row * LDC + c * 8); }
  (void)wr; (void)g; (void)l15;
}
DEVFN void cvt_tile(unsigned char* smem, const float* src, int K, int N, int k0, int n0, bf16_t* dst, int ldd, int mode) {
  float* s = (float*)smem;
  const int tid = TIDX;
  const AS1 float* gsrc = gptr(src);
  __syncthreads();
  { const int kk = tid >> 4, n4 = (tid & 15) * 4;
#pragma unroll
    for (int pass = 0; pass < 4; ++pass) { const int k = kk + 16 * pass;
      f32x4 v = f32x4{0.f, 0.f, 0.f, 0.f};
      if (n0 + n4 < N) v = *(const AS1 f32x4*)(gsrc + (size_t)(k0 + k) * N + n0 + n4);
      s[k * 65 + n4] = v[0]; s[k * 65 + n4 + 1] = v[1]; s[k * 65 + n4 + 2] = v[2]; s[k * 65 + n4 + 3] = v[3]; } }
  __syncthreads();
  { const int nn = tid >> 2, k16 = (tid & 3) * 16, n = n0 + nn;
    if (n < N) { const int row = mode == 0 ? n : ((n >> 4) * 32 + (n & 15) + (mode == 2 ? 16 : 0));
      u32x4 o0, o1;
#pragma unroll
      for (int j = 0; j < 4; ++j) { o0[j] = (unsigned)f2bf(s[(k16 + 2 * j) * 65 + nn]) | ((unsigned)f2bf(s[(k16 + 2 * j + 1) * 65 + nn]) << 16);
        o1[j] = (unsigned)f2bf(s[(k16 + 8 + 2 * j) * 65 + nn]) | ((unsigned)f2bf(s[(k16 + 9 + 2 * j) * 65 + nn]) << 16); }
      AS1 bf16_t* d = gptr(dst) + (size_t)row * ldd + k0 + k16;
      *(AS1 u32x4*)d = o0; *(AS1 u32x4*)(d + 8) = o1; } }
  (void)K;
}
struct CvtJob { const float* src; bf16_t* dst; int N, k0, n0, ldd, mode; };
DEVFN void cvt_load(const CvtJob& j, f32x4 (&v)[4]) {
  const int tid = TIDX, kk = tid >> 4, n4 = (tid & 15) * 4;
  const AS1 float* g = gptr(j.src);
#pragma unroll
  for (int pass = 0; pass < 4; ++pass) { v[pass] = f32x4{0.f, 0.f, 0.f, 0.f};
    if (j.n0 + n4 < j.N) v[pass] = *(const AS1 f32x4*)(g + (size_t)(j.k0 + kk + 16 * pass) * j.N + j.n0 + n4); }
}
DEVFN void cvt_store(unsigned char* smem, const CvtJob& j, const f32x4 (&v)[4]) {
  float* s = (float*)smem;
  const int tid = TIDX, kk = tid >> 4, n4 = (tid & 15) * 4;
  __syncthreads();
#pragma unroll
  for (int pass = 0; pass < 4; ++pass) { const int k = kk + 16 * pass; s[k * 65 + n4] = v[pass][0]; s[k * 65 + n4 + 1] = v[pass][1]; s[k * 65 + n4 + 2] = v[pass][2]; s[k * 65 + n4 + 3] = v[pass][3]; }
  __syncthreads();
  const int nn = tid >> 2, k16 = (tid & 3) * 16, n = j.n0 + nn;
  if (n < j.N) { const int row = j.mode == 0 ? n : ((n >> 4) * 32 + (n & 15) + (j.mode == 2 ? 16 : 0));
    u32x4 o0, o1;
#pragma unroll
    for (int q = 0; q < 4; ++q) { o0[q] = (unsigned)f2bf(s[(k16 + 2 * q) * 65 + nn]) | ((unsigned)f2bf(s[(k16 + 2 * q + 1) * 65 + nn]) << 16);
      o1[q] = (unsigned)f2bf(s[(k16 + 8 + 2 * q) * 65 + nn]) | ((unsigned)f2bf(s[(k16 + 9 + 2 * q) * 65 + nn]) << 16); }
    AS1 bf16_t* d = gptr(j.dst) + (size_t)row * j.ldd + j.k0 + k16;
    *(AS1 u32x4*)d = o0; *(AS1 u32x4*)(d + 8) = o1; }
}
DEVFN CvtJob moe_cvt_job(const Params& p, int l, int u) {
  bf16_t* w13 = (bf16_t*)(p.ws + Ws::W13); bf16_t* w2t = (bf16_t*)(p.ws + Ws::W2T);
  const int e = u / 192, r = u % 192, which = r / 64, t = r % 64;
  CvtJob j;
  if (which < 2) {
    j.src = e < 64 ? (which == 0 ? INP(I_EW1) : INP(I_EW3)) + ((size_t)l * 64 + e) * 1024 * 256 : (which == 0 ? INP(I_SW1) : INP(I_SW3)) + (size_t)l * 1024 * 256;
    j.N = 256; j.k0 = (t >> 2) * 64; j.n0 = (t & 3) * 64; j.dst = w13 + (size_t)e * 512 * 1024; j.ldd = 1024; j.mode = which == 0 ? 1 : 2;
  } else {
    j.src = e < 64 ? INP(I_EW2) + ((size_t)l * 64 + e) * 256 * 1024 : INP(I_SW2) + (size_t)l * 256 * 1024;
    j.N = 1024; j.k0 = (t >> 4) * 64; j.n0 = (t & 15) * 64; j.dst = w2t + (size_t)e * 1024 * 256; j.ldd = 256; j.mode = 0;
  }
  return j;
}
DEVFN void convert_moe_weights(const Params& p, int l, unsigned char* smem, int bid, int nb) {
  const int total = 65 * 192;
  if (bid >= total) return;
  f32x4 v[4], vn[4];
  CvtJob j = moe_cvt_job(p, l, bid);
  cvt_load(j, v);
  for (int u = bid; u < total; u += nb) {
    const int un = u + nb;
    CvtJob jn = j;
    if (un < total) { jn = moe_cvt_job(p, l, un); cvt_load(jn, vn); }
    cvt_store(smem, j, v);
    j = jn;
#pragma unroll
    for (int q = 0; q < 4; ++q) v[q] = vn[q];
  }
}
DEVFN void phase0(const Params& p, unsigned char* smem) {
  const int tid = TIDX;
  float* modp = (float*)(p.ws + Ws::MODP);
  for (int u = BIDX; u < DEPTH_ * 24 * 16; u += gridDim.x) {
    int l = u / (24 * 16), jb = (u / 16) % 24, ks = u % 16;
    float* sc = (float*)smem;
    __syncthreads();
    for (int e = tid; e < NR_ * 64; e += 256) { int r = e / 64, i = ks * 64 + (e % 64); float cv = r < B_ ? INP(I_C)[(size_t)r * D_ + i] : INP(I_CCTX)[i]; sc[e] = siluf_(cv); }
    __syncthreads();
    int j = jb * 256 + tid;
    float acc[NR_];
#pragma unroll
    for (int r = 0; r < NR_; ++r) acc[r] = 0.f;
    const float* w = INP(I_ADAW) + ((size_t)l * D_ + ks * 64) * NMOD_ + j;
#pragma unroll 4
    for (int i = 0; i < 64; ++i) { float wv = w[(size_t)i * NMOD_];
#pragma unroll
      for (int r = 0; r < NR_; ++r) acc[r] += sc[r * 64 + i] * wv; }
#pragma unroll
    for (int r = 0; r < NR_; ++r) modp[(((size_t)ks * DEPTH_ + l) * NR_ + r) * NMOD_ + j] = acc[r];
  }
  bf16_t* win = (bf16_t*)(p.ws + Ws::WIN);
  bf16_t* wout = (bf16_t*)(p.ws + Ws::WOUT);
  for (int u = BIDX; u < DEPTH_ * 16 * 55; u += gridDim.x) {
    int l = u / (16 * 55), r = u % (16 * 55);
    cvt_tile(smem, INP(I_WIN) + (size_t)l * 1024 * NIN_, 1024, NIN_, (r / 55) * 64, (r % 55) * 64, win + (size_t)l * NIN_ * 1024, 1024, 0);
  }
  for (int u = BIDX; u < DEPTH_ * 256; u += gridDim.x) {
    int l = u / 256, r = u % 256;
    cvt_tile(smem, INP(I_WOUT) + (size_t)l * 1024 * 1024, 1024, 1024, (r / 16) * 64, (r % 16) * 64, wout + (size_t)l * 1024 * 1024, 1024, 0);
  }
  { bf16_t* lo = (bf16_t*)(p.ws + Ws::LORA);
    for (int u = BIDX * 256 + tid; u < DEPTH_ * 98304; u += gridDim.x * 256) {
      const int l = u / 98304, r = u % 98304; float v;
      if (r < 32768) { const int d = r >> 14, n = (r >> 6) & 255, k = r & 63; v = INP(I_W2)[(((size_t)l * 2 + d) * 64 + k) * 256 + n]; }
      else if (r < 65536) { const int r2 = r - 32768, d = r2 >> 14, n = (r2 >> 6) & 255, k = r2 & 63; v = INP(I_A2)[(((size_t)l * 2 + d) * 64 + k) * 256 + n]; }
      else { const int r2 = r - 65536, n = r2 >> 7, k = r2 & 127; v = INP(I_G2)[((size_t)l * 128 + k) * 256 + n]; }
      lo[u] = f2bf(v); } }
  float* rwt = (float*)(p.ws + Ws::RWT);
  for (int u = BIDX * 256 + tid; u < DEPTH_ * 64 * 1024; u += gridDim.x * 256) {
    int l = u / (64 * 1024), e = (u / 1024) % 64, i = u % 1024;
    rwt[u] = INP(I_RW)[((size_t)l * 1024 + i) * 64 + e];
  }
}

DEVFN void phase0b(const Params& p) {
  float* mod = (float*)(p.ws + Ws::MOD); const float* modp = (const float*)(p.ws + Ws::MODP);
  for (int u = BIDX * 256 + TIDX; u < DEPTH_ * NR_ * NMOD_; u += gridDim.x * 256) {
    int l = u / (NR_ * NMOD_), j = u % NMOD_;
    float s = INP(I_ADAB)[(size_t)l * NMOD_ + j];
    for (int ks = 0; ks < 16; ++ks) s += modp[(size_t)ks * DEPTH_ * NR_ * NMOD_ + u];
    mod[u] = s;
  }
}

DEVFN void row_stats(const float (&v)[16], float& mean, float& rstd) {
  float s = 0.f;
#pragma unroll
  for (int i = 0; i < 16; ++i) s += v[i];
  mean = wave_sum(s) * (1.f / 1024.f);
  float q = 0.f;
#pragma unroll
  for (int i = 0; i < 16; ++i) { float d = v[i] - mean; q += d * d; }
  rstd = rsqrtf(wave_sum(q) * (1.f / 1024.f) + 1e-5f);
}
DEVFN void load_row16(const float* row, int lane, float (&v)[16]) {
  const AS1 float* r = gptr(row);
#pragma unroll
  for (int j = 0; j < 4; ++j) { const f32x4 t = *(const AS1 f32x4*)(r + lane * 4 + 256 * j); v[4 * j] = t[0]; v[4 * j + 1] = t[1]; v[4 * j + 2] = t[2]; v[4 * j + 3] = t[3]; }
}
DEVFN void moe_residual_row(const Params& p, int lp, int tok, int lane, float (&xv)[16]) {
  const float* mod = (const float*)(p.ws + Ws::MOD) + ((size_t)lp * NR_ + tok_modrow(tok)) * NMOD_;
  const bf16_t* yb = (const bf16_t*)(p.ws + Ws::YBUF) + (size_t)tok * NSLOT * 1024;
  float g2[16], w[16], b[16];
  load_row16(mod + 5 * 1024, lane, g2);
  load_row16(INP(I_LN2W) + (size_t)lp * 1024, lane, w);
  load_row16(INP(I_LN2B) + (size_t)lp * 1024, lane, b);
  u32x2 sl[NSLOT][4];
#pragma unroll
  for (int s = 0; s < NSLOT; ++s)
#pragma unroll
    for (int j = 0; j < 4; ++j) sl[s][j] = *(const AS1 u32x2*)gptr(yb + (size_t)s * 1024 + lane * 4 + 256 * j);
  float f[16];
#pragma unroll
  for (int i = 0; i < 16; ++i) f[i] = 0.f;
#pragma unroll
  for (int s = 0; s < NSLOT; ++s)
#pragma unroll
    for (int j = 0; j < 4; ++j) { const u32x2 t = sl[s][j];
      f[4 * j] += bf2f((bf16_t)(t[0] & 0xFFFF)); f[4 * j + 1] += bf2f((bf16_t)(t[0] >> 16)); f[4 * j + 2] += bf2f((bf16_t)(t[1] & 0xFFFF)); f[4 * j + 3] += bf2f((bf16_t)(t[1] >> 16)); }
#pragma unroll
  for (int i = 0; i < 16; ++i) xv[i] = ALPHA_ * xv[i] + g2[i] * f[i];
  float mean, rstd;
  row_stats(xv, mean, rstd);
#pragma unroll
  for (int i = 0; i < 16; ++i) xv[i] = (xv[i] - mean) * rstd * w[i] + b[i];
}
DEVFN void phase1(const Params& p, int l) {
  const int lane = TIDX & 63, wave = TIDX >> 6;
  float* X = (float*)(p.ws + Ws::X);
  bf16_t* U = (bf16_t*)(p.ws + Ws::U);
  for (int tok = BIDX * 4 + wave; tok < NT_; tok += gridDim.x * 4) {
    float xv[16], sh[16], sc[16], mean, rstd;
    const float* mod = (const float*)(p.ws + Ws::MOD) + ((size_t)l * NR_ + tok_modrow(tok)) * NMOD_;
    load_row16(mod, lane, sh);
    load_row16(mod + 1024, lane, sc);
    if (l == 0) load_row16(tok_input_row(p, tok), lane, xv);
    else { load_row16(X + (size_t)tok * 1024, lane, xv); moe_residual_row(p, l - 1, tok, lane, xv); }
#pragma unroll
    for (int j = 0; j < 4; ++j) *(float4*)(X + (size_t)tok * 1024 + lane * 4 + 256 * j) = make_float4(xv[4 * j], xv[4 * j + 1], xv[4 * j + 2], xv[4 * j + 3]);
    row_stats(xv, mean, rstd);
#pragma unroll
    for (int j = 0; j < 4; ++j) {
      float u0 = (xv[4 * j] - mean) * rstd * (1.f + sc[4 * j]) + sh[4 * j], u1 = (xv[4 * j + 1] - mean) * rstd * (1.f + sc[4 * j + 1]) + sh[4 * j + 1];
      float u2 = (xv[4 * j + 2] - mean) * rstd * (1.f + sc[4 * j + 2]) + sh[4 * j + 2], u3 = (xv[4 * j + 3] - mean) * rstd * (1.f + sc[4 * j + 3]) + sh[4 * j + 3];
      *(uint2*)(U + (size_t)tok * 1024 + lane * 4 + 256 * j) = make_uint2((unsigned)f2bf(u0) | ((unsigned)f2bf(u1) << 16), (unsigned)f2bf(u2) | ((unsigned)f2bf(u3) << 16));
    }
  }
}
DEVFN void phase_final(const Params& p) {
  const int lane = TIDX & 63, wave = TIDX >> 6;
  const float* X = (const float*)(p.ws + Ws::X);
  for (int r = BIDX * 4 + wave; r < B_ * SEQ_; r += gridDim.x * 4) {
    int b = r / SEQ_, s = r % SEQ_, tok = b * T_ + CTX_ + s;
    float xv[16];
    load_row16(X + (size_t)tok * 1024, lane, xv);
    moe_residual_row(p, DEPTH_ - 1, tok, lane, xv);
#pragma unroll
    for (int j = 0; j < 4; ++j) *(float4*)(p.out + (size_t)r * 1024 + lane * 4 + 256 * j) = make_float4(xv[4 * j], xv[4 * j + 1], xv[4 * j + 2], xv[4 * j + 3]);
  }
}

DEVFN void phase2(const Params& p, int l, unsigned char* smem) {
  const bf16_t* U = (const bf16_t*)(p.ws + Ws::U);
  const bf16_t* W = (const bf16_t*)(p.ws + Ws::WIN) + (size_t)l * NIN_ * 1024;
  bf16_t* ZX = (bf16_t*)(p.ws + Ws::ZX);
  const int nct = (NIN_ + 127) / 128;
  for (int u = BIDX; u < (NT_ / 128) * nct; u += gridDim.x) {
    int rt = u / nct, ct = u % nct;
    gemm_tile(smem, 1024,
      [&](int r) { return U + (size_t)(rt * 128 + r) * 1024; },
      [&](int r) { int n = ct * 128 + r; return n < NIN_ ? W + (size_t)n * 1024 : (const bf16_t*)(p.ws + Ws::ZROW); },
      [&](f32x4 (&acc)[4][4], int wr, int wc, int g, int l15) {
        tile_store_bf16<16>(smem, wr, g, l15,
          [&](bf16_t* T, int ldc) {
#pragma unroll
            for (int mi = 0; mi < 4; ++mi)
#pragma unroll
              for (int ni = 0; ni < 4; ++ni)
#pragma unroll
                for (int i = 0; i < 4; ++i) T[(wr * 64 + mi * 16 + 4 * g + i) * ldc + wc * 64 + ni * 16 + l15] = f2bf(acc[mi][ni][i]); },
          [&](int row, int c0) { return ct * 128 + c0 < NIN_ ? ZX + (size_t)(rt * 128 + row) * NIN_ + ct * 128 + c0 : (bf16_t*)nullptr; });
      });
  }
}

DEVFN float zxv(const bf16_t* ZX, int tok, int col) { return bf2f(gptr(ZX)[(size_t)tok * NIN_ + col]); }
struct Nbr { int n; int tok[4]; };
DEVFN Nbr shift_nbrs(int tok) {
  Nbr nb; int b = tok / T_, t = tok % T_;
  if (t < CTX_) { nb.n = 2; nb.tok[0] = t > 0 ? tok - 1 : -1; nb.tok[1] = t < CTX_ - 1 ? tok + 1 : -1; nb.tok[2] = -1; nb.tok[3] = -1; }
  else { int s = t - CTX_, row = s / 64, col = s % 64; nb.n = 4; nb.tok[0] = col > 0 ? tok - 1 : -1; nb.tok[1] = col < 63 ? tok + 1 : -1;
    nb.tok[2] = row > 0 ? tok - 64 : -1; nb.tok[3] = row < SEQ_ / 64 - 1 ? tok + 64 : -1; }
  (void)b; return nb;
}
DEVFN float shiftmix(const bf16_t* ZX, const float* mu, int tok, const Nbr& nb, int ch) {
  float z = zxv(ZX, tok, ORW + ch), o = z;
#pragma unroll
  for (int j = 0; j < 4; ++j) if (j < nb.n) { float v = nb.tok[j] >= 0 ? zxv(ZX, nb.tok[j], ORW + ch) : 0.f; o += mu[j * 1152 + ch] * (v - z); }
  return o;
}
#define LI_LD 392
#define KL_LD 264
DEVFN void phase3(const Params& p, int l, unsigned char* smem) {
  const int tid = TIDX, lane = tid & 63, wave = tid >> 6, q = lane >> 4, l15 = lane & 15;
  const bf16_t* ZX = (const bf16_t*)(p.ws + Ws::ZX);
  bf16_t* XBC = (bf16_t*)(p.ws + Ws::XBC); float* DTB = (float*)(p.ws + Ws::DTB);
  bf16_t* RR = (bf16_t*)(p.ws + Ws::RR); bf16_t* VV = (bf16_t*)(p.ws + Ws::VV); bf16_t* KKb = (bf16_t*)(p.ws + Ws::KK);
  bf16_t* KRW = (bf16_t*)(p.ws + Ws::KRW); bf16_t* LIg = (bf16_t*)(p.ws + Ws::LI);
  float* LA = (float*)(p.ws + Ws::LA);
  const float* convw = INP(I_CONVW) + (size_t)l * 3 * 1024; const float* convb = INP(I_CONVB) + (size_t)l * 1024;
  const float* mu = INP(I_MU) + (size_t)l * 4 * 1152;
  float* gdl = (float*)smem;
  const float kkw = INP(I_KKW)[(size_t)l * 256 + tid];
  for (int tile = BIDX; tile < NT_ / 16; tile += gridDim.x) {
    const int tok0 = tile * 16, t0 = tok0 % T_, bb = tok0 / T_;
    const bool isctx = t0 < CTX_;
    const int s0 = t0 - CTX_;
    const bool lval = isctx ? (t0 > 0) : ((s0 & 63) != 0), rval = isctx ? (t0 + 16 < CTX_) : ((s0 & 63) != 48);
    const bool uval = !isctx && (s0 >= 64), dval = !isctx && (s0 + 64 < SEQ_);
    __syncthreads();
    {
      const bool segstart = (t0 == 0 || t0 == CTX_), segend = (t0 + 16 == CTX_ || t0 + 16 == T_);
      bf16_t* XBCT = (bf16_t*)(p.ws + Ws::XBCT) + ((size_t)(bb * NC128 + t0 / 128) * 768) * 128 + (t0 % 128);
#pragma unroll 1
      for (int j = 0; j < 4; ++j) { const int c = tid + 256 * j;
        const AS1 bf16_t* zp = gptr(ZX) + (size_t)tok0 * NIN_ + OXBC + c - NIN_; AS1 bf16_t* xp = gptr(XBC) + (size_t)tok0 * 1024 + c;
        float z[18];
#pragma unroll
        for (int i = 0; i < 18; ++i) { z[i] = ((i == 0 && segstart) || (i == 17 && segend)) ? 0.f : bf2f(*zp); zp += NIN_; LAUNDER_V(zp); }
        const float w0 = convw[c], w1 = convw[1024 + c], w2 = convw[2048 + c], cb = convb[c];
        bf16_t y[16];
#pragma unroll
        for (int i = 0; i < 16; ++i) { y[i] = f2bf(siluf_(cb + w0 * z[i] + w1 * z[i + 1] + w2 * z[i + 2])); *xp = y[i]; xp += 1024; LAUNDER_V(xp); }
        if (c < 768) {
          u32x4 o0, o1;
#pragma unroll
          for (int i = 0; i < 4; ++i) { o0[i] = (unsigned)y[2 * i] | ((unsigned)y[2 * i + 1] << 16); o1[i] = (unsigned)y[8 + 2 * i] | ((unsigned)y[9 + 2 * i] << 16); }
          *(u32x4*)(XBCT + (size_t)c * 128) = o0; *(u32x4*)(XBCT + (size_t)c * 128 + 8) = o1; } }
      { bf16_t* VTp = (bf16_t*)(p.ws + Ws::VT) + ((size_t)(bb * NC64 + t0 / 64) * 256 + tid) * 64 + (t0 % 64);
        const AS1 bf16_t* vp = gptr(ZX) + (size_t)tok0 * NIN_ + OGV + tid;
        u32x4 o0, o1;
        bf16_t vv16[16];
#pragma unroll
        for (int i = 0; i < 16; ++i) { vv16[i] = *vp; vp += NIN_; LAUNDER_V(vp); }
#pragma unroll
        for (int i = 0; i < 4; ++i) { o0[i] = (unsigned)vv16[2 * i] | ((unsigned)vv16[2 * i + 1] << 16); o1[i] = (unsigned)vv16[8 + 2 * i] | ((unsigned)vv16[9 + 2 * i] << 16); }
        *(u32x4*)VTp = o0; *(u32x4*)(VTp + 8) = o1; }
      DTB[(size_t)tok0 * 16 + tid] = softplusf_(zxv(ZX, tok0 + (tid >> 4), ODT + (tid & 15)) + INP(I_DTBIAS)[(size_t)l * 16 + (tid & 15)]);
      gdl[tid] = zxv(ZX, tok0 + (tid >> 5), OGD + (tid & 31)); gdl[256 + tid] = zxv(ZX, tok0 + 8 + (tid >> 5), OGD + (tid & 31));
    }
#pragma unroll 1
    for (int g = 0; g < 5; ++g) {
      const bool act = !(g == 4 && tid >= 128);
      const int ch = act ? g * 256 + tid : 0;
      const AS1 bf16_t* zp0 = gptr(ZX) + (size_t)tok0 * NIN_ + ORW + ch;
      const AS1 bf16_t* zp = zp0 - NIN_;
      const float m0 = mu[ch], m1 = mu[1152 + ch], m2 = mu[2304 + ch], m3 = mu[3456 + ch];
      float z[18], o[16];
#pragma unroll
      for (int i = 0; i < 18; ++i) { z[i] = ((i == 0 && !lval) || (i == 17 && !rval)) ? 0.f : bf2f(*zp); zp += NIN_; LAUNDER_V(zp); }
#pragma unroll
      for (int i = 0; i < 16; ++i) o[i] = z[i + 1] + m0 * (z[i] - z[i + 1]) + m1 * (z[i + 2] - z[i + 1]);
      if (!isctx) {
        const AS1 bf16_t* up = zp0 - (size_t)64 * NIN_; const AS1 bf16_t* dn = zp0 + (size_t)64 * NIN_;
#pragma unroll
        for (int i = 0; i < 16; ++i) { const float zu = uval ? bf2f(*up) : 0.f, zd = dval ? bf2f(*dn) : 0.f; up += NIN_; dn += NIN_; LAUNDER_V(up); LAUNDER_V(dn);
          o[i] += m2 * (zu - z[i + 1]) + m3 * (zd - z[i + 1]); } }
      if (g == 0) { AS1 bf16_t* rp = gptr(RR) + (size_t)tok0 * 256 + tid;
#pragma unroll
        for (int i = 0; i < 16; ++i) { *rp = f2bf(o[i]); rp += 256; LAUNDER_V(rp); }
      } else if (g == 1) { AS1 bf16_t* kp = gptr(KKb) + (size_t)tok0 * 256 + tid; AS1 bf16_t* krp = gptr(KRW) + (size_t)tok0 * 256 + tid;
#pragma unroll
        for (int i = 0; i < 16; ++i) { const float kq = o[i] * kkw, nrm = sqrtf(wave_sum(kq * kq));
          *kp = f2bf(kq / fmaxf(nrm, 1e-12f)); *krp = f2bf(o[i]); kp += 256; krp += 256; LAUNDER_V(kp); LAUNDER_V(krp); }
      } else if (g == 2) { AS1 bf16_t* vp2 = gptr(VV) + (size_t)tok0 * 256 + tid;
#pragma unroll
        for (int i = 0; i < 16; ++i) { *vp2 = f2bf(o[i]); vp2 += 256; LAUNDER_V(vp2); }
      } else if (g == 3) { AS1 bf16_t* lp = gptr(LIg) + (size_t)tok0 * 384 + tid;
#pragma unroll
        for (int i = 0; i < 16; ++i) { *lp = f2bf(tid < 128 ? tanhf(o[i]) : o[i]); lp += 384; LAUNDER_V(lp); }
      } else if (act) { AS1 bf16_t* lp = gptr(LIg) + (size_t)tok0 * 384 + 256 + tid;
#pragma unroll
        for (int i = 0; i < 16; ++i) { *lp = f2bf(sigmoidf_(o[i])); lp += 384; LAUNDER_V(lp); }
      }
    }
    __syncthreads();
    { const int d = tid >> 7, c = tid & 127; const float* gu = INP(I_GU) + ((size_t)l * 2 + d) * 16 * 128; const float gb = INP(I_GB)[((size_t)l * 2 + d) * 128 + c];
      float guw[16];
#pragma unroll
      for (int i = 0; i < 16; ++i) guw[i] = gu[i * 128 + c];
#pragma unroll 4
      for (int tt = 0; tt < 16; ++tt) { float sacc = gb;
#pragma unroll
        for (int i = 0; i < 16; ++i) sacc += gdl[tt * 32 + d * 16 + i] * guw[i];
        LA[((size_t)d * NT_ + tok0 + tt) * 128 + c] = logsigmoidf_(sacc) * (1.f / 16.f); } }
  }
}

DEVFN void phase3b(const Params& p, int l, unsigned char* smem) {
  const bf16_t* LIg = (const bf16_t*)(p.ws + Ws::LI);
  const bf16_t* lora = (const bf16_t*)(p.ws + Ws::LORA) + (size_t)l * 98304;
  const bf16_t* KRg = (const bf16_t*)(p.ws + Ws::KRW); const bf16_t* KKg = (const bf16_t*)(p.ws + Ws::KK);
  float* LWp = (float*)(p.ws + Ws::LW); bf16_t* KD = (bf16_t*)(p.ws + Ws::KD); bf16_t* BD = (bf16_t*)(p.ws + Ws::BD); float* GATE = (float*)(p.ws + Ws::GATE);
  for (int u = BIDX; u < (NT_ / 128) * 10; u += gridDim.x) {
    const int rt = u / 10, which = (u % 10) >> 1, ct = u & 1;
    const int K = which < 4 ? 64 : 128, acol = which < 4 ? which * 64 : 256;
    const bf16_t* wb = which < 2 ? lora + (size_t)which * 16384 : which < 4 ? lora + 32768 + (size_t)(which - 2) * 16384 : lora + 65536;
    const float* bias = which < 2 ? INP(I_W0) + (size_t)l * 512 + which * 256 : INP(I_A0) + (size_t)l * 512 + (which & 1) * 256;
    const float* kav = INP(I_KAW) + (size_t)l * 256;
    gemm_tile(smem, K,
      [&](int r) { return LIg + (size_t)(rt * 128 + r) * 384 + acol; },
      [&](int r) { return wb + (size_t)(ct * 128 + r) * K; },
      [&](f32x4 (&acc)[4][4], int wr, int wc, int g, int l15) {
        const int tid = TIDX;
        if (which == 2 || which == 3) {
          bf16_t* T = (bf16_t*)smem; constexpr int LDC = 136;
          __syncthreads();
#pragma unroll
          for (int ni = 0; ni < 4; ++ni) { const int cl = wc * 64 + ni * 16 + l15; const float bv = bias[ct * 128 + cl];
#pragma unroll
            for (int mi = 0; mi < 4; ++mi)
#pragma unroll
              for (int i = 0; i < 4; ++i) T[(wr * 64 + mi * 16 + 4 * g + i) * LDC + cl] = f2bf(sigmoidf_(acc[mi][ni][i] + bv)); }
          __syncthreads();
          const int c = tid & 15, col0 = ct * 128 + c * 8;
          float ka[8];
#pragma unroll
          for (int j = 0; j < 8; ++j) ka[j] = kav[col0 + j];
          const size_t dofs = (size_t)(which - 2) * NT_ * 256;
#pragma unroll
          for (int pass = 0; pass < 8; ++pass) { const int row = (tid >> 4) + 16 * pass; const size_t o = (size_t)(rt * 128 + row) * 256 + col0;
            const bf16x8 a8 = *(const bf16x8*)(T + row * LDC + c * 8), kr8 = ld8g(KRg + o), kk8 = ld8g(KKg + o);
            bf16x8 kd8, bd8;
#pragma unroll
            for (int j = 0; j < 8; ++j) { const float a = bf2f((bf16_t)a8[j]); kd8[j] = (short)f2bf(bf2f((bf16_t)kr8[j]) * (1.f + (a - 1.f) * ka[j])); bd8[j] = (short)f2bf(bf2f((bf16_t)kk8[j]) * a); }
            *(AS1 bf16x8*)gptr(KD + dofs + o) = kd8; *(AS1 bf16x8*)gptr(BD + dofs + o) = bd8; }
        } else {
          float* T = (float*)smem; constexpr int LDC = 132;
          float* dst = which < 2 ? LWp + (size_t)which * NT_ * 256 : GATE;
#pragma unroll 1
          for (int h = 0; h < 2; ++h) {
            __syncthreads();
            if (wr == h) {
#pragma unroll
              for (int ni = 0; ni < 4; ++ni) { const int cl = wc * 64 + ni * 16 + l15; const float bv = which < 2 ? bias[ct * 128 + cl] : 0.f;
#pragma unroll
                for (int mi = 0; mi < 4; ++mi)
#pragma unroll
                  for (int i = 0; i < 4; ++i) { const float v = acc[mi][ni][i]; T[(mi * 16 + 4 * g + i) * LDC + cl] = which < 2 ? -0.6065306597126334f * sigmoidf_(v + bv) : v; } } }
            __syncthreads();
#pragma unroll
            for (int pass = 0; pass < 8; ++pass) { const int id = tid + 256 * pass, row = id >> 5, c = id & 31;
              *(AS1 f32x4*)gptr(dst + (size_t)(rt * 128 + h * 64 + row) * 256 + ct * 128 + c * 4) = *(const f32x4*)(T + row * LDC + c * 4); } }
        }
      });
  }
}

DEVFN bf16x8 ld8(const bf16_t* p) { return *(const bf16x8*)p; }
typedef short bf16x4v __attribute__((ext_vector_type(4)));
DEVFN bf16x4v cvt4(f32x4 v) { return bf16x4v{(short)f2bf(v[0]), (short)f2bf(v[1]), (short)f2bf(v[2]), (short)f2bf(v[3])}; }
DEVFN bf16x8 cat44(bf16x4v a, bf16x4v b) { return bf16x8{a[0], a[1], a[2], a[3], b[0], b[1], b[2], b[3]}; }
DEVFN bf16x4v ld4(const bf16_t* p) { return *(const bf16x4v*)p; }
DEVFN int rm_off(int i, int k) { return i * 64 + ((((k >> 3) ^ (i & 7)) << 3) | (k & 7)); }
#define RW_WAVE_LDS 11264
DEVFN void rwkv_chunk(const Params& p, int unit_base, unsigned char* smem) {
  const int tid = TIDX, lane = tid & 63, wave = tid >> 6, q = lane >> 4, l15 = lane & 15;
  const int unit = unit_base + wave;
  const int c = unit % NC16, h = (unit / NC16) & 3, dir = (unit / (NC16 * 4)) & 1, b = unit / (NC16 * 8);
  bf16_t* big = (bf16_t*)(smem + wave * RW_WAVE_LDS);
  unsigned char* small = smem + wave * RW_WAVE_LDS + 8192;
  float* AbF = (float*)small;
  bf16_t* TN = (bf16_t*)(small + 1024);
  bf16_t* AK = TN + 256; bf16_t* RB = AK + 256; bf16_t* RK = RB + 256;
  const bf16_t* RRg = (const bf16_t*)(p.ws + Ws::RR); const bf16_t* VVg = (const bf16_t*)(p.ws + Ws::VV); const bf16_t* KKg = (const bf16_t*)(p.ws + Ws::KK);
  const bf16_t* KDg = (const bf16_t*)(p.ws + Ws::KD) + (size_t)dir * NT_ * 256; const bf16_t* BDg = (const bf16_t*)(p.ws + Ws::BD) + (size_t)dir * NT_ * 256;
  const float* LWg = (const float*)(p.ws + Ws::LW) + (size_t)dir * NT_ * 256;
  float kkm[16], vv[16], bneg[16], kneg[16];
  float run = 0.f;
  __syncthreads();
#pragma unroll
  for (int i = 0; i < 16; ++i) {
    const size_t o = (size_t)(b * T_ + tokmap(dir, c * 16 + i)) * 256 + h * 64 + lane;
    const float lw = gptr(LWg)[o], r = bf2f(gptr(RRg)[o]), k = bf2f(gptr(KDg)[o]), v = bf2f(gptr(VVg)[o]), kk = bf2f(gptr(KKg)[o]), bb = bf2f(gptr(BDg)[o]);
    const float e_ex = expf(run); run += lw; const float e_in = expf(run), e_neg = expf(-run);
    kkm[i] = kk * e_ex; vv[i] = v; bneg[i] = bb * e_neg; kneg[i] = k * e_neg;
    big[rm_off(i, lane)] = f2bf(kkm[i]); big[1024 + rm_off(i, lane)] = f2bf(r * e_in);
    big[2048 + rm_off(i, lane)] = f2bf(bneg[i]); big[3072 + rm_off(i, lane)] = f2bf(kneg[i]);
  }
  const float WC = expf(run);
  __syncthreads();
  f32x4 ab = f32x4{0.f, 0.f, 0.f, 0.f}, ak = ab, rb = ab, rk = ab;
#pragma unroll
  for (int s2 = 0; s2 < 2; ++s2) { const int ch = ((4 * s2 + q) ^ (l15 & 7)) << 3;
    const bf16x8 a_kk = ld8(big + l15 * 64 + ch), a_r = ld8(big + 1024 + l15 * 64 + ch), b_b = ld8(big + 2048 + l15 * 64 + ch), b_k = ld8(big + 3072 + l15 * 64 + ch);
    ab = MFMA16(a_kk, b_b, ab); ak = MFMA16(a_kk, b_k, ak); rb = MFMA16(a_r, b_b, rb); rk = MFMA16(a_r, b_k, rk); }
  f32x4 gacc[4];
#pragma unroll
  for (int nk = 0; nk < 4; ++nk)
#pragma unroll
    for (int r = 0; r < 4; ++r) gacc[nk][r] = bf2f(big[1024 + rm_off(4 * q + r, 16 * nk + l15)]);
  __syncthreads();
#pragma unroll
  for (int r = 0; r < 4; ++r) { const int i = 4 * q + r, j = l15;
    AbF[i * 16 + j] = j < i ? ab[r] : 0.f; AK[i * 16 + j] = f2bf(j < i ? ak[r] : 0.f);
    RB[i * 16 + j] = f2bf(j <= i ? rb[r] : 0.f); RK[i * 16 + j] = f2bf(j <= i ? rk[r] : 0.f); }
  { bf16_t* KKMT = big; bf16_t* VTT = big + 1024; bf16_t* BHT = big + 2048; bf16_t* KHT = big + 3072;
#pragma unroll
    for (int i = 0; i < 16; ++i) { KKMT[lane * 16 + i] = f2bf(kkm[i]); VTT[lane * 16 + i] = f2bf(vv[i]); BHT[lane * 16 + i] = f2bf(bneg[i] * WC); KHT[lane * 16 + i] = f2bf(kneg[i] * WC); } }
  __syncthreads();
  { float t[16];
#pragma unroll
    for (int i = 0; i < 16; ++i) { float acc = (i == l15) ? 1.f : 0.f;
#pragma unroll
      for (int j = 0; j < i; ++j) acc -= AbF[i * 16 + j] * t[j];
      t[i] = acc; }
    if (q == 0) {
#pragma unroll
      for (int i = 0; i < 16; ++i) TN[i * 16 + l15] = f2bf(-t[i]); } }
  __syncthreads();
  const size_t ci = (size_t)((b * 2 + dir) * 4 + h) * NC16 + c;
  bf16_t* MLg = (bf16_t*)(p.ws + Ws::RML) + ci * 4096; bf16_t* Ng = (bf16_t*)(p.ws + Ws::RNS) + ci * 4096;
  bf16_t* Gg = (bf16_t*)(p.ws + Ws::RG) + ci * 1024; float* Y0g = (float*)(p.ws + Ws::RY0) + ci * 1024;
  const bf16x4v a_T = ld4(TN + l15 * 16 + 4 * q), a_Ak = ld4(AK + l15 * 16 + 4 * q), a_Rb = ld4(RB + l15 * 16 + 4 * q), a_Rk = ld4(RK + l15 * 16 + 4 * q);
  const f32x4 z4 = f32x4{0.f, 0.f, 0.f, 0.f};
  bf16x4v vfr[4], qfr[4], pfr[4];
#pragma unroll
  for (int n = 0; n < 4; ++n) {
    vfr[n] = ld4(big + 1024 + (16 * n + l15) * 16 + 4 * q);
    const f32x4 akv = MFMA16K16(a_Ak, vfr[n], z4);
    qfr[n] = cvt4(MFMA16K16(a_T, cvt4(akv), z4));
    pfr[n] = cvt4(MFMA16K16(a_T, ld4(big + (16 * n + l15) * 16 + 4 * q), z4)); }
  const bf16x8 a_RbRk = cat44(a_Rb, a_Rk);
#pragma unroll
  for (int n = 0; n < 4; ++n) {
    const f32x4 g = MFMA16K16(a_Rb, pfr[n], gacc[n]);
    const f32x4 y0 = MFMA16(a_RbRk, cat44(qfr[n], vfr[n]), z4);
#pragma unroll
    for (int r = 0; r < 4; ++r) { Gg[(4 * q + r) * 64 + 16 * n + l15] = f2bf(g[r]); Y0g[(4 * q + r) * 64 + 16 * n + l15] = y0[r]; } }
#pragma unroll
  for (int mk = 0; mk < 4; ++mk) {
    const bf16x4v a_B = ld4(big + 2048 + (16 * mk + l15) * 16 + 4 * q), a_K = ld4(big + 3072 + (16 * mk + l15) * 16 + 4 * q);
    const bf16x8 a_BK = cat44(a_B, a_K);
#pragma unroll
    for (int n = 0; n < 4; ++n) {
      const f32x4 m = MFMA16K16(a_B, pfr[n], z4);
      const f32x4 nn = MFMA16(a_BK, cat44(qfr[n], vfr[n]), z4);
#pragma unroll
      for (int r = 0; r < 4; ++r) MLg[((mk * 2 + (n >> 1)) * 64 + (l15 >> 2) * 16 + 4 * q + r) * 8 + (n & 1) * 4 + (l15 & 3)] = f2bf(m[r]);
      *(bf16x4v*)(Ng + (n * 64 + lane) * 16 + mk * 4) = cvt4(nn); } }
  ((float*)(p.ws + Ws::RWC))[ci * 64 + ((lane >> 2) & 3) * 16 + (lane >> 4) * 4 + (lane & 3)] = WC;
}
struct RwStep { bf16x8 ml[4][2]; bf16x8 n[2]; f32x4 wc[4]; };
DEVFN void rw_load(RwStep& t, const bf16_t* MLg, const bf16_t* NSg, const float* WCg, int c, int lane, int q) {
#pragma unroll
  for (int mk = 0; mk < 4; ++mk) { t.ml[mk][0] = ld8g(MLg + (size_t)c * 4096 + ((mk * 2 + 0) * 64 + lane) * 8); t.ml[mk][1] = ld8g(MLg + (size_t)c * 4096 + ((mk * 2 + 1) * 64 + lane) * 8);
    t.wc[mk] = *(const AS1 f32x4*)gptr(WCg + (size_t)c * 64 + q * 16 + mk * 4); }
  t.n[0] = ld8g(NSg + (size_t)c * 4096 + lane * 16); t.n[1] = ld8g(NSg + (size_t)c * 4096 + lane * 16 + 8);
}
DEVFN void rw_step(const RwStep& t, f32x4 (&S)[4], bf16_t* NSg, int c, int q, int l15) {
  bf16x4v sb[4];
#pragma unroll
  for (int mk = 0; mk < 4; ++mk) sb[mk] = cvt4(S[mk]);
  const bf16x8 bf0 = cat44(sb[0], sb[1]), bf1 = cat44(sb[2], sb[3]);
#pragma unroll
  for (int mk = 0; mk < 4; ++mk) {
    f32x4 acc;
#pragma unroll
    for (int r = 0; r < 4; ++r) acc[r] = bf2f((bf16_t)t.n[mk >> 1][(mk & 1) * 4 + r]) + t.wc[mk][r] * S[mk][r];
    acc = MFMA16(t.ml[mk][0], bf0, acc);
    acc = MFMA16(t.ml[mk][1], bf1, acc);
    S[mk] = acc; }
#pragma unroll
  for (int mk = 0; mk < 4; ++mk) *(AS1 bf16x4v*)gptr(NSg + (size_t)c * 4096 + l15 * 64 + 16 * mk + 4 * q) = sb[mk];
}
DEVFN void rwkv_scan(const Params& p, int chain, int wave) {
  const int tid = TIDX, lane = tid & 63, q = lane >> 4, l15 = lane & 15;
  const bf16_t* MLg = (const bf16_t*)(p.ws + Ws::RML) + (size_t)chain * NC16 * 4096;
  bf16_t* NSg = (bf16_t*)(p.ws + Ws::RNS) + (size_t)chain * NC16 * 4096 + wave * 1024;
  const float* WCg = (const float*)(p.ws + Ws::RWC) + (size_t)chain * NC16 * 64;
  f32x4 S[4];
#pragma unroll
  for (int mk = 0; mk < 4; ++mk) S[mk] = f32x4{0.f, 0.f, 0.f, 0.f};
  RwStep t0, t1, t2;
#define RWC_(x) ((x) < NC16 ? (x) : NC16 - 1)
  rw_load(t0, MLg, NSg, WCg, 0, lane, q);
  rw_load(t1, MLg, NSg, WCg, RWC_(1), lane, q);
  int c = 0;
  for (; c + 2 < NC16; c += 3) {
    rw_load(t2, MLg, NSg, WCg, c + 2, lane, q);
    rw_step(t0, S, NSg, c, q, l15);
    rw_load(t0, MLg, NSg, WCg, RWC_(c + 3), lane, q);
    rw_step(t1, S, NSg, c + 1, q, l15);
    rw_load(t1, MLg, NSg, WCg, RWC_(c + 4), lane, q);
    rw_step(t2, S, NSg, c + 2, q, l15);
  }
  if (c < NC16) { rw_step(t0, S, NSg, c, q, l15); if (c + 1 < NC16) rw_step(t1, S, NSg, c + 1, q, l15); }
#undef RWC_
}
DEVFN void rwkv_out(const Params& p, int unit_base) {
  const int tid = TIDX, lane = tid & 63, wave = tid >> 6, q = lane >> 4, l15 = lane & 15;
  const int unit = unit_base + wave;
  const int c = unit % NC16, h = (unit / NC16) & 3, dir = (unit / (NC16 * 4)) & 1, b = unit / (NC16 * 8);
  const size_t ci = (size_t)((b * 2 + dir) * 4 + h) * NC16 + c;
  const bf16_t* Sg = (const bf16_t*)(p.ws + Ws::RNS) + ci * 4096; const bf16_t* Gg = (const bf16_t*)(p.ws + Ws::RG) + ci * 1024;
  const float* Y0g = (const float*)(p.ws + Ws::RY0) + ci * 1024;
  float* YR = (float*)(p.ws + Ws::YR) + (size_t)dir * NT_ * 256;
  const bf16x8 a0 = ld8g(Gg + l15 * 64 + 8 * q), a1 = ld8g(Gg + l15 * 64 + 32 + 8 * q);
#pragma unroll
  for (int n = 0; n < 4; ++n) {
    f32x4 acc;
#pragma unroll
    for (int r = 0; r < 4; ++r) acc[r] = gptr(Y0g)[(4 * q + r) * 64 + 16 * n + l15];
    acc = MFMA16(a0, ld8g(Sg + n * 1024 + l15 * 64 + 8 * q), acc);
    acc = MFMA16(a1, ld8g(Sg + n * 1024 + l15 * 64 + 32 + 8 * q), acc);
#pragma unroll
    for (int r = 0; r < 4; ++r) YR[(size_t)(b * T_ + tokmap(dir, c * 16 + 4 * q + r)) * 256 + h * 64 + 16 * n + l15] = acc[r]; }
}
DEVFN int cscan(int dir, int co, int nctx, int nc) { return dir == 0 ? co : (co < nctx ? nctx - 1 - co : 2 * nctx + nc - 1 - co); }
DEVFN bf16x8 ld4x2g(const bf16_t* p0, const bf16_t* p1) { bf16x4v a = *(const AS1 bf16x4v*)gptr(p0), b = *(const AS1 bf16x4v*)gptr(p1); return bf16x8{a[0], a[1], a[2], a[3], b[0], b[1], b[2], b[3]}; }
DEVFN bf16x8 ld4x2(const bf16_t* p0, const bf16_t* p1) { bf16x4v a = *(const bf16x4v*)p0, b = *(const bf16x4v*)p1; return bf16x8{a[0], a[1], a[2], a[3], b[0], b[1], b[2], b[3]}; }

DEVFN void ssd_chunk_scalars(const Params& p, int l, int b, int co, int h, float* f) {
  const int tid = TIDX, d = tid >> 7, j = tid & 127;
  const float* DTB = (const float*)(p.ws + Ws::DTB);
  const float nega = -expf(INP(I_ALOG)[(size_t)l * 16 + d * 8 + h]);
  const float dt = DTB[(size_t)(b * T_ + co * 128 + j) * 16 + d * 8 + h];
  __syncthreads();
  f[256 + d * 128 + j] = dt;
  float* cur = f + d * 128; float* tmp = f + 512 + d * 128;
  cur[j] = dt * nega;
  __syncthreads();
  for (int off = 1; off < 128; off <<= 1) {
    float v = cur[j] + (j >= off ? cur[j - off] : 0.f);
    tmp[j] = v;
    __syncthreads();
    cur[j] = tmp[j];
    __syncthreads();
  }
}
DEVFN void ssd_states(const Params& p, int l, int unit, unsigned char* smem) {
  const int tid = TIDX, lane = tid & 63, wave = tid >> 6, q = lane >> 4, l15 = lane & 15;
  const int h = unit & 7, co = (unit >> 3) % NC128, b = unit / (8 * NC128), grp = h >> 2;
  float* f = (float*)smem;
  ssd_chunk_scalars(p, l, b, co, h, f);
  { const int d = tid >> 7, j = tid & 127; const float* cum = f + d * 128; const float dt = f[256 + d * 128 + j];
    float w = d == 0 ? expf(cum[127] - cum[j]) * dt : expf(j > 0 ? cum[j - 1] : 0.f) * dt;
    f[512 + d * 128 + j] = w; }
  __syncthreads();
  const bf16_t* XT = (const bf16_t*)(p.ws + Ws::XBCT) + (size_t)(b * NC128 + co) * 768 * 128;
  f32x4 acc[2][8];
#pragma unroll
  for (int d = 0; d < 2; ++d)
#pragma unroll
    for (int n = 0; n < 8; ++n) acc[d][n] = f32x4{0.f, 0.f, 0.f, 0.f};
#pragma unroll 1
  for (int s4 = 0; s4 < 4; ++s4) {
    const int j0 = s4 * 32 + q * 8;
    bf16x8 xa = ld8g(XT + (size_t)(h * 64 + wave * 16 + l15) * 128 + j0), a0, a1;
#pragma unroll
    for (int jj = 0; jj < 8; ++jj) { float x = bf2f((bf16_t)xa[jj]); a0[jj] = (short)f2bf(x * f[512 + j0 + jj]); a1[jj] = (short)f2bf(x * f[640 + j0 + jj]); }
#pragma unroll
    for (int n = 0; n < 8; ++n) { bf16x8 bb = ld8g(XT + (size_t)(512 + grp * 128 + n * 16 + l15) * 128 + j0);
      acc[0][n] = MFMA16(a0, bb, acc[0][n]); acc[1][n] = MFMA16(a1, bb, acc[1][n]); }
  }
#pragma unroll
  for (int d = 0; d < 2; ++d) {
    const int cs = cscan(d, co, CTX_ / 128, SEQ_ / 128);
    float* ST = (float*)(p.ws + Ws::SST) + ((size_t)((d * B_ + b) * NC128 + cs) * 8 + h) * 8192;
#pragma unroll
    for (int n = 0; n < 8; ++n)
#pragma unroll
      for (int r = 0; r < 4; ++r) ST[(wave * 16 + q * 4 + r) * 128 + n * 16 + l15] = acc[d][n][r];
    if (tid == 0) ((float*)(p.ws + Ws::SCD))[((size_t)(d * B_ + b) * NC128 + cs) * 8 + h] = expf(f[d * 128 + 127]);
  }
}
#define SSD_SB ((NC128 % 17) == 0 ? 17 : NC128)
DEVFN void ssd_scan(const Params& p, int gtid, int gthreads) {
  const float* __restrict__ ST = (const float*)(p.ws + Ws::SST); const float* __restrict__ CD = (const float*)(p.ws + Ws::SCD); bf16_t* __restrict__ HIN = (bf16_t*)(p.ws + Ws::HIN);
  for (int e = gtid; e < 2 * B_ * 8 * 8192; e += gthreads) {
    const int pd = e & 8191, h = (e >> 13) & 7, db = e >> 16;
    float hv = 0.f;
#pragma unroll 1
    for (int c0 = 0; c0 < NC128; c0 += SSD_SB) {
      float st[SSD_SB], cd[SSD_SB];
#pragma unroll
      for (int i = 0; i < SSD_SB; ++i) { st[i] = ST[((size_t)(db * NC128 + c0 + i) * 8 + h) * 8192 + pd]; cd[i] = CD[(size_t)(db * NC128 + c0 + i) * 8 + h]; }
#pragma unroll
      for (int i = 0; i < SSD_SB; ++i) { HIN[((size_t)(db * NC128 + c0 + i) * 8 + h) * 8192 + pd] = f2bf(hv); hv = hv * cd[i] + st[i]; }
    }
  }
}
DEVFN void ssd_out(const Params& p, int l, int unit, unsigned char* smem) {
  const int tid = TIDX, lane = tid & 63, wave = tid >> 6, q = lane >> 4, l15 = lane & 15;
  const int h = unit & 7, co = (unit >> 3) % NC128, b = unit / (8 * NC128), grp = h >> 2;
  float* f = (float*)smem;
  ssd_chunk_scalars(p, l, b, co, h, f);
  if (tid < 128) f[640 + tid] = f[128 + 127] - (tid > 0 ? f[128 + tid - 1] : 0.f);
  __syncthreads();
  const float* cum0 = f; const float* suf1 = f + 640; const float* dt0 = f + 256; const float* dt1 = f + 384;
  const bf16_t* XBC = (const bf16_t*)(p.ws + Ws::XBC) + (size_t)(b * T_ + co * 128) * 1024;
  const bf16_t* XT = (const bf16_t*)(p.ws + Ws::XBCT) + (size_t)(b * NC128 + co) * 768 * 128;
  const bf16_t* Cb = XBC + (size_t)(wave * 32 + l15) * 1024 + 768 + grp * 128 + q * 8;
  f32x4 y[4][2];
  { f32x4 o0[4][2], o1[4][2];
#pragma unroll
    for (int mp = 0; mp < 4; ++mp)
#pragma unroll
      for (int ni = 0; ni < 2; ++ni) { o0[mp][ni] = f32x4{0.f, 0.f, 0.f, 0.f}; o1[mp][ni] = f32x4{0.f, 0.f, 0.f, 0.f}; }
    const int cs0 = cscan(0, co, CTX_ / 128, SEQ_ / 128), cs1 = cscan(1, co, CTX_ / 128, SEQ_ / 128);
    const bf16_t* H0 = (const bf16_t*)(p.ws + Ws::HIN) + ((size_t)((0 * B_ + b) * NC128 + cs0) * 8 + h) * 8192;
    const bf16_t* H1 = (const bf16_t*)(p.ws + Ws::HIN) + ((size_t)((1 * B_ + b) * NC128 + cs1) * 8 + h) * 8192;
#pragma unroll 1
    for (int s4 = 0; s4 < 4; ++s4) { const bf16x8 c0 = ld8g(Cb + s4 * 32), c1 = ld8g(Cb + 16 * 1024 + s4 * 32);
#pragma unroll
      for (int mp = 0; mp < 4; ++mp) { bf16x8 h0 = ld8g(H0 + (size_t)(mp * 16 + l15) * 128 + s4 * 32 + q * 8), h1 = ld8g(H1 + (size_t)(mp * 16 + l15) * 128 + s4 * 32 + q * 8);
        o0[mp][0] = MFMA16(h0, c0, o0[mp][0]); o0[mp][1] = MFMA16(h0, c1, o0[mp][1]);
        o1[mp][0] = MFMA16(h1, c0, o1[mp][0]); o1[mp][1] = MFMA16(h1, c1, o1[mp][1]); } }
#pragma unroll
    for (int ni = 0; ni < 2; ++ni) { const int i = wave * 32 + ni * 16 + l15; const float e0 = expf(cum0[i]), e1 = expf(suf1[i]);
#pragma unroll
      for (int mp = 0; mp < 4; ++mp)
#pragma unroll
        for (int r = 0; r < 4; ++r) y[mp][ni][r] = e0 * o0[mp][ni][r] + e1 * o1[mp][ni][r]; } }
  bf16x8 mfr[4][2];
  { f32x4 g[8][2];
#pragma unroll
    for (int mj = 0; mj < 8; ++mj) { g[mj][0] = f32x4{0.f, 0.f, 0.f, 0.f}; g[mj][1] = f32x4{0.f, 0.f, 0.f, 0.f}; }
#pragma unroll 1
    for (int s4 = 0; s4 < 4; ++s4) { const bf16x8 c0 = ld8g(Cb + s4 * 32), c1 = ld8g(Cb + 16 * 1024 + s4 * 32);
#pragma unroll
      for (int mj = 0; mj < 8; ++mj) { bf16x8 bb = ld8g(XBC + (size_t)(mj * 16 + l15) * 1024 + 512 + grp * 128 + s4 * 32 + q * 8);
        g[mj][0] = MFMA16(bb, c0, g[mj][0]); g[mj][1] = MFMA16(bb, c1, g[mj][1]); } }
    const int i0 = wave * 32 + l15, i1 = i0 + 16;
    const float c0i0 = cum0[i0], s1i0 = suf1[i0], c0i1 = cum0[i1], s1i1 = suf1[i1];
#pragma unroll
    for (int mj = 0; mj < 8; ++mj)
#pragma unroll
      for (int r = 0; r < 4; ++r) { const int j = mj * 16 + q * 4 + r;
        const float cj = cum0[j], sj = suf1[j], d0 = dt0[j], d1 = dt1[j];
        const float lw0 = (j <= i0 ? expf(c0i0 - cj) * d0 : 0.f) + (j >= i0 ? expf(s1i0 - sj) * d1 : 0.f);
        const float lw1 = (j <= i1 ? expf(c0i1 - cj) * d0 : 0.f) + (j >= i1 ? expf(s1i1 - sj) * d1 : 0.f);
        mfr[mj >> 1][0][(mj & 1) * 4 + r] = (short)f2bf(g[mj][0][r] * lw0);
        mfr[mj >> 1][1][(mj & 1) * 4 + r] = (short)f2bf(g[mj][1][r] * lw1); } }
#pragma unroll
  for (int s4 = 0; s4 < 4; ++s4)
#pragma unroll
    for (int mp = 0; mp < 4; ++mp) { const bf16_t* xr = XT + (size_t)(h * 64 + mp * 16 + l15) * 128 + s4 * 32 + q * 4;
      bf16x8 xa = ld4x2g(xr, xr + 16);
      y[mp][0] = MFMA16(xa, mfr[s4][0], y[mp][0]); y[mp][1] = MFMA16(xa, mfr[s4][1], y[mp][1]); }
  __syncthreads();
  float* yl = f + 1024;
#pragma unroll
  for (int mp = 0; mp < 4; ++mp)
#pragma unroll
    for (int ni = 0; ni < 2; ++ni)
#pragma unroll
      for (int r = 0; r < 4; ++r) yl[(wave * 32 + ni * 16 + l15) * 65 + mp * 16 + q * 4 + r] = y[mp][ni][r];
  __syncthreads();
  float* YS = (float*)(p.ws + Ws::YS) + (size_t)(b * T_ + co * 128) * 512 + h * 64;
  for (int e = tid; e < 128 * 64; e += 256) YS[(size_t)(e >> 6) * 512 + (e & 63)] = yl[(e >> 6) * 65 + (e & 63)];
}

#define GQ_LD 40
#define GK_LD 72
DEVFN void gla_chunk(const Params& p, int unit, unsigned char* smem) {
  const int tid = TIDX, lane = tid & 63, wave = tid >> 6, q = lane >> 4, l15 = lane & 15;
  const int h = unit & 3, co = (unit >> 2) % NC64, b = unit / (4 * NC64);
  const bf16_t* ZX = (const bf16_t*)(p.ws + Ws::ZX) + (size_t)(b * T_ + co * 64) * NIN_;
  const float* LA = (const float*)(p.ws + Ws::LA);
  float* cum = (float*)smem;
  bf16_t* qs = (bf16_t*)(smem + 16384);
  bf16_t* ks = qs + 2 * 64 * GQ_LD;
  bf16_t* kt = ks + 2 * 64 * GQ_LD;
  __syncthreads();
  for (int e = tid; e < 2 * 64 * 32; e += 256) { const int d = e >> 11, i = (e >> 5) & 63, dd = e & 31;
    cum[e] = LA[((size_t)d * NT_ + b * T_ + co * 64 + i) * 128 + h * 32 + dd]; }
  __syncthreads();
  if (tid < 64) { const int d = tid >> 5, dd = tid & 31; float* c = cum + d * 2048 + dd; float sacc = 0.f;
    if (d == 0) for (int i = 0; i < 64; ++i) { sacc += c[i * 32]; c[i * 32] = sacc; }
    else for (int i = 63; i >= 0; --i) { sacc += c[i * 32]; c[i * 32] = sacc; } }
  __syncthreads();
  bf16_t* QT = (bf16_t*)(p.ws + Ws::QT);
  for (int e = tid; e < 64 * 32; e += 256) { const int i = e >> 5, dd = e & 31;
    const float qv = bf2f(ZX[(size_t)i * NIN_ + OGQ + h * 32 + dd]) * 0.17677669529663687f, kv = bf2f(ZX[(size_t)i * NIN_ + OGK + h * 32 + dd]);
    const float c0 = cum[i * 32 + dd], c1 = cum[2048 + i * 32 + dd], t0 = cum[63 * 32 + dd], t1 = cum[2048 + dd];
    const bf16_t q0 = f2bf(qv * expf(c0)), q1 = f2bf(qv * expf(c1));
    qs[i * GQ_LD + dd] = q0; qs[64 * GQ_LD + i * GQ_LD + dd] = q1;
    ks[i * GQ_LD + dd] = f2bf(kv * expf(-c0)); ks[64 * GQ_LD + i * GQ_LD + dd] = f2bf(kv * expf(-c1));
    kt[dd * GK_LD + i] = f2bf(kv * expf(t0 - c0)); kt[32 * GK_LD + dd * GK_LD + i] = f2bf(kv * expf(t1 - c1));
    const size_t tok = (size_t)b * T_ + co * 64 + i;
    QT[tok * 128 + h * 32 + dd] = q0; QT[((size_t)NT_ + tok) * 128 + h * 32 + dd] = q1; }
  if (tid < 64) { const int d = tid >> 5, dd = tid & 31; const int cs = cscan(d, co, CTX_ / 64, SEQ_ / 64);
    ((float*)(p.ws + Ws::GCD))[(((size_t)(d * B_ + b) * NC64 + cs) * 4 + h) * 32 + dd] = expf(d == 0 ? cum[63 * 32 + dd] : cum[2048 + dd]); }
  __syncthreads();
  bf16x8 pfr[2];
  { f32x4 p0[4], p1[4];
    const bf16x8 qb0 = ld8(qs + (wave * 16 + l15) * GQ_LD + q * 8), qb1 = ld8(qs + 64 * GQ_LD + (wave * 16 + l15) * GQ_LD + q * 8);
#pragma unroll
    for (int mj = 0; mj < 4; ++mj) { p0[mj] = MFMA16(ld8(ks + (mj * 16 + l15) * GQ_LD + q * 8), qb0, (f32x4{0.f, 0.f, 0.f, 0.f}));
      p1[mj] = MFMA16(ld8(ks + 64 * GQ_LD + (mj * 16 + l15) * GQ_LD + q * 8), qb1, (f32x4{0.f, 0.f, 0.f, 0.f})); }
    const int i = wave * 16 + l15;
#pragma unroll
    for (int mj = 0; mj < 4; ++mj)
#pragma unroll
      for (int r = 0; r < 4; ++r) { const int j = mj * 16 + q * 4 + r; pfr[mj >> 1][(mj & 1) * 4 + r] = (short)f2bf((j <= i ? p0[mj][r] : 0.f) + (j >= i ? p1[mj][r] : 0.f)); } }
  const bf16_t* VT = (const bf16_t*)(p.ws + Ws::VT) + ((size_t)(b * NC64 + co) * 256 + h * 64) * 64;
  f32x4 o[4];
#pragma unroll
  for (int md = 0; md < 4; ++md) { o[md] = f32x4{0.f, 0.f, 0.f, 0.f};
#pragma unroll
    for (int s2 = 0; s2 < 2; ++s2) { const bf16_t* vr = VT + (size_t)(md * 16 + l15) * 64 + s2 * 32 + q * 4; o[md] = MFMA16(ld4x2g(vr, vr + 16), pfr[s2], o[md]); } }
#pragma unroll
  for (int d = 0; d < 2; ++d) { const int cs = cscan(d, co, CTX_ / 64, SEQ_ / 64);
    float* GST = (float*)(p.ws + Ws::GST) + (((size_t)(d * B_ + b) * NC64 + cs) * 4 + h) * 2048;
#pragma unroll
    for (int nd = 0; nd < 2; ++nd) { f32x4 st = f32x4{0.f, 0.f, 0.f, 0.f};
#pragma unroll
      for (int s2 = 0; s2 < 2; ++s2) st = MFMA16(ld8g(VT + (size_t)(wave * 16 + l15) * 64 + s2 * 32 + q * 8), ld8(kt + d * 32 * GK_LD + (nd * 16 + l15) * GK_LD + s2 * 32 + q * 8), st);
#pragma unroll
      for (int r = 0; r < 4; ++r) GST[(wave * 16 + q * 4 + r) * 32 + nd * 16 + l15] = st[r]; } }
  __syncthreads();
  float* ol = (float*)smem;
#pragma unroll
  for (int md = 0; md < 4; ++md)
#pragma unroll
    for (int r = 0; r < 4; ++r) ol[(wave * 16 + l15) * 65 + md * 16 + q * 4 + r] = o[md][r];
  __syncthreads();
  float* OI = (float*)(p.ws + Ws::OI) + (size_t)(b * T_ + co * 64) * 256 + h * 64;
  for (int e = tid; e < 64 * 64; e += 256) OI[(size_t)(e >> 6) * 256 + (e & 63)] = ol[(e >> 6) * 65 + (e & 63)];
}
#define GLA_SB ((NC64 % 17) == 0 ? 17 : NC64)
DEVFN void gla_scan(const Params& p, int gtid, int gthreads) {
  const float* __restrict__ ST = (const float*)(p.ws + Ws::GST); const float* __restrict__ CD = (const float*)(p.ws + Ws::GCD); bf16_t* __restrict__ SIN = (bf16_t*)(p.ws + Ws::GSIN);
  for (int e = gtid; e < 2 * B_ * 4 * 2048; e += gthreads) {
    const int vd = e & 2047, h = (e >> 11) & 3, db = e >> 13;
    float sv = 0.f;
#pragma unroll 1
    for (int c0 = 0; c0 < NC64; c0 += GLA_SB) {
      float st[GLA_SB], cd[GLA_SB];
#pragma unroll
      for (int i = 0; i < GLA_SB; ++i) { st[i] = ST[(((size_t)db * NC64 + c0 + i) * 4 + h) * 2048 + vd]; cd[i] = CD[(((size_t)db * NC64 + c0 + i) * 4 + h) * 32 + (vd & 31)]; }
#pragma unroll
      for (int i = 0; i < GLA_SB; ++i) { SIN[(((size_t)db * NC64 + c0 + i) * 4 + h) * 2048 + vd] = f2bf(sv); sv = sv * cd[i] + st[i]; }
    }
  }
}
DEVFN void convert_moe_weights(const Params& p, int l, unsigned char* smem, int bid, int nb);
DEVFN void phase4a(const Params& p, int l, unsigned char* smem) {
  const int n_r = B_ * 8 * NC16 / 4;
  for (int u = BIDX; u < n_r; u += gridDim.x) rwkv_chunk(p, (u) * 4, smem);
  (void)l;
}
DEVFN void phase4b(const Params& p, int l, unsigned char* smem) {
  const int bid = BIDX, nrw = B_ * 8, G = (int)gridDim.x;
  const int n_s = B_ * NC128 * 8, n_g = B_ * NC64 * 4;
  int ob = bid, on = G;
  if (G >= 8 * nrw) {
    if (bid < 4 * nrw) { if ((TIDX >> 6) == 0) rwkv_scan(p, bid >> 2, bid & 3); return; }
    ob = bid - 4 * nrw; on = G - 4 * nrw; }
  else { for (int u = bid; u < nrw; u += G) rwkv_scan(p, u, TIDX >> 6); }
  for (int u = ob; u < n_s + n_g; u += on) { if (u < n_s) ssd_states(p, l, u, smem); else gla_chunk(p, u - n_s, smem); }
  convert_moe_weights(p, l, smem, ob, on);
}
DEVFN void phase4b2(const Params& p) {
  const int bid = BIDX, G = (int)gridDim.x;
  ssd_scan(p, bid * 256 + TIDX, G * 256); gla_scan(p, bid * 256 + TIDX, G * 256);
}
DEVFN void phase4c(const Params& p, int l, unsigned char* smem) {
  const int n_s = B_ * NC128 * 8, n_r = B_ * 8 * NC16 / 4;
  for (int u = BIDX; u < n_s + n_r; u += gridDim.x) { if (u < n_s) ssd_out(p, l, u, smem); else rwkv_out(p, (u - n_s) * 4); }
}

DEVFN void phase5(const Params& p, int l, unsigned char* smem) {
  const int tid = TIDX, lane = tid & 63, wave = tid >> 6;
  const bf16_t* ZX = (const bf16_t*)(p.ws + Ws::ZX);
  const bf16_t* XBC = (const bf16_t*)(p.ws + Ws::XBC);
  const float* YS = (const float*)(p.ws + Ws::YS); const float* YR = (const float*)(p.ws + Ws::YR); const float* OI = (const float*)(p.ws + Ws::OI);
  const bf16_t* QT = (const bf16_t*)(p.ws + Ws::QT); const bf16_t* GSIN = (const bf16_t*)(p.ws + Ws::GSIN);
  const bf16_t* RR = (const bf16_t*)(p.ws + Ws::RR); const bf16_t* VV = (const bf16_t*)(p.ws + Ws::VV); const bf16_t* KD = (const bf16_t*)(p.ws + Ws::KD);
  const float* GATE = (const float*)(p.ws + Ws::GATE);
  bf16_t* YM = (bf16_t*)(p.ws + Ws::YMIX);
  float* red = (float*)smem;
  float* qt = red + 16;
  const float dA = INP(I_SSDD)[(size_t)l * 8 + (tid >> 6)], dB = INP(I_SSDD)[(size_t)l * 8 + 4 + (tid >> 6)];
  const float nwA = INP(I_SSDNW)[(size_t)l * 512 + tid], nwB = INP(I_SSDNW)[(size_t)l * 512 + 256 + tid];
  const float lnw = INP(I_LNXW)[(size_t)l * 256 + tid], lnb = INP(I_LNXB)[(size_t)l * 256 + tid], rk = INP(I_RK)[(size_t)l * 256 + tid];
  const float gnw = INP(I_GNW)[(size_t)l * 256 + tid];
  const int per_ = (NT_ / 2 + (int)gridDim.x - 1) / (int)gridDim.x, tp_lo = BIDX * per_, tp_hi = (tp_lo + per_ < NT_ / 2) ? tp_lo + per_ : NT_ / 2;
  for (int tp = tp_lo; tp < tp_hi; ++tp) {
    float ys0[2], ys1[2], x0[2], x1[2], z0[2], z1[2], og[2], yr[2], rr[2], kf[2], kb[2], vv[2], gt[2], oi[2], qv[2];
    bf16x8 gs[2][2][4];
#pragma unroll
    for (int t = 0; t < 2; ++t) { const int tok = tp * 2 + t; const int b = tok / T_, co = (tok % T_) / 64;
      ys0[t] = gptr(YS)[(size_t)tok * 512 + tid]; ys1[t] = gptr(YS)[(size_t)tok * 512 + 256 + tid];
      x0[t] = bf2f(gptr(XBC)[(size_t)tok * 1024 + tid]); x1[t] = bf2f(gptr(XBC)[(size_t)tok * 1024 + 256 + tid]);
      z0[t] = zxv(ZX, tok, OZ + tid); z1[t] = zxv(ZX, tok, OZ + 256 + tid); og[t] = zxv(ZX, tok, OOG + tid);
      yr[t] = gptr(YR)[(size_t)tok * 256 + tid] + gptr(YR)[((size_t)NT_ + tok) * 256 + tid];
      rr[t] = bf2f(gptr(RR)[(size_t)tok * 256 + tid]); kf[t] = bf2f(gptr(KD)[(size_t)tok * 256 + tid]); kb[t] = bf2f(gptr(KD)[((size_t)NT_ + tok) * 256 + tid]);
      vv[t] = bf2f(gptr(VV)[(size_t)tok * 256 + tid]); gt[t] = gptr(GATE)[(size_t)tok * 256 + tid]; oi[t] = gptr(OI)[(size_t)tok * 256 + tid];
      qv[t] = bf2f(gptr(QT)[((size_t)(tid >> 7) * NT_ + tok) * 128 + (tid & 127)]);
#pragma unroll
      for (int d = 0; d < 2; ++d) { const int cs = cscan(d, co, CTX_ / 64, SEQ_ / 64);
        const bf16_t* sr = GSIN + ((((size_t)(d * B_ + b) * NC64 + cs) * 4 + wave) * 64 + lane) * 32;
#pragma unroll
        for (int c8 = 0; c8 < 4; ++c8) gs[t][d][c8] = ld8g(sr + c8 * 8); } }
    float ya[2], yb[2], qa[2], qb[2];
#pragma unroll
    for (int t = 0; t < 2; ++t) {
      ya[t] = (ys0[t] + dA * x0[t]) * siluf_(z0[t]); yb[t] = (ys1[t] + dB * x1[t]) * siluf_(z1[t]);
      qa[t] = wave_sum(ya[t] * ya[t]); qb[t] = wave_sum(yb[t] * yb[t]); }
    __syncthreads();
#pragma unroll
    for (int t = 0; t < 2; ++t) {
      if (lane == 0) { red[t * 8 + wave] = qa[t]; red[t * 8 + 4 + wave] = qb[t]; }
      qt[t * 256 + tid] = qv[t]; }
    __syncthreads();
#pragma unroll
    for (int t = 0; t < 2; ++t) { const int tok = tp * 2 + t;
      const float* rd = red + t * 8; const float* qtt = qt + t * 256;
      float ma = (rd[0] + rd[1] + rd[2] + rd[3]) * (1.f / 256.f), mb = (rd[4] + rd[5] + rd[6] + rd[7]) * (1.f / 256.f);
      YM[(size_t)tok * 1024 + tid] = f2bf(ya[t] * rsqrtf(ma + 1e-5f) * nwA);
      YM[(size_t)tok * 1024 + 256 + tid] = f2bf(yb[t] * rsqrtf(mb + 1e-5f) * nwB);
      { const float y = yr[t];
        float mu = wave_sum(y) * (1.f / 64.f), d = y - mu, var = wave_sum(d * d) * (1.f / 64.f);
        float yn = d * rsqrtf(var + 64e-5f) * lnw + lnb;
        float bonus = wave_sum(rr[t] * (kf[t] + kb[t]) * rk) * vv[t];
        YM[(size_t)tok * 1024 + 512 + tid] = f2bf((yn + bonus) * gt[t]); }
      { float o = oi[t];
#pragma unroll
        for (int d = 0; d < 2; ++d)
#pragma unroll
          for (int c8 = 0; c8 < 4; ++c8)
#pragma unroll
            for (int jj = 0; jj < 8; ++jj) o += qtt[d * 128 + wave * 32 + c8 * 8 + jj] * bf2f((bf16_t)gs[t][d][c8][jj]);
        float ms = wave_sum(o * o) * (1.f / 64.f);
        YM[(size_t)tok * 1024 + 768 + tid] = f2bf(o * rsqrtf(ms + 1e-5f) * gnw * siluf_(og[t])); } }
  }
}

DEVFN void phase6(const Params& p, int l, unsigned char* smem) {
  const bf16_t* A = (const bf16_t*)(p.ws + Ws::YMIX);
  const bf16_t* W = (const bf16_t*)(p.ws + Ws::WOUT) + (size_t)l * 1024 * 1024;
  float* MIX = (float*)(p.ws + Ws::MIX);
  for (int u = BIDX; u < (NT_ / 128) * 8; u += gridDim.x) {
    int rt = u / 8, ct = u % 8;
    gemm_tile(smem, 1024,
      [&](int r) { return A + (size_t)(rt * 128 + r) * 1024; },
      [&](int r) { return W + (size_t)(ct * 128 + r) * 1024; },
      [&](f32x4 (&acc)[4][4], int wr, int wc, int g, int l15) {
#pragma unroll
        for (int mi = 0; mi < 4; ++mi)
#pragma unroll
          for (int ni = 0; ni < 4; ++ni)
#pragma unroll
            for (int i = 0; i < 4; ++i) MIX[(size_t)(rt * 128 + wr * 64 + mi * 16 + 4 * g + i) * 1024 + ct * 128 + wc * 64 + ni * 16 + l15] = acc[mi][ni][i];
      });
  }
}

#define P7_MAXE 2048
DEVFN void phase7(const Params& p, int l, unsigned char* smem) {
  const int lane = TIDX & 63, wave = TIDX >> 6;
  float* X = (float*)(p.ws + Ws::X);
  const float* MIX = (const float*)(p.ws + Ws::MIX);
  bf16_t* H = (bf16_t*)(p.ws + Ws::U);
  const float* rwt = (const float*)(p.ws + Ws::RWT) + (size_t)l * 64 * 1024;
  int* cnt = (int*)(p.ws + Ws::CNT) + l * 64 * 64;
  int* ltok = (int*)(p.ws + Ws::LTOK); float* lwt = (float*)(p.ws + Ws::LWT);
  const float rbias = INP(I_RB)[(size_t)l * 64 + lane];
  float* hs = (float*)smem;
  float* lg = hs + 4096;
  int* lcnt = (int*)(lg + 256);
  int* lbase = lcnt + 80;
  int* etok = lbase + 64;
  int* epos = etok + P7_MAXE; float* ewt = (float*)(epos + P7_MAXE);
  for (int i = TIDX; i < 80; i += 256) lcnt[i] = 0;
  for (int tok0 = BIDX * 4; tok0 < NT_; tok0 += gridDim.x * 4) {
    const int tok = tok0 + wave;
    const float* mod = (const float*)(p.ws + Ws::MOD) + ((size_t)l * NR_ + tok_modrow(tok)) * NMOD_;
    float xv[16], mx[16], g1[16], lw[16], lb[16], sh2[16], sc2[16], mean, rstd;
    load_row16(X + (size_t)tok * 1024, lane, xv);
    load_row16(MIX + (size_t)tok * 1024, lane, mx);
    load_row16(mod + 2 * 1024, lane, g1);
    load_row16(INP(I_LN1W) + (size_t)l * 1024, lane, lw);
    load_row16(INP(I_LN1B) + (size_t)l * 1024, lane, lb);
    load_row16(mod + 3 * 1024, lane, sh2);
    load_row16(mod + 4 * 1024, lane, sc2);
#pragma unroll
    for (int i = 0; i < 16; ++i) xv[i] = ALPHA_ * xv[i] + g1[i] * mx[i];
    row_stats(xv, mean, rstd);
#pragma unroll
    for (int i = 0; i < 16; ++i) xv[i] = (xv[i] - mean) * rstd * lw[i] + lb[i];
#pragma unroll
    for (int j = 0; j < 4; ++j) *(float4*)(X + (size_t)tok * 1024 + lane * 4 + 256 * j) = make_float4(xv[4 * j], xv[4 * j + 1], xv[4 * j + 2], xv[4 * j + 3]);
    const bool routed = !(l == DEPTH_ - 1 && (tok % T_) < CTX_);
    row_stats(xv, mean, rstd);
#pragma unroll
    for (int i = 0; i < 16; ++i) xv[i] = (xv[i] - mean) * rstd * (1.f + sc2[i]) + sh2[i];
    __syncthreads();
#pragma unroll
    for (int j = 0; j < 4; ++j) {
      if (routed) *(uint2*)(H + (size_t)tok * 1024 + lane * 4 + 256 * j) = make_uint2((unsigned)f2bf(xv[4 * j]) | ((unsigned)f2bf(xv[4 * j + 1]) << 16), (unsigned)f2bf(xv[4 * j + 2]) | ((unsigned)f2bf(xv[4 * j + 3]) << 16));
      *(float4*)(hs + wave * 1024 + lane * 4 + 256 * j) = make_float4(xv[4 * j], xv[4 * j + 1], xv[4 * j + 2], xv[4 * j + 3]); }
    __syncthreads();
    { float hv[4][16];
      const int rot = BIDX & 15;
#pragma unroll
      for (int t = 0; t < 4; ++t)
#pragma unroll
        for (int j = 0; j < 4; ++j) { const float4 v = *(const float4*)(hs + t * 1024 + lane * 4 + 256 * j); hv[t][4 * j] = v.x; hv[t][4 * j + 1] = v.y; hv[t][4 * j + 2] = v.z; hv[t][4 * j + 3] = v.w; }
      float pe[64];
      const AS1 float* rw = gptr(rwt) + lane * 4;
      f32x4 w[4], wn[4];
#pragma unroll
      for (int j = 0; j < 4; ++j) w[j] = *(const AS1 f32x4*)(rw + (size_t)(16 * wave + (rot & 15)) * 1024 + 256 * j);
#pragma unroll
      for (int e = 0; e < 16; ++e) {
        if (e + 1 < 16) {
#pragma unroll
          for (int j = 0; j < 4; ++j) wn[j] = *(const AS1 f32x4*)(rw + (size_t)(16 * wave + ((e + 1 + rot) & 15)) * 1024 + 256 * j); }
#pragma unroll
        for (int t = 0; t < 4; ++t) { float s0 = 0.f, s1 = 0.f;
#pragma unroll
          for (int j = 0; j < 4; ++j) { s0 += hv[t][4 * j] * w[j][0] + hv[t][4 * j + 2] * w[j][2]; s1 += hv[t][4 * j + 1] * w[j][1] + hv[t][4 * j + 3] * w[j][3]; }
          pe[e * 4 + t] = s0 + s1; }
#pragma unroll
        for (int j = 0; j < 4; ++j) w[j] = wn[j]; }
#pragma unroll
      for (int half = 32; half >= 1; half >>= 1) { const bool up = (lane & half) != 0;
#pragma unroll
        for (int e = 0; e < half; ++e) { const float send = up ? pe[e] : pe[e + half]; const float recv = __shfl_xor(send, half); pe[e] = (up ? pe[e + half] : pe[e]) + recv; } }
      lg[(lane & 3) * 64 + 16 * wave + (((lane >> 2) + rot) & 15)] = pe[0]; }
    __syncthreads();
    if (!routed) continue;
    const float logit = lg[wave * 64 + lane];
    const float score = sigmoidf_(logit), sel = score + rbias;
    float m1 = sel; int a1 = lane;
#pragma unroll
    for (int m = 1; m <= 4; m <<= 1) { float ov = XOR8(m1, m); int oa = XOR8(a1, m); if (ov > m1 || (ov == m1 && oa < a1)) { m1 = ov; a1 = oa; } }
    float m2 = (lane == a1) ? -3.0e38f : sel;
#pragma unroll
    for (int m = 1; m <= 4; m <<= 1) m2 = fmaxf(m2, XOR8(m2, m));
    const float gs = m1 + m2; const int grp = lane >> 3;
    int grank = 0;
#pragma unroll
    for (int g2 = 0; g2 < 8; ++g2) { float og = SHFL_CONST(gs, g2 * 8); grank += (og > gs || (og == gs && g2 < grp)) ? 1 : 0; }
    const bool gsel = grank < 4;
    const float msel = gsel ? sel : -3.0e38f;
    int rank = 0;
#pragma unroll
    for (int e = 0; e < 64; ++e) { float ov = SHFL_CONST(msel, e); rank += (ov > msel || (ov == msel && e < lane)) ? 1 : 0; }
    const bool chosen = gsel && rank < 8;
    const float wsum = wave_sum(chosen ? score : 0.f);
    if (chosen) { const float wv = score / wsum * 2.5f;
      const int idx = atomicAdd(&lcnt[64], 1);
      if (idx < P7_MAXE) { const int slot = atomicAdd(&lcnt[lane], 1); etok[idx] = tok * 8 + rank; epos[idx] = lane | (slot << 8); ewt[idx] = wv; }
      else { int pos = atomicAdd(&cnt[lane * 64], 1); ltok[(size_t)lane * NT_ + pos] = tok * 8 + rank; lwt[(size_t)lane * NT_ + pos] = wv; } }
  }
  __syncthreads();
  if (TIDX < 64) { const int c = lcnt[TIDX]; lbase[TIDX] = c ? atomicAdd(&cnt[TIDX * 64], c) : 0; }
  __syncthreads();
  { const int ne = lcnt[64] < P7_MAXE ? lcnt[64] : P7_MAXE;
    for (int i = TIDX; i < ne; i += 256) { const int e = epos[i] & 255, pos = lbase[e] + (epos[i] >> 8);
      ltok[(size_t)e * NT_ + pos] = etok[i]; lwt[(size_t)e * NT_ + pos] = ewt[i]; } }
}

struct MoeMap { int nblk_total; int e; int rb; int cnt; int hoff; };
DEVFN int moe_ntok(int l) { return l == DEPTH_ - 1 ? B_ * SEQ_ : NT_; }
DEVFN int moe_shared_tok(int l, int i) { return l == DEPTH_ - 1 ? (i / SEQ_) * T_ + CTX_ + (i % SEQ_) : i; }
DEVFN void moe_prefix(const Params& p, int l, int* pre) {
  const int* cnt = (const int*)(p.ws + Ws::CNT) + l * 64 * 64;
  __syncthreads();
  if (TIDX < 64) pre[66 + TIDX] = gptr(cnt)[TIDX * 64];
  if (TIDX == 64) pre[66 + 64] = moe_ntok(l);
  __syncthreads();
  if (TIDX == 0) { int s = 0; for (int e = 0; e < 65; ++e) { pre[e] = s; s += (pre[66 + e] + 127) / 128; } pre[65] = s; }
  __syncthreads();
}
DEVFN void phase8(const Params& p, int l, unsigned char* smem) {
  int* pre = (int*)(smem + SM_PRE);
  moe_prefix(p, l, pre);
  const bf16_t* H = (const bf16_t*)(p.ws + Ws::U);
  const bf16_t* W13 = (const bf16_t*)(p.ws + Ws::W13);
  bf16_t* HID = (bf16_t*)(p.ws + Ws::HID);
  const int* ltok = (const int*)(p.ws + Ws::LTOK); const float* lwt = (const float*)(p.ws + Ws::LWT);
  const int total = pre[65];
  for (int u = BIDX; u < total * 4; u += gridDim.x) {
    const int gb = u >> 2, nt = u & 3;
    int e = 0; while (pre[e + 1] <= gb) ++e;
    const int rb = gb - pre[e], cnt = pre[66 + e];
    int* tk_s = (int*)(smem + GEMM_SMEM); float* gw_s = (float*)(tk_s + 128);
    __syncthreads();
    if (TIDX < 128) { const int pos = rb * 128 + TIDX; int tk = -1; float gw = 0.f;
      if (pos < cnt) { tk = e < 64 ? (gptr(ltok)[(size_t)e * NT_ + pos] >> 3) : moe_shared_tok(l, pos); gw = e < 64 ? gptr(lwt)[(size_t)e * NT_ + pos] : 1.f; }
      tk_s[TIDX] = tk; gw_s[TIDX] = gw; }
    __syncthreads();
    gemm_tile(smem, 1024,
      [&](int r) { const int tk = tk_s[r]; return tk >= 0 ? H + (size_t)tk * 1024 : (const bf16_t*)(p.ws + Ws::ZROW); },
      [&](int r) { return W13 + ((size_t)e * 512 + nt * 128 + r) * 1024; },
      [&](f32x4 (&acc)[4][4], int wr, int wc, int g, int l15) {
        tile_store_bf16<8>(smem, wr, g, l15,
          [&](bf16_t* T, int ldc) {
#pragma unroll
            for (int mi = 0; mi < 4; ++mi)
#pragma unroll
              for (int i = 0; i < 4; ++i) { const int r = wr * 64 + mi * 16 + 4 * g + i, pos = rb * 128 + r;
                const float gw = gw_s[r]; (void)pos;
#pragma unroll
                for (int j = 0; j < 2; ++j) T[r * ldc + wc * 32 + j * 16 + l15] = f2bf(siluf_(acc[mi][2 * j][i]) * acc[mi][2 * j + 1][i] * gw); } },
          [&](int row, int c0) { const int pos = rb * 128 + row; return pos < cnt ? HID + ((size_t)gb * 128 + row) * 256 + nt * 64 + c0 : (bf16_t*)nullptr; });
      });
  }
}
DEVFN void phase9(const Params& p, int l, unsigned char* smem) {
  int* pre = (int*)(smem + SM_PRE);
  moe_prefix(p, l, pre);
  const bf16_t* HID = (const bf16_t*)(p.ws + Ws::HID);
  const bf16_t* W2T = (const bf16_t*)(p.ws + Ws::W2T);
  bf16_t* YB = (bf16_t*)(p.ws + Ws::YBUF);
  const int* ltok = (const int*)(p.ws + Ws::LTOK);
  const int total = pre[65];
  for (int u = BIDX; u < total * 8; u += gridDim.x) {
    const int gb = u >> 3, nt = u & 7;
    int e = 0; while (pre[e + 1] <= gb) ++e;
    const int rb = gb - pre[e], cnt = pre[66 + e];
    int* ts_s = (int*)(smem + GEMM_SMEM);
    __syncthreads();
    if (TIDX < 128) { const int pos = rb * 128 + TIDX; int ts = -1;
      if (pos < cnt) ts = e < 64 ? gptr(ltok)[(size_t)e * NT_ + pos] : moe_shared_tok(l, pos) * 8;
      ts_s[TIDX] = ts; }
    __syncthreads();
    gemm_tile(smem, 256,
      [&](int r) { return ts_s[r] >= 0 ? HID + ((size_t)gb * 128 + r) * 256 : (const bf16_t*)(p.ws + Ws::ZROW); },
      [&](int r) { return W2T + ((size_t)e * 1024 + nt * 128 + r) * 256; },
      [&](f32x4 (&acc)[4][4], int wr, int wc, int g, int l15) {
        tile_store_bf16<16>(smem, wr, g, l15,
          [&](bf16_t* T, int ldc) {
#pragma unroll
            for (int mi = 0; mi < 4; ++mi)
#pragma unroll
              for (int ni = 0; ni < 4; ++ni)
#pragma unroll
                for (int i = 0; i < 4; ++i) T[(wr * 64 + mi * 16 + 4 * g + i) * ldc + wc * 64 + ni * 16 + l15] = f2bf(acc[mi][ni][i]); },
          [&](int row, int c0) { const int ts = ts_s[row]; if (ts < 0) return (bf16_t*)nullptr;
            const int tok = ts >> 3, slot = e < 64 ? (ts & 7) : 8;
            return YB + ((size_t)tok * NSLOT + slot) * 1024 + nt * 128 + c0; });
      });
  }
}

#define SMEM_BYTES (PH_SMEM + 2048)
#define N_PHASES (3 + 13 * DEPTH_)
__global__ void __launch_bounds__(256, 2) mega(Params p, int ph_lo, int ph_hi) {
#ifdef HIPEMU
  unsigned char* smem = hipemu::cur_smem();
#else
  unsigned char* smem = smem_dyn;
  volatile LAS unsigned* st = (volatile LAS unsigned*)(smem_dyn + SM_BAR);
  if (threadIdx.x == 0) {
    st[0] = 0u; st[1] = 0u;
    unsigned long long* tab = (unsigned long long*)(smem_dyn + SM_TAB);
#pragma unroll
    for (int i = 0; i < 40; ++i) tab[i] = (unsigned long long)p.in[i];
  }
  __syncthreads();
  XcdBarrier bar = xcd_barrier_post((unsigned*)(p.ws + Ws::BAR), st);
#define GRID_SYNC() xcd_barrier(bar)
#endif
  int ph = 0;
#ifdef ONLY_KIND
#define KIND_ON(k) ((k) == ONLY_KIND)
#else
#define KIND_ON(k) 1
#endif
#ifndef REPEAT_MASK
#define REPEAT_MASK 0u
#endif
#define RUN_PHASE(kind, code) { if (KIND_ON(kind) && ph >= ph_lo && ph < ph_hi) { \
    int nrep_ = ((REPEAT_MASK >> (kind)) & 1u) ? 2 : 1; LAUNDER(nrep_); \
    _Pragma("unroll 1") for (int rep_ = 0; rep_ < nrep_; ++rep_) { LAUNDER(p.ws); LAUNDER(p.out); code; if (rep_ + 1 < nrep_ || ph + 1 < ph_hi) { GRID_SYNC(); } } } ++ph; }
  RUN_PHASE(0, phase0(p, smem));
  RUN_PHASE(11, phase0b(p));
  for (int l = 0; l < DEPTH_; ++l) {
    RUN_PHASE(1, phase1(p, l));
    RUN_PHASE(2, phase2(p, l, smem));
    RUN_PHASE(3, phase3(p, l, smem));
    RUN_PHASE(14, phase3b(p, l, smem));
    RUN_PHASE(4, phase4a(p, l, smem));
    RUN_PHASE(12, phase4b(p, l, smem));
    RUN_PHASE(16, phase4b2(p));
    RUN_PHASE(13, phase4c(p, l, smem));
    RUN_PHASE(5, phase5(p, l, smem));
    RUN_PHASE(6, phase6(p, l, smem));
    RUN_PHASE(7, phase7(p, l, smem));
    RUN_PHASE(8, phase8(p, l, smem));
    RUN_PHASE(9, phase9(p, l, smem));
  }
  RUN_PHASE(10, phase_final(p));
}

extern "C" void kernel_launch(void* const* d_in, const int* in_sizes, int n_in, void* d_out, int out_size, void* d_ws, size_t ws_size, hipStream_t stream) {
  Params p{};
  for (int i = 0; i < 40; ++i) p.in[i] = (const float*)d_in[i];
  p.out = (float*)d_out;
  p.ws = (unsigned char*)d_ws;
  if (ws_size < Ws::END) { fprintf(stderr, "workspace too small: %zu < %zu\n", ws_size, (size_t)Ws::END); return; }
  hipMemsetAsync(d_ws, 0, Ws::ZERO_END, stream);
#ifdef HIPEMU
  int grid = 16; if (const char* e = getenv("EMU_GRID")) grid = atoi(e);
  int stop = N_PHASES; if (const char* e = getenv("EMU_STOP")) stop = atoi(e);
  if (getenv("EMU_ONE")) hipemu::launch(grid, 256, SMEM_BYTES, true, [=] { mega(p, 0, stop); });
  else for (int ph = 0; ph < stop; ++ph) hipemu::launch(grid, 256, SMEM_BYTES, false, [=] { mega(p, ph, ph + 1); });
#else
  static int grid = 0;
  if (!grid) {
    int dev = 0, cus = 0, per_cu = 0;
    hipGetDevice(&dev);
    hipDeviceGetAttribute(&cus, hipDeviceAttributeMultiprocessorCount, dev);
    hipOccupancyMaxActiveBlocksPerMultiprocessor(&per_cu, mega, 256, SMEM_BYTES);
    if (per_cu > 2) per_cu = 2;
    if (per_cu < 1) per_cu = 1;
    grid = cus * per_cu;
  }
#if N_LAUNCH_MODE == 1
  mega<<<grid, 256, SMEM_BYTES, stream>>>(p, 0, N_PHASES);
#else
  for (int ph = 0; ph < N_PHASES; ++ph) mega<<<grid, 256, SMEM_BYTES, stream>>>(p, ph, ph + 1);
#endif
#endif
}
```

```cpp
#ifndef HIPEMU
#include <hip/hip_runtime.h>
#endif
#include <stdint.h>
#include <stdio.h>

#ifndef B_
#define B_ 4
#endif
#ifndef SEQ_
#define SEQ_ 4096
#endif
#ifndef CTX_
#define CTX_ 256
#endif
#ifndef DEPTH_
#define DEPTH_ 4
#endif
#ifndef N_LAUNCH_MODE
#define N_LAUNCH_MODE 1
#endif
#define T_ (SEQ_ + CTX_)
#define NT_ (B_ * T_)
#define D_ 1024
#define NIN_ 3504
#define NMOD_ 6144
#define NR_ (B_ + 1)
#define OZ 0
#define OXBC 512
#define ODT 1536
#define ORW 1552
#define OGQ 2704
#define OGK 2832
#define OGV 2960
#define OGD 3216
#define OOG 3248
#define ALPHA_ 1.681792830507429f
#define NEXP 64
#define NSLOT 9
#define NC128 (T_ / 128)
#define NC64 (T_ / 64)
#define NC16 (T_ / 16)

#define DEVFN __device__ __forceinline__
#define LDT 72
#define GEMM_SMEM (2 * 128 * LDT * 2)
typedef unsigned short bf16_t;
#ifdef HIPEMU
#define AS1
#else
#define AS1 __attribute__((address_space(1)))
#endif
typedef unsigned u32x4 __attribute__((ext_vector_type(4)));
typedef unsigned u32x2 __attribute__((ext_vector_type(2)));

#ifdef HIPEMU
typedef emu_bf16x8 bf16x8;
typedef emu_f32x4 f32x4;
#define MFMA16(a, b, c) emu_mfma_16x16x32_bf16(a, b, c)
#define MFMA16K16(a, b, c) emu_mfma_16x16x16_bf16(a, b, c)
#define GRID_SYNC() hipemu::grid_sync()
#else
typedef short bf16x8 __attribute__((ext_vector_type(8)));
typedef float f32x4 __attribute__((ext_vector_type(4)));
#define MFMA16(a, b, c) __builtin_amdgcn_mfma_f32_16x16x32_bf16(a, b, c, 0, 0, 0)
#define MFMA16K16(a, b, c) __builtin_amdgcn_mfma_f32_16x16x16bf16_1k(a, b, c, 0, 0, 0)
#endif

DEVFN float bf2f(bf16_t h) { return __builtin_bit_cast(float, (unsigned)h << 16); }
DEVFN bf16_t f2bf(float f) { unsigned u = __builtin_bit_cast(unsigned, f); u += 0x7FFFu + ((u >> 16) & 1u); return (bf16_t)(u >> 16); }
template <class T> DEVFN AS1 T* gptr(T* q) { return (AS1 T*)q; }
DEVFN bf16x8 ld8g(const bf16_t* q) { return *(const AS1 bf16x8*)gptr(q); }
DEVFN float sigmoidf_(float x) { return 1.f / (1.f + expf(-x)); }
DEVFN float siluf_(float x) { return x / (1.f + expf(-x)); }
DEVFN float softplusf_(float x) { return x > 20.f ? x : log1pf(expf(x)); }
DEVFN float logsigmoidf_(float x) { return fminf(x, 0.f) - log1pf(expf(-fabsf(x))); }
#ifdef HIPEMU
DEVFN float wave_sum(float v) { for (int m = 32; m >= 1; m >>= 1) v += __shfl_xor(v, m); return v; }
#define SHFL_CONST(x, ln) __shfl(x, ln)
#define XOR8(x, m) __shfl_xor(x, m)
#else
template <int CTRL> DEVFN float dpp_f(float v) { return __builtin_bit_cast(float, __builtin_amdgcn_update_dpp(0, __builtin_bit_cast(int, v), CTRL, 0xF, 0xF, false)); }
template <int CTRL> DEVFN int dpp_i(int v) { return __builtin_amdgcn_update_dpp(0, v, CTRL, 0xF, 0xF, false); }
DEVFN float rdl_f(float v, int ln) { return __builtin_bit_cast(float, __builtin_amdgcn_readlane(__builtin_bit_cast(int, v), ln)); }
DEVFN float wave_sum(float v) {
  v += dpp_f<0xB1>(v);
  v += dpp_f<0x4E>(v);
  v += dpp_f<0x141>(v);
  v += dpp_f<0x140>(v);
  return (rdl_f(v, 0) + rdl_f(v, 16)) + (rdl_f(v, 32) + rdl_f(v, 48));
}
DEVFN float shfl_const_(float x, int ln) { return rdl_f(x, ln); }
DEVFN int shfl_const_(int x, int ln) { return __builtin_amdgcn_readlane(x, ln); }
#define SHFL_CONST(x, ln) shfl_const_(x, ln)
DEVFN float xor8_(float x, int m) { return m == 1 ? dpp_f<0xB1>(x) : m == 2 ? dpp_f<0x4E>(x) : dpp_f<0x141>(x); }
DEVFN int xor8_(int x, int m) { return m == 1 ? dpp_i<0xB1>(x) : m == 2 ? dpp_i<0x4E>(x) : dpp_i<0x141>(x); }
#define XOR8(x, m) xor8_(x, m)
#endif

constexpr size_t al(size_t x) { return (x + 255) & ~(size_t)255; }
struct Ws {
  static constexpr size_t BAR = 0;
  static constexpr size_t CNT = 16384;
  static constexpr size_t MOD = CNT + (size_t)DEPTH_ * 64 * 256;
  static constexpr size_t ZROW = al(MOD + (size_t)DEPTH_ * NR_ * NMOD_ * 4);
  static constexpr size_t ZERO_END = al(ZROW + 2048);
  static constexpr size_t MODP = ZERO_END;
  static constexpr size_t RWT = al(MODP + (size_t)16 * DEPTH_ * NR_ * NMOD_ * 4);
  static constexpr size_t LORA = al(RWT + (size_t)DEPTH_ * 64 * 1024 * 4);
  static constexpr size_t X = al(LORA + (size_t)DEPTH_ * 98304 * 2);
  static constexpr size_t U = al(X + (size_t)NT_ * 1024 * 4);
  static constexpr size_t YMIX = al(U + (size_t)NT_ * 1024 * 2);
  static constexpr size_t ZX = al(YMIX + (size_t)NT_ * 1024 * 2);
  static constexpr size_t MIX = ZX;
  static constexpr size_t LTOK = al(ZX + (size_t)NT_ * NIN_ * 2);
  static constexpr size_t LWT = al(LTOK + (size_t)64 * NT_ * 4);
  static constexpr size_t WIN = al(LWT + (size_t)64 * NT_ * 4);
  static constexpr size_t WOUT = al(WIN + (size_t)DEPTH_ * NIN_ * 1024 * 2);
  static constexpr size_t W13 = al(WOUT + (size_t)DEPTH_ * 1024 * 1024 * 2);
  static constexpr size_t W2T = al(W13 + (size_t)65 * 512 * 1024 * 2);
  static constexpr size_t UNI = al(W2T + (size_t)65 * 1024 * 256 * 2);
  static constexpr size_t XBC = UNI;
  static constexpr size_t XBCT = al(XBC + (size_t)NT_ * 1024 * 2);
  static constexpr size_t DTB = al(XBCT + (size_t)NT_ * 768 * 2);
  static constexpr size_t SST = al(DTB + (size_t)NT_ * 16 * 4);
  static constexpr size_t SCD = al(SST + (size_t)2 * NT_ / 128 * 8 * 8192 * 4);
  static constexpr size_t HIN = al(SCD + (size_t)2 * NT_ / 128 * 8 * 4);
  static constexpr size_t YS = SST;
  static constexpr size_t LA = al(HIN + (size_t)2 * NT_ / 128 * 8 * 8192 * 2);
  static constexpr size_t VT = al(LA + (size_t)2 * NT_ * 128 * 4);
  static constexpr size_t QT = al(VT + (size_t)NT_ * 256 * 2);
  static constexpr size_t OI = al(QT + (size_t)2 * NT_ * 128 * 2);
  static constexpr size_t GST = al(OI + (size_t)NT_ * 256 * 4);
  static constexpr size_t GCD = al(GST + (size_t)2 * NT_ / 64 * 4 * 2048 * 4);
  static constexpr size_t GSIN = al(GCD + (size_t)2 * NT_ / 64 * 4 * 32 * 4);
  static constexpr size_t RR = al(GSIN + (size_t)2 * NT_ / 64 * 4 * 2048 * 2);
  static constexpr size_t VV = RR + (size_t)NT_ * 256 * 2;
  static constexpr size_t KK = VV + (size_t)NT_ * 256 * 2;
  static constexpr size_t KD = KK + (size_t)NT_ * 256 * 2;
  static constexpr size_t BD = KD + (size_t)2 * NT_ * 256 * 2;
  static constexpr size_t LW = BD + (size_t)2 * NT_ * 256 * 2;
  static constexpr size_t GATE = LW + (size_t)2 * NT_ * 256 * 4;
  static constexpr size_t YR = GATE + (size_t)NT_ * 256 * 4;
  static constexpr size_t RML = al(YR + (size_t)2 * NT_ * 256 * 4);
  static constexpr size_t RNS = RML + (size_t)(NT_ / 16) * 8 * 4096 * 2;
  static constexpr size_t RWC = RNS + (size_t)(NT_ / 16) * 8 * 4096 * 2;
  static constexpr size_t RG = RWC + (size_t)(NT_ / 16) * 8 * 64 * 4;
  static constexpr size_t RY0 = RG + (size_t)(NT_ / 16) * 8 * 1024 * 2;
  static constexpr size_t LI = RY0 + (size_t)(NT_ / 16) * 8 * 1024 * 4;
  static constexpr size_t KRW = LI + (size_t)NT_ * 384 * 2;
  static constexpr size_t MIXER_END = KRW + (size_t)NT_ * 256 * 2;
  static constexpr size_t HID = UNI;
  static constexpr size_t YBUF = al(HID + ((size_t)NT_ * 9 + 65 * 128) * 256 * 2);
  static constexpr size_t MOE_END = YBUF + (size_t)NT_ * 9 * 1024 * 2;
  static constexpr size_t END = al(MIXER_END > MOE_END ? MIXER_END : MOE_END);
};

struct Params {
  const float* in[40];
  float* out;
  unsigned char* ws;
};
enum { I_X = 0, I_C, I_CTX, I_CCTX, I_ADAW, I_ADAB, I_WIN, I_CONVW, I_CONVB, I_DTBIAS, I_ALOG, I_SSDD, I_SSDNW, I_MU, I_W0, I_W2, I_A0, I_A2,
       I_G2, I_KKW, I_KAW, I_RK, I_LNXW, I_LNXB, I_GU, I_GB, I_GNW, I_WOUT, I_LN1W, I_LN1B, I_LN2W, I_LN2B, I_RW, I_RB, I_EW1, I_EW3, I_EW2,
       I_SW1, I_SW3, I_SW2 };

#define PH_SMEM 47104
#define SM_PRE (PH_SMEM)
#define SM_TAB (PH_SMEM + 1024)
#define SM_BAR (PH_SMEM + 2032)
#ifdef HIPEMU
#define INP(i) (p.in[i])
#define LAUNDER(x)
#define TIDX ((int)threadIdx.x)
#define BIDX ((int)blockIdx.x)
#define LAUNDER_V(x)
#else
extern __shared__ __align__(16) unsigned char smem_dyn[];
DEVFN const float* inp_lds(int i) {
  const volatile unsigned* t = (const volatile unsigned*)(smem_dyn + SM_TAB) + 2 * i;
  unsigned lo = __builtin_amdgcn_readfirstlane(t[0]), hi = __builtin_amdgcn_readfirstlane(t[1]);
  return (const float*)(((unsigned long long)hi << 32) | lo);
}
#define INP(i) inp_lds(i)
#define LAUNDER(x) asm volatile("" : "+s"(x))
DEVFN int tidx_() { int t = threadIdx.x; asm volatile("" : "+v"(t)); return t; }
DEVFN int bidx_() { int b = blockIdx.x; asm volatile("" : "+s"(b)); return b; }
#define TIDX tidx_()
#define LAUNDER_V(x) asm volatile("" : "+v"(x))
#define BIDX bidx_()
#endif
#ifndef HIPEMU
#define XB_TMO      128
#define XB_XCNT(j)  (256  + 64 * (j))
#define XB_XSUB(j)  (1280 + 64 * (j))
#define XB_XGEN(j)  (2304 + 64 * (j))
#define XB_TOP      3328
#define XB_TOPGEN   3392
#define XCD_BAR_WORDS 3456
#define XB_SPIN_CAP (1u << 22)
#define LAS __attribute__((address_space(3)))
__device__ __forceinline__ unsigned xb_ld(unsigned* p)              { return __hip_atomic_load(p, __ATOMIC_RELAXED, __HIP_MEMORY_SCOPE_AGENT); }
__device__ __forceinline__ unsigned xb_add(unsigned* p, unsigned v) { return __hip_atomic_fetch_add(p, v, __ATOMIC_RELAXED, __HIP_MEMORY_SCOPE_AGENT); }
__device__ __forceinline__ unsigned xb_xcc_id() { return (unsigned)__builtin_amdgcn_s_getreg((3 << 11) | 20) & 0xFu; }
#define XB_SPIN(cond, bar) do { unsigned _sp = 0; while (cond) { __builtin_amdgcn_s_sleep(1); \
    if ((++_sp & 255u) == 0u) { if (xb_ld(&(bar)[XB_TMO])) break; if (_sp > XB_SPIN_CAP) { atomicAdd(&(bar)[XB_TMO], 1u); break; } } } } while (0)
struct XcdBarrier { unsigned* bar; unsigned x; volatile LAS unsigned* st; };
__device__ __forceinline__ XcdBarrier xcd_barrier_post(unsigned* bar, volatile LAS unsigned* st) {
    XcdBarrier b; b.bar = bar; b.x = xb_xcc_id(); b.st = st;
    if (threadIdx.x == 0) (void)xb_add(&bar[XB_XCNT(b.x)], 1u);
    return b;
}
__device__ __forceinline__ void xcd_barrier_complete(unsigned* bar, unsigned x, unsigned& nloc, unsigned& nx) {
    const unsigned G = gridDim.x * gridDim.y * gridDim.z;
    unsigned sum, cnt, mine, sp = 0u;
    for (;;) {
        sum = 0u; cnt = 0u; mine = 0u;
#pragma unroll
        for (unsigned j = 0; j < 16; ++j) { const unsigned c = xb_ld(&bar[XB_XCNT(j)]); sum += c; cnt += (c > 0u) ? 1u : 0u; mine = (j == x) ? c : mine; }
        if (sum == G) break;
        __builtin_amdgcn_s_sleep(1);
        if ((++sp & 255u) == 0u) { if (xb_ld(&bar[XB_TMO])) break; if (sp > XB_SPIN_CAP) { atomicAdd(&bar[XB_TMO], 1u); break; } }
    }
    nloc = mine > 0u ? mine : 1u; nx = cnt > 0u ? cnt : 1u;
}
__device__ __forceinline__ void xcd_barrier(const XcdBarrier& b) {
    asm volatile("s_waitcnt vmcnt(0)" ::: "memory");
    __syncthreads();
    if (threadIdx.x == 0) {
        unsigned* bar = b.bar;
        __builtin_amdgcn_s_waitcnt(0);
        unsigned nloc = b.st[0], nx = b.st[1];
        if (nloc == 0u) { xcd_barrier_complete(bar, b.x, nloc, nx); b.st[0] = nloc; b.st[1] = nx; }
        const unsigned old = xb_add(&bar[XB_XSUB(b.x)], 1u);
        const unsigned gen = old / nloc;
        if (old + 1u == (gen + 1u) * nloc) {
            __builtin_amdgcn_fence(__ATOMIC_RELEASE, "agent");
            asm volatile("s_waitcnt vmcnt(0)" ::: "memory");
            const unsigned og = xb_add(&bar[XB_TOP], 1u);
            const unsigned tg = og / nx;
            if (og + 1u == (tg + 1u) * nx) xb_add(&bar[XB_TOPGEN], 1u);
            else XB_SPIN(xb_ld(&bar[XB_TOPGEN]) == tg, bar);
            __builtin_amdgcn_fence(__ATOMIC_ACQUIRE, "agent");
            xb_add(&bar[XB_XGEN(b.x)], 1u);
            asm volatile("s_waitcnt vmcnt(0)" ::: "memory");
        } else {
            XB_SPIN(xb_ld(&bar[XB_XGEN(b.x)]) == gen, bar);
            __builtin_amdgcn_fence(__ATOMIC_ACQUIRE, "agent");
            asm volatile("s_waitcnt vmcnt(0)" ::: "memory");
        }
    }
    __syncthreads();
}
#endif

DEVFN int tokmap(int dir, int p) { return dir == 0 ? p : (p < CTX_ ? CTX_ - 1 - p : 2 * CTX_ + SEQ_ - 1 - p); }
DEVFN const float* tok_input_row(const Params& p, int tok) {
  int b = tok / T_, t = tok % T_;
  return t < CTX_ ? INP(I_CTX) + ((size_t)b * CTX_ + t) * D_ : INP(I_X) + ((size_t)b * SEQ_ + (t - CTX_)) * D_;
}
DEVFN int tok_modrow(int tok) { return (tok % T_) < CTX_ ? B_ : tok / T_; }

template <class ARow, class BRow, class Epi>
DEVFN void gemm_tile(unsigned char* smem, int K, ARow arow, BRow brow, Epi epi) {
  bf16_t* As = (bf16_t*)smem;
  bf16_t* Bs = As + 128 * LDT;
  const int tid = TIDX, lane = tid & 63, wave = tid >> 6, wr = wave >> 1, wc = wave & 1;
  const int g = lane >> 4, l15 = lane & 15;
  const int lr = tid >> 3, lc = (tid & 7) * 8;
  const AS1 bf16_t* ap[4];
  const AS1 bf16_t* bp[4];
#pragma unroll
  for (int i = 0; i < 4; ++i) { ap[i] = gptr(arow(lr + 32 * i)); bp[i] = gptr(brow(lr + 32 * i)); }
  f32x4 acc[4][4];
#pragma unroll
  for (int mi = 0; mi < 4; ++mi)
#pragma unroll
    for (int ni = 0; ni < 4; ++ni) acc[mi][ni] = f32x4{0.f, 0.f, 0.f, 0.f};
  u32x4 ra0[4], rb0[4], ra1[4], rb1[4];
#pragma unroll
  for (int i = 0; i < 4; ++i) { ra0[i] = *(const AS1 u32x4*)(ap[i] + lc); rb0[i] = *(const AS1 u32x4*)(bp[i] + lc); }
  if (K > 64) {
#pragma unroll
    for (int i = 0; i < 4; ++i) { ra1[i] = *(const AS1 u32x4*)(ap[i] + 64 + lc); rb1[i] = *(const AS1 u32x4*)(bp[i] + 64 + lc); } }
  auto compute = [&]() {
#pragma unroll
    for (int kk = 0; kk < 2; ++kk) {
      bf16x8 af[4], bfr[4];
#pragma unroll
      for (int mi = 0; mi < 4; ++mi) af[mi] = *(const bf16x8*)(As + (wr * 64 + mi * 16 + l15) * LDT + kk * 32 + g * 8);
#pragma unroll
      for (int ni = 0; ni < 4; ++ni) bfr[ni] = *(const bf16x8*)(Bs + (wc * 64 + ni * 16 + l15) * LDT + kk * 32 + g * 8);
#pragma unroll
      for (int mi = 0; mi < 4; ++mi)
#pragma unroll
        for (int ni = 0; ni < 4; ++ni) acc[mi][ni] = MFMA16(af[mi], bfr[ni], acc[mi][ni]);
    } };
  for (int k0 = 0; k0 < K; k0 += 128) {
    __syncthreads();
#pragma unroll
    for (int i = 0; i < 4; ++i) { *(u32x4*)(As + (lr + 32 * i) * LDT + lc) = ra0[i]; *(u32x4*)(Bs + (lr + 32 * i) * LDT + lc) = rb0[i]; }
    __syncthreads();
    if (k0 + 128 < K) {
#pragma unroll
      for (int i = 0; i < 4; ++i) { ra0[i] = *(const AS1 u32x4*)(ap[i] + k0 + 128 + lc); rb0[i] = *(const AS1 u32x4*)(bp[i] + k0 + 128 + lc); } }
    compute();
    if (k0 + 64 < K) {
      __syncthreads();
#pragma unroll
      for (int i = 0; i < 4; ++i) { *(u32x4*)(As + (lr + 32 * i) * LDT + lc) = ra1[i]; *(u32x4*)(Bs + (lr + 32 * i) * LDT + lc) = rb1[i]; }
      __syncthreads();
      if (k0 + 192 < K) {
#pragma unroll
        for (int i = 0; i < 4; ++i) { ra1[i] = *(const AS1 u32x4*)(ap[i] + k0 + 192 + lc); rb1[i] = *(const AS1 u32x4*)(bp[i] + k0 + 192 + lc); } }
      compute();
    }
  }
  epi(acc, wr, wc, g, l15);
}

template <int NCH, class Val, class RowP>
DEVFN void tile_store_bf16(unsigned char* smem, int wr, int g, int l15, Val val, RowP rowp) {
  constexpr int LDC = NCH * 8 + 8;
  bf16_t* T = (bf16_t*)smem;
  const int tid = TIDX;
  __syncthreads();
  val(T, LDC);
  __syncthreads();
#pragma unroll
  for (int pass = 0; pass < NCH / 2; ++pass) { const int id = tid + 256 * pass, row = id / NCH, c = id % NCH;
    bf16_t* dst = rowp(row, c * 8);
    if (dst) *(AS1 u32x4*)gptr(dst) = *(const u32x4*)(T + row * LDC + c * 8); }
  (void)wr; (void)g; (void)l15;
}
DEVFN void cvt_tile(unsigned char* smem, const float* src, int K, int N, int k0, int n0, bf16_t* dst, int ldd, int mode) {
  float* s = (float*)smem;
  const int tid = TIDX;
  const AS1 float* gsrc = gptr(src);
  __syncthreads();
  { const int kk = tid >> 4, n4 = (tid & 15) * 4;
#pragma unroll
    for (int pass = 0; pass < 4; ++pass) { const int k = kk + 16 * pass;
      f32x4 v = f32x4{0.f, 0.f, 0.f, 0.f};
      if (n0 + n4 < N) v = *(const AS1 f32x4*)(gsrc + (size_t)(k0 + k) * N + n0 + n4);
      s[k * 65 + n4] = v[0]; s[k * 65 + n4 + 1] = v[1]; s[k * 65 + n4 + 2] = v[2]; s[k * 65 + n4 + 3] = v[3]; } }
  __syncthreads();
  { const int nn = tid >> 2, k16 = (tid & 3) * 16, n = n0 + nn;
    if (n < N) { const int row = mode == 0 ? n : ((n >> 4) * 32 + (n & 15) + (mode == 2 ? 16 : 0));
      u32x4 o0, o1;
#pragma unroll
      for (int j = 0; j < 4; ++j) { o0[j] = (unsigned)f2bf(s[(k16 + 2 * j) * 65 + nn]) | ((unsigned)f2bf(s[(k16 + 2 * j + 1) * 65 + nn]) << 16);
        o1[j] = (unsigned)f2bf(s[(k16 + 8 + 2 * j) * 65 + nn]) | ((unsigned)f2bf(s[(k16 + 9 + 2 * j) * 65 + nn]) << 16); }
      AS1 bf16_t* d = gptr(dst) + (size_t)row * ldd + k0 + k16;
      *(AS1 u32x4*)d = o0; *(AS1 u32x4*)(d + 8) = o1; } }
  (void)K;
}
struct CvtJob { const float* src; bf16_t* dst; int N, k0, n0, ldd, mode; };
DEVFN void cvt_load(const CvtJob& j, f32x4 (&v)[4]) {
  const int tid = TIDX, kk = tid >> 4, n4 = (tid & 15) * 4;
  const AS1 float* g = gptr(j.src);
#pragma unroll
  for (int pass = 0; pass < 4; ++pass) { v[pass] = f32x4{0.f, 0.f, 0.f, 0.f};
    if (j.n0 + n4 < j.N) v[pass] = *(const AS1 f32x4*)(g + (size_t)(j.k0 + kk + 16 * pass) * j.N + j.n0 + n4); }
}
DEVFN void cvt_store(unsigned char* smem, const CvtJob& j, const f32x4 (&v)[4]) {
  float* s = (float*)smem;
  const int tid = TIDX, kk = tid >> 4, n4 = (tid & 15) * 4;
  __syncthreads();
#pragma unroll
  for (int pass = 0; pass < 4; ++pass) { const int k = kk + 16 * pass; s[k * 65 + n4] = v[pass][0]; s[k * 65 + n4 + 1] = v[pass][1]; s[k * 65 + n4 + 2] = v[pass][2]; s[k * 65 + n4 + 3] = v[pass][3]; }
  __syncthreads();
  const int nn = tid >> 2, k16 = (tid & 3) * 16, n = j.n0 + nn;
  if (n < j.N) { const int row = j.mode == 0 ? n : ((n >> 4) * 32 + (n & 15) + (j.mode == 2 ? 16 : 0));
    u32x4 o0, o1;
#pragma unroll
    for (int q = 0; q < 4; ++q) { o0[q] = (unsigned)f2bf(s[(k16 + 2 * q) * 65 + nn]) | ((unsigned)f2bf(s[(k16 + 2 * q + 1) * 65 + nn]) << 16);
      o1[q] = (unsigned)f2bf(s[(k16 + 8 + 2 * q) * 65 + nn]) | ((unsigned)f2bf(s[(k16 + 9 + 2 * q) * 65 + nn]) << 16); }
    AS1 bf16_t* d = gptr(j.dst) + (size_t)row * j.ldd + j.k0 + k16;
    *(AS1 u32x4*)d = o0; *(AS1 u32x4*)(d + 8) = o1; }
}
DEVFN CvtJob moe_cvt_job(const Params& p, int l, int u) {
  bf16_t* w13 = (bf16_t*)(p.ws + Ws::W13); bf16_t* w2t = (bf16_t*)(p.ws + Ws::W2T);
  const int e = u / 192, r = u % 192, which = r / 64, t = r % 64;
  CvtJob j;
  if (which < 2) {
    j.src = e < 64 ? (which == 0 ? INP(I_EW1) : INP(I_EW3)) + ((size_t)l * 64 + e) * 1024 * 256 : (which == 0 ? INP(I_SW1) : INP(I_SW3)) + (size_t)l * 1024 * 256;
    j.N = 256; j.k0 = (t >> 2) * 64; j.n0 = (t & 3) * 64; j.dst = w13 + (size_t)e * 512 * 1024; j.ldd = 1024; j.mode = which == 0 ? 1 : 2;
  } else {
    j.src = e < 64 ? INP(I_EW2) + ((size_t)l * 64 + e) * 256 * 1024 : INP(I_SW2) + (size_t)l * 256 * 1024;
    j.N = 1024; j.k0 = (t >> 4) * 64; j.n0 = (t & 15) * 64; j.dst = w2t + (size_t)e * 1024 * 256; j.ldd = 256; j.mode = 0;
  }
  return j;
}
DEVFN void convert_moe_weights(const Params& p, int l, unsigned char* smem, int bid, int nb) {
  const int total = 65 * 192;
  if (bid >= total) return;
  f32x4 v[4], vn[4];
  CvtJob j = moe_cvt_job(p, l, bid);
  cvt_load(j, v);
  for (int u = bid; u < total; u += nb) {
    const int un = u + nb;
    CvtJob jn = j;
    if (un < total) { jn = moe_cvt_job(p, l, un); cvt_load(jn, vn); }
    cvt_store(smem, j, v);
    j = jn;
#pragma unroll
    for (int q = 0; q < 4; ++q) v[q] = vn[q];
  }
}
DEVFN void phase0(const Params& p, unsigned char* smem) {
  const int tid = TIDX;
  float* modp = (float*)(p.ws + Ws::MODP);
  for (int u = BIDX; u < DEPTH_ * 24 * 16; u += gridDim.x) {
    int l = u / (24 * 16), jb = (u / 16) % 24, ks = u % 16;
    float* sc = (float*)smem;
    __syncthreads();
    for (int e = tid; e < NR_ * 64; e += 256) { int r = e / 64, i = ks * 64 + (e % 64); float cv = r < B_ ? INP(I_C)[(size_t)r * D_ + i] : INP(I_CCTX)[i]; sc[e] = siluf_(cv); }
    __syncthreads();
    int j = jb * 256 + tid;
    float acc[NR_];
#pragma unroll
    for (int r = 0; r < NR_; ++r) acc[r] = 0.f;
    const float* w = INP(I_ADAW) + ((size_t)l * D_ + ks * 64) * NMOD_ + j;
#pragma unroll 4
    for (int i = 0; i < 64; ++i) { float wv = w[(size_t)i * NMOD_];
#pragma unroll
      for (int r = 0; r < NR_; ++r) acc[r] += sc[r * 64 + i] * wv; }
#pragma unroll
    for (int r = 0; r < NR_; ++r) modp[(((size_t)ks * DEPTH_ + l) * NR_ + r) * NMOD_ + j] = acc[r];
  }
  bf16_t* win = (bf16_t*)(p.ws + Ws::WIN);
  bf16_t* wout = (bf16_t*)(p.ws + Ws::WOUT);
  for (int u = BIDX; u < DEPTH_ * 16 * 55; u += gridDim.x) {
    int l = u / (16 * 55), r = u % (16 * 55);
    cvt_tile(smem, INP(I_WIN) + (size_t)l * 1024 * NIN_, 1024, NIN_, (r / 55) * 64, (r % 55) * 64, win + (size_t)l * NIN_ * 1024, 1024, 0);
  }
  for (int u = BIDX; u < DEPTH_ * 256; u += gridDim.x) {
    int l = u / 256, r = u % 256;
    cvt_tile(smem, INP(I_WOUT) + (size_t)l * 1024 * 1024, 1024, 1024, (r / 16) * 64, (r % 16) * 64, wout + (size_t)l * 1024 * 1024, 1024, 0);
  }
  { bf16_t* lo = (bf16_t*)(p.ws + Ws::LORA);
    for (int u = BIDX * 256 + tid; u < DEPTH_ * 98304; u += gridDim.x * 256) {
      const int l = u / 98304, r = u % 98304; float v;
      if (r < 32768) { const int d = r >> 14, n = (r >> 6) & 255, k = r & 63; v = INP(I_W2)[(((size_t)l * 2 + d) * 64 + k) * 256 + n]; }
      else if (r < 65536) { const int r2 = r - 32768, d = r2 >> 14, n = (r2 >> 6) & 255, k = r2 & 63; v = INP(I_A2)[(((size_t)l * 2 + d) * 64 + k) * 256 + n]; }
      else { const int r2 = r - 65536, n = r2 >> 7, k = r2 & 127; v = INP(I_G2)[((size_t)l * 128 + k) * 256 + n]; }
      lo[u] = f2bf(v); } }
  float* rwt = (float*)(p.ws + Ws::RWT);
  for (int u = BIDX * 256 + tid; u < DEPTH_ * 64 * 1024; u += gridDim.x * 256) {
    int l = u / (64 * 1024), e = (u / 1024) % 64, i = u % 1024;
    rwt[u] = INP(I_RW)[((size_t)l * 1024 + i) * 64 + e];
  }
}

DEVFN void phase0b(const Params& p) {
  float* mod = (float*)(p.ws + Ws::MOD); const float* modp = (const float*)(p.ws + Ws::MODP);
  for (int u = BIDX * 256 + TIDX; u < DEPTH_ * NR_ * NMOD_; u += gridDim.x * 256) {
    int l = u / (NR_ * NMOD_), j = u % NMOD_;
    float s = INP(I_ADAB)[(size_t)l * NMOD_ + j];
    for (int ks = 0; ks < 16; ++ks) s += modp[(size_t)ks * DEPTH_ * NR_ * NMOD_ + u];
    mod[u] = s;
  }
}

DEVFN void row_stats(const float (&v)[16], float& mean, float& rstd) {
  float s = 0.f;
#pragma unroll
  for (int i = 0; i < 16; ++i) s += v[i];
  mean = wave_sum(s) * (1.f / 1024.f);
  float q = 0.f;
#pragma unroll
  for (int i = 0; i < 16; ++i) { float d = v[i] - mean; q += d * d; }
  rstd = rsqrtf(wave_sum(q) * (1.f / 1024.f) + 1e-5f);
}
DEVFN void load_row16(const float* row, int lane, float (&v)[16]) {
  const AS1 float* r = gptr(row);
#pragma unroll
  for (int j = 0; j < 4; ++j) { const f32x4 t = *(const AS1 f32x4*)(r + lane * 4 + 256 * j); v[4 * j] = t[0]; v[4 * j + 1] = t[1]; v[4 * j + 2] = t[2]; v[4 * j + 3] = t[3]; }
}
DEVFN void moe_residual_row(const Params& p, int lp, int tok, int lane, float (&xv)[16]) {
  const float* mod = (const float*)(p.ws + Ws::MOD) + ((size_t)lp * NR_ + tok_modrow(tok)) * NMOD_;
  const bf16_t* yb = (const bf16_t*)(p.ws + Ws::YBUF) + (size_t)tok * NSLOT * 1024;
  float g2[16], w[16], b[16];
  load_row16(mod + 5 * 1024, lane, g2);
  load_row16(INP(I_LN2W) + (size_t)lp * 1024, lane, w);
  load_row16(INP(I_LN2B) + (size_t)lp * 1024, lane, b);
  u32x2 sl[NSLOT][4];
#pragma unroll
  for (int s = 0; s < NSLOT; ++s)
#pragma unroll
    for (int j = 0; j < 4; ++j) sl[s][j] = *(const AS1 u32x2*)gptr(yb + (size_t)s * 1024 + lane * 4 + 256 * j);
  float f[16];
#pragma unroll
  for (int i = 0; i < 16; ++i) f[i] = 0.f;
#pragma unroll
  for (int s = 0; s < NSLOT; ++s)
#pragma unroll
    for (int j = 0; j < 4; ++j) { const u32x2 t = sl[s][j];
      f[4 * j] += bf2f((bf16_t)(t[0] & 0xFFFF)); f[4 * j + 1] += bf2f((bf16_t)(t[0] >> 16)); f[4 * j + 2] += bf2f((bf16_t)(t[1] & 0xFFFF)); f[4 * j + 3] += bf2f((bf16_t)(t[1] >> 16)); }
#pragma unroll
  for (int i = 0; i < 16; ++i) xv[i] = ALPHA_ * xv[i] + g2[i] * f[i];
  float mean, rstd;
  row_stats(xv, mean, rstd);
#pragma unroll
  for (int i = 0; i < 16; ++i) xv[i] = (xv[i] - mean) * rstd * w[i] + b[i];
}
DEVFN void phase1(const Params& p, int l) {
  const int lane = TIDX & 63, wave = TIDX >> 6;
  float* X = (float*)(p.ws + Ws::X);
  bf16_t* U = (bf16_t*)(p.ws + Ws::U);
  for (int tok = BIDX * 4 + wave; tok < NT_; tok += gridDim.x * 4) {
    float xv[16], sh[16], sc[16], mean, rstd;
    const float* mod = (const float*)(p.ws + Ws::MOD) + ((size_t)l * NR_ + tok_modrow(tok)) * NMOD_;
    load_row16(mod, lane, sh);
    load_row16(mod + 1024, lane, sc);
    if (l == 0) load_row16(tok_input_row(p, tok), lane, xv);
    else { load_row16(X + (size_t)tok * 1024, lane, xv); moe_residual_row(p, l - 1, tok, lane, xv); }
#pragma unroll
    for (int j = 0; j < 4; ++j) *(float4*)(X + (size_t)tok * 1024 + lane * 4 + 256 * j) = make_float4(xv[4 * j], xv[4 * j + 1], xv[4 * j + 2], xv[4 * j + 3]);
    row_stats(xv, mean, rstd);
#pragma unroll
    for (int j = 0; j < 4; ++j) {
      float u0 = (xv[4 * j] - mean) * rstd * (1.f + sc[4 * j]) + sh[4 * j], u1 = (xv[4 * j + 1] - mean) * rstd * (1.f + sc[4 * j + 1]) + sh[4 * j + 1];
      float u2 = (xv[4 * j + 2] - mean) * rstd * (1.f + sc[4 * j + 2]) + sh[4 * j + 2], u3 = (xv[4 * j + 3] - mean) * rstd * (1.f + sc[4 * j + 3]) + sh[4 * j + 3];
      *(uint2*)(U + (size_t)tok * 1024 + lane * 4 + 256 * j) = make_uint2((unsigned)f2bf(u0) | ((unsigned)f2bf(u1) << 16), (unsigned)f2bf(u2) | ((unsigned)f2bf(u3) << 16));
    }
  }
}
DEVFN void phase_final(const Params& p) {
  const int lane = TIDX & 63, wave = TIDX >> 6;
  const float* X = (const float*)(p.ws + Ws::X);
  for (int r = BIDX * 4 + wave; r < B_ * SEQ_; r += gridDim.x * 4) {
    int b = r / SEQ_, s = r % SEQ_, tok = b * T_ + CTX_ + s;
    float xv[16];
    load_row16(X + (size_t)tok * 1024, lane, xv);
    moe_residual_row(p, DEPTH_ - 1, tok, lane, xv);
#pragma unroll
    for (int j = 0; j < 4; ++j) *(float4*)(p.out + (size_t)r * 1024 + lane * 4 + 256 * j) = make_float4(xv[4 * j], xv[4 * j + 1], xv[4 * j + 2], xv[4 * j + 3]);
  }
}

DEVFN void phase2(const Params& p, int l, unsigned char* smem) {
  const bf16_t* U = (const bf16_t*)(p.ws + Ws::U);
  const bf16_t* W = (const bf16_t*)(p.ws + Ws::WIN) + (size_t)l * NIN_ * 1024;
  bf16_t* ZX = (bf16_t*)(p.ws + Ws::ZX);
  const int nct = (NIN_ + 127) / 128;
  for (int u = BIDX; u < (NT_ / 128) * nct; u += gridDim.x) {
    int rt = u / nct, ct = u % nct;
    gemm_tile(smem, 1024,
      [&](int r) { return U + (size_t)(rt * 128 + r) * 1024; },
      [&](int r) { int n = ct * 128 + r; return n < NIN_ ? W + (size_t)n * 1024 : (const bf16_t*)(p.ws + Ws::ZROW); },
      [&](f32x4 (&acc)[4][4], int wr, int wc, int g, int l15) {
        tile_store_bf16<16>(smem, wr, g, l15,
          [&](bf16_t* T, int ldc) {
#pragma unroll
            for (int mi = 0; mi < 4; ++mi)
#pragma unroll
              for (int ni = 0; ni < 4; ++ni)
#pragma unroll
                for (int i = 0; i < 4; ++i) T[(wr * 64 + mi * 16 + 4 * g + i) * ldc + wc * 64 + ni * 16 + l15] = f2bf(acc[mi][ni][i]); },
          [&](int row, int c0) { return ct * 128 + c0 < NIN_ ? ZX + (size_t)(rt * 128 + row) * NIN_ + ct * 128 + c0 : (bf16_t*)nullptr; });
      });
  }
}

DEVFN float zxv(const bf16_t* ZX, int tok, int col) { return bf2f(gptr(ZX)[(size_t)tok * NIN_ + col]); }
struct Nbr { int n; int tok[4]; };
DEVFN Nbr shift_nbrs(int tok) {
  Nbr nb; int b = tok / T_, t = tok % T_;
  if (t < CTX_) { nb.n = 2; nb.tok[0] = t > 0 ? tok - 1 : -1; nb.tok[1] = t < CTX_ - 1 ? tok + 1 : -1; nb.tok[2] = -1; nb.tok[3] = -1; }
  else { int s = t - CTX_, row = s / 64, col = s % 64; nb.n = 4; nb.tok[0] = col > 0 ? tok - 1 : -1; nb.tok[1] = col < 63 ? tok + 1 : -1;
    nb.tok[2] = row > 0 ? tok - 64 : -1; nb.tok[3] = row < SEQ_ / 64 - 1 ? tok + 64 : -1; }
  (void)b; return nb;
}
DEVFN float shiftmix(const bf16_t* ZX, const float* mu, int tok, const Nbr& nb, int ch) {
  float z = zxv(ZX, tok, ORW + ch), o = z;
#pragma unroll
  for (int j = 0; j < 4; ++j) if (j < nb.n) { float v = nb.tok[j] >= 0 ? zxv(ZX, nb.tok[j], ORW + ch) : 0.f; o += mu[j * 1152 + ch] * (v - z); }
  return o;
}
#define LI_LD 392
#define KL_LD 264
DEVFN void phase3(const Params& p, int l, unsigned char* smem) {
  const int tid = TIDX, lane = tid & 63, wave = tid >> 6, q = lane >> 4, l15 = lane & 15;
  const bf16_t* ZX = (const bf16_t*)(p.ws + Ws::ZX);
  bf16_t* XBC = (bf16_t*)(p.ws + Ws::XBC); float* DTB = (float*)(p.ws + Ws::DTB);
  bf16_t* RR = (bf16_t*)(p.ws + Ws::RR); bf16_t* VV = (bf16_t*)(p.ws + Ws::VV); bf16_t* KKb = (bf16_t*)(p.ws + Ws::KK);
  bf16_t* KRW = (bf16_t*)(p.ws + Ws::KRW); bf16_t* LIg = (bf16_t*)(p.ws + Ws::LI);
  float* LA = (float*)(p.ws + Ws::LA);
  const float* convw = INP(I_CONVW) + (size_t)l * 3 * 1024; const float* convb = INP(I_CONVB) + (size_t)l * 1024;
  const float* mu = INP(I_MU) + (size_t)l * 4 * 1152;
  float* gdl = (float*)smem;
  const float kkw = INP(I_KKW)[(size_t)l * 256 + tid];
  for (int wu = BIDX; wu < 2 * (NT_ / 16); wu += gridDim.x) {
    const int tile = wu >> 1, part = wu & 1;
    const int tok0 = tile * 16, t0 = tok0 % T_, bb = tok0 / T_;
    const bool isctx = t0 < CTX_;
    const int s0 = t0 - CTX_;
    const bool lval = isctx ? (t0 > 0) : ((s0 & 63) != 0), rval = isctx ? (t0 + 16 < CTX_) : ((s0 & 63) != 48);
    const bool uval = !isctx && (s0 >= 64), dval = !isctx && (s0 + 64 < SEQ_);
    if (part == 0) {
    __syncthreads();
    {
      const bool segstart = (t0 == 0 || t0 == CTX_), segend = (t0 + 16 == CTX_ || t0 + 16 == T_);
      bf16_t* XBCT = (bf16_t*)(p.ws + Ws::XBCT) + ((size_t)(bb * NC128 + t0 / 128) * 768) * 128 + (t0 % 128);
#pragma unroll 1
      for (int j = 0; j < 4; ++j) { const int c = tid + 256 * j;
        const AS1 bf16_t* zp = gptr(ZX) + (size_t)tok0 * NIN_ + OXBC + c - NIN_; AS1 bf16_t* xp = gptr(XBC) + (size_t)tok0 * 1024 + c;
        float z[18];
#pragma unroll
        for (int i = 0; i < 18; ++i) { z[i] = ((i == 0 && segstart) || (i == 17 && segend)) ? 0.f : bf2f(*zp); zp += NIN_; LAUNDER_V(zp); }
        const float w0 = convw[c], w1 = convw[1024 + c], w2 = convw[2048 + c], cb = convb[c];
        bf16_t y[16];
#pragma unroll
        for (int i = 0; i < 16; ++i) { y[i] = f2bf(siluf_(cb + w0 * z[i] + w1 * z[i + 1] + w2 * z[i + 2])); *xp = y[i]; xp += 1024; LAUNDER_V(xp); }
        if (c < 768) {
          u32x4 o0, o1;
#pragma unroll
          for (int i = 0; i < 4; ++i) { o0[i] = (unsigned)y[2 * i] | ((unsigned)y[2 * i + 1] << 16); o1[i] = (unsigned)y[8 + 2 * i] | ((unsigned)y[9 + 2 * i] << 16); }
          *(u32x4*)(XBCT + (size_t)c * 128) = o0; *(u32x4*)(XBCT + (size_t)c * 128 + 8) = o1; } }
      { bf16_t* VTp = (bf16_t*)(p.ws + Ws::VT) + ((size_t)(bb * NC64 + t0 / 64) * 256 + tid) * 64 + (t0 % 64);
        const AS1 bf16_t* vp = gptr(ZX) + (size_t)tok0 * NIN_ + OGV + tid;
        u32x4 o0, o1;
        bf16_t vv16[16];
#pragma unroll
        for (int i = 0; i < 16; ++i) { vv16[i] = *vp; vp += NIN_; LAUNDER_V(vp); }
#pragma unroll
        for (int i = 0; i < 4; ++i) { o0[i] = (unsigned)vv16[2 * i] | ((unsigned)vv16[2 * i + 1] << 16); o1[i] = (unsigned)vv16[8 + 2 * i] | ((unsigned)vv16[9 + 2 * i] << 16); }
        *(u32x4*)VTp = o0; *(u32x4*)(VTp + 8) = o1; }
      DTB[(size_t)tok0 * 16 + tid] = softplusf_(zxv(ZX, tok0 + (tid >> 4), ODT + (tid & 15)) + INP(I_DTBIAS)[(size_t)l * 16 + (tid & 15)]);
      gdl[tid] = zxv(ZX, tok0 + (tid >> 5), OGD + (tid & 31)); gdl[256 + tid] = zxv(ZX, tok0 + 8 + (tid >> 5), OGD + (tid & 31));
    }
    } else {
#pragma unroll 1
    for (int g = 0; g < 5; ++g) {
      const bool act = !(g == 4 && tid >= 128);
      const int ch = act ? g * 256 + tid : 0;
      const AS1 bf16_t* zp0 = gptr(ZX) + (size_t)tok0 * NIN_ + ORW + ch;
      const AS1 bf16_t* zp = zp0 - NIN_;
      const float m0 = mu[ch], m1 = mu[1152 + ch], m2 = mu[2304 + ch], m3 = mu[3456 + ch];
      float z[18], o[16];
#pragma unroll
      for (int i = 0; i < 18; ++i) { z[i] = ((i == 0 && !lval) || (i == 17 && !rval)) ? 0.f : bf2f(*zp); zp += NIN_; LAUNDER_V(zp); }
#pragma unroll
      for (int i = 0; i < 16; ++i) o[i] = z[i + 1] + m0 * (z[i] - z[i + 1]) + m1 * (z[i + 2] - z[i + 1]);
      if (!isctx) {
        const AS1 bf16_t* up = zp0 - (size_t)64 * NIN_; const AS1 bf16_t* dn = zp0 + (size_t)64 * NIN_;
#pragma unroll
        for (int i = 0; i < 16; ++i) { const float zu = uval ? bf2f(*up) : 0.f, zd = dval ? bf2f(*dn) : 0.f; up += NIN_; dn += NIN_; LAUNDER_V(up); LAUNDER_V(dn);
          o[i] += m2 * (zu - z[i + 1]) + m3 * (zd - z[i + 1]); } }
      if (g == 0) { AS1 bf16_t* rp = gptr(RR) + (size_t)tok0 * 256 + tid;
#pragma unroll
        for (int i = 0; i < 16; ++i) { *rp = f2bf(o[i]); rp += 256; LAUNDER_V(rp); }
      } else if (g == 1) { AS1 bf16_t* kp = gptr(KKb) + (size_t)tok0 * 256 + tid; AS1 bf16_t* krp = gptr(KRW) + (size_t)tok0 * 256 + tid;
#pragma unroll
        for (int i = 0; i < 16; ++i) { const float kq = o[i] * kkw, nrm = sqrtf(wave_sum(kq * kq));
          *kp = f2bf(kq / fmaxf(nrm, 1e-12f)); *krp = f2bf(o[i]); kp += 256; krp += 256; LAUNDER_V(kp); LAUNDER_V(krp); }
      } else if (g == 2) { AS1 bf16_t* vp2 = gptr(VV) + (size_t)tok0 * 256 + tid;
#pragma unroll
        for (int i = 0; i < 16; ++i) { *vp2 = f2bf(o[i]); vp2 += 256; LAUNDER_V(vp2); }
      } else if (g == 3) { AS1 bf16_t* lp = gptr(LIg) + (size_t)tok0 * 384 + tid;
#pragma unroll
        for (int i = 0; i < 16; ++i) { *lp = f2bf(tid < 128 ? tanhf(o[i]) : o[i]); lp += 384; LAUNDER_V(lp); }
      } else if (act) { AS1 bf16_t* lp = gptr(LIg) + (size_t)tok0 * 384 + 256 + tid;
#pragma unroll
        for (int i = 0; i < 16; ++i) { *lp = f2bf(sigmoidf_(o[i])); lp += 384; LAUNDER_V(lp); }
      }
    }
    }
    if (part == 0) {
    __syncthreads();
    { const int d = tid >> 7, c = tid & 127; const float* gu = INP(I_GU) + ((size_t)l * 2 + d) * 16 * 128; const float gb = INP(I_GB)[((size_t)l * 2 + d) * 128 + c];
      float guw[16];
#pragma unroll
      for (int i = 0; i < 16; ++i) guw[i] = gu[i * 128 + c];
#pragma unroll 4
      for (int tt = 0; tt < 16; ++tt) { float sacc = gb;
#pragma unroll
        for (int i = 0; i < 16; ++i) sacc += gdl[tt * 32 + d * 16 + i] * guw[i];
        LA[((size_t)d * NT_ + tok0 + tt) * 128 + c] = logsigmoidf_(sacc) * (1.f / 16.f); } }
    }
  }
}

DEVFN void phase3b(const Params& p, int l, unsigned char* smem) {
  const bf16_t* LIg = (const bf16_t*)(p.ws + Ws::LI);
  const bf16_t* lora = (const bf16_t*)(p.ws + Ws::LORA) + (size_t)l * 98304;
  const bf16_t* KRg = (const bf16_t*)(p.ws + Ws::KRW); const bf16_t* KKg = (const bf16_t*)(p.ws + Ws::KK);
  float* LWp = (float*)(p.ws + Ws::LW); bf16_t* KD = (bf16_t*)(p.ws + Ws::KD); bf16_t* BD = (bf16_t*)(p.ws + Ws::BD); float* GATE = (float*)(p.ws + Ws::GATE);
  for (int u = BIDX; u < (NT_ / 128) * 10; u += gridDim.x) {
    const int rt = u / 10, which = (u % 10) >> 1, ct = u & 1;
    const int K = which < 4 ? 64 : 128, acol = which < 4 ? which * 64 : 256;
    const bf16_t* wb = which < 2 ? lora + (size_t)which * 16384 : which < 4 ? lora + 32768 + (size_t)(which - 2) * 16384 : lora + 65536;
    const float* bias = which < 2 ? INP(I_W0) + (size_t)l * 512 + which * 256 : INP(I_A0) + (size_t)l * 512 + (which & 1) * 256;
    const float* kav = INP(I_KAW) + (size_t)l * 256;
    gemm_tile(smem, K,
      [&](int r) { return LIg + (size_t)(rt * 128 + r) * 384 + acol; },
      [&](int r) { return wb + (size_t)(ct * 128 + r) * K; },
      [&](f32x4 (&acc)[4][4], int wr, int wc, int g, int l15) {
        const int tid = TIDX;
        if (which == 2 || which == 3) {
          bf16_t* T = (bf16_t*)smem; constexpr int LDC = 136;
          __syncthreads();
#pragma unroll
          for (int ni = 0; ni < 4; ++ni) { const int cl = wc * 64 + ni * 16 + l15; const float bv = bias[ct * 128 + cl];
#pragma unroll
            for (int mi = 0; mi < 4; ++mi)
#pragma unroll
              for (int i = 0; i < 4; ++i) T[(wr * 64 + mi * 16 + 4 * g + i) * LDC + cl] = f2bf(sigmoidf_(acc[mi][ni][i] + bv)); }
          __syncthreads();
          const int c = tid & 15, col0 = ct * 128 + c * 8;
          float ka[8];
#pragma unroll
          for (int j = 0; j < 8; ++j) ka[j] = kav[col0 + j];
          const size_t dofs = (size_t)(which - 2) * NT_ * 256;
#pragma unroll
          for (int pass = 0; pass < 8; ++pass) { const int row = (tid >> 4) + 16 * pass; const size_t o = (size_t)(rt * 128 + row) * 256 + col0;
            const bf16x8 a8 = *(const bf16x8*)(T + row * LDC + c * 8), kr8 = ld8g(KRg + o), kk8 = ld8g(KKg + o);
            bf16x8 kd8, bd8;
#pragma unroll
            for (int j = 0; j < 8; ++j) { const float a = bf2f((bf16_t)a8[j]); kd8[j] = (short)f2bf(bf2f((bf16_t)kr8[j]) * (1.f + (a - 1.f) * ka[j])); bd8[j] = (short)f2bf(bf2f((bf16_t)kk8[j]) * a); }
            *(AS1 bf16x8*)gptr(KD + dofs + o) = kd8; *(AS1 bf16x8*)gptr(BD + dofs + o) = bd8; }
        } else {
          float* T = (float*)smem; constexpr int LDC = 132;
          float* dst = which < 2 ? LWp + (size_t)which * NT_ * 256 : GATE;
#pragma unroll 1
          for (int h = 0; h < 2; ++h) {
            __syncthreads();
            if (wr == h) {
#pragma unroll
              for (int ni = 0; ni < 4; ++ni) { const int cl = wc * 64 + ni * 16 + l15; const float bv = which < 2 ? bias[ct * 128 + cl] : 0.f;
#pragma unroll
                for (int mi = 0; mi < 4; ++mi)
#pragma unroll
                  for (int i = 0; i < 4; ++i) { const float v = acc[mi][ni][i]; T[(mi * 16 + 4 * g + i) * LDC + cl] = which < 2 ? -0.6065306597126334f * sigmoidf_(v + bv) : v; } } }
            __syncthreads();
#pragma unroll
            for (int pass = 0; pass < 8; ++pass) { const int id = tid + 256 * pass, row = id >> 5, c = id & 31;
              *(AS1 f32x4*)gptr(dst + (size_t)(rt * 128 + h * 64 + row) * 256 + ct * 128 + c * 4) = *(const f32x4*)(T + row * LDC + c * 4); } }
        }
      });
  }
}

DEVFN bf16x8 ld8(const bf16_t* p) { return *(const bf16x8*)p; }
typedef short bf16x4v __attribute__((ext_vector_type(4)));
DEVFN bf16x4v cvt4(f32x4 v) { return bf16x4v{(short)f2bf(v[0]), (short)f2bf(v[1]), (short)f2bf(v[2]), (short)f2bf(v[3])}; }
DEVFN bf16x8 cat44(bf16x4v a, bf16x4v b) { return bf16x8{a[0], a[1], a[2], a[3], b[0], b[1], b[2], b[3]}; }
DEVFN bf16x4v ld4(const bf16_t* p) { return *(const bf16x4v*)p; }
DEVFN int rm_off(int i, int k) { return i * 64 + ((((k >> 3) ^ (i & 7)) << 3) | (k & 7)); }
#define RW_WAVE_LDS 11264
DEVFN void rwkv_chunk(const Params& p, int unit_base, unsigned char* smem) {
  const int tid = TIDX, lane = tid & 63, wave = tid >> 6, q = lane >> 4, l15 = lane & 15;
  const int unit = unit_base + wave;
  const int c = unit % NC16, h = (unit / NC16) & 3, dir = (unit / (NC16 * 4)) & 1, b = unit / (NC16 * 8);
  bf16_t* big = (bf16_t*)(smem + wave * RW_WAVE_LDS);
  unsigned char* small = smem + wave * RW_WAVE_LDS + 8192;
  float* AbF = (float*)small;
  bf16_t* TN = (bf16_t*)(small + 1024);
  bf16_t* AK = TN + 256; bf16_t* RB = AK + 256; bf16_t* RK = RB + 256;
  const bf16_t* RRg = (const bf16_t*)(p.ws + Ws::RR); const bf16_t* VVg = (const bf16_t*)(p.ws + Ws::VV); const bf16_t* KKg = (const bf16_t*)(p.ws + Ws::KK);
  const bf16_t* KDg = (const bf16_t*)(p.ws + Ws::KD) + (size_t)dir * NT_ * 256; const bf16_t* BDg = (const bf16_t*)(p.ws + Ws::BD) + (size_t)dir * NT_ * 256;
  const float* LWg = (const float*)(p.ws + Ws::LW) + (size_t)dir * NT_ * 256;
  float kkm[16], vv[16], bneg[16], kneg[16];
  float run = 0.f;
  __syncthreads();
#pragma unroll
  for (int i = 0; i < 16; ++i) {
    const size_t o = (size_t)(b * T_ + tokmap(dir, c * 16 + i)) * 256 + h * 64 + lane;
    const float lw = gptr(LWg)[o], r = bf2f(gptr(RRg)[o]), k = bf2f(gptr(KDg)[o]), v = bf2f(gptr(VVg)[o]), kk = bf2f(gptr(KKg)[o]), bb = bf2f(gptr(BDg)[o]);
    const float e_ex = expf(run); run += lw; const float e_in = expf(run), e_neg = expf(-run);
    kkm[i] = kk * e_ex; vv[i] = v; bneg[i] = bb * e_neg; kneg[i] = k * e_neg;
    big[rm_off(i, lane)] = f2bf(kkm[i]); big[1024 + rm_off(i, lane)] = f2bf(r * e_in);
    big[2048 + rm_off(i, lane)] = f2bf(bneg[i]); big[3072 + rm_off(i, lane)] = f2bf(kneg[i]);
  }
  const float WC = expf(run);
  __syncthreads();
  f32x4 ab = f32x4{0.f, 0.f, 0.f, 0.f}, ak = ab, rb = ab, rk = ab;
#pragma unroll
  for (int s2 = 0; s2 < 2; ++s2) { const int ch = ((4 * s2 + q) ^ (l15 & 7)) << 3;
    const bf16x8 a_kk = ld8(big + l15 * 64 + ch), a_r = ld8(big + 1024 + l15 * 64 + ch), b_b = ld8(big + 2048 + l15 * 64 + ch), b_k = ld8(big + 3072 + l15 * 64 + ch);
    ab = MFMA16(a_kk, b_b, ab); ak = MFMA16(a_kk, b_k, ak); rb = MFMA16(a_r, b_b, rb); rk = MFMA16(a_r, b_k, rk); }
  f32x4 gacc[4];
#pragma unroll
  for (int nk = 0; nk < 4; ++nk)
#pragma unroll
    for (int r = 0; r < 4; ++r) gacc[nk][r] = bf2f(big[1024 + rm_off(4 * q + r, 16 * nk + l15)]);
  __syncthreads();
#pragma unroll
  for (int r = 0; r < 4; ++r) { const int i = 4 * q + r, j = l15;
    AbF[i * 16 + j] = j < i ? ab[r] : 0.f; AK[i * 16 + j] = f2bf(j < i ? ak[r] : 0.f);
    RB[i * 16 + j] = f2bf(j <= i ? rb[r] : 0.f); RK[i * 16 + j] = f2bf(j <= i ? rk[r] : 0.f); }
  { bf16_t* KKMT = big; bf16_t* VTT = big + 1024; bf16_t* BHT = big + 2048; bf16_t* KHT = big + 3072;
#pragma unroll
    for (int i = 0; i < 16; ++i) { KKMT[lane * 16 + i] = f2bf(kkm[i]); VTT[lane * 16 + i] = f2bf(vv[i]); BHT[lane * 16 + i] = f2bf(bneg[i] * WC); KHT[lane * 16 + i] = f2bf(kneg[i] * WC); } }
  __syncthreads();
  { float t[16];
#pragma unroll
    for (int i = 0; i < 16; ++i) { float acc = (i == l15) ? 1.f : 0.f;
#pragma unroll
      for (int j = 0; j < i; ++j) acc -= AbF[i * 16 + j] * t[j];
      t[i] = acc; }
    if (q == 0) {
#pragma unroll
      for (int i = 0; i < 16; ++i) TN[i * 16 + l15] = f2bf(-t[i]); } }
  __syncthreads();
  const size_t ci = (size_t)((b * 2 + dir) * 4 + h) * NC16 + c;
  bf16_t* MLg = (bf16_t*)(p.ws + Ws::RML) + ci * 4096; bf16_t* Ng = (bf16_t*)(p.ws + Ws::RNS) + ci * 4096;
  bf16_t* Gg = (bf16_t*)(p.ws + Ws::RG) + ci * 1024; float* Y0g = (float*)(p.ws + Ws::RY0) + ci * 1024;
  const bf16x4v a_T = ld4(TN + l15 * 16 + 4 * q), a_Ak = ld4(AK + l15 * 16 + 4 * q), a_Rb = ld4(RB + l15 * 16 + 4 * q), a_Rk = ld4(RK + l15 * 16 + 4 * q);
  const f32x4 z4 = f32x4{0.f, 0.f, 0.f, 0.f};
  bf16x4v vfr[4], qfr[4], pfr[4];
#pragma unroll
  for (int n = 0; n < 4; ++n) {
    vfr[n] = ld4(big + 1024 + (16 * n + l15) * 16 + 4 * q);
    const f32x4 akv = MFMA16K16(a_Ak, vfr[n], z4);
    qfr[n] = cvt4(MFMA16K16(a_T, cvt4(akv), z4));
    pfr[n] = cvt4(MFMA16K16(a_T, ld4(big + (16 * n + l15) * 16 + 4 * q), z4)); }
  const bf16x8 a_RbRk = cat44(a_Rb, a_Rk);
#pragma unroll
  for (int n = 0; n < 4; ++n) {
    const f32x4 g = MFMA16K16(a_Rb, pfr[n], gacc[n]);
    const f32x4 y0 = MFMA16(a_RbRk, cat44(qfr[n], vfr[n]), z4);
#pragma unroll
    for (int r = 0; r < 4; ++r) { Gg[(4 * q + r) * 64 + 16 * n + l15] = f2bf(g[r]); Y0g[(4 * q + r) * 64 + 16 * n + l15] = y0[r]; } }
#pragma unroll
  for (int mk = 0; mk < 4; ++mk) {
    const bf16x4v a_B = ld4(big + 2048 + (16 * mk + l15) * 16 + 4 * q), a_K = ld4(big + 3072 + (16 * mk + l15) * 16 + 4 * q);
    const bf16x8 a_BK = cat44(a_B, a_K);
#pragma unroll
    for (int n = 0; n < 4; ++n) {
      const f32x4 m = MFMA16K16(a_B, pfr[n], z4);
      const f32x4 nn = MFMA16(a_BK, cat44(qfr[n], vfr[n]), z4);
#pragma unroll
      for (int r = 0; r < 4; ++r) MLg[((mk * 2 + (n >> 1)) * 64 + (l15 >> 2) * 16 + 4 * q + r) * 8 + (n & 1) * 4 + (l15 & 3)] = f2bf(m[r]);
      *(bf16x4v*)(Ng + (n * 64 + lane) * 16 + mk * 4) = cvt4(nn); } }
  ((float*)(p.ws + Ws::RWC))[ci * 64 + ((lane >> 2) & 3) * 16 + (lane >> 4) * 4 + (lane & 3)] = WC;
}
struct RwStep { bf16x8 ml[4][2]; bf16x8 n[2]; f32x4 wc[4]; };
DEVFN void rw_load(RwStep& t, const bf16_t* MLg, const bf16_t* NSg, const float* WCg, int c, int lane, int q) {
#pragma unroll
  for (int mk = 0; mk < 4; ++mk) { t.ml[mk][0] = ld8g(MLg + (size_t)c * 4096 + ((mk * 2 + 0) * 64 + lane) * 8); t.ml[mk][1] = ld8g(MLg + (size_t)c * 4096 + ((mk * 2 + 1) * 64 + lane) * 8);
    t.wc[mk] = *(const AS1 f32x4*)gptr(WCg + (size_t)c * 64 + q * 16 + mk * 4); }
  t.n[0] = ld8g(NSg + (size_t)c * 4096 + lane * 16); t.n[1] = ld8g(NSg + (size_t)c * 4096 + lane * 16 + 8);
}
DEVFN void rw_step(const RwStep& t, f32x4 (&S)[4], bf16_t* NSg, int c, int q, int l15) {
  bf16x4v sb[4];
#pragma unroll
  for (int mk = 0; mk < 4; ++mk) sb[mk] = cvt4(S[mk]);
  const bf16x8 bf0 = cat44(sb[0], sb[1]), bf1 = cat44(sb[2], sb[3]);
#pragma unroll
  for (int mk = 0; mk < 4; ++mk) {
    f32x4 acc;
#pragma unroll
    for (int r = 0; r < 4; ++r) acc[r] = bf2f((bf16_t)t.n[mk >> 1][(mk & 1) * 4 + r]) + t.wc[mk][r] * S[mk][r];
    acc = MFMA16(t.ml[mk][0], bf0, acc);
    acc = MFMA16(t.ml[mk][1], bf1, acc);
    S[mk] = acc; }
#pragma unroll
  for (int mk = 0; mk < 4; ++mk) *(AS1 bf16x4v*)gptr(NSg + (size_t)c * 4096 + l15 * 64 + 16 * mk + 4 * q) = sb[mk];
}
DEVFN void rwkv_scan(const Params& p, int chain, int wave) {
  const int tid = TIDX, lane = tid & 63, q = lane >> 4, l15 = lane & 15;
  const bf16_t* MLg = (const bf16_t*)(p.ws + Ws::RML) + (size_t)chain * NC16 * 4096;
  bf16_t* NSg = (bf16_t*)(p.ws + Ws::RNS) + (size_t)chain * NC16 * 4096 + wave * 1024;
  const float* WCg = (const float*)(p.ws + Ws::RWC) + (size_t)chain * NC16 * 64;
  f32x4 S[4];
#pragma unroll
  for (int mk = 0; mk < 4; ++mk) S[mk] = f32x4{0.f, 0.f, 0.f, 0.f};
  RwStep t0, t1, t2;
#define RWC_(x) ((x) < NC16 ? (x) : NC16 - 1)
  rw_load(t0, MLg, NSg, WCg, 0, lane, q);
  rw_load(t1, MLg, NSg, WCg, RWC_(1), lane, q);
  int c = 0;
  for (; c + 2 < NC16; c += 3) {
    rw_load(t2, MLg, NSg, WCg, c + 2, lane, q);
    rw_step(t0, S, NSg, c, q, l15);
    rw_load(t0, MLg, NSg, WCg, RWC_(c + 3), lane, q);
    rw_step(t1, S, NSg, c + 1, q, l15);
    rw_load(t1, MLg, NSg, WCg, RWC_(c + 4), lane, q);
    rw_step(t2, S, NSg, c + 2, q, l15);
  }
  if (c < NC16) { rw_step(t0, S, NSg, c, q, l15); if (c + 1 < NC16) rw_step(t1, S, NSg, c + 1, q, l15); }
#undef RWC_
}
DEVFN void rwkv_out(const Params& p, int unit_base) {
  const int tid = TIDX, lane = tid & 63, wave = tid >> 6, q = lane >> 4, l15 = lane & 15;
  const int unit = unit_base + wave;
  const int c = unit % NC16, h = (unit / NC16) & 3, dir = (unit / (NC16 * 4)) & 1, b = unit / (NC16 * 8);
  const size_t ci = (size_t)((b * 2 + dir) * 4 + h) * NC16 + c;
  const bf16_t* Sg = (const bf16_t*)(p.ws + Ws::RNS) + ci * 4096; const bf16_t* Gg = (const bf16_t*)(p.ws + Ws::RG) + ci * 1024;
  const float* Y0g = (const float*)(p.ws + Ws::RY0) + ci * 1024;
  float* YR = (float*)(p.ws + Ws::YR) + (size_t)dir * NT_ * 256;
  const bf16x8 a0 = ld8g(Gg + l15 * 64 + 8 * q), a1 = ld8g(Gg + l15 * 64 + 32 + 8 * q);
#pragma unroll
  for (int n = 0; n < 4; ++n) {
    f32x4 acc;
#pragma unroll
    for (int r = 0; r < 4; ++r) acc[r] = gptr(Y0g)[(4 * q + r) * 64 + 16 * n + l15];
    acc = MFMA16(a0, ld8g(Sg + n * 1024 + l15 * 64 + 8 * q), acc);
    acc = MFMA16(a1, ld8g(Sg + n * 1024 + l15 * 64 + 32 + 8 * q), acc);
#pragma unroll
    for (int r = 0; r < 4; ++r) YR[(size_t)(b * T_ + tokmap(dir, c * 16 + 4 * q + r)) * 256 + h * 64 + 16 * n + l15] = acc[r]; }
}
DEVFN int cscan(int dir, int co, int nctx, int nc) { return dir == 0 ? co : (co < nctx ? nctx - 1 - co : 2 * nctx + nc - 1 - co); }
DEVFN bf16x8 ld4x2g(const bf16_t* p0, const bf16_t* p1) { bf16x4v a = *(const AS1 bf16x4v*)gptr(p0), b = *(const AS1 bf16x4v*)gptr(p1); return bf16x8{a[0], a[1], a[2], a[3], b[0], b[1], b[2], b[3]}; }
DEVFN bf16x8 ld4x2(const bf16_t* p0, const bf16_t* p1) { bf16x4v a = *(const bf16x4v*)p0, b = *(const bf16x4v*)p1; return bf16x8{a[0], a[1], a[2], a[3], b[0], b[1], b[2], b[3]}; }

DEVFN void ssd_chunk_scalars(const Params& p, int l, int b, int co, int h, float* f) {
  const int tid = TIDX, d = tid >> 7, j = tid & 127;
  const float* DTB = (const float*)(p.ws + Ws::DTB);
  const float nega = -expf(INP(I_ALOG)[(size_t)l * 16 + d * 8 + h]);
  const float dt = DTB[(size_t)(b * T_ + co * 128 + j) * 16 + d * 8 + h];
  __syncthreads();
  f[256 + d * 128 + j] = dt;
  float* cur = f + d * 128; float* tmp = f + 512 + d * 128;
  cur[j] = dt * nega;
  __syncthreads();
  for (int off = 1; off < 128; off <<= 1) {
    float v = cur[j] + (j >= off ? cur[j - off] : 0.f);
    tmp[j] = v;
    __syncthreads();
    cur[j] = tmp[j];
    __syncthreads();
  }
}
DEVFN void ssd_states(const Params& p, int l, int unit, unsigned char* smem) {
  const int tid = TIDX, lane = tid & 63, wave = tid >> 6, q = lane >> 4, l15 = lane & 15;
  const int h = unit & 7, co = (unit >> 3) % NC128, b = unit / (8 * NC128), grp = h >> 2;
  float* f = (float*)smem;
  ssd_chunk_scalars(p, l, b, co, h, f);
  { const int d = tid >> 7, j = tid & 127; const float* cum = f + d * 128; const float dt = f[256 + d * 128 + j];
    float w = d == 0 ? expf(cum[127] - cum[j]) * dt : expf(j > 0 ? cum[j - 1] : 0.f) * dt;
    f[512 + d * 128 + j] = w; }
  __syncthreads();
  const bf16_t* XT = (const bf16_t*)(p.ws + Ws::XBCT) + (size_t)(b * NC128 + co) * 768 * 128;
  f32x4 acc[2][8];
#pragma unroll
  for (int d = 0; d < 2; ++d)
#pragma unroll
    for (int n = 0; n < 8; ++n) acc[d][n] = f32x4{0.f, 0.f, 0.f, 0.f};
#pragma unroll 1
  for (int s4 = 0; s4 < 4; ++s4) {
    const int j0 = s4 * 32 + q * 8;
    bf16x8 xa = ld8g(XT + (size_t)(h * 64 + wave * 16 + l15) * 128 + j0), a0, a1;
#pragma unroll
    for (int jj = 0; jj < 8; ++jj) { float x = bf2f((bf16_t)xa[jj]); a0[jj] = (short)f2bf(x * f[512 + j0 + jj]); a1[jj] = (short)f2bf(x * f[640 + j0 + jj]); }
#pragma unroll
    for (int n = 0; n < 8; ++n) { bf16x8 bb = ld8g(XT + (size_t)(512 + grp * 128 + n * 16 + l15) * 128 + j0);
      acc[0][n] = MFMA16(a0, bb, acc[0][n]); acc[1][n] = MFMA16(a1, bb, acc[1][n]); }
  }
#pragma unroll
  for (int d = 0; d < 2; ++d) {
    const int cs = cscan(d, co, CTX_ / 128, SEQ_ / 128);
    float* ST = (float*)(p.ws + Ws::SST) + ((size_t)((d * B_ + b) * NC128 + cs) * 8 + h) * 8192;
#pragma unroll
    for (int n = 0; n < 8; ++n)
#pragma unroll
      for (int r = 0; r < 4; ++r) ST[(wave * 16 + q * 4 + r) * 128 + n * 16 + l15] = acc[d][n][r];
    if (tid == 0) ((float*)(p.ws + Ws::SCD))[((size_t)(d * B_ + b) * NC128 + cs) * 8 + h] = expf(f[d * 128 + 127]);
  }
}
#define SSD_SB ((NC128 % 17) == 0 ? 17 : NC128)
DEVFN void ssd_scan(const Params& p, int gtid, int gthreads) {
  const float* __restrict__ ST = (const float*)(p.ws + Ws::SST); const float* __restrict__ CD = (const float*)(p.ws + Ws::SCD); bf16_t* __restrict__ HIN = (bf16_t*)(p.ws + Ws::HIN);
  for (int e = gtid; e < 2 * B_ * 8 * 8192; e += gthreads) {
    const int pd = e & 8191, h = (e >> 13) & 7, db = e >> 16;
    float hv = 0.f;
#pragma unroll 1
    for (int c0 = 0; c0 < NC128; c0 += SSD_SB) {
      float st[SSD_SB], cd[SSD_SB];
#pragma unroll
      for (int i = 0; i < SSD_SB; ++i) { st[i] = ST[((size_t)(db * NC128 + c0 + i) * 8 + h) * 8192 + pd]; cd[i] = CD[(size_t)(db * NC128 + c0 + i) * 8 + h]; }
#pragma unroll
      for (int i = 0; i < SSD_SB; ++i) { HIN[((size_t)(db * NC128 + c0 + i) * 8 + h) * 8192 + pd] = f2bf(hv); hv = hv * cd[i] + st[i]; }
    }
  }
}
DEVFN void ssd_out(const Params& p, int l, int unit, unsigned char* smem) {
  const int tid = TIDX, lane = tid & 63, wave = tid >> 6, q = lane >> 4, l15 = lane & 15;
  const int h = unit & 7, co = (unit >> 3) % NC128, b = unit / (8 * NC128), grp = h >> 2;
  float* f = (float*)smem;
  ssd_chunk_scalars(p, l, b, co, h, f);
  if (tid < 128) f[640 + tid] = f[128 + 127] - (tid > 0 ? f[128 + tid - 1] : 0.f);
  __syncthreads();
  const float* cum0 = f; const float* suf1 = f + 640; const float* dt0 = f + 256; const float* dt1 = f + 384;
  const bf16_t* XBC = (const bf16_t*)(p.ws + Ws::XBC) + (size_t)(b * T_ + co * 128) * 1024;
  const bf16_t* XT = (const bf16_t*)(p.ws + Ws::XBCT) + (size_t)(b * NC128 + co) * 768 * 128;
  const bf16_t* Cb = XBC + (size_t)(wave * 32 + l15) * 1024 + 768 + grp * 128 + q * 8;
  f32x4 y[4][2];
  { f32x4 o0[4][2], o1[4][2];
#pragma unroll
    for (int mp = 0; mp < 4; ++mp)
#pragma unroll
      for (int ni = 0; ni < 2; ++ni) { o0[mp][ni] = f32x4{0.f, 0.f, 0.f, 0.f}; o1[mp][ni] = f32x4{0.f, 0.f, 0.f, 0.f}; }
    const int cs0 = cscan(0, co, CTX_ / 128, SEQ_ / 128), cs1 = cscan(1, co, CTX_ / 128, SEQ_ / 128);
    const bf16_t* H0 = (const bf16_t*)(p.ws + Ws::HIN) + ((size_t)((0 * B_ + b) * NC128 + cs0) * 8 + h) * 8192;
    const bf16_t* H1 = (const bf16_t*)(p.ws + Ws::HIN) + ((size_t)((1 * B_ + b) * NC128 + cs1) * 8 + h) * 8192;
#pragma unroll 1
    for (int s4 = 0; s4 < 4; ++s4) { const bf16x8 c0 = ld8g(Cb + s4 * 32), c1 = ld8g(Cb + 16 * 1024 + s4 * 32);
#pragma unroll
      for (int mp = 0; mp < 4; ++mp) { bf16x8 h0 = ld8g(H0 + (size_t)(mp * 16 + l15) * 128 + s4 * 32 + q * 8), h1 = ld8g(H1 + (size_t)(mp * 16 + l15) * 128 + s4 * 32 + q * 8);
        o0[mp][0] = MFMA16(h0, c0, o0[mp][0]); o0[mp][1] = MFMA16(h0, c1, o0[mp][1]);
        o1[mp][0] = MFMA16(h1, c0, o1[mp][0]); o1[mp][1] = MFMA16(h1, c1, o1[mp][1]); } }
#pragma unroll
    for (int ni = 0; ni < 2; ++ni) { const int i = wave * 32 + ni * 16 + l15; const float e0 = expf(cum0[i]), e1 = expf(suf1[i]);
#pragma unroll
      for (int mp = 0; mp < 4; ++mp)
#pragma unroll
        for (int r = 0; r < 4; ++r) y[mp][ni][r] = e0 * o0[mp][ni][r] + e1 * o1[mp][ni][r]; } }
  bf16x8 mfr[4][2];
  { f32x4 g[8][2];
#pragma unroll
    for (int mj = 0; mj < 8; ++mj) { g[mj][0] = f32x4{0.f, 0.f, 0.f, 0.f}; g[mj][1] = f32x4{0.f, 0.f, 0.f, 0.f}; }
#pragma unroll 1
    for (int s4 = 0; s4 < 4; ++s4) { const bf16x8 c0 = ld8g(Cb + s4 * 32), c1 = ld8g(Cb + 16 * 1024 + s4 * 32);
#pragma unroll
      for (int mj = 0; mj < 8; ++mj) { bf16x8 bb = ld8g(XBC + (size_t)(mj * 16 + l15) * 1024 + 512 + grp * 128 + s4 * 32 + q * 8);
        g[mj][0] = MFMA16(bb, c0, g[mj][0]); g[mj][1] = MFMA16(bb, c1, g[mj][1]); } }
    const int i0 = wave * 32 + l15, i1 = i0 + 16;
    const float c0i0 = cum0[i0], s1i0 = suf1[i0], c0i1 = cum0[i1], s1i1 = suf1[i1];
#pragma unroll
    for (int mj = 0; mj < 8; ++mj)
#pragma unroll
      for (int r = 0; r < 4; ++r) { const int j = mj * 16 + q * 4 + r;
        const float cj = cum0[j], sj = suf1[j], d0 = dt0[j], d1 = dt1[j];
        const float lw0 = (j <= i0 ? expf(c0i0 - cj) * d0 : 0.f) + (j >= i0 ? expf(s1i0 - sj) * d1 : 0.f);
        const float lw1 = (j <= i1 ? expf(c0i1 - cj) * d0 : 0.f) + (j >= i1 ? expf(s1i1 - sj) * d1 : 0.f);
        mfr[mj >> 1][0][(mj & 1) * 4 + r] = (short)f2bf(g[mj][0][r] * lw0);
        mfr[mj >> 1][1][(mj & 1) * 4 + r] = (short)f2bf(g[mj][1][r] * lw1); } }
#pragma unroll
  for (int s4 = 0; s4 < 4; ++s4)
#pragma unroll
    for (int mp = 0; mp < 4; ++mp) { const bf16_t* xr = XT + (size_t)(h * 64 + mp * 16 + l15) * 128 + s4 * 32 + q * 4;
      bf16x8 xa = ld4x2g(xr, xr + 16);
      y[mp][0] = MFMA16(xa, mfr[s4][0], y[mp][0]); y[mp][1] = MFMA16(xa, mfr[s4][1], y[mp][1]); }
  __syncthreads();
  float* yl = f + 1024;
#pragma unroll
  for (int mp = 0; mp < 4; ++mp)
#pragma unroll
    for (int ni = 0; ni < 2; ++ni)
#pragma unroll
      for (int r = 0; r < 4; ++r) yl[(wave * 32 + ni * 16 + l15) * 65 + mp * 16 + q * 4 + r] = y[mp][ni][r];
  __syncthreads();
  float* YS = (float*)(p.ws + Ws::YS) + (size_t)(b * T_ + co * 128) * 512 + h * 64;
  for (int e = tid; e < 128 * 64; e += 256) YS[(size_t)(e >> 6) * 512 + (e & 63)] = yl[(e >> 6) * 65 + (e & 63)];
}

#define GQ_LD 40
#define GK_LD 72
DEVFN void gla_chunk(const Params& p, int unit, unsigned char* smem) {
  const int tid = TIDX, lane = tid & 63, wave = tid >> 6, q = lane >> 4, l15 = lane & 15;
  const int h = unit & 3, co = (unit >> 2) % NC64, b = unit / (4 * NC64);
  const bf16_t* ZX = (const bf16_t*)(p.ws + Ws::ZX) + (size_t)(b * T_ + co * 64) * NIN_;
  const float* LA = (const float*)(p.ws + Ws::LA);
  float* cum = (float*)smem;
  bf16_t* qs = (bf16_t*)(smem + 16384);
  bf16_t* ks = qs + 2 * 64 * GQ_LD;
  bf16_t* kt = ks + 2 * 64 * GQ_LD;
  __syncthreads();
  for (int e = tid; e < 2 * 64 * 32; e += 256) { const int d = e >> 11, i = (e >> 5) & 63, dd = e & 31;
    cum[e] = LA[((size_t)d * NT_ + b * T_ + co * 64 + i) * 128 + h * 32 + dd]; }
  __syncthreads();
  if (tid < 64) { const int d = tid >> 5, dd = tid & 31; float* c = cum + d * 2048 + dd; float sacc = 0.f;
    if (d == 0) for (int i = 0; i < 64; ++i) { sacc += c[i * 32]; c[i * 32] = sacc; }
    else for (int i = 63; i >= 0; --i) { sacc += c[i * 32]; c[i * 32] = sacc; } }
  __syncthreads();
  bf16_t* QT = (bf16_t*)(p.ws + Ws::QT);
  for (int e = tid; e < 64 * 32; e += 256) { const int i = e >> 5, dd = e & 31;
    const float qv = bf2f(ZX[(size_t)i * NIN_ + OGQ + h * 32 + dd]) * 0.17677669529663687f, kv = bf2f(ZX[(size_t)i * NIN_ + OGK + h * 32 + dd]);
    const float c0 = cum[i * 32 + dd], c1 = cum[2048 + i * 32 + dd], t0 = cum[63 * 32 + dd], t1 = cum[2048 + dd];
    const bf16_t q0 = f2bf(qv * expf(c0)), q1 = f2bf(qv * expf(c1));
    qs[i * GQ_LD + dd] = q0; qs[64 * GQ_LD + i * GQ_LD + dd] = q1;
    ks[i * GQ_LD + dd] = f2bf(kv * expf(-c0)); ks[64 * GQ_LD + i * GQ_LD + dd] = f2bf(kv * expf(-c1));
    kt[dd * GK_LD + i] = f2bf(kv * expf(t0 - c0)); kt[32 * GK_LD + dd * GK_LD + i] = f2bf(kv * expf(t1 - c1));
    const size_t tok = (size_t)b * T_ + co * 64 + i;
    QT[tok * 128 + h * 32 + dd] = q0; QT[((size_t)NT_ + tok) * 128 + h * 32 + dd] = q1; }
  if (tid < 64) { const int d = tid >> 5, dd = tid & 31; const int cs = cscan(d, co, CTX_ / 64, SEQ_ / 64);
    ((float*)(p.ws + Ws::GCD))[(((size_t)(d * B_ + b) * NC64 + cs) * 4 + h) * 32 + dd] = expf(d == 0 ? cum[63 * 32 + dd] : cum[2048 + dd]); }
  __syncthreads();
  bf16x8 pfr[2];
  { f32x4 p0[4], p1[4];
    const bf16x8 qb0 = ld8(qs + (wave * 16 + l15) * GQ_LD + q * 8), qb1 = ld8(qs + 64 * GQ_LD + (wave * 16 + l15) * GQ_LD + q * 8);
#pragma unroll
    for (int mj = 0; mj < 4; ++mj) { p0[mj] = MFMA16(ld8(ks + (mj * 16 + l15) * GQ_LD + q * 8), qb0, (f32x4{0.f, 0.f, 0.f, 0.f}));
      p1[mj] = MFMA16(ld8(ks + 64 * GQ_LD + (mj * 16 + l15) * GQ_LD + q * 8), qb1, (f32x4{0.f, 0.f, 0.f, 0.f})); }
    const int i = wave * 16 + l15;
#pragma unroll
    for (int mj = 0; mj < 4; ++mj)
#pragma unroll
      for (int r = 0; r < 4; ++r) { const int j = mj * 16 + q * 4 + r; pfr[mj >> 1][(mj & 1) * 4 + r] = (short)f2bf((j <= i ? p0[mj][r] : 0.f) + (j >= i ? p1[mj][r] : 0.f)); } }
  const bf16_t* VT = (const bf16_t*)(p.ws + Ws::VT) + ((size_t)(b * NC64 + co) * 256 + h * 64) * 64;
  f32x4 o[4];
#pragma unroll
  for (int md = 0; md < 4; ++md) { o[md] = f32x4{0.f, 0.f, 0.f, 0.f};
#pragma unroll
    for (int s2 = 0; s2 < 2; ++s2) { const bf16_t* vr = VT + (size_t)(md * 16 + l15) * 64 + s2 * 32 + q * 4; o[md] = MFMA16(ld4x2g(vr, vr + 16), pfr[s2], o[md]); } }
#pragma unroll
  for (int d = 0; d < 2; ++d) { const int cs = cscan(d, co, CTX_ / 64, SEQ_ / 64);
    float* GST = (float*)(p.ws + Ws::GST) + (((size_t)(d * B_ + b) * NC64 + cs) * 4 + h) * 2048;
#pragma unroll
    for (int nd = 0; nd < 2; ++nd) { f32x4 st = f32x4{0.f, 0.f, 0.f, 0.f};
#pragma unroll
      for (int s2 = 0; s2 < 2; ++s2) st = MFMA16(ld8g(VT + (size_t)(wave * 16 + l15) * 64 + s2 * 32 + q * 8), ld8(kt + d * 32 * GK_LD + (nd * 16 + l15) * GK_LD + s2 * 32 + q * 8), st);
#pragma unroll
      for (int r = 0; r < 4; ++r) GST[(wave * 16 + q * 4 + r) * 32 + nd * 16 + l15] = st[r]; } }
  __syncthreads();
  float* ol = (float*)smem;
#pragma unroll
  for (int md = 0; md < 4; ++md)
#pragma unroll
    for (int r = 0; r < 4; ++r) ol[(wave * 16 + l15) * 65 + md * 16 + q * 4 + r] = o[md][r];
  __syncthreads();
  float* OI = (float*)(p.ws + Ws::OI) + (size_t)(b * T_ + co * 64) * 256 + h * 64;
  for (int e = tid; e < 64 * 64; e += 256) OI[(size_t)(e >> 6) * 256 + (e & 63)] = ol[(e >> 6) * 65 + (e & 63)];
}
#define GLA_SB ((NC64 % 17) == 0 ? 17 : NC64)
DEVFN void gla_scan(const Params& p, int gtid, int gthreads) {
  const float* __restrict__ ST = (const float*)(p.ws + Ws::GST); const float* __restrict__ CD = (const float*)(p.ws + Ws::GCD); bf16_t* __restrict__ SIN = (bf16_t*)(p.ws + Ws::GSIN);
  for (int e = gtid; e < 2 * B_ * 4 * 2048; e += gthreads) {
    const int vd = e & 2047, h = (e >> 11) & 3, db = e >> 13;
    float sv = 0.f;
#pragma unroll 1
    for (int c0 = 0; c0 < NC64; c0 += GLA_SB) {
      float st[GLA_SB], cd[GLA_SB];
#pragma unroll
      for (int i = 0; i < GLA_SB; ++i) { st[i] = ST[(((size_t)db * NC64 + c0 + i) * 4 + h) * 2048 + vd]; cd[i] = CD[(((size_t)db * NC64 + c0 + i) * 4 + h) * 32 + (vd & 31)]; }
#pragma unroll
      for (int i = 0; i < GLA_SB; ++i) { SIN[(((size_t)db * NC64 + c0 + i) * 4 + h) * 2048 + vd] = f2bf(sv); sv = sv * cd[i] + st[i]; }
    }
  }
}
DEVFN void convert_moe_weights(const Params& p, int l, unsigned char* smem, int bid, int nb);
DEVFN void phase4a(const Params& p, int l, unsigned char* smem) {
  const int n_r = B_ * 8 * NC16 / 4;
  for (int u = BIDX; u < n_r; u += gridDim.x) rwkv_chunk(p, (u) * 4, smem);
  (void)l;
}
DEVFN void phase4b(const Params& p, int l, unsigned char* smem) {
  const int bid = BIDX, nrw = B_ * 8, G = (int)gridDim.x;
  const int n_s = B_ * NC128 * 8, n_g = B_ * NC64 * 4;
  int ob = bid, on = G;
  if (G >= 8 * nrw) {
    if (bid < 4 * nrw) { if ((TIDX >> 6) == 0) rwkv_scan(p, bid >> 2, bid & 3); return; }
    ob = bid - 4 * nrw; on = G - 4 * nrw; }
  else { for (int u = bid; u < nrw; u += G) rwkv_scan(p, u, TIDX >> 6); }
  for (int u = ob; u < n_s + n_g; u += on) { if (u < n_s) ssd_states(p, l, u, smem); else gla_chunk(p, u - n_s, smem); }
  convert_moe_weights(p, l, smem, ob, on);
}
DEVFN void phase4b2(const Params& p) {
  const int bid = BIDX, G = (int)gridDim.x;
  ssd_scan(p, bid * 256 + TIDX, G * 256); gla_scan(p, bid * 256 + TIDX, G * 256);
}
DEVFN void phase4c(const Params& p, int l, unsigned char* smem) {
  const int n_s = B_ * NC128 * 8, n_r = B_ * 8 * NC16 / 4;
  for (int u = BIDX; u < n_s + n_r; u += gridDim.x) { if (u < n_s) ssd_out(p, l, u, smem); else rwkv_out(p, (u - n_s) * 4); }
}

DEVFN void phase5(const Params& p, int l, unsigned char* smem) {
  const int tid = TIDX, lane = tid & 63, wave = tid >> 6;
  const bf16_t* ZX = (const bf16_t*)(p.ws + Ws::ZX);
  const bf16_t* XBC = (const bf16_t*)(p.ws + Ws::XBC);
  const float* YS = (const float*)(p.ws + Ws::YS); const float* YR = (const float*)(p.ws + Ws::YR); const float* OI = (const float*)(p.ws + Ws::OI);
  const bf16_t* QT = (const bf16_t*)(p.ws + Ws::QT); const bf16_t* GSIN = (const bf16_t*)(p.ws + Ws::GSIN);
  const bf16_t* RR = (const bf16_t*)(p.ws + Ws::RR); const bf16_t* VV = (const bf16_t*)(p.ws + Ws::VV); const bf16_t* KD = (const bf16_t*)(p.ws + Ws::KD);
  const float* GATE = (const float*)(p.ws + Ws::GATE);
  bf16_t* YM = (bf16_t*)(p.ws + Ws::YMIX);
  float* red = (float*)smem;
  float* qt = red + 16;
  const float dA = INP(I_SSDD)[(size_t)l * 8 + (tid >> 6)], dB = INP(I_SSDD)[(size_t)l * 8 + 4 + (tid >> 6)];
  const float nwA = INP(I_SSDNW)[(size_t)l * 512 + tid], nwB = INP(I_SSDNW)[(size_t)l * 512 + 256 + tid];
  const float lnw = INP(I_LNXW)[(size_t)l * 256 + tid], lnb = INP(I_LNXB)[(size_t)l * 256 + tid], rk = INP(I_RK)[(size_t)l * 256 + tid];
  const float gnw = INP(I_GNW)[(size_t)l * 256 + tid];
  const int per_ = (NT_ / 2 + (int)gridDim.x - 1) / (int)gridDim.x, tp_lo = BIDX * per_, tp_hi = (tp_lo + per_ < NT_ / 2) ? tp_lo + per_ : NT_ / 2;
  for (int tp = tp_lo; tp < tp_hi; ++tp) {
    float ys0[2], ys1[2], x0[2], x1[2], z0[2], z1[2], og[2], yr[2], rr[2], kf[2], kb[2], vv[2], gt[2], oi[2], qv[2];
    bf16x8 gs[2][2][4];
#pragma unroll
    for (int t = 0; t < 2; ++t) { const int tok = tp * 2 + t; const int b = tok / T_, co = (tok % T_) / 64;
      ys0[t] = gptr(YS)[(size_t)tok * 512 + tid]; ys1[t] = gptr(YS)[(size_t)tok * 512 + 256 + tid];
      x0[t] = bf2f(gptr(XBC)[(size_t)tok * 1024 + tid]); x1[t] = bf2f(gptr(XBC)[(size_t)tok * 1024 + 256 + tid]);
      z0[t] = zxv(ZX, tok, OZ + tid); z1[t] = zxv(ZX, tok, OZ + 256 + tid); og[t] = zxv(ZX, tok, OOG + tid);
      yr[t] = gptr(YR)[(size_t)tok * 256 + tid] + gptr(YR)[((size_t)NT_ + tok) * 256 + tid];
      rr[t] = bf2f(gptr(RR)[(size_t)tok * 256 + tid]); kf[t] = bf2f(gptr(KD)[(size_t)tok * 256 + tid]); kb[t] = bf2f(gptr(KD)[((size_t)NT_ + tok) * 256 + tid]);
      vv[t] = bf2f(gptr(VV)[(size_t)tok * 256 + tid]); gt[t] = gptr(GATE)[(size_t)tok * 256 + tid]; oi[t] = gptr(OI)[(size_t)tok * 256 + tid];
      qv[t] = bf2f(gptr(QT)[((size_t)(tid >> 7) * NT_ + tok) * 128 + (tid & 127)]);
#pragma unroll
      for (int d = 0; d < 2; ++d) { const int cs = cscan(d, co, CTX_ / 64, SEQ_ / 64);
        const bf16_t* sr = GSIN + ((((size_t)(d * B_ + b) * NC64 + cs) * 4 + wave) * 64 + lane) * 32;
#pragma unroll
        for (int c8 = 0; c8 < 4; ++c8) gs[t][d][c8] = ld8g(sr + c8 * 8); } }
    float ya[2], yb[2], qa[2], qb[2];
#pragma unroll
    for (int t = 0; t < 2; ++t) {
      ya[t] = (ys0[t] + dA * x0[t]) * siluf_(z0[t]); yb[t] = (ys1[t] + dB * x1[t]) * siluf_(z1[t]);
      qa[t] = wave_sum(ya[t] * ya[t]); qb[t] = wave_sum(yb[t] * yb[t]); }
    __syncthreads();
#pragma unroll
    for (int t = 0; t < 2; ++t) {
      if (lane == 0) { red[t * 8 + wave] = qa[t]; red[t * 8 + 4 + wave] = qb[t]; }
      qt[t * 256 + tid] = qv[t]; }
    __syncthreads();
#pragma unroll
    for (int t = 0; t < 2; ++t) { const int tok = tp * 2 + t;
      const float* rd = red + t * 8; const float* qtt = qt + t * 256;
      float ma = (rd[0] + rd[1] + rd[2] + rd[3]) * (1.f / 256.f), mb = (rd[4] + rd[5] + rd[6] + rd[7]) * (1.f / 256.f);
      YM[(size_t)tok * 1024 + tid] = f2bf(ya[t] * rsqrtf(ma + 1e-5f) * nwA);
      YM[(size_t)tok * 1024 + 256 + tid] = f2bf(yb[t] * rsqrtf(mb + 1e-5f) * nwB);
      { const float y = yr[t];
        float mu = wave_sum(y) * (1.f / 64.f), d = y - mu, var = wave_sum(d * d) * (1.f / 64.f);
        float yn = d * rsqrtf(var + 64e-5f) * lnw + lnb;
        float bonus = wave_sum(rr[t] * (kf[t] + kb[t]) * rk) * vv[t];
        YM[(size_t)tok * 1024 + 512 + tid] = f2bf((yn + bonus) * gt[t]); }
      { float o = oi[t];
#pragma unroll
        for (int d = 0; d < 2; ++d)
#pragma unroll
          for (int c8 = 0; c8 < 4; ++c8)
#pragma unroll
            for (int jj = 0; jj < 8; ++jj) o += qtt[d * 128 + wave * 32 + c8 * 8 + jj] * bf2f((bf16_t)gs[t][d][c8][jj]);
        float ms = wave_sum(o * o) * (1.f / 64.f);
        YM[(size_t)tok * 1024 + 768 + tid] = f2bf(o * rsqrtf(ms + 1e-5f) * gnw * siluf_(og[t])); } }
  }
}

DEVFN void phase6(const Params& p, int l, unsigned char* smem) {
  const bf16_t* A = (const bf16_t*)(p.ws + Ws::YMIX);
  const bf16_t* W = (const bf16_t*)(p.ws + Ws::WOUT) + (size_t)l * 1024 * 1024;
  float* MIX = (float*)(p.ws + Ws::MIX);
  for (int u = BIDX; u < (NT_ / 128) * 8; u += gridDim.x) {
    int rt = u / 8, ct = u % 8;
    gemm_tile(smem, 1024,
      [&](int r) { return A + (size_t)(rt * 128 + r) * 1024; },
      [&](int r) { return W + (size_t)(ct * 128 + r) * 1024; },
      [&](f32x4 (&acc)[4][4], int wr, int wc, int g, int l15) {
#pragma unroll
        for (int mi = 0; mi < 4; ++mi)
#pragma unroll
          for (int ni = 0; ni < 4; ++ni)
#pragma unroll
            for (int i = 0; i < 4; ++i) MIX[(size_t)(rt * 128 + wr * 64 + mi * 16 + 4 * g + i) * 1024 + ct * 128 + wc * 64 + ni * 16 + l15] = acc[mi][ni][i];
      });
  }
}

#define P7_MAXE 2048
DEVFN void phase7(const Params& p, int l, unsigned char* smem) {
  const int lane = TIDX & 63, wave = TIDX >> 6;
  float* X = (float*)(p.ws + Ws::X);
  const float* MIX = (const float*)(p.ws + Ws::MIX);
  bf16_t* H = (bf16_t*)(p.ws + Ws::U);
  const float* rwt = (const float*)(p.ws + Ws::RWT) + (size_t)l * 64 * 1024;
  int* cnt = (int*)(p.ws + Ws::CNT) + l * 64 * 64;
  int* ltok = (int*)(p.ws + Ws::LTOK); float* lwt = (float*)(p.ws + Ws::LWT);
  const float rbias = INP(I_RB)[(size_t)l * 64 + lane];
  float* hs = (float*)smem;
  float* lg = hs + 4096;
  int* lcnt = (int*)(lg + 256);
  int* lbase = lcnt + 80;
  int* etok = lbase + 64;
  int* epos = etok + P7_MAXE; float* ewt = (float*)(epos + P7_MAXE);
  for (int i = TIDX; i < 80; i += 256) lcnt[i] = 0;
  for (int tok0 = BIDX * 4; tok0 < NT_; tok0 += gridDim.x * 4) {
    const int tok = tok0 + wave;
    const float* mod = (const float*)(p.ws + Ws::MOD) + ((size_t)l * NR_ + tok_modrow(tok)) * NMOD_;
    float xv[16], mx[16], g1[16], lw[16], lb[16], sh2[16], sc2[16], mean, rstd;
    load_row16(X + (size_t)tok * 1024, lane, xv);
    load_row16(MIX + (size_t)tok * 1024, lane, mx);
    load_row16(mod + 2 * 1024, lane, g1);
    load_row16(INP(I_LN1W) + (size_t)l * 1024, lane, lw);
    load_row16(INP(I_LN1B) + (size_t)l * 1024, lane, lb);
    load_row16(mod + 3 * 1024, lane, sh2);
    load_row16(mod + 4 * 1024, lane, sc2);
#pragma unroll
    for (int i = 0; i < 16; ++i) xv[i] = ALPHA_ * xv[i] + g1[i] * mx[i];
    row_stats(xv, mean, rstd);
#pragma unroll
    for (int i = 0; i < 16; ++i) xv[i] = (xv[i] - mean) * rstd * lw[i] + lb[i];
#pragma unroll
    for (int j = 0; j < 4; ++j) *(float4*)(X + (size_t)tok * 1024 + lane * 4 + 256 * j) = make_float4(xv[4 * j], xv[4 * j + 1], xv[4 * j + 2], xv[4 * j + 3]);
    const bool routed = !(l == DEPTH_ - 1 && (tok % T_) < CTX_);
    row_stats(xv, mean, rstd);
#pragma unroll
    for (int i = 0; i < 16; ++i) xv[i] = (xv[i] - mean) * rstd * (1.f + sc2[i]) + sh2[i];
    __syncthreads();
#pragma unroll
    for (int j = 0; j < 4; ++j) {
      if (routed) *(uint2*)(H + (size_t)tok * 1024 + lane * 4 + 256 * j) = make_uint2((unsigned)f2bf(xv[4 * j]) | ((unsigned)f2bf(xv[4 * j + 1]) << 16), (unsigned)f2bf(xv[4 * j + 2]) | ((unsigned)f2bf(xv[4 * j + 3]) << 16));
      *(float4*)(hs + wave * 1024 + lane * 4 + 256 * j) = make_float4(xv[4 * j], xv[4 * j + 1], xv[4 * j + 2], xv[4 * j + 3]); }
    __syncthreads();
    { float hv[4][16];
      const int rot = BIDX & 15;
#pragma unroll
      for (int t = 0; t < 4; ++t)
#pragma unroll
        for (int j = 0; j < 4; ++j) { const float4 v = *(const float4*)(hs + t * 1024 + lane * 4 + 256 * j); hv[t][4 * j] = v.x; hv[t][4 * j + 1] = v.y; hv[t][4 * j + 2] = v.z; hv[t][4 * j + 3] = v.w; }
      float pe[64];
      const AS1 float* rw = gptr(rwt) + lane * 4;
      f32x4 w[4], wn[4];
#pragma unroll
      for (int j = 0; j < 4; ++j) w[j] = *(const AS1 f32x4*)(rw + (size_t)(16 * wave + (rot & 15)) * 1024 + 256 * j);
#pragma unroll
      for (int e = 0; e < 16; ++e) {
        if (e + 1 < 16) {
#pragma unroll
          for (int j = 0; j < 4; ++j) wn[j] = *(const AS1 f32x4*)(rw + (size_t)(16 * wave + ((e + 1 + rot) & 15)) * 1024 + 256 * j); }
#pragma unroll
        for (int t = 0; t < 4; ++t) { float s0 = 0.f, s1 = 0.f;
#pragma unroll
          for (int j = 0; j < 4; ++j) { s0 += hv[t][4 * j] * w[j][0] + hv[t][4 * j + 2] * w[j][2]; s1 += hv[t][4 * j + 1] * w[j][1] + hv[t][4 * j + 3] * w[j][3]; }
          pe[e * 4 + t] = s0 + s1; }
#pragma unroll
        for (int j = 0; j < 4; ++j) w[j] = wn[j]; }
#pragma unroll
      for (int half = 32; half >= 1; half >>= 1) { const bool up = (lane & half) != 0;
#pragma unroll
        for (int e = 0; e < half; ++e) { const float send = up ? pe[e] : pe[e + half]; const float recv = __shfl_xor(send, half); pe[e] = (up ? pe[e + half] : pe[e]) + recv; } }
      lg[(lane & 3) * 64 + 16 * wave + (((lane >> 2) + rot) & 15)] = pe[0]; }
    __syncthreads();
    if (!routed) continue;
    const float logit = lg[wave * 64 + lane];
    const float score = sigmoidf_(logit), sel = score + rbias;
    float m1 = sel; int a1 = lane;
#pragma unroll
    for (int m = 1; m <= 4; m <<= 1) { float ov = XOR8(m1, m); int oa = XOR8(a1, m); if (ov > m1 || (ov == m1 && oa < a1)) { m1 = ov; a1 = oa; } }
    float m2 = (lane == a1) ? -3.0e38f : sel;
#pragma unroll
    for (int m = 1; m <= 4; m <<= 1) m2 = fmaxf(m2, XOR8(m2, m));
    const float gs = m1 + m2; const int grp = lane >> 3;
    int grank = 0;
#pragma unroll
    for (int g2 = 0; g2 < 8; ++g2) { float og = SHFL_CONST(gs, g2 * 8); grank += (og > gs || (og == gs && g2 < grp)) ? 1 : 0; }
    const bool gsel = grank < 4;
    const float msel = gsel ? sel : -3.0e38f;
    int rank = 0;
#pragma unroll
    for (int e = 0; e < 64; ++e) { float ov = SHFL_CONST(msel, e); rank += (ov > msel || (ov == msel && e < lane)) ? 1 : 0; }
    const bool chosen = gsel && rank < 8;
    const float wsum = wave_sum(chosen ? score : 0.f);
    if (chosen) { const float wv = score / wsum * 2.5f;
      const int idx = atomicAdd(&lcnt[64], 1);
      if (idx < P7_MAXE) { const int slot = atomicAdd(&lcnt[lane], 1); etok[idx] = tok * 8 + rank; epos[idx] = lane | (slot << 8); ewt[idx] = wv; }
      else { int pos = atomicAdd(&cnt[lane * 64], 1); ltok[(size_t)lane * NT_ + pos] = tok * 8 + rank; lwt[(size_t)lane * NT_ + pos] = wv; } }
  }
  __syncthreads();
  if (TIDX < 64) { const int c = lcnt[TIDX]; lbase[TIDX] = c ? atomicAdd(&cnt[TIDX * 64], c) : 0; }
  __syncthreads();
  { const int ne = lcnt[64] < P7_MAXE ? lcnt[64] : P7_MAXE;
    for (int i = TIDX; i < ne; i += 256) { const int e = epos[i] & 255, pos = lbase[e] + (epos[i] >> 8);
      ltok[(size_t)e * NT_ + pos] = etok[i]; lwt[(size_t)e * NT_ + pos] = ewt[i]; } }
}

struct MoeMap { int nblk_total; int e; int rb; int cnt; int hoff; };
DEVFN int moe_ntok(int l) { return l == DEPTH_ - 1 ? B_ * SEQ_ : NT_; }
DEVFN int moe_shared_tok(int l, int i) { return l == DEPTH_ - 1 ? (i / SEQ_) * T_ + CTX_ + (i % SEQ_) : i; }
DEVFN void moe_prefix(const Params& p, int l, int* pre) {
  const int* cnt = (const int*)(p.ws + Ws::CNT) + l * 64 * 64;
  __syncthreads();
  if (TIDX < 64) pre[66 + TIDX] = gptr(cnt)[TIDX * 64];
  if (TIDX == 64) pre[66 + 64] = moe_ntok(l);
  __syncthreads();
  if (TIDX == 0) { int s = 0; for (int e = 0; e < 65; ++e) { pre[e] = s; s += (pre[66 + e] + 127) / 128; } pre[65] = s; }
  __syncthreads();
}
DEVFN void phase8(const Params& p, int l, unsigned char* smem) {
  int* pre = (int*)(smem + SM_PRE);
  moe_prefix(p, l, pre);
  const bf16_t* H = (const bf16_t*)(p.ws + Ws::U);
  const bf16_t* W13 = (const bf16_t*)(p.ws + Ws::W13);
  bf16_t* HID = (bf16_t*)(p.ws + Ws::HID);
  const int* ltok = (const int*)(p.ws + Ws::LTOK); const float* lwt = (const float*)(p.ws + Ws::LWT);
  const int total = pre[65];
  for (int u = BIDX; u < total * 4; u += gridDim.x) {
    const int gb = u >> 2, nt = u & 3;
    int e = 0; while (pre[e + 1] <= gb) ++e;
    const int rb = gb - pre[e], cnt = pre[66 + e];
    int* tk_s = (int*)(smem + GEMM_SMEM); float* gw_s = (float*)(tk_s + 128);
    __syncthreads();
    if (TIDX < 128) { const int pos = rb * 128 + TIDX; int tk = -1; float gw = 0.f;
      if (pos < cnt) { tk = e < 64 ? (gptr(ltok)[(size_t)e * NT_ + pos] >> 3) : moe_shared_tok(l, pos); gw = e < 64 ? gptr(lwt)[(size_t)e * NT_ + pos] : 1.f; }
      tk_s[TIDX] = tk; gw_s[TIDX] = gw; }
    __syncthreads();
    gemm_tile(smem, 1024,
      [&](int r) { const int tk = tk_s[r]; return tk >= 0 ? H + (size_t)tk * 1024 : (const bf16_t*)(p.ws + Ws::ZROW); },
      [&](int r) { return W13 + ((size_t)e * 512 + nt * 128 + r) * 1024; },
      [&](f32x4 (&acc)[4][4], int wr, int wc, int g, int l15) {
        tile_store_bf16<8>(smem, wr, g, l15,
          [&](bf16_t* T, int ldc) {
#pragma unroll
            for (int mi = 0; mi < 4; ++mi)
#pragma unroll
              for (int i = 0; i < 4; ++i) { const int r = wr * 64 + mi * 16 + 4 * g + i, pos = rb * 128 + r;
                const float gw = gw_s[r]; (void)pos;
#pragma unroll
                for (int j = 0; j < 2; ++j) T[r * ldc + wc * 32 + j * 16 + l15] = f2bf(siluf_(acc[mi][2 * j][i]) * acc[mi][2 * j + 1][i] * gw); } },
          [&](int row, int c0) { const int pos = rb * 128 + row; return pos < cnt ? HID + ((size_t)gb * 128 + row) * 256 + nt * 64 + c0 : (bf16_t*)nullptr; });
      });
  }
}
DEVFN void phase9(const Params& p, int l, unsigned char* smem) {
  int* pre = (int*)(smem + SM_PRE);
  moe_prefix(p, l, pre);
  const bf16_t* HID = (const bf16_t*)(p.ws + Ws::HID);
  const bf16_t* W2T = (const bf16_t*)(p.ws + Ws::W2T);
  bf16_t* YB = (bf16_t*)(p.ws + Ws::YBUF);
  const int* ltok = (const int*)(p.ws + Ws::LTOK);
  const int total = pre[65];
  for (int u = BIDX; u < total * 8; u += gridDim.x) {
    const int gb = u >> 3, nt = u & 7;
    int e = 0; while (pre[e + 1] <= gb) ++e;
    const int rb = gb - pre[e], cnt = pre[66 + e];
    int* ts_s = (int*)(smem + GEMM_SMEM);
    __syncthreads();
    if (TIDX < 128) { const int pos = rb * 128 + TIDX; int ts = -1;
      if (pos < cnt) ts = e < 64 ? gptr(ltok)[(size_t)e * NT_ + pos] : moe_shared_tok(l, pos) * 8;
      ts_s[TIDX] = ts; }
    __syncthreads();
    gemm_tile(smem, 256,
      [&](int r) { return ts_s[r] >= 0 ? HID + ((size_t)gb * 128 + r) * 256 : (const bf16_t*)(p.ws + Ws::ZROW); },
      [&](int r) { return W2T + ((size_t)e * 1024 + nt * 128 + r) * 256; },
      [&](f32x4 (&acc)[4][4], int wr, int wc, int g, int l15) {
        tile_store_bf16<16>(smem, wr, g, l15,
          [&](bf16_t* T, int ldc) {
#pragma unroll
            for (int mi = 0; mi < 4; ++mi)
#pragma unroll
              for (int ni = 0; ni < 4; ++ni)
#pragma unroll
                for (int i = 0; i < 4; ++i) T[(wr * 64 + mi * 16 + 4 * g + i) * ldc + wc * 64 + ni * 16 + l15] = f2bf(acc[mi][ni][i]); },
          [&](int row, int c0) { const int ts = ts_s[row]; if (ts < 0) return (bf16_t*)nullptr;
            const int tok = ts >> 3, slot = e < 64 ? (ts & 7) : 8;
            return YB + ((size_t)tok * NSLOT + slot) * 1024 + nt * 128 + c0; });
      });
  }
}

#define SMEM_BYTES (PH_SMEM + 2048)
#define N_PHASES (3 + 13 * DEPTH_)
__global__ void __launch_bounds__(256, 2) mega(Params p, int ph_lo, int ph_hi) {
#ifdef HIPEMU
  unsigned char* smem = hipemu::cur_smem();
#else
  unsigned char* smem = smem_dyn;
  volatile LAS unsigned* st = (volatile LAS unsigned*)(smem_dyn + SM_BAR);
  if (threadIdx.x == 0) {
    st[0] = 0u; st[1] = 0u;
    unsigned long long* tab = (unsigned long long*)(smem_dyn + SM_TAB);
#pragma unroll
    for (int i = 0; i < 40; ++i) tab[i] = (unsigned long long)p.in[i];
  }
  __syncthreads();
  XcdBarrier bar = xcd_barrier_post((unsigned*)(p.ws + Ws::BAR), st);
#define GRID_SYNC() xcd_barrier(bar)
#endif
  int ph = 0;
#ifdef ONLY_KIND
#define KIND_ON(k) ((k) == ONLY_KIND)
#else
#define KIND_ON(k) 1
#endif
#ifndef REPEAT_MASK
#define REPEAT_MASK 0u
#endif
#define RUN_PHASE(kind, code) { if (KIND_ON(kind) && ph >= ph_lo && ph < ph_hi) { \
    int nrep_ = ((REPEAT_MASK >> (kind)) & 1u) ? 2 : 1; LAUNDER(nrep_); \
    _Pragma("unroll 1") for (int rep_ = 0; rep_ < nrep_; ++rep_) { LAUNDER(p.ws); LAUNDER(p.out); code; if (rep_ + 1 < nrep_ || ph + 1 < ph_hi) { GRID_SYNC(); } } } ++ph; }
  RUN_PHASE(0, phase0(p, smem));
  RUN_PHASE(11, phase0b(p));
  for (int l = 0; l < DEPTH_; ++l) {
    RUN_PHASE(1, phase1(p, l));
    RUN_PHASE(2, phase2(p, l, smem));
    RUN_PHASE(3, phase3(p, l, smem));
    RUN_PHASE(14, phase3b(p, l, smem));
    RUN_PHASE(4, phase4a(p, l, smem));
    RUN_PHASE(12, phase4b(p, l, smem));
    RUN_PHASE(16, phase4b2(p));
    RUN_PHASE(13, phase4c(p, l, smem));
    RUN_PHASE(5, phase5(p, l, smem));
    RUN_PHASE(6, phase6(p, l, smem));
    RUN_PHASE(7, phase7(p, l, smem));
    RUN_PHASE(8, phase8(p, l, smem));
    RUN_PHASE(9, phase9(p, l, smem));
  }
  RUN_PHASE(10, phase_final(p));
}

extern "C" void kernel_launch(void* const* d_in, const int* in_sizes, int n_in, void* d_out, int out_size, void* d_ws, size_t ws_size, hipStream_t stream) {
  Params p{};
  for (int i = 0; i < 40; ++i) p.in[i] = (const float*)d_in[i];
  p.out = (float*)d_out;
  p.ws = (unsigned char*)d_ws;
  if (ws_size < Ws::END) { fprintf(stderr, "workspace too small: %zu < %zu\n", ws_size, (size_t)Ws::END); return; }
  hipMemsetAsync(d_ws, 0, Ws::ZERO_END, stream);
#ifdef HIPEMU
  int grid = 16; if (const char* e = getenv("EMU_GRID")) grid = atoi(e);
  int stop = N_PHASES; if (const char* e = getenv("EMU_STOP")) stop = atoi(e);
  if (getenv("EMU_ONE")) hipemu::launch(grid, 256, SMEM_BYTES, true, [=] { mega(p, 0, stop); });
  else for (int ph = 0; ph < stop; ++ph) hipemu::launch(grid, 256, SMEM_BYTES, false, [=] { mega(p, ph, ph + 1); });
#else
  static int grid = 0;
  if (!grid) {
    int dev = 0, cus = 0, per_cu = 0;
    hipGetDevice(&dev);
    hipDeviceGetAttribute(&cus, hipDeviceAttributeMultiprocessorCount, dev);
    hipOccupancyMaxActiveBlocksPerMultiprocessor(&per_cu, mega, 256, SMEM_BYTES);
    if (per_cu > 2) per_cu = 2;
    if (per_cu < 1) per_cu = 1;
    grid = cus * per_cu;
  }
#if N_LAUNCH_MODE == 1
  mega<<<grid, 256, SMEM_BYTES, stream>>>(p, 0, N_PHASES);
#else
  for (int ph = 0; ph < N_PHASES; ++ph) mega<<<grid, 256, SMEM_BYTES, stream>>>(p, ph, ph + 1);
#endif
#endif
}
```

```cpp
#ifndef HIPEMU
#include <hip/hip_runtime.h>
#endif
#include <stdint.h>
#include <stdio.h>

#ifndef B_
#define B_ 4
#endif
#ifndef SEQ_
#define SEQ_ 4096
#endif
#ifndef CTX_
#define CTX_ 256
#endif
#ifndef DEPTH_
#define DEPTH_ 4
#endif
#ifndef N_LAUNCH_MODE
#define N_LAUNCH_MODE 1
#endif
#define T_ (SEQ_ + CTX_)
#define NT_ (B_ * T_)
#define D_ 1024
#define NIN_ 3504
#define NMOD_ 6144
#define NR_ (B_ + 1)
#define OZ 0
#define OXBC 512
#define ODT 1536
#define ORW 1552
#define OGQ 2704
#define OGK 2832
#define OGV 2960
#define OGD 3216
#define OOG 3248
#define ALPHA_ 1.681792830507429f
#define NEXP 64
#define NSLOT 9
#define NC128 (T_ / 128)
#define NC64 (T_ / 64)
#define NC16 (T_ / 16)

#define DEVFN __device__ __forceinline__
#define LDT 72
#define GEMM_SMEM (2 * 128 * LDT * 2)
typedef unsigned short bf16_t;
#ifdef HIPEMU
#define AS1
#else
#define AS1 __attribute__((address_space(1)))
#endif
typedef unsigned u32x4 __attribute__((ext_vector_type(4)));
typedef unsigned u32x2 __attribute__((ext_vector_type(2)));

#ifdef HIPEMU
typedef emu_bf16x8 bf16x8;
typedef emu_f32x4 f32x4;
#define MFMA16(a, b, c) emu_mfma_16x16x32_bf16(a, b, c)
#define MFMA16K16(a, b, c) emu_mfma_16x16x16_bf16(a, b, c)
#define GRID_SYNC() hipemu::grid_sync()
#else
typedef short bf16x8 __attribute__((ext_vector_type(8)));
typedef float f32x4 __attribute__((ext_vector_type(4)));
#define MFMA16(a, b, c) __builtin_amdgcn_mfma_f32_16x16x32_bf16(a, b, c, 0, 0, 0)
#define MFMA16K16(a, b, c) __builtin_amdgcn_mfma_f32_16x16x16bf16_1k(a, b, c, 0, 0, 0)
#endif

DEVFN float bf2f(bf16_t h) { return __builtin_bit_cast(float, (unsigned)h << 16); }
DEVFN bf16_t f2bf(float f) { unsigned u = __builtin_bit_cast(unsigned, f); u += 0x7FFFu + ((u >> 16) & 1u); return (bf16_t)(u >> 16); }
template <class T> DEVFN AS1 T* gptr(T* q) { return (AS1 T*)q; }
DEVFN bf16x8 ld8g(const bf16_t* q) { return *(const AS1 bf16x8*)gptr(q); }
DEVFN float sigmoidf_(float x) { return 1.f / (1.f + expf(-x)); }
DEVFN float siluf_(float x) { return x / (1.f + expf(-x)); }
DEVFN float softplusf_(float x) { return x > 20.f ? x : log1pf(expf(x)); }
DEVFN float logsigmoidf_(float x) { return fminf(x, 0.f) - log1pf(expf(-fabsf(x))); }
#ifdef HIPEMU
DEVFN float wave_sum(float v) { for (int m = 32; m >= 1; m >>= 1) v += __shfl_xor(v, m); return v; }
#define SHFL_CONST(x, ln) __shfl(x, ln)
#define XOR8(x, m) __shfl_xor(x, m)
#else
template <int CTRL> DEVFN float dpp_f(float v) { return __builtin_bit_cast(float, __builtin_amdgcn_update_dpp(0, __builtin_bit_cast(int, v), CTRL, 0xF, 0xF, false)); }
template <int CTRL> DEVFN int dpp_i(int v) { return __builtin_amdgcn_update_dpp(0, v, CTRL, 0xF, 0xF, false); }
DEVFN float rdl_f(float v, int ln) { return __builtin_bit_cast(float, __builtin_amdgcn_readlane(__builtin_bit_cast(int, v), ln)); }
DEVFN float wave_sum(float v) {
  v += dpp_f<0xB1>(v);
  v += dpp_f<0x4E>(v);
  v += dpp_f<0x141>(v);
  v += dpp_f<0x140>(v);
  return (rdl_f(v, 0) + rdl_f(v, 16)) + (rdl_f(v, 32) + rdl_f(v, 48));
}
DEVFN float shfl_const_(float x, int ln) { return rdl_f(x, ln); }
DEVFN int shfl_const_(int x, int ln) { return __builtin_amdgcn_readlane(x, ln); }
#define SHFL_CONST(x, ln) shfl_const_(x, ln)
DEVFN float xor8_(float x, int m) { return m == 1 ? dpp_f<0xB1>(x) : m == 2 ? dpp_f<0x4E>(x) : dpp_f<0x141>(x); }
DEVFN int xor8_(int x, int m) { return m == 1 ? dpp_i<0xB1>(x) : m == 2 ? dpp_i<0x4E>(x) : dpp_i<0x141>(x); }
#define XOR8(x, m) xor8_(x, m)
#endif

constexpr size_t al(size_t x) { return (x + 255) & ~(size_t)255; }
struct Ws {
  static constexpr size_t BAR = 0;
  static constexpr size_t CNT = 16384;
  static constexpr size_t MOD = CNT + (size_t)DEPTH_ * 64 * 256;
  static constexpr size_t ZROW = al(MOD + (size_t)DEPTH_ * NR_ * NMOD_ * 4);
  static constexpr size_t ZERO_END = al(ZROW + 2048);
  static constexpr size_t MODP = ZERO_END;
  static constexpr size_t RWT = al(MODP + (size_t)16 * DEPTH_ * NR_ * NMOD_ * 4);
  static constexpr size_t LORA = al(RWT + (size_t)DEPTH_ * 64 * 1024 * 4);
  static constexpr size_t X = al(LORA + (size_t)DEPTH_ * 98304 * 2);
  static constexpr size_t U = al(X + (size_t)NT_ * 1024 * 4);
  static constexpr size_t YMIX = al(U + (size_t)NT_ * 1024 * 2);
  static constexpr size_t ZX = al(YMIX + (size_t)NT_ * 1024 * 2);
  static constexpr size_t MIX = ZX;
  static constexpr size_t LTOK = al(ZX + (size_t)NT_ * NIN_ * 2);
  static constexpr size_t LWT = al(LTOK + (size_t)64 * NT_ * 4);
  static constexpr size_t WIN = al(LWT + (size_t)64 * NT_ * 4);
  static constexpr size_t WOUT = al(WIN + (size_t)DEPTH_ * NIN_ * 1024 * 2);
  static constexpr size_t W13 = al(WOUT + (size_t)DEPTH_ * 1024 * 1024 * 2);
  static constexpr size_t W2T = al(W13 + (size_t)65 * 512 * 1024 * 2);
  static constexpr size_t UNI = al(W2T + (size_t)65 * 1024 * 256 * 2);
  static constexpr size_t XBC = UNI;
  static constexpr size_t XBCT = al(XBC + (size_t)NT_ * 1024 * 2);
  static constexpr size_t DTB = al(XBCT + (size_t)NT_ * 768 * 2);
  static constexpr size_t SST = al(DTB + (size_t)NT_ * 16 * 4);
  static constexpr size_t SCD = al(SST + (size_t)2 * NT_ / 128 * 8 * 8192 * 4);
  static constexpr size_t HIN = al(SCD + (size_t)2 * NT_ / 128 * 8 * 4);
  static constexpr size_t YS = SST;
  static constexpr size_t LA = al(HIN + (size_t)2 * NT_ / 128 * 8 * 8192 * 2);
  static constexpr size_t VT = al(LA + (size_t)2 * NT_ * 128 * 4);
  static constexpr size_t QT = al(VT + (size_t)NT_ * 256 * 2);
  static constexpr size_t OI = al(QT + (size_t)2 * NT_ * 128 * 2);
  static constexpr size_t GST = al(OI + (size_t)NT_ * 256 * 4);
  static constexpr size_t GCD = al(GST + (size_t)2 * NT_ / 64 * 4 * 2048 * 4);
  static constexpr size_t GSIN = al(GCD + (size_t)2 * NT_ / 64 * 4 * 32 * 4);
  static constexpr size_t RR = al(GSIN + (size_t)2 * NT_ / 64 * 4 * 2048 * 2);
  static constexpr size_t VV = RR + (size_t)NT_ * 256 * 2;
  static constexpr size_t KK = VV + (size_t)NT_ * 256 * 2;
  static constexpr size_t KD = KK + (size_t)NT_ * 256 * 2;
  static constexpr size_t BD = KD + (size_t)2 * NT_ * 256 * 2;
  static constexpr size_t LW = BD + (size_t)2 * NT_ * 256 * 2;
  static constexpr size_t GATE = LW + (size_t)2 * NT_ * 256 * 4;
  static constexpr size_t YR = GATE + (size_t)NT_ * 256 * 4;
  static constexpr size_t RML = al(YR + (size_t)2 * NT_ * 256 * 4);
  static constexpr size_t RNS = RML + (size_t)(NT_ / 16) * 8 * 4096 * 2;
  static constexpr size_t RWC = RNS + (size_t)(NT_ / 16) * 8 * 4096 * 2;
  static constexpr size_t RG = RWC + (size_t)(NT_ / 16) * 8 * 64 * 4;
  static constexpr size_t RY0 = RG + (size_t)(NT_ / 16) * 8 * 1024 * 2;
  static constexpr size_t LI = RY0 + (size_t)(NT_ / 16) * 8 * 1024 * 4;
  static constexpr size_t KRW = LI + (size_t)NT_ * 384 * 2;
  static constexpr size_t MIXER_END = KRW + (size_t)NT_ * 256 * 2;
  static constexpr size_t HID = UNI;
  static constexpr size_t YBUF = al(HID + ((size_t)NT_ * 9 + 65 * 128) * 256 * 2);
  static constexpr size_t MOE_END = YBUF + (size_t)NT_ * 9 * 1024 * 2;
  static constexpr size_t END = al(MIXER_END > MOE_END ? MIXER_END : MOE_END);
};

struct Params {
  const float* in[40];
  float* out;
  unsigned char* ws;
};
enum { I_X = 0, I_C, I_CTX, I_CCTX, I_ADAW, I_ADAB, I_WIN, I_CONVW, I_CONVB, I_DTBIAS, I_ALOG, I_SSDD, I_SSDNW, I_MU, I_W0, I_W2, I_A0, I_A2,
       I_G2, I_KKW, I_KAW, I_RK, I_LNXW, I_LNXB, I_GU, I_GB, I_GNW, I_WOUT, I_LN1W, I_LN1B, I_LN2W, I_LN2B, I_RW, I_RB, I_EW1, I_EW3, I_EW2,
       I_SW1, I_SW3, I_SW2 };

#define PH_SMEM 47104
#define SM_PRE (PH_SMEM)
#define SM_TAB (PH_SMEM + 1024)
#define SM_BAR (PH_SMEM + 2032)
#ifdef HIPEMU
#define INP(i) (p.in[i])
#define LAUNDER(x)
#define TIDX ((int)threadIdx.x)
#define BIDX ((int)blockIdx.x)
#define LAUNDER_V(x)
#else
extern __shared__ __align__(16) unsigned char smem_dyn[];
DEVFN const float* inp_lds(int i) {
  const volatile unsigned* t = (const volatile unsigned*)(smem_dyn + SM_TAB) + 2 * i;
  unsigned lo = __builtin_amdgcn_readfirstlane(t[0]), hi = __builtin_amdgcn_readfirstlane(t[1]);
  return (const float*)(((unsigned long long)hi << 32) | lo);
}
#define INP(i) inp_lds(i)
#define LAUNDER(x) asm volatile("" : "+s"(x))
DEVFN int tidx_() { int t = threadIdx.x; asm volatile("" : "+v"(t)); return t; }
DEVFN int bidx_() { int b = blockIdx.x; asm volatile("" : "+s"(b)); return b; }
#define TIDX tidx_()
#define LAUNDER_V(x) asm volatile("" : "+v"(x))
#define BIDX bidx_()
#endif
#ifndef HIPEMU
#define XB_TMO      128
#define XB_XCNT(j)  (256  + 64 * (j))
#define XB_XSUB(j)  (1280 + 64 * (j))
#define XB_XGEN(j)  (2304 + 64 * (j))
#define XB_TOP      3328
#define XB_TOPGEN   3392
#define XCD_BAR_WORDS 3456
#define XB_SPIN_CAP (1u << 22)
#define LAS __attribute__((address_space(3)))
__device__ __forceinline__ unsigned xb_ld(unsigned* p)              { return __hip_atomic_load(p, __ATOMIC_RELAXED, __HIP_MEMORY_SCOPE_AGENT); }
__device__ __forceinline__ unsigned xb_add(unsigned* p, unsigned v) { return __hip_atomic_fetch_add(p, v, __ATOMIC_RELAXED, __HIP_MEMORY_SCOPE_AGENT); }
__device__ __forceinline__ unsigned xb_xcc_id() { return (unsigned)__builtin_amdgcn_s_getreg((3 << 11) | 20) & 0xFu; }
#define XB_SPIN(cond, bar) do { unsigned _sp = 0; while (cond) { __builtin_amdgcn_s_sleep(1); \
    if ((++_sp & 255u) == 0u) { if (xb_ld(&(bar)[XB_TMO])) break; if (_sp > XB_SPIN_CAP) { atomicAdd(&(bar)[XB_TMO], 1u); break; } } } } while (0)
struct XcdBarrier { unsigned* bar; unsigned x; volatile LAS unsigned* st; };
__device__ __forceinline__ XcdBarrier xcd_barrier_post(unsigned* bar, volatile LAS unsigned* st) {
    XcdBarrier b; b.bar = bar; b.x = xb_xcc_id(); b.st = st;
    if (threadIdx.x == 0) (void)xb_add(&bar[XB_XCNT(b.x)], 1u);
    return b;
}
__device__ __forceinline__ void xcd_barrier_complete(unsigned* bar, unsigned x, unsigned& nloc, unsigned& nx) {
    const unsigned G = gridDim.x * gridDim.y * gridDim.z;
    unsigned sum, cnt, mine, sp = 0u;
    for (;;) {
        sum = 0u; cnt = 0u; mine = 0u;
#pragma unroll
        for (unsigned j = 0; j < 16; ++j) { const unsigned c = xb_ld(&bar[XB_XCNT(j)]); sum += c; cnt += (c > 0u) ? 1u : 0u; mine = (j == x) ? c : mine; }
        if (sum == G) break;
        __builtin_amdgcn_s_sleep(1);
        if ((++sp & 255u) == 0u) { if (xb_ld(&bar[XB_TMO])) break; if (sp > XB_SPIN_CAP) { atomicAdd(&bar[XB_TMO], 1u); break; } }
    }
    nloc = mine > 0u ? mine : 1u; nx = cnt > 0u ? cnt : 1u;
}
__device__ __forceinline__ void xcd_barrier(const XcdBarrier& b) {
    asm volatile("s_waitcnt vmcnt(0)" ::: "memory");
    __syncthreads();
    if (threadIdx.x == 0) {
        unsigned* bar = b.bar;
        __builtin_amdgcn_s_waitcnt(0);
        unsigned nloc = b.st[0], nx = b.st[1];
        if (nloc == 0u) { xcd_barrier_complete(bar, b.x, nloc, nx); b.st[0] = nloc; b.st[1] = nx; }
        const unsigned old = xb_add(&bar[XB_XSUB(b.x)], 1u);
        const unsigned gen = old / nloc;
        if (old + 1u == (gen + 1u) * nloc) {
            __builtin_amdgcn_fence(__ATOMIC_RELEASE, "agent");
            asm volatile("s_waitcnt vmcnt(0)" ::: "memory");
            const unsigned og = xb_add(&bar[XB_TOP], 1u);
            const unsigned tg = og / nx;
            if (og + 1u == (tg + 1u) * nx) xb_add(&bar[XB_TOPGEN], 1u);
            else XB_SPIN(xb_ld(&bar[XB_TOPGEN]) == tg, bar);
            __builtin_amdgcn_fence(__ATOMIC_ACQUIRE, "agent");
            xb_add(&bar[XB_XGEN(b.x)], 1u);
            asm volatile("s_waitcnt vmcnt(0)" ::: "memory");
        } else {
            XB_SPIN(xb_ld(&bar[XB_XGEN(b.x)]) == gen, bar);
            __builtin_amdgcn_fence(__ATOMIC_ACQUIRE, "agent");
            asm volatile("s_waitcnt vmcnt(0)" ::: "memory");
        }
    }
    __syncthreads();
}
#endif

DEVFN int tokmap(int dir, int p) { return dir == 0 ? p : (p < CTX_ ? CTX_ - 1 - p : 2 * CTX_ + SEQ_ - 1 - p); }
DEVFN const float* tok_input_row(const Params& p, int tok) {
  int b = tok / T_, t = tok % T_;
  return t < CTX_ ? INP(I_CTX) + ((size_t)b * CTX_ + t) * D_ : INP(I_X) + ((size_t)b * SEQ_ + (t - CTX_)) * D_;
}
DEVFN int tok_modrow(int tok) { return (tok % T_) < CTX_ ? B_ : tok / T_; }

template <class ARow, class BRow, class Epi>
DEVFN void gemm_tile(unsigned char* smem, int K, ARow arow, BRow brow, Epi epi) {
  bf16_t* As = (bf16_t*)smem;
  bf16_t* Bs = As + 128 * LDT;
  const int tid = TIDX, lane = tid & 63, wave = tid >> 6, wr = wave >> 1, wc = wave & 1;
  const int g = lane >> 4, l15 = lane & 15;
  const int lr = tid >> 3, lc = (tid & 7) * 8;
  const AS1 bf16_t* ap[4];
  const AS1 bf16_t* bp[4];
#pragma unroll
  for (int i = 0; i < 4; ++i) { ap[i] = gptr(arow(lr + 32 * i)); bp[i] = gptr(brow(lr + 32 * i)); }
  f32x4 acc[4][4];
#pragma unroll
  for (int mi = 0; mi < 4; ++mi)
#pragma unroll
    for (int ni = 0; ni < 4; ++ni) acc[mi][ni] = f32x4{0.f, 0.f, 0.f, 0.f};
  u32x4 ra0[4], rb0[4], ra1[4], rb1[4];
#pragma unroll
  for (int i = 0; i < 4; ++i) { ra0[i] = *(const AS1 u32x4*)(ap[i] + lc); rb0[i] = *(const AS1 u32x4*)(bp[i] + lc); }
  if (K > 64) {
#pragma unroll
    for (int i = 0; i < 4; ++i) { ra1[i] = *(const AS1 u32x4*)(ap[i] + 64 + lc); rb1[i] = *(const AS1 u32x4*)(bp[i] + 64 + lc); } }
  auto compute = [&]() {
#pragma unroll
    for (int kk = 0; kk < 2; ++kk) {
      bf16x8 af[4], bfr[4];
#pragma unroll
      for (int mi = 0; mi < 4; ++mi) af[mi] = *(const bf16x8*)(As + (wr * 64 + mi * 16 + l15) * LDT + kk * 32 + g * 8);
#pragma unroll
      for (int ni = 0; ni < 4; ++ni) bfr[ni] = *(const bf16x8*)(Bs + (wc * 64 + ni * 16 + l15) * LDT + kk * 32 + g * 8);
#pragma unroll
      for (int mi = 0; mi < 4; ++mi)
#pragma unroll
        for (int ni = 0; ni < 4; ++ni) acc[mi][ni] = MFMA16(af[mi], bfr[ni], acc[mi][ni]);
    } };
  for (int k0 = 0; k0 < K; k0 += 128) {
    __syncthreads();
#pragma unroll
    for (int i = 0; i < 4; ++i) { *(u32x4*)(As + (lr + 32 * i) * LDT + lc) = ra0[i]; *(u32x4*)(Bs + (lr + 32 * i) * LDT + lc) = rb0[i]; }
    __syncthreads();
    if (k0 + 128 < K) {
#pragma unroll
      for (int i = 0; i < 4; ++i) { ra0[i] = *(const AS1 u32x4*)(ap[i] + k0 + 128 + lc); rb0[i] = *(const AS1 u32x4*)(bp[i] + k0 + 128 + lc); } }
    compute();
    if (k0 + 64 < K) {
      __syncthreads();
#pragma unroll
      for (int i = 0; i < 4; ++i) { *(u32x4*)(As + (lr + 32 * i) * LDT + lc) = ra1[i]; *(u32x4*)(Bs + (lr + 32 * i) * LDT + lc) = rb1[i]; }
      __syncthreads();
      if (k0 + 192 < K) {
#pragma unroll
        for (int i = 0; i < 4; ++i) { ra1[i] = *(const AS1 u32x4*)(ap[i] + k0 + 192 + lc); rb1[i] = *(const AS1 u32x4*)(bp[i] + k0 + 192 + lc); } }
      compute();
    }
  }
  epi(acc, wr, wc, g, l15);
}

template <int NB, class ARow, class BRow, class Epi>
DEVFN void gemm_tile_multi(unsigned char* smem, int K, ARow arow, BRow brow, Epi epi) {
  bf16_t* As = (bf16_t*)smem;
  bf16_t* Bs = As + 128 * LDT;
  const int tid = TIDX, lane = tid & 63, wave = tid >> 6, wr = wave >> 1, wc = wave & 1;
  const int g = lane >> 4, l15 = lane & 15;
  const int lr = tid >> 3, lc = (tid & 7) * 8;
  const AS1 bf16_t* ap[4];
  const AS1 bf16_t* bp[4];
#pragma unroll
  for (int i = 0; i < 4; ++i) { ap[i] = gptr(arow(lr + 32 * i)); bp[i] = gptr(brow(lr + 32 * i, 0)); }
  f32x4 acc[4][4];
  u32x4 ra0[4], rb0[4], ra1[4], rb1[4];
#pragma unroll
  for (int i = 0; i < 4; ++i) { ra0[i] = *(const AS1 u32x4*)(ap[i] + lc); rb0[i] = *(const AS1 u32x4*)(bp[i] + lc); }
  if (K > 64) {
#pragma unroll
    for (int i = 0; i < 4; ++i) { ra1[i] = *(const AS1 u32x4*)(ap[i] + 64 + lc); rb1[i] = *(const AS1 u32x4*)(bp[i] + 64 + lc); } }
  auto compute = [&]() {
#pragma unroll
    for (int kk = 0; kk < 2; ++kk) {
      bf16x8 af[4], bfr[4];
#pragma unroll
      for (int mi = 0; mi < 4; ++mi) af[mi] = *(const bf16x8*)(As + (wr * 64 + mi * 16 + l15) * LDT + kk * 32 + g * 8);
#pragma unroll
      for (int ni = 0; ni < 4; ++ni) bfr[ni] = *(const bf16x8*)(Bs + (wc * 64 + ni * 16 + l15) * LDT + kk * 32 + g * 8);
#pragma unroll
      for (int mi = 0; mi < 4; ++mi)
#pragma unroll
        for (int ni = 0; ni < 4; ++ni) acc[mi][ni] = MFMA16(af[mi], bfr[ni], acc[mi][ni]);
    } };
#pragma unroll
  for (int j = 0; j < NB; ++j) {
#pragma unroll
  for (int mi = 0; mi < 4; ++mi)
#pragma unroll
    for (int ni = 0; ni < 4; ++ni) acc[mi][ni] = f32x4{0.f, 0.f, 0.f, 0.f};
  for (int k0 = 0; k0 < K; k0 += 128) {
    __syncthreads();
#pragma unroll
    for (int i = 0; i < 4; ++i) { *(u32x4*)(As + (lr + 32 * i) * LDT + lc) = ra0[i]; *(u32x4*)(Bs + (lr + 32 * i) * LDT + lc) = rb0[i]; }
    __syncthreads();
    if (k0 + 128 < K) {
#pragma unroll
      for (int i = 0; i < 4; ++i) { ra0[i] = *(const AS1 u32x4*)(ap[i] + k0 + 128 + lc); rb0[i] = *(const AS1 u32x4*)(bp[i] + k0 + 128 + lc); } }
    compute();
    if (k0 + 64 < K) {
      __syncthreads();
#pragma unroll
      for (int i = 0; i < 4; ++i) { *(u32x4*)(As + (lr + 32 * i) * LDT + lc) = ra1[i]; *(u32x4*)(Bs + (lr + 32 * i) * LDT + lc) = rb1[i]; }
      __syncthreads();
      if (k0 + 192 < K) {
#pragma unroll
        for (int i = 0; i < 4; ++i) { ra1[i] = *(const AS1 u32x4*)(ap[i] + k0 + 192 + lc); rb1[i] = *(const AS1 u32x4*)(bp[i] + k0 + 192 + lc); } }
      compute();
    }
  }
  if (j + 1 < NB) {
#pragma unroll
    for (int i = 0; i < 4; ++i) { bp[i] = gptr(brow(lr + 32 * i, j + 1)); ra0[i] = *(const AS1 u32x4*)(ap[i] + lc); rb0[i] = *(const AS1 u32x4*)(bp[i] + lc); } }
  epi(acc, j, wr, wc, g, l15);
  if (j + 1 < NB) {
#pragma unroll
    for (int i = 0; i < 4; ++i) { ra1[i] = *(const AS1 u32x4*)(ap[i] + 64 + lc); rb1[i] = *(const AS1 u32x4*)(bp[i] + 64 + lc); } }
  }
}

template <int NCH, class Val, class RowP>
DEVFN void tile_store_bf16(unsigned char* smem, int wr, int g, int l15, Val val, RowP rowp) {
  constexpr int LDC = NCH * 8 + 8;
  bf16_t* T = (bf16_t*)smem;
  const int tid = TIDX;
  __syncthreads();
  val(T, LDC);
  __syncthreads();
#pragma unroll
  for (int pass = 0; pass < NCH / 2; ++pass) { const int id = tid + 256 * pass, row = id / NCH, c = id % NCH;
    bf16_t* dst = rowp(row, c * 8);
    if (dst) *(AS1 u32x4*)gptr(dst) = *(const u32x4*)(T + row * LDC + c * 8); }
  (void)wr; (void)g; (void)l15;
}
DEVFN void cvt_tile(unsigned char* smem, const float* src, int K, int N, int k0, int n0, bf16_t* dst, int ldd, int mode) {
  float* s = (float*)smem;
  const int tid = TIDX;
  const AS1 float* gsrc = gptr(src);
  __syncthreads();
  { const int kk = tid >> 4, n4 = (tid & 15) * 4;
#pragma unroll
    for (int pass = 0; pass < 4; ++pass) { const int k = kk + 16 * pass;
      f32x4 v = f32x4{0.f, 0.f, 0.f, 0.f};
      if (n0 + n4 < N) v = *(const AS1 f32x4*)(gsrc + (size_t)(k0 + k) * N + n0 + n4);
      s[k * 65 + n4] = v[0]; s[k * 65 + n4 + 1] = v[1]; s[k * 65 + n4 + 2] = v[2]; s[k * 65 + n4 + 3] = v[3]; } }
  __syncthreads();
  { const int nn = tid >> 2, k16 = (tid & 3) * 16, n = n0 + nn;
    if (n < N) { const int row = mode == 0 ? n : ((n >> 4) * 32 + (n & 15) + (mode == 2 ? 16 : 0));
      u32x4 o0, o1;
#pragma unroll
      for (int j = 0; j < 4; ++j) { o0[j] = (unsigned)f2bf(s[(k16 + 2 * j) * 65 + nn]) | ((unsigned)f2bf(s[(k16 + 2 * j + 1) * 65 + nn]) << 16);
        o1[j] = (unsigned)f2bf(s[(k16 + 8 + 2 * j) * 65 + nn]) | ((unsigned)f2bf(s[(k16 + 9 + 2 * j) * 65 + nn]) << 16); }
      AS1 bf16_t* d = gptr(dst) + (size_t)row * ldd + k0 + k16;
      *(AS1 u32x4*)d = o0; *(AS1 u32x4*)(d + 8) = o1; } }
  (void)K;
}
struct CvtJob { const float* src; bf16_t* dst; int N, k0, n0, ldd, mode; };
DEVFN void cvt_load(const CvtJob& j, f32x4 (&v)[4]) {
  const int tid = TIDX, kk = tid >> 4, n4 = (tid & 15) * 4;
  const AS1 float* g = gptr(j.src);
#pragma unroll
  for (int pass = 0; pass < 4; ++pass) { v[pass] = f32x4{0.f, 0.f, 0.f, 0.f};
    if (j.n0 + n4 < j.N) v[pass] = *(const AS1 f32x4*)(g + (size_t)(j.k0 + kk + 16 * pass) * j.N + j.n0 + n4); }
}
DEVFN void cvt_store(unsigned char* smem, const CvtJob& j, const f32x4 (&v)[4]) {
  float* s = (float*)smem;
  const int tid = TIDX, kk = tid >> 4, n4 = (tid & 15) * 4;
  __syncthreads();
#pragma unroll
  for (int pass = 0; pass < 4; ++pass) { const int k = kk + 16 * pass; s[k * 65 + n4] = v[pass][0]; s[k * 65 + n4 + 1] = v[pass][1]; s[k * 65 + n4 + 2] = v[pass][2]; s[k * 65 + n4 + 3] = v[pass][3]; }
  __syncthreads();
  const int nn = tid >> 2, k16 = (tid & 3) * 16, n = j.n0 + nn;
  if (n < j.N) { const int row = j.mode == 0 ? n : ((n >> 4) * 32 + (n & 15) + (j.mode == 2 ? 16 : 0));
    u32x4 o0, o1;
#pragma unroll
    for (int q = 0; q < 4; ++q) { o0[q] = (unsigned)f2bf(s[(k16 + 2 * q) * 65 + nn]) | ((unsigned)f2bf(s[(k16 + 2 * q + 1) * 65 + nn]) << 16);
      o1[q] = (unsigned)f2bf(s[(k16 + 8 + 2 * q) * 65 + nn]) | ((unsigned)f2bf(s[(k16 + 9 + 2 * q) * 65 + nn]) << 16); }
    AS1 bf16_t* d = gptr(j.dst) + (size_t)row * j.ldd + j.k0 + k16;
    *(AS1 u32x4*)d = o0; *(AS1 u32x4*)(d + 8) = o1; }
}
DEVFN CvtJob moe_cvt_job(const Params& p, int l, int u) {
  bf16_t* w13 = (bf16_t*)(p.ws + Ws::W13); bf16_t* w2t = (bf16_t*)(p.ws + Ws::W2T);
  const int e = u / 192, r = u % 192, which = r / 64, t = r % 64;
  CvtJob j;
  if (which < 2) {
    j.src = e < 64 ? (which == 0 ? INP(I_EW1) : INP(I_EW3)) + ((size_t)l * 64 + e) * 1024 * 256 : (which == 0 ? INP(I_SW1) : INP(I_SW3)) + (size_t)l * 1024 * 256;
    j.N = 256; j.k0 = (t >> 2) * 64; j.n0 = (t & 3) * 64; j.dst = w13 + (size_t)e * 512 * 1024; j.ldd = 1024; j.mode = which == 0 ? 1 : 2;
  } else {
    j.src = e < 64 ? INP(I_EW2) + ((size_t)l * 64 + e) * 256 * 1024 : INP(I_SW2) + (size_t)l * 256 * 1024;
    j.N = 1024; j.k0 = (t >> 4) * 64; j.n0 = (t & 15) * 64; j.dst = w2t + (size_t)e * 1024 * 256; j.ldd = 256; j.mode = 0;
  }
  return j;
}
DEVFN void convert_moe_weights(const Params& p, int l, unsigned char* smem, int bid, int nb) {
  const int total = 65 * 192;
  if (bid >= total) return;
  f32x4 v[4], vn[4];
  CvtJob j = moe_cvt_job(p, l, bid);
  cvt_load(j, v);
  for (int u = bid; u < total; u += nb) {
    const int un = u + nb;
    CvtJob jn = j;
    if (un < total) { jn = moe_cvt_job(p, l, un); cvt_load(jn, vn); }
    cvt_store(smem, j, v);
    j = jn;
#pragma unroll
    for (int q = 0; q < 4; ++q) v[q] = vn[q];
  }
}
DEVFN void phase0(const Params& p, unsigned char* smem) {
  const int tid = TIDX;
  float* modp = (float*)(p.ws + Ws::MODP);
  for (int u = BIDX; u < DEPTH_ * 24 * 16; u += gridDim.x) {
    int l = u / (24 * 16), jb = (u / 16) % 24, ks = u % 16;
    float* sc = (float*)smem;
    __syncthreads();
    for (int e = tid; e < NR_ * 64; e += 256) { int r = e / 64, i = ks * 64 + (e % 64); float cv = r < B_ ? INP(I_C)[(size_t)r * D_ + i] : INP(I_CCTX)[i]; sc[e] = siluf_(cv); }
    __syncthreads();
    int j = jb * 256 + tid;
    float acc[NR_];
#pragma unroll
    for (int r = 0; r < NR_; ++r) acc[r] = 0.f;
    const float* w = INP(I_ADAW) + ((size_t)l * D_ + ks * 64) * NMOD_ + j;
#pragma unroll 4
    for (int i = 0; i < 64; ++i) { float wv = w[(size_t)i * NMOD_];
#pragma unroll
      for (int r = 0; r < NR_; ++r) acc[r] += sc[r * 64 + i] * wv; }
#pragma unroll
    for (int r = 0; r < NR_; ++r) modp[(((size_t)ks * DEPTH_ + l) * NR_ + r) * NMOD_ + j] = acc[r];
  }
  bf16_t* win = (bf16_t*)(p.ws + Ws::WIN);
  bf16_t* wout = (bf16_t*)(p.ws + Ws::WOUT);
  for (int u = BIDX; u < DEPTH_ * 16 * 55; u += gridDim.x) {
    int l = u / (16 * 55), r = u % (16 * 55);
    cvt_tile(smem, INP(I_WIN) + (size_t)l * 1024 * NIN_, 1024, NIN_, (r / 55) * 64, (r % 55) * 64, win + (size_t)l * NIN_ * 1024, 1024, 0);
  }
  for (int u = BIDX; u < DEPTH_ * 256; u += gridDim.x) {
    int l = u / 256, r = u % 256;
    cvt_tile(smem, INP(I_WOUT) + (size_t)l * 1024 * 1024, 1024, 1024, (r / 16) * 64, (r % 16) * 64, wout + (size_t)l * 1024 * 1024, 1024, 0);
  }
  { bf16_t* lo = (bf16_t*)(p.ws + Ws::LORA);
    for (int u = BIDX * 256 + tid; u < DEPTH_ * 98304; u += gridDim.x * 256) {
      const int l = u / 98304, r = u % 98304; float v;
      if (r < 32768) { const int d = r >> 14, n = (r >> 6) & 255, k = r & 63; v = INP(I_W2)[(((size_t)l * 2 + d) * 64 + k) * 256 + n]; }
      else if (r < 65536) { const int r2 = r - 32768, d = r2 >> 14, n = (r2 >> 6) & 255, k = r2 & 63; v = INP(I_A2)[(((size_t)l * 2 + d) * 64 + k) * 256 + n]; }
      else { const int r2 = r - 65536, n = r2 >> 7, k = r2 & 127; v = INP(I_G2)[((size_t)l * 128 + k) * 256 + n]; }
      lo[u] = f2bf(v); } }
  float* rwt = (float*)(p.ws + Ws::RWT);
  for (int u = BIDX * 256 + tid; u < DEPTH_ * 64 * 1024; u += gridDim.x * 256) {
    int l = u / (64 * 1024), e = (u / 1024) % 64, i = u % 1024;
    rwt[u] = INP(I_RW)[((size_t)l * 1024 + i) * 64 + e];
  }
}

DEVFN void phase0b(const Params& p) {
  float* mod = (float*)(p.ws + Ws::MOD); const float* modp = (const float*)(p.ws + Ws::MODP);
  for (int u = BIDX * 256 + TIDX; u < DEPTH_ * NR_ * NMOD_; u += gridDim.x * 256) {
    int l = u / (NR_ * NMOD_), j = u % NMOD_;
    float s = INP(I_ADAB)[(size_t)l * NMOD_ + j];
    for (int ks = 0; ks < 16; ++ks) s += modp[(size_t)ks * DEPTH_ * NR_ * NMOD_ + u];
    mod[u] = s;
  }
}

DEVFN void row_stats(const float (&v)[16], float& mean, float& rstd) {
  float s = 0.f;
#pragma unroll
  for (int i = 0; i < 16; ++i) s += v[i];
  mean = wave_sum(s) * (1.f / 1024.f);
  float q = 0.f;
#pragma unroll
  for (int i = 0; i < 16; ++i) { float d = v[i] - mean; q += d * d; }
  rstd = rsqrtf(wave_sum(q) * (1.f / 1024.f) + 1e-5f);
}
DEVFN void load_row16(const float* row, int lane, float (&v)[16]) {
  const AS1 float* r = gptr(row);
#pragma unroll
  for (int j = 0; j < 4; ++j) { const f32x4 t = *(const AS1 f32x4*)(r + lane * 4 + 256 * j); v[4 * j] = t[0]; v[4 * j + 1] = t[1]; v[4 * j + 2] = t[2]; v[4 * j + 3] = t[3]; }
}
DEVFN void moe_residual_row(const Params& p, int lp, int tok, int lane, float (&xv)[16]) {
  const float* mod = (const float*)(p.ws + Ws::MOD) + ((size_t)lp * NR_ + tok_modrow(tok)) * NMOD_;
  const bf16_t* yb = (const bf16_t*)(p.ws + Ws::YBUF) + (size_t)tok * NSLOT * 1024;
  float g2[16], w[16], b[16];
  load_row16(mod + 5 * 1024, lane, g2);
  load_row16(INP(I_LN2W) + (size_t)lp * 1024, lane, w);
  load_row16(INP(I_LN2B) + (size_t)lp * 1024, lane, b);
  u32x2 sl[NSLOT][4];
#pragma unroll
  for (int s = 0; s < NSLOT; ++s)
#pragma unroll
    for (int j = 0; j < 4; ++j) sl[s][j] = *(const AS1 u32x2*)gptr(yb + (size_t)s * 1024 + lane * 4 + 256 * j);
  float f[16];
#pragma unroll
  for (int i = 0; i < 16; ++i) f[i] = 0.f;
#pragma unroll
  for (int s = 0; s < NSLOT; ++s)
#pragma unroll
    for (int j = 0; j < 4; ++j) { const u32x2 t = sl[s][j];
      f[4 * j] += bf2f((bf16_t)(t[0] & 0xFFFF)); f[4 * j + 1] += bf2f((bf16_t)(t[0] >> 16)); f[4 * j + 2] += bf2f((bf16_t)(t[1] & 0xFFFF)); f[4 * j + 3] += bf2f((bf16_t)(t[1] >> 16)); }
#pragma unroll
  for (int i = 0; i < 16; ++i) xv[i] = ALPHA_ * xv[i] + g2[i] * f[i];
  float mean, rstd;
  row_stats(xv, mean, rstd);
#pragma unroll
  for (int i = 0; i < 16; ++i) xv[i] = (xv[i] - mean) * rstd * w[i] + b[i];
}
DEVFN void phase1(const Params& p, int l) {
  const int lane = TIDX & 63, wave = TIDX >> 6;
  float* X = (float*)(p.ws + Ws::X);
  bf16_t* U = (bf16_t*)(p.ws + Ws::U);
  for (int tok = BIDX * 4 + wave; tok < NT_; tok += gridDim.x * 4) {
    float xv[16], sh[16], sc[16], mean, rstd;
    const float* mod = (const float*)(p.ws + Ws::MOD) + ((size_t)l * NR_ + tok_modrow(tok)) * NMOD_;
    load_row16(mod, lane, sh);
    load_row16(mod + 1024, lane, sc);
    if (l == 0) load_row16(tok_input_row(p, tok), lane, xv);
    else { load_row16(X + (size_t)tok * 1024, lane, xv); moe_residual_row(p, l - 1, tok, lane, xv); }
#pragma unroll
    for (int j = 0; j < 4; ++j) *(float4*)(X + (size_t)tok * 1024 + lane * 4 + 256 * j) = make_float4(xv[4 * j], xv[4 * j + 1], xv[4 * j + 2], xv[4 * j + 3]);
    row_stats(xv, mean, rstd);
#pragma unroll
    for (int j = 0; j < 4; ++j) {
      float u0 = (xv[4 * j] - mean) * rstd * (1.f + sc[4 * j]) + sh[4 * j], u1 = (xv[4 * j + 1] - mean) * rstd * (1.f + sc[4 * j + 1]) + sh[4 * j + 1];
      float u2 = (xv[4 * j + 2] - mean) * rstd * (1.f + sc[4 * j + 2]) + sh[4 * j + 2], u3 = (xv[4 * j + 3] - mean) * rstd * (1.f + sc[4 * j + 3]) + sh[4 * j + 3];
      *(uint2*)(U + (size_t)tok * 1024 + lane * 4 + 256 * j) = make_uint2((unsigned)f2bf(u0) | ((unsigned)f2bf(u1) << 16), (unsigned)f2bf(u2) | ((unsigned)f2bf(u3) << 16));
    }
  }
}
DEVFN void phase_final(const Params& p) {
  const int lane = TIDX & 63, wave = TIDX >> 6;
  const float* X = (const float*)(p.ws + Ws::X);
  for (int r = BIDX * 4 + wave; r < B_ * SEQ_; r += gridDim.x * 4) {
    int b = r / SEQ_, s = r % SEQ_, tok = b * T_ + CTX_ + s;
    float xv[16];
    load_row16(X + (size_t)tok * 1024, lane, xv);
    moe_residual_row(p, DEPTH_ - 1, tok, lane, xv);
#pragma unroll
    for (int j = 0; j < 4; ++j) *(float4*)(p.out + (size_t)r * 1024 + lane * 4 + 256 * j) = make_float4(xv[4 * j], xv[4 * j + 1], xv[4 * j + 2], xv[4 * j + 3]);
  }
}

DEVFN void phase2(const Params& p, int l, unsigned char* smem) {
  const bf16_t* U = (const bf16_t*)(p.ws + Ws::U);
  const bf16_t* W = (const bf16_t*)(p.ws + Ws::WIN) + (size_t)l * NIN_ * 1024;
  bf16_t* ZX = (bf16_t*)(p.ws + Ws::ZX);
  const int nct = (NIN_ + 127) / 128;
  for (int u = BIDX; u < (NT_ / 128) * nct; u += gridDim.x) {
    int rt = u / nct, ct = u % nct;
    gemm_tile(smem, 1024,
      [&](int r) { return U + (size_t)(rt * 128 + r) * 1024; },
      [&](int r) { int n = ct * 128 + r; return n < NIN_ ? W + (size_t)n * 1024 : (const bf16_t*)(p.ws + Ws::ZROW); },
      [&](f32x4 (&acc)[4][4], int wr, int wc, int g, int l15) {
        tile_store_bf16<16>(smem, wr, g, l15,
          [&](bf16_t* T, int ldc) {
#pragma unroll
            for (int mi = 0; mi < 4; ++mi)
#pragma unroll
              for (int ni = 0; ni < 4; ++ni)
#pragma unroll
                for (int i = 0; i < 4; ++i) T[(wr * 64 + mi * 16 + 4 * g + i) * ldc + wc * 64 + ni * 16 + l15] = f2bf(acc[mi][ni][i]); },
          [&](int row, int c0) { return ct * 128 + c0 < NIN_ ? ZX + (size_t)(rt * 128 + row) * NIN_ + ct * 128 + c0 : (bf16_t*)nullptr; });
      });
  }
}

DEVFN float zxv(const bf16_t* ZX, int tok, int col) { return bf2f(gptr(ZX)[(size_t)tok * NIN_ + col]); }
struct Nbr { int n; int tok[4]; };
DEVFN Nbr shift_nbrs(int tok) {
  Nbr nb; int b = tok / T_, t = tok % T_;
  if (t < CTX_) { nb.n = 2; nb.tok[0] = t > 0 ? tok - 1 : -1; nb.tok[1] = t < CTX_ - 1 ? tok + 1 : -1; nb.tok[2] = -1; nb.tok[3] = -1; }
  else { int s = t - CTX_, row = s / 64, col = s % 64; nb.n = 4; nb.tok[0] = col > 0 ? tok - 1 : -1; nb.tok[1] = col < 63 ? tok + 1 : -1;
    nb.tok[2] = row > 0 ? tok - 64 : -1; nb.tok[3] = row < SEQ_ / 64 - 1 ? tok + 64 : -1; }
  (void)b; return nb;
}
DEVFN float shiftmix(const bf16_t* ZX, const float* mu, int tok, const Nbr& nb, int ch) {
  float z = zxv(ZX, tok, ORW + ch), o = z;
#pragma unroll
  for (int j = 0; j < 4; ++j) if (j < nb.n) { float v = nb.tok[j] >= 0 ? zxv(ZX, nb.tok[j], ORW + ch) : 0.f; o += mu[j * 1152 + ch] * (v - z); }
  return o;
}
#define LI_LD 392
#define KL_LD 264
DEVFN void phase3(const Params& p, int l, unsigned char* smem) {
  const int tid = TIDX, lane = tid & 63, wave = tid >> 6, q = lane >> 4, l15 = lane & 15;
  const bf16_t* ZX = (const bf16_t*)(p.ws + Ws::ZX);
  bf16_t* XBC = (bf16_t*)(p.ws + Ws::XBC); float* DTB = (float*)(p.ws + Ws::DTB);
  bf16_t* RR = (bf16_t*)(p.ws + Ws::RR); bf16_t* VV = (bf16_t*)(p.ws + Ws::VV); bf16_t* KKb = (bf16_t*)(p.ws + Ws::KK);
  bf16_t* KRW = (bf16_t*)(p.ws + Ws::KRW); bf16_t* LIg = (bf16_t*)(p.ws + Ws::LI);
  float* LA = (float*)(p.ws + Ws::LA);
  const float* convw = INP(I_CONVW) + (size_t)l * 3 * 1024; const float* convb = INP(I_CONVB) + (size_t)l * 1024;
  const float* mu = INP(I_MU) + (size_t)l * 4 * 1152;
  float* gdl = (float*)smem;
  const float kkw = INP(I_KKW)[(size_t)l * 256 + tid];
  for (int wu = BIDX; wu < 2 * (NT_ / 16); wu += gridDim.x) {
    const int tile = wu >> 1, part = wu & 1;
    const int tok0 = tile * 16, t0 = tok0 % T_, bb = tok0 / T_;
    const bool isctx = t0 < CTX_;
    const int s0 = t0 - CTX_;
    const bool lval = isctx ? (t0 > 0) : ((s0 & 63) != 0), rval = isctx ? (t0 + 16 < CTX_) : ((s0 & 63) != 48);
    const bool uval = !isctx && (s0 >= 64), dval = !isctx && (s0 + 64 < SEQ_);
    if (part == 0) {
    __syncthreads();
    {
      const bool segstart = (t0 == 0 || t0 == CTX_), segend = (t0 + 16 == CTX_ || t0 + 16 == T_);
      bf16_t* XBCT = (bf16_t*)(p.ws + Ws::XBCT) + ((size_t)(bb * NC128 + t0 / 128) * 768) * 128 + (t0 % 128);
#pragma unroll 1
      for (int j = 0; j < 4; ++j) { const int c = tid + 256 * j;
        const AS1 bf16_t* zp = gptr(ZX) + (size_t)tok0 * NIN_ + OXBC + c - NIN_; AS1 bf16_t* xp = gptr(XBC) + (size_t)tok0 * 1024 + c;
        float z[18];
#pragma unroll
        for (int i = 0; i < 18; ++i) { z[i] = ((i == 0 && segstart) || (i == 17 && segend)) ? 0.f : bf2f(*zp); zp += NIN_; LAUNDER_V(zp); }
        const float w0 = convw[c], w1 = convw[1024 + c], w2 = convw[2048 + c], cb = convb[c];
        bf16_t y[16];
#pragma unroll
        for (int i = 0; i < 16; ++i) { y[i] = f2bf(siluf_(cb + w0 * z[i] + w1 * z[i + 1] + w2 * z[i + 2])); *xp = y[i]; xp += 1024; LAUNDER_V(xp); }
        if (c < 768) {
          u32x4 o0, o1;
#pragma unroll
          for (int i = 0; i < 4; ++i) { o0[i] = (unsigned)y[2 * i] | ((unsigned)y[2 * i + 1] << 16); o1[i] = (unsigned)y[8 + 2 * i] | ((unsigned)y[9 + 2 * i] << 16); }
          *(u32x4*)(XBCT + (size_t)c * 128) = o0; *(u32x4*)(XBCT + (size_t)c * 128 + 8) = o1; } }
      { bf16_t* VTp = (bf16_t*)(p.ws + Ws::VT) + ((size_t)(bb * NC64 + t0 / 64) * 256 + tid) * 64 + (t0 % 64);
        const AS1 bf16_t* vp = gptr(ZX) + (size_t)tok0 * NIN_ + OGV + tid;
        u32x4 o0, o1;
        bf16_t vv16[16];
#pragma unroll
        for (int i = 0; i < 16; ++i) { vv16[i] = *vp; vp += NIN_; LAUNDER_V(vp); }
#pragma unroll
        for (int i = 0; i < 4; ++i) { o0[i] = (unsigned)vv16[2 * i] | ((unsigned)vv16[2 * i + 1] << 16); o1[i] = (unsigned)vv16[8 + 2 * i] | ((unsigned)vv16[9 + 2 * i] << 16); }
        *(u32x4*)VTp = o0; *(u32x4*)(VTp + 8) = o1; }
      DTB[(size_t)tok0 * 16 + tid] = softplusf_(zxv(ZX, tok0 + (tid >> 4), ODT + (tid & 15)) + INP(I_DTBIAS)[(size_t)l * 16 + (tid & 15)]);
      gdl[tid] = zxv(ZX, tok0 + (tid >> 5), OGD + (tid & 31)); gdl[256 + tid] = zxv(ZX, tok0 + 8 + (tid >> 5), OGD + (tid & 31));
    }
    } else {
#pragma unroll 1
    for (int g = 0; g < 5; ++g) {
      const bool act = !(g == 4 && tid >= 128);
      const int ch = act ? g * 256 + tid : 0;
      const AS1 bf16_t* zp0 = gptr(ZX) + (size_t)tok0 * NIN_ + ORW + ch;
      const AS1 bf16_t* zp = zp0 - NIN_;
      const float m0 = mu[ch], m1 = mu[1152 + ch], m2 = mu[2304 + ch], m3 = mu[3456 + ch];
      float z[18], o[16];
#pragma unroll
      for (int i = 0; i < 18; ++i) { z[i] = ((i == 0 && !lval) || (i == 17 && !rval)) ? 0.f : bf2f(*zp); zp += NIN_; LAUNDER_V(zp); }
#pragma unroll
      for (int i = 0; i < 16; ++i) o[i] = z[i + 1] + m0 * (z[i] - z[i + 1]) + m1 * (z[i + 2] - z[i + 1]);
      if (!isctx) {
        const AS1 bf16_t* up = zp0 - (size_t)64 * NIN_; const AS1 bf16_t* dn = zp0 + (size_t)64 * NIN_;
#pragma unroll
        for (int i = 0; i < 16; ++i) { const float zu = uval ? bf2f(*up) : 0.f, zd = dval ? bf2f(*dn) : 0.f; up += NIN_; dn += NIN_; LAUNDER_V(up); LAUNDER_V(dn);
          o[i] += m2 * (zu - z[i + 1]) + m3 * (zd - z[i + 1]); } }
      if (g == 0) { AS1 bf16_t* rp = gptr(RR) + (size_t)tok0 * 256 + tid;
#pragma unroll
        for (int i = 0; i < 16; ++i) { *rp = f2bf(o[i]); rp += 256; LAUNDER_V(rp); }
      } else if (g == 1) { AS1 bf16_t* kp = gptr(KKb) + (size_t)tok0 * 256 + tid; AS1 bf16_t* krp = gptr(KRW) + (size_t)tok0 * 256 + tid;
#pragma unroll
        for (int i = 0; i < 16; ++i) { const float kq = o[i] * kkw, nrm = sqrtf(wave_sum(kq * kq));
          *kp = f2bf(kq / fmaxf(nrm, 1e-12f)); *krp = f2bf(o[i]); kp += 256; krp += 256; LAUNDER_V(kp); LAUNDER_V(krp); }
      } else if (g == 2) { AS1 bf16_t* vp2 = gptr(VV) + (size_t)tok0 * 256 + tid;
#pragma unroll
        for (int i = 0; i < 16; ++i) { *vp2 = f2bf(o[i]); vp2 += 256; LAUNDER_V(vp2); }
      } else if (g == 3) { AS1 bf16_t* lp = gptr(LIg) + (size_t)tok0 * 384 + tid;
#pragma unroll
        for (int i = 0; i < 16; ++i) { *lp = f2bf(tid < 128 ? tanhf(o[i]) : o[i]); lp += 384; LAUNDER_V(lp); }
      } else if (act) { AS1 bf16_t* lp = gptr(LIg) + (size_t)tok0 * 384 + 256 + tid;
#pragma unroll
        for (int i = 0; i < 16; ++i) { *lp = f2bf(sigmoidf_(o[i])); lp += 384; LAUNDER_V(lp); }
      }
    }
    }
    if (part == 0) {
    __syncthreads();
    { const int d = tid >> 7, c = tid & 127; const float* gu = INP(I_GU) + ((size_t)l * 2 + d) * 16 * 128; const float gb = INP(I_GB)[((size_t)l * 2 + d) * 128 + c];
      float guw[16];
#pragma unroll
      for (int i = 0; i < 16; ++i) guw[i] = gu[i * 128 + c];
#pragma unroll 4
      for (int tt = 0; tt < 16; ++tt) { float sacc = gb;
#pragma unroll
        for (int i = 0; i < 16; ++i) sacc += gdl[tt * 32 + d * 16 + i] * guw[i];
        LA[((size_t)d * NT_ + tok0 + tt) * 128 + c] = logsigmoidf_(sacc) * (1.f / 16.f); } }
    }
  }
}

DEVFN void phase3b(const Params& p, int l, unsigned char* smem) {
  const bf16_t* LIg = (const bf16_t*)(p.ws + Ws::LI);
  const bf16_t* lora = (const bf16_t*)(p.ws + Ws::LORA) + (size_t)l * 98304;
  const bf16_t* KRg = (const bf16_t*)(p.ws + Ws::KRW); const bf16_t* KKg = (const bf16_t*)(p.ws + Ws::KK);
  float* LWp = (float*)(p.ws + Ws::LW); bf16_t* KD = (bf16_t*)(p.ws + Ws::KD); bf16_t* BD = (bf16_t*)(p.ws + Ws::BD); float* GATE = (float*)(p.ws + Ws::GATE);
  for (int u = BIDX; u < (NT_ / 128) * 10; u += gridDim.x) {
    const int rt = u / 10, which = (u % 10) >> 1, ct = u & 1;
    const int K = which < 4 ? 64 : 128, acol = which < 4 ? which * 64 : 256;
    const bf16_t* wb = which < 2 ? lora + (size_t)which * 16384 : which < 4 ? lora + 32768 + (size_t)(which - 2) * 16384 : lora + 65536;
    const float* bias = which < 2 ? INP(I_W0) + (size_t)l * 512 + which * 256 : INP(I_A0) + (size_t)l * 512 + (which & 1) * 256;
    const float* kav = INP(I_KAW) + (size_t)l * 256;
    gemm_tile(smem, K,
      [&](int r) { return LIg + (size_t)(rt * 128 + r) * 384 + acol; },
      [&](int r) { return wb + (size_t)(ct * 128 + r) * K; },
      [&](f32x4 (&acc)[4][4], int wr, int wc, int g, int l15) {
        const int tid = TIDX;
        if (which == 2 || which == 3) {
          bf16_t* T = (bf16_t*)smem; constexpr int LDC = 136;
          __syncthreads();
#pragma unroll
          for (int ni = 0; ni < 4; ++ni) { const int cl = wc * 64 + ni * 16 + l15; const float bv = bias[ct * 128 + cl];
#pragma unroll
            for (int mi = 0; mi < 4; ++mi)
#pragma unroll
              for (int i = 0; i < 4; ++i) T[(wr * 64 + mi * 16 + 4 * g + i) * LDC + cl] = f2bf(sigmoidf_(acc[mi][ni][i] + bv)); }
          __syncthreads();
          const int c = tid & 15, col0 = ct * 128 + c * 8;
          float ka[8];
#pragma unroll
          for (int j = 0; j < 8; ++j) ka[j] = kav[col0 + j];
          const size_t dofs = (size_t)(which - 2) * NT_ * 256;
#pragma unroll
          for (int pass = 0; pass < 8; ++pass) { const int row = (tid >> 4) + 16 * pass; const size_t o = (size_t)(rt * 128 + row) * 256 + col0;
            const bf16x8 a8 = *(const bf16x8*)(T + row * LDC + c * 8), kr8 = ld8g(KRg + o), kk8 = ld8g(KKg + o);
            bf16x8 kd8, bd8;
#pragma unroll
            for (int j = 0; j < 8; ++j) { const float a = bf2f((bf16_t)a8[j]); kd8[j] = (short)f2bf(bf2f((bf16_t)kr8[j]) * (1.f + (a - 1.f) * ka[j])); bd8[j] = (short)f2bf(bf2f((bf16_t)kk8[j]) * a); }
            *(AS1 bf16x8*)gptr(KD + dofs + o) = kd8; *(AS1 bf16x8*)gptr(BD + dofs + o) = bd8; }
        } else {
          float* T = (float*)smem; constexpr int LDC = 132;
          float* dst = which < 2 ? LWp + (size_t)which * NT_ * 256 : GATE;
#pragma unroll 1
          for (int h = 0; h < 2; ++h) {
            __syncthreads();
            if (wr == h) {
#pragma unroll
              for (int ni = 0; ni < 4; ++ni) { const int cl = wc * 64 + ni * 16 + l15; const float bv = which < 2 ? bias[ct * 128 + cl] : 0.f;
#pragma unroll
                for (int mi = 0; mi < 4; ++mi)
#pragma unroll
                  for (int i = 0; i < 4; ++i) { const float v = acc[mi][ni][i]; T[(mi * 16 + 4 * g + i) * LDC + cl] = which < 2 ? -0.6065306597126334f * sigmoidf_(v + bv) : v; } } }
            __syncthreads();
#pragma unroll
            for (int pass = 0; pass < 8; ++pass) { const int id = tid + 256 * pass, row = id >> 5, c = id & 31;
              *(AS1 f32x4*)gptr(dst + (size_t)(rt * 128 + h * 64 + row) * 256 + ct * 128 + c * 4) = *(const f32x4*)(T + row * LDC + c * 4); } }
        }
      });
  }
}

DEVFN bf16x8 ld8(const bf16_t* p) { return *(const bf16x8*)p; }
typedef short bf16x4v __attribute__((ext_vector_type(4)));
DEVFN bf16x4v cvt4(f32x4 v) { return bf16x4v{(short)f2bf(v[0]), (short)f2bf(v[1]), (short)f2bf(v[2]), (short)f2bf(v[3])}; }
DEVFN bf16x8 cat44(bf16x4v a, bf16x4v b) { return bf16x8{a[0], a[1], a[2], a[3], b[0], b[1], b[2], b[3]}; }
DEVFN bf16x4v ld4(const bf16_t* p) { return *(const bf16x4v*)p; }
DEVFN int rm_off(int i, int k) { return i * 64 + ((((k >> 3) ^ (i & 7)) << 3) | (k & 7)); }
#define RW_WAVE_LDS 11264
DEVFN void rwkv_chunk(const Params& p, int unit_base, unsigned char* smem) {
  const int tid = TIDX, lane = tid & 63, wave = tid >> 6, q = lane >> 4, l15 = lane & 15;
  const int unit = unit_base + wave;
  const int c = unit % NC16, h = (unit / NC16) & 3, dir = (unit / (NC16 * 4)) & 1, b = unit / (NC16 * 8);
  bf16_t* big = (bf16_t*)(smem + wave * RW_WAVE_LDS);
  unsigned char* small = smem + wave * RW_WAVE_LDS + 8192;
  float* AbF = (float*)small;
  bf16_t* TN = (bf16_t*)(small + 1024);
  bf16_t* AK = TN + 256; bf16_t* RB = AK + 256; bf16_t* RK = RB + 256;
  const bf16_t* RRg = (const bf16_t*)(p.ws + Ws::RR); const bf16_t* VVg = (const bf16_t*)(p.ws + Ws::VV); const bf16_t* KKg = (const bf16_t*)(p.ws + Ws::KK);
  const bf16_t* KDg = (const bf16_t*)(p.ws + Ws::KD) + (size_t)dir * NT_ * 256; const bf16_t* BDg = (const bf16_t*)(p.ws + Ws::BD) + (size_t)dir * NT_ * 256;
  const float* LWg = (const float*)(p.ws + Ws::LW) + (size_t)dir * NT_ * 256;
  float kkm[16], vv[16], bneg[16], kneg[16];
  float run = 0.f;
  __syncthreads();
#pragma unroll
  for (int i = 0; i < 16; ++i) {
    const size_t o = (size_t)(b * T_ + tokmap(dir, c * 16 + i)) * 256 + h * 64 + lane;
    const float lw = gptr(LWg)[o], r = bf2f(gptr(RRg)[o]), k = bf2f(gptr(KDg)[o]), v = bf2f(gptr(VVg)[o]), kk = bf2f(gptr(KKg)[o]), bb = bf2f(gptr(BDg)[o]);
    const float e_ex = expf(run); run += lw; const float e_in = expf(run), e_neg = expf(-run);
    kkm[i] = kk * e_ex; vv[i] = v; bneg[i] = bb * e_neg; kneg[i] = k * e_neg;
    big[rm_off(i, lane)] = f2bf(kkm[i]); big[1024 + rm_off(i, lane)] = f2bf(r * e_in);
    big[2048 + rm_off(i, lane)] = f2bf(bneg[i]); big[3072 + rm_off(i, lane)] = f2bf(kneg[i]);
  }
  const float WC = expf(run);
  __syncthreads();
  f32x4 ab = f32x4{0.f, 0.f, 0.f, 0.f}, ak = ab, rb = ab, rk = ab;
#pragma unroll
  for (int s2 = 0; s2 < 2; ++s2) { const int ch = ((4 * s2 + q) ^ (l15 & 7)) << 3;
    const bf16x8 a_kk = ld8(big + l15 * 64 + ch), a_r = ld8(big + 1024 + l15 * 64 + ch), b_b = ld8(big + 2048 + l15 * 64 + ch), b_k = ld8(big + 3072 + l15 * 64 + ch);
    ab = MFMA16(a_kk, b_b, ab); ak = MFMA16(a_kk, b_k, ak); rb = MFMA16(a_r, b_b, rb); rk = MFMA16(a_r, b_k, rk); }
  f32x4 gacc[4];
#pragma unroll
  for (int nk = 0; nk < 4; ++nk)
#pragma unroll
    for (int r = 0; r < 4; ++r) gacc[nk][r] = bf2f(big[1024 + rm_off(4 * q + r, 16 * nk + l15)]);
  __syncthreads();
#pragma unroll
  for (int r = 0; r < 4; ++r) { const int i = 4 * q + r, j = l15;
    AbF[i * 16 + j] = j < i ? ab[r] : 0.f; AK[i * 16 + j] = f2bf(j < i ? ak[r] : 0.f);
    RB[i * 16 + j] = f2bf(j <= i ? rb[r] : 0.f); RK[i * 16 + j] = f2bf(j <= i ? rk[r] : 0.f); }
  { bf16_t* KKMT = big; bf16_t* VTT = big + 1024; bf16_t* BHT = big + 2048; bf16_t* KHT = big + 3072;
#pragma unroll
    for (int i = 0; i < 16; ++i) { KKMT[lane * 16 + i] = f2bf(kkm[i]); VTT[lane * 16 + i] = f2bf(vv[i]); BHT[lane * 16 + i] = f2bf(bneg[i] * WC); KHT[lane * 16 + i] = f2bf(kneg[i] * WC); } }
  __syncthreads();
  { float t[16];
#pragma unroll
    for (int i = 0; i < 16; ++i) { float acc = (i == l15) ? 1.f : 0.f;
#pragma unroll
      for (int j = 0; j < i; ++j) acc -= AbF[i * 16 + j] * t[j];
      t[i] = acc; }
    if (q == 0) {
#pragma unroll
      for (int i = 0; i < 16; ++i) TN[i * 16 + l15] = f2bf(-t[i]); } }
  __syncthreads();
  const size_t ci = (size_t)((b * 2 + dir) * 4 + h) * NC16 + c;
  bf16_t* MLg = (bf16_t*)(p.ws + Ws::RML) + ci * 4096; bf16_t* Ng = (bf16_t*)(p.ws + Ws::RNS) + ci * 4096;
  bf16_t* Gg = (bf16_t*)(p.ws + Ws::RG) + ci * 1024; float* Y0g = (float*)(p.ws + Ws::RY0) + ci * 1024;
  const bf16x4v a_T = ld4(TN + l15 * 16 + 4 * q), a_Ak = ld4(AK + l15 * 16 + 4 * q), a_Rb = ld4(RB + l15 * 16 + 4 * q), a_Rk = ld4(RK + l15 * 16 + 4 * q);
  const f32x4 z4 = f32x4{0.f, 0.f, 0.f, 0.f};
  bf16x4v vfr[4], qfr[4], pfr[4];
#pragma unroll
  for (int n = 0; n < 4; ++n) {
    vfr[n] = ld4(big + 1024 + (16 * n + l15) * 16 + 4 * q);
    const f32x4 akv = MFMA16K16(a_Ak, vfr[n], z4);
    qfr[n] = cvt4(MFMA16K16(a_T, cvt4(akv), z4));
    pfr[n] = cvt4(MFMA16K16(a_T, ld4(big + (16 * n + l15) * 16 + 4 * q), z4)); }
  const bf16x8 a_RbRk = cat44(a_Rb, a_Rk);
#pragma unroll
  for (int n = 0; n < 4; ++n) {
    const f32x4 g = MFMA16K16(a_Rb, pfr[n], gacc[n]);
    const f32x4 y0 = MFMA16(a_RbRk, cat44(qfr[n], vfr[n]), z4);
#pragma unroll
    for (int r = 0; r < 4; ++r) { Gg[(4 * q + r) * 64 + 16 * n + l15] = f2bf(g[r]); Y0g[(4 * q + r) * 64 + 16 * n + l15] = y0[r]; } }
#pragma unroll
  for (int mk = 0; mk < 4; ++mk) {
    const bf16x4v a_B = ld4(big + 2048 + (16 * mk + l15) * 16 + 4 * q), a_K = ld4(big + 3072 + (16 * mk + l15) * 16 + 4 * q);
    const bf16x8 a_BK = cat44(a_B, a_K);
#pragma unroll
    for (int n = 0; n < 4; ++n) {
      const f32x4 m = MFMA16K16(a_B, pfr[n], z4);
      const f32x4 nn = MFMA16(a_BK, cat44(qfr[n], vfr[n]), z4);
#pragma unroll
      for (int r = 0; r < 4; ++r) MLg[((mk * 2 + (n >> 1)) * 64 + (l15 >> 2) * 16 + 4 * q + r) * 8 + (n & 1) * 4 + (l15 & 3)] = f2bf(m[r]);
      *(bf16x4v*)(Ng + (n * 64 + lane) * 16 + mk * 4) = cvt4(nn); } }
  ((float*)(p.ws + Ws::RWC))[ci * 64 + ((lane >> 2) & 3) * 16 + (lane >> 4) * 4 + (lane & 3)] = WC;
}
struct RwStep { bf16x8 ml[4][2]; bf16x8 n[2]; f32x4 wc[4]; };
DEVFN void rw_load(RwStep& t, const bf16_t* MLg, const bf16_t* NSg, const float* WCg, int c, int lane, int q) {
#pragma unroll
  for (int mk = 0; mk < 4; ++mk) { t.ml[mk][0] = ld8g(MLg + (size_t)c * 4096 + ((mk * 2 + 0) * 64 + lane) * 8); t.ml[mk][1] = ld8g(MLg + (size_t)c * 4096 + ((mk * 2 + 1) * 64 + lane) * 8);
    t.wc[mk] = *(const AS1 f32x4*)gptr(WCg + (size_t)c * 64 + q * 16 + mk * 4); }
  t.n[0] = ld8g(NSg + (size_t)c * 4096 + lane * 16); t.n[1] = ld8g(NSg + (size_t)c * 4096 + lane * 16 + 8);
}
DEVFN void rw_step(const RwStep& t, f32x4 (&S)[4], bf16_t* NSg, int c, int q, int l15) {
  bf16x4v sb[4];
#pragma unroll
  for (int mk = 0; mk < 4; ++mk) sb[mk] = cvt4(S[mk]);
  const bf16x8 bf0 = cat44(sb[0], sb[1]), bf1 = cat44(sb[2], sb[3]);
#pragma unroll
  for (int mk = 0; mk < 4; ++mk) {
    f32x4 acc;
#pragma unroll
    for (int r = 0; r < 4; ++r) acc[r] = bf2f((bf16_t)t.n[mk >> 1][(mk & 1) * 4 + r]) + t.wc[mk][r] * S[mk][r];
    acc = MFMA16(t.ml[mk][0], bf0, acc);
    acc = MFMA16(t.ml[mk][1], bf1, acc);
    S[mk] = acc; }
#pragma unroll
  for (int mk = 0; mk < 4; ++mk) *(AS1 bf16x4v*)gptr(NSg + (size_t)c * 4096 + l15 * 64 + 16 * mk + 4 * q) = sb[mk];
}
DEVFN void rwkv_scan(const Params& p, int chain, int wave) {
  const int tid = TIDX, lane = tid & 63, q = lane >> 4, l15 = lane & 15;
  const bf16_t* MLg = (const bf16_t*)(p.ws + Ws::RML) + (size_t)chain * NC16 * 4096;
  bf16_t* NSg = (bf16_t*)(p.ws + Ws::RNS) + (size_t)chain * NC16 * 4096 + wave * 1024;
  const float* WCg = (const float*)(p.ws + Ws::RWC) + (size_t)chain * NC16 * 64;
  f32x4 S[4];
#pragma unroll
  for (int mk = 0; mk < 4; ++mk) S[mk] = f32x4{0.f, 0.f, 0.f, 0.f};
  RwStep t0, t1, t2;
#define RWC_(x) ((x) < NC16 ? (x) : NC16 - 1)
  rw_load(t0, MLg, NSg, WCg, 0, lane, q);
  rw_load(t1, MLg, NSg, WCg, RWC_(1), lane, q);
  int c = 0;
  for (; c + 2 < NC16; c += 3) {
    rw_load(t2, MLg, NSg, WCg, c + 2, lane, q);
    rw_step(t0, S, NSg, c, q, l15);
    rw_load(t0, MLg, NSg, WCg, RWC_(c + 3), lane, q);
    rw_step(t1, S, NSg, c + 1, q, l15);
    rw_load(t1, MLg, NSg, WCg, RWC_(c + 4), lane, q);
    rw_step(t2, S, NSg, c + 2, q, l15);
  }
  if (c < NC16) { rw_step(t0, S, NSg, c, q, l15); if (c + 1 < NC16) rw_step(t1, S, NSg, c + 1, q, l15); }
#undef RWC_
}
DEVFN void rwkv_out(const Params& p, int unit_base) {
  const int tid = TIDX, lane = tid & 63, wave = tid >> 6, q = lane >> 4, l15 = lane & 15;
  const int unit = unit_base + wave;
  const int c = unit % NC16, h = (unit / NC16) & 3, dir = (unit / (NC16 * 4)) & 1, b = unit / (NC16 * 8);
  const size_t ci = (size_t)((b * 2 + dir) * 4 + h) * NC16 + c;
  const bf16_t* Sg = (const bf16_t*)(p.ws + Ws::RNS) + ci * 4096; const bf16_t* Gg = (const bf16_t*)(p.ws + Ws::RG) + ci * 1024;
  const float* Y0g = (const float*)(p.ws + Ws::RY0) + ci * 1024;
  float* YR = (float*)(p.ws + Ws::YR) + (size_t)dir * NT_ * 256;
  const bf16x8 a0 = ld8g(Gg + l15 * 64 + 8 * q), a1 = ld8g(Gg + l15 * 64 + 32 + 8 * q);
#pragma unroll
  for (int n = 0; n < 4; ++n) {
    f32x4 acc;
#pragma unroll
    for (int r = 0; r < 4; ++r) acc[r] = gptr(Y0g)[(4 * q + r) * 64 + 16 * n + l15];
    acc = MFMA16(a0, ld8g(Sg + n * 1024 + l15 * 64 + 8 * q), acc);
    acc = MFMA16(a1, ld8g(Sg + n * 1024 + l15 * 64 + 32 + 8 * q), acc);
#pragma unroll
    for (int r = 0; r < 4; ++r) YR[(size_t)(b * T_ + tokmap(dir, c * 16 + 4 * q + r)) * 256 + h * 64 + 16 * n + l15] = acc[r]; }
}
DEVFN int cscan(int dir, int co, int nctx, int nc) { return dir == 0 ? co : (co < nctx ? nctx - 1 - co : 2 * nctx + nc - 1 - co); }
DEVFN bf16x8 ld4x2g(const bf16_t* p0, const bf16_t* p1) { bf16x4v a = *(const AS1 bf16x4v*)gptr(p0), b = *(const AS1 bf16x4v*)gptr(p1); return bf16x8{a[0], a[1], a[2], a[3], b[0], b[1], b[2], b[3]}; }
DEVFN bf16x8 ld4x2(const bf16_t* p0, const bf16_t* p1) { bf16x4v a = *(const bf16x4v*)p0, b = *(const bf16x4v*)p1; return bf16x8{a[0], a[1], a[2], a[3], b[0], b[1], b[2], b[3]}; }

DEVFN void ssd_chunk_scalars(const Params& p, int l, int b, int co, int h, float* f) {
  const int tid = TIDX, d = tid >> 7, j = tid & 127;
  const float* DTB = (const float*)(p.ws + Ws::DTB);
  const float nega = -expf(INP(I_ALOG)[(size_t)l * 16 + d * 8 + h]);
  const float dt = DTB[(size_t)(b * T_ + co * 128 + j) * 16 + d * 8 + h];
  __syncthreads();
  f[256 + d * 128 + j] = dt;
  float* cur = f + d * 128; float* tmp = f + 512 + d * 128;
  cur[j] = dt * nega;
  __syncthreads();
  for (int off = 1; off < 128; off <<= 1) {
    float v = cur[j] + (j >= off ? cur[j - off] : 0.f);
    tmp[j] = v;
    __syncthreads();
    cur[j] = tmp[j];
    __syncthreads();
  }
}
DEVFN void ssd_states(const Params& p, int l, int unit, unsigned char* smem) {
  const int tid = TIDX, lane = tid & 63, wave = tid >> 6, q = lane >> 4, l15 = lane & 15;
  const int h = unit & 7, co = (unit >> 3) % NC128, b = unit / (8 * NC128), grp = h >> 2;
  float* f = (float*)smem;
  ssd_chunk_scalars(p, l, b, co, h, f);
  { const int d = tid >> 7, j = tid & 127; const float* cum = f + d * 128; const float dt = f[256 + d * 128 + j];
    float w = d == 0 ? expf(cum[127] - cum[j]) * dt : expf(j > 0 ? cum[j - 1] : 0.f) * dt;
    f[512 + d * 128 + j] = w; }
  __syncthreads();
  const bf16_t* XT = (const bf16_t*)(p.ws + Ws::XBCT) + (size_t)(b * NC128 + co) * 768 * 128;
  f32x4 acc[2][8];
#pragma unroll
  for (int d = 0; d < 2; ++d)
#pragma unroll
    for (int n = 0; n < 8; ++n) acc[d][n] = f32x4{0.f, 0.f, 0.f, 0.f};
#pragma unroll 1
  for (int s4 = 0; s4 < 4; ++s4) {
    const int j0 = s4 * 32 + q * 8;
    bf16x8 xa = ld8g(XT + (size_t)(h * 64 + wave * 16 + l15) * 128 + j0), a0, a1;
#pragma unroll
    for (int jj = 0; jj < 8; ++jj) { float x = bf2f((bf16_t)xa[jj]); a0[jj] = (short)f2bf(x * f[512 + j0 + jj]); a1[jj] = (short)f2bf(x * f[640 + j0 + jj]); }
#pragma unroll
    for (int n = 0; n < 8; ++n) { bf16x8 bb = ld8g(XT + (size_t)(512 + grp * 128 + n * 16 + l15) * 128 + j0);
      acc[0][n] = MFMA16(a0, bb, acc[0][n]); acc[1][n] = MFMA16(a1, bb, acc[1][n]); }
  }
#pragma unroll
  for (int d = 0; d < 2; ++d) {
    const int cs = cscan(d, co, CTX_ / 128, SEQ_ / 128);
    float* ST = (float*)(p.ws + Ws::SST) + ((size_t)((d * B_ + b) * NC128 + cs) * 8 + h) * 8192;
#pragma unroll
    for (int n = 0; n < 8; ++n)
#pragma unroll
      for (int r = 0; r < 4; ++r) ST[(wave * 16 + q * 4 + r) * 128 + n * 16 + l15] = acc[d][n][r];
    if (tid == 0) ((float*)(p.ws + Ws::SCD))[((size_t)(d * B_ + b) * NC128 + cs) * 8 + h] = expf(f[d * 128 + 127]);
  }
}
#define SSD_SB ((NC128 % 17) == 0 ? 17 : NC128)
DEVFN void ssd_scan(const Params& p, int gtid, int gthreads) {
  const float* __restrict__ ST = (const float*)(p.ws + Ws::SST); const float* __restrict__ CD = (const float*)(p.ws + Ws::SCD); bf16_t* __restrict__ HIN = (bf16_t*)(p.ws + Ws::HIN);
  for (int e = gtid; e < 2 * B_ * 8 * 8192; e += gthreads) {
    const int pd = e & 8191, h = (e >> 13) & 7, db = e >> 16;
    float hv = 0.f;
#pragma unroll 1
    for (int c0 = 0; c0 < NC128; c0 += SSD_SB) {
      float st[SSD_SB], cd[SSD_SB];
#pragma unroll
      for (int i = 0; i < SSD_SB; ++i) { st[i] = ST[((size_t)(db * NC128 + c0 + i) * 8 + h) * 8192 + pd]; cd[i] = CD[(size_t)(db * NC128 + c0 + i) * 8 + h]; }
#pragma unroll
      for (int i = 0; i < SSD_SB; ++i) { HIN[((size_t)(db * NC128 + c0 + i) * 8 + h) * 8192 + pd] = f2bf(hv); hv = hv * cd[i] + st[i]; }
    }
  }
}
DEVFN void ssd_out(const Params& p, int l, int unit, unsigned char* smem) {
  const int tid = TIDX, lane = tid & 63, wave = tid >> 6, q = lane >> 4, l15 = lane & 15;
  const int h = unit & 7, co = (unit >> 3) % NC128, b = unit / (8 * NC128), grp = h >> 2;
  float* f = (float*)smem;
  ssd_chunk_scalars(p, l, b, co, h, f);
  if (tid < 128) f[640 + tid] = f[128 + 127] - (tid > 0 ? f[128 + tid - 1] : 0.f);
  __syncthreads();
  const float* cum0 = f; const float* suf1 = f + 640; const float* dt0 = f + 256; const float* dt1 = f + 384;
  const bf16_t* XBC = (const bf16_t*)(p.ws + Ws::XBC) + (size_t)(b * T_ + co * 128) * 1024;
  const bf16_t* XT = (const bf16_t*)(p.ws + Ws::XBCT) + (size_t)(b * NC128 + co) * 768 * 128;
  const bf16_t* Cb = XBC + (size_t)(wave * 32 + l15) * 1024 + 768 + grp * 128 + q * 8;
  f32x4 y[4][2];
  { f32x4 o0[4][2], o1[4][2];
#pragma unroll
    for (int mp = 0; mp < 4; ++mp)
#pragma unroll
      for (int ni = 0; ni < 2; ++ni) { o0[mp][ni] = f32x4{0.f, 0.f, 0.f, 0.f}; o1[mp][ni] = f32x4{0.f, 0.f, 0.f, 0.f}; }
    const int cs0 = cscan(0, co, CTX_ / 128, SEQ_ / 128), cs1 = cscan(1, co, CTX_ / 128, SEQ_ / 128);
    const bf16_t* H0 = (const bf16_t*)(p.ws + Ws::HIN) + ((size_t)((0 * B_ + b) * NC128 + cs0) * 8 + h) * 8192;
    const bf16_t* H1 = (const bf16_t*)(p.ws + Ws::HIN) + ((size_t)((1 * B_ + b) * NC128 + cs1) * 8 + h) * 8192;
#pragma unroll 1
    for (int s4 = 0; s4 < 4; ++s4) { const bf16x8 c0 = ld8g(Cb + s4 * 32), c1 = ld8g(Cb + 16 * 1024 + s4 * 32);
#pragma unroll
      for (int mp = 0; mp < 4; ++mp) { bf16x8 h0 = ld8g(H0 + (size_t)(mp * 16 + l15) * 128 + s4 * 32 + q * 8), h1 = ld8g(H1 + (size_t)(mp * 16 + l15) * 128 + s4 * 32 + q * 8);
        o0[mp][0] = MFMA16(h0, c0, o0[mp][0]); o0[mp][1] = MFMA16(h0, c1, o0[mp][1]);
        o1[mp][0] = MFMA16(h1, c0, o1[mp][0]); o1[mp][1] = MFMA16(h1, c1, o1[mp][1]); } }
#pragma unroll
    for (int ni = 0; ni < 2; ++ni) { const int i = wave * 32 + ni * 16 + l15; const float e0 = expf(cum0[i]), e1 = expf(suf1[i]);
#pragma unroll
      for (int mp = 0; mp < 4; ++mp)
#pragma unroll
        for (int r = 0; r < 4; ++r) y[mp][ni][r] = e0 * o0[mp][ni][r] + e1 * o1[mp][ni][r]; } }
  bf16x8 mfr[4][2];
  { f32x4 g[8][2];
#pragma unroll
    for (int mj = 0; mj < 8; ++mj) { g[mj][0] = f32x4{0.f, 0.f, 0.f, 0.f}; g[mj][1] = f32x4{0.f, 0.f, 0.f, 0.f}; }
#pragma unroll 1
    for (int s4 = 0; s4 < 4; ++s4) { const bf16x8 c0 = ld8g(Cb + s4 * 32), c1 = ld8g(Cb + 16 * 1024 + s4 * 32);
#pragma unroll
      for (int mj = 0; mj < 8; ++mj) { bf16x8 bb = ld8g(XBC + (size_t)(mj * 16 + l15) * 1024 + 512 + grp * 128 + s4 * 32 + q * 8);
        g[mj][0] = MFMA16(bb, c0, g[mj][0]); g[mj][1] = MFMA16(bb, c1, g[mj][1]); } }
    const int i0 = wave * 32 + l15, i1 = i0 + 16;
    const float c0i0 = cum0[i0], s1i0 = suf1[i0], c0i1 = cum0[i1], s1i1 = suf1[i1];
#pragma unroll
    for (int mj = 0; mj < 8; ++mj)
#pragma unroll
      for (int r = 0; r < 4; ++r) { const int j = mj * 16 + q * 4 + r;
        const float cj = cum0[j], sj = suf1[j], d0 = dt0[j], d1 = dt1[j];
        const float lw0 = (j <= i0 ? expf(c0i0 - cj) * d0 : 0.f) + (j >= i0 ? expf(s1i0 - sj) * d1 : 0.f);
        const float lw1 = (j <= i1 ? expf(c0i1 - cj) * d0 : 0.f) + (j >= i1 ? expf(s1i1 - sj) * d1 : 0.f);
        mfr[mj >> 1][0][(mj & 1) * 4 + r] = (short)f2bf(g[mj][0][r] * lw0);
        mfr[mj >> 1][1][(mj & 1) * 4 + r] = (short)f2bf(g[mj][1][r] * lw1); } }
#pragma unroll
  for (int s4 = 0; s4 < 4; ++s4)
#pragma unroll
    for (int mp = 0; mp < 4; ++mp) { const bf16_t* xr = XT + (size_t)(h * 64 + mp * 16 + l15) * 128 + s4 * 32 + q * 4;
      bf16x8 xa = ld4x2g(xr, xr + 16);
      y[mp][0] = MFMA16(xa, mfr[s4][0], y[mp][0]); y[mp][1] = MFMA16(xa, mfr[s4][1], y[mp][1]); }
  __syncthreads();
  float* yl = f + 1024;
#pragma unroll
  for (int mp = 0; mp < 4; ++mp)
#pragma unroll
    for (int ni = 0; ni < 2; ++ni)
#pragma unroll
      for (int r = 0; r < 4; ++r) yl[(wave * 32 + ni * 16 + l15) * 65 + mp * 16 + q * 4 + r] = y[mp][ni][r];
  __syncthreads();
  float* YS = (float*)(p.ws + Ws::YS) + (size_t)(b * T_ + co * 128) * 512 + h * 64;
  for (int e = tid; e < 128 * 64; e += 256) YS[(size_t)(e >> 6) * 512 + (e & 63)] = yl[(e >> 6) * 65 + (e & 63)];
}

#define GQ_LD 40
#define GK_LD 72
DEVFN void gla_chunk(const Params& p, int unit, unsigned char* smem) {
  const int tid = TIDX, lane = tid & 63, wave = tid >> 6, q = lane >> 4, l15 = lane & 15;
  const int h = unit & 3, co = (unit >> 2) % NC64, b = unit / (4 * NC64);
  const bf16_t* ZX = (const bf16_t*)(p.ws + Ws::ZX) + (size_t)(b * T_ + co * 64) * NIN_;
  const float* LA = (const float*)(p.ws + Ws::LA);
  float* cum = (float*)smem;
  bf16_t* qs = (bf16_t*)(smem + 16384);
  bf16_t* ks = qs + 2 * 64 * GQ_LD;
  bf16_t* kt = ks + 2 * 64 * GQ_LD;
  __syncthreads();
  for (int e = tid; e < 2 * 64 * 32; e += 256) { const int d = e >> 11, i = (e >> 5) & 63, dd = e & 31;
    cum[e] = LA[((size_t)d * NT_ + b * T_ + co * 64 + i) * 128 + h * 32 + dd]; }
  __syncthreads();
  if (tid < 64) { const int d = tid >> 5, dd = tid & 31; float* c = cum + d * 2048 + dd; float sacc = 0.f;
    if (d == 0) for (int i = 0; i < 64; ++i) { sacc += c[i * 32]; c[i * 32] = sacc; }
    else for (int i = 63; i >= 0; --i) { sacc += c[i * 32]; c[i * 32] = sacc; } }
  __syncthreads();
  bf16_t* QT = (bf16_t*)(p.ws + Ws::QT);
  for (int e = tid; e < 64 * 32; e += 256) { const int i = e >> 5, dd = e & 31;
    const float qv = bf2f(ZX[(size_t)i * NIN_ + OGQ + h * 32 + dd]) * 0.17677669529663687f, kv = bf2f(ZX[(size_t)i * NIN_ + OGK + h * 32 + dd]);
    const float c0 = cum[i * 32 + dd], c1 = cum[2048 + i * 32 + dd], t0 = cum[63 * 32 + dd], t1 = cum[2048 + dd];
    const bf16_t q0 = f2bf(qv * expf(c0)), q1 = f2bf(qv * expf(c1));
    qs[i * GQ_LD + dd] = q0; qs[64 * GQ_LD + i * GQ_LD + dd] = q1;
    ks[i * GQ_LD + dd] = f2bf(kv * expf(-c0)); ks[64 * GQ_LD + i * GQ_LD + dd] = f2bf(kv * expf(-c1));
    kt[dd * GK_LD + i] = f2bf(kv * expf(t0 - c0)); kt[32 * GK_LD + dd * GK_LD + i] = f2bf(kv * expf(t1 - c1));
    const size_t tok = (size_t)b * T_ + co * 64 + i;
    QT[tok * 128 + h * 32 + dd] = q0; QT[((size_t)NT_ + tok) * 128 + h * 32 + dd] = q1; }
  if (tid < 64) { const int d = tid >> 5, dd = tid & 31; const int cs = cscan(d, co, CTX_ / 64, SEQ_ / 64);
    ((float*)(p.ws + Ws::GCD))[(((size_t)(d * B_ + b) * NC64 + cs) * 4 + h) * 32 + dd] = expf(d == 0 ? cum[63 * 32 + dd] : cum[2048 + dd]); }
  __syncthreads();
  bf16x8 pfr[2];
  { f32x4 p0[4], p1[4];
    const bf16x8 qb0 = ld8(qs + (wave * 16 + l15) * GQ_LD + q * 8), qb1 = ld8(qs + 64 * GQ_LD + (wave * 16 + l15) * GQ_LD + q * 8);
#pragma unroll
    for (int mj = 0; mj < 4; ++mj) { p0[mj] = MFMA16(ld8(ks + (mj * 16 + l15) * GQ_LD + q * 8), qb0, (f32x4{0.f, 0.f, 0.f, 0.f}));
      p1[mj] = MFMA16(ld8(ks + 64 * GQ_LD + (mj * 16 + l15) * GQ_LD + q * 8), qb1, (f32x4{0.f, 0.f, 0.f, 0.f})); }
    const int i = wave * 16 + l15;
#pragma unroll
    for (int mj = 0; mj < 4; ++mj)
#pragma unroll
      for (int r = 0; r < 4; ++r) { const int j = mj * 16 + q * 4 + r; pfr[mj >> 1][(mj & 1) * 4 + r] = (short)f2bf((j <= i ? p0[mj][r] : 0.f) + (j >= i ? p1[mj][r] : 0.f)); } }
  const bf16_t* VT = (const bf16_t*)(p.ws + Ws::VT) + ((size_t)(b * NC64 + co) * 256 + h * 64) * 64;
  f32x4 o[4];
#pragma unroll
  for (int md = 0; md < 4; ++md) { o[md] = f32x4{0.f, 0.f, 0.f, 0.f};
#pragma unroll
    for (int s2 = 0; s2 < 2; ++s2) { const bf16_t* vr = VT + (size_t)(md * 16 + l15) * 64 + s2 * 32 + q * 4; o[md] = MFMA16(ld4x2g(vr, vr + 16), pfr[s2], o[md]); } }
#pragma unroll
  for (int d = 0; d < 2; ++d) { const int cs = cscan(d, co, CTX_ / 64, SEQ_ / 64);
    float* GST = (float*)(p.ws + Ws::GST) + (((size_t)(d * B_ + b) * NC64 + cs) * 4 + h) * 2048;
#pragma unroll
    for (int nd = 0; nd < 2; ++nd) { f32x4 st = f32x4{0.f, 0.f, 0.f, 0.f};
#pragma unroll
      for (int s2 = 0; s2 < 2; ++s2) st = MFMA16(ld8g(VT + (size_t)(wave * 16 + l15) * 64 + s2 * 32 + q * 8), ld8(kt + d * 32 * GK_LD + (nd * 16 + l15) * GK_LD + s2 * 32 + q * 8), st);
#pragma unroll
      for (int r = 0; r < 4; ++r) GST[(wave * 16 + q * 4 + r) * 32 + nd * 16 + l15] = st[r]; } }
  __syncthreads();
  float* ol = (float*)smem;
#pragma unroll
  for (int md = 0; md < 4; ++md)
#pragma unroll
    for (int r = 0; r < 4; ++r) ol[(wave * 16 + l15) * 65 + md * 16 + q * 4 + r] = o[md][r];
  __syncthreads();
  float* OI = (float*)(p.ws + Ws::OI) + (size_t)(b * T_ + co * 64) * 256 + h * 64;
  for (int e = tid; e < 64 * 64; e += 256) OI[(size_t)(e >> 6) * 256 + (e & 63)] = ol[(e >> 6) * 65 + (e & 63)];
}
#define GLA_SB ((NC64 % 17) == 0 ? 17 : NC64)
DEVFN void gla_scan(const Params& p, int gtid, int gthreads) {
  const float* __restrict__ ST = (const float*)(p.ws + Ws::GST); const float* __restrict__ CD = (const float*)(p.ws + Ws::GCD); bf16_t* __restrict__ SIN = (bf16_t*)(p.ws + Ws::GSIN);
  for (int e = gtid; e < 2 * B_ * 4 * 2048; e += gthreads) {
    const int vd = e & 2047, h = (e >> 11) & 3, db = e >> 13;
    float sv = 0.f;
#pragma unroll 1
    for (int c0 = 0; c0 < NC64; c0 += GLA_SB) {
      float st[GLA_SB], cd[GLA_SB];
#pragma unroll
      for (int i = 0; i < GLA_SB; ++i) { st[i] = ST[(((size_t)db * NC64 + c0 + i) * 4 + h) * 2048 + vd]; cd[i] = CD[(((size_t)db * NC64 + c0 + i) * 4 + h) * 32 + (vd & 31)]; }
#pragma unroll
      for (int i = 0; i < GLA_SB; ++i) { SIN[(((size_t)db * NC64 + c0 + i) * 4 + h) * 2048 + vd] = f2bf(sv); sv = sv * cd[i] + st[i]; }
    }
  }
}
DEVFN void convert_moe_weights(const Params& p, int l, unsigned char* smem, int bid, int nb);
DEVFN void phase4a(const Params& p, int l, unsigned char* smem) {
  const int n_r = B_ * 8 * NC16 / 4;
  for (int u = BIDX; u < n_r; u += gridDim.x) rwkv_chunk(p, (u) * 4, smem);
  (void)l;
}
DEVFN void phase4b(const Params& p, int l, unsigned char* smem) {
  const int bid = BIDX, nrw = B_ * 8, G = (int)gridDim.x;
  const int n_s = B_ * NC128 * 8, n_g = B_ * NC64 * 4;
  int ob = bid, on = G;
  if (G >= 8 * nrw) {
    const int q = 2 * nrw, half = G >> 1;
    int sb = -1;
    if (bid < q) sb = bid; else if (bid >= half && bid < half + q) sb = q + (bid - half);
    if (sb >= 0) { if ((TIDX >> 6) == 0) rwkv_scan(p, sb >> 2, sb & 3); return; }
    ob = bid < half ? bid - q : bid - 2 * q; on = G - 4 * nrw; }
  else { for (int u = bid; u < nrw; u += G) rwkv_scan(p, u, TIDX >> 6); }
  for (int u = ob; u < n_s + n_g; u += on) { if (u < n_s) ssd_states(p, l, u, smem); else gla_chunk(p, u - n_s, smem); }
  convert_moe_weights(p, l, smem, ob, on);
}
DEVFN void phase4b2(const Params& p) {
  const int bid = BIDX, G = (int)gridDim.x;
  ssd_scan(p, bid * 256 + TIDX, G * 256); gla_scan(p, bid * 256 + TIDX, G * 256);
}
DEVFN void phase4c(const Params& p, int l, unsigned char* smem) {
  const int n_s = B_ * NC128 * 8, n_r = B_ * 8 * NC16 / 4;
  for (int u = BIDX; u < n_s + n_r; u += gridDim.x) { if (u < n_s) ssd_out(p, l, u, smem); else rwkv_out(p, (u - n_s) * 4); }
}

DEVFN void phase5(const Params& p, int l, unsigned char* smem) {
  const int tid = TIDX, lane = tid & 63, wave = tid >> 6;
  const bf16_t* ZX = (const bf16_t*)(p.ws + Ws::ZX);
  const bf16_t* XBC = (const bf16_t*)(p.ws + Ws::XBC);
  const float* YS = (const float*)(p.ws + Ws::YS); const float* YR = (const float*)(p.ws + Ws::YR); const float* OI = (const float*)(p.ws + Ws::OI);
  const bf16_t* QT = (const bf16_t*)(p.ws + Ws::QT); const bf16_t* GSIN = (const bf16_t*)(p.ws + Ws::GSIN);
  const bf16_t* RR = (const bf16_t*)(p.ws + Ws::RR); const bf16_t* VV = (const bf16_t*)(p.ws + Ws::VV); const bf16_t* KD = (const bf16_t*)(p.ws + Ws::KD);
  const float* GATE = (const float*)(p.ws + Ws::GATE);
  bf16_t* YM = (bf16_t*)(p.ws + Ws::YMIX);
  float* red = (float*)smem;
  float* qt = red + 16;
  const float dA = INP(I_SSDD)[(size_t)l * 8 + (tid >> 6)], dB = INP(I_SSDD)[(size_t)l * 8 + 4 + (tid >> 6)];
  const float nwA = INP(I_SSDNW)[(size_t)l * 512 + tid], nwB = INP(I_SSDNW)[(size_t)l * 512 + 256 + tid];
  const float lnw = INP(I_LNXW)[(size_t)l * 256 + tid], lnb = INP(I_LNXB)[(size_t)l * 256 + tid], rk = INP(I_RK)[(size_t)l * 256 + tid];
  const float gnw = INP(I_GNW)[(size_t)l * 256 + tid];
  const int per_ = (NT_ / 2 + (int)gridDim.x - 1) / (int)gridDim.x, tp_lo = BIDX * per_, tp_hi = (tp_lo + per_ < NT_ / 2) ? tp_lo + per_ : NT_ / 2;
  for (int tp = tp_lo; tp < tp_hi; ++tp) {
    float ys0[2], ys1[2], x0[2], x1[2], z0[2], z1[2], og[2], yr[2], rr[2], kf[2], kb[2], vv[2], gt[2], oi[2], qv[2];
    bf16x8 gs[2][2][4];
#pragma unroll
    for (int t = 0; t < 2; ++t) { const int tok = tp * 2 + t; const int b = tok / T_, co = (tok % T_) / 64;
      ys0[t] = gptr(YS)[(size_t)tok * 512 + tid]; ys1[t] = gptr(YS)[(size_t)tok * 512 + 256 + tid];
      x0[t] = bf2f(gptr(XBC)[(size_t)tok * 1024 + tid]); x1[t] = bf2f(gptr(XBC)[(size_t)tok * 1024 + 256 + tid]);
      z0[t] = zxv(ZX, tok, OZ + tid); z1[t] = zxv(ZX, tok, OZ + 256 + tid); og[t] = zxv(ZX, tok, OOG + tid);
      yr[t] = gptr(YR)[(size_t)tok * 256 + tid] + gptr(YR)[((size_t)NT_ + tok) * 256 + tid];
      rr[t] = bf2f(gptr(RR)[(size_t)tok * 256 + tid]); kf[t] = bf2f(gptr(KD)[(size_t)tok * 256 + tid]); kb[t] = bf2f(gptr(KD)[((size_t)NT_ + tok) * 256 + tid]);
      vv[t] = bf2f(gptr(VV)[(size_t)tok * 256 + tid]); gt[t] = gptr(GATE)[(size_t)tok * 256 + tid]; oi[t] = gptr(OI)[(size_t)tok * 256 + tid];
      qv[t] = bf2f(gptr(QT)[((size_t)(tid >> 7) * NT_ + tok) * 128 + (tid & 127)]);
#pragma unroll
      for (int d = 0; d < 2; ++d) { const int cs = cscan(d, co, CTX_ / 64, SEQ_ / 64);
        const bf16_t* sr = GSIN + ((((size_t)(d * B_ + b) * NC64 + cs) * 4 + wave) * 64 + lane) * 32;
#pragma unroll
        for (int c8 = 0; c8 < 4; ++c8) gs[t][d][c8] = ld8g(sr + c8 * 8); } }
    float ya[2], yb[2], qa[2], qb[2];
#pragma unroll
    for (int t = 0; t < 2; ++t) {
      ya[t] = (ys0[t] + dA * x0[t]) * siluf_(z0[t]); yb[t] = (ys1[t] + dB * x1[t]) * siluf_(z1[t]);
      qa[t] = wave_sum(ya[t] * ya[t]); qb[t] = wave_sum(yb[t] * yb[t]); }
    __syncthreads();
#pragma unroll
    for (int t = 0; t < 2; ++t) {
      if (lane == 0) { red[t * 8 + wave] = qa[t]; red[t * 8 + 4 + wave] = qb[t]; }
      qt[t * 256 + tid] = qv[t]; }
    __syncthreads();
#pragma unroll
    for (int t = 0; t < 2; ++t) { const int tok = tp * 2 + t;
      const float* rd = red + t * 8; const float* qtt = qt + t * 256;
      float ma = (rd[0] + rd[1] + rd[2] + rd[3]) * (1.f / 256.f), mb = (rd[4] + rd[5] + rd[6] + rd[7]) * (1.f / 256.f);
      YM[(size_t)tok * 1024 + tid] = f2bf(ya[t] * rsqrtf(ma + 1e-5f) * nwA);
      YM[(size_t)tok * 1024 + 256 + tid] = f2bf(yb[t] * rsqrtf(mb + 1e-5f) * nwB);
      { const float y = yr[t];
        float mu = wave_sum(y) * (1.f / 64.f), d = y - mu, var = wave_sum(d * d) * (1.f / 64.f);
        float yn = d * rsqrtf(var + 64e-5f) * lnw + lnb;
        float bonus = wave_sum(rr[t] * (kf[t] + kb[t]) * rk) * vv[t];
        YM[(size_t)tok * 1024 + 512 + tid] = f2bf((yn + bonus) * gt[t]); }
      { float o = oi[t];
#pragma unroll
        for (int d = 0; d < 2; ++d)
#pragma unroll
          for (int c8 = 0; c8 < 4; ++c8)
#pragma unroll
            for (int jj = 0; jj < 8; ++jj) o += qtt[d * 128 + wave * 32 + c8 * 8 + jj] * bf2f((bf16_t)gs[t][d][c8][jj]);
        float ms = wave_sum(o * o) * (1.f / 64.f);
        YM[(size_t)tok * 1024 + 768 + tid] = f2bf(o * rsqrtf(ms + 1e-5f) * gnw * siluf_(og[t])); } }
  }
}

DEVFN void phase6(const Params& p, int l, unsigned char* smem) {
  const bf16_t* A = (const bf16_t*)(p.ws + Ws::YMIX);
  const bf16_t* W = (const bf16_t*)(p.ws + Ws::WOUT) + (size_t)l * 1024 * 1024;
  float* MIX = (float*)(p.ws + Ws::MIX);
  for (int u = BIDX; u < (NT_ / 128) * 8; u += gridDim.x) {
    int rt = u / 8, ct = u % 8;
    gemm_tile(smem, 1024,
      [&](int r) { return A + (size_t)(rt * 128 + r) * 1024; },
      [&](int r) { return W + (size_t)(ct * 128 + r) * 1024; },
      [&](f32x4 (&acc)[4][4], int wr, int wc, int g, int l15) {
#pragma unroll
        for (int mi = 0; mi < 4; ++mi)
#pragma unroll
          for (int ni = 0; ni < 4; ++ni)
#pragma unroll
            for (int i = 0; i < 4; ++i) MIX[(size_t)(rt * 128 + wr * 64 + mi * 16 + 4 * g + i) * 1024 + ct * 128 + wc * 64 + ni * 16 + l15] = acc[mi][ni][i];
      });
  }
}

#define P7_MAXE 2048
DEVFN void phase7(const Params& p, int l, unsigned char* smem) {
  const int lane = TIDX & 63, wave = TIDX >> 6;
  float* X = (float*)(p.ws + Ws::X);
  const float* MIX = (const float*)(p.ws + Ws::MIX);
  bf16_t* H = (bf16_t*)(p.ws + Ws::U);
  const float* rwt = (const float*)(p.ws + Ws::RWT) + (size_t)l * 64 * 1024;
  int* cnt = (int*)(p.ws + Ws::CNT) + l * 64 * 64;
  int* ltok = (int*)(p.ws + Ws::LTOK); float* lwt = (float*)(p.ws + Ws::LWT);
  const float rbias = INP(I_RB)[(size_t)l * 64 + lane];
  float* hs = (float*)smem;
  float* lg = hs + 4096;
  int* lcnt = (int*)(lg + 256);
  int* lbase = lcnt + 80;
  int* etok = lbase + 64;
  int* epos = etok + P7_MAXE; float* ewt = (float*)(epos + P7_MAXE);
  for (int i = TIDX; i < 80; i += 256) lcnt[i] = 0;
  for (int tok0 = BIDX * 4; tok0 < NT_; tok0 += gridDim.x * 4) {
    const int tok = tok0 + wave;
    const float* mod = (const float*)(p.ws + Ws::MOD) + ((size_t)l * NR_ + tok_modrow(tok)) * NMOD_;
    float xv[16], mx[16], g1[16], lw[16], lb[16], sh2[16], sc2[16], mean, rstd;
    load_row16(X + (size_t)tok * 1024, lane, xv);
    load_row16(MIX + (size_t)tok * 1024, lane, mx);
    load_row16(mod + 2 * 1024, lane, g1);
    load_row16(INP(I_LN1W) + (size_t)l * 1024, lane, lw);
    load_row16(INP(I_LN1B) + (size_t)l * 1024, lane, lb);
    load_row16(mod + 3 * 1024, lane, sh2);
    load_row16(mod + 4 * 1024, lane, sc2);
#pragma unroll
    for (int i = 0; i < 16; ++i) xv[i] = ALPHA_ * xv[i] + g1[i] * mx[i];
    row_stats(xv, mean, rstd);
#pragma unroll
    for (int i = 0; i < 16; ++i) xv[i] = (xv[i] - mean) * rstd * lw[i] + lb[i];
#pragma unroll
    for (int j = 0; j < 4; ++j) *(float4*)(X + (size_t)tok * 1024 + lane * 4 + 256 * j) = make_float4(xv[4 * j], xv[4 * j + 1], xv[4 * j + 2], xv[4 * j + 3]);
    const bool routed = !(l == DEPTH_ - 1 && (tok % T_) < CTX_);
    row_stats(xv, mean, rstd);
#pragma unroll
    for (int i = 0; i < 16; ++i) xv[i] = (xv[i] - mean) * rstd * (1.f + sc2[i]) + sh2[i];
    __syncthreads();
#pragma unroll
    for (int j = 0; j < 4; ++j) {
      if (routed) *(uint2*)(H + (size_t)tok * 1024 + lane * 4 + 256 * j) = make_uint2((unsigned)f2bf(xv[4 * j]) | ((unsigned)f2bf(xv[4 * j + 1]) << 16), (unsigned)f2bf(xv[4 * j + 2]) | ((unsigned)f2bf(xv[4 * j + 3]) << 16));
      *(float4*)(hs + wave * 1024 + lane * 4 + 256 * j) = make_float4(xv[4 * j], xv[4 * j + 1], xv[4 * j + 2], xv[4 * j + 3]); }
    __syncthreads();
    { float hv[4][16];
      const int rot = BIDX & 15;
#pragma unroll
      for (int t = 0; t < 4; ++t)
#pragma unroll
        for (int j = 0; j < 4; ++j) { const float4 v = *(const float4*)(hs + t * 1024 + lane * 4 + 256 * j); hv[t][4 * j] = v.x; hv[t][4 * j + 1] = v.y; hv[t][4 * j + 2] = v.z; hv[t][4 * j + 3] = v.w; }
      float pe[64];
      const AS1 float* rw = gptr(rwt) + lane * 4;
      f32x4 w[4], wn[4];
#pragma unroll
      for (int j = 0; j < 4; ++j) w[j] = *(const AS1 f32x4*)(rw + (size_t)(16 * wave + (rot & 15)) * 1024 + 256 * j);
#pragma unroll
      for (int e = 0; e < 16; ++e) {
        if (e + 1 < 16) {
#pragma unroll
          for (int j = 0; j < 4; ++j) wn[j] = *(const AS1 f32x4*)(rw + (size_t)(16 * wave + ((e + 1 + rot) & 15)) * 1024 + 256 * j); }
#pragma unroll
        for (int t = 0; t < 4; ++t) { float s0 = 0.f, s1 = 0.f;
#pragma unroll
          for (int j = 0; j < 4; ++j) { s0 += hv[t][4 * j] * w[j][0] + hv[t][4 * j + 2] * w[j][2]; s1 += hv[t][4 * j + 1] * w[j][1] + hv[t][4 * j + 3] * w[j][3]; }
          pe[e * 4 + t] = s0 + s1; }
#pragma unroll
        for (int j = 0; j < 4; ++j) w[j] = wn[j]; }
#pragma unroll
      for (int half = 32; half >= 1; half >>= 1) { const bool up = (lane & half) != 0;
#pragma unroll
        for (int e = 0; e < half; ++e) { const float send = up ? pe[e] : pe[e + half]; const float recv = __shfl_xor(send, half); pe[e] = (up ? pe[e + half] : pe[e]) + recv; } }
      lg[(lane & 3) * 64 + 16 * wave + (((lane >> 2) + rot) & 15)] = pe[0]; }
    __syncthreads();
    if (!routed) continue;
    const float logit = lg[wave * 64 + lane];
    const float score = sigmoidf_(logit), sel = score + rbias;
    float m1 = sel; int a1 = lane;
#pragma unroll
    for (int m = 1; m <= 4; m <<= 1) { float ov = XOR8(m1, m); int oa = XOR8(a1, m); if (ov > m1 || (ov == m1 && oa < a1)) { m1 = ov; a1 = oa; } }
    float m2 = (lane == a1) ? -3.0e38f : sel;
#pragma unroll
    for (int m = 1; m <= 4; m <<= 1) m2 = fmaxf(m2, XOR8(m2, m));
    const float gs = m1 + m2; const int grp = lane >> 3;
    int grank = 0;
#pragma unroll
    for (int g2 = 0; g2 < 8; ++g2) { float og = SHFL_CONST(gs, g2 * 8); grank += (og > gs || (og == gs && g2 < grp)) ? 1 : 0; }
    const bool gsel = grank < 4;
    const float msel = gsel ? sel : -3.0e38f;
    int rank = 0;
#pragma unroll
    for (int e = 0; e < 64; ++e) { float ov = SHFL_CONST(msel, e); rank += (ov > msel || (ov == msel && e < lane)) ? 1 : 0; }
    const bool chosen = gsel && rank < 8;
    const float wsum = wave_sum(chosen ? score : 0.f);
    if (chosen) { const float wv = score / wsum * 2.5f;
      const int idx = atomicAdd(&lcnt[64], 1);
      if (idx < P7_MAXE) { const int slot = atomicAdd(&lcnt[lane], 1); etok[idx] = tok * 8 + rank; epos[idx] = lane | (slot << 8); ewt[idx] = wv; }
      else { int pos = atomicAdd(&cnt[lane * 64], 1); ltok[(size_t)lane * NT_ + pos] = tok * 8 + rank; lwt[(size_t)lane * NT_ + pos] = wv; } }
  }
  __syncthreads();
  if (TIDX < 64) { const int c = lcnt[TIDX]; lbase[TIDX] = c ? atomicAdd(&cnt[TIDX * 64], c) : 0; }
  __syncthreads();
  { const int ne = lcnt[64] < P7_MAXE ? lcnt[64] : P7_MAXE;
    for (int i = TIDX; i < ne; i += 256) { const int e = epos[i] & 255, pos = lbase[e] + (epos[i] >> 8);
      ltok[(size_t)e * NT_ + pos] = etok[i]; lwt[(size_t)e * NT_ + pos] = ewt[i]; } }
}

struct MoeMap { int nblk_total; int e; int rb; int cnt; int hoff; };
DEVFN int moe_ntok(int l) { return l == DEPTH_ - 1 ? B_ * SEQ_ : NT_; }
DEVFN int moe_shared_tok(int l, int i) { return l == DEPTH_ - 1 ? (i / SEQ_) * T_ + CTX_ + (i % SEQ_) : i; }
DEVFN void moe_prefix(const Params& p, int l, int* pre) {
  const int* cnt = (const int*)(p.ws + Ws::CNT) + l * 64 * 64;
  __syncthreads();
  if (TIDX < 64) pre[66 + TIDX] = gptr(cnt)[TIDX * 64];
  if (TIDX == 64) pre[66 + 64] = moe_ntok(l);
  __syncthreads();
  if (TIDX == 0) { int s = 0; for (int e = 0; e < 65; ++e) { pre[e] = s; s += (pre[66 + e] + 127) / 128; } pre[65] = s; }
  __syncthreads();
}
DEVFN void phase8(const Params& p, int l, unsigned char* smem) {
  int* pre = (int*)(smem + SM_PRE);
  moe_prefix(p, l, pre);
  const bf16_t* H = (const bf16_t*)(p.ws + Ws::U);
  const bf16_t* W13 = (const bf16_t*)(p.ws + Ws::W13);
  bf16_t* HID = (bf16_t*)(p.ws + Ws::HID);
  const int* ltok = (const int*)(p.ws + Ws::LTOK); const float* lwt = (const float*)(p.ws + Ws::LWT);
  const int total = pre[65];
  for (int u = BIDX; u < total * 4; u += gridDim.x) {
    const int gb = u >> 2, nt = u & 3;
    int e = 0; while (pre[e + 1] <= gb) ++e;
    const int rb = gb - pre[e], cnt = pre[66 + e];
    int* tk_s = (int*)(smem + GEMM_SMEM); float* gw_s = (float*)(tk_s + 128);
    __syncthreads();
    if (TIDX < 128) { const int pos = rb * 128 + TIDX; int tk = -1; float gw = 0.f;
      if (pos < cnt) { tk = e < 64 ? (gptr(ltok)[(size_t)e * NT_ + pos] >> 3) : moe_shared_tok(l, pos); gw = e < 64 ? gptr(lwt)[(size_t)e * NT_ + pos] : 1.f; }
      tk_s[TIDX] = tk; gw_s[TIDX] = gw; }
    __syncthreads();
    gemm_tile(smem, 1024,
      [&](int r) { const int tk = tk_s[r]; return tk >= 0 ? H + (size_t)tk * 1024 : (const bf16_t*)(p.ws + Ws::ZROW); },
      [&](int r) { return W13 + ((size_t)e * 512 + nt * 128 + r) * 1024; },
      [&](f32x4 (&acc)[4][4], int wr, int wc, int g, int l15) {
        tile_store_bf16<8>(smem, wr, g, l15,
          [&](bf16_t* T, int ldc) {
#pragma unroll
            for (int mi = 0; mi < 4; ++mi)
#pragma unroll
              for (int i = 0; i < 4; ++i) { const int r = wr * 64 + mi * 16 + 4 * g + i, pos = rb * 128 + r;
                const float gw = gw_s[r]; (void)pos;
#pragma unroll
                for (int j = 0; j < 2; ++j) T[r * ldc + wc * 32 + j * 16 + l15] = f2bf(siluf_(acc[mi][2 * j][i]) * acc[mi][2 * j + 1][i] * gw); } },
          [&](int row, int c0) { const int pos = rb * 128 + row; return pos < cnt ? HID + ((size_t)gb * 128 + row) * 256 + nt * 64 + c0 : (bf16_t*)nullptr; });
      });
  }
}
DEVFN void phase9(const Params& p, int l, unsigned char* smem) {
  int* pre = (int*)(smem + SM_PRE);
  moe_prefix(p, l, pre);
  const bf16_t* HID = (const bf16_t*)(p.ws + Ws::HID);
  const bf16_t* W2T = (const bf16_t*)(p.ws + Ws::W2T);
  bf16_t* YB = (bf16_t*)(p.ws + Ws::YBUF);
  const int* ltok = (const int*)(p.ws + Ws::LTOK);
  const int total = pre[65];
  for (int u = BIDX; u < total * 2; u += gridDim.x) {
    const int gb = u >> 1, ntp = u & 1;
    int e = 0; while (pre[e + 1] <= gb) ++e;
    const int rb = gb - pre[e], cnt = pre[66 + e];
    int* ts_s = (int*)(smem + GEMM_SMEM);
    __syncthreads();
    if (TIDX < 128) { const int pos = rb * 128 + TIDX; int ts = -1;
      if (pos < cnt) ts = e < 64 ? gptr(ltok)[(size_t)e * NT_ + pos] : moe_shared_tok(l, pos) * 8;
      ts_s[TIDX] = ts; }
    __syncthreads();
    gemm_tile_multi<4>(smem, 256,
      [&](int r) { return ts_s[r] >= 0 ? HID + ((size_t)gb * 128 + r) * 256 : (const bf16_t*)(p.ws + Ws::ZROW); },
      [&](int r, int j) { return W2T + ((size_t)e * 1024 + (ntp * 4 + j) * 128 + r) * 256; },
      [&](f32x4 (&acc)[4][4], int j, int wr, int wc, int g, int l15) { const int nt = ntp * 4 + j;
        tile_store_bf16<16>(smem, wr, g, l15,
          [&](bf16_t* T, int ldc) {
#pragma unroll
            for (int mi = 0; mi < 4; ++mi)
#pragma unroll
              for (int ni = 0; ni < 4; ++ni)
#pragma unroll
                for (int i = 0; i < 4; ++i) T[(wr * 64 + mi * 16 + 4 * g + i) * ldc + wc * 64 + ni * 16 + l15] = f2bf(acc[mi][ni][i]); },
          [&](int row, int c0) { const int ts = ts_s[row]; if (ts < 0) return (bf16_t*)nullptr;
            const int tok = ts >> 3, slot = e < 64 ? (ts & 7) : 8;
            return YB + ((size_t)tok * NSLOT + slot) * 1024 + nt * 128 + c0; });
      });
  }
}

#define SMEM_BYTES (PH_SMEM + 2048)
#define N_PHASES (3 + 13 * DEPTH_)
__global__ void __launch_bounds__(256, 2) mega(Params p, int ph_lo, int ph_hi) {
#ifdef HIPEMU
  unsigned char* smem = hipemu::cur_smem();
#else
  unsigned char* smem = smem_dyn;
  volatile LAS unsigned* st = (volatile LAS unsigned*)(smem_dyn + SM_BAR);
  if (threadIdx.x == 0) {
    st[0] = 0u; st[1] = 0u;
    unsigned long long* tab = (unsigned long long*)(smem_dyn + SM_TAB);
#pragma unroll
    for (int i = 0; i < 40; ++i) tab[i] = (unsigned long long)p.in[i];
  }
  __syncthreads();
  XcdBarrier bar = xcd_barrier_post((unsigned*)(p.ws + Ws::BAR), st);
#define GRID_SYNC() xcd_barrier(bar)
#endif
  int ph = 0;
#ifdef ONLY_KIND
#define KIND_ON(k) ((k) == ONLY_KIND)
#else
#define KIND_ON(k) 1
#endif
#ifndef REPEAT_MASK
#define REPEAT_MASK 0u
#endif
#define RUN_PHASE(kind, code) { if (KIND_ON(kind) && ph >= ph_lo && ph < ph_hi) { \
    int nrep_ = ((REPEAT_MASK >> (kind)) & 1u) ? 2 : 1; LAUNDER(nrep_); \
    _Pragma("unroll 1") for (int rep_ = 0; rep_ < nrep_; ++rep_) { LAUNDER(p.ws); LAUNDER(p.out); code; if (rep_ + 1 < nrep_ || ph + 1 < ph_hi) { GRID_SYNC(); } } } ++ph; }
  RUN_PHASE(0, phase0(p, smem));
  RUN_PHASE(11, phase0b(p));
  for (int l = 0; l < DEPTH_; ++l) {
    RUN_PHASE(1, phase1(p, l));
    RUN_PHASE(2, phase2(p, l, smem));
    RUN_PHASE(3, phase3(p, l, smem));
    RUN_PHASE(14, phase3b(p, l, smem));
    RUN_PHASE(4, phase4a(p, l, smem));
    RUN_PHASE(12, phase4b(p, l, smem));
    RUN_PHASE(16, phase4b2(p));
    RUN_PHASE(13, phase4c(p, l, smem));
    RUN_PHASE(5, phase5(p, l, smem));
    RUN_PHASE(6, phase6(p, l, smem));
    RUN_PHASE(7, phase7(p, l, smem));
    RUN_PHASE(8, phase8(p, l, smem));
    RUN_PHASE(9, phase9(p, l, smem));
  }
  RUN_PHASE(10, phase_final(p));
}

extern "C" void kernel_launch(void* const* d_in, const int* in_sizes, int n_in, void* d_out, int out_size, void* d_ws, size_t ws_size, hipStream_t stream) {
  Params p{};
  for (int i = 0; i < 40; ++i) p.in[i] = (const float*)d_in[i];
  p.out = (float*)d_out;
  p.ws = (unsigned char*)d_ws;
  if (ws_size < Ws::END) { fprintf(stderr, "workspace too small: %zu < %zu\n", ws_size, (size_t)Ws::END); return; }
  hipMemsetAsync(d_ws, 0, Ws::ZERO_END, stream);
#ifdef HIPEMU
  int grid = 16; if (const char* e = getenv("EMU_GRID")) grid = atoi(e);
  int stop = N_PHASES; if (const char* e = getenv("EMU_STOP")) stop = atoi(e);
  if (getenv("EMU_ONE")) hipemu::launch(grid, 256, SMEM_BYTES, true, [=] { mega(p, 0, stop); });
  else for (int ph = 0; ph < stop; ++ph) hipemu::launch(grid, 256, SMEM_BYTES, false, [=] { mega(p, ph, ph + 1); });
#else
  static int grid = 0;
  if (!grid) {
    int dev = 0, cus = 0, per_cu = 0;
    hipGetDevice(&dev);
    hipDeviceGetAttribute(&cus, hipDeviceAttributeMultiprocessorCount, dev);
    hipOccupancyMaxActiveBlocksPerMultiprocessor(&per_cu, mega, 256, SMEM_BYTES);
    if (per_cu > 2) per_cu = 2;
    if (per_cu < 1) per_cu = 1;
    grid = cus * per_cu;
  }
#if N_LAUNCH_MODE == 1
  mega<<<grid, 256, SMEM_BYTES, stream>>>(p, 0, N_PHASES);
#else
  for (int ph = 0; ph < N_PHASES; ++ph) mega<<<grid, 256, SMEM_BYTES, stream>>>(p, ph, ph + 1);
#endif
#endif
}
```

```cpp
#ifndef HIPEMU
#include <hip/hip_runtime.h>
#endif
#include <stdint.h>
#include <stdio.h>

#ifndef B_
#define B_ 4
#endif
#ifndef SEQ_
#define SEQ_ 4096
#endif
#ifndef CTX_
#define CTX_ 256
#endif
#ifndef DEPTH_
#define DEPTH_ 4
#endif
#ifndef N_LAUNCH_MODE
#define N_LAUNCH_MODE 1
#endif
#define T_ (SEQ_ + CTX_)
#define NT_ (B_ * T_)
#define D_ 1024
#define NIN_ 3504
#define NMOD_ 6144
#define NR_ (B_ + 1)
#define OZ 0
#define OXBC 512
#define ODT 1536
#define ORW 1552
#define OGQ 2704
#define OGK 2832
#define OGV 2960
#define OGD 3216
#define OOG 3248
#define ALPHA_ 1.681792830507429f
#define NEXP 64
#define NSLOT 9
#define NC128 (T_ / 128)
#define NC64 (T_ / 64)
#define NC16 (T_ / 16)

#define DEVFN __device__ __forceinline__
#define LDT 72
#define GEMM_SMEM (2 * 128 * LDT * 2)
#define GEMMW_SMEM (3 * 128 * LDT * 2)
typedef unsigned short bf16_t;
#ifdef HIPEMU
#define AS1
#else
#define AS1 __attribute__((address_space(1)))
#endif
typedef unsigned u32x4 __attribute__((ext_vector_type(4)));
typedef unsigned u32x2 __attribute__((ext_vector_type(2)));

#ifdef HIPEMU
typedef emu_bf16x8 bf16x8;
typedef emu_f32x4 f32x4;
#define MFMA16(a, b, c) emu_mfma_16x16x32_bf16(a, b, c)
#define MFMA16K16(a, b, c) emu_mfma_16x16x16_bf16(a, b, c)
#define GRID_SYNC() hipemu::grid_sync()
#else
typedef short bf16x8 __attribute__((ext_vector_type(8)));
typedef float f32x4 __attribute__((ext_vector_type(4)));
#define MFMA16(a, b, c) __builtin_amdgcn_mfma_f32_16x16x32_bf16(a, b, c, 0, 0, 0)
#define MFMA16K16(a, b, c) __builtin_amdgcn_mfma_f32_16x16x16bf16_1k(a, b, c, 0, 0, 0)
#endif

DEVFN float bf2f(bf16_t h) { return __builtin_bit_cast(float, (unsigned)h << 16); }
DEVFN bf16_t f2bf(float f) { unsigned u = __builtin_bit_cast(unsigned, f); u += 0x7FFFu + ((u >> 16) & 1u); return (bf16_t)(u >> 16); }
template <class T> DEVFN AS1 T* gptr(T* q) { return (AS1 T*)q; }
DEVFN bf16x8 ld8g(const bf16_t* q) { return *(const AS1 bf16x8*)gptr(q); }
DEVFN float sigmoidf_(float x) { return 1.f / (1.f + expf(-x)); }
DEVFN float siluf_(float x) { return x / (1.f + expf(-x)); }
DEVFN float softplusf_(float x) { return x > 20.f ? x : log1pf(expf(x)); }
DEVFN float logsigmoidf_(float x) { return fminf(x, 0.f) - log1pf(expf(-fabsf(x))); }
#ifdef HIPEMU
DEVFN float wave_sum(float v) { for (int m = 32; m >= 1; m >>= 1) v += __shfl_xor(v, m); return v; }
#define SHFL_CONST(x, ln) __shfl(x, ln)
#define XOR8(x, m) __shfl_xor(x, m)
#else
template <int CTRL> DEVFN float dpp_f(float v) { return __builtin_bit_cast(float, __builtin_amdgcn_update_dpp(0, __builtin_bit_cast(int, v), CTRL, 0xF, 0xF, false)); }
template <int CTRL> DEVFN int dpp_i(int v) { return __builtin_amdgcn_update_dpp(0, v, CTRL, 0xF, 0xF, false); }
DEVFN float rdl_f(float v, int ln) { return __builtin_bit_cast(float, __builtin_amdgcn_readlane(__builtin_bit_cast(int, v), ln)); }
DEVFN float wave_sum(float v) {
  v += dpp_f<0xB1>(v);
  v += dpp_f<0x4E>(v);
  v += dpp_f<0x141>(v);
  v += dpp_f<0x140>(v);
  return (rdl_f(v, 0) + rdl_f(v, 16)) + (rdl_f(v, 32) + rdl_f(v, 48));
}
DEVFN float shfl_const_(float x, int ln) { return rdl_f(x, ln); }
DEVFN int shfl_const_(int x, int ln) { return __builtin_amdgcn_readlane(x, ln); }
#define SHFL_CONST(x, ln) shfl_const_(x, ln)
DEVFN float xor8_(float x, int m) { return m == 1 ? dpp_f<0xB1>(x) : m == 2 ? dpp_f<0x4E>(x) : dpp_f<0x141>(x); }
DEVFN int xor8_(int x, int m) { return m == 1 ? dpp_i<0xB1>(x) : m == 2 ? dpp_i<0x4E>(x) : dpp_i<0x141>(x); }
#define XOR8(x, m) xor8_(x, m)
#endif

constexpr size_t al(size_t x) { return (x + 255) & ~(size_t)255; }
struct Ws {
  static constexpr size_t BAR = 0;
  static constexpr size_t CNT = 16384;
  static constexpr size_t MOD = CNT + (size_t)DEPTH_ * 64 * 256;
  static constexpr size_t ZROW = al(MOD + (size_t)DEPTH_ * NR_ * NMOD_ * 4);
  static constexpr size_t ZERO_END = al(ZROW + 2048);
  static constexpr size_t MODP = ZERO_END;
  static constexpr size_t RWT = al(MODP + (size_t)16 * DEPTH_ * NR_ * NMOD_ * 4);
  static constexpr size_t LORA = al(RWT + (size_t)DEPTH_ * 64 * 1024 * 4);
  static constexpr size_t X = al(LORA + (size_t)DEPTH_ * 98304 * 2);
  static constexpr size_t U = al(X + (size_t)NT_ * 1024 * 4);
  static constexpr size_t YMIX = al(U + (size_t)NT_ * 1024 * 2);
  static constexpr size_t ZX = al(YMIX + (size_t)NT_ * 1024 * 2);
  static constexpr size_t MIX = ZX;
  static constexpr size_t LTOK = al(ZX + (size_t)NT_ * NIN_ * 2);
  static constexpr size_t LWT = al(LTOK + (size_t)64 * NT_ * 4);
  static constexpr size_t WIN = al(LWT + (size_t)64 * NT_ * 4);
  static constexpr size_t WOUT = al(WIN + (size_t)DEPTH_ * NIN_ * 1024 * 2);
  static constexpr size_t W13 = al(WOUT + (size_t)DEPTH_ * 1024 * 1024 * 2);
  static constexpr size_t W2T = al(W13 + (size_t)65 * 512 * 1024 * 2);
  static constexpr size_t UNI = al(W2T + (size_t)65 * 1024 * 256 * 2);
  static constexpr size_t XBC = UNI;
  static constexpr size_t XBCT = al(XBC + (size_t)NT_ * 1024 * 2);
  static constexpr size_t DTB = al(XBCT + (size_t)NT_ * 768 * 2);
  static constexpr size_t SST = al(DTB + (size_t)NT_ * 16 * 4);
  static constexpr size_t SCD = al(SST + (size_t)2 * NT_ / 128 * 8 * 8192 * 4);
  static constexpr size_t HIN = al(SCD + (size_t)2 * NT_ / 128 * 8 * 4);
  static constexpr size_t YS = SST;
  static constexpr size_t LA = al(HIN + (size_t)2 * NT_ / 128 * 8 * 8192 * 2);
  static constexpr size_t VT = al(LA + (size_t)2 * NT_ * 128 * 4);
  static constexpr size_t QT = al(VT + (size_t)NT_ * 256 * 2);
  static constexpr size_t OI = al(QT + (size_t)2 * NT_ * 128 * 2);
  static constexpr size_t GST = al(OI + (size_t)NT_ * 256 * 4);
  static constexpr size_t GCD = al(GST + (size_t)2 * NT_ / 64 * 4 * 2048 * 4);
  static constexpr size_t GSIN = al(GCD + (size_t)2 * NT_ / 64 * 4 * 32 * 4);
  static constexpr size_t RR = al(GSIN + (size_t)2 * NT_ / 64 * 4 * 2048 * 2);
  static constexpr size_t VV = RR + (size_t)NT_ * 256 * 2;
  static constexpr size_t KK = VV + (size_t)NT_ * 256 * 2;
  static constexpr size_t KD = KK + (size_t)NT_ * 256 * 2;
  static constexpr size_t BD = KD + (size_t)2 * NT_ * 256 * 2;
  static constexpr size_t LW = BD + (size_t)2 * NT_ * 256 * 2;
  static constexpr size_t GATE = LW + (size_t)2 * NT_ * 256 * 4;
  static constexpr size_t YR = GATE + (size_t)NT_ * 256 * 4;
  static constexpr size_t RML = al(YR + (size_t)2 * NT_ * 256 * 4);
  static constexpr size_t RNS = RML + (size_t)(NT_ / 16) * 8 * 4096 * 2;
  static constexpr size_t RWC = RNS + (size_t)(NT_ / 16) * 8 * 4096 * 2;
  static constexpr size_t RG = RWC + (size_t)(NT_ / 16) * 8 * 64 * 4;
  static constexpr size_t RY0 = RG + (size_t)(NT_ / 16) * 8 * 1024 * 2;
  static constexpr size_t LI = RY0 + (size_t)(NT_ / 16) * 8 * 1024 * 4;
  static constexpr size_t KRW = LI + (size_t)NT_ * 384 * 2;
  static constexpr size_t MIXER_END = KRW + (size_t)NT_ * 256 * 2;
  static constexpr size_t HID = UNI;
  static constexpr size_t YBUF = al(HID + ((size_t)NT_ * 9 + 65 * 128) * 256 * 2);
  static constexpr size_t MOE_END = YBUF + (size_t)NT_ * 9 * 1024 * 2;
  static constexpr size_t END = al(MIXER_END > MOE_END ? MIXER_END : MOE_END);
};

struct Params {
  const float* in[40];
  float* out;
  unsigned char* ws;
};
enum { I_X = 0, I_C, I_CTX, I_CCTX, I_ADAW, I_ADAB, I_WIN, I_CONVW, I_CONVB, I_DTBIAS, I_ALOG, I_SSDD, I_SSDNW, I_MU, I_W0, I_W2, I_A0, I_A2,
       I_G2, I_KKW, I_KAW, I_RK, I_LNXW, I_LNXB, I_GU, I_GB, I_GNW, I_WOUT, I_LN1W, I_LN1B, I_LN2W, I_LN2B, I_RW, I_RB, I_EW1, I_EW3, I_EW2,
       I_SW1, I_SW3, I_SW2 };

#define PH_SMEM 57344
#define SM_PRE (PH_SMEM)
#define SM_TAB (PH_SMEM + 1024)
#define SM_BAR (PH_SMEM + 2032)
#ifdef HIPEMU
#define INP(i) (p.in[i])
#define LAUNDER(x)
#define TIDX ((int)threadIdx.x)
#define BIDX ((int)blockIdx.x)
#define LAUNDER_V(x)
#define UNI(x) (x)
#else
extern __shared__ __align__(16) unsigned char smem_dyn[];
DEVFN const float* inp_lds(int i) {
  const volatile unsigned* t = (const volatile unsigned*)(smem_dyn + SM_TAB) + 2 * i;
  unsigned lo = __builtin_amdgcn_readfirstlane(t[0]), hi = __builtin_amdgcn_readfirstlane(t[1]);
  return (const float*)(((unsigned long long)hi << 32) | lo);
}
#define INP(i) inp_lds(i)
#define LAUNDER(x) asm volatile("" : "+s"(x))
DEVFN int tidx_() { int t = threadIdx.x; asm volatile("" : "+v"(t)); return t; }
DEVFN int bidx_() { int b = blockIdx.x; asm volatile("" : "+s"(b)); return b; }
#define TIDX tidx_()
#define LAUNDER_V(x) asm volatile("" : "+v"(x))
#define BIDX bidx_()
#define UNI(x) __builtin_amdgcn_readfirstlane(x)
#endif
#ifndef HIPEMU
#define XB_TMO      128
#define XB_XCNT(j)  (256  + 64 * (j))
#define XB_XSUB(j)  (1280 + 64 * (j))
#define XB_XGEN(j)  (2304 + 64 * (j))
#define XB_TOP      3328
#define XB_TOPGEN   3392
#define XCD_BAR_WORDS 3456
#define XB_SPIN_CAP (1u << 22)
#define LAS __attribute__((address_space(3)))
__device__ __forceinline__ unsigned xb_ld(unsigned* p)              { return __hip_atomic_load(p, __ATOMIC_RELAXED, __HIP_MEMORY_SCOPE_AGENT); }
__device__ __forceinline__ unsigned xb_add(unsigned* p, unsigned v) { return __hip_atomic_fetch_add(p, v, __ATOMIC_RELAXED, __HIP_MEMORY_SCOPE_AGENT); }
__device__ __forceinline__ unsigned xb_xcc_id() { return (unsigned)__builtin_amdgcn_s_getreg((3 << 11) | 20) & 0xFu; }
#define XB_SPIN(cond, bar) do { unsigned _sp = 0; while (cond) { __builtin_amdgcn_s_sleep(1); \
    if ((++_sp & 255u) == 0u) { if (xb_ld(&(bar)[XB_TMO])) break; if (_sp > XB_SPIN_CAP) { atomicAdd(&(bar)[XB_TMO], 1u); break; } } } } while (0)
struct XcdBarrier { unsigned* bar; unsigned x; volatile LAS unsigned* st; };
__device__ __forceinline__ XcdBarrier xcd_barrier_post(unsigned* bar, volatile LAS unsigned* st) {
    XcdBarrier b; b.bar = bar; b.x = xb_xcc_id(); b.st = st;
    if (threadIdx.x == 0) (void)xb_add(&bar[XB_XCNT(b.x)], 1u);
    return b;
}
__device__ __forceinline__ void xcd_barrier_complete(unsigned* bar, unsigned x, unsigned& nloc, unsigned& nx) {
    const unsigned G = gridDim.x * gridDim.y * gridDim.z;
    unsigned sum, cnt, mine, sp = 0u;
    for (;;) {
        sum = 0u; cnt = 0u; mine = 0u;
#pragma unroll
        for (unsigned j = 0; j < 16; ++j) { const unsigned c = xb_ld(&bar[XB_XCNT(j)]); sum += c; cnt += (c > 0u) ? 1u : 0u; mine = (j == x) ? c : mine; }
        if (sum == G) break;
        __builtin_amdgcn_s_sleep(1);
        if ((++sp & 255u) == 0u) { if (xb_ld(&bar[XB_TMO])) break; if (sp > XB_SPIN_CAP) { atomicAdd(&bar[XB_TMO], 1u); break; } }
    }
    nloc = mine > 0u ? mine : 1u; nx = cnt > 0u ? cnt : 1u;
}
__device__ __forceinline__ void xcd_barrier(const XcdBarrier& b) {
    asm volatile("s_waitcnt vmcnt(0)" ::: "memory");
    __syncthreads();
    if (threadIdx.x == 0) {
        unsigned* bar = b.bar;
        __builtin_amdgcn_s_waitcnt(0);
        unsigned nloc = b.st[0], nx = b.st[1];
        if (nloc == 0u) { xcd_barrier_complete(bar, b.x, nloc, nx); b.st[0] = nloc; b.st[1] = nx; }
        const unsigned old = xb_add(&bar[XB_XSUB(b.x)], 1u);
        const unsigned gen = old / nloc;
        if (old + 1u == (gen + 1u) * nloc) {
            __builtin_amdgcn_fence(__ATOMIC_RELEASE, "agent");
            asm volatile("s_waitcnt vmcnt(0)" ::: "memory");
            const unsigned og = xb_add(&bar[XB_TOP], 1u);
            const unsigned tg = og / nx;
            if (og + 1u == (tg + 1u) * nx) xb_add(&bar[XB_TOPGEN], 1u);
            else XB_SPIN(xb_ld(&bar[XB_TOPGEN]) == tg, bar);
            __builtin_amdgcn_fence(__ATOMIC_ACQUIRE, "agent");
            xb_add(&bar[XB_XGEN(b.x)], 1u);
            asm volatile("s_waitcnt vmcnt(0)" ::: "memory");
        } else {
            XB_SPIN(xb_ld(&bar[XB_XGEN(b.x)]) == gen, bar);
            __builtin_amdgcn_fence(__ATOMIC_ACQUIRE, "agent");
            asm volatile("s_waitcnt vmcnt(0)" ::: "memory");
        }
    }
    __syncthreads();
}
#endif

DEVFN int tokmap(int dir, int p) { return dir == 0 ? p : (p < CTX_ ? CTX_ - 1 - p : 2 * CTX_ + SEQ_ - 1 - p); }
DEVFN const float* tok_input_row(const Params& p, int tok) {
  int b = tok / T_, t = tok % T_;
  return t < CTX_ ? INP(I_CTX) + ((size_t)b * CTX_ + t) * D_ : INP(I_X) + ((size_t)b * SEQ_ + (t - CTX_)) * D_;
}
DEVFN int tok_modrow(int tok) { return (tok % T_) < CTX_ ? B_ : tok / T_; }

template <class ARow, class BRow, class Epi>
DEVFN void gemm_tile(unsigned char* smem, int K, ARow arow, BRow brow, Epi epi) {
  bf16_t* As = (bf16_t*)smem;
  bf16_t* Bs = As + 128 * LDT;
  const int tid = TIDX, lane = tid & 63, wave = tid >> 6, wr = wave >> 1, wc = wave & 1;
  const int g = lane >> 4, l15 = lane & 15;
  const int lr = tid >> 3, lc = (tid & 7) * 8;
  const AS1 bf16_t* ap[4];
  const AS1 bf16_t* bp[4];
#pragma unroll
  for (int i = 0; i < 4; ++i) { ap[i] = gptr(arow(lr + 32 * i)); bp[i] = gptr(brow(lr + 32 * i)); }
  f32x4 acc[4][4];
#pragma unroll
  for (int mi = 0; mi < 4; ++mi)
#pragma unroll
    for (int ni = 0; ni < 4; ++ni) acc[mi][ni] = f32x4{0.f, 0.f, 0.f, 0.f};
  u32x4 ra0[4], rb0[4], ra1[4], rb1[4];
#pragma unroll
  for (int i = 0; i < 4; ++i) { ra0[i] = *(const AS1 u32x4*)(ap[i] + lc); rb0[i] = *(const AS1 u32x4*)(bp[i] + lc); }
  if (K > 64) {
#pragma unroll
    for (int i = 0; i < 4; ++i) { ra1[i] = *(const AS1 u32x4*)(ap[i] + 64 + lc); rb1[i] = *(const AS1 u32x4*)(bp[i] + 64 + lc); } }
  auto compute = [&]() {
#pragma unroll
    for (int kk = 0; kk < 2; ++kk) {
      bf16x8 af[4], bfr[4];
#pragma unroll
      for (int mi = 0; mi < 4; ++mi) af[mi] = *(const bf16x8*)(As + (wr * 64 + mi * 16 + l15) * LDT + kk * 32 + g * 8);
#pragma unroll
      for (int ni = 0; ni < 4; ++ni) bfr[ni] = *(const bf16x8*)(Bs + (wc * 64 + ni * 16 + l15) * LDT + kk * 32 + g * 8);
#pragma unroll
      for (int mi = 0; mi < 4; ++mi)
#pragma unroll
        for (int ni = 0; ni < 4; ++ni) acc[mi][ni] = MFMA16(af[mi], bfr[ni], acc[mi][ni]);
    } };
  for (int k0 = 0; k0 < K; k0 += 128) {
    __syncthreads();
#pragma unroll
    for (int i = 0; i < 4; ++i) { *(u32x4*)(As + (lr + 32 * i) * LDT + lc) = ra0[i]; *(u32x4*)(Bs + (lr + 32 * i) * LDT + lc) = rb0[i]; }
    __syncthreads();
    if (k0 + 128 < K) {
#pragma unroll
      for (int i = 0; i < 4; ++i) { ra0[i] = *(const AS1 u32x4*)(ap[i] + k0 + 128 + lc); rb0[i] = *(const AS1 u32x4*)(bp[i] + k0 + 128 + lc); } }
    compute();
    if (k0 + 64 < K) {
      __syncthreads();
#pragma unroll
      for (int i = 0; i < 4; ++i) { *(u32x4*)(As + (lr + 32 * i) * LDT + lc) = ra1[i]; *(u32x4*)(Bs + (lr + 32 * i) * LDT + lc) = rb1[i]; }
      __syncthreads();
      if (k0 + 192 < K) {
#pragma unroll
        for (int i = 0; i < 4; ++i) { ra1[i] = *(const AS1 u32x4*)(ap[i] + k0 + 192 + lc); rb1[i] = *(const AS1 u32x4*)(bp[i] + k0 + 192 + lc); } }
      compute();
    }
  }
  epi(acc, wr, wc, g, l15);
}

template <int NB, class ARow, class BRow, class Epi>
DEVFN void gemm_tile_multi(unsigned char* smem, int K, ARow arow, BRow brow, Epi epi) {
  bf16_t* As = (bf16_t*)smem;
  bf16_t* Bs = As + 128 * LDT;
  const int tid = TIDX, lane = tid & 63, wave = tid >> 6, wr = wave >> 1, wc = wave & 1;
  const int g = lane >> 4, l15 = lane & 15;
  const int lr = tid >> 3, lc = (tid & 7) * 8;
  const AS1 bf16_t* ap[4];
  const AS1 bf16_t* bp[4];
#pragma unroll
  for (int i = 0; i < 4; ++i) { ap[i] = gptr(arow(lr + 32 * i)); bp[i] = gptr(brow(lr + 32 * i, 0)); }
  f32x4 acc[4][4];
  u32x4 ra0[4], rb0[4], ra1[4], rb1[4];
#pragma unroll
  for (int i = 0; i < 4; ++i) { ra0[i] = *(const AS1 u32x4*)(ap[i] + lc); rb0[i] = *(const AS1 u32x4*)(bp[i] + lc); }
  if (K > 64) {
#pragma unroll
    for (int i = 0; i < 4; ++i) { ra1[i] = *(const AS1 u32x4*)(ap[i] + 64 + lc); rb1[i] = *(const AS1 u32x4*)(bp[i] + 64 + lc); } }
  auto compute = [&]() {
#pragma unroll
    for (int kk = 0; kk < 2; ++kk) {
      bf16x8 af[4], bfr[4];
#pragma unroll
      for (int mi = 0; mi < 4; ++mi) af[mi] = *(const bf16x8*)(As + (wr * 64 + mi * 16 + l15) * LDT + kk * 32 + g * 8);
#pragma unroll
      for (int ni = 0; ni < 4; ++ni) bfr[ni] = *(const bf16x8*)(Bs + (wc * 64 + ni * 16 + l15) * LDT + kk * 32 + g * 8);
#pragma unroll
      for (int mi = 0; mi < 4; ++mi)
#pragma unroll
        for (int ni = 0; ni < 4; ++ni) acc[mi][ni] = MFMA16(af[mi], bfr[ni], acc[mi][ni]);
    } };
#pragma unroll
  for (int j = 0; j < NB; ++j) {
#pragma unroll
  for (int mi = 0; mi < 4; ++mi)
#pragma unroll
    for (int ni = 0; ni < 4; ++ni) acc[mi][ni] = f32x4{0.f, 0.f, 0.f, 0.f};
  for (int k0 = 0; k0 < K; k0 += 128) {
    __syncthreads();
#pragma unroll
    for (int i = 0; i < 4; ++i) { *(u32x4*)(As + (lr + 32 * i) * LDT + lc) = ra0[i]; *(u32x4*)(Bs + (lr + 32 * i) * LDT + lc) = rb0[i]; }
    __syncthreads();
    if (k0 + 128 < K) {
#pragma unroll
      for (int i = 0; i < 4; ++i) { ra0[i] = *(const AS1 u32x4*)(ap[i] + k0 + 128 + lc); rb0[i] = *(const AS1 u32x4*)(bp[i] + k0 + 128 + lc); } }
    compute();
    if (k0 + 64 < K) {
      __syncthreads();
#pragma unroll
      for (int i = 0; i < 4; ++i) { *(u32x4*)(As + (lr + 32 * i) * LDT + lc) = ra1[i]; *(u32x4*)(Bs + (lr + 32 * i) * LDT + lc) = rb1[i]; }
      __syncthreads();
      if (k0 + 192 < K) {
#pragma unroll
        for (int i = 0; i < 4; ++i) { ra1[i] = *(const AS1 u32x4*)(ap[i] + k0 + 192 + lc); rb1[i] = *(const AS1 u32x4*)(bp[i] + k0 + 192 + lc); } }
      compute();
    }
  }
  if (j + 1 < NB) {
#pragma unroll
    for (int i = 0; i < 4; ++i) { bp[i] = gptr(brow(lr + 32 * i, j + 1)); ra0[i] = *(const AS1 u32x4*)(ap[i] + lc); rb0[i] = *(const AS1 u32x4*)(bp[i] + lc); } }
  epi(acc, j, wr, wc, g, l15);
  if (j + 1 < NB) {
#pragma unroll
    for (int i = 0; i < 4; ++i) { ra1[i] = *(const AS1 u32x4*)(ap[i] + 64 + lc); rb1[i] = *(const AS1 u32x4*)(bp[i] + 64 + lc); } }
  }
}

template <int NB, int LDB, class ARow, class BBase, class Epi>
DEVFN void gemm_tile_w(unsigned char* smem, int K, ARow arow, BBase bbase, Epi epi) {
  bf16_t* As = (bf16_t*)smem;
  bf16_t* Bs = As + 128 * LDT;
  const int tid = TIDX, lane = tid & 63, wave = tid >> 6, wr = wave >> 1, wc = wave & 1;
  const int g = lane >> 4, l15 = lane & 15;
  const int lr = tid >> 3, lc = (tid & 7) * 8;
  const AS1 bf16_t* ap[4];
#pragma unroll
  for (int i = 0; i < 4; ++i) ap[i] = gptr(arow(lr + 32 * i));
  const AS1 bf16_t* bb = gptr(bbase(0));
  const unsigned boff = (unsigned)(lr * LDB + lc);
  f32x4 acc[4][8];
  u32x4 ra[4], rb[8];
#pragma unroll
  for (int i = 0; i < 4; ++i) ra[i] = *(const AS1 u32x4*)(ap[i] + lc);
#pragma unroll
  for (int i = 0; i < 8; ++i) rb[i] = *(const AS1 u32x4*)(bb + (size_t)(i * 32 * LDB) + boff);
#pragma unroll
  for (int j = 0; j < NB; ++j) {
#pragma unroll
    for (int mi = 0; mi < 4; ++mi)
#pragma unroll
      for (int ni = 0; ni < 8; ++ni) acc[mi][ni] = f32x4{0.f, 0.f, 0.f, 0.f};
#pragma unroll 1
    for (int k0 = 0; k0 < K; k0 += 64) {
      __syncthreads();
#pragma unroll
      for (int i = 0; i < 4; ++i) *(u32x4*)(As + (lr + 32 * i) * LDT + lc) = ra[i];
#pragma unroll
      for (int i = 0; i < 8; ++i) *(u32x4*)(Bs + (lr + 32 * i) * LDT + lc) = rb[i];
      __syncthreads();
      if (k0 + 64 < K) {
#pragma unroll
        for (int i = 0; i < 4; ++i) ra[i] = *(const AS1 u32x4*)(ap[i] + k0 + 64 + lc);
#pragma unroll
        for (int i = 0; i < 8; ++i) rb[i] = *(const AS1 u32x4*)(bb + (size_t)(i * 32 * LDB + k0 + 64) + boff);
      }
#pragma unroll
      for (int kk = 0; kk < 2; ++kk) {
        bf16x8 af[4];
#pragma unroll
        for (int mi = 0; mi < 4; ++mi) af[mi] = *(const bf16x8*)(As + (wr * 64 + mi * 16 + l15) * LDT + kk * 32 + g * 8);
#pragma unroll
        for (int h = 0; h < 2; ++h) {
          bf16x8 bfr[4];
#pragma unroll
          for (int ni = 0; ni < 4; ++ni) bfr[ni] = *(const bf16x8*)(Bs + (wc * 128 + h * 64 + ni * 16 + l15) * LDT + kk * 32 + g * 8);
#pragma unroll
          for (int mi = 0; mi < 4; ++mi)
#pragma unroll
            for (int ni = 0; ni < 4; ++ni) acc[mi][h * 4 + ni] = MFMA16(af[mi], bfr[ni], acc[mi][h * 4 + ni]);
        }
      }
    }
    if (j + 1 < NB) {
      bb = gptr(bbase(j + 1));
#pragma unroll
      for (int i = 0; i < 4; ++i) ra[i] = *(const AS1 u32x4*)(ap[i] + lc);
#pragma unroll
      for (int i = 0; i < 8; ++i) rb[i] = *(const AS1 u32x4*)(bb + (size_t)(i * 32 * LDB) + boff); }
    epi(acc, j, wr, wc, g, l15);
  }
}

template <int NCH, class Val, class RowP>
DEVFN void tile_store_bf16(unsigned char* smem, int wr, int g, int l15, Val val, RowP rowp) {
  constexpr int LDC = NCH * 8 + 8;
  bf16_t* T = (bf16_t*)smem;
  const int tid = TIDX;
  __syncthreads();
  val(T, LDC);
  __syncthreads();
#pragma unroll
  for (int pass = 0; pass < NCH / 2; ++pass) { const int id = tid + 256 * pass, row = id / NCH, c = id % NCH;
    bf16_t* dst = rowp(row, c * 8);
    if (dst) *(AS1 u32x4*)gptr(dst) = *(const u32x4*)(T + row * LDC + c * 8); }
  (void)wr; (void)g; (void)l15;
}
DEVFN void cvt_tile(unsigned char* smem, const float* src, int K, int N, int k0, int n0, bf16_t* dst, int ldd, int mode) {
  float* s = (float*)smem;
  const int tid = TIDX;
  const AS1 float* gsrc = gptr(src);
  __syncthreads();
  { const int kk = tid >> 4, n4 = (tid & 15) * 4;
#pragma unroll
    for (int pass = 0; pass < 4; ++pass) { const int k = kk + 16 * pass;
      f32x4 v = f32x4{0.f, 0.f, 0.f, 0.f};
      if (n0 + n4 < N) v = *(const AS1 f32x4*)(gsrc + (size_t)(k0 + k) * N + n0 + n4);
      s[k * 65 + n4] = v[0]; s[k * 65 + n4 + 1] = v[1]; s[k * 65 + n4 + 2] = v[2]; s[k * 65 + n4 + 3] = v[3]; } }
  __syncthreads();
  { const int nn = tid >> 2, k16 = (tid & 3) * 16, n = n0 + nn;
    if (n < N) { const int row = mode == 0 ? n : ((n >> 4) * 32 + (n & 15) + (mode == 2 ? 16 : 0));
      u32x4 o0, o1;
#pragma unroll
      for (int j = 0; j < 4; ++j) { o0[j] = (unsigned)f2bf(s[(k16 + 2 * j) * 65 + nn]) | ((unsigned)f2bf(s[(k16 + 2 * j + 1) * 65 + nn]) << 16);
        o1[j] = (unsigned)f2bf(s[(k16 + 8 + 2 * j) * 65 + nn]) | ((unsigned)f2bf(s[(k16 + 9 + 2 * j) * 65 + nn]) << 16); }
      AS1 bf16_t* d = gptr(dst) + (size_t)row * ldd + k0 + k16;
      *(AS1 u32x4*)d = o0; *(AS1 u32x4*)(d + 8) = o1; } }
  (void)K;
}
struct CvtJob { const float* src; bf16_t* dst; int N, k0, n0, ldd, mode; };
DEVFN void cvt_load(const CvtJob& j, f32x4 (&v)[4]) {
  const int tid = TIDX, kk = tid >> 4, n4 = (tid & 15) * 4;
  const AS1 float* g = gptr(j.src);
#pragma unroll
  for (int pass = 0; pass < 4; ++pass) { v[pass] = f32x4{0.f, 0.f, 0.f, 0.f};
    if (j.n0 + n4 < j.N) v[pass] = *(const AS1 f32x4*)(g + (size_t)(j.k0 + kk + 16 * pass) * j.N + j.n0 + n4); }
}
DEVFN void cvt_store(unsigned char* smem, const CvtJob& j, const f32x4 (&v)[4]) {
  float* s = (float*)smem;
  const int tid = TIDX, kk = tid >> 4, n4 = (tid & 15) * 4;
  __syncthreads();
#pragma unroll
  for (int pass = 0; pass < 4; ++pass) { const int k = kk + 16 * pass; s[k * 65 + n4] = v[pass][0]; s[k * 65 + n4 + 1] = v[pass][1]; s[k * 65 + n4 + 2] = v[pass][2]; s[k * 65 + n4 + 3] = v[pass][3]; }
  __syncthreads();
  const int nn = tid >> 2, k16 = (tid & 3) * 16, n = j.n0 + nn;
  if (n < j.N) { const int row = j.mode == 0 ? n : ((n >> 4) * 32 + (n & 15) + (j.mode == 2 ? 16 : 0));
    u32x4 o0, o1;
#pragma unroll
    for (int q = 0; q < 4; ++q) { o0[q] = (unsigned)f2bf(s[(k16 + 2 * q) * 65 + nn]) | ((unsigned)f2bf(s[(k16 + 2 * q + 1) * 65 + nn]) << 16);
      o1[q] = (unsigned)f2bf(s[(k16 + 8 + 2 * q) * 65 + nn]) | ((unsigned)f2bf(s[(k16 + 9 + 2 * q) * 65 + nn]) << 16); }
    AS1 bf16_t* d = gptr(j.dst) + (size_t)row * j.ldd + j.k0 + k16;
    *(AS1 u32x4*)d = o0; *(AS1 u32x4*)(d + 8) = o1; }
}
DEVFN CvtJob moe_cvt_job(const Params& p, int l, int u) {
  bf16_t* w13 = (bf16_t*)(p.ws + Ws::W13); bf16_t* w2t = (bf16_t*)(p.ws + Ws::W2T);
  const int e = u / 192, r = u % 192, which = r / 64, t = r % 64;
  CvtJob j;
  if (which < 2) {
    j.src = e < 64 ? (which == 0 ? INP(I_EW1) : INP(I_EW3)) + ((size_t)l * 64 + e) * 1024 * 256 : (which == 0 ? INP(I_SW1) : INP(I_SW3)) + (size_t)l * 1024 * 256;
    j.N = 256; j.k0 = (t >> 2) * 64; j.n0 = (t & 3) * 64; j.dst = w13 + (size_t)e * 512 * 1024; j.ldd = 1024; j.mode = which == 0 ? 1 : 2;
  } else {
    j.src = e < 64 ? INP(I_EW2) + ((size_t)l * 64 + e) * 256 * 1024 : INP(I_SW2) + (size_t)l * 256 * 1024;
    j.N = 1024; j.k0 = (t >> 4) * 64; j.n0 = (t & 15) * 64; j.dst = w2t + (size_t)e * 1024 * 256; j.ldd = 256; j.mode = 0;
  }
  return j;
}
DEVFN void convert_moe_weights(const Params& p, int l, unsigned char* smem, int bid, int nb) {
  const int total = 65 * 192;
  if (bid >= total) return;
  f32x4 v[4], vn[4];
  CvtJob j = moe_cvt_job(p, l, bid);
  cvt_load(j, v);
  for (int u = bid; u < total; u += nb) {
    const int un = u + nb;
    CvtJob jn = j;
    if (un < total) { jn = moe_cvt_job(p, l, un); cvt_load(jn, vn); }
    cvt_store(smem, j, v);
    j = jn;
#pragma unroll
    for (int q = 0; q < 4; ++q) v[q] = vn[q];
  }
}
DEVFN void phase0(const Params& p, unsigned char* smem) {
  const int tid = TIDX;
  float* modp = (float*)(p.ws + Ws::MODP);
  for (int u = BIDX; u < DEPTH_ * 24 * 16; u += gridDim.x) {
    int l = u / (24 * 16), jb = (u / 16) % 24, ks = u % 16;
    float* sc = (float*)smem;
    __syncthreads();
    for (int e = tid; e < NR_ * 64; e += 256) { int r = e / 64, i = ks * 64 + (e % 64); float cv = r < B_ ? INP(I_C)[(size_t)r * D_ + i] : INP(I_CCTX)[i]; sc[e] = siluf_(cv); }
    __syncthreads();
    int j = jb * 256 + tid;
    float acc[NR_];
#pragma unroll
    for (int r = 0; r < NR_; ++r) acc[r] = 0.f;
    const float* w = INP(I_ADAW) + ((size_t)l * D_ + ks * 64) * NMOD_ + j;
#pragma unroll 4
    for (int i = 0; i < 64; ++i) { float wv = w[(size_t)i * NMOD_];
#pragma unroll
      for (int r = 0; r < NR_; ++r) acc[r] += sc[r * 64 + i] * wv; }
#pragma unroll
    for (int r = 0; r < NR_; ++r) modp[(((size_t)ks * DEPTH_ + l) * NR_ + r) * NMOD_ + j] = acc[r];
  }
  bf16_t* win = (bf16_t*)(p.ws + Ws::WIN);
  bf16_t* wout = (bf16_t*)(p.ws + Ws::WOUT);
  for (int u = BIDX; u < DEPTH_ * 16 * 55; u += gridDim.x) {
    int l = u / (16 * 55), r = u % (16 * 55);
    cvt_tile(smem, INP(I_WIN) + (size_t)l * 1024 * NIN_, 1024, NIN_, (r / 55) * 64, (r % 55) * 64, win + (size_t)l * NIN_ * 1024, 1024, 0);
  }
  for (int u = BIDX; u < DEPTH_ * 256; u += gridDim.x) {
    int l = u / 256, r = u % 256;
    cvt_tile(smem, INP(I_WOUT) + (size_t)l * 1024 * 1024, 1024, 1024, (r / 16) * 64, (r % 16) * 64, wout + (size_t)l * 1024 * 1024, 1024, 0);
  }
  { bf16_t* lo = (bf16_t*)(p.ws + Ws::LORA);
    for (int u = BIDX * 256 + tid; u < DEPTH_ * 98304; u += gridDim.x * 256) {
      const int l = u / 98304, r = u % 98304; float v;
      if (r < 32768) { const int d = r >> 14, n = (r >> 6) & 255, k = r & 63; v = INP(I_W2)[(((size_t)l * 2 + d) * 64 + k) * 256 + n]; }
      else if (r < 65536) { const int r2 = r - 32768, d = r2 >> 14, n = (r2 >> 6) & 255, k = r2 & 63; v = INP(I_A2)[(((size_t)l * 2 + d) * 64 + k) * 256 + n]; }
      else { const int r2 = r - 65536, n = r2 >> 7, k = r2 & 127; v = INP(I_G2)[((size_t)l * 128 + k) * 256 + n]; }
      lo[u] = f2bf(v); } }
  float* rwt = (float*)(p.ws + Ws::RWT);
  for (int u = BIDX * 256 + tid; u < DEPTH_ * 64 * 1024; u += gridDim.x * 256) {
    int l = u / (64 * 1024), e = (u / 1024) % 64, i = u % 1024;
    rwt[u] = INP(I_RW)[((size_t)l * 1024 + i) * 64 + e];
  }
}

DEVFN void phase0b(const Params& p) {
  float* mod = (float*)(p.ws + Ws::MOD); const float* modp = (const float*)(p.ws + Ws::MODP);
  for (int u = BIDX * 256 + TIDX; u < DEPTH_ * NR_ * NMOD_; u += gridDim.x * 256) {
    int l = u / (NR_ * NMOD_), j = u % NMOD_;
    float s = INP(I_ADAB)[(size_t)l * NMOD_ + j];
    for (int ks = 0; ks < 16; ++ks) s += modp[(size_t)ks * DEPTH_ * NR_ * NMOD_ + u];
    mod[u] = s;
  }
}

DEVFN void row_stats(const float (&v)[16], float& mean, float& rstd) {
  float s = 0.f;
#pragma unroll
  for (int i = 0; i < 16; ++i) s += v[i];
  mean = wave_sum(s) * (1.f / 1024.f);
  float q = 0.f;
#pragma unroll
  for (int i = 0; i < 16; ++i) { float d = v[i] - mean; q += d * d; }
  rstd = rsqrtf(wave_sum(q) * (1.f / 1024.f) + 1e-5f);
}
DEVFN void load_row16(const float* row, int lane, float (&v)[16]) {
  const AS1 float* r = gptr(row);
#pragma unroll
  for (int j = 0; j < 4; ++j) { const f32x4 t = *(const AS1 f32x4*)(r + lane * 4 + 256 * j); v[4 * j] = t[0]; v[4 * j + 1] = t[1]; v[4 * j + 2] = t[2]; v[4 * j + 3] = t[3]; }
}
DEVFN void moe_residual_row(const Params& p, int lp, int tok, int lane, float (&xv)[16]) {
  const float* mod = (const float*)(p.ws + Ws::MOD) + ((size_t)lp * NR_ + tok_modrow(tok)) * NMOD_;
  const bf16_t* yb = (const bf16_t*)(p.ws + Ws::YBUF) + (size_t)tok * NSLOT * 1024;
  float g2[16], w[16], b[16];
  load_row16(mod + 5 * 1024, lane, g2);
  load_row16(INP(I_LN2W) + (size_t)lp * 1024, lane, w);
  load_row16(INP(I_LN2B) + (size_t)lp * 1024, lane, b);
  u32x2 sl[NSLOT][4];
#pragma unroll
  for (int s = 0; s < NSLOT; ++s)
#pragma unroll
    for (int j = 0; j < 4; ++j) sl[s][j] = *(const AS1 u32x2*)gptr(yb + (size_t)s * 1024 + lane * 4 + 256 * j);
  float f[16];
#pragma unroll
  for (int i = 0; i < 16; ++i) f[i] = 0.f;
#pragma unroll
  for (int s = 0; s < NSLOT; ++s)
#pragma unroll
    for (int j = 0; j < 4; ++j) { const u32x2 t = sl[s][j];
      f[4 * j] += bf2f((bf16_t)(t[0] & 0xFFFF)); f[4 * j + 1] += bf2f((bf16_t)(t[0] >> 16)); f[4 * j + 2] += bf2f((bf16_t)(t[1] & 0xFFFF)); f[4 * j + 3] += bf2f((bf16_t)(t[1] >> 16)); }
#pragma unroll
  for (int i = 0; i < 16; ++i) xv[i] = ALPHA_ * xv[i] + g2[i] * f[i];
  float mean, rstd;
  row_stats(xv, mean, rstd);
#pragma unroll
  for (int i = 0; i < 16; ++i) xv[i] = (xv[i] - mean) * rstd * w[i] + b[i];
}
DEVFN void phase1(const Params& p, int l) {
  const int lane = TIDX & 63, wave = TIDX >> 6;
  float* X = (float*)(p.ws + Ws::X);
  bf16_t* U = (bf16_t*)(p.ws + Ws::U);
  for (int tok = BIDX * 4 + wave; tok < NT_; tok += gridDim.x * 4) {
    float xv[16], sh[16], sc[16], mean, rstd;
    const float* mod = (const float*)(p.ws + Ws::MOD) + ((size_t)l * NR_ + tok_modrow(tok)) * NMOD_;
    load_row16(mod, lane, sh);
    load_row16(mod + 1024, lane, sc);
    if (l == 0) load_row16(tok_input_row(p, tok), lane, xv);
    else { load_row16(X + (size_t)tok * 1024, lane, xv); moe_residual_row(p, l - 1, tok, lane, xv); }
#pragma unroll
    for (int j = 0; j < 4; ++j) *(float4*)(X + (size_t)tok * 1024 + lane * 4 + 256 * j) = make_float4(xv[4 * j], xv[4 * j + 1], xv[4 * j + 2], xv[4 * j + 3]);
    row_stats(xv, mean, rstd);
#pragma unroll
    for (int j = 0; j < 4; ++j) {
      float u0 = (xv[4 * j] - mean) * rstd * (1.f + sc[4 * j]) + sh[4 * j], u1 = (xv[4 * j + 1] - mean) * rstd * (1.f + sc[4 * j + 1]) + sh[4 * j + 1];
      float u2 = (xv[4 * j + 2] - mean) * rstd * (1.f + sc[4 * j + 2]) + sh[4 * j + 2], u3 = (xv[4 * j + 3] - mean) * rstd * (1.f + sc[4 * j + 3]) + sh[4 * j + 3];
      *(uint2*)(U + (size_t)tok * 1024 + lane * 4 + 256 * j) = make_uint2((unsigned)f2bf(u0) | ((unsigned)f2bf(u1) << 16), (unsigned)f2bf(u2) | ((unsigned)f2bf(u3) << 16));
    }
  }
}
DEVFN void phase_final(const Params& p) {
  const int lane = TIDX & 63, wave = TIDX >> 6;
  const float* X = (const float*)(p.ws + Ws::X);
  for (int r = BIDX * 4 + wave; r < B_ * SEQ_; r += gridDim.x * 4) {
    int b = r / SEQ_, s = r % SEQ_, tok = b * T_ + CTX_ + s;
    float xv[16];
    load_row16(X + (size_t)tok * 1024, lane, xv);
    moe_residual_row(p, DEPTH_ - 1, tok, lane, xv);
#pragma unroll
    for (int j = 0; j < 4; ++j) *(float4*)(p.out + (size_t)r * 1024 + lane * 4 + 256 * j) = make_float4(xv[4 * j], xv[4 * j + 1], xv[4 * j + 2], xv[4 * j + 3]);
  }
}

DEVFN void phase2(const Params& p, int l, unsigned char* smem) {
  const bf16_t* U = (const bf16_t*)(p.ws + Ws::U);
  const bf16_t* W = (const bf16_t*)(p.ws + Ws::WIN) + (size_t)l * NIN_ * 1024;
  bf16_t* ZX = (bf16_t*)(p.ws + Ws::ZX);
  const int nct = (NIN_ + 255) / 256;
  for (int u = BIDX; u < (NT_ / 128) * nct; u += gridDim.x) {
    int rt = u / nct, ct = u % nct;
    gemm_tile_w<1, 1024>(smem, 1024,
      [&](int r) { return U + (size_t)(rt * 128 + r) * 1024; },
      [&](int) { return W + (size_t)(ct * 256) * 1024; },
      [&](f32x4 (&acc)[4][8], int, int wr, int wc, int g, int l15) {
#pragma unroll 1
        for (int h = 0; h < 2; ++h)
          tile_store_bf16<16>(smem, wr, g, l15,
            [&](bf16_t* T, int ldc) {
              if (wc == h) {
#pragma unroll
                for (int mi = 0; mi < 4; ++mi)
#pragma unroll
                  for (int ni = 0; ni < 8; ++ni)
#pragma unroll
                    for (int i = 0; i < 4; ++i) T[(wr * 64 + mi * 16 + 4 * g + i) * ldc + ni * 16 + l15] = f2bf(acc[mi][ni][i]); } },
            [&](int row, int c0) { const int col = ct * 256 + h * 128 + c0; return col < NIN_ ? ZX + (size_t)(rt * 128 + row) * NIN_ + col : (bf16_t*)nullptr; });
      });
  }
}

DEVFN float zxv(const bf16_t* ZX, int tok, int col) { return bf2f(gptr(ZX)[(size_t)tok * NIN_ + col]); }
struct Nbr { int n; int tok[4]; };
DEVFN Nbr shift_nbrs(int tok) {
  Nbr nb; int b = tok / T_, t = tok % T_;
  if (t < CTX_) { nb.n = 2; nb.tok[0] = t > 0 ? tok - 1 : -1; nb.tok[1] = t < CTX_ - 1 ? tok + 1 : -1; nb.tok[2] = -1; nb.tok[3] = -1; }
  else { int s = t - CTX_, row = s / 64, col = s % 64; nb.n = 4; nb.tok[0] = col > 0 ? tok - 1 : -1; nb.tok[1] = col < 63 ? tok + 1 : -1;
    nb.tok[2] = row > 0 ? tok - 64 : -1; nb.tok[3] = row < SEQ_ / 64 - 1 ? tok + 64 : -1; }
  (void)b; return nb;
}
DEVFN float shiftmix(const bf16_t* ZX, const float* mu, int tok, const Nbr& nb, int ch) {
  float z = zxv(ZX, tok, ORW + ch), o = z;
#pragma unroll
  for (int j = 0; j < 4; ++j) if (j < nb.n) { float v = nb.tok[j] >= 0 ? zxv(ZX, nb.tok[j], ORW + ch) : 0.f; o += mu[j * 1152 + ch] * (v - z); }
  return o;
}
#define LI_LD 392
#define KL_LD 264
DEVFN void phase3(const Params& p, int l, unsigned char* smem) {
  const int tid = TIDX, lane = tid & 63, wave = tid >> 6, q = lane >> 4, l15 = lane & 15;
  const bf16_t* ZX = (const bf16_t*)(p.ws + Ws::ZX);
  bf16_t* XBC = (bf16_t*)(p.ws + Ws::XBC); float* DTB = (float*)(p.ws + Ws::DTB);
  bf16_t* RR = (bf16_t*)(p.ws + Ws::RR); bf16_t* VV = (bf16_t*)(p.ws + Ws::VV); bf16_t* KKb = (bf16_t*)(p.ws + Ws::KK);
  bf16_t* KRW = (bf16_t*)(p.ws + Ws::KRW); bf16_t* LIg = (bf16_t*)(p.ws + Ws::LI);
  float* LA = (float*)(p.ws + Ws::LA);
  const float* convw = INP(I_CONVW) + (size_t)l * 3 * 1024; const float* convb = INP(I_CONVB) + (size_t)l * 1024;
  const float* mu = INP(I_MU) + (size_t)l * 4 * 1152;
  float* gdl = (float*)smem;
  const float kkw = INP(I_KKW)[(size_t)l * 256 + tid];
  for (int wu = BIDX; wu < 2 * (NT_ / 16); wu += gridDim.x) {
    const int tile = wu >> 1, part = wu & 1;
    const int tok0 = tile * 16, t0 = tok0 % T_, bb = tok0 / T_;
    const bool isctx = t0 < CTX_;
    const int s0 = t0 - CTX_;
    const bool lval = isctx ? (t0 > 0) : ((s0 & 63) != 0), rval = isctx ? (t0 + 16 < CTX_) : ((s0 & 63) != 48);
    const bool uval = !isctx && (s0 >= 64), dval = !isctx && (s0 + 64 < SEQ_);
    if (part == 0) {
    __syncthreads();
    {
      const bool segstart = (t0 == 0 || t0 == CTX_), segend = (t0 + 16 == CTX_ || t0 + 16 == T_);
      bf16_t* XBCT = (bf16_t*)(p.ws + Ws::XBCT) + ((size_t)(bb * NC128 + t0 / 128) * 768) * 128 + (t0 % 128);
#pragma unroll 1
      for (int j = 0; j < 4; ++j) { const int c = tid + 256 * j;
        const AS1 bf16_t* zp = gptr(ZX) + (size_t)tok0 * NIN_ + OXBC + c - NIN_; AS1 bf16_t* xp = gptr(XBC) + (size_t)tok0 * 1024 + c;
        float z[18];
#pragma unroll
        for (int i = 0; i < 18; ++i) { z[i] = ((i == 0 && segstart) || (i == 17 && segend)) ? 0.f : bf2f(*zp); zp += NIN_; LAUNDER_V(zp); }
        const float w0 = convw[c], w1 = convw[1024 + c], w2 = convw[2048 + c], cb = convb[c];
        bf16_t y[16];
#pragma unroll
        for (int i = 0; i < 16; ++i) { y[i] = f2bf(siluf_(cb + w0 * z[i] + w1 * z[i + 1] + w2 * z[i + 2])); *xp = y[i]; xp += 1024; LAUNDER_V(xp); }
        if (c < 768) {
          u32x4 o0, o1;
#pragma unroll
          for (int i = 0; i < 4; ++i) { o0[i] = (unsigned)y[2 * i] | ((unsigned)y[2 * i + 1] << 16); o1[i] = (unsigned)y[8 + 2 * i] | ((unsigned)y[9 + 2 * i] << 16); }
          *(u32x4*)(XBCT + (size_t)c * 128) = o0; *(u32x4*)(XBCT + (size_t)c * 128 + 8) = o1; } }
      { bf16_t* VTp = (bf16_t*)(p.ws + Ws::VT) + ((size_t)(bb * NC64 + t0 / 64) * 256 + tid) * 64 + (t0 % 64);
        const AS1 bf16_t* vp = gptr(ZX) + (size_t)tok0 * NIN_ + OGV + tid;
        u32x4 o0, o1;
        bf16_t vv16[16];
#pragma unroll
        for (int i = 0; i < 16; ++i) { vv16[i] = *vp; vp += NIN_; LAUNDER_V(vp); }
#pragma unroll
        for (int i = 0; i < 4; ++i) { o0[i] = (unsigned)vv16[2 * i] | ((unsigned)vv16[2 * i + 1] << 16); o1[i] = (unsigned)vv16[8 + 2 * i] | ((unsigned)vv16[9 + 2 * i] << 16); }
        *(u32x4*)VTp = o0; *(u32x4*)(VTp + 8) = o1; }
      DTB[(size_t)tok0 * 16 + tid] = softplusf_(zxv(ZX, tok0 + (tid >> 4), ODT + (tid & 15)) + INP(I_DTBIAS)[(size_t)l * 16 + (tid & 15)]);
      gdl[tid] = zxv(ZX, tok0 + (tid >> 5), OGD + (tid & 31)); gdl[256 + tid] = zxv(ZX, tok0 + 8 + (tid >> 5), OGD + (tid & 31));
    }
    } else {
#pragma unroll 1
    for (int g = 0; g < 5; ++g) {
      const bool act = !(g == 4 && tid >= 128);
      const int ch = act ? g * 256 + tid : 0;
      const AS1 bf16_t* zp0 = gptr(ZX) + (size_t)tok0 * NIN_ + ORW + ch;
      const AS1 bf16_t* zp = zp0 - NIN_;
      const float m0 = mu[ch], m1 = mu[1152 + ch], m2 = mu[2304 + ch], m3 = mu[3456 + ch];
      float z[18], o[16];
#pragma unroll
      for (int i = 0; i < 18; ++i) { z[i] = ((i == 0 && !lval) || (i == 17 && !rval)) ? 0.f : bf2f(*zp); zp += NIN_; LAUNDER_V(zp); }
#pragma unroll
      for (int i = 0; i < 16; ++i) o[i] = z[i + 1] + m0 * (z[i] - z[i + 1]) + m1 * (z[i + 2] - z[i + 1]);
      if (!isctx) {
        const AS1 bf16_t* up = zp0 - (size_t)64 * NIN_; const AS1 bf16_t* dn = zp0 + (size_t)64 * NIN_;
#pragma unroll
        for (int i = 0; i < 16; ++i) { const float zu = uval ? bf2f(*up) : 0.f, zd = dval ? bf2f(*dn) : 0.f; up += NIN_; dn += NIN_; LAUNDER_V(up); LAUNDER_V(dn);
          o[i] += m2 * (zu - z[i + 1]) + m3 * (zd - z[i + 1]); } }
      if (g == 0) { AS1 bf16_t* rp = gptr(RR) + (size_t)tok0 * 256 + tid;
#pragma unroll
        for (int i = 0; i < 16; ++i) { *rp = f2bf(o[i]); rp += 256; LAUNDER_V(rp); }
      } else if (g == 1) { AS1 bf16_t* kp = gptr(KKb) + (size_t)tok0 * 256 + tid; AS1 bf16_t* krp = gptr(KRW) + (size_t)tok0 * 256 + tid;
#pragma unroll
        for (int i = 0; i < 16; ++i) { const float kq = o[i] * kkw, nrm = sqrtf(wave_sum(kq * kq));
          *kp = f2bf(kq / fmaxf(nrm, 1e-12f)); *krp = f2bf(o[i]); kp += 256; krp += 256; LAUNDER_V(kp); LAUNDER_V(krp); }
      } else if (g == 2) { AS1 bf16_t* vp2 = gptr(VV) + (size_t)tok0 * 256 + tid;
#pragma unroll
        for (int i = 0; i < 16; ++i) { *vp2 = f2bf(o[i]); vp2 += 256; LAUNDER_V(vp2); }
      } else if (g == 3) { AS1 bf16_t* lp = gptr(LIg) + (size_t)tok0 * 384 + tid;
#pragma unroll
        for (int i = 0; i < 16; ++i) { *lp = f2bf(tid < 128 ? tanhf(o[i]) : o[i]); lp += 384; LAUNDER_V(lp); }
      } else if (act) { AS1 bf16_t* lp = gptr(LIg) + (size_t)tok0 * 384 + 256 + tid;
#pragma unroll
        for (int i = 0; i < 16; ++i) { *lp = f2bf(sigmoidf_(o[i])); lp += 384; LAUNDER_V(lp); }
      }
    }
    }
    if (part == 0) {
    __syncthreads();
    { const int d = tid >> 7, c = tid & 127; const float* gu = INP(I_GU) + ((size_t)l * 2 + d) * 16 * 128; const float gb = INP(I_GB)[((size_t)l * 2 + d) * 128 + c];
      float guw[16];
#pragma unroll
      for (int i = 0; i < 16; ++i) guw[i] = gu[i * 128 + c];
#pragma unroll 4
      for (int tt = 0; tt < 16; ++tt) { float sacc = gb;
#pragma unroll
        for (int i = 0; i < 16; ++i) sacc += gdl[tt * 32 + d * 16 + i] * guw[i];
        LA[((size_t)d * NT_ + tok0 + tt) * 128 + c] = logsigmoidf_(sacc) * (1.f / 16.f); } }
    }
  }
}

DEVFN void phase3b(const Params& p, int l, unsigned char* smem) {
  const bf16_t* LIg = (const bf16_t*)(p.ws + Ws::LI);
  const bf16_t* lora = (const bf16_t*)(p.ws + Ws::LORA) + (size_t)l * 98304;
  const bf16_t* KRg = (const bf16_t*)(p.ws + Ws::KRW); const bf16_t* KKg = (const bf16_t*)(p.ws + Ws::KK);
  float* LWp = (float*)(p.ws + Ws::LW); bf16_t* KD = (bf16_t*)(p.ws + Ws::KD); bf16_t* BD = (bf16_t*)(p.ws + Ws::BD); float* GATE = (float*)(p.ws + Ws::GATE);
  for (int u = BIDX; u < (NT_ / 128) * 10; u += gridDim.x) {
    const int rt = u / 10, which = (u % 10) >> 1, ct = u & 1;
    const int K = which < 4 ? 64 : 128, acol = which < 4 ? which * 64 : 256;
    const bf16_t* wb = which < 2 ? lora + (size_t)which * 16384 : which < 4 ? lora + 32768 + (size_t)(which - 2) * 16384 : lora + 65536;
    const float* bias = which < 2 ? INP(I_W0) + (size_t)l * 512 + which * 256 : INP(I_A0) + (size_t)l * 512 + (which & 1) * 256;
    const float* kav = INP(I_KAW) + (size_t)l * 256;
    gemm_tile(smem, K,
      [&](int r) { return LIg + (size_t)(rt * 128 + r) * 384 + acol; },
      [&](int r) { return wb + (size_t)(ct * 128 + r) * K; },
      [&](f32x4 (&acc)[4][4], int wr, int wc, int g, int l15) {
        const int tid = TIDX;
        if (which == 2 || which == 3) {
          bf16_t* T = (bf16_t*)smem; constexpr int LDC = 136;
          __syncthreads();
#pragma unroll
          for (int ni = 0; ni < 4; ++ni) { const int cl = wc * 64 + ni * 16 + l15; const float bv = bias[ct * 128 + cl];
#pragma unroll
            for (int mi = 0; mi < 4; ++mi)
#pragma unroll
              for (int i = 0; i < 4; ++i) T[(wr * 64 + mi * 16 + 4 * g + i) * LDC + cl] = f2bf(sigmoidf_(acc[mi][ni][i] + bv)); }
          __syncthreads();
          const int c = tid & 15, col0 = ct * 128 + c * 8;
          float ka[8];
#pragma unroll
          for (int j = 0; j < 8; ++j) ka[j] = kav[col0 + j];
          const size_t dofs = (size_t)(which - 2) * NT_ * 256;
#pragma unroll
          for (int pass = 0; pass < 8; ++pass) { const int row = (tid >> 4) + 16 * pass; const size_t o = (size_t)(rt * 128 + row) * 256 + col0;
            const bf16x8 a8 = *(const bf16x8*)(T + row * LDC + c * 8), kr8 = ld8g(KRg + o), kk8 = ld8g(KKg + o);
            bf16x8 kd8, bd8;
#pragma unroll
            for (int j = 0; j < 8; ++j) { const float a = bf2f((bf16_t)a8[j]); kd8[j] = (short)f2bf(bf2f((bf16_t)kr8[j]) * (1.f + (a - 1.f) * ka[j])); bd8[j] = (short)f2bf(bf2f((bf16_t)kk8[j]) * a); }
            *(AS1 bf16x8*)gptr(KD + dofs + o) = kd8; *(AS1 bf16x8*)gptr(BD + dofs + o) = bd8; }
        } else {
          float* T = (float*)smem; constexpr int LDC = 132;
          float* dst = which < 2 ? LWp + (size_t)which * NT_ * 256 : GATE;
#pragma unroll 1
          for (int h = 0; h < 2; ++h) {
            __syncthreads();
            if (wr == h) {
#pragma unroll
              for (int ni = 0; ni < 4; ++ni) { const int cl = wc * 64 + ni * 16 + l15; const float bv = which < 2 ? bias[ct * 128 + cl] : 0.f;
#pragma unroll
                for (int mi = 0; mi < 4; ++mi)
#pragma unroll
                  for (int i = 0; i < 4; ++i) { const float v = acc[mi][ni][i]; T[(mi * 16 + 4 * g + i) * LDC + cl] = which < 2 ? -0.6065306597126334f * sigmoidf_(v + bv) : v; } } }
            __syncthreads();
#pragma unroll
            for (int pass = 0; pass < 8; ++pass) { const int id = tid + 256 * pass, row = id >> 5, c = id & 31;
              *(AS1 f32x4*)gptr(dst + (size_t)(rt * 128 + h * 64 + row) * 256 + ct * 128 + c * 4) = *(const f32x4*)(T + row * LDC + c * 4); } }
        }
      });
  }
}

DEVFN bf16x8 ld8(const bf16_t* p) { return *(const bf16x8*)p; }
typedef short bf16x4v __attribute__((ext_vector_type(4)));
DEVFN bf16x4v cvt4(f32x4 v) { return bf16x4v{(short)f2bf(v[0]), (short)f2bf(v[1]), (short)f2bf(v[2]), (short)f2bf(v[3])}; }
DEVFN bf16x8 cat44(bf16x4v a, bf16x4v b) { return bf16x8{a[0], a[1], a[2], a[3], b[0], b[1], b[2], b[3]}; }
DEVFN bf16x4v ld4(const bf16_t* p) { return *(const bf16x4v*)p; }
DEVFN int rm_off(int i, int k) { return i * 64 + ((((k >> 3) ^ (i & 7)) << 3) | (k & 7)); }
#define RW_WAVE_LDS 11264
DEVFN void rwkv_chunk(const Params& p, int unit_base, unsigned char* smem) {
  const int tid = TIDX, lane = tid & 63, wave = tid >> 6, q = lane >> 4, l15 = lane & 15;
  const int unit = unit_base + wave;
  const int c = unit % NC16, h = (unit / NC16) & 3, dir = (unit / (NC16 * 4)) & 1, b = unit / (NC16 * 8);
  bf16_t* big = (bf16_t*)(smem + wave * RW_WAVE_LDS);
  unsigned char* small = smem + wave * RW_WAVE_LDS + 8192;
  float* AbF = (float*)small;
  bf16_t* TN = (bf16_t*)(small + 1024);
  bf16_t* AK = TN + 256; bf16_t* RB = AK + 256; bf16_t* RK = RB + 256;
  const bf16_t* RRg = (const bf16_t*)(p.ws + Ws::RR); const bf16_t* VVg = (const bf16_t*)(p.ws + Ws::VV); const bf16_t* KKg = (const bf16_t*)(p.ws + Ws::KK);
  const bf16_t* KDg = (const bf16_t*)(p.ws + Ws::KD) + (size_t)dir * NT_ * 256; const bf16_t* BDg = (const bf16_t*)(p.ws + Ws::BD) + (size_t)dir * NT_ * 256;
  const float* LWg = (const float*)(p.ws + Ws::LW) + (size_t)dir * NT_ * 256;
  float kkm[16], vv[16], bneg[16], kneg[16];
  float run = 0.f;
  __syncthreads();
#pragma unroll
  for (int i = 0; i < 16; ++i) {
    const size_t o = (size_t)(b * T_ + tokmap(dir, c * 16 + i)) * 256 + h * 64 + lane;
    const float lw = gptr(LWg)[o], r = bf2f(gptr(RRg)[o]), k = bf2f(gptr(KDg)[o]), v = bf2f(gptr(VVg)[o]), kk = bf2f(gptr(KKg)[o]), bb = bf2f(gptr(BDg)[o]);
    const float e_ex = expf(run); run += lw; const float e_in = expf(run), e_neg = expf(-run);
    kkm[i] = kk * e_ex; vv[i] = v; bneg[i] = bb * e_neg; kneg[i] = k * e_neg;
    big[rm_off(i, lane)] = f2bf(kkm[i]); big[1024 + rm_off(i, lane)] = f2bf(r * e_in);
    big[2048 + rm_off(i, lane)] = f2bf(bneg[i]); big[3072 + rm_off(i, lane)] = f2bf(kneg[i]);
  }
  const float WC = expf(run);
  __syncthreads();
  f32x4 ab = f32x4{0.f, 0.f, 0.f, 0.f}, ak = ab, rb = ab, rk = ab;
#pragma unroll
  for (int s2 = 0; s2 < 2; ++s2) { const int ch = ((4 * s2 + q) ^ (l15 & 7)) << 3;
    const bf16x8 a_kk = ld8(big + l15 * 64 + ch), a_r = ld8(big + 1024 + l15 * 64 + ch), b_b = ld8(big + 2048 + l15 * 64 + ch), b_k = ld8(big + 3072 + l15 * 64 + ch);
    ab = MFMA16(a_kk, b_b, ab); ak = MFMA16(a_kk, b_k, ak); rb = MFMA16(a_r, b_b, rb); rk = MFMA16(a_r, b_k, rk); }
  f32x4 gacc[4];
#pragma unroll
  for (int nk = 0; nk < 4; ++nk)
#pragma unroll
    for (int r = 0; r < 4; ++r) gacc[nk][r] = bf2f(big[1024 + rm_off(4 * q + r, 16 * nk + l15)]);
  __syncthreads();
#pragma unroll
  for (int r = 0; r < 4; ++r) { const int i = 4 * q + r, j = l15;
    AbF[i * 16 + j] = j < i ? ab[r] : 0.f; AK[i * 16 + j] = f2bf(j < i ? ak[r] : 0.f);
    RB[i * 16 + j] = f2bf(j <= i ? rb[r] : 0.f); RK[i * 16 + j] = f2bf(j <= i ? rk[r] : 0.f); }
  { bf16_t* KKMT = big; bf16_t* VTT = big + 1024; bf16_t* BHT = big + 2048; bf16_t* KHT = big + 3072;
#pragma unroll
    for (int i = 0; i < 16; ++i) { KKMT[lane * 16 + i] = f2bf(kkm[i]); VTT[lane * 16 + i] = f2bf(vv[i]); BHT[lane * 16 + i] = f2bf(bneg[i] * WC); KHT[lane * 16 + i] = f2bf(kneg[i] * WC); } }
  __syncthreads();
  { float t[16];
#pragma unroll
    for (int i = 0; i < 16; ++i) { float acc = (i == l15) ? 1.f : 0.f;
#pragma unroll
      for (int j = 0; j < i; ++j) acc -= AbF[i * 16 + j] * t[j];
      t[i] = acc; }
    if (q == 0) {
#pragma unroll
      for (int i = 0; i < 16; ++i) TN[i * 16 + l15] = f2bf(-t[i]); } }
  __syncthreads();
  const size_t ci = (size_t)((b * 2 + dir) * 4 + h) * NC16 + c;
  bf16_t* MLg = (bf16_t*)(p.ws + Ws::RML) + ci * 4096; bf16_t* Ng = (bf16_t*)(p.ws + Ws::RNS) + ci * 4096;
  bf16_t* Gg = (bf16_t*)(p.ws + Ws::RG) + ci * 1024; float* Y0g = (float*)(p.ws + Ws::RY0) + ci * 1024;
  const bf16x4v a_T = ld4(TN + l15 * 16 + 4 * q), a_Ak = ld4(AK + l15 * 16 + 4 * q), a_Rb = ld4(RB + l15 * 16 + 4 * q), a_Rk = ld4(RK + l15 * 16 + 4 * q);
  const f32x4 z4 = f32x4{0.f, 0.f, 0.f, 0.f};
  bf16x4v vfr[4], qfr[4], pfr[4];
#pragma unroll
  for (int n = 0; n < 4; ++n) {
    vfr[n] = ld4(big + 1024 + (16 * n + l15) * 16 + 4 * q);
    const f32x4 akv = MFMA16K16(a_Ak, vfr[n], z4);
    qfr[n] = cvt4(MFMA16K16(a_T, cvt4(akv), z4));
    pfr[n] = cvt4(MFMA16K16(a_T, ld4(big + (16 * n + l15) * 16 + 4 * q), z4)); }
  const bf16x8 a_RbRk = cat44(a_Rb, a_Rk);
#pragma unroll
  for (int n = 0; n < 4; ++n) {
    const f32x4 g = MFMA16K16(a_Rb, pfr[n], gacc[n]);
    const f32x4 y0 = MFMA16(a_RbRk, cat44(qfr[n], vfr[n]), z4);
#pragma unroll
    for (int r = 0; r < 4; ++r) { Gg[(4 * q + r) * 64 + 16 * n + l15] = f2bf(g[r]); Y0g[(4 * q + r) * 64 + 16 * n + l15] = y0[r]; } }
#pragma unroll
  for (int mk = 0; mk < 4; ++mk) {
    const bf16x4v a_B = ld4(big + 2048 + (16 * mk + l15) * 16 + 4 * q), a_K = ld4(big + 3072 + (16 * mk + l15) * 16 + 4 * q);
    const bf16x8 a_BK = cat44(a_B, a_K);
#pragma unroll
    for (int n = 0; n < 4; ++n) {
      const f32x4 m = MFMA16K16(a_B, pfr[n], z4);
      const f32x4 nn = MFMA16(a_BK, cat44(qfr[n], vfr[n]), z4);
#pragma unroll
      for (int r = 0; r < 4; ++r) MLg[((mk * 2 + (n >> 1)) * 64 + (l15 >> 2) * 16 + 4 * q + r) * 8 + (n & 1) * 4 + (l15 & 3)] = f2bf(m[r]);
      *(bf16x4v*)(Ng + (n * 64 + lane) * 16 + mk * 4) = cvt4(nn); } }
  ((float*)(p.ws + Ws::RWC))[ci * 64 + ((lane >> 2) & 3) * 16 + (lane >> 4) * 4 + (lane & 3)] = WC;
}
struct RwStep { bf16x8 ml[4][2]; bf16x8 n[2]; f32x4 wc[4]; };
DEVFN void rw_load(RwStep& t, const bf16_t* MLg, const bf16_t* NSg, const float* WCg, int c, int lane, int q) {
#pragma unroll
  for (int mk = 0; mk < 4; ++mk) { t.ml[mk][0] = ld8g(MLg + (size_t)c * 4096 + ((mk * 2 + 0) * 64 + lane) * 8); t.ml[mk][1] = ld8g(MLg + (size_t)c * 4096 + ((mk * 2 + 1) * 64 + lane) * 8);
    t.wc[mk] = *(const AS1 f32x4*)gptr(WCg + (size_t)c * 64 + q * 16 + mk * 4); }
  t.n[0] = ld8g(NSg + (size_t)c * 4096 + lane * 16); t.n[1] = ld8g(NSg + (size_t)c * 4096 + lane * 16 + 8);
}
DEVFN void rw_step(const RwStep& t, f32x4 (&S)[4], bf16_t* NSg, int c, int q, int l15) {
  bf16x4v sb[4];
#pragma unroll
  for (int mk = 0; mk < 4; ++mk) sb[mk] = cvt4(S[mk]);
  const bf16x8 bf0 = cat44(sb[0], sb[1]), bf1 = cat44(sb[2], sb[3]);
#pragma unroll
  for (int mk = 0; mk < 4; ++mk) {
    f32x4 acc;
#pragma unroll
    for (int r = 0; r < 4; ++r) acc[r] = bf2f((bf16_t)t.n[mk >> 1][(mk & 1) * 4 + r]) + t.wc[mk][r] * S[mk][r];
    acc = MFMA16(t.ml[mk][0], bf0, acc);
    acc = MFMA16(t.ml[mk][1], bf1, acc);
    S[mk] = acc; }
#pragma unroll
  for (int mk = 0; mk < 4; ++mk) *(AS1 bf16x4v*)gptr(NSg + (size_t)c * 4096 + l15 * 64 + 16 * mk + 4 * q) = sb[mk];
}
DEVFN void rwkv_scan(const Params& p, int chain, int wave) {
  const int tid = TIDX, lane = tid & 63, q = lane >> 4, l15 = lane & 15;
  const bf16_t* MLg = (const bf16_t*)(p.ws + Ws::RML) + (size_t)chain * NC16 * 4096;
  bf16_t* NSg = (bf16_t*)(p.ws + Ws::RNS) + (size_t)chain * NC16 * 4096 + wave * 1024;
  const float* WCg = (const float*)(p.ws + Ws::RWC) + (size_t)chain * NC16 * 64;
  f32x4 S[4];
#pragma unroll
  for (int mk = 0; mk < 4; ++mk) S[mk] = f32x4{0.f, 0.f, 0.f, 0.f};
  RwStep t0, t1, t2;
#define RWC_(x) ((x) < NC16 ? (x) : NC16 - 1)
  rw_load(t0, MLg, NSg, WCg, 0, lane, q);
  rw_load(t1, MLg, NSg, WCg, RWC_(1), lane, q);
  int c = 0;
  for (; c + 2 < NC16; c += 3) {
    rw_load(t2, MLg, NSg, WCg, c + 2, lane, q);
    rw_step(t0, S, NSg, c, q, l15);
    rw_load(t0, MLg, NSg, WCg, RWC_(c + 3), lane, q);
    rw_step(t1, S, NSg, c + 1, q, l15);
    rw_load(t1, MLg, NSg, WCg, RWC_(c + 4), lane, q);
    rw_step(t2, S, NSg, c + 2, q, l15);
  }
  if (c < NC16) { rw_step(t0, S, NSg, c, q, l15); if (c + 1 < NC16) rw_step(t1, S, NSg, c + 1, q, l15); }
#undef RWC_
}
DEVFN void rwkv_out(const Params& p, int unit_base) {
  const int tid = TIDX, lane = tid & 63, wave = tid >> 6, q = lane >> 4, l15 = lane & 15;
  const int unit = unit_base + wave;
  const int c = unit % NC16, h = (unit / NC16) & 3, dir = (unit / (NC16 * 4)) & 1, b = unit / (NC16 * 8);
  const size_t ci = (size_t)((b * 2 + dir) * 4 + h) * NC16 + c;
  const bf16_t* Sg = (const bf16_t*)(p.ws + Ws::RNS) + ci * 4096; const bf16_t* Gg = (const bf16_t*)(p.ws + Ws::RG) + ci * 1024;
  const float* Y0g = (const float*)(p.ws + Ws::RY0) + ci * 1024;
  float* YR = (float*)(p.ws + Ws::YR) + (size_t)dir * NT_ * 256;
  const bf16x8 a0 = ld8g(Gg + l15 * 64 + 8 * q), a1 = ld8g(Gg + l15 * 64 + 32 + 8 * q);
#pragma unroll
  for (int n = 0; n < 4; ++n) {
    f32x4 acc;
#pragma unroll
    for (int r = 0; r < 4; ++r) acc[r] = gptr(Y0g)[(4 * q + r) * 64 + 16 * n + l15];
    acc = MFMA16(a0, ld8g(Sg + n * 1024 + l15 * 64 + 8 * q), acc);
    acc = MFMA16(a1, ld8g(Sg + n * 1024 + l15 * 64 + 32 + 8 * q), acc);
#pragma unroll
    for (int r = 0; r < 4; ++r) YR[(size_t)(b * T_ + tokmap(dir, c * 16 + 4 * q + r)) * 256 + h * 64 + 16 * n + l15] = acc[r]; }
}
DEVFN int cscan(int dir, int co, int nctx, int nc) { return dir == 0 ? co : (co < nctx ? nctx - 1 - co : 2 * nctx + nc - 1 - co); }
DEVFN bf16x8 ld4x2g(const bf16_t* p0, const bf16_t* p1) { bf16x4v a = *(const AS1 bf16x4v*)gptr(p0), b = *(const AS1 bf16x4v*)gptr(p1); return bf16x8{a[0], a[1], a[2], a[3], b[0], b[1], b[2], b[3]}; }
DEVFN bf16x8 ld4x2(const bf16_t* p0, const bf16_t* p1) { bf16x4v a = *(const bf16x4v*)p0, b = *(const bf16x4v*)p1; return bf16x8{a[0], a[1], a[2], a[3], b[0], b[1], b[2], b[3]}; }

DEVFN void ssd_chunk_scalars(const Params& p, int l, int b, int co, int h, float* f) {
  const int tid = TIDX, d = tid >> 7, j = tid & 127;
  const float* DTB = (const float*)(p.ws + Ws::DTB);
  const float nega = -expf(INP(I_ALOG)[(size_t)l * 16 + d * 8 + h]);
  const float dt = DTB[(size_t)(b * T_ + co * 128 + j) * 16 + d * 8 + h];
  __syncthreads();
  f[256 + d * 128 + j] = dt;
  float* cur = f + d * 128; float* tmp = f + 512 + d * 128;
  cur[j] = dt * nega;
  __syncthreads();
  for (int off = 1; off < 128; off <<= 1) {
    float v = cur[j] + (j >= off ? cur[j - off] : 0.f);
    tmp[j] = v;
    __syncthreads();
    cur[j] = tmp[j];
    __syncthreads();
  }
}
DEVFN void ssd_states(const Params& p, int l, int unit, unsigned char* smem) {
  const int tid = TIDX, lane = tid & 63, wave = tid >> 6, q = lane >> 4, l15 = lane & 15;
  const int h = unit & 7, co = (unit >> 3) % NC128, b = unit / (8 * NC128), grp = h >> 2;
  float* f = (float*)smem;
  ssd_chunk_scalars(p, l, b, co, h, f);
  { const int d = tid >> 7, j = tid & 127; const float* cum = f + d * 128; const float dt = f[256 + d * 128 + j];
    float w = d == 0 ? expf(cum[127] - cum[j]) * dt : expf(j > 0 ? cum[j - 1] : 0.f) * dt;
    f[512 + d * 128 + j] = w; }
  __syncthreads();
  const bf16_t* XT = (const bf16_t*)(p.ws + Ws::XBCT) + (size_t)(b * NC128 + co) * 768 * 128;
  f32x4 acc[2][8];
#pragma unroll
  for (int d = 0; d < 2; ++d)
#pragma unroll
    for (int n = 0; n < 8; ++n) acc[d][n] = f32x4{0.f, 0.f, 0.f, 0.f};
#pragma unroll 1
  for (int s4 = 0; s4 < 4; ++s4) {
    const int j0 = s4 * 32 + q * 8;
    bf16x8 xa = ld8g(XT + (size_t)(h * 64 + wave * 16 + l15) * 128 + j0), a0, a1;
#pragma unroll
    for (int jj = 0; jj < 8; ++jj) { float x = bf2f((bf16_t)xa[jj]); a0[jj] = (short)f2bf(x * f[512 + j0 + jj]); a1[jj] = (short)f2bf(x * f[640 + j0 + jj]); }
#pragma unroll
    for (int n = 0; n < 8; ++n) { bf16x8 bb = ld8g(XT + (size_t)(512 + grp * 128 + n * 16 + l15) * 128 + j0);
      acc[0][n] = MFMA16(a0, bb, acc[0][n]); acc[1][n] = MFMA16(a1, bb, acc[1][n]); }
  }
#pragma unroll
  for (int d = 0; d < 2; ++d) {
    const int cs = cscan(d, co, CTX_ / 128, SEQ_ / 128);
    float* ST = (float*)(p.ws + Ws::SST) + ((size_t)((d * B_ + b) * NC128 + cs) * 8 + h) * 8192;
#pragma unroll
    for (int n = 0; n < 8; ++n)
#pragma unroll
      for (int r = 0; r < 4; ++r) ST[(wave * 16 + q * 4 + r) * 128 + n * 16 + l15] = acc[d][n][r];
    if (tid == 0) ((float*)(p.ws + Ws::SCD))[((size_t)(d * B_ + b) * NC128 + cs) * 8 + h] = expf(f[d * 128 + 127]);
  }
}
#define SSD_SB ((NC128 % 17) == 0 ? 17 : NC128)
DEVFN void ssd_scan(const Params& p, int gtid, int gthreads) {
  const float* __restrict__ ST = (const float*)(p.ws + Ws::SST); const float* __restrict__ CD = (const float*)(p.ws + Ws::SCD); bf16_t* __restrict__ HIN = (bf16_t*)(p.ws + Ws::HIN);
  for (int e = gtid; e < 2 * B_ * 8 * 8192; e += gthreads) {
    const int pd = e & 8191, h = (e >> 13) & 7, db = e >> 16;
    float hv = 0.f;
#pragma unroll 1
    for (int c0 = 0; c0 < NC128; c0 += SSD_SB) {
      float st[SSD_SB], cd[SSD_SB];
#pragma unroll
      for (int i = 0; i < SSD_SB; ++i) { st[i] = ST[((size_t)(db * NC128 + c0 + i) * 8 + h) * 8192 + pd]; cd[i] = CD[(size_t)(db * NC128 + c0 + i) * 8 + h]; }
#pragma unroll
      for (int i = 0; i < SSD_SB; ++i) { HIN[((size_t)(db * NC128 + c0 + i) * 8 + h) * 8192 + pd] = f2bf(hv); hv = hv * cd[i] + st[i]; }
    }
  }
}
DEVFN void ssd_out(const Params& p, int l, int unit, unsigned char* smem) {
  const int tid = TIDX, lane = tid & 63, wave = tid >> 6, q = lane >> 4, l15 = lane & 15;
  const int h = unit & 7, co = (unit >> 3) % NC128, b = unit / (8 * NC128), grp = h >> 2;
  float* f = (float*)smem;
  ssd_chunk_scalars(p, l, b, co, h, f);
  if (tid < 128) f[640 + tid] = f[128 + 127] - (tid > 0 ? f[128 + tid - 1] : 0.f);
  __syncthreads();
  const float* cum0 = f; const float* suf1 = f + 640; const float* dt0 = f + 256; const float* dt1 = f + 384;
  const bf16_t* XBC = (const bf16_t*)(p.ws + Ws::XBC) + (size_t)(b * T_ + co * 128) * 1024;
  const bf16_t* XT = (const bf16_t*)(p.ws + Ws::XBCT) + (size_t)(b * NC128 + co) * 768 * 128;
  const bf16_t* Cb = XBC + (size_t)(wave * 32 + l15) * 1024 + 768 + grp * 128 + q * 8;
  f32x4 y[4][2];
  { f32x4 o0[4][2], o1[4][2];
#pragma unroll
    for (int mp = 0; mp < 4; ++mp)
#pragma unroll
      for (int ni = 0; ni < 2; ++ni) { o0[mp][ni] = f32x4{0.f, 0.f, 0.f, 0.f}; o1[mp][ni] = f32x4{0.f, 0.f, 0.f, 0.f}; }
    const int cs0 = cscan(0, co, CTX_ / 128, SEQ_ / 128), cs1 = cscan(1, co, CTX_ / 128, SEQ_ / 128);
    const bf16_t* H0 = (const bf16_t*)(p.ws + Ws::HIN) + ((size_t)((0 * B_ + b) * NC128 + cs0) * 8 + h) * 8192;
    const bf16_t* H1 = (const bf16_t*)(p.ws + Ws::HIN) + ((size_t)((1 * B_ + b) * NC128 + cs1) * 8 + h) * 8192;
#pragma unroll 1
    for (int s4 = 0; s4 < 4; ++s4) { const bf16x8 c0 = ld8g(Cb + s4 * 32), c1 = ld8g(Cb + 16 * 1024 + s4 * 32);
#pragma unroll
      for (int mp = 0; mp < 4; ++mp) { bf16x8 h0 = ld8g(H0 + (size_t)(mp * 16 + l15) * 128 + s4 * 32 + q * 8), h1 = ld8g(H1 + (size_t)(mp * 16 + l15) * 128 + s4 * 32 + q * 8);
        o0[mp][0] = MFMA16(h0, c0, o0[mp][0]); o0[mp][1] = MFMA16(h0, c1, o0[mp][1]);
        o1[mp][0] = MFMA16(h1, c0, o1[mp][0]); o1[mp][1] = MFMA16(h1, c1, o1[mp][1]); } }
#pragma unroll
    for (int ni = 0; ni < 2; ++ni) { const int i = wave * 32 + ni * 16 + l15; const float e0 = expf(cum0[i]), e1 = expf(suf1[i]);
#pragma unroll
      for (int mp = 0; mp < 4; ++mp)
#pragma unroll
        for (int r = 0; r < 4; ++r) y[mp][ni][r] = e0 * o0[mp][ni][r] + e1 * o1[mp][ni][r]; } }
  bf16x8 mfr[4][2];
  { f32x4 g[8][2];
#pragma unroll
    for (int mj = 0; mj < 8; ++mj) { g[mj][0] = f32x4{0.f, 0.f, 0.f, 0.f}; g[mj][1] = f32x4{0.f, 0.f, 0.f, 0.f}; }
#pragma unroll 1
    for (int s4 = 0; s4 < 4; ++s4) { const bf16x8 c0 = ld8g(Cb + s4 * 32), c1 = ld8g(Cb + 16 * 1024 + s4 * 32);
#pragma unroll
      for (int mj = 0; mj < 8; ++mj) { bf16x8 bb = ld8g(XBC + (size_t)(mj * 16 + l15) * 1024 + 512 + grp * 128 + s4 * 32 + q * 8);
        g[mj][0] = MFMA16(bb, c0, g[mj][0]); g[mj][1] = MFMA16(bb, c1, g[mj][1]); } }
    const int i0 = wave * 32 + l15, i1 = i0 + 16;
    const float c0i0 = cum0[i0], s1i0 = suf1[i0], c0i1 = cum0[i1], s1i1 = suf1[i1];
#pragma unroll
    for (int mj = 0; mj < 8; ++mj)
#pragma unroll
      for (int r = 0; r < 4; ++r) { const int j = mj * 16 + q * 4 + r;
        const float cj = cum0[j], sj = suf1[j], d0 = dt0[j], d1 = dt1[j];
        const float lw0 = (j <= i0 ? expf(c0i0 - cj) * d0 : 0.f) + (j >= i0 ? expf(s1i0 - sj) * d1 : 0.f);
        const float lw1 = (j <= i1 ? expf(c0i1 - cj) * d0 : 0.f) + (j >= i1 ? expf(s1i1 - sj) * d1 : 0.f);
        mfr[mj >> 1][0][(mj & 1) * 4 + r] = (short)f2bf(g[mj][0][r] * lw0);
        mfr[mj >> 1][1][(mj & 1) * 4 + r] = (short)f2bf(g[mj][1][r] * lw1); } }
#pragma unroll
  for (int s4 = 0; s4 < 4; ++s4)
#pragma unroll
    for (int mp = 0; mp < 4; ++mp) { const bf16_t* xr = XT + (size_t)(h * 64 + mp * 16 + l15) * 128 + s4 * 32 + q * 4;
      bf16x8 xa = ld4x2g(xr, xr + 16);
      y[mp][0] = MFMA16(xa, mfr[s4][0], y[mp][0]); y[mp][1] = MFMA16(xa, mfr[s4][1], y[mp][1]); }
  __syncthreads();
  float* yl = f + 1024;
#pragma unroll
  for (int mp = 0; mp < 4; ++mp)
#pragma unroll
    for (int ni = 0; ni < 2; ++ni)
#pragma unroll
      for (int r = 0; r < 4; ++r) yl[(wave * 32 + ni * 16 + l15) * 65 + mp * 16 + q * 4 + r] = y[mp][ni][r];
  __syncthreads();
  float* YS = (float*)(p.ws + Ws::YS) + (size_t)(b * T_ + co * 128) * 512 + h * 64;
  for (int e = tid; e < 128 * 64; e += 256) YS[(size_t)(e >> 6) * 512 + (e & 63)] = yl[(e >> 6) * 65 + (e & 63)];
}

#define GQ_LD 40
#define GK_LD 72
DEVFN void gla_chunk(const Params& p, int unit, unsigned char* smem) {
  const int tid = TIDX, lane = tid & 63, wave = tid >> 6, q = lane >> 4, l15 = lane & 15;
  const int h = unit & 3, co = (unit >> 2) % NC64, b = unit / (4 * NC64);
  const bf16_t* ZX = (const bf16_t*)(p.ws + Ws::ZX) + (size_t)(b * T_ + co * 64) * NIN_;
  const float* LA = (const float*)(p.ws + Ws::LA);
  float* cum = (float*)smem;
  bf16_t* qs = (bf16_t*)(smem + 16384);
  bf16_t* ks = qs + 2 * 64 * GQ_LD;
  bf16_t* kt = ks + 2 * 64 * GQ_LD;
  __syncthreads();
  for (int e = tid; e < 2 * 64 * 32; e += 256) { const int d = e >> 11, i = (e >> 5) & 63, dd = e & 31;
    cum[e] = LA[((size_t)d * NT_ + b * T_ + co * 64 + i) * 128 + h * 32 + dd]; }
  __syncthreads();
  if (tid < 64) { const int d = tid >> 5, dd = tid & 31; float* c = cum + d * 2048 + dd; float sacc = 0.f;
    if (d == 0) for (int i = 0; i < 64; ++i) { sacc += c[i * 32]; c[i * 32] = sacc; }
    else for (int i = 63; i >= 0; --i) { sacc += c[i * 32]; c[i * 32] = sacc; } }
  __syncthreads();
  bf16_t* QT = (bf16_t*)(p.ws + Ws::QT);
  for (int e = tid; e < 64 * 32; e += 256) { const int i = e >> 5, dd = e & 31;
    const float qv = bf2f(ZX[(size_t)i * NIN_ + OGQ + h * 32 + dd]) * 0.17677669529663687f, kv = bf2f(ZX[(size_t)i * NIN_ + OGK + h * 32 + dd]);
    const float c0 = cum[i * 32 + dd], c1 = cum[2048 + i * 32 + dd], t0 = cum[63 * 32 + dd], t1 = cum[2048 + dd];
    const bf16_t q0 = f2bf(qv * expf(c0)), q1 = f2bf(qv * expf(c1));
    qs[i * GQ_LD + dd] = q0; qs[64 * GQ_LD + i * GQ_LD + dd] = q1;
    ks[i * GQ_LD + dd] = f2bf(kv * expf(-c0)); ks[64 * GQ_LD + i * GQ_LD + dd] = f2bf(kv * expf(-c1));
    kt[dd * GK_LD + i] = f2bf(kv * expf(t0 - c0)); kt[32 * GK_LD + dd * GK_LD + i] = f2bf(kv * expf(t1 - c1));
    const size_t tok = (size_t)b * T_ + co * 64 + i;
    QT[tok * 128 + h * 32 + dd] = q0; QT[((size_t)NT_ + tok) * 128 + h * 32 + dd] = q1; }
  if (tid < 64) { const int d = tid >> 5, dd = tid & 31; const int cs = cscan(d, co, CTX_ / 64, SEQ_ / 64);
    ((float*)(p.ws + Ws::GCD))[(((size_t)(d * B_ + b) * NC64 + cs) * 4 + h) * 32 + dd] = expf(d == 0 ? cum[63 * 32 + dd] : cum[2048 + dd]); }
  __syncthreads();
  bf16x8 pfr[2];
  { f32x4 p0[4], p1[4];
    const bf16x8 qb0 = ld8(qs + (wave * 16 + l15) * GQ_LD + q * 8), qb1 = ld8(qs + 64 * GQ_LD + (wave * 16 + l15) * GQ_LD + q * 8);
#pragma unroll
    for (int mj = 0; mj < 4; ++mj) { p0[mj] = MFMA16(ld8(ks + (mj * 16 + l15) * GQ_LD + q * 8), qb0, (f32x4{0.f, 0.f, 0.f, 0.f}));
      p1[mj] = MFMA16(ld8(ks + 64 * GQ_LD + (mj * 16 + l15) * GQ_LD + q * 8), qb1, (f32x4{0.f, 0.f, 0.f, 0.f})); }
    const int i = wave * 16 + l15;
#pragma unroll
    for (int mj = 0; mj < 4; ++mj)
#pragma unroll
      for (int r = 0; r < 4; ++r) { const int j = mj * 16 + q * 4 + r; pfr[mj >> 1][(mj & 1) * 4 + r] = (short)f2bf((j <= i ? p0[mj][r] : 0.f) + (j >= i ? p1[mj][r] : 0.f)); } }
  const bf16_t* VT = (const bf16_t*)(p.ws + Ws::VT) + ((size_t)(b * NC64 + co) * 256 + h * 64) * 64;
  f32x4 o[4];
#pragma unroll
  for (int md = 0; md < 4; ++md) { o[md] = f32x4{0.f, 0.f, 0.f, 0.f};
#pragma unroll
    for (int s2 = 0; s2 < 2; ++s2) { const bf16_t* vr = VT + (size_t)(md * 16 + l15) * 64 + s2 * 32 + q * 4; o[md] = MFMA16(ld4x2g(vr, vr + 16), pfr[s2], o[md]); } }
#pragma unroll
  for (int d = 0; d < 2; ++d) { const int cs = cscan(d, co, CTX_ / 64, SEQ_ / 64);
    float* GST = (float*)(p.ws + Ws::GST) + (((size_t)(d * B_ + b) * NC64 + cs) * 4 + h) * 2048;
#pragma unroll
    for (int nd = 0; nd < 2; ++nd) { f32x4 st = f32x4{0.f, 0.f, 0.f, 0.f};
#pragma unroll
      for (int s2 = 0; s2 < 2; ++s2) st = MFMA16(ld8g(VT + (size_t)(wave * 16 + l15) * 64 + s2 * 32 + q * 8), ld8(kt + d * 32 * GK_LD + (nd * 16 + l15) * GK_LD + s2 * 32 + q * 8), st);
#pragma unroll
      for (int r = 0; r < 4; ++r) GST[(wave * 16 + q * 4 + r) * 32 + nd * 16 + l15] = st[r]; } }
  __syncthreads();
  float* ol = (float*)smem;
#pragma unroll
  for (int md = 0; md < 4; ++md)
#pragma unroll
    for (int r = 0; r < 4; ++r) ol[(wave * 16 + l15) * 65 + md * 16 + q * 4 + r] = o[md][r];
  __syncthreads();
  float* OI = (float*)(p.ws + Ws::OI) + (size_t)(b * T_ + co * 64) * 256 + h * 64;
  for (int e = tid; e < 64 * 64; e += 256) OI[(size_t)(e >> 6) * 256 + (e & 63)] = ol[(e >> 6) * 65 + (e & 63)];
}
#define GLA_SB ((NC64 % 17) == 0 ? 17 : NC64)
DEVFN void gla_scan(const Params& p, int gtid, int gthreads) {
  const float* __restrict__ ST = (const float*)(p.ws + Ws::GST); const float* __restrict__ CD = (const float*)(p.ws + Ws::GCD); bf16_t* __restrict__ SIN = (bf16_t*)(p.ws + Ws::GSIN);
  for (int e = gtid; e < 2 * B_ * 4 * 2048; e += gthreads) {
    const int vd = e & 2047, h = (e >> 11) & 3, db = e >> 13;
    float sv = 0.f;
#pragma unroll 1
    for (int c0 = 0; c0 < NC64; c0 += GLA_SB) {
      float st[GLA_SB], cd[GLA_SB];
#pragma unroll
      for (int i = 0; i < GLA_SB; ++i) { st[i] = ST[(((size_t)db * NC64 + c0 + i) * 4 + h) * 2048 + vd]; cd[i] = CD[(((size_t)db * NC64 + c0 + i) * 4 + h) * 32 + (vd & 31)]; }
#pragma unroll
      for (int i = 0; i < GLA_SB; ++i) { SIN[(((size_t)db * NC64 + c0 + i) * 4 + h) * 2048 + vd] = f2bf(sv); sv = sv * cd[i] + st[i]; }
    }
  }
}
DEVFN void convert_moe_weights(const Params& p, int l, unsigned char* smem, int bid, int nb);
DEVFN void phase4a(const Params& p, int l, unsigned char* smem) {
  const int n_r = B_ * 8 * NC16 / 4;
  for (int u = BIDX; u < n_r; u += gridDim.x) rwkv_chunk(p, (u) * 4, smem);
  (void)l;
}
DEVFN void phase4b(const Params& p, int l, unsigned char* smem) {
  const int bid = BIDX, nrw = B_ * 8, G = (int)gridDim.x;
  const int n_s = B_ * NC128 * 8, n_g = B_ * NC64 * 4;
  int ob = bid, on = G;
  if (G >= 8 * nrw) {
    const int q = 2 * nrw, half = G >> 1;
    int sb = -1;
    if (bid < q) sb = bid; else if (bid >= half && bid < half + q) sb = q + (bid - half);
    if (sb >= 0) { if ((TIDX >> 6) == 0) rwkv_scan(p, sb >> 2, sb & 3); return; }
    ob = bid < half ? bid - q : bid - 2 * q; on = G - 4 * nrw; }
  else { for (int u = bid; u < nrw; u += G) rwkv_scan(p, u, TIDX >> 6); }
  for (int u = ob; u < n_s + n_g; u += on) { if (u < n_s) ssd_states(p, l, u, smem); else gla_chunk(p, u - n_s, smem); }
  convert_moe_weights(p, l, smem, ob, on);
}
DEVFN void phase4b2(const Params& p) {
  const int bid = BIDX, G = (int)gridDim.x;
  ssd_scan(p, bid * 256 + TIDX, G * 256); gla_scan(p, bid * 256 + TIDX, G * 256);
}
DEVFN void phase4c(const Params& p, int l, unsigned char* smem) {
  const int n_s = B_ * NC128 * 8, n_r = B_ * 8 * NC16 / 4;
  for (int u = BIDX; u < n_s + n_r; u += gridDim.x) { if (u < n_s) ssd_out(p, l, u, smem); else rwkv_out(p, (u - n_s) * 4); }
}

DEVFN void phase5(const Params& p, int l, unsigned char* smem) {
  const int tid = TIDX, lane = tid & 63, wave = tid >> 6;
  const bf16_t* ZX = (const bf16_t*)(p.ws + Ws::ZX);
  const bf16_t* XBC = (const bf16_t*)(p.ws + Ws::XBC);
  const float* YS = (const float*)(p.ws + Ws::YS); const float* YR = (const float*)(p.ws + Ws::YR); const float* OI = (const float*)(p.ws + Ws::OI);
  const bf16_t* QT = (const bf16_t*)(p.ws + Ws::QT); const bf16_t* GSIN = (const bf16_t*)(p.ws + Ws::GSIN);
  const bf16_t* RR = (const bf16_t*)(p.ws + Ws::RR); const bf16_t* VV = (const bf16_t*)(p.ws + Ws::VV); const bf16_t* KD = (const bf16_t*)(p.ws + Ws::KD);
  const float* GATE = (const float*)(p.ws + Ws::GATE);
  bf16_t* YM = (bf16_t*)(p.ws + Ws::YMIX);
  float* red = (float*)smem;
  float* qt = red + 16;
  const float dA = INP(I_SSDD)[(size_t)l * 8 + (tid >> 6)], dB = INP(I_SSDD)[(size_t)l * 8 + 4 + (tid >> 6)];
  const float nwA = INP(I_SSDNW)[(size_t)l * 512 + tid], nwB = INP(I_SSDNW)[(size_t)l * 512 + 256 + tid];
  const float lnw = INP(I_LNXW)[(size_t)l * 256 + tid], lnb = INP(I_LNXB)[(size_t)l * 256 + tid], rk = INP(I_RK)[(size_t)l * 256 + tid];
  const float gnw = INP(I_GNW)[(size_t)l * 256 + tid];
  const int per_ = (NT_ / 2 + (int)gridDim.x - 1) / (int)gridDim.x, tp_lo = BIDX * per_, tp_hi = (tp_lo + per_ < NT_ / 2) ? tp_lo + per_ : NT_ / 2;
  for (int tp = tp_lo; tp < tp_hi; ++tp) {
    float ys0[2], ys1[2], x0[2], x1[2], z0[2], z1[2], og[2], yr[2], rr[2], kf[2], kb[2], vv[2], gt[2], oi[2], qv[2];
    bf16x8 gs[2][2][4];
#pragma unroll
    for (int t = 0; t < 2; ++t) { const int tok = tp * 2 + t; const int b = tok / T_, co = (tok % T_) / 64;
      ys0[t] = gptr(YS)[(size_t)tok * 512 + tid]; ys1[t] = gptr(YS)[(size_t)tok * 512 + 256 + tid];
      x0[t] = bf2f(gptr(XBC)[(size_t)tok * 1024 + tid]); x1[t] = bf2f(gptr(XBC)[(size_t)tok * 1024 + 256 + tid]);
      z0[t] = zxv(ZX, tok, OZ + tid); z1[t] = zxv(ZX, tok, OZ + 256 + tid); og[t] = zxv(ZX, tok, OOG + tid);
      yr[t] = gptr(YR)[(size_t)tok * 256 + tid] + gptr(YR)[((size_t)NT_ + tok) * 256 + tid];
      rr[t] = bf2f(gptr(RR)[(size_t)tok * 256 + tid]); kf[t] = bf2f(gptr(KD)[(size_t)tok * 256 + tid]); kb[t] = bf2f(gptr(KD)[((size_t)NT_ + tok) * 256 + tid]);
      vv[t] = bf2f(gptr(VV)[(size_t)tok * 256 + tid]); gt[t] = gptr(GATE)[(size_t)tok * 256 + tid]; oi[t] = gptr(OI)[(size_t)tok * 256 + tid];
      qv[t] = bf2f(gptr(QT)[((size_t)(tid >> 7) * NT_ + tok) * 128 + (tid & 127)]);
#pragma unroll
      for (int d = 0; d < 2; ++d) { const int cs = cscan(d, co, CTX_ / 64, SEQ_ / 64);
        const bf16_t* sr = GSIN + ((((size_t)(d * B_ + b) * NC64 + cs) * 4 + wave) * 64 + lane) * 32;
#pragma unroll
        for (int c8 = 0; c8 < 4; ++c8) gs[t][d][c8] = ld8g(sr + c8 * 8); } }
    float ya[2], yb[2], qa[2], qb[2];
#pragma unroll
    for (int t = 0; t < 2; ++t) {
      ya[t] = (ys0[t] + dA * x0[t]) * siluf_(z0[t]); yb[t] = (ys1[t] + dB * x1[t]) * siluf_(z1[t]);
      qa[t] = wave_sum(ya[t] * ya[t]); qb[t] = wave_sum(yb[t] * yb[t]); }
    __syncthreads();
#pragma unroll
    for (int t = 0; t < 2; ++t) {
      if (lane == 0) { red[t * 8 + wave] = qa[t]; red[t * 8 + 4 + wave] = qb[t]; }
      qt[t * 256 + tid] = qv[t]; }
    __syncthreads();
#pragma unroll
    for (int t = 0; t < 2; ++t) { const int tok = tp * 2 + t;
      const float* rd = red + t * 8; const float* qtt = qt + t * 256;
      float ma = (rd[0] + rd[1] + rd[2] + rd[3]) * (1.f / 256.f), mb = (rd[4] + rd[5] + rd[6] + rd[7]) * (1.f / 256.f);
      YM[(size_t)tok * 1024 + tid] = f2bf(ya[t] * rsqrtf(ma + 1e-5f) * nwA);
      YM[(size_t)tok * 1024 + 256 + tid] = f2bf(yb[t] * rsqrtf(mb + 1e-5f) * nwB);
      { const float y = yr[t];
        float mu = wave_sum(y) * (1.f / 64.f), d = y - mu, var = wave_sum(d * d) * (1.f / 64.f);
        float yn = d * rsqrtf(var + 64e-5f) * lnw + lnb;
        float bonus = wave_sum(rr[t] * (kf[t] + kb[t]) * rk) * vv[t];
        YM[(size_t)tok * 1024 + 512 + tid] = f2bf((yn + bonus) * gt[t]); }
      { float o = oi[t];
#pragma unroll
        for (int d = 0; d < 2; ++d)
#pragma unroll
          for (int c8 = 0; c8 < 4; ++c8)
#pragma unroll
            for (int jj = 0; jj < 8; ++jj) o += qtt[d * 128 + wave * 32 + c8 * 8 + jj] * bf2f((bf16_t)gs[t][d][c8][jj]);
        float ms = wave_sum(o * o) * (1.f / 64.f);
        YM[(size_t)tok * 1024 + 768 + tid] = f2bf(o * rsqrtf(ms + 1e-5f) * gnw * siluf_(og[t])); } }
  }
}

DEVFN void phase6(const Params& p, int l, unsigned char* smem) {
  const bf16_t* A = (const bf16_t*)(p.ws + Ws::YMIX);
  const bf16_t* W = (const bf16_t*)(p.ws + Ws::WOUT) + (size_t)l * 1024 * 1024;
  float* MIX = (float*)(p.ws + Ws::MIX);
  for (int u = BIDX; u < (NT_ / 128) * 8; u += gridDim.x) {
    int rt = u / 8, ct = u % 8;
    gemm_tile(smem, 1024,
      [&](int r) { return A + (size_t)(rt * 128 + r) * 1024; },
      [&](int r) { return W + (size_t)(ct * 128 + r) * 1024; },
      [&](f32x4 (&acc)[4][4], int wr, int wc, int g, int l15) {
#pragma unroll
        for (int mi = 0; mi < 4; ++mi)
#pragma unroll
          for (int ni = 0; ni < 4; ++ni)
#pragma unroll
            for (int i = 0; i < 4; ++i) MIX[(size_t)(rt * 128 + wr * 64 + mi * 16 + 4 * g + i) * 1024 + ct * 128 + wc * 64 + ni * 16 + l15] = acc[mi][ni][i];
      });
  }
}

#define P7_MAXE 2048
DEVFN void phase7(const Params& p, int l, unsigned char* smem) {
  const int lane = TIDX & 63, wave = TIDX >> 6;
  float* X = (float*)(p.ws + Ws::X);
  const float* MIX = (const float*)(p.ws + Ws::MIX);
  bf16_t* H = (bf16_t*)(p.ws + Ws::U);
  const float* rwt = (const float*)(p.ws + Ws::RWT) + (size_t)l * 64 * 1024;
  int* cnt = (int*)(p.ws + Ws::CNT) + l * 64 * 64;
  int* ltok = (int*)(p.ws + Ws::LTOK); float* lwt = (float*)(p.ws + Ws::LWT);
  const float rbias = INP(I_RB)[(size_t)l * 64 + lane];
  float* hs = (float*)smem;
  float* lg = hs + 4096;
  int* lcnt = (int*)(lg + 256);
  int* lbase = lcnt + 80;
  int* etok = lbase + 64;
  int* epos = etok + P7_MAXE; float* ewt = (float*)(epos + P7_MAXE);
  for (int i = TIDX; i < 80; i += 256) lcnt[i] = 0;
  for (int tok0 = BIDX * 4; tok0 < NT_; tok0 += gridDim.x * 4) {
    const int tok = tok0 + wave;
    const float* mod = (const float*)(p.ws + Ws::MOD) + ((size_t)l * NR_ + tok_modrow(tok)) * NMOD_;
    float xv[16], mx[16], g1[16], lw[16], lb[16], sh2[16], sc2[16], mean, rstd;
    load_row16(X + (size_t)tok * 1024, lane, xv);
    load_row16(MIX + (size_t)tok * 1024, lane, mx);
    load_row16(mod + 2 * 1024, lane, g1);
    load_row16(INP(I_LN1W) + (size_t)l * 1024, lane, lw);
    load_row16(INP(I_LN1B) + (size_t)l * 1024, lane, lb);
    load_row16(mod + 3 * 1024, lane, sh2);
    load_row16(mod + 4 * 1024, lane, sc2);
#pragma unroll
    for (int i = 0; i < 16; ++i) xv[i] = ALPHA_ * xv[i] + g1[i] * mx[i];
    row_stats(xv, mean, rstd);
#pragma unroll
    for (int i = 0; i < 16; ++i) xv[i] = (xv[i] - mean) * rstd * lw[i] + lb[i];
#pragma unroll
    for (int j = 0; j < 4; ++j) *(float4*)(X + (size_t)tok * 1024 + lane * 4 + 256 * j) = make_float4(xv[4 * j], xv[4 * j + 1], xv[4 * j + 2], xv[4 * j + 3]);
    const bool routed = !(l == DEPTH_ - 1 && (tok % T_) < CTX_);
    row_stats(xv, mean, rstd);
#pragma unroll
    for (int i = 0; i < 16; ++i) xv[i] = (xv[i] - mean) * rstd * (1.f + sc2[i]) + sh2[i];
    __syncthreads();
#pragma unroll
    for (int j = 0; j < 4; ++j) {
      if (routed) *(uint2*)(H + (size_t)tok * 1024 + lane * 4 + 256 * j) = make_uint2((unsigned)f2bf(xv[4 * j]) | ((unsigned)f2bf(xv[4 * j + 1]) << 16), (unsigned)f2bf(xv[4 * j + 2]) | ((unsigned)f2bf(xv[4 * j + 3]) << 16));
      *(float4*)(hs + wave * 1024 + lane * 4 + 256 * j) = make_float4(xv[4 * j], xv[4 * j + 1], xv[4 * j + 2], xv[4 * j + 3]); }
    __syncthreads();
    { float hv[4][16];
      const int rot = BIDX & 15;
#pragma unroll
      for (int t = 0; t < 4; ++t)
#pragma unroll
        for (int j = 0; j < 4; ++j) { const float4 v = *(const float4*)(hs + t * 1024 + lane * 4 + 256 * j); hv[t][4 * j] = v.x; hv[t][4 * j + 1] = v.y; hv[t][4 * j + 2] = v.z; hv[t][4 * j + 3] = v.w; }
      float pe[64];
      const AS1 float* rw = gptr(rwt) + lane * 4;
      f32x4 w[4], wn[4];
#pragma unroll
      for (int j = 0; j < 4; ++j) w[j] = *(const AS1 f32x4*)(rw + (size_t)(16 * wave + (rot & 15)) * 1024 + 256 * j);
#pragma unroll
      for (int e = 0; e < 16; ++e) {
        if (e + 1 < 16) {
#pragma unroll
          for (int j = 0; j < 4; ++j) wn[j] = *(const AS1 f32x4*)(rw + (size_t)(16 * wave + ((e + 1 + rot) & 15)) * 1024 + 256 * j); }
#pragma unroll
        for (int t = 0; t < 4; ++t) { float s0 = 0.f, s1 = 0.f;
#pragma unroll
          for (int j = 0; j < 4; ++j) { s0 += hv[t][4 * j] * w[j][0] + hv[t][4 * j + 2] * w[j][2]; s1 += hv[t][4 * j + 1] * w[j][1] + hv[t][4 * j + 3] * w[j][3]; }
          pe[e * 4 + t] = s0 + s1; }
#pragma unroll
        for (int j = 0; j < 4; ++j) w[j] = wn[j]; }
#pragma unroll
      for (int half = 32; half >= 1; half >>= 1) { const bool up = (lane & half) != 0;
#pragma unroll
        for (int e = 0; e < half; ++e) { const float send = up ? pe[e] : pe[e + half]; const float recv = __shfl_xor(send, half); pe[e] = (up ? pe[e + half] : pe[e]) + recv; } }
      lg[(lane & 3) * 64 + 16 * wave + (((lane >> 2) + rot) & 15)] = pe[0]; }
    __syncthreads();
    if (!routed) continue;
    const float logit = lg[wave * 64 + lane];
    const float score = sigmoidf_(logit), sel = score + rbias;
    float m1 = sel; int a1 = lane;
#pragma unroll
    for (int m = 1; m <= 4; m <<= 1) { float ov = XOR8(m1, m); int oa = XOR8(a1, m); if (ov > m1 || (ov == m1 && oa < a1)) { m1 = ov; a1 = oa; } }
    float m2 = (lane == a1) ? -3.0e38f : sel;
#pragma unroll
    for (int m = 1; m <= 4; m <<= 1) m2 = fmaxf(m2, XOR8(m2, m));
    const float gs = m1 + m2; const int grp = lane >> 3;
    int grank = 0;
#pragma unroll
    for (int g2 = 0; g2 < 8; ++g2) { float og = SHFL_CONST(gs, g2 * 8); grank += (og > gs || (og == gs && g2 < grp)) ? 1 : 0; }
    const bool gsel = grank < 4;
    const float msel = gsel ? sel : -3.0e38f;
    int rank = 0;
#pragma unroll
    for (int e = 0; e < 64; ++e) { float ov = SHFL_CONST(msel, e); rank += (ov > msel || (ov == msel && e < lane)) ? 1 : 0; }
    const bool chosen = gsel && rank < 8;
    const float wsum = wave_sum(chosen ? score : 0.f);
    if (chosen) { const float wv = score / wsum * 2.5f;
      const int idx = atomicAdd(&lcnt[64], 1);
      if (idx < P7_MAXE) { const int slot = atomicAdd(&lcnt[lane], 1); etok[idx] = tok * 8 + rank; epos[idx] = lane | (slot << 8); ewt[idx] = wv; }
      else { int pos = atomicAdd(&cnt[lane * 64], 1); ltok[(size_t)lane * NT_ + pos] = tok * 8 + rank; lwt[(size_t)lane * NT_ + pos] = wv; } }
  }
  __syncthreads();
  if (TIDX < 64) { const int c = lcnt[TIDX]; lbase[TIDX] = c ? atomicAdd(&cnt[TIDX * 64], c) : 0; }
  __syncthreads();
  { const int ne = lcnt[64] < P7_MAXE ? lcnt[64] : P7_MAXE;
    for (int i = TIDX; i < ne; i += 256) { const int e = epos[i] & 255, pos = lbase[e] + (epos[i] >> 8);
      ltok[(size_t)e * NT_ + pos] = etok[i]; lwt[(size_t)e * NT_ + pos] = ewt[i]; } }
}

struct MoeMap { int nblk_total; int e; int rb; int cnt; int hoff; };
DEVFN int moe_ntok(int l) { return l == DEPTH_ - 1 ? B_ * SEQ_ : NT_; }
DEVFN int moe_shared_tok(int l, int i) { return l == DEPTH_ - 1 ? (i / SEQ_) * T_ + CTX_ + (i % SEQ_) : i; }
DEVFN void moe_prefix(const Params& p, int l, int* pre) {
  const int* cnt = (const int*)(p.ws + Ws::CNT) + l * 64 * 64;
  __syncthreads();
  if (TIDX < 64) pre[66 + TIDX] = gptr(cnt)[TIDX * 64];
  if (TIDX == 64) pre[66 + 64] = moe_ntok(l);
  __syncthreads();
  if (TIDX == 0) { int s = 0; for (int e = 0; e < 65; ++e) { pre[e] = s; s += (pre[66 + e] + 127) / 128; } pre[65] = s; }
  __syncthreads();
}
DEVFN void phase8(const Params& p, int l, unsigned char* smem) {
  int* pre = (int*)(smem + SM_PRE);
  moe_prefix(p, l, pre);
  const bf16_t* H = (const bf16_t*)(p.ws + Ws::U);
  const bf16_t* W13 = (const bf16_t*)(p.ws + Ws::W13);
  bf16_t* HID = (bf16_t*)(p.ws + Ws::HID);
  const int* ltok = (const int*)(p.ws + Ws::LTOK); const float* lwt = (const float*)(p.ws + Ws::LWT);
  const int total = pre[65];
  for (int u = BIDX; u < total * 2; u += gridDim.x) {
    const int gb = u >> 1, nt = u & 1;
    int e = 0; while (pre[e + 1] <= gb) ++e;
    e = UNI(e);
    const int rb = UNI(gb - pre[e]), cnt = UNI(pre[66 + e]);
    int* tk_s = (int*)(smem + GEMMW_SMEM); float* gw_s = (float*)(tk_s + 128);
    __syncthreads();
    if (TIDX < 128) { const int pos = rb * 128 + TIDX; int tk = -1; float gw = 0.f;
      if (pos < cnt) { tk = e < 64 ? (gptr(ltok)[(size_t)e * NT_ + pos] >> 3) : moe_shared_tok(l, pos); gw = e < 64 ? gptr(lwt)[(size_t)e * NT_ + pos] : 1.f; }
      tk_s[TIDX] = tk; gw_s[TIDX] = gw; }
    __syncthreads();
    gemm_tile_w<1, 1024>(smem, 1024,
      [&](int r) { const int tk = tk_s[r]; return tk >= 0 ? H + (size_t)tk * 1024 : (const bf16_t*)(p.ws + Ws::ZROW); },
      [&](int) { return W13 + ((size_t)e * 512 + nt * 256) * 1024; },
      [&](f32x4 (&acc)[4][8], int, int wr, int wc, int g, int l15) {
        tile_store_bf16<16>(smem, wr, g, l15,
          [&](bf16_t* T, int ldc) {
#pragma unroll
            for (int mi = 0; mi < 4; ++mi)
#pragma unroll
              for (int i = 0; i < 4; ++i) { const int r = wr * 64 + mi * 16 + 4 * g + i;
                const float gw = gw_s[r];
#pragma unroll
                for (int j = 0; j < 4; ++j) T[r * ldc + wc * 64 + j * 16 + l15] = f2bf(siluf_(acc[mi][2 * j][i]) * acc[mi][2 * j + 1][i] * gw); } },
          [&](int row, int c0) { const int pos = rb * 128 + row; return pos < cnt ? HID + ((size_t)gb * 128 + row) * 256 + nt * 128 + c0 : (bf16_t*)nullptr; });
      });
  }
}
DEVFN void phase9(const Params& p, int l, unsigned char* smem) {
  int* pre = (int*)(smem + SM_PRE);
  moe_prefix(p, l, pre);
  const bf16_t* HID = (const bf16_t*)(p.ws + Ws::HID);
  const bf16_t* W2T = (const bf16_t*)(p.ws + Ws::W2T);
  bf16_t* YB = (bf16_t*)(p.ws + Ws::YBUF);
  const int* ltok = (const int*)(p.ws + Ws::LTOK);
  const int total = pre[65];
  for (int u = BIDX; u < total * 2; u += gridDim.x) {
    const int gb = u >> 1, ntp = u & 1;
    int e = 0; while (pre[e + 1] <= gb) ++e;
    e = UNI(e);
    const int rb = UNI(gb - pre[e]), cnt = UNI(pre[66 + e]);
    int* ts_s = (int*)(smem + GEMMW_SMEM);
    __syncthreads();
    if (TIDX < 128) { const int pos = rb * 128 + TIDX; int ts = -1;
      if (pos < cnt) ts = e < 64 ? gptr(ltok)[(size_t)e * NT_ + pos] : moe_shared_tok(l, pos) * 8;
      ts_s[TIDX] = ts; }
    __syncthreads();
    gemm_tile_w<2, 256>(smem, 256,
      [&](int r) { return ts_s[r] >= 0 ? HID + ((size_t)gb * 128 + r) * 256 : (const bf16_t*)(p.ws + Ws::ZROW); },
      [&](int j) { return W2T + ((size_t)e * 1024 + (ntp * 2 + j) * 256) * 256; },
      [&](f32x4 (&acc)[4][8], int j, int wr, int wc, int g, int l15) { const int nt = ntp * 2 + j;
#pragma unroll 1
        for (int h = 0; h < 2; ++h)
          tile_store_bf16<16>(smem, wr, g, l15,
            [&](bf16_t* T, int ldc) {
              if (wc == h) {
#pragma unroll
                for (int mi = 0; mi < 4; ++mi)
#pragma unroll
                  for (int ni = 0; ni < 8; ++ni)
#pragma unroll
                    for (int i = 0; i < 4; ++i) T[(wr * 64 + mi * 16 + 4 * g + i) * ldc + ni * 16 + l15] = f2bf(acc[mi][ni][i]); } },
            [&](int row, int c0) { const int ts = ts_s[row]; if (ts < 0) return (bf16_t*)nullptr;
              const int tok = ts >> 3, slot = e < 64 ? (ts & 7) : 8;
              return YB + ((size_t)tok * NSLOT + slot) * 1024 + nt * 256 + h * 128 + c0; });
      });
  }
}

#define SMEM_BYTES (PH_SMEM + 2048)
#define N_PHASES (3 + 13 * DEPTH_)
__global__ void __launch_bounds__(256, 2) mega(Params p, int ph_lo, int ph_hi) {
#ifdef HIPEMU
  unsigned char* smem = hipemu::cur_smem();
#else
  unsigned char* smem = smem_dyn;
  volatile LAS unsigned* st = (volatile LAS unsigned*)(smem_dyn + SM_BAR);
  if (threadIdx.x == 0) {
    st[0] = 0u; st[1] = 0u;
    unsigned long long* tab = (unsigned long long*)(smem_dyn + SM_TAB);
#pragma unroll
    for (int i = 0; i < 40; ++i) tab[i] = (unsigned long long)p.in[i];
  }
  __syncthreads();
  XcdBarrier bar = xcd_barrier_post((unsigned*)(p.ws + Ws::BAR), st);
#define GRID_SYNC() xcd_barrier(bar)
#endif
  int ph = 0;
#ifdef ONLY_KIND
#define KIND_ON(k) ((k) == ONLY_KIND)
#else
#define KIND_ON(k) 1
#endif
#ifndef REPEAT_MASK
#define REPEAT_MASK 0u
#endif
#define RUN_PHASE(kind, code) { if (KIND_ON(kind) && ph >= ph_lo && ph < ph_hi) { \
    int nrep_ = ((REPEAT_MASK >> (kind)) & 1u) ? 2 : 1; LAUNDER(nrep_); \
    _Pragma("unroll 1") for (int rep_ = 0; rep_ < nrep_; ++rep_) { LAUNDER(p.ws); LAUNDER(p.out); code; if (rep_ + 1 < nrep_ || ph + 1 < ph_hi) { GRID_SYNC(); } } } ++ph; }
  RUN_PHASE(0, phase0(p, smem));
  RUN_PHASE(11, phase0b(p));
  for (int l = 0; l < DEPTH_; ++l) {
    RUN_PHASE(1, phase1(p, l));
    RUN_PHASE(2, phase2(p, l, smem));
    RUN_PHASE(3, phase3(p, l, smem));
    RUN_PHASE(14, phase3b(p, l, smem));
    RUN_PHASE(4, phase4a(p, l, smem));
    RUN_PHASE(12, phase4b(p, l, smem));
    RUN_PHASE(16, phase4b2(p));
    RUN_PHASE(13, phase4c(p, l, smem));
    RUN_PHASE(5, phase5(p, l, smem));
    RUN_PHASE(6, phase6(p, l, smem));
    RUN_PHASE(7, phase7(p, l, smem));
    RUN_PHASE(8, phase8(p, l, smem));
    RUN_PHASE(9, phase9(p, l, smem));
  }
  RUN_PHASE(10, phase_final(p));
}

extern "C" void kernel_launch(void* const* d_in, const int* in_sizes, int n_in, void* d_out, int out_size, void* d_ws, size_t ws_size, hipStream_t stream) {
  Params p{};
  for (int i = 0; i < 40; ++i) p.in[i] = (const float*)d_in[i];
  p.out = (float*)d_out;
  p.ws = (unsigned char*)d_ws;
  if (ws_size < Ws::END) { fprintf(stderr, "workspace too small: %zu < %zu\n", ws_size, (size_t)Ws::END); return; }
  hipMemsetAsync(d_ws, 0, Ws::ZERO_END, stream);
#ifdef HIPEMU
  int grid = 16; if (const char* e = getenv("EMU_GRID")) grid = atoi(e);
  int stop = N_PHASES; if (const char* e = getenv("EMU_STOP")) stop = atoi(e);
  if (getenv("EMU_ONE")) hipemu::launch(grid, 256, SMEM_BYTES, true, [=] { mega(p, 0, stop); });
  else for (int ph = 0; ph < stop; ++ph) hipemu::launch(grid, 256, SMEM_BYTES, false, [=] { mega(p, ph, ph + 1); });
#else
  static int grid = 0;
  if (!grid) {
    int dev = 0, cus = 0, per_cu = 0;
    hipGetDevice(&dev);
    hipDeviceGetAttribute(&cus, hipDeviceAttributeMultiprocessorCount, dev);
    hipOccupancyMaxActiveBlocksPerMultiprocessor(&per_cu, mega, 256, SMEM_BYTES);
    if (per_cu > 2) per_cu = 2;
    if (per_cu < 1) per_cu = 1;
    grid = cus * per_cu;
  }
#if N_LAUNCH_MODE == 1
  mega<<<grid, 256, SMEM_BYTES, stream>>>(p, 0, N_PHASES);
#else
  for (int ph = 0; ph < N_PHASES; ++ph) mega<<<grid, 256, SMEM_BYTES, stream>>>(p, ph, ph + 1);
#endif
#endif
}
```

```cpp
#ifndef HIPEMU
#include <hip/hip_runtime.h>
#endif
#include <stdint.h>
#include <stdio.h>

#ifndef B_
#define B_ 4
#endif
#ifndef SEQ_
#define SEQ_ 4096
#endif
#ifndef CTX_
#define CTX_ 256
#endif
#ifndef DEPTH_
#define DEPTH_ 4
#endif
#ifndef N_LAUNCH_MODE
#define N_LAUNCH_MODE 1
#endif
#define T_ (SEQ_ + CTX_)
#define NT_ (B_ * T_)
#define D_ 1024
#define NIN_ 3504
#define NMOD_ 6144
#define NR_ (B_ + 1)
#define OZ 0
#define OXBC 512
#define ODT 1536
#define ORW 1552
#define OGQ 2704
#define OGK 2832
#define OGV 2960
#define OGD 3216
#define OOG 3248
#define ALPHA_ 1.681792830507429f
#define NEXP 64
#define NSLOT 9
#define NC128 (T_ / 128)
#define NC64 (T_ / 64)
#define NC16 (T_ / 16)

#define DEVFN __device__ __forceinline__
#define LDT 72
#define GEMM_SMEM (2 * 128 * LDT * 2)
#define GEMMW_SMEM (3 * 128 * LDT * 2)
typedef unsigned short bf16_t;
#ifdef HIPEMU
#define AS1
#else
#define AS1 __attribute__((address_space(1)))
#endif
typedef unsigned u32x4 __attribute__((ext_vector_type(4)));
typedef unsigned u32x2 __attribute__((ext_vector_type(2)));

#ifdef HIPEMU
typedef emu_bf16x8 bf16x8;
typedef emu_f32x4 f32x4;
#define MFMA16(a, b, c) emu_mfma_16x16x32_bf16(a, b, c)
#define MFMA16K16(a, b, c) emu_mfma_16x16x16_bf16(a, b, c)
#define GRID_SYNC() hipemu::grid_sync()
#else
typedef short bf16x8 __attribute__((ext_vector_type(8)));
typedef float f32x4 __attribute__((ext_vector_type(4)));
#define MFMA16(a, b, c) __builtin_amdgcn_mfma_f32_16x16x32_bf16(a, b, c, 0, 0, 0)
#define MFMA16K16(a, b, c) __builtin_amdgcn_mfma_f32_16x16x16bf16_1k(a, b, c, 0, 0, 0)
#endif

DEVFN float bf2f(bf16_t h) { return __builtin_bit_cast(float, (unsigned)h << 16); }
DEVFN bf16_t f2bf(float f) { unsigned u = __builtin_bit_cast(unsigned, f); u += 0x7FFFu + ((u >> 16) & 1u); return (bf16_t)(u >> 16); }
template <class T> DEVFN AS1 T* gptr(T* q) { return (AS1 T*)q; }
DEVFN bf16x8 ld8g(const bf16_t* q) { return *(const AS1 bf16x8*)gptr(q); }
DEVFN float sigmoidf_(float x) { return 1.f / (1.f + expf(-x)); }
DEVFN float siluf_(float x) { return x / (1.f + expf(-x)); }
DEVFN float softplusf_(float x) { return x > 20.f ? x : log1pf(expf(x)); }
DEVFN float logsigmoidf_(float x) { return fminf(x, 0.f) - log1pf(expf(-fabsf(x))); }
#ifdef HIPEMU
DEVFN float wave_sum(float v) { for (int m = 32; m >= 1; m >>= 1) v += __shfl_xor(v, m); return v; }
#define SHFL_CONST(x, ln) __shfl(x, ln)
#define XOR8(x, m) __shfl_xor(x, m)
#else
template <int CTRL> DEVFN float dpp_f(float v) { return __builtin_bit_cast(float, __builtin_amdgcn_update_dpp(0, __builtin_bit_cast(int, v), CTRL, 0xF, 0xF, false)); }
template <int CTRL> DEVFN int dpp_i(int v) { return __builtin_amdgcn_update_dpp(0, v, CTRL, 0xF, 0xF, false); }
DEVFN float rdl_f(float v, int ln) { return __builtin_bit_cast(float, __builtin_amdgcn_readlane(__builtin_bit_cast(int, v), ln)); }
DEVFN float wave_sum(float v) {
  v += dpp_f<0xB1>(v);
  v += dpp_f<0x4E>(v);
  v += dpp_f<0x141>(v);
  v += dpp_f<0x140>(v);
  return (rdl_f(v, 0) + rdl_f(v, 16)) + (rdl_f(v, 32) + rdl_f(v, 48));
}
DEVFN float shfl_const_(float x, int ln) { return rdl_f(x, ln); }
DEVFN int shfl_const_(int x, int ln) { return __builtin_amdgcn_readlane(x, ln); }
#define SHFL_CONST(x, ln) shfl_const_(x, ln)
DEVFN float xor8_(float x, int m) { return m == 1 ? dpp_f<0xB1>(x) : m == 2 ? dpp_f<0x4E>(x) : dpp_f<0x141>(x); }
DEVFN int xor8_(int x, int m) { return m == 1 ? dpp_i<0xB1>(x) : m == 2 ? dpp_i<0x4E>(x) : dpp_i<0x141>(x); }
#define XOR8(x, m) xor8_(x, m)
#endif

constexpr size_t al(size_t x) { return (x + 255) & ~(size_t)255; }
struct Ws {
  static constexpr size_t BAR = 0;
  static constexpr size_t CNT = 16384;
  static constexpr size_t MOD = CNT + (size_t)DEPTH_ * 64 * 256;
  static constexpr size_t ZROW = al(MOD + (size_t)DEPTH_ * NR_ * NMOD_ * 4);
  static constexpr size_t ZERO_END = al(ZROW + 2048);
  static constexpr size_t MODP = ZERO_END;
  static constexpr size_t RWT = al(MODP + (size_t)16 * DEPTH_ * NR_ * NMOD_ * 4);
  static constexpr size_t LORA = al(RWT + (size_t)DEPTH_ * 64 * 1024 * 4);
  static constexpr size_t X = al(LORA + (size_t)DEPTH_ * 98304 * 2);
  static constexpr size_t U = al(X + (size_t)NT_ * 1024 * 4);
  static constexpr size_t YMIX = al(U + (size_t)NT_ * 1024 * 2);
  static constexpr size_t ZX = al(YMIX + (size_t)NT_ * 1024 * 2);
  static constexpr size_t MIX = ZX;
  static constexpr size_t LTOK = al(ZX + (size_t)NT_ * NIN_ * 2);
  static constexpr size_t LWT = al(LTOK + (size_t)64 * NT_ * 4);
  static constexpr size_t WIN = al(LWT + (size_t)64 * NT_ * 4);
  static constexpr size_t WOUT = al(WIN + (size_t)DEPTH_ * NIN_ * 1024 * 2);
  static constexpr size_t W13 = al(WOUT + (size_t)DEPTH_ * 1024 * 1024 * 2);
  static constexpr size_t W2T = al(W13 + (size_t)65 * 512 * 1024 * 2);
  static constexpr size_t UNI = al(W2T + (size_t)65 * 1024 * 256 * 2);
  static constexpr size_t XBC = UNI;
  static constexpr size_t XBCT = al(XBC + (size_t)NT_ * 1024 * 2);
  static constexpr size_t DTB = al(XBCT + (size_t)NT_ * 768 * 2);
  static constexpr size_t SST = al(DTB + (size_t)NT_ * 16 * 4);
  static constexpr size_t SCD = al(SST + (size_t)2 * NT_ / 128 * 8 * 8192 * 4);
  static constexpr size_t HIN = al(SCD + (size_t)2 * NT_ / 128 * 8 * 4);
  static constexpr size_t YS = SST;
  static constexpr size_t LA = al(HIN + (size_t)2 * NT_ / 128 * 8 * 8192 * 2);
  static constexpr size_t VT = al(LA + (size_t)2 * NT_ * 128 * 4);
  static constexpr size_t QT = al(VT + (size_t)NT_ * 256 * 2);
  static constexpr size_t OI = al(QT + (size_t)2 * NT_ * 128 * 2);
  static constexpr size_t GST = al(OI + (size_t)NT_ * 256 * 4);
  static constexpr size_t GCD = al(GST + (size_t)2 * NT_ / 64 * 4 * 2048 * 4);
  static constexpr size_t GSIN = al(GCD + (size_t)2 * NT_ / 64 * 4 * 32 * 4);
  static constexpr size_t RR = al(GSIN + (size_t)2 * NT_ / 64 * 4 * 2048 * 2);
  static constexpr size_t VV = RR + (size_t)NT_ * 256 * 2;
  static constexpr size_t KK = VV + (size_t)NT_ * 256 * 2;
  static constexpr size_t KD = KK + (size_t)NT_ * 256 * 2;
  static constexpr size_t BD = KD + (size_t)2 * NT_ * 256 * 2;
  static constexpr size_t LW = BD + (size_t)2 * NT_ * 256 * 2;
  static constexpr size_t GATE = LW + (size_t)2 * NT_ * 256 * 4;
  static constexpr size_t YR = GATE + (size_t)NT_ * 256 * 4;
  static constexpr size_t RML = al(YR + (size_t)2 * NT_ * 256 * 4);
  static constexpr size_t RNS = RML + (size_t)(NT_ / 16) * 8 * 4096 * 2;
  static constexpr size_t RWC = RNS + (size_t)(NT_ / 16) * 8 * 4096 * 2;
  static constexpr size_t RG = RWC + (size_t)(NT_ / 16) * 8 * 64 * 4;
  static constexpr size_t RY0 = RG + (size_t)(NT_ / 16) * 8 * 1024 * 2;
  static constexpr size_t LI = RY0 + (size_t)(NT_ / 16) * 8 * 1024 * 4;
  static constexpr size_t KRW = LI + (size_t)NT_ * 384 * 2;
  static constexpr size_t MIXER_END = KRW + (size_t)NT_ * 256 * 2;
  static constexpr size_t HID = UNI;
  static constexpr size_t YBUF = al(HID + ((size_t)NT_ * 9 + 65 * 128) * 256 * 2);
  static constexpr size_t MOE_END = YBUF + (size_t)NT_ * 9 * 1024 * 2;
  static constexpr size_t END = al(MIXER_END > MOE_END ? MIXER_END : MOE_END);
};

struct Params {
  const float* in[40];
  float* out;
  unsigned char* ws;
};
enum { I_X = 0, I_C, I_CTX, I_CCTX, I_ADAW, I_ADAB, I_WIN, I_CONVW, I_CONVB, I_DTBIAS, I_ALOG, I_SSDD, I_SSDNW, I_MU, I_W0, I_W2, I_A0, I_A2,
       I_G2, I_KKW, I_KAW, I_RK, I_LNXW, I_LNXB, I_GU, I_GB, I_GNW, I_WOUT, I_LN1W, I_LN1B, I_LN2W, I_LN2B, I_RW, I_RB, I_EW1, I_EW3, I_EW2,
       I_SW1, I_SW3, I_SW2 };

#define PH_SMEM 57344
#define SM_PRE (PH_SMEM)
#define SM_TAB (PH_SMEM + 1024)
#define SM_BAR (PH_SMEM + 2032)
#ifdef HIPEMU
#define INP(i) (p.in[i])
#define LAUNDER(x)
#define TIDX ((int)threadIdx.x)
#define BIDX ((int)blockIdx.x)
#define LAUNDER_V(x)
#define UNI(x) (x)
#else
extern __shared__ __align__(16) unsigned char smem_dyn[];
DEVFN const float* inp_lds(int i) {
  const volatile unsigned* t = (const volatile unsigned*)(smem_dyn + SM_TAB) + 2 * i;
  unsigned lo = __builtin_amdgcn_readfirstlane(t[0]), hi = __builtin_amdgcn_readfirstlane(t[1]);
  return (const float*)(((unsigned long long)hi << 32) | lo);
}
#define INP(i) inp_lds(i)
#define LAUNDER(x) asm volatile("" : "+s"(x))
DEVFN int tidx_() { int t = threadIdx.x; asm volatile("" : "+v"(t)); return t; }
DEVFN int bidx_() { int b = blockIdx.x; asm volatile("" : "+s"(b)); return b; }
#define TIDX tidx_()
#define LAUNDER_V(x) asm volatile("" : "+v"(x))
#define BIDX bidx_()
#define UNI(x) __builtin_amdgcn_readfirstlane(x)
#endif
#ifndef HIPEMU
#define XB_TMO      128
#define XB_XCNT(j)  (256  + 64 * (j))
#define XB_XSUB(j)  (1280 + 64 * (j))
#define XB_XGEN(j)  (2304 + 64 * (j))
#define XB_TOP      3328
#define XB_TOPGEN   3392
#define XCD_BAR_WORDS 3456
#define XB_SPIN_CAP (1u << 22)
#define LAS __attribute__((address_space(3)))
__device__ __forceinline__ unsigned xb_ld(unsigned* p)              { return __hip_atomic_load(p, __ATOMIC_RELAXED, __HIP_MEMORY_SCOPE_AGENT); }
__device__ __forceinline__ unsigned xb_add(unsigned* p, unsigned v) { return __hip_atomic_fetch_add(p, v, __ATOMIC_RELAXED, __HIP_MEMORY_SCOPE_AGENT); }
__device__ __forceinline__ unsigned xb_xcc_id() { return (unsigned)__builtin_amdgcn_s_getreg((3 << 11) | 20) & 0xFu; }
#define XB_SPIN(cond, bar) do { unsigned _sp = 0; while (cond) { __builtin_amdgcn_s_sleep(1); \
    if ((++_sp & 255u) == 0u) { if (xb_ld(&(bar)[XB_TMO])) break; if (_sp > XB_SPIN_CAP) { atomicAdd(&(bar)[XB_TMO], 1u); break; } } } } while (0)
struct XcdBarrier { unsigned* bar; unsigned x; volatile LAS unsigned* st; };
__device__ __forceinline__ XcdBarrier xcd_barrier_post(unsigned* bar, volatile LAS unsigned* st) {
    XcdBarrier b; b.bar = bar; b.x = xb_xcc_id(); b.st = st;
    if (threadIdx.x == 0) (void)xb_add(&bar[XB_XCNT(b.x)], 1u);
    return b;
}
__device__ __forceinline__ void xcd_barrier_complete(unsigned* bar, unsigned x, unsigned& nloc, unsigned& nx) {
    const unsigned G = gridDim.x * gridDim.y * gridDim.z;
    unsigned sum, cnt, mine, sp = 0u;
    for (;;) {
        sum = 0u; cnt = 0u; mine = 0u;
#pragma unroll
        for (unsigned j = 0; j < 16; ++j) { const unsigned c = xb_ld(&bar[XB_XCNT(j)]); sum += c; cnt += (c > 0u) ? 1u : 0u; mine = (j == x) ? c : mine; }
        if (sum == G) break;
        __builtin_amdgcn_s_sleep(1);
        if ((++sp & 255u) == 0u) { if (xb_ld(&bar[XB_TMO])) break; if (sp > XB_SPIN_CAP) { atomicAdd(&bar[XB_TMO], 1u); break; } }
    }
    nloc = mine > 0u ? mine : 1u; nx = cnt > 0u ? cnt : 1u;
}
__device__ __forceinline__ void xcd_barrier(const XcdBarrier& b) {
    asm volatile("s_waitcnt vmcnt(0)" ::: "memory");
    __syncthreads();
    if (threadIdx.x == 0) {
        unsigned* bar = b.bar;
        __builtin_amdgcn_s_waitcnt(0);
        unsigned nloc = b.st[0], nx = b.st[1];
        if (nloc == 0u) { xcd_barrier_complete(bar, b.x, nloc, nx); b.st[0] = nloc; b.st[1] = nx; }
        const unsigned old = xb_add(&bar[XB_XSUB(b.x)], 1u);
        const unsigned gen = old / nloc;
        if (old + 1u == (gen + 1u) * nloc) {
            __builtin_amdgcn_fence(__ATOMIC_RELEASE, "agent");
            asm volatile("s_waitcnt vmcnt(0)" ::: "memory");
            const unsigned og = xb_add(&bar[XB_TOP], 1u);
            const unsigned tg = og / nx;
            if (og + 1u == (tg + 1u) * nx) xb_add(&bar[XB_TOPGEN], 1u);
            else XB_SPIN(xb_ld(&bar[XB_TOPGEN]) == tg, bar);
            __builtin_amdgcn_fence(__ATOMIC_ACQUIRE, "agent");
            xb_add(&bar[XB_XGEN(b.x)], 1u);
            asm volatile("s_waitcnt vmcnt(0)" ::: "memory");
        } else {
            XB_SPIN(xb_ld(&bar[XB_XGEN(b.x)]) == gen, bar);
            __builtin_amdgcn_fence(__ATOMIC_ACQUIRE, "agent");
            asm volatile("s_waitcnt vmcnt(0)" ::: "memory");
        }
    }
    __syncthreads();
}
#endif

DEVFN int tokmap(int dir, int p) { return dir == 0 ? p : (p < CTX_ ? CTX_ - 1 - p : 2 * CTX_ + SEQ_ - 1 - p); }
DEVFN const float* tok_input_row(const Params& p, int tok) {
  int b = tok / T_, t = tok % T_;
  return t < CTX_ ? INP(I_CTX) + ((size_t)b * CTX_ + t) * D_ : INP(I_X) + ((size_t)b * SEQ_ + (t - CTX_)) * D_;
}
DEVFN int tok_modrow(int tok) { return (tok % T_) < CTX_ ? B_ : tok / T_; }

template <class ARow, class BRow, class Epi>
DEVFN void gemm_tile(unsigned char* smem, int K, ARow arow, BRow brow, Epi epi) {
  bf16_t* As = (bf16_t*)smem;
  bf16_t* Bs = As + 128 * LDT;
  const int tid = TIDX, lane = tid & 63, wave = tid >> 6, wr = wave >> 1, wc = wave & 1;
  const int g = lane >> 4, l15 = lane & 15;
  const int lr = tid >> 3, lc = (tid & 7) * 8;
  const AS1 bf16_t* ap[4];
  const AS1 bf16_t* bp[4];
#pragma unroll
  for (int i = 0; i < 4; ++i) { ap[i] = gptr(arow(lr + 32 * i)); bp[i] = gptr(brow(lr + 32 * i)); }
  f32x4 acc[4][4];
#pragma unroll
  for (int mi = 0; mi < 4; ++mi)
#pragma unroll
    for (int ni = 0; ni < 4; ++ni) acc[mi][ni] = f32x4{0.f, 0.f, 0.f, 0.f};
  u32x4 ra0[4], rb0[4], ra1[4], rb1[4];
#pragma unroll
  for (int i = 0; i < 4; ++i) { ra0[i] = *(const AS1 u32x4*)(ap[i] + lc); rb0[i] = *(const AS1 u32x4*)(bp[i] + lc); }
  if (K > 64) {
#pragma unroll
    for (int i = 0; i < 4; ++i) { ra1[i] = *(const AS1 u32x4*)(ap[i] + 64 + lc); rb1[i] = *(const AS1 u32x4*)(bp[i] + 64 + lc); } }
  auto compute = [&]() {
#pragma unroll
    for (int kk = 0; kk < 2; ++kk) {
      bf16x8 af[4], bfr[4];
#pragma unroll
      for (int mi = 0; mi < 4; ++mi) af[mi] = *(const bf16x8*)(As + (wr * 64 + mi * 16 + l15) * LDT + kk * 32 + g * 8);
#pragma unroll
      for (int ni = 0; ni < 4; ++ni) bfr[ni] = *(const bf16x8*)(Bs + (wc * 64 + ni * 16 + l15) * LDT + kk * 32 + g * 8);
#pragma unroll
      for (int mi = 0; mi < 4; ++mi)
#pragma unroll
        for (int ni = 0; ni < 4; ++ni) acc[mi][ni] = MFMA16(af[mi], bfr[ni], acc[mi][ni]);
    } };
  for (int k0 = 0; k0 < K; k0 += 128) {
    __syncthreads();
#pragma unroll
    for (int i = 0; i < 4; ++i) { *(u32x4*)(As + (lr + 32 * i) * LDT + lc) = ra0[i]; *(u32x4*)(Bs + (lr + 32 * i) * LDT + lc) = rb0[i]; }
    __syncthreads();
    if (k0 + 128 < K) {
#pragma unroll
      for (int i = 0; i < 4; ++i) { ra0[i] = *(const AS1 u32x4*)(ap[i] + k0 + 128 + lc); rb0[i] = *(const AS1 u32x4*)(bp[i] + k0 + 128 + lc); } }
    compute();
    if (k0 + 64 < K) {
      __syncthreads();
#pragma unroll
      for (int i = 0; i < 4; ++i) { *(u32x4*)(As + (lr + 32 * i) * LDT + lc) = ra1[i]; *(u32x4*)(Bs + (lr + 32 * i) * LDT + lc) = rb1[i]; }
      __syncthreads();
      if (k0 + 192 < K) {
#pragma unroll
        for (int i = 0; i < 4; ++i) { ra1[i] = *(const AS1 u32x4*)(ap[i] + k0 + 192 + lc); rb1[i] = *(const AS1 u32x4*)(bp[i] + k0 + 192 + lc); } }
      compute();
    }
  }
  epi(acc, wr, wc, g, l15);
}

template <int NB, class ARow, class BRow, class Epi>
DEVFN void gemm_tile_multi(unsigned char* smem, int K, ARow arow, BRow brow, Epi epi) {
  bf16_t* As = (bf16_t*)smem;
  bf16_t* Bs = As + 128 * LDT;
  const int tid = TIDX, lane = tid & 63, wave = tid >> 6, wr = wave >> 1, wc = wave & 1;
  const int g = lane >> 4, l15 = lane & 15;
  const int lr = tid >> 3, lc = (tid & 7) * 8;
  const AS1 bf16_t* ap[4];
  const AS1 bf16_t* bp[4];
#pragma unroll
  for (int i = 0; i < 4; ++i) { ap[i] = gptr(arow(lr + 32 * i)); bp[i] = gptr(brow(lr + 32 * i, 0)); }
  f32x4 acc[4][4];
  u32x4 ra0[4], rb0[4], ra1[4], rb1[4];
#pragma unroll
  for (int i = 0; i < 4; ++i) { ra0[i] = *(const AS1 u32x4*)(ap[i] + lc); rb0[i] = *(const AS1 u32x4*)(bp[i] + lc); }
  if (K > 64) {
#pragma unroll
    for (int i = 0; i < 4; ++i) { ra1[i] = *(const AS1 u32x4*)(ap[i] + 64 + lc); rb1[i] = *(const AS1 u32x4*)(bp[i] + 64 + lc); } }
  auto compute = [&]() {
#pragma unroll
    for (int kk = 0; kk < 2; ++kk) {
      bf16x8 af[4], bfr[4];
#pragma unroll
      for (int mi = 0; mi < 4; ++mi) af[mi] = *(const bf16x8*)(As + (wr * 64 + mi * 16 + l15) * LDT + kk * 32 + g * 8);
#pragma unroll
      for (int ni = 0; ni < 4; ++ni) bfr[ni] = *(const bf16x8*)(Bs + (wc * 64 + ni * 16 + l15) * LDT + kk * 32 + g * 8);
#pragma unroll
      for (int mi = 0; mi < 4; ++mi)
#pragma unroll
        for (int ni = 0; ni < 4; ++ni) acc[mi][ni] = MFMA16(af[mi], bfr[ni], acc[mi][ni]);
    } };
#pragma unroll
  for (int j = 0; j < NB; ++j) {
#pragma unroll
  for (int mi = 0; mi < 4; ++mi)
#pragma unroll
    for (int ni = 0; ni < 4; ++ni) acc[mi][ni] = f32x4{0.f, 0.f, 0.f, 0.f};
  for (int k0 = 0; k0 < K; k0 += 128) {
    __syncthreads();
#pragma unroll
    for (int i = 0; i < 4; ++i) { *(u32x4*)(As + (lr + 32 * i) * LDT + lc) = ra0[i]; *(u32x4*)(Bs + (lr + 32 * i) * LDT + lc) = rb0[i]; }
    __syncthreads();
    if (k0 + 128 < K) {
#pragma unroll
      for (int i = 0; i < 4; ++i) { ra0[i] = *(const AS1 u32x4*)(ap[i] + k0 + 128 + lc); rb0[i] = *(const AS1 u32x4*)(bp[i] + k0 + 128 + lc); } }
    compute();
    if (k0 + 64 < K) {
      __syncthreads();
#pragma unroll
      for (int i = 0; i < 4; ++i) { *(u32x4*)(As + (lr + 32 * i) * LDT + lc) = ra1[i]; *(u32x4*)(Bs + (lr + 32 * i) * LDT + lc) = rb1[i]; }
      __syncthreads();
      if (k0 + 192 < K) {
#pragma unroll
        for (int i = 0; i < 4; ++i) { ra1[i] = *(const AS1 u32x4*)(ap[i] + k0 + 192 + lc); rb1[i] = *(const AS1 u32x4*)(bp[i] + k0 + 192 + lc); } }
      compute();
    }
  }
  if (j + 1 < NB) {
#pragma unroll
    for (int i = 0; i < 4; ++i) { bp[i] = gptr(brow(lr + 32 * i, j + 1)); ra0[i] = *(const AS1 u32x4*)(ap[i] + lc); rb0[i] = *(const AS1 u32x4*)(bp[i] + lc); } }
  epi(acc, j, wr, wc, g, l15);
  if (j + 1 < NB) {
#pragma unroll
    for (int i = 0; i < 4; ++i) { ra1[i] = *(const AS1 u32x4*)(ap[i] + 64 + lc); rb1[i] = *(const AS1 u32x4*)(bp[i] + 64 + lc); } }
  }
}

template <int NB, int LDB, class ARow, class BBase, class Epi>
DEVFN void gemm_tile_w(unsigned char* smem, int K, ARow arow, BBase bbase, Epi epi) {
  bf16_t* As = (bf16_t*)smem;
  bf16_t* Bs = As + 128 * LDT;
  const int tid = TIDX, lane = tid & 63, wave = tid >> 6, wr = wave >> 1, wc = wave & 1;
  const int g = lane >> 4, l15 = lane & 15;
  const int lr = tid >> 3, lc = (tid & 7) * 8;
  const AS1 bf16_t* ap[4];
#pragma unroll
  for (int i = 0; i < 4; ++i) ap[i] = gptr(arow(lr + 32 * i));
  const AS1 bf16_t* bb = gptr(bbase(0));
  const unsigned boff = (unsigned)(lr * LDB + lc);
  f32x4 acc[4][8];
  u32x4 ra[4], rb[8];
#pragma unroll
  for (int i = 0; i < 4; ++i) ra[i] = *(const AS1 u32x4*)(ap[i] + lc);
#pragma unroll
  for (int i = 0; i < 8; ++i) rb[i] = *(const AS1 u32x4*)(bb + (size_t)(i * 32 * LDB) + boff);
#pragma unroll
  for (int j = 0; j < NB; ++j) {
#pragma unroll
    for (int mi = 0; mi < 4; ++mi)
#pragma unroll
      for (int ni = 0; ni < 8; ++ni) acc[mi][ni] = f32x4{0.f, 0.f, 0.f, 0.f};
#pragma unroll 1
    for (int k0 = 0; k0 < K; k0 += 64) {
      __syncthreads();
#pragma unroll
      for (int i = 0; i < 4; ++i) *(u32x4*)(As + (lr + 32 * i) * LDT + lc) = ra[i];
#pragma unroll
      for (int i = 0; i < 8; ++i) *(u32x4*)(Bs + (lr + 32 * i) * LDT + lc) = rb[i];
      __syncthreads();
      if (k0 + 64 < K) {
#pragma unroll
        for (int i = 0; i < 4; ++i) ra[i] = *(const AS1 u32x4*)(ap[i] + k0 + 64 + lc);
#pragma unroll
        for (int i = 0; i < 8; ++i) rb[i] = *(const AS1 u32x4*)(bb + (size_t)(i * 32 * LDB + k0 + 64) + boff);
      }
#pragma unroll
      for (int kk = 0; kk < 2; ++kk) {
        bf16x8 af[4];
#pragma unroll
        for (int mi = 0; mi < 4; ++mi) af[mi] = *(const bf16x8*)(As + (wr * 64 + mi * 16 + l15) * LDT + kk * 32 + g * 8);
#pragma unroll
        for (int h = 0; h < 2; ++h) {
          bf16x8 bfr[4];
#pragma unroll
          for (int ni = 0; ni < 4; ++ni) bfr[ni] = *(const bf16x8*)(Bs + (wc * 128 + h * 64 + ni * 16 + l15) * LDT + kk * 32 + g * 8);
#pragma unroll
          for (int mi = 0; mi < 4; ++mi)
#pragma unroll
            for (int ni = 0; ni < 4; ++ni) acc[mi][h * 4 + ni] = MFMA16(af[mi], bfr[ni], acc[mi][h * 4 + ni]);
        }
      }
    }
    if (j + 1 < NB) {
      bb = gptr(bbase(j + 1));
#pragma unroll
      for (int i = 0; i < 4; ++i) ra[i] = *(const AS1 u32x4*)(ap[i] + lc);
#pragma unroll
      for (int i = 0; i < 8; ++i) rb[i] = *(const AS1 u32x4*)(bb + (size_t)(i * 32 * LDB) + boff); }
    epi(acc, j, wr, wc, g, l15);
  }
}

template <int NCH, class Val, class RowP>
DEVFN void tile_store_bf16(unsigned char* smem, int wr, int g, int l15, Val val, RowP rowp) {
  constexpr int LDC = NCH * 8 + 8;
  bf16_t* T = (bf16_t*)smem;
  const int tid = TIDX;
  __syncthreads();
  val(T, LDC);
  __syncthreads();
#pragma unroll
  for (int pass = 0; pass < NCH / 2; ++pass) { const int id = tid + 256 * pass, row = id / NCH, c = id % NCH;
    bf16_t* dst = rowp(row, c * 8);
    if (dst) *(AS1 u32x4*)gptr(dst) = *(const u32x4*)(T + row * LDC + c * 8); }
  (void)wr; (void)g; (void)l15;
}
DEVFN void cvt_tile(unsigned char* smem, const float* src, int K, int N, int k0, int n0, bf16_t* dst, int ldd, int mode) {
  float* s = (float*)smem;
  const int tid = TIDX;
  const AS1 float* gsrc = gptr(src);
  __syncthreads();
  { const int kk = tid >> 4, n4 = (tid & 15) * 4;
#pragma unroll
    for (int pass = 0; pass < 4; ++pass) { const int k = kk + 16 * pass;
      f32x4 v = f32x4{0.f, 0.f, 0.f, 0.f};
      if (n0 + n4 < N) v = *(const AS1 f32x4*)(gsrc + (size_t)(k0 + k) * N + n0 + n4);
      s[k * 65 + n4] = v[0]; s[k * 65 + n4 + 1] = v[1]; s[k * 65 + n4 + 2] = v[2]; s[k * 65 + n4 + 3] = v[3]; } }
  __syncthreads();
  { const int nn = tid >> 2, k16 = (tid & 3) * 16, n = n0 + nn;
    if (n < N) { const int row = mode == 0 ? n : ((n >> 4) * 32 + (n & 15) + (mode == 2 ? 16 : 0));
      u32x4 o0, o1;
#pragma unroll
      for (int j = 0; j < 4; ++j) { o0[j] = (unsigned)f2bf(s[(k16 + 2 * j) * 65 + nn]) | ((unsigned)f2bf(s[(k16 + 2 * j + 1) * 65 + nn]) << 16);
        o1[j] = (unsigned)f2bf(s[(k16 + 8 + 2 * j) * 65 + nn]) | ((unsigned)f2bf(s[(k16 + 9 + 2 * j) * 65 + nn]) << 16); }
      AS1 bf16_t* d = gptr(dst) + (size_t)row * ldd + k0 + k16;
      *(AS1 u32x4*)d = o0; *(AS1 u32x4*)(d + 8) = o1; } }
  (void)K;
}
struct CvtJob { const float* src; bf16_t* dst; int N, k0, n0, ldd, mode; };
DEVFN void cvt_load(const CvtJob& j, f32x4 (&v)[4]) {
  const int tid = TIDX, kk = tid >> 4, n4 = (tid & 15) * 4;
  const AS1 float* g = gptr(j.src);
#pragma unroll
  for (int pass = 0; pass < 4; ++pass) { v[pass] = f32x4{0.f, 0.f, 0.f, 0.f};
    if (j.n0 + n4 < j.N) v[pass] = *(const AS1 f32x4*)(g + (size_t)(j.k0 + kk + 16 * pass) * j.N + j.n0 + n4); }
}
DEVFN void cvt_store(unsigned char* smem, const CvtJob& j, const f32x4 (&v)[4]) {
  float* s = (float*)smem;
  const int tid = TIDX, kk = tid >> 4, n4 = (tid & 15) * 4;
  __syncthreads();
#pragma unroll
  for (int pass = 0; pass < 4; ++pass) { const int k = kk + 16 * pass; s[k * 65 + n4] = v[pass][0]; s[k * 65 + n4 + 1] = v[pass][1]; s[k * 65 + n4 + 2] = v[pass][2]; s[k * 65 + n4 + 3] = v[pass][3]; }
  __syncthreads();
  const int nn = tid >> 2, k16 = (tid & 3) * 16, n = j.n0 + nn;
  if (n < j.N) { const int row = j.mode == 0 ? n : ((n >> 4) * 32 + (n & 15) + (j.mode == 2 ? 16 : 0));
    u32x4 o0, o1;
#pragma unroll
    for (int q = 0; q < 4; ++q) { o0[q] = (unsigned)f2bf(s[(k16 + 2 * q) * 65 + nn]) | ((unsigned)f2bf(s[(k16 + 2 * q + 1) * 65 + nn]) << 16);
      o1[q] = (unsigned)f2bf(s[(k16 + 8 + 2 * q) * 65 + nn]) | ((unsigned)f2bf(s[(k16 + 9 + 2 * q) * 65 + nn]) << 16); }
    AS1 bf16_t* d = gptr(j.dst) + (size_t)row * j.ldd + j.k0 + k16;
    *(AS1 u32x4*)d = o0; *(AS1 u32x4*)(d + 8) = o1; }
}
DEVFN CvtJob moe_cvt_job(const Params& p, int l, int u) {
  bf16_t* w13 = (bf16_t*)(p.ws + Ws::W13); bf16_t* w2t = (bf16_t*)(p.ws + Ws::W2T);
  const int e = u / 192, r = u % 192, which = r / 64, t = r % 64;
  CvtJob j;
  if (which < 2) {
    j.src = e < 64 ? (which == 0 ? INP(I_EW1) : INP(I_EW3)) + ((size_t)l * 64 + e) * 1024 * 256 : (which == 0 ? INP(I_SW1) : INP(I_SW3)) + (size_t)l * 1024 * 256;
    j.N = 256; j.k0 = (t >> 2) * 64; j.n0 = (t & 3) * 64; j.dst = w13 + (size_t)e * 512 * 1024; j.ldd = 1024; j.mode = which == 0 ? 1 : 2;
  } else {
    j.src = e < 64 ? INP(I_EW2) + ((size_t)l * 64 + e) * 256 * 1024 : INP(I_SW2) + (size_t)l * 256 * 1024;
    j.N = 1024; j.k0 = (t >> 4) * 64; j.n0 = (t & 15) * 64; j.dst = w2t + (size_t)e * 1024 * 256; j.ldd = 256; j.mode = 0;
  }
  return j;
}
DEVFN void convert_moe_weights(const Params& p, int l, unsigned char* smem, int bid, int nb) {
  const int total = 65 * 192;
  if (bid >= total) return;
  f32x4 v[4], vn[4];
  CvtJob j = moe_cvt_job(p, l, bid);
  cvt_load(j, v);
  for (int u = bid; u < total; u += nb) {
    const int un = u + nb;
    CvtJob jn = j;
    if (un < total) { jn = moe_cvt_job(p, l, un); cvt_load(jn, vn); }
    cvt_store(smem, j, v);
    j = jn;
#pragma unroll
    for (int q = 0; q < 4; ++q) v[q] = vn[q];
  }
}
DEVFN void phase0(const Params& p, unsigned char* smem) {
  const int tid = TIDX;
  float* modp = (float*)(p.ws + Ws::MODP);
  for (int u = BIDX; u < DEPTH_ * 24 * 16; u += gridDim.x) {
    int l = u / (24 * 16), jb = (u / 16) % 24, ks = u % 16;
    float* sc = (float*)smem;
    __syncthreads();
    for (int e = tid; e < NR_ * 64; e += 256) { int r = e / 64, i = ks * 64 + (e % 64); float cv = r < B_ ? INP(I_C)[(size_t)r * D_ + i] : INP(I_CCTX)[i]; sc[e] = siluf_(cv); }
    __syncthreads();
    int j = jb * 256 + tid;
    float acc[NR_];
#pragma unroll
    for (int r = 0; r < NR_; ++r) acc[r] = 0.f;
    const float* w = INP(I_ADAW) + ((size_t)l * D_ + ks * 64) * NMOD_ + j;
#pragma unroll 4
    for (int i = 0; i < 64; ++i) { float wv = w[(size_t)i * NMOD_];
#pragma unroll
      for (int r = 0; r < NR_; ++r) acc[r] += sc[r * 64 + i] * wv; }
#pragma unroll
    for (int r = 0; r < NR_; ++r) modp[(((size_t)ks * DEPTH_ + l) * NR_ + r) * NMOD_ + j] = acc[r];
  }
  bf16_t* win = (bf16_t*)(p.ws + Ws::WIN);
  bf16_t* wout = (bf16_t*)(p.ws + Ws::WOUT);
  for (int u = BIDX; u < DEPTH_ * 16 * 55; u += gridDim.x) {
    int l = u / (16 * 55), r = u % (16 * 55);
    cvt_tile(smem, INP(I_WIN) + (size_t)l * 1024 * NIN_, 1024, NIN_, (r / 55) * 64, (r % 55) * 64, win + (size_t)l * NIN_ * 1024, 1024, 0);
  }
  for (int u = BIDX; u < DEPTH_ * 256; u += gridDim.x) {
    int l = u / 256, r = u % 256;
    cvt_tile(smem, INP(I_WOUT) + (size_t)l * 1024 * 1024, 1024, 1024, (r / 16) * 64, (r % 16) * 64, wout + (size_t)l * 1024 * 1024, 1024, 0);
  }
  { bf16_t* lo = (bf16_t*)(p.ws + Ws::LORA);
    for (int u = BIDX * 256 + tid; u < DEPTH_ * 98304; u += gridDim.x * 256) {
      const int l = u / 98304, r = u % 98304; float v;
      if (r < 32768) { const int d = r >> 14, n = (r >> 6) & 255, k = r & 63; v = INP(I_W2)[(((size_t)l * 2 + d) * 64 + k) * 256 + n]; }
      else if (r < 65536) { const int r2 = r - 32768, d = r2 >> 14, n = (r2 >> 6) & 255, k = r2 & 63; v = INP(I_A2)[(((size_t)l * 2 + d) * 64 + k) * 256 + n]; }
      else { const int r2 = r - 65536, n = r2 >> 7, k = r2 & 127; v = INP(I_G2)[((size_t)l * 128 + k) * 256 + n]; }
      lo[u] = f2bf(v); } }
  float* rwt = (float*)(p.ws + Ws::RWT);
  for (int u = BIDX * 256 + tid; u < DEPTH_ * 64 * 1024; u += gridDim.x * 256) {
    int l = u / (64 * 1024), e = (u / 1024) % 64, i = u % 1024;
    rwt[u] = INP(I_RW)[((size_t)l * 1024 + i) * 64 + e];
  }
}

DEVFN void phase0b(const Params& p) {
  float* mod = (float*)(p.ws + Ws::MOD); const float* modp = (const float*)(p.ws + Ws::MODP);
  for (int u = BIDX * 256 + TIDX; u < DEPTH_ * NR_ * NMOD_; u += gridDim.x * 256) {
    int l = u / (NR_ * NMOD_), j = u % NMOD_;
    float s = INP(I_ADAB)[(size_t)l * NMOD_ + j];
    for (int ks = 0; ks < 16; ++ks) s += modp[(size_t)ks * DEPTH_ * NR_ * NMOD_ + u];
    mod[u] = s;
  }
}

DEVFN void row_stats(const float (&v)[16], float& mean, float& rstd) {
  float s = 0.f;
#pragma unroll
  for (int i = 0; i < 16; ++i) s += v[i];
  mean = wave_sum(s) * (1.f / 1024.f);
  float q = 0.f;
#pragma unroll
  for (int i = 0; i < 16; ++i) { float d = v[i] - mean; q += d * d; }
  rstd = rsqrtf(wave_sum(q) * (1.f / 1024.f) + 1e-5f);
}
DEVFN void load_row16(const float* row, int lane, float (&v)[16]) {
  const AS1 float* r = gptr(row);
#pragma unroll
  for (int j = 0; j < 4; ++j) { const f32x4 t = *(const AS1 f32x4*)(r + lane * 4 + 256 * j); v[4 * j] = t[0]; v[4 * j + 1] = t[1]; v[4 * j + 2] = t[2]; v[4 * j + 3] = t[3]; }
}
DEVFN void moe_residual_row(const Params& p, int lp, int tok, int lane, float (&xv)[16]) {
  const float* mod = (const float*)(p.ws + Ws::MOD) + ((size_t)lp * NR_ + tok_modrow(tok)) * NMOD_;
  const bf16_t* yb = (const bf16_t*)(p.ws + Ws::YBUF) + (size_t)tok * NSLOT * 1024;
  float g2[16], w[16], b[16];
  load_row16(mod + 5 * 1024, lane, g2);
  load_row16(INP(I_LN2W) + (size_t)lp * 1024, lane, w);
  load_row16(INP(I_LN2B) + (size_t)lp * 1024, lane, b);
  u32x2 sl[NSLOT][4];
#pragma unroll
  for (int s = 0; s < NSLOT; ++s)
#pragma unroll
    for (int j = 0; j < 4; ++j) sl[s][j] = *(const AS1 u32x2*)gptr(yb + (size_t)s * 1024 + lane * 4 + 256 * j);
  float f[16];
#pragma unroll
  for (int i = 0; i < 16; ++i) f[i] = 0.f;
#pragma unroll
  for (int s = 0; s < NSLOT; ++s)
#pragma unroll
    for (int j = 0; j < 4; ++j) { const u32x2 t = sl[s][j];
      f[4 * j] += bf2f((bf16_t)(t[0] & 0xFFFF)); f[4 * j + 1] += bf2f((bf16_t)(t[0] >> 16)); f[4 * j + 2] += bf2f((bf16_t)(t[1] & 0xFFFF)); f[4 * j + 3] += bf2f((bf16_t)(t[1] >> 16)); }
#pragma unroll
  for (int i = 0; i < 16; ++i) xv[i] = ALPHA_ * xv[i] + g2[i] * f[i];
  float mean, rstd;
  row_stats(xv, mean, rstd);
#pragma unroll
  for (int i = 0; i < 16; ++i) xv[i] = (xv[i] - mean) * rstd * w[i] + b[i];
}
DEVFN void phase1(const Params& p, int l) {
  const int lane = TIDX & 63, wave = TIDX >> 6;
  float* X = (float*)(p.ws + Ws::X);
  bf16_t* U = (bf16_t*)(p.ws + Ws::U);
  for (int tok = BIDX * 4 + wave; tok < NT_; tok += gridDim.x * 4) {
    float xv[16], sh[16], sc[16], mean, rstd;
    const float* mod = (const float*)(p.ws + Ws::MOD) + ((size_t)l * NR_ + tok_modrow(tok)) * NMOD_;
    load_row16(mod, lane, sh);
    load_row16(mod + 1024, lane, sc);
    if (l == 0) load_row16(tok_input_row(p, tok), lane, xv);
    else { load_row16(X + (size_t)tok * 1024, lane, xv); moe_residual_row(p, l - 1, tok, lane, xv); }
#pragma unroll
    for (int j = 0; j < 4; ++j) *(float4*)(X + (size_t)tok * 1024 + lane * 4 + 256 * j) = make_float4(xv[4 * j], xv[4 * j + 1], xv[4 * j + 2], xv[4 * j + 3]);
    row_stats(xv, mean, rstd);
#pragma unroll
    for (int j = 0; j < 4; ++j) {
      float u0 = (xv[4 * j] - mean) * rstd * (1.f + sc[4 * j]) + sh[4 * j], u1 = (xv[4 * j + 1] - mean) * rstd * (1.f + sc[4 * j + 1]) + sh[4 * j + 1];
      float u2 = (xv[4 * j + 2] - mean) * rstd * (1.f + sc[4 * j + 2]) + sh[4 * j + 2], u3 = (xv[4 * j + 3] - mean) * rstd * (1.f + sc[4 * j + 3]) + sh[4 * j + 3];
      *(uint2*)(U + (size_t)tok * 1024 + lane * 4 + 256 * j) = make_uint2((unsigned)f2bf(u0) | ((unsigned)f2bf(u1) << 16), (unsigned)f2bf(u2) | ((unsigned)f2bf(u3) << 16));
    }
  }
}
DEVFN void phase_final(const Params& p) {
  const int lane = TIDX & 63, wave = TIDX >> 6;
  const float* X = (const float*)(p.ws + Ws::X);
  for (int r = BIDX * 4 + wave; r < B_ * SEQ_; r += gridDim.x * 4) {
    int b = r / SEQ_, s = r % SEQ_, tok = b * T_ + CTX_ + s;
    float xv[16];
    load_row16(X + (size_t)tok * 1024, lane, xv);
    moe_residual_row(p, DEPTH_ - 1, tok, lane, xv);
#pragma unroll
    for (int j = 0; j < 4; ++j) *(float4*)(p.out + (size_t)r * 1024 + lane * 4 + 256 * j) = make_float4(xv[4 * j], xv[4 * j + 1], xv[4 * j + 2], xv[4 * j + 3]);
  }
}

DEVFN void phase2(const Params& p, int l, unsigned char* smem) {
  const bf16_t* U = (const bf16_t*)(p.ws + Ws::U);
  const bf16_t* W = (const bf16_t*)(p.ws + Ws::WIN) + (size_t)l * NIN_ * 1024;
  bf16_t* ZX = (bf16_t*)(p.ws + Ws::ZX);
  const int nct = (NIN_ + 255) / 256;
  for (int u = BIDX; u < (NT_ / 128) * nct; u += gridDim.x) {
    int rt = u / nct, ct = u % nct;
    gemm_tile_w<1, 1024>(smem, 1024,
      [&](int r) { return U + (size_t)(rt * 128 + r) * 1024; },
      [&](int) { return W + (size_t)(ct * 256) * 1024; },
      [&](f32x4 (&acc)[4][8], int, int wr, int wc, int g, int l15) {
#pragma unroll 1
        for (int h = 0; h < 2; ++h)
          tile_store_bf16<16>(smem, wr, g, l15,
            [&](bf16_t* T, int ldc) {
              if (wc == h) {
#pragma unroll
                for (int mi = 0; mi < 4; ++mi)
#pragma unroll
                  for (int ni = 0; ni < 8; ++ni)
#pragma unroll
                    for (int i = 0; i < 4; ++i) T[(wr * 64 + mi * 16 + 4 * g + i) * ldc + ni * 16 + l15] = f2bf(acc[mi][ni][i]); } },
            [&](int row, int c0) { const int col = ct * 256 + h * 128 + c0; return col < NIN_ ? ZX + (size_t)(rt * 128 + row) * NIN_ + col : (bf16_t*)nullptr; });
      });
  }
}

DEVFN float zxv(const bf16_t* ZX, int tok, int col) { return bf2f(gptr(ZX)[(size_t)tok * NIN_ + col]); }
struct Nbr { int n; int tok[4]; };
DEVFN Nbr shift_nbrs(int tok) {
  Nbr nb; int b = tok / T_, t = tok % T_;
  if (t < CTX_) { nb.n = 2; nb.tok[0] = t > 0 ? tok - 1 : -1; nb.tok[1] = t < CTX_ - 1 ? tok + 1 : -1; nb.tok[2] = -1; nb.tok[3] = -1; }
  else { int s = t - CTX_, row = s / 64, col = s % 64; nb.n = 4; nb.tok[0] = col > 0 ? tok - 1 : -1; nb.tok[1] = col < 63 ? tok + 1 : -1;
    nb.tok[2] = row > 0 ? tok - 64 : -1; nb.tok[3] = row < SEQ_ / 64 - 1 ? tok + 64 : -1; }
  (void)b; return nb;
}
DEVFN float shiftmix(const bf16_t* ZX, const float* mu, int tok, const Nbr& nb, int ch) {
  float z = zxv(ZX, tok, ORW + ch), o = z;
#pragma unroll
  for (int j = 0; j < 4; ++j) if (j < nb.n) { float v = nb.tok[j] >= 0 ? zxv(ZX, nb.tok[j], ORW + ch) : 0.f; o += mu[j * 1152 + ch] * (v - z); }
  return o;
}
#define LI_LD 392
#define KL_LD 264
DEVFN void phase3(const Params& p, int l, unsigned char* smem) {
  const int tid = TIDX, lane = tid & 63, wave = tid >> 6, q = lane >> 4, l15 = lane & 15;
  const bf16_t* ZX = (const bf16_t*)(p.ws + Ws::ZX);
  bf16_t* XBC = (bf16_t*)(p.ws + Ws::XBC); float* DTB = (float*)(p.ws + Ws::DTB);
  bf16_t* RR = (bf16_t*)(p.ws + Ws::RR); bf16_t* VV = (bf16_t*)(p.ws + Ws::VV); bf16_t* KKb = (bf16_t*)(p.ws + Ws::KK);
  bf16_t* KRW = (bf16_t*)(p.ws + Ws::KRW); bf16_t* LIg = (bf16_t*)(p.ws + Ws::LI);
  float* LA = (float*)(p.ws + Ws::LA);
  const float* convw = INP(I_CONVW) + (size_t)l * 3 * 1024; const float* convb = INP(I_CONVB) + (size_t)l * 1024;
  const float* mu = INP(I_MU) + (size_t)l * 4 * 1152;
  float* gdl = (float*)smem;
  const float kkw = INP(I_KKW)[(size_t)l * 256 + tid];
  for (int wu = BIDX; wu < 2 * (NT_ / 16); wu += gridDim.x) {
    const int tile = wu >> 1, part = wu & 1;
    const int tok0 = tile * 16, t0 = tok0 % T_, bb = tok0 / T_;
    const bool isctx = t0 < CTX_;
    const int s0 = t0 - CTX_;
    const bool lval = isctx ? (t0 > 0) : ((s0 & 63) != 0), rval = isctx ? (t0 + 16 < CTX_) : ((s0 & 63) != 48);
    const bool uval = !isctx && (s0 >= 64), dval = !isctx && (s0 + 64 < SEQ_);
    if (part == 0) {
    __syncthreads();
    {
      const bool segstart = (t0 == 0 || t0 == CTX_), segend = (t0 + 16 == CTX_ || t0 + 16 == T_);
      bf16_t* XBCT = (bf16_t*)(p.ws + Ws::XBCT) + ((size_t)(bb * NC128 + t0 / 128) * 768) * 128 + (t0 % 128);
#pragma unroll 1
      for (int j = 0; j < 4; ++j) { const int c = tid + 256 * j;
        const AS1 bf16_t* zp = gptr(ZX) + (size_t)tok0 * NIN_ + OXBC + c - NIN_; AS1 bf16_t* xp = gptr(XBC) + (size_t)tok0 * 1024 + c;
        float z[18];
#pragma unroll
        for (int i = 0; i < 18; ++i) { z[i] = ((i == 0 && segstart) || (i == 17 && segend)) ? 0.f : bf2f(*zp); zp += NIN_; LAUNDER_V(zp); }
        const float w0 = convw[c], w1 = convw[1024 + c], w2 = convw[2048 + c], cb = convb[c];
        bf16_t y[16];
#pragma unroll
        for (int i = 0; i < 16; ++i) { y[i] = f2bf(siluf_(cb + w0 * z[i] + w1 * z[i + 1] + w2 * z[i + 2])); *xp = y[i]; xp += 1024; LAUNDER_V(xp); }
        if (c < 768) {
          u32x4 o0, o1;
#pragma unroll
          for (int i = 0; i < 4; ++i) { o0[i] = (unsigned)y[2 * i] | ((unsigned)y[2 * i + 1] << 16); o1[i] = (unsigned)y[8 + 2 * i] | ((unsigned)y[9 + 2 * i] << 16); }
          *(u32x4*)(XBCT + (size_t)c * 128) = o0; *(u32x4*)(XBCT + (size_t)c * 128 + 8) = o1; } }
      { bf16_t* VTp = (bf16_t*)(p.ws + Ws::VT) + ((size_t)(bb * NC64 + t0 / 64) * 256 + tid) * 64 + (t0 % 64);
        const AS1 bf16_t* vp = gptr(ZX) + (size_t)tok0 * NIN_ + OGV + tid;
        u32x4 o0, o1;
        bf16_t vv16[16];
#pragma unroll
        for (int i = 0; i < 16; ++i) { vv16[i] = *vp; vp += NIN_; LAUNDER_V(vp); }
#pragma unroll
        for (int i = 0; i < 4; ++i) { o0[i] = (unsigned)vv16[2 * i] | ((unsigned)vv16[2 * i + 1] << 16); o1[i] = (unsigned)vv16[8 + 2 * i] | ((unsigned)vv16[9 + 2 * i] << 16); }
        *(u32x4*)VTp = o0; *(u32x4*)(VTp + 8) = o1; }
      DTB[(size_t)tok0 * 16 + tid] = softplusf_(zxv(ZX, tok0 + (tid >> 4), ODT + (tid & 15)) + INP(I_DTBIAS)[(size_t)l * 16 + (tid & 15)]);
      gdl[tid] = zxv(ZX, tok0 + (tid >> 5), OGD + (tid & 31)); gdl[256 + tid] = zxv(ZX, tok0 + 8 + (tid >> 5), OGD + (tid & 31));
    }
    } else {
#pragma unroll 1
    for (int g = 0; g < 5; ++g) {
      const bool act = !(g == 4 && tid >= 128);
      const int ch = act ? g * 256 + tid : 0;
      const AS1 bf16_t* zp0 = gptr(ZX) + (size_t)tok0 * NIN_ + ORW + ch;
      const AS1 bf16_t* zp = zp0 - NIN_;
      const float m0 = mu[ch], m1 = mu[1152 + ch], m2 = mu[2304 + ch], m3 = mu[3456 + ch];
      float z[18], o[16];
#pragma unroll
      for (int i = 0; i < 18; ++i) { z[i] = ((i == 0 && !lval) || (i == 17 && !rval)) ? 0.f : bf2f(*zp); zp += NIN_; LAUNDER_V(zp); }
#pragma unroll
      for (int i = 0; i < 16; ++i) o[i] = z[i + 1] + m0 * (z[i] - z[i + 1]) + m1 * (z[i + 2] - z[i + 1]);
      if (!isctx) {
        const AS1 bf16_t* up = zp0 - (size_t)64 * NIN_; const AS1 bf16_t* dn = zp0 + (size_t)64 * NIN_;
#pragma unroll
        for (int i = 0; i < 16; ++i) { const float zu = uval ? bf2f(*up) : 0.f, zd = dval ? bf2f(*dn) : 0.f; up += NIN_; dn += NIN_; LAUNDER_V(up); LAUNDER_V(dn);
          o[i] += m2 * (zu - z[i + 1]) + m3 * (zd - z[i + 1]); } }
      if (g == 0) { AS1 bf16_t* rp = gptr(RR) + (size_t)tok0 * 256 + tid;
#pragma unroll
        for (int i = 0; i < 16; ++i) { *rp = f2bf(o[i]); rp += 256; LAUNDER_V(rp); }
      } else if (g == 1) { AS1 bf16_t* kp = gptr(KKb) + (size_t)tok0 * 256 + tid; AS1 bf16_t* krp = gptr(KRW) + (size_t)tok0 * 256 + tid;
#pragma unroll
        for (int i = 0; i < 16; ++i) { const float kq = o[i] * kkw, nrm = sqrtf(wave_sum(kq * kq));
          *kp = f2bf(kq / fmaxf(nrm, 1e-12f)); *krp = f2bf(o[i]); kp += 256; krp += 256; LAUNDER_V(kp); LAUNDER_V(krp); }
      } else if (g == 2) { AS1 bf16_t* vp2 = gptr(VV) + (size_t)tok0 * 256 + tid;
#pragma unroll
        for (int i = 0; i < 16; ++i) { *vp2 = f2bf(o[i]); vp2 += 256; LAUNDER_V(vp2); }
      } else if (g == 3) { AS1 bf16_t* lp = gptr(LIg) + (size_t)tok0 * 384 + tid;
#pragma unroll
        for (int i = 0; i < 16; ++i) { *lp = f2bf(tid < 128 ? tanhf(o[i]) : o[i]); lp += 384; LAUNDER_V(lp); }
      } else if (act) { AS1 bf16_t* lp = gptr(LIg) + (size_t)tok0 * 384 + 256 + tid;
#pragma unroll
        for (int i = 0; i < 16; ++i) { *lp = f2bf(sigmoidf_(o[i])); lp += 384; LAUNDER_V(lp); }
      }
    }
    }
    if (part == 0) {
    __syncthreads();
    { const int d = tid >> 7, c = tid & 127; const float* gu = INP(I_GU) + ((size_t)l * 2 + d) * 16 * 128; const float gb = INP(I_GB)[((size_t)l * 2 + d) * 128 + c];
      float guw[16];
#pragma unroll
      for (int i = 0; i < 16; ++i) guw[i] = gu[i * 128 + c];
#pragma unroll 4
      for (int tt = 0; tt < 16; ++tt) { float sacc = gb;
#pragma unroll
        for (int i = 0; i < 16; ++i) sacc += gdl[tt * 32 + d * 16 + i] * guw[i];
        LA[((size_t)d * NT_ + tok0 + tt) * 128 + c] = logsigmoidf_(sacc) * (1.f / 16.f); } }
    }
  }
}

DEVFN void phase3b(const Params& p, int l, unsigned char* smem) {
  const bf16_t* LIg = (const bf16_t*)(p.ws + Ws::LI);
  const bf16_t* lora = (const bf16_t*)(p.ws + Ws::LORA) + (size_t)l * 98304;
  const bf16_t* KRg = (const bf16_t*)(p.ws + Ws::KRW); const bf16_t* KKg = (const bf16_t*)(p.ws + Ws::KK);
  float* LWp = (float*)(p.ws + Ws::LW); bf16_t* KD = (bf16_t*)(p.ws + Ws::KD); bf16_t* BD = (bf16_t*)(p.ws + Ws::BD); float* GATE = (float*)(p.ws + Ws::GATE);
  for (int u = BIDX; u < (NT_ / 128) * 10; u += gridDim.x) {
    const int rt = u / 10, which = (u % 10) >> 1, ct = u & 1;
    const int K = which < 4 ? 64 : 128, acol = which < 4 ? which * 64 : 256;
    const bf16_t* wb = which < 2 ? lora + (size_t)which * 16384 : which < 4 ? lora + 32768 + (size_t)(which - 2) * 16384 : lora + 65536;
    const float* bias = which < 2 ? INP(I_W0) + (size_t)l * 512 + which * 256 : INP(I_A0) + (size_t)l * 512 + (which & 1) * 256;
    const float* kav = INP(I_KAW) + (size_t)l * 256;
    gemm_tile(smem, K,
      [&](int r) { return LIg + (size_t)(rt * 128 + r) * 384 + acol; },
      [&](int r) { return wb + (size_t)(ct * 128 + r) * K; },
      [&](f32x4 (&acc)[4][4], int wr, int wc, int g, int l15) {
        const int tid = TIDX;
        if (which == 2 || which == 3) {
          bf16_t* T = (bf16_t*)smem; constexpr int LDC = 136;
          __syncthreads();
#pragma unroll
          for (int ni = 0; ni < 4; ++ni) { const int cl = wc * 64 + ni * 16 + l15; const float bv = bias[ct * 128 + cl];
#pragma unroll
            for (int mi = 0; mi < 4; ++mi)
#pragma unroll
              for (int i = 0; i < 4; ++i) T[(wr * 64 + mi * 16 + 4 * g + i) * LDC + cl] = f2bf(sigmoidf_(acc[mi][ni][i] + bv)); }
          __syncthreads();
          const int c = tid & 15, col0 = ct * 128 + c * 8;
          float ka[8];
#pragma unroll
          for (int j = 0; j < 8; ++j) ka[j] = kav[col0 + j];
          const size_t dofs = (size_t)(which - 2) * NT_ * 256;
#pragma unroll
          for (int pass = 0; pass < 8; ++pass) { const int row = (tid >> 4) + 16 * pass; const size_t o = (size_t)(rt * 128 + row) * 256 + col0;
            const bf16x8 a8 = *(const bf16x8*)(T + row * LDC + c * 8), kr8 = ld8g(KRg + o), kk8 = ld8g(KKg + o);
            bf16x8 kd8, bd8;
#pragma unroll
            for (int j = 0; j < 8; ++j) { const float a = bf2f((bf16_t)a8[j]); kd8[j] = (short)f2bf(bf2f((bf16_t)kr8[j]) * (1.f + (a - 1.f) * ka[j])); bd8[j] = (short)f2bf(bf2f((bf16_t)kk8[j]) * a); }
            *(AS1 bf16x8*)gptr(KD + dofs + o) = kd8; *(AS1 bf16x8*)gptr(BD + dofs + o) = bd8; }
        } else {
          float* T = (float*)smem; constexpr int LDC = 132;
          float* dst = which < 2 ? LWp + (size_t)which * NT_ * 256 : GATE;
#pragma unroll 1
          for (int h = 0; h < 2; ++h) {
            __syncthreads();
            if (wr == h) {
#pragma unroll
              for (int ni = 0; ni < 4; ++ni) { const int cl = wc * 64 + ni * 16 + l15; const float bv = which < 2 ? bias[ct * 128 + cl] : 0.f;
#pragma unroll
                for (int mi = 0; mi < 4; ++mi)
#pragma unroll
                  for (int i = 0; i < 4; ++i) { const float v = acc[mi][ni][i]; T[(mi * 16 + 4 * g + i) * LDC + cl] = which < 2 ? -0.6065306597126334f * sigmoidf_(v + bv) : v; } } }
            __syncthreads();
#pragma unroll
            for (int pass = 0; pass < 8; ++pass) { const int id = tid + 256 * pass, row = id >> 5, c = id & 31;
              *(AS1 f32x4*)gptr(dst + (size_t)(rt * 128 + h * 64 + row) * 256 + ct * 128 + c * 4) = *(const f32x4*)(T + row * LDC + c * 4); } }
        }
      });
  }
}

DEVFN bf16x8 ld8(const bf16_t* p) { return *(const bf16x8*)p; }
typedef short bf16x4v __attribute__((ext_vector_type(4)));
DEVFN bf16x4v cvt4(f32x4 v) { return bf16x4v{(short)f2bf(v[0]), (short)f2bf(v[1]), (short)f2bf(v[2]), (short)f2bf(v[3])}; }
DEVFN bf16x8 cat44(bf16x4v a, bf16x4v b) { return bf16x8{a[0], a[1], a[2], a[3], b[0], b[1], b[2], b[3]}; }
DEVFN bf16x4v ld4(const bf16_t* p) { return *(const bf16x4v*)p; }
DEVFN int rm_off(int i, int k) { return i * 64 + ((((k >> 3) ^ (i & 7)) << 3) | (k & 7)); }
#define RW_WAVE_LDS 11264
DEVFN void rwkv_chunk(const Params& p, int unit_base, unsigned char* smem) {
  const int tid = TIDX, lane = tid & 63, wave = tid >> 6, q = lane >> 4, l15 = lane & 15;
  const int unit = unit_base + wave;
  const int c = unit % NC16, h = (unit / NC16) & 3, dir = (unit / (NC16 * 4)) & 1, b = unit / (NC16 * 8);
  bf16_t* big = (bf16_t*)(smem + wave * RW_WAVE_LDS);
  unsigned char* small = smem + wave * RW_WAVE_LDS + 8192;
  float* AbF = (float*)small;
  bf16_t* TN = (bf16_t*)(small + 1024);
  bf16_t* AK = TN + 256; bf16_t* RB = AK + 256; bf16_t* RK = RB + 256;
  const bf16_t* RRg = (const bf16_t*)(p.ws + Ws::RR); const bf16_t* VVg = (const bf16_t*)(p.ws + Ws::VV); const bf16_t* KKg = (const bf16_t*)(p.ws + Ws::KK);
  const bf16_t* KDg = (const bf16_t*)(p.ws + Ws::KD) + (size_t)dir * NT_ * 256; const bf16_t* BDg = (const bf16_t*)(p.ws + Ws::BD) + (size_t)dir * NT_ * 256;
  const float* LWg = (const float*)(p.ws + Ws::LW) + (size_t)dir * NT_ * 256;
  float kkm[16], vv[16], bneg[16], kneg[16];
  float run = 0.f;
  __syncthreads();
#pragma unroll
  for (int i = 0; i < 16; ++i) {
    const size_t o = (size_t)(b * T_ + tokmap(dir, c * 16 + i)) * 256 + h * 64 + lane;
    const float lw = gptr(LWg)[o], r = bf2f(gptr(RRg)[o]), k = bf2f(gptr(KDg)[o]), v = bf2f(gptr(VVg)[o]), kk = bf2f(gptr(KKg)[o]), bb = bf2f(gptr(BDg)[o]);
    const float e_ex = expf(run); run += lw; const float e_in = expf(run), e_neg = expf(-run);
    kkm[i] = kk * e_ex; vv[i] = v; bneg[i] = bb * e_neg; kneg[i] = k * e_neg;
    big[rm_off(i, lane)] = f2bf(kkm[i]); big[1024 + rm_off(i, lane)] = f2bf(r * e_in);
    big[2048 + rm_off(i, lane)] = f2bf(bneg[i]); big[3072 + rm_off(i, lane)] = f2bf(kneg[i]);
  }
  const float WC = expf(run);
  __syncthreads();
  f32x4 ab = f32x4{0.f, 0.f, 0.f, 0.f}, ak = ab, rb = ab, rk = ab;
#pragma unroll
  for (int s2 = 0; s2 < 2; ++s2) { const int ch = ((4 * s2 + q) ^ (l15 & 7)) << 3;
    const bf16x8 a_kk = ld8(big + l15 * 64 + ch), a_r = ld8(big + 1024 + l15 * 64 + ch), b_b = ld8(big + 2048 + l15 * 64 + ch), b_k = ld8(big + 3072 + l15 * 64 + ch);
    ab = MFMA16(a_kk, b_b, ab); ak = MFMA16(a_kk, b_k, ak); rb = MFMA16(a_r, b_b, rb); rk = MFMA16(a_r, b_k, rk); }
  f32x4 gacc[4];
#pragma unroll
  for (int nk = 0; nk < 4; ++nk)
#pragma unroll
    for (int r = 0; r < 4; ++r) gacc[nk][r] = bf2f(big[1024 + rm_off(4 * q + r, 16 * nk + l15)]);
  __syncthreads();
#pragma unroll
  for (int r = 0; r < 4; ++r) { const int i = 4 * q + r, j = l15;
    AbF[i * 16 + j] = j < i ? ab[r] : 0.f; AK[i * 16 + j] = f2bf(j < i ? ak[r] : 0.f);
    RB[i * 16 + j] = f2bf(j <= i ? rb[r] : 0.f); RK[i * 16 + j] = f2bf(j <= i ? rk[r] : 0.f); }
  { bf16_t* KKMT = big; bf16_t* VTT = big + 1024; bf16_t* BHT = big + 2048; bf16_t* KHT = big + 3072;
#pragma unroll
    for (int i = 0; i < 16; ++i) { KKMT[lane * 16 + i] = f2bf(kkm[i]); VTT[lane * 16 + i] = f2bf(vv[i]); BHT[lane * 16 + i] = f2bf(bneg[i] * WC); KHT[lane * 16 + i] = f2bf(kneg[i] * WC); } }
  __syncthreads();
  { float t[16];
#pragma unroll
    for (int i = 0; i < 16; ++i) { float acc = (i == l15) ? 1.f : 0.f;
#pragma unroll
      for (int j = 0; j < i; ++j) acc -= AbF[i * 16 + j] * t[j];
      t[i] = acc; }
    if (q == 0) {
#pragma unroll
      for (int i = 0; i < 16; ++i) TN[i * 16 + l15] = f2bf(-t[i]); } }
  __syncthreads();
  const size_t ci = (size_t)((b * 2 + dir) * 4 + h) * NC16 + c;
  bf16_t* MLg = (bf16_t*)(p.ws + Ws::RML) + ci * 4096; bf16_t* Ng = (bf16_t*)(p.ws + Ws::RNS) + ci * 4096;
  bf16_t* Gg = (bf16_t*)(p.ws + Ws::RG) + ci * 1024; float* Y0g = (float*)(p.ws + Ws::RY0) + ci * 1024;
  const bf16x4v a_T = ld4(TN + l15 * 16 + 4 * q), a_Ak = ld4(AK + l15 * 16 + 4 * q), a_Rb = ld4(RB + l15 * 16 + 4 * q), a_Rk = ld4(RK + l15 * 16 + 4 * q);
  const f32x4 z4 = f32x4{0.f, 0.f, 0.f, 0.f};
  bf16x4v vfr[4], qfr[4], pfr[4];
#pragma unroll
  for (int n = 0; n < 4; ++n) {
    vfr[n] = ld4(big + 1024 + (16 * n + l15) * 16 + 4 * q);
    const f32x4 akv = MFMA16K16(a_Ak, vfr[n], z4);
    qfr[n] = cvt4(MFMA16K16(a_T, cvt4(akv), z4));
    pfr[n] = cvt4(MFMA16K16(a_T, ld4(big + (16 * n + l15) * 16 + 4 * q), z4)); }
  const bf16x8 a_RbRk = cat44(a_Rb, a_Rk);
#pragma unroll
  for (int n = 0; n < 4; ++n) {
    const f32x4 g = MFMA16K16(a_Rb, pfr[n], gacc[n]);
    const f32x4 y0 = MFMA16(a_RbRk, cat44(qfr[n], vfr[n]), z4);
#pragma unroll
    for (int r = 0; r < 4; ++r) { Gg[(4 * q + r) * 64 + 16 * n + l15] = f2bf(g[r]); Y0g[(4 * q + r) * 64 + 16 * n + l15] = y0[r]; } }
#pragma unroll
  for (int mk = 0; mk < 4; ++mk) {
    const bf16x4v a_B = ld4(big + 2048 + (16 * mk + l15) * 16 + 4 * q), a_K = ld4(big + 3072 + (16 * mk + l15) * 16 + 4 * q);
    const bf16x8 a_BK = cat44(a_B, a_K);
#pragma unroll
    for (int n = 0; n < 4; ++n) {
      const f32x4 m = MFMA16K16(a_B, pfr[n], z4);
      const f32x4 nn = MFMA16(a_BK, cat44(qfr[n], vfr[n]), z4);
#pragma unroll
      for (int r = 0; r < 4; ++r) MLg[((mk * 2 + (n >> 1)) * 64 + (l15 >> 2) * 16 + 4 * q + r) * 8 + (n & 1) * 4 + (l15 & 3)] = f2bf(m[r]);
      *(bf16x4v*)(Ng + (n * 64 + lane) * 16 + mk * 4) = cvt4(nn); } }
  ((float*)(p.ws + Ws::RWC))[ci * 64 + ((lane >> 2) & 3) * 16 + (lane >> 4) * 4 + (lane & 3)] = WC;
}
struct RwStep { bf16x8 ml[4][2]; bf16x8 n[2]; f32x4 wc[4]; };
DEVFN void rw_load(RwStep& t, const bf16_t* MLg, const bf16_t* NSg, const float* WCg, int c, int lane, int q) {
#pragma unroll
  for (int mk = 0; mk < 4; ++mk) { t.ml[mk][0] = ld8g(MLg + (size_t)c * 4096 + ((mk * 2 + 0) * 64 + lane) * 8); t.ml[mk][1] = ld8g(MLg + (size_t)c * 4096 + ((mk * 2 + 1) * 64 + lane) * 8);
    t.wc[mk] = *(const AS1 f32x4*)gptr(WCg + (size_t)c * 64 + q * 16 + mk * 4); }
  t.n[0] = ld8g(NSg + (size_t)c * 4096 + lane * 16); t.n[1] = ld8g(NSg + (size_t)c * 4096 + lane * 16 + 8);
}
DEVFN void rw_step(const RwStep& t, f32x4 (&S)[4], bf16_t* NSg, int c, int q, int l15) {
  bf16x4v sb[4];
#pragma unroll
  for (int mk = 0; mk < 4; ++mk) sb[mk] = cvt4(S[mk]);
  const bf16x8 bf0 = cat44(sb[0], sb[1]), bf1 = cat44(sb[2], sb[3]);
#pragma unroll
  for (int mk = 0; mk < 4; ++mk) {
    f32x4 acc;
#pragma unroll
    for (int r = 0; r < 4; ++r) acc[r] = bf2f((bf16_t)t.n[mk >> 1][(mk & 1) * 4 + r]) + t.wc[mk][r] * S[mk][r];
    acc = MFMA16(t.ml[mk][0], bf0, acc);
    acc = MFMA16(t.ml[mk][1], bf1, acc);
    S[mk] = acc; }
#pragma unroll
  for (int mk = 0; mk < 4; ++mk) *(AS1 bf16x4v*)gptr(NSg + (size_t)c * 4096 + l15 * 64 + 16 * mk + 4 * q) = sb[mk];
}
DEVFN void rwkv_scan(const Params& p, int chain, int wave) {
  const int tid = TIDX, lane = tid & 63, q = lane >> 4, l15 = lane & 15;
  const bf16_t* MLg = (const bf16_t*)(p.ws + Ws::RML) + (size_t)chain * NC16 * 4096;
  bf16_t* NSg = (bf16_t*)(p.ws + Ws::RNS) + (size_t)chain * NC16 * 4096 + wave * 1024;
  const float* WCg = (const float*)(p.ws + Ws::RWC) + (size_t)chain * NC16 * 64;
  f32x4 S[4];
#pragma unroll
  for (int mk = 0; mk < 4; ++mk) S[mk] = f32x4{0.f, 0.f, 0.f, 0.f};
  RwStep t0, t1, t2;
#define RWC_(x) ((x) < NC16 ? (x) : NC16 - 1)
  rw_load(t0, MLg, NSg, WCg, 0, lane, q);
  rw_load(t1, MLg, NSg, WCg, RWC_(1), lane, q);
  int c = 0;
  for (; c + 2 < NC16; c += 3) {
    rw_load(t2, MLg, NSg, WCg, c + 2, lane, q);
    rw_step(t0, S, NSg, c, q, l15);
    rw_load(t0, MLg, NSg, WCg, RWC_(c + 3), lane, q);
    rw_step(t1, S, NSg, c + 1, q, l15);
    rw_load(t1, MLg, NSg, WCg, RWC_(c + 4), lane, q);
    rw_step(t2, S, NSg, c + 2, q, l15);
  }
  if (c < NC16) { rw_step(t0, S, NSg, c, q, l15); if (c + 1 < NC16) rw_step(t1, S, NSg, c + 1, q, l15); }
#undef RWC_
}
DEVFN void rwkv_out(const Params& p, int unit_base) {
  const int tid = TIDX, lane = tid & 63, wave = tid >> 6, q = lane >> 4, l15 = lane & 15;
  const int unit = unit_base + wave;
  const int c = unit % NC16, h = (unit / NC16) & 3, dir = (unit / (NC16 * 4)) & 1, b = unit / (NC16 * 8);
  const size_t ci = (size_t)((b * 2 + dir) * 4 + h) * NC16 + c;
  const bf16_t* Sg = (const bf16_t*)(p.ws + Ws::RNS) + ci * 4096; const bf16_t* Gg = (const bf16_t*)(p.ws + Ws::RG) + ci * 1024;
  const float* Y0g = (const float*)(p.ws + Ws::RY0) + ci * 1024;
  float* YR = (float*)(p.ws + Ws::YR) + (size_t)dir * NT_ * 256;
  const bf16x8 a0 = ld8g(Gg + l15 * 64 + 8 * q), a1 = ld8g(Gg + l15 * 64 + 32 + 8 * q);
#pragma unroll
  for (int n = 0; n < 4; ++n) {
    f32x4 acc;
#pragma unroll
    for (int r = 0; r < 4; ++r) acc[r] = gptr(Y0g)[(4 * q + r) * 64 + 16 * n + l15];
    acc = MFMA16(a0, ld8g(Sg + n * 1024 + l15 * 64 + 8 * q), acc);
    acc = MFMA16(a1, ld8g(Sg + n * 1024 + l15 * 64 + 32 + 8 * q), acc);
#pragma unroll
    for (int r = 0; r < 4; ++r) YR[(size_t)(b * T_ + tokmap(dir, c * 16 + 4 * q + r)) * 256 + h * 64 + 16 * n + l15] = acc[r]; }
}
DEVFN int cscan(int dir, int co, int nctx, int nc) { return dir == 0 ? co : (co < nctx ? nctx - 1 - co : 2 * nctx + nc - 1 - co); }
DEVFN bf16x8 ld4x2g(const bf16_t* p0, const bf16_t* p1) { bf16x4v a = *(const AS1 bf16x4v*)gptr(p0), b = *(const AS1 bf16x4v*)gptr(p1); return bf16x8{a[0], a[1], a[2], a[3], b[0], b[1], b[2], b[3]}; }
DEVFN bf16x8 ld4x2(const bf16_t* p0, const bf16_t* p1) { bf16x4v a = *(const bf16x4v*)p0, b = *(const bf16x4v*)p1; return bf16x8{a[0], a[1], a[2], a[3], b[0], b[1], b[2], b[3]}; }

DEVFN void ssd_chunk_scalars(const Params& p, int l, int b, int co, int h, float* f) {
  const int tid = TIDX, d = tid >> 7, j = tid & 127;
  const float* DTB = (const float*)(p.ws + Ws::DTB);
  const float nega = -expf(INP(I_ALOG)[(size_t)l * 16 + d * 8 + h]);
  const float dt = DTB[(size_t)(b * T_ + co * 128 + j) * 16 + d * 8 + h];
  __syncthreads();
  f[256 + d * 128 + j] = dt;
  float* cur = f + d * 128; float* tmp = f + 512 + d * 128;
  cur[j] = dt * nega;
  __syncthreads();
  for (int off = 1; off < 128; off <<= 1) {
    float v = cur[j] + (j >= off ? cur[j - off] : 0.f);
    tmp[j] = v;
    __syncthreads();
    cur[j] = tmp[j];
    __syncthreads();
  }
}
DEVFN void ssd_states(const Params& p, int l, int unit, unsigned char* smem) {
  const int tid = TIDX, lane = tid & 63, wave = tid >> 6, q = lane >> 4, l15 = lane & 15;
  const int h = unit & 7, co = (unit >> 3) % NC128, b = unit / (8 * NC128), grp = h >> 2;
  float* f = (float*)smem;
  ssd_chunk_scalars(p, l, b, co, h, f);
  { const int d = tid >> 7, j = tid & 127; const float* cum = f + d * 128; const float dt = f[256 + d * 128 + j];
    float w = d == 0 ? expf(cum[127] - cum[j]) * dt : expf(j > 0 ? cum[j - 1] : 0.f) * dt;
    f[512 + d * 128 + j] = w; }
  __syncthreads();
  const bf16_t* XT = (const bf16_t*)(p.ws + Ws::XBCT) + (size_t)(b * NC128 + co) * 768 * 128;
  f32x4 acc[2][8];
#pragma unroll
  for (int d = 0; d < 2; ++d)
#pragma unroll
    for (int n = 0; n < 8; ++n) acc[d][n] = f32x4{0.f, 0.f, 0.f, 0.f};
#pragma unroll 1
  for (int s4 = 0; s4 < 4; ++s4) {
    const int j0 = s4 * 32 + q * 8;
    bf16x8 xa = ld8g(XT + (size_t)(h * 64 + wave * 16 + l15) * 128 + j0), a0, a1;
#pragma unroll
    for (int jj = 0; jj < 8; ++jj) { float x = bf2f((bf16_t)xa[jj]); a0[jj] = (short)f2bf(x * f[512 + j0 + jj]); a1[jj] = (short)f2bf(x * f[640 + j0 + jj]); }
#pragma unroll
    for (int n = 0; n < 8; ++n) { bf16x8 bb = ld8g(XT + (size_t)(512 + grp * 128 + n * 16 + l15) * 128 + j0);
      acc[0][n] = MFMA16(a0, bb, acc[0][n]); acc[1][n] = MFMA16(a1, bb, acc[1][n]); }
  }
#pragma unroll
  for (int d = 0; d < 2; ++d) {
    const int cs = cscan(d, co, CTX_ / 128, SEQ_ / 128);
    float* ST = (float*)(p.ws + Ws::SST) + ((size_t)((d * B_ + b) * NC128 + cs) * 8 + h) * 8192;
#pragma unroll
    for (int n = 0; n < 8; ++n)
#pragma unroll
      for (int r = 0; r < 4; ++r) ST[(wave * 16 + q * 4 + r) * 128 + n * 16 + l15] = acc[d][n][r];
    if (tid == 0) ((float*)(p.ws + Ws::SCD))[((size_t)(d * B_ + b) * NC128 + cs) * 8 + h] = expf(f[d * 128 + 127]);
  }
}
#define SSD_SB ((NC128 % 17) == 0 ? 17 : NC128)
DEVFN void ssd_scan(const Params& p, int gtid, int gthreads) {
  const float* __restrict__ ST = (const float*)(p.ws + Ws::SST); const float* __restrict__ CD = (const float*)(p.ws + Ws::SCD); bf16_t* __restrict__ HIN = (bf16_t*)(p.ws + Ws::HIN);
  for (int e = gtid; e < 2 * B_ * 8 * 8192; e += gthreads) {
    const int pd = e & 8191, h = (e >> 13) & 7, db = e >> 16;
    float hv = 0.f;
#pragma unroll 1
    for (int c0 = 0; c0 < NC128; c0 += SSD_SB) {
      float st[SSD_SB], cd[SSD_SB];
#pragma unroll
      for (int i = 0; i < SSD_SB; ++i) { st[i] = ST[((size_t)(db * NC128 + c0 + i) * 8 + h) * 8192 + pd]; cd[i] = CD[(size_t)(db * NC128 + c0 + i) * 8 + h]; }
#pragma unroll
      for (int i = 0; i < SSD_SB; ++i) { HIN[((size_t)(db * NC128 + c0 + i) * 8 + h) * 8192 + pd] = f2bf(hv); hv = hv * cd[i] + st[i]; }
    }
  }
}
DEVFN void ssd_out(const Params& p, int l, int unit, unsigned char* smem) {
  const int tid = TIDX, lane = tid & 63, wave = tid >> 6, q = lane >> 4, l15 = lane & 15;
  const int h = unit & 7, co = (unit >> 3) % NC128, b = unit / (8 * NC128), grp = h >> 2;
  float* f = (float*)smem;
  ssd_chunk_scalars(p, l, b, co, h, f);
  if (tid < 128) f[640 + tid] = f[128 + 127] - (tid > 0 ? f[128 + tid - 1] : 0.f);
  __syncthreads();
  const float* cum0 = f; const float* suf1 = f + 640; const float* dt0 = f + 256; const float* dt1 = f + 384;
  const bf16_t* XBC = (const bf16_t*)(p.ws + Ws::XBC) + (size_t)(b * T_ + co * 128) * 1024;
  const bf16_t* XT = (const bf16_t*)(p.ws + Ws::XBCT) + (size_t)(b * NC128 + co) * 768 * 128;
  const bf16_t* Cb = XBC + (size_t)(wave * 32 + l15) * 1024 + 768 + grp * 128 + q * 8;
  f32x4 y[4][2];
  { f32x4 o0[4][2], o1[4][2];
#pragma unroll
    for (int mp = 0; mp < 4; ++mp)
#pragma unroll
      for (int ni = 0; ni < 2; ++ni) { o0[mp][ni] = f32x4{0.f, 0.f, 0.f, 0.f}; o1[mp][ni] = f32x4{0.f, 0.f, 0.f, 0.f}; }
    const int cs0 = cscan(0, co, CTX_ / 128, SEQ_ / 128), cs1 = cscan(1, co, CTX_ / 128, SEQ_ / 128);
    const bf16_t* H0 = (const bf16_t*)(p.ws + Ws::HIN) + ((size_t)((0 * B_ + b) * NC128 + cs0) * 8 + h) * 8192;
    const bf16_t* H1 = (const bf16_t*)(p.ws + Ws::HIN) + ((size_t)((1 * B_ + b) * NC128 + cs1) * 8 + h) * 8192;
#pragma unroll 1
    for (int s4 = 0; s4 < 4; ++s4) { const bf16x8 c0 = ld8g(Cb + s4 * 32), c1 = ld8g(Cb + 16 * 1024 + s4 * 32);
#pragma unroll
      for (int mp = 0; mp < 4; ++mp) { bf16x8 h0 = ld8g(H0 + (size_t)(mp * 16 + l15) * 128 + s4 * 32 + q * 8), h1 = ld8g(H1 + (size_t)(mp * 16 + l15) * 128 + s4 * 32 + q * 8);
        o0[mp][0] = MFMA16(h0, c0, o0[mp][0]); o0[mp][1] = MFMA16(h0, c1, o0[mp][1]);
        o1[mp][0] = MFMA16(h1, c0, o1[mp][0]); o1[mp][1] = MFMA16(h1, c1, o1[mp][1]); } }
#pragma unroll
    for (int ni = 0; ni < 2; ++ni) { const int i = wave * 32 + ni * 16 + l15; const float e0 = expf(cum0[i]), e1 = expf(suf1[i]);
#pragma unroll
      for (int mp = 0; mp < 4; ++mp)
#pragma unroll
        for (int r = 0; r < 4; ++r) y[mp][ni][r] = e0 * o0[mp][ni][r] + e1 * o1[mp][ni][r]; } }
  bf16x8 mfr[4][2];
  { f32x4 g[8][2];
#pragma unroll
    for (int mj = 0; mj < 8; ++mj) { g[mj][0] = f32x4{0.f, 0.f, 0.f, 0.f}; g[mj][1] = f32x4{0.f, 0.f, 0.f, 0.f}; }
#pragma unroll 1
    for (int s4 = 0; s4 < 4; ++s4) { const bf16x8 c0 = ld8g(Cb + s4 * 32), c1 = ld8g(Cb + 16 * 1024 + s4 * 32);
#pragma unroll
      for (int mj = 0; mj < 8; ++mj) { bf16x8 bb = ld8g(XBC + (size_t)(mj * 16 + l15) * 1024 + 512 + grp * 128 + s4 * 32 + q * 8);
        g[mj][0] = MFMA16(bb, c0, g[mj][0]); g[mj][1] = MFMA16(bb, c1, g[mj][1]); } }
    const int i0 = wave * 32 + l15, i1 = i0 + 16;
    const float c0i0 = cum0[i0], s1i0 = suf1[i0], c0i1 = cum0[i1], s1i1 = suf1[i1];
#pragma unroll
    for (int mj = 0; mj < 8; ++mj)
#pragma unroll
      for (int r = 0; r < 4; ++r) { const int j = mj * 16 + q * 4 + r;
        const float cj = cum0[j], sj = suf1[j], d0 = dt0[j], d1 = dt1[j];
        const float lw0 = (j <= i0 ? expf(c0i0 - cj) * d0 : 0.f) + (j >= i0 ? expf(s1i0 - sj) * d1 : 0.f);
        const float lw1 = (j <= i1 ? expf(c0i1 - cj) * d0 : 0.f) + (j >= i1 ? expf(s1i1 - sj) * d1 : 0.f);
        mfr[mj >> 1][0][(mj & 1) * 4 + r] = (short)f2bf(g[mj][0][r] * lw0);
        mfr[mj >> 1][1][(mj & 1) * 4 + r] = (short)f2bf(g[mj][1][r] * lw1); } }
#pragma unroll
  for (int s4 = 0; s4 < 4; ++s4)
#pragma unroll
    for (int mp = 0; mp < 4; ++mp) { const bf16_t* xr = XT + (size_t)(h * 64 + mp * 16 + l15) * 128 + s4 * 32 + q * 4;
      bf16x8 xa = ld4x2g(xr, xr + 16);
      y[mp][0] = MFMA16(xa, mfr[s4][0], y[mp][0]); y[mp][1] = MFMA16(xa, mfr[s4][1], y[mp][1]); }
  __syncthreads();
  float* yl = f + 1024;
#pragma unroll
  for (int mp = 0; mp < 4; ++mp)
#pragma unroll
    for (int ni = 0; ni < 2; ++ni)
#pragma unroll
      for (int r = 0; r < 4; ++r) yl[(wave * 32 + ni * 16 + l15) * 65 + mp * 16 + q * 4 + r] = y[mp][ni][r];
  __syncthreads();
  float* YS = (float*)(p.ws + Ws::YS) + (size_t)(b * T_ + co * 128) * 512 + h * 64;
  for (int e = tid; e < 128 * 64; e += 256) YS[(size_t)(e >> 6) * 512 + (e & 63)] = yl[(e >> 6) * 65 + (e & 63)];
}

#define GQ_LD 40
#define GK_LD 72
DEVFN void gla_chunk(const Params& p, int unit, unsigned char* smem) {
  const int tid = TIDX, lane = tid & 63, wave = tid >> 6, q = lane >> 4, l15 = lane & 15;
  const int h = unit & 3, co = (unit >> 2) % NC64, b = unit / (4 * NC64);
  const bf16_t* ZX = (const bf16_t*)(p.ws + Ws::ZX) + (size_t)(b * T_ + co * 64) * NIN_;
  const float* LA = (const float*)(p.ws + Ws::LA);
  float* cum = (float*)smem;
  bf16_t* qs = (bf16_t*)(smem + 16384);
  bf16_t* ks = qs + 2 * 64 * GQ_LD;
  bf16_t* kt = ks + 2 * 64 * GQ_LD;
  __syncthreads();
  for (int e = tid; e < 2 * 64 * 32; e += 256) { const int d = e >> 11, i = (e >> 5) & 63, dd = e & 31;
    cum[e] = LA[((size_t)d * NT_ + b * T_ + co * 64 + i) * 128 + h * 32 + dd]; }
  __syncthreads();
  if (tid < 64) { const int d = tid >> 5, dd = tid & 31; float* c = cum + d * 2048 + dd; float sacc = 0.f;
    if (d == 0) for (int i = 0; i < 64; ++i) { sacc += c[i * 32]; c[i * 32] = sacc; }
    else for (int i = 63; i >= 0; --i) { sacc += c[i * 32]; c[i * 32] = sacc; } }
  __syncthreads();
  bf16_t* QT = (bf16_t*)(p.ws + Ws::QT);
  for (int e = tid; e < 64 * 32; e += 256) { const int i = e >> 5, dd = e & 31;
    const float qv = bf2f(ZX[(size_t)i * NIN_ + OGQ + h * 32 + dd]) * 0.17677669529663687f, kv = bf2f(ZX[(size_t)i * NIN_ + OGK + h * 32 + dd]);
    const float c0 = cum[i * 32 + dd], c1 = cum[2048 + i * 32 + dd], t0 = cum[63 * 32 + dd], t1 = cum[2048 + dd];
    const bf16_t q0 = f2bf(qv * expf(c0)), q1 = f2bf(qv * expf(c1));
    qs[i * GQ_LD + dd] = q0; qs[64 * GQ_LD + i * GQ_LD + dd] = q1;
    ks[i * GQ_LD + dd] = f2bf(kv * expf(-c0)); ks[64 * GQ_LD + i * GQ_LD + dd] = f2bf(kv * expf(-c1));
    kt[dd * GK_LD + i] = f2bf(kv * expf(t0 - c0)); kt[32 * GK_LD + dd * GK_LD + i] = f2bf(kv * expf(t1 - c1));
    const size_t tok = (size_t)b * T_ + co * 64 + i;
    QT[tok * 128 + h * 32 + dd] = q0; QT[((size_t)NT_ + tok) * 128 + h * 32 + dd] = q1; }
  if (tid < 64) { const int d = tid >> 5, dd = tid & 31; const int cs = cscan(d, co, CTX_ / 64, SEQ_ / 64);
    ((float*)(p.ws + Ws::GCD))[(((size_t)(d * B_ + b) * NC64 + cs) * 4 + h) * 32 + dd] = expf(d == 0 ? cum[63 * 32 + dd] : cum[2048 + dd]); }
  __syncthreads();
  bf16x8 pfr[2];
  { f32x4 p0[4], p1[4];
    const bf16x8 qb0 = ld8(qs + (wave * 16 + l15) * GQ_LD + q * 8), qb1 = ld8(qs + 64 * GQ_LD + (wave * 16 + l15) * GQ_LD + q * 8);
#pragma unroll
    for (int mj = 0; mj < 4; ++mj) { p0[mj] = MFMA16(ld8(ks + (mj * 16 + l15) * GQ_LD + q * 8), qb0, (f32x4{0.f, 0.f, 0.f, 0.f}));
      p1[mj] = MFMA16(ld8(ks + 64 * GQ_LD + (mj * 16 + l15) * GQ_LD + q * 8), qb1, (f32x4{0.f, 0.f, 0.f, 0.f})); }
    const int i = wave * 16 + l15;
#pragma unroll
    for (int mj = 0; mj < 4; ++mj)
#pragma unroll
      for (int r = 0; r < 4; ++r) { const int j = mj * 16 + q * 4 + r; pfr[mj >> 1][(mj & 1) * 4 + r] = (short)f2bf((j <= i ? p0[mj][r] : 0.f) + (j >= i ? p1[mj][r] : 0.f)); } }
  const bf16_t* VT = (const bf16_t*)(p.ws + Ws::VT) + ((size_t)(b * NC64 + co) * 256 + h * 64) * 64;
  f32x4 o[4];
#pragma unroll
  for (int md = 0; md < 4; ++md) { o[md] = f32x4{0.f, 0.f, 0.f, 0.f};
#pragma unroll
    for (int s2 = 0; s2 < 2; ++s2) { const bf16_t* vr = VT + (size_t)(md * 16 + l15) * 64 + s2 * 32 + q * 4; o[md] = MFMA16(ld4x2g(vr, vr + 16), pfr[s2], o[md]); } }
#pragma unroll
  for (int d = 0; d < 2; ++d) { const int cs = cscan(d, co, CTX_ / 64, SEQ_ / 64);
    float* GST = (float*)(p.ws + Ws::GST) + (((size_t)(d * B_ + b) * NC64 + cs) * 4 + h) * 2048;
#pragma unroll
    for (int nd = 0; nd < 2; ++nd) { f32x4 st = f32x4{0.f, 0.f, 0.f, 0.f};
#pragma unroll
      for (int s2 = 0; s2 < 2; ++s2) st = MFMA16(ld8g(VT + (size_t)(wave * 16 + l15) * 64 + s2 * 32 + q * 8), ld8(kt + d * 32 * GK_LD + (nd * 16 + l15) * GK_LD + s2 * 32 + q * 8), st);
#pragma unroll
      for (int r = 0; r < 4; ++r) GST[(wave * 16 + q * 4 + r) * 32 + nd * 16 + l15] = st[r]; } }
  __syncthreads();
  float* ol = (float*)smem;
#pragma unroll
  for (int md = 0; md < 4; ++md)
#pragma unroll
    for (int r = 0; r < 4; ++r) ol[(wave * 16 + l15) * 65 + md * 16 + q * 4 + r] = o[md][r];
  __syncthreads();
  float* OI = (float*)(p.ws + Ws::OI) + (size_t)(b * T_ + co * 64) * 256 + h * 64;
  for (int e = tid; e < 64 * 64; e += 256) OI[(size_t)(e >> 6) * 256 + (e & 63)] = ol[(e >> 6) * 65 + (e & 63)];
}
#define GLA_SB ((NC64 % 17) == 0 ? 17 : NC64)
DEVFN void gla_scan(const Params& p, int gtid, int gthreads) {
  const float* __restrict__ ST = (const float*)(p.ws + Ws::GST); const float* __restrict__ CD = (const float*)(p.ws + Ws::GCD); bf16_t* __restrict__ SIN = (bf16_t*)(p.ws + Ws::GSIN);
  for (int e = gtid; e < 2 * B_ * 4 * 2048; e += gthreads) {
    const int vd = e & 2047, h = (e >> 11) & 3, db = e >> 13;
    float sv = 0.f;
#pragma unroll 1
    for (int c0 = 0; c0 < NC64; c0 += GLA_SB) {
      float st[GLA_SB], cd[GLA_SB];
#pragma unroll
      for (int i = 0; i < GLA_SB; ++i) { st[i] = ST[(((size_t)db * NC64 + c0 + i) * 4 + h) * 2048 + vd]; cd[i] = CD[(((size_t)db * NC64 + c0 + i) * 4 + h) * 32 + (vd & 31)]; }
#pragma unroll
      for (int i = 0; i < GLA_SB; ++i) { SIN[(((size_t)db * NC64 + c0 + i) * 4 + h) * 2048 + vd] = f2bf(sv); sv = sv * cd[i] + st[i]; }
    }
  }
}
DEVFN void gla_out(const Params& p, int unit_base) {
  const int tid = TIDX, lane = tid & 63, wave = tid >> 6, g = lane >> 4, l15 = lane & 15;
  const int unit = unit_base + wave;
  if (unit >= B_ * NC64 * 4) return;
  const int h = unit & 3, co = (unit >> 2) % NC64, b = unit / (4 * NC64);
  const bf16_t* QT = (const bf16_t*)(p.ws + Ws::QT);
  const bf16_t* GSIN = (const bf16_t*)(p.ws + Ws::GSIN);
  float* OI = (float*)(p.ws + Ws::OI) + (size_t)(b * T_ + co * 64) * 256 + h * 64;
  const int tok0 = b * T_ + co * 64;
  bf16x8 af[2][4], bfr[2][4];
#pragma unroll
  for (int d = 0; d < 2; ++d) { const int cs = cscan(d, co, CTX_ / 64, SEQ_ / 64);
    const bf16_t* sr = GSIN + ((((size_t)(d * B_ + b) * NC64 + cs) * 4 + h) * 64) * 32;
#pragma unroll
    for (int mi = 0; mi < 4; ++mi) af[d][mi] = ld8g(QT + ((size_t)d * NT_ + tok0 + mi * 16 + l15) * 128 + h * 32 + g * 8);
#pragma unroll
    for (int ni = 0; ni < 4; ++ni) bfr[d][ni] = ld8g(sr + (ni * 16 + l15) * 32 + g * 8); }
#pragma unroll
  for (int mi = 0; mi < 4; ++mi) {
    f32x4 acc[4];
#pragma unroll
    for (int ni = 0; ni < 4; ++ni)
#pragma unroll
      for (int i = 0; i < 4; ++i) acc[ni][i] = gptr(OI)[(size_t)(mi * 16 + 4 * g + i) * 256 + ni * 16 + l15];
#pragma unroll
    for (int ni = 0; ni < 4; ++ni) { acc[ni] = MFMA16(af[0][mi], bfr[0][ni], acc[ni]); acc[ni] = MFMA16(af[1][mi], bfr[1][ni], acc[ni]); }
#pragma unroll
    for (int ni = 0; ni < 4; ++ni)
#pragma unroll
      for (int i = 0; i < 4; ++i) gptr(OI)[(size_t)(mi * 16 + 4 * g + i) * 256 + ni * 16 + l15] = acc[ni][i];
  }
}
DEVFN void convert_moe_weights(const Params& p, int l, unsigned char* smem, int bid, int nb);
DEVFN void phase4a(const Params& p, int l, unsigned char* smem) {
  const int n_r = B_ * 8 * NC16 / 4;
  for (int u = BIDX; u < n_r; u += gridDim.x) rwkv_chunk(p, (u) * 4, smem);
  (void)l;
}
DEVFN void phase4b(const Params& p, int l, unsigned char* smem) {
  const int bid = BIDX, nrw = B_ * 8, G = (int)gridDim.x;
  const int n_s = B_ * NC128 * 8, n_g = B_ * NC64 * 4;
  int ob = bid, on = G;
  if (G >= 8 * nrw) {
    const int q = 2 * nrw, half = G >> 1;
    int sb = -1;
    if (bid < q) sb = bid; else if (bid >= half && bid < half + q) sb = q + (bid - half);
    if (sb >= 0) { if ((TIDX >> 6) == 0) rwkv_scan(p, sb >> 2, sb & 3); return; }
    ob = bid < half ? bid - q : bid - 2 * q; on = G - 4 * nrw; }
  else { for (int u = bid; u < nrw; u += G) rwkv_scan(p, u, TIDX >> 6); }
  for (int u = ob; u < n_s + n_g; u += on) { if (u < n_s) ssd_states(p, l, u, smem); else gla_chunk(p, u - n_s, smem); }
  convert_moe_weights(p, l, smem, ob, on);
}
DEVFN void phase4b2(const Params& p) {
  const int bid = BIDX, G = (int)gridDim.x;
  ssd_scan(p, bid * 256 + TIDX, G * 256); gla_scan(p, bid * 256 + TIDX, G * 256);
}
DEVFN void phase4c(const Params& p, int l, unsigned char* smem) {
  const int n_s = B_ * NC128 * 8, n_r = B_ * 8 * NC16 / 4, n_g = B_ * NC64;
  for (int u = BIDX; u < n_s + n_r + n_g; u += gridDim.x) { if (u < n_s) ssd_out(p, l, u, smem); else if (u < n_s + n_r) rwkv_out(p, (u - n_s) * 4); else gla_out(p, (u - n_s - n_r) * 4); }
}

DEVFN void phase5(const Params& p, int l, unsigned char* smem) {
  const int tid = TIDX, lane = tid & 63, wave = tid >> 6;
  const bf16_t* ZX = (const bf16_t*)(p.ws + Ws::ZX);
  const bf16_t* XBC = (const bf16_t*)(p.ws + Ws::XBC);
  const float* YS = (const float*)(p.ws + Ws::YS); const float* YR = (const float*)(p.ws + Ws::YR); const float* OI = (const float*)(p.ws + Ws::OI);
  const bf16_t* RR = (const bf16_t*)(p.ws + Ws::RR); const bf16_t* VV = (const bf16_t*)(p.ws + Ws::VV); const bf16_t* KD = (const bf16_t*)(p.ws + Ws::KD);
  const float* GATE = (const float*)(p.ws + Ws::GATE);
  bf16_t* YM = (bf16_t*)(p.ws + Ws::YMIX);
  constexpr int TPI = 4;
  float* red = (float*)smem;
  const float dA = INP(I_SSDD)[(size_t)l * 8 + (tid >> 6)], dB = INP(I_SSDD)[(size_t)l * 8 + 4 + (tid >> 6)];
  const float nwA = INP(I_SSDNW)[(size_t)l * 512 + tid], nwB = INP(I_SSDNW)[(size_t)l * 512 + 256 + tid];
  const float lnw = INP(I_LNXW)[(size_t)l * 256 + tid], lnb = INP(I_LNXB)[(size_t)l * 256 + tid], rk = INP(I_RK)[(size_t)l * 256 + tid];
  const float gnw = INP(I_GNW)[(size_t)l * 256 + tid];
  const int per_ = (NT_ / TPI + (int)gridDim.x - 1) / (int)gridDim.x, tp_lo = BIDX * per_, tp_hi = (tp_lo + per_ < NT_ / TPI) ? tp_lo + per_ : NT_ / TPI;
  for (int tp = tp_lo; tp < tp_hi; ++tp) {
    float ys0[TPI], ys1[TPI], x0[TPI], x1[TPI], z0[TPI], z1[TPI], og[TPI], yr[TPI], rr[TPI], kf[TPI], kb[TPI], vv[TPI], gt[TPI], oi[TPI];
#pragma unroll
    for (int t = 0; t < TPI; ++t) { const int tok = tp * TPI + t;
      ys0[t] = gptr(YS)[(size_t)tok * 512 + tid]; ys1[t] = gptr(YS)[(size_t)tok * 512 + 256 + tid];
      x0[t] = bf2f(gptr(XBC)[(size_t)tok * 1024 + tid]); x1[t] = bf2f(gptr(XBC)[(size_t)tok * 1024 + 256 + tid]);
      z0[t] = zxv(ZX, tok, OZ + tid); z1[t] = zxv(ZX, tok, OZ + 256 + tid); og[t] = zxv(ZX, tok, OOG + tid);
      yr[t] = gptr(YR)[(size_t)tok * 256 + tid] + gptr(YR)[((size_t)NT_ + tok) * 256 + tid];
      rr[t] = bf2f(gptr(RR)[(size_t)tok * 256 + tid]); kf[t] = bf2f(gptr(KD)[(size_t)tok * 256 + tid]); kb[t] = bf2f(gptr(KD)[((size_t)NT_ + tok) * 256 + tid]);
      vv[t] = bf2f(gptr(VV)[(size_t)tok * 256 + tid]); gt[t] = gptr(GATE)[(size_t)tok * 256 + tid]; oi[t] = gptr(OI)[(size_t)tok * 256 + tid];
    }
    float ya[TPI], yb[TPI], qa[TPI], qb[TPI];
#pragma unroll
    for (int t = 0; t < TPI; ++t) {
      ya[t] = (ys0[t] + dA * x0[t]) * siluf_(z0[t]); yb[t] = (ys1[t] + dB * x1[t]) * siluf_(z1[t]);
      qa[t] = wave_sum(ya[t] * ya[t]); qb[t] = wave_sum(yb[t] * yb[t]); }
    __syncthreads();
#pragma unroll
    for (int t = 0; t < TPI; ++t)
      if (lane == 0) { red[t * 8 + wave] = qa[t]; red[t * 8 + 4 + wave] = qb[t]; }
    __syncthreads();
#pragma unroll
    for (int t = 0; t < TPI; ++t) { const int tok = tp * TPI + t;
      const float* rd = red + t * 8;
      float ma = (rd[0] + rd[1] + rd[2] + rd[3]) * (1.f / 256.f), mb = (rd[4] + rd[5] + rd[6] + rd[7]) * (1.f / 256.f);
      YM[(size_t)tok * 1024 + tid] = f2bf(ya[t] * rsqrtf(ma + 1e-5f) * nwA);
      YM[(size_t)tok * 1024 + 256 + tid] = f2bf(yb[t] * rsqrtf(mb + 1e-5f) * nwB);
      { const float y = yr[t];
        float mu = wave_sum(y) * (1.f / 64.f), d = y - mu, var = wave_sum(d * d) * (1.f / 64.f);
        float yn = d * rsqrtf(var + 64e-5f) * lnw + lnb;
        float bonus = wave_sum(rr[t] * (kf[t] + kb[t]) * rk) * vv[t];
        YM[(size_t)tok * 1024 + 512 + tid] = f2bf((yn + bonus) * gt[t]); }
      { float o = oi[t];
        float ms = wave_sum(o * o) * (1.f / 64.f);
        YM[(size_t)tok * 1024 + 768 + tid] = f2bf(o * rsqrtf(ms + 1e-5f) * gnw * siluf_(og[t])); } }
  }
}

DEVFN void phase6(const Params& p, int l, unsigned char* smem) {
  const bf16_t* A = (const bf16_t*)(p.ws + Ws::YMIX);
  const bf16_t* W = (const bf16_t*)(p.ws + Ws::WOUT) + (size_t)l * 1024 * 1024;
  float* MIX = (float*)(p.ws + Ws::MIX);
  for (int u = BIDX; u < (NT_ / 128) * 8; u += gridDim.x) {
    int rt = u / 8, ct = u % 8;
    gemm_tile(smem, 1024,
      [&](int r) { return A + (size_t)(rt * 128 + r) * 1024; },
      [&](int r) { return W + (size_t)(ct * 128 + r) * 1024; },
      [&](f32x4 (&acc)[4][4], int wr, int wc, int g, int l15) {
#pragma unroll
        for (int mi = 0; mi < 4; ++mi)
#pragma unroll
          for (int ni = 0; ni < 4; ++ni)
#pragma unroll
            for (int i = 0; i < 4; ++i) MIX[(size_t)(rt * 128 + wr * 64 + mi * 16 + 4 * g + i) * 1024 + ct * 128 + wc * 64 + ni * 16 + l15] = acc[mi][ni][i];
      });
  }
}

#define P7_MAXE 2048
DEVFN void phase7(const Params& p, int l, unsigned char* smem) {
  const int lane = TIDX & 63, wave = TIDX >> 6;
  float* X = (float*)(p.ws + Ws::X);
  const float* MIX = (const float*)(p.ws + Ws::MIX);
  bf16_t* H = (bf16_t*)(p.ws + Ws::U);
  const float* rwt = (const float*)(p.ws + Ws::RWT) + (size_t)l * 64 * 1024;
  int* cnt = (int*)(p.ws + Ws::CNT) + l * 64 * 64;
  int* ltok = (int*)(p.ws + Ws::LTOK); float* lwt = (float*)(p.ws + Ws::LWT);
  const float rbias = INP(I_RB)[(size_t)l * 64 + lane];
  float* hs = (float*)smem;
  float* lg = hs + 4096;
  int* lcnt = (int*)(lg + 256);
  int* lbase = lcnt + 80;
  int* etok = lbase + 64;
  int* epos = etok + P7_MAXE; float* ewt = (float*)(epos + P7_MAXE);
  for (int i = TIDX; i < 80; i += 256) lcnt[i] = 0;
  for (int tok0 = BIDX * 4; tok0 < NT_; tok0 += gridDim.x * 4) {
    const int tok = tok0 + wave;
    const float* mod = (const float*)(p.ws + Ws::MOD) + ((size_t)l * NR_ + tok_modrow(tok)) * NMOD_;
    float xv[16], mx[16], g1[16], lw[16], lb[16], sh2[16], sc2[16], mean, rstd;
    load_row16(X + (size_t)tok * 1024, lane, xv);
    load_row16(MIX + (size_t)tok * 1024, lane, mx);
    load_row16(mod + 2 * 1024, lane, g1);
    load_row16(INP(I_LN1W) + (size_t)l * 1024, lane, lw);
    load_row16(INP(I_LN1B) + (size_t)l * 1024, lane, lb);
    load_row16(mod + 3 * 1024, lane, sh2);
    load_row16(mod + 4 * 1024, lane, sc2);
#pragma unroll
    for (int i = 0; i < 16; ++i) xv[i] = ALPHA_ * xv[i] + g1[i] * mx[i];
    row_stats(xv, mean, rstd);
#pragma unroll
    for (int i = 0; i < 16; ++i) xv[i] = (xv[i] - mean) * rstd * lw[i] + lb[i];
#pragma unroll
    for (int j = 0; j < 4; ++j) *(float4*)(X + (size_t)tok * 1024 + lane * 4 + 256 * j) = make_float4(xv[4 * j], xv[4 * j + 1], xv[4 * j + 2], xv[4 * j + 3]);
    const bool routed = !(l == DEPTH_ - 1 && (tok % T_) < CTX_);
    row_stats(xv, mean, rstd);
#pragma unroll
    for (int i = 0; i < 16; ++i) xv[i] = (xv[i] - mean) * rstd * (1.f + sc2[i]) + sh2[i];
    __syncthreads();
#pragma unroll
    for (int j = 0; j < 4; ++j) {
      if (routed) *(uint2*)(H + (size_t)tok * 1024 + lane * 4 + 256 * j) = make_uint2((unsigned)f2bf(xv[4 * j]) | ((unsigned)f2bf(xv[4 * j + 1]) << 16), (unsigned)f2bf(xv[4 * j + 2]) | ((unsigned)f2bf(xv[4 * j + 3]) << 16));
      *(float4*)(hs + wave * 1024 + lane * 4 + 256 * j) = make_float4(xv[4 * j], xv[4 * j + 1], xv[4 * j + 2], xv[4 * j + 3]); }
    __syncthreads();
    { float hv[4][16];
      const int rot = BIDX & 15;
#pragma unroll
      for (int t = 0; t < 4; ++t)
#pragma unroll
        for (int j = 0; j < 4; ++j) { const float4 v = *(const float4*)(hs + t * 1024 + lane * 4 + 256 * j); hv[t][4 * j] = v.x; hv[t][4 * j + 1] = v.y; hv[t][4 * j + 2] = v.z; hv[t][4 * j + 3] = v.w; }
      float pe[64];
      const AS1 float* rw = gptr(rwt) + lane * 4;
      f32x4 w[4], wn[4];
#pragma unroll
      for (int j = 0; j < 4; ++j) w[j] = *(const AS1 f32x4*)(rw + (size_t)(16 * wave + (rot & 15)) * 1024 + 256 * j);
#pragma unroll
      for (int e = 0; e < 16; ++e) {
        if (e + 1 < 16) {
#pragma unroll
          for (int j = 0; j < 4; ++j) wn[j] = *(const AS1 f32x4*)(rw + (size_t)(16 * wave + ((e + 1 + rot) & 15)) * 1024 + 256 * j); }
#pragma unroll
        for (int t = 0; t < 4; ++t) { float s0 = 0.f, s1 = 0.f;
#pragma unroll
          for (int j = 0; j < 4; ++j) { s0 += hv[t][4 * j] * w[j][0] + hv[t][4 * j + 2] * w[j][2]; s1 += hv[t][4 * j + 1] * w[j][1] + hv[t][4 * j + 3] * w[j][3]; }
          pe[e * 4 + t] = s0 + s1; }
#pragma unroll
        for (int j = 0; j < 4; ++j) w[j] = wn[j]; }
#pragma unroll
      for (int half = 32; half >= 1; half >>= 1) { const bool up = (lane & half) != 0;
#pragma unroll
        for (int e = 0; e < half; ++e) { const float send = up ? pe[e] : pe[e + half]; const float recv = __shfl_xor(send, half); pe[e] = (up ? pe[e + half] : pe[e]) + recv; } }
      lg[(lane & 3) * 64 + 16 * wave + (((lane >> 2) + rot) & 15)] = pe[0]; }
    __syncthreads();
    if (!routed) continue;
    const float logit = lg[wave * 64 + lane];
    const float score = sigmoidf_(logit), sel = score + rbias;
    float m1 = sel; int a1 = lane;
#pragma unroll
    for (int m = 1; m <= 4; m <<= 1) { float ov = XOR8(m1, m); int oa = XOR8(a1, m); if (ov > m1 || (ov == m1 && oa < a1)) { m1 = ov; a1 = oa; } }
    float m2 = (lane == a1) ? -3.0e38f : sel;
#pragma unroll
    for (int m = 1; m <= 4; m <<= 1) m2 = fmaxf(m2, XOR8(m2, m));
    const float gs = m1 + m2; const int grp = lane >> 3;
    int grank = 0;
#pragma unroll
    for (int g2 = 0; g2 < 8; ++g2) { float og = SHFL_CONST(gs, g2 * 8); grank += (og > gs || (og == gs && g2 < grp)) ? 1 : 0; }
    const bool gsel = grank < 4;
    const float msel = gsel ? sel : -3.0e38f;
    int rank = 0;
#pragma unroll
    for (int e = 0; e < 64; ++e) { float ov = SHFL_CONST(msel, e); rank += (ov > msel || (ov == msel && e < lane)) ? 1 : 0; }
    const bool chosen = gsel && rank < 8;
    const float wsum = wave_sum(chosen ? score : 0.f);
    if (chosen) { const float wv = score / wsum * 2.5f;
      const int idx = atomicAdd(&lcnt[64], 1);
      if (idx < P7_MAXE) { const int slot = atomicAdd(&lcnt[lane], 1); etok[idx] = tok * 8 + rank; epos[idx] = lane | (slot << 8); ewt[idx] = wv; }
      else { int pos = atomicAdd(&cnt[lane * 64], 1); ltok[(size_t)lane * NT_ + pos] = tok * 8 + rank; lwt[(size_t)lane * NT_ + pos] = wv; } }
  }
  __syncthreads();
  if (TIDX < 64) { const int c = lcnt[TIDX]; lbase[TIDX] = c ? atomicAdd(&cnt[TIDX * 64], c) : 0; }
  __syncthreads();
  { const int ne = lcnt[64] < P7_MAXE ? lcnt[64] : P7_MAXE;
    for (int i = TIDX; i < ne; i += 256) { const int e = epos[i] & 255, pos = lbase[e] + (epos[i] >> 8);
      ltok[(size_t)e * NT_ + pos] = etok[i]; lwt[(size_t)e * NT_ + pos] = ewt[i]; } }
}

struct MoeMap { int nblk_total; int e; int rb; int cnt; int hoff; };
DEVFN int moe_ntok(int l) { return l == DEPTH_ - 1 ? B_ * SEQ_ : NT_; }
DEVFN int moe_shared_tok(int l, int i) { return l == DEPTH_ - 1 ? (i / SEQ_) * T_ + CTX_ + (i % SEQ_) : i; }
DEVFN void moe_prefix(const Params& p, int l, int* pre) {
  const int* cnt = (const int*)(p.ws + Ws::CNT) + l * 64 * 64;
  __syncthreads();
  if (TIDX < 64) pre[66 + TIDX] = gptr(cnt)[TIDX * 64];
  if (TIDX == 64) pre[66 + 64] = moe_ntok(l);
  __syncthreads();
  if (TIDX == 0) { int s = 0; for (int e = 0; e < 65; ++e) { pre[e] = s; s += (pre[66 + e] + 127) / 128; } pre[65] = s; }
  __syncthreads();
}
DEVFN void phase8(const Params& p, int l, unsigned char* smem) {
  int* pre = (int*)(smem + SM_PRE);
  moe_prefix(p, l, pre);
  const bf16_t* H = (const bf16_t*)(p.ws + Ws::U);
  const bf16_t* W13 = (const bf16_t*)(p.ws + Ws::W13);
  bf16_t* HID = (bf16_t*)(p.ws + Ws::HID);
  const int* ltok = (const int*)(p.ws + Ws::LTOK); const float* lwt = (const float*)(p.ws + Ws::LWT);
  const int total = pre[65];
  for (int u = BIDX; u < total * 2; u += gridDim.x) {
    const int gb = u >> 1, nt = u & 1;
    int e = 0; while (pre[e + 1] <= gb) ++e;
    e = UNI(e);
    const int rb = UNI(gb - pre[e]), cnt = UNI(pre[66 + e]);
    int* tk_s = (int*)(smem + GEMMW_SMEM); float* gw_s = (float*)(tk_s + 128);
    __syncthreads();
    if (TIDX < 128) { const int pos = rb * 128 + TIDX; int tk = -1; float gw = 0.f;
      if (pos < cnt) { tk = e < 64 ? (gptr(ltok)[(size_t)e * NT_ + pos] >> 3) : moe_shared_tok(l, pos); gw = e < 64 ? gptr(lwt)[(size_t)e * NT_ + pos] : 1.f; }
      tk_s[TIDX] = tk; gw_s[TIDX] = gw; }
    __syncthreads();
    gemm_tile_w<1, 1024>(smem, 1024,
      [&](int r) { const int tk = tk_s[r]; return tk >= 0 ? H + (size_t)tk * 1024 : (const bf16_t*)(p.ws + Ws::ZROW); },
      [&](int) { return W13 + ((size_t)e * 512 + nt * 256) * 1024; },
      [&](f32x4 (&acc)[4][8], int, int wr, int wc, int g, int l15) {
        tile_store_bf16<16>(smem, wr, g, l15,
          [&](bf16_t* T, int ldc) {
#pragma unroll
            for (int mi = 0; mi < 4; ++mi)
#pragma unroll
              for (int i = 0; i < 4; ++i) { const int r = wr * 64 + mi * 16 + 4 * g + i;
                const float gw = gw_s[r];
#pragma unroll
                for (int j = 0; j < 4; ++j) T[r * ldc + wc * 64 + j * 16 + l15] = f2bf(siluf_(acc[mi][2 * j][i]) * acc[mi][2 * j + 1][i] * gw); } },
          [&](int row, int c0) { const int pos = rb * 128 + row; return pos < cnt ? HID + ((size_t)gb * 128 + row) * 256 + nt * 128 + c0 : (bf16_t*)nullptr; });
      });
  }
}
DEVFN void phase9(const Params& p, int l, unsigned char* smem) {
  int* pre = (int*)(smem + SM_PRE);
  moe_prefix(p, l, pre);
  const bf16_t* HID = (const bf16_t*)(p.ws + Ws::HID);
  const bf16_t* W2T = (const bf16_t*)(p.ws + Ws::W2T);
  bf16_t* YB = (bf16_t*)(p.ws + Ws::YBUF);
  const int* ltok = (const int*)(p.ws + Ws::LTOK);
  const int total = pre[65];
  for (int u = BIDX; u < total * 2; u += gridDim.x) {
    const int gb = u >> 1, ntp = u & 1;
    int e = 0; while (pre[e + 1] <= gb) ++e;
    e = UNI(e);
    const int rb = UNI(gb - pre[e]), cnt = UNI(pre[66 + e]);
    int* ts_s = (int*)(smem + GEMMW_SMEM);
    __syncthreads();
    if (TIDX < 128) { const int pos = rb * 128 + TIDX; int ts = -1;
      if (pos < cnt) ts = e < 64 ? gptr(ltok)[(size_t)e * NT_ + pos] : moe_shared_tok(l, pos) * 8;
      ts_s[TIDX] = ts; }
    __syncthreads();
    gemm_tile_w<2, 256>(smem, 256,
      [&](int r) { return ts_s[r] >= 0 ? HID + ((size_t)gb * 128 + r) * 256 : (const bf16_t*)(p.ws + Ws::ZROW); },
      [&](int j) { return W2T + ((size_t)e * 1024 + (ntp * 2 + j) * 256) * 256; },
      [&](f32x4 (&acc)[4][8], int j, int wr, int wc, int g, int l15) { const int nt = ntp * 2 + j;
#pragma unroll 1
        for (int h = 0; h < 2; ++h)
          tile_store_bf16<16>(smem, wr, g, l15,
            [&](bf16_t* T, int ldc) {
              if (wc == h) {
#pragma unroll
                for (int mi = 0; mi < 4; ++mi)
#pragma unroll
                  for (int ni = 0; ni < 8; ++ni)
#pragma unroll
                    for (int i = 0; i < 4; ++i) T[(wr * 64 + mi * 16 + 4 * g + i) * ldc + ni * 16 + l15] = f2bf(acc[mi][ni][i]); } },
            [&](int row, int c0) { const int ts = ts_s[row]; if (ts < 0) return (bf16_t*)nullptr;
              const int tok = ts >> 3, slot = e < 64 ? (ts & 7) : 8;
              return YB + ((size_t)tok * NSLOT + slot) * 1024 + nt * 256 + h * 128 + c0; });
      });
  }
}

#define SMEM_BYTES (PH_SMEM + 2048)
#define N_PHASES (3 + 13 * DEPTH_)
__global__ void __launch_bounds__(256, 2) mega(Params p, int ph_lo, int ph_hi) {
#ifdef HIPEMU
  unsigned char* smem = hipemu::cur_smem();
#else
  unsigned char* smem = smem_dyn;
  volatile LAS unsigned* st = (volatile LAS unsigned*)(smem_dyn + SM_BAR);
  if (threadIdx.x == 0) {
    st[0] = 0u; st[1] = 0u;
    unsigned long long* tab = (unsigned long long*)(smem_dyn + SM_TAB);
#pragma unroll
    for (int i = 0; i < 40; ++i) tab[i] = (unsigned long long)p.in[i];
  }
  __syncthreads();
  XcdBarrier bar = xcd_barrier_post((unsigned*)(p.ws + Ws::BAR), st);
#define GRID_SYNC() xcd_barrier(bar)
#endif
  int ph = 0;
#ifdef ONLY_KIND
#define KIND_ON(k) ((k) == ONLY_KIND)
#else
#define KIND_ON(k) 1
#endif
#ifndef REPEAT_MASK
#define REPEAT_MASK 0u
#endif
#define RUN_PHASE(kind, code) { if (KIND_ON(kind) && ph >= ph_lo && ph < ph_hi) { \
    int nrep_ = ((REPEAT_MASK >> (kind)) & 1u) ? 2 : 1; LAUNDER(nrep_); \
    _Pragma("unroll 1") for (int rep_ = 0; rep_ < nrep_; ++rep_) { LAUNDER(p.ws); LAUNDER(p.out); code; if (rep_ + 1 < nrep_ || ph + 1 < ph_hi) { GRID_SYNC(); } } } ++ph; }
  RUN_PHASE(0, phase0(p, smem));
  RUN_PHASE(11, phase0b(p));
  for (int l = 0; l < DEPTH_; ++l) {
    RUN_PHASE(1, phase1(p, l));
    RUN_PHASE(2, phase2(p, l, smem));
    RUN_PHASE(3, phase3(p, l, smem));
    RUN_PHASE(14, phase3b(p, l, smem));
    RUN_PHASE(4, phase4a(p, l, smem));
    RUN_PHASE(12, phase4b(p, l, smem));
    RUN_PHASE(16, phase4b2(p));
    RUN_PHASE(13, phase4c(p, l, smem));
    RUN_PHASE(5, phase5(p, l, smem));
    RUN_PHASE(6, phase6(p, l, smem));
    RUN_PHASE(7, phase7(p, l, smem));
    RUN_PHASE(8, phase8(p, l, smem));
    RUN_PHASE(9, phase9(p, l, smem));
  }
  RUN_PHASE(10, phase_final(p));
}

extern "C" void kernel_launch(void* const* d_in, const int* in_sizes, int n_in, void* d_out, int out_size, void* d_ws, size_t ws_size, hipStream_t stream) {
  Params p{};
  for (int i = 0; i < 40; ++i) p.in[i] = (const float*)d_in[i];
  p.out = (float*)d_out;
  p.ws = (unsigned char*)d_ws;
  if (ws_size < Ws::END) { fprintf(stderr, "workspace too small: %zu < %zu\n", ws_size, (size_t)Ws::END); return; }
  hipMemsetAsync(d_ws, 0, Ws::ZERO_END, stream);
#ifdef HIPEMU
  int grid = 16; if (const char* e = getenv("EMU_GRID")) grid = atoi(e);
  int stop = N_PHASES; if (const char* e = getenv("EMU_STOP")) stop = atoi(e);
  if (getenv("EMU_ONE")) hipemu::launch(grid, 256, SMEM_BYTES, true, [=] { mega(p, 0, stop); });
  else for (int ph = 0; ph < stop; ++ph) hipemu::launch(grid, 256, SMEM_BYTES, false, [=] { mega(p, ph, ph + 1); });
#else
  static int grid = 0;
  if (!grid) {
    int dev = 0, cus = 0, per_cu = 0;
    hipGetDevice(&dev);
    hipDeviceGetAttribute(&cus, hipDeviceAttributeMultiprocessorCount, dev);
    hipOccupancyMaxActiveBlocksPerMultiprocessor(&per_cu, mega, 256, SMEM_BYTES);
    if (per_cu > 2) per_cu = 2;
    if (per_cu < 1) per_cu = 1;
    grid = cus * per_cu;
  }
#if N_LAUNCH_MODE == 1
  mega<<<grid, 256, SMEM_BYTES, stream>>>(p, 0, N_PHASES);
#else
  for (int ph = 0; ph < N_PHASES; ++ph) mega<<<grid, 256, SMEM_BYTES, stream>>>(p, ph, ph + 1);
#endif
#endif
}
```

```cpp
#ifndef HIPEMU
#include <hip/hip_runtime.h>
#endif
#include <stdint.h>
#include <stdio.h>

#ifndef B_
#define B_ 4
#endif
#ifndef SEQ_
#define SEQ_ 4096
#endif
#ifndef CTX_
#define CTX_ 256
#endif
#ifndef DEPTH_
#define DEPTH_ 4
#endif
#ifndef N_LAUNCH_MODE
#define N_LAUNCH_MODE 1
#endif
#define T_ (SEQ_ + CTX_)
#define NT_ (B_ * T_)
#define D_ 1024
#define NIN_ 3504
#define NMOD_ 6144
#define NR_ (B_ + 1)
#define OZ 0
#define OXBC 512
#define ODT 1536
#define ORW 1552
#define OGQ 2704
#define OGK 2832
#define OGV 2960
#define OGD 3216
#define OOG 3248
#define ALPHA_ 1.681792830507429f
#define NEXP 64
#define NSLOT 9
#define NC128 (T_ / 128)
#define NC64 (T_ / 64)
#define NC16 (T_ / 16)

#define DEVFN __device__ __forceinline__
#define LDT 72
#define GEMM_SMEM (2 * 128 * LDT * 2)
#define GEMMW_SMEM (3 * 128 * LDT * 2)
typedef unsigned short bf16_t;
#ifdef HIPEMU
#define AS1
#else
#define AS1 __attribute__((address_space(1)))
#endif
typedef unsigned u32x4 __attribute__((ext_vector_type(4)));
typedef unsigned u32x2 __attribute__((ext_vector_type(2)));

#ifdef HIPEMU
typedef emu_bf16x8 bf16x8;
typedef emu_f32x4 f32x4;
#define MFMA16(a, b, c) emu_mfma_16x16x32_bf16(a, b, c)
#define MFMA16K16(a, b, c) emu_mfma_16x16x16_bf16(a, b, c)
#define GRID_SYNC() hipemu::grid_sync()
#else
typedef short bf16x8 __attribute__((ext_vector_type(8)));
typedef float f32x4 __attribute__((ext_vector_type(4)));
#define MFMA16(a, b, c) __builtin_amdgcn_mfma_f32_16x16x32_bf16(a, b, c, 0, 0, 0)
#define MFMA16K16(a, b, c) __builtin_amdgcn_mfma_f32_16x16x16bf16_1k(a, b, c, 0, 0, 0)
#endif

DEVFN float bf2f(bf16_t h) { return __builtin_bit_cast(float, (unsigned)h << 16); }
DEVFN bf16_t f2bf(float f) { unsigned u = __builtin_bit_cast(unsigned, f); u += 0x7FFFu + ((u >> 16) & 1u); return (bf16_t)(u >> 16); }
template <class T> DEVFN AS1 T* gptr(T* q) { return (AS1 T*)q; }
DEVFN bf16x8 ld8g(const bf16_t* q) { return *(const AS1 bf16x8*)gptr(q); }
DEVFN float sigmoidf_(float x) { return 1.f / (1.f + expf(-x)); }
DEVFN float siluf_(float x) { return x / (1.f + expf(-x)); }
DEVFN float softplusf_(float x) { return x > 20.f ? x : log1pf(expf(x)); }
DEVFN float logsigmoidf_(float x) { return fminf(x, 0.f) - log1pf(expf(-fabsf(x))); }
#ifdef HIPEMU
DEVFN float wave_sum(float v) { for (int m = 32; m >= 1; m >>= 1) v += __shfl_xor(v, m); return v; }
#define SHFL_CONST(x, ln) __shfl(x, ln)
#define XOR8(x, m) __shfl_xor(x, m)
#else
template <int CTRL> DEVFN float dpp_f(float v) { return __builtin_bit_cast(float, __builtin_amdgcn_update_dpp(0, __builtin_bit_cast(int, v), CTRL, 0xF, 0xF, false)); }
template <int CTRL> DEVFN int dpp_i(int v) { return __builtin_amdgcn_update_dpp(0, v, CTRL, 0xF, 0xF, false); }
DEVFN float rdl_f(float v, int ln) { return __builtin_bit_cast(float, __builtin_amdgcn_readlane(__builtin_bit_cast(int, v), ln)); }
DEVFN float wave_sum(float v) {
  v += dpp_f<0xB1>(v);
  v += dpp_f<0x4E>(v);
  v += dpp_f<0x141>(v);
  v += dpp_f<0x140>(v);
  return (rdl_f(v, 0) + rdl_f(v, 16)) + (rdl_f(v, 32) + rdl_f(v, 48));
}
DEVFN float shfl_const_(float x, int ln) { return rdl_f(x, ln); }
DEVFN int shfl_const_(int x, int ln) { return __builtin_amdgcn_readlane(x, ln); }
#define SHFL_CONST(x, ln) shfl_const_(x, ln)
DEVFN float xor8_(float x, int m) { return m == 1 ? dpp_f<0xB1>(x) : m == 2 ? dpp_f<0x4E>(x) : dpp_f<0x141>(x); }
DEVFN int xor8_(int x, int m) { return m == 1 ? dpp_i<0xB1>(x) : m == 2 ? dpp_i<0x4E>(x) : dpp_i<0x141>(x); }
#define XOR8(x, m) xor8_(x, m)
#endif

constexpr size_t al(size_t x) { return (x + 255) & ~(size_t)255; }
struct Ws {
  static constexpr size_t BAR = 0;
  static constexpr size_t CNT = 16384;
  static constexpr size_t MOD = CNT + (size_t)DEPTH_ * 64 * 256;
  static constexpr size_t ZROW = al(MOD + (size_t)DEPTH_ * NR_ * NMOD_ * 4);
  static constexpr size_t ZERO_END = al(ZROW + 2048);
  static constexpr size_t MODP = ZERO_END;
  static constexpr size_t RWT = al(MODP + (size_t)16 * DEPTH_ * NR_ * NMOD_ * 4);
  static constexpr size_t LORA = al(RWT + (size_t)DEPTH_ * 64 * 1024 * 4);
  static constexpr size_t X = al(LORA + (size_t)DEPTH_ * 98304 * 2);
  static constexpr size_t U = al(X + (size_t)NT_ * 1024 * 4);
  static constexpr size_t YMIX = al(U + (size_t)NT_ * 1024 * 2);
  static constexpr size_t ZX = al(YMIX + (size_t)NT_ * 1024 * 2);
  static constexpr size_t MIX = ZX;
  static constexpr size_t LTOK = al(ZX + (size_t)NT_ * NIN_ * 2);
  static constexpr size_t LWT = al(LTOK + (size_t)64 * NT_ * 4);
  static constexpr size_t WIN = al(LWT + (size_t)64 * NT_ * 4);
  static constexpr size_t WOUT = al(WIN + (size_t)DEPTH_ * NIN_ * 1024 * 2);
  static constexpr size_t W13 = al(WOUT + (size_t)DEPTH_ * 1024 * 1024 * 2);
  static constexpr size_t W2T = al(W13 + (size_t)65 * 512 * 1024 * 2);
  static constexpr size_t UNI = al(W2T + (size_t)65 * 1024 * 256 * 2);
  static constexpr size_t XBC = UNI;
  static constexpr size_t XBCT = al(XBC + (size_t)NT_ * 1024 * 2);
  static constexpr size_t DTB = al(XBCT + (size_t)NT_ * 768 * 2);
  static constexpr size_t SST = al(DTB + (size_t)NT_ * 16 * 4);
  static constexpr size_t SCD = al(SST + (size_t)2 * NT_ / 128 * 8 * 8192 * 4);
  static constexpr size_t HIN = al(SCD + (size_t)2 * NT_ / 128 * 8 * 4);
  static constexpr size_t YS = SST;
  static constexpr size_t LA = al(HIN + (size_t)2 * NT_ / 128 * 8 * 8192 * 2);
  static constexpr size_t VT = al(LA + (size_t)2 * NT_ * 128 * 4);
  static constexpr size_t QT = al(VT + (size_t)NT_ * 256 * 2);
  static constexpr size_t OI = al(QT + (size_t)2 * NT_ * 128 * 2);
  static constexpr size_t GST = al(OI + (size_t)NT_ * 256 * 4);
  static constexpr size_t GCD = al(GST + (size_t)2 * NT_ / 64 * 4 * 2048 * 4);
  static constexpr size_t GSIN = al(GCD + (size_t)2 * NT_ / 64 * 4 * 32 * 4);
  static constexpr size_t RR = al(GSIN + (size_t)2 * NT_ / 64 * 4 * 2048 * 2);
  static constexpr size_t VV = RR + (size_t)NT_ * 256 * 2;
  static constexpr size_t KK = VV + (size_t)NT_ * 256 * 2;
  static constexpr size_t KD = KK + (size_t)NT_ * 256 * 2;
  static constexpr size_t BD = KD + (size_t)2 * NT_ * 256 * 2;
  static constexpr size_t LW = BD + (size_t)2 * NT_ * 256 * 2;
  static constexpr size_t GATE = LW + (size_t)2 * NT_ * 256 * 4;
  static constexpr size_t YR = GATE + (size_t)NT_ * 256 * 4;
  static constexpr size_t RML = al(YR + (size_t)2 * NT_ * 256 * 4);
  static constexpr size_t RNS = RML + (size_t)(NT_ / 16) * 8 * 4096 * 2;
  static constexpr size_t RWC = RNS + (size_t)(NT_ / 16) * 8 * 4096 * 2;
  static constexpr size_t RG = RWC + (size_t)(NT_ / 16) * 8 * 64 * 4;
  static constexpr size_t RY0 = RG + (size_t)(NT_ / 16) * 8 * 1024 * 2;
  static constexpr size_t LI = RY0 + (size_t)(NT_ / 16) * 8 * 1024 * 4;
  static constexpr size_t KRW = LI + (size_t)NT_ * 384 * 2;
  static constexpr size_t MIXER_END = KRW + (size_t)NT_ * 256 * 2;
  static constexpr size_t HID = UNI;
  static constexpr size_t YBUF = al(HID + ((size_t)NT_ * 9 + 65 * 128) * 256 * 2);
  static constexpr size_t MOE_END = YBUF + (size_t)NT_ * 9 * 1024 * 2;
  static constexpr size_t END = al(MIXER_END > MOE_END ? MIXER_END : MOE_END);
};

struct Params {
  const float* in[40];
  float* out;
  unsigned char* ws;
};
enum { I_X = 0, I_C, I_CTX, I_CCTX, I_ADAW, I_ADAB, I_WIN, I_CONVW, I_CONVB, I_DTBIAS, I_ALOG, I_SSDD, I_SSDNW, I_MU, I_W0, I_W2, I_A0, I_A2,
       I_G2, I_KKW, I_KAW, I_RK, I_LNXW, I_LNXB, I_GU, I_GB, I_GNW, I_WOUT, I_LN1W, I_LN1B, I_LN2W, I_LN2B, I_RW, I_RB, I_EW1, I_EW3, I_EW2,
       I_SW1, I_SW3, I_SW2 };

#define PH_SMEM 57344
#define SM_PRE (PH_SMEM)
#define SM_TAB (PH_SMEM + 1024)
#define SM_BAR (PH_SMEM + 2032)
#ifdef HIPEMU
#define INP(i) (p.in[i])
#define LAUNDER(x)
#define TIDX ((int)threadIdx.x)
#define BIDX ((int)blockIdx.x)
#define LAUNDER_V(x)
#define UNI(x) (x)
#else
extern __shared__ __align__(16) unsigned char smem_dyn[];
DEVFN const float* inp_lds(int i) {
  const volatile unsigned* t = (const volatile unsigned*)(smem_dyn + SM_TAB) + 2 * i;
  unsigned lo = __builtin_amdgcn_readfirstlane(t[0]), hi = __builtin_amdgcn_readfirstlane(t[1]);
  return (const float*)(((unsigned long long)hi << 32) | lo);
}
#define INP(i) inp_lds(i)
#define LAUNDER(x) asm volatile("" : "+s"(x))
DEVFN int tidx_() { int t = threadIdx.x; asm volatile("" : "+v"(t)); return t; }
DEVFN int bidx_() { int b = blockIdx.x; asm volatile("" : "+s"(b)); return b; }
#define TIDX tidx_()
#define LAUNDER_V(x) asm volatile("" : "+v"(x))
#define BIDX bidx_()
#define UNI(x) __builtin_amdgcn_readfirstlane(x)
#endif
#ifndef HIPEMU
#define XB_TMO      128
#define XB_XCNT(j)  (256  + 64 * (j))
#define XB_XSUB(j)  (1280 + 64 * (j))
#define XB_XGEN(j)  (2304 + 64 * (j))
#define XB_TOP      3328
#define XB_TOPGEN   3392
#define XCD_BAR_WORDS 3456
#define XB_SPIN_CAP (1u << 22)
#define LAS __attribute__((address_space(3)))
__device__ __forceinline__ unsigned xb_ld(unsigned* p)              { return __hip_atomic_load(p, __ATOMIC_RELAXED, __HIP_MEMORY_SCOPE_AGENT); }
__device__ __forceinline__ unsigned xb_add(unsigned* p, unsigned v) { return __hip_atomic_fetch_add(p, v, __ATOMIC_RELAXED, __HIP_MEMORY_SCOPE_AGENT); }
__device__ __forceinline__ unsigned xb_xcc_id() { return (unsigned)__builtin_amdgcn_s_getreg((3 << 11) | 20) & 0xFu; }
#define XB_SPIN(cond, bar) do { unsigned _sp = 0; while (cond) { __builtin_amdgcn_s_sleep(1); \
    if ((++_sp & 255u) == 0u) { if (xb_ld(&(bar)[XB_TMO])) break; if (_sp > XB_SPIN_CAP) { atomicAdd(&(bar)[XB_TMO], 1u); break; } } } } while (0)
struct XcdBarrier { unsigned* bar; unsigned x; volatile LAS unsigned* st; };
__device__ __forceinline__ XcdBarrier xcd_barrier_post(unsigned* bar, volatile LAS unsigned* st) {
    XcdBarrier b; b.bar = bar; b.x = xb_xcc_id(); b.st = st;
    if (threadIdx.x == 0) (void)xb_add(&bar[XB_XCNT(b.x)], 1u);
    return b;
}
__device__ __forceinline__ void xcd_barrier_complete(unsigned* bar, unsigned x, unsigned& nloc, unsigned& nx) {
    const unsigned G = gridDim.x * gridDim.y * gridDim.z;
    unsigned sum, cnt, mine, sp = 0u;
    for (;;) {
        sum = 0u; cnt = 0u; mine = 0u;
#pragma unroll
        for (unsigned j = 0; j < 16; ++j) { const unsigned c = xb_ld(&bar[XB_XCNT(j)]); sum += c; cnt += (c > 0u) ? 1u : 0u; mine = (j == x) ? c : mine; }
        if (sum == G) break;
        __builtin_amdgcn_s_sleep(1);
        if ((++sp & 255u) == 0u) { if (xb_ld(&bar[XB_TMO])) break; if (sp > XB_SPIN_CAP) { atomicAdd(&bar[XB_TMO], 1u); break; } }
    }
    nloc = mine > 0u ? mine : 1u; nx = cnt > 0u ? cnt : 1u;
}
__device__ __forceinline__ void xcd_barrier(const XcdBarrier& b) {
    asm volatile("s_waitcnt vmcnt(0)" ::: "memory");
    __syncthreads();
    if (threadIdx.x == 0) {
        unsigned* bar = b.bar;
        __builtin_amdgcn_s_waitcnt(0);
        unsigned nloc = b.st[0], nx = b.st[1];
        if (nloc == 0u) { xcd_barrier_complete(bar, b.x, nloc, nx); b.st[0] = nloc; b.st[1] = nx; }
        const unsigned old = xb_add(&bar[XB_XSUB(b.x)], 1u);
        const unsigned gen = old / nloc;
        if (old + 1u == (gen + 1u) * nloc) {
            __builtin_amdgcn_fence(__ATOMIC_RELEASE, "agent");
            asm volatile("s_waitcnt vmcnt(0)" ::: "memory");
            const unsigned og = xb_add(&bar[XB_TOP], 1u);
            const unsigned tg = og / nx;
            if (og + 1u == (tg + 1u) * nx) xb_add(&bar[XB_TOPGEN], 1u);
            else XB_SPIN(xb_ld(&bar[XB_TOPGEN]) == tg, bar);
            __builtin_amdgcn_fence(__ATOMIC_ACQUIRE, "agent");
            xb_add(&bar[XB_XGEN(b.x)], 1u);
            asm volatile("s_waitcnt vmcnt(0)" ::: "memory");
        } else {
            XB_SPIN(xb_ld(&bar[XB_XGEN(b.x)]) == gen, bar);
            __builtin_amdgcn_fence(__ATOMIC_ACQUIRE, "agent");
            asm volatile("s_waitcnt vmcnt(0)" ::: "memory");
        }
    }
    __syncthreads();
}
#endif

DEVFN int tokmap(int dir, int p) { return dir == 0 ? p : (p < CTX_ ? CTX_ - 1 - p : 2 * CTX_ + SEQ_ - 1 - p); }
DEVFN const float* tok_input_row(const Params& p, int tok) {
  int b = tok / T_, t = tok % T_;
  return t < CTX_ ? INP(I_CTX) + ((size_t)b * CTX_ + t) * D_ : INP(I_X) + ((size_t)b * SEQ_ + (t - CTX_)) * D_;
}
DEVFN int tok_modrow(int tok) { return (tok % T_) < CTX_ ? B_ : tok / T_; }

template <class ARow, class BRow, class Epi>
DEVFN void gemm_tile(unsigned char* smem, int K, ARow arow, BRow brow, Epi epi) {
  bf16_t* As = (bf16_t*)smem;
  bf16_t* Bs = As + 128 * LDT;
  const int tid = TIDX, lane = tid & 63, wave = tid >> 6, wr = wave >> 1, wc = wave & 1;
  const int g = lane >> 4, l15 = lane & 15;
  const int lr = tid >> 3, lc = (tid & 7) * 8;
  const AS1 bf16_t* ap[4];
  const AS1 bf16_t* bp[4];
#pragma unroll
  for (int i = 0; i < 4; ++i) { ap[i] = gptr(arow(lr + 32 * i)); bp[i] = gptr(brow(lr + 32 * i)); }
  f32x4 acc[4][4];
#pragma unroll
  for (int mi = 0; mi < 4; ++mi)
#pragma unroll
    for (int ni = 0; ni < 4; ++ni) acc[mi][ni] = f32x4{0.f, 0.f, 0.f, 0.f};
  u32x4 ra0[4], rb0[4], ra1[4], rb1[4];
#pragma unroll
  for (int i = 0; i < 4; ++i) { ra0[i] = *(const AS1 u32x4*)(ap[i] + lc); rb0[i] = *(const AS1 u32x4*)(bp[i] + lc); }
  if (K > 64) {
#pragma unroll
    for (int i = 0; i < 4; ++i) { ra1[i] = *(const AS1 u32x4*)(ap[i] + 64 + lc); rb1[i] = *(const AS1 u32x4*)(bp[i] + 64 + lc); } }
  auto compute = [&]() {
#pragma unroll
    for (int kk = 0; kk < 2; ++kk) {
      bf16x8 af[4], bfr[4];
#pragma unroll
      for (int mi = 0; mi < 4; ++mi) af[mi] = *(const bf16x8*)(As + (wr * 64 + mi * 16 + l15) * LDT + kk * 32 + g * 8);
#pragma unroll
      for (int ni = 0; ni < 4; ++ni) bfr[ni] = *(const bf16x8*)(Bs + (wc * 64 + ni * 16 + l15) * LDT + kk * 32 + g * 8);
#pragma unroll
      for (int mi = 0; mi < 4; ++mi)
#pragma unroll
        for (int ni = 0; ni < 4; ++ni) acc[mi][ni] = MFMA16(af[mi], bfr[ni], acc[mi][ni]);
    } };
  for (int k0 = 0; k0 < K; k0 += 128) {
    __syncthreads();
#pragma unroll
    for (int i = 0; i < 4; ++i) { *(u32x4*)(As + (lr + 32 * i) * LDT + lc) = ra0[i]; *(u32x4*)(Bs + (lr + 32 * i) * LDT + lc) = rb0[i]; }
    __syncthreads();
    if (k0 + 128 < K) {
#pragma unroll
      for (int i = 0; i < 4; ++i) { ra0[i] = *(const AS1 u32x4*)(ap[i] + k0 + 128 + lc); rb0[i] = *(const AS1 u32x4*)(bp[i] + k0 + 128 + lc); } }
    compute();
    if (k0 + 64 < K) {
      __syncthreads();
#pragma unroll
      for (int i = 0; i < 4; ++i) { *(u32x4*)(As + (lr + 32 * i) * LDT + lc) = ra1[i]; *(u32x4*)(Bs + (lr + 32 * i) * LDT + lc) = rb1[i]; }
      __syncthreads();
      if (k0 + 192 < K) {
#pragma unroll
        for (int i = 0; i < 4; ++i) { ra1[i] = *(const AS1 u32x4*)(ap[i] + k0 + 192 + lc); rb1[i] = *(const AS1 u32x4*)(bp[i] + k0 + 192 + lc); } }
      compute();
    }
  }
  epi(acc, wr, wc, g, l15);
}

template <int NB, class ARow, class BRow, class Epi>
DEVFN void gemm_tile_multi(unsigned char* smem, int K, ARow arow, BRow brow, Epi epi) {
  bf16_t* As = (bf16_t*)smem;
  bf16_t* Bs = As + 128 * LDT;
  const int tid = TIDX, lane = tid & 63, wave = tid >> 6, wr = wave >> 1, wc = wave & 1;
  const int g = lane >> 4, l15 = lane & 15;
  const int lr = tid >> 3, lc = (tid & 7) * 8;
  const AS1 bf16_t* ap[4];
  const AS1 bf16_t* bp[4];
#pragma unroll
  for (int i = 0; i < 4; ++i) { ap[i] = gptr(arow(lr + 32 * i)); bp[i] = gptr(brow(lr + 32 * i, 0)); }
  f32x4 acc[4][4];
  u32x4 ra0[4], rb0[4], ra1[4], rb1[4];
#pragma unroll
  for (int i = 0; i < 4; ++i) { ra0[i] = *(const AS1 u32x4*)(ap[i] + lc); rb0[i] = *(const AS1 u32x4*)(bp[i] + lc); }
  if (K > 64) {
#pragma unroll
    for (int i = 0; i < 4; ++i) { ra1[i] = *(const AS1 u32x4*)(ap[i] + 64 + lc); rb1[i] = *(const AS1 u32x4*)(bp[i] + 64 + lc); } }
  auto compute = [&]() {
#pragma unroll
    for (int kk = 0; kk < 2; ++kk) {
      bf16x8 af[4], bfr[4];
#pragma unroll
      for (int mi = 0; mi < 4; ++mi) af[mi] = *(const bf16x8*)(As + (wr * 64 + mi * 16 + l15) * LDT + kk * 32 + g * 8);
#pragma unroll
      for (int ni = 0; ni < 4; ++ni) bfr[ni] = *(const bf16x8*)(Bs + (wc * 64 + ni * 16 + l15) * LDT + kk * 32 + g * 8);
#pragma unroll
      for (int mi = 0; mi < 4; ++mi)
#pragma unroll
        for (int ni = 0; ni < 4; ++ni) acc[mi][ni] = MFMA16(af[mi], bfr[ni], acc[mi][ni]);
    } };
#pragma unroll
  for (int j = 0; j < NB; ++j) {
#pragma unroll
  for (int mi = 0; mi < 4; ++mi)
#pragma unroll
    for (int ni = 0; ni < 4; ++ni) acc[mi][ni] = f32x4{0.f, 0.f, 0.f, 0.f};
  for (int k0 = 0; k0 < K; k0 += 128) {
    __syncthreads();
#pragma unroll
    for (int i = 0; i < 4; ++i) { *(u32x4*)(As + (lr + 32 * i) * LDT + lc) = ra0[i]; *(u32x4*)(Bs + (lr + 32 * i) * LDT + lc) = rb0[i]; }
    __syncthreads();
    if (k0 + 128 < K) {
#pragma unroll
      for (int i = 0; i < 4; ++i) { ra0[i] = *(const AS1 u32x4*)(ap[i] + k0 + 128 + lc); rb0[i] = *(const AS1 u32x4*)(bp[i] + k0 + 128 + lc); } }
    compute();
    if (k0 + 64 < K) {
      __syncthreads();
#pragma unroll
      for (int i = 0; i < 4; ++i) { *(u32x4*)(As + (lr + 32 * i) * LDT + lc) = ra1[i]; *(u32x4*)(Bs + (lr + 32 * i) * LDT + lc) = rb1[i]; }
      __syncthreads();
      if (k0 + 192 < K) {
#pragma unroll
        for (int i = 0; i < 4; ++i) { ra1[i] = *(const AS1 u32x4*)(ap[i] + k0 + 192 + lc); rb1[i] = *(const AS1 u32x4*)(bp[i] + k0 + 192 + lc); } }
      compute();
    }
  }
  if (j + 1 < NB) {
#pragma unroll
    for (int i = 0; i < 4; ++i) { bp[i] = gptr(brow(lr + 32 * i, j + 1)); ra0[i] = *(const AS1 u32x4*)(ap[i] + lc); rb0[i] = *(const AS1 u32x4*)(bp[i] + lc); } }
  epi(acc, j, wr, wc, g, l15);
  if (j + 1 < NB) {
#pragma unroll
    for (int i = 0; i < 4; ++i) { ra1[i] = *(const AS1 u32x4*)(ap[i] + 64 + lc); rb1[i] = *(const AS1 u32x4*)(bp[i] + 64 + lc); } }
  }
}

template <int NB, int LDB, class ARow, class BBase, class Epi>
DEVFN void gemm_tile_w(unsigned char* smem, int K, ARow arow, BBase bbase, Epi epi) {
  bf16_t* As = (bf16_t*)smem;
  bf16_t* Bs = As + 128 * LDT;
  const int tid = TIDX, lane = tid & 63, wave = tid >> 6, wr = wave >> 1, wc = wave & 1;
  const int g = lane >> 4, l15 = lane & 15;
  const int lr = tid >> 3, lc = (tid & 7) * 8;
  const AS1 bf16_t* ap[4];
#pragma unroll
  for (int i = 0; i < 4; ++i) ap[i] = gptr(arow(lr + 32 * i));
  const AS1 bf16_t* bb = gptr(bbase(0));
  const unsigned boff = (unsigned)(lr * LDB + lc);
  f32x4 acc[4][8];
  u32x4 ra[4], rb[8];
#pragma unroll
  for (int i = 0; i < 4; ++i) ra[i] = *(const AS1 u32x4*)(ap[i] + lc);
#pragma unroll
  for (int i = 0; i < 8; ++i) rb[i] = *(const AS1 u32x4*)(bb + (size_t)(i * 32 * LDB) + boff);
#pragma unroll
  for (int j = 0; j < NB; ++j) {
#pragma unroll
    for (int mi = 0; mi < 4; ++mi)
#pragma unroll
      for (int ni = 0; ni < 8; ++ni) acc[mi][ni] = f32x4{0.f, 0.f, 0.f, 0.f};
#pragma unroll 1
    for (int k0 = 0; k0 < K; k0 += 64) {
      __syncthreads();
#pragma unroll
      for (int i = 0; i < 4; ++i) *(u32x4*)(As + (lr + 32 * i) * LDT + lc) = ra[i];
#pragma unroll
      for (int i = 0; i < 8; ++i) *(u32x4*)(Bs + (lr + 32 * i) * LDT + lc) = rb[i];
      __syncthreads();
      if (k0 + 64 < K) {
#pragma unroll
        for (int i = 0; i < 4; ++i) ra[i] = *(const AS1 u32x4*)(ap[i] + k0 + 64 + lc);
#pragma unroll
        for (int i = 0; i < 8; ++i) rb[i] = *(const AS1 u32x4*)(bb + (size_t)(i * 32 * LDB + k0 + 64) + boff);
      }
#pragma unroll
      for (int kk = 0; kk < 2; ++kk) {
        bf16x8 af[4];
#pragma unroll
        for (int mi = 0; mi < 4; ++mi) af[mi] = *(const bf16x8*)(As + (wr * 64 + mi * 16 + l15) * LDT + kk * 32 + g * 8);
#pragma unroll
        for (int h = 0; h < 2; ++h) {
          bf16x8 bfr[4];
#pragma unroll
          for (int ni = 0; ni < 4; ++ni) bfr[ni] = *(const bf16x8*)(Bs + (wc * 128 + h * 64 + ni * 16 + l15) * LDT + kk * 32 + g * 8);
#pragma unroll
          for (int mi = 0; mi < 4; ++mi)
#pragma unroll
            for (int ni = 0; ni < 4; ++ni) acc[mi][h * 4 + ni] = MFMA16(af[mi], bfr[ni], acc[mi][h * 4 + ni]);
        }
      }
    }
    if (j + 1 < NB) {
      bb = gptr(bbase(j + 1));
#pragma unroll
      for (int i = 0; i < 4; ++i) ra[i] = *(const AS1 u32x4*)(ap[i] + lc);
#pragma unroll
      for (int i = 0; i < 8; ++i) rb[i] = *(const AS1 u32x4*)(bb + (size_t)(i * 32 * LDB) + boff); }
    epi(acc, j, wr, wc, g, l15);
  }
}

template <int NCH, class Val, class RowP>
DEVFN void tile_store_bf16(unsigned char* smem, int wr, int g, int l15, Val val, RowP rowp) {
  constexpr int LDC = NCH * 8 + 8;
  bf16_t* T = (bf16_t*)smem;
  const int tid = TIDX;
  __syncthreads();
  val(T, LDC);
  __syncthreads();
#pragma unroll
  for (int pass = 0; pass < NCH / 2; ++pass) { const int id = tid + 256 * pass, row = id / NCH, c = id % NCH;
    bf16_t* dst = rowp(row, c * 8);
    if (dst) *(AS1 u32x4*)gptr(dst) = *(const u32x4*)(T + row * LDC + c * 8); }
  (void)wr; (void)g; (void)l15;
}
DEVFN void cvt_tile(unsigned char* smem, const float* src, int K, int N, int k0, int n0, bf16_t* dst, int ldd, int mode) {
  float* s = (float*)smem;
  const int tid = TIDX;
  const AS1 float* gsrc = gptr(src);
  __syncthreads();
  { const int kk = tid >> 4, n4 = (tid & 15) * 4;
#pragma unroll
    for (int pass = 0; pass < 4; ++pass) { const int k = kk + 16 * pass;
      f32x4 v = f32x4{0.f, 0.f, 0.f, 0.f};
      if (n0 + n4 < N) v = *(const AS1 f32x4*)(gsrc + (size_t)(k0 + k) * N + n0 + n4);
      s[k * 65 + n4] = v[0]; s[k * 65 + n4 + 1] = v[1]; s[k * 65 + n4 + 2] = v[2]; s[k * 65 + n4 + 3] = v[3]; } }
  __syncthreads();
  { const int nn = tid >> 2, k16 = (tid & 3) * 16, n = n0 + nn;
    if (n < N) { const int row = mode == 0 ? n : ((n >> 4) * 32 + (n & 15) + (mode == 2 ? 16 : 0));
      u32x4 o0, o1;
#pragma unroll
      for (int j = 0; j < 4; ++j) { o0[j] = (unsigned)f2bf(s[(k16 + 2 * j) * 65 + nn]) | ((unsigned)f2bf(s[(k16 + 2 * j + 1) * 65 + nn]) << 16);
        o1[j] = (unsigned)f2bf(s[(k16 + 8 + 2 * j) * 65 + nn]) | ((unsigned)f2bf(s[(k16 + 9 + 2 * j) * 65 + nn]) << 16); }
      AS1 bf16_t* d = gptr(dst) + (size_t)row * ldd + k0 + k16;
      *(AS1 u32x4*)d = o0; *(AS1 u32x4*)(d + 8) = o1; } }
  (void)K;
}
struct CvtJob { const float* src; bf16_t* dst; int N, k0, n0, ldd, mode; };
DEVFN void cvt_load(const CvtJob& j, f32x4 (&v)[4]) {
  const int tid = TIDX, kk = tid >> 4, n4 = (tid & 15) * 4;
  const AS1 float* g = gptr(j.src);
#pragma unroll
  for (int pass = 0; pass < 4; ++pass) { v[pass] = f32x4{0.f, 0.f, 0.f, 0.f};
    if (j.n0 + n4 < j.N) v[pass] = *(const AS1 f32x4*)(g + (size_t)(j.k0 + kk + 16 * pass) * j.N + j.n0 + n4); }
}
DEVFN void cvt_store(unsigned char* smem, const CvtJob& j, const f32x4 (&v)[4]) {
  float* s = (float*)smem;
  const int tid = TIDX, kk = tid >> 4, n4 = (tid & 15) * 4;
  __syncthreads();
#pragma unroll
  for (int pass = 0; pass < 4; ++pass) { const int k = kk + 16 * pass; s[k * 65 + n4] = v[pass][0]; s[k * 65 + n4 + 1] = v[pass][1]; s[k * 65 + n4 + 2] = v[pass][2]; s[k * 65 + n4 + 3] = v[pass][3]; }
  __syncthreads();
  const int nn = tid >> 2, k16 = (tid & 3) * 16, n = j.n0 + nn;
  if (n < j.N) { const int row = j.mode == 0 ? n : ((n >> 4) * 32 + (n & 15) + (j.mode == 2 ? 16 : 0));
    u32x4 o0, o1;
#pragma unroll
    for (int q = 0; q < 4; ++q) { o0[q] = (unsigned)f2bf(s[(k16 + 2 * q) * 65 + nn]) | ((unsigned)f2bf(s[(k16 + 2 * q + 1) * 65 + nn]) << 16);
      o1[q] = (unsigned)f2bf(s[(k16 + 8 + 2 * q) * 65 + nn]) | ((unsigned)f2bf(s[(k16 + 9 + 2 * q) * 65 + nn]) << 16); }
    AS1 bf16_t* d = gptr(j.dst) + (size_t)row * j.ldd + j.k0 + k16;
    *(AS1 u32x4*)d = o0; *(AS1 u32x4*)(d + 8) = o1; }
}
DEVFN CvtJob moe_cvt_job(const Params& p, int l, int u) {
  bf16_t* w13 = (bf16_t*)(p.ws + Ws::W13); bf16_t* w2t = (bf16_t*)(p.ws + Ws::W2T);
  const int e = u / 192, r = u % 192, which = r / 64, t = r % 64;
  CvtJob j;
  if (which < 2) {
    j.src = e < 64 ? (which == 0 ? INP(I_EW1) : INP(I_EW3)) + ((size_t)l * 64 + e) * 1024 * 256 : (which == 0 ? INP(I_SW1) : INP(I_SW3)) + (size_t)l * 1024 * 256;
    j.N = 256; j.k0 = (t >> 2) * 64; j.n0 = (t & 3) * 64; j.dst = w13 + (size_t)e * 512 * 1024; j.ldd = 1024; j.mode = which == 0 ? 1 : 2;
  } else {
    j.src = e < 64 ? INP(I_EW2) + ((size_t)l * 64 + e) * 256 * 1024 : INP(I_SW2) + (size_t)l * 256 * 1024;
    j.N = 1024; j.k0 = (t >> 4) * 64; j.n0 = (t & 15) * 64; j.dst = w2t + (size_t)e * 1024 * 256; j.ldd = 256; j.mode = 0;
  }
  return j;
}
DEVFN void convert_moe_weights(const Params& p, int l, unsigned char* smem, int bid, int nb) {
  const int total = 65 * 192;
  if (bid >= total) return;
  f32x4 v[4], vn[4];
  CvtJob j = moe_cvt_job(p, l, bid);
  cvt_load(j, v);
  for (int u = bid; u < total; u += nb) {
    const int un = u + nb;
    CvtJob jn = j;
    if (un < total) { jn = moe_cvt_job(p, l, un); cvt_load(jn, vn); }
    cvt_store(smem, j, v);
    j = jn;
#pragma unroll
    for (int q = 0; q < 4; ++q) v[q] = vn[q];
  }
}
DEVFN void phase0(const Params& p, unsigned char* smem) {
  const int tid = TIDX;
  float* modp = (float*)(p.ws + Ws::MODP);
  for (int u = BIDX; u < DEPTH_ * 24 * 16; u += gridDim.x) {
    int l = u / (24 * 16), jb = (u / 16) % 24, ks = u % 16;
    float* sc = (float*)smem;
    __syncthreads();
    for (int e = tid; e < NR_ * 64; e += 256) { int r = e / 64, i = ks * 64 + (e % 64); float cv = r < B_ ? INP(I_C)[(size_t)r * D_ + i] : INP(I_CCTX)[i]; sc[e] = siluf_(cv); }
    __syncthreads();
    int j = jb * 256 + tid;
    float acc[NR_];
#pragma unroll
    for (int r = 0; r < NR_; ++r) acc[r] = 0.f;
    const float* w = INP(I_ADAW) + ((size_t)l * D_ + ks * 64) * NMOD_ + j;
#pragma unroll 4
    for (int i = 0; i < 64; ++i) { float wv = w[(size_t)i * NMOD_];
#pragma unroll
      for (int r = 0; r < NR_; ++r) acc[r] += sc[r * 64 + i] * wv; }
#pragma unroll
    for (int r = 0; r < NR_; ++r) modp[(((size_t)ks * DEPTH_ + l) * NR_ + r) * NMOD_ + j] = acc[r];
  }
  bf16_t* win = (bf16_t*)(p.ws + Ws::WIN);
  bf16_t* wout = (bf16_t*)(p.ws + Ws::WOUT);
  for (int u = BIDX; u < DEPTH_ * 16 * 55; u += gridDim.x) {
    int l = u / (16 * 55), r = u % (16 * 55);
    cvt_tile(smem, INP(I_WIN) + (size_t)l * 1024 * NIN_, 1024, NIN_, (r / 55) * 64, (r % 55) * 64, win + (size_t)l * NIN_ * 1024, 1024, 0);
  }
  for (int u = BIDX; u < DEPTH_ * 256; u += gridDim.x) {
    int l = u / 256, r = u % 256;
    cvt_tile(smem, INP(I_WOUT) + (size_t)l * 1024 * 1024, 1024, 1024, (r / 16) * 64, (r % 16) * 64, wout + (size_t)l * 1024 * 1024, 1024, 0);
  }
  { bf16_t* lo = (bf16_t*)(p.ws + Ws::LORA);
    for (int u = BIDX * 256 + tid; u < DEPTH_ * 98304; u += gridDim.x * 256) {
      const int l = u / 98304, r = u % 98304; float v;
      if (r < 32768) { const int d = r >> 14, n = (r >> 6) & 255, k = r & 63; v = INP(I_W2)[(((size_t)l * 2 + d) * 64 + k) * 256 + n]; }
      else if (r < 65536) { const int r2 = r - 32768, d = r2 >> 14, n = (r2 >> 6) & 255, k = r2 & 63; v = INP(I_A2)[(((size_t)l * 2 + d) * 64 + k) * 256 + n]; }
      else { const int r2 = r - 65536, n = r2 >> 7, k = r2 & 127; v = INP(I_G2)[((size_t)l * 128 + k) * 256 + n]; }
      lo[u] = f2bf(v); } }
  float* rwt = (float*)(p.ws + Ws::RWT);
  for (int u = BIDX * 256 + tid; u < DEPTH_ * 64 * 1024; u += gridDim.x * 256) {
    int l = u / (64 * 1024), e = (u / 1024) % 64, i = u % 1024;
    rwt[u] = INP(I_RW)[((size_t)l * 1024 + i) * 64 + e];
  }
}

DEVFN void phase0b(const Params& p) {
  float* mod = (float*)(p.ws + Ws::MOD); const float* modp = (const float*)(p.ws + Ws::MODP);
  for (int u = BIDX * 256 + TIDX; u < DEPTH_ * NR_ * NMOD_; u += gridDim.x * 256) {
    int l = u / (NR_ * NMOD_), j = u % NMOD_;
    float s = INP(I_ADAB)[(size_t)l * NMOD_ + j];
    for (int ks = 0; ks < 16; ++ks) s += modp[(size_t)ks * DEPTH_ * NR_ * NMOD_ + u];
    mod[u] = s;
  }
}

DEVFN void row_stats(const float (&v)[16], float& mean, float& rstd) {
  float s = 0.f;
#pragma unroll
  for (int i = 0; i < 16; ++i) s += v[i];
  mean = wave_sum(s) * (1.f / 1024.f);
  float q = 0.f;
#pragma unroll
  for (int i = 0; i < 16; ++i) { float d = v[i] - mean; q += d * d; }
  rstd = rsqrtf(wave_sum(q) * (1.f / 1024.f) + 1e-5f);
}
DEVFN void load_row16(const float* row, int lane, float (&v)[16]) {
  const AS1 float* r = gptr(row);
#pragma unroll
  for (int j = 0; j < 4; ++j) { const f32x4 t = *(const AS1 f32x4*)(r + lane * 4 + 256 * j); v[4 * j] = t[0]; v[4 * j + 1] = t[1]; v[4 * j + 2] = t[2]; v[4 * j + 3] = t[3]; }
}
DEVFN void moe_residual_row(const Params& p, int lp, int tok, int lane, float (&xv)[16]) {
  const float* mod = (const float*)(p.ws + Ws::MOD) + ((size_t)lp * NR_ + tok_modrow(tok)) * NMOD_;
  const bf16_t* yb = (const bf16_t*)(p.ws + Ws::YBUF) + (size_t)tok * NSLOT * 1024;
  float g2[16], w[16], b[16];
  load_row16(mod + 5 * 1024, lane, g2);
  load_row16(INP(I_LN2W) + (size_t)lp * 1024, lane, w);
  load_row16(INP(I_LN2B) + (size_t)lp * 1024, lane, b);
  u32x2 sl[NSLOT][4];
#pragma unroll
  for (int s = 0; s < NSLOT; ++s)
#pragma unroll
    for (int j = 0; j < 4; ++j) sl[s][j] = *(const AS1 u32x2*)gptr(yb + (size_t)s * 1024 + lane * 4 + 256 * j);
  float f[16];
#pragma unroll
  for (int i = 0; i < 16; ++i) f[i] = 0.f;
#pragma unroll
  for (int s = 0; s < NSLOT; ++s)
#pragma unroll
    for (int j = 0; j < 4; ++j) { const u32x2 t = sl[s][j];
      f[4 * j] += bf2f((bf16_t)(t[0] & 0xFFFF)); f[4 * j + 1] += bf2f((bf16_t)(t[0] >> 16)); f[4 * j + 2] += bf2f((bf16_t)(t[1] & 0xFFFF)); f[4 * j + 3] += bf2f((bf16_t)(t[1] >> 16)); }
#pragma unroll
  for (int i = 0; i < 16; ++i) xv[i] = ALPHA_ * xv[i] + g2[i] * f[i];
  float mean, rstd;
  row_stats(xv, mean, rstd);
#pragma unroll
  for (int i = 0; i < 16; ++i) xv[i] = (xv[i] - mean) * rstd * w[i] + b[i];
}
DEVFN void phase1(const Params& p, int l) {
  const int lane = TIDX & 63, wave = TIDX >> 6;
  float* X = (float*)(p.ws + Ws::X);
  bf16_t* U = (bf16_t*)(p.ws + Ws::U);
  for (int tok = BIDX * 4 + wave; tok < NT_; tok += gridDim.x * 4) {
    float xv[16], sh[16], sc[16], mean, rstd;
    const float* mod = (const float*)(p.ws + Ws::MOD) + ((size_t)l * NR_ + tok_modrow(tok)) * NMOD_;
    load_row16(mod, lane, sh);
    load_row16(mod + 1024, lane, sc);
    if (l == 0) load_row16(tok_input_row(p, tok), lane, xv);
    else { load_row16(X + (size_t)tok * 1024, lane, xv); moe_residual_row(p, l - 1, tok, lane, xv); }
#pragma unroll
    for (int j = 0; j < 4; ++j) *(float4*)(X + (size_t)tok * 1024 + lane * 4 + 256 * j) = make_float4(xv[4 * j], xv[4 * j + 1], xv[4 * j + 2], xv[4 * j + 3]);
    row_stats(xv, mean, rstd);
#pragma unroll
    for (int j = 0; j < 4; ++j) {
      float u0 = (xv[4 * j] - mean) * rstd * (1.f + sc[4 * j]) + sh[4 * j], u1 = (xv[4 * j + 1] - mean) * rstd * (1.f + sc[4 * j + 1]) + sh[4 * j + 1];
      float u2 = (xv[4 * j + 2] - mean) * rstd * (1.f + sc[4 * j + 2]) + sh[4 * j + 2], u3 = (xv[4 * j + 3] - mean) * rstd * (1.f + sc[4 * j + 3]) + sh[4 * j + 3];
      *(uint2*)(U + (size_t)tok * 1024 + lane * 4 + 256 * j) = make_uint2((unsigned)f2bf(u0) | ((unsigned)f2bf(u1) << 16), (unsigned)f2bf(u2) | ((unsigned)f2bf(u3) << 16));
    }
  }
}
DEVFN void phase_final(const Params& p) {
  const int lane = TIDX & 63, wave = TIDX >> 6;
  const float* X = (const float*)(p.ws + Ws::X);
  for (int r = BIDX * 4 + wave; r < B_ * SEQ_; r += gridDim.x * 4) {
    int b = r / SEQ_, s = r % SEQ_, tok = b * T_ + CTX_ + s;
    float xv[16];
    load_row16(X + (size_t)tok * 1024, lane, xv);
    moe_residual_row(p, DEPTH_ - 1, tok, lane, xv);
#pragma unroll
    for (int j = 0; j < 4; ++j) *(float4*)(p.out + (size_t)r * 1024 + lane * 4 + 256 * j) = make_float4(xv[4 * j], xv[4 * j + 1], xv[4 * j + 2], xv[4 * j + 3]);
  }
}

DEVFN void phase2(const Params& p, int l, unsigned char* smem) {
  const bf16_t* U = (const bf16_t*)(p.ws + Ws::U);
  const bf16_t* W = (const bf16_t*)(p.ws + Ws::WIN) + (size_t)l * NIN_ * 1024;
  bf16_t* ZX = (bf16_t*)(p.ws + Ws::ZX);
  const int nct = (NIN_ + 255) / 256;
  for (int u = BIDX; u < (NT_ / 128) * nct; u += gridDim.x) {
    int rt = u / nct, ct = u % nct;
    gemm_tile_w<1, 1024>(smem, 1024,
      [&](int r) { return U + (size_t)(rt * 128 + r) * 1024; },
      [&](int) { return W + (size_t)(ct * 256) * 1024; },
      [&](f32x4 (&acc)[4][8], int, int wr, int wc, int g, int l15) {
#pragma unroll 1
        for (int h = 0; h < 2; ++h)
          tile_store_bf16<16>(smem, wr, g, l15,
            [&](bf16_t* T, int ldc) {
              if (wc == h) {
#pragma unroll
                for (int mi = 0; mi < 4; ++mi)
#pragma unroll
                  for (int ni = 0; ni < 8; ++ni)
#pragma unroll
                    for (int i = 0; i < 4; ++i) T[(wr * 64 + mi * 16 + 4 * g + i) * ldc + ni * 16 + l15] = f2bf(acc[mi][ni][i]); } },
            [&](int row, int c0) { const int col = ct * 256 + h * 128 + c0; return col < NIN_ ? ZX + (size_t)(rt * 128 + row) * NIN_ + col : (bf16_t*)nullptr; });
      });
  }
}

DEVFN float zxv(const bf16_t* ZX, int tok, int col) { return bf2f(gptr(ZX)[(size_t)tok * NIN_ + col]); }
struct Nbr { int n; int tok[4]; };
DEVFN Nbr shift_nbrs(int tok) {
  Nbr nb; int b = tok / T_, t = tok % T_;
  if (t < CTX_) { nb.n = 2; nb.tok[0] = t > 0 ? tok - 1 : -1; nb.tok[1] = t < CTX_ - 1 ? tok + 1 : -1; nb.tok[2] = -1; nb.tok[3] = -1; }
  else { int s = t - CTX_, row = s / 64, col = s % 64; nb.n = 4; nb.tok[0] = col > 0 ? tok - 1 : -1; nb.tok[1] = col < 63 ? tok + 1 : -1;
    nb.tok[2] = row > 0 ? tok - 64 : -1; nb.tok[3] = row < SEQ_ / 64 - 1 ? tok + 64 : -1; }
  (void)b; return nb;
}
DEVFN float shiftmix(const bf16_t* ZX, const float* mu, int tok, const Nbr& nb, int ch) {
  float z = zxv(ZX, tok, ORW + ch), o = z;
#pragma unroll
  for (int j = 0; j < 4; ++j) if (j < nb.n) { float v = nb.tok[j] >= 0 ? zxv(ZX, nb.tok[j], ORW + ch) : 0.f; o += mu[j * 1152 + ch] * (v - z); }
  return o;
}
#define LI_LD 392
#define KL_LD 264
DEVFN void phase3(const Params& p, int l, unsigned char* smem) {
  const int tid = TIDX, lane = tid & 63, wave = tid >> 6, q = lane >> 4, l15 = lane & 15;
  const bf16_t* ZX = (const bf16_t*)(p.ws + Ws::ZX);
  bf16_t* XBC = (bf16_t*)(p.ws + Ws::XBC); float* DTB = (float*)(p.ws + Ws::DTB);
  bf16_t* RR = (bf16_t*)(p.ws + Ws::RR); bf16_t* VV = (bf16_t*)(p.ws + Ws::VV); bf16_t* KKb = (bf16_t*)(p.ws + Ws::KK);
  bf16_t* KRW = (bf16_t*)(p.ws + Ws::KRW); bf16_t* LIg = (bf16_t*)(p.ws + Ws::LI);
  float* LA = (float*)(p.ws + Ws::LA);
  const float* convw = INP(I_CONVW) + (size_t)l * 3 * 1024; const float* convb = INP(I_CONVB) + (size_t)l * 1024;
  const float* mu = INP(I_MU) + (size_t)l * 4 * 1152;
  float* gdl = (float*)smem;
  const float kkw = INP(I_KKW)[(size_t)l * 256 + tid];
  for (int wu = BIDX; wu < 2 * (NT_ / 16); wu += gridDim.x) {
    const int tile = wu >> 1, part = wu & 1;
    const int tok0 = tile * 16, t0 = tok0 % T_, bb = tok0 / T_;
    const bool isctx = t0 < CTX_;
    const int s0 = t0 - CTX_;
    const bool lval = isctx ? (t0 > 0) : ((s0 & 63) != 0), rval = isctx ? (t0 + 16 < CTX_) : ((s0 & 63) != 48);
    const bool uval = !isctx && (s0 >= 64), dval = !isctx && (s0 + 64 < SEQ_);
    if (part == 0) {
    __syncthreads();
    {
      const bool segstart = (t0 == 0 || t0 == CTX_), segend = (t0 + 16 == CTX_ || t0 + 16 == T_);
      bf16_t* XBCT = (bf16_t*)(p.ws + Ws::XBCT) + ((size_t)(bb * NC128 + t0 / 128) * 768) * 128 + (t0 % 128);
#pragma unroll 1
      for (int j = 0; j < 4; ++j) { const int c = tid + 256 * j;
        const AS1 bf16_t* zp = gptr(ZX) + (size_t)tok0 * NIN_ + OXBC + c - NIN_; AS1 bf16_t* xp = gptr(XBC) + (size_t)tok0 * 1024 + c;
        float z[18];
#pragma unroll
        for (int i = 0; i < 18; ++i) { z[i] = ((i == 0 && segstart) || (i == 17 && segend)) ? 0.f : bf2f(*zp); zp += NIN_; LAUNDER_V(zp); }
        const float w0 = convw[c], w1 = convw[1024 + c], w2 = convw[2048 + c], cb = convb[c];
        bf16_t y[16];
#pragma unroll
        for (int i = 0; i < 16; ++i) { y[i] = f2bf(siluf_(cb + w0 * z[i] + w1 * z[i + 1] + w2 * z[i + 2])); *xp = y[i]; xp += 1024; LAUNDER_V(xp); }
        if (c < 768) {
          u32x4 o0, o1;
#pragma unroll
          for (int i = 0; i < 4; ++i) { o0[i] = (unsigned)y[2 * i] | ((unsigned)y[2 * i + 1] << 16); o1[i] = (unsigned)y[8 + 2 * i] | ((unsigned)y[9 + 2 * i] << 16); }
          *(u32x4*)(XBCT + (size_t)c * 128) = o0; *(u32x4*)(XBCT + (size_t)c * 128 + 8) = o1; } }
      { bf16_t* VTp = (bf16_t*)(p.ws + Ws::VT) + ((size_t)(bb * NC64 + t0 / 64) * 256 + tid) * 64 + (t0 % 64);
        const AS1 bf16_t* vp = gptr(ZX) + (size_t)tok0 * NIN_ + OGV + tid;
        u32x4 o0, o1;
        bf16_t vv16[16];
#pragma unroll
        for (int i = 0; i < 16; ++i) { vv16[i] = *vp; vp += NIN_; LAUNDER_V(vp); }
#pragma unroll
        for (int i = 0; i < 4; ++i) { o0[i] = (unsigned)vv16[2 * i] | ((unsigned)vv16[2 * i + 1] << 16); o1[i] = (unsigned)vv16[8 + 2 * i] | ((unsigned)vv16[9 + 2 * i] << 16); }
        *(u32x4*)VTp = o0; *(u32x4*)(VTp + 8) = o1; }
      DTB[(size_t)tok0 * 16 + tid] = softplusf_(zxv(ZX, tok0 + (tid >> 4), ODT + (tid & 15)) + INP(I_DTBIAS)[(size_t)l * 16 + (tid & 15)]);
      gdl[tid] = zxv(ZX, tok0 + (tid >> 5), OGD + (tid & 31)); gdl[256 + tid] = zxv(ZX, tok0 + 8 + (tid >> 5), OGD + (tid & 31));
    }
    } else {
#pragma unroll 1
    for (int g = 0; g < 5; ++g) {
      const bool act = !(g == 4 && tid >= 128);
      const int ch = act ? g * 256 + tid : 0;
      const AS1 bf16_t* zp0 = gptr(ZX) + (size_t)tok0 * NIN_ + ORW + ch;
      const AS1 bf16_t* zp = zp0 - NIN_;
      const float m0 = mu[ch], m1 = mu[1152 + ch], m2 = mu[2304 + ch], m3 = mu[3456 + ch];
      float z[18], o[16];
#pragma unroll
      for (int i = 0; i < 18; ++i) { z[i] = ((i == 0 && !lval) || (i == 17 && !rval)) ? 0.f : bf2f(*zp); zp += NIN_; LAUNDER_V(zp); }
#pragma unroll
      for (int i = 0; i < 16; ++i) o[i] = z[i + 1] + m0 * (z[i] - z[i + 1]) + m1 * (z[i + 2] - z[i + 1]);
      if (!isctx) {
        const AS1 bf16_t* up = zp0 - (size_t)64 * NIN_; const AS1 bf16_t* dn = zp0 + (size_t)64 * NIN_;
#pragma unroll
        for (int i = 0; i < 16; ++i) { const float zu = uval ? bf2f(*up) : 0.f, zd = dval ? bf2f(*dn) : 0.f; up += NIN_; dn += NIN_; LAUNDER_V(up); LAUNDER_V(dn);
          o[i] += m2 * (zu - z[i + 1]) + m3 * (zd - z[i + 1]); } }
      if (g == 0) { AS1 bf16_t* rp = gptr(RR) + (size_t)tok0 * 256 + tid;
#pragma unroll
        for (int i = 0; i < 16; ++i) { *rp = f2bf(o[i]); rp += 256; LAUNDER_V(rp); }
      } else if (g == 1) { AS1 bf16_t* kp = gptr(KKb) + (size_t)tok0 * 256 + tid; AS1 bf16_t* krp = gptr(KRW) + (size_t)tok0 * 256 + tid;
#pragma unroll
        for (int i = 0; i < 16; ++i) { const float kq = o[i] * kkw, nrm = sqrtf(wave_sum(kq * kq));
          *kp = f2bf(kq / fmaxf(nrm, 1e-12f)); *krp = f2bf(o[i]); kp += 256; krp += 256; LAUNDER_V(kp); LAUNDER_V(krp); }
      } else if (g == 2) { AS1 bf16_t* vp2 = gptr(VV) + (size_t)tok0 * 256 + tid;
#pragma unroll
        for (int i = 0; i < 16; ++i) { *vp2 = f2bf(o[i]); vp2 += 256; LAUNDER_V(vp2); }
      } else if (g == 3) { AS1 bf16_t* lp = gptr(LIg) + (size_t)tok0 * 384 + tid;
#pragma unroll
        for (int i = 0; i < 16; ++i) { *lp = f2bf(tid < 128 ? tanhf(o[i]) : o[i]); lp += 384; LAUNDER_V(lp); }
      } else if (act) { AS1 bf16_t* lp = gptr(LIg) + (size_t)tok0 * 384 + 256 + tid;
#pragma unroll
        for (int i = 0; i < 16; ++i) { *lp = f2bf(sigmoidf_(o[i])); lp += 384; LAUNDER_V(lp); }
      }
    }
    }
    if (part == 0) {
    __syncthreads();
    { const int d = tid >> 7, c = tid & 127; const float* gu = INP(I_GU) + ((size_t)l * 2 + d) * 16 * 128; const float gb = INP(I_GB)[((size_t)l * 2 + d) * 128 + c];
      float guw[16];
#pragma unroll
      for (int i = 0; i < 16; ++i) guw[i] = gu[i * 128 + c];
#pragma unroll 4
      for (int tt = 0; tt < 16; ++tt) { float sacc = gb;
#pragma unroll
        for (int i = 0; i < 16; ++i) sacc += gdl[tt * 32 + d * 16 + i] * guw[i];
        LA[((size_t)d * NT_ + tok0 + tt) * 128 + c] = logsigmoidf_(sacc) * (1.f / 16.f); } }
    }
  }
}

DEVFN void phase3b(const Params& p, int l, unsigned char* smem) {
  const bf16_t* LIg = (const bf16_t*)(p.ws + Ws::LI);
  const bf16_t* lora = (const bf16_t*)(p.ws + Ws::LORA) + (size_t)l * 98304;
  const bf16_t* KRg = (const bf16_t*)(p.ws + Ws::KRW); const bf16_t* KKg = (const bf16_t*)(p.ws + Ws::KK);
  float* LWp = (float*)(p.ws + Ws::LW); bf16_t* KD = (bf16_t*)(p.ws + Ws::KD); bf16_t* BD = (bf16_t*)(p.ws + Ws::BD); float* GATE = (float*)(p.ws + Ws::GATE);
  for (int u = BIDX; u < (NT_ / 128) * 10; u += gridDim.x) {
    const int rt = u / 10, which = (u % 10) >> 1, ct = u & 1;
    const int K = which < 4 ? 64 : 128, acol = which < 4 ? which * 64 : 256;
    const bf16_t* wb = which < 2 ? lora + (size_t)which * 16384 : which < 4 ? lora + 32768 + (size_t)(which - 2) * 16384 : lora + 65536;
    const float* bias = which < 2 ? INP(I_W0) + (size_t)l * 512 + which * 256 : INP(I_A0) + (size_t)l * 512 + (which & 1) * 256;
    const float* kav = INP(I_KAW) + (size_t)l * 256;
    gemm_tile(smem, K,
      [&](int r) { return LIg + (size_t)(rt * 128 + r) * 384 + acol; },
      [&](int r) { return wb + (size_t)(ct * 128 + r) * K; },
      [&](f32x4 (&acc)[4][4], int wr, int wc, int g, int l15) {
        const int tid = TIDX;
        if (which == 2 || which == 3) {
          bf16_t* T = (bf16_t*)smem; constexpr int LDC = 136;
          __syncthreads();
#pragma unroll
          for (int ni = 0; ni < 4; ++ni) { const int cl = wc * 64 + ni * 16 + l15; const float bv = bias[ct * 128 + cl];
#pragma unroll
            for (int mi = 0; mi < 4; ++mi)
#pragma unroll
              for (int i = 0; i < 4; ++i) T[(wr * 64 + mi * 16 + 4 * g + i) * LDC + cl] = f2bf(sigmoidf_(acc[mi][ni][i] + bv)); }
          __syncthreads();
          const int c = tid & 15, col0 = ct * 128 + c * 8;
          float ka[8];
#pragma unroll
          for (int j = 0; j < 8; ++j) ka[j] = kav[col0 + j];
          const size_t dofs = (size_t)(which - 2) * NT_ * 256;
#pragma unroll
          for (int pass = 0; pass < 8; ++pass) { const int row = (tid >> 4) + 16 * pass; const size_t o = (size_t)(rt * 128 + row) * 256 + col0;
            const bf16x8 a8 = *(const bf16x8*)(T + row * LDC + c * 8), kr8 = ld8g(KRg + o), kk8 = ld8g(KKg + o);
            bf16x8 kd8, bd8;
#pragma unroll
            for (int j = 0; j < 8; ++j) { const float a = bf2f((bf16_t)a8[j]); kd8[j] = (short)f2bf(bf2f((bf16_t)kr8[j]) * (1.f + (a - 1.f) * ka[j])); bd8[j] = (short)f2bf(bf2f((bf16_t)kk8[j]) * a); }
            *(AS1 bf16x8*)gptr(KD + dofs + o) = kd8; *(AS1 bf16x8*)gptr(BD + dofs + o) = bd8; }
        } else {
          float* T = (float*)smem; constexpr int LDC = 132;
          float* dst = which < 2 ? LWp + (size_t)which * NT_ * 256 : GATE;
#pragma unroll 1
          for (int h = 0; h < 2; ++h) {
            __syncthreads();
            if (wr == h) {
#pragma unroll
              for (int ni = 0; ni < 4; ++ni) { const int cl = wc * 64 + ni * 16 + l15; const float bv = which < 2 ? bias[ct * 128 + cl] : 0.f;
#pragma unroll
                for (int mi = 0; mi < 4; ++mi)
#pragma unroll
                  for (int i = 0; i < 4; ++i) { const float v = acc[mi][ni][i]; T[(mi * 16 + 4 * g + i) * LDC + cl] = which < 2 ? -0.6065306597126334f * sigmoidf_(v + bv) : v; } } }
            __syncthreads();
#pragma unroll
            for (int pass = 0; pass < 8; ++pass) { const int id = tid + 256 * pass, row = id >> 5, c = id & 31;
              *(AS1 f32x4*)gptr(dst + (size_t)(rt * 128 + h * 64 + row) * 256 + ct * 128 + c * 4) = *(const f32x4*)(T + row * LDC + c * 4); } }
        }
      });
  }
}

DEVFN bf16x8 ld8(const bf16_t* p) { return *(const bf16x8*)p; }
typedef short bf16x4v __attribute__((ext_vector_type(4)));
DEVFN bf16x4v cvt4(f32x4 v) { return bf16x4v{(short)f2bf(v[0]), (short)f2bf(v[1]), (short)f2bf(v[2]), (short)f2bf(v[3])}; }
DEVFN bf16x8 cat44(bf16x4v a, bf16x4v b) { return bf16x8{a[0], a[1], a[2], a[3], b[0], b[1], b[2], b[3]}; }
DEVFN bf16x4v ld4(const bf16_t* p) { return *(const bf16x4v*)p; }
DEVFN int rm_off(int i, int k) { return i * 64 + ((((k >> 3) ^ (i & 7)) << 3) | (k & 7)); }
#define RW_WAVE_LDS 11264
DEVFN void rwkv_chunk(const Params& p, int unit_base, unsigned char* smem) {
  const int tid = TIDX, lane = tid & 63, wave = tid >> 6, q = lane >> 4, l15 = lane & 15;
  const int unit = unit_base + wave;
  const int c = unit % NC16, h = (unit / NC16) & 3, dir = (unit / (NC16 * 4)) & 1, b = unit / (NC16 * 8);
  bf16_t* big = (bf16_t*)(smem + wave * RW_WAVE_LDS);
  unsigned char* small = smem + wave * RW_WAVE_LDS + 8192;
  float* AbF = (float*)small;
  bf16_t* TN = (bf16_t*)(small + 1024);
  bf16_t* AK = TN + 256; bf16_t* RB = AK + 256; bf16_t* RK = RB + 256;
  const bf16_t* RRg = (const bf16_t*)(p.ws + Ws::RR); const bf16_t* VVg = (const bf16_t*)(p.ws + Ws::VV); const bf16_t* KKg = (const bf16_t*)(p.ws + Ws::KK);
  const bf16_t* KDg = (const bf16_t*)(p.ws + Ws::KD) + (size_t)dir * NT_ * 256; const bf16_t* BDg = (const bf16_t*)(p.ws + Ws::BD) + (size_t)dir * NT_ * 256;
  const float* LWg = (const float*)(p.ws + Ws::LW) + (size_t)dir * NT_ * 256;
  float kkm[16], vv[16], bneg[16], kneg[16];
  float run = 0.f;
  __syncthreads();
#pragma unroll
  for (int i = 0; i < 16; ++i) {
    const size_t o = (size_t)(b * T_ + tokmap(dir, c * 16 + i)) * 256 + h * 64 + lane;
    const float lw = gptr(LWg)[o], r = bf2f(gptr(RRg)[o]), k = bf2f(gptr(KDg)[o]), v = bf2f(gptr(VVg)[o]), kk = bf2f(gptr(KKg)[o]), bb = bf2f(gptr(BDg)[o]);
    const float e_ex = expf(run); run += lw; const float e_in = expf(run), e_neg = expf(-run);
    kkm[i] = kk * e_ex; vv[i] = v; bneg[i] = bb * e_neg; kneg[i] = k * e_neg;
    big[rm_off(i, lane)] = f2bf(kkm[i]); big[1024 + rm_off(i, lane)] = f2bf(r * e_in);
    big[2048 + rm_off(i, lane)] = f2bf(bneg[i]); big[3072 + rm_off(i, lane)] = f2bf(kneg[i]);
  }
  const float WC = expf(run);
  __syncthreads();
  f32x4 ab = f32x4{0.f, 0.f, 0.f, 0.f}, ak = ab, rb = ab, rk = ab;
#pragma unroll
  for (int s2 = 0; s2 < 2; ++s2) { const int ch = ((4 * s2 + q) ^ (l15 & 7)) << 3;
    const bf16x8 a_kk = ld8(big + l15 * 64 + ch), a_r = ld8(big + 1024 + l15 * 64 + ch), b_b = ld8(big + 2048 + l15 * 64 + ch), b_k = ld8(big + 3072 + l15 * 64 + ch);
    ab = MFMA16(a_kk, b_b, ab); ak = MFMA16(a_kk, b_k, ak); rb = MFMA16(a_r, b_b, rb); rk = MFMA16(a_r, b_k, rk); }
  f32x4 gacc[4];
#pragma unroll
  for (int nk = 0; nk < 4; ++nk)
#pragma unroll
    for (int r = 0; r < 4; ++r) gacc[nk][r] = bf2f(big[1024 + rm_off(4 * q + r, 16 * nk + l15)]);
  __syncthreads();
#pragma unroll
  for (int r = 0; r < 4; ++r) { const int i = 4 * q + r, j = l15;
    AbF[i * 16 + j] = j < i ? ab[r] : 0.f; AK[i * 16 + j] = f2bf(j < i ? ak[r] : 0.f);
    RB[i * 16 + j] = f2bf(j <= i ? rb[r] : 0.f); RK[i * 16 + j] = f2bf(j <= i ? rk[r] : 0.f); }
  { bf16_t* KKMT = big; bf16_t* VTT = big + 1024; bf16_t* BHT = big + 2048; bf16_t* KHT = big + 3072;
#pragma unroll
    for (int i = 0; i < 16; ++i) { KKMT[lane * 16 + i] = f2bf(kkm[i]); VTT[lane * 16 + i] = f2bf(vv[i]); BHT[lane * 16 + i] = f2bf(bneg[i] * WC); KHT[lane * 16 + i] = f2bf(kneg[i] * WC); } }
  __syncthreads();
  { float t[16];
#pragma unroll
    for (int i = 0; i < 16; ++i) { float acc = (i == l15) ? 1.f : 0.f;
#pragma unroll
      for (int j = 0; j < i; ++j) acc -= AbF[i * 16 + j] * t[j];
      t[i] = acc; }
    if (q == 0) {
#pragma unroll
      for (int i = 0; i < 16; ++i) TN[i * 16 + l15] = f2bf(-t[i]); } }
  __syncthreads();
  const size_t ci = (size_t)((b * 2 + dir) * 4 + h) * NC16 + c;
  bf16_t* MLg = (bf16_t*)(p.ws + Ws::RML) + ci * 4096; bf16_t* Ng = (bf16_t*)(p.ws + Ws::RNS) + ci * 4096;
  bf16_t* Gg = (bf16_t*)(p.ws + Ws::RG) + ci * 1024; float* Y0g = (float*)(p.ws + Ws::RY0) + ci * 1024;
  const bf16x4v a_T = ld4(TN + l15 * 16 + 4 * q), a_Ak = ld4(AK + l15 * 16 + 4 * q), a_Rb = ld4(RB + l15 * 16 + 4 * q), a_Rk = ld4(RK + l15 * 16 + 4 * q);
  const f32x4 z4 = f32x4{0.f, 0.f, 0.f, 0.f};
  bf16x4v vfr[4], qfr[4], pfr[4];
#pragma unroll
  for (int n = 0; n < 4; ++n) {
    vfr[n] = ld4(big + 1024 + (16 * n + l15) * 16 + 4 * q);
    const f32x4 akv = MFMA16K16(a_Ak, vfr[n], z4);
    qfr[n] = cvt4(MFMA16K16(a_T, cvt4(akv), z4));
    pfr[n] = cvt4(MFMA16K16(a_T, ld4(big + (16 * n + l15) * 16 + 4 * q), z4)); }
  const bf16x8 a_RbRk = cat44(a_Rb, a_Rk);
#pragma unroll
  for (int n = 0; n < 4; ++n) {
    const f32x4 g = MFMA16K16(a_Rb, pfr[n], gacc[n]);
    const f32x4 y0 = MFMA16(a_RbRk, cat44(qfr[n], vfr[n]), z4);
#pragma unroll
    for (int r = 0; r < 4; ++r) { Gg[(4 * q + r) * 64 + 16 * n + l15] = f2bf(g[r]); Y0g[(4 * q + r) * 64 + 16 * n + l15] = y0[r]; } }
#pragma unroll
  for (int n = 0; n < 4; ++n)
#pragma unroll
    for (int r = 0; r < 4; ++r) MLg[((n >> 1) * 64 + (l15 >> 2) * 16 + 4 * q + r) * 8 + (n & 1) * 4 + (l15 & 3)] = (bf16_t)pfr[n][r];
#pragma unroll
  for (int mk = 0; mk < 4; ++mk) {
    const bf16x4v a_B = ld4(big + 2048 + (16 * mk + l15) * 16 + 4 * q), a_K = ld4(big + 3072 + (16 * mk + l15) * 16 + 4 * q);
    const bf16x8 a_BK = cat44(a_B, a_K);
    *(bf16x4v*)(MLg + 1024 + ((mk >> 1) * 64 + lane) * 8 + (mk & 1) * 4) = a_B;
#pragma unroll
    for (int n = 0; n < 4; ++n) {
      const f32x4 nn = MFMA16(a_BK, cat44(qfr[n], vfr[n]), z4);
      *(bf16x4v*)(Ng + (n * 64 + lane) * 16 + mk * 4) = cvt4(nn); } }
  ((float*)(p.ws + Ws::RWC))[ci * 64 + ((lane >> 2) & 3) * 16 + (lane >> 4) * 4 + (lane & 3)] = WC;
}
struct RwStep { bf16x8 pf[2]; bf16x8 bh[2]; bf16x8 n[2]; float wc; };
DEVFN void rw_load(RwStep& t, const bf16_t* MLg, const bf16_t* NSg, const float* WCg, int c, int lane, int q) {
#pragma unroll
  for (int s2 = 0; s2 < 2; ++s2) { t.pf[s2] = ld8g(MLg + (size_t)c * 4096 + (s2 * 64 + lane) * 8); t.bh[s2] = ld8g(MLg + (size_t)c * 4096 + 1024 + (s2 * 64 + lane) * 8); }
  t.wc = gptr(WCg)[(size_t)c * 64 + lane];
  t.n[0] = ld8g(NSg + (size_t)c * 4096 + lane * 16); t.n[1] = ld8g(NSg + (size_t)c * 4096 + lane * 16 + 8);
  (void)q;
}
DEVFN void rw_step(const RwStep& t, f32x4 (&S)[4], bf16_t* NSg, int c, int q, int l15) {
  bf16x4v sb[4];
#pragma unroll
  for (int mk = 0; mk < 4; ++mk) sb[mk] = cvt4(S[mk]);
  const bf16x8 bf0 = cat44(sb[0], sb[1]), bf1 = cat44(sb[2], sb[3]);
  f32x4 w = MFMA16(t.pf[0], bf0, (f32x4{0.f, 0.f, 0.f, 0.f}));
  w = MFMA16(t.pf[1], bf1, w);
  const bf16x4v wb = cvt4(w);
#pragma unroll
  for (int mk = 0; mk < 4; ++mk) {
    f32x4 acc;
#pragma unroll
    for (int r = 0; r < 4; ++r) acc[r] = bf2f((bf16_t)t.n[mk >> 1][(mk & 1) * 4 + r]) + __shfl(t.wc, q * 16 + mk * 4 + r) * S[mk][r];
    const bf16x8 b2 = t.bh[mk >> 1];
    const bf16x4v a_B = (mk & 1) ? bf16x4v{b2[4], b2[5], b2[6], b2[7]} : bf16x4v{b2[0], b2[1], b2[2], b2[3]};
    S[mk] = MFMA16K16(a_B, wb, acc); }
#pragma unroll
  for (int mk = 0; mk < 4; ++mk) *(AS1 bf16x4v*)gptr(NSg + (size_t)c * 4096 + l15 * 64 + 16 * mk + 4 * q) = sb[mk];
}
DEVFN void rwkv_scan(const Params& p, int chain, int wave) {
  const int tid = TIDX, lane = tid & 63, q = lane >> 4, l15 = lane & 15;
  const bf16_t* MLg = (const bf16_t*)(p.ws + Ws::RML) + (size_t)chain * NC16 * 4096;
  bf16_t* NSg = (bf16_t*)(p.ws + Ws::RNS) + (size_t)chain * NC16 * 4096 + wave * 1024;
  const float* WCg = (const float*)(p.ws + Ws::RWC) + (size_t)chain * NC16 * 64;
  f32x4 S[4];
#pragma unroll
  for (int mk = 0; mk < 4; ++mk) S[mk] = f32x4{0.f, 0.f, 0.f, 0.f};
  RwStep t0, t1, t2, t3;
#define RWC_(x) ((x) < NC16 ? (x) : NC16 - 1)
  rw_load(t0, MLg, NSg, WCg, 0, lane, q);
  rw_load(t1, MLg, NSg, WCg, RWC_(1), lane, q);
  rw_load(t2, MLg, NSg, WCg, RWC_(2), lane, q);
  int c = 0;
  for (; c + 3 < NC16; c += 4) {
    rw_load(t3, MLg, NSg, WCg, c + 3, lane, q);
    rw_step(t0, S, NSg, c, q, l15);
    rw_load(t0, MLg, NSg, WCg, RWC_(c + 4), lane, q);
    rw_step(t1, S, NSg, c + 1, q, l15);
    rw_load(t1, MLg, NSg, WCg, RWC_(c + 5), lane, q);
    rw_step(t2, S, NSg, c + 2, q, l15);
    rw_load(t2, MLg, NSg, WCg, RWC_(c + 6), lane, q);
    rw_step(t3, S, NSg, c + 3, q, l15);
  }
  if (c < NC16) { rw_step(t0, S, NSg, c, q, l15); if (c + 1 < NC16) { rw_step(t1, S, NSg, c + 1, q, l15); if (c + 2 < NC16) rw_step(t2, S, NSg, c + 2, q, l15); } }
#undef RWC_
}
DEVFN void rwkv_out(const Params& p, int unit_base) {
  const int tid = TIDX, lane = tid & 63, wave = tid >> 6, q = lane >> 4, l15 = lane & 15;
  const int unit = unit_base + wave;
  const int c = unit % NC16, h = (unit / NC16) & 3, dir = (unit / (NC16 * 4)) & 1, b = unit / (NC16 * 8);
  const size_t ci = (size_t)((b * 2 + dir) * 4 + h) * NC16 + c;
  const bf16_t* Sg = (const bf16_t*)(p.ws + Ws::RNS) + ci * 4096; const bf16_t* Gg = (const bf16_t*)(p.ws + Ws::RG) + ci * 1024;
  const float* Y0g = (const float*)(p.ws + Ws::RY0) + ci * 1024;
  float* YR = (float*)(p.ws + Ws::YR) + (size_t)dir * NT_ * 256;
  const bf16x8 a0 = ld8g(Gg + l15 * 64 + 8 * q), a1 = ld8g(Gg + l15 * 64 + 32 + 8 * q);
#pragma unroll
  for (int n = 0; n < 4; ++n) {
    f32x4 acc;
#pragma unroll
    for (int r = 0; r < 4; ++r) acc[r] = gptr(Y0g)[(4 * q + r) * 64 + 16 * n + l15];
    acc = MFMA16(a0, ld8g(Sg + n * 1024 + l15 * 64 + 8 * q), acc);
    acc = MFMA16(a1, ld8g(Sg + n * 1024 + l15 * 64 + 32 + 8 * q), acc);
#pragma unroll
    for (int r = 0; r < 4; ++r) YR[(size_t)(b * T_ + tokmap(dir, c * 16 + 4 * q + r)) * 256 + h * 64 + 16 * n + l15] = acc[r]; }
}
DEVFN int cscan(int dir, int co, int nctx, int nc) { return dir == 0 ? co : (co < nctx ? nctx - 1 - co : 2 * nctx + nc - 1 - co); }
DEVFN bf16x8 ld4x2g(const bf16_t* p0, const bf16_t* p1) { bf16x4v a = *(const AS1 bf16x4v*)gptr(p0), b = *(const AS1 bf16x4v*)gptr(p1); return bf16x8{a[0], a[1], a[2], a[3], b[0], b[1], b[2], b[3]}; }
DEVFN bf16x8 ld4x2(const bf16_t* p0, const bf16_t* p1) { bf16x4v a = *(const bf16x4v*)p0, b = *(const bf16x4v*)p1; return bf16x8{a[0], a[1], a[2], a[3], b[0], b[1], b[2], b[3]}; }

DEVFN void ssd_chunk_scalars(const Params& p, int l, int b, int co, int h, float* f) {
  const int tid = TIDX, d = tid >> 7, j = tid & 127;
  const float* DTB = (const float*)(p.ws + Ws::DTB);
  const float nega = -expf(INP(I_ALOG)[(size_t)l * 16 + d * 8 + h]);
  const float dt = DTB[(size_t)(b * T_ + co * 128 + j) * 16 + d * 8 + h];
  __syncthreads();
  f[256 + d * 128 + j] = dt;
  float* cur = f + d * 128; float* tmp = f + 512 + d * 128;
  cur[j] = dt * nega;
  __syncthreads();
  for (int off = 1; off < 128; off <<= 1) {
    float v = cur[j] + (j >= off ? cur[j - off] : 0.f);
    tmp[j] = v;
    __syncthreads();
    cur[j] = tmp[j];
    __syncthreads();
  }
}
DEVFN void ssd_states(const Params& p, int l, int unit, unsigned char* smem) {
  const int tid = TIDX, lane = tid & 63, wave = tid >> 6, q = lane >> 4, l15 = lane & 15;
  const int h = unit & 7, co = (unit >> 3) % NC128, b = unit / (8 * NC128), grp = h >> 2;
  float* f = (float*)smem;
  ssd_chunk_scalars(p, l, b, co, h, f);
  { const int d = tid >> 7, j = tid & 127; const float* cum = f + d * 128; const float dt = f[256 + d * 128 + j];
    float w = d == 0 ? expf(cum[127] - cum[j]) * dt : expf(j > 0 ? cum[j - 1] : 0.f) * dt;
    f[512 + d * 128 + j] = w; }
  __syncthreads();
  const bf16_t* XT = (const bf16_t*)(p.ws + Ws::XBCT) + (size_t)(b * NC128 + co) * 768 * 128;
  f32x4 acc[2][8];
#pragma unroll
  for (int d = 0; d < 2; ++d)
#pragma unroll
    for (int n = 0; n < 8; ++n) acc[d][n] = f32x4{0.f, 0.f, 0.f, 0.f};
#pragma unroll 1
  for (int s4 = 0; s4 < 4; ++s4) {
    const int j0 = s4 * 32 + q * 8;
    bf16x8 xa = ld8g(XT + (size_t)(h * 64 + wave * 16 + l15) * 128 + j0), a0, a1;
#pragma unroll
    for (int jj = 0; jj < 8; ++jj) { float x = bf2f((bf16_t)xa[jj]); a0[jj] = (short)f2bf(x * f[512 + j0 + jj]); a1[jj] = (short)f2bf(x * f[640 + j0 + jj]); }
#pragma unroll
    for (int n = 0; n < 8; ++n) { bf16x8 bb = ld8g(XT + (size_t)(512 + grp * 128 + n * 16 + l15) * 128 + j0);
      acc[0][n] = MFMA16(a0, bb, acc[0][n]); acc[1][n] = MFMA16(a1, bb, acc[1][n]); }
  }
#pragma unroll
  for (int d = 0; d < 2; ++d) {
    const int cs = cscan(d, co, CTX_ / 128, SEQ_ / 128);
    float* ST = (float*)(p.ws + Ws::SST) + ((size_t)((d * B_ + b) * NC128 + cs) * 8 + h) * 8192;
#pragma unroll
    for (int n = 0; n < 8; ++n)
#pragma unroll
      for (int r = 0; r < 4; ++r) ST[(wave * 16 + q * 4 + r) * 128 + n * 16 + l15] = acc[d][n][r];
    if (tid == 0) ((float*)(p.ws + Ws::SCD))[((size_t)(d * B_ + b) * NC128 + cs) * 8 + h] = expf(f[d * 128 + 127]);
  }
}
#define SSD_SB ((NC128 % 17) == 0 ? 17 : NC128)
DEVFN void ssd_scan(const Params& p, int gtid, int gthreads) {
  const float* __restrict__ ST = (const float*)(p.ws + Ws::SST); const float* __restrict__ CD = (const float*)(p.ws + Ws::SCD); bf16_t* __restrict__ HIN = (bf16_t*)(p.ws + Ws::HIN);
  for (int e = gtid; e < 2 * B_ * 8 * 8192; e += gthreads) {
    const int pd = e & 8191, h = (e >> 13) & 7, db = e >> 16;
    float hv = 0.f;
#pragma unroll 1
    for (int c0 = 0; c0 < NC128; c0 += SSD_SB) {
      float st[SSD_SB], cd[SSD_SB];
#pragma unroll
      for (int i = 0; i < SSD_SB; ++i) { st[i] = ST[((size_t)(db * NC128 + c0 + i) * 8 + h) * 8192 + pd]; cd[i] = CD[(size_t)(db * NC128 + c0 + i) * 8 + h]; }
#pragma unroll
      for (int i = 0; i < SSD_SB; ++i) { HIN[((size_t)(db * NC128 + c0 + i) * 8 + h) * 8192 + pd] = f2bf(hv); hv = hv * cd[i] + st[i]; }
    }
  }
}
DEVFN void ssd_out(const Params& p, int l, int unit, unsigned char* smem) {
  const int tid = TIDX, lane = tid & 63, wave = tid >> 6, q = lane >> 4, l15 = lane & 15;
  const int h = unit & 7, co = (unit >> 3) % NC128, b = unit / (8 * NC128), grp = h >> 2;
  float* f = (float*)smem;
  ssd_chunk_scalars(p, l, b, co, h, f);
  if (tid < 128) f[640 + tid] = f[128 + 127] - (tid > 0 ? f[128 + tid - 1] : 0.f);
  __syncthreads();
  const float* cum0 = f; const float* suf1 = f + 640; const float* dt0 = f + 256; const float* dt1 = f + 384;
  const bf16_t* XBC = (const bf16_t*)(p.ws + Ws::XBC) + (size_t)(b * T_ + co * 128) * 1024;
  const bf16_t* XT = (const bf16_t*)(p.ws + Ws::XBCT) + (size_t)(b * NC128 + co) * 768 * 128;
  const bf16_t* Cb = XBC + (size_t)(wave * 32 + l15) * 1024 + 768 + grp * 128 + q * 8;
  f32x4 y[4][2];
  { f32x4 o0[4][2], o1[4][2];
#pragma unroll
    for (int mp = 0; mp < 4; ++mp)
#pragma unroll
      for (int ni = 0; ni < 2; ++ni) { o0[mp][ni] = f32x4{0.f, 0.f, 0.f, 0.f}; o1[mp][ni] = f32x4{0.f, 0.f, 0.f, 0.f}; }
    const int cs0 = cscan(0, co, CTX_ / 128, SEQ_ / 128), cs1 = cscan(1, co, CTX_ / 128, SEQ_ / 128);
    const bf16_t* H0 = (const bf16_t*)(p.ws + Ws::HIN) + ((size_t)((0 * B_ + b) * NC128 + cs0) * 8 + h) * 8192;
    const bf16_t* H1 = (const bf16_t*)(p.ws + Ws::HIN) + ((size_t)((1 * B_ + b) * NC128 + cs1) * 8 + h) * 8192;
#pragma unroll 1
    for (int s4 = 0; s4 < 4; ++s4) { const bf16x8 c0 = ld8g(Cb + s4 * 32), c1 = ld8g(Cb + 16 * 1024 + s4 * 32);
#pragma unroll
      for (int mp = 0; mp < 4; ++mp) { bf16x8 h0 = ld8g(H0 + (size_t)(mp * 16 + l15) * 128 + s4 * 32 + q * 8), h1 = ld8g(H1 + (size_t)(mp * 16 + l15) * 128 + s4 * 32 + q * 8);
        o0[mp][0] = MFMA16(h0, c0, o0[mp][0]); o0[mp][1] = MFMA16(h0, c1, o0[mp][1]);
        o1[mp][0] = MFMA16(h1, c0, o1[mp][0]); o1[mp][1] = MFMA16(h1, c1, o1[mp][1]); } }
#pragma unroll
    for (int ni = 0; ni < 2; ++ni) { const int i = wave * 32 + ni * 16 + l15; const float e0 = expf(cum0[i]), e1 = expf(suf1[i]);
#pragma unroll
      for (int mp = 0; mp < 4; ++mp)
#pragma unroll
        for (int r = 0; r < 4; ++r) y[mp][ni][r] = e0 * o0[mp][ni][r] + e1 * o1[mp][ni][r]; } }
  bf16x8 mfr[4][2];
  { f32x4 g[8][2];
#pragma unroll
    for (int mj = 0; mj < 8; ++mj) { g[mj][0] = f32x4{0.f, 0.f, 0.f, 0.f}; g[mj][1] = f32x4{0.f, 0.f, 0.f, 0.f}; }
#pragma unroll 1
    for (int s4 = 0; s4 < 4; ++s4) { const bf16x8 c0 = ld8g(Cb + s4 * 32), c1 = ld8g(Cb + 16 * 1024 + s4 * 32);
#pragma unroll
      for (int mj = 0; mj < 8; ++mj) { bf16x8 bb = ld8g(XBC + (size_t)(mj * 16 + l15) * 1024 + 512 + grp * 128 + s4 * 32 + q * 8);
        g[mj][0] = MFMA16(bb, c0, g[mj][0]); g[mj][1] = MFMA16(bb, c1, g[mj][1]); } }
    const int i0 = wave * 32 + l15, i1 = i0 + 16;
    const float c0i0 = cum0[i0], s1i0 = suf1[i0], c0i1 = cum0[i1], s1i1 = suf1[i1];
#pragma unroll
    for (int mj = 0; mj < 8; ++mj)
#pragma unroll
      for (int r = 0; r < 4; ++r) { const int j = mj * 16 + q * 4 + r;
        const float cj = cum0[j], sj = suf1[j], d0 = dt0[j], d1 = dt1[j];
        const float lw0 = (j <= i0 ? expf(c0i0 - cj) * d0 : 0.f) + (j >= i0 ? expf(s1i0 - sj) * d1 : 0.f);
        const float lw1 = (j <= i1 ? expf(c0i1 - cj) * d0 : 0.f) + (j >= i1 ? expf(s1i1 - sj) * d1 : 0.f);
        mfr[mj >> 1][0][(mj & 1) * 4 + r] = (short)f2bf(g[mj][0][r] * lw0);
        mfr[mj >> 1][1][(mj & 1) * 4 + r] = (short)f2bf(g[mj][1][r] * lw1); } }
#pragma unroll
  for (int s4 = 0; s4 < 4; ++s4)
#pragma unroll
    for (int mp = 0; mp < 4; ++mp) { const bf16_t* xr = XT + (size_t)(h * 64 + mp * 16 + l15) * 128 + s4 * 32 + q * 4;
      bf16x8 xa = ld4x2g(xr, xr + 16);
      y[mp][0] = MFMA16(xa, mfr[s4][0], y[mp][0]); y[mp][1] = MFMA16(xa, mfr[s4][1], y[mp][1]); }
  __syncthreads();
  float* yl = f + 1024;
#pragma unroll
  for (int mp = 0; mp < 4; ++mp)
#pragma unroll
    for (int ni = 0; ni < 2; ++ni)
#pragma unroll
      for (int r = 0; r < 4; ++r) yl[(wave * 32 + ni * 16 + l15) * 65 + mp * 16 + q * 4 + r] = y[mp][ni][r];
  __syncthreads();
  float* YS = (float*)(p.ws + Ws::YS) + (size_t)(b * T_ + co * 128) * 512 + h * 64;
  for (int e = tid; e < 128 * 64; e += 256) YS[(size_t)(e >> 6) * 512 + (e & 63)] = yl[(e >> 6) * 65 + (e & 63)];
}

#define GQ_LD 40
#define GK_LD 72
DEVFN void gla_chunk(const Params& p, int unit, unsigned char* smem) {
  const int tid = TIDX, lane = tid & 63, wave = tid >> 6, q = lane >> 4, l15 = lane & 15;
  const int h = unit & 3, co = (unit >> 2) % NC64, b = unit / (4 * NC64);
  const bf16_t* ZX = (const bf16_t*)(p.ws + Ws::ZX) + (size_t)(b * T_ + co * 64) * NIN_;
  const float* LA = (const float*)(p.ws + Ws::LA);
  float* cum = (float*)smem;
  bf16_t* qs = (bf16_t*)(smem + 16384);
  bf16_t* ks = qs + 2 * 64 * GQ_LD;
  bf16_t* kt = ks + 2 * 64 * GQ_LD;
  __syncthreads();
  for (int e = tid; e < 2 * 64 * 32; e += 256) { const int d = e >> 11, i = (e >> 5) & 63, dd = e & 31;
    cum[e] = LA[((size_t)d * NT_ + b * T_ + co * 64 + i) * 128 + h * 32 + dd]; }
  __syncthreads();
  if (tid < 64) { const int d = tid >> 5, dd = tid & 31; float* c = cum + d * 2048 + dd; float sacc = 0.f;
    if (d == 0) for (int i = 0; i < 64; ++i) { sacc += c[i * 32]; c[i * 32] = sacc; }
    else for (int i = 63; i >= 0; --i) { sacc += c[i * 32]; c[i * 32] = sacc; } }
  __syncthreads();
  bf16_t* QT = (bf16_t*)(p.ws + Ws::QT);
  for (int e = tid; e < 64 * 32; e += 256) { const int i = e >> 5, dd = e & 31;
    const float qv = bf2f(ZX[(size_t)i * NIN_ + OGQ + h * 32 + dd]) * 0.17677669529663687f, kv = bf2f(ZX[(size_t)i * NIN_ + OGK + h * 32 + dd]);
    const float c0 = cum[i * 32 + dd], c1 = cum[2048 + i * 32 + dd], t0 = cum[63 * 32 + dd], t1 = cum[2048 + dd];
    const bf16_t q0 = f2bf(qv * expf(c0)), q1 = f2bf(qv * expf(c1));
    qs[i * GQ_LD + dd] = q0; qs[64 * GQ_LD + i * GQ_LD + dd] = q1;
    ks[i * GQ_LD + dd] = f2bf(kv * expf(-c0)); ks[64 * GQ_LD + i * GQ_LD + dd] = f2bf(kv * expf(-c1));
    kt[dd * GK_LD + i] = f2bf(kv * expf(t0 - c0)); kt[32 * GK_LD + dd * GK_LD + i] = f2bf(kv * expf(t1 - c1));
    const size_t tok = (size_t)b * T_ + co * 64 + i;
    QT[tok * 128 + h * 32 + dd] = q0; QT[((size_t)NT_ + tok) * 128 + h * 32 + dd] = q1; }
  if (tid < 64) { const int d = tid >> 5, dd = tid & 31; const int cs = cscan(d, co, CTX_ / 64, SEQ_ / 64);
    ((float*)(p.ws + Ws::GCD))[(((size_t)(d * B_ + b) * NC64 + cs) * 4 + h) * 32 + dd] = expf(d == 0 ? cum[63 * 32 + dd] : cum[2048 + dd]); }
  __syncthreads();
  bf16x8 pfr[2];
  { f32x4 p0[4], p1[4];
    const bf16x8 qb0 = ld8(qs + (wave * 16 + l15) * GQ_LD + q * 8), qb1 = ld8(qs + 64 * GQ_LD + (wave * 16 + l15) * GQ_LD + q * 8);
#pragma unroll
    for (int mj = 0; mj < 4; ++mj) { p0[mj] = MFMA16(ld8(ks + (mj * 16 + l15) * GQ_LD + q * 8), qb0, (f32x4{0.f, 0.f, 0.f, 0.f}));
      p1[mj] = MFMA16(ld8(ks + 64 * GQ_LD + (mj * 16 + l15) * GQ_LD + q * 8), qb1, (f32x4{0.f, 0.f, 0.f, 0.f})); }
    const int i = wave * 16 + l15;
#pragma unroll
    for (int mj = 0; mj < 4; ++mj)
#pragma unroll
      for (int r = 0; r < 4; ++r) { const int j = mj * 16 + q * 4 + r; pfr[mj >> 1][(mj & 1) * 4 + r] = (short)f2bf((j <= i ? p0[mj][r] : 0.f) + (j >= i ? p1[mj][r] : 0.f)); } }
  const bf16_t* VT = (const bf16_t*)(p.ws + Ws::VT) + ((size_t)(b * NC64 + co) * 256 + h * 64) * 64;
  f32x4 o[4];
#pragma unroll
  for (int md = 0; md < 4; ++md) { o[md] = f32x4{0.f, 0.f, 0.f, 0.f};
#pragma unroll
    for (int s2 = 0; s2 < 2; ++s2) { const bf16_t* vr = VT + (size_t)(md * 16 + l15) * 64 + s2 * 32 + q * 4; o[md] = MFMA16(ld4x2g(vr, vr + 16), pfr[s2], o[md]); } }
#pragma unroll
  for (int d = 0; d < 2; ++d) { const int cs = cscan(d, co, CTX_ / 64, SEQ_ / 64);
    float* GST = (float*)(p.ws + Ws::GST) + (((size_t)(d * B_ + b) * NC64 + cs) * 4 + h) * 2048;
#pragma unroll
    for (int nd = 0; nd < 2; ++nd) { f32x4 st = f32x4{0.f, 0.f, 0.f, 0.f};
#pragma unroll
      for (int s2 = 0; s2 < 2; ++s2) st = MFMA16(ld8g(VT + (size_t)(wave * 16 + l15) * 64 + s2 * 32 + q * 8), ld8(kt + d * 32 * GK_LD + (nd * 16 + l15) * GK_LD + s2 * 32 + q * 8), st);
#pragma unroll
      for (int r = 0; r < 4; ++r) GST[(wave * 16 + q * 4 + r) * 32 + nd * 16 + l15] = st[r]; } }
  __syncthreads();
  float* ol = (float*)smem;
#pragma unroll
  for (int md = 0; md < 4; ++md)
#pragma unroll
    for (int r = 0; r < 4; ++r) ol[(wave * 16 + l15) * 65 + md * 16 + q * 4 + r] = o[md][r];
  __syncthreads();
  float* OI = (float*)(p.ws + Ws::OI) + (size_t)(b * T_ + co * 64) * 256 + h * 64;
  for (int e = tid; e < 64 * 64; e += 256) OI[(size_t)(e >> 6) * 256 + (e & 63)] = ol[(e >> 6) * 65 + (e & 63)];
}
#define GLA_SB ((NC64 % 17) == 0 ? 17 : NC64)
DEVFN void gla_scan(const Params& p, int gtid, int gthreads) {
  const float* __restrict__ ST = (const float*)(p.ws + Ws::GST); const float* __restrict__ CD = (const float*)(p.ws + Ws::GCD); bf16_t* __restrict__ SIN = (bf16_t*)(p.ws + Ws::GSIN);
  for (int e = gtid; e < 2 * B_ * 4 * 2048; e += gthreads) {
    const int vd = e & 2047, h = (e >> 11) & 3, db = e >> 13;
    float sv = 0.f;
#pragma unroll 1
    for (int c0 = 0; c0 < NC64; c0 += GLA_SB) {
      float st[GLA_SB], cd[GLA_SB];
#pragma unroll
      for (int i = 0; i < GLA_SB; ++i) { st[i] = ST[(((size_t)db * NC64 + c0 + i) * 4 + h) * 2048 + vd]; cd[i] = CD[(((size_t)db * NC64 + c0 + i) * 4 + h) * 32 + (vd & 31)]; }
#pragma unroll
      for (int i = 0; i < GLA_SB; ++i) { SIN[(((size_t)db * NC64 + c0 + i) * 4 + h) * 2048 + vd] = f2bf(sv); sv = sv * cd[i] + st[i]; }
    }
  }
}
DEVFN void gla_out(const Params& p, int unit_base) {
  const int tid = TIDX, lane = tid & 63, wave = tid >> 6, g = lane >> 4, l15 = lane & 15;
  const int unit = unit_base + wave;
  if (unit >= B_ * NC64 * 4) return;
  const int h = unit & 3, co = (unit >> 2) % NC64, b = unit / (4 * NC64);
  const bf16_t* QT = (const bf16_t*)(p.ws + Ws::QT);
  const bf16_t* GSIN = (const bf16_t*)(p.ws + Ws::GSIN);
  float* OI = (float*)(p.ws + Ws::OI) + (size_t)(b * T_ + co * 64) * 256 + h * 64;
  const int tok0 = b * T_ + co * 64;
  bf16x8 af[2][4], bfr[2][4];
#pragma unroll
  for (int d = 0; d < 2; ++d) { const int cs = cscan(d, co, CTX_ / 64, SEQ_ / 64);
    const bf16_t* sr = GSIN + ((((size_t)(d * B_ + b) * NC64 + cs) * 4 + h) * 64) * 32;
#pragma unroll
    for (int mi = 0; mi < 4; ++mi) af[d][mi] = ld8g(QT + ((size_t)d * NT_ + tok0 + mi * 16 + l15) * 128 + h * 32 + g * 8);
#pragma unroll
    for (int ni = 0; ni < 4; ++ni) bfr[d][ni] = ld8g(sr + (ni * 16 + l15) * 32 + g * 8); }
#pragma unroll
  for (int mi = 0; mi < 4; ++mi) {
    f32x4 acc[4];
#pragma unroll
    for (int ni = 0; ni < 4; ++ni)
#pragma unroll
      for (int i = 0; i < 4; ++i) acc[ni][i] = gptr(OI)[(size_t)(mi * 16 + 4 * g + i) * 256 + ni * 16 + l15];
#pragma unroll
    for (int ni = 0; ni < 4; ++ni) { acc[ni] = MFMA16(af[0][mi], bfr[0][ni], acc[ni]); acc[ni] = MFMA16(af[1][mi], bfr[1][ni], acc[ni]); }
#pragma unroll
    for (int ni = 0; ni < 4; ++ni)
#pragma unroll
      for (int i = 0; i < 4; ++i) gptr(OI)[(size_t)(mi * 16 + 4 * g + i) * 256 + ni * 16 + l15] = acc[ni][i];
  }
}
DEVFN void convert_moe_weights(const Params& p, int l, unsigned char* smem, int bid, int nb);
DEVFN void phase4a(const Params& p, int l, unsigned char* smem) {
  const int n_r = B_ * 8 * NC16 / 4;
  for (int u = BIDX; u < n_r; u += gridDim.x) rwkv_chunk(p, (u) * 4, smem);
  (void)l;
}
DEVFN void phase4b(const Params& p, int l, unsigned char* smem) {
  const int bid = BIDX, nrw = B_ * 8, G = (int)gridDim.x;
  const int n_s = B_ * NC128 * 8, n_g = B_ * NC64 * 4;
  int ob = bid, on = G;
  if (G >= 8 * nrw) {
    const int q = 2 * nrw, half = G >> 1;
    int sb = -1;
    if (bid < q) sb = bid; else if (bid >= half && bid < half + q) sb = q + (bid - half);
    if (sb >= 0) { if ((TIDX >> 6) == 0) rwkv_scan(p, sb >> 2, sb & 3); return; }
    ob = bid < half ? bid - q : bid - 2 * q; on = G - 4 * nrw; }
  else { for (int u = bid; u < nrw; u += G) rwkv_scan(p, u, TIDX >> 6); }
  for (int u = ob; u < n_s + n_g; u += on) { if (u < n_s) ssd_states(p, l, u, smem); else gla_chunk(p, u - n_s, smem); }
  convert_moe_weights(p, l, smem, ob, on);
}
DEVFN void phase4b2(const Params& p) {
  const int bid = BIDX, G = (int)gridDim.x;
  ssd_scan(p, bid * 256 + TIDX, G * 256); gla_scan(p, bid * 256 + TIDX, G * 256);
}
DEVFN void phase4c(const Params& p, int l, unsigned char* smem) {
  const int n_s = B_ * NC128 * 8, n_r = B_ * 8 * NC16 / 4, n_g = B_ * NC64;
  for (int u = BIDX; u < n_s + n_r + n_g; u += gridDim.x) { if (u < n_s) ssd_out(p, l, u, smem); else if (u < n_s + n_r) rwkv_out(p, (u - n_s) * 4); else gla_out(p, (u - n_s - n_r) * 4); }
}

DEVFN void phase5(const Params& p, int l, unsigned char* smem) {
  const int tid = TIDX, lane = tid & 63, wave = tid >> 6;
  const bf16_t* ZX = (const bf16_t*)(p.ws + Ws::ZX);
  const bf16_t* XBC = (const bf16_t*)(p.ws + Ws::XBC);
  const float* YS = (const float*)(p.ws + Ws::YS); const float* YR = (const float*)(p.ws + Ws::YR); const float* OI = (const float*)(p.ws + Ws::OI);
  const bf16_t* RR = (const bf16_t*)(p.ws + Ws::RR); const bf16_t* VV = (const bf16_t*)(p.ws + Ws::VV); const bf16_t* KD = (const bf16_t*)(p.ws + Ws::KD);
  const float* GATE = (const float*)(p.ws + Ws::GATE);
  bf16_t* YM = (bf16_t*)(p.ws + Ws::YMIX);
  constexpr int TPI = 4;
  float* red = (float*)smem;
  const float dA = INP(I_SSDD)[(size_t)l * 8 + (tid >> 6)], dB = INP(I_SSDD)[(size_t)l * 8 + 4 + (tid >> 6)];
  const float nwA = INP(I_SSDNW)[(size_t)l * 512 + tid], nwB = INP(I_SSDNW)[(size_t)l * 512 + 256 + tid];
  const float lnw = INP(I_LNXW)[(size_t)l * 256 + tid], lnb = INP(I_LNXB)[(size_t)l * 256 + tid], rk = INP(I_RK)[(size_t)l * 256 + tid];
  const float gnw = INP(I_GNW)[(size_t)l * 256 + tid];
  const int per_ = (NT_ / TPI + (int)gridDim.x - 1) / (int)gridDim.x, tp_lo = BIDX * per_, tp_hi = (tp_lo + per_ < NT_ / TPI) ? tp_lo + per_ : NT_ / TPI;
  for (int tp = tp_lo; tp < tp_hi; ++tp) {
    float ys0[TPI], ys1[TPI], x0[TPI], x1[TPI], z0[TPI], z1[TPI], og[TPI], yr[TPI], rr[TPI], kf[TPI], kb[TPI], vv[TPI], gt[TPI], oi[TPI];
#pragma unroll
    for (int t = 0; t < TPI; ++t) { const int tok = tp * TPI + t;
      ys0[t] = gptr(YS)[(size_t)tok * 512 + tid]; ys1[t] = gptr(YS)[(size_t)tok * 512 + 256 + tid];
      x0[t] = bf2f(gptr(XBC)[(size_t)tok * 1024 + tid]); x1[t] = bf2f(gptr(XBC)[(size_t)tok * 1024 + 256 + tid]);
      z0[t] = zxv(ZX, tok, OZ + tid); z1[t] = zxv(ZX, tok, OZ + 256 + tid); og[t] = zxv(ZX, tok, OOG + tid);
      yr[t] = gptr(YR)[(size_t)tok * 256 + tid] + gptr(YR)[((size_t)NT_ + tok) * 256 + tid];
      rr[t] = bf2f(gptr(RR)[(size_t)tok * 256 + tid]); kf[t] = bf2f(gptr(KD)[(size_t)tok * 256 + tid]); kb[t] = bf2f(gptr(KD)[((size_t)NT_ + tok) * 256 + tid]);
      vv[t] = bf2f(gptr(VV)[(size_t)tok * 256 + tid]); gt[t] = gptr(GATE)[(size_t)tok * 256 + tid]; oi[t] = gptr(OI)[(size_t)tok * 256 + tid];
    }
    float ya[TPI], yb[TPI], qa[TPI], qb[TPI];
#pragma unroll
    for (int t = 0; t < TPI; ++t) {
      ya[t] = (ys0[t] + dA * x0[t]) * siluf_(z0[t]); yb[t] = (ys1[t] + dB * x1[t]) * siluf_(z1[t]);
      qa[t] = wave_sum(ya[t] * ya[t]); qb[t] = wave_sum(yb[t] * yb[t]); }
    __syncthreads();
#pragma unroll
    for (int t = 0; t < TPI; ++t)
      if (lane == 0) { red[t * 8 + wave] = qa[t]; red[t * 8 + 4 + wave] = qb[t]; }
    __syncthreads();
#pragma unroll
    for (int t = 0; t < TPI; ++t) { const int tok = tp * TPI + t;
      const float* rd = red + t * 8;
      float ma = (rd[0] + rd[1] + rd[2] + rd[3]) * (1.f / 256.f), mb = (rd[4] + rd[5] + rd[6] + rd[7]) * (1.f / 256.f);
      YM[(size_t)tok * 1024 + tid] = f2bf(ya[t] * rsqrtf(ma + 1e-5f) * nwA);
      YM[(size_t)tok * 1024 + 256 + tid] = f2bf(yb[t] * rsqrtf(mb + 1e-5f) * nwB);
      { const float y = yr[t];
        float mu = wave_sum(y) * (1.f / 64.f), d = y - mu, var = wave_sum(d * d) * (1.f / 64.f);
        float yn = d * rsqrtf(var + 64e-5f) * lnw + lnb;
        float bonus = wave_sum(rr[t] * (kf[t] + kb[t]) * rk) * vv[t];
        YM[(size_t)tok * 1024 + 512 + tid] = f2bf((yn + bonus) * gt[t]); }
      { float o = oi[t];
        float ms = wave_sum(o * o) * (1.f / 64.f);
        YM[(size_t)tok * 1024 + 768 + tid] = f2bf(o * rsqrtf(ms + 1e-5f) * gnw * siluf_(og[t])); } }
  }
}

DEVFN void phase6(const Params& p, int l, unsigned char* smem) {
  const bf16_t* A = (const bf16_t*)(p.ws + Ws::YMIX);
  const bf16_t* W = (const bf16_t*)(p.ws + Ws::WOUT) + (size_t)l * 1024 * 1024;
  float* MIX = (float*)(p.ws + Ws::MIX);
  for (int u = BIDX; u < (NT_ / 128) * 8; u += gridDim.x) {
    int rt = u / 8, ct = u % 8;
    gemm_tile(smem, 1024,
      [&](int r) { return A + (size_t)(rt * 128 + r) * 1024; },
      [&](int r) { return W + (size_t)(ct * 128 + r) * 1024; },
      [&](f32x4 (&acc)[4][4], int wr, int wc, int g, int l15) {
#pragma unroll
        for (int mi = 0; mi < 4; ++mi)
#pragma unroll
          for (int ni = 0; ni < 4; ++ni)
#pragma unroll
            for (int i = 0; i < 4; ++i) MIX[(size_t)(rt * 128 + wr * 64 + mi * 16 + 4 * g + i) * 1024 + ct * 128 + wc * 64 + ni * 16 + l15] = acc[mi][ni][i];
      });
  }
}

#define P7_MAXE 2048
DEVFN void phase7(const Params& p, int l, unsigned char* smem) {
  const int lane = TIDX & 63, wave = TIDX >> 6;
  float* X = (float*)(p.ws + Ws::X);
  const float* MIX = (const float*)(p.ws + Ws::MIX);
  bf16_t* H = (bf16_t*)(p.ws + Ws::U);
  const float* rwt = (const float*)(p.ws + Ws::RWT) + (size_t)l * 64 * 1024;
  int* cnt = (int*)(p.ws + Ws::CNT) + l * 64 * 64;
  int* ltok = (int*)(p.ws + Ws::LTOK); float* lwt = (float*)(p.ws + Ws::LWT);
  const float rbias = INP(I_RB)[(size_t)l * 64 + lane];
  float* hs = (float*)smem;
  float* lg = hs + 4096;
  int* lcnt = (int*)(lg + 256);
  int* lbase = lcnt + 80;
  int* etok = lbase + 64;
  int* epos = etok + P7_MAXE; float* ewt = (float*)(epos + P7_MAXE);
  for (int i = TIDX; i < 80; i += 256) lcnt[i] = 0;
  for (int tok0 = BIDX * 4; tok0 < NT_; tok0 += gridDim.x * 4) {
    const int tok = tok0 + wave;
    const float* mod = (const float*)(p.ws + Ws::MOD) + ((size_t)l * NR_ + tok_modrow(tok)) * NMOD_;
    float xv[16], mx[16], g1[16], lw[16], lb[16], sh2[16], sc2[16], mean, rstd;
    load_row16(X + (size_t)tok * 1024, lane, xv);
    load_row16(MIX + (size_t)tok * 1024, lane, mx);
    load_row16(mod + 2 * 1024, lane, g1);
    load_row16(INP(I_LN1W) + (size_t)l * 1024, lane, lw);
    load_row16(INP(I_LN1B) + (size_t)l * 1024, lane, lb);
    load_row16(mod + 3 * 1024, lane, sh2);
    load_row16(mod + 4 * 1024, lane, sc2);
#pragma unroll
    for (int i = 0; i < 16; ++i) xv[i] = ALPHA_ * xv[i] + g1[i] * mx[i];
    row_stats(xv, mean, rstd);
#pragma unroll
    for (int i = 0; i < 16; ++i) xv[i] = (xv[i] - mean) * rstd * lw[i] + lb[i];
#pragma unroll
    for (int j = 0; j < 4; ++j) *(float4*)(X + (size_t)tok * 1024 + lane * 4 + 256 * j) = make_float4(xv[4 * j], xv[4 * j + 1], xv[4 * j + 2], xv[4 * j + 3]);
    const bool routed = !(l == DEPTH_ - 1 && (tok % T_) < CTX_);
    row_stats(xv, mean, rstd);
#pragma unroll
    for (int i = 0; i < 16; ++i) xv[i] = (xv[i] - mean) * rstd * (1.f + sc2[i]) + sh2[i];
    __syncthreads();
#pragma unroll
    for (int j = 0; j < 4; ++j) {
      if (routed) *(uint2*)(H + (size_t)tok * 1024 + lane * 4 + 256 * j) = make_uint2((unsigned)f2bf(xv[4 * j]) | ((unsigned)f2bf(xv[4 * j + 1]) << 16), (unsigned)f2bf(xv[4 * j + 2]) | ((unsigned)f2bf(xv[4 * j + 3]) << 16));
      *(float4*)(hs + wave * 1024 + lane * 4 + 256 * j) = make_float4(xv[4 * j], xv[4 * j + 1], xv[4 * j + 2], xv[4 * j + 3]); }
    __syncthreads();
    { float hv[4][16];
      const int rot = BIDX & 15;
#pragma unroll
      for (int t = 0; t < 4; ++t)
#pragma unroll
        for (int j = 0; j < 4; ++j) { const float4 v = *(const float4*)(hs + t * 1024 + lane * 4 + 256 * j); hv[t][4 * j] = v.x; hv[t][4 * j + 1] = v.y; hv[t][4 * j + 2] = v.z; hv[t][4 * j + 3] = v.w; }
      float pe[64];
      const AS1 float* rw = gptr(rwt) + lane * 4;
      f32x4 w[4], wn[4];
#pragma unroll
      for (int j = 0; j < 4; ++j) w[j] = *(const AS1 f32x4*)(rw + (size_t)(16 * wave + (rot & 15)) * 1024 + 256 * j);
#pragma unroll
      for (int e = 0; e < 16; ++e) {
        if (e + 1 < 16) {
#pragma unroll
          for (int j = 0; j < 4; ++j) wn[j] = *(const AS1 f32x4*)(rw + (size_t)(16 * wave + ((e + 1 + rot) & 15)) * 1024 + 256 * j); }
#pragma unroll
        for (int t = 0; t < 4; ++t) { float s0 = 0.f, s1 = 0.f;
#pragma unroll
          for (int j = 0; j < 4; ++j) { s0 += hv[t][4 * j] * w[j][0] + hv[t][4 * j + 2] * w[j][2]; s1 += hv[t][4 * j + 1] * w[j][1] + hv[t][4 * j + 3] * w[j][3]; }
          pe[e * 4 + t] = s0 + s1; }
#pragma unroll
        for (int j = 0; j < 4; ++j) w[j] = wn[j]; }
#pragma unroll
      for (int half = 32; half >= 1; half >>= 1) { const bool up = (lane & half) != 0;
#pragma unroll
        for (int e = 0; e < half; ++e) { const float send = up ? pe[e] : pe[e + half]; const float recv = __shfl_xor(send, half); pe[e] = (up ? pe[e + half] : pe[e]) + recv; } }
      lg[(lane & 3) * 64 + 16 * wave + (((lane >> 2) + rot) & 15)] = pe[0]; }
    __syncthreads();
    if (!routed) continue;
    const float logit = lg[wave * 64 + lane];
    const float score = sigmoidf_(logit), sel = score + rbias;
    float m1 = sel; int a1 = lane;
#pragma unroll
    for (int m = 1; m <= 4; m <<= 1) { float ov = XOR8(m1, m); int oa = XOR8(a1, m); if (ov > m1 || (ov == m1 && oa < a1)) { m1 = ov; a1 = oa; } }
    float m2 = (lane == a1) ? -3.0e38f : sel;
#pragma unroll
    for (int m = 1; m <= 4; m <<= 1) m2 = fmaxf(m2, XOR8(m2, m));
    const float gs = m1 + m2; const int grp = lane >> 3;
    int grank = 0;
#pragma unroll
    for (int g2 = 0; g2 < 8; ++g2) { float og = SHFL_CONST(gs, g2 * 8); grank += (og > gs || (og == gs && g2 < grp)) ? 1 : 0; }
    const bool gsel = grank < 4;
    const float msel = gsel ? sel : -3.0e38f;
    int rank = 0;
#pragma unroll
    for (int e = 0; e < 64; ++e) { float ov = SHFL_CONST(msel, e); rank += (ov > msel || (ov == msel && e < lane)) ? 1 : 0; }
    const bool chosen = gsel && rank < 8;
    const float wsum = wave_sum(chosen ? score : 0.f);
    if (chosen) { const float wv = score / wsum * 2.5f;
      const int idx = atomicAdd(&lcnt[64], 1);
      if (idx < P7_MAXE) { const int slot = atomicAdd(&lcnt[lane], 1); etok[idx] = tok * 8 + rank; epos[idx] = lane | (slot << 8); ewt[idx] = wv; }
      else { int pos = atomicAdd(&cnt[lane * 64], 1); ltok[(size_t)lane * NT_ + pos] = tok * 8 + rank; lwt[(size_t)lane * NT_ + pos] = wv; } }
  }
  __syncthreads();
  if (TIDX < 64) { const int c = lcnt[TIDX]; lbase[TIDX] = c ? atomicAdd(&cnt[TIDX * 64], c) : 0; }
  __syncthreads();
  { const int ne = lcnt[64] < P7_MAXE ? lcnt[64] : P7_MAXE;
    for (int i = TIDX; i < ne; i += 256) { const int e = epos[i] & 255, pos = lbase[e] + (epos[i] >> 8);
      ltok[(size_t)e * NT_ + pos] = etok[i]; lwt[(size_t)e * NT_ + pos] = ewt[i]; } }
}

struct MoeMap { int nblk_total; int e; int rb; int cnt; int hoff; };
DEVFN int moe_ntok(int l) { return l == DEPTH_ - 1 ? B_ * SEQ_ : NT_; }
DEVFN int moe_shared_tok(int l, int i) { return l == DEPTH_ - 1 ? (i / SEQ_) * T_ + CTX_ + (i % SEQ_) : i; }
DEVFN void moe_prefix(const Params& p, int l, int* pre) {
  const int* cnt = (const int*)(p.ws + Ws::CNT) + l * 64 * 64;
  __syncthreads();
  if (TIDX < 64) pre[66 + TIDX] = gptr(cnt)[TIDX * 64];
  if (TIDX == 64) pre[66 + 64] = moe_ntok(l);
  __syncthreads();
  if (TIDX == 0) { int s = 0; for (int e = 0; e < 65; ++e) { pre[e] = s; s += (pre[66 + e] + 127) / 128; } pre[65] = s; }
  __syncthreads();
}
DEVFN void phase8(const Params& p, int l, unsigned char* smem) {
  int* pre = (int*)(smem + SM_PRE);
  moe_prefix(p, l, pre);
  const bf16_t* H = (const bf16_t*)(p.ws + Ws::U);
  const bf16_t* W13 = (const bf16_t*)(p.ws + Ws::W13);
  bf16_t* HID = (bf16_t*)(p.ws + Ws::HID);
  const int* ltok = (const int*)(p.ws + Ws::LTOK); const float* lwt = (const float*)(p.ws + Ws::LWT);
  const int total = pre[65];
  for (int u = BIDX; u < total * 2; u += gridDim.x) {
    const int gb = u >> 1, nt = u & 1;
    int e = 0; while (pre[e + 1] <= gb) ++e;
    e = UNI(e);
    const int rb = UNI(gb - pre[e]), cnt = UNI(pre[66 + e]);
    int* tk_s = (int*)(smem + GEMMW_SMEM); float* gw_s = (float*)(tk_s + 128);
    __syncthreads();
    if (TIDX < 128) { const int pos = rb * 128 + TIDX; int tk = -1; float gw = 0.f;
      if (pos < cnt) { tk = e < 64 ? (gptr(ltok)[(size_t)e * NT_ + pos] >> 3) : moe_shared_tok(l, pos); gw = e < 64 ? gptr(lwt)[(size_t)e * NT_ + pos] : 1.f; }
      tk_s[TIDX] = tk; gw_s[TIDX] = gw; }
    __syncthreads();
    gemm_tile_w<1, 1024>(smem, 1024,
      [&](int r) { const int tk = tk_s[r]; return tk >= 0 ? H + (size_t)tk * 1024 : (const bf16_t*)(p.ws + Ws::ZROW); },
      [&](int) { return W13 + ((size_t)e * 512 + nt * 256) * 1024; },
      [&](f32x4 (&acc)[4][8], int, int wr, int wc, int g, int l15) {
        tile_store_bf16<16>(smem, wr, g, l15,
          [&](bf16_t* T, int ldc) {
#pragma unroll
            for (int mi = 0; mi < 4; ++mi)
#pragma unroll
              for (int i = 0; i < 4; ++i) { const int r = wr * 64 + mi * 16 + 4 * g + i;
                const float gw = gw_s[r];
#pragma unroll
                for (int j = 0; j < 4; ++j) T[r * ldc + wc * 64 + j * 16 + l15] = f2bf(siluf_(acc[mi][2 * j][i]) * acc[mi][2 * j + 1][i] * gw); } },
          [&](int row, int c0) { const int pos = rb * 128 + row; return pos < cnt ? HID + ((size_t)gb * 128 + row) * 256 + nt * 128 + c0 : (bf16_t*)nullptr; });
      });
  }
}
DEVFN void phase9(const Params& p, int l, unsigned char* smem) {
  int* pre = (int*)(smem + SM_PRE);
  moe_prefix(p, l, pre);
  const bf16_t* HID = (const bf16_t*)(p.ws + Ws::HID);
  const bf16_t* W2T = (const bf16_t*)(p.ws + Ws::W2T);
  bf16_t* YB = (bf16_t*)(p.ws + Ws::YBUF);
  const int* ltok = (const int*)(p.ws + Ws::LTOK);
  const int total = pre[65];
  for (int u = BIDX; u < total * 2; u += gridDim.x) {
    const int gb = u >> 1, ntp = u & 1;
    int e = 0; while (pre[e + 1] <= gb) ++e;
    e = UNI(e);
    const int rb = UNI(gb - pre[e]), cnt = UNI(pre[66 + e]);
    int* ts_s = (int*)(smem + GEMMW_SMEM);
    __syncthreads();
    if (TIDX < 128) { const int pos = rb * 128 + TIDX; int ts = -1;
      if (pos < cnt) ts = e < 64 ? gptr(ltok)[(size_t)e * NT_ + pos] : moe_shared_tok(l, pos) * 8;
      ts_s[TIDX] = ts; }
    __syncthreads();
    gemm_tile_w<2, 256>(smem, 256,
      [&](int r) { return ts_s[r] >= 0 ? HID + ((size_t)gb * 128 + r) * 256 : (const bf16_t*)(p.ws + Ws::ZROW); },
      [&](int j) { return W2T + ((size_t)e * 1024 + (ntp * 2 + j) * 256) * 256; },
      [&](f32x4 (&acc)[4][8], int j, int wr, int wc, int g, int l15) { const int nt = ntp * 2 + j;
#pragma unroll 1
        for (int h = 0; h < 2; ++h)
          tile_store_bf16<16>(smem, wr, g, l15,
            [&](bf16_t* T, int ldc) {
              if (wc == h) {
#pragma unroll
                for (int mi = 0; mi < 4; ++mi)
#pragma unroll
                  for (int ni = 0; ni < 8; ++ni)
#pragma unroll
                    for (int i = 0; i < 4; ++i) T[(wr * 64 + mi * 16 + 4 * g + i) * ldc + ni * 16 + l15] = f2bf(acc[mi][ni][i]); } },
            [&](int row, int c0) { const int ts = ts_s[row]; if (ts < 0) return (bf16_t*)nullptr;
              const int tok = ts >> 3, slot = e < 64 ? (ts & 7) : 8;
              return YB + ((size_t)tok * NSLOT + slot) * 1024 + nt * 256 + h * 128 + c0; });
      });
  }
}

#define SMEM_BYTES (PH_SMEM + 2048)
#define N_PHASES (3 + 13 * DEPTH_)
__global__ void __launch_bounds__(256, 2) mega(Params p, int ph_lo, int ph_hi) {
#ifdef HIPEMU
  unsigned char* smem = hipemu::cur_smem();
#else
  unsigned char* smem = smem_dyn;
  volatile LAS unsigned* st = (volatile LAS unsigned*)(smem_dyn + SM_BAR);
  if (threadIdx.x == 0) {
    st[0] = 0u; st[1] = 0u;
    unsigned long long* tab = (unsigned long long*)(smem_dyn + SM_TAB);
#pragma unroll
    for (int i = 0; i < 40; ++i) tab[i] = (unsigned long long)p.in[i];
  }
  __syncthreads();
  XcdBarrier bar = xcd_barrier_post((unsigned*)(p.ws + Ws::BAR), st);
#define GRID_SYNC() xcd_barrier(bar)
#endif
  int ph = 0;
#ifdef ONLY_KIND
#define KIND_ON(k) ((k) == ONLY_KIND)
#else
#define KIND_ON(k) 1
#endif
#ifndef REPEAT_MASK
#define REPEAT_MASK 0u
#endif
#define RUN_PHASE(kind, code) { if (KIND_ON(kind) && ph >= ph_lo && ph < ph_hi) { \
    int nrep_ = ((REPEAT_MASK >> (kind)) & 1u) ? 2 : 1; LAUNDER(nrep_); \
    _Pragma("unroll 1") for (int rep_ = 0; rep_ < nrep_; ++rep_) { LAUNDER(p.ws); LAUNDER(p.out); code; if (rep_ + 1 < nrep_ || ph + 1 < ph_hi) { GRID_SYNC(); } } } ++ph; }
  RUN_PHASE(0, phase0(p, smem));
  RUN_PHASE(11, phase0b(p));
  for (int l = 0; l < DEPTH_; ++l) {
    RUN_PHASE(1, phase1(p, l));
    RUN_PHASE(2, phase2(p, l, smem));
    RUN_PHASE(3, phase3(p, l, smem));
    RUN_PHASE(14, phase3b(p, l, smem));
    RUN_PHASE(4, phase4a(p, l, smem));
    RUN_PHASE(12, phase4b(p, l, smem));
    RUN_PHASE(16, phase4b2(p));
    RUN_PHASE(13, phase4c(p, l, smem));
    RUN_PHASE(5, phase5(p, l, smem));
    RUN_PHASE(6, phase6(p, l, smem));
    RUN_PHASE(7, phase7(p, l, smem));
    RUN_PHASE(8, phase8(p, l, smem));
    RUN_PHASE(9, phase9(p, l, smem));
  }
  RUN_PHASE(10, phase_final(p));
}

extern "C" void kernel_launch(void* const* d_in, const int* in_sizes, int n_in, void* d_out, int out_size, void* d_ws, size_t ws_size, hipStream_t stream) {
  Params p{};
  for (int i = 0; i < 40; ++i) p.in[i] = (const float*)d_in[i];
  p.out = (float*)d_out;
  p.ws = (unsigned char*)d_ws;
  if (ws_size < Ws::END) { fprintf(stderr, "workspace too small: %zu < %zu\n", ws_size, (size_t)Ws::END); return; }
  hipMemsetAsync(d_ws, 0, Ws::ZERO_END, stream);
#ifdef HIPEMU
  int grid = 16; if (const char* e = getenv("EMU_GRID")) grid = atoi(e);
  int stop = N_PHASES; if (const char* e = getenv("EMU_STOP")) stop = atoi(e);
  if (getenv("EMU_ONE")) hipemu::launch(grid, 256, SMEM_BYTES, true, [=] { mega(p, 0, stop); });
  else for (int ph = 0; ph < stop; ++ph) hipemu::launch(grid, 256, SMEM_BYTES, false, [=] { mega(p, ph, ph + 1); });
#else
  static int grid = 0;
  if (!grid) {
    int dev = 0, cus = 0, per_cu = 0;
    hipGetDevice(&dev);
    hipDeviceGetAttribute(&cus, hipDeviceAttributeMultiprocessorCount, dev);
    hipOccupancyMaxActiveBlocksPerMultiprocessor(&per_cu, mega, 256, SMEM_BYTES);
    if (per_cu > 2) per_cu = 2;
    if (per_cu < 1) per_cu = 1;
    grid = cus * per_cu;
  }
#if N_LAUNCH_MODE == 1
  mega<<<grid, 256, SMEM_BYTES, stream>>>(p, 0, N_PHASES);
#else
  for (int ph = 0; ph < N_PHASES; ++ph) mega<<<grid, 256, SMEM_BYTES, stream>>>(p, ph, ph + 1);
#endif
#endif
}
```

```cpp
#ifndef HIPEMU
#include <hip/hip_runtime.h>
#endif
#include <stdint.h>
#include <stdio.h>

#ifndef B_
#define B_ 4
#endif
#ifndef SEQ_
#define SEQ_ 4096
#endif
#ifndef CTX_
#define CTX_ 256
#endif
#ifndef DEPTH_
#define DEPTH_ 4
#endif
#ifndef N_LAUNCH_MODE
#define N_LAUNCH_MODE 1
#endif
#define T_ (SEQ_ + CTX_)
#define NT_ (B_ * T_)
#define D_ 1024
#define NIN_ 3504
#define NMOD_ 6144
#define NR_ (B_ + 1)
#define OZ 0
#define OXBC 512
#define ODT 1536
#define ORW 1552
#define OGQ 2704
#define OGK 2832
#define OGV 2960
#define OGD 3216
#define OOG 3248
#define ALPHA_ 1.681792830507429f
#define NEXP 64
#define NSLOT 9
#define NC128 (T_ / 128)
#define NC64 (T_ / 64)
#define NC16 (T_ / 16)

#define DEVFN __device__ __forceinline__
#define LDT 72
#define GEMM_SMEM (2 * 128 * LDT * 2)
#define GEMMW_SMEM (3 * 128 * LDT * 2)
typedef unsigned short bf16_t;
#ifdef HIPEMU
#define AS1
#else
#define AS1 __attribute__((address_space(1)))
#endif
typedef unsigned u32x4 __attribute__((ext_vector_type(4)));
typedef unsigned u32x2 __attribute__((ext_vector_type(2)));

#ifdef HIPEMU
typedef emu_bf16x8 bf16x8;
typedef emu_f32x4 f32x4;
#define MFMA16(a, b, c) emu_mfma_16x16x32_bf16(a, b, c)
#define MFMA16K16(a, b, c) emu_mfma_16x16x16_bf16(a, b, c)
#define GRID_SYNC() hipemu::grid_sync()
#else
typedef short bf16x8 __attribute__((ext_vector_type(8)));
typedef float f32x4 __attribute__((ext_vector_type(4)));
#define MFMA16(a, b, c) __builtin_amdgcn_mfma_f32_16x16x32_bf16(a, b, c, 0, 0, 0)
#define MFMA16K16(a, b, c) __builtin_amdgcn_mfma_f32_16x16x16bf16_1k(a, b, c, 0, 0, 0)
#endif

DEVFN float bf2f(bf16_t h) { return __builtin_bit_cast(float, (unsigned)h << 16); }
DEVFN bf16_t f2bf(float f) { unsigned u = __builtin_bit_cast(unsigned, f); u += 0x7FFFu + ((u >> 16) & 1u); return (bf16_t)(u >> 16); }
template <class T> DEVFN AS1 T* gptr(T* q) { return (AS1 T*)q; }
DEVFN bf16x8 ld8g(const bf16_t* q) { return *(const AS1 bf16x8*)gptr(q); }
DEVFN float sigmoidf_(float x) { return 1.f / (1.f + expf(-x)); }
DEVFN float siluf_(float x) { return x / (1.f + expf(-x)); }
DEVFN float softplusf_(float x) { return x > 20.f ? x : log1pf(expf(x)); }
DEVFN float logsigmoidf_(float x) { return fminf(x, 0.f) - log1pf(expf(-fabsf(x))); }
#ifdef HIPEMU
DEVFN float wave_sum(float v) { for (int m = 32; m >= 1; m >>= 1) v += __shfl_xor(v, m); return v; }
#define SHFL_CONST(x, ln) __shfl(x, ln)
#define XOR8(x, m) __shfl_xor(x, m)
#else
template <int CTRL> DEVFN float dpp_f(float v) { return __builtin_bit_cast(float, __builtin_amdgcn_update_dpp(0, __builtin_bit_cast(int, v), CTRL, 0xF, 0xF, false)); }
template <int CTRL> DEVFN int dpp_i(int v) { return __builtin_amdgcn_update_dpp(0, v, CTRL, 0xF, 0xF, false); }
DEVFN float rdl_f(float v, int ln) { return __builtin_bit_cast(float, __builtin_amdgcn_readlane(__builtin_bit_cast(int, v), ln)); }
DEVFN float wave_sum(float v) {
  v += dpp_f<0xB1>(v);
  v += dpp_f<0x4E>(v);
  v += dpp_f<0x141>(v);
  v += dpp_f<0x140>(v);
  return (rdl_f(v, 0) + rdl_f(v, 16)) + (rdl_f(v, 32) + rdl_f(v, 48));
}
DEVFN float shfl_const_(float x, int ln) { return rdl_f(x, ln); }
DEVFN int shfl_const_(int x, int ln) { return __builtin_amdgcn_readlane(x, ln); }
#define SHFL_CONST(x, ln) shfl_const_(x, ln)
DEVFN float xor8_(float x, int m) { return m == 1 ? dpp_f<0xB1>(x) : m == 2 ? dpp_f<0x4E>(x) : dpp_f<0x141>(x); }
DEVFN int xor8_(int x, int m) { return m == 1 ? dpp_i<0xB1>(x) : m == 2 ? dpp_i<0x4E>(x) : dpp_i<0x141>(x); }
#define XOR8(x, m) xor8_(x, m)
#endif

constexpr size_t al(size_t x) { return (x + 255) & ~(size_t)255; }
struct Ws {
  static constexpr size_t BAR = 0;
  static constexpr size_t CNT = 16384;
  static constexpr size_t MOD = CNT + (size_t)DEPTH_ * 64 * 256;
  static constexpr size_t ZROW = al(MOD + (size_t)DEPTH_ * NR_ * NMOD_ * 4);
  static constexpr size_t ZERO_END = al(ZROW + 2048);
  static constexpr size_t MODP = ZERO_END;
  static constexpr size_t RWT = al(MODP + (size_t)16 * DEPTH_ * NR_ * NMOD_ * 4);
  static constexpr size_t LORA = al(RWT + (size_t)DEPTH_ * 64 * 1024 * 4);
  static constexpr size_t X = al(LORA + (size_t)DEPTH_ * 98304 * 2);
  static constexpr size_t U = al(X + (size_t)NT_ * 1024 * 4);
  static constexpr size_t YMIX = al(U + (size_t)NT_ * 1024 * 2);
  static constexpr size_t ZX = al(YMIX + (size_t)NT_ * 1024 * 2);
  static constexpr size_t MIX = ZX;
  static constexpr size_t LTOK = al(ZX + (size_t)NT_ * NIN_ * 2);
  static constexpr size_t LWT = al(LTOK + (size_t)64 * NT_ * 4);
  static constexpr size_t WIN = al(LWT + (size_t)64 * NT_ * 4);
  static constexpr size_t WOUT = al(WIN + (size_t)DEPTH_ * NIN_ * 1024 * 2);
  static constexpr size_t W13 = al(WOUT + (size_t)DEPTH_ * 1024 * 1024 * 2);
  static constexpr size_t W2T = al(W13 + (size_t)65 * 512 * 1024 * 2);
  static constexpr size_t UNI = al(W2T + (size_t)65 * 1024 * 256 * 2);
  static constexpr size_t XBC = UNI;
  static constexpr size_t XBCT = al(XBC + (size_t)NT_ * 1024 * 2);
  static constexpr size_t DTB = al(XBCT + (size_t)NT_ * 768 * 2);
  static constexpr size_t SST = al(DTB + (size_t)NT_ * 16 * 4);
  static constexpr size_t SCD = al(SST + (size_t)2 * NT_ / 128 * 8 * 8192 * 4);
  static constexpr size_t HIN = al(SCD + (size_t)2 * NT_ / 128 * 8 * 4);
  static constexpr size_t YS = SST;
  static constexpr size_t LA = al(HIN + (size_t)2 * NT_ / 128 * 8 * 8192 * 2);
  static constexpr size_t VT = al(LA + (size_t)2 * NT_ * 128 * 4);
  static constexpr size_t QT = al(VT + (size_t)NT_ * 256 * 2);
  static constexpr size_t OI = al(QT + (size_t)2 * NT_ * 128 * 2);
  static constexpr size_t GST = al(OI + (size_t)NT_ * 256 * 4);
  static constexpr size_t GCD = al(GST + (size_t)2 * NT_ / 64 * 4 * 2048 * 4);
  static constexpr size_t GSIN = al(GCD + (size_t)2 * NT_ / 64 * 4 * 32 * 4);
  static constexpr size_t RR = al(GSIN + (size_t)2 * NT_ / 64 * 4 * 2048 * 2);
  static constexpr size_t VV = RR + (size_t)NT_ * 256 * 2;
  static constexpr size_t KK = VV + (size_t)NT_ * 256 * 2;
  static constexpr size_t KD = KK + (size_t)NT_ * 256 * 2;
  static constexpr size_t BD = KD + (size_t)2 * NT_ * 256 * 2;
  static constexpr size_t LW = BD + (size_t)2 * NT_ * 256 * 2;
  static constexpr size_t GATE = LW + (size_t)2 * NT_ * 256 * 4;
  static constexpr size_t YR = GATE + (size_t)NT_ * 256 * 4;
  static constexpr size_t RML = al(YR + (size_t)2 * NT_ * 256 * 4);
  static constexpr size_t RNS = RML + (size_t)(NT_ / 16) * 8 * 4096 * 2;
  static constexpr size_t RWC = RNS + (size_t)(NT_ / 16) * 8 * 4096 * 2;
  static constexpr size_t RG = RWC + (size_t)(NT_ / 16) * 8 * 64 * 4;
  static constexpr size_t RY0 = RG + (size_t)(NT_ / 16) * 8 * 1024 * 2;
  static constexpr size_t LI = RY0 + (size_t)(NT_ / 16) * 8 * 1024 * 4;
  static constexpr size_t KRW = LI + (size_t)NT_ * 384 * 2;
  static constexpr size_t MIXER_END = KRW + (size_t)NT_ * 256 * 2;
  static constexpr size_t HID = UNI;
  static constexpr size_t YBUF = al(HID + ((size_t)NT_ * 9 + 65 * 128) * 256 * 2);
  static constexpr size_t MOE_END = YBUF + (size_t)NT_ * 9 * 1024 * 2;
  static constexpr size_t END = al(MIXER_END > MOE_END ? MIXER_END : MOE_END);
};

struct Params {
  const float* in[40];
  float* out;
  unsigned char* ws;
};
enum { I_X = 0, I_C, I_CTX, I_CCTX, I_ADAW, I_ADAB, I_WIN, I_CONVW, I_CONVB, I_DTBIAS, I_ALOG, I_SSDD, I_SSDNW, I_MU, I_W0, I_W2, I_A0, I_A2,
       I_G2, I_KKW, I_KAW, I_RK, I_LNXW, I_LNXB, I_GU, I_GB, I_GNW, I_WOUT, I_LN1W, I_LN1B, I_LN2W, I_LN2B, I_RW, I_RB, I_EW1, I_EW3, I_EW2,
       I_SW1, I_SW3, I_SW2 };

#define PH_SMEM 57344
#define SM_PRE (PH_SMEM)
#define SM_TAB (PH_SMEM + 1024)
#define SM_BAR (PH_SMEM + 2032)
#ifdef HIPEMU
#define INP(i) (p.in[i])
#define LAUNDER(x)
#define TIDX ((int)threadIdx.x)
#define BIDX ((int)blockIdx.x)
#define LAUNDER_V(x)
#define UNI(x) (x)
#else
extern __shared__ __align__(16) unsigned char smem_dyn[];
DEVFN const float* inp_lds(int i) {
  const volatile unsigned* t = (const volatile unsigned*)(smem_dyn + SM_TAB) + 2 * i;
  unsigned lo = __builtin_amdgcn_readfirstlane(t[0]), hi = __builtin_amdgcn_readfirstlane(t[1]);
  return (const float*)(((unsigned long long)hi << 32) | lo);
}
#define INP(i) inp_lds(i)
#define LAUNDER(x) asm volatile("" : "+s"(x))
DEVFN int tidx_() { int t = threadIdx.x; asm volatile("" : "+v"(t)); return t; }
DEVFN int bidx_() { int b = blockIdx.x; asm volatile("" : "+s"(b)); return b; }
#define TIDX tidx_()
#define LAUNDER_V(x) asm volatile("" : "+v"(x))
#define BIDX bidx_()
#define UNI(x) __builtin_amdgcn_readfirstlane(x)
#endif
#ifndef HIPEMU
#define XB_TMO      128
#define XB_XCNT(j)  (256  + 64 * (j))
#define XB_XSUB(j)  (1280 + 64 * (j))
#define XB_XGEN(j)  (2304 + 64 * (j))
#define XB_TOP      3328
#define XB_TOPGEN   3392
#define XCD_BAR_WORDS 3456
#define XB_SPIN_CAP (1u << 22)
#define LAS __attribute__((address_space(3)))
__device__ __forceinline__ unsigned xb_ld(unsigned* p)              { return __hip_atomic_load(p, __ATOMIC_RELAXED, __HIP_MEMORY_SCOPE_AGENT); }
__device__ __forceinline__ unsigned xb_add(unsigned* p, unsigned v) { return __hip_atomic_fetch_add(p, v, __ATOMIC_RELAXED, __HIP_MEMORY_SCOPE_AGENT); }
__device__ __forceinline__ unsigned xb_xcc_id() { return (unsigned)__builtin_amdgcn_s_getreg((3 << 11) | 20) & 0xFu; }
#define XB_SPIN(cond, bar) do { unsigned _sp = 0; while (cond) { __builtin_amdgcn_s_sleep(1); \
    if ((++_sp & 255u) == 0u) { if (xb_ld(&(bar)[XB_TMO])) break; if (_sp > XB_SPIN_CAP) { atomicAdd(&(bar)[XB_TMO], 1u); break; } } } } while (0)
struct XcdBarrier { unsigned* bar; unsigned x; volatile LAS unsigned* st; };
__device__ __forceinline__ XcdBarrier xcd_barrier_post(unsigned* bar, volatile LAS unsigned* st) {
    XcdBarrier b; b.bar = bar; b.x = xb_xcc_id(); b.st = st;
    if (threadIdx.x == 0) (void)xb_add(&bar[XB_XCNT(b.x)], 1u);
    return b;
}
__device__ __forceinline__ void xcd_barrier_complete(unsigned* bar, unsigned x, unsigned& nloc, unsigned& nx) {
    const unsigned G = gridDim.x * gridDim.y * gridDim.z;
    unsigned sum, cnt, mine, sp = 0u;
    for (;;) {
        sum = 0u; cnt = 0u; mine = 0u;
#pragma unroll
        for (unsigned j = 0; j < 16; ++j) { const unsigned c = xb_ld(&bar[XB_XCNT(j)]); sum += c; cnt += (c > 0u) ? 1u : 0u; mine = (j == x) ? c : mine; }
        if (sum == G) break;
        __builtin_amdgcn_s_sleep(1);
        if ((++sp & 255u) == 0u) { if (xb_ld(&bar[XB_TMO])) break; if (sp > XB_SPIN_CAP) { atomicAdd(&bar[XB_TMO], 1u); break; } }
    }
    nloc = mine > 0u ? mine : 1u; nx = cnt > 0u ? cnt : 1u;
}
__device__ __forceinline__ void xcd_barrier(const XcdBarrier& b) {
    asm volatile("s_waitcnt vmcnt(0)" ::: "memory");
    __syncthreads();
    if (threadIdx.x == 0) {
        unsigned* bar = b.bar;
        __builtin_amdgcn_s_waitcnt(0);
        unsigned nloc = b.st[0], nx = b.st[1];
        if (nloc == 0u) { xcd_barrier_complete(bar, b.x, nloc, nx); b.st[0] = nloc; b.st[1] = nx; }
        const unsigned old = xb_add(&bar[XB_XSUB(b.x)], 1u);
        const unsigned gen = old / nloc;
        if (old + 1u == (gen + 1u) * nloc) {
            __builtin_amdgcn_fence(__ATOMIC_RELEASE, "agent");
            asm volatile("s_waitcnt vmcnt(0)" ::: "memory");
            const unsigned og = xb_add(&bar[XB_TOP], 1u);
            const unsigned tg = og / nx;
            if (og + 1u == (tg + 1u) * nx) xb_add(&bar[XB_TOPGEN], 1u);
            else XB_SPIN(xb_ld(&bar[XB_TOPGEN]) == tg, bar);
            __builtin_amdgcn_fence(__ATOMIC_ACQUIRE, "agent");
            xb_add(&bar[XB_XGEN(b.x)], 1u);
            asm volatile("s_waitcnt vmcnt(0)" ::: "memory");
        } else {
            XB_SPIN(xb_ld(&bar[XB_XGEN(b.x)]) == gen, bar);
            __builtin_amdgcn_fence(__ATOMIC_ACQUIRE, "agent");
            asm volatile("s_waitcnt vmcnt(0)" ::: "memory");
        }
    }
    __syncthreads();
}
#endif

DEVFN int tokmap(int dir, int p) { return dir == 0 ? p : (p < CTX_ ? CTX_ - 1 - p : 2 * CTX_ + SEQ_ - 1 - p); }
DEVFN const float* tok_input_row(const Params& p, int tok) {
  int b = tok / T_, t = tok % T_;
  return t < CTX_ ? INP(I_CTX) + ((size_t)b * CTX_ + t) * D_ : INP(I_X) + ((size_t)b * SEQ_ + (t - CTX_)) * D_;
}
DEVFN int tok_modrow(int tok) { return (tok % T_) < CTX_ ? B_ : tok / T_; }

template <class ARow, class BRow, class Epi>
DEVFN void gemm_tile(unsigned char* smem, int K, ARow arow, BRow brow, Epi epi) {
  bf16_t* As = (bf16_t*)smem;
  bf16_t* Bs = As + 128 * LDT;
  const int tid = TIDX, lane = tid & 63, wave = tid >> 6, wr = wave >> 1, wc = wave & 1;
  const int g = lane >> 4, l15 = lane & 15;
  const int lr = tid >> 3, lc = (tid & 7) * 8;
  const AS1 bf16_t* ap[4];
  const AS1 bf16_t* bp[4];
#pragma unroll
  for (int i = 0; i < 4; ++i) { ap[i] = gptr(arow(lr + 32 * i)); bp[i] = gptr(brow(lr + 32 * i)); }
  f32x4 acc[4][4];
#pragma unroll
  for (int mi = 0; mi < 4; ++mi)
#pragma unroll
    for (int ni = 0; ni < 4; ++ni) acc[mi][ni] = f32x4{0.f, 0.f, 0.f, 0.f};
  u32x4 ra0[4], rb0[4], ra1[4], rb1[4];
#pragma unroll
  for (int i = 0; i < 4; ++i) { ra0[i] = *(const AS1 u32x4*)(ap[i] + lc); rb0[i] = *(const AS1 u32x4*)(bp[i] + lc); }
  if (K > 64) {
#pragma unroll
    for (int i = 0; i < 4; ++i) { ra1[i] = *(const AS1 u32x4*)(ap[i] + 64 + lc); rb1[i] = *(const AS1 u32x4*)(bp[i] + 64 + lc); } }
  auto compute = [&]() {
#pragma unroll
    for (int kk = 0; kk < 2; ++kk) {
      bf16x8 af[4], bfr[4];
#pragma unroll
      for (int mi = 0; mi < 4; ++mi) af[mi] = *(const bf16x8*)(As + (wr * 64 + mi * 16 + l15) * LDT + kk * 32 + g * 8);
#pragma unroll
      for (int ni = 0; ni < 4; ++ni) bfr[ni] = *(const bf16x8*)(Bs + (wc * 64 + ni * 16 + l15) * LDT + kk * 32 + g * 8);
#pragma unroll
      for (int mi = 0; mi < 4; ++mi)
#pragma unroll
        for (int ni = 0; ni < 4; ++ni) acc[mi][ni] = MFMA16(af[mi], bfr[ni], acc[mi][ni]);
    } };
  for (int k0 = 0; k0 < K; k0 += 128) {
    __syncthreads();
#pragma unroll
    for (int i = 0; i < 4; ++i) { *(u32x4*)(As + (lr + 32 * i) * LDT + lc) = ra0[i]; *(u32x4*)(Bs + (lr + 32 * i) * LDT + lc) = rb0[i]; }
    __syncthreads();
    if (k0 + 128 < K) {
#pragma unroll
      for (int i = 0; i < 4; ++i) { ra0[i] = *(const AS1 u32x4*)(ap[i] + k0 + 128 + lc); rb0[i] = *(const AS1 u32x4*)(bp[i] + k0 + 128 + lc); } }
    compute();
    if (k0 + 64 < K) {
      __syncthreads();
#pragma unroll
      for (int i = 0; i < 4; ++i) { *(u32x4*)(As + (lr + 32 * i) * LDT + lc) = ra1[i]; *(u32x4*)(Bs + (lr + 32 * i) * LDT + lc) = rb1[i]; }
      __syncthreads();
      if (k0 + 192 < K) {
#pragma unroll
        for (int i = 0; i < 4; ++i) { ra1[i] = *(const AS1 u32x4*)(ap[i] + k0 + 192 + lc); rb1[i] = *(const AS1 u32x4*)(bp[i] + k0 + 192 + lc); } }
      compute();
    }
  }
  epi(acc, wr, wc, g, l15);
}

template <int NB, class ARow, class BRow, class Epi>
DEVFN void gemm_tile_multi(unsigned char* smem, int K, ARow arow, BRow brow, Epi epi) {
  bf16_t* As = (bf16_t*)smem;
  bf16_t* Bs = As + 128 * LDT;
  const int tid = TIDX, lane = tid & 63, wave = tid >> 6, wr = wave >> 1, wc = wave & 1;
  const int g = lane >> 4, l15 = lane & 15;
  const int lr = tid >> 3, lc = (tid & 7) * 8;
  const AS1 bf16_t* ap[4];
  const AS1 bf16_t* bp[4];
#pragma unroll
  for (int i = 0; i < 4; ++i) { ap[i] = gptr(arow(lr + 32 * i)); bp[i] = gptr(brow(lr + 32 * i, 0)); }
  f32x4 acc[4][4];
  u32x4 ra0[4], rb0[4], ra1[4], rb1[4];
#pragma unroll
  for (int i = 0; i < 4; ++i) { ra0[i] = *(const AS1 u32x4*)(ap[i] + lc); rb0[i] = *(const AS1 u32x4*)(bp[i] + lc); }
  if (K > 64) {
#pragma unroll
    for (int i = 0; i < 4; ++i) { ra1[i] = *(const AS1 u32x4*)(ap[i] + 64 + lc); rb1[i] = *(const AS1 u32x4*)(bp[i] + 64 + lc); } }
  auto compute = [&]() {
#pragma unroll
    for (int kk = 0; kk < 2; ++kk) {
      bf16x8 af[4], bfr[4];
#pragma unroll
      for (int mi = 0; mi < 4; ++mi) af[mi] = *(const bf16x8*)(As + (wr * 64 + mi * 16 + l15) * LDT + kk * 32 + g * 8);
#pragma unroll
      for (int ni = 0; ni < 4; ++ni) bfr[ni] = *(const bf16x8*)(Bs + (wc * 64 + ni * 16 + l15) * LDT + kk * 32 + g * 8);
#pragma unroll
      for (int mi = 0; mi < 4; ++mi)
#pragma unroll
        for (int ni = 0; ni < 4; ++ni) acc[mi][ni] = MFMA16(af[mi], bfr[ni], acc[mi][ni]);
    } };
#pragma unroll
  for (int j = 0; j < NB; ++j) {
#pragma unroll
  for (int mi = 0; mi < 4; ++mi)
#pragma unroll
    for (int ni = 0; ni < 4; ++ni) acc[mi][ni] = f32x4{0.f, 0.f, 0.f, 0.f};
  for (int k0 = 0; k0 < K; k0 += 128) {
    __syncthreads();
#pragma unroll
    for (int i = 0; i < 4; ++i) { *(u32x4*)(As + (lr + 32 * i) * LDT + lc) = ra0[i]; *(u32x4*)(Bs + (lr + 32 * i) * LDT + lc) = rb0[i]; }
    __syncthreads();
    if (k0 + 128 < K) {
#pragma unroll
      for (int i = 0; i < 4; ++i) { ra0[i] = *(const AS1 u32x4*)(ap[i] + k0 + 128 + lc); rb0[i] = *(const AS1 u32x4*)(bp[i] + k0 + 128 + lc); } }
    compute();
    if (k0 + 64 < K) {
      __syncthreads();
#pragma unroll
      for (int i = 0; i < 4; ++i) { *(u32x4*)(As + (lr + 32 * i) * LDT + lc) = ra1[i]; *(u32x4*)(Bs + (lr + 32 * i) * LDT + lc) = rb1[i]; }
      __syncthreads();
      if (k0 + 192 < K) {
#pragma unroll
        for (int i = 0; i < 4; ++i) { ra1[i] = *(const AS1 u32x4*)(ap[i] + k0 + 192 + lc); rb1[i] = *(const AS1 u32x4*)(bp[i] + k0 + 192 + lc); } }
      compute();
    }
  }
  if (j + 1 < NB) {
#pragma unroll
    for (int i = 0; i < 4; ++i) { bp[i] = gptr(brow(lr + 32 * i, j + 1)); ra0[i] = *(const AS1 u32x4*)(ap[i] + lc); rb0[i] = *(const AS1 u32x4*)(bp[i] + lc); } }
  epi(acc, j, wr, wc, g, l15);
  if (j + 1 < NB) {
#pragma unroll
    for (int i = 0; i < 4; ++i) { ra1[i] = *(const AS1 u32x4*)(ap[i] + 64 + lc); rb1[i] = *(const AS1 u32x4*)(bp[i] + 64 + lc); } }
  }
}

template <int NB, int LDB, class ARow, class BBase, class Epi>
DEVFN void gemm_tile_w(unsigned char* smem, int K, ARow arow, BBase bbase, Epi epi) {
  bf16_t* As = (bf16_t*)smem;
  bf16_t* Bs = As + 128 * LDT;
  const int tid = TIDX, lane = tid & 63, wave = tid >> 6, wr = wave >> 1, wc = wave & 1;
  const int g = lane >> 4, l15 = lane & 15;
  const int lr = tid >> 3, lc = (tid & 7) * 8;
  const AS1 bf16_t* ap[4];
#pragma unroll
  for (int i = 0; i < 4; ++i) ap[i] = gptr(arow(lr + 32 * i));
  const AS1 bf16_t* bb = gptr(bbase(0));
  const unsigned boff = (unsigned)(lr * LDB + lc);
  f32x4 acc[4][8];
  u32x4 ra[4], rb[8];
#pragma unroll
  for (int i = 0; i < 4; ++i) ra[i] = *(const AS1 u32x4*)(ap[i] + lc);
#pragma unroll
  for (int i = 0; i < 8; ++i) rb[i] = *(const AS1 u32x4*)(bb + (size_t)(i * 32 * LDB) + boff);
#pragma unroll
  for (int j = 0; j < NB; ++j) {
#pragma unroll
    for (int mi = 0; mi < 4; ++mi)
#pragma unroll
      for (int ni = 0; ni < 8; ++ni) acc[mi][ni] = f32x4{0.f, 0.f, 0.f, 0.f};
#pragma unroll 1
    for (int k0 = 0; k0 < K; k0 += 64) {
      __syncthreads();
#pragma unroll
      for (int i = 0; i < 4; ++i) *(u32x4*)(As + (lr + 32 * i) * LDT + lc) = ra[i];
#pragma unroll
      for (int i = 0; i < 8; ++i) *(u32x4*)(Bs + (lr + 32 * i) * LDT + lc) = rb[i];
      __syncthreads();
      if (k0 + 64 < K) {
#pragma unroll
        for (int i = 0; i < 4; ++i) ra[i] = *(const AS1 u32x4*)(ap[i] + k0 + 64 + lc);
#pragma unroll
        for (int i = 0; i < 8; ++i) rb[i] = *(const AS1 u32x4*)(bb + (size_t)(i * 32 * LDB + k0 + 64) + boff);
      }
#pragma unroll
      for (int kk = 0; kk < 2; ++kk) {
        bf16x8 af[4];
#pragma unroll
        for (int mi = 0; mi < 4; ++mi) af[mi] = *(const bf16x8*)(As + (wr * 64 + mi * 16 + l15) * LDT + kk * 32 + g * 8);
#pragma unroll
        for (int h = 0; h < 2; ++h) {
          bf16x8 bfr[4];
#pragma unroll
          for (int ni = 0; ni < 4; ++ni) bfr[ni] = *(const bf16x8*)(Bs + (wc * 128 + h * 64 + ni * 16 + l15) * LDT + kk * 32 + g * 8);
#pragma unroll
          for (int mi = 0; mi < 4; ++mi)
#pragma unroll
            for (int ni = 0; ni < 4; ++ni) acc[mi][h * 4 + ni] = MFMA16(af[mi], bfr[ni], acc[mi][h * 4 + ni]);
        }
      }
    }
    if (j + 1 < NB) {
      bb = gptr(bbase(j + 1));
#pragma unroll
      for (int i = 0; i < 4; ++i) ra[i] = *(const AS1 u32x4*)(ap[i] + lc);
#pragma unroll
      for (int i = 0; i < 8; ++i) rb[i] = *(const AS1 u32x4*)(bb + (size_t)(i * 32 * LDB) + boff); }
    epi(acc, j, wr, wc, g, l15);
  }
}

template <int NCH, class Val, class RowP>
DEVFN void tile_store_bf16(unsigned char* smem, int wr, int g, int l15, Val val, RowP rowp) {
  constexpr int LDC = NCH * 8 + 8;
  bf16_t* T = (bf16_t*)smem;
  const int tid = TIDX;
  __syncthreads();
  val(T, LDC);
  __syncthreads();
#pragma unroll
  for (int pass = 0; pass < NCH / 2; ++pass) { const int id = tid + 256 * pass, row = id / NCH, c = id % NCH;
    bf16_t* dst = rowp(row, c * 8);
    if (dst) *(AS1 u32x4*)gptr(dst) = *(const u32x4*)(T + row * LDC + c * 8); }
  (void)wr; (void)g; (void)l15;
}
DEVFN void cvt_tile(unsigned char* smem, const float* src, int K, int N, int k0, int n0, bf16_t* dst, int ldd, int mode) {
  float* s = (float*)smem;
  const int tid = TIDX;
  const AS1 float* gsrc = gptr(src);
  __syncthreads();
  { const int kk = tid >> 4, n4 = (tid & 15) * 4;
#pragma unroll
    for (int pass = 0; pass < 4; ++pass) { const int k = kk + 16 * pass;
      f32x4 v = f32x4{0.f, 0.f, 0.f, 0.f};
      if (n0 + n4 < N) v = *(const AS1 f32x4*)(gsrc + (size_t)(k0 + k) * N + n0 + n4);
      s[k * 65 + n4] = v[0]; s[k * 65 + n4 + 1] = v[1]; s[k * 65 + n4 + 2] = v[2]; s[k * 65 + n4 + 3] = v[3]; } }
  __syncthreads();
  { const int nn = tid >> 2, k16 = (tid & 3) * 16, n = n0 + nn;
    if (n < N) { const int row = mode == 0 ? n : ((n >> 4) * 32 + (n & 15) + (mode == 2 ? 16 : 0));
      u32x4 o0, o1;
#pragma unroll
      for (int j = 0; j < 4; ++j) { o0[j] = (unsigned)f2bf(s[(k16 + 2 * j) * 65 + nn]) | ((unsigned)f2bf(s[(k16 + 2 * j + 1) * 65 + nn]) << 16);
        o1[j] = (unsigned)f2bf(s[(k16 + 8 + 2 * j) * 65 + nn]) | ((unsigned)f2bf(s[(k16 + 9 + 2 * j) * 65 + nn]) << 16); }
      AS1 bf16_t* d = gptr(dst) + (size_t)row * ldd + k0 + k16;
      *(AS1 u32x4*)d = o0; *(AS1 u32x4*)(d + 8) = o1; } }
  (void)K;
}
struct CvtJob { const float* src; bf16_t* dst; int N, k0, n0, ldd, mode; };
DEVFN void cvt_load(const CvtJob& j, f32x4 (&v)[4]) {
  const int tid = TIDX, kk = tid >> 4, n4 = (tid & 15) * 4;
  const AS1 float* g = gptr(j.src);
#pragma unroll
  for (int pass = 0; pass < 4; ++pass) { v[pass] = f32x4{0.f, 0.f, 0.f, 0.f};
    if (j.n0 + n4 < j.N) v[pass] = *(const AS1 f32x4*)(g + (size_t)(j.k0 + kk + 16 * pass) * j.N + j.n0 + n4); }
}
DEVFN void cvt_store(unsigned char* smem, const CvtJob& j, const f32x4 (&v)[4]) {
  float* s = (float*)smem;
  const int tid = TIDX, kk = tid >> 4, n4 = (tid & 15) * 4;
  __syncthreads();
#pragma unroll
  for (int pass = 0; pass < 4; ++pass) { const int k = kk + 16 * pass; s[k * 65 + n4] = v[pass][0]; s[k * 65 + n4 + 1] = v[pass][1]; s[k * 65 + n4 + 2] = v[pass][2]; s[k * 65 + n4 + 3] = v[pass][3]; }
  __syncthreads();
  const int nn = tid >> 2, k16 = (tid & 3) * 16, n = j.n0 + nn;
  if (n < j.N) { const int row = j.mode == 0 ? n : ((n >> 4) * 32 + (n & 15) + (j.mode == 2 ? 16 : 0));
    u32x4 o0, o1;
#pragma unroll
    for (int q = 0; q < 4; ++q) { o0[q] = (unsigned)f2bf(s[(k16 + 2 * q) * 65 + nn]) | ((unsigned)f2bf(s[(k16 + 2 * q + 1) * 65 + nn]) << 16);
      o1[q] = (unsigned)f2bf(s[(k16 + 8 + 2 * q) * 65 + nn]) | ((unsigned)f2bf(s[(k16 + 9 + 2 * q) * 65 + nn]) << 16); }
    AS1 bf16_t* d = gptr(j.dst) + (size_t)row * j.ldd + j.k0 + k16;
    *(AS1 u32x4*)d = o0; *(AS1 u32x4*)(d + 8) = o1; }
}
DEVFN CvtJob moe_cvt_job(const Params& p, int l, int u) {
  bf16_t* w13 = (bf16_t*)(p.ws + Ws::W13); bf16_t* w2t = (bf16_t*)(p.ws + Ws::W2T);
  const int e = u / 192, r = u % 192, which = r / 64, t = r % 64;
  CvtJob j;
  if (which < 2) {
    j.src = e < 64 ? (which == 0 ? INP(I_EW1) : INP(I_EW3)) + ((size_t)l * 64 + e) * 1024 * 256 : (which == 0 ? INP(I_SW1) : INP(I_SW3)) + (size_t)l * 1024 * 256;
    j.N = 256; j.k0 = (t >> 2) * 64; j.n0 = (t & 3) * 64; j.dst = w13 + (size_t)e * 512 * 1024; j.ldd = 1024; j.mode = which == 0 ? 1 : 2;
  } else {
    j.src = e < 64 ? INP(I_EW2) + ((size_t)l * 64 + e) * 256 * 1024 : INP(I_SW2) + (size_t)l * 256 * 1024;
    j.N = 1024; j.k0 = (t >> 4) * 64; j.n0 = (t & 15) * 64; j.dst = w2t + (size_t)e * 1024 * 256; j.ldd = 256; j.mode = 0;
  }
  return j;
}
DEVFN void convert_moe_weights(const Params& p, int l, unsigned char* smem, int bid, int nb, int j_lo, int j_hi) {
  if (j_lo + bid >= j_hi) return;
  f32x4 v[4], vn[4];
  CvtJob j = moe_cvt_job(p, l, j_lo + bid);
  cvt_load(j, v);
  for (int u = j_lo + bid; u < j_hi; u += nb) {
    const int un = u + nb;
    CvtJob jn = j;
    if (un < j_hi) { jn = moe_cvt_job(p, l, un); cvt_load(jn, vn); }
    cvt_store(smem, j, v);
    j = jn;
#pragma unroll
    for (int q = 0; q < 4; ++q) v[q] = vn[q];
  }
}
DEVFN void phase0(const Params& p, unsigned char* smem) {
  const int tid = TIDX;
  float* modp = (float*)(p.ws + Ws::MODP);
  for (int u = BIDX; u < DEPTH_ * 24 * 16; u += gridDim.x) {
    int l = u / (24 * 16), jb = (u / 16) % 24, ks = u % 16;
    float* sc = (float*)smem;
    __syncthreads();
    for (int e = tid; e < NR_ * 64; e += 256) { int r = e / 64, i = ks * 64 + (e % 64); float cv = r < B_ ? INP(I_C)[(size_t)r * D_ + i] : INP(I_CCTX)[i]; sc[e] = siluf_(cv); }
    __syncthreads();
    int j = jb * 256 + tid;
    float acc[NR_];
#pragma unroll
    for (int r = 0; r < NR_; ++r) acc[r] = 0.f;
    const float* w = INP(I_ADAW) + ((size_t)l * D_ + ks * 64) * NMOD_ + j;
#pragma unroll 4
    for (int i = 0; i < 64; ++i) { float wv = w[(size_t)i * NMOD_];
#pragma unroll
      for (int r = 0; r < NR_; ++r) acc[r] += sc[r * 64 + i] * wv; }
#pragma unroll
    for (int r = 0; r < NR_; ++r) modp[(((size_t)ks * DEPTH_ + l) * NR_ + r) * NMOD_ + j] = acc[r];
  }
  bf16_t* win = (bf16_t*)(p.ws + Ws::WIN);
  bf16_t* wout = (bf16_t*)(p.ws + Ws::WOUT);
  for (int u = BIDX; u < DEPTH_ * 16 * 55; u += gridDim.x) {
    int l = u / (16 * 55), r = u % (16 * 55);
    cvt_tile(smem, INP(I_WIN) + (size_t)l * 1024 * NIN_, 1024, NIN_, (r / 55) * 64, (r % 55) * 64, win + (size_t)l * NIN_ * 1024, 1024, 0);
  }
  for (int u = BIDX; u < DEPTH_ * 256; u += gridDim.x) {
    int l = u / 256, r = u % 256;
    cvt_tile(smem, INP(I_WOUT) + (size_t)l * 1024 * 1024, 1024, 1024, (r / 16) * 64, (r % 16) * 64, wout + (size_t)l * 1024 * 1024, 1024, 0);
  }
  { bf16_t* lo = (bf16_t*)(p.ws + Ws::LORA);
    for (int u = BIDX * 256 + tid; u < DEPTH_ * 98304; u += gridDim.x * 256) {
      const int l = u / 98304, r = u % 98304; float v;
      if (r < 32768) { const int d = r >> 14, n = (r >> 6) & 255, k = r & 63; v = INP(I_W2)[(((size_t)l * 2 + d) * 64 + k) * 256 + n]; }
      else if (r < 65536) { const int r2 = r - 32768, d = r2 >> 14, n = (r2 >> 6) & 255, k = r2 & 63; v = INP(I_A2)[(((size_t)l * 2 + d) * 64 + k) * 256 + n]; }
      else { const int r2 = r - 65536, n = r2 >> 7, k = r2 & 127; v = INP(I_G2)[((size_t)l * 128 + k) * 256 + n]; }
      lo[u] = f2bf(v); } }
  float* rwt = (float*)(p.ws + Ws::RWT);
  for (int u = BIDX * 256 + tid; u < DEPTH_ * 64 * 1024; u += gridDim.x * 256) {
    int l = u / (64 * 1024), e = (u / 1024) % 64, i = u % 1024;
    rwt[u] = INP(I_RW)[((size_t)l * 1024 + i) * 64 + e];
  }
}

DEVFN void phase0b(const Params& p) {
  float* mod = (float*)(p.ws + Ws::MOD); const float* modp = (const float*)(p.ws + Ws::MODP);
  for (int u = BIDX * 256 + TIDX; u < DEPTH_ * NR_ * NMOD_; u += gridDim.x * 256) {
    int l = u / (NR_ * NMOD_), j = u % NMOD_;
    float s = INP(I_ADAB)[(size_t)l * NMOD_ + j];
    for (int ks = 0; ks < 16; ++ks) s += modp[(size_t)ks * DEPTH_ * NR_ * NMOD_ + u];
    mod[u] = s;
  }
}

DEVFN void row_stats(const float (&v)[16], float& mean, float& rstd) {
  float s = 0.f;
#pragma unroll
  for (int i = 0; i < 16; ++i) s += v[i];
  mean = wave_sum(s) * (1.f / 1024.f);
  float q = 0.f;
#pragma unroll
  for (int i = 0; i < 16; ++i) { float d = v[i] - mean; q += d * d; }
  rstd = rsqrtf(wave_sum(q) * (1.f / 1024.f) + 1e-5f);
}
DEVFN void load_row16(const float* row, int lane, float (&v)[16]) {
  const AS1 float* r = gptr(row);
#pragma unroll
  for (int j = 0; j < 4; ++j) { const f32x4 t = *(const AS1 f32x4*)(r + lane * 4 + 256 * j); v[4 * j] = t[0]; v[4 * j + 1] = t[1]; v[4 * j + 2] = t[2]; v[4 * j + 3] = t[3]; }
}
DEVFN void moe_residual_row(const Params& p, int lp, int tok, int lane, float (&xv)[16]) {
  const float* mod = (const float*)(p.ws + Ws::MOD) + ((size_t)lp * NR_ + tok_modrow(tok)) * NMOD_;
  const bf16_t* yb = (const bf16_t*)(p.ws + Ws::YBUF) + (size_t)tok * NSLOT * 1024;
  float g2[16], w[16], b[16];
  load_row16(mod + 5 * 1024, lane, g2);
  load_row16(INP(I_LN2W) + (size_t)lp * 1024, lane, w);
  load_row16(INP(I_LN2B) + (size_t)lp * 1024, lane, b);
  u32x2 sl[NSLOT][4];
#pragma unroll
  for (int s = 0; s < NSLOT; ++s)
#pragma unroll
    for (int j = 0; j < 4; ++j) sl[s][j] = *(const AS1 u32x2*)gptr(yb + (size_t)s * 1024 + lane * 4 + 256 * j);
  float f[16];
#pragma unroll
  for (int i = 0; i < 16; ++i) f[i] = 0.f;
#pragma unroll
  for (int s = 0; s < NSLOT; ++s)
#pragma unroll
    for (int j = 0; j < 4; ++j) { const u32x2 t = sl[s][j];
      f[4 * j] += bf2f((bf16_t)(t[0] & 0xFFFF)); f[4 * j + 1] += bf2f((bf16_t)(t[0] >> 16)); f[4 * j + 2] += bf2f((bf16_t)(t[1] & 0xFFFF)); f[4 * j + 3] += bf2f((bf16_t)(t[1] >> 16)); }
#pragma unroll
  for (int i = 0; i < 16; ++i) xv[i] = ALPHA_ * xv[i] + g2[i] * f[i];
  float mean, rstd;
  row_stats(xv, mean, rstd);
#pragma unroll
  for (int i = 0; i < 16; ++i) xv[i] = (xv[i] - mean) * rstd * w[i] + b[i];
}
DEVFN void phase1(const Params& p, int l) {
  const int lane = TIDX & 63, wave = TIDX >> 6;
  float* X = (float*)(p.ws + Ws::X);
  bf16_t* U = (bf16_t*)(p.ws + Ws::U);
  for (int tok = BIDX * 4 + wave; tok < NT_; tok += gridDim.x * 4) {
    float xv[16], sh[16], sc[16], mean, rstd;
    const float* mod = (const float*)(p.ws + Ws::MOD) + ((size_t)l * NR_ + tok_modrow(tok)) * NMOD_;
    load_row16(mod, lane, sh);
    load_row16(mod + 1024, lane, sc);
    if (l == 0) load_row16(tok_input_row(p, tok), lane, xv);
    else { load_row16(X + (size_t)tok * 1024, lane, xv); moe_residual_row(p, l - 1, tok, lane, xv); }
#pragma unroll
    for (int j = 0; j < 4; ++j) *(float4*)(X + (size_t)tok * 1024 + lane * 4 + 256 * j) = make_float4(xv[4 * j], xv[4 * j + 1], xv[4 * j + 2], xv[4 * j + 3]);
    row_stats(xv, mean, rstd);
#pragma unroll
    for (int j = 0; j < 4; ++j) {
      float u0 = (xv[4 * j] - mean) * rstd * (1.f + sc[4 * j]) + sh[4 * j], u1 = (xv[4 * j + 1] - mean) * rstd * (1.f + sc[4 * j + 1]) + sh[4 * j + 1];
      float u2 = (xv[4 * j + 2] - mean) * rstd * (1.f + sc[4 * j + 2]) + sh[4 * j + 2], u3 = (xv[4 * j + 3] - mean) * rstd * (1.f + sc[4 * j + 3]) + sh[4 * j + 3];
      *(uint2*)(U + (size_t)tok * 1024 + lane * 4 + 256 * j) = make_uint2((unsigned)f2bf(u0) | ((unsigned)f2bf(u1) << 16), (unsigned)f2bf(u2) | ((unsigned)f2bf(u3) << 16));
    }
  }
}
DEVFN void phase_final(const Params& p) {
  const int lane = TIDX & 63, wave = TIDX >> 6;
  const float* X = (const float*)(p.ws + Ws::X);
  for (int r = BIDX * 4 + wave; r < B_ * SEQ_; r += gridDim.x * 4) {
    int b = r / SEQ_, s = r % SEQ_, tok = b * T_ + CTX_ + s;
    float xv[16];
    load_row16(X + (size_t)tok * 1024, lane, xv);
    moe_residual_row(p, DEPTH_ - 1, tok, lane, xv);
#pragma unroll
    for (int j = 0; j < 4; ++j) *(float4*)(p.out + (size_t)r * 1024 + lane * 4 + 256 * j) = make_float4(xv[4 * j], xv[4 * j + 1], xv[4 * j + 2], xv[4 * j + 3]);
  }
}

DEVFN void phase2(const Params& p, int l, unsigned char* smem) {
  const bf16_t* U = (const bf16_t*)(p.ws + Ws::U);
  const bf16_t* W = (const bf16_t*)(p.ws + Ws::WIN) + (size_t)l * NIN_ * 1024;
  bf16_t* ZX = (bf16_t*)(p.ws + Ws::ZX);
  const int nct = (NIN_ + 255) / 256;
  for (int u = BIDX; u < (NT_ / 128) * nct; u += gridDim.x) {
    int rt = u / nct, ct = u % nct;
    gemm_tile_w<1, 1024>(smem, 1024,
      [&](int r) { return U + (size_t)(rt * 128 + r) * 1024; },
      [&](int) { return W + (size_t)(ct * 256) * 1024; },
      [&](f32x4 (&acc)[4][8], int, int wr, int wc, int g, int l15) {
#pragma unroll 1
        for (int h = 0; h < 2; ++h)
          tile_store_bf16<16>(smem, wr, g, l15,
            [&](bf16_t* T, int ldc) {
              if (wc == h) {
#pragma unroll
                for (int mi = 0; mi < 4; ++mi)
#pragma unroll
                  for (int ni = 0; ni < 8; ++ni)
#pragma unroll
                    for (int i = 0; i < 4; ++i) T[(wr * 64 + mi * 16 + 4 * g + i) * ldc + ni * 16 + l15] = f2bf(acc[mi][ni][i]); } },
            [&](int row, int c0) { const int col = ct * 256 + h * 128 + c0; return col < NIN_ ? ZX + (size_t)(rt * 128 + row) * NIN_ + col : (bf16_t*)nullptr; });
      });
  }
}

DEVFN float zxv(const bf16_t* ZX, int tok, int col) { return bf2f(gptr(ZX)[(size_t)tok * NIN_ + col]); }
struct Nbr { int n; int tok[4]; };
DEVFN Nbr shift_nbrs(int tok) {
  Nbr nb; int b = tok / T_, t = tok % T_;
  if (t < CTX_) { nb.n = 2; nb.tok[0] = t > 0 ? tok - 1 : -1; nb.tok[1] = t < CTX_ - 1 ? tok + 1 : -1; nb.tok[2] = -1; nb.tok[3] = -1; }
  else { int s = t - CTX_, row = s / 64, col = s % 64; nb.n = 4; nb.tok[0] = col > 0 ? tok - 1 : -1; nb.tok[1] = col < 63 ? tok + 1 : -1;
    nb.tok[2] = row > 0 ? tok - 64 : -1; nb.tok[3] = row < SEQ_ / 64 - 1 ? tok + 64 : -1; }
  (void)b; return nb;
}
DEVFN float shiftmix(const bf16_t* ZX, const float* mu, int tok, const Nbr& nb, int ch) {
  float z = zxv(ZX, tok, ORW + ch), o = z;
#pragma unroll
  for (int j = 0; j < 4; ++j) if (j < nb.n) { float v = nb.tok[j] >= 0 ? zxv(ZX, nb.tok[j], ORW + ch) : 0.f; o += mu[j * 1152 + ch] * (v - z); }
  return o;
}
#define LI_LD 392
#define KL_LD 264
DEVFN void phase3(const Params& p, int l, unsigned char* smem) {
  const int tid = TIDX, lane = tid & 63, wave = tid >> 6, q = lane >> 4, l15 = lane & 15;
  const bf16_t* ZX = (const bf16_t*)(p.ws + Ws::ZX);
  bf16_t* XBC = (bf16_t*)(p.ws + Ws::XBC); float* DTB = (float*)(p.ws + Ws::DTB);
  bf16_t* RR = (bf16_t*)(p.ws + Ws::RR); bf16_t* VV = (bf16_t*)(p.ws + Ws::VV); bf16_t* KKb = (bf16_t*)(p.ws + Ws::KK);
  bf16_t* KRW = (bf16_t*)(p.ws + Ws::KRW); bf16_t* LIg = (bf16_t*)(p.ws + Ws::LI);
  float* LA = (float*)(p.ws + Ws::LA);
  const float* convw = INP(I_CONVW) + (size_t)l * 3 * 1024; const float* convb = INP(I_CONVB) + (size_t)l * 1024;
  const float* mu = INP(I_MU) + (size_t)l * 4 * 1152;
  float* gdl = (float*)smem;
  const float kkw = INP(I_KKW)[(size_t)l * 256 + tid];
  for (int wu = BIDX; wu < 2 * (NT_ / 16); wu += gridDim.x) {
    const int tile = wu >> 1, part = wu & 1;
    const int tok0 = tile * 16, t0 = tok0 % T_, bb = tok0 / T_;
    const bool isctx = t0 < CTX_;
    const int s0 = t0 - CTX_;
    const bool lval = isctx ? (t0 > 0) : ((s0 & 63) != 0), rval = isctx ? (t0 + 16 < CTX_) : ((s0 & 63) != 48);
    const bool uval = !isctx && (s0 >= 64), dval = !isctx && (s0 + 64 < SEQ_);
    if (part == 0) {
    __syncthreads();
    {
      const bool segstart = (t0 == 0 || t0 == CTX_), segend = (t0 + 16 == CTX_ || t0 + 16 == T_);
      bf16_t* XBCT = (bf16_t*)(p.ws + Ws::XBCT) + ((size_t)(bb * NC128 + t0 / 128) * 768) * 128 + (t0 % 128);
#pragma unroll 1
      for (int j = 0; j < 4; ++j) { const int c = tid + 256 * j;
        const AS1 bf16_t* zp = gptr(ZX) + (size_t)tok0 * NIN_ + OXBC + c - NIN_; AS1 bf16_t* xp = gptr(XBC) + (size_t)tok0 * 1024 + c;
        float z[18];
#pragma unroll
        for (int i = 0; i < 18; ++i) { z[i] = ((i == 0 && segstart) || (i == 17 && segend)) ? 0.f : bf2f(*zp); zp += NIN_; LAUNDER_V(zp); }
        const float w0 = convw[c], w1 = convw[1024 + c], w2 = convw[2048 + c], cb = convb[c];
        bf16_t y[16];
#pragma unroll
        for (int i = 0; i < 16; ++i) { y[i] = f2bf(siluf_(cb + w0 * z[i] + w1 * z[i + 1] + w2 * z[i + 2])); *xp = y[i]; xp += 1024; LAUNDER_V(xp); }
        if (c < 768) {
          u32x4 o0, o1;
#pragma unroll
          for (int i = 0; i < 4; ++i) { o0[i] = (unsigned)y[2 * i] | ((unsigned)y[2 * i + 1] << 16); o1[i] = (unsigned)y[8 + 2 * i] | ((unsigned)y[9 + 2 * i] << 16); }
          *(u32x4*)(XBCT + (size_t)c * 128) = o0; *(u32x4*)(XBCT + (size_t)c * 128 + 8) = o1; } }
      { bf16_t* VTp = (bf16_t*)(p.ws + Ws::VT) + ((size_t)(bb * NC64 + t0 / 64) * 256 + tid) * 64 + (t0 % 64);
        const AS1 bf16_t* vp = gptr(ZX) + (size_t)tok0 * NIN_ + OGV + tid;
        u32x4 o0, o1;
        bf16_t vv16[16];
#pragma unroll
        for (int i = 0; i < 16; ++i) { vv16[i] = *vp; vp += NIN_; LAUNDER_V(vp); }
#pragma unroll
        for (int i = 0; i < 4; ++i) { o0[i] = (unsigned)vv16[2 * i] | ((unsigned)vv16[2 * i + 1] << 16); o1[i] = (unsigned)vv16[8 + 2 * i] | ((unsigned)vv16[9 + 2 * i] << 16); }
        *(u32x4*)VTp = o0; *(u32x4*)(VTp + 8) = o1; }
      DTB[(size_t)tok0 * 16 + tid] = softplusf_(zxv(ZX, tok0 + (tid >> 4), ODT + (tid & 15)) + INP(I_DTBIAS)[(size_t)l * 16 + (tid & 15)]);
      gdl[tid] = zxv(ZX, tok0 + (tid >> 5), OGD + (tid & 31)); gdl[256 + tid] = zxv(ZX, tok0 + 8 + (tid >> 5), OGD + (tid & 31));
    }
    } else {
#pragma unroll 1
    for (int g = 0; g < 5; ++g) {
      const bool act = !(g == 4 && tid >= 128);
      const int ch = act ? g * 256 + tid : 0;
      const AS1 bf16_t* zp0 = gptr(ZX) + (size_t)tok0 * NIN_ + ORW + ch;
      const AS1 bf16_t* zp = zp0 - NIN_;
      const float m0 = mu[ch], m1 = mu[1152 + ch], m2 = mu[2304 + ch], m3 = mu[3456 + ch];
      float z[18], zu[16], zd[16], o[16];
      const AS1 bf16_t* up = uval ? zp0 - (size_t)64 * NIN_ : zp0; const AS1 bf16_t* dn = dval ? zp0 + (size_t)64 * NIN_ : zp0;
      const float um = uval ? 1.f : 0.f, dm = dval ? 1.f : 0.f, m2v = isctx ? 0.f : m2, m3v = isctx ? 0.f : m3;
#pragma unroll
      for (int i = 0; i < 18; ++i) { z[i] = ((i == 0 && !lval) || (i == 17 && !rval)) ? 0.f : bf2f(*zp); zp += NIN_; LAUNDER_V(zp); }
#pragma unroll
      for (int i = 0; i < 16; ++i) { zu[i] = bf2f(*up); zd[i] = bf2f(*dn); up += NIN_; dn += NIN_; LAUNDER_V(up); LAUNDER_V(dn); }
#pragma unroll
      for (int i = 0; i < 16; ++i) o[i] = z[i + 1] + m0 * (z[i] - z[i + 1]) + m1 * (z[i + 2] - z[i + 1]) + m2v * (zu[i] * um - z[i + 1]) + m3v * (zd[i] * dm - z[i + 1]);
      if (g == 0) { AS1 bf16_t* rp = gptr(RR) + (size_t)tok0 * 256 + tid;
#pragma unroll
        for (int i = 0; i < 16; ++i) { *rp = f2bf(o[i]); rp += 256; LAUNDER_V(rp); }
      } else if (g == 1) { AS1 bf16_t* kp = gptr(KKb) + (size_t)tok0 * 256 + tid; AS1 bf16_t* krp = gptr(KRW) + (size_t)tok0 * 256 + tid;
#pragma unroll
        for (int i = 0; i < 16; ++i) { const float kq = o[i] * kkw, nrm = sqrtf(wave_sum(kq * kq));
          *kp = f2bf(kq / fmaxf(nrm, 1e-12f)); *krp = f2bf(o[i]); kp += 256; krp += 256; LAUNDER_V(kp); LAUNDER_V(krp); }
      } else if (g == 2) { AS1 bf16_t* vp2 = gptr(VV) + (size_t)tok0 * 256 + tid;
#pragma unroll
        for (int i = 0; i < 16; ++i) { *vp2 = f2bf(o[i]); vp2 += 256; LAUNDER_V(vp2); }
      } else if (g == 3) { AS1 bf16_t* lp = gptr(LIg) + (size_t)tok0 * 384 + tid;
#pragma unroll
        for (int i = 0; i < 16; ++i) { *lp = f2bf(tid < 128 ? tanhf(o[i]) : o[i]); lp += 384; LAUNDER_V(lp); }
      } else if (act) { AS1 bf16_t* lp = gptr(LIg) + (size_t)tok0 * 384 + 256 + tid;
#pragma unroll
        for (int i = 0; i < 16; ++i) { *lp = f2bf(sigmoidf_(o[i])); lp += 384; LAUNDER_V(lp); }
      }
    }
    }
    if (part == 0) {
    __syncthreads();
    { const int d = tid >> 7, c = tid & 127; const float* gu = INP(I_GU) + ((size_t)l * 2 + d) * 16 * 128; const float gb = INP(I_GB)[((size_t)l * 2 + d) * 128 + c];
      float guw[16];
#pragma unroll
      for (int i = 0; i < 16; ++i) guw[i] = gu[i * 128 + c];
#pragma unroll 4
      for (int tt = 0; tt < 16; ++tt) { float sacc = gb;
#pragma unroll
        for (int i = 0; i < 16; ++i) sacc += gdl[tt * 32 + d * 16 + i] * guw[i];
        LA[((size_t)d * NT_ + tok0 + tt) * 128 + c] = logsigmoidf_(sacc) * (1.f / 16.f); } }
    }
  }
}

DEVFN void phase3b(const Params& p, int l, unsigned char* smem) {
  const bf16_t* LIg = (const bf16_t*)(p.ws + Ws::LI);
  const bf16_t* lora = (const bf16_t*)(p.ws + Ws::LORA) + (size_t)l * 98304;
  const bf16_t* KRg = (const bf16_t*)(p.ws + Ws::KRW); const bf16_t* KKg = (const bf16_t*)(p.ws + Ws::KK);
  float* LWp = (float*)(p.ws + Ws::LW); bf16_t* KD = (bf16_t*)(p.ws + Ws::KD); bf16_t* BD = (bf16_t*)(p.ws + Ws::BD); float* GATE = (float*)(p.ws + Ws::GATE);
  for (int u = BIDX; u < (NT_ / 128) * 10; u += gridDim.x) {
    const int rt = u / 10, which = (u % 10) >> 1, ct = u & 1;
    const int K = which < 4 ? 64 : 128, acol = which < 4 ? which * 64 : 256;
    const bf16_t* wb = which < 2 ? lora + (size_t)which * 16384 : which < 4 ? lora + 32768 + (size_t)(which - 2) * 16384 : lora + 65536;
    const float* bias = which < 2 ? INP(I_W0) + (size_t)l * 512 + which * 256 : INP(I_A0) + (size_t)l * 512 + (which & 1) * 256;
    const float* kav = INP(I_KAW) + (size_t)l * 256;
    gemm_tile(smem, K,
      [&](int r) { return LIg + (size_t)(rt * 128 + r) * 384 + acol; },
      [&](int r) { return wb + (size_t)(ct * 128 + r) * K; },
      [&](f32x4 (&acc)[4][4], int wr, int wc, int g, int l15) {
        const int tid = TIDX;
        if (which == 2 || which == 3) {
          bf16_t* T = (bf16_t*)smem; constexpr int LDC = 136;
          __syncthreads();
#pragma unroll
          for (int ni = 0; ni < 4; ++ni) { const int cl = wc * 64 + ni * 16 + l15; const float bv = bias[ct * 128 + cl];
#pragma unroll
            for (int mi = 0; mi < 4; ++mi)
#pragma unroll
              for (int i = 0; i < 4; ++i) T[(wr * 64 + mi * 16 + 4 * g + i) * LDC + cl] = f2bf(sigmoidf_(acc[mi][ni][i] + bv)); }
          __syncthreads();
          const int c = tid & 15, col0 = ct * 128 + c * 8;
          float ka[8];
#pragma unroll
          for (int j = 0; j < 8; ++j) ka[j] = kav[col0 + j];
          const size_t dofs = (size_t)(which - 2) * NT_ * 256;
#pragma unroll
          for (int pass = 0; pass < 8; ++pass) { const int row = (tid >> 4) + 16 * pass; const size_t o = (size_t)(rt * 128 + row) * 256 + col0;
            const bf16x8 a8 = *(const bf16x8*)(T + row * LDC + c * 8), kr8 = ld8g(KRg + o), kk8 = ld8g(KKg + o);
            bf16x8 kd8, bd8;
#pragma unroll
            for (int j = 0; j < 8; ++j) { const float a = bf2f((bf16_t)a8[j]); kd8[j] = (short)f2bf(bf2f((bf16_t)kr8[j]) * (1.f + (a - 1.f) * ka[j])); bd8[j] = (short)f2bf(bf2f((bf16_t)kk8[j]) * a); }
            *(AS1 bf16x8*)gptr(KD + dofs + o) = kd8; *(AS1 bf16x8*)gptr(BD + dofs + o) = bd8; }
        } else {
          float* T = (float*)smem; constexpr int LDC = 132;
          float* dst = which < 2 ? LWp + (size_t)which * NT_ * 256 : GATE;
#pragma unroll 1
          for (int h = 0; h < 2; ++h) {
            __syncthreads();
            if (wr == h) {
#pragma unroll
              for (int ni = 0; ni < 4; ++ni) { const int cl = wc * 64 + ni * 16 + l15; const float bv = which < 2 ? bias[ct * 128 + cl] : 0.f;
#pragma unroll
                for (int mi = 0; mi < 4; ++mi)
#pragma unroll
                  for (int i = 0; i < 4; ++i) { const float v = acc[mi][ni][i]; T[(mi * 16 + 4 * g + i) * LDC + cl] = which < 2 ? -0.6065306597126334f * sigmoidf_(v + bv) : v; } } }
            __syncthreads();
#pragma unroll
            for (int pass = 0; pass < 8; ++pass) { const int id = tid + 256 * pass, row = id >> 5, c = id & 31;
              *(AS1 f32x4*)gptr(dst + (size_t)(rt * 128 + h * 64 + row) * 256 + ct * 128 + c * 4) = *(const f32x4*)(T + row * LDC + c * 4); } }
        }
      });
  }
}

DEVFN bf16x8 ld8(const bf16_t* p) { return *(const bf16x8*)p; }
typedef short bf16x4v __attribute__((ext_vector_type(4)));
DEVFN bf16x4v cvt4(f32x4 v) { return bf16x4v{(short)f2bf(v[0]), (short)f2bf(v[1]), (short)f2bf(v[2]), (short)f2bf(v[3])}; }
DEVFN bf16x8 cat44(bf16x4v a, bf16x4v b) { return bf16x8{a[0], a[1], a[2], a[3], b[0], b[1], b[2], b[3]}; }
DEVFN bf16x4v ld4(const bf16_t* p) { return *(const bf16x4v*)p; }
DEVFN int rm_off(int i, int k) { return i * 64 + ((((k >> 3) ^ (i & 7)) << 3) | (k & 7)); }
#define RW_WAVE_LDS 11264
DEVFN void rwkv_chunk(const Params& p, int unit_base, unsigned char* smem) {
  const int tid = TIDX, lane = tid & 63, wave = tid >> 6, q = lane >> 4, l15 = lane & 15;
  const int unit = unit_base + wave;
  const int c = unit % NC16, h = (unit / NC16) & 3, dir = (unit / (NC16 * 4)) & 1, b = unit / (NC16 * 8);
  bf16_t* big = (bf16_t*)(smem + wave * RW_WAVE_LDS);
  unsigned char* small = smem + wave * RW_WAVE_LDS + 8192;
  float* AbF = (float*)small;
  bf16_t* TN = (bf16_t*)(small + 1024);
  bf16_t* AK = TN + 256; bf16_t* RB = AK + 256; bf16_t* RK = RB + 256;
  const bf16_t* RRg = (const bf16_t*)(p.ws + Ws::RR); const bf16_t* VVg = (const bf16_t*)(p.ws + Ws::VV); const bf16_t* KKg = (const bf16_t*)(p.ws + Ws::KK);
  const bf16_t* KDg = (const bf16_t*)(p.ws + Ws::KD) + (size_t)dir * NT_ * 256; const bf16_t* BDg = (const bf16_t*)(p.ws + Ws::BD) + (size_t)dir * NT_ * 256;
  const float* LWg = (const float*)(p.ws + Ws::LW) + (size_t)dir * NT_ * 256;
  float kkm[16], vv[16], bneg[16], kneg[16];
  float run = 0.f;
  __syncthreads();
#pragma unroll
  for (int i = 0; i < 16; ++i) {
    const size_t o = (size_t)(b * T_ + tokmap(dir, c * 16 + i)) * 256 + h * 64 + lane;
    const float lw = gptr(LWg)[o], r = bf2f(gptr(RRg)[o]), k = bf2f(gptr(KDg)[o]), v = bf2f(gptr(VVg)[o]), kk = bf2f(gptr(KKg)[o]), bb = bf2f(gptr(BDg)[o]);
    const float e_ex = expf(run); run += lw; const float e_in = expf(run), e_neg = expf(-run);
    kkm[i] = kk * e_ex; vv[i] = v; bneg[i] = bb * e_neg; kneg[i] = k * e_neg;
    big[rm_off(i, lane)] = f2bf(kkm[i]); big[1024 + rm_off(i, lane)] = f2bf(r * e_in);
    big[2048 + rm_off(i, lane)] = f2bf(bneg[i]); big[3072 + rm_off(i, lane)] = f2bf(kneg[i]);
  }
  const float WC = expf(run);
  __syncthreads();
  f32x4 ab = f32x4{0.f, 0.f, 0.f, 0.f}, ak = ab, rb = ab, rk = ab;
#pragma unroll
  for (int s2 = 0; s2 < 2; ++s2) { const int ch = ((4 * s2 + q) ^ (l15 & 7)) << 3;
    const bf16x8 a_kk = ld8(big + l15 * 64 + ch), a_r = ld8(big + 1024 + l15 * 64 + ch), b_b = ld8(big + 2048 + l15 * 64 + ch), b_k = ld8(big + 3072 + l15 * 64 + ch);
    ab = MFMA16(a_kk, b_b, ab); ak = MFMA16(a_kk, b_k, ak); rb = MFMA16(a_r, b_b, rb); rk = MFMA16(a_r, b_k, rk); }
  f32x4 gacc[4];
#pragma unroll
  for (int nk = 0; nk < 4; ++nk)
#pragma unroll
    for (int r = 0; r < 4; ++r) gacc[nk][r] = bf2f(big[1024 + rm_off(4 * q + r, 16 * nk + l15)]);
  __syncthreads();
#pragma unroll
  for (int r = 0; r < 4; ++r) { const int i = 4 * q + r, j = l15;
    AbF[i * 16 + j] = j < i ? ab[r] : 0.f; AK[i * 16 + j] = f2bf(j < i ? ak[r] : 0.f);
    RB[i * 16 + j] = f2bf(j <= i ? rb[r] : 0.f); RK[i * 16 + j] = f2bf(j <= i ? rk[r] : 0.f); }
  { bf16_t* KKMT = big; bf16_t* VTT = big + 1024; bf16_t* BHT = big + 2048; bf16_t* KHT = big + 3072;
#pragma unroll
    for (int i = 0; i < 16; ++i) { KKMT[lane * 16 + i] = f2bf(kkm[i]); VTT[lane * 16 + i] = f2bf(vv[i]); BHT[lane * 16 + i] = f2bf(bneg[i] * WC); KHT[lane * 16 + i] = f2bf(kneg[i] * WC); } }
  __syncthreads();
  { float t[16];
#pragma unroll
    for (int i = 0; i < 16; ++i) { float acc = (i == l15) ? 1.f : 0.f;
#pragma unroll
      for (int j = 0; j < i; ++j) acc -= AbF[i * 16 + j] * t[j];
      t[i] = acc; }
    if (q == 0) {
#pragma unroll
      for (int i = 0; i < 16; ++i) TN[i * 16 + l15] = f2bf(-t[i]); } }
  __syncthreads();
  const size_t ci = (size_t)((b * 2 + dir) * 4 + h) * NC16 + c;
  bf16_t* MLg = (bf16_t*)(p.ws + Ws::RML) + ci * 4096; bf16_t* Ng = (bf16_t*)(p.ws + Ws::RNS) + ci * 4096;
  bf16_t* Gg = (bf16_t*)(p.ws + Ws::RG) + ci * 1024; float* Y0g = (float*)(p.ws + Ws::RY0) + ci * 1024;
  const bf16x4v a_T = ld4(TN + l15 * 16 + 4 * q), a_Ak = ld4(AK + l15 * 16 + 4 * q), a_Rb = ld4(RB + l15 * 16 + 4 * q), a_Rk = ld4(RK + l15 * 16 + 4 * q);
  const f32x4 z4 = f32x4{0.f, 0.f, 0.f, 0.f};
  bf16x4v vfr[4], qfr[4], pfr[4];
#pragma unroll
  for (int n = 0; n < 4; ++n) {
    vfr[n] = ld4(big + 1024 + (16 * n + l15) * 16 + 4 * q);
    const f32x4 akv = MFMA16K16(a_Ak, vfr[n], z4);
    qfr[n] = cvt4(MFMA16K16(a_T, cvt4(akv), z4));
    pfr[n] = cvt4(MFMA16K16(a_T, ld4(big + (16 * n + l15) * 16 + 4 * q), z4)); }
  const bf16x8 a_RbRk = cat44(a_Rb, a_Rk);
#pragma unroll
  for (int n = 0; n < 4; ++n) {
    const f32x4 g = MFMA16K16(a_Rb, pfr[n], gacc[n]);
    const f32x4 y0 = MFMA16(a_RbRk, cat44(qfr[n], vfr[n]), z4);
#pragma unroll
    for (int r = 0; r < 4; ++r) { Gg[(4 * q + r) * 64 + 16 * n + l15] = f2bf(g[r]); Y0g[(4 * q + r) * 64 + 16 * n + l15] = y0[r]; } }
#pragma unroll
  for (int n = 0; n < 4; ++n)
#pragma unroll
    for (int r = 0; r < 4; ++r) MLg[((n >> 1) * 64 + (l15 >> 2) * 16 + 4 * q + r) * 8 + (n & 1) * 4 + (l15 & 3)] = (bf16_t)pfr[n][r];
#pragma unroll
  for (int mk = 0; mk < 4; ++mk) {
    const bf16x4v a_B = ld4(big + 2048 + (16 * mk + l15) * 16 + 4 * q), a_K = ld4(big + 3072 + (16 * mk + l15) * 16 + 4 * q);
    const bf16x8 a_BK = cat44(a_B, a_K);
    *(bf16x4v*)(MLg + 1024 + ((mk >> 1) * 64 + lane) * 8 + (mk & 1) * 4) = a_B;
#pragma unroll
    for (int n = 0; n < 4; ++n) {
      const f32x4 nn = MFMA16(a_BK, cat44(qfr[n], vfr[n]), z4);
      *(bf16x4v*)(Ng + (n * 64 + lane) * 16 + mk * 4) = cvt4(nn); } }
  ((float*)(p.ws + Ws::RWC))[ci * 64 + ((lane >> 2) & 3) * 16 + (lane >> 4) * 4 + (lane & 3)] = WC;
}
struct RwStep { bf16x8 pf[2]; bf16x8 bh[2]; bf16x8 n[2]; float wc; };
DEVFN void rw_load(RwStep& t, const bf16_t* MLg, const bf16_t* NSg, const float* WCg, int c, int lane, int q) {
#pragma unroll
  for (int s2 = 0; s2 < 2; ++s2) { t.pf[s2] = ld8g(MLg + (size_t)c * 4096 + (s2 * 64 + lane) * 8); t.bh[s2] = ld8g(MLg + (size_t)c * 4096 + 1024 + (s2 * 64 + lane) * 8); }
  t.wc = gptr(WCg)[(size_t)c * 64 + lane];
  t.n[0] = ld8g(NSg + (size_t)c * 4096 + lane * 16); t.n[1] = ld8g(NSg + (size_t)c * 4096 + lane * 16 + 8);
  (void)q;
}
DEVFN void rw_step(const RwStep& t, f32x4 (&S)[4], bf16_t* NSg, int c, int q, int l15) {
  bf16x4v sb[4];
#pragma unroll
  for (int mk = 0; mk < 4; ++mk) sb[mk] = cvt4(S[mk]);
  const bf16x8 bf0 = cat44(sb[0], sb[1]), bf1 = cat44(sb[2], sb[3]);
  f32x4 w = MFMA16(t.pf[0], bf0, (f32x4{0.f, 0.f, 0.f, 0.f}));
  w = MFMA16(t.pf[1], bf1, w);
  const bf16x4v wb = cvt4(w);
#pragma unroll
  for (int mk = 0; mk < 4; ++mk) {
    f32x4 acc;
#pragma unroll
    for (int r = 0; r < 4; ++r) acc[r] = bf2f((bf16_t)t.n[mk >> 1][(mk & 1) * 4 + r]) + __shfl(t.wc, q * 16 + mk * 4 + r) * S[mk][r];
    const bf16x8 b2 = t.bh[mk >> 1];
    const bf16x4v a_B = (mk & 1) ? bf16x4v{b2[4], b2[5], b2[6], b2[7]} : bf16x4v{b2[0], b2[1], b2[2], b2[3]};
    S[mk] = MFMA16K16(a_B, wb, acc); }
#pragma unroll
  for (int mk = 0; mk < 4; ++mk) *(AS1 bf16x4v*)gptr(NSg + (size_t)c * 4096 + l15 * 64 + 16 * mk + 4 * q) = sb[mk];
}
DEVFN void rwkv_scan(const Params& p, int chain, int wave) {
  const int tid = TIDX, lane = tid & 63, q = lane >> 4, l15 = lane & 15;
  const bf16_t* MLg = (const bf16_t*)(p.ws + Ws::RML) + (size_t)chain * NC16 * 4096;
  bf16_t* NSg = (bf16_t*)(p.ws + Ws::RNS) + (size_t)chain * NC16 * 4096 + wave * 1024;
  const float* WCg = (const float*)(p.ws + Ws::RWC) + (size_t)chain * NC16 * 64;
  f32x4 S[4];
#pragma unroll
  for (int mk = 0; mk < 4; ++mk) S[mk] = f32x4{0.f, 0.f, 0.f, 0.f};
  RwStep t0, t1, t2, t3;
#define RWC_(x) ((x) < NC16 ? (x) : NC16 - 1)
  rw_load(t0, MLg, NSg, WCg, 0, lane, q);
  rw_load(t1, MLg, NSg, WCg, RWC_(1), lane, q);
  rw_load(t2, MLg, NSg, WCg, RWC_(2), lane, q);
  int c = 0;
  for (; c + 3 < NC16; c += 4) {
    rw_load(t3, MLg, NSg, WCg, c + 3, lane, q);
    rw_step(t0, S, NSg, c, q, l15);
    rw_load(t0, MLg, NSg, WCg, RWC_(c + 4), lane, q);
    rw_step(t1, S, NSg, c + 1, q, l15);
    rw_load(t1, MLg, NSg, WCg, RWC_(c + 5), lane, q);
    rw_step(t2, S, NSg, c + 2, q, l15);
    rw_load(t2, MLg, NSg, WCg, RWC_(c + 6), lane, q);
    rw_step(t3, S, NSg, c + 3, q, l15);
  }
  if (c < NC16) { rw_step(t0, S, NSg, c, q, l15); if (c + 1 < NC16) { rw_step(t1, S, NSg, c + 1, q, l15); if (c + 2 < NC16) rw_step(t2, S, NSg, c + 2, q, l15); } }
#undef RWC_
}
DEVFN void rwkv_out(const Params& p, int unit_base) {
  const int tid = TIDX, lane = tid & 63, wave = tid >> 6, q = lane >> 4, l15 = lane & 15;
  const int unit = unit_base + wave;
  const int c = unit % NC16, h = (unit / NC16) & 3, dir = (unit / (NC16 * 4)) & 1, b = unit / (NC16 * 8);
  const size_t ci = (size_t)((b * 2 + dir) * 4 + h) * NC16 + c;
  const bf16_t* Sg = (const bf16_t*)(p.ws + Ws::RNS) + ci * 4096; const bf16_t* Gg = (const bf16_t*)(p.ws + Ws::RG) + ci * 1024;
  const float* Y0g = (const float*)(p.ws + Ws::RY0) + ci * 1024;
  float* YR = (float*)(p.ws + Ws::YR) + (size_t)dir * NT_ * 256;
  const bf16x8 a0 = ld8g(Gg + l15 * 64 + 8 * q), a1 = ld8g(Gg + l15 * 64 + 32 + 8 * q);
#pragma unroll
  for (int n = 0; n < 4; ++n) {
    f32x4 acc;
#pragma unroll
    for (int r = 0; r < 4; ++r) acc[r] = gptr(Y0g)[(4 * q + r) * 64 + 16 * n + l15];
    acc = MFMA16(a0, ld8g(Sg + n * 1024 + l15 * 64 + 8 * q), acc);
    acc = MFMA16(a1, ld8g(Sg + n * 1024 + l15 * 64 + 32 + 8 * q), acc);
#pragma unroll
    for (int r = 0; r < 4; ++r) YR[(size_t)(b * T_ + tokmap(dir, c * 16 + 4 * q + r)) * 256 + h * 64 + 16 * n + l15] = acc[r]; }
}
DEVFN int cscan(int dir, int co, int nctx, int nc) { return dir == 0 ? co : (co < nctx ? nctx - 1 - co : 2 * nctx + nc - 1 - co); }
DEVFN bf16x8 ld4x2g(const bf16_t* p0, const bf16_t* p1) { bf16x4v a = *(const AS1 bf16x4v*)gptr(p0), b = *(const AS1 bf16x4v*)gptr(p1); return bf16x8{a[0], a[1], a[2], a[3], b[0], b[1], b[2], b[3]}; }
DEVFN bf16x8 ld4x2(const bf16_t* p0, const bf16_t* p1) { bf16x4v a = *(const bf16x4v*)p0, b = *(const bf16x4v*)p1; return bf16x8{a[0], a[1], a[2], a[3], b[0], b[1], b[2], b[3]}; }

DEVFN void ssd_chunk_scalars(const Params& p, int l, int b, int co, int h, float* f) {
  const int tid = TIDX, d = tid >> 7, j = tid & 127;
  const float* DTB = (const float*)(p.ws + Ws::DTB);
  const float nega = -expf(INP(I_ALOG)[(size_t)l * 16 + d * 8 + h]);
  const float dt = DTB[(size_t)(b * T_ + co * 128 + j) * 16 + d * 8 + h];
  __syncthreads();
  f[256 + d * 128 + j] = dt;
  float* cur = f + d * 128; float* tmp = f + 512 + d * 128;
  cur[j] = dt * nega;
  __syncthreads();
  for (int off = 1; off < 128; off <<= 1) {
    float v = cur[j] + (j >= off ? cur[j - off] : 0.f);
    tmp[j] = v;
    __syncthreads();
    cur[j] = tmp[j];
    __syncthreads();
  }
}
DEVFN void ssd_states(const Params& p, int l, int unit, unsigned char* smem) {
  const int tid = TIDX, lane = tid & 63, wave = tid >> 6, q = lane >> 4, l15 = lane & 15;
  const int h = unit & 7, co = (unit >> 3) % NC128, b = unit / (8 * NC128), grp = h >> 2;
  float* f = (float*)smem;
  ssd_chunk_scalars(p, l, b, co, h, f);
  { const int d = tid >> 7, j = tid & 127; const float* cum = f + d * 128; const float dt = f[256 + d * 128 + j];
    float w = d == 0 ? expf(cum[127] - cum[j]) * dt : expf(j > 0 ? cum[j - 1] : 0.f) * dt;
    f[512 + d * 128 + j] = w; }
  __syncthreads();
  const bf16_t* XT = (const bf16_t*)(p.ws + Ws::XBCT) + (size_t)(b * NC128 + co) * 768 * 128;
  f32x4 acc[2][8];
#pragma unroll
  for (int d = 0; d < 2; ++d)
#pragma unroll
    for (int n = 0; n < 8; ++n) acc[d][n] = f32x4{0.f, 0.f, 0.f, 0.f};
#pragma unroll 1
  for (int s4 = 0; s4 < 4; ++s4) {
    const int j0 = s4 * 32 + q * 8;
    bf16x8 xa = ld8g(XT + (size_t)(h * 64 + wave * 16 + l15) * 128 + j0), a0, a1;
#pragma unroll
    for (int jj = 0; jj < 8; ++jj) { float x = bf2f((bf16_t)xa[jj]); a0[jj] = (short)f2bf(x * f[512 + j0 + jj]); a1[jj] = (short)f2bf(x * f[640 + j0 + jj]); }
#pragma unroll
    for (int n = 0; n < 8; ++n) { bf16x8 bb = ld8g(XT + (size_t)(512 + grp * 128 + n * 16 + l15) * 128 + j0);
      acc[0][n] = MFMA16(a0, bb, acc[0][n]); acc[1][n] = MFMA16(a1, bb, acc[1][n]); }
  }
#pragma unroll
  for (int d = 0; d < 2; ++d) {
    const int cs = cscan(d, co, CTX_ / 128, SEQ_ / 128);
    float* ST = (float*)(p.ws + Ws::SST) + ((size_t)((d * B_ + b) * NC128 + cs) * 8 + h) * 8192;
#pragma unroll
    for (int n = 0; n < 8; ++n)
#pragma unroll
      for (int r = 0; r < 4; ++r) ST[(wave * 16 + q * 4 + r) * 128 + n * 16 + l15] = acc[d][n][r];
    if (tid == 0) ((float*)(p.ws + Ws::SCD))[((size_t)(d * B_ + b) * NC128 + cs) * 8 + h] = expf(f[d * 128 + 127]);
  }
}
#define SSD_SB ((NC128 % 17) == 0 ? 17 : NC128)
DEVFN void ssd_scan(const Params& p, int gtid, int gthreads) {
  const float* __restrict__ ST = (const float*)(p.ws + Ws::SST); const float* __restrict__ CD = (const float*)(p.ws + Ws::SCD); bf16_t* __restrict__ HIN = (bf16_t*)(p.ws + Ws::HIN);
  for (int e = gtid; e < 2 * B_ * 8 * 8192; e += gthreads) {
    const int pd = e & 8191, h = (e >> 13) & 7, db = e >> 16;
    float hv = 0.f;
#pragma unroll 1
    for (int c0 = 0; c0 < NC128; c0 += SSD_SB) {
      float st[SSD_SB], cd[SSD_SB];
#pragma unroll
      for (int i = 0; i < SSD_SB; ++i) { st[i] = ST[((size_t)(db * NC128 + c0 + i) * 8 + h) * 8192 + pd]; cd[i] = CD[(size_t)(db * NC128 + c0 + i) * 8 + h]; }
#pragma unroll
      for (int i = 0; i < SSD_SB; ++i) { HIN[((size_t)(db * NC128 + c0 + i) * 8 + h) * 8192 + pd] = f2bf(hv); hv = hv * cd[i] + st[i]; }
    }
  }
}
DEVFN void ssd_out(const Params& p, int l, int unit, unsigned char* smem) {
  const int tid = TIDX, lane = tid & 63, wave = tid >> 6, q = lane >> 4, l15 = lane & 15;
  const int h = unit & 7, co = (unit >> 3) % NC128, b = unit / (8 * NC128), grp = h >> 2;
  float* f = (float*)smem;
  ssd_chunk_scalars(p, l, b, co, h, f);
  if (tid < 128) f[640 + tid] = f[128 + 127] - (tid > 0 ? f[128 + tid - 1] : 0.f);
  __syncthreads();
  const float* cum0 = f; const float* suf1 = f + 640; const float* dt0 = f + 256; const float* dt1 = f + 384;
  const bf16_t* XBC = (const bf16_t*)(p.ws + Ws::XBC) + (size_t)(b * T_ + co * 128) * 1024;
  const bf16_t* XT = (const bf16_t*)(p.ws + Ws::XBCT) + (size_t)(b * NC128 + co) * 768 * 128;
  const bf16_t* Cb = XBC + (size_t)(wave * 32 + l15) * 1024 + 768 + grp * 128 + q * 8;
  f32x4 y[4][2];
  { f32x4 o0[4][2], o1[4][2];
#pragma unroll
    for (int mp = 0; mp < 4; ++mp)
#pragma unroll
      for (int ni = 0; ni < 2; ++ni) { o0[mp][ni] = f32x4{0.f, 0.f, 0.f, 0.f}; o1[mp][ni] = f32x4{0.f, 0.f, 0.f, 0.f}; }
    const int cs0 = cscan(0, co, CTX_ / 128, SEQ_ / 128), cs1 = cscan(1, co, CTX_ / 128, SEQ_ / 128);
    const bf16_t* H0 = (const bf16_t*)(p.ws + Ws::HIN) + ((size_t)((0 * B_ + b) * NC128 + cs0) * 8 + h) * 8192;
    const bf16_t* H1 = (const bf16_t*)(p.ws + Ws::HIN) + ((size_t)((1 * B_ + b) * NC128 + cs1) * 8 + h) * 8192;
#pragma unroll
    for (int s4 = 0; s4 < 4; ++s4) { const bf16x8 c0 = ld8g(Cb + s4 * 32), c1 = ld8g(Cb + 16 * 1024 + s4 * 32);
#pragma unroll
      for (int mp = 0; mp < 4; ++mp) { bf16x8 h0 = ld8g(H0 + (size_t)(mp * 16 + l15) * 128 + s4 * 32 + q * 8), h1 = ld8g(H1 + (size_t)(mp * 16 + l15) * 128 + s4 * 32 + q * 8);
        o0[mp][0] = MFMA16(h0, c0, o0[mp][0]); o0[mp][1] = MFMA16(h0, c1, o0[mp][1]);
        o1[mp][0] = MFMA16(h1, c0, o1[mp][0]); o1[mp][1] = MFMA16(h1, c1, o1[mp][1]); } }
#pragma unroll
    for (int ni = 0; ni < 2; ++ni) { const int i = wave * 32 + ni * 16 + l15; const float e0 = expf(cum0[i]), e1 = expf(suf1[i]);
#pragma unroll
      for (int mp = 0; mp < 4; ++mp)
#pragma unroll
        for (int r = 0; r < 4; ++r) y[mp][ni][r] = e0 * o0[mp][ni][r] + e1 * o1[mp][ni][r]; } }
  bf16x8 mfr[4][2];
  { f32x4 g[8][2];
#pragma unroll
    for (int mj = 0; mj < 8; ++mj) { g[mj][0] = f32x4{0.f, 0.f, 0.f, 0.f}; g[mj][1] = f32x4{0.f, 0.f, 0.f, 0.f}; }
#pragma unroll
    for (int s4 = 0; s4 < 4; ++s4) { const bf16x8 c0 = ld8g(Cb + s4 * 32), c1 = ld8g(Cb + 16 * 1024 + s4 * 32);
#pragma unroll
      for (int mj = 0; mj < 8; ++mj) { bf16x8 bb = ld8g(XBC + (size_t)(mj * 16 + l15) * 1024 + 512 + grp * 128 + s4 * 32 + q * 8);
        g[mj][0] = MFMA16(bb, c0, g[mj][0]); g[mj][1] = MFMA16(bb, c1, g[mj][1]); } }
    const int i0 = wave * 32 + l15, i1 = i0 + 16;
    const float c0i0 = cum0[i0], s1i0 = suf1[i0], c0i1 = cum0[i1], s1i1 = suf1[i1];
#pragma unroll
    for (int mj = 0; mj < 8; ++mj)
#pragma unroll
      for (int r = 0; r < 4; ++r) { const int j = mj * 16 + q * 4 + r;
        const float cj = cum0[j], sj = suf1[j], d0 = dt0[j], d1 = dt1[j];
        const float lw0 = (j <= i0 ? expf(c0i0 - cj) * d0 : 0.f) + (j >= i0 ? expf(s1i0 - sj) * d1 : 0.f);
        const float lw1 = (j <= i1 ? expf(c0i1 - cj) * d0 : 0.f) + (j >= i1 ? expf(s1i1 - sj) * d1 : 0.f);
        mfr[mj >> 1][0][(mj & 1) * 4 + r] = (short)f2bf(g[mj][0][r] * lw0);
        mfr[mj >> 1][1][(mj & 1) * 4 + r] = (short)f2bf(g[mj][1][r] * lw1); } }
#pragma unroll
  for (int s4 = 0; s4 < 4; ++s4)
#pragma unroll
    for (int mp = 0; mp < 4; ++mp) { const bf16_t* xr = XT + (size_t)(h * 64 + mp * 16 + l15) * 128 + s4 * 32 + q * 4;
      bf16x8 xa = ld4x2g(xr, xr + 16);
      y[mp][0] = MFMA16(xa, mfr[s4][0], y[mp][0]); y[mp][1] = MFMA16(xa, mfr[s4][1], y[mp][1]); }
  __syncthreads();
  float* yl = f + 1024;
#pragma unroll
  for (int mp = 0; mp < 4; ++mp)
#pragma unroll
    for (int ni = 0; ni < 2; ++ni)
#pragma unroll
      for (int r = 0; r < 4; ++r) yl[(wave * 32 + ni * 16 + l15) * 65 + mp * 16 + q * 4 + r] = y[mp][ni][r];
  __syncthreads();
  float* YS = (float*)(p.ws + Ws::YS) + (size_t)(b * T_ + co * 128) * 512 + h * 64;
  for (int e = tid; e < 128 * 64; e += 256) YS[(size_t)(e >> 6) * 512 + (e & 63)] = yl[(e >> 6) * 65 + (e & 63)];
}

#define GQ_LD 40
#define GK_LD 72
DEVFN void gla_chunk(const Params& p, int unit, unsigned char* smem) {
  const int tid = TIDX, lane = tid & 63, wave = tid >> 6, q = lane >> 4, l15 = lane & 15;
  const int h = unit & 3, co = (unit >> 2) % NC64, b = unit / (4 * NC64);
  const bf16_t* ZX = (const bf16_t*)(p.ws + Ws::ZX) + (size_t)(b * T_ + co * 64) * NIN_;
  const float* LA = (const float*)(p.ws + Ws::LA);
  float* cum = (float*)smem;
  bf16_t* qs = (bf16_t*)(smem + 16384);
  bf16_t* ks = qs + 2 * 64 * GQ_LD;
  bf16_t* kt = ks + 2 * 64 * GQ_LD;
  __syncthreads();
  for (int e = tid; e < 2 * 64 * 32; e += 256) { const int d = e >> 11, i = (e >> 5) & 63, dd = e & 31;
    cum[e] = LA[((size_t)d * NT_ + b * T_ + co * 64 + i) * 128 + h * 32 + dd]; }
  __syncthreads();
  if (tid < 64) { const int d = tid >> 5, dd = tid & 31; float* c = cum + d * 2048 + dd; float sacc = 0.f;
    if (d == 0) for (int i = 0; i < 64; ++i) { sacc += c[i * 32]; c[i * 32] = sacc; }
    else for (int i = 63; i >= 0; --i) { sacc += c[i * 32]; c[i * 32] = sacc; } }
  __syncthreads();
  bf16_t* QT = (bf16_t*)(p.ws + Ws::QT);
  for (int e = tid; e < 64 * 32; e += 256) { const int i = e >> 5, dd = e & 31;
    const float qv = bf2f(ZX[(size_t)i * NIN_ + OGQ + h * 32 + dd]) * 0.17677669529663687f, kv = bf2f(ZX[(size_t)i * NIN_ + OGK + h * 32 + dd]);
    const float c0 = cum[i * 32 + dd], c1 = cum[2048 + i * 32 + dd], t0 = cum[63 * 32 + dd], t1 = cum[2048 + dd];
    const bf16_t q0 = f2bf(qv * expf(c0)), q1 = f2bf(qv * expf(c1));
    qs[i * GQ_LD + dd] = q0; qs[64 * GQ_LD + i * GQ_LD + dd] = q1;
    ks[i * GQ_LD + dd] = f2bf(kv * expf(-c0)); ks[64 * GQ_LD + i * GQ_LD + dd] = f2bf(kv * expf(-c1));
    kt[dd * GK_LD + i] = f2bf(kv * expf(t0 - c0)); kt[32 * GK_LD + dd * GK_LD + i] = f2bf(kv * expf(t1 - c1));
    const size_t tok = (size_t)b * T_ + co * 64 + i;
    QT[tok * 128 + h * 32 + dd] = q0; QT[((size_t)NT_ + tok) * 128 + h * 32 + dd] = q1; }
  if (tid < 64) { const int d = tid >> 5, dd = tid & 31; const int cs = cscan(d, co, CTX_ / 64, SEQ_ / 64);
    ((float*)(p.ws + Ws::GCD))[(((size_t)(d * B_ + b) * NC64 + cs) * 4 + h) * 32 + dd] = expf(d == 0 ? cum[63 * 32 + dd] : cum[2048 + dd]); }
  __syncthreads();
  bf16x8 pfr[2];
  { f32x4 p0[4], p1[4];
    const bf16x8 qb0 = ld8(qs + (wave * 16 + l15) * GQ_LD + q * 8), qb1 = ld8(qs + 64 * GQ_LD + (wave * 16 + l15) * GQ_LD + q * 8);
#pragma unroll
    for (int mj = 0; mj < 4; ++mj) { p0[mj] = MFMA16(ld8(ks + (mj * 16 + l15) * GQ_LD + q * 8), qb0, (f32x4{0.f, 0.f, 0.f, 0.f}));
      p1[mj] = MFMA16(ld8(ks + 64 * GQ_LD + (mj * 16 + l15) * GQ_LD + q * 8), qb1, (f32x4{0.f, 0.f, 0.f, 0.f})); }
    const int i = wave * 16 + l15;
#pragma unroll
    for (int mj = 0; mj < 4; ++mj)
#pragma unroll
      for (int r = 0; r < 4; ++r) { const int j = mj * 16 + q * 4 + r; pfr[mj >> 1][(mj & 1) * 4 + r] = (short)f2bf((j <= i ? p0[mj][r] : 0.f) + (j >= i ? p1[mj][r] : 0.f)); } }
  const bf16_t* VT = (const bf16_t*)(p.ws + Ws::VT) + ((size_t)(b * NC64 + co) * 256 + h * 64) * 64;
  f32x4 o[4];
#pragma unroll
  for (int md = 0; md < 4; ++md) { o[md] = f32x4{0.f, 0.f, 0.f, 0.f};
#pragma unroll
    for (int s2 = 0; s2 < 2; ++s2) { const bf16_t* vr = VT + (size_t)(md * 16 + l15) * 64 + s2 * 32 + q * 4; o[md] = MFMA16(ld4x2g(vr, vr + 16), pfr[s2], o[md]); } }
#pragma unroll
  for (int d = 0; d < 2; ++d) { const int cs = cscan(d, co, CTX_ / 64, SEQ_ / 64);
    float* GST = (float*)(p.ws + Ws::GST) + (((size_t)(d * B_ + b) * NC64 + cs) * 4 + h) * 2048;
#pragma unroll
    for (int nd = 0; nd < 2; ++nd) { f32x4 st = f32x4{0.f, 0.f, 0.f, 0.f};
#pragma unroll
      for (int s2 = 0; s2 < 2; ++s2) st = MFMA16(ld8g(VT + (size_t)(wave * 16 + l15) * 64 + s2 * 32 + q * 8), ld8(kt + d * 32 * GK_LD + (nd * 16 + l15) * GK_LD + s2 * 32 + q * 8), st);
#pragma unroll
      for (int r = 0; r < 4; ++r) GST[(wave * 16 + q * 4 + r) * 32 + nd * 16 + l15] = st[r]; } }
  __syncthreads();
  float* ol = (float*)smem;
#pragma unroll
  for (int md = 0; md < 4; ++md)
#pragma unroll
    for (int r = 0; r < 4; ++r) ol[(wave * 16 + l15) * 65 + md * 16 + q * 4 + r] = o[md][r];
  __syncthreads();
  float* OI = (float*)(p.ws + Ws::OI) + (size_t)(b * T_ + co * 64) * 256 + h * 64;
  for (int e = tid; e < 64 * 64; e += 256) OI[(size_t)(e >> 6) * 256 + (e & 63)] = ol[(e >> 6) * 65 + (e & 63)];
}
#define GLA_SB ((NC64 % 17) == 0 ? 17 : NC64)
DEVFN void gla_scan(const Params& p, int gtid, int gthreads) {
  const float* __restrict__ ST = (const float*)(p.ws + Ws::GST); const float* __restrict__ CD = (const float*)(p.ws + Ws::GCD); bf16_t* __restrict__ SIN = (bf16_t*)(p.ws + Ws::GSIN);
  for (int e = gtid; e < 2 * B_ * 4 * 2048; e += gthreads) {
    const int vd = e & 2047, h = (e >> 11) & 3, db = e >> 13;
    float sv = 0.f;
#pragma unroll 1
    for (int c0 = 0; c0 < NC64; c0 += GLA_SB) {
      float st[GLA_SB], cd[GLA_SB];
#pragma unroll
      for (int i = 0; i < GLA_SB; ++i) { st[i] = ST[(((size_t)db * NC64 + c0 + i) * 4 + h) * 2048 + vd]; cd[i] = CD[(((size_t)db * NC64 + c0 + i) * 4 + h) * 32 + (vd & 31)]; }
#pragma unroll
      for (int i = 0; i < GLA_SB; ++i) { SIN[(((size_t)db * NC64 + c0 + i) * 4 + h) * 2048 + vd] = f2bf(sv); sv = sv * cd[i] + st[i]; }
    }
  }
}
DEVFN void gla_out(const Params& p, int unit_base) {
  const int tid = TIDX, lane = tid & 63, wave = tid >> 6, g = lane >> 4, l15 = lane & 15;
  const int unit = unit_base + wave;
  if (unit >= B_ * NC64 * 4) return;
  const int h = unit & 3, co = (unit >> 2) % NC64, b = unit / (4 * NC64);
  const bf16_t* QT = (const bf16_t*)(p.ws + Ws::QT);
  const bf16_t* GSIN = (const bf16_t*)(p.ws + Ws::GSIN);
  float* OI = (float*)(p.ws + Ws::OI) + (size_t)(b * T_ + co * 64) * 256 + h * 64;
  const int tok0 = b * T_ + co * 64;
  bf16x8 af[2][4], bfr[2][4];
#pragma unroll
  for (int d = 0; d < 2; ++d) { const int cs = cscan(d, co, CTX_ / 64, SEQ_ / 64);
    const bf16_t* sr = GSIN + ((((size_t)(d * B_ + b) * NC64 + cs) * 4 + h) * 64) * 32;
#pragma unroll
    for (int mi = 0; mi < 4; ++mi) af[d][mi] = ld8g(QT + ((size_t)d * NT_ + tok0 + mi * 16 + l15) * 128 + h * 32 + g * 8);
#pragma unroll
    for (int ni = 0; ni < 4; ++ni) bfr[d][ni] = ld8g(sr + (ni * 16 + l15) * 32 + g * 8); }
#pragma unroll
  for (int mi = 0; mi < 4; ++mi) {
    f32x4 acc[4];
#pragma unroll
    for (int ni = 0; ni < 4; ++ni)
#pragma unroll
      for (int i = 0; i < 4; ++i) acc[ni][i] = gptr(OI)[(size_t)(mi * 16 + 4 * g + i) * 256 + ni * 16 + l15];
#pragma unroll
    for (int ni = 0; ni < 4; ++ni) { acc[ni] = MFMA16(af[0][mi], bfr[0][ni], acc[ni]); acc[ni] = MFMA16(af[1][mi], bfr[1][ni], acc[ni]); }
#pragma unroll
    for (int ni = 0; ni < 4; ++ni)
#pragma unroll
      for (int i = 0; i < 4; ++i) gptr(OI)[(size_t)(mi * 16 + 4 * g + i) * 256 + ni * 16 + l15] = acc[ni][i];
  }
}
DEVFN void convert_moe_weights(const Params& p, int l, unsigned char* smem, int bid, int nb, int j_lo, int j_hi);
#define CVT_JOBS (65 * 192)
#ifndef CVT_SCAN_SHARE
#define CVT_SCAN_SHARE (CVT_JOBS / 8)
#endif
DEVFN void phase4a(const Params& p, int l, unsigned char* smem) {
  const int n_r = B_ * 8 * NC16 / 4;
  for (int u = BIDX; u < n_r; u += gridDim.x) rwkv_chunk(p, (u) * 4, smem);
  (void)l;
}
DEVFN void phase4b(const Params& p, int l, unsigned char* smem) {
  const int bid = BIDX, nrw = B_ * 8, G = (int)gridDim.x;
  const int n_s = B_ * NC128 * 8, n_g = B_ * NC64 * 4;
  int ob = bid, on = G, cv_lo = 0;
  if (G >= 8 * nrw) {
    const int q = 2 * nrw, half = G >> 1;
    int sb = -1;
    if (bid < q) sb = bid; else if (bid >= half && bid < half + q) sb = q + (bid - half);
    if (sb >= 0) { if ((TIDX >> 6) == 0) rwkv_scan(p, sb >> 2, sb & 3); convert_moe_weights(p, l, smem, sb, 4 * nrw, 0, CVT_SCAN_SHARE); return; }
    ob = bid < half ? bid - q : bid - 2 * q; on = G - 4 * nrw; cv_lo = CVT_SCAN_SHARE; }
  else { for (int u = bid; u < nrw; u += G) rwkv_scan(p, u, TIDX >> 6); }
  for (int u = ob; u < n_s + n_g; u += on) { if (u < n_s) ssd_states(p, l, u, smem); else gla_chunk(p, u - n_s, smem); }
  convert_moe_weights(p, l, smem, ob, on, cv_lo, CVT_JOBS);
}
DEVFN void phase4b2(const Params& p) {
  const int bid = BIDX, G = (int)gridDim.x;
  ssd_scan(p, bid * 256 + TIDX, G * 256); gla_scan(p, bid * 256 + TIDX, G * 256);
}
DEVFN void phase4c(const Params& p, int l, unsigned char* smem) {
  const int n_s = B_ * NC128 * 8, n_r = B_ * 8 * NC16 / 4, n_g = B_ * NC64, total = n_s + n_r + n_g, G = (int)gridDim.x;
  unsigned* ctr = (unsigned*)(p.ws + Ws::BAR) + l * 32;
  volatile int* nxt_s = (volatile int*)(smem + SM_PRE);
  int u = BIDX;
  while (u < total) {
    int nxt = 0;
    if (TIDX == 0) nxt = G + (int)atomicAdd(ctr, 1u);
    if (u < n_s) ssd_out(p, l, u, smem); else if (u < n_s + n_r) rwkv_out(p, (u - n_s) * 4); else gla_out(p, (u - n_s - n_r) * 4);
    __syncthreads();
    if (TIDX == 0) *nxt_s = nxt;
    __syncthreads();
    u = *nxt_s;
  }
}

DEVFN void phase5(const Params& p, int l, unsigned char* smem) {
  const int tid = TIDX, lane = tid & 63, wave = tid >> 6;
  const bf16_t* ZX = (const bf16_t*)(p.ws + Ws::ZX);
  const bf16_t* XBC = (const bf16_t*)(p.ws + Ws::XBC);
  const float* YS = (const float*)(p.ws + Ws::YS); const float* YR = (const float*)(p.ws + Ws::YR); const float* OI = (const float*)(p.ws + Ws::OI);
  const bf16_t* RR = (const bf16_t*)(p.ws + Ws::RR); const bf16_t* VV = (const bf16_t*)(p.ws + Ws::VV); const bf16_t* KD = (const bf16_t*)(p.ws + Ws::KD);
  const float* GATE = (const float*)(p.ws + Ws::GATE);
  bf16_t* YM = (bf16_t*)(p.ws + Ws::YMIX);
  constexpr int TPI = 4;
  float* red = (float*)smem;
  const float dA = INP(I_SSDD)[(size_t)l * 8 + (tid >> 6)], dB = INP(I_SSDD)[(size_t)l * 8 + 4 + (tid >> 6)];
  const float nwA = INP(I_SSDNW)[(size_t)l * 512 + tid], nwB = INP(I_SSDNW)[(size_t)l * 512 + 256 + tid];
  const float lnw = INP(I_LNXW)[(size_t)l * 256 + tid], lnb = INP(I_LNXB)[(size_t)l * 256 + tid], rk = INP(I_RK)[(size_t)l * 256 + tid];
  const float gnw = INP(I_GNW)[(size_t)l * 256 + tid];
  const int per_ = (NT_ / TPI + (int)gridDim.x - 1) / (int)gridDim.x, tp_lo = BIDX * per_, tp_hi = (tp_lo + per_ < NT_ / TPI) ? tp_lo + per_ : NT_ / TPI;
  for (int tp = tp_lo; tp < tp_hi; ++tp) {
    float ys0[TPI], ys1[TPI], x0[TPI], x1[TPI], z0[TPI], z1[TPI], og[TPI], yr[TPI], rr[TPI], kf[TPI], kb[TPI], vv[TPI], gt[TPI], oi[TPI];
#pragma unroll
    for (int t = 0; t < TPI; ++t) { const int tok = tp * TPI + t;
      ys0[t] = gptr(YS)[(size_t)tok * 512 + tid]; ys1[t] = gptr(YS)[(size_t)tok * 512 + 256 + tid];
      x0[t] = bf2f(gptr(XBC)[(size_t)tok * 1024 + tid]); x1[t] = bf2f(gptr(XBC)[(size_t)tok * 1024 + 256 + tid]);
      z0[t] = zxv(ZX, tok, OZ + tid); z1[t] = zxv(ZX, tok, OZ + 256 + tid); og[t] = zxv(ZX, tok, OOG + tid);
      yr[t] = gptr(YR)[(size_t)tok * 256 + tid] + gptr(YR)[((size_t)NT_ + tok) * 256 + tid];
      rr[t] = bf2f(gptr(RR)[(size_t)tok * 256 + tid]); kf[t] = bf2f(gptr(KD)[(size_t)tok * 256 + tid]); kb[t] = bf2f(gptr(KD)[((size_t)NT_ + tok) * 256 + tid]);
      vv[t] = bf2f(gptr(VV)[(size_t)tok * 256 + tid]); gt[t] = gptr(GATE)[(size_t)tok * 256 + tid]; oi[t] = gptr(OI)[(size_t)tok * 256 + tid];
    }
    float ya[TPI], yb[TPI], qa[TPI], qb[TPI];
#pragma unroll
    for (int t = 0; t < TPI; ++t) {
      ya[t] = (ys0[t] + dA * x0[t]) * siluf_(z0[t]); yb[t] = (ys1[t] + dB * x1[t]) * siluf_(z1[t]);
      qa[t] = wave_sum(ya[t] * ya[t]); qb[t] = wave_sum(yb[t] * yb[t]); }
    __syncthreads();
#pragma unroll
    for (int t = 0; t < TPI; ++t)
      if (lane == 0) { red[t * 8 + wave] = qa[t]; red[t * 8 + 4 + wave] = qb[t]; }
    __syncthreads();
#pragma unroll
    for (int t = 0; t < TPI; ++t) { const int tok = tp * TPI + t;
      const float* rd = red + t * 8;
      float ma = (rd[0] + rd[1] + rd[2] + rd[3]) * (1.f / 256.f), mb = (rd[4] + rd[5] + rd[6] + rd[7]) * (1.f / 256.f);
      YM[(size_t)tok * 1024 + tid] = f2bf(ya[t] * rsqrtf(ma + 1e-5f) * nwA);
      YM[(size_t)tok * 1024 + 256 + tid] = f2bf(yb[t] * rsqrtf(mb + 1e-5f) * nwB);
      { const float y = yr[t];
        float mu = wave_sum(y) * (1.f / 64.f), d = y - mu, var = wave_sum(d * d) * (1.f / 64.f);
        float yn = d * rsqrtf(var + 64e-5f) * lnw + lnb;
        float bonus = wave_sum(rr[t] * (kf[t] + kb[t]) * rk) * vv[t];
        YM[(size_t)tok * 1024 + 512 + tid] = f2bf((yn + bonus) * gt[t]); }
      { float o = oi[t];
        float ms = wave_sum(o * o) * (1.f / 64.f);
        YM[(size_t)tok * 1024 + 768 + tid] = f2bf(o * rsqrtf(ms + 1e-5f) * gnw * siluf_(og[t])); } }
  }
}

DEVFN void phase6(const Params& p, int l, unsigned char* smem) {
  const bf16_t* A = (const bf16_t*)(p.ws + Ws::YMIX);
  const bf16_t* W = (const bf16_t*)(p.ws + Ws::WOUT) + (size_t)l * 1024 * 1024;
  float* MIX = (float*)(p.ws + Ws::MIX);
  for (int u = BIDX; u < (NT_ / 128) * 8; u += gridDim.x) {
    int rt = u / 8, ct = u % 8;
    gemm_tile(smem, 1024,
      [&](int r) { return A + (size_t)(rt * 128 + r) * 1024; },
      [&](int r) { return W + (size_t)(ct * 128 + r) * 1024; },
      [&](f32x4 (&acc)[4][4], int wr, int wc, int g, int l15) {
#pragma unroll
        for (int mi = 0; mi < 4; ++mi)
#pragma unroll
          for (int ni = 0; ni < 4; ++ni)
#pragma unroll
            for (int i = 0; i < 4; ++i) MIX[(size_t)(rt * 128 + wr * 64 + mi * 16 + 4 * g + i) * 1024 + ct * 128 + wc * 64 + ni * 16 + l15] = acc[mi][ni][i];
      });
  }
}

#define P7_MAXE 2048
DEVFN void phase7(const Params& p, int l, unsigned char* smem) {
  const int lane = TIDX & 63, wave = TIDX >> 6;
  float* X = (float*)(p.ws + Ws::X);
  const float* MIX = (const float*)(p.ws + Ws::MIX);
  bf16_t* H = (bf16_t*)(p.ws + Ws::U);
  const float* rwt = (const float*)(p.ws + Ws::RWT) + (size_t)l * 64 * 1024;
  int* cnt = (int*)(p.ws + Ws::CNT) + l * 64 * 64;
  int* ltok = (int*)(p.ws + Ws::LTOK); float* lwt = (float*)(p.ws + Ws::LWT);
  const float rbias = INP(I_RB)[(size_t)l * 64 + lane];
  float* hs = (float*)smem;
  float* lg = hs + 4096;
  int* lcnt = (int*)(lg + 256);
  int* lbase = lcnt + 80;
  int* etok = lbase + 64;
  int* epos = etok + P7_MAXE; float* ewt = (float*)(epos + P7_MAXE);
  for (int i = TIDX; i < 80; i += 256) lcnt[i] = 0;
  for (int tok0 = BIDX * 4; tok0 < NT_; tok0 += gridDim.x * 4) {
    const int tok = tok0 + wave;
    const float* mod = (const float*)(p.ws + Ws::MOD) + ((size_t)l * NR_ + tok_modrow(tok)) * NMOD_;
    float xv[16], mx[16], g1[16], lw[16], lb[16], sh2[16], sc2[16], mean, rstd;
    load_row16(X + (size_t)tok * 1024, lane, xv);
    load_row16(MIX + (size_t)tok * 1024, lane, mx);
    load_row16(mod + 2 * 1024, lane, g1);
    load_row16(INP(I_LN1W) + (size_t)l * 1024, lane, lw);
    load_row16(INP(I_LN1B) + (size_t)l * 1024, lane, lb);
    load_row16(mod + 3 * 1024, lane, sh2);
    load_row16(mod + 4 * 1024, lane, sc2);
#pragma unroll
    for (int i = 0; i < 16; ++i) xv[i] = ALPHA_ * xv[i] + g1[i] * mx[i];
    row_stats(xv, mean, rstd);
#pragma unroll
    for (int i = 0; i < 16; ++i) xv[i] = (xv[i] - mean) * rstd * lw[i] + lb[i];
#pragma unroll
    for (int j = 0; j < 4; ++j) *(float4*)(X + (size_t)tok * 1024 + lane * 4 + 256 * j) = make_float4(xv[4 * j], xv[4 * j + 1], xv[4 * j + 2], xv[4 * j + 3]);
    const bool routed = !(l == DEPTH_ - 1 && (tok % T_) < CTX_);
    row_stats(xv, mean, rstd);
#pragma unroll
    for (int i = 0; i < 16; ++i) xv[i] = (xv[i] - mean) * rstd * (1.f + sc2[i]) + sh2[i];
    __syncthreads();
#pragma unroll
    for (int j = 0; j < 4; ++j) {
      if (routed) *(uint2*)(H + (size_t)tok * 1024 + lane * 4 + 256 * j) = make_uint2((unsigned)f2bf(xv[4 * j]) | ((unsigned)f2bf(xv[4 * j + 1]) << 16), (unsigned)f2bf(xv[4 * j + 2]) | ((unsigned)f2bf(xv[4 * j + 3]) << 16));
      *(float4*)(hs + wave * 1024 + lane * 4 + 256 * j) = make_float4(xv[4 * j], xv[4 * j + 1], xv[4 * j + 2], xv[4 * j + 3]); }
    __syncthreads();
    { float hv[4][16];
      const int rot = BIDX & 15;
#pragma unroll
      for (int t = 0; t < 4; ++t)
#pragma unroll
        for (int j = 0; j < 4; ++j) { const float4 v = *(const float4*)(hs + t * 1024 + lane * 4 + 256 * j); hv[t][4 * j] = v.x; hv[t][4 * j + 1] = v.y; hv[t][4 * j + 2] = v.z; hv[t][4 * j + 3] = v.w; }
      float pe[64];
      const AS1 float* rw = gptr(rwt) + lane * 4;
      f32x4 w[4], wn[4];
#pragma unroll
      for (int j = 0; j < 4; ++j) w[j] = *(const AS1 f32x4*)(rw + (size_t)(16 * wave + (rot & 15)) * 1024 + 256 * j);
#pragma unroll
      for (int e = 0; e < 16; ++e) {
        if (e + 1 < 16) {
#pragma unroll
          for (int j = 0; j < 4; ++j) wn[j] = *(const AS1 f32x4*)(rw + (size_t)(16 * wave + ((e + 1 + rot) & 15)) * 1024 + 256 * j); }
#pragma unroll
        for (int t = 0; t < 4; ++t) { float s0 = 0.f, s1 = 0.f;
#pragma unroll
          for (int j = 0; j < 4; ++j) { s0 += hv[t][4 * j] * w[j][0] + hv[t][4 * j + 2] * w[j][2]; s1 += hv[t][4 * j + 1] * w[j][1] + hv[t][4 * j + 3] * w[j][3]; }
          pe[e * 4 + t] = s0 + s1; }
#pragma unroll
        for (int j = 0; j < 4; ++j) w[j] = wn[j]; }
#pragma unroll
      for (int half = 32; half >= 1; half >>= 1) { const bool up = (lane & half) != 0;
#pragma unroll
        for (int e = 0; e < half; ++e) { const float send = up ? pe[e] : pe[e + half]; const float recv = __shfl_xor(send, half); pe[e] = (up ? pe[e + half] : pe[e]) + recv; } }
      lg[(lane & 3) * 64 + 16 * wave + (((lane >> 2) + rot) & 15)] = pe[0]; }
    __syncthreads();
    if (!routed) continue;
    const float logit = lg[wave * 64 + lane];
    const float score = sigmoidf_(logit), sel = score + rbias;
    float m1 = sel; int a1 = lane;
#pragma unroll
    for (int m = 1; m <= 4; m <<= 1) { float ov = XOR8(m1, m); int oa = XOR8(a1, m); if (ov > m1 || (ov == m1 && oa < a1)) { m1 = ov; a1 = oa; } }
    float m2 = (lane == a1) ? -3.0e38f : sel;
#pragma unroll
    for (int m = 1; m <= 4; m <<= 1) m2 = fmaxf(m2, XOR8(m2, m));
    const float gs = m1 + m2; const int grp = lane >> 3;
    int grank = 0;
#pragma unroll
    for (int g2 = 0; g2 < 8; ++g2) { float og = SHFL_CONST(gs, g2 * 8); grank += (og > gs || (og == gs && g2 < grp)) ? 1 : 0; }
    const bool gsel = grank < 4;
    const float msel = gsel ? sel : -3.0e38f;
    int rank = 0;
#pragma unroll
    for (int e = 0; e < 64; ++e) { float ov = SHFL_CONST(msel, e); rank += (ov > msel || (ov == msel && e < lane)) ? 1 : 0; }
    const bool chosen = gsel && rank < 8;
    const float wsum = wave_sum(chosen ? score : 0.f);
    if (chosen) { const float wv = score / wsum * 2.5f;
      const int idx = atomicAdd(&lcnt[64], 1);
      if (idx < P7_MAXE) { const int slot = atomicAdd(&lcnt[lane], 1); etok[idx] = tok * 8 + rank; epos[idx] = lane | (slot << 8); ewt[idx] = wv; }
      else { int pos = atomicAdd(&cnt[lane * 64], 1); ltok[(size_t)lane * NT_ + pos] = tok * 8 + rank; lwt[(size_t)lane * NT_ + pos] = wv; } }
  }
  __syncthreads();
  if (TIDX < 64) { const int c = lcnt[TIDX]; lbase[TIDX] = c ? atomicAdd(&cnt[TIDX * 64], c) : 0; }
  __syncthreads();
  { const int ne = lcnt[64] < P7_MAXE ? lcnt[64] : P7_MAXE;
    for (int i = TIDX; i < ne; i += 256) { const int e = epos[i] & 255, pos = lbase[e] + (epos[i] >> 8);
      ltok[(size_t)e * NT_ + pos] = etok[i]; lwt[(size_t)e * NT_ + pos] = ewt[i]; } }
}

struct MoeMap { int nblk_total; int e; int rb; int cnt; int hoff; };
DEVFN int moe_ntok(int l) { return l == DEPTH_ - 1 ? B_ * SEQ_ : NT_; }
DEVFN int moe_shared_tok(int l, int i) { return l == DEPTH_ - 1 ? (i / SEQ_) * T_ + CTX_ + (i % SEQ_) : i; }
DEVFN void moe_prefix(const Params& p, int l, int* pre) {
  const int* cnt = (const int*)(p.ws + Ws::CNT) + l * 64 * 64;
  __syncthreads();
  if (TIDX < 64) pre[66 + TIDX] = gptr(cnt)[TIDX * 64];
  if (TIDX == 64) pre[66 + 64] = moe_ntok(l);
  __syncthreads();
  if (TIDX == 0) { int s = 0; for (int e = 0; e < 65; ++e) { pre[e] = s; s += (pre[66 + e] + 127) / 128; } pre[65] = s; }
  __syncthreads();
}
DEVFN void phase8(const Params& p, int l, unsigned char* smem) {
  int* pre = (int*)(smem + SM_PRE);
  moe_prefix(p, l, pre);
  const bf16_t* H = (const bf16_t*)(p.ws + Ws::U);
  const bf16_t* W13 = (const bf16_t*)(p.ws + Ws::W13);
  bf16_t* HID = (bf16_t*)(p.ws + Ws::HID);
  const int* ltok = (const int*)(p.ws + Ws::LTOK); const float* lwt = (const float*)(p.ws + Ws::LWT);
  const int total = pre[65];
  for (int u = BIDX; u < total * 2; u += gridDim.x) {
    const int gb = u >> 1, nt = u & 1;
    int e = 0; while (pre[e + 1] <= gb) ++e;
    e = UNI(e);
    const int rb = UNI(gb - pre[e]), cnt = UNI(pre[66 + e]);
    int* tk_s = (int*)(smem + GEMMW_SMEM); float* gw_s = (float*)(tk_s + 128);
    __syncthreads();
    if (TIDX < 128) { const int pos = rb * 128 + TIDX; int tk = -1; float gw = 0.f;
      if (pos < cnt) { tk = e < 64 ? (gptr(ltok)[(size_t)e * NT_ + pos] >> 3) : moe_shared_tok(l, pos); gw = e < 64 ? gptr(lwt)[(size_t)e * NT_ + pos] : 1.f; }
      tk_s[TIDX] = tk; gw_s[TIDX] = gw; }
    __syncthreads();
    gemm_tile_w<1, 1024>(smem, 1024,
      [&](int r) { const int tk = tk_s[r]; return tk >= 0 ? H + (size_t)tk * 1024 : (const bf16_t*)(p.ws + Ws::ZROW); },
      [&](int) { return W13 + ((size_t)e * 512 + nt * 256) * 1024; },
      [&](f32x4 (&acc)[4][8], int, int wr, int wc, int g, int l15) {
        tile_store_bf16<16>(smem, wr, g, l15,
          [&](bf16_t* T, int ldc) {
#pragma unroll
            for (int mi = 0; mi < 4; ++mi)
#pragma unroll
              for (int i = 0; i < 4; ++i) { const int r = wr * 64 + mi * 16 + 4 * g + i;
                const float gw = gw_s[r];
#pragma unroll
                for (int j = 0; j < 4; ++j) T[r * ldc + wc * 64 + j * 16 + l15] = f2bf(siluf_(acc[mi][2 * j][i]) * acc[mi][2 * j + 1][i] * gw); } },
          [&](int row, int c0) { const int pos = rb * 128 + row; return pos < cnt ? HID + ((size_t)gb * 128 + row) * 256 + nt * 128 + c0 : (bf16_t*)nullptr; });
      });
  }
}
DEVFN void phase9(const Params& p, int l, unsigned char* smem) {
  int* pre = (int*)(smem + SM_PRE);
  moe_prefix(p, l, pre);
  const bf16_t* HID = (const bf16_t*)(p.ws + Ws::HID);
  const bf16_t* W2T = (const bf16_t*)(p.ws + Ws::W2T);
  bf16_t* YB = (bf16_t*)(p.ws + Ws::YBUF);
  const int* ltok = (const int*)(p.ws + Ws::LTOK);
  const int total = pre[65];
  for (int u = BIDX; u < total * 2; u += gridDim.x) {
    const int gb = u >> 1, ntp = u & 1;
    int e = 0; while (pre[e + 1] <= gb) ++e;
    e = UNI(e);
    const int rb = UNI(gb - pre[e]), cnt = UNI(pre[66 + e]);
    int* ts_s = (int*)(smem + GEMMW_SMEM);
    __syncthreads();
    if (TIDX < 128) { const int pos = rb * 128 + TIDX; int ts = -1;
      if (pos < cnt) ts = e < 64 ? gptr(ltok)[(size_t)e * NT_ + pos] : moe_shared_tok(l, pos) * 8;
      ts_s[TIDX] = ts; }
    __syncthreads();
    gemm_tile_w<2, 256>(smem, 256,
      [&](int r) { return ts_s[r] >= 0 ? HID + ((size_t)gb * 128 + r) * 256 : (const bf16_t*)(p.ws + Ws::ZROW); },
      [&](int j) { return W2T + ((size_t)e * 1024 + (ntp * 2 + j) * 256) * 256; },
      [&](f32x4 (&acc)[4][8], int j, int wr, int wc, int g, int l15) { const int nt = ntp * 2 + j;
#pragma unroll 1
        for (int h = 0; h < 2; ++h)
          tile_store_bf16<16>(smem, wr, g, l15,
            [&](bf16_t* T, int ldc) {
              if (wc == h) {
#pragma unroll
                for (int mi = 0; mi < 4; ++mi)
#pragma unroll
                  for (int ni = 0; ni < 8; ++ni)
#pragma unroll
                    for (int i = 0; i < 4; ++i) T[(wr * 64 + mi * 16 + 4 * g + i) * ldc + ni * 16 + l15] = f2bf(acc[mi][ni][i]); } },
            [&](int row, int c0) { const int ts = ts_s[row]; if (ts < 0) return (bf16_t*)nullptr;
              const int tok = ts >> 3, slot = e < 64 ? (ts & 7) : 8;
              return YB + ((size_t)tok * NSLOT + slot) * 1024 + nt * 256 + h * 128 + c0; });
      });
  }
}

#define SMEM_BYTES (PH_SMEM + 2048)
#define N_PHASES (3 + 13 * DEPTH_)
__global__ void __launch_bounds__(256, 2) mega(Params p, int ph_lo, int ph_hi) {
#ifdef HIPEMU
  unsigned char* smem = hipemu::cur_smem();
#else
  unsigned char* smem = smem_dyn;
  volatile LAS unsigned* st = (volatile LAS unsigned*)(smem_dyn + SM_BAR);
  if (threadIdx.x == 0) {
    st[0] = 0u; st[1] = 0u;
    unsigned long long* tab = (unsigned long long*)(smem_dyn + SM_TAB);
#pragma unroll
    for (int i = 0; i < 40; ++i) tab[i] = (unsigned long long)p.in[i];
  }
  __syncthreads();
  XcdBarrier bar = xcd_barrier_post((unsigned*)(p.ws + Ws::BAR), st);
#define GRID_SYNC() xcd_barrier(bar)
#endif
  int ph = 0;
#ifdef ONLY_KIND
#define KIND_ON(k) ((k) == ONLY_KIND)
#else
#define KIND_ON(k) 1
#endif
#ifndef REPEAT_MASK
#define REPEAT_MASK 0u
#endif
#define RUN_PHASE(kind, code) { if (KIND_ON(kind) && ph >= ph_lo && ph < ph_hi) { \
    int nrep_ = ((REPEAT_MASK >> (kind)) & 1u) ? 2 : 1; LAUNDER(nrep_); \
    _Pragma("unroll 1") for (int rep_ = 0; rep_ < nrep_; ++rep_) { LAUNDER(p.ws); LAUNDER(p.out); code; if (rep_ + 1 < nrep_ || ph + 1 < ph_hi) { GRID_SYNC(); } } } ++ph; }
  RUN_PHASE(0, phase0(p, smem));
  RUN_PHASE(11, phase0b(p));
  for (int l = 0; l < DEPTH_; ++l) {
    RUN_PHASE(1, phase1(p, l));
    RUN_PHASE(2, phase2(p, l, smem));
    RUN_PHASE(3, phase3(p, l, smem));
    RUN_PHASE(14, phase3b(p, l, smem));
    RUN_PHASE(4, phase4a(p, l, smem));
    RUN_PHASE(12, phase4b(p, l, smem));
    RUN_PHASE(16, phase4b2(p));
    RUN_PHASE(13, phase4c(p, l, smem));
    RUN_PHASE(5, phase5(p, l, smem));
    RUN_PHASE(6, phase6(p, l, smem));
    RUN_PHASE(7, phase7(p, l, smem));
    RUN_PHASE(8, phase8(p, l, smem));
    RUN_PHASE(9, phase9(p, l, smem));
  }
  RUN_PHASE(10, phase_final(p));
}

extern "C" void kernel_launch(void* const* d_in, const int* in_sizes, int n_in, void* d_out, int out_size, void* d_ws, size_t ws_size, hipStream_t stream) {
  Params p{};
  for (int i = 0; i < 40; ++i) p.in[i] = (const float*)d_in[i];
  p.out = (float*)d_out;
  p.ws = (unsigned char*)d_ws;
  if (ws_size < Ws::END) { fprintf(stderr, "workspace too small: %zu < %zu\n", ws_size, (size_t)Ws::END); return; }
  hipMemsetAsync(d_ws, 0, Ws::ZERO_END, stream);
#ifdef HIPEMU
  int grid = 16; if (const char* e = getenv("EMU_GRID")) grid = atoi(e);
  int stop = N_PHASES; if (const char* e = getenv("EMU_STOP")) stop = atoi(e);
  if (getenv("EMU_ONE")) hipemu::launch(grid, 256, SMEM_BYTES, true, [=] { mega(p, 0, stop); });
  else for (int ph = 0; ph < stop; ++ph) hipemu::launch(grid, 256, SMEM_BYTES, false, [=] { mega(p, ph, ph + 1); });
#else
  static int grid = 0;
  if (!grid) {
    int dev = 0, cus = 0, per_cu = 0;
    hipGetDevice(&dev);
    hipDeviceGetAttribute(&cus, hipDeviceAttributeMultiprocessorCount, dev);
    hipOccupancyMaxActiveBlocksPerMultiprocessor(&per_cu, mega, 256, SMEM_BYTES);
    if (per_cu > 2) per_cu = 2;
    if (per_cu < 1) per_cu = 1;
    grid = cus * per_cu;
  }
#if N_LAUNCH_MODE == 1
  mega<<<grid, 256, SMEM_BYTES, stream>>>(p, 0, N_PHASES);
#else
  for (int ph = 0; ph < N_PHASES; ++ph) mega<<<grid, 256, SMEM_BYTES, stream>>>(p, ph, ph + 1);
#endif
#endif
}
```

```cpp
#ifndef HIPEMU
#include <hip/hip_runtime.h>
#endif
#include <stdint.h>
#include <stdio.h>

#ifndef B_
#define B_ 4
#endif
#ifndef SEQ_
#define SEQ_ 4096
#endif
#ifndef CTX_
#define CTX_ 256
#endif
#ifndef DEPTH_
#define DEPTH_ 4
#endif
#ifndef N_LAUNCH_MODE
#define N_LAUNCH_MODE 1
#endif
#define T_ (SEQ_ + CTX_)
#define NT_ (B_ * T_)
#define D_ 1024
#define NIN_ 3504
#define NMOD_ 6144
#define NR_ (B_ + 1)
#define OZ 0
#define OXBC 512
#define ODT 1536
#define ORW 1552
#define OGQ 2704
#define OGK 2832
#define OGV 2960
#define OGD 3216
#define OOG 3248
#define ALPHA_ 1.681792830507429f
#define NEXP 64
#define NSLOT 9
#define NC128 (T_ / 128)
#define NC64 (T_ / 64)
#define NC16 (T_ / 16)

#define DEVFN __device__ __forceinline__
#define LDT 72
#define GEMM_SMEM (2 * 128 * LDT * 2)
#define GEMMW_SMEM (3 * 128 * LDT * 2)
typedef unsigned short bf16_t;
#ifdef HIPEMU
#define AS1
#else
#define AS1 __attribute__((address_space(1)))
#endif
typedef unsigned u32x4 __attribute__((ext_vector_type(4)));
typedef unsigned u32x2 __attribute__((ext_vector_type(2)));

#ifdef HIPEMU
typedef emu_bf16x8 bf16x8;
typedef emu_f32x4 f32x4;
#define MFMA16(a, b, c) emu_mfma_16x16x32_bf16(a, b, c)
#define MFMA16K16(a, b, c) emu_mfma_16x16x16_bf16(a, b, c)
#define GRID_SYNC() hipemu::grid_sync()
#else
typedef short bf16x8 __attribute__((ext_vector_type(8)));
typedef float f32x4 __attribute__((ext_vector_type(4)));
#define MFMA16(a, b, c) __builtin_amdgcn_mfma_f32_16x16x32_bf16(a, b, c, 0, 0, 0)
#define MFMA16K16(a, b, c) __builtin_amdgcn_mfma_f32_16x16x16bf16_1k(a, b, c, 0, 0, 0)
#endif

DEVFN float bf2f(bf16_t h) { return __builtin_bit_cast(float, (unsigned)h << 16); }
DEVFN bf16_t f2bf(float f) { unsigned u = __builtin_bit_cast(unsigned, f); u += 0x7FFFu + ((u >> 16) & 1u); return (bf16_t)(u >> 16); }
template <class T> DEVFN AS1 T* gptr(T* q) { return (AS1 T*)q; }
DEVFN bf16x8 ld8g(const bf16_t* q) { return *(const AS1 bf16x8*)gptr(q); }
DEVFN float sigmoidf_(float x) { return 1.f / (1.f + expf(-x)); }
DEVFN float siluf_(float x) { return x / (1.f + expf(-x)); }
DEVFN float softplusf_(float x) { return x > 20.f ? x : log1pf(expf(x)); }
DEVFN float logsigmoidf_(float x) { return fminf(x, 0.f) - log1pf(expf(-fabsf(x))); }
#ifdef HIPEMU
DEVFN float wave_sum(float v) { for (int m = 32; m >= 1; m >>= 1) v += __shfl_xor(v, m); return v; }
#define SHFL_CONST(x, ln) __shfl(x, ln)
#define XOR8(x, m) __shfl_xor(x, m)
#else
template <int CTRL> DEVFN float dpp_f(float v) { return __builtin_bit_cast(float, __builtin_amdgcn_update_dpp(0, __builtin_bit_cast(int, v), CTRL, 0xF, 0xF, false)); }
template <int CTRL> DEVFN int dpp_i(int v) { return __builtin_amdgcn_update_dpp(0, v, CTRL, 0xF, 0xF, false); }
DEVFN float rdl_f(float v, int ln) { return __builtin_bit_cast(float, __builtin_amdgcn_readlane(__builtin_bit_cast(int, v), ln)); }
DEVFN float wave_sum(float v) {
  v += dpp_f<0xB1>(v);
  v += dpp_f<0x4E>(v);
  v += dpp_f<0x141>(v);
  v += dpp_f<0x140>(v);
  return (rdl_f(v, 0) + rdl_f(v, 16)) + (rdl_f(v, 32) + rdl_f(v, 48));
}
DEVFN float shfl_const_(float x, int ln) { return rdl_f(x, ln); }
DEVFN int shfl_const_(int x, int ln) { return __builtin_amdgcn_readlane(x, ln); }
#define SHFL_CONST(x, ln) shfl_const_(x, ln)
DEVFN float xor8_(float x, int m) { return m == 1 ? dpp_f<0xB1>(x) : m == 2 ? dpp_f<0x4E>(x) : dpp_f<0x141>(x); }
DEVFN int xor8_(int x, int m) { return m == 1 ? dpp_i<0xB1>(x) : m == 2 ? dpp_i<0x4E>(x) : dpp_i<0x141>(x); }
#define XOR8(x, m) xor8_(x, m)
#endif

constexpr size_t al(size_t x) { return (x + 255) & ~(size_t)255; }
struct Ws {
  static constexpr size_t BAR = 0;
  static constexpr size_t CNT = 16384;
  static constexpr size_t MOD = CNT + (size_t)DEPTH_ * 64 * 256;
  static constexpr size_t ZROW = al(MOD + (size_t)DEPTH_ * NR_ * NMOD_ * 4);
  static constexpr size_t ZERO_END = al(ZROW + 2048);
  static constexpr size_t MODP = ZERO_END;
  static constexpr size_t RWT = al(MODP + (size_t)16 * DEPTH_ * NR_ * NMOD_ * 4);
  static constexpr size_t LORA = al(RWT + (size_t)DEPTH_ * 64 * 1024 * 4);
  static constexpr size_t X = al(LORA + (size_t)DEPTH_ * 98304 * 2);
  static constexpr size_t U = al(X + (size_t)NT_ * 1024 * 4);
  static constexpr size_t YMIX = al(U + (size_t)NT_ * 1024 * 2);
  static constexpr size_t ZX = al(YMIX + (size_t)NT_ * 1024 * 2);
  static constexpr size_t MIX = ZX;
  static constexpr size_t LTOK = al(ZX + (size_t)NT_ * NIN_ * 2);
  static constexpr size_t LWT = al(LTOK + (size_t)64 * NT_ * 4);
  static constexpr size_t WIN = al(LWT + (size_t)64 * NT_ * 4);
  static constexpr size_t WOUT = al(WIN + (size_t)DEPTH_ * NIN_ * 1024 * 2);
  static constexpr size_t W13 = al(WOUT + (size_t)DEPTH_ * 1024 * 1024 * 2);
  static constexpr size_t W2T = al(W13 + (size_t)65 * 512 * 1024 * 2);
  static constexpr size_t UNI = al(W2T + (size_t)65 * 1024 * 256 * 2);
  static constexpr size_t XBC = UNI;
  static constexpr size_t XBCT = al(XBC + (size_t)NT_ * 1024 * 2);
  static constexpr size_t DTB = al(XBCT + (size_t)NT_ * 768 * 2);
  static constexpr size_t SST = al(DTB + (size_t)NT_ * 16 * 4);
  static constexpr size_t SCD = al(SST + (size_t)2 * NT_ / 128 * 8 * 8192 * 4);
  static constexpr size_t HIN = al(SCD + (size_t)2 * NT_ / 128 * 8 * 4);
  static constexpr size_t YS = SST;
  static constexpr size_t LA = al(HIN + (size_t)2 * NT_ / 128 * 8 * 8192 * 2);
  static constexpr size_t VT = al(LA + (size_t)2 * NT_ * 128 * 4);
  static constexpr size_t QT = al(VT + (size_t)NT_ * 256 * 2);
  static constexpr size_t OI = al(QT + (size_t)2 * NT_ * 128 * 2);
  static constexpr size_t GST = al(OI + (size_t)NT_ * 256 * 4);
  static constexpr size_t GCD = al(GST + (size_t)2 * NT_ / 64 * 4 * 2048 * 4);
  static constexpr size_t GSIN = al(GCD + (size_t)2 * NT_ / 64 * 4 * 32 * 4);
  static constexpr size_t RR = al(GSIN + (size_t)2 * NT_ / 64 * 4 * 2048 * 2);
  static constexpr size_t VV = RR + (size_t)NT_ * 256 * 2;
  static constexpr size_t KK = VV + (size_t)NT_ * 256 * 2;
  static constexpr size_t KD = KK + (size_t)NT_ * 256 * 2;
  static constexpr size_t BD = KD + (size_t)2 * NT_ * 256 * 2;
  static constexpr size_t LW = BD + (size_t)2 * NT_ * 256 * 2;
  static constexpr size_t GATE = LW + (size_t)2 * NT_ * 256 * 4;
  static constexpr size_t YR = GATE + (size_t)NT_ * 256 * 4;
  static constexpr size_t RML = al(YR + (size_t)2 * NT_ * 256 * 4);
  static constexpr size_t RNS = RML + (size_t)(NT_ / 16) * 8 * 4096 * 2;
  static constexpr size_t RWC = RNS + (size_t)(NT_ / 16) * 8 * 4096 * 2;
  static constexpr size_t RG = RWC + (size_t)(NT_ / 16) * 8 * 64 * 4;
  static constexpr size_t RY0 = RG + (size_t)(NT_ / 16) * 8 * 1024 * 2;
  static constexpr size_t LI = RY0 + (size_t)(NT_ / 16) * 8 * 1024 * 4;
  static constexpr size_t KRW = LI + (size_t)NT_ * 384 * 2;
  static constexpr size_t MIXER_END = KRW + (size_t)NT_ * 256 * 2;
  static constexpr size_t HID = UNI;
  static constexpr size_t YBUF = al(HID + ((size_t)NT_ * 9 + 65 * 128) * 256 * 2);
  static constexpr size_t MOE_END = YBUF + (size_t)NT_ * 9 * 1024 * 2;
  static constexpr size_t END = al(MIXER_END > MOE_END ? MIXER_END : MOE_END);
};

struct Params {
  const float* in[40];
  float* out;
  unsigned char* ws;
};
enum { I_X = 0, I_C, I_CTX, I_CCTX, I_ADAW, I_ADAB, I_WIN, I_CONVW, I_CONVB, I_DTBIAS, I_ALOG, I_SSDD, I_SSDNW, I_MU, I_W0, I_W2, I_A0, I_A2,
       I_G2, I_KKW, I_KAW, I_RK, I_LNXW, I_LNXB, I_GU, I_GB, I_GNW, I_WOUT, I_LN1W, I_LN1B, I_LN2W, I_LN2B, I_RW, I_RB, I_EW1, I_EW3, I_EW2,
       I_SW1, I_SW3, I_SW2 };

#define PH_SMEM 57344
#define SM_PRE (PH_SMEM)
#define SM_TAB (PH_SMEM + 1024)
#define SM_BAR (PH_SMEM + 2032)
#ifdef HIPEMU
#define INP(i) (p.in[i])
#define LAUNDER(x)
#define TIDX ((int)threadIdx.x)
#define BIDX ((int)blockIdx.x)
#define LAUNDER_V(x)
#define UNI(x) (x)
#else
extern __shared__ __align__(16) unsigned char smem_dyn[];
DEVFN const float* inp_lds(int i) {
  const volatile unsigned* t = (const volatile unsigned*)(smem_dyn + SM_TAB) + 2 * i;
  unsigned lo = __builtin_amdgcn_readfirstlane(t[0]), hi = __builtin_amdgcn_readfirstlane(t[1]);
  return (const float*)(((unsigned long long)hi << 32) | lo);
}
#define INP(i) inp_lds(i)
#define LAUNDER(x) asm volatile("" : "+s"(x))
DEVFN int tidx_() { int t = threadIdx.x; asm volatile("" : "+v"(t)); return t; }
DEVFN int bidx_() { int b = blockIdx.x; asm volatile("" : "+s"(b)); return b; }
#define TIDX tidx_()
#define LAUNDER_V(x) asm volatile("" : "+v"(x))
#define BIDX bidx_()
#define UNI(x) __builtin_amdgcn_readfirstlane(x)
#endif
#ifndef HIPEMU
#define XB_TMO      128
#define XB_XCNT(j)  (256  + 64 * (j))
#define XB_XSUB(j)  (1280 + 64 * (j))
#define XB_XGEN(j)  (2304 + 64 * (j))
#define XB_TOP      3328
#define XB_TOPGEN   3392
#define XCD_BAR_WORDS 3456
#define XB_SPIN_CAP (1u << 22)
#define LAS __attribute__((address_space(3)))
__device__ __forceinline__ unsigned xb_ld(unsigned* p)              { return __hip_atomic_load(p, __ATOMIC_RELAXED, __HIP_MEMORY_SCOPE_AGENT); }
__device__ __forceinline__ unsigned xb_add(unsigned* p, unsigned v) { return __hip_atomic_fetch_add(p, v, __ATOMIC_RELAXED, __HIP_MEMORY_SCOPE_AGENT); }
__device__ __forceinline__ unsigned xb_xcc_id() { return (unsigned)__builtin_amdgcn_s_getreg((3 << 11) | 20) & 0xFu; }
#define XB_SPIN(cond, bar) do { unsigned _sp = 0; while (cond) { __builtin_amdgcn_s_sleep(1); \
    if ((++_sp & 255u) == 0u) { if (xb_ld(&(bar)[XB_TMO])) break; if (_sp > XB_SPIN_CAP) { atomicAdd(&(bar)[XB_TMO], 1u); break; } } } } while (0)
struct XcdBarrier { unsigned* bar; unsigned x; volatile LAS unsigned* st; };
__device__ __forceinline__ XcdBarrier xcd_barrier_post(unsigned* bar, volatile LAS unsigned* st) {
    XcdBarrier b; b.bar = bar; b.x = xb_xcc_id(); b.st = st;
    if (threadIdx.x == 0) (void)xb_add(&bar[XB_XCNT(b.x)], 1u);
    return b;
}
__device__ __forceinline__ void xcd_barrier_complete(unsigned* bar, unsigned x, unsigned& nloc, unsigned& nx) {
    const unsigned G = gridDim.x * gridDim.y * gridDim.z;
    unsigned sum, cnt, mine, sp = 0u;
    for (;;) {
        sum = 0u; cnt = 0u; mine = 0u;
#pragma unroll
        for (unsigned j = 0; j < 16; ++j) { const unsigned c = xb_ld(&bar[XB_XCNT(j)]); sum += c; cnt += (c > 0u) ? 1u : 0u; mine = (j == x) ? c : mine; }
        if (sum == G) break;
        __builtin_amdgcn_s_sleep(1);
        if ((++sp & 255u) == 0u) { if (xb_ld(&bar[XB_TMO])) break; if (sp > XB_SPIN_CAP) { atomicAdd(&bar[XB_TMO], 1u); break; } }
    }
    nloc = mine > 0u ? mine : 1u; nx = cnt > 0u ? cnt : 1u;
}
__device__ __forceinline__ void xcd_barrier(const XcdBarrier& b) {
    asm volatile("s_waitcnt vmcnt(0)" ::: "memory");
    __syncthreads();
    if (threadIdx.x == 0) {
        unsigned* bar = b.bar;
        __builtin_amdgcn_s_waitcnt(0);
        unsigned nloc = b.st[0], nx = b.st[1];
        if (nloc == 0u) { xcd_barrier_complete(bar, b.x, nloc, nx); b.st[0] = nloc; b.st[1] = nx; }
        const unsigned old = xb_add(&bar[XB_XSUB(b.x)], 1u);
        const unsigned gen = old / nloc;
        if (old + 1u == (gen + 1u) * nloc) {
            __builtin_amdgcn_fence(__ATOMIC_RELEASE, "agent");
            asm volatile("s_waitcnt vmcnt(0)" ::: "memory");
            const unsigned og = xb_add(&bar[XB_TOP], 1u);
            const unsigned tg = og / nx;
            if (og + 1u == (tg + 1u) * nx) xb_add(&bar[XB_TOPGEN], 1u);
            else XB_SPIN(xb_ld(&bar[XB_TOPGEN]) == tg, bar);
            __builtin_amdgcn_fence(__ATOMIC_ACQUIRE, "agent");
            xb_add(&bar[XB_XGEN(b.x)], 1u);
            asm volatile("s_waitcnt vmcnt(0)" ::: "memory");
        } else {
            XB_SPIN(xb_ld(&bar[XB_XGEN(b.x)]) == gen, bar);
            __builtin_amdgcn_fence(__ATOMIC_ACQUIRE, "agent");
            asm volatile("s_waitcnt vmcnt(0)" ::: "memory");
        }
    }
    __syncthreads();
}
#endif

DEVFN int tokmap(int dir, int p) { return dir == 0 ? p : (p < CTX_ ? CTX_ - 1 - p : 2 * CTX_ + SEQ_ - 1 - p); }
DEVFN const float* tok_input_row(const Params& p, int tok) {
  int b = tok / T_, t = tok % T_;
  return t < CTX_ ? INP(I_CTX) + ((size_t)b * CTX_ + t) * D_ : INP(I_X) + ((size_t)b * SEQ_ + (t - CTX_)) * D_;
}
DEVFN int tok_modrow(int tok) { return (tok % T_) < CTX_ ? B_ : tok / T_; }

template <class ARow, class BRow, class Epi>
DEVFN void gemm_tile(unsigned char* smem, int K, ARow arow, BRow brow, Epi epi) {
  bf16_t* As = (bf16_t*)smem;
  bf16_t* Bs = As + 128 * LDT;
  const int tid = TIDX, lane = tid & 63, wave = tid >> 6, wr = wave >> 1, wc = wave & 1;
  const int g = lane >> 4, l15 = lane & 15;
  const int lr = tid >> 3, lc = (tid & 7) * 8;
  const AS1 bf16_t* ap[4];
  const AS1 bf16_t* bp[4];
#pragma unroll
  for (int i = 0; i < 4; ++i) { ap[i] = gptr(arow(lr + 32 * i)); bp[i] = gptr(brow(lr + 32 * i)); }
  f32x4 acc[4][4];
#pragma unroll
  for (int mi = 0; mi < 4; ++mi)
#pragma unroll
    for (int ni = 0; ni < 4; ++ni) acc[mi][ni] = f32x4{0.f, 0.f, 0.f, 0.f};
  u32x4 ra0[4], rb0[4], ra1[4], rb1[4];
#pragma unroll
  for (int i = 0; i < 4; ++i) { ra0[i] = *(const AS1 u32x4*)(ap[i] + lc); rb0[i] = *(const AS1 u32x4*)(bp[i] + lc); }
  if (K > 64) {
#pragma unroll
    for (int i = 0; i < 4; ++i) { ra1[i] = *(const AS1 u32x4*)(ap[i] + 64 + lc); rb1[i] = *(const AS1 u32x4*)(bp[i] + 64 + lc); } }
  auto compute = [&]() {
#pragma unroll
    for (int kk = 0; kk < 2; ++kk) {
      bf16x8 af[4], bfr[4];
#pragma unroll
      for (int mi = 0; mi < 4; ++mi) af[mi] = *(const bf16x8*)(As + (wr * 64 + mi * 16 + l15) * LDT + kk * 32 + g * 8);
#pragma unroll
      for (int ni = 0; ni < 4; ++ni) bfr[ni] = *(const bf16x8*)(Bs + (wc * 64 + ni * 16 + l15) * LDT + kk * 32 + g * 8);
#pragma unroll
      for (int mi = 0; mi < 4; ++mi)
#pragma unroll
        for (int ni = 0; ni < 4; ++ni) acc[mi][ni] = MFMA16(af[mi], bfr[ni], acc[mi][ni]);
    } };
  for (int k0 = 0; k0 < K; k0 += 128) {
    __syncthreads();
#pragma unroll
    for (int i = 0; i < 4; ++i) { *(u32x4*)(As + (lr + 32 * i) * LDT + lc) = ra0[i]; *(u32x4*)(Bs + (lr + 32 * i) * LDT + lc) = rb0[i]; }
    __syncthreads();
    if (k0 + 128 < K) {
#pragma unroll
      for (int i = 0; i < 4; ++i) { ra0[i] = *(const AS1 u32x4*)(ap[i] + k0 + 128 + lc); rb0[i] = *(const AS1 u32x4*)(bp[i] + k0 + 128 + lc); } }
    compute();
    if (k0 + 64 < K) {
      __syncthreads();
#pragma unroll
      for (int i = 0; i < 4; ++i) { *(u32x4*)(As + (lr + 32 * i) * LDT + lc) = ra1[i]; *(u32x4*)(Bs + (lr + 32 * i) * LDT + lc) = rb1[i]; }
      __syncthreads();
      if (k0 + 192 < K) {
#pragma unroll
        for (int i = 0; i < 4; ++i) { ra1[i] = *(const AS1 u32x4*)(ap[i] + k0 + 192 + lc); rb1[i] = *(const AS1 u32x4*)(bp[i] + k0 + 192 + lc); } }
      compute();
    }
  }
  epi(acc, wr, wc, g, l15);
}

template <int NB, class ARow, class BRow, class Epi>
DEVFN void gemm_tile_multi(unsigned char* smem, int K, ARow arow, BRow brow, Epi epi) {
  bf16_t* As = (bf16_t*)smem;
  bf16_t* Bs = As + 128 * LDT;
  const int tid = TIDX, lane = tid & 63, wave = tid >> 6, wr = wave >> 1, wc = wave & 1;
  const int g = lane >> 4, l15 = lane & 15;
  const int lr = tid >> 3, lc = (tid & 7) * 8;
  const AS1 bf16_t* ap[4];
  const AS1 bf16_t* bp[4];
#pragma unroll
  for (int i = 0; i < 4; ++i) { ap[i] = gptr(arow(lr + 32 * i)); bp[i] = gptr(brow(lr + 32 * i, 0)); }
  f32x4 acc[4][4];
  u32x4 ra0[4], rb0[4], ra1[4], rb1[4];
#pragma unroll
  for (int i = 0; i < 4; ++i) { ra0[i] = *(const AS1 u32x4*)(ap[i] + lc); rb0[i] = *(const AS1 u32x4*)(bp[i] + lc); }
  if (K > 64) {
#pragma unroll
    for (int i = 0; i < 4; ++i) { ra1[i] = *(const AS1 u32x4*)(ap[i] + 64 + lc); rb1[i] = *(const AS1 u32x4*)(bp[i] + 64 + lc); } }
  auto compute = [&]() {
#pragma unroll
    for (int kk = 0; kk < 2; ++kk) {
      bf16x8 af[4], bfr[4];
#pragma unroll
      for (int mi = 0; mi < 4; ++mi) af[mi] = *(const bf16x8*)(As + (wr * 64 + mi * 16 + l15) * LDT + kk * 32 + g * 8);
#pragma unroll
      for (int ni = 0; ni < 4; ++ni) bfr[ni] = *(const bf16x8*)(Bs + (wc * 64 + ni * 16 + l15) * LDT + kk * 32 + g * 8);
#pragma unroll
      for (int mi = 0; mi < 4; ++mi)
#pragma unroll
        for (int ni = 0; ni < 4; ++ni) acc[mi][ni] = MFMA16(af[mi], bfr[ni], acc[mi][ni]);
    } };
#pragma unroll
  for (int j = 0; j < NB; ++j) {
#pragma unroll
  for (int mi = 0; mi < 4; ++mi)
#pragma unroll
    for (int ni = 0; ni < 4; ++ni) acc[mi][ni] = f32x4{0.f, 0.f, 0.f, 0.f};
  for (int k0 = 0; k0 < K; k0 += 128) {
    __syncthreads();
#pragma unroll
    for (int i = 0; i < 4; ++i) { *(u32x4*)(As + (lr + 32 * i) * LDT + lc) = ra0[i]; *(u32x4*)(Bs + (lr + 32 * i) * LDT + lc) = rb0[i]; }
    __syncthreads();
    if (k0 + 128 < K) {
#pragma unroll
      for (int i = 0; i < 4; ++i) { ra0[i] = *(const AS1 u32x4*)(ap[i] + k0 + 128 + lc); rb0[i] = *(const AS1 u32x4*)(bp[i] + k0 + 128 + lc); } }
    compute();
    if (k0 + 64 < K) {
      __syncthreads();
#pragma unroll
      for (int i = 0; i < 4; ++i) { *(u32x4*)(As + (lr + 32 * i) * LDT + lc) = ra1[i]; *(u32x4*)(Bs + (lr + 32 * i) * LDT + lc) = rb1[i]; }
      __syncthreads();
      if (k0 + 192 < K) {
#pragma unroll
        for (int i = 0; i < 4; ++i) { ra1[i] = *(const AS1 u32x4*)(ap[i] + k0 + 192 + lc); rb1[i] = *(const AS1 u32x4*)(bp[i] + k0 + 192 + lc); } }
      compute();
    }
  }
  if (j + 1 < NB) {
#pragma unroll
    for (int i = 0; i < 4; ++i) { bp[i] = gptr(brow(lr + 32 * i, j + 1)); ra0[i] = *(const AS1 u32x4*)(ap[i] + lc); rb0[i] = *(const AS1 u32x4*)(bp[i] + lc); } }
  epi(acc, j, wr, wc, g, l15);
  if (j + 1 < NB) {
#pragma unroll
    for (int i = 0; i < 4; ++i) { ra1[i] = *(const AS1 u32x4*)(ap[i] + 64 + lc); rb1[i] = *(const AS1 u32x4*)(bp[i] + 64 + lc); } }
  }
}

template <int NB, int LDB, class ARow, class BBase, class Epi>
DEVFN void gemm_tile_w(unsigned char* smem, int K, ARow arow, BBase bbase, Epi epi) {
  bf16_t* As = (bf16_t*)smem;
  bf16_t* Bs = As + 128 * LDT;
  const int tid = TIDX, lane = tid & 63, wave = tid >> 6, wr = wave >> 1, wc = wave & 1;
  const int g = lane >> 4, l15 = lane & 15;
  const int lr = tid >> 3, lc = (tid & 7) * 8;
  const AS1 bf16_t* ap[4];
#pragma unroll
  for (int i = 0; i < 4; ++i) ap[i] = gptr(arow(lr + 32 * i));
  const AS1 bf16_t* bb = gptr(bbase(0));
  const unsigned boff = (unsigned)(lr * LDB + lc);
  f32x4 acc[4][8];
  u32x4 ra[4], rb[8];
#pragma unroll
  for (int i = 0; i < 4; ++i) ra[i] = *(const AS1 u32x4*)(ap[i] + lc);
#pragma unroll
  for (int i = 0; i < 8; ++i) rb[i] = *(const AS1 u32x4*)(bb + (size_t)(i * 32 * LDB) + boff);
#pragma unroll
  for (int j = 0; j < NB; ++j) {
#pragma unroll
    for (int mi = 0; mi < 4; ++mi)
#pragma unroll
      for (int ni = 0; ni < 8; ++ni) acc[mi][ni] = f32x4{0.f, 0.f, 0.f, 0.f};
#pragma unroll 1
    for (int k0 = 0; k0 < K; k0 += 64) {
      __syncthreads();
#pragma unroll
      for (int i = 0; i < 4; ++i) *(u32x4*)(As + (lr + 32 * i) * LDT + lc) = ra[i];
#pragma unroll
      for (int i = 0; i < 8; ++i) *(u32x4*)(Bs + (lr + 32 * i) * LDT + lc) = rb[i];
      __syncthreads();
      if (k0 + 64 < K) {
#pragma unroll
        for (int i = 0; i < 4; ++i) ra[i] = *(const AS1 u32x4*)(ap[i] + k0 + 64 + lc);
#pragma unroll
        for (int i = 0; i < 8; ++i) rb[i] = *(const AS1 u32x4*)(bb + (size_t)(i * 32 * LDB + k0 + 64) + boff);
      }
#pragma unroll
      for (int kk = 0; kk < 2; ++kk) {
        bf16x8 af[4];
#pragma unroll
        for (int mi = 0; mi < 4; ++mi) af[mi] = *(const bf16x8*)(As + (wr * 64 + mi * 16 + l15) * LDT + kk * 32 + g * 8);
#pragma unroll
        for (int h = 0; h < 2; ++h) {
          bf16x8 bfr[4];
#pragma unroll
          for (int ni = 0; ni < 4; ++ni) bfr[ni] = *(const bf16x8*)(Bs + (wc * 128 + h * 64 + ni * 16 + l15) * LDT + kk * 32 + g * 8);
#pragma unroll
          for (int mi = 0; mi < 4; ++mi)
#pragma unroll
            for (int ni = 0; ni < 4; ++ni) acc[mi][h * 4 + ni] = MFMA16(af[mi], bfr[ni], acc[mi][h * 4 + ni]);
        }
      }
    }
    if (j + 1 < NB) {
      bb = gptr(bbase(j + 1));
#pragma unroll
      for (int i = 0; i < 4; ++i) ra[i] = *(const AS1 u32x4*)(ap[i] + lc);
#pragma unroll
      for (int i = 0; i < 8; ++i) rb[i] = *(const AS1 u32x4*)(bb + (size_t)(i * 32 * LDB) + boff); }
    epi(acc, j, wr, wc, g, l15);
  }
}

template <int NCH, class Val, class RowP>
DEVFN void tile_store_bf16(unsigned char* smem, int wr, int g, int l15, Val val, RowP rowp) {
  constexpr int LDC = NCH * 8 + 8;
  bf16_t* T = (bf16_t*)smem;
  const int tid = TIDX;
  __syncthreads();
  val(T, LDC);
  __syncthreads();
#pragma unroll
  for (int pass = 0; pass < NCH / 2; ++pass) { const int id = tid + 256 * pass, row = id / NCH, c = id % NCH;
    bf16_t* dst = rowp(row, c * 8);
    if (dst) *(AS1 u32x4*)gptr(dst) = *(const u32x4*)(T + row * LDC + c * 8); }
  (void)wr; (void)g; (void)l15;
}
DEVFN void cvt_tile(unsigned char* smem, const float* src, int K, int N, int k0, int n0, bf16_t* dst, int ldd, int mode) {
  float* s = (float*)smem;
  const int tid = TIDX;
  const AS1 float* gsrc = gptr(src);
  __syncthreads();
  { const int kk = tid >> 4, n4 = (tid & 15) * 4;
#pragma unroll
    for (int pass = 0; pass < 4; ++pass) { const int k = kk + 16 * pass;
      f32x4 v = f32x4{0.f, 0.f, 0.f, 0.f};
      if (n0 + n4 < N) v = *(const AS1 f32x4*)(gsrc + (size_t)(k0 + k) * N + n0 + n4);
      s[k * 65 + n4] = v[0]; s[k * 65 + n4 + 1] = v[1]; s[k * 65 + n4 + 2] = v[2]; s[k * 65 + n4 + 3] = v[3]; } }
  __syncthreads();
  { const int nn = tid >> 2, k16 = (tid & 3) * 16, n = n0 + nn;
    if (n < N) { const int row = mode == 0 ? n : ((n >> 4) * 32 + (n & 15) + (mode == 2 ? 16 : 0));
      u32x4 o0, o1;
#pragma unroll
      for (int j = 0; j < 4; ++j) { o0[j] = (unsigned)f2bf(s[(k16 + 2 * j) * 65 + nn]) | ((unsigned)f2bf(s[(k16 + 2 * j + 1) * 65 + nn]) << 16);
        o1[j] = (unsigned)f2bf(s[(k16 + 8 + 2 * j) * 65 + nn]) | ((unsigned)f2bf(s[(k16 + 9 + 2 * j) * 65 + nn]) << 16); }
      AS1 bf16_t* d = gptr(dst) + (size_t)row * ldd + k0 + k16;
      *(AS1 u32x4*)d = o0; *(AS1 u32x4*)(d + 8) = o1; } }
  (void)K;
}
struct CvtJob { const float* src; bf16_t* dst; int N, k0, n0, ldd, mode; };
DEVFN void cvt_load(const CvtJob& j, f32x4 (&v)[4]) {
  const int tid = TIDX, kk = tid >> 4, n4 = (tid & 15) * 4;
  const AS1 float* g = gptr(j.src);
#pragma unroll
  for (int pass = 0; pass < 4; ++pass) { v[pass] = f32x4{0.f, 0.f, 0.f, 0.f};
    if (j.n0 + n4 < j.N) v[pass] = *(const AS1 f32x4*)(g + (size_t)(j.k0 + kk + 16 * pass) * j.N + j.n0 + n4); }
}
DEVFN void cvt_store(unsigned char* smem, const CvtJob& j, const f32x4 (&v)[4]) {
  float* s = (float*)smem;
  const int tid = TIDX, kk = tid >> 4, n4 = (tid & 15) * 4;
  __syncthreads();
#pragma unroll
  for (int pass = 0; pass < 4; ++pass) { const int k = kk + 16 * pass; s[k * 65 + n4] = v[pass][0]; s[k * 65 + n4 + 1] = v[pass][1]; s[k * 65 + n4 + 2] = v[pass][2]; s[k * 65 + n4 + 3] = v[pass][3]; }
  __syncthreads();
  const int nn = tid >> 2, k16 = (tid & 3) * 16, n = j.n0 + nn;
  if (n < j.N) { const int row = j.mode == 0 ? n : ((n >> 4) * 32 + (n & 15) + (j.mode == 2 ? 16 : 0));
    u32x4 o0, o1;
#pragma unroll
    for (int q = 0; q < 4; ++q) { o0[q] = (unsigned)f2bf(s[(k16 + 2 * q) * 65 + nn]) | ((unsigned)f2bf(s[(k16 + 2 * q + 1) * 65 + nn]) << 16);
      o1[q] = (unsigned)f2bf(s[(k16 + 8 + 2 * q) * 65 + nn]) | ((unsigned)f2bf(s[(k16 + 9 + 2 * q) * 65 + nn]) << 16); }
    AS1 bf16_t* d = gptr(j.dst) + (size_t)row * j.ldd + j.k0 + k16;
    *(AS1 u32x4*)d = o0; *(AS1 u32x4*)(d + 8) = o1; }
}
DEVFN CvtJob moe_cvt_job(const Params& p, int l, int u) {
  bf16_t* w13 = (bf16_t*)(p.ws + Ws::W13); bf16_t* w2t = (bf16_t*)(p.ws + Ws::W2T);
  const int e = u / 192, r = u % 192, which = r / 64, t = r % 64;
  CvtJob j;
  if (which < 2) {
    j.src = e < 64 ? (which == 0 ? INP(I_EW1) : INP(I_EW3)) + ((size_t)l * 64 + e) * 1024 * 256 : (which == 0 ? INP(I_SW1) : INP(I_SW3)) + (size_t)l * 1024 * 256;
    j.N = 256; j.k0 = (t >> 2) * 64; j.n0 = (t & 3) * 64; j.dst = w13 + (size_t)e * 512 * 1024; j.ldd = 1024; j.mode = which == 0 ? 1 : 2;
  } else {
    j.src = e < 64 ? INP(I_EW2) + ((size_t)l * 64 + e) * 256 * 1024 : INP(I_SW2) + (size_t)l * 256 * 1024;
    j.N = 1024; j.k0 = (t >> 4) * 64; j.n0 = (t & 15) * 64; j.dst = w2t + (size_t)e * 1024 * 256; j.ldd = 256; j.mode = 0;
  }
  return j;
}
DEVFN void convert_moe_weights(const Params& p, int l, unsigned char* smem, int bid, int nb, int j_lo, int j_hi) {
  if (j_lo + bid >= j_hi) return;
  f32x4 v[4], vn[4];
  CvtJob j = moe_cvt_job(p, l, j_lo + bid);
  cvt_load(j, v);
  for (int u = j_lo + bid; u < j_hi; u += nb) {
    const int un = u + nb;
    CvtJob jn = j;
    if (un < j_hi) { jn = moe_cvt_job(p, l, un); cvt_load(jn, vn); }
    cvt_store(smem, j, v);
    j = jn;
#pragma unroll
    for (int q = 0; q < 4; ++q) v[q] = vn[q];
  }
}
DEVFN void phase0(const Params& p, unsigned char* smem) {
  const int tid = TIDX;
  float* modp = (float*)(p.ws + Ws::MODP);
  for (int u = BIDX; u < DEPTH_ * 24 * 16; u += gridDim.x) {
    int l = u / (24 * 16), jb = (u / 16) % 24, ks = u % 16;
    float* sc = (float*)smem;
    __syncthreads();
    for (int e = tid; e < NR_ * 64; e += 256) { int r = e / 64, i = ks * 64 + (e % 64); float cv = r < B_ ? INP(I_C)[(size_t)r * D_ + i] : INP(I_CCTX)[i]; sc[e] = siluf_(cv); }
    __syncthreads();
    int j = jb * 256 + tid;
    float acc[NR_];
#pragma unroll
    for (int r = 0; r < NR_; ++r) acc[r] = 0.f;
    const float* w = INP(I_ADAW) + ((size_t)l * D_ + ks * 64) * NMOD_ + j;
#pragma unroll 4
    for (int i = 0; i < 64; ++i) { float wv = w[(size_t)i * NMOD_];
#pragma unroll
      for (int r = 0; r < NR_; ++r) acc[r] += sc[r * 64 + i] * wv; }
#pragma unroll
    for (int r = 0; r < NR_; ++r) modp[(((size_t)ks * DEPTH_ + l) * NR_ + r) * NMOD_ + j] = acc[r];
  }
  bf16_t* win = (bf16_t*)(p.ws + Ws::WIN);
  bf16_t* wout = (bf16_t*)(p.ws + Ws::WOUT);
  for (int u = BIDX; u < DEPTH_ * 16 * 55; u += gridDim.x) {
    int l = u / (16 * 55), r = u % (16 * 55);
    cvt_tile(smem, INP(I_WIN) + (size_t)l * 1024 * NIN_, 1024, NIN_, (r / 55) * 64, (r % 55) * 64, win + (size_t)l * NIN_ * 1024, 1024, 0);
  }
  for (int u = BIDX; u < DEPTH_ * 256; u += gridDim.x) {
    int l = u / 256, r = u % 256;
    cvt_tile(smem, INP(I_WOUT) + (size_t)l * 1024 * 1024, 1024, 1024, (r / 16) * 64, (r % 16) * 64, wout + (size_t)l * 1024 * 1024, 1024, 0);
  }
  { bf16_t* lo = (bf16_t*)(p.ws + Ws::LORA);
    for (int u = BIDX * 256 + tid; u < DEPTH_ * 98304; u += gridDim.x * 256) {
      const int l = u / 98304, r = u % 98304; float v;
      if (r < 32768) { const int d = r >> 14, n = (r >> 6) & 255, k = r & 63; v = INP(I_W2)[(((size_t)l * 2 + d) * 64 + k) * 256 + n]; }
      else if (r < 65536) { const int r2 = r - 32768, d = r2 >> 14, n = (r2 >> 6) & 255, k = r2 & 63; v = INP(I_A2)[(((size_t)l * 2 + d) * 64 + k) * 256 + n]; }
      else { const int r2 = r - 65536, n = r2 >> 7, k = r2 & 127; v = INP(I_G2)[((size_t)l * 128 + k) * 256 + n]; }
      lo[u] = f2bf(v); } }
  float* rwt = (float*)(p.ws + Ws::RWT);
  for (int u = BIDX * 256 + tid; u < DEPTH_ * 64 * 1024; u += gridDim.x * 256) {
    int l = u / (64 * 1024), e = (u / 1024) % 64, i = u % 1024;
    rwt[u] = INP(I_RW)[((size_t)l * 1024 + i) * 64 + e];
  }
}

DEVFN void phase0b(const Params& p) {
  float* mod = (float*)(p.ws + Ws::MOD); const float* modp = (const float*)(p.ws + Ws::MODP);
  for (int u = BIDX * 256 + TIDX; u < DEPTH_ * NR_ * NMOD_; u += gridDim.x * 256) {
    int l = u / (NR_ * NMOD_), j = u % NMOD_;
    float s = INP(I_ADAB)[(size_t)l * NMOD_ + j];
    for (int ks = 0; ks < 16; ++ks) s += modp[(size_t)ks * DEPTH_ * NR_ * NMOD_ + u];
    mod[u] = s;
  }
}

DEVFN void row_stats(const float (&v)[16], float& mean, float& rstd) {
  float s = 0.f;
#pragma unroll
  for (int i = 0; i < 16; ++i) s += v[i];
  mean = wave_sum(s) * (1.f / 1024.f);
  float q = 0.f;
#pragma unroll
  for (int i = 0; i < 16; ++i) { float d = v[i] - mean; q += d * d; }
  rstd = rsqrtf(wave_sum(q) * (1.f / 1024.f) + 1e-5f);
}
DEVFN void load_row16(const float* row, int lane, float (&v)[16]) {
  const AS1 float* r = gptr(row);
#pragma unroll
  for (int j = 0; j < 4; ++j) { const f32x4 t = *(const AS1 f32x4*)(r + lane * 4 + 256 * j); v[4 * j] = t[0]; v[4 * j + 1] = t[1]; v[4 * j + 2] = t[2]; v[4 * j + 3] = t[3]; }
}
DEVFN void moe_residual_row(const Params& p, int lp, int tok, int lane, float (&xv)[16]) {
  const float* mod = (const float*)(p.ws + Ws::MOD) + ((size_t)lp * NR_ + tok_modrow(tok)) * NMOD_;
  const bf16_t* yb = (const bf16_t*)(p.ws + Ws::YBUF) + (size_t)tok * NSLOT * 1024;
  float g2[16], w[16], b[16];
  load_row16(mod + 5 * 1024, lane, g2);
  load_row16(INP(I_LN2W) + (size_t)lp * 1024, lane, w);
  load_row16(INP(I_LN2B) + (size_t)lp * 1024, lane, b);
  u32x2 sl[NSLOT][4];
#pragma unroll
  for (int s = 0; s < NSLOT; ++s)
#pragma unroll
    for (int j = 0; j < 4; ++j) sl[s][j] = *(const AS1 u32x2*)gptr(yb + (size_t)s * 1024 + lane * 4 + 256 * j);
  float f[16];
#pragma unroll
  for (int i = 0; i < 16; ++i) f[i] = 0.f;
#pragma unroll
  for (int s = 0; s < NSLOT; ++s)
#pragma unroll
    for (int j = 0; j < 4; ++j) { const u32x2 t = sl[s][j];
      f[4 * j] += bf2f((bf16_t)(t[0] & 0xFFFF)); f[4 * j + 1] += bf2f((bf16_t)(t[0] >> 16)); f[4 * j + 2] += bf2f((bf16_t)(t[1] & 0xFFFF)); f[4 * j + 3] += bf2f((bf16_t)(t[1] >> 16)); }
#pragma unroll
  for (int i = 0; i < 16; ++i) xv[i] = ALPHA_ * xv[i] + g2[i] * f[i];
  float mean, rstd;
  row_stats(xv, mean, rstd);
#pragma unroll
  for (int i = 0; i < 16; ++i) xv[i] = (xv[i] - mean) * rstd * w[i] + b[i];
}
DEVFN void phase1(const Params& p, int l) {
  const int lane = TIDX & 63, wave = TIDX >> 6;
  float* X = (float*)(p.ws + Ws::X);
  bf16_t* U = (bf16_t*)(p.ws + Ws::U);
  for (int tok = BIDX * 4 + wave; tok < NT_; tok += gridDim.x * 4) {
    float xv[16], sh[16], sc[16], mean, rstd;
    const float* mod = (const float*)(p.ws + Ws::MOD) + ((size_t)l * NR_ + tok_modrow(tok)) * NMOD_;
    load_row16(mod, lane, sh);
    load_row16(mod + 1024, lane, sc);
    if (l == 0) load_row16(tok_input_row(p, tok), lane, xv);
    else { load_row16(X + (size_t)tok * 1024, lane, xv); moe_residual_row(p, l - 1, tok, lane, xv); }
#pragma unroll
    for (int j = 0; j < 4; ++j) *(float4*)(X + (size_t)tok * 1024 + lane * 4 + 256 * j) = make_float4(xv[4 * j], xv[4 * j + 1], xv[4 * j + 2], xv[4 * j + 3]);
    row_stats(xv, mean, rstd);
#pragma unroll
    for (int j = 0; j < 4; ++j) {
      float u0 = (xv[4 * j] - mean) * rstd * (1.f + sc[4 * j]) + sh[4 * j], u1 = (xv[4 * j + 1] - mean) * rstd * (1.f + sc[4 * j + 1]) + sh[4 * j + 1];
      float u2 = (xv[4 * j + 2] - mean) * rstd * (1.f + sc[4 * j + 2]) + sh[4 * j + 2], u3 = (xv[4 * j + 3] - mean) * rstd * (1.f + sc[4 * j + 3]) + sh[4 * j + 3];
      *(uint2*)(U + (size_t)tok * 1024 + lane * 4 + 256 * j) = make_uint2((unsigned)f2bf(u0) | ((unsigned)f2bf(u1) << 16), (unsigned)f2bf(u2) | ((unsigned)f2bf(u3) << 16));
    }
  }
}
DEVFN void phase_final(const Params& p) {
  const int lane = TIDX & 63, wave = TIDX >> 6;
  const float* X = (const float*)(p.ws + Ws::X);
  for (int r = BIDX * 4 + wave; r < B_ * SEQ_; r += gridDim.x * 4) {
    int b = r / SEQ_, s = r % SEQ_, tok = b * T_ + CTX_ + s;
    float xv[16];
    load_row16(X + (size_t)tok * 1024, lane, xv);
    moe_residual_row(p, DEPTH_ - 1, tok, lane, xv);
#pragma unroll
    for (int j = 0; j < 4; ++j) *(float4*)(p.out + (size_t)r * 1024 + lane * 4 + 256 * j) = make_float4(xv[4 * j], xv[4 * j + 1], xv[4 * j + 2], xv[4 * j + 3]);
  }
}

DEVFN void phase2(const Params& p, int l, unsigned char* smem) {
  const bf16_t* U = (const bf16_t*)(p.ws + Ws::U);
  const bf16_t* W = (const bf16_t*)(p.ws + Ws::WIN) + (size_t)l * NIN_ * 1024;
  bf16_t* ZX = (bf16_t*)(p.ws + Ws::ZX);
  const int nct = (NIN_ + 255) / 256;
  for (int u = BIDX; u < (NT_ / 128) * nct; u += gridDim.x) {
    int rt = u / nct, ct = u % nct;
    gemm_tile_w<1, 1024>(smem, 1024,
      [&](int r) { return U + (size_t)(rt * 128 + r) * 1024; },
      [&](int) { return W + (size_t)(ct * 256) * 1024; },
      [&](f32x4 (&acc)[4][8], int, int wr, int wc, int g, int l15) {
#pragma unroll 1
        for (int h = 0; h < 2; ++h)
          tile_store_bf16<16>(smem, wr, g, l15,
            [&](bf16_t* T, int ldc) {
              if (wc == h) {
#pragma unroll
                for (int mi = 0; mi < 4; ++mi)
#pragma unroll
                  for (int ni = 0; ni < 8; ++ni)
#pragma unroll
                    for (int i = 0; i < 4; ++i) T[(wr * 64 + mi * 16 + 4 * g + i) * ldc + ni * 16 + l15] = f2bf(acc[mi][ni][i]); } },
            [&](int row, int c0) { const int col = ct * 256 + h * 128 + c0; return col < NIN_ ? ZX + (size_t)(rt * 128 + row) * NIN_ + col : (bf16_t*)nullptr; });
      });
  }
}

DEVFN float zxv(const bf16_t* ZX, int tok, int col) { return bf2f(gptr(ZX)[(size_t)tok * NIN_ + col]); }
struct Nbr { int n; int tok[4]; };
DEVFN Nbr shift_nbrs(int tok) {
  Nbr nb; int b = tok / T_, t = tok % T_;
  if (t < CTX_) { nb.n = 2; nb.tok[0] = t > 0 ? tok - 1 : -1; nb.tok[1] = t < CTX_ - 1 ? tok + 1 : -1; nb.tok[2] = -1; nb.tok[3] = -1; }
  else { int s = t - CTX_, row = s / 64, col = s % 64; nb.n = 4; nb.tok[0] = col > 0 ? tok - 1 : -1; nb.tok[1] = col < 63 ? tok + 1 : -1;
    nb.tok[2] = row > 0 ? tok - 64 : -1; nb.tok[3] = row < SEQ_ / 64 - 1 ? tok + 64 : -1; }
  (void)b; return nb;
}
DEVFN float shiftmix(const bf16_t* ZX, const float* mu, int tok, const Nbr& nb, int ch) {
  float z = zxv(ZX, tok, ORW + ch), o = z;
#pragma unroll
  for (int j = 0; j < 4; ++j) if (j < nb.n) { float v = nb.tok[j] >= 0 ? zxv(ZX, nb.tok[j], ORW + ch) : 0.f; o += mu[j * 1152 + ch] * (v - z); }
  return o;
}
#define LI_LD 392
#define KL_LD 264
DEVFN void phase3(const Params& p, int l, unsigned char* smem) {
  const int tid = TIDX, lane = tid & 63, wave = tid >> 6, q = lane >> 4, l15 = lane & 15;
  const bf16_t* ZX = (const bf16_t*)(p.ws + Ws::ZX);
  bf16_t* XBC = (bf16_t*)(p.ws + Ws::XBC); float* DTB = (float*)(p.ws + Ws::DTB);
  bf16_t* RR = (bf16_t*)(p.ws + Ws::RR); bf16_t* VV = (bf16_t*)(p.ws + Ws::VV); bf16_t* KKb = (bf16_t*)(p.ws + Ws::KK);
  bf16_t* KRW = (bf16_t*)(p.ws + Ws::KRW); bf16_t* LIg = (bf16_t*)(p.ws + Ws::LI);
  float* LA = (float*)(p.ws + Ws::LA);
  const float* convw = INP(I_CONVW) + (size_t)l * 3 * 1024; const float* convb = INP(I_CONVB) + (size_t)l * 1024;
  const float* mu = INP(I_MU) + (size_t)l * 4 * 1152;
  float* gdl = (float*)smem;
  const float kkw = INP(I_KKW)[(size_t)l * 256 + tid];
  unsigned* ctr = (unsigned*)(p.ws + Ws::BAR) + l * 32 + 8;
  volatile int* nxt_s = (volatile int*)(smem + SM_PRE);
  int wu = BIDX;
  while (wu < 6 * (NT_ / 16)) {
    int nxt = 0;
    if (TIDX == 0) nxt = (int)gridDim.x + (int)atomicAdd(ctr, 1u);
    const int part = wu < NT_ / 16 ? 0 : 1, tile = wu < NT_ / 16 ? wu : (wu - NT_ / 16) / 5, gsel = wu < NT_ / 16 ? 0 : (wu - NT_ / 16) % 5;
    const int tok0 = tile * 16, t0 = tok0 % T_, bb = tok0 / T_;
    const bool isctx = t0 < CTX_;
    const int s0 = t0 - CTX_;
    const bool lval = isctx ? (t0 > 0) : ((s0 & 63) != 0), rval = isctx ? (t0 + 16 < CTX_) : ((s0 & 63) != 48);
    const bool uval = !isctx && (s0 >= 64), dval = !isctx && (s0 + 64 < SEQ_);
    if (part == 0) {
    __syncthreads();
    {
      const bool segstart = (t0 == 0 || t0 == CTX_), segend = (t0 + 16 == CTX_ || t0 + 16 == T_);
      bf16_t* XBCT = (bf16_t*)(p.ws + Ws::XBCT) + ((size_t)(bb * NC128 + t0 / 128) * 768) * 128 + (t0 % 128);
      bf16_t vv16[16];
      { const AS1 bf16_t* vp = gptr(ZX) + (size_t)tok0 * NIN_ + OGV + tid;
#pragma unroll
        for (int i = 0; i < 16; ++i) { vv16[i] = *vp; vp += NIN_; LAUNDER_V(vp); } }
      const float dtv = zxv(ZX, tok0 + (tid >> 4), ODT + (tid & 15)), gd0 = zxv(ZX, tok0 + (tid >> 5), OGD + (tid & 31)), gd1 = zxv(ZX, tok0 + 8 + (tid >> 5), OGD + (tid & 31));
#pragma unroll 1
      for (int jp = 0; jp < 2; ++jp) {
        float z[2][18];
#pragma unroll
        for (int jj = 0; jj < 2; ++jj) { const int c = tid + 256 * (2 * jp + jj);
          const AS1 bf16_t* zp = gptr(ZX) + (size_t)tok0 * NIN_ + OXBC + c - NIN_;
#pragma unroll
          for (int i = 0; i < 18; ++i) { z[jj][i] = ((i == 0 && segstart) || (i == 17 && segend)) ? 0.f : bf2f(*zp); zp += NIN_; LAUNDER_V(zp); } }
#pragma unroll
        for (int jj = 0; jj < 2; ++jj) { const int c = tid + 256 * (2 * jp + jj);
          AS1 bf16_t* xp = gptr(XBC) + (size_t)tok0 * 1024 + c;
          const float w0 = convw[c], w1 = convw[1024 + c], w2 = convw[2048 + c], cb = convb[c];
          bf16_t y[16];
#pragma unroll
          for (int i = 0; i < 16; ++i) { y[i] = f2bf(siluf_(cb + w0 * z[jj][i] + w1 * z[jj][i + 1] + w2 * z[jj][i + 2])); *xp = y[i]; xp += 1024; LAUNDER_V(xp); }
          if (c < 768) {
            u32x4 o0, o1;
#pragma unroll
            for (int i = 0; i < 4; ++i) { o0[i] = (unsigned)y[2 * i] | ((unsigned)y[2 * i + 1] << 16); o1[i] = (unsigned)y[8 + 2 * i] | ((unsigned)y[9 + 2 * i] << 16); }
            *(u32x4*)(XBCT + (size_t)c * 128) = o0; *(u32x4*)(XBCT + (size_t)c * 128 + 8) = o1; } } }
      { bf16_t* VTp = (bf16_t*)(p.ws + Ws::VT) + ((size_t)(bb * NC64 + t0 / 64) * 256 + tid) * 64 + (t0 % 64);
        u32x4 o0, o1;
#pragma unroll
        for (int i = 0; i < 4; ++i) { o0[i] = (unsigned)vv16[2 * i] | ((unsigned)vv16[2 * i + 1] << 16); o1[i] = (unsigned)vv16[8 + 2 * i] | ((unsigned)vv16[9 + 2 * i] << 16); }
        *(u32x4*)VTp = o0; *(u32x4*)(VTp + 8) = o1; }
      DTB[(size_t)tok0 * 16 + tid] = softplusf_(dtv + INP(I_DTBIAS)[(size_t)l * 16 + (tid & 15)]);
      gdl[tid] = gd0; gdl[256 + tid] = gd1;
    }
    } else {
    { const int g = gsel;
      const bool act = !(g == 4 && tid >= 128);
      const int ch = act ? g * 256 + tid : 0;
      const AS1 bf16_t* zp0 = gptr(ZX) + (size_t)tok0 * NIN_ + ORW + ch;
      const AS1 bf16_t* zp = zp0 - NIN_;
      const float m0 = mu[ch], m1 = mu[1152 + ch], m2 = mu[2304 + ch], m3 = mu[3456 + ch];
      float z[18], zu[16], zd[16], o[16];
      const AS1 bf16_t* up = uval ? zp0 - (size_t)64 * NIN_ : zp0; const AS1 bf16_t* dn = dval ? zp0 + (size_t)64 * NIN_ : zp0;
      const float um = uval ? 1.f : 0.f, dm = dval ? 1.f : 0.f, m2v = isctx ? 0.f : m2, m3v = isctx ? 0.f : m3;
#pragma unroll
      for (int i = 0; i < 18; ++i) { z[i] = ((i == 0 && !lval) || (i == 17 && !rval)) ? 0.f : bf2f(*zp); zp += NIN_; LAUNDER_V(zp); }
#pragma unroll
      for (int i = 0; i < 16; ++i) { zu[i] = bf2f(*up); zd[i] = bf2f(*dn); up += NIN_; dn += NIN_; LAUNDER_V(up); LAUNDER_V(dn); }
#pragma unroll
      for (int i = 0; i < 16; ++i) o[i] = z[i + 1] + m0 * (z[i] - z[i + 1]) + m1 * (z[i + 2] - z[i + 1]) + m2v * (zu[i] * um - z[i + 1]) + m3v * (zd[i] * dm - z[i + 1]);
      if (g == 0) { AS1 bf16_t* rp = gptr(RR) + (size_t)tok0 * 256 + tid;
#pragma unroll
        for (int i = 0; i < 16; ++i) { *rp = f2bf(o[i]); rp += 256; LAUNDER_V(rp); }
      } else if (g == 1) { AS1 bf16_t* kp = gptr(KKb) + (size_t)tok0 * 256 + tid; AS1 bf16_t* krp = gptr(KRW) + (size_t)tok0 * 256 + tid;
#pragma unroll
        for (int i = 0; i < 16; ++i) { const float kq = o[i] * kkw, nrm = sqrtf(wave_sum(kq * kq));
          *kp = f2bf(kq / fmaxf(nrm, 1e-12f)); *krp = f2bf(o[i]); kp += 256; krp += 256; LAUNDER_V(kp); LAUNDER_V(krp); }
      } else if (g == 2) { AS1 bf16_t* vp2 = gptr(VV) + (size_t)tok0 * 256 + tid;
#pragma unroll
        for (int i = 0; i < 16; ++i) { *vp2 = f2bf(o[i]); vp2 += 256; LAUNDER_V(vp2); }
      } else if (g == 3) { AS1 bf16_t* lp = gptr(LIg) + (size_t)tok0 * 384 + tid;
#pragma unroll
        for (int i = 0; i < 16; ++i) { *lp = f2bf(tid < 128 ? tanhf(o[i]) : o[i]); lp += 384; LAUNDER_V(lp); }
      } else if (act) { AS1 bf16_t* lp = gptr(LIg) + (size_t)tok0 * 384 + 256 + tid;
#pragma unroll
        for (int i = 0; i < 16; ++i) { *lp = f2bf(sigmoidf_(o[i])); lp += 384; LAUNDER_V(lp); }
      }
    }
    }
    if (part == 0) {
    __syncthreads();
    { const int d = tid >> 7, c = tid & 127; const float* gu = INP(I_GU) + ((size_t)l * 2 + d) * 16 * 128; const float gb = INP(I_GB)[((size_t)l * 2 + d) * 128 + c];
      float guw[16];
#pragma unroll
      for (int i = 0; i < 16; ++i) guw[i] = gu[i * 128 + c];
#pragma unroll 4
      for (int tt = 0; tt < 16; ++tt) { float sacc = gb;
#pragma unroll
        for (int i = 0; i < 16; ++i) sacc += gdl[tt * 32 + d * 16 + i] * guw[i];
        LA[((size_t)d * NT_ + tok0 + tt) * 128 + c] = logsigmoidf_(sacc) * (1.f / 16.f); } }
    }
    __syncthreads();
    if (TIDX == 0) *nxt_s = nxt;
    __syncthreads();
    wu = *nxt_s;
  }
}

DEVFN void phase3b(const Params& p, int l, unsigned char* smem) {
  const bf16_t* LIg = (const bf16_t*)(p.ws + Ws::LI);
  const bf16_t* lora = (const bf16_t*)(p.ws + Ws::LORA) + (size_t)l * 98304;
  const bf16_t* KRg = (const bf16_t*)(p.ws + Ws::KRW); const bf16_t* KKg = (const bf16_t*)(p.ws + Ws::KK);
  float* LWp = (float*)(p.ws + Ws::LW); bf16_t* KD = (bf16_t*)(p.ws + Ws::KD); bf16_t* BD = (bf16_t*)(p.ws + Ws::BD); float* GATE = (float*)(p.ws + Ws::GATE);
  for (int u = BIDX; u < (NT_ / 128) * 10; u += gridDim.x) {
    const int rt = u / 10, which = (u % 10) >> 1, ct = u & 1;
    const int K = which < 4 ? 64 : 128, acol = which < 4 ? which * 64 : 256;
    const bf16_t* wb = which < 2 ? lora + (size_t)which * 16384 : which < 4 ? lora + 32768 + (size_t)(which - 2) * 16384 : lora + 65536;
    const float* bias = which < 2 ? INP(I_W0) + (size_t)l * 512 + which * 256 : INP(I_A0) + (size_t)l * 512 + (which & 1) * 256;
    const float* kav = INP(I_KAW) + (size_t)l * 256;
    gemm_tile(smem, K,
      [&](int r) { return LIg + (size_t)(rt * 128 + r) * 384 + acol; },
      [&](int r) { return wb + (size_t)(ct * 128 + r) * K; },
      [&](f32x4 (&acc)[4][4], int wr, int wc, int g, int l15) {
        const int tid = TIDX;
        if (which == 2 || which == 3) {
          bf16_t* T = (bf16_t*)smem; constexpr int LDC = 136;
          __syncthreads();
#pragma unroll
          for (int ni = 0; ni < 4; ++ni) { const int cl = wc * 64 + ni * 16 + l15; const float bv = bias[ct * 128 + cl];
#pragma unroll
            for (int mi = 0; mi < 4; ++mi)
#pragma unroll
              for (int i = 0; i < 4; ++i) T[(wr * 64 + mi * 16 + 4 * g + i) * LDC + cl] = f2bf(sigmoidf_(acc[mi][ni][i] + bv)); }
          __syncthreads();
          const int c = tid & 15, col0 = ct * 128 + c * 8;
          float ka[8];
#pragma unroll
          for (int j = 0; j < 8; ++j) ka[j] = kav[col0 + j];
          const size_t dofs = (size_t)(which - 2) * NT_ * 256;
#pragma unroll
          for (int pass = 0; pass < 8; ++pass) { const int row = (tid >> 4) + 16 * pass; const size_t o = (size_t)(rt * 128 + row) * 256 + col0;
            const bf16x8 a8 = *(const bf16x8*)(T + row * LDC + c * 8), kr8 = ld8g(KRg + o), kk8 = ld8g(KKg + o);
            bf16x8 kd8, bd8;
#pragma unroll
            for (int j = 0; j < 8; ++j) { const float a = bf2f((bf16_t)a8[j]); kd8[j] = (short)f2bf(bf2f((bf16_t)kr8[j]) * (1.f + (a - 1.f) * ka[j])); bd8[j] = (short)f2bf(bf2f((bf16_t)kk8[j]) * a); }
            *(AS1 bf16x8*)gptr(KD + dofs + o) = kd8; *(AS1 bf16x8*)gptr(BD + dofs + o) = bd8; }
        } else {
          float* T = (float*)smem; constexpr int LDC = 132;
          float* dst = which < 2 ? LWp + (size_t)which * NT_ * 256 : GATE;
#pragma unroll 1
          for (int h = 0; h < 2; ++h) {
            __syncthreads();
            if (wr == h) {
#pragma unroll
              for (int ni = 0; ni < 4; ++ni) { const int cl = wc * 64 + ni * 16 + l15; const float bv = which < 2 ? bias[ct * 128 + cl] : 0.f;
#pragma unroll
                for (int mi = 0; mi < 4; ++mi)
#pragma unroll
                  for (int i = 0; i < 4; ++i) { const float v = acc[mi][ni][i]; T[(mi * 16 + 4 * g + i) * LDC + cl] = which < 2 ? -0.6065306597126334f * sigmoidf_(v + bv) : v; } } }
            __syncthreads();
#pragma unroll
            for (int pass = 0; pass < 8; ++pass) { const int id = tid + 256 * pass, row = id >> 5, c = id & 31;
              *(AS1 f32x4*)gptr(dst + (size_t)(rt * 128 + h * 64 + row) * 256 + ct * 128 + c * 4) = *(const f32x4*)(T + row * LDC + c * 4); } }
        }
      });
  }
}

DEVFN bf16x8 ld8(const bf16_t* p) { return *(const bf16x8*)p; }
typedef short bf16x4v __attribute__((ext_vector_type(4)));
DEVFN bf16x4v cvt4(f32x4 v) { return bf16x4v{(short)f2bf(v[0]), (short)f2bf(v[1]), (short)f2bf(v[2]), (short)f2bf(v[3])}; }
DEVFN bf16x8 cat44(bf16x4v a, bf16x4v b) { return bf16x8{a[0], a[1], a[2], a[3], b[0], b[1], b[2], b[3]}; }
DEVFN bf16x4v ld4(const bf16_t* p) { return *(const bf16x4v*)p; }
DEVFN int rm_off(int i, int k) { return i * 64 + ((((k >> 3) ^ (i & 7)) << 3) | (k & 7)); }
#define RW_WAVE_LDS 11264
DEVFN void rwkv_chunk(const Params& p, int unit_base, unsigned char* smem) {
  const int tid = TIDX, lane = tid & 63, wave = tid >> 6, q = lane >> 4, l15 = lane & 15;
  const int unit = unit_base + wave;
  const int c = unit % NC16, h = (unit / NC16) & 3, dir = (unit / (NC16 * 4)) & 1, b = unit / (NC16 * 8);
  bf16_t* big = (bf16_t*)(smem + wave * RW_WAVE_LDS);
  unsigned char* small = smem + wave * RW_WAVE_LDS + 8192;
  float* AbF = (float*)small;
  bf16_t* TN = (bf16_t*)(small + 1024);
  bf16_t* AK = TN + 256; bf16_t* RB = AK + 256; bf16_t* RK = RB + 256;
  const bf16_t* RRg = (const bf16_t*)(p.ws + Ws::RR); const bf16_t* VVg = (const bf16_t*)(p.ws + Ws::VV); const bf16_t* KKg = (const bf16_t*)(p.ws + Ws::KK);
  const bf16_t* KDg = (const bf16_t*)(p.ws + Ws::KD) + (size_t)dir * NT_ * 256; const bf16_t* BDg = (const bf16_t*)(p.ws + Ws::BD) + (size_t)dir * NT_ * 256;
  const float* LWg = (const float*)(p.ws + Ws::LW) + (size_t)dir * NT_ * 256;
  float kkm[16], vv[16], bneg[16], kneg[16];
  float run = 0.f;
  __syncthreads();
#pragma unroll
  for (int i = 0; i < 16; ++i) {
    const size_t o = (size_t)(b * T_ + tokmap(dir, c * 16 + i)) * 256 + h * 64 + lane;
    const float lw = gptr(LWg)[o], r = bf2f(gptr(RRg)[o]), k = bf2f(gptr(KDg)[o]), v = bf2f(gptr(VVg)[o]), kk = bf2f(gptr(KKg)[o]), bb = bf2f(gptr(BDg)[o]);
    const float e_ex = expf(run); run += lw; const float e_in = expf(run), e_neg = expf(-run);
    kkm[i] = kk * e_ex; vv[i] = v; bneg[i] = bb * e_neg; kneg[i] = k * e_neg;
    big[rm_off(i, lane)] = f2bf(kkm[i]); big[1024 + rm_off(i, lane)] = f2bf(r * e_in);
    big[2048 + rm_off(i, lane)] = f2bf(bneg[i]); big[3072 + rm_off(i, lane)] = f2bf(kneg[i]);
  }
  const float WC = expf(run);
  __syncthreads();
  f32x4 ab = f32x4{0.f, 0.f, 0.f, 0.f}, ak = ab, rb = ab, rk = ab;
#pragma unroll
  for (int s2 = 0; s2 < 2; ++s2) { const int ch = ((4 * s2 + q) ^ (l15 & 7)) << 3;
    const bf16x8 a_kk = ld8(big + l15 * 64 + ch), a_r = ld8(big + 1024 + l15 * 64 + ch), b_b = ld8(big + 2048 + l15 * 64 + ch), b_k = ld8(big + 3072 + l15 * 64 + ch);
    ab = MFMA16(a_kk, b_b, ab); ak = MFMA16(a_kk, b_k, ak); rb = MFMA16(a_r, b_b, rb); rk = MFMA16(a_r, b_k, rk); }
  f32x4 gacc[4];
#pragma unroll
  for (int nk = 0; nk < 4; ++nk)
#pragma unroll
    for (int r = 0; r < 4; ++r) gacc[nk][r] = bf2f(big[1024 + rm_off(4 * q + r, 16 * nk + l15)]);
  __syncthreads();
#pragma unroll
  for (int r = 0; r < 4; ++r) { const int i = 4 * q + r, j = l15;
    AbF[i * 16 + j] = j < i ? ab[r] : 0.f; AK[i * 16 + j] = f2bf(j < i ? ak[r] : 0.f);
    RB[i * 16 + j] = f2bf(j <= i ? rb[r] : 0.f); RK[i * 16 + j] = f2bf(j <= i ? rk[r] : 0.f); }
  { bf16_t* KKMT = big; bf16_t* VTT = big + 1024; bf16_t* BHT = big + 2048; bf16_t* KHT = big + 3072;
#pragma unroll
    for (int i = 0; i < 16; ++i) { KKMT[lane * 16 + i] = f2bf(kkm[i]); VTT[lane * 16 + i] = f2bf(vv[i]); BHT[lane * 16 + i] = f2bf(bneg[i] * WC); KHT[lane * 16 + i] = f2bf(kneg[i] * WC); } }
  __syncthreads();
  { float t[16];
#pragma unroll
    for (int i = 0; i < 16; ++i) { float acc = (i == l15) ? 1.f : 0.f;
#pragma unroll
      for (int j = 0; j < i; ++j) acc -= AbF[i * 16 + j] * t[j];
      t[i] = acc; }
    if (q == 0) {
#pragma unroll
      for (int i = 0; i < 16; ++i) TN[i * 16 + l15] = f2bf(-t[i]); } }
  __syncthreads();
  const size_t ci = (size_t)((b * 2 + dir) * 4 + h) * NC16 + c;
  bf16_t* MLg = (bf16_t*)(p.ws + Ws::RML) + ci * 4096; bf16_t* Ng = (bf16_t*)(p.ws + Ws::RNS) + ci * 4096;
  bf16_t* Gg = (bf16_t*)(p.ws + Ws::RG) + ci * 1024; float* Y0g = (float*)(p.ws + Ws::RY0) + ci * 1024;
  const bf16x4v a_T = ld4(TN + l15 * 16 + 4 * q), a_Ak = ld4(AK + l15 * 16 + 4 * q), a_Rb = ld4(RB + l15 * 16 + 4 * q), a_Rk = ld4(RK + l15 * 16 + 4 * q);
  const f32x4 z4 = f32x4{0.f, 0.f, 0.f, 0.f};
  bf16x4v vfr[4], qfr[4], pfr[4];
#pragma unroll
  for (int n = 0; n < 4; ++n) {
    vfr[n] = ld4(big + 1024 + (16 * n + l15) * 16 + 4 * q);
    const f32x4 akv = MFMA16K16(a_Ak, vfr[n], z4);
    qfr[n] = cvt4(MFMA16K16(a_T, cvt4(akv), z4));
    pfr[n] = cvt4(MFMA16K16(a_T, ld4(big + (16 * n + l15) * 16 + 4 * q), z4)); }
  const bf16x8 a_RbRk = cat44(a_Rb, a_Rk);
#pragma unroll
  for (int n = 0; n < 4; ++n) {
    const f32x4 g = MFMA16K16(a_Rb, pfr[n], gacc[n]);
    const f32x4 y0 = MFMA16(a_RbRk, cat44(qfr[n], vfr[n]), z4);
#pragma unroll
    for (int r = 0; r < 4; ++r) { Gg[(4 * q + r) * 64 + 16 * n + l15] = f2bf(g[r]); Y0g[(4 * q + r) * 64 + 16 * n + l15] = y0[r]; } }
#pragma unroll
  for (int n = 0; n < 4; ++n)
#pragma unroll
    for (int r = 0; r < 4; ++r) MLg[((n >> 1) * 64 + (l15 >> 2) * 16 + 4 * q + r) * 8 + (n & 1) * 4 + (l15 & 3)] = (bf16_t)pfr[n][r];
#pragma unroll
  for (int mk = 0; mk < 4; ++mk) {
    const bf16x4v a_B = ld4(big + 2048 + (16 * mk + l15) * 16 + 4 * q), a_K = ld4(big + 3072 + (16 * mk + l15) * 16 + 4 * q);
    const bf16x8 a_BK = cat44(a_B, a_K);
    *(bf16x4v*)(MLg + 1024 + ((mk >> 1) * 64 + lane) * 8 + (mk & 1) * 4) = a_B;
#pragma unroll
    for (int n = 0; n < 4; ++n) {
      const f32x4 nn = MFMA16(a_BK, cat44(qfr[n], vfr[n]), z4);
      *(bf16x4v*)(Ng + (n * 64 + lane) * 16 + mk * 4) = cvt4(nn); } }
  ((float*)(p.ws + Ws::RWC))[ci * 64 + ((lane >> 2) & 3) * 16 + (lane >> 4) * 4 + (lane & 3)] = WC;
}
struct RwStep { bf16x8 pf[2]; bf16x8 bh[2]; bf16x8 n[2]; float wc; };
DEVFN void rw_load(RwStep& t, const bf16_t* MLg, const bf16_t* NSg, const float* WCg, int c, int lane, int q) {
#pragma unroll
  for (int s2 = 0; s2 < 2; ++s2) { t.pf[s2] = ld8g(MLg + (size_t)c * 4096 + (s2 * 64 + lane) * 8); t.bh[s2] = ld8g(MLg + (size_t)c * 4096 + 1024 + (s2 * 64 + lane) * 8); }
  t.wc = gptr(WCg)[(size_t)c * 64 + lane];
  t.n[0] = ld8g(NSg + (size_t)c * 4096 + lane * 16); t.n[1] = ld8g(NSg + (size_t)c * 4096 + lane * 16 + 8);
  (void)q;
}
DEVFN void rw_step(const RwStep& t, f32x4 (&S)[4], bf16_t* NSg, int c, int q, int l15) {
  bf16x4v sb[4];
#pragma unroll
  for (int mk = 0; mk < 4; ++mk) sb[mk] = cvt4(S[mk]);
  const bf16x8 bf0 = cat44(sb[0], sb[1]), bf1 = cat44(sb[2], sb[3]);
  f32x4 w = MFMA16(t.pf[0], bf0, (f32x4{0.f, 0.f, 0.f, 0.f}));
  w = MFMA16(t.pf[1], bf1, w);
  const bf16x4v wb = cvt4(w);
#pragma unroll
  for (int mk = 0; mk < 4; ++mk) {
    f32x4 acc;
#pragma unroll
    for (int r = 0; r < 4; ++r) acc[r] = bf2f((bf16_t)t.n[mk >> 1][(mk & 1) * 4 + r]) + __shfl(t.wc, q * 16 + mk * 4 + r) * S[mk][r];
    const bf16x8 b2 = t.bh[mk >> 1];
    const bf16x4v a_B = (mk & 1) ? bf16x4v{b2[4], b2[5], b2[6], b2[7]} : bf16x4v{b2[0], b2[1], b2[2], b2[3]};
    S[mk] = MFMA16K16(a_B, wb, acc); }
#pragma unroll
  for (int mk = 0; mk < 4; ++mk) *(AS1 bf16x4v*)gptr(NSg + (size_t)c * 4096 + l15 * 64 + 16 * mk + 4 * q) = sb[mk];
}
DEVFN void rwkv_scan(const Params& p, int chain, int wave) {
  const int tid = TIDX, lane = tid & 63, q = lane >> 4, l15 = lane & 15;
  const bf16_t* MLg = (const bf16_t*)(p.ws + Ws::RML) + (size_t)chain * NC16 * 4096;
  bf16_t* NSg = (bf16_t*)(p.ws + Ws::RNS) + (size_t)chain * NC16 * 4096 + wave * 1024;
  const float* WCg = (const float*)(p.ws + Ws::RWC) + (size_t)chain * NC16 * 64;
  f32x4 S[4];
#pragma unroll
  for (int mk = 0; mk < 4; ++mk) S[mk] = f32x4{0.f, 0.f, 0.f, 0.f};
  RwStep t0, t1, t2, t3;
#define RWC_(x) ((x) < NC16 ? (x) : NC16 - 1)
  rw_load(t0, MLg, NSg, WCg, 0, lane, q);
  rw_load(t1, MLg, NSg, WCg, RWC_(1), lane, q);
  rw_load(t2, MLg, NSg, WCg, RWC_(2), lane, q);
  int c = 0;
  for (; c + 3 < NC16; c += 4) {
    rw_load(t3, MLg, NSg, WCg, c + 3, lane, q);
    rw_step(t0, S, NSg, c, q, l15);
    rw_load(t0, MLg, NSg, WCg, RWC_(c + 4), lane, q);
    rw_step(t1, S, NSg, c + 1, q, l15);
    rw_load(t1, MLg, NSg, WCg, RWC_(c + 5), lane, q);
    rw_step(t2, S, NSg, c + 2, q, l15);
    rw_load(t2, MLg, NSg, WCg, RWC_(c + 6), lane, q);
    rw_step(t3, S, NSg, c + 3, q, l15);
  }
  if (c < NC16) { rw_step(t0, S, NSg, c, q, l15); if (c + 1 < NC16) { rw_step(t1, S, NSg, c + 1, q, l15); if (c + 2 < NC16) rw_step(t2, S, NSg, c + 2, q, l15); } }
#undef RWC_
}
DEVFN void rwkv_out(const Params& p, int unit_base) {
  const int tid = TIDX, lane = tid & 63, wave = tid >> 6, q = lane >> 4, l15 = lane & 15;
  const int unit = unit_base + wave;
  const int c = unit % NC16, h = (unit / NC16) & 3, dir = (unit / (NC16 * 4)) & 1, b = unit / (NC16 * 8);
  const size_t ci = (size_t)((b * 2 + dir) * 4 + h) * NC16 + c;
  const bf16_t* Sg = (const bf16_t*)(p.ws + Ws::RNS) + ci * 4096; const bf16_t* Gg = (const bf16_t*)(p.ws + Ws::RG) + ci * 1024;
  const float* Y0g = (const float*)(p.ws + Ws::RY0) + ci * 1024;
  float* YR = (float*)(p.ws + Ws::YR) + (size_t)dir * NT_ * 256;
  const bf16x8 a0 = ld8g(Gg + l15 * 64 + 8 * q), a1 = ld8g(Gg + l15 * 64 + 32 + 8 * q);
#pragma unroll
  for (int n = 0; n < 4; ++n) {
    f32x4 acc;
#pragma unroll
    for (int r = 0; r < 4; ++r) acc[r] = gptr(Y0g)[(4 * q + r) * 64 + 16 * n + l15];
    acc = MFMA16(a0, ld8g(Sg + n * 1024 + l15 * 64 + 8 * q), acc);
    acc = MFMA16(a1, ld8g(Sg + n * 1024 + l15 * 64 + 32 + 8 * q), acc);
#pragma unroll
    for (int r = 0; r < 4; ++r) YR[(size_t)(b * T_ + tokmap(dir, c * 16 + 4 * q + r)) * 256 + h * 64 + 16 * n + l15] = acc[r]; }
}
DEVFN int cscan(int dir, int co, int nctx, int nc) { return dir == 0 ? co : (co < nctx ? nctx - 1 - co : 2 * nctx + nc - 1 - co); }
DEVFN bf16x8 ld4x2g(const bf16_t* p0, const bf16_t* p1) { bf16x4v a = *(const AS1 bf16x4v*)gptr(p0), b = *(const AS1 bf16x4v*)gptr(p1); return bf16x8{a[0], a[1], a[2], a[3], b[0], b[1], b[2], b[3]}; }
DEVFN bf16x8 ld4x2(const bf16_t* p0, const bf16_t* p1) { bf16x4v a = *(const bf16x4v*)p0, b = *(const bf16x4v*)p1; return bf16x8{a[0], a[1], a[2], a[3], b[0], b[1], b[2], b[3]}; }

DEVFN void ssd_chunk_scalars(const Params& p, int l, int b, int co, int h, float* f) {
  const int tid = TIDX, d = tid >> 7, j = tid & 127;
  const float* DTB = (const float*)(p.ws + Ws::DTB);
  const float nega = -expf(INP(I_ALOG)[(size_t)l * 16 + d * 8 + h]);
  const float dt = DTB[(size_t)(b * T_ + co * 128 + j) * 16 + d * 8 + h];
  __syncthreads();
  f[256 + d * 128 + j] = dt;
  float* cur = f + d * 128; float* tmp = f + 512 + d * 128;
  cur[j] = dt * nega;
  __syncthreads();
  for (int off = 1; off < 128; off <<= 1) {
    float v = cur[j] + (j >= off ? cur[j - off] : 0.f);
    tmp[j] = v;
    __syncthreads();
    cur[j] = tmp[j];
    __syncthreads();
  }
}
DEVFN void ssd_states(const Params& p, int l, int unit, unsigned char* smem) {
  const int tid = TIDX, lane = tid & 63, wave = tid >> 6, q = lane >> 4, l15 = lane & 15;
  const int h = unit & 7, co = (unit >> 3) % NC128, b = unit / (8 * NC128), grp = h >> 2;
  float* f = (float*)smem;
  ssd_chunk_scalars(p, l, b, co, h, f);
  { const int d = tid >> 7, j = tid & 127; const float* cum = f + d * 128; const float dt = f[256 + d * 128 + j];
    float w = d == 0 ? expf(cum[127] - cum[j]) * dt : expf(j > 0 ? cum[j - 1] : 0.f) * dt;
    f[512 + d * 128 + j] = w; }
  __syncthreads();
  const bf16_t* XT = (const bf16_t*)(p.ws + Ws::XBCT) + (size_t)(b * NC128 + co) * 768 * 128;
  f32x4 acc[2][8];
#pragma unroll
  for (int d = 0; d < 2; ++d)
#pragma unroll
    for (int n = 0; n < 8; ++n) acc[d][n] = f32x4{0.f, 0.f, 0.f, 0.f};
#pragma unroll 2
  for (int s4 = 0; s4 < 4; ++s4) {
    const int j0 = s4 * 32 + q * 8;
    bf16x8 xa = ld8g(XT + (size_t)(h * 64 + wave * 16 + l15) * 128 + j0), a0, a1;
#pragma unroll
    for (int jj = 0; jj < 8; ++jj) { float x = bf2f((bf16_t)xa[jj]); a0[jj] = (short)f2bf(x * f[512 + j0 + jj]); a1[jj] = (short)f2bf(x * f[640 + j0 + jj]); }
#pragma unroll
    for (int n = 0; n < 8; ++n) { bf16x8 bb = ld8g(XT + (size_t)(512 + grp * 128 + n * 16 + l15) * 128 + j0);
      acc[0][n] = MFMA16(a0, bb, acc[0][n]); acc[1][n] = MFMA16(a1, bb, acc[1][n]); }
  }
#pragma unroll
  for (int d = 0; d < 2; ++d) {
    const int cs = cscan(d, co, CTX_ / 128, SEQ_ / 128);
    float* ST = (float*)(p.ws + Ws::SST) + ((size_t)((d * B_ + b) * NC128 + cs) * 8 + h) * 8192;
#pragma unroll
    for (int n = 0; n < 8; ++n)
#pragma unroll
      for (int r = 0; r < 4; ++r) ST[(wave * 16 + q * 4 + r) * 128 + n * 16 + l15] = acc[d][n][r];
    if (tid == 0) ((float*)(p.ws + Ws::SCD))[((size_t)(d * B_ + b) * NC128 + cs) * 8 + h] = expf(f[d * 128 + 127]);
  }
}
#define SSD_SB ((NC128 % 17) == 0 ? 17 : NC128)
DEVFN void ssd_scan(const Params& p, int gtid, int gthreads) {
  const float* __restrict__ ST = (const float*)(p.ws + Ws::SST); const float* __restrict__ CD = (const float*)(p.ws + Ws::SCD); bf16_t* __restrict__ HIN = (bf16_t*)(p.ws + Ws::HIN);
  for (int e = gtid; e < 2 * B_ * 8 * 8192; e += gthreads) {
    const int pd = e & 8191, h = (e >> 13) & 7, db = e >> 16;
    float hv = 0.f;
#pragma unroll 1
    for (int c0 = 0; c0 < NC128; c0 += SSD_SB) {
      float st[SSD_SB], cd[SSD_SB];
#pragma unroll
      for (int i = 0; i < SSD_SB; ++i) { st[i] = ST[((size_t)(db * NC128 + c0 + i) * 8 + h) * 8192 + pd]; cd[i] = CD[(size_t)(db * NC128 + c0 + i) * 8 + h]; }
#pragma unroll
      for (int i = 0; i < SSD_SB; ++i) { HIN[((size_t)(db * NC128 + c0 + i) * 8 + h) * 8192 + pd] = f2bf(hv); hv = hv * cd[i] + st[i]; }
    }
  }
}
DEVFN void ssd_out(const Params& p, int l, int unit, unsigned char* smem) {
  const int tid = TIDX, lane = tid & 63, wave = tid >> 6, q = lane >> 4, l15 = lane & 15;
  const int h = unit & 7, co = (unit >> 3) % NC128, b = unit / (8 * NC128), grp = h >> 2;
  float* f = (float*)smem;
  ssd_chunk_scalars(p, l, b, co, h, f);
  if (tid < 128) f[640 + tid] = f[128 + 127] - (tid > 0 ? f[128 + tid - 1] : 0.f);
  __syncthreads();
  const float* cum0 = f; const float* suf1 = f + 640; const float* dt0 = f + 256; const float* dt1 = f + 384;
  const bf16_t* XBC = (const bf16_t*)(p.ws + Ws::XBC) + (size_t)(b * T_ + co * 128) * 1024;
  const bf16_t* XT = (const bf16_t*)(p.ws + Ws::XBCT) + (size_t)(b * NC128 + co) * 768 * 128;
  const bf16_t* Cb = XBC + (size_t)(wave * 32 + l15) * 1024 + 768 + grp * 128 + q * 8;
  f32x4 y[4][2];
  { f32x4 o0[4][2], o1[4][2];
#pragma unroll
    for (int mp = 0; mp < 4; ++mp)
#pragma unroll
      for (int ni = 0; ni < 2; ++ni) { o0[mp][ni] = f32x4{0.f, 0.f, 0.f, 0.f}; o1[mp][ni] = f32x4{0.f, 0.f, 0.f, 0.f}; }
    const int cs0 = cscan(0, co, CTX_ / 128, SEQ_ / 128), cs1 = cscan(1, co, CTX_ / 128, SEQ_ / 128);
    const bf16_t* H0 = (const bf16_t*)(p.ws + Ws::HIN) + ((size_t)((0 * B_ + b) * NC128 + cs0) * 8 + h) * 8192;
    const bf16_t* H1 = (const bf16_t*)(p.ws + Ws::HIN) + ((size_t)((1 * B_ + b) * NC128 + cs1) * 8 + h) * 8192;
#pragma unroll
    for (int s4 = 0; s4 < 4; ++s4) { const bf16x8 c0 = ld8g(Cb + s4 * 32), c1 = ld8g(Cb + 16 * 1024 + s4 * 32);
#pragma unroll
      for (int mp = 0; mp < 4; ++mp) { bf16x8 h0 = ld8g(H0 + (size_t)(mp * 16 + l15) * 128 + s4 * 32 + q * 8), h1 = ld8g(H1 + (size_t)(mp * 16 + l15) * 128 + s4 * 32 + q * 8);
        o0[mp][0] = MFMA16(h0, c0, o0[mp][0]); o0[mp][1] = MFMA16(h0, c1, o0[mp][1]);
        o1[mp][0] = MFMA16(h1, c0, o1[mp][0]); o1[mp][1] = MFMA16(h1, c1, o1[mp][1]); } }
#pragma unroll
    for (int ni = 0; ni < 2; ++ni) { const int i = wave * 32 + ni * 16 + l15; const float e0 = expf(cum0[i]), e1 = expf(suf1[i]);
#pragma unroll
      for (int mp = 0; mp < 4; ++mp)
#pragma unroll
        for (int r = 0; r < 4; ++r) y[mp][ni][r] = e0 * o0[mp][ni][r] + e1 * o1[mp][ni][r]; } }
  bf16x8 mfr[4][2];
  { f32x4 g[8][2];
#pragma unroll
    for (int mj = 0; mj < 8; ++mj) { g[mj][0] = f32x4{0.f, 0.f, 0.f, 0.f}; g[mj][1] = f32x4{0.f, 0.f, 0.f, 0.f}; }
#pragma unroll
    for (int s4 = 0; s4 < 4; ++s4) { const bf16x8 c0 = ld8g(Cb + s4 * 32), c1 = ld8g(Cb + 16 * 1024 + s4 * 32);
#pragma unroll
      for (int mj = 0; mj < 8; ++mj) { bf16x8 bb = ld8g(XBC + (size_t)(mj * 16 + l15) * 1024 + 512 + grp * 128 + s4 * 32 + q * 8);
        g[mj][0] = MFMA16(bb, c0, g[mj][0]); g[mj][1] = MFMA16(bb, c1, g[mj][1]); } }
    const int i0 = wave * 32 + l15, i1 = i0 + 16;
    const float c0i0 = cum0[i0], s1i0 = suf1[i0], c0i1 = cum0[i1], s1i1 = suf1[i1];
#pragma unroll
    for (int mj = 0; mj < 8; ++mj)
#pragma unroll
      for (int r = 0; r < 4; ++r) { const int j = mj * 16 + q * 4 + r;
        const float cj = cum0[j], sj = suf1[j], d0 = dt0[j], d1 = dt1[j];
        const float lw0 = (j <= i0 ? expf(c0i0 - cj) * d0 : 0.f) + (j >= i0 ? expf(s1i0 - sj) * d1 : 0.f);
        const float lw1 = (j <= i1 ? expf(c0i1 - cj) * d0 : 0.f) + (j >= i1 ? expf(s1i1 - sj) * d1 : 0.f);
        mfr[mj >> 1][0][(mj & 1) * 4 + r] = (short)f2bf(g[mj][0][r] * lw0);
        mfr[mj >> 1][1][(mj & 1) * 4 + r] = (short)f2bf(g[mj][1][r] * lw1); } }
#pragma unroll
  for (int s4 = 0; s4 < 4; ++s4)
#pragma unroll
    for (int mp = 0; mp < 4; ++mp) { const bf16_t* xr = XT + (size_t)(h * 64 + mp * 16 + l15) * 128 + s4 * 32 + q * 4;
      bf16x8 xa = ld4x2g(xr, xr + 16);
      y[mp][0] = MFMA16(xa, mfr[s4][0], y[mp][0]); y[mp][1] = MFMA16(xa, mfr[s4][1], y[mp][1]); }
  __syncthreads();
  float* yl = f + 1024;
#pragma unroll
  for (int mp = 0; mp < 4; ++mp)
#pragma unroll
    for (int ni = 0; ni < 2; ++ni)
#pragma unroll
      for (int r = 0; r < 4; ++r) yl[(wave * 32 + ni * 16 + l15) * 65 + mp * 16 + q * 4 + r] = y[mp][ni][r];
  __syncthreads();
  float* YS = (float*)(p.ws + Ws::YS) + (size_t)(b * T_ + co * 128) * 512 + h * 64;
  for (int e = tid; e < 128 * 64; e += 256) YS[(size_t)(e >> 6) * 512 + (e & 63)] = yl[(e >> 6) * 65 + (e & 63)];
}

#define GQ_LD 40
#define GK_LD 72
DEVFN void gla_chunk(const Params& p, int unit, unsigned char* smem) {
  const int tid = TIDX, lane = tid & 63, wave = tid >> 6, q = lane >> 4, l15 = lane & 15;
  const int h = unit & 3, co = (unit >> 2) % NC64, b = unit / (4 * NC64);
  const bf16_t* ZX = (const bf16_t*)(p.ws + Ws::ZX) + (size_t)(b * T_ + co * 64) * NIN_;
  const float* LA = (const float*)(p.ws + Ws::LA);
  float* cum = (float*)smem;
  bf16_t* qs = (bf16_t*)(smem + 16384);
  bf16_t* ks = qs + 2 * 64 * GQ_LD;
  bf16_t* kt = ks + 2 * 64 * GQ_LD;
  __syncthreads();
  float la[16]; bf16_t qraw[8], kraw[8];
#pragma unroll
  for (int it = 0; it < 16; ++it) { const int e = tid + 256 * it, d = e >> 11, i = (e >> 5) & 63, dd = e & 31;
    la[it] = gptr(LA)[((size_t)d * NT_ + b * T_ + co * 64 + i) * 128 + h * 32 + dd]; }
#pragma unroll
  for (int it = 0; it < 8; ++it) { const int e = tid + 256 * it, i = e >> 5, dd = e & 31;
    qraw[it] = gptr(ZX)[(size_t)i * NIN_ + OGQ + h * 32 + dd]; kraw[it] = gptr(ZX)[(size_t)i * NIN_ + OGK + h * 32 + dd]; }
  const bf16_t* VT = (const bf16_t*)(p.ws + Ws::VT) + ((size_t)(b * NC64 + co) * 256 + h * 64) * 64;
  bf16x8 vfa[4][2], vfs[2];
#pragma unroll
  for (int md = 0; md < 4; ++md)
#pragma unroll
    for (int s2 = 0; s2 < 2; ++s2) { const bf16_t* vr = VT + (size_t)(md * 16 + l15) * 64 + s2 * 32 + q * 4; vfa[md][s2] = ld4x2g(vr, vr + 16); }
#pragma unroll
  for (int s2 = 0; s2 < 2; ++s2) vfs[s2] = ld8g(VT + (size_t)(wave * 16 + l15) * 64 + s2 * 32 + q * 8);
#pragma unroll
  for (int it = 0; it < 16; ++it) cum[tid + 256 * it] = la[it];
  __syncthreads();
  if (tid < 64) { const int d = tid >> 5, dd = tid & 31; float* c = cum + d * 2048 + dd; float sacc = 0.f;
    if (d == 0) for (int i = 0; i < 64; ++i) { sacc += c[i * 32]; c[i * 32] = sacc; }
    else for (int i = 63; i >= 0; --i) { sacc += c[i * 32]; c[i * 32] = sacc; } }
  __syncthreads();
  bf16_t* QT = (bf16_t*)(p.ws + Ws::QT);
#pragma unroll
  for (int it = 0; it < 8; ++it) { const int e = tid + 256 * it, i = e >> 5, dd = e & 31;
    const float qv = bf2f(qraw[it]) * 0.17677669529663687f, kv = bf2f(kraw[it]);
    const float c0 = cum[i * 32 + dd], c1 = cum[2048 + i * 32 + dd], t0 = cum[63 * 32 + dd], t1 = cum[2048 + dd];
    const bf16_t q0 = f2bf(qv * expf(c0)), q1 = f2bf(qv * expf(c1));
    qs[i * GQ_LD + dd] = q0; qs[64 * GQ_LD + i * GQ_LD + dd] = q1;
    ks[i * GQ_LD + dd] = f2bf(kv * expf(-c0)); ks[64 * GQ_LD + i * GQ_LD + dd] = f2bf(kv * expf(-c1));
    kt[dd * GK_LD + i] = f2bf(kv * expf(t0 - c0)); kt[32 * GK_LD + dd * GK_LD + i] = f2bf(kv * expf(t1 - c1));
    const size_t tok = (size_t)b * T_ + co * 64 + i;
    QT[tok * 128 + h * 32 + dd] = q0; QT[((size_t)NT_ + tok) * 128 + h * 32 + dd] = q1; }
  if (tid < 64) { const int d = tid >> 5, dd = tid & 31; const int cs = cscan(d, co, CTX_ / 64, SEQ_ / 64);
    ((float*)(p.ws + Ws::GCD))[(((size_t)(d * B_ + b) * NC64 + cs) * 4 + h) * 32 + dd] = expf(d == 0 ? cum[63 * 32 + dd] : cum[2048 + dd]); }
  __syncthreads();
  bf16x8 pfr[2];
  { f32x4 p0[4], p1[4];
    const bf16x8 qb0 = ld8(qs + (wave * 16 + l15) * GQ_LD + q * 8), qb1 = ld8(qs + 64 * GQ_LD + (wave * 16 + l15) * GQ_LD + q * 8);
#pragma unroll
    for (int mj = 0; mj < 4; ++mj) { p0[mj] = MFMA16(ld8(ks + (mj * 16 + l15) * GQ_LD + q * 8), qb0, (f32x4{0.f, 0.f, 0.f, 0.f}));
      p1[mj] = MFMA16(ld8(ks + 64 * GQ_LD + (mj * 16 + l15) * GQ_LD + q * 8), qb1, (f32x4{0.f, 0.f, 0.f, 0.f})); }
    const int i = wave * 16 + l15;
#pragma unroll
    for (int mj = 0; mj < 4; ++mj)
#pragma unroll
      for (int r = 0; r < 4; ++r) { const int j = mj * 16 + q * 4 + r; pfr[mj >> 1][(mj & 1) * 4 + r] = (short)f2bf((j <= i ? p0[mj][r] : 0.f) + (j >= i ? p1[mj][r] : 0.f)); } }
  f32x4 o[4];
#pragma unroll
  for (int md = 0; md < 4; ++md) { o[md] = f32x4{0.f, 0.f, 0.f, 0.f};
#pragma unroll
    for (int s2 = 0; s2 < 2; ++s2) o[md] = MFMA16(vfa[md][s2], pfr[s2], o[md]); }
#pragma unroll
  for (int d = 0; d < 2; ++d) { const int cs = cscan(d, co, CTX_ / 64, SEQ_ / 64);
    float* GST = (float*)(p.ws + Ws::GST) + (((size_t)(d * B_ + b) * NC64 + cs) * 4 + h) * 2048;
#pragma unroll
    for (int nd = 0; nd < 2; ++nd) { f32x4 st = f32x4{0.f, 0.f, 0.f, 0.f};
#pragma unroll
      for (int s2 = 0; s2 < 2; ++s2) st = MFMA16(vfs[s2], ld8(kt + d * 32 * GK_LD + (nd * 16 + l15) * GK_LD + s2 * 32 + q * 8), st);
#pragma unroll
      for (int r = 0; r < 4; ++r) GST[(wave * 16 + q * 4 + r) * 32 + nd * 16 + l15] = st[r]; } }
  __syncthreads();
  float* ol = (float*)smem;
#pragma unroll
  for (int md = 0; md < 4; ++md)
#pragma unroll
    for (int r = 0; r < 4; ++r) ol[(wave * 16 + l15) * 65 + md * 16 + q * 4 + r] = o[md][r];
  __syncthreads();
  float* OI = (float*)(p.ws + Ws::OI) + (size_t)(b * T_ + co * 64) * 256 + h * 64;
  for (int e = tid; e < 64 * 64; e += 256) OI[(size_t)(e >> 6) * 256 + (e & 63)] = ol[(e >> 6) * 65 + (e & 63)];
}
#define GLA_SB ((NC64 % 17) == 0 ? 17 : NC64)
DEVFN void gla_scan(const Params& p, int gtid, int gthreads) {
  const float* __restrict__ ST = (const float*)(p.ws + Ws::GST); const float* __restrict__ CD = (const float*)(p.ws + Ws::GCD); bf16_t* __restrict__ SIN = (bf16_t*)(p.ws + Ws::GSIN);
  for (int e = gtid; e < 2 * B_ * 4 * 2048; e += gthreads) {
    const int vd = e & 2047, h = (e >> 11) & 3, db = e >> 13;
    float sv = 0.f;
#pragma unroll 1
    for (int c0 = 0; c0 < NC64; c0 += GLA_SB) {
      float st[GLA_SB], cd[GLA_SB];
#pragma unroll
      for (int i = 0; i < GLA_SB; ++i) { st[i] = ST[(((size_t)db * NC64 + c0 + i) * 4 + h) * 2048 + vd]; cd[i] = CD[(((size_t)db * NC64 + c0 + i) * 4 + h) * 32 + (vd & 31)]; }
#pragma unroll
      for (int i = 0; i < GLA_SB; ++i) { SIN[(((size_t)db * NC64 + c0 + i) * 4 + h) * 2048 + vd] = f2bf(sv); sv = sv * cd[i] + st[i]; }
    }
  }
}
DEVFN void gla_out(const Params& p, int unit_base) {
  const int tid = TIDX, lane = tid & 63, wave = tid >> 6, g = lane >> 4, l15 = lane & 15;
  const int unit = unit_base + wave;
  if (unit >= B_ * NC64 * 4) return;
  const int h = unit & 3, co = (unit >> 2) % NC64, b = unit / (4 * NC64);
  const bf16_t* QT = (const bf16_t*)(p.ws + Ws::QT);
  const bf16_t* GSIN = (const bf16_t*)(p.ws + Ws::GSIN);
  float* OI = (float*)(p.ws + Ws::OI) + (size_t)(b * T_ + co * 64) * 256 + h * 64;
  const int tok0 = b * T_ + co * 64;
  bf16x8 af[2][4], bfr[2][4];
#pragma unroll
  for (int d = 0; d < 2; ++d) { const int cs = cscan(d, co, CTX_ / 64, SEQ_ / 64);
    const bf16_t* sr = GSIN + ((((size_t)(d * B_ + b) * NC64 + cs) * 4 + h) * 64) * 32;
#pragma unroll
    for (int mi = 0; mi < 4; ++mi) af[d][mi] = ld8g(QT + ((size_t)d * NT_ + tok0 + mi * 16 + l15) * 128 + h * 32 + g * 8);
#pragma unroll
    for (int ni = 0; ni < 4; ++ni) bfr[d][ni] = ld8g(sr + (ni * 16 + l15) * 32 + g * 8); }
#pragma unroll
  for (int mi = 0; mi < 4; ++mi) {
    f32x4 acc[4];
#pragma unroll
    for (int ni = 0; ni < 4; ++ni)
#pragma unroll
      for (int i = 0; i < 4; ++i) acc[ni][i] = gptr(OI)[(size_t)(mi * 16 + 4 * g + i) * 256 + ni * 16 + l15];
#pragma unroll
    for (int ni = 0; ni < 4; ++ni) { acc[ni] = MFMA16(af[0][mi], bfr[0][ni], acc[ni]); acc[ni] = MFMA16(af[1][mi], bfr[1][ni], acc[ni]); }
#pragma unroll
    for (int ni = 0; ni < 4; ++ni)
#pragma unroll
      for (int i = 0; i < 4; ++i) gptr(OI)[(size_t)(mi * 16 + 4 * g + i) * 256 + ni * 16 + l15] = acc[ni][i];
  }
}
DEVFN void convert_moe_weights(const Params& p, int l, unsigned char* smem, int bid, int nb, int j_lo, int j_hi);
#define CVT_JOBS (65 * 192)
#ifndef CVT_SCAN_SHARE
#define CVT_SCAN_SHARE (CVT_JOBS / 8)
#endif
DEVFN void phase4a(const Params& p, int l, unsigned char* smem) {
  const int n_r = B_ * 8 * NC16 / 4;
  for (int u = BIDX; u < n_r; u += gridDim.x) rwkv_chunk(p, (u) * 4, smem);
  (void)l;
}
#define CVT_GRP 8
DEVFN void phase4b(const Params& p, int l, unsigned char* smem) {
  const int bid = BIDX, nrw = B_ * 8, G = (int)gridDim.x;
  const int n_s = B_ * NC128 * 8, n_g = B_ * NC64 * 4;
  if (G >= 8 * nrw) {
    const int q = 2 * nrw, half = G >> 1, on = G - 4 * nrw;
    int sb = -1;
    if (bid < q) sb = bid; else if (bid >= half && bid < half + q) sb = q + (bid - half);
    const int n_c = (CVT_JOBS + CVT_GRP - 1) / CVT_GRP, total = n_s + n_g + n_c;
    unsigned* ctr = (unsigned*)(p.ws + Ws::BAR) + l * 32 + 16;
    volatile int* nxt_s = (volatile int*)(smem + SM_PRE);
    int u;
    if (sb >= 0) { if ((TIDX >> 6) == 0) rwkv_scan(p, sb >> 2, sb & 3);
      __syncthreads();
      if (TIDX == 0) *nxt_s = on + (int)atomicAdd(ctr, 1u);
      __syncthreads();
      u = *nxt_s; }
    else u = bid < half ? bid - q : bid - 2 * q;
    while (u < total) {
      int nxt = 0;
      if (TIDX == 0) nxt = on + (int)atomicAdd(ctr, 1u);
      if (u < n_s) ssd_states(p, l, u, smem); else if (u < n_s + n_g) gla_chunk(p, u - n_s, smem);
      else { const int j0 = (u - n_s - n_g) * CVT_GRP, j1 = j0 + CVT_GRP < CVT_JOBS ? j0 + CVT_GRP : CVT_JOBS; convert_moe_weights(p, l, smem, 0, 1, j0, j1); }
      __syncthreads();
      if (TIDX == 0) *nxt_s = nxt;
      __syncthreads();
      u = *nxt_s;
    }
    return;
  }
  for (int u = bid; u < nrw; u += G) rwkv_scan(p, u, TIDX >> 6);
  for (int u = bid; u < n_s + n_g; u += G) { if (u < n_s) ssd_states(p, l, u, smem); else gla_chunk(p, u - n_s, smem); }
  convert_moe_weights(p, l, smem, bid, G, 0, CVT_JOBS);
}
DEVFN void phase4b2(const Params& p) {
  const int bid = BIDX, G = (int)gridDim.x;
  ssd_scan(p, bid * 256 + TIDX, G * 256); gla_scan(p, bid * 256 + TIDX, G * 256);
}
DEVFN void phase4c(const Params& p, int l, unsigned char* smem) {
  const int n_s = B_ * NC128 * 8, n_r = B_ * 8 * NC16 / 4, n_g = B_ * NC64, total = n_s + n_r + n_g, G = (int)gridDim.x;
  unsigned* ctr = (unsigned*)(p.ws + Ws::BAR) + l * 32;
  volatile int* nxt_s = (volatile int*)(smem + SM_PRE);
  int u = BIDX;
  while (u < total) {
    int nxt = 0;
    if (TIDX == 0) nxt = G + (int)atomicAdd(ctr, 1u);
    if (u < n_s) ssd_out(p, l, u, smem); else if (u < n_s + n_r) rwkv_out(p, (u - n_s) * 4); else gla_out(p, (u - n_s - n_r) * 4);
    __syncthreads();
    if (TIDX == 0) *nxt_s = nxt;
    __syncthreads();
    u = *nxt_s;
  }
}

DEVFN void phase5(const Params& p, int l, unsigned char* smem) {
  const int tid = TIDX, lane = tid & 63, wave = tid >> 6;
  const bf16_t* ZX = (const bf16_t*)(p.ws + Ws::ZX);
  const bf16_t* XBC = (const bf16_t*)(p.ws + Ws::XBC);
  const float* YS = (const float*)(p.ws + Ws::YS); const float* YR = (const float*)(p.ws + Ws::YR); const float* OI = (const float*)(p.ws + Ws::OI);
  const bf16_t* RR = (const bf16_t*)(p.ws + Ws::RR); const bf16_t* VV = (const bf16_t*)(p.ws + Ws::VV); const bf16_t* KD = (const bf16_t*)(p.ws + Ws::KD);
  const float* GATE = (const float*)(p.ws + Ws::GATE);
  bf16_t* YM = (bf16_t*)(p.ws + Ws::YMIX);
  constexpr int TPI = 4;
  float* red = (float*)smem;
  const float dA = INP(I_SSDD)[(size_t)l * 8 + (tid >> 6)], dB = INP(I_SSDD)[(size_t)l * 8 + 4 + (tid >> 6)];
  const float nwA = INP(I_SSDNW)[(size_t)l * 512 + tid], nwB = INP(I_SSDNW)[(size_t)l * 512 + 256 + tid];
  const float lnw = INP(I_LNXW)[(size_t)l * 256 + tid], lnb = INP(I_LNXB)[(size_t)l * 256 + tid], rk = INP(I_RK)[(size_t)l * 256 + tid];
  const float gnw = INP(I_GNW)[(size_t)l * 256 + tid];
  const int per_ = (NT_ / TPI + (int)gridDim.x - 1) / (int)gridDim.x, tp_lo = BIDX * per_, tp_hi = (tp_lo + per_ < NT_ / TPI) ? tp_lo + per_ : NT_ / TPI;
  for (int tp = tp_lo; tp < tp_hi; ++tp) {
    float ys0[TPI], ys1[TPI], x0[TPI], x1[TPI], z0[TPI], z1[TPI], og[TPI], yr[TPI], rr[TPI], kf[TPI], kb[TPI], vv[TPI], gt[TPI], oi[TPI];
#pragma unroll
    for (int t = 0; t < TPI; ++t) { const int tok = tp * TPI + t;
      ys0[t] = gptr(YS)[(size_t)tok * 512 + tid]; ys1[t] = gptr(YS)[(size_t)tok * 512 + 256 + tid];
      x0[t] = bf2f(gptr(XBC)[(size_t)tok * 1024 + tid]); x1[t] = bf2f(gptr(XBC)[(size_t)tok * 1024 + 256 + tid]);
      z0[t] = zxv(ZX, tok, OZ + tid); z1[t] = zxv(ZX, tok, OZ + 256 + tid); og[t] = zxv(ZX, tok, OOG + tid);
      yr[t] = gptr(YR)[(size_t)tok * 256 + tid] + gptr(YR)[((size_t)NT_ + tok) * 256 + tid];
      rr[t] = bf2f(gptr(RR)[(size_t)tok * 256 + tid]); kf[t] = bf2f(gptr(KD)[(size_t)tok * 256 + tid]); kb[t] = bf2f(gptr(KD)[((size_t)NT_ + tok) * 256 + tid]);
      vv[t] = bf2f(gptr(VV)[(size_t)tok * 256 + tid]); gt[t] = gptr(GATE)[(size_t)tok * 256 + tid]; oi[t] = gptr(OI)[(size_t)tok * 256 + tid];
    }
    float ya[TPI], yb[TPI], qa[TPI], qb[TPI];
#pragma unroll
    for (int t = 0; t < TPI; ++t) {
      ya[t] = (ys0[t] + dA * x0[t]) * siluf_(z0[t]); yb[t] = (ys1[t] + dB * x1[t]) * siluf_(z1[t]);
      qa[t] = wave_sum(ya[t] * ya[t]); qb[t] = wave_sum(yb[t] * yb[t]); }
    __syncthreads();
#pragma unroll
    for (int t = 0; t < TPI; ++t)
      if (lane == 0) { red[t * 8 + wave] = qa[t]; red[t * 8 + 4 + wave] = qb[t]; }
    __syncthreads();
#pragma unroll
    for (int t = 0; t < TPI; ++t) { const int tok = tp * TPI + t;
      const float* rd = red + t * 8;
      float ma = (rd[0] + rd[1] + rd[2] + rd[3]) * (1.f / 256.f), mb = (rd[4] + rd[5] + rd[6] + rd[7]) * (1.f / 256.f);
      YM[(size_t)tok * 1024 + tid] = f2bf(ya[t] * rsqrtf(ma + 1e-5f) * nwA);
      YM[(size_t)tok * 1024 + 256 + tid] = f2bf(yb[t] * rsqrtf(mb + 1e-5f) * nwB);
      { const float y = yr[t];
        float mu = wave_sum(y) * (1.f / 64.f), d = y - mu, var = wave_sum(d * d) * (1.f / 64.f);
        float yn = d * rsqrtf(var + 64e-5f) * lnw + lnb;
        float bonus = wave_sum(rr[t] * (kf[t] + kb[t]) * rk) * vv[t];
        YM[(size_t)tok * 1024 + 512 + tid] = f2bf((yn + bonus) * gt[t]); }
      { float o = oi[t];
        float ms = wave_sum(o * o) * (1.f / 64.f);
        YM[(size_t)tok * 1024 + 768 + tid] = f2bf(o * rsqrtf(ms + 1e-5f) * gnw * siluf_(og[t])); } }
  }
}

DEVFN void phase6(const Params& p, int l, unsigned char* smem) {
  const bf16_t* A = (const bf16_t*)(p.ws + Ws::YMIX);
  const bf16_t* W = (const bf16_t*)(p.ws + Ws::WOUT) + (size_t)l * 1024 * 1024;
  float* MIX = (float*)(p.ws + Ws::MIX);
  for (int u = BIDX; u < (NT_ / 128) * 8; u += gridDim.x) {
    int rt = u / 8, ct = u % 8;
    gemm_tile(smem, 1024,
      [&](int r) { return A + (size_t)(rt * 128 + r) * 1024; },
      [&](int r) { return W + (size_t)(ct * 128 + r) * 1024; },
      [&](f32x4 (&acc)[4][4], int wr, int wc, int g, int l15) {
#pragma unroll
        for (int mi = 0; mi < 4; ++mi)
#pragma unroll
          for (int ni = 0; ni < 4; ++ni)
#pragma unroll
            for (int i = 0; i < 4; ++i) MIX[(size_t)(rt * 128 + wr * 64 + mi * 16 + 4 * g + i) * 1024 + ct * 128 + wc * 64 + ni * 16 + l15] = acc[mi][ni][i];
      });
  }
}

#define P7_MAXE 2048
DEVFN void phase7(const Params& p, int l, unsigned char* smem) {
  const int lane = TIDX & 63, wave = TIDX >> 6;
  float* X = (float*)(p.ws + Ws::X);
  const float* MIX = (const float*)(p.ws + Ws::MIX);
  bf16_t* H = (bf16_t*)(p.ws + Ws::U);
  const float* rwt = (const float*)(p.ws + Ws::RWT) + (size_t)l * 64 * 1024;
  int* cnt = (int*)(p.ws + Ws::CNT) + l * 64 * 64;
  int* ltok = (int*)(p.ws + Ws::LTOK); float* lwt = (float*)(p.ws + Ws::LWT);
  const float rbias = INP(I_RB)[(size_t)l * 64 + lane];
  float* hs = (float*)smem;
  float* lg = hs + 4096;
  int* lcnt = (int*)(lg + 256);
  int* lbase = lcnt + 80;
  int* etok = lbase + 64;
  int* epos = etok + P7_MAXE; float* ewt = (float*)(epos + P7_MAXE);
  for (int i = TIDX; i < 80; i += 256) lcnt[i] = 0;
  for (int tok0 = BIDX * 4; tok0 < NT_; tok0 += gridDim.x * 4) {
    const int tok = tok0 + wave;
    const float* mod = (const float*)(p.ws + Ws::MOD) + ((size_t)l * NR_ + tok_modrow(tok)) * NMOD_;
    float xv[16], mx[16], g1[16], lw[16], lb[16], sh2[16], sc2[16], mean, rstd;
    load_row16(X + (size_t)tok * 1024, lane, xv);
    load_row16(MIX + (size_t)tok * 1024, lane, mx);
    load_row16(mod + 2 * 1024, lane, g1);
    load_row16(INP(I_LN1W) + (size_t)l * 1024, lane, lw);
    load_row16(INP(I_LN1B) + (size_t)l * 1024, lane, lb);
    load_row16(mod + 3 * 1024, lane, sh2);
    load_row16(mod + 4 * 1024, lane, sc2);
#pragma unroll
    for (int i = 0; i < 16; ++i) xv[i] = ALPHA_ * xv[i] + g1[i] * mx[i];
    row_stats(xv, mean, rstd);
#pragma unroll
    for (int i = 0; i < 16; ++i) xv[i] = (xv[i] - mean) * rstd * lw[i] + lb[i];
#pragma unroll
    for (int j = 0; j < 4; ++j) *(float4*)(X + (size_t)tok * 1024 + lane * 4 + 256 * j) = make_float4(xv[4 * j], xv[4 * j + 1], xv[4 * j + 2], xv[4 * j + 3]);
    const bool routed = !(l == DEPTH_ - 1 && (tok % T_) < CTX_);
    row_stats(xv, mean, rstd);
#pragma unroll
    for (int i = 0; i < 16; ++i) xv[i] = (xv[i] - mean) * rstd * (1.f + sc2[i]) + sh2[i];
    __syncthreads();
#pragma unroll
    for (int j = 0; j < 4; ++j) {
      if (routed) *(uint2*)(H + (size_t)tok * 1024 + lane * 4 + 256 * j) = make_uint2((unsigned)f2bf(xv[4 * j]) | ((unsigned)f2bf(xv[4 * j + 1]) << 16), (unsigned)f2bf(xv[4 * j + 2]) | ((unsigned)f2bf(xv[4 * j + 3]) << 16));
      *(float4*)(hs + wave * 1024 + lane * 4 + 256 * j) = make_float4(xv[4 * j], xv[4 * j + 1], xv[4 * j + 2], xv[4 * j + 3]); }
    __syncthreads();
    { float hv[4][16];
      const int rot = BIDX & 15;
#pragma unroll
      for (int t = 0; t < 4; ++t)
#pragma unroll
        for (int j = 0; j < 4; ++j) { const float4 v = *(const float4*)(hs + t * 1024 + lane * 4 + 256 * j); hv[t][4 * j] = v.x; hv[t][4 * j + 1] = v.y; hv[t][4 * j + 2] = v.z; hv[t][4 * j + 3] = v.w; }
      float pe[64];
      const AS1 float* rw = gptr(rwt) + lane * 4;
      f32x4 w[4], wn[4];
#pragma unroll
      for (int j = 0; j < 4; ++j) w[j] = *(const AS1 f32x4*)(rw + (size_t)(16 * wave + (rot & 15)) * 1024 + 256 * j);
#pragma unroll
      for (int e = 0; e < 16; ++e) {
        if (e + 1 < 16) {
#pragma unroll
          for (int j = 0; j < 4; ++j) wn[j] = *(const AS1 f32x4*)(rw + (size_t)(16 * wave + ((e + 1 + rot) & 15)) * 1024 + 256 * j); }
#pragma unroll
        for (int t = 0; t < 4; ++t) { float s0 = 0.f, s1 = 0.f;
#pragma unroll
          for (int j = 0; j < 4; ++j) { s0 += hv[t][4 * j] * w[j][0] + hv[t][4 * j + 2] * w[j][2]; s1 += hv[t][4 * j + 1] * w[j][1] + hv[t][4 * j + 3] * w[j][3]; }
          pe[e * 4 + t] = s0 + s1; }
#pragma unroll
        for (int j = 0; j < 4; ++j) w[j] = wn[j]; }
#pragma unroll
      for (int half = 32; half >= 1; half >>= 1) { const bool up = (lane & half) != 0;
#pragma unroll
        for (int e = 0; e < half; ++e) { const float send = up ? pe[e] : pe[e + half]; const float recv = __shfl_xor(send, half); pe[e] = (up ? pe[e + half] : pe[e]) + recv; } }
      lg[(lane & 3) * 64 + 16 * wave + (((lane >> 2) + rot) & 15)] = pe[0]; }
    __syncthreads();
    if (!routed) continue;
    const float logit = lg[wave * 64 + lane];
    const float score = sigmoidf_(logit), sel = score + rbias;
    float m1 = sel; int a1 = lane;
#pragma unroll
    for (int m = 1; m <= 4; m <<= 1) { float ov = XOR8(m1, m); int oa = XOR8(a1, m); if (ov > m1 || (ov == m1 && oa < a1)) { m1 = ov; a1 = oa; } }
    float m2 = (lane == a1) ? -3.0e38f : sel;
#pragma unroll
    for (int m = 1; m <= 4; m <<= 1) m2 = fmaxf(m2, XOR8(m2, m));
    const float gs = m1 + m2; const int grp = lane >> 3;
    int grank = 0;
#pragma unroll
    for (int g2 = 0; g2 < 8; ++g2) { float og = SHFL_CONST(gs, g2 * 8); grank += (og > gs || (og == gs && g2 < grp)) ? 1 : 0; }
    const bool gsel = grank < 4;
    const float msel = gsel ? sel : -3.0e38f;
    int rank = 0;
#pragma unroll
    for (int e = 0; e < 64; ++e) { float ov = SHFL_CONST(msel, e); rank += (ov > msel || (ov == msel && e < lane)) ? 1 : 0; }
    const bool chosen = gsel && rank < 8;
    const float wsum = wave_sum(chosen ? score : 0.f);
    if (chosen) { const float wv = score / wsum * 2.5f;
      const int idx = atomicAdd(&lcnt[64], 1);
      if (idx < P7_MAXE) { const int slot = atomicAdd(&lcnt[lane], 1); etok[idx] = tok * 8 + rank; epos[idx] = lane | (slot << 8); ewt[idx] = wv; }
      else { int pos = atomicAdd(&cnt[lane * 64], 1); ltok[(size_t)lane * NT_ + pos] = tok * 8 + rank; lwt[(size_t)lane * NT_ + pos] = wv; } }
  }
  __syncthreads();
  if (TIDX < 64) { const int c = lcnt[TIDX]; lbase[TIDX] = c ? atomicAdd(&cnt[TIDX * 64], c) : 0; }
  __syncthreads();
  { const int ne = lcnt[64] < P7_MAXE ? lcnt[64] : P7_MAXE;
    for (int i = TIDX; i < ne; i += 256) { const int e = epos[i] & 255, pos = lbase[e] + (epos[i] >> 8);
      ltok[(size_t)e * NT_ + pos] = etok[i]; lwt[(size_t)e * NT_ + pos] = ewt[i]; } }
}

struct MoeMap { int nblk_total; int e; int rb; int cnt; int hoff; };
DEVFN int moe_ntok(int l) { return l == DEPTH_ - 1 ? B_ * SEQ_ : NT_; }
DEVFN int moe_shared_tok(int l, int i) { return l == DEPTH_ - 1 ? (i / SEQ_) * T_ + CTX_ + (i % SEQ_) : i; }
DEVFN void moe_prefix(const Params& p, int l, int* pre) {
  const int* cnt = (const int*)(p.ws + Ws::CNT) + l * 64 * 64;
  __syncthreads();
  if (TIDX < 64) pre[66 + TIDX] = gptr(cnt)[TIDX * 64];
  if (TIDX == 64) pre[66 + 64] = moe_ntok(l);
  __syncthreads();
  if (TIDX == 0) { int s = 0; for (int e = 0; e < 65; ++e) { pre[e] = s; s += (pre[66 + e] + 127) / 128; } pre[65] = s; }
  __syncthreads();
}
DEVFN void phase8(const Params& p, int l, unsigned char* smem) {
  int* pre = (int*)(smem + SM_PRE);
  moe_prefix(p, l, pre);
  const bf16_t* H = (const bf16_t*)(p.ws + Ws::U);
  const bf16_t* W13 = (const bf16_t*)(p.ws + Ws::W13);
  bf16_t* HID = (bf16_t*)(p.ws + Ws::HID);
  const int* ltok = (const int*)(p.ws + Ws::LTOK); const float* lwt = (const float*)(p.ws + Ws::LWT);
  const int total = pre[65];
  for (int u = BIDX; u < total * 2; u += gridDim.x) {
    const int gb = u >> 1, nt = u & 1;
    int e = 0; while (pre[e + 1] <= gb) ++e;
    e = UNI(e);
    const int rb = UNI(gb - pre[e]), cnt = UNI(pre[66 + e]);
    int* tk_s = (int*)(smem + GEMMW_SMEM); float* gw_s = (float*)(tk_s + 128);
    __syncthreads();
    if (TIDX < 128) { const int pos = rb * 128 + TIDX; int tk = -1; float gw = 0.f;
      if (pos < cnt) { tk = e < 64 ? (gptr(ltok)[(size_t)e * NT_ + pos] >> 3) : moe_shared_tok(l, pos); gw = e < 64 ? gptr(lwt)[(size_t)e * NT_ + pos] : 1.f; }
      tk_s[TIDX] = tk; gw_s[TIDX] = gw; }
    __syncthreads();
    gemm_tile_w<1, 1024>(smem, 1024,
      [&](int r) { const int tk = tk_s[r]; return tk >= 0 ? H + (size_t)tk * 1024 : (const bf16_t*)(p.ws + Ws::ZROW); },
      [&](int) { return W13 + ((size_t)e * 512 + nt * 256) * 1024; },
      [&](f32x4 (&acc)[4][8], int, int wr, int wc, int g, int l15) {
        tile_store_bf16<16>(smem, wr, g, l15,
          [&](bf16_t* T, int ldc) {
#pragma unroll
            for (int mi = 0; mi < 4; ++mi)
#pragma unroll
              for (int i = 0; i < 4; ++i) { const int r = wr * 64 + mi * 16 + 4 * g + i;
                const float gw = gw_s[r];
#pragma unroll
                for (int j = 0; j < 4; ++j) T[r * ldc + wc * 64 + j * 16 + l15] = f2bf(siluf_(acc[mi][2 * j][i]) * acc[mi][2 * j + 1][i] * gw); } },
          [&](int row, int c0) { const int pos = rb * 128 + row; return pos < cnt ? HID + ((size_t)gb * 128 + row) * 256 + nt * 128 + c0 : (bf16_t*)nullptr; });
      });
  }
}
DEVFN void phase9(const Params& p, int l, unsigned char* smem) {
  int* pre = (int*)(smem + SM_PRE);
  moe_prefix(p, l, pre);
  const bf16_t* HID = (const bf16_t*)(p.ws + Ws::HID);
  const bf16_t* W2T = (const bf16_t*)(p.ws + Ws::W2T);
  bf16_t* YB = (bf16_t*)(p.ws + Ws::YBUF);
  const int* ltok = (const int*)(p.ws + Ws::LTOK);
  const int total = pre[65];
  for (int u = BIDX; u < total * 2; u += gridDim.x) {
    const int gb = u >> 1, ntp = u & 1;
    int e = 0; while (pre[e + 1] <= gb) ++e;
    e = UNI(e);
    const int rb = UNI(gb - pre[e]), cnt = UNI(pre[66 + e]);
    int* ts_s = (int*)(smem + GEMMW_SMEM);
    __syncthreads();
    if (TIDX < 128) { const int pos = rb * 128 + TIDX; int ts = -1;
      if (pos < cnt) ts = e < 64 ? gptr(ltok)[(size_t)e * NT_ + pos] : moe_shared_tok(l, pos) * 8;
      ts_s[TIDX] = ts; }
    __syncthreads();
    gemm_tile_w<2, 256>(smem, 256,
      [&](int r) { return ts_s[r] >= 0 ? HID + ((size_t)gb * 128 + r) * 256 : (const bf16_t*)(p.ws + Ws::ZROW); },
      [&](int j) { return W2T + ((size_t)e * 1024 + (ntp * 2 + j) * 256) * 256; },
      [&](f32x4 (&acc)[4][8], int j, int wr, int wc, int g, int l15) { const int nt = ntp * 2 + j;
#pragma unroll 1
        for (int h = 0; h < 2; ++h)
          tile_store_bf16<16>(smem, wr, g, l15,
            [&](bf16_t* T, int ldc) {
              if (wc == h) {
#pragma unroll
                for (int mi = 0; mi < 4; ++mi)
#pragma unroll
                  for (int ni = 0; ni < 8; ++ni)
#pragma unroll
                    for (int i = 0; i < 4; ++i) T[(wr * 64 + mi * 16 + 4 * g + i) * ldc + ni * 16 + l15] = f2bf(acc[mi][ni][i]); } },
            [&](int row, int c0) { const int ts = ts_s[row]; if (ts < 0) return (bf16_t*)nullptr;
              const int tok = ts >> 3, slot = e < 64 ? (ts & 7) : 8;
              return YB + ((size_t)tok * NSLOT + slot) * 1024 + nt * 256 + h * 128 + c0; });
      });
  }
}

#define SMEM_BYTES (PH_SMEM + 2048)
#define N_PHASES (3 + 13 * DEPTH_)
__global__ void __launch_bounds__(256, 2) mega(Params p, int ph_lo, int ph_hi) {
#ifdef HIPEMU
  unsigned char* smem = hipemu::cur_smem();
#else
  unsigned char* smem = smem_dyn;
  volatile LAS unsigned* st = (volatile LAS unsigned*)(smem_dyn + SM_BAR);
  if (threadIdx.x == 0) {
    st[0] = 0u; st[1] = 0u;
    unsigned long long* tab = (unsigned long long*)(smem_dyn + SM_TAB);
#pragma unroll
    for (int i = 0; i < 40; ++i) tab[i] = (unsigned long long)p.in[i];
  }
  __syncthreads();
  XcdBarrier bar = xcd_barrier_post((unsigned*)(p.ws + Ws::BAR), st);
#define GRID_SYNC() xcd_barrier(bar)
#endif
  int ph = 0;
#ifdef ONLY_KIND
#define KIND_ON(k) ((k) == ONLY_KIND)
#else
#define KIND_ON(k) 1
#endif
#ifndef REPEAT_MASK
#define REPEAT_MASK 0u
#endif
#define RUN_PHASE(kind, code) { if (KIND_ON(kind) && ph >= ph_lo && ph < ph_hi) { \
    int nrep_ = ((REPEAT_MASK >> (kind)) & 1u) ? 2 : 1; LAUNDER(nrep_); \
    _Pragma("unroll 1") for (int rep_ = 0; rep_ < nrep_; ++rep_) { LAUNDER(p.ws); LAUNDER(p.out); code; if (rep_ + 1 < nrep_ || ph + 1 < ph_hi) { GRID_SYNC(); } } } ++ph; }
  RUN_PHASE(0, phase0(p, smem));
  RUN_PHASE(11, phase0b(p));
  for (int l = 0; l < DEPTH_; ++l) {
    RUN_PHASE(1, phase1(p, l));
    RUN_PHASE(2, phase2(p, l, smem));
    RUN_PHASE(3, phase3(p, l, smem));
    RUN_PHASE(14, phase3b(p, l, smem));
    RUN_PHASE(4, phase4a(p, l, smem));
    RUN_PHASE(12, phase4b(p, l, smem));
    RUN_PHASE(16, phase4b2(p));
    RUN_PHASE(13, phase4c(p, l, smem));
    RUN_PHASE(5, phase5(p, l, smem));
    RUN_PHASE(6, phase6(p, l, smem));
    RUN_PHASE(7, phase7(p, l, smem));
    RUN_PHASE(8, phase8(p, l, smem));
    RUN_PHASE(9, phase9(p, l, smem));
  }
  RUN_PHASE(10, phase_final(p));
}

extern "C" void kernel_launch(void* const* d_in, const int* in_sizes, int n_in, void* d_out, int out_size, void* d_ws, size_t ws_size, hipStream_t stream) {
  Params p{};
  for (int i = 0; i < 40; ++i) p.in[i] = (const float*)d_in[i];
  p.out = (float*)d_out;
  p.ws = (unsigned char*)d_ws;
  if (ws_size < Ws::END) { fprintf(stderr, "workspace too small: %zu < %zu\n", ws_size, (size_t)Ws::END); return; }
  hipMemsetAsync(d_ws, 0, Ws::ZERO_END, stream);
#ifdef HIPEMU
  int grid = 16; if (const char* e = getenv("EMU_GRID")) grid = atoi(e);
  int stop = N_PHASES; if (const char* e = getenv("EMU_STOP")) stop = atoi(e);
  if (getenv("EMU_ONE")) hipemu::launch(grid, 256, SMEM_BYTES, true, [=] { mega(p, 0, stop); });
  else for (int ph = 0; ph < stop; ++ph) hipemu::launch(grid, 256, SMEM_BYTES, false, [=] { mega(p, ph, ph + 1); });
#else
  static int grid = 0;
  if (!grid) {
    int dev = 0, cus = 0, per_cu = 0;
    hipGetDevice(&dev);
    hipDeviceGetAttribute(&cus, hipDeviceAttributeMultiprocessorCount, dev);
    hipOccupancyMaxActiveBlocksPerMultiprocessor(&per_cu, mega, 256, SMEM_BYTES);
    if (per_cu > 2) per_cu = 2;
    if (per_cu < 1) per_cu = 1;
    grid = cus * per_cu;
  }
#if N_LAUNCH_MODE == 1
  mega<<<grid, 256, SMEM_BYTES, stream>>>(p, 0, N_PHASES);
#else
  for (int ph = 0; ph < N_PHASES; ++ph) mega<<<grid, 256, SMEM_BYTES, stream>>>(p, ph, ph + 1);
#endif
#endif
}
```

```cpp
#ifndef HIPEMU
#include <hip/hip_runtime.h>
#endif
#include <stdint.h>
#include <stdio.h>

#ifndef B_
#define B_ 4
#endif
#ifndef SEQ_
#define SEQ_ 4096
#endif
#ifndef CTX_
#define CTX_ 256
#endif
#ifndef DEPTH_
#define DEPTH_ 4
#endif
#ifndef N_LAUNCH_MODE
#define N_LAUNCH_MODE 1
#endif
#define T_ (SEQ_ + CTX_)
#define NT_ (B_ * T_)
#define D_ 1024
#define NIN_ 3504
#define NMOD_ 6144
#define NR_ (B_ + 1)
#define OZ 0
#define OXBC 512
#define ODT 1536
#define ORW 1552
#define OGQ 2704
#define OGK 2832
#define OGV 2960
#define OGD 3216
#define OOG 3248
#define ALPHA_ 1.681792830507429f
#define NEXP 64
#define NSLOT 9
#define NC128 (T_ / 128)
#define NC64 (T_ / 64)
#define NC16 (T_ / 16)

#define DEVFN __device__ __forceinline__
#define LDT 72
#define GEMM_SMEM (2 * 128 * LDT * 2)
#define GEMMW_SMEM (3 * 128 * LDT * 2)
typedef unsigned short bf16_t;
#ifdef HIPEMU
#define AS1
#else
#define AS1 __attribute__((address_space(1)))
#endif
typedef unsigned u32x4 __attribute__((ext_vector_type(4)));
typedef unsigned u32x2 __attribute__((ext_vector_type(2)));

#ifdef HIPEMU
typedef emu_bf16x8 bf16x8;
typedef emu_f32x4 f32x4;
#define MFMA16(a, b, c) emu_mfma_16x16x32_bf16(a, b, c)
#define MFMA16K16(a, b, c) emu_mfma_16x16x16_bf16(a, b, c)
#define GRID_SYNC() hipemu::grid_sync()
#else
typedef short bf16x8 __attribute__((ext_vector_type(8)));
typedef float f32x4 __attribute__((ext_vector_type(4)));
#define MFMA16(a, b, c) __builtin_amdgcn_mfma_f32_16x16x32_bf16(a, b, c, 0, 0, 0)
#define MFMA16K16(a, b, c) __builtin_amdgcn_mfma_f32_16x16x16bf16_1k(a, b, c, 0, 0, 0)
#endif

DEVFN float bf2f(bf16_t h) { return __builtin_bit_cast(float, (unsigned)h << 16); }
DEVFN bf16_t f2bf(float f) { unsigned u = __builtin_bit_cast(unsigned, f); u += 0x7FFFu + ((u >> 16) & 1u); return (bf16_t)(u >> 16); }
template <class T> DEVFN AS1 T* gptr(T* q) { return (AS1 T*)q; }
DEVFN bf16x8 ld8g(const bf16_t* q) { return *(const AS1 bf16x8*)gptr(q); }
DEVFN float sigmoidf_(float x) { return 1.f / (1.f + expf(-x)); }
DEVFN float siluf_(float x) { return x / (1.f + expf(-x)); }
DEVFN float softplusf_(float x) { return x > 20.f ? x : log1pf(expf(x)); }
DEVFN float logsigmoidf_(float x) { return fminf(x, 0.f) - log1pf(expf(-fabsf(x))); }
#ifdef HIPEMU
DEVFN float wave_sum(float v) { for (int m = 32; m >= 1; m >>= 1) v += __shfl_xor(v, m); return v; }
#define SHFL_CONST(x, ln) __shfl(x, ln)
#define XOR8(x, m) __shfl_xor(x, m)
#else
template <int CTRL> DEVFN float dpp_f(float v) { return __builtin_bit_cast(float, __builtin_amdgcn_update_dpp(0, __builtin_bit_cast(int, v), CTRL, 0xF, 0xF, false)); }
template <int CTRL> DEVFN int dpp_i(int v) { return __builtin_amdgcn_update_dpp(0, v, CTRL, 0xF, 0xF, false); }
DEVFN float rdl_f(float v, int ln) { return __builtin_bit_cast(float, __builtin_amdgcn_readlane(__builtin_bit_cast(int, v), ln)); }
DEVFN float wave_sum(float v) {
  v += dpp_f<0xB1>(v);
  v += dpp_f<0x4E>(v);
  v += dpp_f<0x141>(v);
  v += dpp_f<0x140>(v);
  return (rdl_f(v, 0) + rdl_f(v, 16)) + (rdl_f(v, 32) + rdl_f(v, 48));
}
DEVFN float shfl_const_(float x, int ln) { return rdl_f(x, ln); }
DEVFN int shfl_const_(int x, int ln) { return __builtin_amdgcn_readlane(x, ln); }
#define SHFL_CONST(x, ln) shfl_const_(x, ln)
DEVFN float xor8_(float x, int m) { return m == 1 ? dpp_f<0xB1>(x) : m == 2 ? dpp_f<0x4E>(x) : dpp_f<0x141>(x); }
DEVFN int xor8_(int x, int m) { return m == 1 ? dpp_i<0xB1>(x) : m == 2 ? dpp_i<0x4E>(x) : dpp_i<0x141>(x); }
#define XOR8(x, m) xor8_(x, m)
#endif

constexpr size_t al(size_t x) { return (x + 255) & ~(size_t)255; }
struct Ws {
  static constexpr size_t BAR = 0;
  static constexpr size_t CNT = 16384;
  static constexpr size_t MOD = CNT + (size_t)DEPTH_ * 64 * 256;
  static constexpr size_t ZROW = al(MOD + (size_t)DEPTH_ * NR_ * NMOD_ * 4);
  static constexpr size_t ZERO_END = al(ZROW + 2048);
  static constexpr size_t MODP = ZERO_END;
  static constexpr size_t RWT = al(MODP + (size_t)16 * DEPTH_ * NR_ * NMOD_ * 4);
  static constexpr size_t LORA = al(RWT + (size_t)DEPTH_ * 64 * 1024 * 4);
  static constexpr size_t X = al(LORA + (size_t)DEPTH_ * 98304 * 2);
  static constexpr size_t U = al(X + (size_t)NT_ * 1024 * 4);
  static constexpr size_t YMIX = al(U + (size_t)NT_ * 1024 * 2);
  static constexpr size_t ZX = al(YMIX + (size_t)NT_ * 1024 * 2);
  static constexpr size_t MIX = ZX;
  static constexpr size_t LTOK = al(ZX + (size_t)NT_ * NIN_ * 2);
  static constexpr size_t LWT = al(LTOK + (size_t)64 * NT_ * 4);
  static constexpr size_t WIN = al(LWT + (size_t)64 * NT_ * 4);
  static constexpr size_t WOUT = al(WIN + (size_t)DEPTH_ * NIN_ * 1024 * 2);
  static constexpr size_t W13 = al(WOUT + (size_t)DEPTH_ * 1024 * 1024 * 2);
  static constexpr size_t W2T = al(W13 + (size_t)65 * 512 * 1024 * 2);
  static constexpr size_t UNI = al(W2T + (size_t)65 * 1024 * 256 * 2);
  static constexpr size_t XBC = UNI;
  static constexpr size_t XBCT = al(XBC + (size_t)NT_ * 1024 * 2);
  static constexpr size_t DTB = al(XBCT + (size_t)NT_ * 768 * 2);
  static constexpr size_t SST = al(DTB + (size_t)NT_ * 16 * 4);
  static constexpr size_t SCD = al(SST + (size_t)2 * NT_ / 128 * 8 * 8192 * 4);
  static constexpr size_t HIN = al(SCD + (size_t)2 * NT_ / 128 * 8 * 4);
  static constexpr size_t YS = SST;
  static constexpr size_t LA = al(HIN + (size_t)2 * NT_ / 128 * 8 * 8192 * 2);
  static constexpr size_t VT = al(LA + (size_t)2 * NT_ * 128 * 4);
  static constexpr size_t QT = al(VT + (size_t)NT_ * 256 * 2);
  static constexpr size_t OI = al(QT + (size_t)2 * NT_ * 128 * 2);
  static constexpr size_t GST = al(OI + (size_t)NT_ * 256 * 4);
  static constexpr size_t GCD = al(GST + (size_t)2 * NT_ / 64 * 4 * 2048 * 4);
  static constexpr size_t GSIN = al(GCD + (size_t)2 * NT_ / 64 * 4 * 32 * 4);
  static constexpr size_t RR = al(GSIN + (size_t)2 * NT_ / 64 * 4 * 2048 * 2);
  static constexpr size_t VV = RR + (size_t)NT_ * 256 * 2;
  static constexpr size_t KK = VV + (size_t)NT_ * 256 * 2;
  static constexpr size_t KD = KK + (size_t)NT_ * 256 * 2;
  static constexpr size_t BD = KD + (size_t)2 * NT_ * 256 * 2;
  static constexpr size_t LW = BD + (size_t)2 * NT_ * 256 * 2;
  static constexpr size_t GATE = LW + (size_t)2 * NT_ * 256 * 4;
  static constexpr size_t YR = GATE + (size_t)NT_ * 256 * 4;
  static constexpr size_t RML = al(YR + (size_t)2 * NT_ * 256 * 4);
  static constexpr size_t RNS = RML + (size_t)(NT_ / 16) * 8 * 4096 * 2;
  static constexpr size_t RWC = RNS + (size_t)(NT_ / 16) * 8 * 4096 * 2;
  static constexpr size_t RG = RWC + (size_t)(NT_ / 16) * 8 * 64 * 4;
  static constexpr size_t RY0 = RG + (size_t)(NT_ / 16) * 8 * 1024 * 2;
  static constexpr size_t LI = RY0 + (size_t)(NT_ / 16) * 8 * 1024 * 4;
  static constexpr size_t KRW = LI + (size_t)NT_ * 384 * 2;
  static constexpr size_t MIXER_END = KRW + (size_t)NT_ * 256 * 2;
  static constexpr size_t HID = UNI;
  static constexpr size_t YBUF = al(HID + ((size_t)NT_ * 9 + 65 * 128) * 256 * 2);
  static constexpr size_t MOE_END = YBUF + (size_t)NT_ * 9 * 1024 * 2;
  static constexpr size_t END = al(MIXER_END > MOE_END ? MIXER_END : MOE_END);
};

struct Params {
  const float* in[40];
  float* out;
  unsigned char* ws;
};
enum { I_X = 0, I_C, I_CTX, I_CCTX, I_ADAW, I_ADAB, I_WIN, I_CONVW, I_CONVB, I_DTBIAS, I_ALOG, I_SSDD, I_SSDNW, I_MU, I_W0, I_W2, I_A0, I_A2,
       I_G2, I_KKW, I_KAW, I_RK, I_LNXW, I_LNXB, I_GU, I_GB, I_GNW, I_WOUT, I_LN1W, I_LN1B, I_LN2W, I_LN2B, I_RW, I_RB, I_EW1, I_EW3, I_EW2,
       I_SW1, I_SW3, I_SW2 };

#define PH_SMEM 57344
#define SM_PRE (PH_SMEM)
#define SM_TAB (PH_SMEM + 1024)
#define SM_BAR (PH_SMEM + 2032)
#ifdef HIPEMU
#define INP(i) (p.in[i])
#define LAUNDER(x)
#define TIDX ((int)threadIdx.x)
#define BIDX ((int)blockIdx.x)
#define LAUNDER_V(x)
#define UNI(x) (x)
#else
extern __shared__ __align__(16) unsigned char smem_dyn[];
DEVFN const float* inp_lds(int i) {
  const volatile unsigned* t = (const volatile unsigned*)(smem_dyn + SM_TAB) + 2 * i;
  unsigned lo = __builtin_amdgcn_readfirstlane(t[0]), hi = __builtin_amdgcn_readfirstlane(t[1]);
  return (const float*)(((unsigned long long)hi << 32) | lo);
}
#define INP(i) inp_lds(i)
#define LAUNDER(x) asm volatile("" : "+s"(x))
DEVFN int tidx_() { int t = threadIdx.x; asm volatile("" : "+v"(t)); return t; }
DEVFN int bidx_() { int b = blockIdx.x; asm volatile("" : "+s"(b)); return b; }
#define TIDX tidx_()
#define LAUNDER_V(x) asm volatile("" : "+v"(x))
#define BIDX bidx_()
#define UNI(x) __builtin_amdgcn_readfirstlane(x)
#endif
#ifndef HIPEMU
#define XB_TMO      128
#define XB_XCNT(j)  (256  + 64 * (j))
#define XB_XSUB(j)  (1280 + 64 * (j))
#define XB_XGEN(j)  (2304 + 64 * (j))
#define XB_TOP      3328
#define XB_TOPGEN   3392
#define XCD_BAR_WORDS 3456
#define XB_SPIN_CAP (1u << 22)
#define LAS __attribute__((address_space(3)))
__device__ __forceinline__ unsigned xb_ld(unsigned* p)              { return __hip_atomic_load(p, __ATOMIC_RELAXED, __HIP_MEMORY_SCOPE_AGENT); }
__device__ __forceinline__ unsigned xb_add(unsigned* p, unsigned v) { return __hip_atomic_fetch_add(p, v, __ATOMIC_RELAXED, __HIP_MEMORY_SCOPE_AGENT); }
__device__ __forceinline__ unsigned xb_xcc_id() { return (unsigned)__builtin_amdgcn_s_getreg((3 << 11) | 20) & 0xFu; }
#define XB_SPIN(cond, bar) do { unsigned _sp = 0; while (cond) { __builtin_amdgcn_s_sleep(1); \
    if ((++_sp & 255u) == 0u) { if (xb_ld(&(bar)[XB_TMO])) break; if (_sp > XB_SPIN_CAP) { atomicAdd(&(bar)[XB_TMO], 1u); break; } } } } while (0)
struct XcdBarrier { unsigned* bar; unsigned x; volatile LAS unsigned* st; };
__device__ __forceinline__ XcdBarrier xcd_barrier_post(unsigned* bar, volatile LAS unsigned* st) {
    XcdBarrier b; b.bar = bar; b.x = xb_xcc_id(); b.st = st;
    if (threadIdx.x == 0) (void)xb_add(&bar[XB_XCNT(b.x)], 1u);
    return b;
}
__device__ __forceinline__ void xcd_barrier_complete(unsigned* bar, unsigned x, unsigned& nloc, unsigned& nx) {
    const unsigned G = gridDim.x * gridDim.y * gridDim.z;
    unsigned sum, cnt, mine, sp = 0u;
    for (;;) {
        sum = 0u; cnt = 0u; mine = 0u;
#pragma unroll
        for (unsigned j = 0; j < 16; ++j) { const unsigned c = xb_ld(&bar[XB_XCNT(j)]); sum += c; cnt += (c > 0u) ? 1u : 0u; mine = (j == x) ? c : mine; }
        if (sum == G) break;
        __builtin_amdgcn_s_sleep(1);
        if ((++sp & 255u) == 0u) { if (xb_ld(&bar[XB_TMO])) break; if (sp > XB_SPIN_CAP) { atomicAdd(&bar[XB_TMO], 1u); break; } }
    }
    nloc = mine > 0u ? mine : 1u; nx = cnt > 0u ? cnt : 1u;
}
__device__ __forceinline__ void xcd_barrier(const XcdBarrier& b) {
    asm volatile("s_waitcnt vmcnt(0)" ::: "memory");
    __syncthreads();
    if (threadIdx.x == 0) {
        unsigned* bar = b.bar;
        __builtin_amdgcn_s_waitcnt(0);
        unsigned nloc = b.st[0], nx = b.st[1];
        if (nloc == 0u) { xcd_barrier_complete(bar, b.x, nloc, nx); b.st[0] = nloc; b.st[1] = nx; }
        const unsigned old = xb_add(&bar[XB_XSUB(b.x)], 1u);
        const unsigned gen = old / nloc;
        if (old + 1u == (gen + 1u) * nloc) {
            __builtin_amdgcn_fence(__ATOMIC_RELEASE, "agent");
            asm volatile("s_waitcnt vmcnt(0)" ::: "memory");
            const unsigned og = xb_add(&bar[XB_TOP], 1u);
            const unsigned tg = og / nx;
            if (og + 1u == (tg + 1u) * nx) xb_add(&bar[XB_TOPGEN], 1u);
            else XB_SPIN(xb_ld(&bar[XB_TOPGEN]) == tg, bar);
            __builtin_amdgcn_fence(__ATOMIC_ACQUIRE, "agent");
            xb_add(&bar[XB_XGEN(b.x)], 1u);
            asm volatile("s_waitcnt vmcnt(0)" ::: "memory");
        } else {
            XB_SPIN(xb_ld(&bar[XB_XGEN(b.x)]) == gen, bar);
            __builtin_amdgcn_fence(__ATOMIC_ACQUIRE, "agent");
            asm volatile("s_waitcnt vmcnt(0)" ::: "memory");
        }
    }
    __syncthreads();
}
#endif

DEVFN int tokmap(int dir, int p) { return dir == 0 ? p : (p < CTX_ ? CTX_ - 1 - p : 2 * CTX_ + SEQ_ - 1 - p); }
DEVFN const float* tok_input_row(const Params& p, int tok) {
  int b = tok / T_, t = tok % T_;
  return t < CTX_ ? INP(I_CTX) + ((size_t)b * CTX_ + t) * D_ : INP(I_X) + ((size_t)b * SEQ_ + (t - CTX_)) * D_;
}
DEVFN int tok_modrow(int tok) { return (tok % T_) < CTX_ ? B_ : tok / T_; }

template <class ARow, class BRow, class Epi>
DEVFN void gemm_tile(unsigned char* smem, int K, ARow arow, BRow brow, Epi epi) {
  bf16_t* As = (bf16_t*)smem;
  bf16_t* Bs = As + 128 * LDT;
  const int tid = TIDX, lane = tid & 63, wave = tid >> 6, wr = wave >> 1, wc = wave & 1;
  const int g = lane >> 4, l15 = lane & 15;
  const int lr = tid >> 3, lc = (tid & 7) * 8;
  const AS1 bf16_t* ap[4];
  const AS1 bf16_t* bp[4];
#pragma unroll
  for (int i = 0; i < 4; ++i) { ap[i] = gptr(arow(lr + 32 * i)); bp[i] = gptr(brow(lr + 32 * i)); }
  f32x4 acc[4][4];
#pragma unroll
  for (int mi = 0; mi < 4; ++mi)
#pragma unroll
    for (int ni = 0; ni < 4; ++ni) acc[mi][ni] = f32x4{0.f, 0.f, 0.f, 0.f};
  u32x4 ra0[4], rb0[4], ra1[4], rb1[4];
#pragma unroll
  for (int i = 0; i < 4; ++i) { ra0[i] = *(const AS1 u32x4*)(ap[i] + lc); rb0[i] = *(const AS1 u32x4*)(bp[i] + lc); }
  if (K > 64) {
#pragma unroll
    for (int i = 0; i < 4; ++i) { ra1[i] = *(const AS1 u32x4*)(ap[i] + 64 + lc); rb1[i] = *(const AS1 u32x4*)(bp[i] + 64 + lc); } }
  auto compute = [&]() {
#pragma unroll
    for (int kk = 0; kk < 2; ++kk) {
      bf16x8 af[4], bfr[4];
#pragma unroll
      for (int mi = 0; mi < 4; ++mi) af[mi] = *(const bf16x8*)(As + (wr * 64 + mi * 16 + l15) * LDT + kk * 32 + g * 8);
#pragma unroll
      for (int ni = 0; ni < 4; ++ni) bfr[ni] = *(const bf16x8*)(Bs + (wc * 64 + ni * 16 + l15) * LDT + kk * 32 + g * 8);
#pragma unroll
      for (int mi = 0; mi < 4; ++mi)
#pragma unroll
        for (int ni = 0; ni < 4; ++ni) acc[mi][ni] = MFMA16(af[mi], bfr[ni], acc[mi][ni]);
    } };
  for (int k0 = 0; k0 < K; k0 += 128) {
    __syncthreads();
#pragma unroll
    for (int i = 0; i < 4; ++i) { *(u32x4*)(As + (lr + 32 * i) * LDT + lc) = ra0[i]; *(u32x4*)(Bs + (lr + 32 * i) * LDT + lc) = rb0[i]; }
    __syncthreads();
    if (k0 + 128 < K) {
#pragma unroll
      for (int i = 0; i < 4; ++i) { ra0[i] = *(const AS1 u32x4*)(ap[i] + k0 + 128 + lc); rb0[i] = *(const AS1 u32x4*)(bp[i] + k0 + 128 + lc); } }
    compute();
    if (k0 + 64 < K) {
      __syncthreads();
#pragma unroll
      for (int i = 0; i < 4; ++i) { *(u32x4*)(As + (lr + 32 * i) * LDT + lc) = ra1[i]; *(u32x4*)(Bs + (lr + 32 * i) * LDT + lc) = rb1[i]; }
      __syncthreads();
      if (k0 + 192 < K) {
#pragma unroll
        for (int i = 0; i < 4; ++i) { ra1[i] = *(const AS1 u32x4*)(ap[i] + k0 + 192 + lc); rb1[i] = *(const AS1 u32x4*)(bp[i] + k0 + 192 + lc); } }
      compute();
    }
  }
  epi(acc, wr, wc, g, l15);
}

template <int NB, class ARow, class BRow, class Epi>
DEVFN void gemm_tile_multi(unsigned char* smem, int K, ARow arow, BRow brow, Epi epi) {
  bf16_t* As = (bf16_t*)smem;
  bf16_t* Bs = As + 128 * LDT;
  const int tid = TIDX, lane = tid & 63, wave = tid >> 6, wr = wave >> 1, wc = wave & 1;
  const int g = lane >> 4, l15 = lane & 15;
  const int lr = tid >> 3, lc = (tid & 7) * 8;
  const AS1 bf16_t* ap[4];
  const AS1 bf16_t* bp[4];
#pragma unroll
  for (int i = 0; i < 4; ++i) { ap[i] = gptr(arow(lr + 32 * i)); bp[i] = gptr(brow(lr + 32 * i, 0)); }
  f32x4 acc[4][4];
  u32x4 ra0[4], rb0[4], ra1[4], rb1[4];
#pragma unroll
  for (int i = 0; i < 4; ++i) { ra0[i] = *(const AS1 u32x4*)(ap[i] + lc); rb0[i] = *(const AS1 u32x4*)(bp[i] + lc); }
  if (K > 64) {
#pragma unroll
    for (int i = 0; i < 4; ++i) { ra1[i] = *(const AS1 u32x4*)(ap[i] + 64 + lc); rb1[i] = *(const AS1 u32x4*)(bp[i] + 64 + lc); } }
  auto compute = [&]() {
#pragma unroll
    for (int kk = 0; kk < 2; ++kk) {
      bf16x8 af[4], bfr[4];
#pragma unroll
      for (int mi = 0; mi < 4; ++mi) af[mi] = *(const bf16x8*)(As + (wr * 64 + mi * 16 + l15) * LDT + kk * 32 + g * 8);
#pragma unroll
      for (int ni = 0; ni < 4; ++ni) bfr[ni] = *(const bf16x8*)(Bs + (wc * 64 + ni * 16 + l15) * LDT + kk * 32 + g * 8);
#pragma unroll
      for (int mi = 0; mi < 4; ++mi)
#pragma unroll
        for (int ni = 0; ni < 4; ++ni) acc[mi][ni] = MFMA16(af[mi], bfr[ni], acc[mi][ni]);
    } };
#pragma unroll
  for (int j = 0; j < NB; ++j) {
#pragma unroll
  for (int mi = 0; mi < 4; ++mi)
#pragma unroll
    for (int ni = 0; ni < 4; ++ni) acc[mi][ni] = f32x4{0.f, 0.f, 0.f, 0.f};
  for (int k0 = 0; k0 < K; k0 += 128) {
    __syncthreads();
#pragma unroll
    for (int i = 0; i < 4; ++i) { *(u32x4*)(As + (lr + 32 * i) * LDT + lc) = ra0[i]; *(u32x4*)(Bs + (lr + 32 * i) * LDT + lc) = rb0[i]; }
    __syncthreads();
    if (k0 + 128 < K) {
#pragma unroll
      for (int i = 0; i < 4; ++i) { ra0[i] = *(const AS1 u32x4*)(ap[i] + k0 + 128 + lc); rb0[i] = *(const AS1 u32x4*)(bp[i] + k0 + 128 + lc); } }
    compute();
    if (k0 + 64 < K) {
      __syncthreads();
#pragma unroll
      for (int i = 0; i < 4; ++i) { *(u32x4*)(As + (lr + 32 * i) * LDT + lc) = ra1[i]; *(u32x4*)(Bs + (lr + 32 * i) * LDT + lc) = rb1[i]; }
      __syncthreads();
      if (k0 + 192 < K) {
#pragma unroll
        for (int i = 0; i < 4; ++i) { ra1[i] = *(const AS1 u32x4*)(ap[i] + k0 + 192 + lc); rb1[i] = *(const AS1 u32x4*)(bp[i] + k0 + 192 + lc); } }
      compute();
    }
  }
  if (j + 1 < NB) {
#pragma unroll
    for (int i = 0; i < 4; ++i) { bp[i] = gptr(brow(lr + 32 * i, j + 1)); ra0[i] = *(const AS1 u32x4*)(ap[i] + lc); rb0[i] = *(const AS1 u32x4*)(bp[i] + lc); } }
  epi(acc, j, wr, wc, g, l15);
  if (j + 1 < NB) {
#pragma unroll
    for (int i = 0; i < 4; ++i) { ra1[i] = *(const AS1 u32x4*)(ap[i] + 64 + lc); rb1[i] = *(const AS1 u32x4*)(bp[i] + 64 + lc); } }
  }
}

template <int NB, int LDB, class ARow, class BBase, class Epi>
DEVFN void gemm_tile_w(unsigned char* smem, int K, ARow arow, BBase bbase, Epi epi) {
  bf16_t* As = (bf16_t*)smem;
  bf16_t* Bs = As + 128 * LDT;
  const int tid = TIDX, lane = tid & 63, wave = tid >> 6, wr = wave >> 1, wc = wave & 1;
  const int g = lane >> 4, l15 = lane & 15;
  const int lr = tid >> 3, lc = (tid & 7) * 8;
  const AS1 bf16_t* ap[4];
#pragma unroll
  for (int i = 0; i < 4; ++i) ap[i] = gptr(arow(lr + 32 * i));
  const AS1 bf16_t* bb = gptr(bbase(0));
  const unsigned boff = (unsigned)(lr * LDB + lc);
  f32x4 acc[4][8];
  u32x4 ra[4], rb[8];
#pragma unroll
  for (int i = 0; i < 4; ++i) ra[i] = *(const AS1 u32x4*)(ap[i] + lc);
#pragma unroll
  for (int i = 0; i < 8; ++i) rb[i] = *(const AS1 u32x4*)(bb + (size_t)(i * 32 * LDB) + boff);
#pragma unroll
  for (int j = 0; j < NB; ++j) {
#pragma unroll
    for (int mi = 0; mi < 4; ++mi)
#pragma unroll
      for (int ni = 0; ni < 8; ++ni) acc[mi][ni] = f32x4{0.f, 0.f, 0.f, 0.f};
#pragma unroll 1
    for (int k0 = 0; k0 < K; k0 += 64) {
      __syncthreads();
#pragma unroll
      for (int i = 0; i < 4; ++i) *(u32x4*)(As + (lr + 32 * i) * LDT + lc) = ra[i];
#pragma unroll
      for (int i = 0; i < 8; ++i) *(u32x4*)(Bs + (lr + 32 * i) * LDT + lc) = rb[i];
      __syncthreads();
      if (k0 + 64 < K) {
#pragma unroll
        for (int i = 0; i < 4; ++i) ra[i] = *(const AS1 u32x4*)(ap[i] + k0 + 64 + lc);
#pragma unroll
        for (int i = 0; i < 8; ++i) rb[i] = *(const AS1 u32x4*)(bb + (size_t)(i * 32 * LDB + k0 + 64) + boff);
      }
#pragma unroll
      for (int kk = 0; kk < 2; ++kk) {
        bf16x8 af[4];
#pragma unroll
        for (int mi = 0; mi < 4; ++mi) af[mi] = *(const bf16x8*)(As + (wr * 64 + mi * 16 + l15) * LDT + kk * 32 + g * 8);
#pragma unroll
        for (int h = 0; h < 2; ++h) {
          bf16x8 bfr[4];
#pragma unroll
          for (int ni = 0; ni < 4; ++ni) bfr[ni] = *(const bf16x8*)(Bs + (wc * 128 + h * 64 + ni * 16 + l15) * LDT + kk * 32 + g * 8);
#pragma unroll
          for (int mi = 0; mi < 4; ++mi)
#pragma unroll
            for (int ni = 0; ni < 4; ++ni) acc[mi][h * 4 + ni] = MFMA16(af[mi], bfr[ni], acc[mi][h * 4 + ni]);
        }
      }
    }
    if (j + 1 < NB) {
      bb = gptr(bbase(j + 1));
#pragma unroll
      for (int i = 0; i < 4; ++i) ra[i] = *(const AS1 u32x4*)(ap[i] + lc);
#pragma unroll
      for (int i = 0; i < 8; ++i) rb[i] = *(const AS1 u32x4*)(bb + (size_t)(i * 32 * LDB) + boff); }
    epi(acc, j, wr, wc, g, l15);
  }
}

template <int NCH, class Val, class RowP>
DEVFN void tile_store_bf16(unsigned char* smem, int wr, int g, int l15, Val val, RowP rowp) {
  constexpr int LDC = NCH * 8 + 8;
  bf16_t* T = (bf16_t*)smem;
  const int tid = TIDX;
  __syncthreads();
  val(T, LDC);
  __syncthreads();
#pragma unroll
  for (int pass = 0; pass < NCH / 2; ++pass) { const int id = tid + 256 * pass, row = id / NCH, c = id % NCH;
    bf16_t* dst = rowp(row, c * 8);
    if (dst) *(AS1 u32x4*)gptr(dst) = *(const u32x4*)(T + row * LDC + c * 8); }
  (void)wr; (void)g; (void)l15;
}
DEVFN void cvt_tile(unsigned char* smem, const float* src, int K, int N, int k0, int n0, bf16_t* dst, int ldd, int mode) {
  float* s = (float*)smem;
  const int tid = TIDX;
  const AS1 float* gsrc = gptr(src);
  __syncthreads();
  { const int kk = tid >> 4, n4 = (tid & 15) * 4;
#pragma unroll
    for (int pass = 0; pass < 4; ++pass) { const int k = kk + 16 * pass;
      f32x4 v = f32x4{0.f, 0.f, 0.f, 0.f};
      if (n0 + n4 < N) v = *(const AS1 f32x4*)(gsrc + (size_t)(k0 + k) * N + n0 + n4);
      s[k * 65 + n4] = v[0]; s[k * 65 + n4 + 1] = v[1]; s[k * 65 + n4 + 2] = v[2]; s[k * 65 + n4 + 3] = v[3]; } }
  __syncthreads();
  { const int nn = tid >> 2, k16 = (tid & 3) * 16, n = n0 + nn;
    if (n < N) { const int row = mode == 0 ? n : ((n >> 4) * 32 + (n & 15) + (mode == 2 ? 16 : 0));
      u32x4 o0, o1;
#pragma unroll
      for (int j = 0; j < 4; ++j) { o0[j] = (unsigned)f2bf(s[(k16 + 2 * j) * 65 + nn]) | ((unsigned)f2bf(s[(k16 + 2 * j + 1) * 65 + nn]) << 16);
        o1[j] = (unsigned)f2bf(s[(k16 + 8 + 2 * j) * 65 + nn]) | ((unsigned)f2bf(s[(k16 + 9 + 2 * j) * 65 + nn]) << 16); }
      AS1 bf16_t* d = gptr(dst) + (size_t)row * ldd + k0 + k16;
      *(AS1 u32x4*)d = o0; *(AS1 u32x4*)(d + 8) = o1; } }
  (void)K;
}
struct CvtJob { const float* src; bf16_t* dst; int N, k0, n0, ldd, mode; };
DEVFN void cvt_load(const CvtJob& j, f32x4 (&v)[4]) {
  const int tid = TIDX, kk = tid >> 4, n4 = (tid & 15) * 4;
  const AS1 float* g = gptr(j.src);
#pragma unroll
  for (int pass = 0; pass < 4; ++pass) { v[pass] = f32x4{0.f, 0.f, 0.f, 0.f};
    if (j.n0 + n4 < j.N) v[pass] = *(const AS1 f32x4*)(g + (size_t)(j.k0 + kk + 16 * pass) * j.N + j.n0 + n4); }
}
DEVFN void cvt_store(unsigned char* smem, const CvtJob& j, const f32x4 (&v)[4]) {
  float* s = (float*)smem;
  const int tid = TIDX, kk = tid >> 4, n4 = (tid & 15) * 4;
  __syncthreads();
#pragma unroll
  for (int pass = 0; pass < 4; ++pass) { const int k = kk + 16 * pass; s[k * 65 + n4] = v[pass][0]; s[k * 65 + n4 + 1] = v[pass][1]; s[k * 65 + n4 + 2] = v[pass][2]; s[k * 65 + n4 + 3] = v[pass][3]; }
  __syncthreads();
  const int nn = tid >> 2, k16 = (tid & 3) * 16, n = j.n0 + nn;
  if (n < j.N) { const int row = j.mode == 0 ? n : ((n >> 4) * 32 + (n & 15) + (j.mode == 2 ? 16 : 0));
    u32x4 o0, o1;
#pragma unroll
    for (int q = 0; q < 4; ++q) { o0[q] = (unsigned)f2bf(s[(k16 + 2 * q) * 65 + nn]) | ((unsigned)f2bf(s[(k16 + 2 * q + 1) * 65 + nn]) << 16);
      o1[q] = (unsigned)f2bf(s[(k16 + 8 + 2 * q) * 65 + nn]) | ((unsigned)f2bf(s[(k16 + 9 + 2 * q) * 65 + nn]) << 16); }
    AS1 bf16_t* d = gptr(j.dst) + (size_t)row * j.ldd + j.k0 + k16;
    *(AS1 u32x4*)d = o0; *(AS1 u32x4*)(d + 8) = o1; }
}
DEVFN CvtJob moe_cvt_job(const Params& p, int l, int u) {
  bf16_t* w13 = (bf16_t*)(p.ws + Ws::W13); bf16_t* w2t = (bf16_t*)(p.ws + Ws::W2T);
  const int e = u / 192, r = u % 192, which = r / 64, t = r % 64;
  CvtJob j;
  if (which < 2) {
    j.src = e < 64 ? (which == 0 ? INP(I_EW1) : INP(I_EW3)) + ((size_t)l * 64 + e) * 1024 * 256 : (which == 0 ? INP(I_SW1) : INP(I_SW3)) + (size_t)l * 1024 * 256;
    j.N = 256; j.k0 = (t >> 2) * 64; j.n0 = (t & 3) * 64; j.dst = w13 + (size_t)e * 512 * 1024; j.ldd = 1024; j.mode = which == 0 ? 1 : 2;
  } else {
    j.src = e < 64 ? INP(I_EW2) + ((size_t)l * 64 + e) * 256 * 1024 : INP(I_SW2) + (size_t)l * 256 * 1024;
    j.N = 1024; j.k0 = (t >> 4) * 64; j.n0 = (t & 15) * 64; j.dst = w2t + (size_t)e * 1024 * 256; j.ldd = 256; j.mode = 0;
  }
  return j;
}
DEVFN void convert_moe_weights(const Params& p, int l, unsigned char* smem, int bid, int nb, int j_lo, int j_hi) {
  if (j_lo + bid >= j_hi) return;
  f32x4 v[4], vn[4];
  CvtJob j = moe_cvt_job(p, l, j_lo + bid);
  cvt_load(j, v);
  for (int u = j_lo + bid; u < j_hi; u += nb) {
    const int un = u + nb;
    CvtJob jn = j;
    if (un < j_hi) { jn = moe_cvt_job(p, l, un); cvt_load(jn, vn); }
    cvt_store(smem, j, v);
    j = jn;
#pragma unroll
    for (int q = 0; q < 4; ++q) v[q] = vn[q];
  }
}
DEVFN void phase0(const Params& p, unsigned char* smem) {
  const int tid = TIDX;
  float* modp = (float*)(p.ws + Ws::MODP);
  for (int u = BIDX; u < DEPTH_ * 24 * 16; u += gridDim.x) {
    int l = u / (24 * 16), jb = (u / 16) % 24, ks = u % 16;
    float* sc = (float*)smem;
    __syncthreads();
    for (int e = tid; e < NR_ * 64; e += 256) { int r = e / 64, i = ks * 64 + (e % 64); float cv = r < B_ ? INP(I_C)[(size_t)r * D_ + i] : INP(I_CCTX)[i]; sc[e] = siluf_(cv); }
    __syncthreads();
    int j = jb * 256 + tid;
    float acc[NR_];
#pragma unroll
    for (int r = 0; r < NR_; ++r) acc[r] = 0.f;
    const float* w = INP(I_ADAW) + ((size_t)l * D_ + ks * 64) * NMOD_ + j;
#pragma unroll 4
    for (int i = 0; i < 64; ++i) { float wv = w[(size_t)i * NMOD_];
#pragma unroll
      for (int r = 0; r < NR_; ++r) acc[r] += sc[r * 64 + i] * wv; }
#pragma unroll
    for (int r = 0; r < NR_; ++r) modp[(((size_t)ks * DEPTH_ + l) * NR_ + r) * NMOD_ + j] = acc[r];
  }
  bf16_t* win = (bf16_t*)(p.ws + Ws::WIN);
  bf16_t* wout = (bf16_t*)(p.ws + Ws::WOUT);
  for (int u = BIDX; u < DEPTH_ * 16 * 55; u += gridDim.x) {
    int l = u / (16 * 55), r = u % (16 * 55);
    cvt_tile(smem, INP(I_WIN) + (size_t)l * 1024 * NIN_, 1024, NIN_, (r / 55) * 64, (r % 55) * 64, win + (size_t)l * NIN_ * 1024, 1024, 0);
  }
  for (int u = BIDX; u < DEPTH_ * 256; u += gridDim.x) {
    int l = u / 256, r = u % 256;
    cvt_tile(smem, INP(I_WOUT) + (size_t)l * 1024 * 1024, 1024, 1024, (r / 16) * 64, (r % 16) * 64, wout + (size_t)l * 1024 * 1024, 1024, 0);
  }
  { bf16_t* lo = (bf16_t*)(p.ws + Ws::LORA);
    for (int u = BIDX * 256 + tid; u < DEPTH_ * 98304; u += gridDim.x * 256) {
      const int l = u / 98304, r = u % 98304; float v;
      if (r < 32768) { const int d = r >> 14, n = (r >> 6) & 255, k = r & 63; v = INP(I_W2)[(((size_t)l * 2 + d) * 64 + k) * 256 + n]; }
      else if (r < 65536) { const int r2 = r - 32768, d = r2 >> 14, n = (r2 >> 6) & 255, k = r2 & 63; v = INP(I_A2)[(((size_t)l * 2 + d) * 64 + k) * 256 + n]; }
      else { const int r2 = r - 65536, n = r2 >> 7, k = r2 & 127; v = INP(I_G2)[((size_t)l * 128 + k) * 256 + n]; }
      lo[u] = f2bf(v); } }
  float* rwt = (float*)(p.ws + Ws::RWT);
  for (int u = BIDX * 256 + tid; u < DEPTH_ * 64 * 1024; u += gridDim.x * 256) {
    int l = u / (64 * 1024), e = (u / 1024) % 64, i = u % 1024;
    rwt[u] = INP(I_RW)[((size_t)l * 1024 + i) * 64 + e];
  }
}

DEVFN void phase0b(const Params& p) {
  float* mod = (float*)(p.ws + Ws::MOD); const float* modp = (const float*)(p.ws + Ws::MODP);
  for (int u = BIDX * 256 + TIDX; u < DEPTH_ * NR_ * NMOD_; u += gridDim.x * 256) {
    int l = u / (NR_ * NMOD_), j = u % NMOD_;
    float s = INP(I_ADAB)[(size_t)l * NMOD_ + j];
    for (int ks = 0; ks < 16; ++ks) s += modp[(size_t)ks * DEPTH_ * NR_ * NMOD_ + u];
    mod[u] = s;
  }
}

DEVFN void row_stats(const float (&v)[16], float& mean, float& rstd) {
  float s = 0.f;
#pragma unroll
  for (int i = 0; i < 16; ++i) s += v[i];
  mean = wave_sum(s) * (1.f / 1024.f);
  float q = 0.f;
#pragma unroll
  for (int i = 0; i < 16; ++i) { float d = v[i] - mean; q += d * d; }
  rstd = rsqrtf(wave_sum(q) * (1.f / 1024.f) + 1e-5f);
}
DEVFN void load_row16(const float* row, int lane, float (&v)[16]) {
  const AS1 float* r = gptr(row);
#pragma unroll
  for (int j = 0; j < 4; ++j) { const f32x4 t = *(const AS1 f32x4*)(r + lane * 4 + 256 * j); v[4 * j] = t[0]; v[4 * j + 1] = t[1]; v[4 * j + 2] = t[2]; v[4 * j + 3] = t[3]; }
}
DEVFN void moe_residual_row(const Params& p, int lp, int tok, int lane, float (&xv)[16]) {
  const float* mod = (const float*)(p.ws + Ws::MOD) + ((size_t)lp * NR_ + tok_modrow(tok)) * NMOD_;
  const bf16_t* yb = (const bf16_t*)(p.ws + Ws::YBUF) + (size_t)tok * NSLOT * 1024;
  float g2[16], w[16], b[16];
  load_row16(mod + 5 * 1024, lane, g2);
  load_row16(INP(I_LN2W) + (size_t)lp * 1024, lane, w);
  load_row16(INP(I_LN2B) + (size_t)lp * 1024, lane, b);
  u32x2 sl[NSLOT][4];
#pragma unroll
  for (int s = 0; s < NSLOT; ++s)
#pragma unroll
    for (int j = 0; j < 4; ++j) sl[s][j] = *(const AS1 u32x2*)gptr(yb + (size_t)s * 1024 + lane * 4 + 256 * j);
  float f[16];
#pragma unroll
  for (int i = 0; i < 16; ++i) f[i] = 0.f;
#pragma unroll
  for (int s = 0; s < NSLOT; ++s)
#pragma unroll
    for (int j = 0; j < 4; ++j) { const u32x2 t = sl[s][j];
      f[4 * j] += bf2f((bf16_t)(t[0] & 0xFFFF)); f[4 * j + 1] += bf2f((bf16_t)(t[0] >> 16)); f[4 * j + 2] += bf2f((bf16_t)(t[1] & 0xFFFF)); f[4 * j + 3] += bf2f((bf16_t)(t[1] >> 16)); }
#pragma unroll
  for (int i = 0; i < 16; ++i) xv[i] = ALPHA_ * xv[i] + g2[i] * f[i];
  float mean, rstd;
  row_stats(xv, mean, rstd);
#pragma unroll
  for (int i = 0; i < 16; ++i) xv[i] = (xv[i] - mean) * rstd * w[i] + b[i];
}
DEVFN void phase1(const Params& p, int l) {
  const int lane = TIDX & 63, wave = TIDX >> 6;
  float* X = (float*)(p.ws + Ws::X);
  bf16_t* U = (bf16_t*)(p.ws + Ws::U);
  for (int tok = BIDX * 4 + wave; tok < NT_; tok += gridDim.x * 4) {
    float xv[16], sh[16], sc[16], mean, rstd;
    const float* mod = (const float*)(p.ws + Ws::MOD) + ((size_t)l * NR_ + tok_modrow(tok)) * NMOD_;
    load_row16(mod, lane, sh);
    load_row16(mod + 1024, lane, sc);
    if (l == 0) load_row16(tok_input_row(p, tok), lane, xv);
    else { load_row16(X + (size_t)tok * 1024, lane, xv); moe_residual_row(p, l - 1, tok, lane, xv); }
#pragma unroll
    for (int j = 0; j < 4; ++j) *(float4*)(X + (size_t)tok * 1024 + lane * 4 + 256 * j) = make_float4(xv[4 * j], xv[4 * j + 1], xv[4 * j + 2], xv[4 * j + 3]);
    row_stats(xv, mean, rstd);
#pragma unroll
    for (int j = 0; j < 4; ++j) {
      float u0 = (xv[4 * j] - mean) * rstd * (1.f + sc[4 * j]) + sh[4 * j], u1 = (xv[4 * j + 1] - mean) * rstd * (1.f + sc[4 * j + 1]) + sh[4 * j + 1];
      float u2 = (xv[4 * j + 2] - mean) * rstd * (1.f + sc[4 * j + 2]) + sh[4 * j + 2], u3 = (xv[4 * j + 3] - mean) * rstd * (1.f + sc[4 * j + 3]) + sh[4 * j + 3];
      *(uint2*)(U + (size_t)tok * 1024 + lane * 4 + 256 * j) = make_uint2((unsigned)f2bf(u0) | ((unsigned)f2bf(u1) << 16), (unsigned)f2bf(u2) | ((unsigned)f2bf(u3) << 16));
    }
  }
}
DEVFN void phase_final(const Params& p) {
  const int lane = TIDX & 63, wave = TIDX >> 6;
  const float* X = (const float*)(p.ws + Ws::X);
  for (int r = BIDX * 4 + wave; r < B_ * SEQ_; r += gridDim.x * 4) {
    int b = r / SEQ_, s = r % SEQ_, tok = b * T_ + CTX_ + s;
    float xv[16];
    load_row16(X + (size_t)tok * 1024, lane, xv);
    moe_residual_row(p, DEPTH_ - 1, tok, lane, xv);
#pragma unroll
    for (int j = 0; j < 4; ++j) *(float4*)(p.out + (size_t)r * 1024 + lane * 4 + 256 * j) = make_float4(xv[4 * j], xv[4 * j + 1], xv[4 * j + 2], xv[4 * j + 3]);
  }
}

DEVFN void phase2(const Params& p, int l, unsigned char* smem) {
  const bf16_t* U = (const bf16_t*)(p.ws + Ws::U);
  const bf16_t* W = (const bf16_t*)(p.ws + Ws::WIN) + (size_t)l * NIN_ * 1024;
  bf16_t* ZX = (bf16_t*)(p.ws + Ws::ZX);
  const int nct = (NIN_ + 255) / 256;
  for (int u = BIDX; u < (NT_ / 128) * nct; u += gridDim.x) {
    int rt = u / nct, ct = u % nct;
    gemm_tile_w<1, 1024>(smem, 1024,
      [&](int r) { return U + (size_t)(rt * 128 + r) * 1024; },
      [&](int) { return W + (size_t)(ct * 256) * 1024; },
      [&](f32x4 (&acc)[4][8], int, int wr, int wc, int g, int l15) {
#pragma unroll 1
        for (int h = 0; h < 2; ++h)
          tile_store_bf16<16>(smem, wr, g, l15,
            [&](bf16_t* T, int ldc) {
              if (wc == h) {
#pragma unroll
                for (int mi = 0; mi < 4; ++mi)
#pragma unroll
                  for (int ni = 0; ni < 8; ++ni)
#pragma unroll
                    for (int i = 0; i < 4; ++i) T[(wr * 64 + mi * 16 + 4 * g + i) * ldc + ni * 16 + l15] = f2bf(acc[mi][ni][i]); } },
            [&](int row, int c0) { const int col = ct * 256 + h * 128 + c0; return col < NIN_ ? ZX + (size_t)(rt * 128 + row) * NIN_ + col : (bf16_t*)nullptr; });
      });
  }
}

DEVFN float zxv(const bf16_t* ZX, int tok, int col) { return bf2f(gptr(ZX)[(size_t)tok * NIN_ + col]); }
struct Nbr { int n; int tok[4]; };
DEVFN Nbr shift_nbrs(int tok) {
  Nbr nb; int b = tok / T_, t = tok % T_;
  if (t < CTX_) { nb.n = 2; nb.tok[0] = t > 0 ? tok - 1 : -1; nb.tok[1] = t < CTX_ - 1 ? tok + 1 : -1; nb.tok[2] = -1; nb.tok[3] = -1; }
  else { int s = t - CTX_, row = s / 64, col = s % 64; nb.n = 4; nb.tok[0] = col > 0 ? tok - 1 : -1; nb.tok[1] = col < 63 ? tok + 1 : -1;
    nb.tok[2] = row > 0 ? tok - 64 : -1; nb.tok[3] = row < SEQ_ / 64 - 1 ? tok + 64 : -1; }
  (void)b; return nb;
}
DEVFN float shiftmix(const bf16_t* ZX, const float* mu, int tok, const Nbr& nb, int ch) {
  float z = zxv(ZX, tok, ORW + ch), o = z;
#pragma unroll
  for (int j = 0; j < 4; ++j) if (j < nb.n) { float v = nb.tok[j] >= 0 ? zxv(ZX, nb.tok[j], ORW + ch) : 0.f; o += mu[j * 1152 + ch] * (v - z); }
  return o;
}
#define LI_LD 392
#define KL_LD 264
DEVFN void phase3(const Params& p, int l, unsigned char* smem) {
  const int tid = TIDX, lane = tid & 63, wave = tid >> 6, q = lane >> 4, l15 = lane & 15;
  const bf16_t* ZX = (const bf16_t*)(p.ws + Ws::ZX);
  bf16_t* XBC = (bf16_t*)(p.ws + Ws::XBC); float* DTB = (float*)(p.ws + Ws::DTB);
  bf16_t* RR = (bf16_t*)(p.ws + Ws::RR); bf16_t* VV = (bf16_t*)(p.ws + Ws::VV); bf16_t* KKb = (bf16_t*)(p.ws + Ws::KK);
  bf16_t* KRW = (bf16_t*)(p.ws + Ws::KRW); bf16_t* LIg = (bf16_t*)(p.ws + Ws::LI);
  float* LA = (float*)(p.ws + Ws::LA);
  const float* convw = INP(I_CONVW) + (size_t)l * 3 * 1024; const float* convb = INP(I_CONVB) + (size_t)l * 1024;
  const float* mu = INP(I_MU) + (size_t)l * 4 * 1152;
  float* gdl = (float*)smem;
  const float kkw = INP(I_KKW)[(size_t)l * 256 + tid];
  unsigned* ctr = (unsigned*)(p.ws + Ws::BAR) + l * 32 + 8;
  volatile int* nxt_s = (volatile int*)(smem + SM_PRE);
  int wu = BIDX;
  while (wu < 6 * (NT_ / 16)) {
    int nxt = 0;
    if (TIDX == 0) nxt = (int)gridDim.x + (int)atomicAdd(ctr, 1u);
    const int part = wu < NT_ / 16 ? 0 : 1, tile = wu < NT_ / 16 ? wu : (wu - NT_ / 16) / 5, gsel = wu < NT_ / 16 ? 0 : (wu - NT_ / 16) % 5;
    const int tok0 = tile * 16, t0 = tok0 % T_, bb = tok0 / T_;
    const bool isctx = t0 < CTX_;
    const int s0 = t0 - CTX_;
    const bool lval = isctx ? (t0 > 0) : ((s0 & 63) != 0), rval = isctx ? (t0 + 16 < CTX_) : ((s0 & 63) != 48);
    const bool uval = !isctx && (s0 >= 64), dval = !isctx && (s0 + 64 < SEQ_);
    if (part == 0) {
    __syncthreads();
    {
      const bool segstart = (t0 == 0 || t0 == CTX_), segend = (t0 + 16 == CTX_ || t0 + 16 == T_);
      bf16_t* XBCT = (bf16_t*)(p.ws + Ws::XBCT) + ((size_t)(bb * NC128 + t0 / 128) * 768) * 128 + (t0 % 128);
      bf16_t vv16[16];
      { const AS1 bf16_t* vp = gptr(ZX) + (size_t)tok0 * NIN_ + OGV + tid;
#pragma unroll
        for (int i = 0; i < 16; ++i) { vv16[i] = *vp; vp += NIN_; LAUNDER_V(vp); } }
      const float dtv = zxv(ZX, tok0 + (tid >> 4), ODT + (tid & 15)), gd0 = zxv(ZX, tok0 + (tid >> 5), OGD + (tid & 31)), gd1 = zxv(ZX, tok0 + 8 + (tid >> 5), OGD + (tid & 31));
#pragma unroll 1
      for (int jp = 0; jp < 2; ++jp) {
        float z[2][18];
#pragma unroll
        for (int jj = 0; jj < 2; ++jj) { const int c = tid + 256 * (2 * jp + jj);
          const AS1 bf16_t* zp = gptr(ZX) + (size_t)tok0 * NIN_ + OXBC + c - NIN_;
#pragma unroll
          for (int i = 0; i < 18; ++i) { z[jj][i] = ((i == 0 && segstart) || (i == 17 && segend)) ? 0.f : bf2f(*zp); zp += NIN_; LAUNDER_V(zp); } }
#pragma unroll
        for (int jj = 0; jj < 2; ++jj) { const int c = tid + 256 * (2 * jp + jj);
          AS1 bf16_t* xp = gptr(XBC) + (size_t)tok0 * 1024 + c;
          const float w0 = convw[c], w1 = convw[1024 + c], w2 = convw[2048 + c], cb = convb[c];
          bf16_t y[16];
#pragma unroll
          for (int i = 0; i < 16; ++i) { y[i] = f2bf(siluf_(cb + w0 * z[jj][i] + w1 * z[jj][i + 1] + w2 * z[jj][i + 2])); *xp = y[i]; xp += 1024; LAUNDER_V(xp); }
          if (c < 768) {
            u32x4 o0, o1;
#pragma unroll
            for (int i = 0; i < 4; ++i) { o0[i] = (unsigned)y[2 * i] | ((unsigned)y[2 * i + 1] << 16); o1[i] = (unsigned)y[8 + 2 * i] | ((unsigned)y[9 + 2 * i] << 16); }
            *(u32x4*)(XBCT + (size_t)c * 128) = o0; *(u32x4*)(XBCT + (size_t)c * 128 + 8) = o1; } } }
      { bf16_t* VTp = (bf16_t*)(p.ws + Ws::VT) + ((size_t)(bb * NC64 + t0 / 64) * 256 + tid) * 64 + (t0 % 64);
        u32x4 o0, o1;
#pragma unroll
        for (int i = 0; i < 4; ++i) { o0[i] = (unsigned)vv16[2 * i] | ((unsigned)vv16[2 * i + 1] << 16); o1[i] = (unsigned)vv16[8 + 2 * i] | ((unsigned)vv16[9 + 2 * i] << 16); }
        *(u32x4*)VTp = o0; *(u32x4*)(VTp + 8) = o1; }
      DTB[(size_t)tok0 * 16 + tid] = softplusf_(dtv + INP(I_DTBIAS)[(size_t)l * 16 + (tid & 15)]);
      gdl[tid] = gd0; gdl[256 + tid] = gd1;
    }
    } else {
    { const int g = gsel;
      const bool act = !(g == 4 && tid >= 128);
      const int ch = act ? g * 256 + tid : 0;
      const AS1 bf16_t* zp0 = gptr(ZX) + (size_t)tok0 * NIN_ + ORW + ch;
      const AS1 bf16_t* zp = zp0 - NIN_;
      const float m0 = mu[ch], m1 = mu[1152 + ch], m2 = mu[2304 + ch], m3 = mu[3456 + ch];
      float z[18], zu[16], zd[16], o[16];
      const AS1 bf16_t* up = uval ? zp0 - (size_t)64 * NIN_ : zp0; const AS1 bf16_t* dn = dval ? zp0 + (size_t)64 * NIN_ : zp0;
      const float um = uval ? 1.f : 0.f, dm = dval ? 1.f : 0.f, m2v = isctx ? 0.f : m2, m3v = isctx ? 0.f : m3;
#pragma unroll
      for (int i = 0; i < 18; ++i) { z[i] = ((i == 0 && !lval) || (i == 17 && !rval)) ? 0.f : bf2f(*zp); zp += NIN_; LAUNDER_V(zp); }
#pragma unroll
      for (int i = 0; i < 16; ++i) { zu[i] = bf2f(*up); zd[i] = bf2f(*dn); up += NIN_; dn += NIN_; LAUNDER_V(up); LAUNDER_V(dn); }
#pragma unroll
      for (int i = 0; i < 16; ++i) o[i] = z[i + 1] + m0 * (z[i] - z[i + 1]) + m1 * (z[i + 2] - z[i + 1]) + m2v * (zu[i] * um - z[i + 1]) + m3v * (zd[i] * dm - z[i + 1]);
      if (g == 0) { AS1 bf16_t* rp = gptr(RR) + (size_t)tok0 * 256 + tid;
#pragma unroll
        for (int i = 0; i < 16; ++i) { *rp = f2bf(o[i]); rp += 256; LAUNDER_V(rp); }
      } else if (g == 1) { AS1 bf16_t* kp = gptr(KKb) + (size_t)tok0 * 256 + tid; AS1 bf16_t* krp = gptr(KRW) + (size_t)tok0 * 256 + tid;
#pragma unroll
        for (int i = 0; i < 16; ++i) { const float kq = o[i] * kkw, nrm = sqrtf(wave_sum(kq * kq));
          *kp = f2bf(kq / fmaxf(nrm, 1e-12f)); *krp = f2bf(o[i]); kp += 256; krp += 256; LAUNDER_V(kp); LAUNDER_V(krp); }
      } else if (g == 2) { AS1 bf16_t* vp2 = gptr(VV) + (size_t)tok0 * 256 + tid;
#pragma unroll
        for (int i = 0; i < 16; ++i) { *vp2 = f2bf(o[i]); vp2 += 256; LAUNDER_V(vp2); }
      } else if (g == 3) { AS1 bf16_t* lp = gptr(LIg) + (size_t)tok0 * 384 + tid;
#pragma unroll
        for (int i = 0; i < 16; ++i) { *lp = f2bf(tid < 128 ? tanhf(o[i]) : o[i]); lp += 384; LAUNDER_V(lp); }
      } else if (act) { AS1 bf16_t* lp = gptr(LIg) + (size_t)tok0 * 384 + 256 + tid;
#pragma unroll
        for (int i = 0; i < 16; ++i) { *lp = f2bf(sigmoidf_(o[i])); lp += 384; LAUNDER_V(lp); }
      }
    }
    }
    if (part == 0) {
    __syncthreads();
    { const int d = tid >> 7, c = tid & 127; const float* gu = INP(I_GU) + ((size_t)l * 2 + d) * 16 * 128; const float gb = INP(I_GB)[((size_t)l * 2 + d) * 128 + c];
      float guw[16];
#pragma unroll
      for (int i = 0; i < 16; ++i) guw[i] = gu[i * 128 + c];
#pragma unroll 4
      for (int tt = 0; tt < 16; ++tt) { float sacc = gb;
#pragma unroll
        for (int i = 0; i < 16; ++i) sacc += gdl[tt * 32 + d * 16 + i] * guw[i];
        LA[((size_t)d * NT_ + tok0 + tt) * 128 + c] = logsigmoidf_(sacc) * (1.f / 16.f); } }
    }
    __syncthreads();
    if (TIDX == 0) *nxt_s = nxt;
    __syncthreads();
    wu = *nxt_s;
  }
}

DEVFN void phase3b(const Params& p, int l, unsigned char* smem) {
  const bf16_t* LIg = (const bf16_t*)(p.ws + Ws::LI);
  const bf16_t* lora = (const bf16_t*)(p.ws + Ws::LORA) + (size_t)l * 98304;
  const bf16_t* KRg = (const bf16_t*)(p.ws + Ws::KRW); const bf16_t* KKg = (const bf16_t*)(p.ws + Ws::KK);
  float* LWp = (float*)(p.ws + Ws::LW); bf16_t* KD = (bf16_t*)(p.ws + Ws::KD); bf16_t* BD = (bf16_t*)(p.ws + Ws::BD); float* GATE = (float*)(p.ws + Ws::GATE);
  for (int u = BIDX; u < (NT_ / 128) * 10; u += gridDim.x) {
    const int rt = u / 10, which = (u % 10) >> 1, ct = u & 1;
    const int K = which < 4 ? 64 : 128, acol = which < 4 ? which * 64 : 256;
    const bf16_t* wb = which < 2 ? lora + (size_t)which * 16384 : which < 4 ? lora + 32768 + (size_t)(which - 2) * 16384 : lora + 65536;
    const float* bias = which < 2 ? INP(I_W0) + (size_t)l * 512 + which * 256 : INP(I_A0) + (size_t)l * 512 + (which & 1) * 256;
    const float* kav = INP(I_KAW) + (size_t)l * 256;
    gemm_tile(smem, K,
      [&](int r) { return LIg + (size_t)(rt * 128 + r) * 384 + acol; },
      [&](int r) { return wb + (size_t)(ct * 128 + r) * K; },
      [&](f32x4 (&acc)[4][4], int wr, int wc, int g, int l15) {
        const int tid = TIDX;
        if (which == 2 || which == 3) {
          bf16_t* T = (bf16_t*)smem; constexpr int LDC = 136;
          __syncthreads();
#pragma unroll
          for (int ni = 0; ni < 4; ++ni) { const int cl = wc * 64 + ni * 16 + l15; const float bv = bias[ct * 128 + cl];
#pragma unroll
            for (int mi = 0; mi < 4; ++mi)
#pragma unroll
              for (int i = 0; i < 4; ++i) T[(wr * 64 + mi * 16 + 4 * g + i) * LDC + cl] = f2bf(sigmoidf_(acc[mi][ni][i] + bv)); }
          __syncthreads();
          const int c = tid & 15, col0 = ct * 128 + c * 8;
          float ka[8];
#pragma unroll
          for (int j = 0; j < 8; ++j) ka[j] = kav[col0 + j];
          const size_t dofs = (size_t)(which - 2) * NT_ * 256;
#pragma unroll
          for (int pass = 0; pass < 8; ++pass) { const int row = (tid >> 4) + 16 * pass; const size_t o = (size_t)(rt * 128 + row) * 256 + col0;
            const bf16x8 a8 = *(const bf16x8*)(T + row * LDC + c * 8), kr8 = ld8g(KRg + o), kk8 = ld8g(KKg + o);
            bf16x8 kd8, bd8;
#pragma unroll
            for (int j = 0; j < 8; ++j) { const float a = bf2f((bf16_t)a8[j]); kd8[j] = (short)f2bf(bf2f((bf16_t)kr8[j]) * (1.f + (a - 1.f) * ka[j])); bd8[j] = (short)f2bf(bf2f((bf16_t)kk8[j]) * a); }
            *(AS1 bf16x8*)gptr(KD + dofs + o) = kd8; *(AS1 bf16x8*)gptr(BD + dofs + o) = bd8; }
        } else {
          float* T = (float*)smem; constexpr int LDC = 132;
          float* dst = which < 2 ? LWp + (size_t)which * NT_ * 256 : GATE;
#pragma unroll 1
          for (int h = 0; h < 2; ++h) {
            __syncthreads();
            if (wr == h) {
#pragma unroll
              for (int ni = 0; ni < 4; ++ni) { const int cl = wc * 64 + ni * 16 + l15; const float bv = which < 2 ? bias[ct * 128 + cl] : 0.f;
#pragma unroll
                for (int mi = 0; mi < 4; ++mi)
#pragma unroll
                  for (int i = 0; i < 4; ++i) { const float v = acc[mi][ni][i]; T[(mi * 16 + 4 * g + i) * LDC + cl] = which < 2 ? -0.6065306597126334f * sigmoidf_(v + bv) : v; } } }
            __syncthreads();
#pragma unroll
            for (int pass = 0; pass < 8; ++pass) { const int id = tid + 256 * pass, row = id >> 5, c = id & 31;
              *(AS1 f32x4*)gptr(dst + (size_t)(rt * 128 + h * 64 + row) * 256 + ct * 128 + c * 4) = *(const f32x4*)(T + row * LDC + c * 4); } }
        }
      });
  }
}

DEVFN bf16x8 ld8(const bf16_t* p) { return *(const bf16x8*)p; }
typedef short bf16x4v __attribute__((ext_vector_type(4)));
DEVFN bf16x4v cvt4(f32x4 v) { return bf16x4v{(short)f2bf(v[0]), (short)f2bf(v[1]), (short)f2bf(v[2]), (short)f2bf(v[3])}; }
DEVFN bf16x8 cat44(bf16x4v a, bf16x4v b) { return bf16x8{a[0], a[1], a[2], a[3], b[0], b[1], b[2], b[3]}; }
DEVFN bf16x4v ld4(const bf16_t* p) { return *(const bf16x4v*)p; }
DEVFN int rm_off(int i, int k) { return i * 64 + ((((k >> 3) ^ (i & 7)) << 3) | (k & 7)); }
#define RW_WAVE_LDS 11264
DEVFN void rwkv_chunk(const Params& p, int unit_base, unsigned char* smem) {
  const int tid = TIDX, lane = tid & 63, wave = tid >> 6, q = lane >> 4, l15 = lane & 15;
  const int unit = unit_base + wave;
  const int c = unit % NC16, h = (unit / NC16) & 3, dir = (unit / (NC16 * 4)) & 1, b = unit / (NC16 * 8);
  bf16_t* big = (bf16_t*)(smem + wave * RW_WAVE_LDS);
  unsigned char* small = smem + wave * RW_WAVE_LDS + 8192;
  float* AbF = (float*)small;
  bf16_t* TN = (bf16_t*)(small + 1024);
  bf16_t* AK = TN + 256; bf16_t* RB = AK + 256; bf16_t* RK = RB + 256;
  const bf16_t* RRg = (const bf16_t*)(p.ws + Ws::RR); const bf16_t* VVg = (const bf16_t*)(p.ws + Ws::VV); const bf16_t* KKg = (const bf16_t*)(p.ws + Ws::KK);
  const bf16_t* KDg = (const bf16_t*)(p.ws + Ws::KD) + (size_t)dir * NT_ * 256; const bf16_t* BDg = (const bf16_t*)(p.ws + Ws::BD) + (size_t)dir * NT_ * 256;
  const float* LWg = (const float*)(p.ws + Ws::LW) + (size_t)dir * NT_ * 256;
  float kkm[16], vv[16], bneg[16], kneg[16];
  float run = 0.f;
  __syncthreads();
#pragma unroll
  for (int i = 0; i < 16; ++i) {
    const size_t o = (size_t)(b * T_ + tokmap(dir, c * 16 + i)) * 256 + h * 64 + lane;
    const float lw = gptr(LWg)[o], r = bf2f(gptr(RRg)[o]), k = bf2f(gptr(KDg)[o]), v = bf2f(gptr(VVg)[o]), kk = bf2f(gptr(KKg)[o]), bb = bf2f(gptr(BDg)[o]);
    const float e_ex = expf(run); run += lw; const float e_in = expf(run), e_neg = expf(-run);
    kkm[i] = kk * e_ex; vv[i] = v; bneg[i] = bb * e_neg; kneg[i] = k * e_neg;
    big[rm_off(i, lane)] = f2bf(kkm[i]); big[1024 + rm_off(i, lane)] = f2bf(r * e_in);
    big[2048 + rm_off(i, lane)] = f2bf(bneg[i]); big[3072 + rm_off(i, lane)] = f2bf(kneg[i]);
  }
  const float WC = expf(run);
  __syncthreads();
  f32x4 ab = f32x4{0.f, 0.f, 0.f, 0.f}, ak = ab, rb = ab, rk = ab;
#pragma unroll
  for (int s2 = 0; s2 < 2; ++s2) { const int ch = ((4 * s2 + q) ^ (l15 & 7)) << 3;
    const bf16x8 a_kk = ld8(big + l15 * 64 + ch), a_r = ld8(big + 1024 + l15 * 64 + ch), b_b = ld8(big + 2048 + l15 * 64 + ch), b_k = ld8(big + 3072 + l15 * 64 + ch);
    ab = MFMA16(a_kk, b_b, ab); ak = MFMA16(a_kk, b_k, ak); rb = MFMA16(a_r, b_b, rb); rk = MFMA16(a_r, b_k, rk); }
  f32x4 gacc[4];
#pragma unroll
  for (int nk = 0; nk < 4; ++nk)
#pragma unroll
    for (int r = 0; r < 4; ++r) gacc[nk][r] = bf2f(big[1024 + rm_off(4 * q + r, 16 * nk + l15)]);
  __syncthreads();
#pragma unroll
  for (int r = 0; r < 4; ++r) { const int i = 4 * q + r, j = l15;
    AbF[i * 16 + j] = j < i ? ab[r] : 0.f; AK[i * 16 + j] = f2bf(j < i ? ak[r] : 0.f);
    RB[i * 16 + j] = f2bf(j <= i ? rb[r] : 0.f); RK[i * 16 + j] = f2bf(j <= i ? rk[r] : 0.f); }
  { bf16_t* KKMT = big; bf16_t* VTT = big + 1024; bf16_t* BHT = big + 2048; bf16_t* KHT = big + 3072;
#pragma unroll
    for (int i = 0; i < 16; ++i) { KKMT[lane * 16 + i] = f2bf(kkm[i]); VTT[lane * 16 + i] = f2bf(vv[i]); BHT[lane * 16 + i] = f2bf(bneg[i] * WC); KHT[lane * 16 + i] = f2bf(kneg[i] * WC); } }
  __syncthreads();
  { float t[16];
#pragma unroll
    for (int i = 0; i < 16; ++i) { float acc = (i == l15) ? 1.f : 0.f;
#pragma unroll
      for (int j = 0; j < i; ++j) acc -= AbF[i * 16 + j] * t[j];
      t[i] = acc; }
    if (q == 0) {
#pragma unroll
      for (int i = 0; i < 16; ++i) TN[i * 16 + l15] = f2bf(-t[i]); } }
  __syncthreads();
  const size_t ci = (size_t)((b * 2 + dir) * 4 + h) * NC16 + c;
  bf16_t* MLg = (bf16_t*)(p.ws + Ws::RML) + ci * 4096; bf16_t* Ng = (bf16_t*)(p.ws + Ws::RNS) + ci * 4096;
  bf16_t* Gg = (bf16_t*)(p.ws + Ws::RG) + ci * 1024; float* Y0g = (float*)(p.ws + Ws::RY0) + ci * 1024;
  const bf16x4v a_T = ld4(TN + l15 * 16 + 4 * q), a_Ak = ld4(AK + l15 * 16 + 4 * q), a_Rb = ld4(RB + l15 * 16 + 4 * q), a_Rk = ld4(RK + l15 * 16 + 4 * q);
  const f32x4 z4 = f32x4{0.f, 0.f, 0.f, 0.f};
  bf16x4v vfr[4], qfr[4], pfr[4];
#pragma unroll
  for (int n = 0; n < 4; ++n) {
    vfr[n] = ld4(big + 1024 + (16 * n + l15) * 16 + 4 * q);
    const f32x4 akv = MFMA16K16(a_Ak, vfr[n], z4);
    qfr[n] = cvt4(MFMA16K16(a_T, cvt4(akv), z4));
    pfr[n] = cvt4(MFMA16K16(a_T, ld4(big + (16 * n + l15) * 16 + 4 * q), z4)); }
  const bf16x8 a_RbRk = cat44(a_Rb, a_Rk);
#pragma unroll
  for (int n = 0; n < 4; ++n) {
    const f32x4 g = MFMA16K16(a_Rb, pfr[n], gacc[n]);
    const f32x4 y0 = MFMA16(a_RbRk, cat44(qfr[n], vfr[n]), z4);
#pragma unroll
    for (int r = 0; r < 4; ++r) { Gg[(4 * q + r) * 64 + 16 * n + l15] = f2bf(g[r]); Y0g[(4 * q + r) * 64 + 16 * n + l15] = y0[r]; } }
#pragma unroll
  for (int n = 0; n < 4; ++n)
#pragma unroll
    for (int r = 0; r < 4; ++r) MLg[((n >> 1) * 64 + (l15 >> 2) * 16 + 4 * q + r) * 8 + (n & 1) * 4 + (l15 & 3)] = (bf16_t)pfr[n][r];
#pragma unroll
  for (int mk = 0; mk < 4; ++mk) {
    const bf16x4v a_B = ld4(big + 2048 + (16 * mk + l15) * 16 + 4 * q), a_K = ld4(big + 3072 + (16 * mk + l15) * 16 + 4 * q);
    const bf16x8 a_BK = cat44(a_B, a_K);
    *(bf16x4v*)(MLg + 1024 + ((mk >> 1) * 64 + lane) * 8 + (mk & 1) * 4) = a_B;
#pragma unroll
    for (int n = 0; n < 4; ++n) {
      const f32x4 nn = MFMA16(a_BK, cat44(qfr[n], vfr[n]), z4);
      *(bf16x4v*)(Ng + (n * 64 + lane) * 16 + mk * 4) = cvt4(nn); } }
  ((float*)(p.ws + Ws::RWC))[ci * 64 + ((lane >> 2) & 3) * 16 + (lane >> 4) * 4 + (lane & 3)] = WC;
}
struct RwStep { bf16x8 pf[2]; bf16x8 bh[2]; bf16x8 n[2]; float wc; };
DEVFN void rw_load(RwStep& t, const bf16_t* MLg, const bf16_t* NSg, const float* WCg, int c, int lane, int q) {
#pragma unroll
  for (int s2 = 0; s2 < 2; ++s2) { t.pf[s2] = ld8g(MLg + (size_t)c * 4096 + (s2 * 64 + lane) * 8); t.bh[s2] = ld8g(MLg + (size_t)c * 4096 + 1024 + (s2 * 64 + lane) * 8); }
  t.wc = gptr(WCg)[(size_t)c * 64 + lane];
  t.n[0] = ld8g(NSg + (size_t)c * 4096 + lane * 16); t.n[1] = ld8g(NSg + (size_t)c * 4096 + lane * 16 + 8);
  (void)q;
}
DEVFN void rw_step(const RwStep& t, f32x4 (&S)[4], bf16_t* NSg, int c, int q, int l15) {
  bf16x4v sb[4];
#pragma unroll
  for (int mk = 0; mk < 4; ++mk) sb[mk] = cvt4(S[mk]);
  const bf16x8 bf0 = cat44(sb[0], sb[1]), bf1 = cat44(sb[2], sb[3]);
  f32x4 w = MFMA16(t.pf[0], bf0, (f32x4{0.f, 0.f, 0.f, 0.f}));
  w = MFMA16(t.pf[1], bf1, w);
  const bf16x4v wb = cvt4(w);
#pragma unroll
  for (int mk = 0; mk < 4; ++mk) {
    f32x4 acc;
#pragma unroll
    for (int r = 0; r < 4; ++r) acc[r] = bf2f((bf16_t)t.n[mk >> 1][(mk & 1) * 4 + r]) + __shfl(t.wc, q * 16 + mk * 4 + r) * S[mk][r];
    const bf16x8 b2 = t.bh[mk >> 1];
    const bf16x4v a_B = (mk & 1) ? bf16x4v{b2[4], b2[5], b2[6], b2[7]} : bf16x4v{b2[0], b2[1], b2[2], b2[3]};
    S[mk] = MFMA16K16(a_B, wb, acc); }
#pragma unroll
  for (int mk = 0; mk < 4; ++mk) *(AS1 bf16x4v*)gptr(NSg + (size_t)c * 4096 + l15 * 64 + 16 * mk + 4 * q) = sb[mk];
}
DEVFN void rwkv_scan(const Params& p, int chain, int wave) {
  const int tid = TIDX, lane = tid & 63, q = lane >> 4, l15 = lane & 15;
  const bf16_t* MLg = (const bf16_t*)(p.ws + Ws::RML) + (size_t)chain * NC16 * 4096;
  bf16_t* NSg = (bf16_t*)(p.ws + Ws::RNS) + (size_t)chain * NC16 * 4096 + wave * 1024;
  const float* WCg = (const float*)(p.ws + Ws::RWC) + (size_t)chain * NC16 * 64;
  f32x4 S[4];
#pragma unroll
  for (int mk = 0; mk < 4; ++mk) S[mk] = f32x4{0.f, 0.f, 0.f, 0.f};
  RwStep t0, t1, t2, t3;
#define RWC_(x) ((x) < NC16 ? (x) : NC16 - 1)
  rw_load(t0, MLg, NSg, WCg, 0, lane, q);
  rw_load(t1, MLg, NSg, WCg, RWC_(1), lane, q);
  rw_load(t2, MLg, NSg, WCg, RWC_(2), lane, q);
  int c = 0;
  for (; c + 3 < NC16; c += 4) {
    rw_load(t3, MLg, NSg, WCg, c + 3, lane, q);
    rw_step(t0, S, NSg, c, q, l15);
    rw_load(t0, MLg, NSg, WCg, RWC_(c + 4), lane, q);
    rw_step(t1, S, NSg, c + 1, q, l15);
    rw_load(t1, MLg, NSg, WCg, RWC_(c + 5), lane, q);
    rw_step(t2, S, NSg, c + 2, q, l15);
    rw_load(t2, MLg, NSg, WCg, RWC_(c + 6), lane, q);
    rw_step(t3, S, NSg, c + 3, q, l15);
  }
  if (c < NC16) { rw_step(t0, S, NSg, c, q, l15); if (c + 1 < NC16) { rw_step(t1, S, NSg, c + 1, q, l15); if (c + 2 < NC16) rw_step(t2, S, NSg, c + 2, q, l15); } }
#undef RWC_
}
DEVFN void rwkv_out(const Params& p, int unit_base) {
  const int tid = TIDX, lane = tid & 63, wave = tid >> 6, q = lane >> 4, l15 = lane & 15;
  const int unit = unit_base + wave;
  const int c = unit % NC16, h = (unit / NC16) & 3, dir = (unit / (NC16 * 4)) & 1, b = unit / (NC16 * 8);
  const size_t ci = (size_t)((b * 2 + dir) * 4 + h) * NC16 + c;
  const bf16_t* Sg = (const bf16_t*)(p.ws + Ws::RNS) + ci * 4096; const bf16_t* Gg = (const bf16_t*)(p.ws + Ws::RG) + ci * 1024;
  const float* Y0g = (const float*)(p.ws + Ws::RY0) + ci * 1024;
  float* YR = (float*)(p.ws + Ws::YR) + (size_t)dir * NT_ * 256;
  const bf16x8 a0 = ld8g(Gg + l15 * 64 + 8 * q), a1 = ld8g(Gg + l15 * 64 + 32 + 8 * q);
  f32x4 acc[4]; bf16x8 s0[4], s1[4];
#pragma unroll
  for (int n = 0; n < 4; ++n) {
#pragma unroll
    for (int r = 0; r < 4; ++r) acc[n][r] = gptr(Y0g)[(4 * q + r) * 64 + 16 * n + l15];
    s0[n] = ld8g(Sg + n * 1024 + l15 * 64 + 8 * q); s1[n] = ld8g(Sg + n * 1024 + l15 * 64 + 32 + 8 * q); }
#pragma unroll
  for (int n = 0; n < 4; ++n) {
    acc[n] = MFMA16(a0, s0[n], acc[n]);
    acc[n] = MFMA16(a1, s1[n], acc[n]);
#pragma unroll
    for (int r = 0; r < 4; ++r) gptr(YR)[(size_t)(b * T_ + tokmap(dir, c * 16 + 4 * q + r)) * 256 + h * 64 + 16 * n + l15] = acc[n][r]; }
}
DEVFN int cscan(int dir, int co, int nctx, int nc) { return dir == 0 ? co : (co < nctx ? nctx - 1 - co : 2 * nctx + nc - 1 - co); }
DEVFN bf16x8 ld4x2g(const bf16_t* p0, const bf16_t* p1) { bf16x4v a = *(const AS1 bf16x4v*)gptr(p0), b = *(const AS1 bf16x4v*)gptr(p1); return bf16x8{a[0], a[1], a[2], a[3], b[0], b[1], b[2], b[3]}; }
DEVFN bf16x8 ld4x2(const bf16_t* p0, const bf16_t* p1) { bf16x4v a = *(const bf16x4v*)p0, b = *(const bf16x4v*)p1; return bf16x8{a[0], a[1], a[2], a[3], b[0], b[1], b[2], b[3]}; }

DEVFN void ssd_chunk_scalars(const Params& p, int l, int b, int co, int h, float* f) {
  const int tid = TIDX, d = tid >> 7, j = tid & 127;
  const float* DTB = (const float*)(p.ws + Ws::DTB);
  const float nega = -expf(INP(I_ALOG)[(size_t)l * 16 + d * 8 + h]);
  const float dt = DTB[(size_t)(b * T_ + co * 128 + j) * 16 + d * 8 + h];
  __syncthreads();
  f[256 + d * 128 + j] = dt;
  float* cur = f + d * 128; float* tmp = f + 512 + d * 128;
  cur[j] = dt * nega;
  __syncthreads();
  for (int off = 1; off < 128; off <<= 1) {
    float v = cur[j] + (j >= off ? cur[j - off] : 0.f);
    tmp[j] = v;
    __syncthreads();
    cur[j] = tmp[j];
    __syncthreads();
  }
}
DEVFN void ssd_states(const Params& p, int l, int unit, unsigned char* smem) {
  const int tid = TIDX, lane = tid & 63, wave = tid >> 6, q = lane >> 4, l15 = lane & 15;
  const int h = unit & 7, co = (unit >> 3) % NC128, b = unit / (8 * NC128), grp = h >> 2;
  float* f = (float*)smem;
  ssd_chunk_scalars(p, l, b, co, h, f);
  { const int d = tid >> 7, j = tid & 127; const float* cum = f + d * 128; const float dt = f[256 + d * 128 + j];
    float w = d == 0 ? expf(cum[127] - cum[j]) * dt : expf(j > 0 ? cum[j - 1] : 0.f) * dt;
    f[512 + d * 128 + j] = w; }
  __syncthreads();
  const bf16_t* XT = (const bf16_t*)(p.ws + Ws::XBCT) + (size_t)(b * NC128 + co) * 768 * 128;
  f32x4 acc[2][8];
#pragma unroll
  for (int d = 0; d < 2; ++d)
#pragma unroll
    for (int n = 0; n < 8; ++n) acc[d][n] = f32x4{0.f, 0.f, 0.f, 0.f};
#pragma unroll 2
  for (int s4 = 0; s4 < 4; ++s4) {
    const int j0 = s4 * 32 + q * 8;
    bf16x8 xa = ld8g(XT + (size_t)(h * 64 + wave * 16 + l15) * 128 + j0), a0, a1;
#pragma unroll
    for (int jj = 0; jj < 8; ++jj) { float x = bf2f((bf16_t)xa[jj]); a0[jj] = (short)f2bf(x * f[512 + j0 + jj]); a1[jj] = (short)f2bf(x * f[640 + j0 + jj]); }
#pragma unroll
    for (int n = 0; n < 8; ++n) { bf16x8 bb = ld8g(XT + (size_t)(512 + grp * 128 + n * 16 + l15) * 128 + j0);
      acc[0][n] = MFMA16(a0, bb, acc[0][n]); acc[1][n] = MFMA16(a1, bb, acc[1][n]); }
  }
#pragma unroll
  for (int d = 0; d < 2; ++d) {
    const int cs = cscan(d, co, CTX_ / 128, SEQ_ / 128);
    float* ST = (float*)(p.ws + Ws::SST) + ((size_t)((d * B_ + b) * NC128 + cs) * 8 + h) * 8192;
#pragma unroll
    for (int n = 0; n < 8; ++n)
#pragma unroll
      for (int r = 0; r < 4; ++r) ST[(wave * 16 + q * 4 + r) * 128 + n * 16 + l15] = acc[d][n][r];
    if (tid == 0) ((float*)(p.ws + Ws::SCD))[((size_t)(d * B_ + b) * NC128 + cs) * 8 + h] = expf(f[d * 128 + 127]);
  }
}
#define SSD_SB ((NC128 % 17) == 0 ? 17 : NC128)
DEVFN void ssd_scan(const Params& p, int gtid, int gthreads) {
  const float* __restrict__ ST = (const float*)(p.ws + Ws::SST); const float* __restrict__ CD = (const float*)(p.ws + Ws::SCD); bf16_t* __restrict__ HIN = (bf16_t*)(p.ws + Ws::HIN);
  for (int e = gtid; e < 2 * B_ * 8 * 8192; e += gthreads) {
    const int pd = e & 8191, h = (e >> 13) & 7, db = e >> 16;
    float hv = 0.f;
#pragma unroll 1
    for (int c0 = 0; c0 < NC128; c0 += SSD_SB) {
      float st[SSD_SB], cd[SSD_SB];
#pragma unroll
      for (int i = 0; i < SSD_SB; ++i) { st[i] = ST[((size_t)(db * NC128 + c0 + i) * 8 + h) * 8192 + pd]; cd[i] = CD[(size_t)(db * NC128 + c0 + i) * 8 + h]; }
#pragma unroll
      for (int i = 0; i < SSD_SB; ++i) { HIN[((size_t)(db * NC128 + c0 + i) * 8 + h) * 8192 + pd] = f2bf(hv); hv = hv * cd[i] + st[i]; }
    }
  }
}
DEVFN void ssd_out(const Params& p, int l, int unit, unsigned char* smem) {
  const int tid = TIDX, lane = tid & 63, wave = tid >> 6, q = lane >> 4, l15 = lane & 15;
  const int h = unit & 7, co = (unit >> 3) % NC128, b = unit / (8 * NC128), grp = h >> 2;
  float* f = (float*)smem;
  ssd_chunk_scalars(p, l, b, co, h, f);
  if (tid < 128) f[640 + tid] = f[128 + 127] - (tid > 0 ? f[128 + tid - 1] : 0.f);
  __syncthreads();
  const float* cum0 = f; const float* suf1 = f + 640; const float* dt0 = f + 256; const float* dt1 = f + 384;
  const bf16_t* XBC = (const bf16_t*)(p.ws + Ws::XBC) + (size_t)(b * T_ + co * 128) * 1024;
  const bf16_t* XT = (const bf16_t*)(p.ws + Ws::XBCT) + (size_t)(b * NC128 + co) * 768 * 128;
  const bf16_t* Cb = XBC + (size_t)(wave * 32 + l15) * 1024 + 768 + grp * 128 + q * 8;
  f32x4 y[4][2];
  { f32x4 o0[4][2], o1[4][2];
#pragma unroll
    for (int mp = 0; mp < 4; ++mp)
#pragma unroll
      for (int ni = 0; ni < 2; ++ni) { o0[mp][ni] = f32x4{0.f, 0.f, 0.f, 0.f}; o1[mp][ni] = f32x4{0.f, 0.f, 0.f, 0.f}; }
    const int cs0 = cscan(0, co, CTX_ / 128, SEQ_ / 128), cs1 = cscan(1, co, CTX_ / 128, SEQ_ / 128);
    const bf16_t* H0 = (const bf16_t*)(p.ws + Ws::HIN) + ((size_t)((0 * B_ + b) * NC128 + cs0) * 8 + h) * 8192;
    const bf16_t* H1 = (const bf16_t*)(p.ws + Ws::HIN) + ((size_t)((1 * B_ + b) * NC128 + cs1) * 8 + h) * 8192;
#pragma unroll
    for (int s4 = 0; s4 < 4; ++s4) { const bf16x8 c0 = ld8g(Cb + s4 * 32), c1 = ld8g(Cb + 16 * 1024 + s4 * 32);
#pragma unroll
      for (int mp = 0; mp < 4; ++mp) { bf16x8 h0 = ld8g(H0 + (size_t)(mp * 16 + l15) * 128 + s4 * 32 + q * 8), h1 = ld8g(H1 + (size_t)(mp * 16 + l15) * 128 + s4 * 32 + q * 8);
        o0[mp][0] = MFMA16(h0, c0, o0[mp][0]); o0[mp][1] = MFMA16(h0, c1, o0[mp][1]);
        o1[mp][0] = MFMA16(h1, c0, o1[mp][0]); o1[mp][1] = MFMA16(h1, c1, o1[mp][1]); } }
#pragma unroll
    for (int ni = 0; ni < 2; ++ni) { const int i = wave * 32 + ni * 16 + l15; const float e0 = expf(cum0[i]), e1 = expf(suf1[i]);
#pragma unroll
      for (int mp = 0; mp < 4; ++mp)
#pragma unroll
        for (int r = 0; r < 4; ++r) y[mp][ni][r] = e0 * o0[mp][ni][r] + e1 * o1[mp][ni][r]; } }
  bf16x8 mfr[4][2];
  { f32x4 g[8][2];
#pragma unroll
    for (int mj = 0; mj < 8; ++mj) { g[mj][0] = f32x4{0.f, 0.f, 0.f, 0.f}; g[mj][1] = f32x4{0.f, 0.f, 0.f, 0.f}; }
#pragma unroll
    for (int s4 = 0; s4 < 4; ++s4) { const bf16x8 c0 = ld8g(Cb + s4 * 32), c1 = ld8g(Cb + 16 * 1024 + s4 * 32);
#pragma unroll
      for (int mj = 0; mj < 8; ++mj) { bf16x8 bb = ld8g(XBC + (size_t)(mj * 16 + l15) * 1024 + 512 + grp * 128 + s4 * 32 + q * 8);
        g[mj][0] = MFMA16(bb, c0, g[mj][0]); g[mj][1] = MFMA16(bb, c1, g[mj][1]); } }
    const int i0 = wave * 32 + l15, i1 = i0 + 16;
    const float c0i0 = cum0[i0], s1i0 = suf1[i0], c0i1 = cum0[i1], s1i1 = suf1[i1];
#pragma unroll
    for (int mj = 0; mj < 8; ++mj)
#pragma unroll
      for (int r = 0; r < 4; ++r) { const int j = mj * 16 + q * 4 + r;
        const float cj = cum0[j], sj = suf1[j], d0 = dt0[j], d1 = dt1[j];
        const float lw0 = (j <= i0 ? expf(c0i0 - cj) * d0 : 0.f) + (j >= i0 ? expf(s1i0 - sj) * d1 : 0.f);
        const float lw1 = (j <= i1 ? expf(c0i1 - cj) * d0 : 0.f) + (j >= i1 ? expf(s1i1 - sj) * d1 : 0.f);
        mfr[mj >> 1][0][(mj & 1) * 4 + r] = (short)f2bf(g[mj][0][r] * lw0);
        mfr[mj >> 1][1][(mj & 1) * 4 + r] = (short)f2bf(g[mj][1][r] * lw1); } }
#pragma unroll
  for (int s4 = 0; s4 < 4; ++s4)
#pragma unroll
    for (int mp = 0; mp < 4; ++mp) { const bf16_t* xr = XT + (size_t)(h * 64 + mp * 16 + l15) * 128 + s4 * 32 + q * 4;
      bf16x8 xa = ld4x2g(xr, xr + 16);
      y[mp][0] = MFMA16(xa, mfr[s4][0], y[mp][0]); y[mp][1] = MFMA16(xa, mfr[s4][1], y[mp][1]); }
  __syncthreads();
  float* yl = f + 1024;
#pragma unroll
  for (int mp = 0; mp < 4; ++mp)
#pragma unroll
    for (int ni = 0; ni < 2; ++ni)
#pragma unroll
      for (int r = 0; r < 4; ++r) yl[(wave * 32 + ni * 16 + l15) * 65 + mp * 16 + q * 4 + r] = y[mp][ni][r];
  __syncthreads();
  float* YS = (float*)(p.ws + Ws::YS) + (size_t)(b * T_ + co * 128) * 512 + h * 64;
  for (int e = tid; e < 128 * 64; e += 256) gptr(YS)[(size_t)(e >> 6) * 512 + (e & 63)] = yl[(e >> 6) * 65 + (e & 63)];
}

#define GQ_LD 40
#define GK_LD 72
DEVFN void gla_chunk(const Params& p, int unit, unsigned char* smem) {
  const int tid = TIDX, lane = tid & 63, wave = tid >> 6, q = lane >> 4, l15 = lane & 15;
  const int h = unit & 3, co = (unit >> 2) % NC64, b = unit / (4 * NC64);
  const bf16_t* ZX = (const bf16_t*)(p.ws + Ws::ZX) + (size_t)(b * T_ + co * 64) * NIN_;
  const float* LA = (const float*)(p.ws + Ws::LA);
  float* cum = (float*)smem;
  bf16_t* qs = (bf16_t*)(smem + 16384);
  bf16_t* ks = qs + 2 * 64 * GQ_LD;
  bf16_t* kt = ks + 2 * 64 * GQ_LD;
  __syncthreads();
  float la[16]; bf16_t qraw[8], kraw[8];
#pragma unroll
  for (int it = 0; it < 16; ++it) { const int e = tid + 256 * it, d = e >> 11, i = (e >> 5) & 63, dd = e & 31;
    la[it] = gptr(LA)[((size_t)d * NT_ + b * T_ + co * 64 + i) * 128 + h * 32 + dd]; }
#pragma unroll
  for (int it = 0; it < 8; ++it) { const int e = tid + 256 * it, i = e >> 5, dd = e & 31;
    qraw[it] = gptr(ZX)[(size_t)i * NIN_ + OGQ + h * 32 + dd]; kraw[it] = gptr(ZX)[(size_t)i * NIN_ + OGK + h * 32 + dd]; }
  const bf16_t* VT = (const bf16_t*)(p.ws + Ws::VT) + ((size_t)(b * NC64 + co) * 256 + h * 64) * 64;
  bf16x8 vfa[4][2], vfs[2];
#pragma unroll
  for (int md = 0; md < 4; ++md)
#pragma unroll
    for (int s2 = 0; s2 < 2; ++s2) { const bf16_t* vr = VT + (size_t)(md * 16 + l15) * 64 + s2 * 32 + q * 4; vfa[md][s2] = ld4x2g(vr, vr + 16); }
#pragma unroll
  for (int s2 = 0; s2 < 2; ++s2) vfs[s2] = ld8g(VT + (size_t)(wave * 16 + l15) * 64 + s2 * 32 + q * 8);
#pragma unroll
  for (int it = 0; it < 16; ++it) cum[tid + 256 * it] = la[it];
  __syncthreads();
  if (tid < 64) { const int d = tid >> 5, dd = tid & 31; float* c = cum + d * 2048 + dd; float sacc = 0.f;
    if (d == 0) for (int i = 0; i < 64; ++i) { sacc += c[i * 32]; c[i * 32] = sacc; }
    else for (int i = 63; i >= 0; --i) { sacc += c[i * 32]; c[i * 32] = sacc; } }
  __syncthreads();
  bf16_t* QT = (bf16_t*)(p.ws + Ws::QT);
#pragma unroll
  for (int it = 0; it < 8; ++it) { const int e = tid + 256 * it, i = e >> 5, dd = e & 31;
    const float qv = bf2f(qraw[it]) * 0.17677669529663687f, kv = bf2f(kraw[it]);
    const float c0 = cum[i * 32 + dd], c1 = cum[2048 + i * 32 + dd], t0 = cum[63 * 32 + dd], t1 = cum[2048 + dd];
    const bf16_t q0 = f2bf(qv * expf(c0)), q1 = f2bf(qv * expf(c1));
    qs[i * GQ_LD + dd] = q0; qs[64 * GQ_LD + i * GQ_LD + dd] = q1;
    ks[i * GQ_LD + dd] = f2bf(kv * expf(-c0)); ks[64 * GQ_LD + i * GQ_LD + dd] = f2bf(kv * expf(-c1));
    kt[dd * GK_LD + i] = f2bf(kv * expf(t0 - c0)); kt[32 * GK_LD + dd * GK_LD + i] = f2bf(kv * expf(t1 - c1));
    const size_t tok = (size_t)b * T_ + co * 64 + i;
    QT[tok * 128 + h * 32 + dd] = q0; QT[((size_t)NT_ + tok) * 128 + h * 32 + dd] = q1; }
  if (tid < 64) { const int d = tid >> 5, dd = tid & 31; const int cs = cscan(d, co, CTX_ / 64, SEQ_ / 64);
    ((float*)(p.ws + Ws::GCD))[(((size_t)(d * B_ + b) * NC64 + cs) * 4 + h) * 32 + dd] = expf(d == 0 ? cum[63 * 32 + dd] : cum[2048 + dd]); }
  __syncthreads();
  bf16x8 pfr[2];
  { f32x4 p0[4], p1[4];
    const bf16x8 qb0 = ld8(qs + (wave * 16 + l15) * GQ_LD + q * 8), qb1 = ld8(qs + 64 * GQ_LD + (wave * 16 + l15) * GQ_LD + q * 8);
#pragma unroll
    for (int mj = 0; mj < 4; ++mj) { p0[mj] = MFMA16(ld8(ks + (mj * 16 + l15) * GQ_LD + q * 8), qb0, (f32x4{0.f, 0.f, 0.f, 0.f}));
      p1[mj] = MFMA16(ld8(ks + 64 * GQ_LD + (mj * 16 + l15) * GQ_LD + q * 8), qb1, (f32x4{0.f, 0.f, 0.f, 0.f})); }
    const int i = wave * 16 + l15;
#pragma unroll
    for (int mj = 0; mj < 4; ++mj)
#pragma unroll
      for (int r = 0; r < 4; ++r) { const int j = mj * 16 + q * 4 + r; pfr[mj >> 1][(mj & 1) * 4 + r] = (short)f2bf((j <= i ? p0[mj][r] : 0.f) + (j >= i ? p1[mj][r] : 0.f)); } }
  f32x4 o[4];
#pragma unroll
  for (int md = 0; md < 4; ++md) { o[md] = f32x4{0.f, 0.f, 0.f, 0.f};
#pragma unroll
    for (int s2 = 0; s2 < 2; ++s2) o[md] = MFMA16(vfa[md][s2], pfr[s2], o[md]); }
#pragma unroll
  for (int d = 0; d < 2; ++d) { const int cs = cscan(d, co, CTX_ / 64, SEQ_ / 64);
    float* GST = (float*)(p.ws + Ws::GST) + (((size_t)(d * B_ + b) * NC64 + cs) * 4 + h) * 2048;
#pragma unroll
    for (int nd = 0; nd < 2; ++nd) { f32x4 st = f32x4{0.f, 0.f, 0.f, 0.f};
#pragma unroll
      for (int s2 = 0; s2 < 2; ++s2) st = MFMA16(vfs[s2], ld8(kt + d * 32 * GK_LD + (nd * 16 + l15) * GK_LD + s2 * 32 + q * 8), st);
#pragma unroll
      for (int r = 0; r < 4; ++r) GST[(wave * 16 + q * 4 + r) * 32 + nd * 16 + l15] = st[r]; } }
  __syncthreads();
  float* ol = (float*)smem;
#pragma unroll
  for (int md = 0; md < 4; ++md)
#pragma unroll
    for (int r = 0; r < 4; ++r) ol[(wave * 16 + l15) * 65 + md * 16 + q * 4 + r] = o[md][r];
  __syncthreads();
  float* OI = (float*)(p.ws + Ws::OI) + (size_t)(b * T_ + co * 64) * 256 + h * 64;
  for (int e = tid; e < 64 * 64; e += 256) gptr(OI)[(size_t)(e >> 6) * 256 + (e & 63)] = ol[(e >> 6) * 65 + (e & 63)];
}
#define GLA_SB ((NC64 % 17) == 0 ? 17 : NC64)
DEVFN void gla_scan(const Params& p, int gtid, int gthreads) {
  const float* __restrict__ ST = (const float*)(p.ws + Ws::GST); const float* __restrict__ CD = (const float*)(p.ws + Ws::GCD); bf16_t* __restrict__ SIN = (bf16_t*)(p.ws + Ws::GSIN);
  for (int e = gtid; e < 2 * B_ * 4 * 2048; e += gthreads) {
    const int vd = e & 2047, h = (e >> 11) & 3, db = e >> 13;
    float sv = 0.f;
#pragma unroll 1
    for (int c0 = 0; c0 < NC64; c0 += GLA_SB) {
      float st[GLA_SB], cd[GLA_SB];
#pragma unroll
      for (int i = 0; i < GLA_SB; ++i) { st[i] = ST[(((size_t)db * NC64 + c0 + i) * 4 + h) * 2048 + vd]; cd[i] = CD[(((size_t)db * NC64 + c0 + i) * 4 + h) * 32 + (vd & 31)]; }
#pragma unroll
      for (int i = 0; i < GLA_SB; ++i) { SIN[(((size_t)db * NC64 + c0 + i) * 4 + h) * 2048 + vd] = f2bf(sv); sv = sv * cd[i] + st[i]; }
    }
  }
}
DEVFN void gla_out(const Params& p, int unit_base) {
  const int tid = TIDX, lane = tid & 63, wave = tid >> 6, g = lane >> 4, l15 = lane & 15;
  const int unit = unit_base + wave;
  if (unit >= B_ * NC64 * 4) return;
  const int h = unit & 3, co = (unit >> 2) % NC64, b = unit / (4 * NC64);
  const bf16_t* QT = (const bf16_t*)(p.ws + Ws::QT);
  const bf16_t* GSIN = (const bf16_t*)(p.ws + Ws::GSIN);
  float* OI = (float*)(p.ws + Ws::OI) + (size_t)(b * T_ + co * 64) * 256 + h * 64;
  const int tok0 = b * T_ + co * 64;
  bf16x8 af[2][4], bfr[2][4];
#pragma unroll
  for (int d = 0; d < 2; ++d) { const int cs = cscan(d, co, CTX_ / 64, SEQ_ / 64);
    const bf16_t* sr = GSIN + ((((size_t)(d * B_ + b) * NC64 + cs) * 4 + h) * 64) * 32;
#pragma unroll
    for (int mi = 0; mi < 4; ++mi) af[d][mi] = ld8g(QT + ((size_t)d * NT_ + tok0 + mi * 16 + l15) * 128 + h * 32 + g * 8);
#pragma unroll
    for (int ni = 0; ni < 4; ++ni) bfr[d][ni] = ld8g(sr + (ni * 16 + l15) * 32 + g * 8); }
#pragma unroll
  for (int mi = 0; mi < 4; ++mi) {
    f32x4 acc[4];
#pragma unroll
    for (int ni = 0; ni < 4; ++ni)
#pragma unroll
      for (int i = 0; i < 4; ++i) acc[ni][i] = gptr(OI)[(size_t)(mi * 16 + 4 * g + i) * 256 + ni * 16 + l15];
#pragma unroll
    for (int ni = 0; ni < 4; ++ni) { acc[ni] = MFMA16(af[0][mi], bfr[0][ni], acc[ni]); acc[ni] = MFMA16(af[1][mi], bfr[1][ni], acc[ni]); }
#pragma unroll
    for (int ni = 0; ni < 4; ++ni)
#pragma unroll
      for (int i = 0; i < 4; ++i) gptr(OI)[(size_t)(mi * 16 + 4 * g + i) * 256 + ni * 16 + l15] = acc[ni][i];
  }
}
DEVFN void convert_moe_weights(const Params& p, int l, unsigned char* smem, int bid, int nb, int j_lo, int j_hi);
#define CVT_JOBS (65 * 192)
#ifndef CVT_SCAN_SHARE
#define CVT_SCAN_SHARE (CVT_JOBS / 8)
#endif
DEVFN void phase4a(const Params& p, int l, unsigned char* smem) {
  const int n_r = B_ * 8 * NC16 / 4;
  for (int u = BIDX; u < n_r; u += gridDim.x) rwkv_chunk(p, (u) * 4, smem);
  (void)l;
}
#define CVT_GRP 8
DEVFN void phase4b(const Params& p, int l, unsigned char* smem) {
  const int bid = BIDX, nrw = B_ * 8, G = (int)gridDim.x;
  const int n_s = B_ * NC128 * 8, n_g = B_ * NC64 * 4;
  if (G >= 8 * nrw) {
    const int q = 2 * nrw, half = G >> 1, on = G - 4 * nrw;
    int sb = -1;
    if (bid < q) sb = bid; else if (bid >= half && bid < half + q) sb = q + (bid - half);
    const int n_c = (CVT_JOBS + CVT_GRP - 1) / CVT_GRP, total = n_s + n_g + n_c;
    unsigned* ctr = (unsigned*)(p.ws + Ws::BAR) + l * 32 + 16;
    volatile int* nxt_s = (volatile int*)(smem + SM_PRE);
    int u;
    if (sb >= 0) { if ((TIDX >> 6) == 0) rwkv_scan(p, sb >> 2, sb & 3);
      __syncthreads();
      if (TIDX == 0) *nxt_s = on + (int)atomicAdd(ctr, 1u);
      __syncthreads();
      u = *nxt_s; }
    else u = bid < half ? bid - q : bid - 2 * q;
    while (u < total) {
      int nxt = 0;
      if (TIDX == 0) nxt = on + (int)atomicAdd(ctr, 1u);
      if (u < n_s) ssd_states(p, l, u, smem); else if (u < n_s + n_g) gla_chunk(p, u - n_s, smem);
      else { const int j0 = (u - n_s - n_g) * CVT_GRP, j1 = j0 + CVT_GRP < CVT_JOBS ? j0 + CVT_GRP : CVT_JOBS; convert_moe_weights(p, l, smem, 0, 1, j0, j1); }
      __syncthreads();
      if (TIDX == 0) *nxt_s = nxt;
      __syncthreads();
      u = *nxt_s;
    }
    return;
  }
  for (int u = bid; u < nrw; u += G) rwkv_scan(p, u, TIDX >> 6);
  for (int u = bid; u < n_s + n_g; u += G) { if (u < n_s) ssd_states(p, l, u, smem); else gla_chunk(p, u - n_s, smem); }
  convert_moe_weights(p, l, smem, bid, G, 0, CVT_JOBS);
}
DEVFN void phase4b2(const Params& p) {
  const int bid = BIDX, G = (int)gridDim.x;
  ssd_scan(p, bid * 256 + TIDX, G * 256); gla_scan(p, bid * 256 + TIDX, G * 256);
}
DEVFN void phase4c(const Params& p, int l, unsigned char* smem) {
  const int n_s = B_ * NC128 * 8, n_r = B_ * 8 * NC16 / 4, n_g = B_ * NC64, total = n_s + n_r + n_g, G = (int)gridDim.x;
  unsigned* ctr = (unsigned*)(p.ws + Ws::BAR) + l * 32;
  volatile int* nxt_s = (volatile int*)(smem + SM_PRE);
  int u = BIDX;
  while (u < total) {
    int nxt = 0;
    if (TIDX == 0) nxt = G + (int)atomicAdd(ctr, 1u);
    if (u < n_s) ssd_out(p, l, u, smem); else if (u < n_s + n_r) rwkv_out(p, (u - n_s) * 4); else gla_out(p, (u - n_s - n_r) * 4);
    __syncthreads();
    if (TIDX == 0) *nxt_s = nxt;
    __syncthreads();
    u = *nxt_s;
  }
}

DEVFN void phase5(const Params& p, int l, unsigned char* smem) {
  const int tid = TIDX, lane = tid & 63, wave = tid >> 6;
  const bf16_t* ZX = (const bf16_t*)(p.ws + Ws::ZX);
  const bf16_t* XBC = (const bf16_t*)(p.ws + Ws::XBC);
  const float* YS = (const float*)(p.ws + Ws::YS); const float* YR = (const float*)(p.ws + Ws::YR); const float* OI = (const float*)(p.ws + Ws::OI);
  const bf16_t* RR = (const bf16_t*)(p.ws + Ws::RR); const bf16_t* VV = (const bf16_t*)(p.ws + Ws::VV); const bf16_t* KD = (const bf16_t*)(p.ws + Ws::KD);
  const float* GATE = (const float*)(p.ws + Ws::GATE);
  bf16_t* YM = (bf16_t*)(p.ws + Ws::YMIX);
  constexpr int TPI = 4;
  float* red = (float*)smem;
  const float dA = INP(I_SSDD)[(size_t)l * 8 + (tid >> 6)], dB = INP(I_SSDD)[(size_t)l * 8 + 4 + (tid >> 6)];
  const float nwA = INP(I_SSDNW)[(size_t)l * 512 + tid], nwB = INP(I_SSDNW)[(size_t)l * 512 + 256 + tid];
  const float lnw = INP(I_LNXW)[(size_t)l * 256 + tid], lnb = INP(I_LNXB)[(size_t)l * 256 + tid], rk = INP(I_RK)[(size_t)l * 256 + tid];
  const float gnw = INP(I_GNW)[(size_t)l * 256 + tid];
  const int per_ = (NT_ / TPI + (int)gridDim.x - 1) / (int)gridDim.x, tp_lo = BIDX * per_, tp_hi = (tp_lo + per_ < NT_ / TPI) ? tp_lo + per_ : NT_ / TPI;
  for (int tp = tp_lo; tp < tp_hi; ++tp) {
    float ys0[TPI], ys1[TPI], x0[TPI], x1[TPI], z0[TPI], z1[TPI], og[TPI], yr[TPI], rr[TPI], kf[TPI], kb[TPI], vv[TPI], gt[TPI], oi[TPI];
#pragma unroll
    for (int t = 0; t < TPI; ++t) { const int tok = tp * TPI + t;
      ys0[t] = gptr(YS)[(size_t)tok * 512 + tid]; ys1[t] = gptr(YS)[(size_t)tok * 512 + 256 + tid];
      x0[t] = bf2f(gptr(XBC)[(size_t)tok * 1024 + tid]); x1[t] = bf2f(gptr(XBC)[(size_t)tok * 1024 + 256 + tid]);
      z0[t] = zxv(ZX, tok, OZ + tid); z1[t] = zxv(ZX, tok, OZ + 256 + tid); og[t] = zxv(ZX, tok, OOG + tid);
      yr[t] = gptr(YR)[(size_t)tok * 256 + tid] + gptr(YR)[((size_t)NT_ + tok) * 256 + tid];
      rr[t] = bf2f(gptr(RR)[(size_t)tok * 256 + tid]); kf[t] = bf2f(gptr(KD)[(size_t)tok * 256 + tid]); kb[t] = bf2f(gptr(KD)[((size_t)NT_ + tok) * 256 + tid]);
      vv[t] = bf2f(gptr(VV)[(size_t)tok * 256 + tid]); gt[t] = gptr(GATE)[(size_t)tok * 256 + tid]; oi[t] = gptr(OI)[(size_t)tok * 256 + tid];
    }
    float ya[TPI], yb[TPI], qa[TPI], qb[TPI];
#pragma unroll
    for (int t = 0; t < TPI; ++t) {
      ya[t] = (ys0[t] + dA * x0[t]) * siluf_(z0[t]); yb[t] = (ys1[t] + dB * x1[t]) * siluf_(z1[t]);
      qa[t] = wave_sum(ya[t] * ya[t]); qb[t] = wave_sum(yb[t] * yb[t]); }
    __syncthreads();
#pragma unroll
    for (int t = 0; t < TPI; ++t)
      if (lane == 0) { red[t * 8 + wave] = qa[t]; red[t * 8 + 4 + wave] = qb[t]; }
    __syncthreads();
#pragma unroll
    for (int t = 0; t < TPI; ++t) { const int tok = tp * TPI + t;
      const float* rd = red + t * 8;
      float ma = (rd[0] + rd[1] + rd[2] + rd[3]) * (1.f / 256.f), mb = (rd[4] + rd[5] + rd[6] + rd[7]) * (1.f / 256.f);
      YM[(size_t)tok * 1024 + tid] = f2bf(ya[t] * rsqrtf(ma + 1e-5f) * nwA);
      YM[(size_t)tok * 1024 + 256 + tid] = f2bf(yb[t] * rsqrtf(mb + 1e-5f) * nwB);
      { const float y = yr[t];
        float mu = wave_sum(y) * (1.f / 64.f), d = y - mu, var = wave_sum(d * d) * (1.f / 64.f);
        float yn = d * rsqrtf(var + 64e-5f) * lnw + lnb;
        float bonus = wave_sum(rr[t] * (kf[t] + kb[t]) * rk) * vv[t];
        YM[(size_t)tok * 1024 + 512 + tid] = f2bf((yn + bonus) * gt[t]); }
      { float o = oi[t];
        float ms = wave_sum(o * o) * (1.f / 64.f);
        YM[(size_t)tok * 1024 + 768 + tid] = f2bf(o * rsqrtf(ms + 1e-5f) * gnw * siluf_(og[t])); } }
  }
}

DEVFN void phase6(const Params& p, int l, unsigned char* smem) {
  const bf16_t* A = (const bf16_t*)(p.ws + Ws::YMIX);
  const bf16_t* W = (const bf16_t*)(p.ws + Ws::WOUT) + (size_t)l * 1024 * 1024;
  float* MIX = (float*)(p.ws + Ws::MIX);
  for (int u = BIDX; u < (NT_ / 128) * 8; u += gridDim.x) {
    int rt = u / 8, ct = u % 8;
    gemm_tile(smem, 1024,
      [&](int r) { return A + (size_t)(rt * 128 + r) * 1024; },
      [&](int r) { return W + (size_t)(ct * 128 + r) * 1024; },
      [&](f32x4 (&acc)[4][4], int wr, int wc, int g, int l15) {
#pragma unroll
        for (int mi = 0; mi < 4; ++mi)
#pragma unroll
          for (int ni = 0; ni < 4; ++ni)
#pragma unroll
            for (int i = 0; i < 4; ++i) MIX[(size_t)(rt * 128 + wr * 64 + mi * 16 + 4 * g + i) * 1024 + ct * 128 + wc * 64 + ni * 16 + l15] = acc[mi][ni][i];
      });
  }
}

#define P7_MAXE 2048
DEVFN void phase7(const Params& p, int l, unsigned char* smem) {
  const int lane = TIDX & 63, wave = TIDX >> 6;
  float* X = (float*)(p.ws + Ws::X);
  const float* MIX = (const float*)(p.ws + Ws::MIX);
  bf16_t* H = (bf16_t*)(p.ws + Ws::U);
  const float* rwt = (const float*)(p.ws + Ws::RWT) + (size_t)l * 64 * 1024;
  int* cnt = (int*)(p.ws + Ws::CNT) + l * 64 * 64;
  int* ltok = (int*)(p.ws + Ws::LTOK); float* lwt = (float*)(p.ws + Ws::LWT);
  const float rbias = INP(I_RB)[(size_t)l * 64 + lane];
  float* hs = (float*)smem;
  float* lg = hs + 4096;
  int* lcnt = (int*)(lg + 256);
  int* lbase = lcnt + 80;
  int* etok = lbase + 64;
  int* epos = etok + P7_MAXE; float* ewt = (float*)(epos + P7_MAXE);
  for (int i = TIDX; i < 80; i += 256) lcnt[i] = 0;
  for (int tok0 = BIDX * 4; tok0 < NT_; tok0 += gridDim.x * 4) {
    const int tok = tok0 + wave;
    const float* mod = (const float*)(p.ws + Ws::MOD) + ((size_t)l * NR_ + tok_modrow(tok)) * NMOD_;
    float xv[16], mx[16], g1[16], lw[16], lb[16], sh2[16], sc2[16], mean, rstd;
    load_row16(X + (size_t)tok * 1024, lane, xv);
    load_row16(MIX + (size_t)tok * 1024, lane, mx);
    load_row16(mod + 2 * 1024, lane, g1);
    load_row16(INP(I_LN1W) + (size_t)l * 1024, lane, lw);
    load_row16(INP(I_LN1B) + (size_t)l * 1024, lane, lb);
    load_row16(mod + 3 * 1024, lane, sh2);
    load_row16(mod + 4 * 1024, lane, sc2);
#pragma unroll
    for (int i = 0; i < 16; ++i) xv[i] = ALPHA_ * xv[i] + g1[i] * mx[i];
    row_stats(xv, mean, rstd);
#pragma unroll
    for (int i = 0; i < 16; ++i) xv[i] = (xv[i] - mean) * rstd * lw[i] + lb[i];
#pragma unroll
    for (int j = 0; j < 4; ++j) *(float4*)(X + (size_t)tok * 1024 + lane * 4 + 256 * j) = make_float4(xv[4 * j], xv[4 * j + 1], xv[4 * j + 2], xv[4 * j + 3]);
    const bool routed = !(l == DEPTH_ - 1 && (tok % T_) < CTX_);
    row_stats(xv, mean, rstd);
#pragma unroll
    for (int i = 0; i < 16; ++i) xv[i] = (xv[i] - mean) * rstd * (1.f + sc2[i]) + sh2[i];
    __syncthreads();
#pragma unroll
    for (int j = 0; j < 4; ++j) {
      if (routed) *(uint2*)(H + (size_t)tok * 1024 + lane * 4 + 256 * j) = make_uint2((unsigned)f2bf(xv[4 * j]) | ((unsigned)f2bf(xv[4 * j + 1]) << 16), (unsigned)f2bf(xv[4 * j + 2]) | ((unsigned)f2bf(xv[4 * j + 3]) << 16));
      *(float4*)(hs + wave * 1024 + lane * 4 + 256 * j) = make_float4(xv[4 * j], xv[4 * j + 1], xv[4 * j + 2], xv[4 * j + 3]); }
    __syncthreads();
    { float hv[4][16];
      const int rot = BIDX & 15;
#pragma unroll
      for (int t = 0; t < 4; ++t)
#pragma unroll
        for (int j = 0; j < 4; ++j) { const float4 v = *(const float4*)(hs + t * 1024 + lane * 4 + 256 * j); hv[t][4 * j] = v.x; hv[t][4 * j + 1] = v.y; hv[t][4 * j + 2] = v.z; hv[t][4 * j + 3] = v.w; }
      float pe[64];
      const AS1 float* rw = gptr(rwt) + lane * 4;
      f32x4 w[4], wn[4];
#pragma unroll
      for (int j = 0; j < 4; ++j) w[j] = *(const AS1 f32x4*)(rw + (size_t)(16 * wave + (rot & 15)) * 1024 + 256 * j);
#pragma unroll
      for (int e = 0; e < 16; ++e) {
        if (e + 1 < 16) {
#pragma unroll
          for (int j = 0; j < 4; ++j) wn[j] = *(const AS1 f32x4*)(rw + (size_t)(16 * wave + ((e + 1 + rot) & 15)) * 1024 + 256 * j); }
#pragma unroll
        for (int t = 0; t < 4; ++t) { float s0 = 0.f, s1 = 0.f;
#pragma unroll
          for (int j = 0; j < 4; ++j) { s0 += hv[t][4 * j] * w[j][0] + hv[t][4 * j + 2] * w[j][2]; s1 += hv[t][4 * j + 1] * w[j][1] + hv[t][4 * j + 3] * w[j][3]; }
          pe[e * 4 + t] = s0 + s1; }
#pragma unroll
        for (int j = 0; j < 4; ++j) w[j] = wn[j]; }
#pragma unroll
      for (int half = 32; half >= 1; half >>= 1) { const bool up = (lane & half) != 0;
#pragma unroll
        for (int e = 0; e < half; ++e) { const float send = up ? pe[e] : pe[e + half]; const float recv = __shfl_xor(send, half); pe[e] = (up ? pe[e + half] : pe[e]) + recv; } }
      lg[(lane & 3) * 64 + 16 * wave + (((lane >> 2) + rot) & 15)] = pe[0]; }
    __syncthreads();
    if (!routed) continue;
    const float logit = lg[wave * 64 + lane];
    const float score = sigmoidf_(logit), sel = score + rbias;
    float m1 = sel; int a1 = lane;
#pragma unroll
    for (int m = 1; m <= 4; m <<= 1) { float ov = XOR8(m1, m); int oa = XOR8(a1, m); if (ov > m1 || (ov == m1 && oa < a1)) { m1 = ov; a1 = oa; } }
    float m2 = (lane == a1) ? -3.0e38f : sel;
#pragma unroll
    for (int m = 1; m <= 4; m <<= 1) m2 = fmaxf(m2, XOR8(m2, m));
    const float gs = m1 + m2; const int grp = lane >> 3;
    int grank = 0;
#pragma unroll
    for (int g2 = 0; g2 < 8; ++g2) { float og = SHFL_CONST(gs, g2 * 8); grank += (og > gs || (og == gs && g2 < grp)) ? 1 : 0; }
    const bool gsel = grank < 4;
    const float msel = gsel ? sel : -3.0e38f;
    int rank = 0;
#pragma unroll
    for (int e = 0; e < 64; ++e) { float ov = SHFL_CONST(msel, e); rank += (ov > msel || (ov == msel && e < lane)) ? 1 : 0; }
    const bool chosen = gsel && rank < 8;
    const float wsum = wave_sum(chosen ? score : 0.f);
    if (chosen) { const float wv = score / wsum * 2.5f;
      const int idx = atomicAdd(&lcnt[64], 1);
      if (idx < P7_MAXE) { const int slot = atomicAdd(&lcnt[lane], 1); etok[idx] = tok * 8 + rank; epos[idx] = lane | (slot << 8); ewt[idx] = wv; }
      else { int pos = atomicAdd(&cnt[lane * 64], 1); ltok[(size_t)lane * NT_ + pos] = tok * 8 + rank; lwt[(size_t)lane * NT_ + pos] = wv; } }
  }
  __syncthreads();
  if (TIDX < 64) { const int c = lcnt[TIDX]; lbase[TIDX] = c ? atomicAdd(&cnt[TIDX * 64], c) : 0; }
  __syncthreads();
  { const int ne = lcnt[64] < P7_MAXE ? lcnt[64] : P7_MAXE;
    for (int i = TIDX; i < ne; i += 256) { const int e = epos[i] & 255, pos = lbase[e] + (epos[i] >> 8);
      ltok[(size_t)e * NT_ + pos] = etok[i]; lwt[(size_t)e * NT_ + pos] = ewt[i]; } }
}

struct MoeMap { int nblk_total; int e; int rb; int cnt; int hoff; };
DEVFN int moe_ntok(int l) { return l == DEPTH_ - 1 ? B_ * SEQ_ : NT_; }
DEVFN int moe_shared_tok(int l, int i) { return l == DEPTH_ - 1 ? (i / SEQ_) * T_ + CTX_ + (i % SEQ_) : i; }
DEVFN void moe_prefix(const Params& p, int l, int* pre) {
  const int* cnt = (const int*)(p.ws + Ws::CNT) + l * 64 * 64;
  __syncthreads();
  if (TIDX < 64) pre[66 + TIDX] = gptr(cnt)[TIDX * 64];
  if (TIDX == 64) pre[66 + 64] = moe_ntok(l);
  __syncthreads();
  if (TIDX == 0) { int s = 0; for (int e = 0; e < 65; ++e) { pre[e] = s; s += (pre[66 + e] + 127) / 128; } pre[65] = s; }
  __syncthreads();
}
DEVFN void phase8(const Params& p, int l, unsigned char* smem) {
  int* pre = (int*)(smem + SM_PRE);
  moe_prefix(p, l, pre);
  const bf16_t* H = (const bf16_t*)(p.ws + Ws::U);
  const bf16_t* W13 = (const bf16_t*)(p.ws + Ws::W13);
  bf16_t* HID = (bf16_t*)(p.ws + Ws::HID);
  const int* ltok = (const int*)(p.ws + Ws::LTOK); const float* lwt = (const float*)(p.ws + Ws::LWT);
  const int total = pre[65];
  for (int u = BIDX; u < total * 2; u += gridDim.x) {
    const int gb = u >> 1, nt = u & 1;
    int e = 0; while (pre[e + 1] <= gb) ++e;
    e = UNI(e);
    const int rb = UNI(gb - pre[e]), cnt = UNI(pre[66 + e]);
    int* tk_s = (int*)(smem + GEMMW_SMEM); float* gw_s = (float*)(tk_s + 128);
    __syncthreads();
    if (TIDX < 128) { const int pos = rb * 128 + TIDX; int tk = -1; float gw = 0.f;
      if (pos < cnt) { tk = e < 64 ? (gptr(ltok)[(size_t)e * NT_ + pos] >> 3) : moe_shared_tok(l, pos); gw = e < 64 ? gptr(lwt)[(size_t)e * NT_ + pos] : 1.f; }
      tk_s[TIDX] = tk; gw_s[TIDX] = gw; }
    __syncthreads();
    gemm_tile_w<1, 1024>(smem, 1024,
      [&](int r) { const int tk = tk_s[r]; return tk >= 0 ? H + (size_t)tk * 1024 : (const bf16_t*)(p.ws + Ws::ZROW); },
      [&](int) { return W13 + ((size_t)e * 512 + nt * 256) * 1024; },
      [&](f32x4 (&acc)[4][8], int, int wr, int wc, int g, int l15) {
        tile_store_bf16<16>(smem, wr, g, l15,
          [&](bf16_t* T, int ldc) {
#pragma unroll
            for (int mi = 0; mi < 4; ++mi)
#pragma unroll
              for (int i = 0; i < 4; ++i) { const int r = wr * 64 + mi * 16 + 4 * g + i;
                const float gw = gw_s[r];
#pragma unroll
                for (int j = 0; j < 4; ++j) T[r * ldc + wc * 64 + j * 16 + l15] = f2bf(siluf_(acc[mi][2 * j][i]) * acc[mi][2 * j + 1][i] * gw); } },
          [&](int row, int c0) { const int pos = rb * 128 + row; return pos < cnt ? HID + ((size_t)gb * 128 + row) * 256 + nt * 128 + c0 : (bf16_t*)nullptr; });
      });
  }
}
DEVFN void phase9(const Params& p, int l, unsigned char* smem) {
  int* pre = (int*)(smem + SM_PRE);
  moe_prefix(p, l, pre);
  const bf16_t* HID = (const bf16_t*)(p.ws + Ws::HID);
  const bf16_t* W2T = (const bf16_t*)(p.ws + Ws::W2T);
  bf16_t* YB = (bf16_t*)(p.ws + Ws::YBUF);
  const int* ltok = (const int*)(p.ws + Ws::LTOK);
  const int total = pre[65];
  for (int u = BIDX; u < total * 2; u += gridDim.x) {
    const int gb = u >> 1, ntp = u & 1;
    int e = 0; while (pre[e + 1] <= gb) ++e;
    e = UNI(e);
    const int rb = UNI(gb - pre[e]), cnt = UNI(pre[66 + e]);
    int* ts_s = (int*)(smem + GEMMW_SMEM);
    __syncthreads();
    if (TIDX < 128) { const int pos = rb * 128 + TIDX; int ts = -1;
      if (pos < cnt) ts = e < 64 ? gptr(ltok)[(size_t)e * NT_ + pos] : moe_shared_tok(l, pos) * 8;
      ts_s[TIDX] = ts; }
    __syncthreads();
    gemm_tile_w<2, 256>(smem, 256,
      [&](int r) { return ts_s[r] >= 0 ? HID + ((size_t)gb * 128 + r) * 256 : (const bf16_t*)(p.ws + Ws::ZROW); },
      [&](int j) { return W2T + ((size_t)e * 1024 + (ntp * 2 + j) * 256) * 256; },
      [&](f32x4 (&acc)[4][8], int j, int wr, int wc, int g, int l15) { const int nt = ntp * 2 + j;
#pragma unroll 1
        for (int h = 0; h < 2; ++h)
          tile_store_bf16<16>(smem, wr, g, l15,
            [&](bf16_t* T, int ldc) {
              if (wc == h) {
#pragma unroll
                for (int mi = 0; mi < 4; ++mi)
#pragma unroll
                  for (int ni = 0; ni < 8; ++ni)
#pragma unroll
                    for (int i = 0; i < 4; ++i) T[(wr * 64 + mi * 16 + 4 * g + i) * ldc + ni * 16 + l15] = f2bf(acc[mi][ni][i]); } },
            [&](int row, int c0) { const int ts = ts_s[row]; if (ts < 0) return (bf16_t*)nullptr;
              const int tok = ts >> 3, slot = e < 64 ? (ts & 7) : 8;
              return YB + ((size_t)tok * NSLOT + slot) * 1024 + nt * 256 + h * 128 + c0; });
      });
  }
}

#define SMEM_BYTES (PH_SMEM + 2048)
#define N_PHASES (3 + 13 * DEPTH_)
__global__ void __launch_bounds__(256, 2) mega(Params p, int ph_lo, int ph_hi) {
#ifdef HIPEMU
  unsigned char* smem = hipemu::cur_smem();
#else
  unsigned char* smem = smem_dyn;
  volatile LAS unsigned* st = (volatile LAS unsigned*)(smem_dyn + SM_BAR);
  if (threadIdx.x == 0) {
    st[0] = 0u; st[1] = 0u;
    unsigned long long* tab = (unsigned long long*)(smem_dyn + SM_TAB);
#pragma unroll
    for (int i = 0; i < 40; ++i) tab[i] = (unsigned long long)p.in[i];
  }
  __syncthreads();
  XcdBarrier bar = xcd_barrier_post((unsigned*)(p.ws + Ws::BAR), st);
#define GRID_SYNC() xcd_barrier(bar)
#endif
  int ph = 0;
#ifdef ONLY_KIND
#define KIND_ON(k) ((k) == ONLY_KIND)
#else
#define KIND_ON(k) 1
#endif
#ifndef REPEAT_MASK
#define REPEAT_MASK 0u
#endif
#define RUN_PHASE(kind, code) { if (KIND_ON(kind) && ph >= ph_lo && ph < ph_hi) { \
    int nrep_ = ((REPEAT_MASK >> (kind)) & 1u) ? 2 : 1; LAUNDER(nrep_); \
    _Pragma("unroll 1") for (int rep_ = 0; rep_ < nrep_; ++rep_) { LAUNDER(p.ws); LAUNDER(p.out); code; if (rep_ + 1 < nrep_ || ph + 1 < ph_hi) { GRID_SYNC(); } } } ++ph; }
  RUN_PHASE(0, phase0(p, smem));
  RUN_PHASE(11, phase0b(p));
  for (int l = 0; l < DEPTH_; ++l) {
    RUN_PHASE(1, phase1(p, l));
    RUN_PHASE(2, phase2(p, l, smem));
    RUN_PHASE(3, phase3(p, l, smem));
    RUN_PHASE(14, phase3b(p, l, smem));
    RUN_PHASE(4, phase4a(p, l, smem));
    RUN_PHASE(12, phase4b(p, l, smem));
    RUN_PHASE(16, phase4b2(p));
    RUN_PHASE(13, phase4c(p, l, smem));
    RUN_PHASE(5, phase5(p, l, smem));
    RUN_PHASE(6, phase6(p, l, smem));
    RUN_PHASE(7, phase7(p, l, smem));
    RUN_PHASE(8, phase8(p, l, smem));
    RUN_PHASE(9, phase9(p, l, smem));
  }
  RUN_PHASE(10, phase_final(p));
}

extern "C" void kernel_launch(void* const* d_in, const int* in_sizes, int n_in, void* d_out, int out_size, void* d_ws, size_t ws_size, hipStream_t stream) {
  Params p{};
  for (int i = 0; i < 40; ++i) p.in[i] = (const float*)d_in[i];
  p.out = (float*)d_out;
  p.ws = (unsigned char*)d_ws;
  if (ws_size < Ws::END) { fprintf(stderr, "workspace too small: %zu < %zu\n", ws_size, (size_t)Ws::END); return; }
  hipMemsetAsync(d_ws, 0, Ws::ZERO_END, stream);
#ifdef HIPEMU
  int grid = 16; if (const char* e = getenv("EMU_GRID")) grid = atoi(e);
  int stop = N_PHASES; if (const char* e = getenv("EMU_STOP")) stop = atoi(e);
  if (getenv("EMU_ONE")) hipemu::launch(grid, 256, SMEM_BYTES, true, [=] { mega(p, 0, stop); });
  else for (int ph = 0; ph < stop; ++ph) hipemu::launch(grid, 256, SMEM_BYTES, false, [=] { mega(p, ph, ph + 1); });
#else
  static int grid = 0;
  if (!grid) {
    int dev = 0, cus = 0, per_cu = 0;
    hipGetDevice(&dev);
    hipDeviceGetAttribute(&cus, hipDeviceAttributeMultiprocessorCount, dev);
    hipOccupancyMaxActiveBlocksPerMultiprocessor(&per_cu, mega, 256, SMEM_BYTES);
    if (per_cu > 2) per_cu = 2;
    if (per_cu < 1) per_cu = 1;
    grid = cus * per_cu;
  }
#if N_LAUNCH_MODE == 1
  mega<<<grid, 256, SMEM_BYTES, stream>>>(p, 0, N_PHASES);
#else
  for (int ph = 0; ph < N_PHASES; ++ph) mega<<<grid, 256, SMEM_BYTES, stream>>>(p, ph, ph + 1);
#endif
#endif
}
```

```cpp
#ifndef HIPEMU
#include <hip/hip_runtime.h>
#endif
#include <stdint.h>
#include <stdio.h>

#ifndef B_
#define B_ 4
#endif
#ifndef SEQ_
#define SEQ_ 4096
#endif
#ifndef CTX_
#define CTX_ 256
#endif
#ifndef DEPTH_
#define DEPTH_ 4
#endif
#ifndef N_LAUNCH_MODE
#define N_LAUNCH_MODE 1
#endif
#define T_ (SEQ_ + CTX_)
#define NT_ (B_ * T_)
#define D_ 1024
#define NIN_ 3504
#define NMOD_ 6144
#define NR_ (B_ + 1)
#define OZ 0
#define OXBC 512
#define ODT 1536
#define ORW 1552
#define OGQ 2704
#define OGK 2832
#define OGV 2960
#define OGD 3216
#define OOG 3248
#define ALPHA_ 1.681792830507429f
#define NEXP 64
#define NSLOT 9
#define NC128 (T_ / 128)
#define NC64 (T_ / 64)
#define NC16 (T_ / 16)

#define DEVFN __device__ __forceinline__
#define LDT 72
#define GEMM_SMEM (2 * 128 * LDT * 2)
#define GEMMW_SMEM (3 * 128 * LDT * 2)
typedef unsigned short bf16_t;
#ifdef HIPEMU
#define AS1
#else
#define AS1 __attribute__((address_space(1)))
#endif
typedef unsigned u32x4 __attribute__((ext_vector_type(4)));
typedef unsigned u32x2 __attribute__((ext_vector_type(2)));

#ifdef HIPEMU
typedef emu_bf16x8 bf16x8;
typedef emu_f32x4 f32x4;
#define MFMA16(a, b, c) emu_mfma_16x16x32_bf16(a, b, c)
#define MFMA16K16(a, b, c) emu_mfma_16x16x16_bf16(a, b, c)
#define GRID_SYNC() hipemu::grid_sync()
#else
typedef short bf16x8 __attribute__((ext_vector_type(8)));
typedef float f32x4 __attribute__((ext_vector_type(4)));
#define MFMA16(a, b, c) __builtin_amdgcn_mfma_f32_16x16x32_bf16(a, b, c, 0, 0, 0)
#define MFMA16K16(a, b, c) __builtin_amdgcn_mfma_f32_16x16x16bf16_1k(a, b, c, 0, 0, 0)
#endif

DEVFN float bf2f(bf16_t h) { return __builtin_bit_cast(float, (unsigned)h << 16); }
DEVFN bf16_t f2bf(float f) { unsigned u = __builtin_bit_cast(unsigned, f); u += 0x7FFFu + ((u >> 16) & 1u); return (bf16_t)(u >> 16); }
template <class T> DEVFN AS1 T* gptr(T* q) { return (AS1 T*)q; }
DEVFN bf16x8 ld8g(const bf16_t* q) { return *(const AS1 bf16x8*)gptr(q); }
DEVFN float sigmoidf_(float x) { return 1.f / (1.f + expf(-x)); }
DEVFN float siluf_(float x) { return x / (1.f + expf(-x)); }
DEVFN float softplusf_(float x) { return x > 20.f ? x : log1pf(expf(x)); }
DEVFN float logsigmoidf_(float x) { return fminf(x, 0.f) - log1pf(expf(-fabsf(x))); }
#ifdef HIPEMU
DEVFN float wave_sum(float v) { for (int m = 32; m >= 1; m >>= 1) v += __shfl_xor(v, m); return v; }
#define SHFL_CONST(x, ln) __shfl(x, ln)
#define XOR8(x, m) __shfl_xor(x, m)
#else
template <int CTRL> DEVFN float dpp_f(float v) { return __builtin_bit_cast(float, __builtin_amdgcn_update_dpp(0, __builtin_bit_cast(int, v), CTRL, 0xF, 0xF, false)); }
template <int CTRL> DEVFN int dpp_i(int v) { return __builtin_amdgcn_update_dpp(0, v, CTRL, 0xF, 0xF, false); }
DEVFN float rdl_f(float v, int ln) { return __builtin_bit_cast(float, __builtin_amdgcn_readlane(__builtin_bit_cast(int, v), ln)); }
DEVFN float wave_sum(float v) {
  v += dpp_f<0xB1>(v);
  v += dpp_f<0x4E>(v);
  v += dpp_f<0x141>(v);
  v += dpp_f<0x140>(v);
  return (rdl_f(v, 0) + rdl_f(v, 16)) + (rdl_f(v, 32) + rdl_f(v, 48));
}
DEVFN float shfl_const_(float x, int ln) { return rdl_f(x, ln); }
DEVFN int shfl_const_(int x, int ln) { return __builtin_amdgcn_readlane(x, ln); }
#define SHFL_CONST(x, ln) shfl_const_(x, ln)
DEVFN float xor8_(float x, int m) { return m == 1 ? dpp_f<0xB1>(x) : m == 2 ? dpp_f<0x4E>(x) : dpp_f<0x141>(x); }
DEVFN int xor8_(int x, int m) { return m == 1 ? dpp_i<0xB1>(x) : m == 2 ? dpp_i<0x4E>(x) : dpp_i<0x141>(x); }
#define XOR8(x, m) xor8_(x, m)
#endif

constexpr size_t al(size_t x) { return (x + 255) & ~(size_t)255; }
struct Ws {
  static constexpr size_t BAR = 0;
  static constexpr size_t CNT = 16384;
  static constexpr size_t MOD = CNT + (size_t)DEPTH_ * 64 * 256;
  static constexpr size_t ZROW = al(MOD + (size_t)DEPTH_ * NR_ * NMOD_ * 4);
  static constexpr size_t ZERO_END = al(ZROW + 2048);
  static constexpr size_t MODP = ZERO_END;
  static constexpr size_t RWT = al(MODP + (size_t)16 * DEPTH_ * NR_ * NMOD_ * 4);
  static constexpr size_t LORA = al(RWT + (size_t)DEPTH_ * 64 * 1024 * 4);
  static constexpr size_t X = al(LORA + (size_t)DEPTH_ * 98304 * 2);
  static constexpr size_t U = al(X + (size_t)NT_ * 1024 * 4);
  static constexpr size_t YMIX = al(U + (size_t)NT_ * 1024 * 2);
  static constexpr size_t ZX = al(YMIX + (size_t)NT_ * 1024 * 2);
  static constexpr size_t MIX = ZX;
  static constexpr size_t LTOK = al(ZX + (size_t)NT_ * NIN_ * 2);
  static constexpr size_t LWT = al(LTOK + (size_t)64 * NT_ * 4);
  static constexpr size_t WIN = al(LWT + (size_t)64 * NT_ * 4);
  static constexpr size_t WOUT = al(WIN + (size_t)DEPTH_ * NIN_ * 1024 * 2);
  static constexpr size_t W13 = al(WOUT + (size_t)DEPTH_ * 1024 * 1024 * 2);
  static constexpr size_t W2T = al(W13 + (size_t)65 * 512 * 1024 * 2);
  static constexpr size_t UNI = al(W2T + (size_t)65 * 1024 * 256 * 2);
  static constexpr size_t XBC = UNI;
  static constexpr size_t XBCT = al(XBC + (size_t)NT_ * 1024 * 2);
  static constexpr size_t DTB = al(XBCT + (size_t)NT_ * 768 * 2);
  static constexpr size_t SST = al(DTB + (size_t)NT_ * 16 * 4);
  static constexpr size_t SCD = al(SST + (size_t)2 * NT_ / 128 * 8 * 8192 * 4);
  static constexpr size_t HIN = al(SCD + (size_t)2 * NT_ / 128 * 8 * 4);
  static constexpr size_t YS = SST;
  static constexpr size_t LA = al(HIN + (size_t)2 * NT_ / 128 * 8 * 8192 * 2);
  static constexpr size_t VT = al(LA + (size_t)2 * NT_ * 128 * 4);
  static constexpr size_t QT = al(VT + (size_t)NT_ * 256 * 2);
  static constexpr size_t OI = al(QT + (size_t)2 * NT_ * 128 * 2);
  static constexpr size_t GST = al(OI + (size_t)NT_ * 256 * 4);
  static constexpr size_t GCD = al(GST + (size_t)2 * NT_ / 64 * 4 * 2048 * 4);
  static constexpr size_t GSIN = al(GCD + (size_t)2 * NT_ / 64 * 4 * 32 * 4);
  static constexpr size_t RR = al(GSIN + (size_t)2 * NT_ / 64 * 4 * 2048 * 2);
  static constexpr size_t VV = RR + (size_t)NT_ * 256 * 2;
  static constexpr size_t KK = VV + (size_t)NT_ * 256 * 2;
  static constexpr size_t KD = KK + (size_t)NT_ * 256 * 2;
  static constexpr size_t BD = KD + (size_t)2 * NT_ * 256 * 2;
  static constexpr size_t LW = BD + (size_t)2 * NT_ * 256 * 2;
  static constexpr size_t GATE = LW + (size_t)2 * NT_ * 256 * 4;
  static constexpr size_t YR = GATE + (size_t)NT_ * 256 * 4;
  static constexpr size_t RML = al(YR + (size_t)2 * NT_ * 256 * 4);
  static constexpr size_t RNS = RML + (size_t)(NT_ / 16) * 8 * 4096 * 2;
  static constexpr size_t RWC = RNS + (size_t)(NT_ / 16) * 8 * 4096 * 2;
  static constexpr size_t RG = RWC + (size_t)(NT_ / 16) * 8 * 64 * 4;
  static constexpr size_t RY0 = RG + (size_t)(NT_ / 16) * 8 * 1024 * 2;
  static constexpr size_t LI = RY0 + (size_t)(NT_ / 16) * 8 * 1024 * 4;
  static constexpr size_t KRW = LI + (size_t)NT_ * 384 * 2;
  static constexpr size_t MIXER_END = KRW + (size_t)NT_ * 256 * 2;
  static constexpr size_t HID = UNI;
  static constexpr size_t YBUF = al(HID + ((size_t)NT_ * 9 + 65 * 128) * 256 * 2);
  static constexpr size_t MOE_END = YBUF + (size_t)NT_ * 9 * 1024 * 2;
  static constexpr size_t END = al(MIXER_END > MOE_END ? MIXER_END : MOE_END);
};

struct Params {
  const float* in[40];
  float* out;
  unsigned char* ws;
};
enum { I_X = 0, I_C, I_CTX, I_CCTX, I_ADAW, I_ADAB, I_WIN, I_CONVW, I_CONVB, I_DTBIAS, I_ALOG, I_SSDD, I_SSDNW, I_MU, I_W0, I_W2, I_A0, I_A2,
       I_G2, I_KKW, I_KAW, I_RK, I_LNXW, I_LNXB, I_GU, I_GB, I_GNW, I_WOUT, I_LN1W, I_LN1B, I_LN2W, I_LN2B, I_RW, I_RB, I_EW1, I_EW3, I_EW2,
       I_SW1, I_SW3, I_SW2 };

#define PH_SMEM 57344
#define SM_PRE (PH_SMEM)
#define SM_TAB (PH_SMEM + 1024)
#define SM_BAR (PH_SMEM + 2032)
#ifdef HIPEMU
#define INP(i) (p.in[i])
#define LAUNDER(x)
#define TIDX ((int)threadIdx.x)
#define BIDX ((int)blockIdx.x)
#define LAUNDER_V(x)
#define UNI(x) (x)
#else
extern __shared__ __align__(16) unsigned char smem_dyn[];
DEVFN const float* inp_lds(int i) {
  const volatile unsigned* t = (const volatile unsigned*)(smem_dyn + SM_TAB) + 2 * i;
  unsigned lo = __builtin_amdgcn_readfirstlane(t[0]), hi = __builtin_amdgcn_readfirstlane(t[1]);
  return (const float*)(((unsigned long long)hi << 32) | lo);
}
#define INP(i) inp_lds(i)
#define LAUNDER(x) asm volatile("" : "+s"(x))
DEVFN int tidx_() { int t = threadIdx.x; asm volatile("" : "+v"(t)); return t; }
DEVFN int bidx_() { int b = blockIdx.x; asm volatile("" : "+s"(b)); return b; }
#define TIDX tidx_()
#define LAUNDER_V(x) asm volatile("" : "+v"(x))
#define BIDX bidx_()
#define UNI(x) __builtin_amdgcn_readfirstlane(x)
#endif
#ifndef HIPEMU
#define XB_TMO      128
#define XB_XCNT(j)  (256  + 64 * (j))
#define XB_XSUB(j)  (1280 + 64 * (j))
#define XB_XGEN(j)  (2304 + 64 * (j))
#define XB_TOP      3328
#define XB_TOPGEN   3392
#define XCD_BAR_WORDS 3456
#define XB_SPIN_CAP (1u << 22)
#define LAS __attribute__((address_space(3)))
__device__ __forceinline__ unsigned xb_ld(unsigned* p)              { return __hip_atomic_load(p, __ATOMIC_RELAXED, __HIP_MEMORY_SCOPE_AGENT); }
__device__ __forceinline__ unsigned xb_add(unsigned* p, unsigned v) { return __hip_atomic_fetch_add(p, v, __ATOMIC_RELAXED, __HIP_MEMORY_SCOPE_AGENT); }
__device__ __forceinline__ unsigned xb_xcc_id() { return (unsigned)__builtin_amdgcn_s_getreg((3 << 11) | 20) & 0xFu; }
#define XB_SPIN(cond, bar) do { unsigned _sp = 0; while (cond) { __builtin_amdgcn_s_sleep(1); \
    if ((++_sp & 255u) == 0u) { if (xb_ld(&(bar)[XB_TMO])) break; if (_sp > XB_SPIN_CAP) { atomicAdd(&(bar)[XB_TMO], 1u); break; } } } } while (0)
struct XcdBarrier { unsigned* bar; unsigned x; volatile LAS unsigned* st; };
__device__ __forceinline__ XcdBarrier xcd_barrier_post(unsigned* bar, volatile LAS unsigned* st) {
    XcdBarrier b; b.bar = bar; b.x = xb_xcc_id(); b.st = st;
    if (threadIdx.x == 0) (void)xb_add(&bar[XB_XCNT(b.x)], 1u);
    return b;
}
__device__ __forceinline__ void xcd_barrier_complete(unsigned* bar, unsigned x, unsigned& nloc, unsigned& nx) {
    const unsigned G = gridDim.x * gridDim.y * gridDim.z;
    unsigned sum, cnt, mine, sp = 0u;
    for (;;) {
        sum = 0u; cnt = 0u; mine = 0u;
#pragma unroll
        for (unsigned j = 0; j < 16; ++j) { const unsigned c = xb_ld(&bar[XB_XCNT(j)]); sum += c; cnt += (c > 0u) ? 1u : 0u; mine = (j == x) ? c : mine; }
        if (sum == G) break;
        __builtin_amdgcn_s_sleep(1);
        if ((++sp & 255u) == 0u) { if (xb_ld(&bar[XB_TMO])) break; if (sp > XB_SPIN_CAP) { atomicAdd(&bar[XB_TMO], 1u); break; } }
    }
    nloc = mine > 0u ? mine : 1u; nx = cnt > 0u ? cnt : 1u;
}
__device__ __forceinline__ void xcd_barrier(const XcdBarrier& b) {
    asm volatile("s_waitcnt vmcnt(0)" ::: "memory");
    __syncthreads();
    if (threadIdx.x == 0) {
        unsigned* bar = b.bar;
        __builtin_amdgcn_s_waitcnt(0);
        unsigned nloc = b.st[0], nx = b.st[1];
        if (nloc == 0u) { xcd_barrier_complete(bar, b.x, nloc, nx); b.st[0] = nloc; b.st[1] = nx; }
        const unsigned old = xb_add(&bar[XB_XSUB(b.x)], 1u);
        const unsigned gen = old / nloc;
        if (old + 1u == (gen + 1u) * nloc) {
            __builtin_amdgcn_fence(__ATOMIC_RELEASE, "agent");
            asm volatile("s_waitcnt vmcnt(0)" ::: "memory");
            const unsigned og = xb_add(&bar[XB_TOP], 1u);
            const unsigned tg = og / nx;
            if (og + 1u == (tg + 1u) * nx) xb_add(&bar[XB_TOPGEN], 1u);
            else XB_SPIN(xb_ld(&bar[XB_TOPGEN]) == tg, bar);
            __builtin_amdgcn_fence(__ATOMIC_ACQUIRE, "agent");
            xb_add(&bar[XB_XGEN(b.x)], 1u);
            asm volatile("s_waitcnt vmcnt(0)" ::: "memory");
        } else {
            XB_SPIN(xb_ld(&bar[XB_XGEN(b.x)]) == gen, bar);
            __builtin_amdgcn_fence(__ATOMIC_ACQUIRE, "agent");
            asm volatile("s_waitcnt vmcnt(0)" ::: "memory");
        }
    }
    __syncthreads();
}
#endif

DEVFN int tokmap(int dir, int p) { return dir == 0 ? p : (p < CTX_ ? CTX_ - 1 - p : 2 * CTX_ + SEQ_ - 1 - p); }
DEVFN const float* tok_input_row(const Params& p, int tok) {
  int b = tok / T_, t = tok % T_;
  return t < CTX_ ? INP(I_CTX) + ((size_t)b * CTX_ + t) * D_ : INP(I_X) + ((size_t)b * SEQ_ + (t - CTX_)) * D_;
}
DEVFN int tok_modrow(int tok) { return (tok % T_) < CTX_ ? B_ : tok / T_; }

template <class ARow, class BRow, class Epi>
DEVFN void gemm_tile(unsigned char* smem, int K, ARow arow, BRow brow, Epi epi) {
  bf16_t* As = (bf16_t*)smem;
  bf16_t* Bs = As + 128 * LDT;
  const int tid = TIDX, lane = tid & 63, wave = tid >> 6, wr = wave >> 1, wc = wave & 1;
  const int g = lane >> 4, l15 = lane & 15;
  const int lr = tid >> 3, lc = (tid & 7) * 8;
  const AS1 bf16_t* ap[4];
  const AS1 bf16_t* bp[4];
#pragma unroll
  for (int i = 0; i < 4; ++i) { ap[i] = gptr(arow(lr + 32 * i)); bp[i] = gptr(brow(lr + 32 * i)); }
  f32x4 acc[4][4];
#pragma unroll
  for (int mi = 0; mi < 4; ++mi)
#pragma unroll
    for (int ni = 0; ni < 4; ++ni) acc[mi][ni] = f32x4{0.f, 0.f, 0.f, 0.f};
  u32x4 ra0[4], rb0[4], ra1[4], rb1[4];
#pragma unroll
  for (int i = 0; i < 4; ++i) { ra0[i] = *(const AS1 u32x4*)(ap[i] + lc); rb0[i] = *(const AS1 u32x4*)(bp[i] + lc); }
  if (K > 64) {
#pragma unroll
    for (int i = 0; i < 4; ++i) { ra1[i] = *(const AS1 u32x4*)(ap[i] + 64 + lc); rb1[i] = *(const AS1 u32x4*)(bp[i] + 64 + lc); } }
  auto compute = [&]() {
#pragma unroll
    for (int kk = 0; kk < 2; ++kk) {
      bf16x8 af[4], bfr[4];
#pragma unroll
      for (int mi = 0; mi < 4; ++mi) af[mi] = *(const bf16x8*)(As + (wr * 64 + mi * 16 + l15) * LDT + kk * 32 + g * 8);
#pragma unroll
      for (int ni = 0; ni < 4; ++ni) bfr[ni] = *(const bf16x8*)(Bs + (wc * 64 + ni * 16 + l15) * LDT + kk * 32 + g * 8);
#pragma unroll
      for (int mi = 0; mi < 4; ++mi)
#pragma unroll
        for (int ni = 0; ni < 4; ++ni) acc[mi][ni] = MFMA16(af[mi], bfr[ni], acc[mi][ni]);
    } };
  for (int k0 = 0; k0 < K; k0 += 128) {
    __syncthreads();
#pragma unroll
    for (int i = 0; i < 4; ++i) { *(u32x4*)(As + (lr + 32 * i) * LDT + lc) = ra0[i]; *(u32x4*)(Bs + (lr + 32 * i) * LDT + lc) = rb0[i]; }
    __syncthreads();
    if (k0 + 128 < K) {
#pragma unroll
      for (int i = 0; i < 4; ++i) { ra0[i] = *(const AS1 u32x4*)(ap[i] + k0 + 128 + lc); rb0[i] = *(const AS1 u32x4*)(bp[i] + k0 + 128 + lc); } }
    compute();
    if (k0 + 64 < K) {
      __syncthreads();
#pragma unroll
      for (int i = 0; i < 4; ++i) { *(u32x4*)(As + (lr + 32 * i) * LDT + lc) = ra1[i]; *(u32x4*)(Bs + (lr + 32 * i) * LDT + lc) = rb1[i]; }
      __syncthreads();
      if (k0 + 192 < K) {
#pragma unroll
        for (int i = 0; i < 4; ++i) { ra1[i] = *(const AS1 u32x4*)(ap[i] + k0 + 192 + lc); rb1[i] = *(const AS1 u32x4*)(bp[i] + k0 + 192 + lc); } }
      compute();
    }
  }
  epi(acc, wr, wc, g, l15);
}

template <int NB, class ARow, class BRow, class Epi>
DEVFN void gemm_tile_multi(unsigned char* smem, int K, ARow arow, BRow brow, Epi epi) {
  bf16_t* As = (bf16_t*)smem;
  bf16_t* Bs = As + 128 * LDT;
  const int tid = TIDX, lane = tid & 63, wave = tid >> 6, wr = wave >> 1, wc = wave & 1;
  const int g = lane >> 4, l15 = lane & 15;
  const int lr = tid >> 3, lc = (tid & 7) * 8;
  const AS1 bf16_t* ap[4];
  const AS1 bf16_t* bp[4];
#pragma unroll
  for (int i = 0; i < 4; ++i) { ap[i] = gptr(arow(lr + 32 * i)); bp[i] = gptr(brow(lr + 32 * i, 0)); }
  f32x4 acc[4][4];
  u32x4 ra0[4], rb0[4], ra1[4], rb1[4];
#pragma unroll
  for (int i = 0; i < 4; ++i) { ra0[i] = *(const AS1 u32x4*)(ap[i] + lc); rb0[i] = *(const AS1 u32x4*)(bp[i] + lc); }
  if (K > 64) {
#pragma unroll
    for (int i = 0; i < 4; ++i) { ra1[i] = *(const AS1 u32x4*)(ap[i] + 64 + lc); rb1[i] = *(const AS1 u32x4*)(bp[i] + 64 + lc); } }
  auto compute = [&]() {
#pragma unroll
    for (int kk = 0; kk < 2; ++kk) {
      bf16x8 af[4], bfr[4];
#pragma unroll
      for (int mi = 0; mi < 4; ++mi) af[mi] = *(const bf16x8*)(As + (wr * 64 + mi * 16 + l15) * LDT + kk * 32 + g * 8);
#pragma unroll
      for (int ni = 0; ni < 4; ++ni) bfr[ni] = *(const bf16x8*)(Bs + (wc * 64 + ni * 16 + l15) * LDT + kk * 32 + g * 8);
#pragma unroll
      for (int mi = 0; mi < 4; ++mi)
#pragma unroll
        for (int ni = 0; ni < 4; ++ni) acc[mi][ni] = MFMA16(af[mi], bfr[ni], acc[mi][ni]);
    } };
#pragma unroll
  for (int j = 0; j < NB; ++j) {
#pragma unroll
  for (int mi = 0; mi < 4; ++mi)
#pragma unroll
    for (int ni = 0; ni < 4; ++ni) acc[mi][ni] = f32x4{0.f, 0.f, 0.f, 0.f};
  for (int k0 = 0; k0 < K; k0 += 128) {
    __syncthreads();
#pragma unroll
    for (int i = 0; i < 4; ++i) { *(u32x4*)(As + (lr + 32 * i) * LDT + lc) = ra0[i]; *(u32x4*)(Bs + (lr + 32 * i) * LDT + lc) = rb0[i]; }
    __syncthreads();
    if (k0 + 128 < K) {
#pragma unroll
      for (int i = 0; i < 4; ++i) { ra0[i] = *(const AS1 u32x4*)(ap[i] + k0 + 128 + lc); rb0[i] = *(const AS1 u32x4*)(bp[i] + k0 + 128 + lc); } }
    compute();
    if (k0 + 64 < K) {
      __syncthreads();
#pragma unroll
      for (int i = 0; i < 4; ++i) { *(u32x4*)(As + (lr + 32 * i) * LDT + lc) = ra1[i]; *(u32x4*)(Bs + (lr + 32 * i) * LDT + lc) = rb1[i]; }
      __syncthreads();
      if (k0 + 192 < K) {
#pragma unroll
        for (int i = 0; i < 4; ++i) { ra1[i] = *(const AS1 u32x4*)(ap[i] + k0 + 192 + lc); rb1[i] = *(const AS1 u32x4*)(bp[i] + k0 + 192 + lc); } }
      compute();
    }
  }
  if (j + 1 < NB) {
#pragma unroll
    for (int i = 0; i < 4; ++i) { bp[i] = gptr(brow(lr + 32 * i, j + 1)); ra0[i] = *(const AS1 u32x4*)(ap[i] + lc); rb0[i] = *(const AS1 u32x4*)(bp[i] + lc); } }
  epi(acc, j, wr, wc, g, l15);
  if (j + 1 < NB) {
#pragma unroll
    for (int i = 0; i < 4; ++i) { ra1[i] = *(const AS1 u32x4*)(ap[i] + 64 + lc); rb1[i] = *(const AS1 u32x4*)(bp[i] + 64 + lc); } }
  }
}

template <int NB, int LDB, class ARow, class BBase, class Epi>
DEVFN void gemm_tile_w(unsigned char* smem, int K, ARow arow, BBase bbase, Epi epi) {
  bf16_t* As = (bf16_t*)smem;
  bf16_t* Bs = As + 128 * LDT;
  const int tid = TIDX, lane = tid & 63, wave = tid >> 6, wr = wave >> 1, wc = wave & 1;
  const int g = lane >> 4, l15 = lane & 15;
  const int lr = tid >> 3, lc = (tid & 7) * 8;
  const AS1 bf16_t* ap[4];
#pragma unroll
  for (int i = 0; i < 4; ++i) ap[i] = gptr(arow(lr + 32 * i));
  const AS1 bf16_t* bb = gptr(bbase(0));
  const unsigned boff = (unsigned)(lr * LDB + lc);
  f32x4 acc[4][8];
  u32x4 ra[4], rb[8];
#pragma unroll
  for (int i = 0; i < 4; ++i) ra[i] = *(const AS1 u32x4*)(ap[i] + lc);
#pragma unroll
  for (int i = 0; i < 8; ++i) rb[i] = *(const AS1 u32x4*)(bb + (size_t)(i * 32 * LDB) + boff);
#pragma unroll
  for (int j = 0; j < NB; ++j) {
#pragma unroll
    for (int mi = 0; mi < 4; ++mi)
#pragma unroll
      for (int ni = 0; ni < 8; ++ni) acc[mi][ni] = f32x4{0.f, 0.f, 0.f, 0.f};
#pragma unroll 1
    for (int k0 = 0; k0 < K; k0 += 64) {
      __syncthreads();
#pragma unroll
      for (int i = 0; i < 4; ++i) *(u32x4*)(As + (lr + 32 * i) * LDT + lc) = ra[i];
#pragma unroll
      for (int i = 0; i < 8; ++i) *(u32x4*)(Bs + (lr + 32 * i) * LDT + lc) = rb[i];
      __syncthreads();
      if (k0 + 64 < K) {
#pragma unroll
        for (int i = 0; i < 4; ++i) ra[i] = *(const AS1 u32x4*)(ap[i] + k0 + 64 + lc);
#pragma unroll
        for (int i = 0; i < 8; ++i) rb[i] = *(const AS1 u32x4*)(bb + (size_t)(i * 32 * LDB + k0 + 64) + boff);
      }
#pragma unroll
      for (int kk = 0; kk < 2; ++kk) {
        bf16x8 af[4];
#pragma unroll
        for (int mi = 0; mi < 4; ++mi) af[mi] = *(const bf16x8*)(As + (wr * 64 + mi * 16 + l15) * LDT + kk * 32 + g * 8);
#pragma unroll
        for (int h = 0; h < 2; ++h) {
          bf16x8 bfr[4];
#pragma unroll
          for (int ni = 0; ni < 4; ++ni) bfr[ni] = *(const bf16x8*)(Bs + (wc * 128 + h * 64 + ni * 16 + l15) * LDT + kk * 32 + g * 8);
#pragma unroll
          for (int mi = 0; mi < 4; ++mi)
#pragma unroll
            for (int ni = 0; ni < 4; ++ni) acc[mi][h * 4 + ni] = MFMA16(af[mi], bfr[ni], acc[mi][h * 4 + ni]);
        }
      }
    }
    if (j + 1 < NB) {
      bb = gptr(bbase(j + 1));
#pragma unroll
      for (int i = 0; i < 4; ++i) ra[i] = *(const AS1 u32x4*)(ap[i] + lc);
#pragma unroll
      for (int i = 0; i < 8; ++i) rb[i] = *(const AS1 u32x4*)(bb + (size_t)(i * 32 * LDB) + boff); }
    epi(acc, j, wr, wc, g, l15);
  }
}

template <int NCH, class Val, class RowP>
DEVFN void tile_store_bf16(unsigned char* smem, int wr, int g, int l15, Val val, RowP rowp) {
  constexpr int LDC = NCH * 8 + 8;
  bf16_t* T = (bf16_t*)smem;
  const int tid = TIDX;
  __syncthreads();
  val(T, LDC);
  __syncthreads();
#pragma unroll
  for (int pass = 0; pass < NCH / 2; ++pass) { const int id = tid + 256 * pass, row = id / NCH, c = id % NCH;
    bf16_t* dst = rowp(row, c * 8);
    if (dst) *(AS1 u32x4*)gptr(dst) = *(const u32x4*)(T + row * LDC + c * 8); }
  (void)wr; (void)g; (void)l15;
}
DEVFN void cvt_tile(unsigned char* smem, const float* src, int K, int N, int k0, int n0, bf16_t* dst, int ldd, int mode) {
  float* s = (float*)smem;
  const int tid = TIDX;
  const AS1 float* gsrc = gptr(src);
  __syncthreads();
  { const int kk = tid >> 4, n4 = (tid & 15) * 4;
#pragma unroll
    for (int pass = 0; pass < 4; ++pass) { const int k = kk + 16 * pass;
      f32x4 v = f32x4{0.f, 0.f, 0.f, 0.f};
      if (n0 + n4 < N) v = *(const AS1 f32x4*)(gsrc + (size_t)(k0 + k) * N + n0 + n4);
      s[k * 65 + n4] = v[0]; s[k * 65 + n4 + 1] = v[1]; s[k * 65 + n4 + 2] = v[2]; s[k * 65 + n4 + 3] = v[3]; } }
  __syncthreads();
  { const int nn = tid >> 2, k16 = (tid & 3) * 16, n = n0 + nn;
    if (n < N) { const int row = mode == 0 ? n : ((n >> 4) * 32 + (n & 15) + (mode == 2 ? 16 : 0));
      u32x4 o0, o1;
#pragma unroll
      for (int j = 0; j < 4; ++j) { o0[j] = (unsigned)f2bf(s[(k16 + 2 * j) * 65 + nn]) | ((unsigned)f2bf(s[(k16 + 2 * j + 1) * 65 + nn]) << 16);
        o1[j] = (unsigned)f2bf(s[(k16 + 8 + 2 * j) * 65 + nn]) | ((unsigned)f2bf(s[(k16 + 9 + 2 * j) * 65 + nn]) << 16); }
      AS1 bf16_t* d = gptr(dst) + (size_t)row * ldd + k0 + k16;
      *(AS1 u32x4*)d = o0; *(AS1 u32x4*)(d + 8) = o1; } }
  (void)K;
}
struct CvtJob { const float* src; bf16_t* dst; int N, k0, n0, ldd, mode; };
DEVFN void cvt_load(const CvtJob& j, f32x4 (&v)[4]) {
  const int tid = TIDX, kk = tid >> 4, n4 = (tid & 15) * 4;
  const AS1 float* g = gptr(j.src);
#pragma unroll
  for (int pass = 0; pass < 4; ++pass) { v[pass] = f32x4{0.f, 0.f, 0.f, 0.f};
    if (j.n0 + n4 < j.N) v[pass] = *(const AS1 f32x4*)(g + (size_t)(j.k0 + kk + 16 * pass) * j.N + j.n0 + n4); }
}
DEVFN void cvt_store(unsigned char* smem, const CvtJob& j, const f32x4 (&v)[4]) {
  float* s = (float*)smem;
  const int tid = TIDX, kk = tid >> 4, n4 = (tid & 15) * 4;
  __syncthreads();
#pragma unroll
  for (int pass = 0; pass < 4; ++pass) { const int k = kk + 16 * pass; s[k * 65 + n4] = v[pass][0]; s[k * 65 + n4 + 1] = v[pass][1]; s[k * 65 + n4 + 2] = v[pass][2]; s[k * 65 + n4 + 3] = v[pass][3]; }
  __syncthreads();
  const int nn = tid >> 2, k16 = (tid & 3) * 16, n = j.n0 + nn;
  if (n < j.N) { const int row = j.mode == 0 ? n : ((n >> 4) * 32 + (n & 15) + (j.mode == 2 ? 16 : 0));
    u32x4 o0, o1;
#pragma unroll
    for (int q = 0; q < 4; ++q) { o0[q] = (unsigned)f2bf(s[(k16 + 2 * q) * 65 + nn]) | ((unsigned)f2bf(s[(k16 + 2 * q + 1) * 65 + nn]) << 16);
      o1[q] = (unsigned)f2bf(s[(k16 + 8 + 2 * q) * 65 + nn]) | ((unsigned)f2bf(s[(k16 + 9 + 2 * q) * 65 + nn]) << 16); }
    AS1 bf16_t* d = gptr(j.dst) + (size_t)row * j.ldd + j.k0 + k16;
    *(AS1 u32x4*)d = o0; *(AS1 u32x4*)(d + 8) = o1; }
}
DEVFN CvtJob moe_cvt_job(const Params& p, int l, int u) {
  bf16_t* w13 = (bf16_t*)(p.ws + Ws::W13); bf16_t* w2t = (bf16_t*)(p.ws + Ws::W2T);
  const int e = u / 192, r = u % 192, which = r / 64, t = r % 64;
  CvtJob j;
  if (which < 2) {
    j.src = e < 64 ? (which == 0 ? INP(I_EW1) : INP(I_EW3)) + ((size_t)l * 64 + e) * 1024 * 256 : (which == 0 ? INP(I_SW1) : INP(I_SW3)) + (size_t)l * 1024 * 256;
    j.N = 256; j.k0 = (t >> 2) * 64; j.n0 = (t & 3) * 64; j.dst = w13 + (size_t)e * 512 * 1024; j.ldd = 1024; j.mode = which == 0 ? 1 : 2;
  } else {
    j.src = e < 64 ? INP(I_EW2) + ((size_t)l * 64 + e) * 256 * 1024 : INP(I_SW2) + (size_t)l * 256 * 1024;
    j.N = 1024; j.k0 = (t >> 4) * 64; j.n0 = (t & 15) * 64; j.dst = w2t + (size_t)e * 1024 * 256; j.ldd = 256; j.mode = 0;
  }
  return j;
}
DEVFN void convert_moe_weights(const Params& p, int l, unsigned char* smem, int bid, int nb, int j_lo, int j_hi) {
  if (j_lo + bid >= j_hi) return;
  f32x4 v[4], vn[4];
  CvtJob j = moe_cvt_job(p, l, j_lo + bid);
  cvt_load(j, v);
  for (int u = j_lo + bid; u < j_hi; u += nb) {
    const int un = u + nb;
    CvtJob jn = j;
    if (un < j_hi) { jn = moe_cvt_job(p, l, un); cvt_load(jn, vn); }
    cvt_store(smem, j, v);
    j = jn;
#pragma unroll
    for (int q = 0; q < 4; ++q) v[q] = vn[q];
  }
}
DEVFN void phase0(const Params& p, unsigned char* smem) {
  const int tid = TIDX;
  float* modp = (float*)(p.ws + Ws::MODP);
  for (int u = BIDX; u < DEPTH_ * 24 * 16; u += gridDim.x) {
    int l = u / (24 * 16), jb = (u / 16) % 24, ks = u % 16;
    float* sc = (float*)smem;
    __syncthreads();
    for (int e = tid; e < NR_ * 64; e += 256) { int r = e / 64, i = ks * 64 + (e % 64); float cv = r < B_ ? INP(I_C)[(size_t)r * D_ + i] : INP(I_CCTX)[i]; sc[e] = siluf_(cv); }
    __syncthreads();
    int j = jb * 256 + tid;
    float acc[NR_];
#pragma unroll
    for (int r = 0; r < NR_; ++r) acc[r] = 0.f;
    const float* w = INP(I_ADAW) + ((size_t)l * D_ + ks * 64) * NMOD_ + j;
#pragma unroll 4
    for (int i = 0; i < 64; ++i) { float wv = w[(size_t)i * NMOD_];
#pragma unroll
      for (int r = 0; r < NR_; ++r) acc[r] += sc[r * 64 + i] * wv; }
#pragma unroll
    for (int r = 0; r < NR_; ++r) modp[(((size_t)ks * DEPTH_ + l) * NR_ + r) * NMOD_ + j] = acc[r];
  }
  bf16_t* win = (bf16_t*)(p.ws + Ws::WIN);
  bf16_t* wout = (bf16_t*)(p.ws + Ws::WOUT);
  for (int u = BIDX; u < DEPTH_ * 16 * 55; u += gridDim.x) {
    int l = u / (16 * 55), r = u % (16 * 55);
    cvt_tile(smem, INP(I_WIN) + (size_t)l * 1024 * NIN_, 1024, NIN_, (r / 55) * 64, (r % 55) * 64, win + (size_t)l * NIN_ * 1024, 1024, 0);
  }
  for (int u = BIDX; u < DEPTH_ * 256; u += gridDim.x) {
    int l = u / 256, r = u % 256;
    cvt_tile(smem, INP(I_WOUT) + (size_t)l * 1024 * 1024, 1024, 1024, (r / 16) * 64, (r % 16) * 64, wout + (size_t)l * 1024 * 1024, 1024, 0);
  }
  { bf16_t* lo = (bf16_t*)(p.ws + Ws::LORA);
    for (int u = BIDX * 256 + tid; u < DEPTH_ * 98304; u += gridDim.x * 256) {
      const int l = u / 98304, r = u % 98304; float v;
      if (r < 32768) { const int d = r >> 14, n = (r >> 6) & 255, k = r & 63; v = INP(I_W2)[(((size_t)l * 2 + d) * 64 + k) * 256 + n]; }
      else if (r < 65536) { const int r2 = r - 32768, d = r2 >> 14, n = (r2 >> 6) & 255, k = r2 & 63; v = INP(I_A2)[(((size_t)l * 2 + d) * 64 + k) * 256 + n]; }
      else { const int r2 = r - 65536, n = r2 >> 7, k = r2 & 127; v = INP(I_G2)[((size_t)l * 128 + k) * 256 + n]; }
      lo[u] = f2bf(v); } }
  float* rwt = (float*)(p.ws + Ws::RWT);
  for (int u = BIDX * 256 + tid; u < DEPTH_ * 64 * 1024; u += gridDim.x * 256) {
    int l = u / (64 * 1024), e = (u / 1024) % 64, i = u % 1024;
    rwt[u] = INP(I_RW)[((size_t)l * 1024 + i) * 64 + e];
  }
}

DEVFN void phase0b(const Params& p) {
  float* mod = (float*)(p.ws + Ws::MOD); const float* modp = (const float*)(p.ws + Ws::MODP);
  for (int u = BIDX * 256 + TIDX; u < DEPTH_ * NR_ * NMOD_; u += gridDim.x * 256) {
    int l = u / (NR_ * NMOD_), j = u % NMOD_;
    float s = INP(I_ADAB)[(size_t)l * NMOD_ + j];
    for (int ks = 0; ks < 16; ++ks) s += modp[(size_t)ks * DEPTH_ * NR_ * NMOD_ + u];
    mod[u] = s;
  }
}

DEVFN void row_stats(const float (&v)[16], float& mean, float& rstd) {
  float s = 0.f;
#pragma unroll
  for (int i = 0; i < 16; ++i) s += v[i];
  mean = wave_sum(s) * (1.f / 1024.f);
  float q = 0.f;
#pragma unroll
  for (int i = 0; i < 16; ++i) { float d = v[i] - mean; q += d * d; }
  rstd = rsqrtf(wave_sum(q) * (1.f / 1024.f) + 1e-5f);
}
DEVFN void load_row16(const float* row, int lane, float (&v)[16]) {
  const AS1 float* r = gptr(row);
#pragma unroll
  for (int j = 0; j < 4; ++j) { const f32x4 t = *(const AS1 f32x4*)(r + lane * 4 + 256 * j); v[4 * j] = t[0]; v[4 * j + 1] = t[1]; v[4 * j + 2] = t[2]; v[4 * j + 3] = t[3]; }
}
DEVFN void moe_residual_row(const Params& p, int lp, int tok, int lane, float (&xv)[16]) {
  const float* mod = (const float*)(p.ws + Ws::MOD) + ((size_t)lp * NR_ + tok_modrow(tok)) * NMOD_;
  const bf16_t* yb = (const bf16_t*)(p.ws + Ws::YBUF) + (size_t)tok * NSLOT * 1024;
  float g2[16], w[16], b[16];
  load_row16(mod + 5 * 1024, lane, g2);
  load_row16(INP(I_LN2W) + (size_t)lp * 1024, lane, w);
  load_row16(INP(I_LN2B) + (size_t)lp * 1024, lane, b);
  u32x2 sl[NSLOT][4];
#pragma unroll
  for (int s = 0; s < NSLOT; ++s)
#pragma unroll
    for (int j = 0; j < 4; ++j) sl[s][j] = *(const AS1 u32x2*)gptr(yb + (size_t)s * 1024 + lane * 4 + 256 * j);
  float f[16];
#pragma unroll
  for (int i = 0; i < 16; ++i) f[i] = 0.f;
#pragma unroll
  for (int s = 0; s < NSLOT; ++s)
#pragma unroll
    for (int j = 0; j < 4; ++j) { const u32x2 t = sl[s][j];
      f[4 * j] += bf2f((bf16_t)(t[0] & 0xFFFF)); f[4 * j + 1] += bf2f((bf16_t)(t[0] >> 16)); f[4 * j + 2] += bf2f((bf16_t)(t[1] & 0xFFFF)); f[4 * j + 3] += bf2f((bf16_t)(t[1] >> 16)); }
#pragma unroll
  for (int i = 0; i < 16; ++i) xv[i] = ALPHA_ * xv[i] + g2[i] * f[i];
  float mean, rstd;
  row_stats(xv, mean, rstd);
#pragma unroll
  for (int i = 0; i < 16; ++i) xv[i] = (xv[i] - mean) * rstd * w[i] + b[i];
}
DEVFN void phase1(const Params& p, int l) {
  const int lane = TIDX & 63, wave = TIDX >> 6;
  float* X = (float*)(p.ws + Ws::X);
  bf16_t* U = (bf16_t*)(p.ws + Ws::U);
  for (int tok = BIDX * 4 + wave; tok < NT_; tok += gridDim.x * 4) {
    float xv[16], sh[16], sc[16], mean, rstd;
    const float* mod = (const float*)(p.ws + Ws::MOD) + ((size_t)l * NR_ + tok_modrow(tok)) * NMOD_;
    load_row16(mod, lane, sh);
    load_row16(mod + 1024, lane, sc);
    if (l == 0) load_row16(tok_input_row(p, tok), lane, xv);
    else { load_row16(X + (size_t)tok * 1024, lane, xv); moe_residual_row(p, l - 1, tok, lane, xv); }
#pragma unroll
    for (int j = 0; j < 4; ++j) *(float4*)(X + (size_t)tok * 1024 + lane * 4 + 256 * j) = make_float4(xv[4 * j], xv[4 * j + 1], xv[4 * j + 2], xv[4 * j + 3]);
    row_stats(xv, mean, rstd);
#pragma unroll
    for (int j = 0; j < 4; ++j) {
      float u0 = (xv[4 * j] - mean) * rstd * (1.f + sc[4 * j]) + sh[4 * j], u1 = (xv[4 * j + 1] - mean) * rstd * (1.f + sc[4 * j + 1]) + sh[4 * j + 1];
      float u2 = (xv[4 * j + 2] - mean) * rstd * (1.f + sc[4 * j + 2]) + sh[4 * j + 2], u3 = (xv[4 * j + 3] - mean) * rstd * (1.f + sc[4 * j + 3]) + sh[4 * j + 3];
      *(uint2*)(U + (size_t)tok * 1024 + lane * 4 + 256 * j) = make_uint2((unsigned)f2bf(u0) | ((unsigned)f2bf(u1) << 16), (unsigned)f2bf(u2) | ((unsigned)f2bf(u3) << 16));
    }
  }
}
DEVFN void phase_final(const Params& p) {
  const int lane = TIDX & 63, wave = TIDX >> 6;
  const float* X = (const float*)(p.ws + Ws::X);
  for (int r = BIDX * 4 + wave; r < B_ * SEQ_; r += gridDim.x * 4) {
    int b = r / SEQ_, s = r % SEQ_, tok = b * T_ + CTX_ + s;
    float xv[16];
    load_row16(X + (size_t)tok * 1024, lane, xv);
    moe_residual_row(p, DEPTH_ - 1, tok, lane, xv);
#pragma unroll
    for (int j = 0; j < 4; ++j) *(float4*)(p.out + (size_t)r * 1024 + lane * 4 + 256 * j) = make_float4(xv[4 * j], xv[4 * j + 1], xv[4 * j + 2], xv[4 * j + 3]);
  }
}

DEVFN void phase2(const Params& p, int l, unsigned char* smem) {
  const bf16_t* U = (const bf16_t*)(p.ws + Ws::U);
  const bf16_t* W = (const bf16_t*)(p.ws + Ws::WIN) + (size_t)l * NIN_ * 1024;
  bf16_t* ZX = (bf16_t*)(p.ws + Ws::ZX);
  const int nct = (NIN_ + 255) / 256;
  for (int u = BIDX; u < (NT_ / 128) * nct; u += gridDim.x) {
    int rt = u / nct, ct = u % nct;
    gemm_tile_w<1, 1024>(smem, 1024,
      [&](int r) { return U + (size_t)(rt * 128 + r) * 1024; },
      [&](int) { return W + (size_t)(ct * 256) * 1024; },
      [&](f32x4 (&acc)[4][8], int, int wr, int wc, int g, int l15) {
#pragma unroll 1
        for (int h = 0; h < 2; ++h)
          tile_store_bf16<16>(smem, wr, g, l15,
            [&](bf16_t* T, int ldc) {
              if (wc == h) {
#pragma unroll
                for (int mi = 0; mi < 4; ++mi)
#pragma unroll
                  for (int ni = 0; ni < 8; ++ni)
#pragma unroll
                    for (int i = 0; i < 4; ++i) T[(wr * 64 + mi * 16 + 4 * g + i) * ldc + ni * 16 + l15] = f2bf(acc[mi][ni][i]); } },
            [&](int row, int c0) { const int col = ct * 256 + h * 128 + c0; return col < NIN_ ? ZX + (size_t)(rt * 128 + row) * NIN_ + col : (bf16_t*)nullptr; });
      });
  }
}

DEVFN float zxv(const bf16_t* ZX, int tok, int col) { return bf2f(gptr(ZX)[(size_t)tok * NIN_ + col]); }
struct Nbr { int n; int tok[4]; };
DEVFN Nbr shift_nbrs(int tok) {
  Nbr nb; int b = tok / T_, t = tok % T_;
  if (t < CTX_) { nb.n = 2; nb.tok[0] = t > 0 ? tok - 1 : -1; nb.tok[1] = t < CTX_ - 1 ? tok + 1 : -1; nb.tok[2] = -1; nb.tok[3] = -1; }
  else { int s = t - CTX_, row = s / 64, col = s % 64; nb.n = 4; nb.tok[0] = col > 0 ? tok - 1 : -1; nb.tok[1] = col < 63 ? tok + 1 : -1;
    nb.tok[2] = row > 0 ? tok - 64 : -1; nb.tok[3] = row < SEQ_ / 64 - 1 ? tok + 64 : -1; }
  (void)b; return nb;
}
DEVFN float shiftmix(const bf16_t* ZX, const float* mu, int tok, const Nbr& nb, int ch) {
  float z = zxv(ZX, tok, ORW + ch), o = z;
#pragma unroll
  for (int j = 0; j < 4; ++j) if (j < nb.n) { float v = nb.tok[j] >= 0 ? zxv(ZX, nb.tok[j], ORW + ch) : 0.f; o += mu[j * 1152 + ch] * (v - z); }
  return o;
}
#define LI_LD 392
#define KL_LD 264
DEVFN void phase3(const Params& p, int l, unsigned char* smem) {
  const int tid = TIDX, lane = tid & 63, wave = tid >> 6, q = lane >> 4, l15 = lane & 15;
  const bf16_t* ZX = (const bf16_t*)(p.ws + Ws::ZX);
  bf16_t* XBC = (bf16_t*)(p.ws + Ws::XBC); float* DTB = (float*)(p.ws + Ws::DTB);
  bf16_t* RR = (bf16_t*)(p.ws + Ws::RR); bf16_t* VV = (bf16_t*)(p.ws + Ws::VV); bf16_t* KKb = (bf16_t*)(p.ws + Ws::KK);
  bf16_t* KRW = (bf16_t*)(p.ws + Ws::KRW); bf16_t* LIg = (bf16_t*)(p.ws + Ws::LI);
  float* LA = (float*)(p.ws + Ws::LA);
  const float* convw = INP(I_CONVW) + (size_t)l * 3 * 1024; const float* convb = INP(I_CONVB) + (size_t)l * 1024;
  const float* mu = INP(I_MU) + (size_t)l * 4 * 1152;
  float* gdl = (float*)smem;
  const float kkw = INP(I_KKW)[(size_t)l * 256 + tid];
  unsigned* ctr = (unsigned*)(p.ws + Ws::BAR) + l * 32 + 8;
  volatile int* nxt_s = (volatile int*)(smem + SM_PRE);
  int wu = BIDX;
  while (wu < 6 * (NT_ / 16)) {
    int nxt = 0;
    if (TIDX == 0) nxt = (int)gridDim.x + (int)atomicAdd(ctr, 1u);
    const int part = wu < NT_ / 16 ? 0 : 1, tile = wu < NT_ / 16 ? wu : (wu - NT_ / 16) / 5, gsel = wu < NT_ / 16 ? 0 : (wu - NT_ / 16) % 5;
    const int tok0 = tile * 16, t0 = tok0 % T_, bb = tok0 / T_;
    const bool isctx = t0 < CTX_;
    const int s0 = t0 - CTX_;
    const bool lval = isctx ? (t0 > 0) : ((s0 & 63) != 0), rval = isctx ? (t0 + 16 < CTX_) : ((s0 & 63) != 48);
    const bool uval = !isctx && (s0 >= 64), dval = !isctx && (s0 + 64 < SEQ_);
    if (part == 0) {
    __syncthreads();
    {
      const bool segstart = (t0 == 0 || t0 == CTX_), segend = (t0 + 16 == CTX_ || t0 + 16 == T_);
      bf16_t* XBCT = (bf16_t*)(p.ws + Ws::XBCT) + ((size_t)(bb * NC128 + t0 / 128) * 768) * 128 + (t0 % 128);
      bf16_t vv16[16];
      { const AS1 bf16_t* vp = gptr(ZX) + (size_t)tok0 * NIN_ + OGV + tid;
#pragma unroll
        for (int i = 0; i < 16; ++i) { vv16[i] = *vp; vp += NIN_; LAUNDER_V(vp); } }
      const float dtv = zxv(ZX, tok0 + (tid >> 4), ODT + (tid & 15)), gd0 = zxv(ZX, tok0 + (tid >> 5), OGD + (tid & 31)), gd1 = zxv(ZX, tok0 + 8 + (tid >> 5), OGD + (tid & 31));
#pragma unroll 1
      for (int jp = 0; jp < 2; ++jp) {
        float z[2][18];
#pragma unroll
        for (int jj = 0; jj < 2; ++jj) { const int c = tid + 256 * (2 * jp + jj);
          const AS1 bf16_t* zp = gptr(ZX) + (size_t)tok0 * NIN_ + OXBC + c - NIN_;
#pragma unroll
          for (int i = 0; i < 18; ++i) { z[jj][i] = ((i == 0 && segstart) || (i == 17 && segend)) ? 0.f : bf2f(*zp); zp += NIN_; LAUNDER_V(zp); } }
#pragma unroll
        for (int jj = 0; jj < 2; ++jj) { const int c = tid + 256 * (2 * jp + jj);
          AS1 bf16_t* xp = gptr(XBC) + (size_t)tok0 * 1024 + c;
          const float w0 = convw[c], w1 = convw[1024 + c], w2 = convw[2048 + c], cb = convb[c];
          bf16_t y[16];
#pragma unroll
          for (int i = 0; i < 16; ++i) { y[i] = f2bf(siluf_(cb + w0 * z[jj][i] + w1 * z[jj][i + 1] + w2 * z[jj][i + 2])); *xp = y[i]; xp += 1024; LAUNDER_V(xp); }
          if (c < 768) {
            u32x4 o0, o1;
#pragma unroll
            for (int i = 0; i < 4; ++i) { o0[i] = (unsigned)y[2 * i] | ((unsigned)y[2 * i + 1] << 16); o1[i] = (unsigned)y[8 + 2 * i] | ((unsigned)y[9 + 2 * i] << 16); }
            *(u32x4*)(XBCT + (size_t)c * 128) = o0; *(u32x4*)(XBCT + (size_t)c * 128 + 8) = o1; } } }
      { bf16_t* VTp = (bf16_t*)(p.ws + Ws::VT) + ((size_t)(bb * NC64 + t0 / 64) * 256 + tid) * 64 + (t0 % 64);
        u32x4 o0, o1;
#pragma unroll
        for (int i = 0; i < 4; ++i) { o0[i] = (unsigned)vv16[2 * i] | ((unsigned)vv16[2 * i + 1] << 16); o1[i] = (unsigned)vv16[8 + 2 * i] | ((unsigned)vv16[9 + 2 * i] << 16); }
        *(u32x4*)VTp = o0; *(u32x4*)(VTp + 8) = o1; }
      DTB[(size_t)tok0 * 16 + tid] = softplusf_(dtv + INP(I_DTBIAS)[(size_t)l * 16 + (tid & 15)]);
      gdl[tid] = gd0; gdl[256 + tid] = gd1;
    }
    } else {
    { const int g = gsel;
      const bool act = !(g == 4 && tid >= 128);
      const int ch = act ? g * 256 + tid : 0;
      const AS1 bf16_t* zp0 = gptr(ZX) + (size_t)tok0 * NIN_ + ORW + ch;
      const AS1 bf16_t* zp = zp0 - NIN_;
      const float m0 = mu[ch], m1 = mu[1152 + ch], m2 = mu[2304 + ch], m3 = mu[3456 + ch];
      float z[18], zu[16], zd[16], o[16];
      const AS1 bf16_t* up = uval ? zp0 - (size_t)64 * NIN_ : zp0; const AS1 bf16_t* dn = dval ? zp0 + (size_t)64 * NIN_ : zp0;
      const float um = uval ? 1.f : 0.f, dm = dval ? 1.f : 0.f, m2v = isctx ? 0.f : m2, m3v = isctx ? 0.f : m3;
#pragma unroll
      for (int i = 0; i < 18; ++i) { z[i] = ((i == 0 && !lval) || (i == 17 && !rval)) ? 0.f : bf2f(*zp); zp += NIN_; LAUNDER_V(zp); }
#pragma unroll
      for (int i = 0; i < 16; ++i) { zu[i] = bf2f(*up); zd[i] = bf2f(*dn); up += NIN_; dn += NIN_; LAUNDER_V(up); LAUNDER_V(dn); }
#pragma unroll
      for (int i = 0; i < 16; ++i) o[i] = z[i + 1] + m0 * (z[i] - z[i + 1]) + m1 * (z[i + 2] - z[i + 1]) + m2v * (zu[i] * um - z[i + 1]) + m3v * (zd[i] * dm - z[i + 1]);
      if (g == 0) { AS1 bf16_t* rp = gptr(RR) + (size_t)tok0 * 256 + tid;
#pragma unroll
        for (int i = 0; i < 16; ++i) { *rp = f2bf(o[i]); rp += 256; LAUNDER_V(rp); }
      } else if (g == 1) { AS1 bf16_t* kp = gptr(KKb) + (size_t)tok0 * 256 + tid; AS1 bf16_t* krp = gptr(KRW) + (size_t)tok0 * 256 + tid;
#pragma unroll
        for (int i = 0; i < 16; ++i) { const float kq = o[i] * kkw, nrm = sqrtf(wave_sum(kq * kq));
          *kp = f2bf(kq / fmaxf(nrm, 1e-12f)); *krp = f2bf(o[i]); kp += 256; krp += 256; LAUNDER_V(kp); LAUNDER_V(krp); }
      } else if (g == 2) { AS1 bf16_t* vp2 = gptr(VV) + (size_t)tok0 * 256 + tid;
#pragma unroll
        for (int i = 0; i < 16; ++i) { *vp2 = f2bf(o[i]); vp2 += 256; LAUNDER_V(vp2); }
      } else if (g == 3) { AS1 bf16_t* lp = gptr(LIg) + (size_t)tok0 * 384 + tid;
#pragma unroll
        for (int i = 0; i < 16; ++i) { *lp = f2bf(tid < 128 ? tanhf(o[i]) : o[i]); lp += 384; LAUNDER_V(lp); }
      } else if (act) { AS1 bf16_t* lp = gptr(LIg) + (size_t)tok0 * 384 + 256 + tid;
#pragma unroll
        for (int i = 0; i < 16; ++i) { *lp = f2bf(sigmoidf_(o[i])); lp += 384; LAUNDER_V(lp); }
      }
    }
    }
    if (part == 0) {
    __syncthreads();
    { const int d = tid >> 7, c = tid & 127; const float* gu = INP(I_GU) + ((size_t)l * 2 + d) * 16 * 128; const float gb = INP(I_GB)[((size_t)l * 2 + d) * 128 + c];
      float guw[16];
#pragma unroll
      for (int i = 0; i < 16; ++i) guw[i] = gu[i * 128 + c];
#pragma unroll 4
      for (int tt = 0; tt < 16; ++tt) { float sacc = gb;
#pragma unroll
        for (int i = 0; i < 16; ++i) sacc += gdl[tt * 32 + d * 16 + i] * guw[i];
        LA[((size_t)d * NT_ + tok0 + tt) * 128 + c] = logsigmoidf_(sacc) * (1.f / 16.f); } }
    }
    __syncthreads();
    if (TIDX == 0) *nxt_s = nxt;
    __syncthreads();
    wu = *nxt_s;
  }
}

DEVFN void phase3b(const Params& p, int l, unsigned char* smem) {
  const bf16_t* LIg = (const bf16_t*)(p.ws + Ws::LI);
  const bf16_t* lora = (const bf16_t*)(p.ws + Ws::LORA) + (size_t)l * 98304;
  const bf16_t* KRg = (const bf16_t*)(p.ws + Ws::KRW); const bf16_t* KKg = (const bf16_t*)(p.ws + Ws::KK);
  float* LWp = (float*)(p.ws + Ws::LW); bf16_t* KD = (bf16_t*)(p.ws + Ws::KD); bf16_t* BD = (bf16_t*)(p.ws + Ws::BD); float* GATE = (float*)(p.ws + Ws::GATE);
  for (int u = BIDX; u < (NT_ / 128) * 10; u += gridDim.x) {
    const int rt = u / 10, which = (u % 10) >> 1, ct = u & 1;
    const int K = which < 4 ? 64 : 128, acol = which < 4 ? which * 64 : 256;
    const bf16_t* wb = which < 2 ? lora + (size_t)which * 16384 : which < 4 ? lora + 32768 + (size_t)(which - 2) * 16384 : lora + 65536;
    const float* bias = which < 2 ? INP(I_W0) + (size_t)l * 512 + which * 256 : INP(I_A0) + (size_t)l * 512 + (which & 1) * 256;
    const float* kav = INP(I_KAW) + (size_t)l * 256;
    gemm_tile(smem, K,
      [&](int r) { return LIg + (size_t)(rt * 128 + r) * 384 + acol; },
      [&](int r) { return wb + (size_t)(ct * 128 + r) * K; },
      [&](f32x4 (&acc)[4][4], int wr, int wc, int g, int l15) {
        const int tid = TIDX;
        if (which == 2 || which == 3) {
          bf16_t* T = (bf16_t*)smem; constexpr int LDC = 136;
          __syncthreads();
#pragma unroll
          for (int ni = 0; ni < 4; ++ni) { const int cl = wc * 64 + ni * 16 + l15; const float bv = bias[ct * 128 + cl];
#pragma unroll
            for (int mi = 0; mi < 4; ++mi)
#pragma unroll
              for (int i = 0; i < 4; ++i) T[(wr * 64 + mi * 16 + 4 * g + i) * LDC + cl] = f2bf(sigmoidf_(acc[mi][ni][i] + bv)); }
          __syncthreads();
          const int c = tid & 15, col0 = ct * 128 + c * 8;
          float ka[8];
#pragma unroll
          for (int j = 0; j < 8; ++j) ka[j] = kav[col0 + j];
          const size_t dofs = (size_t)(which - 2) * NT_ * 256;
#pragma unroll
          for (int pass = 0; pass < 8; ++pass) { const int row = (tid >> 4) + 16 * pass; const size_t o = (size_t)(rt * 128 + row) * 256 + col0;
            const bf16x8 a8 = *(const bf16x8*)(T + row * LDC + c * 8), kr8 = ld8g(KRg + o), kk8 = ld8g(KKg + o);
            bf16x8 kd8, bd8;
#pragma unroll
            for (int j = 0; j < 8; ++j) { const float a = bf2f((bf16_t)a8[j]); kd8[j] = (short)f2bf(bf2f((bf16_t)kr8[j]) * (1.f + (a - 1.f) * ka[j])); bd8[j] = (short)f2bf(bf2f((bf16_t)kk8[j]) * a); }
            *(AS1 bf16x8*)gptr(KD + dofs + o) = kd8; *(AS1 bf16x8*)gptr(BD + dofs + o) = bd8; }
        } else {
          float* T = (float*)smem; constexpr int LDC = 132;
          float* dst = which < 2 ? LWp + (size_t)which * NT_ * 256 : GATE;
#pragma unroll 1
          for (int h = 0; h < 2; ++h) {
            __syncthreads();
            if (wr == h) {
#pragma unroll
              for (int ni = 0; ni < 4; ++ni) { const int cl = wc * 64 + ni * 16 + l15; const float bv = which < 2 ? bias[ct * 128 + cl] : 0.f;
#pragma unroll
                for (int mi = 0; mi < 4; ++mi)
#pragma unroll
                  for (int i = 0; i < 4; ++i) { const float v = acc[mi][ni][i]; T[(mi * 16 + 4 * g + i) * LDC + cl] = which < 2 ? -0.6065306597126334f * sigmoidf_(v + bv) : v; } } }
            __syncthreads();
#pragma unroll
            for (int pass = 0; pass < 8; ++pass) { const int id = tid + 256 * pass, row = id >> 5, c = id & 31;
              *(AS1 f32x4*)gptr(dst + (size_t)(rt * 128 + h * 64 + row) * 256 + ct * 128 + c * 4) = *(const f32x4*)(T + row * LDC + c * 4); } }
        }
      });
  }
}

DEVFN bf16x8 ld8(const bf16_t* p) { return *(const bf16x8*)p; }
typedef short bf16x4v __attribute__((ext_vector_type(4)));
DEVFN bf16x4v cvt4(f32x4 v) { return bf16x4v{(short)f2bf(v[0]), (short)f2bf(v[1]), (short)f2bf(v[2]), (short)f2bf(v[3])}; }
DEVFN bf16x8 cat44(bf16x4v a, bf16x4v b) { return bf16x8{a[0], a[1], a[2], a[3], b[0], b[1], b[2], b[3]}; }
DEVFN bf16x4v ld4(const bf16_t* p) { return *(const bf16x4v*)p; }
DEVFN int rm_off(int i, int k) { return i * 64 + ((((k >> 3) ^ (i & 7)) << 3) | (k & 7)); }
#define RW_WAVE_LDS 11264
DEVFN void rwkv_chunk(const Params& p, int unit_base, unsigned char* smem) {
  const int tid = TIDX, lane = tid & 63, wave = tid >> 6, q = lane >> 4, l15 = lane & 15;
  const int unit = unit_base + wave;
  const int c = unit % NC16, h = (unit / NC16) & 3, dir = (unit / (NC16 * 4)) & 1, b = unit / (NC16 * 8);
  bf16_t* big = (bf16_t*)(smem + wave * RW_WAVE_LDS);
  unsigned char* small = smem + wave * RW_WAVE_LDS + 8192;
  float* AbF = (float*)small;
  bf16_t* TN = (bf16_t*)(small + 1024);
  bf16_t* AK = TN + 256; bf16_t* RB = AK + 256; bf16_t* RK = RB + 256;
  const bf16_t* RRg = (const bf16_t*)(p.ws + Ws::RR); const bf16_t* VVg = (const bf16_t*)(p.ws + Ws::VV); const bf16_t* KKg = (const bf16_t*)(p.ws + Ws::KK);
  const bf16_t* KDg = (const bf16_t*)(p.ws + Ws::KD) + (size_t)dir * NT_ * 256; const bf16_t* BDg = (const bf16_t*)(p.ws + Ws::BD) + (size_t)dir * NT_ * 256;
  const float* LWg = (const float*)(p.ws + Ws::LW) + (size_t)dir * NT_ * 256;
  float kkm[16], vv[16], bneg[16], kneg[16];
  float run = 0.f;
  __syncthreads();
#pragma unroll
  for (int i = 0; i < 16; ++i) {
    const size_t o = (size_t)(b * T_ + tokmap(dir, c * 16 + i)) * 256 + h * 64 + lane;
    const float lw = gptr(LWg)[o], r = bf2f(gptr(RRg)[o]), k = bf2f(gptr(KDg)[o]), v = bf2f(gptr(VVg)[o]), kk = bf2f(gptr(KKg)[o]), bb = bf2f(gptr(BDg)[o]);
    const float e_ex = expf(run); run += lw; const float e_in = expf(run), e_neg = expf(-run);
    kkm[i] = kk * e_ex; vv[i] = v; bneg[i] = bb * e_neg; kneg[i] = k * e_neg;
    big[rm_off(i, lane)] = f2bf(kkm[i]); big[1024 + rm_off(i, lane)] = f2bf(r * e_in);
    big[2048 + rm_off(i, lane)] = f2bf(bneg[i]); big[3072 + rm_off(i, lane)] = f2bf(kneg[i]);
  }
  const float WC = expf(run);
  __syncthreads();
  f32x4 ab = f32x4{0.f, 0.f, 0.f, 0.f}, ak = ab, rb = ab, rk = ab;
#pragma unroll
  for (int s2 = 0; s2 < 2; ++s2) { const int ch = ((4 * s2 + q) ^ (l15 & 7)) << 3;
    const bf16x8 a_kk = ld8(big + l15 * 64 + ch), a_r = ld8(big + 1024 + l15 * 64 + ch), b_b = ld8(big + 2048 + l15 * 64 + ch), b_k = ld8(big + 3072 + l15 * 64 + ch);
    ab = MFMA16(a_kk, b_b, ab); ak = MFMA16(a_kk, b_k, ak); rb = MFMA16(a_r, b_b, rb); rk = MFMA16(a_r, b_k, rk); }
  f32x4 gacc[4];
#pragma unroll
  for (int nk = 0; nk < 4; ++nk)
#pragma unroll
    for (int r = 0; r < 4; ++r) gacc[nk][r] = bf2f(big[1024 + rm_off(4 * q + r, 16 * nk + l15)]);
  __syncthreads();
#pragma unroll
  for (int r = 0; r < 4; ++r) { const int i = 4 * q + r, j = l15;
    AbF[i * 16 + j] = j < i ? ab[r] : 0.f; AK[i * 16 + j] = f2bf(j < i ? ak[r] : 0.f);
    RB[i * 16 + j] = f2bf(j <= i ? rb[r] : 0.f); RK[i * 16 + j] = f2bf(j <= i ? rk[r] : 0.f); }
  { bf16_t* KKMT = big; bf16_t* VTT = big + 1024; bf16_t* BHT = big + 2048; bf16_t* KHT = big + 3072;
#pragma unroll
    for (int i = 0; i < 16; ++i) { KKMT[lane * 16 + i] = f2bf(kkm[i]); VTT[lane * 16 + i] = f2bf(vv[i]); BHT[lane * 16 + i] = f2bf(bneg[i] * WC); KHT[lane * 16 + i] = f2bf(kneg[i] * WC); } }
  __syncthreads();
  { float t[16];
#pragma unroll
    for (int i = 0; i < 16; ++i) { float acc = (i == l15) ? 1.f : 0.f;
#pragma unroll
      for (int j = 0; j < i; ++j) acc -= AbF[i * 16 + j] * t[j];
      t[i] = acc; }
    if (q == 0) {
#pragma unroll
      for (int i = 0; i < 16; ++i) TN[i * 16 + l15] = f2bf(-t[i]); } }
  __syncthreads();
  const size_t ci = (size_t)((b * 2 + dir) * 4 + h) * NC16 + c;
  bf16_t* MLg = (bf16_t*)(p.ws + Ws::RML) + ci * 4096; bf16_t* Ng = (bf16_t*)(p.ws + Ws::RNS) + ci * 4096;
  bf16_t* Gg = (bf16_t*)(p.ws + Ws::RG) + ci * 1024; float* Y0g = (float*)(p.ws + Ws::RY0) + ci * 1024;
  const bf16x4v a_T = ld4(TN + l15 * 16 + 4 * q), a_Ak = ld4(AK + l15 * 16 + 4 * q), a_Rb = ld4(RB + l15 * 16 + 4 * q), a_Rk = ld4(RK + l15 * 16 + 4 * q);
  const f32x4 z4 = f32x4{0.f, 0.f, 0.f, 0.f};
  bf16x4v vfr[4], qfr[4], pfr[4];
#pragma unroll
  for (int n = 0; n < 4; ++n) {
    vfr[n] = ld4(big + 1024 + (16 * n + l15) * 16 + 4 * q);
    const f32x4 akv = MFMA16K16(a_Ak, vfr[n], z4);
    qfr[n] = cvt4(MFMA16K16(a_T, cvt4(akv), z4));
    pfr[n] = cvt4(MFMA16K16(a_T, ld4(big + (16 * n + l15) * 16 + 4 * q), z4)); }
  const bf16x8 a_RbRk = cat44(a_Rb, a_Rk);
#pragma unroll
  for (int n = 0; n < 4; ++n) {
    const f32x4 g = MFMA16K16(a_Rb, pfr[n], gacc[n]);
    const f32x4 y0 = MFMA16(a_RbRk, cat44(qfr[n], vfr[n]), z4);
#pragma unroll
    for (int r = 0; r < 4; ++r) { Gg[(4 * q + r) * 64 + 16 * n + l15] = f2bf(g[r]); Y0g[(4 * q + r) * 64 + 16 * n + l15] = y0[r]; } }
#pragma unroll
  for (int n = 0; n < 4; ++n)
#pragma unroll
    for (int r = 0; r < 4; ++r) MLg[((n >> 1) * 64 + (l15 >> 2) * 16 + 4 * q + r) * 8 + (n & 1) * 4 + (l15 & 3)] = (bf16_t)pfr[n][r];
#pragma unroll
  for (int mk = 0; mk < 4; ++mk) {
    const bf16x4v a_B = ld4(big + 2048 + (16 * mk + l15) * 16 + 4 * q), a_K = ld4(big + 3072 + (16 * mk + l15) * 16 + 4 * q);
    const bf16x8 a_BK = cat44(a_B, a_K);
    *(bf16x4v*)(MLg + 1024 + ((mk >> 1) * 64 + lane) * 8 + (mk & 1) * 4) = a_B;
#pragma unroll
    for (int n = 0; n < 4; ++n) {
      const f32x4 nn = MFMA16(a_BK, cat44(qfr[n], vfr[n]), z4);
      *(bf16x4v*)(Ng + (n * 64 + lane) * 16 + mk * 4) = cvt4(nn); } }
  ((float*)(p.ws + Ws::RWC))[ci * 64 + ((lane >> 2) & 3) * 16 + (lane >> 4) * 4 + (lane & 3)] = WC;
}
struct RwStep { bf16x8 pf[2]; bf16x8 bh[2]; bf16x8 n[2]; float wc; };
DEVFN void rw_load(RwStep& t, const bf16_t* MLg, const bf16_t* NSg, const float* WCg, int c, int lane, int q) {
#pragma unroll
  for (int s2 = 0; s2 < 2; ++s2) { t.pf[s2] = ld8g(MLg + (size_t)c * 4096 + (s2 * 64 + lane) * 8); t.bh[s2] = ld8g(MLg + (size_t)c * 4096 + 1024 + (s2 * 64 + lane) * 8); }
  t.wc = gptr(WCg)[(size_t)c * 64 + lane];
  t.n[0] = ld8g(NSg + (size_t)c * 4096 + lane * 16); t.n[1] = ld8g(NSg + (size_t)c * 4096 + lane * 16 + 8);
  (void)q;
}
DEVFN void rw_step(const RwStep& t, f32x4 (&S)[4], bf16_t* NSg, int c, int q, int l15) {
  bf16x4v sb[4];
#pragma unroll
  for (int mk = 0; mk < 4; ++mk) sb[mk] = cvt4(S[mk]);
  const bf16x8 bf0 = cat44(sb[0], sb[1]), bf1 = cat44(sb[2], sb[3]);
  f32x4 w = MFMA16(t.pf[0], bf0, (f32x4{0.f, 0.f, 0.f, 0.f}));
  w = MFMA16(t.pf[1], bf1, w);
  const bf16x4v wb = cvt4(w);
#pragma unroll
  for (int mk = 0; mk < 4; ++mk) {
    f32x4 acc;
#pragma unroll
    for (int r = 0; r < 4; ++r) acc[r] = bf2f((bf16_t)t.n[mk >> 1][(mk & 1) * 4 + r]) + __shfl(t.wc, q * 16 + mk * 4 + r) * S[mk][r];
    const bf16x8 b2 = t.bh[mk >> 1];
    const bf16x4v a_B = (mk & 1) ? bf16x4v{b2[4], b2[5], b2[6], b2[7]} : bf16x4v{b2[0], b2[1], b2[2], b2[3]};
    S[mk] = MFMA16K16(a_B, wb, acc); }
#pragma unroll
  for (int mk = 0; mk < 4; ++mk) *(AS1 bf16x4v*)gptr(NSg + (size_t)c * 4096 + l15 * 64 + 16 * mk + 4 * q) = sb[mk];
}
DEVFN void rwkv_scan(const Params& p, int chain, int wave) {
  const int tid = TIDX, lane = tid & 63, q = lane >> 4, l15 = lane & 15;
  const bf16_t* MLg = (const bf16_t*)(p.ws + Ws::RML) + (size_t)chain * NC16 * 4096;
  bf16_t* NSg = (bf16_t*)(p.ws + Ws::RNS) + (size_t)chain * NC16 * 4096 + wave * 1024;
  const float* WCg = (const float*)(p.ws + Ws::RWC) + (size_t)chain * NC16 * 64;
  f32x4 S[4];
#pragma unroll
  for (int mk = 0; mk < 4; ++mk) S[mk] = f32x4{0.f, 0.f, 0.f, 0.f};
  RwStep t0, t1, t2, t3, t4, t5;
#define RWC_(x) ((x) < NC16 ? (x) : NC16 - 1)
  rw_load(t0, MLg, NSg, WCg, 0, lane, q);
  rw_load(t1, MLg, NSg, WCg, RWC_(1), lane, q);
  rw_load(t2, MLg, NSg, WCg, RWC_(2), lane, q);
  rw_load(t3, MLg, NSg, WCg, RWC_(3), lane, q);
  rw_load(t4, MLg, NSg, WCg, RWC_(4), lane, q);
  int c = 0;
  for (; c + 5 < NC16; c += 6) {
    rw_load(t5, MLg, NSg, WCg, c + 5, lane, q);
    rw_step(t0, S, NSg, c, q, l15);
    rw_load(t0, MLg, NSg, WCg, RWC_(c + 6), lane, q);
    rw_step(t1, S, NSg, c + 1, q, l15);
    rw_load(t1, MLg, NSg, WCg, RWC_(c + 7), lane, q);
    rw_step(t2, S, NSg, c + 2, q, l15);
    rw_load(t2, MLg, NSg, WCg, RWC_(c + 8), lane, q);
    rw_step(t3, S, NSg, c + 3, q, l15);
    rw_load(t3, MLg, NSg, WCg, RWC_(c + 9), lane, q);
    rw_step(t4, S, NSg, c + 4, q, l15);
    rw_load(t4, MLg, NSg, WCg, RWC_(c + 10), lane, q);
    rw_step(t5, S, NSg, c + 5, q, l15);
  }
  if (c < NC16) { rw_step(t0, S, NSg, c, q, l15);
    if (c + 1 < NC16) { rw_step(t1, S, NSg, c + 1, q, l15);
      if (c + 2 < NC16) { rw_step(t2, S, NSg, c + 2, q, l15);
        if (c + 3 < NC16) { rw_step(t3, S, NSg, c + 3, q, l15);
          if (c + 4 < NC16) rw_step(t4, S, NSg, c + 4, q, l15); } } } }
#undef RWC_
}
DEVFN void rwkv_out(const Params& p, int unit_base) {
  const int tid = TIDX, lane = tid & 63, wave = tid >> 6, q = lane >> 4, l15 = lane & 15;
  const int unit = unit_base + wave;
  const int c = unit % NC16, h = (unit / NC16) & 3, dir = (unit / (NC16 * 4)) & 1, b = unit / (NC16 * 8);
  const size_t ci = (size_t)((b * 2 + dir) * 4 + h) * NC16 + c;
  const bf16_t* Sg = (const bf16_t*)(p.ws + Ws::RNS) + ci * 4096; const bf16_t* Gg = (const bf16_t*)(p.ws + Ws::RG) + ci * 1024;
  const float* Y0g = (const float*)(p.ws + Ws::RY0) + ci * 1024;
  float* YR = (float*)(p.ws + Ws::YR) + (size_t)dir * NT_ * 256;
  const bf16x8 a0 = ld8g(Gg + l15 * 64 + 8 * q), a1 = ld8g(Gg + l15 * 64 + 32 + 8 * q);
  f32x4 acc[4]; bf16x8 s0[4], s1[4];
#pragma unroll
  for (int n = 0; n < 4; ++n) {
#pragma unroll
    for (int r = 0; r < 4; ++r) acc[n][r] = gptr(Y0g)[(4 * q + r) * 64 + 16 * n + l15];
    s0[n] = ld8g(Sg + n * 1024 + l15 * 64 + 8 * q); s1[n] = ld8g(Sg + n * 1024 + l15 * 64 + 32 + 8 * q); }
#pragma unroll
  for (int n = 0; n < 4; ++n) {
    acc[n] = MFMA16(a0, s0[n], acc[n]);
    acc[n] = MFMA16(a1, s1[n], acc[n]);
#pragma unroll
    for (int r = 0; r < 4; ++r) gptr(YR)[(size_t)(b * T_ + tokmap(dir, c * 16 + 4 * q + r)) * 256 + h * 64 + 16 * n + l15] = acc[n][r]; }
}
DEVFN int cscan(int dir, int co, int nctx, int nc) { return dir == 0 ? co : (co < nctx ? nctx - 1 - co : 2 * nctx + nc - 1 - co); }
DEVFN bf16x8 ld4x2g(const bf16_t* p0, const bf16_t* p1) { bf16x4v a = *(const AS1 bf16x4v*)gptr(p0), b = *(const AS1 bf16x4v*)gptr(p1); return bf16x8{a[0], a[1], a[2], a[3], b[0], b[1], b[2], b[3]}; }
DEVFN bf16x8 ld4x2(const bf16_t* p0, const bf16_t* p1) { bf16x4v a = *(const bf16x4v*)p0, b = *(const bf16x4v*)p1; return bf16x8{a[0], a[1], a[2], a[3], b[0], b[1], b[2], b[3]}; }

DEVFN void ssd_chunk_scalars(const Params& p, int l, int b, int co, int h, float* f) {
  const int tid = TIDX, d = tid >> 7, j = tid & 127;
  const float* DTB = (const float*)(p.ws + Ws::DTB);
  const float nega = -expf(INP(I_ALOG)[(size_t)l * 16 + d * 8 + h]);
  const float dt = DTB[(size_t)(b * T_ + co * 128 + j) * 16 + d * 8 + h];
  __syncthreads();
  f[256 + d * 128 + j] = dt;
  float* cur = f + d * 128; float* tmp = f + 512 + d * 128;
  cur[j] = dt * nega;
  __syncthreads();
  for (int off = 1; off < 128; off <<= 1) {
    float v = cur[j] + (j >= off ? cur[j - off] : 0.f);
    tmp[j] = v;
    __syncthreads();
    cur[j] = tmp[j];
    __syncthreads();
  }
}
DEVFN void ssd_states(const Params& p, int l, int unit, unsigned char* smem) {
  const int tid = TIDX, lane = tid & 63, wave = tid >> 6, q = lane >> 4, l15 = lane & 15;
  const int h = unit & 7, co = (unit >> 3) % NC128, b = unit / (8 * NC128), grp = h >> 2;
  float* f = (float*)smem;
  ssd_chunk_scalars(p, l, b, co, h, f);
  { const int d = tid >> 7, j = tid & 127; const float* cum = f + d * 128; const float dt = f[256 + d * 128 + j];
    float w = d == 0 ? expf(cum[127] - cum[j]) * dt : expf(j > 0 ? cum[j - 1] : 0.f) * dt;
    f[512 + d * 128 + j] = w; }
  __syncthreads();
  const bf16_t* XT = (const bf16_t*)(p.ws + Ws::XBCT) + (size_t)(b * NC128 + co) * 768 * 128;
  f32x4 acc[2][8];
#pragma unroll
  for (int d = 0; d < 2; ++d)
#pragma unroll
    for (int n = 0; n < 8; ++n) acc[d][n] = f32x4{0.f, 0.f, 0.f, 0.f};
#pragma unroll 2
  for (int s4 = 0; s4 < 4; ++s4) {
    const int j0 = s4 * 32 + q * 8;
    bf16x8 xa = ld8g(XT + (size_t)(h * 64 + wave * 16 + l15) * 128 + j0), a0, a1;
#pragma unroll
    for (int jj = 0; jj < 8; ++jj) { float x = bf2f((bf16_t)xa[jj]); a0[jj] = (short)f2bf(x * f[512 + j0 + jj]); a1[jj] = (short)f2bf(x * f[640 + j0 + jj]); }
#pragma unroll
    for (int n = 0; n < 8; ++n) { bf16x8 bb = ld8g(XT + (size_t)(512 + grp * 128 + n * 16 + l15) * 128 + j0);
      acc[0][n] = MFMA16(a0, bb, acc[0][n]); acc[1][n] = MFMA16(a1, bb, acc[1][n]); }
  }
#pragma unroll
  for (int d = 0; d < 2; ++d) {
    const int cs = cscan(d, co, CTX_ / 128, SEQ_ / 128);
    float* ST = (float*)(p.ws + Ws::SST) + ((size_t)((d * B_ + b) * NC128 + cs) * 8 + h) * 8192;
#pragma unroll
    for (int n = 0; n < 8; ++n)
#pragma unroll
      for (int r = 0; r < 4; ++r) ST[(wave * 16 + q * 4 + r) * 128 + n * 16 + l15] = acc[d][n][r];
    if (tid == 0) ((float*)(p.ws + Ws::SCD))[((size_t)(d * B_ + b) * NC128 + cs) * 8 + h] = expf(f[d * 128 + 127]);
  }
}
#define SSD_SB ((NC128 % 17) == 0 ? 17 : NC128)
DEVFN void ssd_scan(const Params& p, int gtid, int gthreads) {
  const float* __restrict__ ST = (const float*)(p.ws + Ws::SST); const float* __restrict__ CD = (const float*)(p.ws + Ws::SCD); bf16_t* __restrict__ HIN = (bf16_t*)(p.ws + Ws::HIN);
  for (int e = gtid; e < 2 * B_ * 8 * 8192; e += gthreads) {
    const int pd = e & 8191, h = (e >> 13) & 7, db = e >> 16;
    float hv = 0.f;
#pragma unroll 1
    for (int c0 = 0; c0 < NC128; c0 += SSD_SB) {
      float st[SSD_SB], cd[SSD_SB];
#pragma unroll
      for (int i = 0; i < SSD_SB; ++i) { st[i] = ST[((size_t)(db * NC128 + c0 + i) * 8 + h) * 8192 + pd]; cd[i] = CD[(size_t)(db * NC128 + c0 + i) * 8 + h]; }
#pragma unroll
      for (int i = 0; i < SSD_SB; ++i) { HIN[((size_t)(db * NC128 + c0 + i) * 8 + h) * 8192 + pd] = f2bf(hv); hv = hv * cd[i] + st[i]; }
    }
  }
}
DEVFN void ssd_out(const Params& p, int l, int unit, unsigned char* smem) {
  const int tid = TIDX, lane = tid & 63, wave = tid >> 6, q = lane >> 4, l15 = lane & 15;
  const int h = unit & 7, co = (unit >> 3) % NC128, b = unit / (8 * NC128), grp = h >> 2;
  float* f = (float*)smem;
  ssd_chunk_scalars(p, l, b, co, h, f);
  if (tid < 128) f[640 + tid] = f[128 + 127] - (tid > 0 ? f[128 + tid - 1] : 0.f);
  __syncthreads();
  const float* cum0 = f; const float* suf1 = f + 640; const float* dt0 = f + 256; const float* dt1 = f + 384;
  const bf16_t* XBC = (const bf16_t*)(p.ws + Ws::XBC) + (size_t)(b * T_ + co * 128) * 1024;
  const bf16_t* XT = (const bf16_t*)(p.ws + Ws::XBCT) + (size_t)(b * NC128 + co) * 768 * 128;
  const bf16_t* Cb = XBC + (size_t)(wave * 32 + l15) * 1024 + 768 + grp * 128 + q * 8;
  f32x4 y[4][2];
  { f32x4 o0[4][2], o1[4][2];
#pragma unroll
    for (int mp = 0; mp < 4; ++mp)
#pragma unroll
      for (int ni = 0; ni < 2; ++ni) { o0[mp][ni] = f32x4{0.f, 0.f, 0.f, 0.f}; o1[mp][ni] = f32x4{0.f, 0.f, 0.f, 0.f}; }
    const int cs0 = cscan(0, co, CTX_ / 128, SEQ_ / 128), cs1 = cscan(1, co, CTX_ / 128, SEQ_ / 128);
    const bf16_t* H0 = (const bf16_t*)(p.ws + Ws::HIN) + ((size_t)((0 * B_ + b) * NC128 + cs0) * 8 + h) * 8192;
    const bf16_t* H1 = (const bf16_t*)(p.ws + Ws::HIN) + ((size_t)((1 * B_ + b) * NC128 + cs1) * 8 + h) * 8192;
#pragma unroll
    for (int s4 = 0; s4 < 4; ++s4) { const bf16x8 c0 = ld8g(Cb + s4 * 32), c1 = ld8g(Cb + 16 * 1024 + s4 * 32);
#pragma unroll
      for (int mp = 0; mp < 4; ++mp) { bf16x8 h0 = ld8g(H0 + (size_t)(mp * 16 + l15) * 128 + s4 * 32 + q * 8), h1 = ld8g(H1 + (size_t)(mp * 16 + l15) * 128 + s4 * 32 + q * 8);
        o0[mp][0] = MFMA16(h0, c0, o0[mp][0]); o0[mp][1] = MFMA16(h0, c1, o0[mp][1]);
        o1[mp][0] = MFMA16(h1, c0, o1[mp][0]); o1[mp][1] = MFMA16(h1, c1, o1[mp][1]); } }
#pragma unroll
    for (int ni = 0; ni < 2; ++ni) { const int i = wave * 32 + ni * 16 + l15; const float e0 = expf(cum0[i]), e1 = expf(suf1[i]);
#pragma unroll
      for (int mp = 0; mp < 4; ++mp)
#pragma unroll
        for (int r = 0; r < 4; ++r) y[mp][ni][r] = e0 * o0[mp][ni][r] + e1 * o1[mp][ni][r]; } }
  bf16x8 mfr[4][2];
  { f32x4 g[8][2];
#pragma unroll
    for (int mj = 0; mj < 8; ++mj) { g[mj][0] = f32x4{0.f, 0.f, 0.f, 0.f}; g[mj][1] = f32x4{0.f, 0.f, 0.f, 0.f}; }
#pragma unroll
    for (int s4 = 0; s4 < 4; ++s4) { const bf16x8 c0 = ld8g(Cb + s4 * 32), c1 = ld8g(Cb + 16 * 1024 + s4 * 32);
#pragma unroll
      for (int mj = 0; mj < 8; ++mj) { bf16x8 bb = ld8g(XBC + (size_t)(mj * 16 + l15) * 1024 + 512 + grp * 128 + s4 * 32 + q * 8);
        g[mj][0] = MFMA16(bb, c0, g[mj][0]); g[mj][1] = MFMA16(bb, c1, g[mj][1]); } }
    const int i0 = wave * 32 + l15, i1 = i0 + 16;
    const float c0i0 = cum0[i0], s1i0 = suf1[i0], c0i1 = cum0[i1], s1i1 = suf1[i1];
#pragma unroll
    for (int mj = 0; mj < 8; ++mj)
#pragma unroll
      for (int r = 0; r < 4; ++r) { const int j = mj * 16 + q * 4 + r;
        const float cj = cum0[j], sj = suf1[j], d0 = dt0[j], d1 = dt1[j];
        const float lw0 = (j <= i0 ? expf(c0i0 - cj) * d0 : 0.f) + (j >= i0 ? expf(s1i0 - sj) * d1 : 0.f);
        const float lw1 = (j <= i1 ? expf(c0i1 - cj) * d0 : 0.f) + (j >= i1 ? expf(s1i1 - sj) * d1 : 0.f);
        mfr[mj >> 1][0][(mj & 1) * 4 + r] = (short)f2bf(g[mj][0][r] * lw0);
        mfr[mj >> 1][1][(mj & 1) * 4 + r] = (short)f2bf(g[mj][1][r] * lw1); } }
#pragma unroll
  for (int s4 = 0; s4 < 4; ++s4)
#pragma unroll
    for (int mp = 0; mp < 4; ++mp) { const bf16_t* xr = XT + (size_t)(h * 64 + mp * 16 + l15) * 128 + s4 * 32 + q * 4;
      bf16x8 xa = ld4x2g(xr, xr + 16);
      y[mp][0] = MFMA16(xa, mfr[s4][0], y[mp][0]); y[mp][1] = MFMA16(xa, mfr[s4][1], y[mp][1]); }
  __syncthreads();
  float* yl = f + 1024;
#pragma unroll
  for (int mp = 0; mp < 4; ++mp)
#pragma unroll
    for (int ni = 0; ni < 2; ++ni)
#pragma unroll
      for (int r = 0; r < 4; ++r) yl[(wave * 32 + ni * 16 + l15) * 65 + mp * 16 + q * 4 + r] = y[mp][ni][r];
  __syncthreads();
  float* YS = (float*)(p.ws + Ws::YS) + (size_t)(b * T_ + co * 128) * 512 + h * 64;
  for (int e = tid; e < 128 * 64; e += 256) gptr(YS)[(size_t)(e >> 6) * 512 + (e & 63)] = yl[(e >> 6) * 65 + (e & 63)];
}

#define GQ_LD 40
#define GK_LD 72
DEVFN void gla_chunk(const Params& p, int unit, unsigned char* smem) {
  const int tid = TIDX, lane = tid & 63, wave = tid >> 6, q = lane >> 4, l15 = lane & 15;
  const int h = unit & 3, co = (unit >> 2) % NC64, b = unit / (4 * NC64);
  const bf16_t* ZX = (const bf16_t*)(p.ws + Ws::ZX) + (size_t)(b * T_ + co * 64) * NIN_;
  const float* LA = (const float*)(p.ws + Ws::LA);
  float* cum = (float*)smem;
  bf16_t* qs = (bf16_t*)(smem + 16384);
  bf16_t* ks = qs + 2 * 64 * GQ_LD;
  bf16_t* kt = ks + 2 * 64 * GQ_LD;
  __syncthreads();
  float la[16]; bf16_t qraw[8], kraw[8];
#pragma unroll
  for (int it = 0; it < 16; ++it) { const int e = tid + 256 * it, d = e >> 11, i = (e >> 5) & 63, dd = e & 31;
    la[it] = gptr(LA)[((size_t)d * NT_ + b * T_ + co * 64 + i) * 128 + h * 32 + dd]; }
#pragma unroll
  for (int it = 0; it < 8; ++it) { const int e = tid + 256 * it, i = e >> 5, dd = e & 31;
    qraw[it] = gptr(ZX)[(size_t)i * NIN_ + OGQ + h * 32 + dd]; kraw[it] = gptr(ZX)[(size_t)i * NIN_ + OGK + h * 32 + dd]; }
  const bf16_t* VT = (const bf16_t*)(p.ws + Ws::VT) + ((size_t)(b * NC64 + co) * 256 + h * 64) * 64;
  bf16x8 vfa[4][2], vfs[2];
#pragma unroll
  for (int md = 0; md < 4; ++md)
#pragma unroll
    for (int s2 = 0; s2 < 2; ++s2) { const bf16_t* vr = VT + (size_t)(md * 16 + l15) * 64 + s2 * 32 + q * 4; vfa[md][s2] = ld4x2g(vr, vr + 16); }
#pragma unroll
  for (int s2 = 0; s2 < 2; ++s2) vfs[s2] = ld8g(VT + (size_t)(wave * 16 + l15) * 64 + s2 * 32 + q * 8);
#pragma unroll
  for (int it = 0; it < 16; ++it) cum[tid + 256 * it] = la[it];
  __syncthreads();
  if (tid < 64) { const int d = tid >> 5, dd = tid & 31; float* c = cum + d * 2048 + dd; float sacc = 0.f;
    if (d == 0) for (int i = 0; i < 64; ++i) { sacc += c[i * 32]; c[i * 32] = sacc; }
    else for (int i = 63; i >= 0; --i) { sacc += c[i * 32]; c[i * 32] = sacc; } }
  __syncthreads();
  bf16_t* QT = (bf16_t*)(p.ws + Ws::QT);
#pragma unroll
  for (int it = 0; it < 8; ++it) { const int e = tid + 256 * it, i = e >> 5, dd = e & 31;
    const float qv = bf2f(qraw[it]) * 0.17677669529663687f, kv = bf2f(kraw[it]);
    const float c0 = cum[i * 32 + dd], c1 = cum[2048 + i * 32 + dd], t0 = cum[63 * 32 + dd], t1 = cum[2048 + dd];
    const bf16_t q0 = f2bf(qv * expf(c0)), q1 = f2bf(qv * expf(c1));
    qs[i * GQ_LD + dd] = q0; qs[64 * GQ_LD + i * GQ_LD + dd] = q1;
    ks[i * GQ_LD + dd] = f2bf(kv * expf(-c0)); ks[64 * GQ_LD + i * GQ_LD + dd] = f2bf(kv * expf(-c1));
    kt[dd * GK_LD + i] = f2bf(kv * expf(t0 - c0)); kt[32 * GK_LD + dd * GK_LD + i] = f2bf(kv * expf(t1 - c1));
    const size_t tok = (size_t)b * T_ + co * 64 + i;
    QT[tok * 128 + h * 32 + dd] = q0; QT[((size_t)NT_ + tok) * 128 + h * 32 + dd] = q1; }
  if (tid < 64) { const int d = tid >> 5, dd = tid & 31; const int cs = cscan(d, co, CTX_ / 64, SEQ_ / 64);
    ((float*)(p.ws + Ws::GCD))[(((size_t)(d * B_ + b) * NC64 + cs) * 4 + h) * 32 + dd] = expf(d == 0 ? cum[63 * 32 + dd] : cum[2048 + dd]); }
  __syncthreads();
  bf16x8 pfr[2];
  { f32x4 p0[4], p1[4];
    const bf16x8 qb0 = ld8(qs + (wave * 16 + l15) * GQ_LD + q * 8), qb1 = ld8(qs + 64 * GQ_LD + (wave * 16 + l15) * GQ_LD + q * 8);
#pragma unroll
    for (int mj = 0; mj < 4; ++mj) { p0[mj] = MFMA16(ld8(ks + (mj * 16 + l15) * GQ_LD + q * 8), qb0, (f32x4{0.f, 0.f, 0.f, 0.f}));
      p1[mj] = MFMA16(ld8(ks + 64 * GQ_LD + (mj * 16 + l15) * GQ_LD + q * 8), qb1, (f32x4{0.f, 0.f, 0.f, 0.f})); }
    const int i = wave * 16 + l15;
#pragma unroll
    for (int mj = 0; mj < 4; ++mj)
#pragma unroll
      for (int r = 0; r < 4; ++r) { const int j = mj * 16 + q * 4 + r; pfr[mj >> 1][(mj & 1) * 4 + r] = (short)f2bf((j <= i ? p0[mj][r] : 0.f) + (j >= i ? p1[mj][r] : 0.f)); } }
  f32x4 o[4];
#pragma unroll
  for (int md = 0; md < 4; ++md) { o[md] = f32x4{0.f, 0.f, 0.f, 0.f};
#pragma unroll
    for (int s2 = 0; s2 < 2; ++s2) o[md] = MFMA16(vfa[md][s2], pfr[s2], o[md]); }
#pragma unroll
  for (int d = 0; d < 2; ++d) { const int cs = cscan(d, co, CTX_ / 64, SEQ_ / 64);
    float* GST = (float*)(p.ws + Ws::GST) + (((size_t)(d * B_ + b) * NC64 + cs) * 4 + h) * 2048;
#pragma unroll
    for (int nd = 0; nd < 2; ++nd) { f32x4 st = f32x4{0.f, 0.f, 0.f, 0.f};
#pragma unroll
      for (int s2 = 0; s2 < 2; ++s2) st = MFMA16(vfs[s2], ld8(kt + d * 32 * GK_LD + (nd * 16 + l15) * GK_LD + s2 * 32 + q * 8), st);
#pragma unroll
      for (int r = 0; r < 4; ++r) GST[(wave * 16 + q * 4 + r) * 32 + nd * 16 + l15] = st[r]; } }
  __syncthreads();
  float* ol = (float*)smem;
#pragma unroll
  for (int md = 0; md < 4; ++md)
#pragma unroll
    for (int r = 0; r < 4; ++r) ol[(wave * 16 + l15) * 65 + md * 16 + q * 4 + r] = o[md][r];
  __syncthreads();
  float* OI = (float*)(p.ws + Ws::OI) + (size_t)(b * T_ + co * 64) * 256 + h * 64;
  for (int e = tid; e < 64 * 64; e += 256) gptr(OI)[(size_t)(e >> 6) * 256 + (e & 63)] = ol[(e >> 6) * 65 + (e & 63)];
}
#define GLA_SB ((NC64 % 17) == 0 ? 17 : NC64)
DEVFN void gla_scan(const Params& p, int gtid, int gthreads) {
  const float* __restrict__ ST = (const float*)(p.ws + Ws::GST); const float* __restrict__ CD = (const float*)(p.ws + Ws::GCD); bf16_t* __restrict__ SIN = (bf16_t*)(p.ws + Ws::GSIN);
  for (int e = gtid; e < 2 * B_ * 4 * 2048; e += gthreads) {
    const int vd = e & 2047, h = (e >> 11) & 3, db = e >> 13;
    float sv = 0.f;
#pragma unroll 1
    for (int c0 = 0; c0 < NC64; c0 += GLA_SB) {
      float st[GLA_SB], cd[GLA_SB];
#pragma unroll
      for (int i = 0; i < GLA_SB; ++i) { st[i] = ST[(((size_t)db * NC64 + c0 + i) * 4 + h) * 2048 + vd]; cd[i] = CD[(((size_t)db * NC64 + c0 + i) * 4 + h) * 32 + (vd & 31)]; }
#pragma unroll
      for (int i = 0; i < GLA_SB; ++i) { SIN[(((size_t)db * NC64 + c0 + i) * 4 + h) * 2048 + vd] = f2bf(sv); sv = sv * cd[i] + st[i]; }
    }
  }
}
DEVFN void gla_out(const Params& p, int unit_base) {
  const int tid = TIDX, lane = tid & 63, wave = tid >> 6, g = lane >> 4, l15 = lane & 15;
  const int unit = unit_base + wave;
  if (unit >= B_ * NC64 * 4) return;
  const int h = unit & 3, co = (unit >> 2) % NC64, b = unit / (4 * NC64);
  const bf16_t* QT = (const bf16_t*)(p.ws + Ws::QT);
  const bf16_t* GSIN = (const bf16_t*)(p.ws + Ws::GSIN);
  float* OI = (float*)(p.ws + Ws::OI) + (size_t)(b * T_ + co * 64) * 256 + h * 64;
  const int tok0 = b * T_ + co * 64;
  bf16x8 af[2][4], bfr[2][4];
#pragma unroll
  for (int d = 0; d < 2; ++d) { const int cs = cscan(d, co, CTX_ / 64, SEQ_ / 64);
    const bf16_t* sr = GSIN + ((((size_t)(d * B_ + b) * NC64 + cs) * 4 + h) * 64) * 32;
#pragma unroll
    for (int mi = 0; mi < 4; ++mi) af[d][mi] = ld8g(QT + ((size_t)d * NT_ + tok0 + mi * 16 + l15) * 128 + h * 32 + g * 8);
#pragma unroll
    for (int ni = 0; ni < 4; ++ni) bfr[d][ni] = ld8g(sr + (ni * 16 + l15) * 32 + g * 8); }
#pragma unroll
  for (int mi = 0; mi < 4; ++mi) {
    f32x4 acc[4];
#pragma unroll
    for (int ni = 0; ni < 4; ++ni)
#pragma unroll
      for (int i = 0; i < 4; ++i) acc[ni][i] = gptr(OI)[(size_t)(mi * 16 + 4 * g + i) * 256 + ni * 16 + l15];
#pragma unroll
    for (int ni = 0; ni < 4; ++ni) { acc[ni] = MFMA16(af[0][mi], bfr[0][ni], acc[ni]); acc[ni] = MFMA16(af[1][mi], bfr[1][ni], acc[ni]); }
#pragma unroll
    for (int ni = 0; ni < 4; ++ni)
#pragma unroll
      for (int i = 0; i < 4; ++i) gptr(OI)[(size_t)(mi * 16 + 4 * g + i) * 256 + ni * 16 + l15] = acc[ni][i];
  }
}
DEVFN void convert_moe_weights(const Params& p, int l, unsigned char* smem, int bid, int nb, int j_lo, int j_hi);
#define CVT_JOBS (65 * 192)
#ifndef CVT_SCAN_SHARE
#define CVT_SCAN_SHARE (CVT_JOBS / 8)
#endif
DEVFN void phase4a(const Params& p, int l, unsigned char* smem) {
  const int n_r = B_ * 8 * NC16 / 4;
  for (int u = BIDX; u < n_r; u += gridDim.x) rwkv_chunk(p, (u) * 4, smem);
  (void)l;
}
#define CVT_GRP 8
DEVFN void phase4b(const Params& p, int l, unsigned char* smem) {
  const int bid = BIDX, nrw = B_ * 8, G = (int)gridDim.x;
  const int n_s = B_ * NC128 * 8, n_g = B_ * NC64 * 4;
  if (G >= 8 * nrw) {
    const int q = 2 * nrw, half = G >> 1, on = G - 4 * nrw;
    int sb = -1;
    if (bid < q) sb = bid; else if (bid >= half && bid < half + q) sb = q + (bid - half);
    const int n_c = (CVT_JOBS + CVT_GRP - 1) / CVT_GRP, total = n_s + n_g + n_c;
    unsigned* ctr = (unsigned*)(p.ws + Ws::BAR) + l * 32 + 16;
    volatile int* nxt_s = (volatile int*)(smem + SM_PRE);
    int u;
    if (sb >= 0) { if ((TIDX >> 6) == 0) rwkv_scan(p, sb >> 2, sb & 3);
      __syncthreads();
      if (TIDX == 0) *nxt_s = on + (int)atomicAdd(ctr, 1u);
      __syncthreads();
      u = *nxt_s; }
    else u = bid < half ? bid - q : bid - 2 * q;
    while (u < total) {
      int nxt = 0;
      if (TIDX == 0) nxt = on + (int)atomicAdd(ctr, 1u);
      if (u < n_s) ssd_states(p, l, u, smem); else if (u < n_s + n_g) gla_chunk(p, u - n_s, smem);
      else { const int j0 = (u - n_s - n_g) * CVT_GRP, j1 = j0 + CVT_GRP < CVT_JOBS ? j0 + CVT_GRP : CVT_JOBS; convert_moe_weights(p, l, smem, 0, 1, j0, j1); }
      __syncthreads();
      if (TIDX == 0) *nxt_s = nxt;
      __syncthreads();
      u = *nxt_s;
    }
    return;
  }
  for (int u = bid; u < nrw; u += G) rwkv_scan(p, u, TIDX >> 6);
  for (int u = bid; u < n_s + n_g; u += G) { if (u < n_s) ssd_states(p, l, u, smem); else gla_chunk(p, u - n_s, smem); }
  convert_moe_weights(p, l, smem, bid, G, 0, CVT_JOBS);
}
DEVFN void phase4b2(const Params& p) {
  const int bid = BIDX, G = (int)gridDim.x;
  ssd_scan(p, bid * 256 + TIDX, G * 256); gla_scan(p, bid * 256 + TIDX, G * 256);
}
DEVFN void phase4c(const Params& p, int l, unsigned char* smem) {
  const int n_s = B_ * NC128 * 8, n_r = B_ * 8 * NC16 / 4, n_g = B_ * NC64, total = n_s + n_r + n_g, G = (int)gridDim.x;
  unsigned* ctr = (unsigned*)(p.ws + Ws::BAR) + l * 32;
  volatile int* nxt_s = (volatile int*)(smem + SM_PRE);
  int u = BIDX;
  while (u < total) {
    int nxt = 0;
    if (TIDX == 0) nxt = G + (int)atomicAdd(ctr, 1u);
    if (u < n_s) ssd_out(p, l, u, smem); else if (u < n_s + n_r) rwkv_out(p, (u - n_s) * 4); else gla_out(p, (u - n_s - n_r) * 4);
    __syncthreads();
    if (TIDX == 0) *nxt_s = nxt;
    __syncthreads();
    u = *nxt_s;
  }
}

DEVFN void phase5(const Params& p, int l, unsigned char* smem) {
  const int tid = TIDX, lane = tid & 63, wave = tid >> 6;
  const bf16_t* ZX = (const bf16_t*)(p.ws + Ws::ZX);
  const bf16_t* XBC = (const bf16_t*)(p.ws + Ws::XBC);
  const float* YS = (const float*)(p.ws + Ws::YS); const float* YR = (const float*)(p.ws + Ws::YR); const float* OI = (const float*)(p.ws + Ws::OI);
  const bf16_t* RR = (const bf16_t*)(p.ws + Ws::RR); const bf16_t* VV = (const bf16_t*)(p.ws + Ws::VV); const bf16_t* KD = (const bf16_t*)(p.ws + Ws::KD);
  const float* GATE = (const float*)(p.ws + Ws::GATE);
  bf16_t* YM = (bf16_t*)(p.ws + Ws::YMIX);
  constexpr int TPI = 4;
  float* red = (float*)smem;
  const float dA = INP(I_SSDD)[(size_t)l * 8 + (tid >> 6)], dB = INP(I_SSDD)[(size_t)l * 8 + 4 + (tid >> 6)];
  const float nwA = INP(I_SSDNW)[(size_t)l * 512 + tid], nwB = INP(I_SSDNW)[(size_t)l * 512 + 256 + tid];
  const float lnw = INP(I_LNXW)[(size_t)l * 256 + tid], lnb = INP(I_LNXB)[(size_t)l * 256 + tid], rk = INP(I_RK)[(size_t)l * 256 + tid];
  const float gnw = INP(I_GNW)[(size_t)l * 256 + tid];
  const int per_ = (NT_ / TPI + (int)gridDim.x - 1) / (int)gridDim.x, tp_lo = BIDX * per_, tp_hi = (tp_lo + per_ < NT_ / TPI) ? tp_lo + per_ : NT_ / TPI;
  for (int tp = tp_lo; tp < tp_hi; ++tp) {
    float ys0[TPI], ys1[TPI], x0[TPI], x1[TPI], z0[TPI], z1[TPI], og[TPI], yr[TPI], rr[TPI], kf[TPI], kb[TPI], vv[TPI], gt[TPI], oi[TPI];
#pragma unroll
    for (int t = 0; t < TPI; ++t) { const int tok = tp * TPI + t;
      ys0[t] = gptr(YS)[(size_t)tok * 512 + tid]; ys1[t] = gptr(YS)[(size_t)tok * 512 + 256 + tid];
      x0[t] = bf2f(gptr(XBC)[(size_t)tok * 1024 + tid]); x1[t] = bf2f(gptr(XBC)[(size_t)tok * 1024 + 256 + tid]);
      z0[t] = zxv(ZX, tok, OZ + tid); z1[t] = zxv(ZX, tok, OZ + 256 + tid); og[t] = zxv(ZX, tok, OOG + tid);
      yr[t] = gptr(YR)[(size_t)tok * 256 + tid] + gptr(YR)[((size_t)NT_ + tok) * 256 + tid];
      rr[t] = bf2f(gptr(RR)[(size_t)tok * 256 + tid]); kf[t] = bf2f(gptr(KD)[(size_t)tok * 256 + tid]); kb[t] = bf2f(gptr(KD)[((size_t)NT_ + tok) * 256 + tid]);
      vv[t] = bf2f(gptr(VV)[(size_t)tok * 256 + tid]); gt[t] = gptr(GATE)[(size_t)tok * 256 + tid]; oi[t] = gptr(OI)[(size_t)tok * 256 + tid];
    }
    float ya[TPI], yb[TPI], qa[TPI], qb[TPI];
#pragma unroll
    for (int t = 0; t < TPI; ++t) {
      ya[t] = (ys0[t] + dA * x0[t]) * siluf_(z0[t]); yb[t] = (ys1[t] + dB * x1[t]) * siluf_(z1[t]);
      qa[t] = wave_sum(ya[t] * ya[t]); qb[t] = wave_sum(yb[t] * yb[t]); }
    __syncthreads();
#pragma unroll
    for (int t = 0; t < TPI; ++t)
      if (lane == 0) { red[t * 8 + wave] = qa[t]; red[t * 8 + 4 + wave] = qb[t]; }
    __syncthreads();
#pragma unroll
    for (int t = 0; t < TPI; ++t) { const int tok = tp * TPI + t;
      const float* rd = red + t * 8;
      float ma = (rd[0] + rd[1] + rd[2] + rd[3]) * (1.f / 256.f), mb = (rd[4] + rd[5] + rd[6] + rd[7]) * (1.f / 256.f);
      YM[(size_t)tok * 1024 + tid] = f2bf(ya[t] * rsqrtf(ma + 1e-5f) * nwA);
      YM[(size_t)tok * 1024 + 256 + tid] = f2bf(yb[t] * rsqrtf(mb + 1e-5f) * nwB);
      { const float y = yr[t];
        float mu = wave_sum(y) * (1.f / 64.f), d = y - mu, var = wave_sum(d * d) * (1.f / 64.f);
        float yn = d * rsqrtf(var + 64e-5f) * lnw + lnb;
        float bonus = wave_sum(rr[t] * (kf[t] + kb[t]) * rk) * vv[t];
        YM[(size_t)tok * 1024 + 512 + tid] = f2bf((yn + bonus) * gt[t]); }
      { float o = oi[t];
        float ms = wave_sum(o * o) * (1.f / 64.f);
        YM[(size_t)tok * 1024 + 768 + tid] = f2bf(o * rsqrtf(ms + 1e-5f) * gnw * siluf_(og[t])); } }
  }
}

DEVFN void phase6(const Params& p, int l, unsigned char* smem) {
  const bf16_t* A = (const bf16_t*)(p.ws + Ws::YMIX);
  const bf16_t* W = (const bf16_t*)(p.ws + Ws::WOUT) + (size_t)l * 1024 * 1024;
  float* MIX = (float*)(p.ws + Ws::MIX);
  for (int u = BIDX; u < (NT_ / 128) * 8; u += gridDim.x) {
    int rt = u / 8, ct = u % 8;
    gemm_tile(smem, 1024,
      [&](int r) { return A + (size_t)(rt * 128 + r) * 1024; },
      [&](int r) { return W + (size_t)(ct * 128 + r) * 1024; },
      [&](f32x4 (&acc)[4][4], int wr, int wc, int g, int l15) {
#pragma unroll
        for (int mi = 0; mi < 4; ++mi)
#pragma unroll
          for (int ni = 0; ni < 4; ++ni)
#pragma unroll
            for (int i = 0; i < 4; ++i) MIX[(size_t)(rt * 128 + wr * 64 + mi * 16 + 4 * g + i) * 1024 + ct * 128 + wc * 64 + ni * 16 + l15] = acc[mi][ni][i];
      });
  }
}

#define P7_MAXE 2048
DEVFN void phase7(const Params& p, int l, unsigned char* smem) {
  const int lane = TIDX & 63, wave = TIDX >> 6;
  float* X = (float*)(p.ws + Ws::X);
  const float* MIX = (const float*)(p.ws + Ws::MIX);
  bf16_t* H = (bf16_t*)(p.ws + Ws::U);
  const float* rwt = (const float*)(p.ws + Ws::RWT) + (size_t)l * 64 * 1024;
  int* cnt = (int*)(p.ws + Ws::CNT) + l * 64 * 64;
  int* ltok = (int*)(p.ws + Ws::LTOK); float* lwt = (float*)(p.ws + Ws::LWT);
  const float rbias = INP(I_RB)[(size_t)l * 64 + lane];
  float* hs = (float*)smem;
  float* lg = hs + 4096;
  int* lcnt = (int*)(lg + 256);
  int* lbase = lcnt + 80;
  int* etok = lbase + 64;
  int* epos = etok + P7_MAXE; float* ewt = (float*)(epos + P7_MAXE);
  for (int i = TIDX; i < 80; i += 256) lcnt[i] = 0;
  for (int tok0 = BIDX * 4; tok0 < NT_; tok0 += gridDim.x * 4) {
    const int tok = tok0 + wave;
    const float* mod = (const float*)(p.ws + Ws::MOD) + ((size_t)l * NR_ + tok_modrow(tok)) * NMOD_;
    float xv[16], mx[16], g1[16], lw[16], lb[16], sh2[16], sc2[16], mean, rstd;
    load_row16(X + (size_t)tok * 1024, lane, xv);
    load_row16(MIX + (size_t)tok * 1024, lane, mx);
    load_row16(mod + 2 * 1024, lane, g1);
    load_row16(INP(I_LN1W) + (size_t)l * 1024, lane, lw);
    load_row16(INP(I_LN1B) + (size_t)l * 1024, lane, lb);
    load_row16(mod + 3 * 1024, lane, sh2);
    load_row16(mod + 4 * 1024, lane, sc2);
#pragma unroll
    for (int i = 0; i < 16; ++i) xv[i] = ALPHA_ * xv[i] + g1[i] * mx[i];
    row_stats(xv, mean, rstd);
#pragma unroll
    for (int i = 0; i < 16; ++i) xv[i] = (xv[i] - mean) * rstd * lw[i] + lb[i];
#pragma unroll
    for (int j = 0; j < 4; ++j) *(float4*)(X + (size_t)tok * 1024 + lane * 4 + 256 * j) = make_float4(xv[4 * j], xv[4 * j + 1], xv[4 * j + 2], xv[4 * j + 3]);
    const bool routed = !(l == DEPTH_ - 1 && (tok % T_) < CTX_);
    row_stats(xv, mean, rstd);
#pragma unroll
    for (int i = 0; i < 16; ++i) xv[i] = (xv[i] - mean) * rstd * (1.f + sc2[i]) + sh2[i];
    __syncthreads();
#pragma unroll
    for (int j = 0; j < 4; ++j) {
      if (routed) *(uint2*)(H + (size_t)tok * 1024 + lane * 4 + 256 * j) = make_uint2((unsigned)f2bf(xv[4 * j]) | ((unsigned)f2bf(xv[4 * j + 1]) << 16), (unsigned)f2bf(xv[4 * j + 2]) | ((unsigned)f2bf(xv[4 * j + 3]) << 16));
      *(float4*)(hs + wave * 1024 + lane * 4 + 256 * j) = make_float4(xv[4 * j], xv[4 * j + 1], xv[4 * j + 2], xv[4 * j + 3]); }
    __syncthreads();
    { float hv[4][16];
      const int rot = BIDX & 15;
#pragma unroll
      for (int t = 0; t < 4; ++t)
#pragma unroll
        for (int j = 0; j < 4; ++j) { const float4 v = *(const float4*)(hs + t * 1024 + lane * 4 + 256 * j); hv[t][4 * j] = v.x; hv[t][4 * j + 1] = v.y; hv[t][4 * j + 2] = v.z; hv[t][4 * j + 3] = v.w; }
      float pe[64];
      const AS1 float* rw = gptr(rwt) + lane * 4;
      f32x4 w[4], wn[4];
#pragma unroll
      for (int j = 0; j < 4; ++j) w[j] = *(const AS1 f32x4*)(rw + (size_t)(16 * wave + (rot & 15)) * 1024 + 256 * j);
#pragma unroll
      for (int e = 0; e < 16; ++e) {
        if (e + 1 < 16) {
#pragma unroll
          for (int j = 0; j < 4; ++j) wn[j] = *(const AS1 f32x4*)(rw + (size_t)(16 * wave + ((e + 1 + rot) & 15)) * 1024 + 256 * j); }
#pragma unroll
        for (int t = 0; t < 4; ++t) { float s0 = 0.f, s1 = 0.f;
#pragma unroll
          for (int j = 0; j < 4; ++j) { s0 += hv[t][4 * j] * w[j][0] + hv[t][4 * j + 2] * w[j][2]; s1 += hv[t][4 * j + 1] * w[j][1] + hv[t][4 * j + 3] * w[j][3]; }
          pe[e * 4 + t] = s0 + s1; }
#pragma unroll
        for (int j = 0; j < 4; ++j) w[j] = wn[j]; }
#pragma unroll
      for (int half = 32; half >= 1; half >>= 1) { const bool up = (lane & half) != 0;
#pragma unroll
        for (int e = 0; e < half; ++e) { const float send = up ? pe[e] : pe[e + half]; const float recv = __shfl_xor(send, half); pe[e] = (up ? pe[e + half] : pe[e]) + recv; } }
      lg[(lane & 3) * 64 + 16 * wave + (((lane >> 2) + rot) & 15)] = pe[0]; }
    __syncthreads();
    if (!routed) continue;
    const float logit = lg[wave * 64 + lane];
    const float score = sigmoidf_(logit), sel = score + rbias;
    float m1 = sel; int a1 = lane;
#pragma unroll
    for (int m = 1; m <= 4; m <<= 1) { float ov = XOR8(m1, m); int oa = XOR8(a1, m); if (ov > m1 || (ov == m1 && oa < a1)) { m1 = ov; a1 = oa; } }
    float m2 = (lane == a1) ? -3.0e38f : sel;
#pragma unroll
    for (int m = 1; m <= 4; m <<= 1) m2 = fmaxf(m2, XOR8(m2, m));
    const float gs = m1 + m2; const int grp = lane >> 3;
    int grank = 0;
#pragma unroll
    for (int g2 = 0; g2 < 8; ++g2) { float og = SHFL_CONST(gs, g2 * 8); grank += (og > gs || (og == gs && g2 < grp)) ? 1 : 0; }
    const bool gsel = grank < 4;
    const float msel = gsel ? sel : -3.0e38f;
    int rank = 0;
#pragma unroll
    for (int e = 0; e < 64; ++e) { float ov = SHFL_CONST(msel, e); rank += (ov > msel || (ov == msel && e < lane)) ? 1 : 0; }
    const bool chosen = gsel && rank < 8;
    const float wsum = wave_sum(chosen ? score : 0.f);
    if (chosen) { const float wv = score / wsum * 2.5f;
      const int idx = atomicAdd(&lcnt[64], 1);
      if (idx < P7_MAXE) { const int slot = atomicAdd(&lcnt[lane], 1); etok[idx] = tok * 8 + rank; epos[idx] = lane | (slot << 8); ewt[idx] = wv; }
      else { int pos = atomicAdd(&cnt[lane * 64], 1); ltok[(size_t)lane * NT_ + pos] = tok * 8 + rank; lwt[(size_t)lane * NT_ + pos] = wv; } }
  }
  __syncthreads();
  if (TIDX < 64) { const int c = lcnt[TIDX]; lbase[TIDX] = c ? atomicAdd(&cnt[TIDX * 64], c) : 0; }
  __syncthreads();
  { const int ne = lcnt[64] < P7_MAXE ? lcnt[64] : P7_MAXE;
    for (int i = TIDX; i < ne; i += 256) { const int e = epos[i] & 255, pos = lbase[e] + (epos[i] >> 8);
      ltok[(size_t)e * NT_ + pos] = etok[i]; lwt[(size_t)e * NT_ + pos] = ewt[i]; } }
}

struct MoeMap { int nblk_total; int e; int rb; int cnt; int hoff; };
DEVFN int moe_ntok(int l) { return l == DEPTH_ - 1 ? B_ * SEQ_ : NT_; }
DEVFN int moe_shared_tok(int l, int i) { return l == DEPTH_ - 1 ? (i / SEQ_) * T_ + CTX_ + (i % SEQ_) : i; }
DEVFN void moe_prefix(const Params& p, int l, int* pre) {
  const int* cnt = (const int*)(p.ws + Ws::CNT) + l * 64 * 64;
  __syncthreads();
  if (TIDX < 64) pre[66 + TIDX] = gptr(cnt)[TIDX * 64];
  if (TIDX == 64) pre[66 + 64] = moe_ntok(l);
  __syncthreads();
  if (TIDX == 0) { int s = 0; for (int e = 0; e < 65; ++e) { pre[e] = s; s += (pre[66 + e] + 127) / 128; } pre[65] = s; }
  __syncthreads();
}
DEVFN void phase8(const Params& p, int l, unsigned char* smem) {
  int* pre = (int*)(smem + SM_PRE);
  moe_prefix(p, l, pre);
  const bf16_t* H = (const bf16_t*)(p.ws + Ws::U);
  const bf16_t* W13 = (const bf16_t*)(p.ws + Ws::W13);
  bf16_t* HID = (bf16_t*)(p.ws + Ws::HID);
  const int* ltok = (const int*)(p.ws + Ws::LTOK); const float* lwt = (const float*)(p.ws + Ws::LWT);
  const int total = pre[65];
  for (int u = BIDX; u < total * 2; u += gridDim.x) {
    const int gb = u >> 1, nt = u & 1;
    int e = 0; while (pre[e + 1] <= gb) ++e;
    e = UNI(e);
    const int rb = UNI(gb - pre[e]), cnt = UNI(pre[66 + e]);
    int* tk_s = (int*)(smem + GEMMW_SMEM); float* gw_s = (float*)(tk_s + 128);
    __syncthreads();
    if (TIDX < 128) { const int pos = rb * 128 + TIDX; int tk = -1; float gw = 0.f;
      if (pos < cnt) { tk = e < 64 ? (gptr(ltok)[(size_t)e * NT_ + pos] >> 3) : moe_shared_tok(l, pos); gw = e < 64 ? gptr(lwt)[(size_t)e * NT_ + pos] : 1.f; }
      tk_s[TIDX] = tk; gw_s[TIDX] = gw; }
    __syncthreads();
    gemm_tile_w<1, 1024>(smem, 1024,
      [&](int r) { const int tk = tk_s[r]; return tk >= 0 ? H + (size_t)tk * 1024 : (const bf16_t*)(p.ws + Ws::ZROW); },
      [&](int) { return W13 + ((size_t)e * 512 + nt * 256) * 1024; },
      [&](f32x4 (&acc)[4][8], int, int wr, int wc, int g, int l15) {
        tile_store_bf16<16>(smem, wr, g, l15,
          [&](bf16_t* T, int ldc) {
#pragma unroll
            for (int mi = 0; mi < 4; ++mi)
#pragma unroll
              for (int i = 0; i < 4; ++i) { const int r = wr * 64 + mi * 16 + 4 * g + i;
                const float gw = gw_s[r];
#pragma unroll
                for (int j = 0; j < 4; ++j) T[r * ldc + wc * 64 + j * 16 + l15] = f2bf(siluf_(acc[mi][2 * j][i]) * acc[mi][2 * j + 1][i] * gw); } },
          [&](int row, int c0) { const int pos = rb * 128 + row; return pos < cnt ? HID + ((size_t)gb * 128 + row) * 256 + nt * 128 + c0 : (bf16_t*)nullptr; });
      });
  }
}
DEVFN void phase9(const Params& p, int l, unsigned char* smem) {
  int* pre = (int*)(smem + SM_PRE);
  moe_prefix(p, l, pre);
  const bf16_t* HID = (const bf16_t*)(p.ws + Ws::HID);
  const bf16_t* W2T = (const bf16_t*)(p.ws + Ws::W2T);
  bf16_t* YB = (bf16_t*)(p.ws + Ws::YBUF);
  const int* ltok = (const int*)(p.ws + Ws::LTOK);
  const int total = pre[65];
  for (int u = BIDX; u < total * 2; u += gridDim.x) {
    const int gb = u >> 1, ntp = u & 1;
    int e = 0; while (pre[e + 1] <= gb) ++e;
    e = UNI(e);
    const int rb = UNI(gb - pre[e]), cnt = UNI(pre[66 + e]);
    int* ts_s = (int*)(smem + GEMMW_SMEM);
    __syncthreads();
    if (TIDX < 128) { const int pos = rb * 128 + TIDX; int ts = -1;
      if (pos < cnt) ts = e < 64 ? gptr(ltok)[(size_t)e * NT_ + pos] : moe_shared_tok(l, pos) * 8;
      ts_s[TIDX] = ts; }
    __syncthreads();
    gemm_tile_w<2, 256>(smem, 256,
      [&](int r) { return ts_s[r] >= 0 ? HID + ((size_t)gb * 128 + r) * 256 : (const bf16_t*)(p.ws + Ws::ZROW); },
      [&](int j) { return W2T + ((size_t)e * 1024 + (ntp * 2 + j) * 256) * 256; },
      [&](f32x4 (&acc)[4][8], int j, int wr, int wc, int g, int l15) { const int nt = ntp * 2 + j;
#pragma unroll 1
        for (int h = 0; h < 2; ++h)
          tile_store_bf16<16>(smem, wr, g, l15,
            [&](bf16_t* T, int ldc) {
              if (wc == h) {
#pragma unroll
                for (int mi = 0; mi < 4; ++mi)
#pragma unroll
                  for (int ni = 0; ni < 8; ++ni)
#pragma unroll
                    for (int i = 0; i < 4; ++i) T[(wr * 64 + mi * 16 + 4 * g + i) * ldc + ni * 16 + l15] = f2bf(acc[mi][ni][i]); } },
            [&](int row, int c0) { const int ts = ts_s[row]; if (ts < 0) return (bf16_t*)nullptr;
              const int tok = ts >> 3, slot = e < 64 ? (ts & 7) : 8;
              return YB + ((size_t)tok * NSLOT + slot) * 1024 + nt * 256 + h * 128 + c0; });
      });
  }
}

#define SMEM_BYTES (PH_SMEM + 2048)
#define N_PHASES (3 + 13 * DEPTH_)
__global__ void __launch_bounds__(256, 2) mega(Params p, int ph_lo, int ph_hi) {
#ifdef HIPEMU
  unsigned char* smem = hipemu::cur_smem();
#else
  unsigned char* smem = smem_dyn;
  volatile LAS unsigned* st = (volatile LAS unsigned*)(smem_dyn + SM_BAR);
  if (threadIdx.x == 0) {
    st[0] = 0u; st[1] = 0u;
    unsigned long long* tab = (unsigned long long*)(smem_dyn + SM_TAB);
#pragma unroll
    for (int i = 0; i < 40; ++i) tab[i] = (unsigned long long)p.in[i];
  }
  __syncthreads();
  XcdBarrier bar = xcd_barrier_post((unsigned*)(p.ws + Ws::BAR), st);
#define GRID_SYNC() xcd_barrier(bar)
#endif
  int ph = 0;
#ifdef ONLY_KIND
#define KIND_ON(k) ((k) == ONLY_KIND)
#else
#define KIND_ON(k) 1
#endif
#ifndef REPEAT_MASK
#define REPEAT_MASK 0u
#endif
#define RUN_PHASE(kind, code) { if (KIND_ON(kind) && ph >= ph_lo && ph < ph_hi) { \
    int nrep_ = ((REPEAT_MASK >> (kind)) & 1u) ? 2 : 1; LAUNDER(nrep_); \
    _Pragma("unroll 1") for (int rep_ = 0; rep_ < nrep_; ++rep_) { LAUNDER(p.ws); LAUNDER(p.out); code; if (rep_ + 1 < nrep_ || ph + 1 < ph_hi) { GRID_SYNC(); } } } ++ph; }
  RUN_PHASE(0, phase0(p, smem));
  RUN_PHASE(11, phase0b(p));
  for (int l = 0; l < DEPTH_; ++l) {
    RUN_PHASE(1, phase1(p, l));
    RUN_PHASE(2, phase2(p, l, smem));
    RUN_PHASE(3, phase3(p, l, smem));
    RUN_PHASE(14, phase3b(p, l, smem));
    RUN_PHASE(4, phase4a(p, l, smem));
    RUN_PHASE(12, phase4b(p, l, smem));
    RUN_PHASE(16, phase4b2(p));
    RUN_PHASE(13, phase4c(p, l, smem));
    RUN_PHASE(5, phase5(p, l, smem));
    RUN_PHASE(6, phase6(p, l, smem));
    RUN_PHASE(7, phase7(p, l, smem));
    RUN_PHASE(8, phase8(p, l, smem));
    RUN_PHASE(9, phase9(p, l, smem));
  }
  RUN_PHASE(10, phase_final(p));
}

extern "C" void kernel_launch(void* const* d_in, const int* in_sizes, int n_in, void* d_out, int out_size, void* d_ws, size_t ws_size, hipStream_t stream) {
  Params p{};
  for (int i = 0; i < 40; ++i) p.in[i] = (const float*)d_in[i];
  p.out = (float*)d_out;
  p.ws = (unsigned char*)d_ws;
  if (ws_size < Ws::END) { fprintf(stderr, "workspace too small: %zu < %zu\n", ws_size, (size_t)Ws::END); return; }
  hipMemsetAsync(d_ws, 0, Ws::ZERO_END, stream);
#ifdef HIPEMU
  int grid = 16; if (const char* e = getenv("EMU_GRID")) grid = atoi(e);
  int stop = N_PHASES; if (const char* e = getenv("EMU_STOP")) stop = atoi(e);
  if (getenv("EMU_ONE")) hipemu::launch(grid, 256, SMEM_BYTES, true, [=] { mega(p, 0, stop); });
  else for (int ph = 0; ph < stop; ++ph) hipemu::launch(grid, 256, SMEM_BYTES, false, [=] { mega(p, ph, ph + 1); });
#else
  static int grid = 0;
  if (!grid) {
    int dev = 0, cus = 0, per_cu = 0;
    hipGetDevice(&dev);
    hipDeviceGetAttribute(&cus, hipDeviceAttributeMultiprocessorCount, dev);
    hipOccupancyMaxActiveBlocksPerMultiprocessor(&per_cu, mega, 256, SMEM_BYTES);
    if (per_cu > 2) per_cu = 2;
    if (per_cu < 1) per_cu = 1;
    grid = cus * per_cu;
  }
#if N_LAUNCH_MODE == 1
  mega<<<grid, 256, SMEM_BYTES, stream>>>(p, 0, N_PHASES);
#else
  for (int ph = 0; ph < N_PHASES; ++ph) mega<<<grid, 256, SMEM_BYTES, stream>>>(p, ph, ph + 1);
#endif
#endif
}
```

```cpp
#ifndef HIPEMU
#include <hip/hip_runtime.h>
#endif
#include <stdint.h>
#include <stdio.h>

#ifndef B_
#define B_ 4
#endif
#ifndef SEQ_
#define SEQ_ 4096
#endif
#ifndef CTX_
#define CTX_ 256
#endif
#ifndef DEPTH_
#define DEPTH_ 4
#endif
#ifndef N_LAUNCH_MODE
#define N_LAUNCH_MODE 1
#endif
#define T_ (SEQ_ + CTX_)
#define NT_ (B_ * T_)
#define D_ 1024
#define NIN_ 3504
#define NMOD_ 6144
#define NR_ (B_ + 1)
#define OZ 0
#define OXBC 512
#define ODT 1536
#define ORW 1552
#define OGQ 2704
#define OGK 2832
#define OGV 2960
#define OGD 3216
#define OOG 3248
#define ALPHA_ 1.681792830507429f
#define NEXP 64
#define NSLOT 9
#define NC128 (T_ / 128)
#define NC64 (T_ / 64)
#define NC16 (T_ / 16)

#define DEVFN __device__ __forceinline__
#define LDT 72
#define GEMM_SMEM (2 * 128 * LDT * 2)
#define GEMMW_SMEM (3 * 128 * LDT * 2)
typedef unsigned short bf16_t;
#ifdef HIPEMU
#define AS1
#else
#define AS1 __attribute__((address_space(1)))
#endif
typedef unsigned u32x4 __attribute__((ext_vector_type(4)));
typedef unsigned u32x2 __attribute__((ext_vector_type(2)));

#ifdef HIPEMU
typedef emu_bf16x8 bf16x8;
typedef emu_f32x4 f32x4;
#define MFMA16(a, b, c) emu_mfma_16x16x32_bf16(a, b, c)
#define MFMA16K16(a, b, c) emu_mfma_16x16x16_bf16(a, b, c)
#define GRID_SYNC() hipemu::grid_sync()
#else
typedef short bf16x8 __attribute__((ext_vector_type(8)));
typedef float f32x4 __attribute__((ext_vector_type(4)));
#define MFMA16(a, b, c) __builtin_amdgcn_mfma_f32_16x16x32_bf16(a, b, c, 0, 0, 0)
#define MFMA16K16(a, b, c) __builtin_amdgcn_mfma_f32_16x16x16bf16_1k(a, b, c, 0, 0, 0)
#endif

DEVFN float bf2f(bf16_t h) { return __builtin_bit_cast(float, (unsigned)h << 16); }
#ifdef HIPEMU
DEVFN bf16_t f2bf(float f) { unsigned u = __builtin_bit_cast(unsigned, f); u += 0x7FFFu + ((u >> 16) & 1u); return (bf16_t)(u >> 16); }
#else
DEVFN bf16_t f2bf(float f) { return __builtin_bit_cast(unsigned short, (__bf16)f); }
#endif
#define FP8_SCALE 64.f
#ifdef HIPEMU
DEVFN unsigned emu_f2fp8(float x) {
  unsigned sgn = x < 0.f ? 0x80u : 0u; float a = fabsf(x);
  if (!(a == a)) return sgn | 0x7Fu;
  if (a >= 448.f) return sgn | 0x7Eu;
  if (a < 0.0009765625f) return sgn;
  int e; float m = frexpf(a, &e); m *= 2.f; e -= 1;
  if (e < -6) { int qv = (int)nearbyintf(a * 512.f); return sgn | (unsigned)qv; }
  int mant = (int)nearbyintf((m - 1.f) * 8.f); if (mant == 8) { mant = 0; e += 1; }
  unsigned bits = ((unsigned)(e + 7) << 3) | (unsigned)mant; if (bits > 0x7Eu) bits = 0x7Eu;
  return sgn | bits;
}
DEVFN float emu_fp82f(unsigned v) { const float sg = (v & 0x80u) ? -1.f : 1.f; const int E = (v >> 3) & 15, M = v & 7; return sg * (E == 0 ? M * 0.001953125f : ldexpf(1.f + M * 0.125f, E - 7)); }
#define FP8PK(a, b) (emu_f2fp8(a) | (emu_f2fp8(b) << 8))
#define FP8DEC(w, k) emu_fp82f(((w) >> (8 * (k))) & 0xFFu)
#else
#define FP8PK(a, b) ((unsigned)__builtin_amdgcn_cvt_pk_fp8_f32((a), (b), 0, false) & 0xFFFFu)
#define FP8DEC(w, k) __builtin_amdgcn_cvt_f32_fp8((int)(w), (k))
#endif
template <class T> DEVFN AS1 T* gptr(T* q) { return (AS1 T*)q; }
DEVFN bf16x8 ld8g(const bf16_t* q) { return *(const AS1 bf16x8*)gptr(q); }
DEVFN float sigmoidf_(float x) { return 1.f / (1.f + expf(-x)); }
DEVFN float siluf_(float x) { return x / (1.f + expf(-x)); }
DEVFN float softplusf_(float x) { return x > 20.f ? x : log1pf(expf(x)); }
DEVFN float logsigmoidf_(float x) { return fminf(x, 0.f) - log1pf(expf(-fabsf(x))); }
#ifdef HIPEMU
DEVFN float wave_sum(float v) { for (int m = 32; m >= 1; m >>= 1) v += __shfl_xor(v, m); return v; }
#define SHFL_CONST(x, ln) __shfl(x, ln)
#define XOR8(x, m) __shfl_xor(x, m)
#define WAVE_SYNC() hipemu::wave_sync()
#define ROWBCAST(v_, n_) __shfl(v_, (int)((TIDX & 48) + (n_)))
#else
template <int CTRL> DEVFN float dpp_f(float v) { return __builtin_bit_cast(float, __builtin_amdgcn_update_dpp(0, __builtin_bit_cast(int, v), CTRL, 0xF, 0xF, false)); }
template <int CTRL> DEVFN int dpp_i(int v) { return __builtin_amdgcn_update_dpp(0, v, CTRL, 0xF, 0xF, false); }
DEVFN float rdl_f(float v, int ln) { return __builtin_bit_cast(float, __builtin_amdgcn_readlane(__builtin_bit_cast(int, v), ln)); }
DEVFN float wave_sum(float v) {
  v += dpp_f<0xB1>(v);
  v += dpp_f<0x4E>(v);
  v += dpp_f<0x141>(v);
  v += dpp_f<0x140>(v);
  return (rdl_f(v, 0) + rdl_f(v, 16)) + (rdl_f(v, 32) + rdl_f(v, 48));
}
DEVFN float shfl_const_(float x, int ln) { return rdl_f(x, ln); }
DEVFN int shfl_const_(int x, int ln) { return __builtin_amdgcn_readlane(x, ln); }
#define SHFL_CONST(x, ln) shfl_const_(x, ln)
DEVFN float xor8_(float x, int m) { return m == 1 ? dpp_f<0xB1>(x) : m == 2 ? dpp_f<0x4E>(x) : dpp_f<0x141>(x); }
DEVFN int xor8_(int x, int m) { return m == 1 ? dpp_i<0xB1>(x) : m == 2 ? dpp_i<0x4E>(x) : dpp_i<0x141>(x); }
#define XOR8(x, m) xor8_(x, m)
#define WAVE_SYNC() __builtin_amdgcn_wave_barrier()
#define ROWBCAST(x, n) dpp_f<0x150 + (n)>(x)
#endif

constexpr size_t al(size_t x) { return (x + 255) & ~(size_t)255; }
struct Ws {
  static constexpr size_t BAR = 0;
  static constexpr size_t CNT = 16384;
  static constexpr size_t MOD = CNT + (size_t)DEPTH_ * 64 * 256;
  static constexpr size_t ZROW = al(MOD + (size_t)DEPTH_ * NR_ * NMOD_ * 4);
  static constexpr size_t ZERO_END = al(ZROW + 2048);
  static constexpr size_t MODP = ZERO_END;
  static constexpr size_t RWT = al(MODP + (size_t)16 * DEPTH_ * NR_ * NMOD_ * 4);
  static constexpr size_t LORA = al(RWT + (size_t)DEPTH_ * 64 * 1024 * 4);
  static constexpr size_t X = al(LORA + (size_t)DEPTH_ * 98304 * 2);
  static constexpr size_t U = al(X + (size_t)NT_ * 1024 * 4);
  static constexpr size_t YMIX = al(U + (size_t)NT_ * 1024 * 2);
  static constexpr size_t ZX = al(YMIX + (size_t)NT_ * 1024 * 2);
  static constexpr size_t MIX = ZX;
  static constexpr size_t LTOK = al(ZX + (size_t)NT_ * NIN_ * 2);
  static constexpr size_t LWT = al(LTOK + (size_t)64 * NT_ * 4);
  static constexpr size_t WIN = al(LWT + (size_t)64 * NT_ * 4);
  static constexpr size_t WOUT = al(WIN + (size_t)DEPTH_ * NIN_ * 1024 * 2);
  static constexpr size_t W13 = al(WOUT + (size_t)DEPTH_ * 1024 * 1024 * 2);
  static constexpr size_t W2T = al(W13 + (size_t)65 * 512 * 1024 * 2);
  static constexpr size_t UNI = al(W2T + (size_t)65 * 1024 * 256 * 2);
  static constexpr size_t XBC = UNI;
  static constexpr size_t XBCT = al(XBC + (size_t)NT_ * 1024 * 2);
  static constexpr size_t DTB = al(XBCT + (size_t)NT_ * 768 * 2);
  static constexpr size_t SST = al(DTB + (size_t)NT_ * 16 * 4);
  static constexpr size_t SCD = al(SST + (size_t)2 * NT_ / 128 * 8 * 8192 * 4);
  static constexpr size_t HIN = al(SCD + (size_t)2 * NT_ / 128 * 8 * 4);
  static constexpr size_t YS = SST;
  static constexpr size_t LA = al(HIN + (size_t)2 * NT_ / 128 * 8 * 8192 * 2);
  static constexpr size_t VT = al(LA + (size_t)2 * NT_ * 128 * 4);
  static constexpr size_t QT = al(VT + (size_t)NT_ * 256 * 2);
  static constexpr size_t OI = al(QT + (size_t)2 * NT_ * 128 * 2);
  static constexpr size_t GST = al(OI + (size_t)NT_ * 256 * 4);
  static constexpr size_t GCD = al(GST + (size_t)2 * NT_ / 64 * 4 * 2048 * 4);
  static constexpr size_t GSIN = al(GCD + (size_t)2 * NT_ / 64 * 4 * 32 * 4);
  static constexpr size_t RR = al(GSIN + (size_t)2 * NT_ / 64 * 4 * 2048 * 2);
  static constexpr size_t VV = RR + (size_t)NT_ * 256 * 2;
  static constexpr size_t KK = VV + (size_t)NT_ * 256 * 2;
  static constexpr size_t KD = KK + (size_t)NT_ * 256 * 2;
  static constexpr size_t BD = KD + (size_t)2 * NT_ * 256 * 2;
  static constexpr size_t LW = BD + (size_t)2 * NT_ * 256 * 2;
  static constexpr size_t GATE = LW + (size_t)2 * NT_ * 256 * 4;
  static constexpr size_t YR = GATE + (size_t)NT_ * 256 * 4;
  static constexpr size_t RML = al(YR + (size_t)2 * NT_ * 256 * 4);
  static constexpr size_t RNS = RML + (size_t)(NT_ / 16) * 8 * 4096 * 2;
  static constexpr size_t RWC = RNS + (size_t)(NT_ / 16) * 8 * 4096 * 2;
  static constexpr size_t RG = RWC + (size_t)(NT_ / 16) * 8 * 64 * 4;
  static constexpr size_t RY0 = RG + (size_t)(NT_ / 16) * 8 * 1024 * 2;
  static constexpr size_t LI = RY0 + (size_t)(NT_ / 16) * 8 * 1024 * 4;
  static constexpr size_t KRW = LI + (size_t)NT_ * 384 * 2;
  static constexpr size_t MIXER_END = KRW + (size_t)NT_ * 256 * 2;
  static constexpr size_t HID = UNI;
  static constexpr size_t YBUF = al(HID + ((size_t)NT_ * 9 + 65 * 128) * 256 * 2);
  static constexpr size_t MOE_END = YBUF + (size_t)NT_ * 9 * 1024 * 2;
  static constexpr size_t END = al(MIXER_END > MOE_END ? MIXER_END : MOE_END);
};

struct Params {
  const float* in[40];
  float* out;
  unsigned char* ws;
};
enum { I_X = 0, I_C, I_CTX, I_CCTX, I_ADAW, I_ADAB, I_WIN, I_CONVW, I_CONVB, I_DTBIAS, I_ALOG, I_SSDD, I_SSDNW, I_MU, I_W0, I_W2, I_A0, I_A2,
       I_G2, I_KKW, I_KAW, I_RK, I_LNXW, I_LNXB, I_GU, I_GB, I_GNW, I_WOUT, I_LN1W, I_LN1B, I_LN2W, I_LN2B, I_RW, I_RB, I_EW1, I_EW3, I_EW2,
       I_SW1, I_SW3, I_SW2 };

#define PH_SMEM 57344
#define SM_PRE (PH_SMEM)
#define SM_TAB (PH_SMEM + 1024)
#define SM_BAR (PH_SMEM + 2032)
#ifdef HIPEMU
#define INP(i) (p.in[i])
#define LAUNDER(x)
#define TIDX ((int)threadIdx.x)
#define BIDX ((int)blockIdx.x)
#define LAUNDER_V(x)
#define UNI(x) (x)
#else
extern __shared__ __align__(16) unsigned char smem_dyn[];
DEVFN const float* inp_lds(int i) {
  const volatile unsigned* t = (const volatile unsigned*)(smem_dyn + SM_TAB) + 2 * i;
  unsigned lo = __builtin_amdgcn_readfirstlane(t[0]), hi = __builtin_amdgcn_readfirstlane(t[1]);
  return (const float*)(((unsigned long long)hi << 32) | lo);
}
#define INP(i) inp_lds(i)
#define LAUNDER(x) asm volatile("" : "+s"(x))
DEVFN int tidx_() { int t = threadIdx.x; asm volatile("" : "+v"(t)); return t; }
DEVFN int bidx_() { int b = blockIdx.x; asm volatile("" : "+s"(b)); return b; }
#define TIDX tidx_()
#define LAUNDER_V(x) asm volatile("" : "+v"(x))
#define BIDX bidx_()
#define UNI(x) __builtin_amdgcn_readfirstlane(x)
#endif
#ifndef HIPEMU
#define XB_TMO      128
#define XB_XCNT(j)  (256  + 64 * (j))
#define XB_XSUB(j)  (1280 + 64 * (j))
#define XB_XGEN(j)  (2304 + 64 * (j))
#define XB_TOP      3328
#define XB_TOPGEN   3392
#define XCD_BAR_WORDS 3456
#define XB_SPIN_CAP (1u << 22)
#define LAS __attribute__((address_space(3)))
__device__ __forceinline__ unsigned xb_ld(unsigned* p)              { return __hip_atomic_load(p, __ATOMIC_RELAXED, __HIP_MEMORY_SCOPE_AGENT); }
__device__ __forceinline__ unsigned xb_add(unsigned* p, unsigned v) { return __hip_atomic_fetch_add(p, v, __ATOMIC_RELAXED, __HIP_MEMORY_SCOPE_AGENT); }
__device__ __forceinline__ unsigned xb_xcc_id() { return (unsigned)__builtin_amdgcn_s_getreg((3 << 11) | 20) & 0xFu; }
#define XB_SPIN(cond, bar) do { unsigned _sp = 0; while (cond) { __builtin_amdgcn_s_sleep(1); \
    if ((++_sp & 255u) == 0u) { if (xb_ld(&(bar)[XB_TMO])) break; if (_sp > XB_SPIN_CAP) { atomicAdd(&(bar)[XB_TMO], 1u); break; } } } } while (0)
struct XcdBarrier { unsigned* bar; unsigned x; volatile LAS unsigned* st; };
__device__ __forceinline__ XcdBarrier xcd_barrier_post(unsigned* bar, volatile LAS unsigned* st) {
    XcdBarrier b; b.bar = bar; b.x = xb_xcc_id(); b.st = st;
    if (threadIdx.x == 0) (void)xb_add(&bar[XB_XCNT(b.x)], 1u);
    return b;
}
__device__ __forceinline__ void xcd_barrier_complete(unsigned* bar, unsigned x, unsigned& nloc, unsigned& nx) {
    const unsigned G = gridDim.x * gridDim.y * gridDim.z;
    unsigned sum, cnt, mine, sp = 0u;
    for (;;) {
        sum = 0u; cnt = 0u; mine = 0u;
#pragma unroll
        for (unsigned j = 0; j < 16; ++j) { const unsigned c = xb_ld(&bar[XB_XCNT(j)]); sum += c; cnt += (c > 0u) ? 1u : 0u; mine = (j == x) ? c : mine; }
        if (sum == G) break;
        __builtin_amdgcn_s_sleep(1);
        if ((++sp & 255u) == 0u) { if (xb_ld(&bar[XB_TMO])) break; if (sp > XB_SPIN_CAP) { atomicAdd(&bar[XB_TMO], 1u); break; } }
    }
    nloc = mine > 0u ? mine : 1u; nx = cnt > 0u ? cnt : 1u;
}
__device__ __forceinline__ void xcd_barrier(const XcdBarrier& b) {
    asm volatile("s_waitcnt vmcnt(0)" ::: "memory");
    __syncthreads();
    if (threadIdx.x == 0) {
        unsigned* bar = b.bar;
        __builtin_amdgcn_s_waitcnt(0);
        unsigned nloc = b.st[0], nx = b.st[1];
        if (nloc == 0u) { xcd_barrier_complete(bar, b.x, nloc, nx); b.st[0] = nloc; b.st[1] = nx; }
        const unsigned old = xb_add(&bar[XB_XSUB(b.x)], 1u);
        const unsigned gen = old / nloc;
        if (old + 1u == (gen + 1u) * nloc) {
            __builtin_amdgcn_fence(__ATOMIC_RELEASE, "agent");
            asm volatile("s_waitcnt vmcnt(0)" ::: "memory");
            const unsigned og = xb_add(&bar[XB_TOP], 1u);
            const unsigned tg = og / nx;
            if (og + 1u == (tg + 1u) * nx) xb_add(&bar[XB_TOPGEN], 1u);
            else XB_SPIN(xb_ld(&bar[XB_TOPGEN]) == tg, bar);
            __builtin_amdgcn_fence(__ATOMIC_ACQUIRE, "agent");
            xb_add(&bar[XB_XGEN(b.x)], 1u);
            asm volatile("s_waitcnt vmcnt(0)" ::: "memory");
        } else {
            XB_SPIN(xb_ld(&bar[XB_XGEN(b.x)]) == gen, bar);
            __builtin_amdgcn_fence(__ATOMIC_ACQUIRE, "agent");
            asm volatile("s_waitcnt vmcnt(0)" ::: "memory");
        }
    }
    __syncthreads();
}
#endif

DEVFN int tokmap(int dir, int p) { return dir == 0 ? p : (p < CTX_ ? CTX_ - 1 - p : 2 * CTX_ + SEQ_ - 1 - p); }
DEVFN const float* tok_input_row(const Params& p, int tok) {
  int b = tok / T_, t = tok % T_;
  return t < CTX_ ? INP(I_CTX) + ((size_t)b * CTX_ + t) * D_ : INP(I_X) + ((size_t)b * SEQ_ + (t - CTX_)) * D_;
}
DEVFN int tok_modrow(int tok) { return (tok % T_) < CTX_ ? B_ : tok / T_; }

template <class ARow, class BRow, class Epi>
DEVFN void gemm_tile(unsigned char* smem, int K, ARow arow, BRow brow, Epi epi) {
  bf16_t* As = (bf16_t*)smem;
  bf16_t* Bs = As + 128 * LDT;
  const int tid = TIDX, lane = tid & 63, wave = tid >> 6, wr = wave >> 1, wc = wave & 1;
  const int g = lane >> 4, l15 = lane & 15;
  const int lr = tid >> 3, lc = (tid & 7) * 8;
  const AS1 bf16_t* ap[4];
  const AS1 bf16_t* bp[4];
#pragma unroll
  for (int i = 0; i < 4; ++i) { ap[i] = gptr(arow(lr + 32 * i)); bp[i] = gptr(brow(lr + 32 * i)); }
  f32x4 acc[4][4];
#pragma unroll
  for (int mi = 0; mi < 4; ++mi)
#pragma unroll
    for (int ni = 0; ni < 4; ++ni) acc[mi][ni] = f32x4{0.f, 0.f, 0.f, 0.f};
  u32x4 ra0[4], rb0[4], ra1[4], rb1[4];
#pragma unroll
  for (int i = 0; i < 4; ++i) { ra0[i] = *(const AS1 u32x4*)(ap[i] + lc); rb0[i] = *(const AS1 u32x4*)(bp[i] + lc); }
  if (K > 64) {
#pragma unroll
    for (int i = 0; i < 4; ++i) { ra1[i] = *(const AS1 u32x4*)(ap[i] + 64 + lc); rb1[i] = *(const AS1 u32x4*)(bp[i] + 64 + lc); } }
  auto compute = [&]() {
#pragma unroll
    for (int kk = 0; kk < 2; ++kk) {
      bf16x8 af[4], bfr[4];
#pragma unroll
      for (int mi = 0; mi < 4; ++mi) af[mi] = *(const bf16x8*)(As + (wr * 64 + mi * 16 + l15) * LDT + kk * 32 + g * 8);
#pragma unroll
      for (int ni = 0; ni < 4; ++ni) bfr[ni] = *(const bf16x8*)(Bs + (wc * 64 + ni * 16 + l15) * LDT + kk * 32 + g * 8);
#pragma unroll
      for (int mi = 0; mi < 4; ++mi)
#pragma unroll
        for (int ni = 0; ni < 4; ++ni) acc[mi][ni] = MFMA16(af[mi], bfr[ni], acc[mi][ni]);
    } };
  for (int k0 = 0; k0 < K; k0 += 128) {
    __syncthreads();
#pragma unroll
    for (int i = 0; i < 4; ++i) { *(u32x4*)(As + (lr + 32 * i) * LDT + lc) = ra0[i]; *(u32x4*)(Bs + (lr + 32 * i) * LDT + lc) = rb0[i]; }
    __syncthreads();
    if (k0 + 128 < K) {
#pragma unroll
      for (int i = 0; i < 4; ++i) { ra0[i] = *(const AS1 u32x4*)(ap[i] + k0 + 128 + lc); rb0[i] = *(const AS1 u32x4*)(bp[i] + k0 + 128 + lc); } }
    compute();
    if (k0 + 64 < K) {
      __syncthreads();
#pragma unroll
      for (int i = 0; i < 4; ++i) { *(u32x4*)(As + (lr + 32 * i) * LDT + lc) = ra1[i]; *(u32x4*)(Bs + (lr + 32 * i) * LDT + lc) = rb1[i]; }
      __syncthreads();
      if (k0 + 192 < K) {
#pragma unroll
        for (int i = 0; i < 4; ++i) { ra1[i] = *(const AS1 u32x4*)(ap[i] + k0 + 192 + lc); rb1[i] = *(const AS1 u32x4*)(bp[i] + k0 + 192 + lc); } }
      compute();
    }
  }
  epi(acc, wr, wc, g, l15);
}

template <int NB, class ARow, class BRow, class Epi>
DEVFN void gemm_tile_multi(unsigned char* smem, int K, ARow arow, BRow brow, Epi epi) {
  bf16_t* As = (bf16_t*)smem;
  bf16_t* Bs = As + 128 * LDT;
  const int tid = TIDX, lane = tid & 63, wave = tid >> 6, wr = wave >> 1, wc = wave & 1;
  const int g = lane >> 4, l15 = lane & 15;
  const int lr = tid >> 3, lc = (tid & 7) * 8;
  const AS1 bf16_t* ap[4];
  const AS1 bf16_t* bp[4];
#pragma unroll
  for (int i = 0; i < 4; ++i) { ap[i] = gptr(arow(lr + 32 * i)); bp[i] = gptr(brow(lr + 32 * i, 0)); }
  f32x4 acc[4][4];
  u32x4 ra0[4], rb0[4], ra1[4], rb1[4];
#pragma unroll
  for (int i = 0; i < 4; ++i) { ra0[i] = *(const AS1 u32x4*)(ap[i] + lc); rb0[i] = *(const AS1 u32x4*)(bp[i] + lc); }
  if (K > 64) {
#pragma unroll
    for (int i = 0; i < 4; ++i) { ra1[i] = *(const AS1 u32x4*)(ap[i] + 64 + lc); rb1[i] = *(const AS1 u32x4*)(bp[i] + 64 + lc); } }
  auto compute = [&]() {
#pragma unroll
    for (int kk = 0; kk < 2; ++kk) {
      bf16x8 af[4], bfr[4];
#pragma unroll
      for (int mi = 0; mi < 4; ++mi) af[mi] = *(const bf16x8*)(As + (wr * 64 + mi * 16 + l15) * LDT + kk * 32 + g * 8);
#pragma unroll
      for (int ni = 0; ni < 4; ++ni) bfr[ni] = *(const bf16x8*)(Bs + (wc * 64 + ni * 16 + l15) * LDT + kk * 32 + g * 8);
#pragma unroll
      for (int mi = 0; mi < 4; ++mi)
#pragma unroll
        for (int ni = 0; ni < 4; ++ni) acc[mi][ni] = MFMA16(af[mi], bfr[ni], acc[mi][ni]);
    } };
#pragma unroll
  for (int j = 0; j < NB; ++j) {
#pragma unroll
  for (int mi = 0; mi < 4; ++mi)
#pragma unroll
    for (int ni = 0; ni < 4; ++ni) acc[mi][ni] = f32x4{0.f, 0.f, 0.f, 0.f};
  for (int k0 = 0; k0 < K; k0 += 128) {
    __syncthreads();
#pragma unroll
    for (int i = 0; i < 4; ++i) { *(u32x4*)(As + (lr + 32 * i) * LDT + lc) = ra0[i]; *(u32x4*)(Bs + (lr + 32 * i) * LDT + lc) = rb0[i]; }
    __syncthreads();
    if (k0 + 128 < K) {
#pragma unroll
      for (int i = 0; i < 4; ++i) { ra0[i] = *(const AS1 u32x4*)(ap[i] + k0 + 128 + lc); rb0[i] = *(const AS1 u32x4*)(bp[i] + k0 + 128 + lc); } }
    compute();
    if (k0 + 64 < K) {
      __syncthreads();
#pragma unroll
      for (int i = 0; i < 4; ++i) { *(u32x4*)(As + (lr + 32 * i) * LDT + lc) = ra1[i]; *(u32x4*)(Bs + (lr + 32 * i) * LDT + lc) = rb1[i]; }
      __syncthreads();
      if (k0 + 192 < K) {
#pragma unroll
        for (int i = 0; i < 4; ++i) { ra1[i] = *(const AS1 u32x4*)(ap[i] + k0 + 192 + lc); rb1[i] = *(const AS1 u32x4*)(bp[i] + k0 + 192 + lc); } }
      compute();
    }
  }
  if (j + 1 < NB) {
#pragma unroll
    for (int i = 0; i < 4; ++i) { bp[i] = gptr(brow(lr + 32 * i, j + 1)); ra0[i] = *(const AS1 u32x4*)(ap[i] + lc); rb0[i] = *(const AS1 u32x4*)(bp[i] + lc); } }
  epi(acc, j, wr, wc, g, l15);
  if (j + 1 < NB) {
#pragma unroll
    for (int i = 0; i < 4; ++i) { ra1[i] = *(const AS1 u32x4*)(ap[i] + 64 + lc); rb1[i] = *(const AS1 u32x4*)(bp[i] + 64 + lc); } }
  }
}

template <int NB, int LDB, class ARow, class BBase, class Epi>
DEVFN void gemm_tile_w(unsigned char* smem, int K, ARow arow, BBase bbase, Epi epi) {
  bf16_t* As = (bf16_t*)smem;
  bf16_t* Bs = As + 128 * LDT;
  const int tid = TIDX, lane = tid & 63, wave = tid >> 6, wr = wave >> 1, wc = wave & 1;
  const int g = lane >> 4, l15 = lane & 15;
  const int lr = tid >> 3, lc = (tid & 7) * 8;
  const AS1 bf16_t* ap[4];
#pragma unroll
  for (int i = 0; i < 4; ++i) ap[i] = gptr(arow(lr + 32 * i));
  const AS1 bf16_t* bb = gptr(bbase(0));
  const unsigned boff = (unsigned)(lr * LDB + lc);
  f32x4 acc[4][8];
  u32x4 ra[4], rb[8];
#pragma unroll
  for (int i = 0; i < 4; ++i) ra[i] = *(const AS1 u32x4*)(ap[i] + lc);
#pragma unroll
  for (int i = 0; i < 8; ++i) rb[i] = *(const AS1 u32x4*)(bb + (size_t)(i * 32 * LDB) + boff);
#pragma unroll
  for (int j = 0; j < NB; ++j) {
#pragma unroll
    for (int mi = 0; mi < 4; ++mi)
#pragma unroll
      for (int ni = 0; ni < 8; ++ni) acc[mi][ni] = f32x4{0.f, 0.f, 0.f, 0.f};
#pragma unroll 1
    for (int k0 = 0; k0 < K; k0 += 64) {
      __syncthreads();
#pragma unroll
      for (int i = 0; i < 4; ++i) *(u32x4*)(As + (lr + 32 * i) * LDT + lc) = ra[i];
#pragma unroll
      for (int i = 0; i < 8; ++i) *(u32x4*)(Bs + (lr + 32 * i) * LDT + lc) = rb[i];
      __syncthreads();
      if (k0 + 64 < K) {
#pragma unroll
        for (int i = 0; i < 4; ++i) ra[i] = *(const AS1 u32x4*)(ap[i] + k0 + 64 + lc);
#pragma unroll
        for (int i = 0; i < 8; ++i) rb[i] = *(const AS1 u32x4*)(bb + (size_t)(i * 32 * LDB + k0 + 64) + boff);
      }
#pragma unroll
      for (int kk = 0; kk < 2; ++kk) {
        bf16x8 af[4];
#pragma unroll
        for (int mi = 0; mi < 4; ++mi) af[mi] = *(const bf16x8*)(As + (wr * 64 + mi * 16 + l15) * LDT + kk * 32 + g * 8);
#pragma unroll
        for (int h = 0; h < 2; ++h) {
          bf16x8 bfr[4];
#pragma unroll
          for (int ni = 0; ni < 4; ++ni) bfr[ni] = *(const bf16x8*)(Bs + (wc * 128 + h * 64 + ni * 16 + l15) * LDT + kk * 32 + g * 8);
#pragma unroll
          for (int mi = 0; mi < 4; ++mi)
#pragma unroll
            for (int ni = 0; ni < 4; ++ni) acc[mi][h * 4 + ni] = MFMA16(af[mi], bfr[ni], acc[mi][h * 4 + ni]);
        }
      }
    }
    if (j + 1 < NB) {
      bb = gptr(bbase(j + 1));
#pragma unroll
      for (int i = 0; i < 4; ++i) ra[i] = *(const AS1 u32x4*)(ap[i] + lc);
#pragma unroll
      for (int i = 0; i < 8; ++i) rb[i] = *(const AS1 u32x4*)(bb + (size_t)(i * 32 * LDB) + boff); }
    epi(acc, j, wr, wc, g, l15);
  }
}

template <int NCH, class Val, class RowP>
DEVFN void tile_store_bf16(unsigned char* smem, int wr, int g, int l15, Val val, RowP rowp) {
  constexpr int LDC = NCH * 8 + 8;
  bf16_t* T = (bf16_t*)smem;
  const int tid = TIDX;
  __syncthreads();
  val(T, LDC);
  __syncthreads();
#pragma unroll
  for (int pass = 0; pass < NCH / 2; ++pass) { const int id = tid + 256 * pass, row = id / NCH, c = id % NCH;
    bf16_t* dst = rowp(row, c * 8);
    if (dst) *(AS1 u32x4*)gptr(dst) = *(const u32x4*)(T + row * LDC + c * 8); }
  (void)wr; (void)g; (void)l15;
}
DEVFN void cvt_tile(unsigned char* smem, const float* src, int K, int N, int k0, int n0, bf16_t* dst, int ldd, int mode) {
  float* s = (float*)smem;
  const int tid = TIDX;
  const AS1 float* gsrc = gptr(src);
  __syncthreads();
  { const int kk = tid >> 4, n4 = (tid & 15) * 4;
#pragma unroll
    for (int pass = 0; pass < 4; ++pass) { const int k = kk + 16 * pass;
      f32x4 v = f32x4{0.f, 0.f, 0.f, 0.f};
      if (n0 + n4 < N) v = *(const AS1 f32x4*)(gsrc + (size_t)(k0 + k) * N + n0 + n4);
      s[k * 65 + n4] = v[0]; s[k * 65 + n4 + 1] = v[1]; s[k * 65 + n4 + 2] = v[2]; s[k * 65 + n4 + 3] = v[3]; } }
  __syncthreads();
  { const int nn = tid >> 2, k16 = (tid & 3) * 16, n = n0 + nn;
    if (n < N) { const int row = mode == 0 ? n : ((n >> 4) * 32 + (n & 15) + (mode == 2 ? 16 : 0));
      u32x4 o0, o1;
#pragma unroll
      for (int j = 0; j < 4; ++j) { o0[j] = (unsigned)f2bf(s[(k16 + 2 * j) * 65 + nn]) | ((unsigned)f2bf(s[(k16 + 2 * j + 1) * 65 + nn]) << 16);
        o1[j] = (unsigned)f2bf(s[(k16 + 8 + 2 * j) * 65 + nn]) | ((unsigned)f2bf(s[(k16 + 9 + 2 * j) * 65 + nn]) << 16); }
      AS1 bf16_t* d = gptr(dst) + (size_t)row * ldd + k0 + k16;
      *(AS1 u32x4*)d = o0; *(AS1 u32x4*)(d + 8) = o1; } }
  (void)K;
}
struct CvtJob { const float* src; bf16_t* dst; int N, k0, n0, ldd, mode; };
DEVFN void cvt_load(const CvtJob& j, f32x4 (&v)[4]) {
  const int tid = TIDX, kk = tid >> 4, n4 = (tid & 15) * 4;
  const AS1 float* g = gptr(j.src);
#pragma unroll
  for (int pass = 0; pass < 4; ++pass) { v[pass] = f32x4{0.f, 0.f, 0.f, 0.f};
    if (j.n0 + n4 < j.N) v[pass] = *(const AS1 f32x4*)(g + (size_t)(j.k0 + kk + 16 * pass) * j.N + j.n0 + n4); }
}
DEVFN void cvt_store(unsigned char* smem, const CvtJob& j, const f32x4 (&v)[4]) {
  float* s = (float*)smem;
  const int tid = TIDX, kk = tid >> 4, n4 = (tid & 15) * 4;
  __syncthreads();
#pragma unroll
  for (int pass = 0; pass < 4; ++pass) { const int k = kk + 16 * pass; s[k * 65 + n4] = v[pass][0]; s[k * 65 + n4 + 1] = v[pass][1]; s[k * 65 + n4 + 2] = v[pass][2]; s[k * 65 + n4 + 3] = v[pass][3]; }
  __syncthreads();
  const int nn = tid >> 2, k16 = (tid & 3) * 16, n = j.n0 + nn;
  if (n < j.N) { const int row = j.mode == 0 ? n : ((n >> 4) * 32 + (n & 15) + (j.mode == 2 ? 16 : 0));
    u32x4 o0, o1;
#pragma unroll
    for (int q = 0; q < 4; ++q) { o0[q] = (unsigned)f2bf(s[(k16 + 2 * q) * 65 + nn]) | ((unsigned)f2bf(s[(k16 + 2 * q + 1) * 65 + nn]) << 16);
      o1[q] = (unsigned)f2bf(s[(k16 + 8 + 2 * q) * 65 + nn]) | ((unsigned)f2bf(s[(k16 + 9 + 2 * q) * 65 + nn]) << 16); }
    AS1 bf16_t* d = gptr(j.dst) + (size_t)row * j.ldd + j.k0 + k16;
    *(AS1 u32x4*)d = o0; *(AS1 u32x4*)(d + 8) = o1; }
}
DEVFN CvtJob moe_cvt_job(const Params& p, int l, int u) {
  bf16_t* w13 = (bf16_t*)(p.ws + Ws::W13); bf16_t* w2t = (bf16_t*)(p.ws + Ws::W2T);
  const int e = u / 192, r = u % 192, which = r / 64, t = r % 64;
  CvtJob j;
  if (which < 2) {
    j.src = e < 64 ? (which == 0 ? INP(I_EW1) : INP(I_EW3)) + ((size_t)l * 64 + e) * 1024 * 256 : (which == 0 ? INP(I_SW1) : INP(I_SW3)) + (size_t)l * 1024 * 256;
    j.N = 256; j.k0 = (t >> 2) * 64; j.n0 = (t & 3) * 64; j.dst = w13 + (size_t)e * 512 * 1024; j.ldd = 1024; j.mode = which == 0 ? 1 : 2;
  } else {
    j.src = e < 64 ? INP(I_EW2) + ((size_t)l * 64 + e) * 256 * 1024 : INP(I_SW2) + (size_t)l * 256 * 1024;
    j.N = 1024; j.k0 = (t >> 4) * 64; j.n0 = (t & 15) * 64; j.dst = w2t + (size_t)e * 1024 * 256; j.ldd = 256; j.mode = 0;
  }
  return j;
}
DEVFN void convert_moe_weights(const Params& p, int l, unsigned char* smem, int bid, int nb, int j_lo, int j_hi) {
  if (j_lo + bid >= j_hi) return;
  f32x4 v[4], vn[4];
  CvtJob j = moe_cvt_job(p, l, j_lo + bid);
  cvt_load(j, v);
  for (int u = j_lo + bid; u < j_hi; u += nb) {
    const int un = u + nb;
    CvtJob jn = j;
    if (un < j_hi) { jn = moe_cvt_job(p, l, un); cvt_load(jn, vn); }
    cvt_store(smem, j, v);
    j = jn;
#pragma unroll
    for (int q = 0; q < 4; ++q) v[q] = vn[q];
  }
}
DEVFN void phase0(const Params& p, unsigned char* smem) {
  const int tid = TIDX;
  float* modp = (float*)(p.ws + Ws::MODP);
  for (int u = BIDX; u < DEPTH_ * 24 * 16; u += gridDim.x) {
    int l = u / (24 * 16), jb = (u / 16) % 24, ks = u % 16;
    float* sc = (float*)smem;
    __syncthreads();
    for (int e = tid; e < NR_ * 64; e += 256) { int r = e / 64, i = ks * 64 + (e % 64); float cv = r < B_ ? INP(I_C)[(size_t)r * D_ + i] : INP(I_CCTX)[i]; sc[e] = siluf_(cv); }
    __syncthreads();
    int j = jb * 256 + tid;
    float acc[NR_];
#pragma unroll
    for (int r = 0; r < NR_; ++r) acc[r] = 0.f;
    const float* w = INP(I_ADAW) + ((size_t)l * D_ + ks * 64) * NMOD_ + j;
#pragma unroll 4
    for (int i = 0; i < 64; ++i) { float wv = w[(size_t)i * NMOD_];
#pragma unroll
      for (int r = 0; r < NR_; ++r) acc[r] += sc[r * 64 + i] * wv; }
#pragma unroll
    for (int r = 0; r < NR_; ++r) modp[(((size_t)ks * DEPTH_ + l) * NR_ + r) * NMOD_ + j] = acc[r];
  }
  bf16_t* win = (bf16_t*)(p.ws + Ws::WIN);
  bf16_t* wout = (bf16_t*)(p.ws + Ws::WOUT);
  for (int u = BIDX; u < DEPTH_ * 16 * 55; u += gridDim.x) {
    int l = u / (16 * 55), r = u % (16 * 55);
    cvt_tile(smem, INP(I_WIN) + (size_t)l * 1024 * NIN_, 1024, NIN_, (r / 55) * 64, (r % 55) * 64, win + (size_t)l * NIN_ * 1024, 1024, 0);
  }
  for (int u = BIDX; u < DEPTH_ * 256; u += gridDim.x) {
    int l = u / 256, r = u % 256;
    cvt_tile(smem, INP(I_WOUT) + (size_t)l * 1024 * 1024, 1024, 1024, (r / 16) * 64, (r % 16) * 64, wout + (size_t)l * 1024 * 1024, 1024, 0);
  }
  { bf16_t* lo = (bf16_t*)(p.ws + Ws::LORA);
    for (int u = BIDX * 256 + tid; u < DEPTH_ * 98304; u += gridDim.x * 256) {
      const int l = u / 98304, r = u % 98304; float v;
      if (r < 32768) { const int d = r >> 14, n = (r >> 6) & 255, k = r & 63; v = INP(I_W2)[(((size_t)l * 2 + d) * 64 + k) * 256 + n]; }
      else if (r < 65536) { const int r2 = r - 32768, d = r2 >> 14, n = (r2 >> 6) & 255, k = r2 & 63; v = INP(I_A2)[(((size_t)l * 2 + d) * 64 + k) * 256 + n]; }
      else { const int r2 = r - 65536, n = r2 >> 7, k = r2 & 127; v = INP(I_G2)[((size_t)l * 128 + k) * 256 + n]; }
      lo[u] = f2bf(v); } }
  float* rwt = (float*)(p.ws + Ws::RWT);
  for (int u = BIDX * 256 + tid; u < DEPTH_ * 64 * 1024; u += gridDim.x * 256) {
    int l = u / (64 * 1024), e = (u / 1024) % 64, i = u % 1024;
    rwt[u] = INP(I_RW)[((size_t)l * 1024 + i) * 64 + e];
  }
}

DEVFN void phase0b(const Params& p) {
  float* mod = (float*)(p.ws + Ws::MOD); const float* modp = (const float*)(p.ws + Ws::MODP);
  for (int u = BIDX * 256 + TIDX; u < DEPTH_ * NR_ * NMOD_; u += gridDim.x * 256) {
    int l = u / (NR_ * NMOD_), j = u % NMOD_;
    float s = INP(I_ADAB)[(size_t)l * NMOD_ + j];
    for (int ks = 0; ks < 16; ++ks) s += modp[(size_t)ks * DEPTH_ * NR_ * NMOD_ + u];
    mod[u] = s;
  }
}

DEVFN void row_stats(const float (&v)[16], float& mean, float& rstd) {
  float s = 0.f;
#pragma unroll
  for (int i = 0; i < 16; ++i) s += v[i];
  mean = wave_sum(s) * (1.f / 1024.f);
  float q = 0.f;
#pragma unroll
  for (int i = 0; i < 16; ++i) { float d = v[i] - mean; q += d * d; }
  rstd = rsqrtf(wave_sum(q) * (1.f / 1024.f) + 1e-5f);
}
DEVFN void load_row16(const float* row, int lane, float (&v)[16]) {
  const AS1 float* r = gptr(row);
#pragma unroll
  for (int j = 0; j < 4; ++j) { const f32x4 t = *(const AS1 f32x4*)(r + lane * 4 + 256 * j); v[4 * j] = t[0]; v[4 * j + 1] = t[1]; v[4 * j + 2] = t[2]; v[4 * j + 3] = t[3]; }
}
DEVFN void load_row16_bf(const bf16_t* row, int lane, float (&v)[16]) {
  const AS1 bf16_t* r = gptr(row);
#pragma unroll
  for (int j = 0; j < 4; ++j) { const u32x2 t = *(const AS1 u32x2*)(r + lane * 4 + 256 * j);
    v[4 * j] = bf2f((bf16_t)(t[0] & 0xFFFF)); v[4 * j + 1] = bf2f((bf16_t)(t[0] >> 16)); v[4 * j + 2] = bf2f((bf16_t)(t[1] & 0xFFFF)); v[4 * j + 3] = bf2f((bf16_t)(t[1] >> 16)); }
}
DEVFN void store_row16_bf(bf16_t* row, int lane, const float (&v)[16]) {
  AS1 bf16_t* r = gptr(row);
#pragma unroll
  for (int j = 0; j < 4; ++j) { u32x2 t; t[0] = (unsigned)f2bf(v[4 * j]) | ((unsigned)f2bf(v[4 * j + 1]) << 16); t[1] = (unsigned)f2bf(v[4 * j + 2]) | ((unsigned)f2bf(v[4 * j + 3]) << 16);
    *(AS1 u32x2*)(r + lane * 4 + 256 * j) = t; }
}
DEVFN void moe_residual_row(const Params& p, int lp, int tok, int lane, float (&xv)[16]) {
  const float* mod = (const float*)(p.ws + Ws::MOD) + ((size_t)lp * NR_ + tok_modrow(tok)) * NMOD_;
  const unsigned char* yb = (const unsigned char*)(p.ws + Ws::YBUF) + (size_t)tok * NSLOT * 1024;
  float g2[16], w[16], b[16];
  load_row16(mod + 5 * 1024, lane, g2);
  load_row16(INP(I_LN2W) + (size_t)lp * 1024, lane, w);
  load_row16(INP(I_LN2B) + (size_t)lp * 1024, lane, b);
  unsigned sl[NSLOT][4];
#pragma unroll
  for (int s = 0; s < NSLOT; ++s)
#pragma unroll
    for (int j = 0; j < 4; ++j) sl[s][j] = *(const AS1 unsigned*)gptr(yb + (size_t)s * 1024 + lane * 4 + 256 * j);
  float f[16];
#pragma unroll
  for (int i = 0; i < 16; ++i) f[i] = 0.f;
#pragma unroll
  for (int s = 0; s < NSLOT; ++s)
#pragma unroll
    for (int j = 0; j < 4; ++j) { const unsigned t = sl[s][j];
      f[4 * j] += FP8DEC(t, 0); f[4 * j + 1] += FP8DEC(t, 1); f[4 * j + 2] += FP8DEC(t, 2); f[4 * j + 3] += FP8DEC(t, 3); }
#pragma unroll
  for (int i = 0; i < 16; ++i) f[i] *= (1.f / FP8_SCALE);
#pragma unroll
  for (int i = 0; i < 16; ++i) xv[i] = ALPHA_ * xv[i] + g2[i] * f[i];
  float mean, rstd;
  row_stats(xv, mean, rstd);
#pragma unroll
  for (int i = 0; i < 16; ++i) xv[i] = (xv[i] - mean) * rstd * w[i] + b[i];
}
DEVFN void p1_finish(float* X, bf16_t* U, int tok, int lane, float (&xv)[16], const float (&sh)[16], const float (&sc)[16]) {
  float mean, rstd;
#pragma unroll
  for (int j = 0; j < 4; ++j) *(AS1 f32x4*)gptr(X + (size_t)tok * 1024 + lane * 4 + 256 * j) = f32x4{xv[4 * j], xv[4 * j + 1], xv[4 * j + 2], xv[4 * j + 3]};
  row_stats(xv, mean, rstd);
#pragma unroll
  for (int j = 0; j < 4; ++j) {
    float u0 = (xv[4 * j] - mean) * rstd * (1.f + sc[4 * j]) + sh[4 * j], u1 = (xv[4 * j + 1] - mean) * rstd * (1.f + sc[4 * j + 1]) + sh[4 * j + 1];
    float u2 = (xv[4 * j + 2] - mean) * rstd * (1.f + sc[4 * j + 2]) + sh[4 * j + 2], u3 = (xv[4 * j + 3] - mean) * rstd * (1.f + sc[4 * j + 3]) + sh[4 * j + 3];
    u32x2 o; o[0] = (unsigned)f2bf(u0) | ((unsigned)f2bf(u1) << 16); o[1] = (unsigned)f2bf(u2) | ((unsigned)f2bf(u3) << 16);
    *(AS1 u32x2*)gptr(U + (size_t)tok * 1024 + lane * 4 + 256 * j) = o;
  }
}
DEVFN void phase1(const Params& p, int l) {
  const int lane = TIDX & 63, wave = TIDX >> 6;
  float* X = (float*)(p.ws + Ws::X);
  bf16_t* U = (bf16_t*)(p.ws + Ws::U);
  const int stride = (int)gridDim.x * 4;
  if (l == 0) {
    for (int tok = BIDX * 4 + wave; tok < NT_; tok += stride) {
      float xv[16], sh[16], sc[16];
      const float* mod = (const float*)(p.ws + Ws::MOD) + ((size_t)l * NR_ + tok_modrow(tok)) * NMOD_;
      load_row16(mod, lane, sh);
      load_row16(mod + 1024, lane, sc);
      load_row16(tok_input_row(p, tok), lane, xv);
      p1_finish(X, U, tok, lane, xv, sh, sc);
    }
    return;
  }
  const int lp = l - 1;
  float w[16], b[16];
  load_row16(INP(I_LN2W) + (size_t)lp * 1024, lane, w);
  load_row16(INP(I_LN2B) + (size_t)lp * 1024, lane, b);
  auto ld = [&](int t, float (&x)[16], unsigned (&sl)[NSLOT][4]) {
    load_row16(X + (size_t)t * 1024, lane, x);
    const unsigned char* yb = (const unsigned char*)(p.ws + Ws::YBUF) + (size_t)t * NSLOT * 1024;
#pragma unroll
    for (int s2 = 0; s2 < NSLOT; ++s2)
#pragma unroll
      for (int j = 0; j < 4; ++j) sl[s2][j] = *(const AS1 unsigned*)gptr(yb + (size_t)s2 * 1024 + lane * 4 + 256 * j); };
  float xc[16], xn[16]; unsigned slc[NSLOT][4], sln[NSLOT][4];
  int tok = BIDX * 4 + wave;
  if (tok < NT_) ld(tok, xc, slc);
  for (; tok < NT_; tok += stride) {
    ld(tok + stride < NT_ ? tok + stride : tok, xn, sln);
    float sh[16], sc[16], g2[16];
    const float* mod = (const float*)(p.ws + Ws::MOD) + ((size_t)l * NR_ + tok_modrow(tok)) * NMOD_;
    const float* modp = (const float*)(p.ws + Ws::MOD) + ((size_t)lp * NR_ + tok_modrow(tok)) * NMOD_;
    load_row16(mod, lane, sh);
    load_row16(mod + 1024, lane, sc);
    load_row16(modp + 5 * 1024, lane, g2);
    float f[16];
#pragma unroll
    for (int i = 0; i < 16; ++i) f[i] = 0.f;
#pragma unroll
    for (int s2 = 0; s2 < NSLOT; ++s2)
#pragma unroll
      for (int j = 0; j < 4; ++j) { const unsigned t = slc[s2][j];
        f[4 * j] += FP8DEC(t, 0); f[4 * j + 1] += FP8DEC(t, 1); f[4 * j + 2] += FP8DEC(t, 2); f[4 * j + 3] += FP8DEC(t, 3); }
    float xv[16];
#pragma unroll
    for (int i = 0; i < 16; ++i) xv[i] = ALPHA_ * xc[i] + g2[i] * (f[i] * (1.f / FP8_SCALE));
    float mean, rstd;
    row_stats(xv, mean, rstd);
#pragma unroll
    for (int i = 0; i < 16; ++i) xv[i] = (xv[i] - mean) * rstd * w[i] + b[i];
    p1_finish(X, U, tok, lane, xv, sh, sc);
#pragma unroll
    for (int i = 0; i < 16; ++i) xc[i] = xn[i];
#pragma unroll
    for (int s2 = 0; s2 < NSLOT; ++s2)
#pragma unroll
      for (int j = 0; j < 4; ++j) slc[s2][j] = sln[s2][j];
  }
}
DEVFN void phase_final(const Params& p) {
  const int lane = TIDX & 63, wave = TIDX >> 6;
  const float* X = (const float*)(p.ws + Ws::X);
  const int lp = DEPTH_ - 1, stride = (int)gridDim.x * 4, NROW = B_ * SEQ_;
  float w[16], b[16];
  load_row16(INP(I_LN2W) + (size_t)lp * 1024, lane, w);
  load_row16(INP(I_LN2B) + (size_t)lp * 1024, lane, b);
  auto ld = [&](int r, float (&x)[16], unsigned (&sl)[NSLOT][4]) {
    const int t = (r / SEQ_) * T_ + CTX_ + (r % SEQ_);
    load_row16(X + (size_t)t * 1024, lane, x);
    const unsigned char* yb = (const unsigned char*)(p.ws + Ws::YBUF) + (size_t)t * NSLOT * 1024;
#pragma unroll
    for (int s2 = 0; s2 < NSLOT; ++s2)
#pragma unroll
      for (int j = 0; j < 4; ++j) sl[s2][j] = *(const AS1 unsigned*)gptr(yb + (size_t)s2 * 1024 + lane * 4 + 256 * j); };
  float xc[16], xn[16]; unsigned slc[NSLOT][4], sln[NSLOT][4];
  int r = BIDX * 4 + wave;
  if (r < NROW) ld(r, xc, slc);
  for (; r < NROW; r += stride) {
    ld(r + stride < NROW ? r + stride : r, xn, sln);
    const int tok = (r / SEQ_) * T_ + CTX_ + (r % SEQ_);
    float g2[16];
    const float* modp = (const float*)(p.ws + Ws::MOD) + ((size_t)lp * NR_ + tok_modrow(tok)) * NMOD_;
    load_row16(modp + 5 * 1024, lane, g2);
    float f[16];
#pragma unroll
    for (int i = 0; i < 16; ++i) f[i] = 0.f;
#pragma unroll
    for (int s2 = 0; s2 < NSLOT; ++s2)
#pragma unroll
      for (int j = 0; j < 4; ++j) { const unsigned t = slc[s2][j];
        f[4 * j] += FP8DEC(t, 0); f[4 * j + 1] += FP8DEC(t, 1); f[4 * j + 2] += FP8DEC(t, 2); f[4 * j + 3] += FP8DEC(t, 3); }
    float xv[16];
#pragma unroll
    for (int i = 0; i < 16; ++i) xv[i] = ALPHA_ * xc[i] + g2[i] * (f[i] * (1.f / FP8_SCALE));
    float mean, rstd;
    row_stats(xv, mean, rstd);
#pragma unroll
    for (int i = 0; i < 16; ++i) xv[i] = (xv[i] - mean) * rstd * w[i] + b[i];
#pragma unroll
    for (int j = 0; j < 4; ++j) *(AS1 f32x4*)gptr(p.out + (size_t)r * 1024 + lane * 4 + 256 * j) = f32x4{xv[4 * j], xv[4 * j + 1], xv[4 * j + 2], xv[4 * j + 3]};
#pragma unroll
    for (int i = 0; i < 16; ++i) xc[i] = xn[i];
#pragma unroll
    for (int s2 = 0; s2 < NSLOT; ++s2)
#pragma unroll
      for (int j = 0; j < 4; ++j) slc[s2][j] = sln[s2][j];
  }
}

DEVFN void phase2(const Params& p, int l, unsigned char* smem) {
  const bf16_t* U = (const bf16_t*)(p.ws + Ws::U);
  const bf16_t* W = (const bf16_t*)(p.ws + Ws::WIN) + (size_t)l * NIN_ * 1024;
  bf16_t* ZX = (bf16_t*)(p.ws + Ws::ZX);
  const int nct = (NIN_ + 255) / 256;
  for (int u = BIDX; u < (NT_ / 128) * nct; u += gridDim.x) {
    int rt = u / nct, ct = u % nct;
    gemm_tile_w<1, 1024>(smem, 1024,
      [&](int r) { return U + (size_t)(rt * 128 + r) * 1024; },
      [&](int) { return W + (size_t)(ct * 256) * 1024; },
      [&](f32x4 (&acc)[4][8], int, int wr, int wc, int g, int l15) {
#pragma unroll 1
        for (int h = 0; h < 2; ++h)
          tile_store_bf16<16>(smem, wr, g, l15,
            [&](bf16_t* T, int ldc) {
              if (wc == h) {
#pragma unroll
                for (int mi = 0; mi < 4; ++mi)
#pragma unroll
                  for (int ni = 0; ni < 8; ++ni)
#pragma unroll
                    for (int i = 0; i < 4; ++i) T[(wr * 64 + mi * 16 + 4 * g + i) * ldc + ni * 16 + l15] = f2bf(acc[mi][ni][i]); } },
            [&](int row, int c0) { const int col = ct * 256 + h * 128 + c0; return col < NIN_ ? ZX + (size_t)(rt * 128 + row) * NIN_ + col : (bf16_t*)nullptr; });
      });
  }
}

DEVFN float zxv(const bf16_t* ZX, int tok, int col) { return bf2f(gptr(ZX)[(size_t)tok * NIN_ + col]); }
struct Nbr { int n; int tok[4]; };
DEVFN Nbr shift_nbrs(int tok) {
  Nbr nb; int b = tok / T_, t = tok % T_;
  if (t < CTX_) { nb.n = 2; nb.tok[0] = t > 0 ? tok - 1 : -1; nb.tok[1] = t < CTX_ - 1 ? tok + 1 : -1; nb.tok[2] = -1; nb.tok[3] = -1; }
  else { int s = t - CTX_, row = s / 64, col = s % 64; nb.n = 4; nb.tok[0] = col > 0 ? tok - 1 : -1; nb.tok[1] = col < 63 ? tok + 1 : -1;
    nb.tok[2] = row > 0 ? tok - 64 : -1; nb.tok[3] = row < SEQ_ / 64 - 1 ? tok + 64 : -1; }
  (void)b; return nb;
}
DEVFN float shiftmix(const bf16_t* ZX, const float* mu, int tok, const Nbr& nb, int ch) {
  float z = zxv(ZX, tok, ORW + ch), o = z;
#pragma unroll
  for (int j = 0; j < 4; ++j) if (j < nb.n) { float v = nb.tok[j] >= 0 ? zxv(ZX, nb.tok[j], ORW + ch) : 0.f; o += mu[j * 1152 + ch] * (v - z); }
  return o;
}
#define LI_LD 392
#define KL_LD 264
DEVFN void phase3(const Params& p, int l, unsigned char* smem) {
  const int tid = TIDX, lane = tid & 63, wave = tid >> 6, q = lane >> 4, l15 = lane & 15;
  const bf16_t* ZX = (const bf16_t*)(p.ws + Ws::ZX);
  bf16_t* XBC = (bf16_t*)(p.ws + Ws::XBC); float* DTB = (float*)(p.ws + Ws::DTB);
  bf16_t* RR = (bf16_t*)(p.ws + Ws::RR); bf16_t* VV = (bf16_t*)(p.ws + Ws::VV); bf16_t* KKb = (bf16_t*)(p.ws + Ws::KK);
  bf16_t* KRW = (bf16_t*)(p.ws + Ws::KRW); bf16_t* LIg = (bf16_t*)(p.ws + Ws::LI);
  float* LA = (float*)(p.ws + Ws::LA);
  const float* convw = INP(I_CONVW) + (size_t)l * 3 * 1024; const float* convb = INP(I_CONVB) + (size_t)l * 1024;
  const float* mu = INP(I_MU) + (size_t)l * 4 * 1152;
  float* gdl = (float*)smem;
  const float kkw = INP(I_KKW)[(size_t)l * 256 + tid];
  unsigned* ctr = (unsigned*)(p.ws + Ws::BAR) + l * 32 + 8;
  volatile int* nxt_s = (volatile int*)(smem + SM_PRE);
  int wu = BIDX;
  while (wu < 6 * (NT_ / 16)) {
    int nxt = 0;
    if (TIDX == 0) nxt = (int)gridDim.x + (int)atomicAdd(ctr, 1u);
    const int part = wu < NT_ / 16 ? 0 : 1, tile = wu < NT_ / 16 ? wu : (wu - NT_ / 16) / 5, gsel = wu < NT_ / 16 ? 0 : (wu - NT_ / 16) % 5;
    const int tok0 = tile * 16, t0 = tok0 % T_, bb = tok0 / T_;
    const bool isctx = t0 < CTX_;
    const int s0 = t0 - CTX_;
    const bool lval = isctx ? (t0 > 0) : ((s0 & 63) != 0), rval = isctx ? (t0 + 16 < CTX_) : ((s0 & 63) != 48);
    const bool uval = !isctx && (s0 >= 64), dval = !isctx && (s0 + 64 < SEQ_);
    if (part == 0) {
    __syncthreads();
    {
      const bool segstart = (t0 == 0 || t0 == CTX_), segend = (t0 + 16 == CTX_ || t0 + 16 == T_);
      bf16_t* XBCT = (bf16_t*)(p.ws + Ws::XBCT) + ((size_t)(bb * NC128 + t0 / 128) * 768) * 128 + (t0 % 128);
      bf16_t vv16[16];
      { const AS1 bf16_t* vp = gptr(ZX) + (size_t)tok0 * NIN_ + OGV + tid;
#pragma unroll
        for (int i = 0; i < 16; ++i) { vv16[i] = *vp; vp += NIN_; LAUNDER_V(vp); } }
      const float dtv = zxv(ZX, tok0 + (tid >> 4), ODT + (tid & 15)), gd0 = zxv(ZX, tok0 + (tid >> 5), OGD + (tid & 31)), gd1 = zxv(ZX, tok0 + 8 + (tid >> 5), OGD + (tid & 31));
#pragma unroll 1
      for (int jp = 0; jp < 2; ++jp) {
        float z[2][18];
#pragma unroll
        for (int jj = 0; jj < 2; ++jj) { const int c = tid + 256 * (2 * jp + jj);
          const AS1 bf16_t* zp = gptr(ZX) + (size_t)tok0 * NIN_ + OXBC + c - NIN_;
#pragma unroll
          for (int i = 0; i < 18; ++i) { z[jj][i] = ((i == 0 && segstart) || (i == 17 && segend)) ? 0.f : bf2f(*zp); zp += NIN_; LAUNDER_V(zp); } }
#pragma unroll
        for (int jj = 0; jj < 2; ++jj) { const int c = tid + 256 * (2 * jp + jj);
          AS1 bf16_t* xp = gptr(XBC) + (size_t)tok0 * 1024 + c;
          const float w0 = convw[c], w1 = convw[1024 + c], w2 = convw[2048 + c], cb = convb[c];
          bf16_t y[16];
#pragma unroll
          for (int i = 0; i < 16; ++i) { y[i] = f2bf(siluf_(cb + w0 * z[jj][i] + w1 * z[jj][i + 1] + w2 * z[jj][i + 2])); *xp = y[i]; xp += 1024; LAUNDER_V(xp); }
          if (c < 768) {
            u32x4 o0, o1;
#pragma unroll
            for (int i = 0; i < 4; ++i) { o0[i] = (unsigned)y[2 * i] | ((unsigned)y[2 * i + 1] << 16); o1[i] = (unsigned)y[8 + 2 * i] | ((unsigned)y[9 + 2 * i] << 16); }
            *(AS1 u32x4*)gptr(XBCT + (size_t)c * 128) = o0; *(AS1 u32x4*)gptr(XBCT + (size_t)c * 128 + 8) = o1; } } }
      { bf16_t* VTp = (bf16_t*)(p.ws + Ws::VT) + ((size_t)(bb * NC64 + t0 / 64) * 256 + tid) * 64 + (t0 % 64);
        u32x4 o0, o1;
#pragma unroll
        for (int i = 0; i < 4; ++i) { o0[i] = (unsigned)vv16[2 * i] | ((unsigned)vv16[2 * i + 1] << 16); o1[i] = (unsigned)vv16[8 + 2 * i] | ((unsigned)vv16[9 + 2 * i] << 16); }
        *(AS1 u32x4*)gptr(VTp) = o0; *(AS1 u32x4*)gptr(VTp + 8) = o1; }
      gptr(DTB)[(size_t)tok0 * 16 + tid] = softplusf_(dtv + INP(I_DTBIAS)[(size_t)l * 16 + (tid & 15)]);
      gdl[tid] = gd0; gdl[256 + tid] = gd1;
    }
    } else {
    { const int g = gsel;
      const bool act = !(g == 4 && tid >= 128);
      const int ch = act ? g * 256 + tid : 0;
      const AS1 bf16_t* zp0 = gptr(ZX) + (size_t)tok0 * NIN_ + ORW + ch;
      const AS1 bf16_t* zp = zp0 - NIN_;
      const float m0 = mu[ch], m1 = mu[1152 + ch], m2 = mu[2304 + ch], m3 = mu[3456 + ch];
      float z[18], zu[16], zd[16], o[16];
      const AS1 bf16_t* up = uval ? zp0 - (size_t)64 * NIN_ : zp0; const AS1 bf16_t* dn = dval ? zp0 + (size_t)64 * NIN_ : zp0;
      const float um = uval ? 1.f : 0.f, dm = dval ? 1.f : 0.f, m2v = isctx ? 0.f : m2, m3v = isctx ? 0.f : m3;
#pragma unroll
      for (int i = 0; i < 18; ++i) { z[i] = ((i == 0 && !lval) || (i == 17 && !rval)) ? 0.f : bf2f(*zp); zp += NIN_; LAUNDER_V(zp); }
#pragma unroll
      for (int i = 0; i < 16; ++i) { zu[i] = bf2f(*up); zd[i] = bf2f(*dn); up += NIN_; dn += NIN_; LAUNDER_V(up); LAUNDER_V(dn); }
#pragma unroll
      for (int i = 0; i < 16; ++i) o[i] = z[i + 1] + m0 * (z[i] - z[i + 1]) + m1 * (z[i + 2] - z[i + 1]) + m2v * (zu[i] * um - z[i + 1]) + m3v * (zd[i] * dm - z[i + 1]);
      if (g == 0) { AS1 bf16_t* rp = gptr(RR) + (size_t)tok0 * 256 + tid;
#pragma unroll
        for (int i = 0; i < 16; ++i) { *rp = f2bf(o[i]); rp += 256; LAUNDER_V(rp); }
      } else if (g == 1) { AS1 bf16_t* kp = gptr(KKb) + (size_t)tok0 * 256 + tid; AS1 bf16_t* krp = gptr(KRW) + (size_t)tok0 * 256 + tid;
#pragma unroll
        for (int i = 0; i < 16; ++i) { const float kq = o[i] * kkw, nrm = sqrtf(wave_sum(kq * kq));
          *kp = f2bf(kq / fmaxf(nrm, 1e-12f)); *krp = f2bf(o[i]); kp += 256; krp += 256; LAUNDER_V(kp); LAUNDER_V(krp); }
      } else if (g == 2) { AS1 bf16_t* vp2 = gptr(VV) + (size_t)tok0 * 256 + tid;
#pragma unroll
        for (int i = 0; i < 16; ++i) { *vp2 = f2bf(o[i]); vp2 += 256; LAUNDER_V(vp2); }
      } else if (g == 3) { AS1 bf16_t* lp = gptr(LIg) + (size_t)tok0 * 384 + tid;
#pragma unroll
        for (int i = 0; i < 16; ++i) { *lp = f2bf(tid < 128 ? tanhf(o[i]) : o[i]); lp += 384; LAUNDER_V(lp); }
      } else if (act) { AS1 bf16_t* lp = gptr(LIg) + (size_t)tok0 * 384 + 256 + tid;
#pragma unroll
        for (int i = 0; i < 16; ++i) { *lp = f2bf(sigmoidf_(o[i])); lp += 384; LAUNDER_V(lp); }
      }
    }
    }
    if (part == 0) {
    __syncthreads();
    { const int d = tid >> 7, c = tid & 127; const float* gu = INP(I_GU) + ((size_t)l * 2 + d) * 16 * 128; const float gb = INP(I_GB)[((size_t)l * 2 + d) * 128 + c];
      float guw[16];
#pragma unroll
      for (int i = 0; i < 16; ++i) guw[i] = gu[i * 128 + c];
#pragma unroll 4
      for (int tt = 0; tt < 16; ++tt) { float sacc = gb;
#pragma unroll
        for (int i = 0; i < 16; ++i) sacc += gdl[tt * 32 + d * 16 + i] * guw[i];
        gptr(LA)[((size_t)d * NT_ + tok0 + tt) * 128 + c] = logsigmoidf_(sacc) * (1.f / 16.f); } }
    }
    __syncthreads();
    if (TIDX == 0) *nxt_s = nxt;
    __syncthreads();
    wu = *nxt_s;
  }
}

DEVFN void phase3b(const Params& p, int l, unsigned char* smem) {
  const bf16_t* LIg = (const bf16_t*)(p.ws + Ws::LI);
  const bf16_t* lora = (const bf16_t*)(p.ws + Ws::LORA) + (size_t)l * 98304;
  const bf16_t* KRg = (const bf16_t*)(p.ws + Ws::KRW); const bf16_t* KKg = (const bf16_t*)(p.ws + Ws::KK);
  float* LWp = (float*)(p.ws + Ws::LW); bf16_t* KD = (bf16_t*)(p.ws + Ws::KD); bf16_t* BD = (bf16_t*)(p.ws + Ws::BD); float* GATE = (float*)(p.ws + Ws::GATE);
  for (int u = BIDX; u < (NT_ / 128) * 10; u += gridDim.x) {
    const int rt = u / 10, which = (u % 10) >> 1, ct = u & 1;
    const int K = which < 4 ? 64 : 128, acol = which < 4 ? which * 64 : 256;
    const bf16_t* wb = which < 2 ? lora + (size_t)which * 16384 : which < 4 ? lora + 32768 + (size_t)(which - 2) * 16384 : lora + 65536;
    const float* bias = which < 2 ? INP(I_W0) + (size_t)l * 512 + which * 256 : INP(I_A0) + (size_t)l * 512 + (which & 1) * 256;
    const float* kav = INP(I_KAW) + (size_t)l * 256;
    gemm_tile(smem, K,
      [&](int r) { return LIg + (size_t)(rt * 128 + r) * 384 + acol; },
      [&](int r) { return wb + (size_t)(ct * 128 + r) * K; },
      [&](f32x4 (&acc)[4][4], int wr, int wc, int g, int l15) {
        const int tid = TIDX;
        if (which == 2 || which == 3) {
          bf16_t* T = (bf16_t*)smem; constexpr int LDC = 136;
          __syncthreads();
#pragma unroll
          for (int ni = 0; ni < 4; ++ni) { const int cl = wc * 64 + ni * 16 + l15; const float bv = bias[ct * 128 + cl];
#pragma unroll
            for (int mi = 0; mi < 4; ++mi)
#pragma unroll
              for (int i = 0; i < 4; ++i) T[(wr * 64 + mi * 16 + 4 * g + i) * LDC + cl] = f2bf(sigmoidf_(acc[mi][ni][i] + bv)); }
          __syncthreads();
          const int c = tid & 15, col0 = ct * 128 + c * 8;
          float ka[8];
#pragma unroll
          for (int j = 0; j < 8; ++j) ka[j] = kav[col0 + j];
          const size_t dofs = (size_t)(which - 2) * NT_ * 256;
#pragma unroll
          for (int pass = 0; pass < 8; ++pass) { const int row = (tid >> 4) + 16 * pass; const size_t o = (size_t)(rt * 128 + row) * 256 + col0;
            const bf16x8 a8 = *(const bf16x8*)(T + row * LDC + c * 8), kr8 = ld8g(KRg + o), kk8 = ld8g(KKg + o);
            bf16x8 kd8, bd8;
#pragma unroll
            for (int j = 0; j < 8; ++j) { const float a = bf2f((bf16_t)a8[j]); kd8[j] = (short)f2bf(bf2f((bf16_t)kr8[j]) * (1.f + (a - 1.f) * ka[j])); bd8[j] = (short)f2bf(bf2f((bf16_t)kk8[j]) * a); }
            *(AS1 bf16x8*)gptr(KD + dofs + o) = kd8; *(AS1 bf16x8*)gptr(BD + dofs + o) = bd8; }
        } else {
          float* T = (float*)smem; constexpr int LDC = 132;
          float* dst = which < 2 ? LWp + (size_t)which * NT_ * 256 : GATE;
#pragma unroll 1
          for (int h = 0; h < 2; ++h) {
            __syncthreads();
            if (wr == h) {
#pragma unroll
              for (int ni = 0; ni < 4; ++ni) { const int cl = wc * 64 + ni * 16 + l15; const float bv = which < 2 ? bias[ct * 128 + cl] : 0.f;
#pragma unroll
                for (int mi = 0; mi < 4; ++mi)
#pragma unroll
                  for (int i = 0; i < 4; ++i) { const float v = acc[mi][ni][i]; T[(mi * 16 + 4 * g + i) * LDC + cl] = which < 2 ? -0.6065306597126334f * sigmoidf_(v + bv) : v; } } }
            __syncthreads();
#pragma unroll
            for (int pass = 0; pass < 8; ++pass) { const int id = tid + 256 * pass, row = id >> 5, c = id & 31;
              *(AS1 f32x4*)gptr(dst + (size_t)(rt * 128 + h * 64 + row) * 256 + ct * 128 + c * 4) = *(const f32x4*)(T + row * LDC + c * 4); } }
        }
      });
  }
}

DEVFN bf16x8 ld8(const bf16_t* p) { return *(const bf16x8*)p; }
typedef short bf16x4v __attribute__((ext_vector_type(4)));
DEVFN bf16x4v cvt4(f32x4 v) { return bf16x4v{(short)f2bf(v[0]), (short)f2bf(v[1]), (short)f2bf(v[2]), (short)f2bf(v[3])}; }
DEVFN bf16x8 cat44(bf16x4v a, bf16x4v b) { return bf16x8{a[0], a[1], a[2], a[3], b[0], b[1], b[2], b[3]}; }
DEVFN bf16x4v ld4(const bf16_t* p) { return *(const bf16x4v*)p; }
DEVFN int rm_off(int i, int k) { return i * 64 + ((((k >> 3) ^ (i & 7)) << 3) | (k & 7)); }
#define RW_WAVE_LDS 11264
struct RwRaw { float lw[16], r[16], k[16], v[16], kk[16], bb[16]; };
DEVFN void rwc_load(const Params& p, int unit_base, RwRaw& d) {
  const int tid = TIDX, lane = tid & 63, wave = tid >> 6;
  const int unit = unit_base + wave;
  const int c = unit % NC16, h = (unit / NC16) & 3, dir = (unit / (NC16 * 4)) & 1, b = unit / (NC16 * 8);
  const bf16_t* RRg = (const bf16_t*)(p.ws + Ws::RR); const bf16_t* VVg = (const bf16_t*)(p.ws + Ws::VV); const bf16_t* KKg = (const bf16_t*)(p.ws + Ws::KK);
  const bf16_t* KDg = (const bf16_t*)(p.ws + Ws::KD) + (size_t)dir * NT_ * 256; const bf16_t* BDg = (const bf16_t*)(p.ws + Ws::BD) + (size_t)dir * NT_ * 256;
  const float* LWg = (const float*)(p.ws + Ws::LW) + (size_t)dir * NT_ * 256;
#pragma unroll
  for (int i = 0; i < 16; ++i) {
    const size_t o = (size_t)(b * T_ + tokmap(dir, c * 16 + i)) * 256 + h * 64 + lane;
    d.lw[i] = gptr(LWg)[o]; d.r[i] = bf2f(gptr(RRg)[o]); d.k[i] = bf2f(gptr(KDg)[o]); d.v[i] = bf2f(gptr(VVg)[o]); d.kk[i] = bf2f(gptr(KKg)[o]); d.bb[i] = bf2f(gptr(BDg)[o]); }
}
DEVFN void rwkv_chunk(const Params& p, int unit_base, unsigned char* smem, const RwRaw& raw) {
  const int tid = TIDX, lane = tid & 63, wave = tid >> 6, q = lane >> 4, l15 = lane & 15;
  const int unit = unit_base + wave;
  const int c = unit % NC16, h = (unit / NC16) & 3, dir = (unit / (NC16 * 4)) & 1, b = unit / (NC16 * 8);
  bf16_t* big = (bf16_t*)(smem + wave * RW_WAVE_LDS);
  unsigned char* small = smem + wave * RW_WAVE_LDS + 8192;
  float* AbF = (float*)small;
  bf16_t* TN = (bf16_t*)(small + 1024);
  bf16_t* AK = TN + 256; bf16_t* RB = AK + 256; bf16_t* RK = RB + 256;
  float kkm[16], vv[16], bneg[16], kneg[16];
  float run = 0.f;
  __syncthreads();
#pragma unroll
  for (int i = 0; i < 16; ++i) {
    const float lw = raw.lw[i], r = raw.r[i], k = raw.k[i], v = raw.v[i], kk = raw.kk[i], bb = raw.bb[i];
    const float e_ex = expf(run); run += lw; const float e_in = expf(run), e_neg = expf(-run);
    kkm[i] = kk * e_ex; vv[i] = v; bneg[i] = bb * e_neg; kneg[i] = k * e_neg;
    big[rm_off(i, lane)] = f2bf(kkm[i]); big[1024 + rm_off(i, lane)] = f2bf(r * e_in);
    big[2048 + rm_off(i, lane)] = f2bf(bneg[i]); big[3072 + rm_off(i, lane)] = f2bf(kneg[i]);
  }
  const float WC = expf(run);
  __syncthreads();
  f32x4 ab = f32x4{0.f, 0.f, 0.f, 0.f}, ak = ab, rb = ab, rk = ab;
#pragma unroll
  for (int s2 = 0; s2 < 2; ++s2) { const int ch = ((4 * s2 + q) ^ (l15 & 7)) << 3;
    const bf16x8 a_kk = ld8(big + l15 * 64 + ch), a_r = ld8(big + 1024 + l15 * 64 + ch), b_b = ld8(big + 2048 + l15 * 64 + ch), b_k = ld8(big + 3072 + l15 * 64 + ch);
    ab = MFMA16(a_kk, b_b, ab); ak = MFMA16(a_kk, b_k, ak); rb = MFMA16(a_r, b_b, rb); rk = MFMA16(a_r, b_k, rk); }
  f32x4 gacc[4];
#pragma unroll
  for (int nk = 0; nk < 4; ++nk)
#pragma unroll
    for (int r = 0; r < 4; ++r) gacc[nk][r] = bf2f(big[1024 + rm_off(4 * q + r, 16 * nk + l15)]);
  __syncthreads();
#pragma unroll
  for (int r = 0; r < 4; ++r) { const int i = 4 * q + r, j = l15;
    AbF[i * 16 + j] = j < i ? ab[r] : 0.f; AK[i * 16 + j] = f2bf(j < i ? ak[r] : 0.f);
    RB[i * 16 + j] = f2bf(j <= i ? rb[r] : 0.f); RK[i * 16 + j] = f2bf(j <= i ? rk[r] : 0.f); }
  { bf16_t* KKMT = big; bf16_t* VTT = big + 1024; bf16_t* BHT = big + 2048; bf16_t* KHT = big + 3072;
#pragma unroll
    for (int i = 0; i < 16; ++i) { KKMT[lane * 16 + i] = f2bf(kkm[i]); VTT[lane * 16 + i] = f2bf(vv[i]); BHT[lane * 16 + i] = f2bf(bneg[i] * WC); KHT[lane * 16 + i] = f2bf(kneg[i] * WC); } }
  __syncthreads();
  { float t[16];
#pragma unroll
    for (int i = 0; i < 16; ++i) { float acc = (i == l15) ? 1.f : 0.f;
#pragma unroll
      for (int j = 0; j < i; ++j) acc -= AbF[i * 16 + j] * t[j];
      t[i] = acc; }
    if (q == 0) {
#pragma unroll
      for (int i = 0; i < 16; ++i) TN[i * 16 + l15] = f2bf(-t[i]); } }
  __syncthreads();
  const size_t ci = (size_t)((b * 2 + dir) * 4 + h) * NC16 + c;
  bf16_t* MLg = (bf16_t*)(p.ws + Ws::RML) + ci * 4096; bf16_t* Ng = (bf16_t*)(p.ws + Ws::RNS) + ci * 4096;
  bf16_t* Gg = (bf16_t*)(p.ws + Ws::RG) + ci * 1024; float* Y0g = (float*)(p.ws + Ws::RY0) + ci * 1024;
  const bf16x4v a_T = ld4(TN + l15 * 16 + 4 * q), a_Ak = ld4(AK + l15 * 16 + 4 * q), a_Rb = ld4(RB + l15 * 16 + 4 * q), a_Rk = ld4(RK + l15 * 16 + 4 * q);
  const f32x4 z4 = f32x4{0.f, 0.f, 0.f, 0.f};
  bf16x4v vfr[4], qfr[4], pfr[4];
#pragma unroll
  for (int n = 0; n < 4; ++n) {
    vfr[n] = ld4(big + 1024 + (16 * n + l15) * 16 + 4 * q);
    const f32x4 akv = MFMA16K16(a_Ak, vfr[n], z4);
    qfr[n] = cvt4(MFMA16K16(a_T, cvt4(akv), z4));
    pfr[n] = cvt4(MFMA16K16(a_T, ld4(big + (16 * n + l15) * 16 + 4 * q), z4)); }
  const bf16x8 a_RbRk = cat44(a_Rb, a_Rk);
  bf16x4v aB[4], aK[4];
#pragma unroll
  for (int mk = 0; mk < 4; ++mk) { aB[mk] = ld4(big + 2048 + (16 * mk + l15) * 16 + 4 * q); aK[mk] = ld4(big + 3072 + (16 * mk + l15) * 16 + 4 * q); }
  f32x4 g[4], y0[4];
#pragma unroll
  for (int n = 0; n < 4; ++n) { g[n] = MFMA16K16(a_Rb, pfr[n], gacc[n]); y0[n] = MFMA16(a_RbRk, cat44(qfr[n], vfr[n]), z4); }
  WAVE_SYNC();
  { float* y0s = (float*)(big + 2048);
#pragma unroll
    for (int n = 0; n < 4; ++n)
#pragma unroll
      for (int r = 0; r < 4; ++r) { big[(4 * q + r) * 64 + 16 * n + l15] = f2bf(g[n][r]); y0s[(4 * q + r) * 64 + 16 * n + l15] = y0[n][r];
        big[1024 + ((n >> 1) * 64 + (l15 >> 2) * 16 + 4 * q + r) * 8 + (n & 1) * 4 + (l15 & 3)] = (bf16_t)pfr[n][r]; } }
  WAVE_SYNC();
  { const u32x4* src = (const u32x4*)big;
    AS1 u32x4* gd = (AS1 u32x4*)gptr(Gg); AS1 u32x4* pd = (AS1 u32x4*)gptr(MLg); AS1 u32x4* yd = (AS1 u32x4*)gptr(Y0g);
    gd[lane] = src[lane]; gd[64 + lane] = src[64 + lane];
    pd[lane] = src[128 + lane]; pd[64 + lane] = src[192 + lane];
#pragma unroll
    for (int j = 0; j < 4; ++j) yd[64 * j + lane] = src[256 + 64 * j + lane]; }
#pragma unroll
  for (int pr = 0; pr < 2; ++pr) *(AS1 bf16x8*)(gptr(MLg) + 1024 + (pr * 64 + lane) * 8) = cat44(aB[2 * pr], aB[2 * pr + 1]);
#pragma unroll
  for (int n = 0; n < 4; ++n) { bf16x4v nb[4];
#pragma unroll
    for (int mk = 0; mk < 4; ++mk) nb[mk] = cvt4(MFMA16(cat44(aB[mk], aK[mk]), cat44(qfr[n], vfr[n]), z4));
    AS1 bf16x8* nd = (AS1 bf16x8*)(gptr(Ng) + (n * 64 + lane) * 16); nd[0] = cat44(nb[0], nb[1]); nd[1] = cat44(nb[2], nb[3]); }
  gptr((float*)(p.ws + Ws::RWC))[ci * 64 + ((lane >> 2) & 3) * 16 + (lane >> 4) * 4 + (lane & 3)] = WC;
}
struct RwStep { bf16x8 pf[2]; bf16x8 bh[2]; bf16x8 n[2]; float wc; };
DEVFN void rw_load(RwStep& t, const bf16_t* MLg, const bf16_t* NSg, const float* WCg, int c, int lane, int q) {
#pragma unroll
  for (int s2 = 0; s2 < 2; ++s2) { t.pf[s2] = ld8g(MLg + (size_t)c * 4096 + (s2 * 64 + lane) * 8); t.bh[s2] = ld8g(MLg + (size_t)c * 4096 + 1024 + (s2 * 64 + lane) * 8); }
  t.wc = gptr(WCg)[(size_t)c * 64 + lane];
  t.n[0] = ld8g(NSg + (size_t)c * 4096 + lane * 16); t.n[1] = ld8g(NSg + (size_t)c * 4096 + lane * 16 + 8);
  (void)q;
}
template <int MK> DEVFN f32x4 rw_tile(const RwStep& t, const f32x4& Smk, const bf16x4v& wb) {
  f32x4 acc;
  acc[0] = bf2f((bf16_t)t.n[MK >> 1][(MK & 1) * 4 + 0]) + ROWBCAST(t.wc, MK * 4 + 0) * Smk[0];
  acc[1] = bf2f((bf16_t)t.n[MK >> 1][(MK & 1) * 4 + 1]) + ROWBCAST(t.wc, MK * 4 + 1) * Smk[1];
  acc[2] = bf2f((bf16_t)t.n[MK >> 1][(MK & 1) * 4 + 2]) + ROWBCAST(t.wc, MK * 4 + 2) * Smk[2];
  acc[3] = bf2f((bf16_t)t.n[MK >> 1][(MK & 1) * 4 + 3]) + ROWBCAST(t.wc, MK * 4 + 3) * Smk[3];
  const bf16x8 b2 = t.bh[MK >> 1];
  const bf16x4v a_B = (MK & 1) ? bf16x4v{b2[4], b2[5], b2[6], b2[7]} : bf16x4v{b2[0], b2[1], b2[2], b2[3]};
  return MFMA16K16(a_B, wb, acc);
}
DEVFN void rw_step(const RwStep& t, f32x4 (&S)[4], bf16_t* NSg, int c, int q, int l15, unsigned char* stg) {
  bf16x4v sb[4];
#pragma unroll
  for (int mk = 0; mk < 4; ++mk) sb[mk] = cvt4(S[mk]);
  const bf16x8 bf0 = cat44(sb[0], sb[1]), bf1 = cat44(sb[2], sb[3]);
  f32x4 w = MFMA16(t.pf[0], bf0, (f32x4{0.f, 0.f, 0.f, 0.f}));
  w = MFMA16(t.pf[1], bf1, w);
  const bf16x4v wb = cvt4(w);
  S[0] = rw_tile<0>(t, S[0], wb); S[1] = rw_tile<1>(t, S[1], wb); S[2] = rw_tile<2>(t, S[2], wb); S[3] = rw_tile<3>(t, S[3], wb);
  WAVE_SYNC();
#pragma unroll
  for (int mk = 0; mk < 4; ++mk) *(bf16x4v*)(stg + l15 * 144 + mk * 32 + q * 8) = sb[mk];
  WAVE_SYNC();
  { const int L = q * 16 + l15;
    const u32x4 v0 = *(const u32x4*)(stg + (L >> 3) * 144 + (L & 7) * 16), v1 = *(const u32x4*)(stg + (8 + (L >> 3)) * 144 + (L & 7) * 16);
    AS1 u32x4* dst = (AS1 u32x4*)gptr(NSg + (size_t)c * 4096) + L;
    dst[0] = v0; dst[64] = v1; }
}
DEVFN void rwkv_scan(const Params& p, int chain, int wave, unsigned char* stg) {
  const int tid = TIDX, lane = tid & 63, q = lane >> 4, l15 = lane & 15;
  const bf16_t* MLg = (const bf16_t*)(p.ws + Ws::RML) + (size_t)chain * NC16 * 4096;
  bf16_t* NSg = (bf16_t*)(p.ws + Ws::RNS) + (size_t)chain * NC16 * 4096 + wave * 1024;
  const float* WCg = (const float*)(p.ws + Ws::RWC) + (size_t)chain * NC16 * 64;
  f32x4 S[4];
#pragma unroll
  for (int mk = 0; mk < 4; ++mk) S[mk] = f32x4{0.f, 0.f, 0.f, 0.f};
  RwStep t0, t1, t2, t3, t4, t5;
#define RWC_(x) ((x) < NC16 ? (x) : NC16 - 1)
  rw_load(t0, MLg, NSg, WCg, 0, lane, q);
  rw_load(t1, MLg, NSg, WCg, RWC_(1), lane, q);
  rw_load(t2, MLg, NSg, WCg, RWC_(2), lane, q);
  rw_load(t3, MLg, NSg, WCg, RWC_(3), lane, q);
  rw_load(t4, MLg, NSg, WCg, RWC_(4), lane, q);
  int c = 0;
  for (; c + 5 < NC16; c += 6) {
    rw_load(t5, MLg, NSg, WCg, c + 5, lane, q);
    rw_step(t0, S, NSg, c, q, l15, stg);
    rw_load(t0, MLg, NSg, WCg, RWC_(c + 6), lane, q);
    rw_step(t1, S, NSg, c + 1, q, l15, stg);
    rw_load(t1, MLg, NSg, WCg, RWC_(c + 7), lane, q);
    rw_step(t2, S, NSg, c + 2, q, l15, stg);
    rw_load(t2, MLg, NSg, WCg, RWC_(c + 8), lane, q);
    rw_step(t3, S, NSg, c + 3, q, l15, stg);
    rw_load(t3, MLg, NSg, WCg, RWC_(c + 9), lane, q);
    rw_step(t4, S, NSg, c + 4, q, l15, stg);
    rw_load(t4, MLg, NSg, WCg, RWC_(c + 10), lane, q);
    rw_step(t5, S, NSg, c + 5, q, l15, stg);
  }
  if (c < NC16) { rw_step(t0, S, NSg, c, q, l15, stg);
    if (c + 1 < NC16) { rw_step(t1, S, NSg, c + 1, q, l15, stg);
      if (c + 2 < NC16) { rw_step(t2, S, NSg, c + 2, q, l15, stg);
        if (c + 3 < NC16) { rw_step(t3, S, NSg, c + 3, q, l15, stg);
          if (c + 4 < NC16) rw_step(t4, S, NSg, c + 4, q, l15, stg); } } } }
#undef RWC_
}
DEVFN void rwkv_out(const Params& p, int unit_base) {
  const int tid = TIDX, lane = tid & 63, wave = tid >> 6, q = lane >> 4, l15 = lane & 15;
  bf16x8 a0[2], a1[2], s0[2][4], s1[2][4]; f32x4 acc[2][4];
#pragma unroll
  for (int u2 = 0; u2 < 2; ++u2) {
    const int unit = unit_base + u2 * 4 + wave;
    const int c = unit % NC16, h = (unit / NC16) & 3, dir = (unit / (NC16 * 4)) & 1, b = unit / (NC16 * 8);
    const size_t ci = (size_t)((b * 2 + dir) * 4 + h) * NC16 + c;
    const bf16_t* Sg = (const bf16_t*)(p.ws + Ws::RNS) + ci * 4096; const bf16_t* Gg = (const bf16_t*)(p.ws + Ws::RG) + ci * 1024;
    const float* Y0g = (const float*)(p.ws + Ws::RY0) + ci * 1024;
    a0[u2] = ld8g(Gg + l15 * 64 + 8 * q); a1[u2] = ld8g(Gg + l15 * 64 + 32 + 8 * q);
#pragma unroll
    for (int n = 0; n < 4; ++n) {
#pragma unroll
      for (int r = 0; r < 4; ++r) acc[u2][n][r] = gptr(Y0g)[(4 * q + r) * 64 + 16 * n + l15];
      s0[u2][n] = ld8g(Sg + n * 1024 + l15 * 64 + 8 * q); s1[u2][n] = ld8g(Sg + n * 1024 + l15 * 64 + 32 + 8 * q); } }
#pragma unroll
  for (int u2 = 0; u2 < 2; ++u2) {
    const int unit = unit_base + u2 * 4 + wave;
    const int c = unit % NC16, h = (unit / NC16) & 3, dir = (unit / (NC16 * 4)) & 1, b = unit / (NC16 * 8);
    float* YR = (float*)(p.ws + Ws::YR) + (size_t)dir * NT_ * 256;
#pragma unroll
    for (int n = 0; n < 4; ++n) {
      acc[u2][n] = MFMA16(a0[u2], s0[u2][n], acc[u2][n]);
      acc[u2][n] = MFMA16(a1[u2], s1[u2][n], acc[u2][n]);
#pragma unroll
      for (int r = 0; r < 4; ++r) gptr(YR)[(size_t)(b * T_ + tokmap(dir, c * 16 + 4 * q + r)) * 256 + h * 64 + 16 * n + l15] = acc[u2][n][r]; } }
}
DEVFN int cscan(int dir, int co, int nctx, int nc) { return dir == 0 ? co : (co < nctx ? nctx - 1 - co : 2 * nctx + nc - 1 - co); }
DEVFN bf16x8 ld4x2g(const bf16_t* p0, const bf16_t* p1) { bf16x4v a = *(const AS1 bf16x4v*)gptr(p0), b = *(const AS1 bf16x4v*)gptr(p1); return bf16x8{a[0], a[1], a[2], a[3], b[0], b[1], b[2], b[3]}; }
DEVFN bf16x8 ld4x2(const bf16_t* p0, const bf16_t* p1) { bf16x4v a = *(const bf16x4v*)p0, b = *(const bf16x4v*)p1; return bf16x8{a[0], a[1], a[2], a[3], b[0], b[1], b[2], b[3]}; }

DEVFN void ssd_chunk_scalars(const Params& p, int l, int b, int co, int h, float* f) {
  const int tid = TIDX, d = tid >> 7, j = tid & 127;
  const float* DTB = (const float*)(p.ws + Ws::DTB);
  const float nega = -expf(INP(I_ALOG)[(size_t)l * 16 + d * 8 + h]);
  const float dt = DTB[(size_t)(b * T_ + co * 128 + j) * 16 + d * 8 + h];
  __syncthreads();
  f[256 + d * 128 + j] = dt;
  float* cur = f + d * 128; float* tmp = f + 512 + d * 128;
  cur[j] = dt * nega;
  __syncthreads();
  for (int off = 1; off < 128; off <<= 1) {
    float v = cur[j] + (j >= off ? cur[j - off] : 0.f);
    tmp[j] = v;
    __syncthreads();
    cur[j] = tmp[j];
    __syncthreads();
  }
}
DEVFN void ssd_states(const Params& p, int l, int unit, unsigned char* smem) {
  const int tid = TIDX, lane = tid & 63, wave = tid >> 6, q = lane >> 4, l15 = lane & 15;
  const int h = unit & 7, co = (unit >> 3) % NC128, b = unit / (8 * NC128), grp = h >> 2;
  float* f = (float*)smem;
  ssd_chunk_scalars(p, l, b, co, h, f);
  { const int d = tid >> 7, j = tid & 127; const float* cum = f + d * 128; const float dt = f[256 + d * 128 + j];
    float w = d == 0 ? expf(cum[127] - cum[j]) * dt : expf(j > 0 ? cum[j - 1] : 0.f) * dt;
    f[512 + d * 128 + j] = w; }
  __syncthreads();
  const bf16_t* XT = (const bf16_t*)(p.ws + Ws::XBCT) + (size_t)(b * NC128 + co) * 768 * 128;
  f32x4 acc[2][8];
#pragma unroll
  for (int d = 0; d < 2; ++d)
#pragma unroll
    for (int n = 0; n < 8; ++n) acc[d][n] = f32x4{0.f, 0.f, 0.f, 0.f};
#pragma unroll 2
  for (int s4 = 0; s4 < 4; ++s4) {
    const int j0 = s4 * 32 + q * 8;
    bf16x8 xa = ld8g(XT + (size_t)(h * 64 + wave * 16 + l15) * 128 + j0), a0, a1;
#pragma unroll
    for (int jj = 0; jj < 8; ++jj) { float x = bf2f((bf16_t)xa[jj]); a0[jj] = (short)f2bf(x * f[512 + j0 + jj]); a1[jj] = (short)f2bf(x * f[640 + j0 + jj]); }
#pragma unroll
    for (int n = 0; n < 8; ++n) { bf16x8 bb = ld8g(XT + (size_t)(512 + grp * 128 + n * 16 + l15) * 128 + j0);
      acc[0][n] = MFMA16(a0, bb, acc[0][n]); acc[1][n] = MFMA16(a1, bb, acc[1][n]); }
  }
#pragma unroll
  for (int d = 0; d < 2; ++d) {
    const int cs = cscan(d, co, CTX_ / 128, SEQ_ / 128);
    float* ST = (float*)(p.ws + Ws::SST) + ((size_t)((d * B_ + b) * NC128 + cs) * 8 + h) * 8192;
#pragma unroll
    for (int n = 0; n < 8; ++n)
#pragma unroll
      for (int r = 0; r < 4; ++r) gptr(ST)[(wave * 16 + q * 4 + r) * 128 + n * 16 + l15] = acc[d][n][r];
    if (tid == 0) gptr((float*)(p.ws + Ws::SCD))[((size_t)(d * B_ + b) * NC128 + cs) * 8 + h] = expf(f[d * 128 + 127]);
  }
}
#define SSD_SB ((NC128 % 17) == 0 ? 17 : NC128)
DEVFN void ssd_scan(const Params& p, int gtid, int gthreads) {
  const AS1 float* ST = gptr((const float*)(p.ws + Ws::SST)); const AS1 float* CD = gptr((const float*)(p.ws + Ws::SCD)); AS1 bf16_t* HIN = gptr((bf16_t*)(p.ws + Ws::HIN));
  const int N = 2 * B_ * 8 * 8192;
  for (int e0 = gtid; e0 < N; e0 += 2 * gthreads) {
    int pd[2], h[2], db[2]; bool ok[2]; float hv[2];
#pragma unroll
    for (int k = 0; k < 2; ++k) { const int e = e0 + k * gthreads; ok[k] = e < N; const int ec = ok[k] ? e : e0; pd[k] = ec & 8191; h[k] = (ec >> 13) & 7; db[k] = ec >> 16; hv[k] = 0.f; }
#pragma unroll 1
    for (int c0 = 0; c0 < NC128; c0 += SSD_SB) {
      float st[2][SSD_SB], cd[2][SSD_SB];
#pragma unroll
      for (int k = 0; k < 2; ++k)
#pragma unroll
        for (int i = 0; i < SSD_SB; ++i) { st[k][i] = ST[((size_t)(db[k] * NC128 + c0 + i) * 8 + h[k]) * 8192 + pd[k]]; cd[k][i] = CD[(size_t)(db[k] * NC128 + c0 + i) * 8 + h[k]]; }
#pragma unroll
      for (int k = 0; k < 2; ++k) if (ok[k]) {
#pragma unroll
        for (int i = 0; i < SSD_SB; ++i) { HIN[((size_t)(db[k] * NC128 + c0 + i) * 8 + h[k]) * 8192 + pd[k]] = f2bf(hv[k]); hv[k] = hv[k] * cd[k][i] + st[k][i]; } }
    }
  }
}
DEVFN void ssd_out(const Params& p, int l, int unit, unsigned char* smem) {
  const int tid = TIDX, lane = tid & 63, wave = tid >> 6, q = lane >> 4, l15 = lane & 15;
  const int h = unit & 7, co = (unit >> 3) % NC128, b = unit / (8 * NC128), grp = h >> 2;
  float* f = (float*)smem;
  ssd_chunk_scalars(p, l, b, co, h, f);
  if (tid < 128) f[640 + tid] = f[128 + 127] - (tid > 0 ? f[128 + tid - 1] : 0.f);
  __syncthreads();
  const float* cum0 = f; const float* suf1 = f + 640; const float* dt0 = f + 256; const float* dt1 = f + 384;
  const bf16_t* XBC = (const bf16_t*)(p.ws + Ws::XBC) + (size_t)(b * T_ + co * 128) * 1024;
  const bf16_t* XT = (const bf16_t*)(p.ws + Ws::XBCT) + (size_t)(b * NC128 + co) * 768 * 128;
  const bf16_t* Cb = XBC + (size_t)(wave * 32 + l15) * 1024 + 768 + grp * 128 + q * 8;
  f32x4 y[4][2];
  { f32x4 o0[4][2], o1[4][2];
#pragma unroll
    for (int mp = 0; mp < 4; ++mp)
#pragma unroll
      for (int ni = 0; ni < 2; ++ni) { o0[mp][ni] = f32x4{0.f, 0.f, 0.f, 0.f}; o1[mp][ni] = f32x4{0.f, 0.f, 0.f, 0.f}; }
    const int cs0 = cscan(0, co, CTX_ / 128, SEQ_ / 128), cs1 = cscan(1, co, CTX_ / 128, SEQ_ / 128);
    const bf16_t* H0 = (const bf16_t*)(p.ws + Ws::HIN) + ((size_t)((0 * B_ + b) * NC128 + cs0) * 8 + h) * 8192;
    const bf16_t* H1 = (const bf16_t*)(p.ws + Ws::HIN) + ((size_t)((1 * B_ + b) * NC128 + cs1) * 8 + h) * 8192;
#pragma unroll
    for (int s4 = 0; s4 < 4; ++s4) { const bf16x8 c0 = ld8g(Cb + s4 * 32), c1 = ld8g(Cb + 16 * 1024 + s4 * 32);
#pragma unroll
      for (int mp = 0; mp < 4; ++mp) { bf16x8 h0 = ld8g(H0 + (size_t)(mp * 16 + l15) * 128 + s4 * 32 + q * 8), h1 = ld8g(H1 + (size_t)(mp * 16 + l15) * 128 + s4 * 32 + q * 8);
        o0[mp][0] = MFMA16(h0, c0, o0[mp][0]); o0[mp][1] = MFMA16(h0, c1, o0[mp][1]);
        o1[mp][0] = MFMA16(h1, c0, o1[mp][0]); o1[mp][1] = MFMA16(h1, c1, o1[mp][1]); } }
#pragma unroll
    for (int ni = 0; ni < 2; ++ni) { const int i = wave * 32 + ni * 16 + l15; const float e0 = expf(cum0[i]), e1 = expf(suf1[i]);
#pragma unroll
      for (int mp = 0; mp < 4; ++mp)
#pragma unroll
        for (int r = 0; r < 4; ++r) y[mp][ni][r] = e0 * o0[mp][ni][r] + e1 * o1[mp][ni][r]; } }
  bf16x8 mfr[4][2];
  { f32x4 g[8][2];
#pragma unroll
    for (int mj = 0; mj < 8; ++mj) { g[mj][0] = f32x4{0.f, 0.f, 0.f, 0.f}; g[mj][1] = f32x4{0.f, 0.f, 0.f, 0.f}; }
#pragma unroll
    for (int s4 = 0; s4 < 4; ++s4) { const bf16x8 c0 = ld8g(Cb + s4 * 32), c1 = ld8g(Cb + 16 * 1024 + s4 * 32);
#pragma unroll
      for (int mj = 0; mj < 8; ++mj) { bf16x8 bb = ld8g(XBC + (size_t)(mj * 16 + l15) * 1024 + 512 + grp * 128 + s4 * 32 + q * 8);
        g[mj][0] = MFMA16(bb, c0, g[mj][0]); g[mj][1] = MFMA16(bb, c1, g[mj][1]); } }
    const int i0 = wave * 32 + l15, i1 = i0 + 16;
    const float c0i0 = cum0[i0], s1i0 = suf1[i0], c0i1 = cum0[i1], s1i1 = suf1[i1];
#pragma unroll
    for (int mj = 0; mj < 8; ++mj)
#pragma unroll
      for (int r = 0; r < 4; ++r) { const int j = mj * 16 + q * 4 + r;
        const float cj = cum0[j], sj = suf1[j], d0 = dt0[j], d1 = dt1[j];
        const float lw0 = (j <= i0 ? expf(c0i0 - cj) * d0 : 0.f) + (j >= i0 ? expf(s1i0 - sj) * d1 : 0.f);
        const float lw1 = (j <= i1 ? expf(c0i1 - cj) * d0 : 0.f) + (j >= i1 ? expf(s1i1 - sj) * d1 : 0.f);
        mfr[mj >> 1][0][(mj & 1) * 4 + r] = (short)f2bf(g[mj][0][r] * lw0);
        mfr[mj >> 1][1][(mj & 1) * 4 + r] = (short)f2bf(g[mj][1][r] * lw1); } }
#pragma unroll
  for (int s4 = 0; s4 < 4; ++s4)
#pragma unroll
    for (int mp = 0; mp < 4; ++mp) { const bf16_t* xr = XT + (size_t)(h * 64 + mp * 16 + l15) * 128 + s4 * 32 + q * 4;
      bf16x8 xa = ld4x2g(xr, xr + 16);
      y[mp][0] = MFMA16(xa, mfr[s4][0], y[mp][0]); y[mp][1] = MFMA16(xa, mfr[s4][1], y[mp][1]); }
  __syncthreads();
  float* yl = f + 1024;
#pragma unroll
  for (int mp = 0; mp < 4; ++mp)
#pragma unroll
    for (int ni = 0; ni < 2; ++ni)
#pragma unroll
      for (int r = 0; r < 4; ++r) yl[(wave * 32 + ni * 16 + l15) * 65 + mp * 16 + q * 4 + r] = y[mp][ni][r];
  __syncthreads();
  float* YS = (float*)(p.ws + Ws::YS) + (size_t)(b * T_ + co * 128) * 512 + h * 64;
  for (int e = tid; e < 128 * 64; e += 256) gptr(YS)[(size_t)(e >> 6) * 512 + (e & 63)] = yl[(e >> 6) * 65 + (e & 63)];
}

#define GQ_LD 40
#define GK_LD 72
DEVFN void gla_chunk(const Params& p, int unit, unsigned char* smem) {
  const int tid = TIDX, lane = tid & 63, wave = tid >> 6, q = lane >> 4, l15 = lane & 15;
  const int h = unit & 3, co = (unit >> 2) % NC64, b = unit / (4 * NC64);
  const bf16_t* ZX = (const bf16_t*)(p.ws + Ws::ZX) + (size_t)(b * T_ + co * 64) * NIN_;
  const float* LA = (const float*)(p.ws + Ws::LA);
  float* cum = (float*)smem;
  bf16_t* qs = (bf16_t*)(smem + 16384);
  bf16_t* ks = qs + 2 * 64 * GQ_LD;
  bf16_t* kt = ks + 2 * 64 * GQ_LD;
  __syncthreads();
  float la[16]; bf16_t qraw[8], kraw[8];
#pragma unroll
  for (int it = 0; it < 16; ++it) { const int e = tid + 256 * it, d = e >> 11, i = (e >> 5) & 63, dd = e & 31;
    la[it] = gptr(LA)[((size_t)d * NT_ + b * T_ + co * 64 + i) * 128 + h * 32 + dd]; }
#pragma unroll
  for (int it = 0; it < 8; ++it) { const int e = tid + 256 * it, i = e >> 5, dd = e & 31;
    qraw[it] = gptr(ZX)[(size_t)i * NIN_ + OGQ + h * 32 + dd]; kraw[it] = gptr(ZX)[(size_t)i * NIN_ + OGK + h * 32 + dd]; }
  const bf16_t* VT = (const bf16_t*)(p.ws + Ws::VT) + ((size_t)(b * NC64 + co) * 256 + h * 64) * 64;
  bf16x8 vfa[4][2], vfs[2];
#pragma unroll
  for (int md = 0; md < 4; ++md)
#pragma unroll
    for (int s2 = 0; s2 < 2; ++s2) { const bf16_t* vr = VT + (size_t)(md * 16 + l15) * 64 + s2 * 32 + q * 4; vfa[md][s2] = ld4x2g(vr, vr + 16); }
#pragma unroll
  for (int s2 = 0; s2 < 2; ++s2) vfs[s2] = ld8g(VT + (size_t)(wave * 16 + l15) * 64 + s2 * 32 + q * 8);
#pragma unroll
  for (int it = 0; it < 16; ++it) cum[tid + 256 * it] = la[it];
  __syncthreads();
  if (tid < 64) { const int d = tid >> 5, dd = tid & 31; float* c = cum + d * 2048 + dd; float sacc = 0.f;
    if (d == 0) for (int i = 0; i < 64; ++i) { sacc += c[i * 32]; c[i * 32] = sacc; }
    else for (int i = 63; i >= 0; --i) { sacc += c[i * 32]; c[i * 32] = sacc; } }
  __syncthreads();
  bf16_t* QT = (bf16_t*)(p.ws + Ws::QT);
#pragma unroll
  for (int it = 0; it < 8; ++it) { const int e = tid + 256 * it, i = e >> 5, dd = e & 31;
    const float qv = bf2f(qraw[it]) * 0.17677669529663687f, kv = bf2f(kraw[it]);
    const float c0 = cum[i * 32 + dd], c1 = cum[2048 + i * 32 + dd], t0 = cum[63 * 32 + dd], t1 = cum[2048 + dd];
    const bf16_t q0 = f2bf(qv * expf(c0)), q1 = f2bf(qv * expf(c1));
    qs[i * GQ_LD + dd] = q0; qs[64 * GQ_LD + i * GQ_LD + dd] = q1;
    ks[i * GQ_LD + dd] = f2bf(kv * expf(-c0)); ks[64 * GQ_LD + i * GQ_LD + dd] = f2bf(kv * expf(-c1));
    kt[dd * GK_LD + i] = f2bf(kv * expf(t0 - c0)); kt[32 * GK_LD + dd * GK_LD + i] = f2bf(kv * expf(t1 - c1));
    const size_t tok = (size_t)b * T_ + co * 64 + i;
    gptr(QT)[tok * 128 + h * 32 + dd] = q0; gptr(QT)[((size_t)NT_ + tok) * 128 + h * 32 + dd] = q1; }
  if (tid < 64) { const int d = tid >> 5, dd = tid & 31; const int cs = cscan(d, co, CTX_ / 64, SEQ_ / 64);
    gptr((float*)(p.ws + Ws::GCD))[(((size_t)(d * B_ + b) * NC64 + cs) * 4 + h) * 32 + dd] = expf(d == 0 ? cum[63 * 32 + dd] : cum[2048 + dd]); }
  __syncthreads();
  bf16x8 pfr[2];
  { f32x4 p0[4], p1[4];
    const bf16x8 qb0 = ld8(qs + (wave * 16 + l15) * GQ_LD + q * 8), qb1 = ld8(qs + 64 * GQ_LD + (wave * 16 + l15) * GQ_LD + q * 8);
#pragma unroll
    for (int mj = 0; mj < 4; ++mj) { p0[mj] = MFMA16(ld8(ks + (mj * 16 + l15) * GQ_LD + q * 8), qb0, (f32x4{0.f, 0.f, 0.f, 0.f}));
      p1[mj] = MFMA16(ld8(ks + 64 * GQ_LD + (mj * 16 + l15) * GQ_LD + q * 8), qb1, (f32x4{0.f, 0.f, 0.f, 0.f})); }
    const int i = wave * 16 + l15;
#pragma unroll
    for (int mj = 0; mj < 4; ++mj)
#pragma unroll
      for (int r = 0; r < 4; ++r) { const int j = mj * 16 + q * 4 + r; pfr[mj >> 1][(mj & 1) * 4 + r] = (short)f2bf((j <= i ? p0[mj][r] : 0.f) + (j >= i ? p1[mj][r] : 0.f)); } }
  f32x4 o[4];
#pragma unroll
  for (int md = 0; md < 4; ++md) { o[md] = f32x4{0.f, 0.f, 0.f, 0.f};
#pragma unroll
    for (int s2 = 0; s2 < 2; ++s2) o[md] = MFMA16(vfa[md][s2], pfr[s2], o[md]); }
#pragma unroll
  for (int d = 0; d < 2; ++d) { const int cs = cscan(d, co, CTX_ / 64, SEQ_ / 64);
    float* GST = (float*)(p.ws + Ws::GST) + (((size_t)(d * B_ + b) * NC64 + cs) * 4 + h) * 2048;
#pragma unroll
    for (int nd = 0; nd < 2; ++nd) { f32x4 st = f32x4{0.f, 0.f, 0.f, 0.f};
#pragma unroll
      for (int s2 = 0; s2 < 2; ++s2) st = MFMA16(vfs[s2], ld8(kt + d * 32 * GK_LD + (nd * 16 + l15) * GK_LD + s2 * 32 + q * 8), st);
#pragma unroll
      for (int r = 0; r < 4; ++r) gptr(GST)[(wave * 16 + q * 4 + r) * 32 + nd * 16 + l15] = st[r]; } }
  __syncthreads();
  float* ol = (float*)smem;
#pragma unroll
  for (int md = 0; md < 4; ++md)
#pragma unroll
    for (int r = 0; r < 4; ++r) ol[(wave * 16 + l15) * 65 + md * 16 + q * 4 + r] = o[md][r];
  __syncthreads();
  float* OI = (float*)(p.ws + Ws::OI) + (size_t)(b * T_ + co * 64) * 256 + h * 64;
  for (int e = tid; e < 64 * 64; e += 256) gptr(OI)[(size_t)(e >> 6) * 256 + (e & 63)] = ol[(e >> 6) * 65 + (e & 63)];
}
#define GLA_SB ((NC64 % 34) == 0 ? 34 : ((NC64 % 17) == 0 ? 17 : NC64))
DEVFN void gla_scan(const Params& p, int gtid, int gthreads) {
  const AS1 float* ST = gptr((const float*)(p.ws + Ws::GST)); const AS1 float* CD = gptr((const float*)(p.ws + Ws::GCD)); AS1 bf16_t* SIN = gptr((bf16_t*)(p.ws + Ws::GSIN));
  for (int e = gtid; e < 2 * B_ * 4 * 2048; e += gthreads) {
    const int vd = e & 2047, h = (e >> 11) & 3, db = e >> 13;
    float sv = 0.f;
#pragma unroll 1
    for (int c0 = 0; c0 < NC64; c0 += GLA_SB) {
      float st[GLA_SB], cd[GLA_SB];
#pragma unroll
      for (int i = 0; i < GLA_SB; ++i) { st[i] = ST[(((size_t)db * NC64 + c0 + i) * 4 + h) * 2048 + vd]; cd[i] = CD[(((size_t)db * NC64 + c0 + i) * 4 + h) * 32 + (vd & 31)]; }
#pragma unroll
      for (int i = 0; i < GLA_SB; ++i) { SIN[(((size_t)db * NC64 + c0 + i) * 4 + h) * 2048 + vd] = f2bf(sv); sv = sv * cd[i] + st[i]; }
    }
  }
}
DEVFN void gla_out(const Params& p, int unit_base) {
  const int tid = TIDX, lane = tid & 63, wave = tid >> 6, g = lane >> 4, l15 = lane & 15;
  const int unit = unit_base + wave;
  if (unit >= B_ * NC64 * 4) return;
  const int h = unit & 3, co = (unit >> 2) % NC64, b = unit / (4 * NC64);
  const bf16_t* QT = (const bf16_t*)(p.ws + Ws::QT);
  const bf16_t* GSIN = (const bf16_t*)(p.ws + Ws::GSIN);
  float* OI = (float*)(p.ws + Ws::OI) + (size_t)(b * T_ + co * 64) * 256 + h * 64;
  const int tok0 = b * T_ + co * 64;
  bf16x8 af[2][4], bfr[2][4];
#pragma unroll
  for (int d = 0; d < 2; ++d) { const int cs = cscan(d, co, CTX_ / 64, SEQ_ / 64);
    const bf16_t* sr = GSIN + ((((size_t)(d * B_ + b) * NC64 + cs) * 4 + h) * 64) * 32;
#pragma unroll
    for (int mi = 0; mi < 4; ++mi) af[d][mi] = ld8g(QT + ((size_t)d * NT_ + tok0 + mi * 16 + l15) * 128 + h * 32 + g * 8);
#pragma unroll
    for (int ni = 0; ni < 4; ++ni) bfr[d][ni] = ld8g(sr + (ni * 16 + l15) * 32 + g * 8); }
  f32x4 acc[4][4];
#pragma unroll
  for (int mi = 0; mi < 4; ++mi)
#pragma unroll
    for (int ni = 0; ni < 4; ++ni)
#pragma unroll
      for (int i = 0; i < 4; ++i) acc[mi][ni][i] = gptr(OI)[(size_t)(mi * 16 + 4 * g + i) * 256 + ni * 16 + l15];
#pragma unroll
  for (int mi = 0; mi < 4; ++mi) {
#pragma unroll
    for (int ni = 0; ni < 4; ++ni) { acc[mi][ni] = MFMA16(af[0][mi], bfr[0][ni], acc[mi][ni]); acc[mi][ni] = MFMA16(af[1][mi], bfr[1][ni], acc[mi][ni]); }
#pragma unroll
    for (int ni = 0; ni < 4; ++ni)
#pragma unroll
      for (int i = 0; i < 4; ++i) gptr(OI)[(size_t)(mi * 16 + 4 * g + i) * 256 + ni * 16 + l15] = acc[mi][ni][i];
  }
}
DEVFN void convert_moe_weights(const Params& p, int l, unsigned char* smem, int bid, int nb, int j_lo, int j_hi);
#define CVT_JOBS (65 * 192)
#ifndef CVT_SCAN_SHARE
#define CVT_SCAN_SHARE (CVT_JOBS / 8)
#endif
DEVFN void phase4a(const Params& p, int l, unsigned char* smem) {
  const int n_r = B_ * 8 * NC16 / 4, G = (int)gridDim.x;
  RwRaw cur, nxt;
  int u = BIDX;
  if (u < n_r) rwc_load(p, u * 4, cur);
  for (; u < n_r; u += G) {
    rwc_load(p, (u + G < n_r ? u + G : u) * 4, nxt);
    rwkv_chunk(p, u * 4, smem, cur);
    cur = nxt;
  }
  (void)l;
}
#define CVT_GRP 8
DEVFN void phase4b(const Params& p, int l, unsigned char* smem) {
  const int bid = BIDX, nrw = B_ * 8, G = (int)gridDim.x;
  const int n_s = B_ * NC128 * 8, n_g = B_ * NC64 * 4;
  if (G >= 8 * nrw) {
    const int q = 2 * nrw, half = G >> 1, on = G - 4 * nrw;
    int sb = -1;
    if (bid < q) sb = bid; else if (bid >= half && bid < half + q) sb = q + (bid - half);
    const int n_c = (CVT_JOBS + CVT_GRP - 1) / CVT_GRP, total = n_s + n_g + n_c;
    unsigned* ctr = (unsigned*)(p.ws + Ws::BAR) + l * 32 + 16;
    volatile int* nxt_s = (volatile int*)(smem + SM_PRE);
    int u;
    if (sb >= 0) { if ((TIDX >> 6) == 0) rwkv_scan(p, sb >> 2, sb & 3, smem);
      __syncthreads();
      if (TIDX == 0) *nxt_s = on + (int)atomicAdd(ctr, 1u);
      __syncthreads();
      u = *nxt_s; }
    else u = bid < half ? bid - q : bid - 2 * q;
    while (u < total) {
      int nxt = 0;
      if (TIDX == 0) nxt = on + (int)atomicAdd(ctr, 1u);
      if (u < n_s) ssd_states(p, l, u, smem); else if (u < n_s + n_g) gla_chunk(p, u - n_s, smem);
      else { const int j0 = (u - n_s - n_g) * CVT_GRP, j1 = j0 + CVT_GRP < CVT_JOBS ? j0 + CVT_GRP : CVT_JOBS; convert_moe_weights(p, l, smem, 0, 1, j0, j1); }
      __syncthreads();
      if (TIDX == 0) *nxt_s = nxt;
      __syncthreads();
      u = *nxt_s;
    }
    return;
  }
  for (int u = bid; u < nrw; u += G) rwkv_scan(p, u, TIDX >> 6, smem + (TIDX >> 6) * 4096);
  for (int u = bid; u < n_s + n_g; u += G) { if (u < n_s) ssd_states(p, l, u, smem); else gla_chunk(p, u - n_s, smem); }
  convert_moe_weights(p, l, smem, bid, G, 0, CVT_JOBS);
}
DEVFN void phase4b2(const Params& p) {
  const int bid = BIDX, G = (int)gridDim.x;
  ssd_scan(p, bid * 256 + TIDX, G * 256); gla_scan(p, bid * 256 + TIDX, G * 256);
}
DEVFN void phase4c(const Params& p, int l, unsigned char* smem) {
  const int n_s = B_ * NC128 * 8, n_r = B_ * 8 * NC16 / 8, n_g = B_ * NC64, total = n_s + n_r + n_g, G = (int)gridDim.x;
  unsigned* ctr = (unsigned*)(p.ws + Ws::BAR) + l * 32;
  volatile int* nxt_s = (volatile int*)(smem + SM_PRE);
  int u = BIDX;
  while (u < total) {
    int nxt = 0;
    if (TIDX == 0) nxt = G + (int)atomicAdd(ctr, 1u);
    if (u < n_s) ssd_out(p, l, u, smem); else if (u < n_s + n_r) rwkv_out(p, (u - n_s) * 8); else gla_out(p, (u - n_s - n_r) * 4);
    __syncthreads();
    if (TIDX == 0) *nxt_s = nxt;
    __syncthreads();
    u = *nxt_s;
  }
}

DEVFN void phase5(const Params& p, int l, unsigned char* smem) {
  const int tid = TIDX, lane = tid & 63, wave = tid >> 6;
  const bf16_t* ZX = (const bf16_t*)(p.ws + Ws::ZX);
  const bf16_t* XBC = (const bf16_t*)(p.ws + Ws::XBC);
  const float* YS = (const float*)(p.ws + Ws::YS); const float* YR = (const float*)(p.ws + Ws::YR); const float* OI = (const float*)(p.ws + Ws::OI);
  const bf16_t* RR = (const bf16_t*)(p.ws + Ws::RR); const bf16_t* VV = (const bf16_t*)(p.ws + Ws::VV); const bf16_t* KD = (const bf16_t*)(p.ws + Ws::KD);
  const float* GATE = (const float*)(p.ws + Ws::GATE);
  bf16_t* YM = (bf16_t*)(p.ws + Ws::YMIX);
  constexpr int TPI = 2;
  float* red = (float*)smem;
  const float dA = INP(I_SSDD)[(size_t)l * 8 + (tid >> 6)], dB = INP(I_SSDD)[(size_t)l * 8 + 4 + (tid >> 6)];
  const float nwA = INP(I_SSDNW)[(size_t)l * 512 + tid], nwB = INP(I_SSDNW)[(size_t)l * 512 + 256 + tid];
  const float lnw = INP(I_LNXW)[(size_t)l * 256 + tid], lnb = INP(I_LNXB)[(size_t)l * 256 + tid], rk = INP(I_RK)[(size_t)l * 256 + tid];
  const float gnw = INP(I_GNW)[(size_t)l * 256 + tid];
  const int per_ = (NT_ / TPI + (int)gridDim.x - 1) / (int)gridDim.x, tp_lo = BIDX * per_, tp_hi = (tp_lo + per_ < NT_ / TPI) ? tp_lo + per_ : NT_ / TPI;
  struct In { float ys0[TPI], ys1[TPI], x0[TPI], x1[TPI], z0[TPI], z1[TPI], og[TPI], yr[TPI], rr[TPI], kf[TPI], kb[TPI], vv[TPI], gt[TPI], oi[TPI]; };
  auto load_in = [&](int tpq, In& d) {
#pragma unroll
    for (int t = 0; t < TPI; ++t) { const int tok = tpq * TPI + t;
      d.ys0[t] = gptr(YS)[(size_t)tok * 512 + tid]; d.ys1[t] = gptr(YS)[(size_t)tok * 512 + 256 + tid];
      d.x0[t] = bf2f(gptr(XBC)[(size_t)tok * 1024 + tid]); d.x1[t] = bf2f(gptr(XBC)[(size_t)tok * 1024 + 256 + tid]);
      d.z0[t] = zxv(ZX, tok, OZ + tid); d.z1[t] = zxv(ZX, tok, OZ + 256 + tid); d.og[t] = zxv(ZX, tok, OOG + tid);
      d.yr[t] = gptr(YR)[(size_t)tok * 256 + tid] + gptr(YR)[((size_t)NT_ + tok) * 256 + tid];
      d.rr[t] = bf2f(gptr(RR)[(size_t)tok * 256 + tid]); d.kf[t] = bf2f(gptr(KD)[(size_t)tok * 256 + tid]); d.kb[t] = bf2f(gptr(KD)[((size_t)NT_ + tok) * 256 + tid]);
      d.vv[t] = bf2f(gptr(VV)[(size_t)tok * 256 + tid]); d.gt[t] = gptr(GATE)[(size_t)tok * 256 + tid]; d.oi[t] = gptr(OI)[(size_t)tok * 256 + tid]; } };
  In cur, nxt;
  if (tp_lo < tp_hi) load_in(tp_lo, cur);
  for (int tp = tp_lo; tp < tp_hi; ++tp) {
    load_in(tp + 1 < tp_hi ? tp + 1 : tp, nxt);
    const float (&ys0)[TPI] = cur.ys0; const float (&ys1)[TPI] = cur.ys1; const float (&x0)[TPI] = cur.x0; const float (&x1)[TPI] = cur.x1;
    const float (&z0)[TPI] = cur.z0; const float (&z1)[TPI] = cur.z1; const float (&og)[TPI] = cur.og; const float (&yr)[TPI] = cur.yr;
    const float (&rr)[TPI] = cur.rr; const float (&kf)[TPI] = cur.kf; const float (&kb)[TPI] = cur.kb; const float (&vv)[TPI] = cur.vv;
    const float (&gt)[TPI] = cur.gt; const float (&oi)[TPI] = cur.oi;
    float ya[TPI], yb[TPI], qa[TPI], qb[TPI];
#pragma unroll
    for (int t = 0; t < TPI; ++t) {
      ya[t] = (ys0[t] + dA * x0[t]) * siluf_(z0[t]); yb[t] = (ys1[t] + dB * x1[t]) * siluf_(z1[t]);
      qa[t] = wave_sum(ya[t] * ya[t]); qb[t] = wave_sum(yb[t] * yb[t]); }
    __syncthreads();
#pragma unroll
    for (int t = 0; t < TPI; ++t)
      if (lane == 0) { red[t * 8 + wave] = qa[t]; red[t * 8 + 4 + wave] = qb[t]; }
    __syncthreads();
#pragma unroll
    for (int t = 0; t < TPI; ++t) { const int tok = tp * TPI + t;
      const float* rd = red + t * 8;
      float ma = (rd[0] + rd[1] + rd[2] + rd[3]) * (1.f / 256.f), mb = (rd[4] + rd[5] + rd[6] + rd[7]) * (1.f / 256.f);
      gptr(YM)[(size_t)tok * 1024 + tid] = f2bf(ya[t] * rsqrtf(ma + 1e-5f) * nwA);
      gptr(YM)[(size_t)tok * 1024 + 256 + tid] = f2bf(yb[t] * rsqrtf(mb + 1e-5f) * nwB);
      { const float y = yr[t];
        float mu = wave_sum(y) * (1.f / 64.f), d = y - mu, var = wave_sum(d * d) * (1.f / 64.f);
        float yn = d * rsqrtf(var + 64e-5f) * lnw + lnb;
        float bonus = wave_sum(rr[t] * (kf[t] + kb[t]) * rk) * vv[t];
        gptr(YM)[(size_t)tok * 1024 + 512 + tid] = f2bf((yn + bonus) * gt[t]); }
      { float o = oi[t];
        float ms = wave_sum(o * o) * (1.f / 64.f);
        gptr(YM)[(size_t)tok * 1024 + 768 + tid] = f2bf(o * rsqrtf(ms + 1e-5f) * gnw * siluf_(og[t])); } }
    cur = nxt;
  }
}

DEVFN void phase6(const Params& p, int l, unsigned char* smem) {
  const bf16_t* A = (const bf16_t*)(p.ws + Ws::YMIX);
  const bf16_t* W = (const bf16_t*)(p.ws + Ws::WOUT) + (size_t)l * 1024 * 1024;
  bf16_t* MIX = (bf16_t*)(p.ws + Ws::MIX);
  for (int u = BIDX; u < (NT_ / 128) * 8; u += gridDim.x) {
    int rt = u / 8, ct = u % 8;
    gemm_tile(smem, 1024,
      [&](int r) { return A + (size_t)(rt * 128 + r) * 1024; },
      [&](int r) { return W + (size_t)(ct * 128 + r) * 1024; },
      [&](f32x4 (&acc)[4][4], int wr, int wc, int g, int l15) {
        tile_store_bf16<16>(smem, wr, g, l15,
          [&](bf16_t* T, int ldc) {
#pragma unroll
            for (int mi = 0; mi < 4; ++mi)
#pragma unroll
              for (int ni = 0; ni < 4; ++ni)
#pragma unroll
                for (int i = 0; i < 4; ++i) T[(wr * 64 + mi * 16 + 4 * g + i) * ldc + wc * 64 + ni * 16 + l15] = f2bf(acc[mi][ni][i]); },
          [&](int row, int c0) { return MIX + (size_t)(rt * 128 + row) * 1024 + ct * 128 + c0; });
      });
  }
}

#define P7_MAXE 2048
DEVFN void phase7(const Params& p, int l, unsigned char* smem) {
  const int lane = TIDX & 63, wave = TIDX >> 6;
  float* X = (float*)(p.ws + Ws::X);
  const bf16_t* MIX = (const bf16_t*)(p.ws + Ws::MIX);
  bf16_t* H = (bf16_t*)(p.ws + Ws::U);
  const float* rwt = (const float*)(p.ws + Ws::RWT) + (size_t)l * 64 * 1024;
  int* cnt = (int*)(p.ws + Ws::CNT) + l * 64 * 64;
  int* ltok = (int*)(p.ws + Ws::LTOK); float* lwt = (float*)(p.ws + Ws::LWT);
  const float rbias = INP(I_RB)[(size_t)l * 64 + lane];
  float* hs = (float*)smem;
  float* lg = hs + 4096;
  int* lcnt = (int*)(lg + 256);
  int* lbase = lcnt + 80;
  int* etok = lbase + 64;
  int* epos = etok + P7_MAXE; float* ewt = (float*)(epos + P7_MAXE);
  for (int i = TIDX; i < 80; i += 256) lcnt[i] = 0;
  float xn[16]; u32x2 mn[4];
  auto prefetch_rows = [&](int t) {
    load_row16(X + (size_t)t * 1024, lane, xn);
#pragma unroll
    for (int j = 0; j < 4; ++j) mn[j] = *(const AS1 u32x2*)(gptr(MIX) + (size_t)t * 1024 + lane * 4 + 256 * j); };
  if (BIDX * 4 < NT_) prefetch_rows(BIDX * 4 + wave);
  for (int tok0 = BIDX * 4; tok0 < NT_; tok0 += gridDim.x * 4) {
    const int tok = tok0 + wave;
    const float* mod = (const float*)(p.ws + Ws::MOD) + ((size_t)l * NR_ + tok_modrow(tok)) * NMOD_;
    float xv[16], mx[16], g1[16], lw[16], lb[16], sh2[16], sc2[16], mean, rstd;
#pragma unroll
    for (int i = 0; i < 16; ++i) xv[i] = xn[i];
#pragma unroll
    for (int j = 0; j < 4; ++j) { mx[4 * j] = bf2f((bf16_t)(mn[j][0] & 0xFFFF)); mx[4 * j + 1] = bf2f((bf16_t)(mn[j][0] >> 16)); mx[4 * j + 2] = bf2f((bf16_t)(mn[j][1] & 0xFFFF)); mx[4 * j + 3] = bf2f((bf16_t)(mn[j][1] >> 16)); }
    load_row16(mod + 2 * 1024, lane, g1);
    load_row16(INP(I_LN1W) + (size_t)l * 1024, lane, lw);
    load_row16(INP(I_LN1B) + (size_t)l * 1024, lane, lb);
    load_row16(mod + 3 * 1024, lane, sh2);
    load_row16(mod + 4 * 1024, lane, sc2);
#pragma unroll
    for (int i = 0; i < 16; ++i) xv[i] = ALPHA_ * xv[i] + g1[i] * mx[i];
    row_stats(xv, mean, rstd);
#pragma unroll
    for (int i = 0; i < 16; ++i) xv[i] = (xv[i] - mean) * rstd * lw[i] + lb[i];
#pragma unroll
    for (int j = 0; j < 4; ++j) *(AS1 f32x4*)gptr(X + (size_t)tok * 1024 + lane * 4 + 256 * j) = f32x4{xv[4 * j], xv[4 * j + 1], xv[4 * j + 2], xv[4 * j + 3]};
    const bool routed = !(l == DEPTH_ - 1 && (tok % T_) < CTX_);
    row_stats(xv, mean, rstd);
#pragma unroll
    for (int i = 0; i < 16; ++i) xv[i] = (xv[i] - mean) * rstd * (1.f + sc2[i]) + sh2[i];
    __syncthreads();
#pragma unroll
    for (int j = 0; j < 4; ++j) {
      if (routed) { u32x2 hv2; hv2[0] = (unsigned)f2bf(xv[4 * j]) | ((unsigned)f2bf(xv[4 * j + 1]) << 16); hv2[1] = (unsigned)f2bf(xv[4 * j + 2]) | ((unsigned)f2bf(xv[4 * j + 3]) << 16); *(AS1 u32x2*)gptr(H + (size_t)tok * 1024 + lane * 4 + 256 * j) = hv2; }
      *(float4*)(hs + wave * 1024 + lane * 4 + 256 * j) = make_float4(xv[4 * j], xv[4 * j + 1], xv[4 * j + 2], xv[4 * j + 3]); }
    __syncthreads();
    { float hv[4][16];
      const int rot = BIDX & 15;
#pragma unroll
      for (int t = 0; t < 4; ++t)
#pragma unroll
        for (int j = 0; j < 4; ++j) { const float4 v = *(const float4*)(hs + t * 1024 + lane * 4 + 256 * j); hv[t][4 * j] = v.x; hv[t][4 * j + 1] = v.y; hv[t][4 * j + 2] = v.z; hv[t][4 * j + 3] = v.w; }
      float pe[64];
      const AS1 float* rw = gptr(rwt) + lane * 4;
      f32x4 w[4], wn[4];
#pragma unroll
      for (int j = 0; j < 4; ++j) w[j] = *(const AS1 f32x4*)(rw + (size_t)(16 * wave + (rot & 15)) * 1024 + 256 * j);
#pragma unroll
      for (int e = 0; e < 16; ++e) {
        if (e + 1 < 16) {
#pragma unroll
          for (int j = 0; j < 4; ++j) wn[j] = *(const AS1 f32x4*)(rw + (size_t)(16 * wave + ((e + 1 + rot) & 15)) * 1024 + 256 * j); }
#pragma unroll
        for (int t = 0; t < 4; ++t) { float s0 = 0.f, s1 = 0.f;
#pragma unroll
          for (int j = 0; j < 4; ++j) { s0 += hv[t][4 * j] * w[j][0] + hv[t][4 * j + 2] * w[j][2]; s1 += hv[t][4 * j + 1] * w[j][1] + hv[t][4 * j + 3] * w[j][3]; }
          pe[e * 4 + t] = s0 + s1; }
#pragma unroll
        for (int j = 0; j < 4; ++j) w[j] = wn[j]; }
#pragma unroll
      for (int half = 32; half >= 1; half >>= 1) { const bool up = (lane & half) != 0;
#pragma unroll
        for (int e = 0; e < half; ++e) { const float send = up ? pe[e] : pe[e + half]; const float recv = __shfl_xor(send, half); pe[e] = (up ? pe[e + half] : pe[e]) + recv; } }
      lg[(lane & 3) * 64 + 16 * wave + (((lane >> 2) + rot) & 15)] = pe[0]; }
    { const int tn0 = tok0 + (int)gridDim.x * 4; prefetch_rows((tn0 < NT_ ? tn0 : tok0) + wave); }
    __syncthreads();
    if (!routed) continue;
    const float logit = lg[wave * 64 + lane];
    const float score = sigmoidf_(logit), sel = score + rbias;
    float m1 = sel; int a1 = lane;
#pragma unroll
    for (int m = 1; m <= 4; m <<= 1) { float ov = XOR8(m1, m); int oa = XOR8(a1, m); if (ov > m1 || (ov == m1 && oa < a1)) { m1 = ov; a1 = oa; } }
    float m2 = (lane == a1) ? -3.0e38f : sel;
#pragma unroll
    for (int m = 1; m <= 4; m <<= 1) m2 = fmaxf(m2, XOR8(m2, m));
    const float gs = m1 + m2; const int grp = lane >> 3;
    int grank = 0;
#pragma unroll
    for (int g2 = 0; g2 < 8; ++g2) { float og = SHFL_CONST(gs, g2 * 8); grank += (og > gs || (og == gs && g2 < grp)) ? 1 : 0; }
    const bool gsel = grank < 4;
    const float msel = gsel ? sel : -3.0e38f;
    int rank = 0;
#pragma unroll
    for (int e = 0; e < 64; ++e) { float ov = SHFL_CONST(msel, e); rank += (ov > msel || (ov == msel && e < lane)) ? 1 : 0; }
    const bool chosen = gsel && rank < 8;
    const float wsum = wave_sum(chosen ? score : 0.f);
    if (chosen) { const float wv = score / wsum * 2.5f;
      const int idx = atomicAdd(&lcnt[64], 1);
      if (idx < P7_MAXE) { const int slot = atomicAdd(&lcnt[lane], 1); etok[idx] = tok * 8 + rank; epos[idx] = lane | (slot << 8); ewt[idx] = wv; }
      else { int pos = atomicAdd(&cnt[lane * 64], 1); ltok[(size_t)lane * NT_ + pos] = tok * 8 + rank; lwt[(size_t)lane * NT_ + pos] = wv; } }
  }
  __syncthreads();
  if (TIDX < 64) { const int c = lcnt[TIDX]; lbase[TIDX] = c ? atomicAdd(&cnt[TIDX * 64], c) : 0; }
  __syncthreads();
  { const int ne = lcnt[64] < P7_MAXE ? lcnt[64] : P7_MAXE;
    for (int i = TIDX; i < ne; i += 256) { const int e = epos[i] & 255, pos = lbase[e] + (epos[i] >> 8);
      ltok[(size_t)e * NT_ + pos] = etok[i]; lwt[(size_t)e * NT_ + pos] = ewt[i]; } }
}

struct MoeMap { int nblk_total; int e; int rb; int cnt; int hoff; };
DEVFN int moe_ntok(int l) { return l == DEPTH_ - 1 ? B_ * SEQ_ : NT_; }
DEVFN int moe_shared_tok(int l, int i) { return l == DEPTH_ - 1 ? (i / SEQ_) * T_ + CTX_ + (i % SEQ_) : i; }
DEVFN void moe_prefix(const Params& p, int l, int* pre) {
  const int* cnt = (const int*)(p.ws + Ws::CNT) + l * 64 * 64;
  __syncthreads();
  if (TIDX < 64) pre[66 + TIDX] = gptr(cnt)[TIDX * 64];
  { int nt_ = moe_ntok(l); LAUNDER(nt_); if (TIDX == 64) pre[66 + 64] = nt_; }
  __syncthreads();
  if (TIDX == 0) { int s = 0; for (int e = 0; e < 65; ++e) { pre[e] = s; s += (pre[66 + e] + 127) / 128; } pre[65] = s; }
  __syncthreads();
}
DEVFN void phase8(const Params& p, int l, unsigned char* smem) {
  int* pre = (int*)(smem + SM_PRE);
  moe_prefix(p, l, pre);
  const bf16_t* H = (const bf16_t*)(p.ws + Ws::U);
  const bf16_t* W13 = (const bf16_t*)(p.ws + Ws::W13);
  bf16_t* HID = (bf16_t*)(p.ws + Ws::HID);
  const int* ltok = (const int*)(p.ws + Ws::LTOK); const float* lwt = (const float*)(p.ws + Ws::LWT);
  const int total = pre[65];
  for (int u = BIDX; u < total * 2; u += gridDim.x) {
    const int gb = u >> 1, nt = u & 1;
    int e = 0; while (pre[e + 1] <= gb) ++e;
    e = UNI(e);
    const int rb = UNI(gb - pre[e]), cnt = UNI(pre[66 + e]);
    int* tk_s = (int*)(smem + GEMMW_SMEM); float* gw_s = (float*)(tk_s + 128);
    __syncthreads();
    if (TIDX < 128) { const int pos = rb * 128 + TIDX; int tk = -1; float gw = 0.f;
      if (pos < cnt) { tk = e < 64 ? (gptr(ltok)[(size_t)e * NT_ + pos] >> 3) : moe_shared_tok(l, pos); gw = e < 64 ? gptr(lwt)[(size_t)e * NT_ + pos] : 1.f; }
      tk_s[TIDX] = tk; gw_s[TIDX] = gw; }
    __syncthreads();
    gemm_tile_w<1, 1024>(smem, 1024,
      [&](int r) { const int tk = tk_s[r]; return tk >= 0 ? H + (size_t)tk * 1024 : (const bf16_t*)(p.ws + Ws::ZROW); },
      [&](int) { return W13 + ((size_t)e * 512 + nt * 256) * 1024; },
      [&](f32x4 (&acc)[4][8], int, int wr, int wc, int g, int l15) {
        tile_store_bf16<16>(smem, wr, g, l15,
          [&](bf16_t* T, int ldc) {
#pragma unroll
            for (int mi = 0; mi < 4; ++mi)
#pragma unroll
              for (int i = 0; i < 4; ++i) { const int r = wr * 64 + mi * 16 + 4 * g + i;
                const float gw = gw_s[r];
#pragma unroll
                for (int j = 0; j < 4; ++j) T[r * ldc + wc * 64 + j * 16 + l15] = f2bf(siluf_(acc[mi][2 * j][i]) * acc[mi][2 * j + 1][i] * gw); } },
          [&](int row, int c0) { const int pos = rb * 128 + row; return pos < cnt ? HID + ((size_t)gb * 128 + row) * 256 + nt * 128 + c0 : (bf16_t*)nullptr; });
      });
  }
}
DEVFN void phase9(const Params& p, int l, unsigned char* smem) {
  int* pre = (int*)(smem + SM_PRE);
  moe_prefix(p, l, pre);
  const bf16_t* HID = (const bf16_t*)(p.ws + Ws::HID);
  const bf16_t* W2T = (const bf16_t*)(p.ws + Ws::W2T);
  bf16_t* YB = (bf16_t*)(p.ws + Ws::YBUF);
  const int* ltok = (const int*)(p.ws + Ws::LTOK);
  const int total = pre[65];
  for (int u = BIDX; u < total * 2; u += gridDim.x) {
    const int gb = u >> 1, ntp = u & 1;
    int e = 0; while (pre[e + 1] <= gb) ++e;
    e = UNI(e);
    const int rb = UNI(gb - pre[e]), cnt = UNI(pre[66 + e]);
    int* ts_s = (int*)(smem + GEMMW_SMEM);
    __syncthreads();
    if (TIDX < 128) { const int pos = rb * 128 + TIDX; int ts = -1;
      if (pos < cnt) ts = e < 64 ? gptr(ltok)[(size_t)e * NT_ + pos] : moe_shared_tok(l, pos) * 8;
      ts_s[TIDX] = ts; }
    __syncthreads();
    gemm_tile_w<2, 256>(smem, 256,
      [&](int r) { return ts_s[r] >= 0 ? HID + ((size_t)gb * 128 + r) * 256 : (const bf16_t*)(p.ws + Ws::ZROW); },
      [&](int j) { return W2T + ((size_t)e * 1024 + (ntp * 2 + j) * 256) * 256; },
      [&](f32x4 (&acc)[4][8], int j, int wr, int wc, int g, int l15) { const int nt = ntp * 2 + j;
        unsigned char* T8 = smem; constexpr int LD8 = 272;
        unsigned char* YB8 = (unsigned char*)YB;
        __syncthreads();
#pragma unroll
        for (int mi = 0; mi < 4; ++mi)
#pragma unroll
          for (int ni = 0; ni < 8; ++ni)
#pragma unroll
            for (int i = 0; i < 4; i += 2) { const unsigned pk = FP8PK(acc[mi][ni][i] * FP8_SCALE, acc[mi][ni][i + 1] * FP8_SCALE);
              unsigned char* t = T8 + (wr * 64 + mi * 16 + 4 * g + i) * LD8 + wc * 128 + ni * 16 + l15;
              t[0] = (unsigned char)(pk & 0xFFu); t[LD8] = (unsigned char)(pk >> 8); }
        __syncthreads();
#pragma unroll
        for (int pass = 0; pass < 8; ++pass) { const int id = TIDX + 256 * pass, row = id >> 4, c = id & 15; const int ts = ts_s[row];
          if (ts >= 0) { const int tok = ts >> 3, slot = e < 64 ? (ts & 7) : 8;
            *(AS1 u32x4*)gptr(YB8 + ((size_t)tok * NSLOT + slot) * 1024 + nt * 256 + c * 16) = *(const u32x4*)(T8 + row * LD8 + c * 16); } }
      });
  }
}

#define SMEM_BYTES (PH_SMEM + 2048)
#define N_PHASES (3 + 13 * DEPTH_)
__global__ void __launch_bounds__(256, 2) mega(Params p, int ph_lo, int ph_hi) {
#ifdef HIPEMU
  unsigned char* smem = hipemu::cur_smem();
#else
  unsigned char* smem = smem_dyn;
  volatile LAS unsigned* st = (volatile LAS unsigned*)(smem_dyn + SM_BAR);
  if (threadIdx.x == 0) {
    st[0] = 0u; st[1] = 0u;
    unsigned long long* tab = (unsigned long long*)(smem_dyn + SM_TAB);
#pragma unroll
    for (int i = 0; i < 40; ++i) tab[i] = (unsigned long long)p.in[i];
  }
  __syncthreads();
  XcdBarrier bar = xcd_barrier_post((unsigned*)(p.ws + Ws::BAR), st);
#define GRID_SYNC() xcd_barrier(bar)
#endif
  int ph = 0;
#ifdef ONLY_KIND
#define KIND_ON(k) ((k) == ONLY_KIND)
#else
#define KIND_ON(k) 1
#endif
#ifndef REPEAT_MASK
#define REPEAT_MASK 0u
#endif
#define RUN_PHASE(kind, code) { if (KIND_ON(kind) && ph >= ph_lo && ph < ph_hi) { \
    int nrep_ = ((REPEAT_MASK >> (kind)) & 1u) ? 2 : 1; LAUNDER(nrep_); \
    _Pragma("unroll 1") for (int rep_ = 0; rep_ < nrep_; ++rep_) { LAUNDER(p.ws); LAUNDER(p.out); code; if (rep_ + 1 < nrep_ || ph + 1 < ph_hi) { GRID_SYNC(); } } } ++ph; }
  RUN_PHASE(0, phase0(p, smem));
  RUN_PHASE(11, phase0b(p));
  for (int l = 0; l < DEPTH_; ++l) {
    RUN_PHASE(1, phase1(p, l));
    RUN_PHASE(2, phase2(p, l, smem));
    RUN_PHASE(3, phase3(p, l, smem));
    RUN_PHASE(14, phase3b(p, l, smem));
    RUN_PHASE(4, phase4a(p, l, smem));
    RUN_PHASE(12, phase4b(p, l, smem));
    RUN_PHASE(16, phase4b2(p));
    RUN_PHASE(13, phase4c(p, l, smem));
    RUN_PHASE(5, phase5(p, l, smem));
    RUN_PHASE(6, phase6(p, l, smem));
    RUN_PHASE(7, phase7(p, l, smem));
    RUN_PHASE(8, phase8(p, l, smem));
    RUN_PHASE(9, phase9(p, l, smem));
  }
  RUN_PHASE(10, phase_final(p));
}

extern "C" void kernel_launch(void* const* d_in, const int* in_sizes, int n_in, void* d_out, int out_size, void* d_ws, size_t ws_size, hipStream_t stream) {
  Params p{};
  for (int i = 0; i < 40; ++i) p.in[i] = (const float*)d_in[i];
  p.out = (float*)d_out;
  p.ws = (unsigned char*)d_ws;
  if (ws_size < Ws::END) { fprintf(stderr, "workspace too small: %zu < %zu\n", ws_size, (size_t)Ws::END); return; }
  hipMemsetAsync(d_ws, 0, Ws::ZERO_END, stream);
#ifdef HIPEMU
  int grid = 16; if (const char* e = getenv("EMU_GRID")) grid = atoi(e);
  int stop = N_PHASES; if (const char* e = getenv("EMU_STOP")) stop = atoi(e);
  if (getenv("EMU_ONE")) hipemu::launch(grid, 256, SMEM_BYTES, true, [=] { mega(p, 0, stop); });
  else for (int ph = 0; ph < stop; ++ph) hipemu::launch(grid, 256, SMEM_BYTES, false, [=] { mega(p, ph, ph + 1); });
#else
  static int grid = 0;
  if (!grid) {
    int dev = 0, cus = 0, per_cu = 0;
    hipGetDevice(&dev);
    hipDeviceGetAttribute(&cus, hipDeviceAttributeMultiprocessorCount, dev);
    hipOccupancyMaxActiveBlocksPerMultiprocessor(&per_cu, mega, 256, SMEM_BYTES);
    if (per_cu > 2) per_cu = 2;
    if (per_cu < 1) per_cu = 1;
    grid = cus * per_cu;
  }
#if N_LAUNCH_MODE == 1
  mega<<<grid, 256, SMEM_BYTES, stream>>>(p, 0, N_PHASES);
#else
  for (int ph = 0; ph < N_PHASES; ++ph) mega<<<grid, 256, SMEM_BYTES, stream>>>(p, ph, ph + 1);
#endif
#endif
}
```
